# Optimizing an MI355X kernel written in HIP

```python
import math
import jax, jax.numpy as jnp
from jax import lax
import numpy as np

D_MODEL = 1024
BATCH = 8
SEQ = 4096
DEPTH = 2

N_MIXERS = 2
RET_HEADS = 4
RET_QK_DIM = D_MODEL // RET_HEADS
RET_V_DIM = 2 * RET_QK_DIM
RET_QK_WIDTH = RET_HEADS * RET_QK_DIM
RET_V_WIDTH = RET_HEADS * RET_V_DIM
RET_IN_WIDTH = 2 * RET_QK_WIDTH + 2 * RET_V_WIDTH
RET_CHUNK = 128
ROPE_BASE = 10000.0
FNET_GROUPS = 4
FNET_GROUP_DIM = D_MODEL // FNET_GROUPS
D_FF_DENSE = ((8 * D_MODEL // 3 + 255) // 256) * 256
N_EXPERTS = 8
TOP_K = 2
D_FF_EXPERT = 7 * D_MODEL // 2
EPS = 1e-6

kernel_name = "hybrid_retention_fnet_moe_encoder"


def rms_norm(x, g):
    xf = x.astype(jnp.float32)
    y = xf * lax.rsqrt(jnp.mean(xf * xf, axis=-1, keepdims=True) + EPS)
    return (y * g.astype(jnp.float32)).astype(x.dtype)


def rotary(t):
    s, dh = t.shape[1], t.shape[-1]
    half = dh // 2
    inv = ROPE_BASE ** (-jnp.arange(half, dtype=jnp.float32) / half)
    ang = jnp.arange(s, dtype=jnp.float32)[:, None] * inv[None, :]
    cos = jnp.cos(ang)[None, :, None, :]
    sin = jnp.sin(ang)[None, :, None, :]
    t1 = t[..., :half].astype(jnp.float32)
    t2 = t[..., half:].astype(jnp.float32)
    return jnp.concatenate([t1 * cos - t2 * sin, t1 * sin + t2 * cos], axis=-1).astype(t.dtype)


def chunk_retention(q, k, v, log_gamma, inclusive):
    b, h, s, dk = q.shape
    dv = v.shape[-1]
    c = RET_CHUNK
    n = s // c
    dt = q.dtype
    qc = q.reshape(b, h, n, c, dk)
    kc = k.reshape(b, h, n, c, dk)
    vc = v.reshape(b, h, n, c, dv)
    idx = jnp.arange(c, dtype=jnp.float32)
    diff = idx[:, None] - idx[None, :]
    mask = (diff >= 0) if inclusive else (diff > 0)
    lg = log_gamma[:, None, None]
    decay = jnp.where(mask[None], jnp.exp(jnp.where(mask[None], diff[None] * lg, 0.0)), 0.0)
    scores = jnp.einsum('bhnid,bhnjd->bhnij', qc, kc) * decay[None, :, None].astype(dt)
    intra = jnp.einsum('bhnij,bhnje->bhnie', scores, vc)

    xi = jnp.exp((idx[None, :] + 1.0) * log_gamma[:, None]).astype(dt)
    zeta = jnp.exp((c - 1.0 - idx[None, :]) * log_gamma[:, None]).astype(dt)
    g_chunk = jnp.exp(c * log_gamma).astype(dt)

    def step(state, inp):
        q_n, k_n, v_n = inp
        cross = jnp.einsum('bhid,bhde->bhie', q_n * xi[None, :, :, None], state)
        state = state * g_chunk[None, :, None, None] + jnp.einsum(
            'bhjd,bhje->bhde', k_n * zeta[None, :, :, None], v_n)
        return state, cross

    state0 = jnp.zeros((b, h, dk, dv), dt)
    xs = (jnp.moveaxis(qc, 2, 0), jnp.moveaxis(kc, 2, 0), jnp.moveaxis(vc, 2, 0))
    _, cross = lax.scan(step, state0, xs)
    cross = jnp.moveaxis(cross, 0, 2)
    return (intra + cross).reshape(b, h, s, dv)


def retention_mixer(h, w_in, decay_logit, gn_gain, w_out):
    b, s, _ = h.shape
    proj = h @ w_in
    q, k, v, g = jnp.split(proj, [RET_QK_WIDTH, 2 * RET_QK_WIDTH, 2 * RET_QK_WIDTH + RET_V_WIDTH], axis=-1)
    q = rotary(q.reshape(b, s, RET_HEADS, RET_QK_DIM))
    k = rotary(k.reshape(b, s, RET_HEADS, RET_QK_DIM)) * (RET_QK_DIM ** -0.5)
    v = v.reshape(b, s, RET_HEADS, RET_V_DIM)
    q, k, v = (jnp.transpose(t, (0, 2, 1, 3)) for t in (q, k, v))
    log_g = jax.nn.log_sigmoid(decay_logit.astype(jnp.float32))
    fwd = chunk_retention(q, k, v, log_g[0], True)
    bwd = jnp.flip(chunk_retention(jnp.flip(q, 2), jnp.flip(k, 2), jnp.flip(v, 2), log_g[1], False), 2)
    y = (fwd + bwd).astype(jnp.float32)
    mu = jnp.mean(y, axis=-1, keepdims=True)
    var = jnp.mean(jnp.square(y - mu), axis=-1, keepdims=True)
    yn = (y - mu) * lax.rsqrt(var + EPS)
    yn = jnp.transpose(yn, (0, 2, 1, 3)).reshape(b, s, RET_V_WIDTH) * gn_gain.astype(jnp.float32)
    return (jax.nn.silu(g) * yn.astype(h.dtype)) @ w_out


def fourier_mixer(h, w_out):
    b, s, d = h.shape
    hg = h.astype(jnp.float32).reshape(b, s, FNET_GROUPS, FNET_GROUP_DIM)
    y = jnp.fft.fft2(hg, axes=(1, 3), norm='ortho').real
    return y.reshape(b, s, d).astype(h.dtype) @ w_out


def swiglu(t, w_gate, w_up, w_down):
    return (jax.nn.silu(t @ w_gate) * (t @ w_up)) @ w_down


def moe_swiglu(h, w_router, w_gate, w_up, w_down):
    b, s, d = h.shape
    t = h.reshape(-1, d)
    logits = (t @ w_router).astype(jnp.float32)
    top_val, top_idx = lax.top_k(logits, TOP_K)
    top_w = jax.nn.softmax(top_val, axis=-1)
    gates = jnp.sum(jax.nn.one_hot(top_idx, N_EXPERTS, dtype=jnp.float32) * top_w[..., None], axis=1)
    gates = gates.astype(h.dtype)
    out = jnp.zeros_like(t)
    for e in range(N_EXPERTS):
        out = out + gates[:, e:e + 1] * swiglu(t, w_gate[e], w_up[e], w_down[e])
    return out.reshape(b, s, d)


def setup_inputs(seed: int = 0) -> dict:
    key = jax.random.key(seed)
    ks = jax.random.split(key, 20)
    n_even = (DEPTH + 1) // 2
    n_odd = DEPTH // 2
    f32 = jnp.float32

    def nrm(k, shape, fan_in):
        return jax.random.normal(k, shape, f32) * (fan_in ** -0.5)

    x = jax.random.normal(ks[0], (BATCH, SEQ, D_MODEL), f32)
    mix_norm = 1.0 + 0.02 * jax.random.normal(ks[1], (DEPTH, D_MODEL), f32)
    ffn_norm = 1.0 + 0.02 * jax.random.normal(ks[2], (DEPTH, D_MODEL), f32)
    ret_w_in = nrm(ks[3], (n_even, D_MODEL, RET_IN_WIDTH), D_MODEL)
    gam = 1.0 - jnp.exp(jnp.linspace(math.log(1.0 / 32), math.log(1.0 / 512), RET_HEADS)).astype(f32)
    base_logit = jnp.log(gam) - jnp.log1p(-gam)
    ret_decay_logit = base_logit[None, None, :] + 0.05 * jax.random.normal(ks[4], (n_even, 2, RET_HEADS), f32)
    ret_gn_gain = 1.0 + 0.02 * jax.random.normal(ks[5], (n_even, RET_V_WIDTH), f32)
    ret_w_out = nrm(ks[6], (n_even, RET_V_WIDTH, D_MODEL), RET_V_WIDTH)
    dense_w_gate = nrm(ks[7], (n_even, D_MODEL, D_FF_DENSE), D_MODEL)
    dense_w_up = nrm(ks[8], (n_even, D_MODEL, D_FF_DENSE), D_MODEL)
    dense_w_down = nrm(ks[9], (n_even, D_FF_DENSE, D_MODEL), D_FF_DENSE)
    fnet_w_out = nrm(ks[10], (n_odd, D_MODEL, D_MODEL), D_MODEL)
    moe_router = nrm(ks[11], (n_odd, D_MODEL, N_EXPERTS), D_MODEL)
    moe_w_gate = nrm(ks[12], (n_odd, N_EXPERTS, D_MODEL, D_FF_EXPERT), D_MODEL)
    moe_w_up = nrm(ks[13], (n_odd, N_EXPERTS, D_MODEL, D_FF_EXPERT), D_MODEL)
    moe_w_down = nrm(ks[14], (n_odd, N_EXPERTS, D_FF_EXPERT, D_MODEL), D_FF_EXPERT)
    final_norm = 1.0 + 0.02 * jax.random.normal(ks[15], (D_MODEL,), f32)
    return {"x": x, "mix_norm": mix_norm, "ffn_norm": ffn_norm,
            "ret_w_in": ret_w_in, "ret_decay_logit": ret_decay_logit,
            "ret_gn_gain": ret_gn_gain, "ret_w_out": ret_w_out,
            "dense_w_gate": dense_w_gate, "dense_w_up": dense_w_up, "dense_w_down": dense_w_down,
            "fnet_w_out": fnet_w_out, "moe_router": moe_router,
            "moe_w_gate": moe_w_gate, "moe_w_up": moe_w_up, "moe_w_down": moe_w_down,
            "final_norm": final_norm}


def reference(x, mix_norm, ffn_norm, ret_w_in, ret_decay_logit, ret_gn_gain, ret_w_out,
              dense_w_gate, dense_w_up, dense_w_down, fnet_w_out, moe_router,
              moe_w_gate, moe_w_up, moe_w_down, final_norm):
    h = x
    for i in range(DEPTH):
        j = i // 2
        hn = rms_norm(h, mix_norm[i])
        if i % N_MIXERS == 0:
            h = h + retention_mixer(hn, ret_w_in[j], ret_decay_logit[j], ret_gn_gain[j], ret_w_out[j])
        else:
            h = h + fourier_mixer(hn, fnet_w_out[j])
        hn = rms_norm(h, ffn_norm[i])
        if i % 2 == 0:
            h = h + swiglu(hn, dense_w_gate[j], dense_w_up[j], dense_w_down[j])
        else:
            h = h + moe_swiglu(hn, moe_router[j], moe_w_gate[j], moe_w_up[j], moe_w_down[j])
    return rms_norm(h, final_norm)
```

```cpp
#include <hip/hip_runtime.h>
#include <cstdio>
#include <cstdint>

#define LAS __attribute__((address_space(3)))
#define GAS __attribute__((address_space(1)))
typedef unsigned short bf16;
typedef short bf16x8 __attribute__((ext_vector_type(8)));
typedef float f32x2 __attribute__((ext_vector_type(2)));
typedef float f32x4 __attribute__((ext_vector_type(4)));
typedef float f32x16 __attribute__((ext_vector_type(16)));
typedef unsigned u32x2 __attribute__((ext_vector_type(2)));
typedef unsigned u32x4 __attribute__((ext_vector_type(4)));
typedef GAS unsigned gu32;

constexpr int D = 1024, NB = 8, SEQ = 4096, T = NB * SEQ;
constexpr int NH = 4, DK = 256, DV = 512, QKW = 1024, VW = 2048, INW = 6144, CH = 128, NCH = SEQ / CH;
constexpr int FFD = 2816, NE = 8, FFE = 3584;
constexpr int MOE_ROWS = T + NE * 256;
constexpr float EPS = 1e-6f;

constexpr size_t MiB = 1u << 20;
constexpr size_t WS_CTL = 0, CTL_ZERO_BYTES = 1 * MiB;
constexpr size_t WS_ROT = 1 * MiB, WS_ROTT = 5 * MiB, WS_WC = 9 * MiB;
constexpr size_t WS_TOKE = 9 * MiB + 256 * 1024;
constexpr size_t WS_TOKW = WS_TOKE + 256 * 1024;
constexpr size_t WS_BCNT = WS_TOKW + 256 * 1024;
constexpr size_t WS_ROWTOK = WS_BCNT + 16 * 1024;
constexpr size_t WS_ROWGATE = WS_ROWTOK + 2 * MOE_ROWS * 4;
constexpr size_t WS_STATS = 11 * MiB;
static_assert(WS_ROWGATE + 2 * MOE_ROWS * 4 <= WS_STATS, "small tables");
constexpr size_t WS_WIN = 12 * MiB, WS_WO = 24 * MiB, WS_WGU = 28 * MiB, WS_WD = 39 * MiB, WS_WF = 44 * MiB + 512 * 1024;
constexpr size_t WS_HN = 48 * MiB;
constexpr size_t WS_Q = 112 * MiB, WS_K = 176 * MiB, WS_KT = 240 * MiB, WS_VT = 304 * MiB, WS_PC = 432 * MiB;
constexpr size_t WS_YG = 112 * MiB;
constexpr size_t WS_ACTD = 112 * MiB;
constexpr size_t WS_Z2 = 112 * MiB, WS_WSEQ = 240 * MiB;
constexpr size_t WS_ACTM = 112 * MiB;
constexpr size_t WS_WMGU = 352 * MiB, WS_WMD = 464 * MiB, WS_END = 520 * MiB;
static_assert(WS_ACTM + (size_t)MOE_ROWS * FFE * 2 <= WS_WMGU, "moe act");
static_assert(WS_WF + (size_t)D * D * 2 <= WS_HN, "weights");
constexpr int CW_BAR = 4096;
constexpr int CW_CHK = 64;

constexpr int RING_BYTES = 131072;
constexpr int LDSCTL_OFF = 139264, MISC_OFF = LDSCTL_OFF + 320;
constexpr int LDS_BYTES = 147456;

#define LDS_WAIT() asm volatile("s_waitcnt lgkmcnt(0)" ::: "memory")
#define VM_WAIT() asm volatile("s_waitcnt vmcnt(0)" ::: "memory")
#define RLX_AGENT __ATOMIC_RELAXED, __HIP_MEMORY_SCOPE_AGENT

__device__ __forceinline__ unsigned cvt_pk_bf16(float lo, float hi) { unsigned r; asm volatile("v_cvt_pk_bf16_f32 %0, %1, %2" : "=v"(r) : "v"(lo), "v"(hi)); return r; }
__device__ __forceinline__ float bf_lo(unsigned w) { return __uint_as_float(w << 16); }
__device__ __forceinline__ float bf_hi(unsigned w) { return __uint_as_float(w & 0xffff0000u); }
__device__ __forceinline__ float fast_exp2(float x) { return __builtin_amdgcn_exp2f(x); }
__device__ __forceinline__ int lane_id_v() { int l; asm volatile("v_mbcnt_lo_u32_b32 %0, -1, 0\n\tv_mbcnt_hi_u32_b32 %0, -1, %0" : "=v"(l)); return l; }
__device__ __forceinline__ int tid_of(int wave_s) { asm volatile("" : "+s"(wave_s)); return wave_s * 64 + lane_id_v(); }
__device__ __forceinline__ float silu_f(float v) { return v / (1.0f + __expf(-v)); }

namespace pg8 {
constexpr int BM = 256, BK = 64, HALF = 128, HTB = HALF * BK * 2, STAGE_BYTES = 8 * HTB, NXCD = 8, WGM = 8;
__host__ __device__ __forceinline__ int lds_byte(int r, int c) { const int st = (r >> 4) * 2 + (c >> 5), rr = r & 15, cc = c & 31, ob = rr * 64 + cc * 2; return st * 1024 + (ob ^ (((ob >> 9) & 1) << 5)); }
__host__ __device__ __forceinline__ void stage_rc(int b, int& R, int& C) { const int st = b / 1024, sb = b % 1024, swz = sb ^ (((sb >> 9) & 1) << 5); R = (st >> 1) * 16 + swz / 64; C = (st & 1) * 32 + (swz % 64) / 2; }
__host__ __device__ __forceinline__ int perm32(int rho) { const int n = rho >> 4, i = rho & 15; return 8 * (i >> 2) + 4 * n + (i & 3); }

struct Unit { const char* A; const char* B; const int* rows; int pm, pn, z; };

__device__ __forceinline__ bool tile_of(long L, int nM, int nN, int& pm, int& pn) {
    const int nwg = nM * nN; if (L >= nwg) return false;
    int wgid = (int)L; { const int q = nwg / NXCD, r = nwg % NXCD, xcd = wgid % NXCD, off = wgid / NXCD; wgid = (xcd < r ? xcd * (q + 1) : r * (q + 1) + (xcd - r) * q) + off; }
    const int nig = WGM * nN, gid = wgid / nig, fm = gid * WGM, gsz = (nM - fm) < WGM ? (nM - fm) : WGM;
    pm = fm + ((wgid % nig) % gsz); pn = (wgid % nig) / gsz; return true;
}

template <class Epi, class Sched, bool GATHER>
__device__ __forceinline__ void gemm_phase(LAS unsigned char* lds, const int wave_s, const int lda, const int ldb, const int K, const Sched& S, const Epi& E) {
    const int tid = tid_of(wave_s);
    const int wid = __builtin_amdgcn_readfirstlane(tid >> 6), lane = tid & 63, wr = wid >> 2, wc = wid & 3, fr = lane & 15, fq = lane >> 4;
    const int nt = K / BK;
    unsigned vA[2][2], vAn[2][2], voffB[2];
#pragma unroll
    for (int i = 0; i < 2; ++i) { int R, C; stage_rc(tid * 16 + i * 8192, R, C); const int Rb = Epi::PERM ? ((R & ~31) + perm32(R & 31)) : R;
        voffB[i] = (unsigned)(Rb * ldb + C) * 2u;
#pragma unroll
        for (int h = 0; h < 2; ++h) { vA[h][i] = (unsigned)((h * HALF + R) * lda + C) * 2u; vAn[h][i] = vA[h][i]; } }
    const size_t kstep = (size_t)(BK * 2);
    const size_t hstepB = (size_t)HALF * ldb * 2;
    const unsigned ldsw = (unsigned)wid * 1024u;
    const int aoff = lds_byte(wr * 64 + fr, fq * 8), boff = lds_byte(wc * 32 + fr, fq * 8);
#define PG8_SA(b, h) (((b) * 2 + (h)) * HTB)
#define PG8_SB(b, h) ((4 + (b) * 2 + (h)) * HTB)
#define PG8_STAGE_B(bufoff, gbase) do { _Pragma("unroll") for (int _i = 0; _i < 2; ++_i) \
        __builtin_amdgcn_global_load_lds((const unsigned*)((const char*)(gbase) + voffB[_i]), (LAS unsigned*)(lds + (bufoff) + ldsw + _i * 8192), 16, 0, 0); } while (0)
#define PG8_STAGE_A(bufoff, gbase, v0, v1) do { \
        __builtin_amdgcn_global_load_lds((const unsigned*)((const char*)(gbase) + (v0)), (LAS unsigned*)(lds + (bufoff) + ldsw), 16, 0, 0); \
        __builtin_amdgcn_global_load_lds((const unsigned*)((const char*)(gbase) + (v1)), (LAS unsigned*)(lds + (bufoff) + ldsw + 8192), 16, 0, 0); } while (0)
#define PG8_LDA(dst, b, h) do { _Pragma("unroll") for (int m = 0; m < 4; ++m) _Pragma("unroll") for (int k = 0; k < 2; ++k) dst[m][k] = *(const LAS bf16x8*)(lds + PG8_SA(b, h) + aoff + m * 2048 + k * 1024); } while (0)
#define PG8_LDB(dst, b, h) do { _Pragma("unroll") for (int n = 0; n < 2; ++n) _Pragma("unroll") for (int k = 0; k < 2; ++k) dst[n][k] = *(const LAS bf16x8*)(lds + PG8_SB(b, h) + boff + n * 2048 + k * 1024); } while (0)
#define PG8_MMA(ai, bj, At, Bt) do { __builtin_amdgcn_s_setprio(1); _Pragma("unroll") for (int m = 0; m < 4; ++m) _Pragma("unroll") for (int n = 0; n < 2; ++n) _Pragma("unroll") for (int k = 0; k < 2; ++k) \
        acc[ai][bj][m][n] = __builtin_amdgcn_mfma_f32_16x16x32_bf16(Bt[n][k], At[m][k], acc[ai][bj][m][n], 0, 0, 0); __builtin_amdgcn_s_setprio(0); } while (0)
#define PG8_WAIT_V(n) asm volatile("s_waitcnt vmcnt(" #n ")" ::: "memory")
#define PG8_WAIT_L(n) asm volatile("s_waitcnt lgkmcnt(" #n ")" ::: "memory")
#define PG8_BAR __builtin_amdgcn_s_barrier()
#define PG8_SCHED __builtin_amdgcn_sched_barrier(0)
#define PG8_LOADROWS(dst, u) do { if constexpr (GATHER) { const int _tz = tid_of(wave_s); _Pragma("unroll") for (int _i = 0; _i < 2; ++_i) { int _R, _C; stage_rc(_tz * 16 + _i * 8192, _R, _C); \
        _Pragma("unroll") for (int _h = 0; _h < 2; ++_h) { const int _t = (u).rows[_h * HALF + _R]; dst[_h][_i] = (unsigned)((_t < 0 ? 0 : _t) * lda + _C) * 2u; } } } } while (0)
#define PG8_VAN(h, i) (GATHER ? vAn[h][i] : vA[h][i])
    Unit cur, nxt; int ui = 0;
    if (!S.next(0, cur)) return;
    f32x4 acc[2][2][4][2];
#pragma unroll
    for (int a = 0; a < 2; ++a)
#pragma unroll
        for (int b = 0; b < 2; ++b)
#pragma unroll
            for (int m = 0; m < 4; ++m)
#pragma unroll
                for (int n = 0; n < 2; ++n) acc[a][b][m][n] = (f32x4){0.f, 0.f, 0.f, 0.f};
    bf16x8 At[4][2], B0[2][2], B1[2][2];
    const char* cA = cur.A; const char* cB = cur.B;
    PG8_LOADROWS(vA, cur);
    if constexpr (GATHER) { vAn[0][0] = vA[0][0]; vAn[0][1] = vA[0][1]; vAn[1][0] = vA[1][0]; vAn[1][1] = vA[1][1]; }
    PG8_STAGE_B(PG8_SB(0, 0), cB); PG8_STAGE_B(PG8_SB(0, 1), cB + hstepB); PG8_STAGE_A(PG8_SA(0, 0), cA, vA[0][0], vA[0][1]); PG8_STAGE_A(PG8_SA(0, 1), cA, vA[1][0], vA[1][1]);
    if (wr == 1) PG8_BAR;
    PG8_WAIT_V(2); PG8_BAR;
    PG8_STAGE_B(PG8_SB(1, 0), cB + kstep); PG8_STAGE_A(PG8_SA(1, 0), cA + kstep, vA[0][0], vA[0][1]); PG8_STAGE_B(PG8_SB(1, 1), cB + hstepB + kstep);
    PG8_WAIT_V(6); PG8_BAR;
    for (;;) {
        const bool has_next = S.next(ui + 1, nxt);
        const char* nA = has_next ? nxt.A : cA; const char* nB = has_next ? nxt.B : cB;
#pragma unroll 1
        for (int t = 0; t < nt; t += 2) {
            const bool last = (t == nt - 2);
            const char* a1 = cA + (size_t)(t + 1) * kstep;
            const char* a2 = last ? nA : cA + (size_t)(t + 2) * kstep; const char* b2 = last ? nB : cB + (size_t)(t + 2) * kstep;
            const char* a3 = a2 + kstep; const char* b3 = b2 + kstep;
            if constexpr (GATHER) { if (last && has_next) { PG8_LOADROWS(vAn, nxt); } }
            PG8_LDB(B0, 0, 0); PG8_LDB(B1, 0, 1); PG8_SCHED; PG8_LDA(At, 0, 0); PG8_STAGE_A(PG8_SA(1, 1), a1, vA[1][0], vA[1][1]);
            PG8_WAIT_V(8); PG8_WAIT_L(0); PG8_BAR; PG8_MMA(0, 0, At, B0); PG8_MMA(0, 1, At, B1); PG8_BAR; PG8_SCHED;
            PG8_LDA(At, 0, 1); PG8_STAGE_B(PG8_SB(0, 0), b2); PG8_STAGE_B(PG8_SB(0, 1), b2 + hstepB); PG8_STAGE_A(PG8_SA(0, 0), a2, PG8_VAN(0, 0), PG8_VAN(0, 1));
            PG8_WAIT_V(8); PG8_WAIT_L(0); PG8_BAR; PG8_MMA(1, 0, At, B0); PG8_MMA(1, 1, At, B1); PG8_BAR; PG8_SCHED;
            PG8_LDB(B0, 1, 0); PG8_LDB(B1, 1, 1); PG8_SCHED; PG8_LDA(At, 1, 0); PG8_STAGE_A(PG8_SA(0, 1), a2, PG8_VAN(1, 0), PG8_VAN(1, 1));
            PG8_WAIT_V(8); PG8_WAIT_L(0); PG8_BAR; PG8_MMA(0, 0, At, B0); PG8_MMA(0, 1, At, B1); PG8_BAR; PG8_SCHED;
            PG8_LDA(At, 1, 1); PG8_STAGE_B(PG8_SB(1, 0), b3); PG8_STAGE_B(PG8_SB(1, 1), b3 + hstepB); PG8_STAGE_A(PG8_SA(1, 0), a3, PG8_VAN(0, 0), PG8_VAN(0, 1));
            PG8_WAIT_V(8); PG8_WAIT_L(0); PG8_BAR; PG8_MMA(1, 0, At, B0); PG8_MMA(1, 1, At, B1); PG8_BAR; PG8_SCHED;
        }
        if (wr == 0) PG8_BAR;
        E(acc, cur, wr, wc, fr, fq);
        if (!has_next) break;
#pragma unroll
        for (int a = 0; a < 2; ++a)
#pragma unroll
            for (int b = 0; b < 2; ++b)
#pragma unroll
                for (int m = 0; m < 4; ++m)
#pragma unroll
                    for (int n = 0; n < 2; ++n) acc[a][b][m][n] = (f32x4){0.f, 0.f, 0.f, 0.f};
        cur = nxt; cA = nA; cB = nB; ++ui;
        if constexpr (GATHER) { vA[0][0] = vAn[0][0]; vA[0][1] = vAn[0][1]; vA[1][0] = vAn[1][0]; vA[1][1] = vAn[1][1]; }
        if (wr == 1) PG8_BAR;
    }
    PG8_WAIT_V(0);
    PG8_BAR;
#undef PG8_SA
#undef PG8_SB
#undef PG8_STAGE_A
#undef PG8_STAGE_B
#undef PG8_LDA
#undef PG8_LDB
#undef PG8_MMA
#undef PG8_WAIT_V
#undef PG8_WAIT_L
#undef PG8_BAR
#undef PG8_SCHED
#undef PG8_LOADROWS
#undef PG8_VAN
}
}

struct SchedPlain {
    const char* A; const char* B; size_t a_tile, b_tile; int nM, nN, G, c;
    __device__ __forceinline__ bool next(int i, pg8::Unit& u) const {
        int pm, pn; if (!pg8::tile_of((long)i * G + c, nM, nN, pm, pn)) return false;
        u.pm = pm; u.pn = pn; u.z = 0; u.rows = nullptr; u.A = A + (size_t)pm * a_tile; u.B = B + (size_t)pn * b_tile; return true; }
};
struct SchedPc {
    const char* Q; const char* Kk; int G, c;
    __device__ __forceinline__ bool next(int i, pg8::Unit& u) const {
        const int L = i * G + c; if (L >= NB * NH * 16) return false;
        const int cp = L & 15, h = (L >> 4) & 3, b = L >> 6;
        const size_t off = ((size_t)(b * SEQ + cp * 256) * QKW + h * DK) * 2;
        u.pm = L; u.pn = 0; u.z = h; u.rows = nullptr; u.A = Q + off; u.B = Kk + off; return true; }
};
struct SchedFnA {
    const char* Wc; const char* Hn; int G, c;
    __device__ __forceinline__ bool next(int i, pg8::Unit& u) const {
        int pm, pn; if (!pg8::tile_of((long)i * G + c, 8, T / 256, pm, pn)) return false;
        const int g = pm >> 1, ri = pm & 1;
        u.pm = pm; u.pn = pn; u.z = 0; u.rows = nullptr; u.A = Wc + (size_t)ri * 256 * 256 * 2; u.B = Hn + ((size_t)pn * 256 * D + g * 256) * 2; return true; }
};
struct SchedFnB {
    const char* Wseq; const char* Z2; int G, c;
    __device__ __forceinline__ bool next(int i, pg8::Unit& u) const {
        int pm, pn; if (!pg8::tile_of((long)i * G + c, NB * 16, 4, pm, pn)) return false;
        const int b = pm >> 4, kt = pm & 15;
        u.pm = pm; u.pn = pn; u.z = 0; u.rows = nullptr; u.A = Wseq + (size_t)kt * 256 * 8192 * 2; u.B = Z2 + ((size_t)b * 1024 + pn * 256) * 8192 * 2; return true; }
};
struct SchedMoe {
    const char* A; const char* W; const int* rowtok; const LAS unsigned char* texp; size_t a_tile, w_exp, w_tile; int ntiles, ncol, G, c; bool gather;
    __device__ __forceinline__ bool next(int i, pg8::Unit& u) const {
        const int L = i * G + c; if (L >= ntiles * ncol) return false;
        const int rt = L / ncol, ct = L - rt * ncol; const int e = texp[rt];
        u.pm = rt; u.pn = ct; u.z = e; u.rows = rowtok + rt * 256; u.A = gather ? A : A + (size_t)rt * a_tile; u.B = W + (size_t)e * w_exp + (size_t)ct * w_tile; return true; }
};

struct EpiRopeQK {
    static constexpr bool PERM = true;
    bf16* Q; bf16* Kk; const f32x2* rot;
    __device__ __forceinline__ void operator()(const f32x4 (&acc)[2][2][4][2], const pg8::Unit& u, int wr, int wc, int fr, int fq) const {
        const bool isk = u.pn >= 4; const int h = u.pn & 3; bf16* dst = isk ? Kk : Q; const float sc = isk ? 0.0625f : 1.0f;
        const int i0 = wc * 32 + 8 * fq;
#pragma unroll
        for (int ai = 0; ai < 2; ++ai)
#pragma unroll
            for (int m = 0; m < 4; ++m) {
                const int t = u.pm * 256 + ai * 128 + wr * 64 + m * 16 + fr, s = t & (SEQ - 1);
                const f32x4* rp = (const f32x4*)(rot + (size_t)s * 128 + i0);
                const f32x4 r0 = rp[0], r1 = rp[1], r2 = rp[2], r3 = rp[3];
                const float cs[8] = {r0[0], r0[2], r1[0], r1[2], r2[0], r2[2], r3[0], r3[2]}, sn[8] = {r0[1], r0[3], r1[1], r1[3], r2[1], r2[3], r3[1], r3[3]};
                float o1[8], o2[8];
#pragma unroll
                for (int n = 0; n < 2; ++n)
#pragma unroll
                    for (int j = 0; j < 4; ++j) { const float t1 = acc[ai][0][m][n][j], t2 = acc[ai][1][m][n][j]; const int q = 4 * n + j;
                        o1[q] = (t1 * cs[q] - t2 * sn[q]) * sc; o2[q] = (t1 * sn[q] + t2 * cs[q]) * sc; }
                bf16* rowp = dst + (size_t)t * QKW + h * DK + i0;
                u32x4 w1, w2; w1.x = cvt_pk_bf16(o1[0], o1[1]); w1.y = cvt_pk_bf16(o1[2], o1[3]); w1.z = cvt_pk_bf16(o1[4], o1[5]); w1.w = cvt_pk_bf16(o1[6], o1[7]);
                w2.x = cvt_pk_bf16(o2[0], o2[1]); w2.y = cvt_pk_bf16(o2[2], o2[3]); w2.z = cvt_pk_bf16(o2[4], o2[5]); w2.w = cvt_pk_bf16(o2[6], o2[7]);
                *(u32x4*)rowp = w1; *(u32x4*)(rowp + 128) = w2; }
    }
};
struct EpiRopeKT {
    static constexpr bool PERM = true;
    bf16* KT; const f32x2* rotT;
    __device__ __forceinline__ void operator()(const f32x4 (&acc)[2][2][4][2], const pg8::Unit& u, int wr, int wc, int fr, int fq) const {
        const int h = u.pm;
#pragma unroll
        for (int m = 0; m < 4; ++m) { const int i = wr * 64 + m * 16 + fr;
#pragma unroll
            for (int bj = 0; bj < 2; ++bj) {
                const int tok0 = u.pn * 256 + bj * 128 + wc * 32 + 8 * fq, s0 = tok0 & (SEQ - 1);
                const f32x4* rp = (const f32x4*)(rotT + (size_t)i * SEQ + s0);
                const f32x4 r0 = rp[0], r1 = rp[1], r2 = rp[2], r3 = rp[3];
                const float cs[8] = {r0[0], r0[2], r1[0], r1[2], r2[0], r2[2], r3[0], r3[2]}, sn[8] = {r0[1], r0[3], r1[1], r1[3], r2[1], r2[3], r3[1], r3[3]};
                float o1[8], o2[8];
#pragma unroll
                for (int n = 0; n < 2; ++n)
#pragma unroll
                    for (int j = 0; j < 4; ++j) { const float t1 = acc[0][bj][m][n][j], t2 = acc[1][bj][m][n][j]; const int q = 4 * n + j;
                        o1[q] = (t1 * cs[q] - t2 * sn[q]) * 0.0625f; o2[q] = (t1 * sn[q] + t2 * cs[q]) * 0.0625f; }
                u32x4 w1, w2; w1.x = cvt_pk_bf16(o1[0], o1[1]); w1.y = cvt_pk_bf16(o1[2], o1[3]); w1.z = cvt_pk_bf16(o1[4], o1[5]); w1.w = cvt_pk_bf16(o1[6], o1[7]);
                w2.x = cvt_pk_bf16(o2[0], o2[1]); w2.y = cvt_pk_bf16(o2[2], o2[3]); w2.z = cvt_pk_bf16(o2[4], o2[5]); w2.w = cvt_pk_bf16(o2[6], o2[7]);
                *(u32x4*)(KT + (size_t)(h * DK + i) * T + tok0) = w1; *(u32x4*)(KT + (size_t)(h * DK + 128 + i) * T + tok0) = w2; } }
    }
};
struct EpiBf16 {
    static constexpr bool PERM = true;
    bf16* O; int ldc;
    __device__ __forceinline__ void operator()(const f32x4 (&acc)[2][2][4][2], const pg8::Unit& u, int wr, int wc, int fr, int fq) const {
#pragma unroll
        for (int ai = 0; ai < 2; ++ai)
#pragma unroll
            for (int m = 0; m < 4; ++m) { bf16* rowp = O + (size_t)(u.pm * 256 + ai * 128 + wr * 64 + m * 16 + fr) * ldc + u.pn * 256 + wc * 32 + 8 * fq;
#pragma unroll
                for (int bj = 0; bj < 2; ++bj) { const f32x4 v0 = acc[ai][bj][m][0], v1 = acc[ai][bj][m][1];
                    u32x4 w; w.x = cvt_pk_bf16(v0[0], v0[1]); w.y = cvt_pk_bf16(v0[2], v0[3]); w.z = cvt_pk_bf16(v1[0], v1[1]); w.w = cvt_pk_bf16(v1[2], v1[3]);
                    *(u32x4*)(rowp + bj * 128) = w; } }
    }
};
struct EpiPc {
    static constexpr bool PERM = true;
    bf16* PC; const LAS float* l2g;
    __device__ __forceinline__ void operator()(const f32x4 (&acc)[2][2][4][2], const pg8::Unit& u, int wr, int wc, int fr, int fq) const {
        const int h = u.z; const float l2f = l2g[h], l2b = l2g[4 + h];
#pragma unroll
        for (int ai = 0; ai < 2; ++ai)
#pragma unroll
            for (int m = 0; m < 4; ++m) { const int il = wr * 64 + m * 16 + fr, jl0 = wc * 32 + 8 * fq; float o[8];
#pragma unroll
                for (int n = 0; n < 2; ++n)
#pragma unroll
                    for (int j = 0; j < 4; ++j) { const int dl = il - (jl0 + 4 * n + j); const float f = dl >= 0 ? fast_exp2((float)dl * l2f) : fast_exp2((float)(-dl) * l2b);
                        o[4 * n + j] = (ai == 0 ? acc[0][0][m][n][j] : acc[1][1][m][n][j]) * f; }
                u32x4 w; w.x = cvt_pk_bf16(o[0], o[1]); w.y = cvt_pk_bf16(o[2], o[3]); w.z = cvt_pk_bf16(o[4], o[5]); w.w = cvt_pk_bf16(o[6], o[7]);
                *(u32x4*)(PC + ((size_t)(u.pm * 2 + ai) * 128 + il) * 128 + jl0) = w; }
    }
};
struct EpiGate {
    static constexpr bool PERM = true;
    const bf16* Y; bf16* YG; const f32x2* stats; const float* gain;
    __device__ __forceinline__ void operator()(const f32x4 (&acc)[2][2][4][2], const pg8::Unit& u, int wr, int wc, int fr, int fq) const {
        const int head = u.pn >> 1, c0 = u.pn * 256 + wc * 32 + 8 * fq;
        f32x4 gv[2][2];
#pragma unroll
        for (int bj = 0; bj < 2; ++bj) { gv[bj][0] = *(const f32x4*)(gain + c0 + bj * 128); gv[bj][1] = *(const f32x4*)(gain + c0 + bj * 128 + 4); }
#pragma unroll
        for (int ai = 0; ai < 2; ++ai)
#pragma unroll
            for (int m = 0; m < 4; ++m) { const int t = u.pm * 256 + ai * 128 + wr * 64 + m * 16 + fr; const f32x2 st = stats[(size_t)t * 4 + head];
#pragma unroll
                for (int bj = 0; bj < 2; ++bj) { const size_t off = (size_t)t * VW + c0 + bj * 128; const u32x4 yv = *(const u32x4*)(Y + off);
                    const float y[8] = {bf_lo(yv.x), bf_hi(yv.x), bf_lo(yv.y), bf_hi(yv.y), bf_lo(yv.z), bf_hi(yv.z), bf_lo(yv.w), bf_hi(yv.w)}; float o[8];
#pragma unroll
                    for (int n = 0; n < 2; ++n)
#pragma unroll
                        for (int j = 0; j < 4; ++j) { const int q = 4 * n + j; const float yn = (y[q] - st.x) * st.y * gv[bj][n][j]; o[q] = silu_f(acc[ai][bj][m][n][j]) * yn; }
                    u32x4 w; w.x = cvt_pk_bf16(o[0], o[1]); w.y = cvt_pk_bf16(o[2], o[3]); w.z = cvt_pk_bf16(o[4], o[5]); w.w = cvt_pk_bf16(o[6], o[7]);
                    *(u32x4*)(YG + off) = w; } }
    }
};
struct EpiResF32 {
    static constexpr bool PERM = false;
    const float* base; float* out;
    __device__ __forceinline__ void operator()(const f32x4 (&acc)[2][2][4][2], const pg8::Unit& u, int wr, int wc, int fr, int fq) const {
#pragma unroll
        for (int ai = 0; ai < 2; ++ai)
#pragma unroll
            for (int m = 0; m < 4; ++m) { const size_t off = (size_t)(u.pm * 256 + ai * 128 + wr * 64 + m * 16 + fr) * D + u.pn * 256 + wc * 32 + 4 * fq;
#pragma unroll
                for (int bj = 0; bj < 2; ++bj)
#pragma unroll
                    for (int n = 0; n < 2; ++n) { const f32x4 bs = *(const f32x4*)(base + off + bj * 128 + n * 16); *(f32x4*)(out + off + bj * 128 + n * 16) = bs + acc[ai][bj][m][n]; } }
    }
};
struct EpiSwiGLU {
    static constexpr bool PERM = true;
    bf16* ACT; int ldc;
    __device__ __forceinline__ void operator()(const f32x4 (&acc)[2][2][4][2], const pg8::Unit& u, int wr, int wc, int fr, int fq) const {
#pragma unroll
        for (int ai = 0; ai < 2; ++ai)
#pragma unroll
            for (int m = 0; m < 4; ++m) { float o[8];
#pragma unroll
                for (int n = 0; n < 2; ++n)
#pragma unroll
                    for (int j = 0; j < 4; ++j) o[4 * n + j] = silu_f(acc[ai][0][m][n][j]) * acc[ai][1][m][n][j];
                u32x4 w; w.x = cvt_pk_bf16(o[0], o[1]); w.y = cvt_pk_bf16(o[2], o[3]); w.z = cvt_pk_bf16(o[4], o[5]); w.w = cvt_pk_bf16(o[6], o[7]);
                *(u32x4*)(ACT + (size_t)(u.pm * 256 + ai * 128 + wr * 64 + m * 16 + fr) * ldc + u.pn * 128 + wc * 32 + 8 * fq) = w; }
    }
};
struct EpiZ2 {
    static constexpr bool PERM = true;
    bf16* Z2;
    __device__ __forceinline__ void operator()(const f32x4 (&acc)[2][2][4][2], const pg8::Unit& u, int wr, int wc, int fr, int fq) const {
        const int g = u.pm >> 1, ri = u.pm & 1;
#pragma unroll
        for (int ai = 0; ai < 2; ++ai)
#pragma unroll
            for (int m = 0; m < 4; ++m) { const int cp = ai * 128 + wr * 64 + m * 16 + fr;
#pragma unroll
                for (int bj = 0; bj < 2; ++bj) { const int tok0 = u.pn * 256 + bj * 128 + wc * 32 + 8 * fq, b = tok0 >> 12, s0 = tok0 & (SEQ - 1);
                    const f32x4 v0 = acc[ai][bj][m][0], v1 = acc[ai][bj][m][1];
                    u32x4 w; w.x = cvt_pk_bf16(v0[0], v0[1]); w.y = cvt_pk_bf16(v0[2], v0[3]); w.z = cvt_pk_bf16(v1[0], v1[1]); w.w = cvt_pk_bf16(v1[2], v1[3]);
                    *(u32x4*)(Z2 + ((size_t)(b * 1024 + g * 256 + cp) * 8192 + ri * SEQ + s0)) = w; } }
    }
};
struct EpiMoeDown {
    static constexpr bool PERM = false;
    float* Hres; const int* rowtok; const float* rowgate;
    __device__ __forceinline__ void operator()(const f32x4 (&acc)[2][2][4][2], const pg8::Unit& u, int wr, int wc, int fr, int fq) const {
#pragma unroll
        for (int ai = 0; ai < 2; ++ai)
#pragma unroll
            for (int m = 0; m < 4; ++m) { const int row = u.pm * 256 + ai * 128 + wr * 64 + m * 16 + fr; const int tok = rowtok[row]; const float gw = rowgate[row];
                if (tok >= 0) { float* rp = Hres + (size_t)tok * D + u.pn * 256 + wc * 32 + 4 * fq;
#pragma unroll
                    for (int bj = 0; bj < 2; ++bj)
#pragma unroll
                        for (int n = 0; n < 2; ++n) { const f32x4 bs = *(const f32x4*)(rp + bj * 128 + n * 16); *(f32x4*)(rp + bj * 128 + n * 16) = bs + gw * acc[ai][bj][m][n]; } } }
    }
};

#define XB_TMO      128
#define XB_XCNT(j)  (256  + 64 * (j))
#define XB_XSUB(j)  (1280 + 64 * (j))
#define XB_XGEN(j)  (2304 + 64 * (j))
#define XB_TOP      3328
#define XB_TOPGEN   3392
#define XCD_BAR_WORDS 3456
#define XB_SPIN_CAP (1u << 18)
__device__ __forceinline__ unsigned xb_ld(unsigned* p)              { return __hip_atomic_load(p, __ATOMIC_RELAXED, __HIP_MEMORY_SCOPE_AGENT); }
__device__ __forceinline__ unsigned xb_add(unsigned* p, unsigned v) { return __hip_atomic_fetch_add(p, v, __ATOMIC_RELAXED, __HIP_MEMORY_SCOPE_AGENT); }
__device__ __forceinline__ unsigned xb_xcc_id() { return (unsigned)__builtin_amdgcn_s_getreg((3 << 11) | 20) & 0xFu; }
#define XB_SPIN(cond, bar) do { unsigned _sp = 0; while (cond) { __builtin_amdgcn_s_sleep(1); \
    if ((++_sp & 255u) == 0u) { if (xb_ld(&(bar)[XB_TMO])) break; if (_sp > XB_SPIN_CAP) { atomicAdd(&(bar)[XB_TMO], 1u); break; } } } } while (0)
struct XcdBarrier { unsigned* bar; unsigned x; volatile LAS unsigned* st; };
__device__ __forceinline__ XcdBarrier xcd_barrier_post(unsigned* bar, volatile LAS unsigned* st, const bool t0) {
    XcdBarrier b; b.bar = bar; b.x = xb_xcc_id(); b.st = st;
    if (t0) (void)xb_add(&bar[XB_XCNT(b.x)], 1u);
    return b;
}
__device__ __forceinline__ void xcd_barrier_complete(unsigned* bar, unsigned x, unsigned& nloc, unsigned& nx) {
    const unsigned G = gridDim.x * gridDim.y * gridDim.z;
    unsigned sum, cnt, mine, sp = 0u;
    for (;;) {
        sum = 0u; cnt = 0u; mine = 0u;
#pragma unroll
        for (unsigned j = 0; j < 16; ++j) { const unsigned c = xb_ld(&bar[XB_XCNT(j)]); sum += c; cnt += (c > 0u) ? 1u : 0u; mine = (j == x) ? c : mine; }
        if (sum == G) break;
        __builtin_amdgcn_s_sleep(1);
        if ((++sp & 255u) == 0u) { if (xb_ld(&bar[XB_TMO])) break; if (sp > XB_SPIN_CAP) { atomicAdd(&bar[XB_TMO], 1u); break; } }
    }
    nloc = mine > 0u ? mine : 1u; nx = cnt > 0u ? cnt : 1u;
}
__device__ __forceinline__ void xcd_barrier(const XcdBarrier& b, const bool t0) {
    asm volatile("s_waitcnt vmcnt(0)" ::: "memory");
    __syncthreads();
    if (t0) {
        unsigned* bar = b.bar;
        __builtin_amdgcn_s_waitcnt(0);
        unsigned nloc = b.st[0], nx = b.st[1];
        if (nloc == 0u) { xcd_barrier_complete(bar, b.x, nloc, nx); b.st[0] = nloc; b.st[1] = nx; }
        const unsigned old = xb_add(&bar[XB_XSUB(b.x)], 1u);
        const unsigned gen = old / nloc;
        if (old + 1u == (gen + 1u) * nloc) {
            __builtin_amdgcn_fence(__ATOMIC_RELEASE, "agent");
            asm volatile("s_waitcnt vmcnt(0)" ::: "memory");
            const unsigned og = xb_add(&bar[XB_TOP], 1u);
            const unsigned tg = og / nx;
            if (og + 1u == (tg + 1u) * nx) xb_add(&bar[XB_TOPGEN], 1u);
            else XB_SPIN(xb_ld(&bar[XB_TOPGEN]) == tg, bar);
            __builtin_amdgcn_fence(__ATOMIC_ACQUIRE, "agent");
            xb_add(&bar[XB_XGEN(b.x)], 1u);
            asm volatile("s_waitcnt vmcnt(0)" ::: "memory");
        } else {
            XB_SPIN(xb_ld(&bar[XB_XGEN(b.x)]) == gen, bar);
            __builtin_amdgcn_fence(__ATOMIC_ACQUIRE, "agent");
            asm volatile("s_waitcnt vmcnt(0)" ::: "memory");
        }
    }
    __syncthreads();
}

__device__ __forceinline__ float wave_sum(float v) {
#pragma unroll
    for (int o = 1; o < 64; o <<= 1) v += __shfl_xor(v, o);
    return v;
}
__device__ __forceinline__ void transpose_item(const float* W, int K, int N, bf16* WT, int k0, int n0, int rbase, LAS float* scr, int lane) {
#pragma unroll 8
    for (int i = 0; i < 32; ++i) { const int kk = 2 * i + (lane >> 5); scr[kk * 33 + (lane & 31)] = W[(size_t)(k0 + kk) * N + n0 + (lane & 31)]; }
    LDS_WAIT(); asm volatile("" ::: "memory");
    const int c = lane & 7;
#pragma unroll
    for (int j = 0; j < 4; ++j) { const int n = (lane >> 3) + 8 * j; const LAS float* s = scr + (8 * c) * 33 + n;
        u32x4 o; o.x = cvt_pk_bf16(s[0 * 33], s[1 * 33]); o.y = cvt_pk_bf16(s[2 * 33], s[3 * 33]); o.z = cvt_pk_bf16(s[4 * 33], s[5 * 33]); o.w = cvt_pk_bf16(s[6 * 33], s[7 * 33]);
        *(u32x4*)(WT + (size_t)(rbase + n) * K + k0 + 8 * c) = o; }
    LDS_WAIT(); asm volatile("" ::: "memory");
}
__device__ __forceinline__ void tr_plain(const float* W, int K, int N, bf16* WT, int it, LAS float* scr, int lane) {
    const int nblk = N / 32, kb = it / nblk, nb = it - kb * nblk; transpose_item(W, K, N, WT, 64 * kb, 32 * nb, 32 * nb, scr, lane);
}
__device__ __forceinline__ void tr_gu(const float* Wg, const float* Wu, int K, int N, bf16* WT, int it, LAS float* scr, int lane) {
    const int nblk = N / 32, per = (K / 64) * nblk; const bool up = it >= per; if (up) it -= per;
    const int kb = it / nblk, nb = it - kb * nblk, f0 = 32 * nb;
    transpose_item(up ? Wu : Wg, K, N, WT, 64 * kb, f0, 256 * (f0 >> 7) + (up ? 128 : 0) + (f0 & 127), scr, lane);
}
__device__ __forceinline__ void rms_row(const float* xrow, const float* g, bf16* orow, int lane, f32x4 (&v)[4]) {
    const GAS f32x4* xr = (const GAS f32x4*)xrow + lane; const GAS f32x4* gr = (const GAS f32x4*)g + lane;
    float s = 0.f;
#pragma unroll
    for (int j = 0; j < 4; ++j) { v[j] = xr[64 * j]; s += (v[j].x * v[j].x + v[j].y * v[j].y) + (v[j].z * v[j].z + v[j].w * v[j].w); }
    const float r = 1.0f / sqrtf(wave_sum(s) * (1.f / D) + EPS);
    GAS u32x2* o8 = (GAS u32x2*)orow + lane;
#pragma unroll
    for (int j = 0; j < 4; ++j) { v[j] = v[j] * r * gr[64 * j]; u32x2 w; w.x = cvt_pk_bf16(v[j].x, v[j].y); w.y = cvt_pk_bf16(v[j].z, v[j].w); o8[64 * j] = w; }
}

constexpr int SW_QL = 0, SW_QPITCH = 528, SW_SL = 67584, SW_VL = 101376, SW_VPITCH = 272, SW_VZL = 118784;
__device__ __forceinline__ int crow(int reg, int hh) { return (reg & 3) + 8 * (reg >> 2) + 4 * hh; }
__device__ __forceinline__ void sweep_unit(LAS unsigned char* lds, const bf16* Qg, const bf16* KTg, const bf16* VTg, const bf16* PCg, bf16* Yg, const float l2f, const float l2b, int b, int h, int es, const int wave_s) {
    const int tid = tid_of(wave_s);
    const int w = __builtin_amdgcn_readfirstlane(tid >> 6), lane = tid & 63, rb = w >> 1, cb = w & 1, r32 = lane & 31, hh = lane >> 5;
    const int vrow = tid >> 4, vpc = tid & 15;
    const bf16* qbase = Qg + (size_t)(b * SEQ) * QKW + h * DK;
    const bf16* ktbase = KTg + (size_t)(h * DK + 32 * w + r32) * T + b * SEQ + 8 * hh;
    const bf16* vtbase = VTg + (size_t)(h * DV + 64 * es) * T + b * SEQ;
    const bf16* pcbase = PCg + ((size_t)((b * NH + h) * NCH) * 128 + rb * 32 + r32) * 128 + 8 * hh;
    bf16* ybase = Yg + (size_t)(b * SEQ) * VW + h * DV + 64 * es + 32 * cb + r32;
    for (int dir = 0; dir < 2; ++dir) {
        const float l2 = dir == 0 ? l2f : l2b;
        float zeta[8];
#pragma unroll
        for (int jj = 0; jj < 8; ++jj) { const int j = 8 * vpc + jj; zeta[jj] = fast_exp2((float)(dir == 0 ? (CH - 1 - j) : j) * l2); }
        const float gC = fast_exp2((float)CH * l2);
        f32x16 Sacc[2];
#pragma unroll
        for (int c = 0; c < 2; ++c)
#pragma unroll
            for (int t = 0; t < 16; ++t) Sacc[c][t] = 0.f;
        for (int step = 0; step < NCH; ++step) {
            const int n = dir == 0 ? step : NCH - 1 - step;
            u32x4 qv[8], vv[2]; bf16x8 pa[8], ka[8];
#pragma unroll
            for (int it = 0; it < 8; ++it) { const int idx = it * 512 + tid; qv[it] = *(const u32x4*)(qbase + (size_t)(n * CH + (idx >> 5)) * QKW + (idx & 31) * 8); }
#pragma unroll
            for (int it = 0; it < 2; ++it) vv[it] = *(const u32x4*)(vtbase + (size_t)(vrow + 32 * it) * T + n * CH + 8 * vpc);
#pragma unroll
            for (int s = 0; s < 8; ++s) { pa[s] = *(const bf16x8*)(pcbase + (size_t)n * (CH * CH) + 16 * s); ka[s] = *(const bf16x8*)(ktbase + n * CH + 16 * s); }
            __syncthreads();
#pragma unroll
            for (int it = 0; it < 8; ++it) { const int idx = it * 512 + tid; *(LAS u32x4*)(lds + SW_QL + (idx >> 5) * SW_QPITCH + (idx & 31) * 16) = qv[it]; }
#pragma unroll
            for (int it = 0; it < 2; ++it) { const u32x4 x = vv[it]; const int off = (vrow + 32 * it) * SW_VPITCH + vpc * 16;
                *(LAS u32x4*)(lds + SW_VL + off) = x;
                u32x4 z; z.x = cvt_pk_bf16(bf_lo(x.x) * zeta[0], bf_hi(x.x) * zeta[1]); z.y = cvt_pk_bf16(bf_lo(x.y) * zeta[2], bf_hi(x.y) * zeta[3]);
                z.z = cvt_pk_bf16(bf_lo(x.z) * zeta[4], bf_hi(x.z) * zeta[5]); z.w = cvt_pk_bf16(bf_lo(x.w) * zeta[6], bf_hi(x.w) * zeta[7]);
                *(LAS u32x4*)(lds + SW_VZL + off) = z; }
#pragma unroll
            for (int c = 0; c < 2; ++c)
#pragma unroll
                for (int g = 0; g < 4; ++g) { u32x2 p; p.x = cvt_pk_bf16(Sacc[c][4 * g], Sacc[c][4 * g + 1]); p.y = cvt_pk_bf16(Sacc[c][4 * g + 2], Sacc[c][4 * g + 3]);
                    *(LAS u32x2*)(lds + SW_SL + (32 * c + r32) * SW_QPITCH + (32 * w + 8 * g + 4 * hh) * 2) = p; }
            __syncthreads();
            f32x16 O;
#pragma unroll
            for (int t = 0; t < 16; ++t) O[t] = 0.f;
#pragma unroll 4
            for (int ks = 0; ks < 16; ++ks) {
                const bf16x8 a = *(const LAS bf16x8*)(lds + SW_QL + (32 * rb + r32) * SW_QPITCH + (16 * ks + 8 * hh) * 2);
                const bf16x8 bb = *(const LAS bf16x8*)(lds + SW_SL + (32 * cb + r32) * SW_QPITCH + (16 * ks + 8 * hh) * 2);
                O = __builtin_amdgcn_mfma_f32_32x32x16_bf16(a, bb, O, 0, 0, 0); }
#pragma unroll
            for (int t = 0; t < 16; ++t) { const int i = 32 * rb + crow(t, hh); O[t] *= fast_exp2((float)(dir == 0 ? (i + 1) : (CH - i)) * l2); }
#pragma unroll
            for (int s = 0; s < 8; ++s) {
                const int jb = s >> 1;
                const bool use = dir == 0 ? (jb <= rb) : (jb >= rb);
                if (use) {
                    u32x4 p = __builtin_bit_cast(u32x4, pa[s]);
                    if (jb == rb) {
                        const int nk = r32 - (16 * (s & 1) + 8 * hh) + 1;
                        unsigned mk[4];
#pragma unroll
                        for (int q = 0; q < 4; ++q) mk[q] = ((2 * q < nk) ? 0xffffu : 0u) | ((2 * q + 1 < nk) ? 0xffff0000u : 0u);
                        if (dir == 0) { p.x &= mk[0]; p.y &= mk[1]; p.z &= mk[2]; p.w &= mk[3]; } else { p.x &= ~mk[0]; p.y &= ~mk[1]; p.z &= ~mk[2]; p.w &= ~mk[3]; }
                    }
                    const bf16x8 bb = *(const LAS bf16x8*)(lds + SW_VL + (32 * cb + r32) * SW_VPITCH + (16 * s + 8 * hh) * 2);
                    O = __builtin_amdgcn_mfma_f32_32x32x16_bf16(__builtin_bit_cast(bf16x8, p), bb, O, 0, 0, 0); } }
#pragma unroll
            for (int c = 0; c < 2; ++c) {
#pragma unroll
                for (int t = 0; t < 16; ++t) Sacc[c][t] *= gC;
#pragma unroll
                for (int s = 0; s < 8; ++s) { const bf16x8 bz = *(const LAS bf16x8*)(lds + SW_VZL + (32 * c + r32) * SW_VPITCH + (16 * s + 8 * hh) * 2);
                    Sacc[c] = __builtin_amdgcn_mfma_f32_32x32x16_bf16(ka[s], bz, Sacc[c], 0, 0, 0); } }
            bf16* yp = ybase + (size_t)(n * CH + 32 * rb) * VW;
            if (dir == 0) {
#pragma unroll
                for (int t = 0; t < 16; ++t) yp[(size_t)crow(t, hh) * VW] = (bf16)(cvt_pk_bf16(O[t], 0.f) & 0xffffu);
            } else {
#pragma unroll
                for (int t = 0; t < 16; ++t) { bf16* p = yp + (size_t)crow(t, hh) * VW; const float y = __uint_as_float(((unsigned)*p) << 16) + O[t]; *p = (bf16)(cvt_pk_bf16(y, 0.f) & 0xffffu); }
            }
        }
        VM_WAIT();
    }
    __syncthreads();
}

struct Args { const float* in[16]; float* out; unsigned char* ws; };
constexpr int NWAVES = 8;
#ifndef PHMASK
#define PHMASK 0xFFFFFFFFu
#endif
#define PH(k) (((PHMASK) >> (k)) & 1u)
__global__ void __launch_bounds__(NWAVES * 64, 2) fwd_kernel(Args args) {
    extern __shared__ __attribute__((aligned(16))) unsigned char lds_raw[];
    LAS unsigned char* lds = (LAS unsigned char*)lds_raw;
    LAS float* l2g = (LAS float*)(lds + LDSCTL_OFF + 64);
    const int wave_k = __builtin_amdgcn_readfirstlane((int)threadIdx.x >> 6);
#define PHASE_VARS \
    const int tid = tid_of(wave_k); const int lane = tid & 63; int wave = wave_k; asm volatile("" : "+s"(wave)); \
    const __attribute__((address_space(4))) Args* ka = (const __attribute__((address_space(4))) Args*)__builtin_amdgcn_kernarg_segment_ptr(); asm volatile("" : "+s"(ka)); \
    const int G = gridDim.x, bx = blockIdx.x; const int vcu = (G % 8 == 0) ? (bx % 8) * (G / 8) + bx / 8 : bx; const int gw = vcu * NWAVES + wave, NGW = G * NWAVES; \
    unsigned char* ws = ka->ws; asm volatile("" : "+s"(ws)); float* hres = ka->out; (void)lane; (void)gw; (void)NGW; (void)vcu; (void)hres; \
    const float* x = ka->in[0]; const float* mix_norm = ka->in[1]; const float* ffn_norm = ka->in[2]; const float* ret_w_in = ka->in[3]; const float* ret_decay = ka->in[4]; \
    const float* gn_gain = ka->in[5]; const float* ret_w_out = ka->in[6]; const float* d_wg = ka->in[7]; const float* d_wu = ka->in[8]; const float* d_wd = ka->in[9]; \
    const float* fnet_w = ka->in[10]; const float* moe_router = ka->in[11]; const float* m_wg = ka->in[12]; const float* m_wu = ka->in[13]; const float* m_wd = ka->in[14]; const float* final_norm = ka->in[15]; \
    (void)x; (void)mix_norm; (void)ffn_norm; (void)ret_w_in; (void)ret_decay; (void)gn_gain; (void)ret_w_out; (void)d_wg; (void)d_wu; (void)d_wd; (void)fnet_w; (void)moe_router; (void)m_wg; (void)m_wu; (void)m_wd; (void)final_norm; \
    f32x2* rot = (f32x2*)(ws + WS_ROT); f32x2* rotT = (f32x2*)(ws + WS_ROTT); bf16* WC = (bf16*)(ws + WS_WC); \
    int* toke = (int*)(ws + WS_TOKE); float* tokw = (float*)(ws + WS_TOKW); int* bcnt = (int*)(ws + WS_BCNT); int* rowtok = (int*)(ws + WS_ROWTOK); float* rowgate = (float*)(ws + WS_ROWGATE); \
    f32x2* stats = (f32x2*)(ws + WS_STATS); \
    bf16* WIN = (bf16*)(ws + WS_WIN); bf16* WO = (bf16*)(ws + WS_WO); bf16* WGU = (bf16*)(ws + WS_WGU); bf16* WD = (bf16*)(ws + WS_WD); bf16* WF = (bf16*)(ws + WS_WF); \
    bf16* HN = (bf16*)(ws + WS_HN); bf16* Qb = (bf16*)(ws + WS_Q); bf16* Kb = (bf16*)(ws + WS_K); bf16* KT = (bf16*)(ws + WS_KT); bf16* VT = (bf16*)(ws + WS_VT); bf16* PC = (bf16*)(ws + WS_PC); \
    bf16* Yb = (bf16*)ka->out; bf16* YG = (bf16*)(ws + WS_YG); bf16* ACTD = (bf16*)(ws + WS_ACTD); bf16* Z2 = (bf16*)(ws + WS_Z2); bf16* WSEQ = (bf16*)(ws + WS_WSEQ); \
    bf16* ACTM = (bf16*)(ws + WS_ACTM); bf16* WMGU = (bf16*)(ws + WS_WMGU); bf16* WMD = (bf16*)(ws + WS_WMD); \
    (void)rot; (void)rotT; (void)WC; (void)toke; (void)tokw; (void)bcnt; (void)rowtok; (void)rowgate; (void)stats; (void)WIN; (void)WO; (void)WGU; (void)WD; (void)WF; (void)HN; (void)Qb; (void)Kb; (void)KT; (void)VT; (void)PC; \
    (void)Yb; (void)YG; (void)ACTD; (void)Z2; (void)WSEQ; (void)ACTM; (void)WMGU; (void)WMD;
#define GRID_BAR() do { const __attribute__((address_space(4))) Args* kb = (const __attribute__((address_space(4))) Args*)__builtin_amdgcn_kernarg_segment_ptr(); asm volatile("" : "+s"(kb)); unsigned char* wsb = kb->ws; XcdBarrier bar_; bar_.bar = (unsigned*)(wsb + WS_CTL) + CW_BAR; bar_.x = xb_xcc_id(); \
    bar_.st = (volatile LAS unsigned*)(lds + MISC_OFF) + 8; xcd_barrier(bar_, tid_of(wave_k) == 0); } while (0)

    {
        PHASE_VARS
        for (int u = tid; u < (LDS_BYTES - LDSCTL_OFF) / 4; u += NWAVES * 64) ((LAS unsigned*)(lds + LDSCTL_OFF))[u] = 0u;
        __syncthreads();
        if (tid < 8) { const float xl = ret_decay[tid]; const float ls = fminf(xl, 0.f) - log1pf(expf(-fabsf(xl))); l2g[tid] = ls * 1.44269504088896341f; }
        __syncthreads();
        (void)xcd_barrier_post((unsigned*)(ws + WS_CTL) + CW_BAR, (volatile LAS unsigned*)(lds + MISC_OFF) + 8, tid == 0);
    }

    if (PH(0)) {
        PHASE_VARS
        LAS float* scr = (LAS float*)(lds + wave * 16384);
        constexpr int I_IN = (D / 64) * (INW / 32), I_O = (VW / 64) * (D / 32), I_GU = 2 * (D / 64) * (FFD / 32), I_D = (FFD / 64) * (D / 32), I_F = (D / 64) * (D / 32);
        constexpr int NITEMS = I_IN + I_O + I_GU + I_D + I_F;
        for (int it = gw; it < NITEMS; it += NGW) {
            int r = it;
            if (r < I_IN) { tr_plain(ret_w_in, D, INW, WIN, r, scr, lane); continue; } r -= I_IN;
            if (r < I_O) { tr_plain(ret_w_out, VW, D, WO, r, scr, lane); continue; } r -= I_O;
            if (r < I_GU) { tr_gu(d_wg, d_wu, D, FFD, WGU, r, scr, lane); continue; } r -= I_GU;
            if (r < I_D) { tr_plain(d_wd, FFD, D, WD, r, scr, lane); continue; } r -= I_D;
            tr_plain(fnet_w, D, D, WF, r, scr, lane);
        }
        for (int e = (vcu * 512 + tid); e < SEQ * 128; e += G * 512) { const int s = e >> 7, i = e & 127;
            const float inv = powf(10000.0f, -(float)i / 128.0f); const float ang = (float)s * inv; float sn, cs; sincosf(ang, &sn, &cs);
            rot[e] = (f32x2){cs, sn}; rotT[(size_t)i * SEQ + s] = (f32x2){cs, sn}; }
        for (int e = (vcu * 512 + tid); e < 512 * 256; e += G * 512) { const int r = e >> 8, c = e & 255, mm = ((r & 255) * c) & 255;
            const float v = r < 256 ? cospif((float)mm * (1.0f / 128.0f)) : -sinpif((float)mm * (1.0f / 128.0f)); WC[e] = (bf16)(cvt_pk_bf16(v, 0.f) & 0xffffu); }
        for (int m = gw; m < T; m += NGW) { f32x4 v[4]; rms_row(x + (size_t)m * D, mix_norm, HN + (size_t)m * D, lane, v); }
    }
    GRID_BAR();

    if (PH(1) && PH(19)) {
        PHASE_VARS
        SchedPlain S{(const char*)HN, (const char*)WIN, (size_t)256 * D * 2, (size_t)256 * D * 2, T / 256, 8, G, bx};
        EpiRopeQK E{Qb, Kb, rot};
        pg8::gemm_phase<EpiRopeQK, SchedPlain, false>(lds, wave_k, D, D, D, S, E);
    }
    if (PH(1) && PH(20)) {
        PHASE_VARS
        SchedPlain S{(const char*)(WIN + (size_t)QKW * D), (const char*)HN, (size_t)256 * D * 2, (size_t)256 * D * 2, 4, T / 256, G, bx};
        EpiRopeKT E{KT, rotT};
        pg8::gemm_phase<EpiRopeKT, SchedPlain, false>(lds, wave_k, D, D, D, S, E);
    }
    if (PH(1) && PH(21)) {
        PHASE_VARS
        SchedPlain S{(const char*)(WIN + (size_t)2 * QKW * D), (const char*)HN, (size_t)256 * D * 2, (size_t)256 * D * 2, 8, T / 256, G, bx};
        EpiBf16 E{VT, T};
        pg8::gemm_phase<EpiBf16, SchedPlain, false>(lds, wave_k, D, D, D, S, E);
    }
    GRID_BAR();

    if (PH(2)) {
        PHASE_VARS
        SchedPc S{(const char*)Qb, (const char*)Kb, G, bx};
        EpiPc E{PC, l2g};
        pg8::gemm_phase<EpiPc, SchedPc, false>(lds, wave_k, QKW, QKW, DK, S, E);
    }
    GRID_BAR();

    if (PH(3)) {
        PHASE_VARS
        for (int u = vcu; u < NB * NH * 8; u += G) { const int hh_ = (u >> 3) & 3; const float l2f = l2g[hh_], l2b = l2g[4 + hh_];
            sweep_unit(lds, Qb, KT, VT, PC, Yb, l2f, l2b, u >> 5, hh_, u & 7, wave_k); }
    }
    GRID_BAR();

    if (PH(4)) {
        PHASE_VARS
    for (int m = gw; m < T; m += NGW) {
#pragma unroll
        for (int hd = 0; hd < NH; ++hd) { const u32x4 yv = *((const u32x4*)(Yb + (size_t)m * VW + hd * DV) + lane);
            const float y[8] = {bf_lo(yv.x), bf_hi(yv.x), bf_lo(yv.y), bf_hi(yv.y), bf_lo(yv.z), bf_hi(yv.z), bf_lo(yv.w), bf_hi(yv.w)};
            float s = 0.f;
#pragma unroll
            for (int q = 0; q < 8; ++q) s += y[q];
            const float mu = wave_sum(s) * (1.f / DV); float s2 = 0.f;
#pragma unroll
            for (int q = 0; q < 8; ++q) { const float d = y[q] - mu; s2 += d * d; }
            const float var = wave_sum(s2) * (1.f / DV);
            if (lane == 0) stats[(size_t)m * 4 + hd] = (f32x2){mu, 1.0f / sqrtf(var + EPS)}; }
    }
    }
    GRID_BAR();

    if (PH(5)) {
        PHASE_VARS
        SchedPlain S{(const char*)HN, (const char*)(WIN + (size_t)(2 * QKW + VW) * D), (size_t)256 * D * 2, (size_t)256 * D * 2, T / 256, 8, G, bx};
        EpiGate E{Yb, YG, stats, gn_gain};
        pg8::gemm_phase<EpiGate, SchedPlain, false>(lds, wave_k, D, D, D, S, E);
    }
    GRID_BAR();

    if (PH(6)) {
        PHASE_VARS
        SchedPlain S{(const char*)YG, (const char*)WO, (size_t)256 * VW * 2, (size_t)256 * VW * 2, T / 256, 4, G, bx};
        EpiResF32 E{x, hres};
        pg8::gemm_phase<EpiResF32, SchedPlain, false>(lds, wave_k, VW, VW, VW, S, E);
    }
    GRID_BAR();

    if (PH(7)) {
        PHASE_VARS
        for (int m = gw; m < T; m += NGW) { f32x4 v[4]; rms_row(hres + (size_t)m * D, ffn_norm, HN + (size_t)m * D, lane, v); }
        LAS float* scr = (LAS float*)(lds + wave * 16384);
        constexpr int I_GU = 2 * (D / 64) * (FFE / 32), I_D = (FFE / 64) * (D / 32);
        for (int it = gw; it < NE * (I_GU + I_D); it += NGW) {
            const int e = it / (I_GU + I_D); int r = it - e * (I_GU + I_D);
            if (r < I_GU) tr_gu(m_wg + (size_t)e * D * FFE, m_wu + (size_t)e * D * FFE, D, FFE, WMGU + (size_t)e * 2 * FFE * D, r, scr, lane);
            else tr_plain(m_wd + (size_t)e * FFE * D, FFE, D, WMD + (size_t)e * D * FFE, r - I_GU, scr, lane);
        }
    }
    GRID_BAR();

    if (PH(8)) {
        PHASE_VARS
        SchedPlain S{(const char*)HN, (const char*)WGU, (size_t)256 * D * 2, (size_t)256 * D * 2, T / 256, 2 * FFD / 256, G, bx};
        EpiSwiGLU E{ACTD, FFD};
        pg8::gemm_phase<EpiSwiGLU, SchedPlain, false>(lds, wave_k, D, D, D, S, E);
    }
    GRID_BAR();
    if (PH(9)) {
        PHASE_VARS
        SchedPlain S{(const char*)ACTD, (const char*)WD, (size_t)256 * FFD * 2, (size_t)256 * FFD * 2, T / 256, 4, G, bx};
        EpiResF32 E{hres, hres};
        pg8::gemm_phase<EpiResF32, SchedPlain, false>(lds, wave_k, FFD, FFD, FFD, S, E);
    }
    GRID_BAR();

    if (PH(10)) {
        PHASE_VARS
        for (int m = gw; m < T; m += NGW) { f32x4 v[4]; rms_row(hres + (size_t)m * D, mix_norm + D, HN + (size_t)m * D, lane, v); }
        LAS float* tab = (LAS float*)lds;
        for (int m = tid; m < SEQ; m += NWAVES * 64) tab[m] = cospif((float)m * (1.0f / 2048.0f)) * (1.0f / 1024.0f);
        __syncthreads();
        for (int e8 = vcu * 512 + tid; e8 < SEQ * 8192 / 8; e8 += G * 512) { const int k = e8 >> 10, c0 = (e8 & 1023) * 8; float v[8];
#pragma unroll
            for (int q = 0; q < 8; ++q) { const int c = c0 + q, s = c & (SEQ - 1); const int mm = (s * k - (c >= SEQ ? 1024 : 0)) & (SEQ - 1); v[q] = tab[mm]; }
            u32x4 w; w.x = cvt_pk_bf16(v[0], v[1]); w.y = cvt_pk_bf16(v[2], v[3]); w.z = cvt_pk_bf16(v[4], v[5]); w.w = cvt_pk_bf16(v[6], v[7]);
            *(u32x4*)(WSEQ + (size_t)e8 * 8) = w; }
        __syncthreads();
    }
    GRID_BAR();

    if (PH(11)) {
        PHASE_VARS
        SchedFnA S{(const char*)WC, (const char*)HN, G, bx};
        EpiZ2 E{Z2};
        pg8::gemm_phase<EpiZ2, SchedFnA, false>(lds, wave_k, 256, D, 256, S, E);
    }
    GRID_BAR();
    if (PH(12)) {
        PHASE_VARS
        SchedFnB S{(const char*)WSEQ, (const char*)Z2, G, bx};
        EpiBf16 E{HN, D};
        pg8::gemm_phase<EpiBf16, SchedFnB, false>(lds, wave_k, 8192, 8192, 8192, S, E);
    }
    GRID_BAR();
    if (PH(13)) {
        PHASE_VARS
        SchedPlain S{(const char*)HN, (const char*)WF, (size_t)256 * D * 2, (size_t)256 * D * 2, T / 256, 4, G, bx};
        EpiResF32 E{hres, hres};
        pg8::gemm_phase<EpiResF32, SchedPlain, false>(lds, wave_k, D, D, D, S, E);
    }
    GRID_BAR();

    if (PH(14)) {
        PHASE_VARS
        LAS float* wrl = (LAS float*)lds;
        LAS int* le = (LAS int*)(lds + 32768);
        for (int i = tid; i < D * NE / 4; i += NWAVES * 64) ((LAS f32x4*)wrl)[i] = ((const f32x4*)moe_router)[i];
        for (int i = vcu * 512 + tid; i < 2 * MOE_ROWS; i += G * 512) rowtok[i] = -1;
        __syncthreads();
        for (int tb = vcu; tb < T / 128; tb += G) {
            for (int rr = 0; rr < 16; ++rr) { const int tl = wave * 16 + rr, m = tb * 128 + tl; f32x4 v[4];
                rms_row(hres + (size_t)m * D, ffn_norm + D, HN + (size_t)m * D, lane, v);
                float lg[8];
#pragma unroll
                for (int e = 0; e < 8; ++e) lg[e] = 0.f;
#pragma unroll
                for (int j = 0; j < 4; ++j)
#pragma unroll
                    for (int c = 0; c < 4; ++c) { const int col = 256 * j + 4 * lane + c; const f32x4 w0 = *(const LAS f32x4*)(wrl + col * 8), w1 = *(const LAS f32x4*)(wrl + col * 8 + 4); const float xv = v[j][c];
                        lg[0] += xv * w0.x; lg[1] += xv * w0.y; lg[2] += xv * w0.z; lg[3] += xv * w0.w; lg[4] += xv * w1.x; lg[5] += xv * w1.y; lg[6] += xv * w1.z; lg[7] += xv * w1.w; }
#pragma unroll
                for (int e = 0; e < 8; ++e) lg[e] = wave_sum(lg[e]);
                int e0 = 0; float b0 = lg[0];
#pragma unroll
                for (int e = 1; e < 8; ++e) if (lg[e] > b0) { b0 = lg[e]; e0 = e; }
                int e1 = -1; float b1 = -3.0e38f;
#pragma unroll
                for (int e = 0; e < 8; ++e) if (e != e0 && lg[e] > b1) { b1 = lg[e]; e1 = e; }
                const float w0 = 1.0f / (1.0f + __expf(b1 - b0));
                if (lane == 0) { toke[2 * m] = e0; toke[2 * m + 1] = e1; tokw[2 * m] = w0; tokw[2 * m + 1] = 1.0f - w0; le[tl] = e0; le[128 + tl] = e1; } }
            __syncthreads();
            if (tid < 16) { const int s = tid >> 3, e = tid & 7; int c = 0; for (int i = 0; i < 128; ++i) c += (le[s * 128 + i] == e) ? 1 : 0; bcnt[tb * 16 + tid] = c; }
            __syncthreads();
        }
    }
    GRID_BAR();

    LAS int* segoff = (LAS int*)(lds + 132096);
    LAS int* ntile = (LAS int*)(lds + 132096 + 64);
    LAS unsigned char* tile_e = (LAS unsigned char*)(lds + 132096 + 128);
    if (PH(15)) {
        PHASE_VARS
        LAS int* pre = (LAS int*)lds;
        LAS int* tot = (LAS int*)(lds + 16384);
        LAS int* wc0 = (LAS int*)(lds + 16384 + 64);
        for (int i = tid; i < 256 * 16; i += NWAVES * 64) pre[i] = bcnt[i];
        __syncthreads();
        if (tid < 16) { int run = 0; for (int b2 = 0; b2 < 256; ++b2) { const int c = pre[b2 * 16 + tid]; pre[b2 * 16 + tid] = run; run += c; } tot[tid] = run; }
        __syncthreads();
        if (tid < 2) { int off = 0, nt = 0; for (int e = 0; e < 8; ++e) { segoff[tid * 8 + e] = off; const int tl = (tot[tid * 8 + e] + 255) >> 8; for (int q = 0; q < tl; ++q) tile_e[tid * 160 + nt + q] = (unsigned char)e; nt += tl; off += tl * 256; } ntile[tid] = nt; }
        __syncthreads();
        for (int tb = vcu; tb < T / 128; tb += G) {
            int ee[2] = {0, 0}, rk[2] = {0, 0};
            if (tid < 128) { const int m = tb * 128 + tid;
#pragma unroll
                for (int s = 0; s < 2; ++s) { const int e = toke[2 * m + s]; ee[s] = e;
#pragma unroll
                    for (int q = 0; q < 8; ++q) { const unsigned long long mk = __ballot(e == q); if (e == q) rk[s] = __popcll(mk & ((1ull << lane) - 1ull)); if (wave == 0 && lane == 0) wc0[s * 8 + q] = __popcll(mk); } } }
            __syncthreads();
            if (tid < 128) { const int m = tb * 128 + tid;
#pragma unroll
                for (int s = 0; s < 2; ++s) { const int e = ee[s]; const int rank = rk[s] + (wave == 1 ? wc0[s * 8 + e] : 0);
                    const int row = segoff[s * 8 + e] + pre[tb * 16 + s * 8 + e] + rank;
                    rowtok[s * MOE_ROWS + row] = m; rowgate[s * MOE_ROWS + row] = tokw[2 * m + s]; } }
            __syncthreads();
        }
    }
    GRID_BAR();

    if (PH(16))
#pragma unroll
    for (int s = 0; s < 2; ++s) {
        {
            PHASE_VARS
            SchedMoe S{(const char*)HN, (const char*)WMGU, rowtok + s * MOE_ROWS, tile_e + s * 160, 0, (size_t)2 * FFE * D * 2, (size_t)256 * D * 2, ntile[s], 2 * FFE / 256, G, bx, true};
            EpiSwiGLU E{ACTM, FFE};
            pg8::gemm_phase<EpiSwiGLU, SchedMoe, true>(lds, wave_k, D, D, D, S, E);
        }
        GRID_BAR();
        {
            PHASE_VARS
            SchedMoe S{(const char*)ACTM, (const char*)WMD, rowtok + s * MOE_ROWS, tile_e + s * 160, (size_t)256 * FFE * 2, (size_t)D * FFE * 2, (size_t)256 * FFE * 2, ntile[s], 4, G, bx, false};
            EpiMoeDown E{hres, rowtok + s * MOE_ROWS, rowgate + s * MOE_ROWS};
            pg8::gemm_phase<EpiMoeDown, SchedMoe, false>(lds, wave_k, FFE, FFE, FFE, S, E);
        }
        GRID_BAR();
    }

    if (PH(17)) {
        PHASE_VARS
        const bool bad = __hip_atomic_load((unsigned*)(ws + WS_CTL) + CW_BAR + XB_TMO, RLX_AGENT) != 0u;
        for (int m = gw; m < T; m += NGW) {
            GAS f32x4* xr = (GAS f32x4*)(hres + (size_t)m * D) + lane; const GAS f32x4* gr = (const GAS f32x4*)final_norm + lane;
            f32x4 v[4]; float s = 0.f;
#pragma unroll
            for (int j = 0; j < 4; ++j) { v[j] = xr[64 * j]; s += (v[j].x * v[j].x + v[j].y * v[j].y) + (v[j].z * v[j].z + v[j].w * v[j].w); }
            const float r = bad ? __builtin_nanf("") : 1.0f / sqrtf(wave_sum(s) * (1.f / D) + EPS);
#pragma unroll
            for (int j = 0; j < 4; ++j) xr[64 * j] = v[j] * r * gr[64 * j];
        }
    }
}

extern "C" void kernel_launch(void* const* d_in, const int* in_sizes, int n_in, void* d_out, int out_size, void* d_ws, size_t ws_size, hipStream_t stream) {
    static int grid = 0;
    if (grid == 0) {
        if (n_in != 16 || in_sizes[0] != T * D || out_size != T * D || ws_size < WS_END) { fprintf(stderr, "kernel_launch: unexpected shapes (n_in %d, in0 %d, out %d, ws %zu)\n", n_in, n_in > 0 ? in_sizes[0] : -1, out_size, ws_size); grid = -1; return; }
        int dev = 0, cus = 0, per_cu = 0;
        if (hipGetDevice(&dev) != hipSuccess || hipDeviceGetAttribute(&cus, hipDeviceAttributeMultiprocessorCount, dev) != hipSuccess) { grid = -1; return; }
        if (hipFuncSetAttribute((const void*)fwd_kernel, hipFuncAttributeMaxDynamicSharedMemorySize, LDS_BYTES) != hipSuccess) { fprintf(stderr, "kernel_launch: hipFuncSetAttribute failed\n"); grid = -1; return; }
        if (hipOccupancyMaxActiveBlocksPerMultiprocessor(&per_cu, (const void*)fwd_kernel, NWAVES * 64, LDS_BYTES) != hipSuccess || per_cu < 1) { fprintf(stderr, "kernel_launch: occupancy query says %d\n", per_cu); }
        (void)hipGetLastError();
        grid = cus;
    }
    if (grid < 0) return;
    if (hipMemsetAsync((char*)d_ws + WS_CTL, 0, CTL_ZERO_BYTES, stream) != hipSuccess) return;
    Args a{};
    for (int i = 0; i < 16; ++i) a.in[i] = (const float*)d_in[i];
    a.out = (float*)d_out; a.ws = (unsigned char*)d_ws;
    hipLaunchKernelGGL(fwd_kernel, dim3(grid), dim3(NWAVES * 64), LDS_BYTES, stream, a);
}
```

```cpp
#include <hip/hip_runtime.h>
#include <cstdio>
#include <cstdint>

#define LAS __attribute__((address_space(3)))
#define GAS __attribute__((address_space(1)))
typedef unsigned short bf16;
typedef short bf16x8 __attribute__((ext_vector_type(8)));
typedef float f32x2 __attribute__((ext_vector_type(2)));
typedef float f32x4 __attribute__((ext_vector_type(4)));
typedef float f32x16 __attribute__((ext_vector_type(16)));
typedef unsigned u32x2 __attribute__((ext_vector_type(2)));
typedef unsigned u32x4 __attribute__((ext_vector_type(4)));
typedef GAS unsigned gu32;

constexpr int D = 1024, NB = 8, SEQ = 4096, T = NB * SEQ;
constexpr int NH = 4, DK = 256, DV = 512, QKW = 1024, VW = 2048, INW = 6144, CH = 128, NCH = SEQ / CH;
constexpr int FFD = 2816, NE = 8, FFE = 3584;
constexpr int MOE_ROWS = T + NE * 256;
constexpr float EPS = 1e-6f;

constexpr size_t MiB = 1u << 20;
constexpr size_t WS_CTL = 0, CTL_ZERO_BYTES = 1 * MiB;
constexpr size_t WS_ROT = 1 * MiB, WS_ROTT = 5 * MiB, WS_WC = 9 * MiB;
constexpr size_t WS_TOKE = 9 * MiB + 256 * 1024;
constexpr size_t WS_TOKW = WS_TOKE + 256 * 1024;
constexpr size_t WS_BCNT = WS_TOKW + 256 * 1024;
constexpr size_t WS_ROWTOK = WS_BCNT + 16 * 1024;
constexpr size_t WS_ROWGATE = WS_ROWTOK + 2 * MOE_ROWS * 4;
constexpr size_t WS_STATS = 11 * MiB;
static_assert(WS_ROWGATE + 2 * MOE_ROWS * 4 <= WS_STATS, "small tables");
constexpr size_t WS_WIN = 12 * MiB, WS_WO = 24 * MiB, WS_WGU = 28 * MiB, WS_WD = 39 * MiB, WS_WF = 44 * MiB + 512 * 1024;
constexpr size_t WS_HN = 48 * MiB;
constexpr size_t WS_Q = 112 * MiB, WS_K = 176 * MiB, WS_KT = 240 * MiB  , WS_VT = 368 * MiB, WS_PC = 496 * MiB;
constexpr size_t WS_YG = 240 * MiB;
constexpr size_t WS_STATP = 176 * MiB;
constexpr size_t WS_ACTD = 112 * MiB;
constexpr size_t WS_Z2 = 112 * MiB, WS_WSEQ = 240 * MiB;
constexpr size_t WS_ACTM = 112 * MiB;
constexpr size_t WS_WMGU = 352 * MiB, WS_WMD = 464 * MiB, WS_END = 528 * MiB;
static_assert(WS_ACTM + (size_t)MOE_ROWS * FFE * 2 <= WS_WMGU, "moe act");
static_assert(WS_PC + (size_t)NB * NH * NCH * CH * CH * 2 <= 528 * MiB, "epoch A");
static_assert(WS_WF + (size_t)D * D * 2 <= WS_HN, "weights");
constexpr int CW_BAR = 4096;
constexpr int CW_CHK = 64;

constexpr int RING_BYTES = 131072;
constexpr int LDSCTL_OFF = 139264, MISC_OFF = LDSCTL_OFF + 320;
constexpr int LDS_BYTES = 147456;

#define LDS_WAIT() asm volatile("s_waitcnt lgkmcnt(0)" ::: "memory")
#define VM_WAIT() asm volatile("s_waitcnt vmcnt(0)" ::: "memory")
#define RLX_AGENT __ATOMIC_RELAXED, __HIP_MEMORY_SCOPE_AGENT

__device__ __forceinline__ unsigned cvt_pk_bf16(float lo, float hi) { unsigned r; asm volatile("v_cvt_pk_bf16_f32 %0, %1, %2" : "=v"(r) : "v"(lo), "v"(hi)); return r; }
__device__ __forceinline__ float bf_lo(unsigned w) { return __uint_as_float(w << 16); }
__device__ __forceinline__ float bf_hi(unsigned w) { return __uint_as_float(w & 0xffff0000u); }
__device__ __forceinline__ float fast_exp2(float x) { return __builtin_amdgcn_exp2f(x); }
__device__ __forceinline__ int lane_id_v() { int l; asm volatile("v_mbcnt_lo_u32_b32 %0, -1, 0\n\tv_mbcnt_hi_u32_b32 %0, -1, %0" : "=v"(l)); return l; }
__device__ __forceinline__ int tid_of(int wave_s) { asm volatile("" : "+s"(wave_s)); return wave_s * 64 + lane_id_v(); }
__device__ __forceinline__ int rot_col(int row, int tok) { return (tok + ((row & 15) << 11)) & (32768 - 1); }
__device__ __forceinline__ float silu_f(float v) { return v / (1.0f + __expf(-v)); }

namespace pg8 {
constexpr int BM = 256, BK = 64, HALF = 128, HTB = HALF * BK * 2, STAGE_BYTES = 8 * HTB, NXCD = 8, WGM = 8;
__host__ __device__ __forceinline__ int lds_byte(int r, int c) { const int st = (r >> 4) * 2 + (c >> 5), rr = r & 15, cc = c & 31, ob = rr * 64 + cc * 2; return st * 1024 + (ob ^ (((ob >> 9) & 1) << 5)); }
__host__ __device__ __forceinline__ void stage_rc(int b, int& R, int& C) { const int st = b / 1024, sb = b % 1024, swz = sb ^ (((sb >> 9) & 1) << 5); R = (st >> 1) * 16 + swz / 64; C = (st & 1) * 32 + (swz % 64) / 2; }
__host__ __device__ __forceinline__ int perm32(int rho) { const int n = rho >> 4, i = rho & 15; return 8 * (i >> 2) + 4 * n + (i & 3); }

struct Unit { const GAS char* A; const GAS char* B; const GAS int* rows; int pm, pn, z; };

__device__ __forceinline__ bool tile_of(long L, int nM, int nN, int& pm, int& pn) {
    const int nwg = nM * nN; if (L >= nwg) return false;
    int wgid = (int)L; { const int q = nwg / NXCD, r = nwg % NXCD, xcd = wgid % NXCD, off = wgid / NXCD; wgid = (xcd < r ? xcd * (q + 1) : r * (q + 1) + (xcd - r) * q) + off; }
    const int nig = WGM * nN, gid = wgid / nig, fm = gid * WGM, gsz = (nM - fm) < WGM ? (nM - fm) : WGM;
    pm = fm + ((wgid % nig) % gsz); pn = (wgid % nig) / gsz; return true;
}

template <class Epi, class Sched, bool GATHER>
__device__ __forceinline__ void gemm_phase(LAS unsigned char* lds, const int wave_s, const int lda, const int ldb, const int K, const Sched& S, const Epi& E) {
    const int tid = tid_of(wave_s);
    const int wid = __builtin_amdgcn_readfirstlane(tid >> 6), lane = tid & 63, wr = wid >> 2, wc = wid & 3, fr = lane & 15, fq = lane >> 4;
    const int nt = K / BK;
    unsigned vA[2][2], vAn[2][2], voffB[2];
#pragma unroll
    for (int i = 0; i < 2; ++i) { int R, C; stage_rc(tid * 16 + i * 8192, R, C); const int Rb = Epi::PERM ? ((R & ~31) + perm32(R & 31)) : R;
        voffB[i] = (unsigned)(Rb * ldb + C) * 2u;
#pragma unroll
        for (int h = 0; h < 2; ++h) { vA[h][i] = (unsigned)((h * HALF + R) * lda + C) * 2u; vAn[h][i] = vA[h][i]; } }
    const size_t kstep = (size_t)(BK * 2);
    const size_t hstepB = (size_t)HALF * ldb * 2;
    const unsigned ldsw = (unsigned)wid * 1024u;
    const int aoff = lds_byte(wr * 64 + fr, fq * 8), boff = lds_byte(wc * 32 + fr, fq * 8);
#define PG8_SA(b, h) (((b) * 2 + (h)) * HTB)
#define PG8_SB(b, h) ((4 + (b) * 2 + (h)) * HTB)
#define PG8_STAGE_B(bufoff, gbase) do { _Pragma("unroll") for (int _i = 0; _i < 2; ++_i) \
        __builtin_amdgcn_global_load_lds((const GAS unsigned*)((const GAS char*)(gbase) + voffB[_i]), (LAS unsigned*)(lds + (bufoff) + ldsw + _i * 8192), 16, 0, 0); } while (0)
#define PG8_STAGE_A(bufoff, gbase, v0, v1) do { \
        __builtin_amdgcn_global_load_lds((const GAS unsigned*)((const GAS char*)(gbase) + (v0)), (LAS unsigned*)(lds + (bufoff) + ldsw), 16, 0, 0); \
        __builtin_amdgcn_global_load_lds((const GAS unsigned*)((const GAS char*)(gbase) + (v1)), (LAS unsigned*)(lds + (bufoff) + ldsw + 8192), 16, 0, 0); } while (0)
#define PG8_LDA(dst, b, h) do { _Pragma("unroll") for (int m = 0; m < 4; ++m) _Pragma("unroll") for (int k = 0; k < 2; ++k) dst[m][k] = *(const LAS bf16x8*)(lds + PG8_SA(b, h) + aoff + m * 2048 + k * 1024); } while (0)
#define PG8_LDB(dst, b, h) do { _Pragma("unroll") for (int n = 0; n < 2; ++n) _Pragma("unroll") for (int k = 0; k < 2; ++k) dst[n][k] = *(const LAS bf16x8*)(lds + PG8_SB(b, h) + boff + n * 2048 + k * 1024); } while (0)
#define PG8_MMA(ai, bj, At, Bt) do { __builtin_amdgcn_s_setprio(1); _Pragma("unroll") for (int m = 0; m < 4; ++m) _Pragma("unroll") for (int n = 0; n < 2; ++n) _Pragma("unroll") for (int k = 0; k < 2; ++k) \
        acc[ai][bj][m][n] = __builtin_amdgcn_mfma_f32_16x16x32_bf16(Bt[n][k], At[m][k], acc[ai][bj][m][n], 0, 0, 0); __builtin_amdgcn_s_setprio(0); } while (0)
#define PG8_WAIT_V(n) asm volatile("s_waitcnt vmcnt(" #n ")" ::: "memory")
#define PG8_WAIT_L(n) asm volatile("s_waitcnt lgkmcnt(" #n ")" ::: "memory")
#define PG8_BAR __builtin_amdgcn_s_barrier()
#define PG8_SCHED __builtin_amdgcn_sched_barrier(0)
#define PG8_LOADROWS(dst, u) do { if constexpr (GATHER) { const int _tz = tid_of(wave_s); _Pragma("unroll") for (int _i = 0; _i < 2; ++_i) { int _R, _C; stage_rc(_tz * 16 + _i * 8192, _R, _C); \
        _Pragma("unroll") for (int _h = 0; _h < 2; ++_h) { const int _t = (u).rows[_h * HALF + _R]; dst[_h][_i] = (unsigned)((_t < 0 ? 0 : _t) * lda + _C) * 2u; } } } } while (0)
#define PG8_VAN(h, i) (GATHER ? vAn[h][i] : vA[h][i])
    Unit cur, nxt; int ui = 0;
    if (!S.next(0, cur)) return;
    f32x4 acc[2][2][4][2];
#pragma unroll
    for (int a = 0; a < 2; ++a)
#pragma unroll
        for (int b = 0; b < 2; ++b)
#pragma unroll
            for (int m = 0; m < 4; ++m)
#pragma unroll
                for (int n = 0; n < 2; ++n) acc[a][b][m][n] = (f32x4){0.f, 0.f, 0.f, 0.f};
    bf16x8 At[4][2], B0[2][2], B1[2][2];
    const GAS char* cA = cur.A; const GAS char* cB = cur.B;
    PG8_LOADROWS(vA, cur);
    if constexpr (GATHER) { vAn[0][0] = vA[0][0]; vAn[0][1] = vA[0][1]; vAn[1][0] = vA[1][0]; vAn[1][1] = vA[1][1]; }
    PG8_STAGE_B(PG8_SB(0, 0), cB); PG8_STAGE_B(PG8_SB(0, 1), cB + hstepB); PG8_STAGE_A(PG8_SA(0, 0), cA, vA[0][0], vA[0][1]); PG8_STAGE_A(PG8_SA(0, 1), cA, vA[1][0], vA[1][1]);
    if (wr == 1) PG8_BAR;
    PG8_WAIT_V(2); PG8_BAR;
    PG8_STAGE_B(PG8_SB(1, 0), cB + kstep); PG8_STAGE_A(PG8_SA(1, 0), cA + kstep, vA[0][0], vA[0][1]); PG8_STAGE_B(PG8_SB(1, 1), cB + hstepB + kstep);
    PG8_WAIT_V(6); PG8_BAR;
    for (;;) {
        const bool has_next = S.next(ui + 1, nxt);
        const GAS char* nA = has_next ? nxt.A : cA; const GAS char* nB = has_next ? nxt.B : cB;
#pragma unroll 1
        for (int t = 0; t < nt; t += 2) {
            const bool last = (t == nt - 2);
            const GAS char* a1 = cA + (size_t)(t + 1) * kstep;
            const GAS char* a2 = last ? nA : cA + (size_t)(t + 2) * kstep; const GAS char* b2 = last ? nB : cB + (size_t)(t + 2) * kstep;
            const GAS char* a3 = a2 + kstep; const GAS char* b3 = b2 + kstep;
            if constexpr (GATHER) { if (last && has_next) { PG8_LOADROWS(vAn, nxt); } }
            PG8_LDB(B0, 0, 0); PG8_LDB(B1, 0, 1); PG8_SCHED; PG8_LDA(At, 0, 0); PG8_STAGE_A(PG8_SA(1, 1), a1, vA[1][0], vA[1][1]);
            PG8_WAIT_V(8); PG8_WAIT_L(0); PG8_BAR; PG8_MMA(0, 0, At, B0); PG8_MMA(0, 1, At, B1); PG8_BAR; PG8_SCHED;
            PG8_LDA(At, 0, 1); PG8_STAGE_B(PG8_SB(0, 0), b2); PG8_STAGE_B(PG8_SB(0, 1), b2 + hstepB); PG8_STAGE_A(PG8_SA(0, 0), a2, PG8_VAN(0, 0), PG8_VAN(0, 1));
            PG8_WAIT_V(8); PG8_WAIT_L(0); PG8_BAR; PG8_MMA(1, 0, At, B0); PG8_MMA(1, 1, At, B1); PG8_BAR; PG8_SCHED;
            PG8_LDB(B0, 1, 0); PG8_LDB(B1, 1, 1); PG8_SCHED; PG8_LDA(At, 1, 0); PG8_STAGE_A(PG8_SA(0, 1), a2, PG8_VAN(1, 0), PG8_VAN(1, 1));
            PG8_WAIT_V(8); PG8_WAIT_L(0); PG8_BAR; PG8_MMA(0, 0, At, B0); PG8_MMA(0, 1, At, B1); PG8_BAR; PG8_SCHED;
            PG8_LDA(At, 1, 1); PG8_STAGE_B(PG8_SB(1, 0), b3); PG8_STAGE_B(PG8_SB(1, 1), b3 + hstepB); PG8_STAGE_A(PG8_SA(1, 0), a3, PG8_VAN(0, 0), PG8_VAN(0, 1));
            PG8_WAIT_V(8); PG8_WAIT_L(0); PG8_BAR; PG8_MMA(1, 0, At, B0); PG8_MMA(1, 1, At, B1); PG8_BAR; PG8_SCHED;
        }
        if (wr == 0) PG8_BAR;
        E(acc, cur, wr, wc, fr, fq);
        if (!has_next) break;
#pragma unroll
        for (int a = 0; a < 2; ++a)
#pragma unroll
            for (int b = 0; b < 2; ++b)
#pragma unroll
                for (int m = 0; m < 4; ++m)
#pragma unroll
                    for (int n = 0; n < 2; ++n) acc[a][b][m][n] = (f32x4){0.f, 0.f, 0.f, 0.f};
        cur = nxt; cA = nA; cB = nB; ++ui;
        if constexpr (GATHER) { vA[0][0] = vAn[0][0]; vA[0][1] = vAn[0][1]; vA[1][0] = vAn[1][0]; vA[1][1] = vAn[1][1]; }
        if (wr == 1) PG8_BAR;
    }
    PG8_WAIT_V(0);
    PG8_BAR;
#undef PG8_SA
#undef PG8_SB
#undef PG8_STAGE_A
#undef PG8_STAGE_B
#undef PG8_LDA
#undef PG8_LDB
#undef PG8_MMA
#undef PG8_WAIT_V
#undef PG8_WAIT_L
#undef PG8_BAR
#undef PG8_SCHED
#undef PG8_LOADROWS
#undef PG8_VAN
}
}

struct SchedPlain {
    const GAS char* A; const GAS char* B; size_t a_tile, b_tile; int nM, nN, G, c;
    __device__ __forceinline__ bool next(int i, pg8::Unit& u) const {
        int pm, pn; if (!pg8::tile_of((long)i * G + c, nM, nN, pm, pn)) return false;
        u.pm = pm; u.pn = pn; u.z = 0; u.rows = nullptr; u.A = A + (size_t)pm * a_tile; u.B = B + (size_t)pn * b_tile; return true; }
};
struct SchedPc {
    const GAS char* Q; const GAS char* Kk; int G, c;
    __device__ __forceinline__ bool next(int i, pg8::Unit& u) const {
        const int L = i * G + c; if (L >= NB * NH * 16) return false;
        const int cp = L & 15, h = (L >> 4) & 3, b = L >> 6;
        const size_t off = ((size_t)(b * SEQ + cp * 256) * QKW + h * DK) * 2;
        u.pm = L; u.pn = 0; u.z = h; u.rows = nullptr; u.A = Q + off; u.B = Kk + off; return true; }
};
struct SchedFnA {
    const GAS char* Wc; const GAS char* Hn; int G, c;
    __device__ __forceinline__ bool next(int i, pg8::Unit& u) const {
        int pm, pn; if (!pg8::tile_of((long)i * G + c, 8, T / 256, pm, pn)) return false;
        const int g = pm >> 1, ri = pm & 1;
        u.pm = pm; u.pn = pn; u.z = 0; u.rows = nullptr; u.A = Wc + (size_t)ri * 256 * 256 * 2; u.B = Hn + ((size_t)pn * 256 * D + g * 256) * 2; return true; }
};
struct SchedFnB {
    const GAS char* Wseq; const GAS char* Z2; int G, c;
    __device__ __forceinline__ bool next(int i, pg8::Unit& u) const {
        int pm, pn; if (!pg8::tile_of((long)i * G + c, NB * 16, 4, pm, pn)) return false;
        const int b = pm >> 4, kt = pm & 15;
        u.pm = pm; u.pn = pn; u.z = 0; u.rows = nullptr; u.A = Wseq + (size_t)kt * 256 * 8192 * 2; u.B = Z2 + ((size_t)b * 1024 + pn * 256) * 8192 * 2; return true; }
};
struct SchedMoe {
    const GAS char* A; const GAS char* W; const GAS int* rowtok; const LAS unsigned char* texp; size_t a_tile, w_exp, w_tile; int ntiles, ncol, G, c; bool gather;
    __device__ __forceinline__ bool next(int i, pg8::Unit& u) const {
        const int L = i * G + c; if (L >= ntiles * ncol) return false;
        const int rt = L / ncol, ct = L - rt * ncol; const int e = texp[rt];
        u.pm = rt; u.pn = ct; u.z = e; u.rows = rowtok + rt * 256; u.A = gather ? A : A + (size_t)rt * a_tile; u.B = W + (size_t)e * w_exp + (size_t)ct * w_tile; return true; }
};

struct EpiRopeQK {
    static constexpr bool PERM = true;
    GAS bf16* Q; GAS bf16* Kk; const GAS f32x2* rot;
    __device__ __forceinline__ void operator()(const f32x4 (&acc)[2][2][4][2], const pg8::Unit& u, int wr, int wc, int fr, int fq) const {
        const bool isk = u.pn >= 4; const int h = u.pn & 3; GAS bf16* dst = isk ? Kk : Q; const float sc = isk ? 0.0625f : 1.0f;
        const int i0 = wc * 32 + 8 * fq;
#pragma unroll
        for (int ai = 0; ai < 2; ++ai)
#pragma unroll
            for (int m = 0; m < 4; ++m) {
                const int t = u.pm * 256 + ai * 128 + wr * 64 + m * 16 + fr, s = t & (SEQ - 1);
                const GAS f32x4* rp = (const GAS f32x4*)(rot + (size_t)s * 128 + i0);
                const f32x4 r0 = rp[0], r1 = rp[1], r2 = rp[2], r3 = rp[3];
                const float cs[8] = {r0[0], r0[2], r1[0], r1[2], r2[0], r2[2], r3[0], r3[2]}, sn[8] = {r0[1], r0[3], r1[1], r1[3], r2[1], r2[3], r3[1], r3[3]};
                float o1[8], o2[8];
#pragma unroll
                for (int n = 0; n < 2; ++n)
#pragma unroll
                    for (int j = 0; j < 4; ++j) { const float t1 = acc[ai][0][m][n][j], t2 = acc[ai][1][m][n][j]; const int q = 4 * n + j;
                        o1[q] = (t1 * cs[q] - t2 * sn[q]) * sc; o2[q] = (t1 * sn[q] + t2 * cs[q]) * sc; }
                GAS bf16* rowp = dst + (size_t)t * QKW + h * DK + i0;
                u32x4 w1, w2; w1.x = cvt_pk_bf16(o1[0], o1[1]); w1.y = cvt_pk_bf16(o1[2], o1[3]); w1.z = cvt_pk_bf16(o1[4], o1[5]); w1.w = cvt_pk_bf16(o1[6], o1[7]);
                w2.x = cvt_pk_bf16(o2[0], o2[1]); w2.y = cvt_pk_bf16(o2[2], o2[3]); w2.z = cvt_pk_bf16(o2[4], o2[5]); w2.w = cvt_pk_bf16(o2[6], o2[7]);
                *(GAS u32x4*)rowp = w1; *(GAS u32x4*)(rowp + 128) = w2; }
    }
};
struct EpiRopeKT {
    static constexpr bool PERM = true;
    GAS bf16* KT; const GAS f32x2* rotT; const LAS float* l2g;
    __device__ __forceinline__ void operator()(const f32x4 (&acc)[2][2][4][2], const pg8::Unit& u, int wr, int wc, int fr, int fq) const {
        const int h = u.pm; const float l2f = l2g[h], l2b = l2g[4 + h];
#pragma unroll
        for (int bj = 0; bj < 2; ++bj) {
            const int tok0 = u.pn * 256 + bj * 128 + wc * 32 + 8 * fq, s0 = tok0 & (SEQ - 1), j0 = tok0 & (CH - 1);
            float zf[8], zb[8];
#pragma unroll
            for (int q = 0; q < 8; ++q) { zf[q] = fast_exp2((float)(CH - 1 - (j0 + q)) * l2f) * 0.0625f; zb[q] = fast_exp2((float)(j0 + q) * l2b) * 0.0625f; }
#pragma unroll
            for (int m = 0; m < 4; ++m) { const int i = wr * 64 + m * 16 + fr;
                const GAS f32x4* rp = (const GAS f32x4*)(rotT + (size_t)i * SEQ + s0);
                const f32x4 r0 = rp[0], r1 = rp[1], r2 = rp[2], r3 = rp[3];
                const float cs[8] = {r0[0], r0[2], r1[0], r1[2], r2[0], r2[2], r3[0], r3[2]}, sn[8] = {r0[1], r0[3], r1[1], r1[3], r2[1], r2[3], r3[1], r3[3]};
                float o1[8], o2[8];
#pragma unroll
                for (int n = 0; n < 2; ++n)
#pragma unroll
                    for (int j = 0; j < 4; ++j) { const float t1 = acc[0][bj][m][n][j], t2 = acc[1][bj][m][n][j]; const int q = 4 * n + j;
                        o1[q] = t1 * cs[q] - t2 * sn[q]; o2[q] = t1 * sn[q] + t2 * cs[q]; }
                u32x4 w1, w2;
                w1.x = cvt_pk_bf16(o1[0] * zf[0], o1[1] * zf[1]); w1.y = cvt_pk_bf16(o1[2] * zf[2], o1[3] * zf[3]); w1.z = cvt_pk_bf16(o1[4] * zf[4], o1[5] * zf[5]); w1.w = cvt_pk_bf16(o1[6] * zf[6], o1[7] * zf[7]);
                w2.x = cvt_pk_bf16(o2[0] * zf[0], o2[1] * zf[1]); w2.y = cvt_pk_bf16(o2[2] * zf[2], o2[3] * zf[3]); w2.z = cvt_pk_bf16(o2[4] * zf[4], o2[5] * zf[5]); w2.w = cvt_pk_bf16(o2[6] * zf[6], o2[7] * zf[7]);
                const int tokr = rot_col(i, tok0);
                *(GAS u32x4*)(KT + (size_t)(h * DK + i) * T + tokr) = w1; *(GAS u32x4*)(KT + (size_t)(h * DK + 128 + i) * T + tokr) = w2;
                w1.x = cvt_pk_bf16(o1[0] * zb[0], o1[1] * zb[1]); w1.y = cvt_pk_bf16(o1[2] * zb[2], o1[3] * zb[3]); w1.z = cvt_pk_bf16(o1[4] * zb[4], o1[5] * zb[5]); w1.w = cvt_pk_bf16(o1[6] * zb[6], o1[7] * zb[7]);
                w2.x = cvt_pk_bf16(o2[0] * zb[0], o2[1] * zb[1]); w2.y = cvt_pk_bf16(o2[2] * zb[2], o2[3] * zb[3]); w2.z = cvt_pk_bf16(o2[4] * zb[4], o2[5] * zb[5]); w2.w = cvt_pk_bf16(o2[6] * zb[6], o2[7] * zb[7]);
                *(GAS u32x4*)(KT + (size_t)QKW * T + (size_t)(h * DK + i) * T + tokr) = w1; *(GAS u32x4*)(KT + (size_t)QKW * T + (size_t)(h * DK + 128 + i) * T + tokr) = w2; } }
    }
};
template <bool ROT> struct EpiBf16 {
    static constexpr bool PERM = true;
    GAS bf16* O; int ldc;
    __device__ __forceinline__ void operator()(const f32x4 (&acc)[2][2][4][2], const pg8::Unit& u, int wr, int wc, int fr, int fq) const {
#pragma unroll
        for (int ai = 0; ai < 2; ++ai)
#pragma unroll
            for (int m = 0; m < 4; ++m) { const int row = u.pm * 256 + ai * 128 + wr * 64 + m * 16 + fr; GAS bf16* rowp = O + (size_t)row * ldc;
#pragma unroll
                for (int bj = 0; bj < 2; ++bj) { const f32x4 v0 = acc[ai][bj][m][0], v1 = acc[ai][bj][m][1]; const int col = u.pn * 256 + bj * 128 + wc * 32 + 8 * fq;
                    u32x4 w; w.x = cvt_pk_bf16(v0[0], v0[1]); w.y = cvt_pk_bf16(v0[2], v0[3]); w.z = cvt_pk_bf16(v1[0], v1[1]); w.w = cvt_pk_bf16(v1[2], v1[3]);
                    *(GAS u32x4*)(rowp + (ROT ? rot_col(row, col) : col)) = w; } }
    }
};
struct EpiPc {
    static constexpr bool PERM = true;
    GAS bf16* PC; const LAS float* l2g;
    __device__ __forceinline__ void operator()(const f32x4 (&acc)[2][2][4][2], const pg8::Unit& u, int wr, int wc, int fr, int fq) const {
        const int h = u.z; const float l2f = l2g[h], l2b = l2g[4 + h];
#pragma unroll
        for (int ai = 0; ai < 2; ++ai)
#pragma unroll
            for (int m = 0; m < 4; ++m) { const int il = wr * 64 + m * 16 + fr, jl0 = wc * 32 + 8 * fq; float o[8];
#pragma unroll
                for (int n = 0; n < 2; ++n)
#pragma unroll
                    for (int j = 0; j < 4; ++j) { const int dl = il - (jl0 + 4 * n + j); const float f = dl >= 0 ? fast_exp2((float)dl * l2f) : fast_exp2((float)(-dl) * l2b);
                        o[4 * n + j] = (ai == 0 ? acc[0][0][m][n][j] : acc[1][1][m][n][j]) * f; }
                u32x4 w; w.x = cvt_pk_bf16(o[0], o[1]); w.y = cvt_pk_bf16(o[2], o[3]); w.z = cvt_pk_bf16(o[4], o[5]); w.w = cvt_pk_bf16(o[6], o[7]);
                *(GAS u32x4*)(PC + ((size_t)(u.pm * 2 + ai) * 128 + il) * 128 + jl0) = w; }
    }
};
struct EpiGate {
    static constexpr bool PERM = true;
    const GAS bf16* Y; GAS bf16* YG; const GAS f32x2* statp; const GAS float* gain;
    __device__ __forceinline__ void operator()(const f32x4 (&acc)[2][2][4][2], const pg8::Unit& u, int wr, int wc, int fr, int fq) const {
        const int head = u.pn >> 1, c0 = u.pn * 256 + wc * 32 + 8 * fq;
        f32x4 gv[2][2];
#pragma unroll
        for (int bj = 0; bj < 2; ++bj) { gv[bj][0] = *(const GAS f32x4*)(gain + c0 + bj * 128); gv[bj][1] = *(const GAS f32x4*)(gain + c0 + bj * 128 + 4); }
#pragma unroll
        for (int ai = 0; ai < 2; ++ai)
#pragma unroll
            for (int m = 0; m < 4; ++m) { const int t = u.pm * 256 + ai * 128 + wr * 64 + m * 16 + fr; f32x2 st;
                { const GAS f32x4* sp = (const GAS f32x4*)(statp + ((size_t)t * 4 + head) * 16); float a1 = 0.f, a2 = 0.f;
#pragma unroll
                  for (int k = 0; k < 8; ++k) { const f32x4 v = sp[k]; a1 += v[0] + v[2]; a2 += v[1] + v[3]; }
                  const float mu = a1 * (1.f / DV), var = fmaxf(a2 * (1.f / DV) - mu * mu, 0.f); st.x = mu; st.y = 1.0f / sqrtf(var + EPS); }
#pragma unroll
                for (int bj = 0; bj < 2; ++bj) { const size_t off = (size_t)t * VW + c0 + bj * 128; const u32x4 yv = *(const GAS u32x4*)(Y + off);
                    const float y[8] = {bf_lo(yv.x), bf_hi(yv.x), bf_lo(yv.y), bf_hi(yv.y), bf_lo(yv.z), bf_hi(yv.z), bf_lo(yv.w), bf_hi(yv.w)}; float o[8];
#pragma unroll
                    for (int n = 0; n < 2; ++n)
#pragma unroll
                        for (int j = 0; j < 4; ++j) { const int q = 4 * n + j; const float yn = (y[q] - st.x) * st.y * gv[bj][n][j]; o[q] = silu_f(acc[ai][bj][m][n][j]) * yn; }
                    u32x4 w; w.x = cvt_pk_bf16(o[0], o[1]); w.y = cvt_pk_bf16(o[2], o[3]); w.z = cvt_pk_bf16(o[4], o[5]); w.w = cvt_pk_bf16(o[6], o[7]);
                    *(GAS u32x4*)(YG + off) = w; } }
    }
};
struct EpiResF32 {
    static constexpr bool PERM = false;
    const GAS float* base; GAS float* out;
    __device__ __forceinline__ void operator()(const f32x4 (&acc)[2][2][4][2], const pg8::Unit& u, int wr, int wc, int fr, int fq) const {
#pragma unroll
        for (int ai = 0; ai < 2; ++ai)
#pragma unroll
            for (int m = 0; m < 4; ++m) { const size_t off = (size_t)(u.pm * 256 + ai * 128 + wr * 64 + m * 16 + fr) * D + u.pn * 256 + wc * 32 + 4 * fq;
#pragma unroll
                for (int bj = 0; bj < 2; ++bj)
#pragma unroll
                    for (int n = 0; n < 2; ++n) { const f32x4 bs = *(const GAS f32x4*)(base + off + bj * 128 + n * 16); *(GAS f32x4*)(out + off + bj * 128 + n * 16) = bs + acc[ai][bj][m][n]; } }
    }
};
struct EpiSwiGLU {
    static constexpr bool PERM = true;
    GAS bf16* ACT; int ldc;
    __device__ __forceinline__ void operator()(const f32x4 (&acc)[2][2][4][2], const pg8::Unit& u, int wr, int wc, int fr, int fq) const {
#pragma unroll
        for (int ai = 0; ai < 2; ++ai)
#pragma unroll
            for (int m = 0; m < 4; ++m) { float o[8];
#pragma unroll
                for (int n = 0; n < 2; ++n)
#pragma unroll
                    for (int j = 0; j < 4; ++j) o[4 * n + j] = silu_f(acc[ai][0][m][n][j]) * acc[ai][1][m][n][j];
                u32x4 w; w.x = cvt_pk_bf16(o[0], o[1]); w.y = cvt_pk_bf16(o[2], o[3]); w.z = cvt_pk_bf16(o[4], o[5]); w.w = cvt_pk_bf16(o[6], o[7]);
                *(GAS u32x4*)(ACT + (size_t)(u.pm * 256 + ai * 128 + wr * 64 + m * 16 + fr) * ldc + u.pn * 128 + wc * 32 + 8 * fq) = w; }
    }
};
struct EpiZ2 {
    static constexpr bool PERM = true;
    GAS bf16* Z2;
    __device__ __forceinline__ void operator()(const f32x4 (&acc)[2][2][4][2], const pg8::Unit& u, int wr, int wc, int fr, int fq) const {
        const int g = u.pm >> 1, ri = u.pm & 1;
#pragma unroll
        for (int ai = 0; ai < 2; ++ai)
#pragma unroll
            for (int m = 0; m < 4; ++m) { const int cp = ai * 128 + wr * 64 + m * 16 + fr;
#pragma unroll
                for (int bj = 0; bj < 2; ++bj) { const int tok0 = u.pn * 256 + bj * 128 + wc * 32 + 8 * fq, b = tok0 >> 12, s0 = tok0 & (SEQ - 1);
                    const f32x4 v0 = acc[ai][bj][m][0], v1 = acc[ai][bj][m][1];
                    u32x4 w; w.x = cvt_pk_bf16(v0[0], v0[1]); w.y = cvt_pk_bf16(v0[2], v0[3]); w.z = cvt_pk_bf16(v1[0], v1[1]); w.w = cvt_pk_bf16(v1[2], v1[3]);
                    *(GAS u32x4*)(Z2 + ((size_t)(b * 1024 + g * 256 + cp) * 8192 + ri * SEQ + s0)) = w; } }
    }
};
struct EpiMoeDown {
    static constexpr bool PERM = false;
    GAS float* Hres; const GAS int* rowtok; const GAS float* rowgate;
    __device__ __forceinline__ void operator()(const f32x4 (&acc)[2][2][4][2], const pg8::Unit& u, int wr, int wc, int fr, int fq) const {
#pragma unroll
        for (int ai = 0; ai < 2; ++ai)
#pragma unroll
            for (int m = 0; m < 4; ++m) { const int row = u.pm * 256 + ai * 128 + wr * 64 + m * 16 + fr; const int tok = rowtok[row]; const float gw = rowgate[row];
                if (tok >= 0) { GAS float* rp = Hres + (size_t)tok * D + u.pn * 256 + wc * 32 + 4 * fq;
#pragma unroll
                    for (int bj = 0; bj < 2; ++bj)
#pragma unroll
                        for (int n = 0; n < 2; ++n) { const f32x4 bs = *(const GAS f32x4*)(rp + bj * 128 + n * 16); *(GAS f32x4*)(rp + bj * 128 + n * 16) = bs + gw * acc[ai][bj][m][n]; } } }
    }
};

#define XB_TMO      128
#define XB_XCNT(j)  (256  + 64 * (j))
#define XB_XSUB(j)  (1280 + 64 * (j))
#define XB_XGEN(j)  (2304 + 64 * (j))
#define XB_TOP      3328
#define XB_TOPGEN   3392
#define XCD_BAR_WORDS 3456
#define XB_SPIN_CAP (1u << 18)
__device__ __forceinline__ unsigned xb_ld(unsigned* p)              { return __hip_atomic_load(p, __ATOMIC_RELAXED, __HIP_MEMORY_SCOPE_AGENT); }
__device__ __forceinline__ unsigned xb_add(unsigned* p, unsigned v) { return __hip_atomic_fetch_add(p, v, __ATOMIC_RELAXED, __HIP_MEMORY_SCOPE_AGENT); }
__device__ __forceinline__ unsigned xb_xcc_id() { return (unsigned)__builtin_amdgcn_s_getreg((3 << 11) | 20) & 0xFu; }
#define XB_SPIN(cond, bar) do { unsigned _sp = 0; while (cond) { __builtin_amdgcn_s_sleep(1); \
    if ((++_sp & 255u) == 0u) { if (xb_ld(&(bar)[XB_TMO])) break; if (_sp > XB_SPIN_CAP) { atomicAdd(&(bar)[XB_TMO], 1u); break; } } } } while (0)
struct XcdBarrier { unsigned* bar; unsigned x; volatile LAS unsigned* st; };
__device__ __forceinline__ XcdBarrier xcd_barrier_post(unsigned* bar, volatile LAS unsigned* st, const bool t0) {
    XcdBarrier b; b.bar = bar; b.x = xb_xcc_id(); b.st = st;
    if (t0) (void)xb_add(&bar[XB_XCNT(b.x)], 1u);
    return b;
}
__device__ __forceinline__ void xcd_barrier_complete(unsigned* bar, unsigned x, unsigned& nloc, unsigned& nx) {
    const unsigned G = gridDim.x * gridDim.y * gridDim.z;
    unsigned sum, cnt, mine, sp = 0u;
    for (;;) {
        sum = 0u; cnt = 0u; mine = 0u;
#pragma unroll
        for (unsigned j = 0; j < 16; ++j) { const unsigned c = xb_ld(&bar[XB_XCNT(j)]); sum += c; cnt += (c > 0u) ? 1u : 0u; mine = (j == x) ? c : mine; }
        if (sum == G) break;
        __builtin_amdgcn_s_sleep(1);
        if ((++sp & 255u) == 0u) { if (xb_ld(&bar[XB_TMO])) break; if (sp > XB_SPIN_CAP) { atomicAdd(&bar[XB_TMO], 1u); break; } }
    }
    nloc = mine > 0u ? mine : 1u; nx = cnt > 0u ? cnt : 1u;
}
__device__ __forceinline__ void xcd_barrier(const XcdBarrier& b, const bool t0) {
    asm volatile("s_waitcnt vmcnt(0)" ::: "memory");
    __syncthreads();
    if (t0) {
        unsigned* bar = b.bar;
        __builtin_amdgcn_s_waitcnt(0);
        unsigned nloc = b.st[0], nx = b.st[1];
        if (nloc == 0u) { xcd_barrier_complete(bar, b.x, nloc, nx); b.st[0] = nloc; b.st[1] = nx; }
        const unsigned old = xb_add(&bar[XB_XSUB(b.x)], 1u);
        const unsigned gen = old / nloc;
        if (old + 1u == (gen + 1u) * nloc) {
            __builtin_amdgcn_fence(__ATOMIC_RELEASE, "agent");
            asm volatile("s_waitcnt vmcnt(0)" ::: "memory");
            const unsigned og = xb_add(&bar[XB_TOP], 1u);
            const unsigned tg = og / nx;
            if (og + 1u == (tg + 1u) * nx) xb_add(&bar[XB_TOPGEN], 1u);
            else XB_SPIN(xb_ld(&bar[XB_TOPGEN]) == tg, bar);
            __builtin_amdgcn_fence(__ATOMIC_ACQUIRE, "agent");
            xb_add(&bar[XB_XGEN(b.x)], 1u);
            asm volatile("s_waitcnt vmcnt(0)" ::: "memory");
        } else {
            XB_SPIN(xb_ld(&bar[XB_XGEN(b.x)]) == gen, bar);
            __builtin_amdgcn_fence(__ATOMIC_ACQUIRE, "agent");
            asm volatile("s_waitcnt vmcnt(0)" ::: "memory");
        }
    }
    __syncthreads();
}

__device__ __forceinline__ float wave_sum(float v) {
#pragma unroll
    for (int o = 1; o < 64; o <<= 1) v += __shfl_xor(v, o);
    return v;
}
__device__ __forceinline__ void transpose_item(const GAS float* W, int K, int N, GAS bf16* WT, int k0, int n0, int rbase, LAS float* scr, int lane) {
#pragma unroll 8
    for (int i = 0; i < 32; ++i) { const int kk = 2 * i + (lane >> 5); scr[kk * 33 + (lane & 31)] = W[(size_t)(k0 + kk) * N + n0 + (lane & 31)]; }
    LDS_WAIT(); asm volatile("" ::: "memory");
    const int c = lane & 7;
#pragma unroll
    for (int j = 0; j < 4; ++j) { const int n = (lane >> 3) + 8 * j; const LAS float* s = scr + (8 * c) * 33 + n;
        u32x4 o; o.x = cvt_pk_bf16(s[0 * 33], s[1 * 33]); o.y = cvt_pk_bf16(s[2 * 33], s[3 * 33]); o.z = cvt_pk_bf16(s[4 * 33], s[5 * 33]); o.w = cvt_pk_bf16(s[6 * 33], s[7 * 33]);
        *(GAS u32x4*)(WT + (size_t)(rbase + n) * K + k0 + 8 * c) = o; }
    LDS_WAIT(); asm volatile("" ::: "memory");
}
__device__ __forceinline__ void tr_plain(const GAS float* W, int K, int N, GAS bf16* WT, int it, LAS float* scr, int lane) {
    const int nblk = N / 32, kb = it / nblk, nb = it - kb * nblk; transpose_item(W, K, N, WT, 64 * kb, 32 * nb, 32 * nb, scr, lane);
}
__device__ __forceinline__ void tr_gu(const GAS float* Wg, const GAS float* Wu, int K, int N, GAS bf16* WT, int it, LAS float* scr, int lane) {
    const int nblk = N / 32, per = (K / 64) * nblk; const bool up = it >= per; if (up) it -= per;
    const int kb = it / nblk, nb = it - kb * nblk, f0 = 32 * nb;
    transpose_item(up ? Wu : Wg, K, N, WT, 64 * kb, f0, 256 * (f0 >> 7) + (up ? 128 : 0) + (f0 & 127), scr, lane);
}
__device__ __forceinline__ void rms_row(const GAS float* xrow, const GAS float* g, GAS bf16* orow, int lane, f32x4 (&v)[4]) {
    const GAS f32x4* xr = (const GAS f32x4*)xrow + lane; const GAS f32x4* gr = (const GAS f32x4*)g + lane;
    float s = 0.f;
#pragma unroll
    for (int j = 0; j < 4; ++j) { v[j] = xr[64 * j]; s += (v[j].x * v[j].x + v[j].y * v[j].y) + (v[j].z * v[j].z + v[j].w * v[j].w); }
    const float r = 1.0f / sqrtf(wave_sum(s) * (1.f / D) + EPS);
    GAS u32x2* o8 = (GAS u32x2*)orow + lane;
#pragma unroll
    for (int j = 0; j < 4; ++j) { v[j] = v[j] * r * gr[64 * j]; u32x2 w; w.x = cvt_pk_bf16(v[j].x, v[j].y); w.y = cvt_pk_bf16(v[j].z, v[j].w); o8[64 * j] = w; }
}

constexpr int SW_QL = 0, SW_SPITCH = 528, SW_SL = 65536, SW_VPITCH = 272, SW_VL = SW_SL + 64 * SW_SPITCH, SW_VB = 64 * SW_VPITCH;
static_assert(SW_VL + 2 * SW_VB <= 139264, "sweep LDS");
__device__ __forceinline__ void sweep_unit(LAS unsigned char* lds, const GAS bf16* Qg, const GAS bf16* KTFg, const GAS bf16* KTBg, const GAS bf16* VTg, const GAS bf16* PCg, GAS bf16* Yg, GAS f32x2* statp, const float l2f, const float l2b, int b, int h, int es, const int wave_s) {
    const int tid = tid_of(wave_s);
    const int w = __builtin_amdgcn_readfirstlane(tid >> 6), lane = tid & 63, rb = w >> 1, cb = w & 1, r32 = lane & 31, hh = lane >> 5;
    const int vrow = tid >> 4, vpc = tid & 15;
    const int qrow = tid >> 5, qpc = tid & 31;
    const GAS bf16* qp = Qg + (size_t)(b * SEQ + qrow) * QKW + h * DK + 8 * qpc;
    const size_t kto = (size_t)(h * DK + 32 * w + r32) * T + 8 * hh; const int krot = b * SEQ + ((r32 & 15) << 11);
    const GAS bf16* vtp = VTg + (size_t)(h * DV + 64 * es + vrow) * T + 8 * vpc; const int vrot = b * SEQ + ((vrow & 15) << 11);
    const GAS bf16* pcp = PCg + ((size_t)((b * NH + h) * NCH) * 128 + rb * 32 + r32) * 128 + 8 * hh;
    GAS bf16* yp = Yg + (size_t)(b * SEQ + 32 * rb + r32) * VW + h * DV + 64 * es + 32 * cb + 4 * hh;
    GAS f32x2* stp = statp + ((size_t)(b * SEQ + 32 * rb + r32) * NH + h) * 16 + es * 2 + cb;
    const int il = 32 * rb + r32;
    const int qrd = SW_QL + il * 512;
    bf16x8 pa[8], ka[8]; u32x4 vv[2], qv[8];
    f32x16 Sacc[2];
#pragma unroll
    for (int s = 0; s < 8; ++s) { pa[s] = *(const GAS bf16x8*)(pcp + 16 * s); ka[s] = *(const GAS bf16x8*)(KTFg + kto + (krot & (T - 1)) + 16 * s); }
#pragma unroll
    for (int it = 0; it < 2; ++it) vv[it] = *(const GAS u32x4*)(vtp + (size_t)(32 * it) * T + (vrot & (T - 1)));
#pragma unroll
    for (int it = 0; it < 8; ++it) qv[it] = *(const GAS u32x4*)(qp + (size_t)(16 * it) * QKW);
#pragma unroll
    for (int it = 0; it < 2; ++it) *(LAS u32x4*)(lds + SW_VL + (vrow + 32 * it) * SW_VPITCH + vpc * 16) = vv[it];
#pragma unroll
    for (int it = 0; it < 8; ++it) { const int row = qrow + 16 * it; *(LAS u32x4*)(lds + SW_QL + row * 512 + ((qpc ^ (row & 15)) * 16)) = qv[it]; }
#pragma unroll 1
    for (int p = 0; p < 2 * NCH; ++p) {
        const int dir = p >> 5, st = p & 31, n = dir ? NCH - 1 - st : st;
        const int pn = p + 1 < 2 * NCH ? p + 1 : p, dirn = pn >> 5, stn = pn & 31, nn = dirn ? NCH - 1 - stn : stn;
        const float l2 = dir ? l2b : l2f;
        const int cur = p & 1;
        if (st == 0) {
#pragma unroll
            for (int c = 0; c < 2; ++c)
#pragma unroll
                for (int t = 0; t < 16; ++t) Sacc[c][t] = 0.f;
        }
#pragma unroll
        for (int c = 0; c < 2; ++c)
#pragma unroll
            for (int g = 0; g < 4; ++g) { u32x2 pk; pk.x = cvt_pk_bf16(Sacc[c][4 * g], Sacc[c][4 * g + 1]); pk.y = cvt_pk_bf16(Sacc[c][4 * g + 2], Sacc[c][4 * g + 3]);
                *(LAS u32x2*)(lds + SW_SL + (32 * c + r32) * SW_SPITCH + (32 * w + 8 * g + 4 * hh) * 2) = pk; }
#pragma unroll
        for (int it = 0; it < 2; ++it) vv[it] = *(const GAS u32x4*)(vtp + (size_t)(32 * it) * T + ((nn * CH + vrot) & (T - 1)));
#pragma unroll
        for (int it = 0; it < 8; ++it) qv[it] = *(const GAS u32x4*)(qp + (size_t)(nn * CH + 16 * it) * QKW);
        u32x2 yf[4];
        GAS bf16* ypn = yp + (size_t)(n * CH) * VW;
        if (dir) {
#pragma unroll
            for (int g = 0; g < 4; ++g) yf[g] = *(const GAS u32x2*)(ypn + 8 * g);
        }
        __syncthreads();
        f32x16 O;
#pragma unroll
        for (int t = 0; t < 16; ++t) O[t] = 0.f;
#pragma unroll
        for (int ks = 0; ks < 16; ++ks) {
            const bf16x8 sf = *(const LAS bf16x8*)(lds + SW_SL + (32 * cb + r32) * SW_SPITCH + (16 * ks + 8 * hh) * 2);
            const bf16x8 qf = *(const LAS bf16x8*)(lds + qrd + (((2 * ks + hh) ^ (il & 15)) * 16));
            O = __builtin_amdgcn_mfma_f32_32x32x16_bf16(sf, qf, O, 0, 0, 0);
            if ((ks & 3) == 3) __builtin_amdgcn_sched_barrier(0); }
        __syncthreads();
        {
            const float xi = fast_exp2((float)(dir == 0 ? (il + 1) : (CH - il)) * l2);
#pragma unroll
            for (int t = 0; t < 16; ++t) O[t] *= xi;
        }
#pragma unroll
        for (int s = 0; s < 8; ++s) {
            const int jb = s >> 1;
            const bool use = dir == 0 ? (jb <= rb) : (jb >= rb);
            if (use) {
                u32x4 pm = __builtin_bit_cast(u32x4, pa[s]);
                if (jb == rb) {
                    const int nk = r32 - (16 * (s & 1) + 8 * hh) + 1;
                    unsigned mk[4];
#pragma unroll
                    for (int q = 0; q < 4; ++q) mk[q] = ((2 * q < nk) ? 0xffffu : 0u) | ((2 * q + 1 < nk) ? 0xffff0000u : 0u);
                    if (dir == 0) { pm.x &= mk[0]; pm.y &= mk[1]; pm.z &= mk[2]; pm.w &= mk[3]; } else { pm.x &= ~mk[0]; pm.y &= ~mk[1]; pm.z &= ~mk[2]; pm.w &= ~mk[3]; }
                }
                const bf16x8 vf = *(const LAS bf16x8*)(lds + SW_VL + cur * SW_VB + (32 * cb + r32) * SW_VPITCH + (16 * s + 8 * hh) * 2);
                O = __builtin_amdgcn_mfma_f32_32x32x16_bf16(vf, __builtin_bit_cast(bf16x8, pm), O, 0, 0, 0); } }
        __builtin_amdgcn_sched_barrier(0);
#pragma unroll
        for (int s = 0; s < 8; ++s) pa[s] = *(const GAS bf16x8*)(pcp + (size_t)nn * (CH * CH) + 16 * s);
        {
            const float gC = fast_exp2((float)CH * l2);
#pragma unroll
            for (int c = 0; c < 2; ++c) {
#pragma unroll
                for (int t = 0; t < 16; ++t) Sacc[c][t] *= gC;
#pragma unroll
                for (int s = 0; s < 8; ++s) { const bf16x8 bv = *(const LAS bf16x8*)(lds + SW_VL + cur * SW_VB + (32 * c + r32) * SW_VPITCH + (16 * s + 8 * hh) * 2);
                    Sacc[c] = __builtin_amdgcn_mfma_f32_32x32x16_bf16(ka[s], bv, Sacc[c], 0, 0, 0); }
                __builtin_amdgcn_sched_barrier(0); }
        }
        __builtin_amdgcn_sched_barrier(0);
        {
            const GAS bf16* ktn = (dirn ? KTBg : KTFg) + kto + ((nn * CH + krot) & (T - 1));
#pragma unroll
            for (int s = 0; s < 8; ++s) ka[s] = *(const GAS bf16x8*)(ktn + 16 * s);
        }
#pragma unroll
        for (int it = 0; it < 2; ++it) *(LAS u32x4*)(lds + SW_VL + (cur ^ 1) * SW_VB + (vrow + 32 * it) * SW_VPITCH + vpc * 16) = vv[it];
#pragma unroll
        for (int it = 0; it < 8; ++it) { const int row = qrow + 16 * it; *(LAS u32x4*)(lds + SW_QL + row * 512 + ((qpc ^ (row & 15)) * 16)) = qv[it]; }
        if (dir == 0) {
#pragma unroll
            for (int g = 0; g < 4; ++g) { u32x2 o; o.x = cvt_pk_bf16(O[4 * g], O[4 * g + 1]); o.y = cvt_pk_bf16(O[4 * g + 2], O[4 * g + 3]); *(GAS u32x2*)(ypn + 8 * g) = o; }
        } else {
            float s1 = 0.f, s2 = 0.f;
#pragma unroll
            for (int g = 0; g < 4; ++g) { const float y0 = bf_lo(yf[g].x) + O[4 * g], y1 = bf_hi(yf[g].x) + O[4 * g + 1], y2 = bf_lo(yf[g].y) + O[4 * g + 2], y3 = bf_hi(yf[g].y) + O[4 * g + 3];
                s1 += (y0 + y1) + (y2 + y3); s2 += (y0 * y0 + y1 * y1) + (y2 * y2 + y3 * y3);
                u32x2 o; o.x = cvt_pk_bf16(y0, y1); o.y = cvt_pk_bf16(y2, y3); *(GAS u32x2*)(ypn + 8 * g) = o; }
            s1 += __shfl_xor(s1, 32); s2 += __shfl_xor(s2, 32);
            if (hh == 0) stp[(size_t)(n * CH) * (NH * 16)] = (f32x2){s1, s2};
        }
    }
    VM_WAIT();
    __syncthreads();
}

struct Args { const float* in[16]; float* out; unsigned char* ws; };
constexpr int NWAVES = 8;
#ifndef PHMASK
#define PHMASK 0xFFFFFFFFu
#endif
#define PH(k) (((PHMASK) >> (k)) & 1u)
__global__ void __launch_bounds__(NWAVES * 64, 2) fwd_kernel(Args args) {
    extern __shared__ __attribute__((aligned(16))) unsigned char lds_raw[];
    LAS unsigned char* lds = (LAS unsigned char*)lds_raw;
    LAS float* l2g = (LAS float*)(lds + LDSCTL_OFF + 64);
    const int wave_k = __builtin_amdgcn_readfirstlane((int)threadIdx.x >> 6);
#define PHASE_VARS \
    const int tid = tid_of(wave_k); const int lane = tid & 63; int wave = wave_k; asm volatile("" : "+s"(wave)); \
    const __attribute__((address_space(4))) Args* ka = (const __attribute__((address_space(4))) Args*)__builtin_amdgcn_kernarg_segment_ptr(); asm volatile("" : "+s"(ka)); \
    const int G = gridDim.x, bx = blockIdx.x; const int vcu = (G % 8 == 0) ? (bx % 8) * (G / 8) + bx / 8 : bx; const int gw = vcu * NWAVES + wave, NGW = G * NWAVES; \
    GAS unsigned char* ws = (GAS unsigned char*)ka->ws; asm volatile("" : "+s"(ws)); GAS float* hres = (GAS float*)ka->out; (void)lane; (void)gw; (void)NGW; (void)vcu; (void)hres; \
    const GAS float* x = (const GAS float*)ka->in[0]; const GAS float* mix_norm = (const GAS float*)ka->in[1]; const GAS float* ffn_norm = (const GAS float*)ka->in[2]; const GAS float* ret_w_in = (const GAS float*)ka->in[3]; const GAS float* ret_decay = (const GAS float*)ka->in[4]; \
    const GAS float* gn_gain = (const GAS float*)ka->in[5]; const GAS float* ret_w_out = (const GAS float*)ka->in[6]; const GAS float* d_wg = (const GAS float*)ka->in[7]; const GAS float* d_wu = (const GAS float*)ka->in[8]; const GAS float* d_wd = (const GAS float*)ka->in[9]; \
    const GAS float* fnet_w = (const GAS float*)ka->in[10]; const GAS float* moe_router = (const GAS float*)ka->in[11]; const GAS float* m_wg = (const GAS float*)ka->in[12]; const GAS float* m_wu = (const GAS float*)ka->in[13]; const GAS float* m_wd = (const GAS float*)ka->in[14]; const GAS float* final_norm = (const GAS float*)ka->in[15]; \
    (void)x; (void)mix_norm; (void)ffn_norm; (void)ret_w_in; (void)ret_decay; (void)gn_gain; (void)ret_w_out; (void)d_wg; (void)d_wu; (void)d_wd; (void)fnet_w; (void)moe_router; (void)m_wg; (void)m_wu; (void)m_wd; (void)final_norm; \
    GAS f32x2* rot = (GAS f32x2*)(ws + WS_ROT); GAS f32x2* rotT = (GAS f32x2*)(ws + WS_ROTT); GAS bf16* WC = (GAS bf16*)(ws + WS_WC); \
    GAS int* toke = (GAS int*)(ws + WS_TOKE); GAS float* tokw = (GAS float*)(ws + WS_TOKW); GAS int* bcnt = (GAS int*)(ws + WS_BCNT); GAS int* rowtok = (GAS int*)(ws + WS_ROWTOK); GAS float* rowgate = (GAS float*)(ws + WS_ROWGATE); \
    GAS f32x2* statp = (GAS f32x2*)(ws + WS_STATP); \
    GAS bf16* WIN = (GAS bf16*)(ws + WS_WIN); GAS bf16* WO = (GAS bf16*)(ws + WS_WO); GAS bf16* WGU = (GAS bf16*)(ws + WS_WGU); GAS bf16* WD = (GAS bf16*)(ws + WS_WD); GAS bf16* WF = (GAS bf16*)(ws + WS_WF); \
    GAS bf16* HN = (GAS bf16*)(ws + WS_HN); GAS bf16* Qb = (GAS bf16*)(ws + WS_Q); GAS bf16* Kb = (GAS bf16*)(ws + WS_K); GAS bf16* KT = (GAS bf16*)(ws + WS_KT); GAS bf16* VT = (GAS bf16*)(ws + WS_VT); GAS bf16* PC = (GAS bf16*)(ws + WS_PC); \
    GAS bf16* Yb = (GAS bf16*)ka->out; GAS bf16* YG = (GAS bf16*)(ws + WS_YG); GAS bf16* ACTD = (GAS bf16*)(ws + WS_ACTD); GAS bf16* Z2 = (GAS bf16*)(ws + WS_Z2); GAS bf16* WSEQ = (GAS bf16*)(ws + WS_WSEQ); \
    GAS bf16* ACTM = (GAS bf16*)(ws + WS_ACTM); GAS bf16* WMGU = (GAS bf16*)(ws + WS_WMGU); GAS bf16* WMD = (GAS bf16*)(ws + WS_WMD); \
    (void)rot; (void)rotT; (void)WC; (void)toke; (void)tokw; (void)bcnt; (void)rowtok; (void)rowgate; (void)statp; (void)WIN; (void)WO; (void)WGU; (void)WD; (void)WF; (void)HN; (void)Qb; (void)Kb; (void)KT; (void)VT; (void)PC; \
    (void)Yb; (void)YG; (void)ACTD; (void)Z2; (void)WSEQ; (void)ACTM; (void)WMGU; (void)WMD;
#define GRID_BAR() do { const __attribute__((address_space(4))) Args* kb = (const __attribute__((address_space(4))) Args*)__builtin_amdgcn_kernarg_segment_ptr(); asm volatile("" : "+s"(kb)); GAS unsigned char* wsb = (GAS unsigned char*)kb->ws; XcdBarrier bar_; bar_.bar = (unsigned*)(wsb + WS_CTL) + CW_BAR; bar_.x = xb_xcc_id(); \
    bar_.st = (volatile LAS unsigned*)(lds + MISC_OFF) + 8; xcd_barrier(bar_, tid_of(wave_k) == 0); } while (0)

    {
        PHASE_VARS
        for (int u = tid; u < (LDS_BYTES - LDSCTL_OFF) / 4; u += NWAVES * 64) ((LAS unsigned*)(lds + LDSCTL_OFF))[u] = 0u;
        __syncthreads();
        if (tid < 8) { const float xl = ret_decay[tid]; const float ls = fminf(xl, 0.f) - log1pf(expf(-fabsf(xl))); l2g[tid] = ls * 1.44269504088896341f; }
        __syncthreads();
        (void)xcd_barrier_post((unsigned*)(ws + WS_CTL) + CW_BAR, (volatile LAS unsigned*)(lds + MISC_OFF) + 8, tid == 0);
    }

    if (PH(0)) {
        PHASE_VARS
        LAS float* scr = (LAS float*)(lds + wave * 16384);
        constexpr int I_IN = (D / 64) * (INW / 32), I_O = (VW / 64) * (D / 32), I_GU = 2 * (D / 64) * (FFD / 32), I_D = (FFD / 64) * (D / 32), I_F = (D / 64) * (D / 32);
        constexpr int NITEMS = I_IN + I_O + I_GU + I_D + I_F;
        for (int it = gw; it < NITEMS; it += NGW) {
            int r = it;
            if (r < I_IN) { tr_plain(ret_w_in, D, INW, WIN, r, scr, lane); continue; } r -= I_IN;
            if (r < I_O) { tr_plain(ret_w_out, VW, D, WO, r, scr, lane); continue; } r -= I_O;
            if (r < I_GU) { tr_gu(d_wg, d_wu, D, FFD, WGU, r, scr, lane); continue; } r -= I_GU;
            if (r < I_D) { tr_plain(d_wd, FFD, D, WD, r, scr, lane); continue; } r -= I_D;
            tr_plain(fnet_w, D, D, WF, r, scr, lane);
        }
        for (int e = (vcu * 512 + tid); e < SEQ * 128; e += G * 512) { const int s = e >> 7, i = e & 127;
            const float inv = powf(10000.0f, -(float)i / 128.0f); const float ang = (float)s * inv; float sn, cs; sincosf(ang, &sn, &cs);
            rot[e] = (f32x2){cs, sn}; rotT[(size_t)i * SEQ + s] = (f32x2){cs, sn}; }
        for (int e = (vcu * 512 + tid); e < 512 * 256; e += G * 512) { const int r = e >> 8, c = e & 255, mm = ((r & 255) * c) & 255;
            const float v = r < 256 ? cospif((float)mm * (1.0f / 128.0f)) : -sinpif((float)mm * (1.0f / 128.0f)); WC[e] = (bf16)(cvt_pk_bf16(v, 0.f) & 0xffffu); }
        for (int m = gw; m < T; m += NGW) { f32x4 v[4]; rms_row(x + (size_t)m * D, mix_norm, HN + (size_t)m * D, lane, v); }
    }
    GRID_BAR();

    if (PH(1) && PH(19)) {
        PHASE_VARS
        SchedPlain S{(const GAS char*)HN, (const GAS char*)WIN, (size_t)256 * D * 2, (size_t)256 * D * 2, T / 256, 8, G, bx};
        EpiRopeQK E{Qb, Kb, rot};
        pg8::gemm_phase<EpiRopeQK, SchedPlain, false>(lds, wave_k, D, D, D, S, E);
    }
    if (PH(1) && PH(20)) {
        PHASE_VARS
        SchedPlain S{(const GAS char*)(WIN + (size_t)QKW * D), (const GAS char*)HN, (size_t)256 * D * 2, (size_t)256 * D * 2, 4, T / 256, G, bx};
        EpiRopeKT E{KT, rotT, l2g};
        pg8::gemm_phase<EpiRopeKT, SchedPlain, false>(lds, wave_k, D, D, D, S, E);
    }
    if (PH(1) && PH(21)) {
        PHASE_VARS
        SchedPlain S{(const GAS char*)(WIN + (size_t)2 * QKW * D), (const GAS char*)HN, (size_t)256 * D * 2, (size_t)256 * D * 2, 8, T / 256, G, bx};
        EpiBf16<true> E{VT, T};
        pg8::gemm_phase<EpiBf16<true>, SchedPlain, false>(lds, wave_k, D, D, D, S, E);
    }
    GRID_BAR();

    if (PH(2)) {
        PHASE_VARS
        SchedPc S{(const GAS char*)Qb, (const GAS char*)Kb, G, bx};
        EpiPc E{PC, l2g};
        pg8::gemm_phase<EpiPc, SchedPc, false>(lds, wave_k, QKW, QKW, DK, S, E);
    }
    GRID_BAR();

    if (PH(3)) {
        PHASE_VARS
        for (int u = vcu; u < NB * NH * 8; u += G) { const int hh_ = (u >> 3) & 3; const float l2f = l2g[hh_], l2b = l2g[4 + hh_];
            sweep_unit(lds, Qb, KT, KT + (size_t)QKW * T, VT, PC, Yb, statp, l2f, l2b, u >> 5, hh_, u & 7, wave_k); }
    }
    GRID_BAR();

    if (PH(5)) {
        PHASE_VARS
        SchedPlain S{(const GAS char*)HN, (const GAS char*)(WIN + (size_t)(2 * QKW + VW) * D), (size_t)256 * D * 2, (size_t)256 * D * 2, T / 256, 8, G, bx};
        EpiGate E{Yb, YG, statp, gn_gain};
        pg8::gemm_phase<EpiGate, SchedPlain, false>(lds, wave_k, D, D, D, S, E);
    }
    GRID_BAR();

    if (PH(6)) {
        PHASE_VARS
        SchedPlain S{(const GAS char*)YG, (const GAS char*)WO, (size_t)256 * VW * 2, (size_t)256 * VW * 2, T / 256, 4, G, bx};
        EpiResF32 E{x, hres};
        pg8::gemm_phase<EpiResF32, SchedPlain, false>(lds, wave_k, VW, VW, VW, S, E);
    }
    GRID_BAR();

    if (PH(7)) {
        PHASE_VARS
        for (int m = gw; m < T; m += NGW) { f32x4 v[4]; rms_row(hres + (size_t)m * D, ffn_norm, HN + (size_t)m * D, lane, v); }
        LAS float* scr = (LAS float*)(lds + wave * 16384);
        constexpr int I_GU = 2 * (D / 64) * (FFE / 32), I_D = (FFE / 64) * (D / 32);
        for (int it = gw; it < NE * (I_GU + I_D); it += NGW) {
            const int e = it / (I_GU + I_D); int r = it - e * (I_GU + I_D);
            if (r < I_GU) tr_gu(m_wg + (size_t)e * D * FFE, m_wu + (size_t)e * D * FFE, D, FFE, WMGU + (size_t)e * 2 * FFE * D, r, scr, lane);
            else tr_plain(m_wd + (size_t)e * FFE * D, FFE, D, WMD + (size_t)e * D * FFE, r - I_GU, scr, lane);
        }
    }
    GRID_BAR();

    if (PH(8)) {
        PHASE_VARS
        SchedPlain S{(const GAS char*)HN, (const GAS char*)WGU, (size_t)256 * D * 2, (size_t)256 * D * 2, T / 256, 2 * FFD / 256, G, bx};
        EpiSwiGLU E{ACTD, FFD};
        pg8::gemm_phase<EpiSwiGLU, SchedPlain, false>(lds, wave_k, D, D, D, S, E);
    }
    GRID_BAR();
    if (PH(9)) {
        PHASE_VARS
        SchedPlain S{(const GAS char*)ACTD, (const GAS char*)WD, (size_t)256 * FFD * 2, (size_t)256 * FFD * 2, T / 256, 4, G, bx};
        EpiResF32 E{hres, hres};
        pg8::gemm_phase<EpiResF32, SchedPlain, false>(lds, wave_k, FFD, FFD, FFD, S, E);
    }
    GRID_BAR();

    if (PH(10)) {
        PHASE_VARS
        for (int m = gw; m < T; m += NGW) { f32x4 v[4]; rms_row(hres + (size_t)m * D, mix_norm + D, HN + (size_t)m * D, lane, v); }
        LAS float* tab = (LAS float*)lds;
        for (int m = tid; m < SEQ; m += NWAVES * 64) tab[m] = cospif((float)m * (1.0f / 2048.0f)) * (1.0f / 1024.0f);
        __syncthreads();
        for (int e8 = vcu * 512 + tid; e8 < SEQ * 8192 / 8; e8 += G * 512) { const int k = e8 >> 10, c0 = (e8 & 1023) * 8; float v[8];
#pragma unroll
            for (int q = 0; q < 8; ++q) { const int c = c0 + q, s = c & (SEQ - 1); const int mm = (s * k - (c >= SEQ ? 1024 : 0)) & (SEQ - 1); v[q] = tab[mm]; }
            u32x4 w; w.x = cvt_pk_bf16(v[0], v[1]); w.y = cvt_pk_bf16(v[2], v[3]); w.z = cvt_pk_bf16(v[4], v[5]); w.w = cvt_pk_bf16(v[6], v[7]);
            *(GAS u32x4*)(WSEQ + (size_t)e8 * 8) = w; }
        __syncthreads();
    }
    GRID_BAR();

    if (PH(11)) {
        PHASE_VARS
        SchedFnA S{(const GAS char*)WC, (const GAS char*)HN, G, bx};
        EpiZ2 E{Z2};
        pg8::gemm_phase<EpiZ2, SchedFnA, false>(lds, wave_k, 256, D, 256, S, E);
    }
    GRID_BAR();
    if (PH(12)) {
        PHASE_VARS
        SchedFnB S{(const GAS char*)WSEQ, (const GAS char*)Z2, G, bx};
        EpiBf16<false> E{HN, D};
        pg8::gemm_phase<EpiBf16<false>, SchedFnB, false>(lds, wave_k, 8192, 8192, 8192, S, E);
    }
    GRID_BAR();
    if (PH(13)) {
        PHASE_VARS
        SchedPlain S{(const GAS char*)HN, (const GAS char*)WF, (size_t)256 * D * 2, (size_t)256 * D * 2, T / 256, 4, G, bx};
        EpiResF32 E{hres, hres};
        pg8::gemm_phase<EpiResF32, SchedPlain, false>(lds, wave_k, D, D, D, S, E);
    }
    GRID_BAR();

    if (PH(14)) {
        PHASE_VARS
        LAS float* wrl = (LAS float*)lds;
        LAS int* le = (LAS int*)(lds + 32768);
        for (int i = tid; i < D * NE / 4; i += NWAVES * 64) ((LAS f32x4*)wrl)[i] = ((const GAS f32x4*)moe_router)[i];
        for (int i = vcu * 512 + tid; i < 2 * MOE_ROWS; i += G * 512) rowtok[i] = -1;
        __syncthreads();
        for (int tb = vcu; tb < T / 128; tb += G) {
            for (int rr = 0; rr < 16; ++rr) { const int tl = wave * 16 + rr, m = tb * 128 + tl; f32x4 v[4];
                rms_row(hres + (size_t)m * D, ffn_norm + D, HN + (size_t)m * D, lane, v);
                float lg[8];
#pragma unroll
                for (int e = 0; e < 8; ++e) lg[e] = 0.f;
#pragma unroll
                for (int j = 0; j < 4; ++j)
#pragma unroll
                    for (int c = 0; c < 4; ++c) { const int col = 256 * j + 4 * lane + c; const f32x4 w0 = *(const LAS f32x4*)(wrl + col * 8), w1 = *(const LAS f32x4*)(wrl + col * 8 + 4); const float xv = v[j][c];
                        lg[0] += xv * w0.x; lg[1] += xv * w0.y; lg[2] += xv * w0.z; lg[3] += xv * w0.w; lg[4] += xv * w1.x; lg[5] += xv * w1.y; lg[6] += xv * w1.z; lg[7] += xv * w1.w; }
#pragma unroll
                for (int e = 0; e < 8; ++e) lg[e] = wave_sum(lg[e]);
                int e0 = 0; float b0 = lg[0];
#pragma unroll
                for (int e = 1; e < 8; ++e) if (lg[e] > b0) { b0 = lg[e]; e0 = e; }
                int e1 = -1; float b1 = -3.0e38f;
#pragma unroll
                for (int e = 0; e < 8; ++e) if (e != e0 && lg[e] > b1) { b1 = lg[e]; e1 = e; }
                const float w0 = 1.0f / (1.0f + __expf(b1 - b0));
                if (lane == 0) { toke[2 * m] = e0; toke[2 * m + 1] = e1; tokw[2 * m] = w0; tokw[2 * m + 1] = 1.0f - w0; le[tl] = e0; le[128 + tl] = e1; } }
            __syncthreads();
            if (tid < 16) { const int s = tid >> 3, e = tid & 7; int c = 0; for (int i = 0; i < 128; ++i) c += (le[s * 128 + i] == e) ? 1 : 0; bcnt[tb * 16 + tid] = c; }
            __syncthreads();
        }
    }
    GRID_BAR();

    LAS int* segoff = (LAS int*)(lds + 132096);
    LAS int* ntile = (LAS int*)(lds + 132096 + 64);
    LAS unsigned char* tile_e = (LAS unsigned char*)(lds + 132096 + 128);
    if (PH(15)) {
        PHASE_VARS
        LAS int* pre = (LAS int*)lds;
        LAS int* tot = (LAS int*)(lds + 16384);
        LAS int* wc0 = (LAS int*)(lds + 16384 + 64);
        for (int i = tid; i < 256 * 16; i += NWAVES * 64) pre[i] = bcnt[i];
        __syncthreads();
        if (tid < 16) { int run = 0; for (int b2 = 0; b2 < 256; ++b2) { const int c = pre[b2 * 16 + tid]; pre[b2 * 16 + tid] = run; run += c; } tot[tid] = run; }
        __syncthreads();
        if (tid < 2) { int off = 0, nt = 0; for (int e = 0; e < 8; ++e) { segoff[tid * 8 + e] = off; const int tl = (tot[tid * 8 + e] + 255) >> 8; for (int q = 0; q < tl; ++q) tile_e[tid * 160 + nt + q] = (unsigned char)e; nt += tl; off += tl * 256; } ntile[tid] = nt; }
        __syncthreads();
        for (int tb = vcu; tb < T / 128; tb += G) {
            int ee[2] = {0, 0}, rk[2] = {0, 0};
            if (tid < 128) { const int m = tb * 128 + tid;
#pragma unroll
                for (int s = 0; s < 2; ++s) { const int e = toke[2 * m + s]; ee[s] = e;
#pragma unroll
                    for (int q = 0; q < 8; ++q) { const unsigned long long mk = __ballot(e == q); if (e == q) rk[s] = __popcll(mk & ((1ull << lane) - 1ull)); if (wave == 0 && lane == 0) wc0[s * 8 + q] = __popcll(mk); } } }
            __syncthreads();
            if (tid < 128) { const int m = tb * 128 + tid;
#pragma unroll
                for (int s = 0; s < 2; ++s) { const int e = ee[s]; const int rank = rk[s] + (wave == 1 ? wc0[s * 8 + e] : 0);
                    const int row = segoff[s * 8 + e] + pre[tb * 16 + s * 8 + e] + rank;
                    rowtok[s * MOE_ROWS + row] = m; rowgate[s * MOE_ROWS + row] = tokw[2 * m + s]; } }
            __syncthreads();
        }
    }
    GRID_BAR();

    if (PH(16))
#pragma unroll
    for (int s = 0; s < 2; ++s) {
        {
            PHASE_VARS
            SchedMoe S{(const GAS char*)HN, (const GAS char*)WMGU, rowtok + s * MOE_ROWS, tile_e + s * 160, 0, (size_t)2 * FFE * D * 2, (size_t)256 * D * 2, ntile[s], 2 * FFE / 256, G, bx, true};
            EpiSwiGLU E{ACTM, FFE};
            pg8::gemm_phase<EpiSwiGLU, SchedMoe, true>(lds, wave_k, D, D, D, S, E);
        }
        GRID_BAR();
        {
            PHASE_VARS
            SchedMoe S{(const GAS char*)ACTM, (const GAS char*)WMD, rowtok + s * MOE_ROWS, tile_e + s * 160, (size_t)256 * FFE * 2, (size_t)D * FFE * 2, (size_t)256 * FFE * 2, ntile[s], 4, G, bx, false};
            EpiMoeDown E{hres, rowtok + s * MOE_ROWS, rowgate + s * MOE_ROWS};
            pg8::gemm_phase<EpiMoeDown, SchedMoe, false>(lds, wave_k, FFE, FFE, FFE, S, E);
        }
        GRID_BAR();
    }

    if (PH(17)) {
        PHASE_VARS
        const bool bad = __hip_atomic_load((GAS unsigned*)(ws + WS_CTL) + CW_BAR + XB_TMO, RLX_AGENT) != 0u;
        for (int m = gw; m < T; m += NGW) {
            GAS f32x4* xr = (GAS f32x4*)(hres + (size_t)m * D) + lane; const GAS f32x4* gr = (const GAS f32x4*)final_norm + lane;
            f32x4 v[4]; float s = 0.f;
#pragma unroll
            for (int j = 0; j < 4; ++j) { v[j] = xr[64 * j]; s += (v[j].x * v[j].x + v[j].y * v[j].y) + (v[j].z * v[j].z + v[j].w * v[j].w); }
            const float r = bad ? __builtin_nanf("") : 1.0f / sqrtf(wave_sum(s) * (1.f / D) + EPS);
#pragma unroll
            for (int j = 0; j < 4; ++j) xr[64 * j] = v[j] * r * gr[64 * j];
        }
    }
}

extern "C" void kernel_launch(void* const* d_in, const int* in_sizes, int n_in, void* d_out, int out_size, void* d_ws, size_t ws_size, hipStream_t stream) {
    static int grid = 0;
    if (grid == 0) {
        if (n_in != 16 || in_sizes[0] != T * D || out_size != T * D || ws_size < WS_END) { fprintf(stderr, "kernel_launch: unexpected shapes (n_in %d, in0 %d, out %d, ws %zu)\n", n_in, n_in > 0 ? in_sizes[0] : -1, out_size, ws_size); grid = -1; return; }
        int dev = 0, cus = 0, per_cu = 0;
        if (hipGetDevice(&dev) != hipSuccess || hipDeviceGetAttribute(&cus, hipDeviceAttributeMultiprocessorCount, dev) != hipSuccess) { grid = -1; return; }
        if (hipFuncSetAttribute((const void*)fwd_kernel, hipFuncAttributeMaxDynamicSharedMemorySize, LDS_BYTES) != hipSuccess) { fprintf(stderr, "kernel_launch: hipFuncSetAttribute failed\n"); grid = -1; return; }
        if (hipOccupancyMaxActiveBlocksPerMultiprocessor(&per_cu, (const void*)fwd_kernel, NWAVES * 64, LDS_BYTES) != hipSuccess || per_cu < 1) { fprintf(stderr, "kernel_launch: occupancy query says %d\n", per_cu); }
        (void)hipGetLastError();
        grid = cus;
    }
    if (grid < 0) return;
    if (hipMemsetAsync((char*)d_ws + WS_CTL, 0, CTL_ZERO_BYTES, stream) != hipSuccess) return;
    Args a{};
    for (int i = 0; i < 16; ++i) a.in[i] = (const float*)d_in[i];
    a.out = (float*)d_out; a.ws = (unsigned char*)d_ws;
    hipLaunchKernelGGL(fwd_kernel, dim3(grid), dim3(NWAVES * 64), LDS_BYTES, stream, a);
}
```

```cpp
#include <hip/hip_runtime.h>
#include <cstdio>
#include <cstdint>

#define LAS __attribute__((address_space(3)))
#define GAS __attribute__((address_space(1)))
typedef unsigned short bf16;
typedef short bf16x8 __attribute__((ext_vector_type(8)));
typedef float f32x2 __attribute__((ext_vector_type(2)));
typedef float f32x4 __attribute__((ext_vector_type(4)));
typedef float f32x16 __attribute__((ext_vector_type(16)));
typedef unsigned u32x2 __attribute__((ext_vector_type(2)));
typedef unsigned u32x4 __attribute__((ext_vector_type(4)));
typedef GAS unsigned gu32;

constexpr int D = 1024, NB = 8, SEQ = 4096, T = NB * SEQ;
constexpr int NH = 4, DK = 256, DV = 512, QKW = 1024, VW = 2048, INW = 6144, CH = 128, NCH = SEQ / CH;
constexpr int FFD = 2816, NE = 8, FFE = 3584;
constexpr int MOE_ROWS = T + NE * 256;
constexpr float EPS = 1e-6f;

constexpr size_t MiB = 1u << 20;
constexpr size_t WS_CTL = 0, CTL_ZERO_BYTES = 1 * MiB;
constexpr size_t WS_ROT = 1 * MiB, WS_ROTT = 5 * MiB, WS_WC = 9 * MiB;
constexpr size_t WS_TOKE = 9 * MiB + 256 * 1024;
constexpr size_t WS_TOKW = WS_TOKE + 256 * 1024;
constexpr size_t WS_BCNT = WS_TOKW + 256 * 1024;
constexpr size_t WS_ROWTOK = WS_BCNT + 16 * 1024;
constexpr size_t WS_ROWGATE = WS_ROWTOK + 2 * MOE_ROWS * 4;
constexpr size_t WS_STATS = 11 * MiB;
static_assert(WS_ROWGATE + 2 * MOE_ROWS * 4 <= WS_STATS, "small tables");
constexpr size_t WS_WIN = 12 * MiB, WS_WO = 24 * MiB, WS_WGU = 28 * MiB, WS_WD = 39 * MiB, WS_WF = 44 * MiB + 512 * 1024;
constexpr size_t WS_HN = 48 * MiB;
constexpr size_t WS_Q = 112 * MiB, WS_K = 176 * MiB, WS_KT = 240 * MiB  , WS_VT = 368 * MiB, WS_PC = 496 * MiB;
constexpr size_t WS_YG = 240 * MiB;
constexpr size_t WS_STATP = 176 * MiB;
constexpr size_t WS_ACTD = 112 * MiB;
constexpr size_t WS_Z2 = 112 * MiB, WS_WSEQ = 240 * MiB;
constexpr size_t WS_ACTM = 112 * MiB;
constexpr size_t WS_WMGU = 352 * MiB, WS_WMD = 464 * MiB, WS_END = 528 * MiB;
static_assert(WS_ACTM + (size_t)MOE_ROWS * FFE * 2 <= WS_WMGU, "moe act");
static_assert(WS_PC + (size_t)NB * NH * NCH * CH * CH * 2 <= 528 * MiB, "epoch A");
static_assert(WS_WF + (size_t)D * D * 2 <= WS_HN, "weights");
constexpr int CW_BAR = 4096;
constexpr int CW_CHK = 64;

constexpr int RING_BYTES = 131072;
constexpr int LDSCTL_OFF = 139264, MISC_OFF = LDSCTL_OFF + 320;
constexpr int LDS_BYTES = 147456;

#define LDS_WAIT() asm volatile("s_waitcnt lgkmcnt(0)" ::: "memory")
#define VM_WAIT() asm volatile("s_waitcnt vmcnt(0)" ::: "memory")
#define RLX_AGENT __ATOMIC_RELAXED, __HIP_MEMORY_SCOPE_AGENT

__device__ __forceinline__ unsigned cvt_pk_bf16(float lo, float hi) { unsigned r; asm volatile("v_cvt_pk_bf16_f32 %0, %1, %2" : "=v"(r) : "v"(lo), "v"(hi)); return r; }
__device__ __forceinline__ float bf_lo(unsigned w) { return __uint_as_float(w << 16); }
__device__ __forceinline__ float bf_hi(unsigned w) { return __uint_as_float(w & 0xffff0000u); }
__device__ __forceinline__ float fast_exp2(float x) { return __builtin_amdgcn_exp2f(x); }
__device__ __forceinline__ int lane_id_v() { int l; asm volatile("v_mbcnt_lo_u32_b32 %0, -1, 0\n\tv_mbcnt_hi_u32_b32 %0, -1, %0" : "=v"(l)); return l; }
__device__ __forceinline__ int tid_of(int wave_s) { asm volatile("" : "+s"(wave_s)); return wave_s * 64 + lane_id_v(); }
__device__ __forceinline__ int rot_col(int row, int tok) { return (tok + ((row & 15) << 11)) & (32768 - 1); }
__device__ __forceinline__ float silu_f(float v) { return v / (1.0f + __expf(-v)); }

namespace pg8 {
constexpr int BM = 256, BK = 64, HALF = 128, HTB = HALF * BK * 2, STAGE_BYTES = 8 * HTB, NXCD = 8, WGM = 8;
__host__ __device__ __forceinline__ int lds_byte(int r, int c) { const int st = (r >> 4) * 2 + (c >> 5), rr = r & 15, cc = c & 31, ob = rr * 64 + cc * 2; return st * 1024 + (ob ^ (((ob >> 9) & 1) << 5)); }
__host__ __device__ __forceinline__ void stage_rc(int b, int& R, int& C) { const int st = b / 1024, sb = b % 1024, swz = sb ^ (((sb >> 9) & 1) << 5); R = (st >> 1) * 16 + swz / 64; C = (st & 1) * 32 + (swz % 64) / 2; }
__host__ __device__ __forceinline__ int perm32(int rho) { const int n = rho >> 4, i = rho & 15; return 8 * (i >> 2) + 4 * n + (i & 3); }

struct Unit { const GAS char* A; const GAS char* B; const GAS int* rows; int pm, pn, z; };

__device__ __forceinline__ bool tile_of(long L, int nM, int nN, int& pm, int& pn) {
    const int nwg = nM * nN; if (L >= nwg) return false;
    int wgid = (int)L; { const int q = nwg / NXCD, r = nwg % NXCD, xcd = wgid % NXCD, off = wgid / NXCD; wgid = (xcd < r ? xcd * (q + 1) : r * (q + 1) + (xcd - r) * q) + off; }
    const int nig = WGM * nN, gid = wgid / nig, fm = gid * WGM, gsz = (nM - fm) < WGM ? (nM - fm) : WGM;
    pm = fm + ((wgid % nig) % gsz); pn = (wgid % nig) / gsz; return true;
}

template <class Epi, class Sched, bool GATHER>
__device__ __forceinline__ void gemm_phase(LAS unsigned char* lds, const int wave_s, const int lda, const int ldb, const int K, const Sched& S, const Epi& E) {
    const int tid = tid_of(wave_s);
    const int wid = __builtin_amdgcn_readfirstlane(tid >> 6), lane = tid & 63, wr = wid >> 2, wc = wid & 3, fr = lane & 15, fq = lane >> 4;
    const int nt = K / BK;
    unsigned vA[2][2], vAn[2][2], voffB[2];
#pragma unroll
    for (int i = 0; i < 2; ++i) { int R, C; stage_rc(tid * 16 + i * 8192, R, C); const int Rb = Epi::PERM ? ((R & ~31) + perm32(R & 31)) : R;
        voffB[i] = (unsigned)(S.brow(Rb) * ldb + C) * 2u;
#pragma unroll
        for (int h = 0; h < 2; ++h) { vA[h][i] = (unsigned)((h * HALF + R) * lda + C) * 2u; vAn[h][i] = vA[h][i]; } }
    const size_t kstep = (size_t)(BK * 2);
    const size_t hstepB = (size_t)(S.brow(HALF) - S.brow(0)) * ldb * 2;
    const unsigned ldsw = (unsigned)wid * 1024u;
    const int aoff = lds_byte(wr * 64 + fr, fq * 8), boff = lds_byte(wc * 32 + fr, fq * 8);
#define PG8_SA(b, h) (((b) * 2 + (h)) * HTB)
#define PG8_SB(b, h) ((4 + (b) * 2 + (h)) * HTB)
#define PG8_STAGE_B(bufoff, gbase) do { _Pragma("unroll") for (int _i = 0; _i < 2; ++_i) \
        __builtin_amdgcn_global_load_lds((const GAS unsigned*)((const GAS char*)(gbase) + voffB[_i]), (LAS unsigned*)(lds + (bufoff) + ldsw + _i * 8192), 16, 0, 0); } while (0)
#define PG8_STAGE_A(bufoff, gbase, v0, v1) do { \
        __builtin_amdgcn_global_load_lds((const GAS unsigned*)((const GAS char*)(gbase) + (v0)), (LAS unsigned*)(lds + (bufoff) + ldsw), 16, 0, 0); \
        __builtin_amdgcn_global_load_lds((const GAS unsigned*)((const GAS char*)(gbase) + (v1)), (LAS unsigned*)(lds + (bufoff) + ldsw + 8192), 16, 0, 0); } while (0)
#define PG8_LDA(dst, b, h) do { _Pragma("unroll") for (int m = 0; m < 4; ++m) _Pragma("unroll") for (int k = 0; k < 2; ++k) dst[m][k] = *(const LAS bf16x8*)(lds + PG8_SA(b, h) + aoff + m * 2048 + k * 1024); } while (0)
#define PG8_LDB(dst, b, h) do { _Pragma("unroll") for (int n = 0; n < 2; ++n) _Pragma("unroll") for (int k = 0; k < 2; ++k) dst[n][k] = *(const LAS bf16x8*)(lds + PG8_SB(b, h) + boff + n * 2048 + k * 1024); } while (0)
#define PG8_MMA(ai, bj, At, Bt) do { __builtin_amdgcn_s_setprio(1); _Pragma("unroll") for (int m = 0; m < 4; ++m) _Pragma("unroll") for (int n = 0; n < 2; ++n) _Pragma("unroll") for (int k = 0; k < 2; ++k) \
        acc[ai][bj][m][n] = __builtin_amdgcn_mfma_f32_16x16x32_bf16(Bt[n][k], At[m][k], acc[ai][bj][m][n], 0, 0, 0); __builtin_amdgcn_s_setprio(0); } while (0)
#define PG8_WAIT_V(n) asm volatile("s_waitcnt vmcnt(" #n ")" ::: "memory")
#define PG8_WAIT_L(n) asm volatile("s_waitcnt lgkmcnt(" #n ")" ::: "memory")
#define PG8_BAR __builtin_amdgcn_s_barrier()
#define PG8_SCHED __builtin_amdgcn_sched_barrier(0)
#define PG8_LOADROWS(dst, u) do { if constexpr (GATHER) { const int _tz = tid_of(wave_s); _Pragma("unroll") for (int _i = 0; _i < 2; ++_i) { int _R, _C; stage_rc(_tz * 16 + _i * 8192, _R, _C); \
        _Pragma("unroll") for (int _h = 0; _h < 2; ++_h) { const int _t = (u).rows[_h * HALF + _R]; dst[_h][_i] = (unsigned)((_t < 0 ? 0 : _t) * lda + _C) * 2u; } } } } while (0)
#define PG8_VAN(h, i) (GATHER ? vAn[h][i] : vA[h][i])
    Unit cur, nxt; int ui = 0;
    if (!S.next(0, cur)) return;
    f32x4 acc[2][2][4][2];
#pragma unroll
    for (int a = 0; a < 2; ++a)
#pragma unroll
        for (int b = 0; b < 2; ++b)
#pragma unroll
            for (int m = 0; m < 4; ++m)
#pragma unroll
                for (int n = 0; n < 2; ++n) acc[a][b][m][n] = (f32x4){0.f, 0.f, 0.f, 0.f};
    bf16x8 At[4][2], B0[2][2], B1[2][2];
    const GAS char* cA = cur.A; const GAS char* cB = cur.B;
    PG8_LOADROWS(vA, cur);
    if constexpr (GATHER) { vAn[0][0] = vA[0][0]; vAn[0][1] = vA[0][1]; vAn[1][0] = vA[1][0]; vAn[1][1] = vA[1][1]; }
    PG8_STAGE_B(PG8_SB(0, 0), cB); PG8_STAGE_B(PG8_SB(0, 1), cB + hstepB); PG8_STAGE_A(PG8_SA(0, 0), cA, vA[0][0], vA[0][1]); PG8_STAGE_A(PG8_SA(0, 1), cA, vA[1][0], vA[1][1]);
    if (wr == 1) PG8_BAR;
    PG8_WAIT_V(2); PG8_BAR;
    PG8_STAGE_B(PG8_SB(1, 0), cB + kstep); PG8_STAGE_A(PG8_SA(1, 0), cA + kstep, vA[0][0], vA[0][1]); PG8_STAGE_B(PG8_SB(1, 1), cB + hstepB + kstep);
    PG8_WAIT_V(6); PG8_BAR;
    for (;;) {
        const bool has_next = S.next(ui + 1, nxt);
        const GAS char* nA = has_next ? nxt.A : cA; const GAS char* nB = has_next ? nxt.B : cB;
#pragma unroll 1
        for (int t = 0; t < nt; t += 2) {
            const bool last = (t == nt - 2);
            const GAS char* a1 = cA + (size_t)(t + 1) * kstep;
            const GAS char* a2 = last ? nA : cA + (size_t)(t + 2) * kstep; const GAS char* b2 = last ? nB : cB + (size_t)(t + 2) * kstep;
            const GAS char* a3 = a2 + kstep; const GAS char* b3 = b2 + kstep;
            if constexpr (GATHER) { if (last && has_next) { PG8_LOADROWS(vAn, nxt); } }
            PG8_LDB(B0, 0, 0); PG8_LDB(B1, 0, 1); PG8_SCHED; PG8_LDA(At, 0, 0); PG8_STAGE_A(PG8_SA(1, 1), a1, vA[1][0], vA[1][1]);
            PG8_WAIT_V(8); PG8_WAIT_L(0); PG8_BAR; PG8_MMA(0, 0, At, B0); PG8_MMA(0, 1, At, B1); PG8_BAR; PG8_SCHED;
            PG8_LDA(At, 0, 1); PG8_STAGE_B(PG8_SB(0, 0), b2); PG8_STAGE_B(PG8_SB(0, 1), b2 + hstepB); PG8_STAGE_A(PG8_SA(0, 0), a2, PG8_VAN(0, 0), PG8_VAN(0, 1));
            PG8_WAIT_V(8); PG8_WAIT_L(0); PG8_BAR; PG8_MMA(1, 0, At, B0); PG8_MMA(1, 1, At, B1); PG8_BAR; PG8_SCHED;
            PG8_LDB(B0, 1, 0); PG8_LDB(B1, 1, 1); PG8_SCHED; PG8_LDA(At, 1, 0); PG8_STAGE_A(PG8_SA(0, 1), a2, PG8_VAN(1, 0), PG8_VAN(1, 1));
            PG8_WAIT_V(8); PG8_WAIT_L(0); PG8_BAR; PG8_MMA(0, 0, At, B0); PG8_MMA(0, 1, At, B1); PG8_BAR; PG8_SCHED;
            PG8_LDA(At, 1, 1); PG8_STAGE_B(PG8_SB(1, 0), b3); PG8_STAGE_B(PG8_SB(1, 1), b3 + hstepB); PG8_STAGE_A(PG8_SA(1, 0), a3, PG8_VAN(0, 0), PG8_VAN(0, 1));
            PG8_WAIT_V(8); PG8_WAIT_L(0); PG8_BAR; PG8_MMA(1, 0, At, B0); PG8_MMA(1, 1, At, B1); PG8_BAR; PG8_SCHED;
        }
        if (wr == 0) PG8_BAR;
        E(acc, cur, wr, wc, fr, fq);
        if (!has_next) break;
#pragma unroll
        for (int a = 0; a < 2; ++a)
#pragma unroll
            for (int b = 0; b < 2; ++b)
#pragma unroll
                for (int m = 0; m < 4; ++m)
#pragma unroll
                    for (int n = 0; n < 2; ++n) acc[a][b][m][n] = (f32x4){0.f, 0.f, 0.f, 0.f};
        cur = nxt; cA = nA; cB = nB; ++ui;
        if constexpr (GATHER) { vA[0][0] = vAn[0][0]; vA[0][1] = vAn[0][1]; vA[1][0] = vAn[1][0]; vA[1][1] = vAn[1][1]; }
        if (wr == 1) PG8_BAR;
    }
    PG8_WAIT_V(0);
    PG8_BAR;
#undef PG8_SA
#undef PG8_SB
#undef PG8_STAGE_A
#undef PG8_STAGE_B
#undef PG8_LDA
#undef PG8_LDB
#undef PG8_MMA
#undef PG8_WAIT_V
#undef PG8_WAIT_L
#undef PG8_BAR
#undef PG8_SCHED
#undef PG8_LOADROWS
#undef PG8_VAN
}
}

struct SchedPlain {
    __device__ __forceinline__ int brow(int r) const { return r; }
    const GAS char* A; const GAS char* B; size_t a_tile, b_tile; int nM, nN, G, c;
    __device__ __forceinline__ bool next(int i, pg8::Unit& u) const {
        int pm, pn; if (!pg8::tile_of((long)i * G + c, nM, nN, pm, pn)) return false;
        u.pm = pm; u.pn = pn; u.z = 0; u.rows = nullptr; u.A = A + (size_t)pm * a_tile; u.B = B + (size_t)pn * b_tile; return true; }
};
struct SchedPc {
    __device__ __forceinline__ int brow(int r) const { return r; }
    const GAS char* Q; const GAS char* Kk; int G, c;
    __device__ __forceinline__ bool next(int i, pg8::Unit& u) const {
        const int L = i * G + c; if (L >= NB * NH * 16) return false;
        const int cp = L & 15, h = (L >> 4) & 3, b = L >> 6;
        const size_t off = ((size_t)(b * SEQ + cp * 256) * QKW + h * DK) * 2;
        u.pm = L; u.pn = 0; u.z = h; u.rows = nullptr; u.A = Q + off; u.B = Kk + off; return true; }
};
struct SchedFnA {
    __device__ __forceinline__ int brow(int r) const { return r; }
    const GAS char* Wc; const GAS char* Hn; int G, c;
    __device__ __forceinline__ bool next(int i, pg8::Unit& u) const {
        int pm, pn; if (!pg8::tile_of((long)i * G + c, 8, T / 256, pm, pn)) return false;
        const int g = pm >> 1, ri = pm & 1;
        u.pm = pm; u.pn = pn; u.z = 0; u.rows = nullptr; u.A = Wc + (size_t)ri * 256 * 256 * 2; u.B = Hn + ((size_t)pn * 256 * D + g * 256) * 2; return true; }
};
struct SchedFnB {
    __device__ __forceinline__ int brow(int r) const { return (r & 63) * 8 + (r >> 6); }
    GAS const char* WY; GAS const char* U; int G, c;
    __device__ __forceinline__ bool next(int i, pg8::Unit& u) const {
        int pm, pn; if (!pg8::tile_of((long)i * G + c, 2, 256, pm, pn)) return false;
        const int batch = pn >> 5, fb = (pn >> 1) & 15, kbb = pn & 1;
        u.pm = pm; u.pn = pn; u.z = 0; u.rows = nullptr; u.A = WY + (size_t)pm * 256 * 1024 * 2; u.B = U + ((size_t)(batch * 1024 + fb * 64) * 8 + kbb * 4) * 1024 * 2; return true; }
};
struct SchedMoe {
    __device__ __forceinline__ int brow(int r) const { return r; }
    const GAS char* A; const GAS char* W; const GAS int* rowtok; const LAS unsigned char* texp; size_t a_tile, w_exp, w_tile; int ntiles, ncol, G, c; bool gather;
    __device__ __forceinline__ bool next(int i, pg8::Unit& u) const {
        const int L = i * G + c; if (L >= ntiles * ncol) return false;
        const int rt = L / ncol, ct = L - rt * ncol; const int e = texp[rt];
        u.pm = rt; u.pn = ct; u.z = e; u.rows = rowtok + rt * 256; u.A = gather ? A : A + (size_t)rt * a_tile; u.B = W + (size_t)e * w_exp + (size_t)ct * w_tile; return true; }
};

struct EpiRopeQK {
    static constexpr bool PERM = true;
    GAS bf16* Q; GAS bf16* Kk; const GAS f32x2* rot;
    __device__ __forceinline__ void operator()(const f32x4 (&acc)[2][2][4][2], const pg8::Unit& u, int wr, int wc, int fr, int fq) const {
        const bool isk = u.pn >= 4; const int h = u.pn & 3; GAS bf16* dst = isk ? Kk : Q; const float sc = isk ? 0.0625f : 1.0f;
        const int i0 = wc * 32 + 8 * fq;
#pragma unroll
        for (int ai = 0; ai < 2; ++ai)
#pragma unroll
            for (int m = 0; m < 4; ++m) {
                const int t = u.pm * 256 + ai * 128 + wr * 64 + m * 16 + fr, s = t & (SEQ - 1);
                const GAS f32x4* rp = (const GAS f32x4*)(rot + (size_t)s * 128 + i0);
                const f32x4 r0 = rp[0], r1 = rp[1], r2 = rp[2], r3 = rp[3];
                const float cs[8] = {r0[0], r0[2], r1[0], r1[2], r2[0], r2[2], r3[0], r3[2]}, sn[8] = {r0[1], r0[3], r1[1], r1[3], r2[1], r2[3], r3[1], r3[3]};
                float o1[8], o2[8];
#pragma unroll
                for (int n = 0; n < 2; ++n)
#pragma unroll
                    for (int j = 0; j < 4; ++j) { const float t1 = acc[ai][0][m][n][j], t2 = acc[ai][1][m][n][j]; const int q = 4 * n + j;
                        o1[q] = (t1 * cs[q] - t2 * sn[q]) * sc; o2[q] = (t1 * sn[q] + t2 * cs[q]) * sc; }
                GAS bf16* rowp = dst + (size_t)t * QKW + h * DK + i0;
                u32x4 w1, w2; w1.x = cvt_pk_bf16(o1[0], o1[1]); w1.y = cvt_pk_bf16(o1[2], o1[3]); w1.z = cvt_pk_bf16(o1[4], o1[5]); w1.w = cvt_pk_bf16(o1[6], o1[7]);
                w2.x = cvt_pk_bf16(o2[0], o2[1]); w2.y = cvt_pk_bf16(o2[2], o2[3]); w2.z = cvt_pk_bf16(o2[4], o2[5]); w2.w = cvt_pk_bf16(o2[6], o2[7]);
                *(GAS u32x4*)rowp = w1; *(GAS u32x4*)(rowp + 128) = w2; }
    }
};
struct EpiRopeKT {
    static constexpr bool PERM = true;
    GAS bf16* KT; const GAS f32x2* rotT; const LAS float* l2g;
    __device__ __forceinline__ void operator()(const f32x4 (&acc)[2][2][4][2], const pg8::Unit& u, int wr, int wc, int fr, int fq) const {
        const int h = u.pm; const float l2f = l2g[h], l2b = l2g[4 + h];
#pragma unroll
        for (int bj = 0; bj < 2; ++bj) {
            const int tok0 = u.pn * 256 + bj * 128 + wc * 32 + 8 * fq, s0 = tok0 & (SEQ - 1), j0 = tok0 & (CH - 1);
            float zf[8], zb[8];
#pragma unroll
            for (int q = 0; q < 8; ++q) { zf[q] = fast_exp2((float)(CH - 1 - (j0 + q)) * l2f) * 0.0625f; zb[q] = fast_exp2((float)(j0 + q) * l2b) * 0.0625f; }
#pragma unroll
            for (int m = 0; m < 4; ++m) { const int i = wr * 64 + m * 16 + fr;
                const GAS f32x4* rp = (const GAS f32x4*)(rotT + (size_t)i * SEQ + s0);
                const f32x4 r0 = rp[0], r1 = rp[1], r2 = rp[2], r3 = rp[3];
                const float cs[8] = {r0[0], r0[2], r1[0], r1[2], r2[0], r2[2], r3[0], r3[2]}, sn[8] = {r0[1], r0[3], r1[1], r1[3], r2[1], r2[3], r3[1], r3[3]};
                float o1[8], o2[8];
#pragma unroll
                for (int n = 0; n < 2; ++n)
#pragma unroll
                    for (int j = 0; j < 4; ++j) { const float t1 = acc[0][bj][m][n][j], t2 = acc[1][bj][m][n][j]; const int q = 4 * n + j;
                        o1[q] = t1 * cs[q] - t2 * sn[q]; o2[q] = t1 * sn[q] + t2 * cs[q]; }
                u32x4 w1, w2;
                w1.x = cvt_pk_bf16(o1[0] * zf[0], o1[1] * zf[1]); w1.y = cvt_pk_bf16(o1[2] * zf[2], o1[3] * zf[3]); w1.z = cvt_pk_bf16(o1[4] * zf[4], o1[5] * zf[5]); w1.w = cvt_pk_bf16(o1[6] * zf[6], o1[7] * zf[7]);
                w2.x = cvt_pk_bf16(o2[0] * zf[0], o2[1] * zf[1]); w2.y = cvt_pk_bf16(o2[2] * zf[2], o2[3] * zf[3]); w2.z = cvt_pk_bf16(o2[4] * zf[4], o2[5] * zf[5]); w2.w = cvt_pk_bf16(o2[6] * zf[6], o2[7] * zf[7]);
                const int tokr = rot_col(i, tok0);
                *(GAS u32x4*)(KT + (size_t)(h * DK + i) * T + tokr) = w1; *(GAS u32x4*)(KT + (size_t)(h * DK + 128 + i) * T + tokr) = w2;
                w1.x = cvt_pk_bf16(o1[0] * zb[0], o1[1] * zb[1]); w1.y = cvt_pk_bf16(o1[2] * zb[2], o1[3] * zb[3]); w1.z = cvt_pk_bf16(o1[4] * zb[4], o1[5] * zb[5]); w1.w = cvt_pk_bf16(o1[6] * zb[6], o1[7] * zb[7]);
                w2.x = cvt_pk_bf16(o2[0] * zb[0], o2[1] * zb[1]); w2.y = cvt_pk_bf16(o2[2] * zb[2], o2[3] * zb[3]); w2.z = cvt_pk_bf16(o2[4] * zb[4], o2[5] * zb[5]); w2.w = cvt_pk_bf16(o2[6] * zb[6], o2[7] * zb[7]);
                *(GAS u32x4*)(KT + (size_t)QKW * T + (size_t)(h * DK + i) * T + tokr) = w1; *(GAS u32x4*)(KT + (size_t)QKW * T + (size_t)(h * DK + 128 + i) * T + tokr) = w2; } }
    }
};
template <bool ROT> struct EpiBf16 {
    static constexpr bool PERM = true;
    GAS bf16* O; int ldc;
    __device__ __forceinline__ void operator()(const f32x4 (&acc)[2][2][4][2], const pg8::Unit& u, int wr, int wc, int fr, int fq) const {
#pragma unroll
        for (int ai = 0; ai < 2; ++ai)
#pragma unroll
            for (int m = 0; m < 4; ++m) { const int row = u.pm * 256 + ai * 128 + wr * 64 + m * 16 + fr; GAS bf16* rowp = O + (size_t)row * ldc;
#pragma unroll
                for (int bj = 0; bj < 2; ++bj) { const f32x4 v0 = acc[ai][bj][m][0], v1 = acc[ai][bj][m][1]; const int col = u.pn * 256 + bj * 128 + wc * 32 + 8 * fq;
                    u32x4 w; w.x = cvt_pk_bf16(v0[0], v0[1]); w.y = cvt_pk_bf16(v0[2], v0[3]); w.z = cvt_pk_bf16(v1[0], v1[1]); w.w = cvt_pk_bf16(v1[2], v1[3]);
                    *(GAS u32x4*)(rowp + (ROT ? rot_col(row, col) : col)) = w; } }
    }
};
struct EpiPc {
    static constexpr bool PERM = true;
    GAS bf16* PC; const LAS float* l2g;
    __device__ __forceinline__ void operator()(const f32x4 (&acc)[2][2][4][2], const pg8::Unit& u, int wr, int wc, int fr, int fq) const {
        const int h = u.z; const float l2f = l2g[h], l2b = l2g[4 + h];
#pragma unroll
        for (int ai = 0; ai < 2; ++ai)
#pragma unroll
            for (int m = 0; m < 4; ++m) { const int il = wr * 64 + m * 16 + fr, jl0 = wc * 32 + 8 * fq; float o[8];
#pragma unroll
                for (int n = 0; n < 2; ++n)
#pragma unroll
                    for (int j = 0; j < 4; ++j) { const int dl = il - (jl0 + 4 * n + j); const float f = dl >= 0 ? fast_exp2((float)dl * l2f) : fast_exp2((float)(-dl) * l2b);
                        o[4 * n + j] = (ai == 0 ? acc[0][0][m][n][j] : acc[1][1][m][n][j]) * f; }
                u32x4 w; w.x = cvt_pk_bf16(o[0], o[1]); w.y = cvt_pk_bf16(o[2], o[3]); w.z = cvt_pk_bf16(o[4], o[5]); w.w = cvt_pk_bf16(o[6], o[7]);
                *(GAS u32x4*)(PC + ((size_t)(u.pm * 2 + ai) * 128 + il) * 128 + jl0) = w; }
    }
};
struct EpiGate {
    static constexpr bool PERM = true;
    const GAS bf16* Y; GAS bf16* YG; const GAS f32x2* statp; const GAS float* gain;
    __device__ __forceinline__ void operator()(const f32x4 (&acc)[2][2][4][2], const pg8::Unit& u, int wr, int wc, int fr, int fq) const {
        const int head = u.pn >> 1, c0 = u.pn * 256 + wc * 32 + 8 * fq;
        f32x4 gv[2][2];
#pragma unroll
        for (int bj = 0; bj < 2; ++bj) { gv[bj][0] = *(const GAS f32x4*)(gain + c0 + bj * 128); gv[bj][1] = *(const GAS f32x4*)(gain + c0 + bj * 128 + 4); }
#pragma unroll
        for (int ai = 0; ai < 2; ++ai)
#pragma unroll
            for (int m = 0; m < 4; ++m) { const int t = u.pm * 256 + ai * 128 + wr * 64 + m * 16 + fr; f32x2 st;
                { const GAS f32x4* sp = (const GAS f32x4*)(statp + ((size_t)t * 4 + head) * 16); float a1 = 0.f, a2 = 0.f;
#pragma unroll
                  for (int k = 0; k < 8; ++k) { const f32x4 v = sp[k]; a1 += v[0] + v[2]; a2 += v[1] + v[3]; }
                  const float mu = a1 * (1.f / DV), var = fmaxf(a2 * (1.f / DV) - mu * mu, 0.f); st.x = mu; st.y = 1.0f / sqrtf(var + EPS); }
#pragma unroll
                for (int bj = 0; bj < 2; ++bj) { const size_t off = (size_t)t * VW + c0 + bj * 128; const u32x4 yv = *(const GAS u32x4*)(Y + off);
                    const float y[8] = {bf_lo(yv.x), bf_hi(yv.x), bf_lo(yv.y), bf_hi(yv.y), bf_lo(yv.z), bf_hi(yv.z), bf_lo(yv.w), bf_hi(yv.w)}; float o[8];
#pragma unroll
                    for (int n = 0; n < 2; ++n)
#pragma unroll
                        for (int j = 0; j < 4; ++j) { const int q = 4 * n + j; const float yn = (y[q] - st.x) * st.y * gv[bj][n][j]; o[q] = silu_f(acc[ai][bj][m][n][j]) * yn; }
                    u32x4 w; w.x = cvt_pk_bf16(o[0], o[1]); w.y = cvt_pk_bf16(o[2], o[3]); w.z = cvt_pk_bf16(o[4], o[5]); w.w = cvt_pk_bf16(o[6], o[7]);
                    *(GAS u32x4*)(YG + off) = w; } }
    }
};
struct EpiResF32 {
    static constexpr bool PERM = false;
    const GAS float* base; GAS float* out;
    __device__ __forceinline__ void operator()(const f32x4 (&acc)[2][2][4][2], const pg8::Unit& u, int wr, int wc, int fr, int fq) const {
#pragma unroll
        for (int ai = 0; ai < 2; ++ai)
#pragma unroll
            for (int m = 0; m < 4; ++m) { const size_t off = (size_t)(u.pm * 256 + ai * 128 + wr * 64 + m * 16 + fr) * D + u.pn * 256 + wc * 32 + 4 * fq;
#pragma unroll
                for (int bj = 0; bj < 2; ++bj)
#pragma unroll
                    for (int n = 0; n < 2; ++n) { const f32x4 bs = *(const GAS f32x4*)(base + off + bj * 128 + n * 16); *(GAS f32x4*)(out + off + bj * 128 + n * 16) = bs + acc[ai][bj][m][n]; } }
    }
};
struct EpiSwiGLU {
    static constexpr bool PERM = true;
    GAS bf16* ACT; int ldc;
    __device__ __forceinline__ void operator()(const f32x4 (&acc)[2][2][4][2], const pg8::Unit& u, int wr, int wc, int fr, int fq) const {
#pragma unroll
        for (int ai = 0; ai < 2; ++ai)
#pragma unroll
            for (int m = 0; m < 4; ++m) { float o[8];
#pragma unroll
                for (int n = 0; n < 2; ++n)
#pragma unroll
                    for (int j = 0; j < 4; ++j) o[4 * n + j] = silu_f(acc[ai][0][m][n][j]) * acc[ai][1][m][n][j];
                u32x4 w; w.x = cvt_pk_bf16(o[0], o[1]); w.y = cvt_pk_bf16(o[2], o[3]); w.z = cvt_pk_bf16(o[4], o[5]); w.w = cvt_pk_bf16(o[6], o[7]);
                *(GAS u32x4*)(ACT + (size_t)(u.pm * 256 + ai * 128 + wr * 64 + m * 16 + fr) * ldc + u.pn * 128 + wc * 32 + 8 * fq) = w; }
    }
};
struct EpiZ2 {
    static constexpr bool PERM = true;
    GAS bf16* Z2;
    __device__ __forceinline__ void operator()(const f32x4 (&acc)[2][2][4][2], const pg8::Unit& u, int wr, int wc, int fr, int fq) const {
        const int g = u.pm >> 1, ri = u.pm & 1;
#pragma unroll
        for (int ai = 0; ai < 2; ++ai)
#pragma unroll
            for (int m = 0; m < 4; ++m) { const int cp = ai * 128 + wr * 64 + m * 16 + fr;
#pragma unroll
                for (int bj = 0; bj < 2; ++bj) { const int tok0 = u.pn * 256 + bj * 128 + wc * 32 + 8 * fq, b = tok0 >> 12, s0 = tok0 & (SEQ - 1);
                    const f32x4 v0 = acc[ai][bj][m][0], v1 = acc[ai][bj][m][1];
                    u32x4 w; w.x = cvt_pk_bf16(v0[0], v0[1]); w.y = cvt_pk_bf16(v0[2], v0[3]); w.z = cvt_pk_bf16(v1[0], v1[1]); w.w = cvt_pk_bf16(v1[2], v1[3]);
                    *(GAS u32x4*)(Z2 + ((size_t)(b * 1024 + g * 256 + cp) * 8192 + ri * SEQ + s0)) = w; } }
    }
};
struct EpiYf {
    static constexpr bool PERM = true;
    GAS bf16* YF;
    __device__ __forceinline__ void operator()(const f32x4 (&acc)[2][2][4][2], const pg8::Unit& u, int wr, int wc, int fr, int fq) const {
        const int batch = u.pn >> 5, fb = (u.pn >> 1) & 15, kbb = u.pn & 1;
#pragma unroll
        for (int ai = 0; ai < 2; ++ai)
#pragma unroll
            for (int m = 0; m < 4; ++m) { const int ka = u.pm * 256 + ai * 128 + wr * 64 + m * 16 + fr;
#pragma unroll
                for (int bj = 0; bj < 2; ++bj) { const int kb = kbb * 4 + 2 * bj + (wc >> 1), f = fb * 64 + 32 * (wc & 1) + 8 * fq;
                    const f32x4 v0 = acc[ai][bj][m][0], v1 = acc[ai][bj][m][1];
                    u32x4 w; w.x = cvt_pk_bf16(v0[0], v0[1]); w.y = cvt_pk_bf16(v0[2], v0[3]); w.z = cvt_pk_bf16(v1[0], v1[1]); w.w = cvt_pk_bf16(v1[2], v1[3]);
                    *(GAS u32x4*)(YF + (size_t)(batch * SEQ + 8 * ka + kb) * D + f) = w; } }
    }
};
struct EpiMoeDown {
    static constexpr bool PERM = false;
    GAS float* Hres; const GAS int* rowtok; const GAS float* rowgate;
    __device__ __forceinline__ void operator()(const f32x4 (&acc)[2][2][4][2], const pg8::Unit& u, int wr, int wc, int fr, int fq) const {
#pragma unroll
        for (int ai = 0; ai < 2; ++ai)
#pragma unroll
            for (int m = 0; m < 4; ++m) { const int row = u.pm * 256 + ai * 128 + wr * 64 + m * 16 + fr; const int tok = rowtok[row]; const float gw = rowgate[row];
                if (tok >= 0) { GAS float* rp = Hres + (size_t)tok * D + u.pn * 256 + wc * 32 + 4 * fq;
#pragma unroll
                    for (int bj = 0; bj < 2; ++bj)
#pragma unroll
                        for (int n = 0; n < 2; ++n) { const f32x4 bs = *(const GAS f32x4*)(rp + bj * 128 + n * 16); *(GAS f32x4*)(rp + bj * 128 + n * 16) = bs + gw * acc[ai][bj][m][n]; } } }
    }
};

#define XB_TMO      128
#define XB_XCNT(j)  (256  + 64 * (j))
#define XB_XSUB(j)  (1280 + 64 * (j))
#define XB_XGEN(j)  (2304 + 64 * (j))
#define XB_TOP      3328
#define XB_TOPGEN   3392
#define XCD_BAR_WORDS 3456
#define XB_SPIN_CAP (1u << 18)
__device__ __forceinline__ unsigned xb_ld(unsigned* p)              { return __hip_atomic_load(p, __ATOMIC_RELAXED, __HIP_MEMORY_SCOPE_AGENT); }
__device__ __forceinline__ unsigned xb_add(unsigned* p, unsigned v) { return __hip_atomic_fetch_add(p, v, __ATOMIC_RELAXED, __HIP_MEMORY_SCOPE_AGENT); }
__device__ __forceinline__ unsigned xb_xcc_id() { return (unsigned)__builtin_amdgcn_s_getreg((3 << 11) | 20) & 0xFu; }
#define XB_SPIN(cond, bar) do { unsigned _sp = 0; while (cond) { __builtin_amdgcn_s_sleep(1); \
    if ((++_sp & 255u) == 0u) { if (xb_ld(&(bar)[XB_TMO])) break; if (_sp > XB_SPIN_CAP) { atomicAdd(&(bar)[XB_TMO], 1u); break; } } } } while (0)
struct XcdBarrier { unsigned* bar; unsigned x; volatile LAS unsigned* st; };
__device__ __forceinline__ XcdBarrier xcd_barrier_post(unsigned* bar, volatile LAS unsigned* st, const bool t0) {
    XcdBarrier b; b.bar = bar; b.x = xb_xcc_id(); b.st = st;
    if (t0) (void)xb_add(&bar[XB_XCNT(b.x)], 1u);
    return b;
}
__device__ __forceinline__ void xcd_barrier_complete(unsigned* bar, unsigned x, unsigned& nloc, unsigned& nx) {
    const unsigned G = gridDim.x * gridDim.y * gridDim.z;
    unsigned sum, cnt, mine, sp = 0u;
    for (;;) {
        sum = 0u; cnt = 0u; mine = 0u;
#pragma unroll
        for (unsigned j = 0; j < 16; ++j) { const unsigned c = xb_ld(&bar[XB_XCNT(j)]); sum += c; cnt += (c > 0u) ? 1u : 0u; mine = (j == x) ? c : mine; }
        if (sum == G) break;
        __builtin_amdgcn_s_sleep(1);
        if ((++sp & 255u) == 0u) { if (xb_ld(&bar[XB_TMO])) break; if (sp > XB_SPIN_CAP) { atomicAdd(&bar[XB_TMO], 1u); break; } }
    }
    nloc = mine > 0u ? mine : 1u; nx = cnt > 0u ? cnt : 1u;
}
__device__ __forceinline__ void xcd_barrier(const XcdBarrier& b, const bool t0) {
    asm volatile("s_waitcnt vmcnt(0)" ::: "memory");
    __syncthreads();
    if (t0) {
        unsigned* bar = b.bar;
        __builtin_amdgcn_s_waitcnt(0);
        unsigned nloc = b.st[0], nx = b.st[1];
        if (nloc == 0u) { xcd_barrier_complete(bar, b.x, nloc, nx); b.st[0] = nloc; b.st[1] = nx; }
        const unsigned old = xb_add(&bar[XB_XSUB(b.x)], 1u);
        const unsigned gen = old / nloc;
        if (old + 1u == (gen + 1u) * nloc) {
            __builtin_amdgcn_fence(__ATOMIC_RELEASE, "agent");
            asm volatile("s_waitcnt vmcnt(0)" ::: "memory");
            const unsigned og = xb_add(&bar[XB_TOP], 1u);
            const unsigned tg = og / nx;
            if (og + 1u == (tg + 1u) * nx) xb_add(&bar[XB_TOPGEN], 1u);
            else XB_SPIN(xb_ld(&bar[XB_TOPGEN]) == tg, bar);
            __builtin_amdgcn_fence(__ATOMIC_ACQUIRE, "agent");
            xb_add(&bar[XB_XGEN(b.x)], 1u);
            asm volatile("s_waitcnt vmcnt(0)" ::: "memory");
        } else {
            XB_SPIN(xb_ld(&bar[XB_XGEN(b.x)]) == gen, bar);
            __builtin_amdgcn_fence(__ATOMIC_ACQUIRE, "agent");
            asm volatile("s_waitcnt vmcnt(0)" ::: "memory");
        }
    }
    __syncthreads();
}

__device__ __forceinline__ float wave_sum(float v) {
#pragma unroll
    for (int o = 1; o < 64; o <<= 1) v += __shfl_xor(v, o);
    return v;
}
__device__ __forceinline__ void transpose_item(const GAS float* W, int K, int N, GAS bf16* WT, int k0, int n0, int rbase, LAS float* scr, int lane) {
#pragma unroll 8
    for (int i = 0; i < 32; ++i) { const int kk = 2 * i + (lane >> 5); scr[kk * 33 + (lane & 31)] = W[(size_t)(k0 + kk) * N + n0 + (lane & 31)]; }
    LDS_WAIT(); asm volatile("" ::: "memory");
    const int c = lane & 7;
#pragma unroll
    for (int j = 0; j < 4; ++j) { const int n = (lane >> 3) + 8 * j; const LAS float* s = scr + (8 * c) * 33 + n;
        u32x4 o; o.x = cvt_pk_bf16(s[0 * 33], s[1 * 33]); o.y = cvt_pk_bf16(s[2 * 33], s[3 * 33]); o.z = cvt_pk_bf16(s[4 * 33], s[5 * 33]); o.w = cvt_pk_bf16(s[6 * 33], s[7 * 33]);
        *(GAS u32x4*)(WT + (size_t)(rbase + n) * K + k0 + 8 * c) = o; }
    LDS_WAIT(); asm volatile("" ::: "memory");
}
__device__ __forceinline__ void tr_plain(const GAS float* W, int K, int N, GAS bf16* WT, int it, LAS float* scr, int lane) {
    const int nblk = N / 32, kb = it / nblk, nb = it - kb * nblk; transpose_item(W, K, N, WT, 64 * kb, 32 * nb, 32 * nb, scr, lane);
}
__device__ __forceinline__ void tr_gu(const GAS float* Wg, const GAS float* Wu, int K, int N, GAS bf16* WT, int it, LAS float* scr, int lane) {
    const int nblk = N / 32, per = (K / 64) * nblk; const bool up = it >= per; if (up) it -= per;
    const int kb = it / nblk, nb = it - kb * nblk, f0 = 32 * nb;
    transpose_item(up ? Wu : Wg, K, N, WT, 64 * kb, f0, 256 * (f0 >> 7) + (up ? 128 : 0) + (f0 & 127), scr, lane);
}
__device__ __forceinline__ void rms_row(const GAS float* xrow, const GAS float* g, GAS bf16* orow, int lane, f32x4 (&v)[4]) {
    const GAS f32x4* xr = (const GAS f32x4*)xrow + lane; const GAS f32x4* gr = (const GAS f32x4*)g + lane;
    float s = 0.f;
#pragma unroll
    for (int j = 0; j < 4; ++j) { v[j] = xr[64 * j]; s += (v[j].x * v[j].x + v[j].y * v[j].y) + (v[j].z * v[j].z + v[j].w * v[j].w); }
    const float r = 1.0f / sqrtf(wave_sum(s) * (1.f / D) + EPS);
    GAS u32x2* o8 = (GAS u32x2*)orow + lane;
#pragma unroll
    for (int j = 0; j < 4; ++j) { v[j] = v[j] * r * gr[64 * j]; u32x2 w; w.x = cvt_pk_bf16(v[j].x, v[j].y); w.y = cvt_pk_bf16(v[j].z, v[j].w); o8[64 * j] = w; }
}

constexpr int SW_QL = 0, SW_SPITCH = 528, SW_SL = 65536, SW_VPITCH = 272, SW_VL = SW_SL + 64 * SW_SPITCH, SW_VB = 64 * SW_VPITCH;
static_assert(SW_VL + 2 * SW_VB <= 139264, "sweep LDS");
__device__ __forceinline__ void sweep_unit(LAS unsigned char* lds, const GAS bf16* Qg, const GAS bf16* KTFg, const GAS bf16* KTBg, const GAS bf16* VTg, const GAS bf16* PCg, GAS bf16* Yg, GAS f32x2* statp, const float l2f, const float l2b, int b, int h, int es, const int wave_s) {
    const int tid = tid_of(wave_s);
    const int w = __builtin_amdgcn_readfirstlane(tid >> 6), lane = tid & 63, rb = w >> 1, cb = w & 1, r32 = lane & 31, hh = lane >> 5;
    const int vrow = tid >> 4, vpc = tid & 15;
    const int qrow = tid >> 5, qpc = tid & 31;
    const GAS bf16* qp = Qg + (size_t)(b * SEQ + qrow) * QKW + h * DK + 8 * qpc;
    const size_t kto = (size_t)(h * DK + 32 * w + r32) * T + 8 * hh; const int krot = b * SEQ + ((r32 & 15) << 11);
    const GAS bf16* vtp = VTg + (size_t)(h * DV + 64 * es + vrow) * T + 8 * vpc; const int vrot = b * SEQ + ((vrow & 15) << 11);
    const GAS bf16* pcp = PCg + ((size_t)((b * NH + h) * NCH) * 128 + rb * 32 + r32) * 128 + 8 * hh;
    GAS bf16* yp = Yg + (size_t)(b * SEQ + 32 * rb + r32) * VW + h * DV + 64 * es + 32 * cb + 4 * hh;
    GAS f32x2* stp = statp + ((size_t)(b * SEQ + 32 * rb + r32) * NH + h) * 16 + es * 2 + cb;
    const int il = 32 * rb + r32;
    const int qrd = SW_QL + il * 512;
    bf16x8 pa[8], ka[8]; u32x4 vv[2], qv[8];
    f32x16 Sacc[2];
#pragma unroll
    for (int s = 0; s < 8; ++s) { pa[s] = *(const GAS bf16x8*)(pcp + 16 * s); ka[s] = *(const GAS bf16x8*)(KTFg + kto + (krot & (T - 1)) + 16 * s); }
#pragma unroll
    for (int it = 0; it < 2; ++it) vv[it] = *(const GAS u32x4*)(vtp + (size_t)(32 * it) * T + (vrot & (T - 1)));
#pragma unroll
    for (int it = 0; it < 8; ++it) qv[it] = *(const GAS u32x4*)(qp + (size_t)(16 * it) * QKW);
#pragma unroll
    for (int it = 0; it < 2; ++it) *(LAS u32x4*)(lds + SW_VL + (vrow + 32 * it) * SW_VPITCH + vpc * 16) = vv[it];
#pragma unroll
    for (int it = 0; it < 8; ++it) { const int row = qrow + 16 * it; *(LAS u32x4*)(lds + SW_QL + row * 512 + ((qpc ^ (row & 15)) * 16)) = qv[it]; }
#pragma unroll 1
    for (int p = 0; p < 2 * NCH; ++p) {
        const int dir = p >> 5, st = p & 31, n = dir ? NCH - 1 - st : st;
        const int pn = p + 1 < 2 * NCH ? p + 1 : p, dirn = pn >> 5, stn = pn & 31, nn = dirn ? NCH - 1 - stn : stn;
        const float l2 = dir ? l2b : l2f;
        const int cur = p & 1;
        if (st == 0) {
#pragma unroll
            for (int c = 0; c < 2; ++c)
#pragma unroll
                for (int t = 0; t < 16; ++t) Sacc[c][t] = 0.f;
        }
#pragma unroll
        for (int c = 0; c < 2; ++c)
#pragma unroll
            for (int g = 0; g < 4; ++g) { u32x2 pk; pk.x = cvt_pk_bf16(Sacc[c][4 * g], Sacc[c][4 * g + 1]); pk.y = cvt_pk_bf16(Sacc[c][4 * g + 2], Sacc[c][4 * g + 3]);
                *(LAS u32x2*)(lds + SW_SL + (32 * c + r32) * SW_SPITCH + (32 * w + 8 * g + 4 * hh) * 2) = pk; }
#pragma unroll
        for (int it = 0; it < 2; ++it) vv[it] = *(const GAS u32x4*)(vtp + (size_t)(32 * it) * T + ((nn * CH + vrot) & (T - 1)));
#pragma unroll
        for (int it = 0; it < 8; ++it) qv[it] = *(const GAS u32x4*)(qp + (size_t)(nn * CH + 16 * it) * QKW);
        u32x2 yf[4];
        GAS bf16* ypn = yp + (size_t)(n * CH) * VW;
        if (dir) {
#pragma unroll
            for (int g = 0; g < 4; ++g) yf[g] = *(const GAS u32x2*)(ypn + 8 * g);
        }
        __syncthreads();
        f32x16 O;
#pragma unroll
        for (int t = 0; t < 16; ++t) O[t] = 0.f;
#pragma unroll
        for (int ks = 0; ks < 16; ++ks) {
            const bf16x8 sf = *(const LAS bf16x8*)(lds + SW_SL + (32 * cb + r32) * SW_SPITCH + (16 * ks + 8 * hh) * 2);
            const bf16x8 qf = *(const LAS bf16x8*)(lds + qrd + (((2 * ks + hh) ^ (il & 15)) * 16));
            O = __builtin_amdgcn_mfma_f32_32x32x16_bf16(sf, qf, O, 0, 0, 0);
            if ((ks & 3) == 3) __builtin_amdgcn_sched_barrier(0); }
        __syncthreads();
        {
            const float xi = fast_exp2((float)(dir == 0 ? (il + 1) : (CH - il)) * l2);
#pragma unroll
            for (int t = 0; t < 16; ++t) O[t] *= xi;
        }
#pragma unroll
        for (int s = 0; s < 8; ++s) {
            const int jb = s >> 1;
            const bool use = dir == 0 ? (jb <= rb) : (jb >= rb);
            if (use) {
                u32x4 pm = __builtin_bit_cast(u32x4, pa[s]);
                if (jb == rb) {
                    const int nk = r32 - (16 * (s & 1) + 8 * hh) + 1;
                    unsigned mk[4];
#pragma unroll
                    for (int q = 0; q < 4; ++q) mk[q] = ((2 * q < nk) ? 0xffffu : 0u) | ((2 * q + 1 < nk) ? 0xffff0000u : 0u);
                    if (dir == 0) { pm.x &= mk[0]; pm.y &= mk[1]; pm.z &= mk[2]; pm.w &= mk[3]; } else { pm.x &= ~mk[0]; pm.y &= ~mk[1]; pm.z &= ~mk[2]; pm.w &= ~mk[3]; }
                }
                const bf16x8 vf = *(const LAS bf16x8*)(lds + SW_VL + cur * SW_VB + (32 * cb + r32) * SW_VPITCH + (16 * s + 8 * hh) * 2);
                O = __builtin_amdgcn_mfma_f32_32x32x16_bf16(vf, __builtin_bit_cast(bf16x8, pm), O, 0, 0, 0); } }
        __builtin_amdgcn_sched_barrier(0);
#pragma unroll
        for (int s = 0; s < 8; ++s) pa[s] = *(const GAS bf16x8*)(pcp + (size_t)nn * (CH * CH) + 16 * s);
        {
            const float gC = fast_exp2((float)CH * l2);
#pragma unroll
            for (int c = 0; c < 2; ++c) {
#pragma unroll
                for (int t = 0; t < 16; ++t) Sacc[c][t] *= gC;
#pragma unroll
                for (int s = 0; s < 8; ++s) { const bf16x8 bv = *(const LAS bf16x8*)(lds + SW_VL + cur * SW_VB + (32 * c + r32) * SW_VPITCH + (16 * s + 8 * hh) * 2);
                    Sacc[c] = __builtin_amdgcn_mfma_f32_32x32x16_bf16(ka[s], bv, Sacc[c], 0, 0, 0); }
                __builtin_amdgcn_sched_barrier(0); }
        }
        __builtin_amdgcn_sched_barrier(0);
        {
            const GAS bf16* ktn = (dirn ? KTBg : KTFg) + kto + ((nn * CH + krot) & (T - 1));
#pragma unroll
            for (int s = 0; s < 8; ++s) ka[s] = *(const GAS bf16x8*)(ktn + 16 * s);
        }
#pragma unroll
        for (int it = 0; it < 2; ++it) *(LAS u32x4*)(lds + SW_VL + (cur ^ 1) * SW_VB + (vrow + 32 * it) * SW_VPITCH + vpc * 16) = vv[it];
#pragma unroll
        for (int it = 0; it < 8; ++it) { const int row = qrow + 16 * it; *(LAS u32x4*)(lds + SW_QL + row * 512 + ((qpc ^ (row & 15)) * 16)) = qv[it]; }
        if (dir == 0) {
#pragma unroll
            for (int g = 0; g < 4; ++g) { u32x2 o; o.x = cvt_pk_bf16(O[4 * g], O[4 * g + 1]); o.y = cvt_pk_bf16(O[4 * g + 2], O[4 * g + 3]); *(GAS u32x2*)(ypn + 8 * g) = o; }
        } else {
            float s1 = 0.f, s2 = 0.f;
#pragma unroll
            for (int g = 0; g < 4; ++g) { const float y0 = bf_lo(yf[g].x) + O[4 * g], y1 = bf_hi(yf[g].x) + O[4 * g + 1], y2 = bf_lo(yf[g].y) + O[4 * g + 2], y3 = bf_hi(yf[g].y) + O[4 * g + 3];
                s1 += (y0 + y1) + (y2 + y3); s2 += (y0 * y0 + y1 * y1) + (y2 * y2 + y3 * y3);
                u32x2 o; o.x = cvt_pk_bf16(y0, y1); o.y = cvt_pk_bf16(y2, y3); *(GAS u32x2*)(ypn + 8 * g) = o; }
            s1 += __shfl_xor(s1, 32); s2 += __shfl_xor(s2, 32);
            if (hh == 0) stp[(size_t)(n * CH) * (NH * 16)] = (f32x2){s1, s2};
        }
    }
    VM_WAIT();
    __syncthreads();
}

struct Args { const float* in[16]; float* out; unsigned char* ws; };
constexpr int NWAVES = 8;
#ifndef PHMASK
#define PHMASK 0xFFFFFFFFu
#endif
#define PH(k) (((PHMASK) >> (k)) & 1u)
__global__ void __launch_bounds__(NWAVES * 64, 2) fwd_kernel(Args args) {
    extern __shared__ __attribute__((aligned(16))) unsigned char lds_raw[];
    LAS unsigned char* lds = (LAS unsigned char*)lds_raw;
    LAS float* l2g = (LAS float*)(lds + LDSCTL_OFF + 64);
    const int wave_k = __builtin_amdgcn_readfirstlane((int)threadIdx.x >> 6);
#define PHASE_VARS \
    const int tid = tid_of(wave_k); const int lane = tid & 63; int wave = wave_k; asm volatile("" : "+s"(wave)); \
    const __attribute__((address_space(4))) Args* ka = (const __attribute__((address_space(4))) Args*)__builtin_amdgcn_kernarg_segment_ptr(); asm volatile("" : "+s"(ka)); \
    const int G = gridDim.x, bx = blockIdx.x; const int vcu = (G % 8 == 0) ? (bx % 8) * (G / 8) + bx / 8 : bx; const int gw = vcu * NWAVES + wave, NGW = G * NWAVES; \
    GAS unsigned char* ws = (GAS unsigned char*)ka->ws; asm volatile("" : "+s"(ws)); GAS float* hres = (GAS float*)ka->out; (void)lane; (void)gw; (void)NGW; (void)vcu; (void)hres; \
    const GAS float* x = (const GAS float*)ka->in[0]; const GAS float* mix_norm = (const GAS float*)ka->in[1]; const GAS float* ffn_norm = (const GAS float*)ka->in[2]; const GAS float* ret_w_in = (const GAS float*)ka->in[3]; const GAS float* ret_decay = (const GAS float*)ka->in[4]; \
    const GAS float* gn_gain = (const GAS float*)ka->in[5]; const GAS float* ret_w_out = (const GAS float*)ka->in[6]; const GAS float* d_wg = (const GAS float*)ka->in[7]; const GAS float* d_wu = (const GAS float*)ka->in[8]; const GAS float* d_wd = (const GAS float*)ka->in[9]; \
    const GAS float* fnet_w = (const GAS float*)ka->in[10]; const GAS float* moe_router = (const GAS float*)ka->in[11]; const GAS float* m_wg = (const GAS float*)ka->in[12]; const GAS float* m_wu = (const GAS float*)ka->in[13]; const GAS float* m_wd = (const GAS float*)ka->in[14]; const GAS float* final_norm = (const GAS float*)ka->in[15]; \
    (void)x; (void)mix_norm; (void)ffn_norm; (void)ret_w_in; (void)ret_decay; (void)gn_gain; (void)ret_w_out; (void)d_wg; (void)d_wu; (void)d_wd; (void)fnet_w; (void)moe_router; (void)m_wg; (void)m_wu; (void)m_wd; (void)final_norm; \
    GAS f32x2* rot = (GAS f32x2*)(ws + WS_ROT); GAS f32x2* rotT = (GAS f32x2*)(ws + WS_ROTT); GAS bf16* WC = (GAS bf16*)(ws + WS_WC); \
    GAS int* toke = (GAS int*)(ws + WS_TOKE); GAS float* tokw = (GAS float*)(ws + WS_TOKW); GAS int* bcnt = (GAS int*)(ws + WS_BCNT); GAS int* rowtok = (GAS int*)(ws + WS_ROWTOK); GAS float* rowgate = (GAS float*)(ws + WS_ROWGATE); \
    GAS f32x2* statp = (GAS f32x2*)(ws + WS_STATP); \
    GAS bf16* WIN = (GAS bf16*)(ws + WS_WIN); GAS bf16* WO = (GAS bf16*)(ws + WS_WO); GAS bf16* WGU = (GAS bf16*)(ws + WS_WGU); GAS bf16* WD = (GAS bf16*)(ws + WS_WD); GAS bf16* WF = (GAS bf16*)(ws + WS_WF); \
    GAS bf16* HN = (GAS bf16*)(ws + WS_HN); GAS bf16* Qb = (GAS bf16*)(ws + WS_Q); GAS bf16* Kb = (GAS bf16*)(ws + WS_K); GAS bf16* KT = (GAS bf16*)(ws + WS_KT); GAS bf16* VT = (GAS bf16*)(ws + WS_VT); GAS bf16* PC = (GAS bf16*)(ws + WS_PC); \
    GAS bf16* Yb = (GAS bf16*)ka->out; GAS bf16* YG = (GAS bf16*)(ws + WS_YG); GAS bf16* ACTD = (GAS bf16*)(ws + WS_ACTD); GAS bf16* Z2 = (GAS bf16*)(ws + WS_Z2); GAS bf16* WSEQ = (GAS bf16*)(ws + WS_WSEQ); \
    GAS bf16* ACTM = (GAS bf16*)(ws + WS_ACTM); GAS bf16* WMGU = (GAS bf16*)(ws + WS_WMGU); GAS bf16* WMD = (GAS bf16*)(ws + WS_WMD); \
    (void)rot; (void)rotT; (void)WC; (void)toke; (void)tokw; (void)bcnt; (void)rowtok; (void)rowgate; (void)statp; (void)WIN; (void)WO; (void)WGU; (void)WD; (void)WF; (void)HN; (void)Qb; (void)Kb; (void)KT; (void)VT; (void)PC; \
    (void)Yb; (void)YG; (void)ACTD; (void)Z2; (void)WSEQ; (void)ACTM; (void)WMGU; (void)WMD;
#define GRID_BAR() do { const __attribute__((address_space(4))) Args* kb = (const __attribute__((address_space(4))) Args*)__builtin_amdgcn_kernarg_segment_ptr(); asm volatile("" : "+s"(kb)); GAS unsigned char* wsb = (GAS unsigned char*)kb->ws; XcdBarrier bar_; bar_.bar = (unsigned*)(wsb + WS_CTL) + CW_BAR; bar_.x = xb_xcc_id(); \
    bar_.st = (volatile LAS unsigned*)(lds + MISC_OFF) + 8; xcd_barrier(bar_, tid_of(wave_k) == 0); } while (0)

    {
        PHASE_VARS
        for (int u = tid; u < (LDS_BYTES - LDSCTL_OFF) / 4; u += NWAVES * 64) ((LAS unsigned*)(lds + LDSCTL_OFF))[u] = 0u;
        __syncthreads();
        if (tid < 8) { const float xl = ret_decay[tid]; const float ls = fminf(xl, 0.f) - log1pf(expf(-fabsf(xl))); l2g[tid] = ls * 1.44269504088896341f; }
        __syncthreads();
        (void)xcd_barrier_post((unsigned*)(ws + WS_CTL) + CW_BAR, (volatile LAS unsigned*)(lds + MISC_OFF) + 8, tid == 0);
    }

    if (PH(0)) {
        PHASE_VARS
        LAS float* scr = (LAS float*)(lds + wave * 16384);
        constexpr int I_IN = (D / 64) * (INW / 32), I_O = (VW / 64) * (D / 32), I_GU = 2 * (D / 64) * (FFD / 32), I_D = (FFD / 64) * (D / 32), I_F = (D / 64) * (D / 32);
        constexpr int NITEMS = I_IN + I_O + I_GU + I_D + I_F;
        for (int it = gw; it < NITEMS; it += NGW) {
            int r = it;
            if (r < I_IN) { tr_plain(ret_w_in, D, INW, WIN, r, scr, lane); continue; } r -= I_IN;
            if (r < I_O) { tr_plain(ret_w_out, VW, D, WO, r, scr, lane); continue; } r -= I_O;
            if (r < I_GU) { tr_gu(d_wg, d_wu, D, FFD, WGU, r, scr, lane); continue; } r -= I_GU;
            if (r < I_D) { tr_plain(d_wd, FFD, D, WD, r, scr, lane); continue; } r -= I_D;
            tr_plain(fnet_w, D, D, WF, r, scr, lane);
        }
        for (int e = (vcu * 512 + tid); e < SEQ * 128; e += G * 512) { const int s = e >> 7, i = e & 127;
            const float inv = powf(10000.0f, -(float)i / 128.0f); const float ang = (float)s * inv; float sn, cs; sincosf(ang, &sn, &cs);
            rot[e] = (f32x2){cs, sn}; rotT[(size_t)i * SEQ + s] = (f32x2){cs, sn}; }
        for (int e = (vcu * 512 + tid); e < 512 * 256; e += G * 512) { const int r = e >> 8, c = e & 255, mm = ((r & 255) * c) & 255;
            const float v = r < 256 ? cospif((float)mm * (1.0f / 128.0f)) : -sinpif((float)mm * (1.0f / 128.0f)); WC[e] = (bf16)(cvt_pk_bf16(v, 0.f) & 0xffffu); }
        for (int m = gw; m < T; m += NGW) { f32x4 v[4]; rms_row(x + (size_t)m * D, mix_norm, HN + (size_t)m * D, lane, v); }
    }
    GRID_BAR();

    if (PH(1) && PH(19)) {
        PHASE_VARS
        SchedPlain S{(const GAS char*)HN, (const GAS char*)WIN, (size_t)256 * D * 2, (size_t)256 * D * 2, T / 256, 8, G, bx};
        EpiRopeQK E{Qb, Kb, rot};
        pg8::gemm_phase<EpiRopeQK, SchedPlain, false>(lds, wave_k, D, D, D, S, E);
    }
    if (PH(1) && PH(20)) {
        PHASE_VARS
        SchedPlain S{(const GAS char*)(WIN + (size_t)QKW * D), (const GAS char*)HN, (size_t)256 * D * 2, (size_t)256 * D * 2, 4, T / 256, G, bx};
        EpiRopeKT E{KT, rotT, l2g};
        pg8::gemm_phase<EpiRopeKT, SchedPlain, false>(lds, wave_k, D, D, D, S, E);
    }
    if (PH(1) && PH(21)) {
        PHASE_VARS
        SchedPlain S{(const GAS char*)(WIN + (size_t)2 * QKW * D), (const GAS char*)HN, (size_t)256 * D * 2, (size_t)256 * D * 2, 8, T / 256, G, bx};
        EpiBf16<true> E{VT, T};
        pg8::gemm_phase<EpiBf16<true>, SchedPlain, false>(lds, wave_k, D, D, D, S, E);
    }
    GRID_BAR();

    if (PH(2)) {
        PHASE_VARS
        SchedPc S{(const GAS char*)Qb, (const GAS char*)Kb, G, bx};
        EpiPc E{PC, l2g};
        pg8::gemm_phase<EpiPc, SchedPc, false>(lds, wave_k, QKW, QKW, DK, S, E);
    }
    GRID_BAR();

    if (PH(3)) {
        PHASE_VARS
        for (int u = vcu; u < NB * NH * 8; u += G) { const int hh_ = (u >> 3) & 3; const float l2f = l2g[hh_], l2b = l2g[4 + hh_];
            sweep_unit(lds, Qb, KT, KT + (size_t)QKW * T, VT, PC, Yb, statp, l2f, l2b, u >> 5, hh_, u & 7, wave_k); }
    }
    GRID_BAR();

    if (PH(5)) {
        PHASE_VARS
        SchedPlain S{(const GAS char*)HN, (const GAS char*)(WIN + (size_t)(2 * QKW + VW) * D), (size_t)256 * D * 2, (size_t)256 * D * 2, T / 256, 8, G, bx};
        EpiGate E{Yb, YG, statp, gn_gain};
        pg8::gemm_phase<EpiGate, SchedPlain, false>(lds, wave_k, D, D, D, S, E);
    }
    GRID_BAR();

    if (PH(6)) {
        PHASE_VARS
        SchedPlain S{(const GAS char*)YG, (const GAS char*)WO, (size_t)256 * VW * 2, (size_t)256 * VW * 2, T / 256, 4, G, bx};
        EpiResF32 E{x, hres};
        pg8::gemm_phase<EpiResF32, SchedPlain, false>(lds, wave_k, VW, VW, VW, S, E);
    }
    GRID_BAR();

    if (PH(7)) {
        PHASE_VARS
        for (int m = gw; m < T; m += NGW) { f32x4 v[4]; rms_row(hres + (size_t)m * D, ffn_norm, HN + (size_t)m * D, lane, v); }
        LAS float* scr = (LAS float*)(lds + wave * 16384);
        constexpr int I_GU = 2 * (D / 64) * (FFE / 32), I_D = (FFE / 64) * (D / 32);
        for (int it = gw; it < NE * (I_GU + I_D); it += NGW) {
            const int e = it / (I_GU + I_D); int r = it - e * (I_GU + I_D);
            if (r < I_GU) tr_gu(m_wg + (size_t)e * D * FFE, m_wu + (size_t)e * D * FFE, D, FFE, WMGU + (size_t)e * 2 * FFE * D, r, scr, lane);
            else tr_plain(m_wd + (size_t)e * FFE * D, FFE, D, WMD + (size_t)e * D * FFE, r - I_GU, scr, lane);
        }
    }
    GRID_BAR();

    if (PH(8)) {
        PHASE_VARS
        SchedPlain S{(const GAS char*)HN, (const GAS char*)WGU, (size_t)256 * D * 2, (size_t)256 * D * 2, T / 256, 2 * FFD / 256, G, bx};
        EpiSwiGLU E{ACTD, FFD};
        pg8::gemm_phase<EpiSwiGLU, SchedPlain, false>(lds, wave_k, D, D, D, S, E);
    }
    GRID_BAR();
    if (PH(9)) {
        PHASE_VARS
        SchedPlain S{(const GAS char*)ACTD, (const GAS char*)WD, (size_t)256 * FFD * 2, (size_t)256 * FFD * 2, T / 256, 4, G, bx};
        EpiResF32 E{hres, hres};
        pg8::gemm_phase<EpiResF32, SchedPlain, false>(lds, wave_k, FFD, FFD, FFD, S, E);
    }
    GRID_BAR();

    if (PH(10)) {
        PHASE_VARS
        for (int m = gw; m < T; m += NGW) { f32x4 v[4]; rms_row(hres + (size_t)m * D, mix_norm + D, HN + (size_t)m * D, lane, v); }
        for (int e = vcu * 512 + tid; e < 512 * 1024; e += G * 512) { const int ka = e >> 10, c = e & 1023, a = c & 511, mm = (a * ka) & 511;
            const float v = (c < 512 ? cospif((float)mm * (1.0f / 256.0f)) : sinpif((float)mm * (1.0f / 256.0f))) * (1.0f / 1024.0f); WSEQ[e] = (bf16)(cvt_pk_bf16(v, 0.f) & 0xffffu); }
    }
    GRID_BAR();

    if (PH(11)) {
        PHASE_VARS
        SchedFnA S{(const GAS char*)WC, (const GAS char*)HN, G, bx};
        EpiZ2 E{Z2};
        pg8::gemm_phase<EpiZ2, SchedFnA, false>(lds, wave_k, 256, D, 256, S, E);
    }
    GRID_BAR();
    if (PH(22)) {
        PHASE_VARS
        float wc0[8], ws0[8];
#pragma unroll
        for (int kb = 0; kb < 8; ++kb) { const float ang = (float)((8 * lane * kb) & 4095) * (1.0f / 2048.0f); wc0[kb] = cospif(ang); ws0[kb] = sinpif(ang); }
        for (int rw = gw; rw < NB * 1024; rw += NGW) {
            GAS bf16* row = Z2 + (size_t)rw * 8192;
#pragma unroll
            for (int hq = 0; hq < 2; ++hq) {
                u32x2 zin[2][8], zout[8][2];
#pragma unroll
                for (int ri = 0; ri < 2; ++ri)
#pragma unroll
                    for (int bb = 0; bb < 8; ++bb) zin[ri][bb] = *(const GAS u32x2*)(row + ri * 4096 + 512 * bb + 8 * lane + 4 * hq);
#pragma unroll
                for (int q = 0; q < 2; ++q) {
                    float outr[2][8], outi[2][8];
#pragma unroll
                    for (int tt = 0; tt < 2; ++tt) {
                        const int t = 4 * hq + 2 * q + tt;
                        float zr[8], zi[8];
#pragma unroll
                        for (int bb = 0; bb < 8; ++bb) { const unsigned wr_ = zin[0][bb][q], wi_ = zin[1][bb][q]; zr[bb] = tt ? bf_hi(wr_) : bf_lo(wr_); zi[bb] = tt ? bf_hi(wi_) : bf_lo(wi_); }
#pragma unroll
                        for (int kb = 0; kb < 8; ++kb) {
                            float ur = 0.f, ui = 0.f;
#pragma unroll
                            for (int bb = 0; bb < 8; ++bb) {
                                const int m8 = (bb * kb) & 7;
                                const float c8 = (m8 == 0) ? 1.f : (m8 == 4) ? -1.f : (m8 == 2 || m8 == 6) ? 0.f : (m8 == 1 || m8 == 7) ? 0.70710678118654752f : -0.70710678118654752f;
                                const float s8 = (m8 == 0 || m8 == 4) ? 0.f : (m8 == 2) ? 1.f : (m8 == 6) ? -1.f : (m8 == 1 || m8 == 3) ? 0.70710678118654752f : -0.70710678118654752f;
                                ur += c8 * zr[bb] + s8 * zi[bb]; ui += c8 * zi[bb] - s8 * zr[bb]; }
                            const int mt = (t * kb);
                            const float ct = __builtin_cosf((float)mt * 0.00153398078788564123f), st_ = __builtin_sinf((float)mt * 0.00153398078788564123f);
                            const float twc = wc0[kb] * ct - ws0[kb] * st_, tws = ws0[kb] * ct + wc0[kb] * st_;
                            outr[tt][kb] = ur * twc + ui * tws; outi[tt][kb] = ui * twc - ur * tws; }
                    }
#pragma unroll
                    for (int kb = 0; kb < 8; ++kb) { zout[kb][0][q] = cvt_pk_bf16(outr[0][kb], outr[1][kb]); zout[kb][1][q] = cvt_pk_bf16(outi[0][kb], outi[1][kb]); }
                    __builtin_amdgcn_sched_barrier(0);
                }
#pragma unroll
                for (int kb = 0; kb < 8; ++kb)
#pragma unroll
                    for (int ri = 0; ri < 2; ++ri) *(GAS u32x2*)(row + kb * 1024 + ri * 512 + 8 * lane + 4 * hq) = zout[kb][ri];
                __builtin_amdgcn_sched_barrier(0);
            }
        }
    }
    GRID_BAR();
    if (PH(12)) {
        PHASE_VARS
        SchedFnB S{(GAS const char*)WSEQ, (GAS const char*)Z2, G, bx};
        EpiYf E{HN};
        pg8::gemm_phase<EpiYf, SchedFnB, false>(lds, wave_k, 1024, 1024, 1024, S, E);
    }
    GRID_BAR();
    if (PH(13)) {
        PHASE_VARS
        SchedPlain S{(const GAS char*)HN, (const GAS char*)WF, (size_t)256 * D * 2, (size_t)256 * D * 2, T / 256, 4, G, bx};
        EpiResF32 E{hres, hres};
        pg8::gemm_phase<EpiResF32, SchedPlain, false>(lds, wave_k, D, D, D, S, E);
    }
    GRID_BAR();

    if (PH(14)) {
        PHASE_VARS
        LAS float* wrl = (LAS float*)lds;
        LAS int* le = (LAS int*)(lds + 32768);
        for (int i = tid; i < D * NE / 4; i += NWAVES * 64) ((LAS f32x4*)wrl)[i] = ((const GAS f32x4*)moe_router)[i];
        for (int i = vcu * 512 + tid; i < 2 * MOE_ROWS; i += G * 512) rowtok[i] = -1;
        __syncthreads();
        for (int tb = vcu; tb < T / 128; tb += G) {
            for (int rr = 0; rr < 16; ++rr) { const int tl = wave * 16 + rr, m = tb * 128 + tl; f32x4 v[4];
                rms_row(hres + (size_t)m * D, ffn_norm + D, HN + (size_t)m * D, lane, v);
                float lg[8];
#pragma unroll
                for (int e = 0; e < 8; ++e) lg[e] = 0.f;
#pragma unroll
                for (int j = 0; j < 4; ++j)
#pragma unroll
                    for (int c = 0; c < 4; ++c) { const int col = 256 * j + 4 * lane + c; const f32x4 w0 = *(const LAS f32x4*)(wrl + col * 8), w1 = *(const LAS f32x4*)(wrl + col * 8 + 4); const float xv = v[j][c];
                        lg[0] += xv * w0.x; lg[1] += xv * w0.y; lg[2] += xv * w0.z; lg[3] += xv * w0.w; lg[4] += xv * w1.x; lg[5] += xv * w1.y; lg[6] += xv * w1.z; lg[7] += xv * w1.w; }
#pragma unroll
                for (int e = 0; e < 8; ++e) lg[e] = wave_sum(lg[e]);
                int e0 = 0; float b0 = lg[0];
#pragma unroll
                for (int e = 1; e < 8; ++e) if (lg[e] > b0) { b0 = lg[e]; e0 = e; }
                int e1 = -1; float b1 = -3.0e38f;
#pragma unroll
                for (int e = 0; e < 8; ++e) if (e != e0 && lg[e] > b1) { b1 = lg[e]; e1 = e; }
                const float w0 = 1.0f / (1.0f + __expf(b1 - b0));
                if (lane == 0) { toke[2 * m] = e0; toke[2 * m + 1] = e1; tokw[2 * m] = w0; tokw[2 * m + 1] = 1.0f - w0; le[tl] = e0; le[128 + tl] = e1; } }
            __syncthreads();
            if (tid < 16) { const int s = tid >> 3, e = tid & 7; int c = 0; for (int i = 0; i < 128; ++i) c += (le[s * 128 + i] == e) ? 1 : 0; bcnt[tb * 16 + tid] = c; }
            __syncthreads();
        }
    }
    GRID_BAR();

    LAS int* segoff = (LAS int*)(lds + 132096);
    LAS int* ntile = (LAS int*)(lds + 132096 + 64);
    LAS unsigned char* tile_e = (LAS unsigned char*)(lds + 132096 + 128);
    if (PH(15)) {
        PHASE_VARS
        LAS int* pre = (LAS int*)lds;
        LAS int* tot = (LAS int*)(lds + 16384);
        LAS int* wc0 = (LAS int*)(lds + 16384 + 64);
        for (int i = tid; i < 256 * 16; i += NWAVES * 64) pre[i] = bcnt[i];
        __syncthreads();
        if (tid < 16) { int run = 0; for (int b2 = 0; b2 < 256; ++b2) { const int c = pre[b2 * 16 + tid]; pre[b2 * 16 + tid] = run; run += c; } tot[tid] = run; }
        __syncthreads();
        if (tid < 2) { int off = 0, nt = 0; for (int e = 0; e < 8; ++e) { segoff[tid * 8 + e] = off; const int tl = (tot[tid * 8 + e] + 255) >> 8; for (int q = 0; q < tl; ++q) tile_e[tid * 160 + nt + q] = (unsigned char)e; nt += tl; off += tl * 256; } ntile[tid] = nt; }
        __syncthreads();
        for (int tb = vcu; tb < T / 128; tb += G) {
            int ee[2] = {0, 0}, rk[2] = {0, 0};
            if (tid < 128) { const int m = tb * 128 + tid;
#pragma unroll
                for (int s = 0; s < 2; ++s) { const int e = toke[2 * m + s]; ee[s] = e;
#pragma unroll
                    for (int q = 0; q < 8; ++q) { const unsigned long long mk = __ballot(e == q); if (e == q) rk[s] = __popcll(mk & ((1ull << lane) - 1ull)); if (wave == 0 && lane == 0) wc0[s * 8 + q] = __popcll(mk); } } }
            __syncthreads();
            if (tid < 128) { const int m = tb * 128 + tid;
#pragma unroll
                for (int s = 0; s < 2; ++s) { const int e = ee[s]; const int rank = rk[s] + (wave == 1 ? wc0[s * 8 + e] : 0);
                    const int row = segoff[s * 8 + e] + pre[tb * 16 + s * 8 + e] + rank;
                    rowtok[s * MOE_ROWS + row] = m; rowgate[s * MOE_ROWS + row] = tokw[2 * m + s]; } }
            __syncthreads();
        }
    }
    GRID_BAR();

    if (PH(16))
#pragma unroll
    for (int s = 0; s < 2; ++s) {
        {
            PHASE_VARS
            SchedMoe S{(const GAS char*)HN, (const GAS char*)WMGU, rowtok + s * MOE_ROWS, tile_e + s * 160, 0, (size_t)2 * FFE * D * 2, (size_t)256 * D * 2, ntile[s], 2 * FFE / 256, G, bx, true};
            EpiSwiGLU E{ACTM, FFE};
            pg8::gemm_phase<EpiSwiGLU, SchedMoe, true>(lds, wave_k, D, D, D, S, E);
        }
        GRID_BAR();
        {
            PHASE_VARS
            SchedMoe S{(const GAS char*)ACTM, (const GAS char*)WMD, rowtok + s * MOE_ROWS, tile_e + s * 160, (size_t)256 * FFE * 2, (size_t)D * FFE * 2, (size_t)256 * FFE * 2, ntile[s], 4, G, bx, false};
            EpiMoeDown E{hres, rowtok + s * MOE_ROWS, rowgate + s * MOE_ROWS};
            pg8::gemm_phase<EpiMoeDown, SchedMoe, false>(lds, wave_k, FFE, FFE, FFE, S, E);
        }
        GRID_BAR();
    }

    if (PH(17)) {
        PHASE_VARS
        const bool bad = __hip_atomic_load((GAS unsigned*)(ws + WS_CTL) + CW_BAR + XB_TMO, RLX_AGENT) != 0u;
        for (int m = gw; m < T; m += NGW) {
            GAS f32x4* xr = (GAS f32x4*)(hres + (size_t)m * D) + lane; const GAS f32x4* gr = (const GAS f32x4*)final_norm + lane;
            f32x4 v[4]; float s = 0.f;
#pragma unroll
            for (int j = 0; j < 4; ++j) { v[j] = xr[64 * j]; s += (v[j].x * v[j].x + v[j].y * v[j].y) + (v[j].z * v[j].z + v[j].w * v[j].w); }
            const float r = bad ? __builtin_nanf("") : 1.0f / sqrtf(wave_sum(s) * (1.f / D) + EPS);
#pragma unroll
            for (int j = 0; j < 4; ++j) xr[64 * j] = v[j] * r * gr[64 * j];
        }
    }
}

extern "C" void kernel_launch(void* const* d_in, const int* in_sizes, int n_in, void* d_out, int out_size, void* d_ws, size_t ws_size, hipStream_t stream) {
    static int grid = 0;
    if (grid == 0) {
        if (n_in != 16 || in_sizes[0] != T * D || out_size != T * D || ws_size < WS_END) { fprintf(stderr, "kernel_launch: unexpected shapes (n_in %d, in0 %d, out %d, ws %zu)\n", n_in, n_in > 0 ? in_sizes[0] : -1, out_size, ws_size); grid = -1; return; }
        int dev = 0, cus = 0, per_cu = 0;
        if (hipGetDevice(&dev) != hipSuccess || hipDeviceGetAttribute(&cus, hipDeviceAttributeMultiprocessorCount, dev) != hipSuccess) { grid = -1; return; }
        if (hipFuncSetAttribute((const void*)fwd_kernel, hipFuncAttributeMaxDynamicSharedMemorySize, LDS_BYTES) != hipSuccess) { fprintf(stderr, "kernel_launch: hipFuncSetAttribute failed\n"); grid = -1; return; }
        if (hipOccupancyMaxActiveBlocksPerMultiprocessor(&per_cu, (const void*)fwd_kernel, NWAVES * 64, LDS_BYTES) != hipSuccess || per_cu < 1) { fprintf(stderr, "kernel_launch: occupancy query says %d\n", per_cu); }
        (void)hipGetLastError();
        grid = cus;
    }
    if (grid < 0) return;
    if (hipMemsetAsync((char*)d_ws + WS_CTL, 0, CTL_ZERO_BYTES, stream) != hipSuccess) return;
    Args a{};
    for (int i = 0; i < 16; ++i) a.in[i] = (const float*)d_in[i];
    a.out = (float*)d_out; a.ws = (unsigned char*)d_ws;
    hipLaunchKernelGGL(fwd_kernel, dim3(grid), dim3(NWAVES * 64), LDS_BYTES, stream, a);
}
```

```cpp
#include <hip/hip_runtime.h>
#include <cstdio>
#include <cstdint>

#define LAS __attribute__((address_space(3)))
#define GAS __attribute__((address_space(1)))
typedef unsigned short bf16;
typedef short bf16x8 __attribute__((ext_vector_type(8)));
typedef float f32x2 __attribute__((ext_vector_type(2)));
typedef float f32x4 __attribute__((ext_vector_type(4)));
typedef float f32x16 __attribute__((ext_vector_type(16)));
typedef unsigned u32x2 __attribute__((ext_vector_type(2)));
typedef unsigned u32x4 __attribute__((ext_vector_type(4)));
typedef GAS unsigned gu32;

constexpr int D = 1024, NB = 8, SEQ = 4096, T = NB * SEQ;
constexpr int NH = 4, DK = 256, DV = 512, QKW = 1024, VW = 2048, INW = 6144, CH = 128, NCH = SEQ / CH;
constexpr int FFD = 2816, NE = 8, FFE = 3584;
constexpr int MOE_ROWS = T + NE * 256;
constexpr float EPS = 1e-6f;

constexpr size_t MiB = 1u << 20;
constexpr size_t WS_CTL = 0, CTL_ZERO_BYTES = 1 * MiB;
constexpr size_t WS_ROT = 1 * MiB, WS_ROTT = 5 * MiB, WS_WC = 9 * MiB;
constexpr size_t WS_TOKE = 9 * MiB + 256 * 1024;
constexpr size_t WS_TOKW = WS_TOKE + 256 * 1024;
constexpr size_t WS_BCNT = WS_TOKW + 256 * 1024;
constexpr size_t WS_ROWTOK = WS_BCNT + 16 * 1024;
constexpr size_t WS_ROWGATE = WS_ROWTOK + 2 * MOE_ROWS * 4;
constexpr size_t WS_PCNT = 10 * MiB + 512 * 1024;
constexpr size_t WS_STATS = 11 * MiB;
static_assert(WS_ROWGATE + 2 * MOE_ROWS * 4 <= WS_PCNT, "small tables");
constexpr size_t WS_WIN = 12 * MiB, WS_WO = 24 * MiB, WS_WGU = 28 * MiB, WS_WD = 39 * MiB, WS_WF = 44 * MiB + 512 * 1024;
constexpr size_t WS_HN = 48 * MiB;
constexpr size_t WS_Q = 112 * MiB, WS_K = 176 * MiB, WS_KT = 240 * MiB  , WS_VT = 368 * MiB, WS_PC = 496 * MiB;
constexpr size_t WS_YG = 240 * MiB;
constexpr size_t WS_STATP = 176 * MiB;
constexpr size_t WS_ACTD = 112 * MiB;
constexpr size_t WS_Z2 = 112 * MiB, WS_WSEQ = 240 * MiB;
constexpr size_t WS_ACTM = 112 * MiB;
constexpr size_t WS_WMGU = 352 * MiB, WS_WMD = 464 * MiB, WS_END = 528 * MiB;
static_assert(WS_ACTM + (size_t)MOE_ROWS * FFE * 2 <= WS_WMGU, "moe act");
static_assert(WS_PC + (size_t)NB * NH * NCH * CH * CH * 2 <= 528 * MiB, "epoch A");
static_assert(WS_WF + (size_t)D * D * 2 <= WS_HN, "weights");
constexpr int CW_BAR = 4096;
constexpr int CW_CHK = 64;

constexpr int RING_BYTES = 131072;
constexpr int LDSCTL_OFF = 139264, MISC_OFF = LDSCTL_OFF + 320;
constexpr int LDS_BYTES = 147456;

#define LDS_WAIT() asm volatile("s_waitcnt lgkmcnt(0)" ::: "memory")
#define VM_WAIT() asm volatile("s_waitcnt vmcnt(0)" ::: "memory")
#define RLX_AGENT __ATOMIC_RELAXED, __HIP_MEMORY_SCOPE_AGENT

__device__ __forceinline__ unsigned cvt_pk_bf16(float lo, float hi) { unsigned r; asm volatile("v_cvt_pk_bf16_f32 %0, %1, %2" : "=v"(r) : "v"(lo), "v"(hi)); return r; }
__device__ __forceinline__ float bf_lo(unsigned w) { return __uint_as_float(w << 16); }
__device__ __forceinline__ float bf_hi(unsigned w) { return __uint_as_float(w & 0xffff0000u); }
__device__ __forceinline__ float fast_exp2(float x) { return __builtin_amdgcn_exp2f(x); }
__device__ __forceinline__ int lane_id_v() { int l; asm volatile("v_mbcnt_lo_u32_b32 %0, -1, 0\n\tv_mbcnt_hi_u32_b32 %0, -1, %0" : "=v"(l)); return l; }
__device__ __forceinline__ int tid_of(int wave_s) { asm volatile("" : "+s"(wave_s)); return wave_s * 64 + lane_id_v(); }
__device__ __forceinline__ int rot_col(int row, int tok) { return (tok + ((row & 15) << 11)) & (32768 - 1); }
__device__ __forceinline__ float silu_f(float v) { return v / (1.0f + __expf(-v)); }

namespace pg8 {
constexpr int BM = 256, BK = 64, HALF = 128, HTB = HALF * BK * 2, STAGE_BYTES = 8 * HTB, NXCD = 8, WGM = 8;
__host__ __device__ __forceinline__ int lds_byte(int r, int c) { const int st = (r >> 4) * 2 + (c >> 5), rr = r & 15, cc = c & 31, ob = rr * 64 + cc * 2; return st * 1024 + (ob ^ (((ob >> 9) & 1) << 5)); }
__host__ __device__ __forceinline__ void stage_rc(int b, int& R, int& C) { const int st = b / 1024, sb = b % 1024, swz = sb ^ (((sb >> 9) & 1) << 5); R = (st >> 1) * 16 + swz / 64; C = (st & 1) * 32 + (swz % 64) / 2; }
__host__ __device__ __forceinline__ int perm32(int rho) { const int n = rho >> 4, i = rho & 15; return 8 * (i >> 2) + 4 * n + (i & 3); }

struct Unit { const GAS char* A; const GAS char* B; const GAS int* rows; int pm, pn, z; };

__device__ __forceinline__ bool tile_of(long L, int nM, int nN, int& pm, int& pn) {
    const int nwg = nM * nN; if (L >= nwg) return false;
    int wgid = (int)L; { const int q = nwg / NXCD, r = nwg % NXCD, xcd = wgid % NXCD, off = wgid / NXCD; wgid = (xcd < r ? xcd * (q + 1) : r * (q + 1) + (xcd - r) * q) + off; }
    const int nig = WGM * nN, gid = wgid / nig, fm = gid * WGM, gsz = (nM - fm) < WGM ? (nM - fm) : WGM;
    pm = fm + ((wgid % nig) % gsz); pn = (wgid % nig) / gsz; return true;
}

template <class Epi, class Sched, bool GATHER>
__device__ __forceinline__ void gemm_phase(LAS unsigned char* lds, const int wave_s, const int lda, const int ldb, const int K, const Sched& S, const Epi& E) {
    const int tid = tid_of(wave_s);
    const int wid = __builtin_amdgcn_readfirstlane(tid >> 6), lane = tid & 63, wr = wid >> 2, wc = wid & 3, fr = lane & 15, fq = lane >> 4;
    const int nt = K / BK;
    unsigned vA[2][2], vAn[2][2], voffB[2];
#pragma unroll
    for (int i = 0; i < 2; ++i) { int R, C; stage_rc(tid * 16 + i * 8192, R, C); const int Rb = Epi::PERM ? ((R & ~31) + perm32(R & 31)) : R;
        voffB[i] = (unsigned)(S.brow(Rb) * ldb + C) * 2u;
#pragma unroll
        for (int h = 0; h < 2; ++h) { vA[h][i] = (unsigned)((h * HALF + R) * lda + C) * 2u; vAn[h][i] = vA[h][i]; } }
    const size_t kstep = (size_t)(BK * 2);
    const size_t hstepB = (size_t)(S.brow(HALF) - S.brow(0)) * ldb * 2;
    const unsigned ldsw = (unsigned)wid * 1024u;
    const int aoff = lds_byte(wr * 64 + fr, fq * 8), boff = lds_byte(wc * 32 + fr, fq * 8);
#define PG8_SA(b, h) (((b) * 2 + (h)) * HTB)
#define PG8_SB(b, h) ((4 + (b) * 2 + (h)) * HTB)
#define PG8_STAGE_B(bufoff, gbase) do { _Pragma("unroll") for (int _i = 0; _i < 2; ++_i) \
        __builtin_amdgcn_global_load_lds((const GAS unsigned*)((const GAS char*)(gbase) + voffB[_i]), (LAS unsigned*)(lds + (bufoff) + ldsw + _i * 8192), 16, 0, 0); } while (0)
#define PG8_STAGE_A(bufoff, gbase, v0, v1) do { \
        __builtin_amdgcn_global_load_lds((const GAS unsigned*)((const GAS char*)(gbase) + (v0)), (LAS unsigned*)(lds + (bufoff) + ldsw), 16, 0, 0); \
        __builtin_amdgcn_global_load_lds((const GAS unsigned*)((const GAS char*)(gbase) + (v1)), (LAS unsigned*)(lds + (bufoff) + ldsw + 8192), 16, 0, 0); } while (0)
#define PG8_LDA(dst, b, h) do { _Pragma("unroll") for (int m = 0; m < 4; ++m) _Pragma("unroll") for (int k = 0; k < 2; ++k) dst[m][k] = *(const LAS bf16x8*)(lds + PG8_SA(b, h) + aoff + m * 2048 + k * 1024); } while (0)
#define PG8_LDB(dst, b, h) do { _Pragma("unroll") for (int n = 0; n < 2; ++n) _Pragma("unroll") for (int k = 0; k < 2; ++k) dst[n][k] = *(const LAS bf16x8*)(lds + PG8_SB(b, h) + boff + n * 2048 + k * 1024); } while (0)
#define PG8_MMA(ai, bj, At, Bt) do { __builtin_amdgcn_s_setprio(1); _Pragma("unroll") for (int m = 0; m < 4; ++m) _Pragma("unroll") for (int n = 0; n < 2; ++n) _Pragma("unroll") for (int k = 0; k < 2; ++k) \
        acc[ai][bj][m][n] = __builtin_amdgcn_mfma_f32_16x16x32_bf16(Bt[n][k], At[m][k], acc[ai][bj][m][n], 0, 0, 0); __builtin_amdgcn_s_setprio(0); } while (0)
#define PG8_WAIT_V(n) asm volatile("s_waitcnt vmcnt(" #n ")" ::: "memory")
#define PG8_WAIT_L(n) asm volatile("s_waitcnt lgkmcnt(" #n ")" ::: "memory")
#define PG8_BAR __builtin_amdgcn_s_barrier()
#define PG8_SCHED __builtin_amdgcn_sched_barrier(0)
#define PG8_LOADROWS(dst, u) do { if constexpr (GATHER) { const int _tz = tid_of(wave_s); _Pragma("unroll") for (int _i = 0; _i < 2; ++_i) { int _R, _C; stage_rc(_tz * 16 + _i * 8192, _R, _C); \
        _Pragma("unroll") for (int _h = 0; _h < 2; ++_h) { const int _t = (u).rows[_h * HALF + _R]; dst[_h][_i] = (unsigned)((_t < 0 ? 0 : _t) * lda + _C) * 2u; } } } } while (0)
#define PG8_VAN(h, i) (GATHER ? vAn[h][i] : vA[h][i])
    Unit cur, nxt; int ui = 0;
    if (!S.next(0, cur)) return;
    f32x4 acc[2][2][4][2];
#pragma unroll
    for (int a = 0; a < 2; ++a)
#pragma unroll
        for (int b = 0; b < 2; ++b)
#pragma unroll
            for (int m = 0; m < 4; ++m)
#pragma unroll
                for (int n = 0; n < 2; ++n) acc[a][b][m][n] = (f32x4){0.f, 0.f, 0.f, 0.f};
    bf16x8 At[4][2], B0[2][2], B1[2][2];
    const GAS char* cA = cur.A; const GAS char* cB = cur.B;
    PG8_LOADROWS(vA, cur);
    if constexpr (GATHER) { vAn[0][0] = vA[0][0]; vAn[0][1] = vA[0][1]; vAn[1][0] = vA[1][0]; vAn[1][1] = vA[1][1]; }
    PG8_STAGE_B(PG8_SB(0, 0), cB); PG8_STAGE_B(PG8_SB(0, 1), cB + hstepB); PG8_STAGE_A(PG8_SA(0, 0), cA, vA[0][0], vA[0][1]); PG8_STAGE_A(PG8_SA(0, 1), cA, vA[1][0], vA[1][1]);
    if (wr == 1) PG8_BAR;
    PG8_WAIT_V(2); PG8_BAR;
    PG8_STAGE_B(PG8_SB(1, 0), cB + kstep); PG8_STAGE_A(PG8_SA(1, 0), cA + kstep, vA[0][0], vA[0][1]); PG8_STAGE_B(PG8_SB(1, 1), cB + hstepB + kstep);
    PG8_WAIT_V(6); PG8_BAR;
    for (;;) {
        const bool has_next = S.next(ui + 1, nxt);
        const GAS char* nA = has_next ? nxt.A : cA; const GAS char* nB = has_next ? nxt.B : cB;
#pragma unroll 1
        for (int t = 0; t < nt; t += 2) {
            const bool last = (t == nt - 2);
            const GAS char* a1 = cA + (size_t)(t + 1) * kstep;
            const GAS char* a2 = last ? nA : cA + (size_t)(t + 2) * kstep; const GAS char* b2 = last ? nB : cB + (size_t)(t + 2) * kstep;
            const GAS char* a3 = a2 + kstep; const GAS char* b3 = b2 + kstep;
            if constexpr (GATHER) { if (last && has_next) { PG8_LOADROWS(vAn, nxt); } }
            PG8_LDB(B0, 0, 0); PG8_LDB(B1, 0, 1); PG8_SCHED; PG8_LDA(At, 0, 0); PG8_STAGE_A(PG8_SA(1, 1), a1, vA[1][0], vA[1][1]);
            PG8_WAIT_V(8); PG8_WAIT_L(0); PG8_BAR; PG8_MMA(0, 0, At, B0); PG8_MMA(0, 1, At, B1); PG8_BAR; PG8_SCHED;
            PG8_LDA(At, 0, 1); PG8_STAGE_B(PG8_SB(0, 0), b2); PG8_STAGE_B(PG8_SB(0, 1), b2 + hstepB); PG8_STAGE_A(PG8_SA(0, 0), a2, PG8_VAN(0, 0), PG8_VAN(0, 1));
            PG8_WAIT_V(8); PG8_WAIT_L(0); PG8_BAR; PG8_MMA(1, 0, At, B0); PG8_MMA(1, 1, At, B1); PG8_BAR; PG8_SCHED;
            PG8_LDB(B0, 1, 0); PG8_LDB(B1, 1, 1); PG8_SCHED; PG8_LDA(At, 1, 0); PG8_STAGE_A(PG8_SA(0, 1), a2, PG8_VAN(1, 0), PG8_VAN(1, 1));
            PG8_WAIT_V(8); PG8_WAIT_L(0); PG8_BAR; PG8_MMA(0, 0, At, B0); PG8_MMA(0, 1, At, B1); PG8_BAR; PG8_SCHED;
            PG8_LDA(At, 1, 1); PG8_STAGE_B(PG8_SB(1, 0), b3); PG8_STAGE_B(PG8_SB(1, 1), b3 + hstepB); PG8_STAGE_A(PG8_SA(1, 0), a3, PG8_VAN(0, 0), PG8_VAN(0, 1));
            PG8_WAIT_V(8); PG8_WAIT_L(0); PG8_BAR; PG8_MMA(1, 0, At, B0); PG8_MMA(1, 1, At, B1); PG8_BAR; PG8_SCHED;
        }
        if (wr == 0) PG8_BAR;
        E(acc, cur, wr, wc, fr, fq);
        if (!has_next) break;
#pragma unroll
        for (int a = 0; a < 2; ++a)
#pragma unroll
            for (int b = 0; b < 2; ++b)
#pragma unroll
                for (int m = 0; m < 4; ++m)
#pragma unroll
                    for (int n = 0; n < 2; ++n) acc[a][b][m][n] = (f32x4){0.f, 0.f, 0.f, 0.f};
        cur = nxt; cA = nA; cB = nB; ++ui;
        if constexpr (GATHER) { vA[0][0] = vAn[0][0]; vA[0][1] = vAn[0][1]; vA[1][0] = vAn[1][0]; vA[1][1] = vAn[1][1]; }
        if (wr == 1) PG8_BAR;
    }
    PG8_WAIT_V(0);
    PG8_BAR;
#undef PG8_SA
#undef PG8_SB
#undef PG8_STAGE_A
#undef PG8_STAGE_B
#undef PG8_LDA
#undef PG8_LDB
#undef PG8_MMA
#undef PG8_WAIT_V
#undef PG8_WAIT_L
#undef PG8_BAR
#undef PG8_SCHED
#undef PG8_LOADROWS
#undef PG8_VAN
}
}

struct SchedPlain {
    __device__ __forceinline__ int brow(int r) const { return r; }
    const GAS char* A; const GAS char* B; size_t a_tile, b_tile; int nM, nN, G, c;
    __device__ __forceinline__ bool next(int i, pg8::Unit& u) const {
        int pm, pn; if (!pg8::tile_of((long)i * G + c, nM, nN, pm, pn)) return false;
        u.pm = pm; u.pn = pn; u.z = 0; u.rows = nullptr; u.A = A + (size_t)pm * a_tile; u.B = B + (size_t)pn * b_tile; return true; }
};
struct SchedPc {
    __device__ __forceinline__ int brow(int r) const { return r; }
    const GAS char* Q; const GAS char* Kk; int G, c;
    __device__ __forceinline__ bool next(int i, pg8::Unit& u) const {
        const int L = i * G + c; if (L >= NB * NH * 16) return false;
        const int cp = L & 15, h = (L >> 4) & 3, b = L >> 6;
        const size_t off = ((size_t)(b * SEQ + cp * 256) * QKW + h * DK) * 2;
        u.pm = L; u.pn = 0; u.z = h; u.rows = nullptr; u.A = Q + off; u.B = Kk + off; return true; }
};
struct SchedFnA {
    __device__ __forceinline__ int brow(int r) const { return r; }
    const GAS char* Wc; const GAS char* Hn; int G, c;
    __device__ __forceinline__ bool next(int i, pg8::Unit& u) const {
        int pm, pn; if (!pg8::tile_of((long)i * G + c, 8, T / 256, pm, pn)) return false;
        const int g = pm >> 1, ri = pm & 1;
        u.pm = pm; u.pn = pn; u.z = 0; u.rows = nullptr; u.A = Wc + (size_t)ri * 256 * 256 * 2; u.B = Hn + ((size_t)pn * 256 * D + g * 256) * 2; return true; }
};
struct SchedFnB {
    __device__ __forceinline__ int brow(int r) const { return (r & 63) * 8 + (r >> 6); }
    GAS const char* WY; GAS const char* U; int G, c;
    __device__ __forceinline__ bool next(int i, pg8::Unit& u) const {
        int pm, pn; if (!pg8::tile_of((long)i * G + c, 2, 256, pm, pn)) return false;
        const int batch = pn >> 5, fb = (pn >> 1) & 15, kbb = pn & 1;
        u.pm = pm; u.pn = pn; u.z = 0; u.rows = nullptr; u.A = WY + (size_t)pm * 256 * 1024 * 2; u.B = U + ((size_t)(batch * 1024 + fb * 64) * 8 + kbb * 4) * 1024 * 2; return true; }
};
struct SchedMoe {
    __device__ __forceinline__ int brow(int r) const { return r; }
    const GAS char* A; const GAS char* W; const GAS int* rowtok; const LAS unsigned char* texp; size_t a_tile, w_exp, w_tile; int ntiles, ncol, G, c; bool gather;
    __device__ __forceinline__ bool next(int i, pg8::Unit& u) const {
        int rt, ct; if (!pg8::tile_of((long)i * G + c, ntiles, ncol, rt, ct)) return false;
        const int e = texp[rt];
        u.pm = rt; u.pn = ct; u.z = e; u.rows = rowtok + rt * 256; u.A = gather ? A : A + (size_t)rt * a_tile; u.B = W + (size_t)e * w_exp + (size_t)ct * w_tile; return true; }
};

struct EpiRopeQK {
    static constexpr bool PERM = true;
    GAS bf16* Q; GAS bf16* Kk; const GAS f32x2* rot;
    __device__ __forceinline__ void operator()(const f32x4 (&acc)[2][2][4][2], const pg8::Unit& u, int wr, int wc, int fr, int fq) const {
        const bool isk = u.pn >= 4; const int h = u.pn & 3; GAS bf16* dst = isk ? Kk : Q; const float sc = isk ? 0.0625f : 1.0f;
        const int i0 = wc * 32 + 8 * fq;
#pragma unroll
        for (int ai = 0; ai < 2; ++ai)
#pragma unroll
            for (int m = 0; m < 4; ++m) {
                const int t = u.pm * 256 + ai * 128 + wr * 64 + m * 16 + fr, s = t & (SEQ - 1);
                const GAS f32x4* rp = (const GAS f32x4*)(rot + (size_t)s * 128 + i0);
                const f32x4 r0 = rp[0], r1 = rp[1], r2 = rp[2], r3 = rp[3];
                const float cs[8] = {r0[0], r0[2], r1[0], r1[2], r2[0], r2[2], r3[0], r3[2]}, sn[8] = {r0[1], r0[3], r1[1], r1[3], r2[1], r2[3], r3[1], r3[3]};
                float o1[8], o2[8];
#pragma unroll
                for (int n = 0; n < 2; ++n)
#pragma unroll
                    for (int j = 0; j < 4; ++j) { const float t1 = acc[ai][0][m][n][j], t2 = acc[ai][1][m][n][j]; const int q = 4 * n + j;
                        o1[q] = (t1 * cs[q] - t2 * sn[q]) * sc; o2[q] = (t1 * sn[q] + t2 * cs[q]) * sc; }
                GAS bf16* rowp = dst + (size_t)t * QKW + h * DK + i0;
                u32x4 w1, w2; w1.x = cvt_pk_bf16(o1[0], o1[1]); w1.y = cvt_pk_bf16(o1[2], o1[3]); w1.z = cvt_pk_bf16(o1[4], o1[5]); w1.w = cvt_pk_bf16(o1[6], o1[7]);
                w2.x = cvt_pk_bf16(o2[0], o2[1]); w2.y = cvt_pk_bf16(o2[2], o2[3]); w2.z = cvt_pk_bf16(o2[4], o2[5]); w2.w = cvt_pk_bf16(o2[6], o2[7]);
                *(GAS u32x4*)rowp = w1; *(GAS u32x4*)(rowp + 128) = w2; }
    }
};
struct EpiRopeKT {
    static constexpr bool PERM = true;
    GAS bf16* KT; const GAS f32x2* rotT; const LAS float* l2g;
    __device__ __forceinline__ void operator()(const f32x4 (&acc)[2][2][4][2], const pg8::Unit& u, int wr, int wc, int fr, int fq) const {
        const int h = u.pm; const float l2f = l2g[h], l2b = l2g[4 + h];
#pragma unroll
        for (int bj = 0; bj < 2; ++bj) {
            const int tok0 = u.pn * 256 + bj * 128 + wc * 32 + 8 * fq, s0 = tok0 & (SEQ - 1), j0 = tok0 & (CH - 1);
            float zf[8], zb[8];
#pragma unroll
            for (int q = 0; q < 8; ++q) { zf[q] = fast_exp2((float)(CH - 1 - (j0 + q)) * l2f) * 0.0625f; zb[q] = fast_exp2((float)(j0 + q) * l2b) * 0.0625f; }
#pragma unroll
            for (int m = 0; m < 4; ++m) { const int i = wr * 64 + m * 16 + fr;
                const GAS f32x4* rp = (const GAS f32x4*)(rotT + (size_t)i * SEQ + s0);
                const f32x4 r0 = rp[0], r1 = rp[1], r2 = rp[2], r3 = rp[3];
                const float cs[8] = {r0[0], r0[2], r1[0], r1[2], r2[0], r2[2], r3[0], r3[2]}, sn[8] = {r0[1], r0[3], r1[1], r1[3], r2[1], r2[3], r3[1], r3[3]};
                float o1[8], o2[8];
#pragma unroll
                for (int n = 0; n < 2; ++n)
#pragma unroll
                    for (int j = 0; j < 4; ++j) { const float t1 = acc[0][bj][m][n][j], t2 = acc[1][bj][m][n][j]; const int q = 4 * n + j;
                        o1[q] = t1 * cs[q] - t2 * sn[q]; o2[q] = t1 * sn[q] + t2 * cs[q]; }
                u32x4 w1, w2;
                w1.x = cvt_pk_bf16(o1[0] * zf[0], o1[1] * zf[1]); w1.y = cvt_pk_bf16(o1[2] * zf[2], o1[3] * zf[3]); w1.z = cvt_pk_bf16(o1[4] * zf[4], o1[5] * zf[5]); w1.w = cvt_pk_bf16(o1[6] * zf[6], o1[7] * zf[7]);
                w2.x = cvt_pk_bf16(o2[0] * zf[0], o2[1] * zf[1]); w2.y = cvt_pk_bf16(o2[2] * zf[2], o2[3] * zf[3]); w2.z = cvt_pk_bf16(o2[4] * zf[4], o2[5] * zf[5]); w2.w = cvt_pk_bf16(o2[6] * zf[6], o2[7] * zf[7]);
                const int tokr = rot_col(i, tok0);
                *(GAS u32x4*)(KT + (size_t)(h * DK + i) * T + tokr) = w1; *(GAS u32x4*)(KT + (size_t)(h * DK + 128 + i) * T + tokr) = w2;
                w1.x = cvt_pk_bf16(o1[0] * zb[0], o1[1] * zb[1]); w1.y = cvt_pk_bf16(o1[2] * zb[2], o1[3] * zb[3]); w1.z = cvt_pk_bf16(o1[4] * zb[4], o1[5] * zb[5]); w1.w = cvt_pk_bf16(o1[6] * zb[6], o1[7] * zb[7]);
                w2.x = cvt_pk_bf16(o2[0] * zb[0], o2[1] * zb[1]); w2.y = cvt_pk_bf16(o2[2] * zb[2], o2[3] * zb[3]); w2.z = cvt_pk_bf16(o2[4] * zb[4], o2[5] * zb[5]); w2.w = cvt_pk_bf16(o2[6] * zb[6], o2[7] * zb[7]);
                *(GAS u32x4*)(KT + (size_t)QKW * T + (size_t)(h * DK + i) * T + tokr) = w1; *(GAS u32x4*)(KT + (size_t)QKW * T + (size_t)(h * DK + 128 + i) * T + tokr) = w2; } }
    }
};
template <bool ROT> struct EpiBf16 {
    static constexpr bool PERM = true;
    GAS bf16* O; int ldc;
    __device__ __forceinline__ void operator()(const f32x4 (&acc)[2][2][4][2], const pg8::Unit& u, int wr, int wc, int fr, int fq) const {
#pragma unroll
        for (int ai = 0; ai < 2; ++ai)
#pragma unroll
            for (int m = 0; m < 4; ++m) { const int row = u.pm * 256 + ai * 128 + wr * 64 + m * 16 + fr; GAS bf16* rowp = O + (size_t)row * ldc;
#pragma unroll
                for (int bj = 0; bj < 2; ++bj) { const f32x4 v0 = acc[ai][bj][m][0], v1 = acc[ai][bj][m][1]; const int col = u.pn * 256 + bj * 128 + wc * 32 + 8 * fq;
                    u32x4 w; w.x = cvt_pk_bf16(v0[0], v0[1]); w.y = cvt_pk_bf16(v0[2], v0[3]); w.z = cvt_pk_bf16(v1[0], v1[1]); w.w = cvt_pk_bf16(v1[2], v1[3]);
                    *(GAS u32x4*)(rowp + (ROT ? rot_col(row, col) : col)) = w; } }
    }
};
struct EpiPc {
    static constexpr bool PERM = true;
    GAS bf16* PC; GAS bf16* PD; const LAS float* l2g;
    __device__ __forceinline__ void operator()(const f32x4 (&acc)[2][2][4][2], const pg8::Unit& u, int wr, int wc, int fr, int fq) const {
        const int h = u.z; const float l2f = l2g[h], l2b = l2g[4 + h];
#pragma unroll
        for (int ai = 0; ai < 2; ++ai)
#pragma unroll
            for (int m = 0; m < 4; ++m) { const int il = wr * 64 + m * 16 + fr, jl0 = wc * 32 + 8 * fq; float o[8];
                const bool diag = (wc == 2 * wr + (m >> 1));
#pragma unroll
                for (int n = 0; n < 2; ++n)
#pragma unroll
                    for (int j = 0; j < 4; ++j) { const int dl = il - (jl0 + 4 * n + j); const float f = dl >= 0 ? fast_exp2((float)dl * l2f) : fast_exp2((float)(-dl) * l2b);
                        o[4 * n + j] = (ai == 0 ? acc[0][0][m][n][j] : acc[1][1][m][n][j]) * f; }
                if (diag) {
                    float ob[8];
#pragma unroll
                    for (int q = 0; q < 8; ++q) { const bool lower = (jl0 + q) <= il; ob[q] = lower ? 0.f : o[q]; o[q] = lower ? o[q] : 0.f; }
                    u32x4 wb; wb.x = cvt_pk_bf16(ob[0], ob[1]); wb.y = cvt_pk_bf16(ob[2], ob[3]); wb.z = cvt_pk_bf16(ob[4], ob[5]); wb.w = cvt_pk_bf16(ob[6], ob[7]);
                    *(GAS u32x4*)(PD + (((size_t)(u.pm * 2 + ai) * 4 + (il >> 5)) * 32 + (il & 31)) * 32 + (jl0 & 31)) = wb;
                }
                u32x4 w; w.x = cvt_pk_bf16(o[0], o[1]); w.y = cvt_pk_bf16(o[2], o[3]); w.z = cvt_pk_bf16(o[4], o[5]); w.w = cvt_pk_bf16(o[6], o[7]);
                *(GAS u32x4*)(PC + ((size_t)(u.pm * 2 + ai) * 128 + il) * 128 + jl0) = w; }
    }
};
struct EpiGate {
    static constexpr bool PERM = true;
    const GAS bf16* Y; GAS bf16* YG; const GAS f32x2* statp; const GAS float* gain;
    __device__ __forceinline__ void operator()(const f32x4 (&acc)[2][2][4][2], const pg8::Unit& u, int wr, int wc, int fr, int fq) const {
        const int head = u.pn >> 1, c0 = u.pn * 256 + wc * 32 + 8 * fq;
        f32x4 gv[2][2];
#pragma unroll
        for (int bj = 0; bj < 2; ++bj) { gv[bj][0] = *(const GAS f32x4*)(gain + c0 + bj * 128); gv[bj][1] = *(const GAS f32x4*)(gain + c0 + bj * 128 + 4); }
#pragma unroll
        for (int ai = 0; ai < 2; ++ai)
#pragma unroll
            for (int m = 0; m < 4; ++m) { const int t = u.pm * 256 + ai * 128 + wr * 64 + m * 16 + fr; f32x2 st;
                { const GAS f32x4* sp = (const GAS f32x4*)(statp + ((size_t)t * 4 + head) * 16); float a1 = 0.f, a2 = 0.f;
#pragma unroll
                  for (int k = 0; k < 8; ++k) { const f32x4 v = sp[k]; a1 += v[0] + v[2]; a2 += v[1] + v[3]; }
                  const float mu = a1 * (1.f / DV), var = fmaxf(a2 * (1.f / DV) - mu * mu, 0.f); st.x = mu; st.y = 1.0f / sqrtf(var + EPS); }
#pragma unroll
                for (int bj = 0; bj < 2; ++bj) { const size_t off = (size_t)t * VW + c0 + bj * 128; const u32x4 yv = *(const GAS u32x4*)(Y + off);
                    const float y[8] = {bf_lo(yv.x), bf_hi(yv.x), bf_lo(yv.y), bf_hi(yv.y), bf_lo(yv.z), bf_hi(yv.z), bf_lo(yv.w), bf_hi(yv.w)}; float o[8];
#pragma unroll
                    for (int n = 0; n < 2; ++n)
#pragma unroll
                        for (int j = 0; j < 4; ++j) { const int q = 4 * n + j; const float yn = (y[q] - st.x) * st.y * gv[bj][n][j]; o[q] = silu_f(acc[ai][bj][m][n][j]) * yn; }
                    u32x4 w; w.x = cvt_pk_bf16(o[0], o[1]); w.y = cvt_pk_bf16(o[2], o[3]); w.z = cvt_pk_bf16(o[4], o[5]); w.w = cvt_pk_bf16(o[6], o[7]);
                    *(GAS u32x4*)(YG + off) = w; } }
    }
};
struct EpiResF32 {
    static constexpr bool PERM = false;
    const GAS float* base; GAS float* out;
    __device__ __forceinline__ void operator()(const f32x4 (&acc)[2][2][4][2], const pg8::Unit& u, int wr, int wc, int fr, int fq) const {
#pragma unroll
        for (int ai = 0; ai < 2; ++ai)
#pragma unroll
            for (int m = 0; m < 4; ++m) { const size_t off = (size_t)(u.pm * 256 + ai * 128 + wr * 64 + m * 16 + fr) * D + u.pn * 256 + wc * 32 + 4 * fq;
#pragma unroll
                for (int bj = 0; bj < 2; ++bj)
#pragma unroll
                    for (int n = 0; n < 2; ++n) { const f32x4 bs = *(const GAS f32x4*)(base + off + bj * 128 + n * 16); *(GAS f32x4*)(out + off + bj * 128 + n * 16) = bs + acc[ai][bj][m][n]; } }
    }
};
struct EpiSwiGLU {
    static constexpr bool PERM = true;
    GAS bf16* ACT; int ldc;
    __device__ __forceinline__ void operator()(const f32x4 (&acc)[2][2][4][2], const pg8::Unit& u, int wr, int wc, int fr, int fq) const {
#pragma unroll
        for (int ai = 0; ai < 2; ++ai)
#pragma unroll
            for (int m = 0; m < 4; ++m) { float o[8];
#pragma unroll
                for (int n = 0; n < 2; ++n)
#pragma unroll
                    for (int j = 0; j < 4; ++j) o[4 * n + j] = silu_f(acc[ai][0][m][n][j]) * acc[ai][1][m][n][j];
                u32x4 w; w.x = cvt_pk_bf16(o[0], o[1]); w.y = cvt_pk_bf16(o[2], o[3]); w.z = cvt_pk_bf16(o[4], o[5]); w.w = cvt_pk_bf16(o[6], o[7]);
                *(GAS u32x4*)(ACT + (size_t)(u.pm * 256 + ai * 128 + wr * 64 + m * 16 + fr) * ldc + u.pn * 128 + wc * 32 + 8 * fq) = w; }
    }
};
struct EpiZ2 {
    static constexpr bool PERM = true;
    GAS bf16* Z2;
    __device__ __forceinline__ void operator()(const f32x4 (&acc)[2][2][4][2], const pg8::Unit& u, int wr, int wc, int fr, int fq) const {
        const int g = u.pm >> 1, ri = u.pm & 1;
#pragma unroll
        for (int ai = 0; ai < 2; ++ai)
#pragma unroll
            for (int m = 0; m < 4; ++m) { const int cp = ai * 128 + wr * 64 + m * 16 + fr;
#pragma unroll
                for (int bj = 0; bj < 2; ++bj) { const int tok0 = u.pn * 256 + bj * 128 + wc * 32 + 8 * fq, b = tok0 >> 12, s0 = tok0 & (SEQ - 1);
                    const f32x4 v0 = acc[ai][bj][m][0], v1 = acc[ai][bj][m][1];
                    u32x4 w; w.x = cvt_pk_bf16(v0[0], v0[1]); w.y = cvt_pk_bf16(v0[2], v0[3]); w.z = cvt_pk_bf16(v1[0], v1[1]); w.w = cvt_pk_bf16(v1[2], v1[3]);
                    *(GAS u32x4*)(Z2 + ((size_t)(b * 1024 + g * 256 + cp) * 8192 + ri * SEQ + s0)) = w; } }
    }
};
struct EpiYf {
    static constexpr bool PERM = true;
    GAS bf16* YF;
    __device__ __forceinline__ void operator()(const f32x4 (&acc)[2][2][4][2], const pg8::Unit& u, int wr, int wc, int fr, int fq) const {
        const int batch = u.pn >> 5, fb = (u.pn >> 1) & 15, kbb = u.pn & 1;
#pragma unroll
        for (int ai = 0; ai < 2; ++ai)
#pragma unroll
            for (int m = 0; m < 4; ++m) { const int ka = u.pm * 256 + ai * 128 + wr * 64 + m * 16 + fr;
#pragma unroll
                for (int bj = 0; bj < 2; ++bj) { const int kb = kbb * 4 + 2 * bj + (wc >> 1), f = fb * 64 + 32 * (wc & 1) + 8 * fq;
                    const f32x4 v0 = acc[ai][bj][m][0], v1 = acc[ai][bj][m][1];
                    u32x4 w; w.x = cvt_pk_bf16(v0[0], v0[1]); w.y = cvt_pk_bf16(v0[2], v0[3]); w.z = cvt_pk_bf16(v1[0], v1[1]); w.w = cvt_pk_bf16(v1[2], v1[3]);
                    *(GAS u32x4*)(YF + (size_t)(batch * SEQ + 8 * ka + kb) * D + f) = w; } }
    }
};
struct EpiMoeDown {
    static constexpr bool PERM = false;
    GAS float* Hres; const GAS int* rowtok; const GAS float* rowgate;
    __device__ __forceinline__ void operator()(const f32x4 (&acc)[2][2][4][2], const pg8::Unit& u, int wr, int wc, int fr, int fq) const {
#pragma unroll
        for (int ai = 0; ai < 2; ++ai)
#pragma unroll
            for (int m = 0; m < 4; ++m) { const int row = u.pm * 256 + ai * 128 + wr * 64 + m * 16 + fr; const int tok = rowtok[row]; const float gw = rowgate[row];
                if (tok >= 0) { GAS float* rp = Hres + (size_t)tok * D + u.pn * 256 + wc * 32 + 4 * fq;
#pragma unroll
                    for (int bj = 0; bj < 2; ++bj)
#pragma unroll
                        for (int n = 0; n < 2; ++n) { const f32x4 bs = *(const GAS f32x4*)(rp + bj * 128 + n * 16); *(GAS f32x4*)(rp + bj * 128 + n * 16) = bs + gw * acc[ai][bj][m][n]; } } }
    }
};

#define XB_TMO      128
#define XB_XCNT(j)  (256  + 64 * (j))
#define XB_XSUB(j)  (1280 + 64 * (j))
#define XB_XGEN(j)  (2304 + 64 * (j))
#define XB_TOP      3328
#define XB_TOPGEN   3392
#define XCD_BAR_WORDS 3456
#define XB_SPIN_CAP (1u << 18)
__device__ __forceinline__ unsigned xb_ld(unsigned* p)              { return __hip_atomic_load(p, __ATOMIC_RELAXED, __HIP_MEMORY_SCOPE_AGENT); }
__device__ __forceinline__ unsigned xb_add(unsigned* p, unsigned v) { return __hip_atomic_fetch_add(p, v, __ATOMIC_RELAXED, __HIP_MEMORY_SCOPE_AGENT); }
__device__ __forceinline__ unsigned xb_xcc_id() { return (unsigned)__builtin_amdgcn_s_getreg((3 << 11) | 20) & 0xFu; }
#define XB_SPIN(cond, bar) do { unsigned _sp = 0; while (cond) { __builtin_amdgcn_s_sleep(1); \
    if ((++_sp & 255u) == 0u) { if (xb_ld(&(bar)[XB_TMO])) break; if (_sp > XB_SPIN_CAP) { atomicAdd(&(bar)[XB_TMO], 1u); break; } } } } while (0)
struct XcdBarrier { unsigned* bar; unsigned x; volatile LAS unsigned* st; };
__device__ __forceinline__ XcdBarrier xcd_barrier_post(unsigned* bar, volatile LAS unsigned* st, const bool t0) {
    XcdBarrier b; b.bar = bar; b.x = xb_xcc_id(); b.st = st;
    if (t0) (void)xb_add(&bar[XB_XCNT(b.x)], 1u);
    return b;
}
__device__ __forceinline__ void xcd_barrier_complete(unsigned* bar, unsigned x, unsigned& nloc, unsigned& nx) {
    const unsigned G = gridDim.x * gridDim.y * gridDim.z;
    unsigned sum, cnt, mine, sp = 0u;
    for (;;) {
        sum = 0u; cnt = 0u; mine = 0u;
#pragma unroll
        for (unsigned j = 0; j < 16; ++j) { const unsigned c = xb_ld(&bar[XB_XCNT(j)]); sum += c; cnt += (c > 0u) ? 1u : 0u; mine = (j == x) ? c : mine; }
        if (sum == G) break;
        __builtin_amdgcn_s_sleep(1);
        if ((++sp & 255u) == 0u) { if (xb_ld(&bar[XB_TMO])) break; if (sp > XB_SPIN_CAP) { atomicAdd(&bar[XB_TMO], 1u); break; } }
    }
    nloc = mine > 0u ? mine : 1u; nx = cnt > 0u ? cnt : 1u;
}
__device__ __forceinline__ void xcd_barrier(const XcdBarrier& b, const bool t0) {
    asm volatile("s_waitcnt vmcnt(0)" ::: "memory");
    __syncthreads();
    if (t0) {
        unsigned* bar = b.bar;
        __builtin_amdgcn_s_waitcnt(0);
        unsigned nloc = b.st[0], nx = b.st[1];
        if (nloc == 0u) { xcd_barrier_complete(bar, b.x, nloc, nx); b.st[0] = nloc; b.st[1] = nx; }
        const unsigned old = xb_add(&bar[XB_XSUB(b.x)], 1u);
        const unsigned gen = old / nloc;
        if (old + 1u == (gen + 1u) * nloc) {
            __builtin_amdgcn_fence(__ATOMIC_RELEASE, "agent");
            asm volatile("s_waitcnt vmcnt(0)" ::: "memory");
            const unsigned og = xb_add(&bar[XB_TOP], 1u);
            const unsigned tg = og / nx;
            if (og + 1u == (tg + 1u) * nx) xb_add(&bar[XB_TOPGEN], 1u);
            else XB_SPIN(xb_ld(&bar[XB_TOPGEN]) == tg, bar);
            __builtin_amdgcn_fence(__ATOMIC_ACQUIRE, "agent");
            xb_add(&bar[XB_XGEN(b.x)], 1u);
            asm volatile("s_waitcnt vmcnt(0)" ::: "memory");
        } else {
            XB_SPIN(xb_ld(&bar[XB_XGEN(b.x)]) == gen, bar);
            __builtin_amdgcn_fence(__ATOMIC_ACQUIRE, "agent");
            asm volatile("s_waitcnt vmcnt(0)" ::: "memory");
        }
    }
    __syncthreads();
}

__device__ __forceinline__ float wave_sum(float v) {
#pragma unroll
    for (int o = 1; o < 64; o <<= 1) v += __shfl_xor(v, o);
    return v;
}
__device__ __forceinline__ void transpose_item(const GAS float* W, int K, int N, GAS bf16* WT, int k0, int n0, int rbase, LAS float* scr, int lane) {
#pragma unroll 8
    for (int i = 0; i < 32; ++i) { const int kk = 2 * i + (lane >> 5); scr[kk * 33 + (lane & 31)] = W[(size_t)(k0 + kk) * N + n0 + (lane & 31)]; }
    LDS_WAIT(); asm volatile("" ::: "memory");
    const int c = lane & 7;
#pragma unroll
    for (int j = 0; j < 4; ++j) { const int n = (lane >> 3) + 8 * j; const LAS float* s = scr + (8 * c) * 33 + n;
        u32x4 o; o.x = cvt_pk_bf16(s[0 * 33], s[1 * 33]); o.y = cvt_pk_bf16(s[2 * 33], s[3 * 33]); o.z = cvt_pk_bf16(s[4 * 33], s[5 * 33]); o.w = cvt_pk_bf16(s[6 * 33], s[7 * 33]);
        *(GAS u32x4*)(WT + (size_t)(rbase + n) * K + k0 + 8 * c) = o; }
    LDS_WAIT(); asm volatile("" ::: "memory");
}
__device__ __forceinline__ void tr_plain(const GAS float* W, int K, int N, GAS bf16* WT, int it, LAS float* scr, int lane) {
    const int nblk = N / 32, kb = it / nblk, nb = it - kb * nblk; transpose_item(W, K, N, WT, 64 * kb, 32 * nb, 32 * nb, scr, lane);
}
__device__ __forceinline__ void tr_gu(const GAS float* Wg, const GAS float* Wu, int K, int N, GAS bf16* WT, int it, LAS float* scr, int lane) {
    const int nblk = N / 32, per = (K / 64) * nblk; const bool up = it >= per; if (up) it -= per;
    const int kb = it / nblk, nb = it - kb * nblk, f0 = 32 * nb;
    transpose_item(up ? Wu : Wg, K, N, WT, 64 * kb, f0, 256 * (f0 >> 7) + (up ? 128 : 0) + (f0 & 127), scr, lane);
}
__device__ __forceinline__ void rms_row(const GAS float* xrow, const GAS float* g, GAS bf16* orow, int lane, f32x4 (&v)[4]) {
    const GAS f32x4* xr = (const GAS f32x4*)xrow + lane; const GAS f32x4* gr = (const GAS f32x4*)g + lane;
    float s = 0.f;
#pragma unroll
    for (int j = 0; j < 4; ++j) { v[j] = xr[64 * j]; s += (v[j].x * v[j].x + v[j].y * v[j].y) + (v[j].z * v[j].z + v[j].w * v[j].w); }
    const float r = 1.0f / sqrtf(wave_sum(s) * (1.f / D) + EPS);
    GAS u32x2* o8 = (GAS u32x2*)orow + lane;
#pragma unroll
    for (int j = 0; j < 4; ++j) { v[j] = v[j] * r * gr[64 * j]; u32x2 w; w.x = cvt_pk_bf16(v[j].x, v[j].y); w.y = cvt_pk_bf16(v[j].z, v[j].w); o8[64 * j] = w; }
}

constexpr int SW_QL = 0, SW_SPITCH = 528, SW_SL = 128 * 528, SW_VPITCH = 272, SW_VL = SW_SL + 64 * SW_SPITCH, SW_VB = 64 * SW_VPITCH;
static_assert(SW_VL + 2 * SW_VB <= 139264, "sweep LDS");
__device__ __forceinline__ void sweep_unit(LAS unsigned char* lds, const GAS bf16* Qg, const GAS bf16* KTFg, const GAS bf16* KTBg, const GAS bf16* VTg, const GAS bf16* PCg, const GAS bf16* PDg, const GAS bf16* ZEROg, GAS bf16* Yg, GAS f32x2* statp, const float l2f, const float l2b, int b, int h, int es, const int wave_s) {
    const int tid = tid_of(wave_s);
    const int w = __builtin_amdgcn_readfirstlane(tid >> 6), lane = tid & 63, rb = w >> 1, cb = w & 1, r32 = lane & 31, hh = lane >> 5;
    const int vrow = tid >> 4, vpc = tid & 15;
    const int qrow = tid >> 5, qpc = tid & 31;
    const GAS bf16* qp = Qg + (size_t)(b * SEQ + qrow) * QKW + h * DK + 8 * qpc;
    const size_t kto = (size_t)(h * DK + 32 * w + r32) * T + 8 * hh; const int krot = b * SEQ + ((r32 & 15) << 11);
    const GAS bf16* vtp = VTg + (size_t)(h * DV + 64 * es + vrow) * T + 8 * vpc; const int vrot = b * SEQ + ((vrow & 15) << 11);
    const GAS bf16* pcp = PCg + ((size_t)((b * NH + h) * NCH) * 128 + rb * 32 + r32) * 128 + 8 * hh;
    const GAS bf16* pdp = PDg + (((size_t)((b * NH + h) * NCH) * 4 + rb) * 32 + r32) * 32 + 8 * hh;
#define SW_LDP(dst, s_, d_, nn_) do { const int jb_ = (s_) >> 1; const bool use_ = (d_) ? (jb_ >= rb) : (jb_ <= rb); const bool dg_ = (d_) && (jb_ == rb); \
        const GAS bf16* src_ = dg_ ? (pdp + (size_t)(nn_) * 4096 + 16 * ((s_) & 1)) : (pcp + (size_t)(nn_) * (CH * CH) + 16 * (s_)); \
        dst = *(const GAS bf16x8*)(use_ ? src_ : ZEROg); } while (0)
    GAS bf16* yp = Yg + (size_t)(b * SEQ + 32 * rb + r32) * VW + h * DV + 64 * es + 32 * cb + 4 * hh;
    GAS f32x2* stp = statp + ((size_t)(b * SEQ + 32 * rb + r32) * NH + h) * 16 + es * 2 + cb;
    const int il = 32 * rb + r32;
    const int qrd = SW_QL + il * SW_SPITCH + 16 * hh;
    bf16x8 pa[8], ka[8]; u32x4 vv[2], qv[4];
    f32x16 Sacc[2];
#pragma unroll
    for (int s = 0; s < 8; ++s) { SW_LDP(pa[s], s, 0, 0); ka[s] = *(const GAS bf16x8*)(KTFg + kto + (krot & (T - 1)) + 16 * s); }
#pragma unroll
    for (int it = 0; it < 2; ++it) vv[it] = *(const GAS u32x4*)(vtp + (size_t)(32 * it) * T + (vrot & (T - 1)));
#pragma unroll
    for (int it = 0; it < 2; ++it) *(LAS u32x4*)(lds + SW_VL + (vrow + 32 * it) * SW_VPITCH + vpc * 16) = vv[it];
#pragma unroll
    for (int hf = 0; hf < 2; ++hf) {
#pragma unroll
        for (int it = 0; it < 4; ++it) qv[it] = *(const GAS u32x4*)(qp + (size_t)(16 * (4 * hf + it)) * QKW);
#pragma unroll
        for (int it = 0; it < 4; ++it) { const int row = qrow + 16 * (4 * hf + it); *(LAS u32x4*)(lds + SW_QL + row * SW_SPITCH + qpc * 16) = qv[it]; }
    }
#pragma unroll
    for (int c = 0; c < 2; ++c)
#pragma unroll
        for (int t = 0; t < 16; ++t) Sacc[c][t] = 0.f;
#define SW_SCHED __builtin_amdgcn_sched_barrier(0)
#define SW_MFMA(a, b, c) c = __builtin_amdgcn_mfma_f32_32x32x16_bf16(a, b, c, 0, 0, 0)
    const int sl_rd = SW_SL + (32 * cb + r32) * SW_SPITCH + 16 * hh;
#pragma unroll 1
    for (int p = 0; p < 2 * NCH; ++p) {
        {
            const int dir = p >> 5, st = p & 31, n = dir ? NCH - 1 - st : st;
            const int pn = p + 1 < 2 * NCH ? p + 1 : p, dirn = pn >> 5, stn = pn & 31, nn = dirn ? NCH - 1 - stn : stn;
            const int cur = p & 1;
            const float l2 = dir ? l2b : l2f;
            const float xi = fast_exp2((float)(dir == 0 ? (il + 1) : (CH - il)) * l2), gC = st == 0 ? 0.f : fast_exp2((float)CH * l2);
#pragma unroll
            for (int c = 0; c < 2; ++c)
#pragma unroll
                for (int g = 0; g < 4; ++g) { u32x2 pk; pk.x = cvt_pk_bf16(Sacc[c][4 * g], Sacc[c][4 * g + 1]); pk.y = cvt_pk_bf16(Sacc[c][4 * g + 2], Sacc[c][4 * g + 3]);
                    if (st == 0) { pk.x = 0u; pk.y = 0u; }
                    *(LAS u32x2*)(lds + SW_SL + (32 * c + r32) * SW_SPITCH + (32 * w + 8 * g + 4 * hh) * 2) = pk; }
#pragma unroll
            for (int it = 0; it < 2; ++it) vv[it] = *(const GAS u32x4*)(vtp + (size_t)(32 * it) * T + ((nn * CH + vrot) & (T - 1)));
#pragma unroll
            for (int it = 0; it < 4; ++it) qv[it] = *(const GAS u32x4*)(qp + (size_t)(nn * CH + 16 * it) * QKW);
            u32x2 yf[4];
            GAS bf16* ypn = yp + (size_t)(n * CH) * VW;
            __syncthreads();
            f32x16 O;
#pragma unroll
            for (int t = 0; t < 16; ++t) O[t] = 0.f;
            bf16x8 sx[2], qx[2], sy[2], qy[2];
#define SW_LDC(ds, dq, g2) do { _Pragma("unroll") for (int k = 0; k < 2; ++k) { const int ks = 2 * (g2) + k; ds[k] = *(const LAS bf16x8*)(lds + sl_rd + 32 * ks); \
                dq[k] = *(const LAS bf16x8*)(lds + qrd + 32 * ks); } } while (0)
#define SW_MMC(ds, dq) do { SW_MFMA(ds[0], dq[0], O); SW_MFMA(ds[1], dq[1], O); } while (0)
            const int vl_rd = SW_VL + cur * SW_VB + (32 * cb + r32) * SW_VPITCH + 16 * hh;
            const int vu_rd = SW_VL + cur * SW_VB + r32 * SW_VPITCH + 16 * hh;
#define SW_LDV(dv, gp) do { dv[0] = *(const LAS bf16x8*)(lds + vl_rd + 32 * (2 * (gp))); dv[1] = *(const LAS bf16x8*)(lds + vl_rd + 32 * (2 * (gp) + 1)); } while (0)
#define SW_LDU(du, ug) do { du[0] = *(const LAS bf16x8*)(lds + vu_rd + ((ug) >> 2) * 32 * SW_VPITCH + 32 * (2 * ((ug) & 3))); du[1] = *(const LAS bf16x8*)(lds + vu_rd + ((ug) >> 2) * 32 * SW_VPITCH + 32 * (2 * ((ug) & 3) + 1)); } while (0)
            SW_LDC(sx, qx, 0); SW_LDC(sy, qy, 1); SW_SCHED;
            SW_MMC(sx, qx); SW_SCHED; SW_LDC(sx, qx, 2); SW_SCHED;
            SW_MMC(sy, qy); SW_SCHED; SW_LDC(sy, qy, 3); SW_SCHED;
            SW_MMC(sx, qx); SW_SCHED; SW_LDC(sx, qx, 4); SW_SCHED;
            SW_MMC(sy, qy); SW_SCHED; SW_LDC(sy, qy, 5); SW_SCHED;
            SW_MMC(sx, qx); SW_SCHED; SW_LDC(sx, qx, 6); SW_SCHED;
            SW_MMC(sy, qy); SW_SCHED; SW_LDC(sy, qy, 7); SW_SCHED;
            SW_MMC(sx, qx); SW_SCHED;
            bf16x8 vx[2], vy[2];
            SW_LDV(vx, 0); SW_SCHED;
            SW_MMC(sy, qy); SW_SCHED;
            SW_LDV(vy, 1); SW_SCHED;
            __syncthreads();
#pragma unroll
            for (int it = 0; it < 4; ++it) { const int row = qrow + 16 * it; *(LAS u32x4*)(lds + SW_QL + row * SW_SPITCH + qpc * 16) = qv[it]; }
#pragma unroll
            for (int it = 0; it < 4; ++it) qv[it] = *(const GAS u32x4*)(qp + (size_t)(nn * CH + 16 * (4 + it)) * QKW);
            if (dir) {
#pragma unroll
                for (int g = 0; g < 4; ++g) yf[g] = *(const GAS u32x2*)(ypn + 8 * g);
            }
#pragma unroll
            for (int t = 0; t < 16; ++t) O[t] *= xi;
#define SW_PV(s, vf) SW_MFMA(vf, pa[s], O)
            SW_PV(0, vx[0]); SW_PV(1, vx[1]); SW_SCHED; SW_LDV(vx, 2); SW_SCHED;
            SW_PV(2, vy[0]); SW_PV(3, vy[1]); SW_SCHED; SW_LDV(vy, 3); SW_SCHED;
            bf16x8 ux[2], uy[2];
            SW_PV(4, vx[0]); SW_PV(5, vx[1]); SW_SCHED; SW_LDU(ux, 0); SW_SCHED;
            SW_PV(6, vy[0]); SW_PV(7, vy[1]); SW_SCHED; SW_LDU(uy, 1); SW_SCHED;
#pragma unroll
            for (int s = 0; s < 8; ++s) SW_LDP(pa[s], s, dirn, nn);
#pragma unroll
            for (int c = 0; c < 2; ++c)
#pragma unroll
                for (int t = 0; t < 16; ++t) Sacc[c][t] *= gC;
            SW_SCHED;
#define SW_UP(ug, du) do { SW_MFMA(ka[2 * ((ug) & 3)], du[0], Sacc[(ug) >> 2]); SW_MFMA(ka[2 * ((ug) & 3) + 1], du[1], Sacc[(ug) >> 2]); } while (0)
            SW_UP(0, ux); SW_SCHED; SW_LDU(ux, 2); SW_SCHED;
            SW_UP(1, uy); SW_SCHED; SW_LDU(uy, 3); SW_SCHED;
            SW_UP(2, ux); SW_SCHED; SW_LDU(ux, 4); SW_SCHED;
            SW_UP(3, uy); SW_SCHED; SW_LDU(uy, 5); SW_SCHED;
            SW_UP(4, ux); SW_SCHED; SW_LDU(ux, 6); SW_SCHED;
            SW_UP(5, uy); SW_SCHED; SW_LDU(uy, 7); SW_SCHED;
            SW_UP(6, ux); SW_SCHED;
            SW_UP(7, uy); SW_SCHED;
            {
                const GAS bf16* ktn = (dirn ? KTBg : KTFg) + kto + ((nn * CH + krot) & (T - 1));
#pragma unroll
                for (int s = 0; s < 8; ++s) ka[s] = *(const GAS bf16x8*)(ktn + 16 * s);
            }
#pragma unroll
            for (int it = 0; it < 2; ++it) *(LAS u32x4*)(lds + SW_VL + (cur ^ 1) * SW_VB + (vrow + 32 * it) * SW_VPITCH + vpc * 16) = vv[it];
#pragma unroll
            for (int it = 0; it < 4; ++it) { const int row = qrow + 16 * (4 + it); *(LAS u32x4*)(lds + SW_QL + row * SW_SPITCH + qpc * 16) = qv[it]; }
            if (dir == 0) {
#pragma unroll
                for (int g = 0; g < 4; ++g) { u32x2 o; o.x = cvt_pk_bf16(O[4 * g], O[4 * g + 1]); o.y = cvt_pk_bf16(O[4 * g + 2], O[4 * g + 3]); *(GAS u32x2*)(ypn + 8 * g) = o; }
            } else {
                float s1 = 0.f, s2 = 0.f;
#pragma unroll
                for (int g = 0; g < 4; ++g) { const float y0 = bf_lo(yf[g].x) + O[4 * g], y1 = bf_hi(yf[g].x) + O[4 * g + 1], y2 = bf_lo(yf[g].y) + O[4 * g + 2], y3 = bf_hi(yf[g].y) + O[4 * g + 3];
                    s1 += (y0 + y1) + (y2 + y3); s2 += (y0 * y0 + y1 * y1) + (y2 * y2 + y3 * y3);
                    u32x2 o; o.x = cvt_pk_bf16(y0, y1); o.y = cvt_pk_bf16(y2, y3); *(GAS u32x2*)(ypn + 8 * g) = o; }
                s1 += __shfl_xor(s1, 32); s2 += __shfl_xor(s2, 32);
                if (hh == 0) stp[(size_t)(n * CH) * (NH * 16)] = (f32x2){s1, s2};
            }
        }
    }
#undef SW_LDC
#undef SW_MMC
#undef SW_LDV
#undef SW_LDU
#undef SW_PV
#undef SW_LDP
#undef SW_UP
#undef SW_MFMA
#undef SW_SCHED
    VM_WAIT();
    __syncthreads();
}

struct Args { const float* in[16]; float* out; unsigned char* ws; };
constexpr int NWAVES = 8;
#ifndef PHMASK
#define PHMASK 0xFFFFFFFFu
#endif
#define PH(k) (((PHMASK) >> (k)) & 1u)
__global__ void __launch_bounds__(NWAVES * 64, 2) fwd_kernel(Args args) {
    extern __shared__ __attribute__((aligned(16))) unsigned char lds_raw[];
    LAS unsigned char* lds = (LAS unsigned char*)lds_raw;
    LAS float* l2g = (LAS float*)(lds + LDSCTL_OFF + 64);
    const int wave_k = __builtin_amdgcn_readfirstlane((int)threadIdx.x >> 6);
#define PHASE_VARS \
    const int tid = tid_of(wave_k); const int lane = tid & 63; int wave = wave_k; asm volatile("" : "+s"(wave)); \
    const __attribute__((address_space(4))) Args* ka = (const __attribute__((address_space(4))) Args*)__builtin_amdgcn_kernarg_segment_ptr(); asm volatile("" : "+s"(ka)); \
    const int G = gridDim.x, bx = blockIdx.x; const int vcu = (G % 8 == 0) ? (bx % 8) * (G / 8) + bx / 8 : bx; const int gw = vcu * NWAVES + wave, NGW = G * NWAVES; \
    GAS unsigned char* ws = (GAS unsigned char*)ka->ws; asm volatile("" : "+s"(ws)); GAS float* hres = (GAS float*)ka->out; (void)lane; (void)gw; (void)NGW; (void)vcu; (void)hres; \
    const GAS float* x = (const GAS float*)ka->in[0]; const GAS float* mix_norm = (const GAS float*)ka->in[1]; const GAS float* ffn_norm = (const GAS float*)ka->in[2]; const GAS float* ret_w_in = (const GAS float*)ka->in[3]; const GAS float* ret_decay = (const GAS float*)ka->in[4]; \
    const GAS float* gn_gain = (const GAS float*)ka->in[5]; const GAS float* ret_w_out = (const GAS float*)ka->in[6]; const GAS float* d_wg = (const GAS float*)ka->in[7]; const GAS float* d_wu = (const GAS float*)ka->in[8]; const GAS float* d_wd = (const GAS float*)ka->in[9]; \
    const GAS float* fnet_w = (const GAS float*)ka->in[10]; const GAS float* moe_router = (const GAS float*)ka->in[11]; const GAS float* m_wg = (const GAS float*)ka->in[12]; const GAS float* m_wu = (const GAS float*)ka->in[13]; const GAS float* m_wd = (const GAS float*)ka->in[14]; const GAS float* final_norm = (const GAS float*)ka->in[15]; \
    (void)x; (void)mix_norm; (void)ffn_norm; (void)ret_w_in; (void)ret_decay; (void)gn_gain; (void)ret_w_out; (void)d_wg; (void)d_wu; (void)d_wd; (void)fnet_w; (void)moe_router; (void)m_wg; (void)m_wu; (void)m_wd; (void)final_norm; \
    GAS f32x2* rot = (GAS f32x2*)(ws + WS_ROT); GAS f32x2* rotT = (GAS f32x2*)(ws + WS_ROTT); GAS bf16* WC = (GAS bf16*)(ws + WS_WC); \
    GAS int* toke = (GAS int*)(ws + WS_TOKE); GAS float* tokw = (GAS float*)(ws + WS_TOKW); GAS int* bcnt = (GAS int*)(ws + WS_BCNT); GAS int* pcnt = (GAS int*)(ws + WS_PCNT); (void)pcnt; GAS int* rowtok = (GAS int*)(ws + WS_ROWTOK); GAS float* rowgate = (GAS float*)(ws + WS_ROWGATE); \
    GAS f32x2* statp = (GAS f32x2*)(ws + WS_STATP); \
    GAS bf16* WIN = (GAS bf16*)(ws + WS_WIN); GAS bf16* WO = (GAS bf16*)(ws + WS_WO); GAS bf16* WGU = (GAS bf16*)(ws + WS_WGU); GAS bf16* WD = (GAS bf16*)(ws + WS_WD); GAS bf16* WF = (GAS bf16*)(ws + WS_WF); \
    GAS bf16* HN = (GAS bf16*)(ws + WS_HN); GAS bf16* Qb = (GAS bf16*)(ws + WS_Q); GAS bf16* Kb = (GAS bf16*)(ws + WS_K); GAS bf16* KT = (GAS bf16*)(ws + WS_KT); GAS bf16* VT = (GAS bf16*)(ws + WS_VT); GAS bf16* PC = (GAS bf16*)(ws + WS_PC); \
    GAS bf16* Yb = (GAS bf16*)ka->out; GAS bf16* YG = (GAS bf16*)(ws + WS_YG); GAS bf16* ACTD = (GAS bf16*)(ws + WS_ACTD); GAS bf16* Z2 = (GAS bf16*)(ws + WS_Z2); GAS bf16* WSEQ = (GAS bf16*)(ws + WS_WSEQ); \
    GAS bf16* ACTM = (GAS bf16*)(ws + WS_ACTM); GAS bf16* WMGU = (GAS bf16*)(ws + WS_WMGU); GAS bf16* WMD = (GAS bf16*)(ws + WS_WMD); \
    (void)rot; (void)rotT; (void)WC; (void)toke; (void)tokw; (void)bcnt; (void)rowtok; (void)rowgate; (void)statp; (void)WIN; (void)WO; (void)WGU; (void)WD; (void)WF; (void)HN; (void)Qb; (void)Kb; (void)KT; (void)VT; (void)PC; \
    (void)Yb; (void)YG; (void)ACTD; (void)Z2; (void)WSEQ; (void)ACTM; (void)WMGU; (void)WMD;
#define GRID_BAR() do { const __attribute__((address_space(4))) Args* kb = (const __attribute__((address_space(4))) Args*)__builtin_amdgcn_kernarg_segment_ptr(); asm volatile("" : "+s"(kb)); GAS unsigned char* wsb = (GAS unsigned char*)kb->ws; XcdBarrier bar_; bar_.bar = (unsigned*)(wsb + WS_CTL) + CW_BAR; bar_.x = xb_xcc_id(); \
    bar_.st = (volatile LAS unsigned*)(lds + MISC_OFF) + 8; xcd_barrier(bar_, tid_of(wave_k) == 0); } while (0)

    {
        PHASE_VARS
        for (int u = tid; u < (LDS_BYTES - LDSCTL_OFF) / 4; u += NWAVES * 64) ((LAS unsigned*)(lds + LDSCTL_OFF))[u] = 0u;
        __syncthreads();
        if (tid < 8) { const float xl = ret_decay[tid]; const float ls = fminf(xl, 0.f) - log1pf(expf(-fabsf(xl))); l2g[tid] = ls * 1.44269504088896341f; }
        __syncthreads();
        (void)xcd_barrier_post((unsigned*)(ws + WS_CTL) + CW_BAR, (volatile LAS unsigned*)(lds + MISC_OFF) + 8, tid == 0);
    }

    if (PH(0)) {
        PHASE_VARS
        LAS float* scr = (LAS float*)(lds + wave * 16384);
        constexpr int I_IN = (D / 64) * (INW / 32), I_O = (VW / 64) * (D / 32), I_GU = 2 * (D / 64) * (FFD / 32), I_D = (FFD / 64) * (D / 32), I_F = (D / 64) * (D / 32);
        constexpr int NITEMS = I_IN + I_O + I_GU + I_D + I_F;
        for (int it = gw; it < NITEMS; it += NGW) {
            int r = it;
            if (r < I_IN) { tr_plain(ret_w_in, D, INW, WIN, r, scr, lane); continue; } r -= I_IN;
            if (r < I_O) { tr_plain(ret_w_out, VW, D, WO, r, scr, lane); continue; } r -= I_O;
            if (r < I_GU) { tr_gu(d_wg, d_wu, D, FFD, WGU, r, scr, lane); continue; } r -= I_GU;
            if (r < I_D) { tr_plain(d_wd, FFD, D, WD, r, scr, lane); continue; } r -= I_D;
            tr_plain(fnet_w, D, D, WF, r, scr, lane);
        }
        for (int e = (vcu * 512 + tid); e < SEQ * 128; e += G * 512) { const int s = e >> 7, i = e & 127;
            const float inv = powf(10000.0f, -(float)i / 128.0f); const float ang = (float)s * inv; float sn, cs; sincosf(ang, &sn, &cs);
            rot[e] = (f32x2){cs, sn}; rotT[(size_t)i * SEQ + s] = (f32x2){cs, sn}; }
        for (int e = (vcu * 512 + tid); e < 512 * 256; e += G * 512) { const int r = e >> 8, c = e & 255, mm = ((r & 255) * c) & 255;
            const float v = r < 256 ? cospif((float)mm * (1.0f / 128.0f)) : -sinpif((float)mm * (1.0f / 128.0f)); WC[e] = (bf16)(cvt_pk_bf16(v, 0.f) & 0xffffu); }
        for (int m = gw; m < T; m += NGW) { f32x4 v[4]; rms_row(x + (size_t)m * D, mix_norm, HN + (size_t)m * D, lane, v); }
    }
    GRID_BAR();

    if (PH(1) && PH(19)) {
        PHASE_VARS
        SchedPlain S{(const GAS char*)HN, (const GAS char*)WIN, (size_t)256 * D * 2, (size_t)256 * D * 2, T / 256, 8, G, bx};
        EpiRopeQK E{Qb, Kb, rot};
        pg8::gemm_phase<EpiRopeQK, SchedPlain, false>(lds, wave_k, D, D, D, S, E);
    }
    if (PH(1) && PH(20)) {
        PHASE_VARS
        SchedPlain S{(const GAS char*)(WIN + (size_t)QKW * D), (const GAS char*)HN, (size_t)256 * D * 2, (size_t)256 * D * 2, 4, T / 256, G, bx};
        EpiRopeKT E{KT, rotT, l2g};
        pg8::gemm_phase<EpiRopeKT, SchedPlain, false>(lds, wave_k, D, D, D, S, E);
    }
    if (PH(1) && PH(21)) {
        PHASE_VARS
        SchedPlain S{(const GAS char*)(WIN + (size_t)2 * QKW * D), (const GAS char*)HN, (size_t)256 * D * 2, (size_t)256 * D * 2, 8, T / 256, G, bx};
        EpiBf16<true> E{VT, T};
        pg8::gemm_phase<EpiBf16<true>, SchedPlain, false>(lds, wave_k, D, D, D, S, E);
    }
    GRID_BAR();

    if (PH(2)) {
        PHASE_VARS
        SchedPc S{(const GAS char*)Qb, (const GAS char*)Kb, G, bx};
        EpiPc E{PC, (GAS bf16*)(ws + WS_ROT), l2g};
        pg8::gemm_phase<EpiPc, SchedPc, false>(lds, wave_k, QKW, QKW, DK, S, E);
    }
    GRID_BAR();

    if (PH(3)) {
        PHASE_VARS
        for (int u = vcu; u < NB * NH * 8; u += G) { const int hh_ = (u >> 3) & 3; const float l2f = l2g[hh_], l2b = l2g[4 + hh_];
            sweep_unit(lds, Qb, KT, KT + (size_t)QKW * T, VT, PC, (const GAS bf16*)(ws + WS_ROT), (const GAS bf16*)(ws + WS_CTL + 512 * 1024), Yb, statp, l2f, l2b, u >> 5, hh_, u & 7, wave_k); }
    }
    GRID_BAR();

    if (PH(5)) {
        PHASE_VARS
        SchedPlain S{(const GAS char*)HN, (const GAS char*)(WIN + (size_t)(2 * QKW + VW) * D), (size_t)256 * D * 2, (size_t)256 * D * 2, T / 256, 8, G, bx};
        EpiGate E{Yb, YG, statp, gn_gain};
        pg8::gemm_phase<EpiGate, SchedPlain, false>(lds, wave_k, D, D, D, S, E);
    }
    GRID_BAR();

    if (PH(6)) {
        PHASE_VARS
        SchedPlain S{(const GAS char*)YG, (const GAS char*)WO, (size_t)256 * VW * 2, (size_t)256 * VW * 2, T / 256, 4, G, bx};
        EpiResF32 E{x, hres};
        pg8::gemm_phase<EpiResF32, SchedPlain, false>(lds, wave_k, VW, VW, VW, S, E);
    }
    GRID_BAR();

    if (PH(7)) {
        PHASE_VARS
        for (int m = gw; m < T; m += NGW) { f32x4 v[4]; rms_row(hres + (size_t)m * D, ffn_norm, HN + (size_t)m * D, lane, v); }
        LAS float* scr = (LAS float*)(lds + wave * 16384);
        constexpr int I_GU = 2 * (D / 64) * (FFE / 32), I_D = (FFE / 64) * (D / 32);
        for (int it = gw; it < NE * (I_GU + I_D); it += NGW) {
            const int e = it / (I_GU + I_D); int r = it - e * (I_GU + I_D);
            if (r < I_GU) tr_gu(m_wg + (size_t)e * D * FFE, m_wu + (size_t)e * D * FFE, D, FFE, WMGU + (size_t)e * 2 * FFE * D, r, scr, lane);
            else tr_plain(m_wd + (size_t)e * FFE * D, FFE, D, WMD + (size_t)e * D * FFE, r - I_GU, scr, lane);
        }
    }
    GRID_BAR();

    if (PH(8)) {
        PHASE_VARS
        SchedPlain S{(const GAS char*)HN, (const GAS char*)WGU, (size_t)256 * D * 2, (size_t)256 * D * 2, T / 256, 2 * FFD / 256, G, bx};
        EpiSwiGLU E{ACTD, FFD};
        pg8::gemm_phase<EpiSwiGLU, SchedPlain, false>(lds, wave_k, D, D, D, S, E);
    }
    GRID_BAR();
    if (PH(9)) {
        PHASE_VARS
        SchedPlain S{(const GAS char*)ACTD, (const GAS char*)WD, (size_t)256 * FFD * 2, (size_t)256 * FFD * 2, T / 256, 4, G, bx};
        EpiResF32 E{hres, hres};
        pg8::gemm_phase<EpiResF32, SchedPlain, false>(lds, wave_k, FFD, FFD, FFD, S, E);
    }
    GRID_BAR();

    if (PH(10)) {
        PHASE_VARS
        for (int m = gw; m < T; m += NGW) { f32x4 v[4]; rms_row(hres + (size_t)m * D, mix_norm + D, HN + (size_t)m * D, lane, v); }
        for (int e = vcu * 512 + tid; e < 512 * 1024; e += G * 512) { const int ka = e >> 10, c = e & 1023, a = c & 511, mm = (a * ka) & 511;
            const float v = (c < 512 ? cospif((float)mm * (1.0f / 256.0f)) : sinpif((float)mm * (1.0f / 256.0f))) * (1.0f / 1024.0f); WSEQ[e] = (bf16)(cvt_pk_bf16(v, 0.f) & 0xffffu); }
    }
    GRID_BAR();

    if (PH(11)) {
        PHASE_VARS
        SchedFnA S{(const GAS char*)WC, (const GAS char*)HN, G, bx};
        EpiZ2 E{Z2};
        pg8::gemm_phase<EpiZ2, SchedFnA, false>(lds, wave_k, 256, D, 256, S, E);
    }
    GRID_BAR();
    if (PH(22)) {
        PHASE_VARS
        float wc0[8], ws0[8];
#pragma unroll
        for (int kb = 0; kb < 8; ++kb) { const float ang = (float)((8 * lane * kb) & 4095) * (1.0f / 2048.0f); wc0[kb] = cospif(ang); ws0[kb] = sinpif(ang); }
        for (int rw = gw; rw < NB * 1024; rw += NGW) {
            GAS bf16* row = Z2 + (size_t)rw * 8192;
#pragma unroll
            for (int hq = 0; hq < 2; ++hq) {
                u32x2 zin[2][8], zout[8][2];
#pragma unroll
                for (int ri = 0; ri < 2; ++ri)
#pragma unroll
                    for (int bb = 0; bb < 8; ++bb) zin[ri][bb] = *(const GAS u32x2*)(row + ri * 4096 + 512 * bb + 8 * lane + 4 * hq);
#pragma unroll
                for (int q = 0; q < 2; ++q) {
                    float outr[2][8], outi[2][8];
#pragma unroll
                    for (int tt = 0; tt < 2; ++tt) {
                        const int t = 4 * hq + 2 * q + tt;
                        float zr[8], zi[8];
#pragma unroll
                        for (int bb = 0; bb < 8; ++bb) { const unsigned wr_ = zin[0][bb][q], wi_ = zin[1][bb][q]; zr[bb] = tt ? bf_hi(wr_) : bf_lo(wr_); zi[bb] = tt ? bf_hi(wi_) : bf_lo(wi_); }
#pragma unroll
                        for (int kb = 0; kb < 8; ++kb) {
                            float ur = 0.f, ui = 0.f;
#pragma unroll
                            for (int bb = 0; bb < 8; ++bb) {
                                const int m8 = (bb * kb) & 7;
                                const float c8 = (m8 == 0) ? 1.f : (m8 == 4) ? -1.f : (m8 == 2 || m8 == 6) ? 0.f : (m8 == 1 || m8 == 7) ? 0.70710678118654752f : -0.70710678118654752f;
                                const float s8 = (m8 == 0 || m8 == 4) ? 0.f : (m8 == 2) ? 1.f : (m8 == 6) ? -1.f : (m8 == 1 || m8 == 3) ? 0.70710678118654752f : -0.70710678118654752f;
                                ur += c8 * zr[bb] + s8 * zi[bb]; ui += c8 * zi[bb] - s8 * zr[bb]; }
                            const int mt = (t * kb);
                            const float ct = __builtin_cosf((float)mt * 0.00153398078788564123f), st_ = __builtin_sinf((float)mt * 0.00153398078788564123f);
                            const float twc = wc0[kb] * ct - ws0[kb] * st_, tws = ws0[kb] * ct + wc0[kb] * st_;
                            outr[tt][kb] = ur * twc + ui * tws; outi[tt][kb] = ui * twc - ur * tws; }
                    }
#pragma unroll
                    for (int kb = 0; kb < 8; ++kb) { zout[kb][0][q] = cvt_pk_bf16(outr[0][kb], outr[1][kb]); zout[kb][1][q] = cvt_pk_bf16(outi[0][kb], outi[1][kb]); }
                    __builtin_amdgcn_sched_barrier(0);
                }
#pragma unroll
                for (int kb = 0; kb < 8; ++kb)
#pragma unroll
                    for (int ri = 0; ri < 2; ++ri) *(GAS u32x2*)(row + kb * 1024 + ri * 512 + 8 * lane + 4 * hq) = zout[kb][ri];
                __builtin_amdgcn_sched_barrier(0);
            }
        }
    }
    GRID_BAR();
    if (PH(12)) {
        PHASE_VARS
        SchedFnB S{(GAS const char*)WSEQ, (GAS const char*)Z2, G, bx};
        EpiYf E{HN};
        pg8::gemm_phase<EpiYf, SchedFnB, false>(lds, wave_k, 1024, 1024, 1024, S, E);
    }
    GRID_BAR();
    if (PH(13)) {
        PHASE_VARS
        SchedPlain S{(const GAS char*)HN, (const GAS char*)WF, (size_t)256 * D * 2, (size_t)256 * D * 2, T / 256, 4, G, bx};
        EpiResF32 E{hres, hres};
        pg8::gemm_phase<EpiResF32, SchedPlain, false>(lds, wave_k, D, D, D, S, E);
    }
    GRID_BAR();

    if (PH(14)) {
        PHASE_VARS
        LAS float* wrl = (LAS float*)lds;
        LAS int* le = (LAS int*)(lds + 32768);
        for (int i = tid; i < D * NE / 4; i += NWAVES * 64) ((LAS f32x4*)wrl)[i] = ((const GAS f32x4*)moe_router)[i];
        for (int i = vcu * 512 + tid; i < 2 * MOE_ROWS; i += G * 512) rowtok[i] = -1;
        __syncthreads();
        for (int tb = vcu; tb < T / 128; tb += G) {
            for (int rr = 0; rr < 16; ++rr) { const int tl = wave * 16 + rr, m = tb * 128 + tl; f32x4 v[4];
                rms_row(hres + (size_t)m * D, ffn_norm + D, HN + (size_t)m * D, lane, v);
                float lg[8];
#pragma unroll
                for (int e = 0; e < 8; ++e) lg[e] = 0.f;
#pragma unroll
                for (int j = 0; j < 4; ++j)
#pragma unroll
                    for (int c = 0; c < 4; ++c) { const int col = 256 * j + 4 * lane + c; const f32x4 w0 = *(const LAS f32x4*)(wrl + col * 8), w1 = *(const LAS f32x4*)(wrl + col * 8 + 4); const float xv = v[j][c];
                        lg[0] += xv * w0.x; lg[1] += xv * w0.y; lg[2] += xv * w0.z; lg[3] += xv * w0.w; lg[4] += xv * w1.x; lg[5] += xv * w1.y; lg[6] += xv * w1.z; lg[7] += xv * w1.w; }
#pragma unroll
                for (int e = 0; e < 8; ++e) lg[e] = wave_sum(lg[e]);
                int e0 = 0; float b0 = lg[0];
#pragma unroll
                for (int e = 1; e < 8; ++e) if (lg[e] > b0) { b0 = lg[e]; e0 = e; }
                int e1 = -1; float b1 = -3.0e38f;
#pragma unroll
                for (int e = 0; e < 8; ++e) if (e != e0 && lg[e] > b1) { b1 = lg[e]; e1 = e; }
                const float w0 = 1.0f / (1.0f + __expf(b1 - b0));
                if (lane == 0) { toke[2 * m] = e0; toke[2 * m + 1] = e1; tokw[2 * m] = w0; tokw[2 * m + 1] = 1.0f - w0; le[tl] = e0; le[128 + tl] = e1; } }
            __syncthreads();
            if (tid < 16) { const int s = tid >> 3, e = tid & 7; int c = 0; for (int i = 0; i < 128; ++i) c += (le[s * 128 + i] == e) ? 1 : 0; bcnt[tb * 16 + tid] = c; }
            if (tid >= 64 && tid < 128) { const int pi = tid - 64; int c = 0; for (int i = 0; i < 128; ++i) c += (le[i] * 8 + le[128 + i] == pi) ? 1 : 0; pcnt[tb * 64 + pi] = c; }
            __syncthreads();
        }
    }
    GRID_BAR();

    LAS int* segoff = (LAS int*)(lds + 132096);
    LAS int* ntile = (LAS int*)(lds + 132096 + 64);
    LAS unsigned char* tile_e = (LAS unsigned char*)(lds + 132096 + 128);
    if (PH(15)) {
        PHASE_VARS
        LAS int* pfx = (LAS int*)lds;
        LAS int* cph = (LAS int*)(lds + 65792);
        LAS int* fq_ = (LAS int*)(lds + 65792 + 16384);
        LAS int* tot = fq_ + 64;
        LAS int* tpi = tot + 16;
        LAS int* tex = tpi + 128;
        for (int i = tid; i < 256 * 64; i += NWAVES * 64) pfx[i] = pcnt[i];
        __syncthreads();
        if (tid < 64) { int run = 0; for (int b2 = 0; b2 < 256; ++b2) { const int c = pfx[b2 * 64 + tid]; pfx[b2 * 64 + tid] = run; run += c; } pfx[256 * 64 + tid] = run; }
        __syncthreads();
        if (tid == 0) {
            int n0[8], d[8], r[8]; int rs = 0;
            for (int e = 0; e < 8; ++e) { int c = 0; for (int x2 = 0; x2 < 8; ++x2) c += pfx[256 * 64 + e * 8 + x2]; n0[e] = c; r[e] = c & 255; d[e] = -(c & 255); rs += c & 255; }
            int extra = rs >> 8;
            for (int k = 0; k < extra; ++k) { int be = -1, br = -1; for (int e = 0; e < 8; ++e) if (d[e] < 0 && d[e] == -r[e] && r[e] > br) { br = r[e]; be = e; } if (be >= 0) d[be] += 256; }
            for (int i = 0; i < 64; ++i) fq_[i] = 0;
            for (int a = 0; a < 8; ++a) for (int e = 0; e < 8; ++e) if (a != e && d[a] < 0 && d[e] > 0) { int fl = -d[a]; if (d[e] < fl) fl = d[e]; const int av = pfx[256 * 64 + a * 8 + e]; if (av < fl) fl = av; fq_[a * 8 + e] = fl; d[a] += fl; d[e] -= fl; }
        }
        __syncthreads();
        if (tid < 256) {
            int c0[8], c1[8];
#pragma unroll
            for (int e = 0; e < 8; ++e) { c0[e] = 0; c1[e] = 0; }
            for (int a = 0; a < 8; ++a) for (int e = 0; e < 8; ++e) { const int pi = a * 8 + e; const int cnt = pfx[(tid + 1) * 64 + pi] - pfx[tid * 64 + pi]; int fl = fq_[pi] - pfx[tid * 64 + pi]; fl = fl < 0 ? 0 : (fl > cnt ? cnt : fl);
#pragma unroll
                for (int q = 0; q < 8; ++q) { c0[q] += (q == a ? cnt - fl : 0) + (q == e ? fl : 0); c1[q] += (q == e ? cnt - fl : 0) + (q == a ? fl : 0); } }
#pragma unroll
            for (int e = 0; e < 8; ++e) { cph[tid * 16 + e] = c0[e]; cph[tid * 16 + 8 + e] = c1[e]; }
        }
        __syncthreads();
        if (tid < 16) { int run = 0; for (int b2 = 0; b2 < 256; ++b2) { const int c = cph[b2 * 16 + tid]; cph[b2 * 16 + tid] = run; run += c; } tot[tid] = run; }
        __syncthreads();
        if (tid < 2) { int off = 0, nt = 0; for (int e = 0; e < 8; ++e) { segoff[tid * 8 + e] = off; const int tl = (tot[tid * 8 + e] + 255) >> 8; for (int q = 0; q < tl; ++q) tile_e[tid * 160 + nt + q] = (unsigned char)e; nt += tl; off += tl * 256; } ntile[tid] = nt; }
        __syncthreads();
        for (int tb = vcu; tb < T / 128; tb += G) {
            int e0 = 0, e1 = 0, flip = 0;
            if (tid < 128) { const int m = tb * 128 + tid; e0 = toke[2 * m]; e1 = toke[2 * m + 1]; tpi[tid] = e0 * 8 + e1; }
            __syncthreads();
            if (tid < 128) { const int pi = e0 * 8 + e1; int rk = 0; for (int i = 0; i < tid; ++i) rk += (tpi[i] == pi) ? 1 : 0;
                flip = (pfx[tb * 64 + pi] + rk) < fq_[pi] ? 1 : 0; tex[tid] = flip ? e1 : e0; tex[128 + tid] = flip ? e0 : e1; }
            __syncthreads();
            if (tid < 128) { const int m = tb * 128 + tid;
#pragma unroll
                for (int ph = 0; ph < 2; ++ph) { const int e = tex[ph * 128 + tid]; int rk = 0; for (int i = 0; i < tid; ++i) rk += (tex[ph * 128 + i] == e) ? 1 : 0;
                    const int row = segoff[ph * 8 + e] + cph[tb * 16 + ph * 8 + e] + rk;
                    rowtok[ph * MOE_ROWS + row] = m; rowgate[ph * MOE_ROWS + row] = tokw[2 * m + (ph ^ flip)]; } }
            __syncthreads();
        }
    }
    GRID_BAR();

    if (PH(16))
#pragma unroll
    for (int s = 0; s < 2; ++s) {
        {
            PHASE_VARS
            SchedMoe S{(const GAS char*)HN, (const GAS char*)WMGU, rowtok + s * MOE_ROWS, tile_e + s * 160, 0, (size_t)2 * FFE * D * 2, (size_t)256 * D * 2, ntile[s], 2 * FFE / 256, G, bx, true};
            EpiSwiGLU E{ACTM, FFE};
            pg8::gemm_phase<EpiSwiGLU, SchedMoe, true>(lds, wave_k, D, D, D, S, E);
        }
        GRID_BAR();
        {
            PHASE_VARS
            SchedMoe S{(const GAS char*)ACTM, (const GAS char*)WMD, rowtok + s * MOE_ROWS, tile_e + s * 160, (size_t)256 * FFE * 2, (size_t)D * FFE * 2, (size_t)256 * FFE * 2, ntile[s], 4, G, bx, false};
            EpiMoeDown E{hres, rowtok + s * MOE_ROWS, rowgate + s * MOE_ROWS};
            pg8::gemm_phase<EpiMoeDown, SchedMoe, false>(lds, wave_k, FFE, FFE, FFE, S, E);
        }
        GRID_BAR();
    }

    if (PH(17)) {
        PHASE_VARS
        const bool bad = __hip_atomic_load((GAS unsigned*)(ws + WS_CTL) + CW_BAR + XB_TMO, RLX_AGENT) != 0u;
        for (int m = gw; m < T; m += NGW) {
            GAS f32x4* xr = (GAS f32x4*)(hres + (size_t)m * D) + lane; const GAS f32x4* gr = (const GAS f32x4*)final_norm + lane;
            f32x4 v[4]; float s = 0.f;
#pragma unroll
            for (int j = 0; j < 4; ++j) { v[j] = xr[64 * j]; s += (v[j].x * v[j].x + v[j].y * v[j].y) + (v[j].z * v[j].z + v[j].w * v[j].w); }
            const float r = bad ? __builtin_nanf("") : 1.0f / sqrtf(wave_sum(s) * (1.f / D) + EPS);
#pragma unroll
            for (int j = 0; j < 4; ++j) xr[64 * j] = v[j] * r * gr[64 * j];
        }
    }
}

extern "C" void kernel_launch(void* const* d_in, const int* in_sizes, int n_in, void* d_out, int out_size, void* d_ws, size_t ws_size, hipStream_t stream) {
    static int grid = 0;
    if (grid == 0) {
        if (n_in != 16 || in_sizes[0] != T * D || out_size != T * D || ws_size < WS_END) { fprintf(stderr, "kernel_launch: unexpected shapes (n_in %d, in0 %d, out %d, ws %zu)\n", n_in, n_in > 0 ? in_sizes[0] : -1, out_size, ws_size); grid = -1; return; }
        int dev = 0, cus = 0, per_cu = 0;
        if (hipGetDevice(&dev) != hipSuccess || hipDeviceGetAttribute(&cus, hipDeviceAttributeMultiprocessorCount, dev) != hipSuccess) { grid = -1; return; }
        if (hipFuncSetAttribute((const void*)fwd_kernel, hipFuncAttributeMaxDynamicSharedMemorySize, LDS_BYTES) != hipSuccess) { fprintf(stderr, "kernel_launch: hipFuncSetAttribute failed\n"); grid = -1; return; }
        if (hipOccupancyMaxActiveBlocksPerMultiprocessor(&per_cu, (const void*)fwd_kernel, NWAVES * 64, LDS_BYTES) != hipSuccess || per_cu < 1) { fprintf(stderr, "kernel_launch: occupancy query says %d\n", per_cu); }
        (void)hipGetLastError();
        grid = cus;
    }
    if (grid < 0) return;
    if (hipMemsetAsync((char*)d_ws + WS_CTL, 0, CTL_ZERO_BYTES, stream) != hipSuccess) return;
    Args a{};
    for (int i = 0; i < 16; ++i) a.in[i] = (const float*)d_in[i];
    a.out = (float*)d_out; a.ws = (unsigned char*)d_ws;
    hipLaunchKernelGGL(fwd_kernel, dim3(grid), dim3(NWAVES * 64), LDS_BYTES, stream, a);
}
```

```cpp
#include <hip/hip_runtime.h>
#include <cstdio>
#include <cstdint>

#define LAS __attribute__((address_space(3)))
#define GAS __attribute__((address_space(1)))
typedef unsigned short bf16;
typedef short bf16x8 __attribute__((ext_vector_type(8)));
typedef float f32x2 __attribute__((ext_vector_type(2)));
typedef float f32x4 __attribute__((ext_vector_type(4)));
typedef float f32x16 __attribute__((ext_vector_type(16)));
typedef unsigned u32x2 __attribute__((ext_vector_type(2)));
typedef unsigned u32x4 __attribute__((ext_vector_type(4)));
typedef GAS unsigned gu32;

constexpr int D = 1024, NB = 8, SEQ = 4096, T = NB * SEQ;
constexpr int NH = 4, DK = 256, DV = 512, QKW = 1024, VW = 2048, INW = 6144, CH = 128, NCH = SEQ / CH;
constexpr int FFD = 2816, NE = 8, FFE = 3584;
constexpr int MOE_ROWS = T + NE * 256;
constexpr float EPS = 1e-6f;

constexpr size_t MiB = 1u << 20;
constexpr size_t WS_CTL = 0, CTL_ZERO_BYTES = 1 * MiB;
constexpr size_t WS_ROT = 1 * MiB, WS_ROTT = 5 * MiB, WS_WC = 10 * MiB + 768 * 1024;
constexpr int RTP = SEQ + 64;
constexpr size_t WS_TOKE = 9 * MiB + 256 * 1024;
constexpr size_t WS_TOKW = WS_TOKE + 256 * 1024;
constexpr size_t WS_BCNT = WS_TOKW + 256 * 1024;
constexpr size_t WS_ROWTOK = WS_BCNT + 16 * 1024;
constexpr size_t WS_ROWGATE = WS_ROWTOK + 2 * MOE_ROWS * 4;
constexpr size_t WS_PCNT = 10 * MiB + 512 * 1024;
constexpr size_t WS_STATS = 11 * MiB;
static_assert(WS_ROWGATE + 2 * MOE_ROWS * 4 <= WS_PCNT, "small tables");
constexpr size_t WS_WIN = 12 * MiB, WS_WO = 24 * MiB, WS_WGU = 28 * MiB, WS_WD = 39 * MiB, WS_WF = 44 * MiB + 512 * 1024;
constexpr size_t WS_HN = 48 * MiB;
constexpr size_t WS_Q = 112 * MiB, WS_K = 176 * MiB, WS_KT = 240 * MiB  , WS_VT = 368 * MiB, WS_PC = 496 * MiB;
constexpr size_t WS_YG = 240 * MiB;
constexpr size_t WS_STATP = 176 * MiB;
constexpr size_t WS_ACTD = 112 * MiB;
constexpr size_t WS_Z2 = 112 * MiB, WS_WSEQ = 240 * MiB;
constexpr size_t WS_ACTM = 112 * MiB;
constexpr size_t WS_WMGU = 352 * MiB, WS_WMD = 464 * MiB, WS_END = 528 * MiB;
static_assert(WS_ACTM + (size_t)MOE_ROWS * FFE * 2 <= WS_WMGU, "moe act");
static_assert(WS_PC + (size_t)NB * NH * NCH * CH * CH * 2 <= 528 * MiB, "epoch A");
static_assert(WS_WF + (size_t)D * D * 2 <= WS_HN, "weights");
constexpr int CW_BAR = 4096;
constexpr int CW_CHK = 64;

constexpr int RING_BYTES = 131072;
constexpr int LDSCTL_OFF = 139264, MISC_OFF = LDSCTL_OFF + 320;
constexpr int LDS_BYTES = 147456;

#define LDS_WAIT() asm volatile("s_waitcnt lgkmcnt(0)" ::: "memory")
#define VM_WAIT() asm volatile("s_waitcnt vmcnt(0)" ::: "memory")
#define RLX_AGENT __ATOMIC_RELAXED, __HIP_MEMORY_SCOPE_AGENT

__device__ __forceinline__ unsigned cvt_pk_bf16(float lo, float hi) { unsigned r; asm volatile("v_cvt_pk_bf16_f32 %0, %1, %2" : "=v"(r) : "v"(lo), "v"(hi)); return r; }
__device__ __forceinline__ float bf_lo(unsigned w) { return __uint_as_float(w << 16); }
__device__ __forceinline__ float bf_hi(unsigned w) { return __uint_as_float(w & 0xffff0000u); }
__device__ __forceinline__ float fast_exp2(float x) { return __builtin_amdgcn_exp2f(x); }
__device__ __forceinline__ int lane_id_v() { int l; asm volatile("v_mbcnt_lo_u32_b32 %0, -1, 0\n\tv_mbcnt_hi_u32_b32 %0, -1, %0" : "=v"(l)); return l; }
__device__ __forceinline__ int tid_of(int wave_s) { asm volatile("" : "+s"(wave_s)); return wave_s * 64 + lane_id_v(); }
__device__ __forceinline__ int rot_col(int row, int tok) { return (tok + ((row & 15) << 11)) & (32768 - 1); }
__device__ __forceinline__ float silu_f(float v) { return v * __builtin_amdgcn_rcpf(1.0f + __builtin_amdgcn_exp2f(v * -1.44269504088896341f)); }

namespace pg8 {
constexpr int BM = 256, BK = 64, HALF = 128, HTB = HALF * BK * 2, STAGE_BYTES = 8 * HTB, NXCD = 8, WGM = 8;
__host__ __device__ __forceinline__ int lds_byte(int r, int c) { const int st = (r >> 4) * 2 + (c >> 5), rr = r & 15, cc = c & 31, ob = rr * 64 + cc * 2; return st * 1024 + (ob ^ (((ob >> 9) & 1) << 5)); }
__host__ __device__ __forceinline__ void stage_rc(int b, int& R, int& C) { const int st = b / 1024, sb = b % 1024, swz = sb ^ (((sb >> 9) & 1) << 5); R = (st >> 1) * 16 + swz / 64; C = (st & 1) * 32 + (swz % 64) / 2; }
__host__ __device__ __forceinline__ int perm32(int rho) { const int n = rho >> 4, i = rho & 15; return 8 * (i >> 2) + 4 * n + (i & 3); }

struct Unit { const GAS char* A; const GAS char* B; const GAS int* rows; int pm, pn, z; };

__device__ __forceinline__ bool tile_of(long L, int nM, int nN, int& pm, int& pn) {
    const int nwg = nM * nN; if (L >= nwg) return false;
    int wgid = (int)L; { const int q = nwg / NXCD, r = nwg % NXCD, xcd = wgid % NXCD, off = wgid / NXCD; wgid = (xcd < r ? xcd * (q + 1) : r * (q + 1) + (xcd - r) * q) + off; }
    const int nig = WGM * nN, gid = wgid / nig, fm = gid * WGM, gsz = (nM - fm) < WGM ? (nM - fm) : WGM;
    pm = fm + ((wgid % nig) % gsz); pn = (wgid % nig) / gsz; return true;
}

template <class Epi, class Sched, bool GATHER>
__device__ __forceinline__ void gemm_phase(LAS unsigned char* lds, const int wave_s, const int lda, const int ldb, const int K, const Sched& S, const Epi& E) {
    const int tid = tid_of(wave_s);
    const int wid = __builtin_amdgcn_readfirstlane(tid >> 6), lane = tid & 63, wr = wid >> 2, wc = wid & 3, fr = lane & 15, fq = lane >> 4;
    const int nt = K / BK;
    unsigned vA[2][2], vAn[2][2], voffB[2];
#pragma unroll
    for (int i = 0; i < 2; ++i) { int R, C; stage_rc(tid * 16 + i * 8192, R, C); const int Rb = Epi::PERM ? ((R & ~31) + perm32(R & 31)) : R;
        voffB[i] = (unsigned)(S.brow(Rb) * ldb + C) * 2u;
#pragma unroll
        for (int h = 0; h < 2; ++h) { vA[h][i] = (unsigned)((h * HALF + R) * lda + C) * 2u; vAn[h][i] = vA[h][i]; } }
    const size_t kstep = (size_t)(BK * 2);
    const size_t hstepB = (size_t)(S.brow(HALF) - S.brow(0)) * ldb * 2;
    const unsigned ldsw = (unsigned)wid * 1024u;
    const int aoff = lds_byte(wr * 64 + fr, fq * 8), boff = lds_byte(wc * 32 + fr, fq * 8);
#define PG8_SA(b, h) (((b) * 2 + (h)) * HTB)
#define PG8_SB(b, h) ((4 + (b) * 2 + (h)) * HTB)
#define PG8_STAGE_B(bufoff, gbase) do { _Pragma("unroll") for (int _i = 0; _i < 2; ++_i) \
        __builtin_amdgcn_global_load_lds((const GAS unsigned*)((const GAS char*)(gbase) + voffB[_i]), (LAS unsigned*)(lds + (bufoff) + ldsw + _i * 8192), 16, 0, 0); } while (0)
#define PG8_STAGE_A(bufoff, gbase, v0, v1) do { \
        __builtin_amdgcn_global_load_lds((const GAS unsigned*)((const GAS char*)(gbase) + (v0)), (LAS unsigned*)(lds + (bufoff) + ldsw), 16, 0, 0); \
        __builtin_amdgcn_global_load_lds((const GAS unsigned*)((const GAS char*)(gbase) + (v1)), (LAS unsigned*)(lds + (bufoff) + ldsw + 8192), 16, 0, 0); } while (0)
#define PG8_LDA(dst, b, h) do { _Pragma("unroll") for (int m = 0; m < 4; ++m) _Pragma("unroll") for (int k = 0; k < 2; ++k) dst[m][k] = *(const LAS bf16x8*)(lds + PG8_SA(b, h) + aoff + m * 2048 + k * 1024); } while (0)
#define PG8_LDB(dst, b, h) do { _Pragma("unroll") for (int n = 0; n < 2; ++n) _Pragma("unroll") for (int k = 0; k < 2; ++k) dst[n][k] = *(const LAS bf16x8*)(lds + PG8_SB(b, h) + boff + n * 2048 + k * 1024); } while (0)
#define PG8_MMA(ai, bj, At, Bt) do { __builtin_amdgcn_s_setprio(1); _Pragma("unroll") for (int m = 0; m < 4; ++m) _Pragma("unroll") for (int n = 0; n < 2; ++n) _Pragma("unroll") for (int k = 0; k < 2; ++k) \
        acc[ai][bj][m][n] = __builtin_amdgcn_mfma_f32_16x16x32_bf16(Bt[n][k], At[m][k], acc[ai][bj][m][n], 0, 0, 0); __builtin_amdgcn_s_setprio(0); } while (0)
#define PG8_WAIT_V(n) asm volatile("s_waitcnt vmcnt(" #n ")" ::: "memory")
#define PG8_WAIT_L(n) asm volatile("s_waitcnt lgkmcnt(" #n ")" ::: "memory")
#define PG8_BAR __builtin_amdgcn_s_barrier()
#define PG8_SCHED __builtin_amdgcn_sched_barrier(0)
#define PG8_LOADROWS(dst, u) do { if constexpr (GATHER) { const int _tz = tid_of(wave_s); _Pragma("unroll") for (int _i = 0; _i < 2; ++_i) { int _R, _C; stage_rc(_tz * 16 + _i * 8192, _R, _C); \
        _Pragma("unroll") for (int _h = 0; _h < 2; ++_h) { const int _t = (u).rows[_h * HALF + _R]; dst[_h][_i] = (unsigned)((_t < 0 ? 0 : _t) * lda + _C) * 2u; } } } } while (0)
#define PG8_VAN(h, i) (GATHER ? vAn[h][i] : vA[h][i])
    Unit cur, nxt; int ui = 0;
    if (!S.next(0, cur)) return;
    f32x4 acc[2][2][4][2];
#pragma unroll
    for (int a = 0; a < 2; ++a)
#pragma unroll
        for (int b = 0; b < 2; ++b)
#pragma unroll
            for (int m = 0; m < 4; ++m)
#pragma unroll
                for (int n = 0; n < 2; ++n) acc[a][b][m][n] = (f32x4){0.f, 0.f, 0.f, 0.f};
    bf16x8 At[4][2], B0[2][2], B1[2][2];
    const GAS char* cA = cur.A; const GAS char* cB = cur.B;
    PG8_LOADROWS(vA, cur);
    if constexpr (GATHER) { vAn[0][0] = vA[0][0]; vAn[0][1] = vA[0][1]; vAn[1][0] = vA[1][0]; vAn[1][1] = vA[1][1]; }
    PG8_STAGE_B(PG8_SB(0, 0), cB); PG8_STAGE_B(PG8_SB(0, 1), cB + hstepB); PG8_STAGE_A(PG8_SA(0, 0), cA, vA[0][0], vA[0][1]); PG8_STAGE_A(PG8_SA(0, 1), cA, vA[1][0], vA[1][1]);
    if (wr == 1) PG8_BAR;
    PG8_WAIT_V(2); PG8_BAR;
    PG8_STAGE_B(PG8_SB(1, 0), cB + kstep); PG8_STAGE_A(PG8_SA(1, 0), cA + kstep, vA[0][0], vA[0][1]); PG8_STAGE_B(PG8_SB(1, 1), cB + hstepB + kstep);
    PG8_WAIT_V(6); PG8_BAR;
    for (;;) {
        const bool has_next = S.next(ui + 1, nxt);
        const GAS char* nA = has_next ? nxt.A : cA; const GAS char* nB = has_next ? nxt.B : cB;
#pragma unroll 1
        for (int t = 0; t < nt; t += 2) {
            const bool last = (t == nt - 2);
            const GAS char* a1 = cA + (size_t)(t + 1) * kstep;
            const GAS char* a2 = last ? nA : cA + (size_t)(t + 2) * kstep; const GAS char* b2 = last ? nB : cB + (size_t)(t + 2) * kstep;
            const GAS char* a3 = a2 + kstep; const GAS char* b3 = b2 + kstep;
            if constexpr (GATHER) { if (last && has_next) { PG8_LOADROWS(vAn, nxt); } }
            PG8_LDB(B0, 0, 0); PG8_LDB(B1, 0, 1); PG8_SCHED; PG8_LDA(At, 0, 0); PG8_STAGE_A(PG8_SA(1, 1), a1, vA[1][0], vA[1][1]);
            PG8_WAIT_V(8); PG8_WAIT_L(0); PG8_BAR; PG8_MMA(0, 0, At, B0); PG8_MMA(0, 1, At, B1); PG8_BAR; PG8_SCHED;
            PG8_LDA(At, 0, 1); PG8_STAGE_B(PG8_SB(0, 0), b2); PG8_STAGE_B(PG8_SB(0, 1), b2 + hstepB); PG8_STAGE_A(PG8_SA(0, 0), a2, PG8_VAN(0, 0), PG8_VAN(0, 1));
            PG8_WAIT_V(8); PG8_WAIT_L(0); PG8_BAR; PG8_MMA(1, 0, At, B0); PG8_MMA(1, 1, At, B1); PG8_BAR; PG8_SCHED;
            PG8_LDB(B0, 1, 0); PG8_LDB(B1, 1, 1); PG8_SCHED; PG8_LDA(At, 1, 0); PG8_STAGE_A(PG8_SA(0, 1), a2, PG8_VAN(1, 0), PG8_VAN(1, 1));
            PG8_WAIT_V(8); PG8_WAIT_L(0); PG8_BAR; PG8_MMA(0, 0, At, B0); PG8_MMA(0, 1, At, B1); PG8_BAR; PG8_SCHED;
            PG8_LDA(At, 1, 1); PG8_STAGE_B(PG8_SB(1, 0), b3); PG8_STAGE_B(PG8_SB(1, 1), b3 + hstepB); PG8_STAGE_A(PG8_SA(1, 0), a3, PG8_VAN(0, 0), PG8_VAN(0, 1));
            PG8_WAIT_V(8); PG8_WAIT_L(0); PG8_BAR; PG8_MMA(1, 0, At, B0); PG8_MMA(1, 1, At, B1); PG8_BAR; PG8_SCHED;
        }
        if (wr == 0) PG8_BAR;
        E(acc, cur, wr, wc, fr, fq);
        if (!has_next) break;
#pragma unroll
        for (int a = 0; a < 2; ++a)
#pragma unroll
            for (int b = 0; b < 2; ++b)
#pragma unroll
                for (int m = 0; m < 4; ++m)
#pragma unroll
                    for (int n = 0; n < 2; ++n) acc[a][b][m][n] = (f32x4){0.f, 0.f, 0.f, 0.f};
        cur = nxt; cA = nA; cB = nB; ++ui;
        if constexpr (GATHER) { vA[0][0] = vAn[0][0]; vA[0][1] = vAn[0][1]; vA[1][0] = vAn[1][0]; vA[1][1] = vAn[1][1]; }
        if (wr == 1) PG8_BAR;
    }
    PG8_WAIT_V(0);
    PG8_BAR;
#undef PG8_SA
#undef PG8_SB
#undef PG8_STAGE_A
#undef PG8_STAGE_B
#undef PG8_LDA
#undef PG8_LDB
#undef PG8_MMA
#undef PG8_WAIT_V
#undef PG8_WAIT_L
#undef PG8_BAR
#undef PG8_SCHED
#undef PG8_LOADROWS
#undef PG8_VAN
}
}

struct SchedPlain {
    __device__ __forceinline__ int brow(int r) const { return r; }
    const GAS char* A; const GAS char* B; size_t a_tile, b_tile; int nM, nN, G, c;
    __device__ __forceinline__ bool next(int i, pg8::Unit& u) const {
        int pm, pn; if (!pg8::tile_of((long)i * G + c, nM, nN, pm, pn)) return false;
        u.pm = pm; u.pn = pn; u.z = 0; u.rows = nullptr; u.A = A + (size_t)pm * a_tile; u.B = B + (size_t)pn * b_tile; return true; }
};
struct SchedPc {
    __device__ __forceinline__ int brow(int r) const { return r; }
    const GAS char* Q; const GAS char* Kk; int G, c;
    __device__ __forceinline__ bool next(int i, pg8::Unit& u) const {
        const int L = i * G + c; if (L >= NB * NH * 16) return false;
        const int cp = L & 15, h = (L >> 4) & 3, b = L >> 6;
        const size_t off = ((size_t)(b * SEQ + cp * 256) * QKW + h * DK) * 2;
        u.pm = L; u.pn = 0; u.z = h; u.rows = nullptr; u.A = Q + off; u.B = Kk + off; return true; }
};
struct SchedFnA {
    __device__ __forceinline__ int brow(int r) const { return r; }
    const GAS char* Wc; const GAS char* Hn; int G, c;
    __device__ __forceinline__ bool next(int i, pg8::Unit& u) const {
        int pm, pn; if (!pg8::tile_of((long)i * G + c, 8, T / 256, pm, pn)) return false;
        const int g = pm >> 1, ri = pm & 1;
        u.pm = pm; u.pn = pn; u.z = 0; u.rows = nullptr; u.A = Wc + (size_t)ri * 256 * 256 * 2; u.B = Hn + ((size_t)pn * 256 * D + g * 256) * 2; return true; }
};
struct SchedFnB {
    __device__ __forceinline__ int brow(int r) const { return (r & 63) * 8 + (r >> 6); }
    GAS const char* WY; GAS const char* U; int G, c;
    __device__ __forceinline__ bool next(int i, pg8::Unit& u) const {
        int pm, pn; if (!pg8::tile_of((long)i * G + c, 2, 256, pm, pn)) return false;
        const int batch = pn >> 5, fb = (pn >> 1) & 15, kbb = pn & 1;
        u.pm = pm; u.pn = pn; u.z = 0; u.rows = nullptr; u.A = WY + (size_t)pm * 256 * 1024 * 2; u.B = U + ((size_t)(batch * 1024 + fb * 64) * 8 + kbb * 4) * 1024 * 2; return true; }
};
struct SchedMoe {
    __device__ __forceinline__ int brow(int r) const { return r; }
    const GAS char* A; const GAS char* W; const GAS int* rowtok; const LAS unsigned char* texp; size_t a_tile, w_exp, w_tile; int ntiles, ncol, G, c; bool gather;
    __device__ __forceinline__ bool next(int i, pg8::Unit& u) const {
        int rt, ct; if (!pg8::tile_of((long)i * G + c, ntiles, ncol, rt, ct)) return false;
        const int e = texp[rt];
        u.pm = rt; u.pn = ct; u.z = e; u.rows = rowtok + rt * 256; u.A = gather ? A : A + (size_t)rt * a_tile; u.B = W + (size_t)e * w_exp + (size_t)ct * w_tile; return true; }
};

struct EpiRopeQK {
    static constexpr bool PERM = true;
    GAS bf16* Q; GAS bf16* Kk; const GAS f32x2* rot;
    __device__ __forceinline__ void operator()(const f32x4 (&acc)[2][2][4][2], const pg8::Unit& u, int wr, int wc, int fr, int fq) const {
        const bool isk = u.pn >= 4; const int h = u.pn & 3; GAS bf16* dst = isk ? Kk : Q; const float sc = isk ? 0.0625f : 1.0f;
        const int i0 = wc * 32 + 8 * fq;
#pragma unroll
        for (int ai = 0; ai < 2; ++ai)
#pragma unroll
            for (int m = 0; m < 4; ++m) {
                const int t = u.pm * 256 + ai * 128 + wr * 64 + m * 16 + fr, s = t & (SEQ - 1);
                const GAS f32x4* rp = (const GAS f32x4*)(rot + (size_t)s * 128 + i0);
                const f32x4 r0 = rp[0], r1 = rp[1], r2 = rp[2], r3 = rp[3];
                const float cs[8] = {r0[0], r0[2], r1[0], r1[2], r2[0], r2[2], r3[0], r3[2]}, sn[8] = {r0[1], r0[3], r1[1], r1[3], r2[1], r2[3], r3[1], r3[3]};
                float o1[8], o2[8];
#pragma unroll
                for (int n = 0; n < 2; ++n)
#pragma unroll
                    for (int j = 0; j < 4; ++j) { const float t1 = acc[ai][0][m][n][j], t2 = acc[ai][1][m][n][j]; const int q = 4 * n + j;
                        o1[q] = (t1 * cs[q] - t2 * sn[q]) * sc; o2[q] = (t1 * sn[q] + t2 * cs[q]) * sc; }
                GAS bf16* rowp = dst + (size_t)t * QKW + h * DK + i0;
                u32x4 w1, w2; w1.x = cvt_pk_bf16(o1[0], o1[1]); w1.y = cvt_pk_bf16(o1[2], o1[3]); w1.z = cvt_pk_bf16(o1[4], o1[5]); w1.w = cvt_pk_bf16(o1[6], o1[7]);
                w2.x = cvt_pk_bf16(o2[0], o2[1]); w2.y = cvt_pk_bf16(o2[2], o2[3]); w2.z = cvt_pk_bf16(o2[4], o2[5]); w2.w = cvt_pk_bf16(o2[6], o2[7]);
                *(GAS u32x4*)rowp = w1; *(GAS u32x4*)(rowp + 128) = w2; }
    }
};
struct EpiRopeKT {
    static constexpr bool PERM = true;
    GAS bf16* KT; const GAS f32x2* rotT; const LAS float* l2g;
    __device__ __forceinline__ void operator()(const f32x4 (&acc)[2][2][4][2], const pg8::Unit& u, int wr, int wc, int fr, int fq) const {
        const int h = u.pm; const float l2f = l2g[h], l2b = l2g[4 + h];
#pragma unroll
        for (int bj = 0; bj < 2; ++bj) {
            const int tok0 = u.pn * 256 + bj * 128 + wc * 32 + 8 * fq, s0 = tok0 & (SEQ - 1), j0 = tok0 & (CH - 1);
            float zf[8], zb[8];
#pragma unroll
            for (int q = 0; q < 8; ++q) { zf[q] = fast_exp2((float)(CH - 1 - (j0 + q)) * l2f) * 0.0625f; zb[q] = fast_exp2((float)(j0 + q) * l2b) * 0.0625f; }
#pragma unroll
            for (int m = 0; m < 4; ++m) { const int i = wr * 64 + m * 16 + fr;
                const GAS f32x4* rp = (const GAS f32x4*)(rotT + (size_t)i * RTP + s0);
                const f32x4 r0 = rp[0], r1 = rp[1], r2 = rp[2], r3 = rp[3];
                const float cs[8] = {r0[0], r0[2], r1[0], r1[2], r2[0], r2[2], r3[0], r3[2]}, sn[8] = {r0[1], r0[3], r1[1], r1[3], r2[1], r2[3], r3[1], r3[3]};
                float o1[8], o2[8];
#pragma unroll
                for (int n = 0; n < 2; ++n)
#pragma unroll
                    for (int j = 0; j < 4; ++j) { const float t1 = acc[0][bj][m][n][j], t2 = acc[1][bj][m][n][j]; const int q = 4 * n + j;
                        o1[q] = t1 * cs[q] - t2 * sn[q]; o2[q] = t1 * sn[q] + t2 * cs[q]; }
                u32x4 w1, w2;
                w1.x = cvt_pk_bf16(o1[0] * zf[0], o1[1] * zf[1]); w1.y = cvt_pk_bf16(o1[2] * zf[2], o1[3] * zf[3]); w1.z = cvt_pk_bf16(o1[4] * zf[4], o1[5] * zf[5]); w1.w = cvt_pk_bf16(o1[6] * zf[6], o1[7] * zf[7]);
                w2.x = cvt_pk_bf16(o2[0] * zf[0], o2[1] * zf[1]); w2.y = cvt_pk_bf16(o2[2] * zf[2], o2[3] * zf[3]); w2.z = cvt_pk_bf16(o2[4] * zf[4], o2[5] * zf[5]); w2.w = cvt_pk_bf16(o2[6] * zf[6], o2[7] * zf[7]);
                const int tokr = rot_col(i, tok0);
                *(GAS u32x4*)(KT + (size_t)(h * DK + i) * T + tokr) = w1; *(GAS u32x4*)(KT + (size_t)(h * DK + 128 + i) * T + tokr) = w2;
                w1.x = cvt_pk_bf16(o1[0] * zb[0], o1[1] * zb[1]); w1.y = cvt_pk_bf16(o1[2] * zb[2], o1[3] * zb[3]); w1.z = cvt_pk_bf16(o1[4] * zb[4], o1[5] * zb[5]); w1.w = cvt_pk_bf16(o1[6] * zb[6], o1[7] * zb[7]);
                w2.x = cvt_pk_bf16(o2[0] * zb[0], o2[1] * zb[1]); w2.y = cvt_pk_bf16(o2[2] * zb[2], o2[3] * zb[3]); w2.z = cvt_pk_bf16(o2[4] * zb[4], o2[5] * zb[5]); w2.w = cvt_pk_bf16(o2[6] * zb[6], o2[7] * zb[7]);
                *(GAS u32x4*)(KT + (size_t)QKW * T + (size_t)(h * DK + i) * T + tokr) = w1; *(GAS u32x4*)(KT + (size_t)QKW * T + (size_t)(h * DK + 128 + i) * T + tokr) = w2; } }
    }
};
template <bool ROT> struct EpiBf16 {
    static constexpr bool PERM = true;
    GAS bf16* O; int ldc;
    __device__ __forceinline__ void operator()(const f32x4 (&acc)[2][2][4][2], const pg8::Unit& u, int wr, int wc, int fr, int fq) const {
#pragma unroll
        for (int ai = 0; ai < 2; ++ai)
#pragma unroll
            for (int m = 0; m < 4; ++m) { const int row = u.pm * 256 + ai * 128 + wr * 64 + m * 16 + fr; GAS bf16* rowp = O + (size_t)row * ldc;
#pragma unroll
                for (int bj = 0; bj < 2; ++bj) { const f32x4 v0 = acc[ai][bj][m][0], v1 = acc[ai][bj][m][1]; const int col = u.pn * 256 + bj * 128 + wc * 32 + 8 * fq;
                    u32x4 w; w.x = cvt_pk_bf16(v0[0], v0[1]); w.y = cvt_pk_bf16(v0[2], v0[3]); w.z = cvt_pk_bf16(v1[0], v1[1]); w.w = cvt_pk_bf16(v1[2], v1[3]);
                    *(GAS u32x4*)(rowp + (ROT ? rot_col(row, col) : col)) = w; } }
    }
};
struct EpiPc {
    static constexpr bool PERM = true;
    GAS bf16* PC; GAS bf16* PD; const LAS float* l2g;
    __device__ __forceinline__ void operator()(const f32x4 (&acc)[2][2][4][2], const pg8::Unit& u, int wr, int wc, int fr, int fq) const {
        const int h = u.z; const float l2f = l2g[h], l2b = l2g[4 + h];
#pragma unroll
        for (int ai = 0; ai < 2; ++ai)
#pragma unroll
            for (int m = 0; m < 4; ++m) { const int il = wr * 64 + m * 16 + fr, jl0 = wc * 32 + 8 * fq; float o[8];
                const bool diag = (wc == 2 * wr + (m >> 1));
#pragma unroll
                for (int n = 0; n < 2; ++n)
#pragma unroll
                    for (int j = 0; j < 4; ++j) { const int dl = il - (jl0 + 4 * n + j); const float f = dl >= 0 ? fast_exp2((float)dl * l2f) : fast_exp2((float)(-dl) * l2b);
                        o[4 * n + j] = (ai == 0 ? acc[0][0][m][n][j] : acc[1][1][m][n][j]) * f; }
                if (diag) {
                    float ob[8];
#pragma unroll
                    for (int q = 0; q < 8; ++q) { const bool lower = (jl0 + q) <= il; ob[q] = lower ? 0.f : o[q]; o[q] = lower ? o[q] : 0.f; }
                    u32x4 wb; wb.x = cvt_pk_bf16(ob[0], ob[1]); wb.y = cvt_pk_bf16(ob[2], ob[3]); wb.z = cvt_pk_bf16(ob[4], ob[5]); wb.w = cvt_pk_bf16(ob[6], ob[7]);
                    *(GAS u32x4*)(PD + (((size_t)(u.pm * 2 + ai) * 4 + (il >> 5)) * 32 + (il & 31)) * 32 + (jl0 & 31)) = wb;
                }
                u32x4 w; w.x = cvt_pk_bf16(o[0], o[1]); w.y = cvt_pk_bf16(o[2], o[3]); w.z = cvt_pk_bf16(o[4], o[5]); w.w = cvt_pk_bf16(o[6], o[7]);
                *(GAS u32x4*)(PC + ((size_t)(u.pm * 2 + ai) * 128 + il) * 128 + jl0) = w; }
    }
};
struct EpiGate {
    static constexpr bool PERM = true;
    const GAS bf16* Y; GAS bf16* YG; const GAS f32x2* statp; const GAS float* gain; LAS f32x2* sst;
    __device__ __forceinline__ void operator()(const f32x4 (&acc)[2][2][4][2], const pg8::Unit& u, int wr, int wc, int fr, int fq) const {
        const int head = u.pn >> 1, c0 = u.pn * 256 + wc * 32 + 8 * fq;
        const int tid = (wr * 4 + wc) * 64 + fq * 16 + fr;
        if (tid < 256) { const int t = u.pm * 256 + tid; const GAS f32x4* sp = (const GAS f32x4*)(statp + ((size_t)t * 4 + head) * 16); float a1 = 0.f, a2 = 0.f;
#pragma unroll
            for (int k = 0; k < 8; ++k) { const f32x4 v = sp[k]; a1 += v[0] + v[2]; a2 += v[1] + v[3]; }
            const float mu = a1 * (1.f / DV), var = fmaxf(a2 * (1.f / DV) - mu * mu, 0.f); sst[tid] = (f32x2){mu, __builtin_amdgcn_rsqf(var + EPS)}; }
        asm volatile("s_waitcnt lgkmcnt(0)" ::: "memory"); __builtin_amdgcn_s_barrier(); asm volatile("" ::: "memory");
        f32x4 gv[2][2];
#pragma unroll
        for (int bj = 0; bj < 2; ++bj) { gv[bj][0] = *(const GAS f32x4*)(gain + c0 + bj * 128); gv[bj][1] = *(const GAS f32x4*)(gain + c0 + bj * 128 + 4); }
#pragma unroll
        for (int ai = 0; ai < 2; ++ai)
#pragma unroll
            for (int m = 0; m < 4; ++m) { const int rl = ai * 128 + wr * 64 + m * 16 + fr, t = u.pm * 256 + rl; const f32x2 st = sst[rl];
#pragma unroll
                for (int bj = 0; bj < 2; ++bj) { const size_t off = (size_t)t * VW + c0 + bj * 128; const u32x4 yv = *(const GAS u32x4*)(Y + off);
                    const float y[8] = {bf_lo(yv.x), bf_hi(yv.x), bf_lo(yv.y), bf_hi(yv.y), bf_lo(yv.z), bf_hi(yv.z), bf_lo(yv.w), bf_hi(yv.w)}; float o[8];
#pragma unroll
                    for (int n = 0; n < 2; ++n)
#pragma unroll
                        for (int j = 0; j < 4; ++j) { const int q = 4 * n + j; const float yn = (y[q] - st.x) * st.y * gv[bj][n][j]; o[q] = silu_f(acc[ai][bj][m][n][j]) * yn; }
                    u32x4 w; w.x = cvt_pk_bf16(o[0], o[1]); w.y = cvt_pk_bf16(o[2], o[3]); w.z = cvt_pk_bf16(o[4], o[5]); w.w = cvt_pk_bf16(o[6], o[7]);
                    *(GAS u32x4*)(YG + off) = w; } }
    }
};
struct EpiResF32 {
    static constexpr bool PERM = false;
    const GAS float* base; GAS float* out;
    __device__ __forceinline__ void operator()(const f32x4 (&acc)[2][2][4][2], const pg8::Unit& u, int wr, int wc, int fr, int fq) const {
#pragma unroll
        for (int ai = 0; ai < 2; ++ai)
#pragma unroll
            for (int m = 0; m < 4; ++m) { const size_t off = (size_t)(u.pm * 256 + ai * 128 + wr * 64 + m * 16 + fr) * D + u.pn * 256 + wc * 32 + 4 * fq;
#pragma unroll
                for (int bj = 0; bj < 2; ++bj)
#pragma unroll
                    for (int n = 0; n < 2; ++n) { const f32x4 bs = *(const GAS f32x4*)(base + off + bj * 128 + n * 16); *(GAS f32x4*)(out + off + bj * 128 + n * 16) = bs + acc[ai][bj][m][n]; } }
    }
};
struct EpiSwiGLU {
    static constexpr bool PERM = true;
    GAS bf16* ACT; int ldc;
    __device__ __forceinline__ void operator()(const f32x4 (&acc)[2][2][4][2], const pg8::Unit& u, int wr, int wc, int fr, int fq) const {
#pragma unroll
        for (int ai = 0; ai < 2; ++ai)
#pragma unroll
            for (int m = 0; m < 4; ++m) { float o[8];
#pragma unroll
                for (int n = 0; n < 2; ++n)
#pragma unroll
                    for (int j = 0; j < 4; ++j) o[4 * n + j] = silu_f(acc[ai][0][m][n][j]) * acc[ai][1][m][n][j];
                u32x4 w; w.x = cvt_pk_bf16(o[0], o[1]); w.y = cvt_pk_bf16(o[2], o[3]); w.z = cvt_pk_bf16(o[4], o[5]); w.w = cvt_pk_bf16(o[6], o[7]);
                *(GAS u32x4*)(ACT + (size_t)(u.pm * 256 + ai * 128 + wr * 64 + m * 16 + fr) * ldc + u.pn * 128 + wc * 32 + 8 * fq) = w; }
    }
};
struct EpiZ2 {
    static constexpr bool PERM = true;
    GAS bf16* Z2;
    __device__ __forceinline__ void operator()(const f32x4 (&acc)[2][2][4][2], const pg8::Unit& u, int wr, int wc, int fr, int fq) const {
        const int g = u.pm >> 1, ri = u.pm & 1;
#pragma unroll
        for (int ai = 0; ai < 2; ++ai)
#pragma unroll
            for (int m = 0; m < 4; ++m) { const int cp = ai * 128 + wr * 64 + m * 16 + fr;
#pragma unroll
                for (int bj = 0; bj < 2; ++bj) { const int tok0 = u.pn * 256 + bj * 128 + wc * 32 + 8 * fq, b = tok0 >> 12, s0 = tok0 & (SEQ - 1);
                    const f32x4 v0 = acc[ai][bj][m][0], v1 = acc[ai][bj][m][1];
                    u32x4 w; w.x = cvt_pk_bf16(v0[0], v0[1]); w.y = cvt_pk_bf16(v0[2], v0[3]); w.z = cvt_pk_bf16(v1[0], v1[1]); w.w = cvt_pk_bf16(v1[2], v1[3]);
                    *(GAS u32x4*)(Z2 + ((size_t)(b * 1024 + g * 256 + cp) * 8192 + ri * SEQ + s0)) = w; } }
    }
};
struct EpiYf {
    static constexpr bool PERM = true;
    GAS bf16* YF;
    __device__ __forceinline__ void operator()(const f32x4 (&acc)[2][2][4][2], const pg8::Unit& u, int wr, int wc, int fr, int fq) const {
        const int batch = u.pn >> 5, fb = (u.pn >> 1) & 15, kbb = u.pn & 1;
#pragma unroll
        for (int ai = 0; ai < 2; ++ai)
#pragma unroll
            for (int m = 0; m < 4; ++m) { const int ka = u.pm * 256 + ai * 128 + wr * 64 + m * 16 + fr;
#pragma unroll
                for (int bj = 0; bj < 2; ++bj) { const int kb = kbb * 4 + 2 * bj + (wc >> 1), f = fb * 64 + 32 * (wc & 1) + 8 * fq;
                    const f32x4 v0 = acc[ai][bj][m][0], v1 = acc[ai][bj][m][1];
                    u32x4 w; w.x = cvt_pk_bf16(v0[0], v0[1]); w.y = cvt_pk_bf16(v0[2], v0[3]); w.z = cvt_pk_bf16(v1[0], v1[1]); w.w = cvt_pk_bf16(v1[2], v1[3]);
                    *(GAS u32x4*)(YF + (size_t)(batch * SEQ + 8 * ka + kb) * D + f) = w; } }
    }
};
struct EpiMoeDown {
    static constexpr bool PERM = false;
    GAS float* Hres; const GAS int* rowtok; const GAS float* rowgate;
    __device__ __forceinline__ void operator()(const f32x4 (&acc)[2][2][4][2], const pg8::Unit& u, int wr, int wc, int fr, int fq) const {
#pragma unroll
        for (int ai = 0; ai < 2; ++ai)
#pragma unroll
            for (int m = 0; m < 4; ++m) { const int row = u.pm * 256 + ai * 128 + wr * 64 + m * 16 + fr; const int tok = rowtok[row]; const float gw = rowgate[row];
                if (tok >= 0) { GAS float* rp = Hres + (size_t)tok * D + u.pn * 256 + wc * 32 + 4 * fq;
#pragma unroll
                    for (int bj = 0; bj < 2; ++bj)
#pragma unroll
                        for (int n = 0; n < 2; ++n) { const f32x4 bs = *(const GAS f32x4*)(rp + bj * 128 + n * 16); *(GAS f32x4*)(rp + bj * 128 + n * 16) = bs + gw * acc[ai][bj][m][n]; } } }
    }
};

#define XB_TMO      128
#define XB_XCNT(j)  (256  + 64 * (j))
#define XB_XSUB(j)  (1280 + 64 * (j))
#define XB_XGEN(j)  (2304 + 64 * (j))
#define XB_TOP      3328
#define XB_TOPGEN   3392
#define XCD_BAR_WORDS 3456
#define XB_SPIN_CAP (1u << 18)
__device__ __forceinline__ unsigned xb_ld(unsigned* p)              { return __hip_atomic_load(p, __ATOMIC_RELAXED, __HIP_MEMORY_SCOPE_AGENT); }
__device__ __forceinline__ unsigned xb_add(unsigned* p, unsigned v) { return __hip_atomic_fetch_add(p, v, __ATOMIC_RELAXED, __HIP_MEMORY_SCOPE_AGENT); }
__device__ __forceinline__ unsigned xb_xcc_id() { return (unsigned)__builtin_amdgcn_s_getreg((3 << 11) | 20) & 0xFu; }
#define XB_SPIN(cond, bar) do { unsigned _sp = 0; while (cond) { __builtin_amdgcn_s_sleep(1); \
    if ((++_sp & 255u) == 0u) { if (xb_ld(&(bar)[XB_TMO])) break; if (_sp > XB_SPIN_CAP) { atomicAdd(&(bar)[XB_TMO], 1u); break; } } } } while (0)
struct XcdBarrier { unsigned* bar; unsigned x; volatile LAS unsigned* st; };
__device__ __forceinline__ XcdBarrier xcd_barrier_post(unsigned* bar, volatile LAS unsigned* st, const bool t0) {
    XcdBarrier b; b.bar = bar; b.x = xb_xcc_id(); b.st = st;
    if (t0) (void)xb_add(&bar[XB_XCNT(b.x)], 1u);
    return b;
}
__device__ __forceinline__ void xcd_barrier_complete(unsigned* bar, unsigned x, unsigned& nloc, unsigned& nx) {
    const unsigned G = gridDim.x * gridDim.y * gridDim.z;
    unsigned sum, cnt, mine, sp = 0u;
    for (;;) {
        sum = 0u; cnt = 0u; mine = 0u;
#pragma unroll
        for (unsigned j = 0; j < 16; ++j) { const unsigned c = xb_ld(&bar[XB_XCNT(j)]); sum += c; cnt += (c > 0u) ? 1u : 0u; mine = (j == x) ? c : mine; }
        if (sum == G) break;
        __builtin_amdgcn_s_sleep(1);
        if ((++sp & 255u) == 0u) { if (xb_ld(&bar[XB_TMO])) break; if (sp > XB_SPIN_CAP) { atomicAdd(&bar[XB_TMO], 1u); break; } }
    }
    nloc = mine > 0u ? mine : 1u; nx = cnt > 0u ? cnt : 1u;
}
__device__ __forceinline__ void xcd_barrier(const XcdBarrier& b, const bool t0) {
    asm volatile("s_waitcnt vmcnt(0)" ::: "memory");
    __syncthreads();
    if (t0) {
        unsigned* bar = b.bar;
        __builtin_amdgcn_s_waitcnt(0);
        unsigned nloc = b.st[0], nx = b.st[1];
        if (nloc == 0u) { xcd_barrier_complete(bar, b.x, nloc, nx); b.st[0] = nloc; b.st[1] = nx; }
        const unsigned old = xb_add(&bar[XB_XSUB(b.x)], 1u);
        const unsigned gen = old / nloc;
        if (old + 1u == (gen + 1u) * nloc) {
            __builtin_amdgcn_fence(__ATOMIC_RELEASE, "agent");
            asm volatile("s_waitcnt vmcnt(0)" ::: "memory");
            const unsigned og = xb_add(&bar[XB_TOP], 1u);
            const unsigned tg = og / nx;
            if (og + 1u == (tg + 1u) * nx) xb_add(&bar[XB_TOPGEN], 1u);
            else XB_SPIN(xb_ld(&bar[XB_TOPGEN]) == tg, bar);
            __builtin_amdgcn_fence(__ATOMIC_ACQUIRE, "agent");
            xb_add(&bar[XB_XGEN(b.x)], 1u);
            asm volatile("s_waitcnt vmcnt(0)" ::: "memory");
        } else {
            XB_SPIN(xb_ld(&bar[XB_XGEN(b.x)]) == gen, bar);
            __builtin_amdgcn_fence(__ATOMIC_ACQUIRE, "agent");
            asm volatile("s_waitcnt vmcnt(0)" ::: "memory");
        }
    }
    __syncthreads();
}

__device__ __forceinline__ float wave_sum(float v) {
#pragma unroll
    for (int o = 1; o < 64; o <<= 1) v += __shfl_xor(v, o);
    return v;
}
__device__ __forceinline__ void transpose_item(const GAS float* W, int K, int N, GAS bf16* WT, int k0, int n0, int rbase, LAS float* scr, int lane) {
#pragma unroll 8
    for (int i = 0; i < 32; ++i) { const int kk = 2 * i + (lane >> 5); scr[kk * 33 + (lane & 31)] = W[(size_t)(k0 + kk) * N + n0 + (lane & 31)]; }
    LDS_WAIT(); asm volatile("" ::: "memory");
    const int c = lane & 7;
#pragma unroll
    for (int j = 0; j < 4; ++j) { const int n = (lane >> 3) + 8 * j; const LAS float* s = scr + (8 * c) * 33 + n;
        u32x4 o; o.x = cvt_pk_bf16(s[0 * 33], s[1 * 33]); o.y = cvt_pk_bf16(s[2 * 33], s[3 * 33]); o.z = cvt_pk_bf16(s[4 * 33], s[5 * 33]); o.w = cvt_pk_bf16(s[6 * 33], s[7 * 33]);
        *(GAS u32x4*)(WT + (size_t)(rbase + n) * K + k0 + 8 * c) = o; }
    LDS_WAIT(); asm volatile("" ::: "memory");
}
__device__ __forceinline__ void tr_plain(const GAS float* W, int K, int N, GAS bf16* WT, int it, LAS float* scr, int lane) {
    const int nblk = N / 32, kb = it / nblk, nb = it - kb * nblk; transpose_item(W, K, N, WT, 64 * kb, 32 * nb, 32 * nb, scr, lane);
}
__device__ __forceinline__ void tr_gu(const GAS float* Wg, const GAS float* Wu, int K, int N, GAS bf16* WT, int it, LAS float* scr, int lane) {
    const int nblk = N / 32, per = (K / 64) * nblk; const bool up = it >= per; if (up) it -= per;
    const int kb = it / nblk, nb = it - kb * nblk, f0 = 32 * nb;
    transpose_item(up ? Wu : Wg, K, N, WT, 64 * kb, f0, 256 * (f0 >> 7) + (up ? 128 : 0) + (f0 & 127), scr, lane);
}
__device__ __forceinline__ void rms_row(const GAS float* xrow, const GAS float* g, GAS bf16* orow, int lane, f32x4 (&v)[4]) {
    const GAS f32x4* xr = (const GAS f32x4*)xrow + lane; const GAS f32x4* gr = (const GAS f32x4*)g + lane;
    float s = 0.f;
#pragma unroll
    for (int j = 0; j < 4; ++j) { v[j] = xr[64 * j]; s += (v[j].x * v[j].x + v[j].y * v[j].y) + (v[j].z * v[j].z + v[j].w * v[j].w); }
    const float r = 1.0f / sqrtf(wave_sum(s) * (1.f / D) + EPS);
    GAS u32x2* o8 = (GAS u32x2*)orow + lane;
#pragma unroll
    for (int j = 0; j < 4; ++j) { v[j] = v[j] * r * gr[64 * j]; u32x2 w; w.x = cvt_pk_bf16(v[j].x, v[j].y); w.y = cvt_pk_bf16(v[j].z, v[j].w); o8[64 * j] = w; }
}

constexpr int SW_QL = 0, SW_SPITCH = 528, SW_SL = 128 * 528, SW_VPITCH = 272, SW_VL = SW_SL + 64 * SW_SPITCH, SW_VB = 64 * SW_VPITCH;
static_assert(SW_VL + 2 * SW_VB <= 139264, "sweep LDS");
__device__ __forceinline__ void sweep_unit(LAS unsigned char* lds, const GAS bf16* Qg, const GAS bf16* KTFg, const GAS bf16* KTBg, const GAS bf16* VTg, const GAS bf16* PCg, const GAS bf16* PDg, const GAS bf16* ZEROg, GAS bf16* Yg, GAS f32x2* statp, const float l2f, const float l2b, int b, int h, int es, const int wave_s) {
    const int tid = tid_of(wave_s);
    const int w = __builtin_amdgcn_readfirstlane(tid >> 6), lane = tid & 63, rb = w >> 1, cb = w & 1, r32 = lane & 31, hh = lane >> 5;
    const int vrow = tid >> 4, vpc = tid & 15;
    const int qrow = tid >> 5, qpc = tid & 31;
    const GAS bf16* qp = Qg + (size_t)(b * SEQ + qrow) * QKW + h * DK + 8 * qpc;
    const size_t kto = (size_t)(h * DK + 32 * w + r32) * T + 8 * hh; const int krot = b * SEQ + ((r32 & 15) << 11);
    const GAS bf16* vtp = VTg + (size_t)(h * DV + 64 * es + vrow) * T + 8 * vpc; const int vrot = b * SEQ + ((vrow & 15) << 11);
    const GAS bf16* pcp = PCg + ((size_t)((b * NH + h) * NCH) * 128 + rb * 32 + r32) * 128 + 8 * hh;
    const GAS bf16* pdp = PDg + (((size_t)((b * NH + h) * NCH) * 4 + rb) * 32 + r32) * 32 + 8 * hh;
#define SW_LDP(dst, s_, d_, nn_) do { const int jb_ = (s_) >> 1; const bool use_ = (d_) ? (jb_ >= rb) : (jb_ <= rb); const bool dg_ = (d_) && (jb_ == rb); \
        const GAS bf16* src_ = dg_ ? (pdp + (size_t)(nn_) * 4096 + 16 * ((s_) & 1)) : (pcp + (size_t)(nn_) * (CH * CH) + 16 * (s_)); \
        dst = *(const GAS bf16x8*)(use_ ? src_ : ZEROg); } while (0)
    GAS bf16* yp = Yg + (size_t)(b * SEQ + 32 * rb + r32) * VW + h * DV + 64 * es + 32 * cb + 4 * hh;
    GAS f32x2* stp = statp + ((size_t)(b * SEQ + 32 * rb + r32) * NH + h) * 16 + es * 2 + cb;
    const int il = 32 * rb + r32;
    const int qrd = SW_QL + il * SW_SPITCH + 16 * hh;
    bf16x8 pa[8], ka[8]; u32x4 vv[2], qv[4];
    f32x16 Sacc[2];
#pragma unroll
    for (int s = 0; s < 8; ++s) { SW_LDP(pa[s], s, 0, 0); ka[s] = *(const GAS bf16x8*)(KTFg + kto + (krot & (T - 1)) + 16 * s); }
#pragma unroll
    for (int it = 0; it < 2; ++it) vv[it] = *(const GAS u32x4*)(vtp + (size_t)(32 * it) * T + (vrot & (T - 1)));
#pragma unroll
    for (int it = 0; it < 2; ++it) *(LAS u32x4*)(lds + SW_VL + (vrow + 32 * it) * SW_VPITCH + vpc * 16) = vv[it];
#pragma unroll
    for (int hf = 0; hf < 2; ++hf) {
#pragma unroll
        for (int it = 0; it < 4; ++it) qv[it] = *(const GAS u32x4*)(qp + (size_t)(16 * (4 * hf + it)) * QKW);
#pragma unroll
        for (int it = 0; it < 4; ++it) { const int row = qrow + 16 * (4 * hf + it); *(LAS u32x4*)(lds + SW_QL + row * SW_SPITCH + qpc * 16) = qv[it]; }
    }
#pragma unroll
    for (int c = 0; c < 2; ++c)
#pragma unroll
        for (int t = 0; t < 16; ++t) Sacc[c][t] = 0.f;
#define SW_SCHED __builtin_amdgcn_sched_barrier(0)
#define SW_MFMA(a, b, c) c = __builtin_amdgcn_mfma_f32_32x32x16_bf16(a, b, c, 0, 0, 0)
    const int sl_rd = SW_SL + (32 * cb + r32) * SW_SPITCH + 16 * hh;
#pragma unroll 1
    for (int p = 0; p < 2 * NCH; ++p) {
        {
            const int dir = p >> 5, st = p & 31, n = dir ? NCH - 1 - st : st;
            const int pn = p + 1 < 2 * NCH ? p + 1 : p, dirn = pn >> 5, stn = pn & 31, nn = dirn ? NCH - 1 - stn : stn;
            const int cur = p & 1;
            const float l2 = dir ? l2b : l2f;
            const float xi = fast_exp2((float)(dir == 0 ? (il + 1) : (CH - il)) * l2), gC = st == 0 ? 0.f : fast_exp2((float)CH * l2);
#pragma unroll
            for (int c = 0; c < 2; ++c)
#pragma unroll
                for (int g = 0; g < 4; ++g) { u32x2 pk; pk.x = cvt_pk_bf16(Sacc[c][4 * g], Sacc[c][4 * g + 1]); pk.y = cvt_pk_bf16(Sacc[c][4 * g + 2], Sacc[c][4 * g + 3]);
                    if (st == 0) { pk.x = 0u; pk.y = 0u; }
                    *(LAS u32x2*)(lds + SW_SL + (32 * c + r32) * SW_SPITCH + (32 * w + 8 * g + 4 * hh) * 2) = pk; }
#pragma unroll
            for (int it = 0; it < 2; ++it) vv[it] = *(const GAS u32x4*)(vtp + (size_t)(32 * it) * T + ((nn * CH + vrot) & (T - 1)));
#pragma unroll
            for (int it = 0; it < 4; ++it) qv[it] = *(const GAS u32x4*)(qp + (size_t)(nn * CH + 16 * it) * QKW);
            u32x2 yf[4];
            GAS bf16* ypn = yp + (size_t)(n * CH) * VW;
            __syncthreads();
            f32x16 O;
#pragma unroll
            for (int t = 0; t < 16; ++t) O[t] = 0.f;
            bf16x8 sx[2], qx[2], sy[2], qy[2];
#define SW_LDC(ds, dq, g2) do { _Pragma("unroll") for (int k = 0; k < 2; ++k) { const int ks = 2 * (g2) + k; ds[k] = *(const LAS bf16x8*)(lds + sl_rd + 32 * ks); \
                dq[k] = *(const LAS bf16x8*)(lds + qrd + 32 * ks); } } while (0)
#define SW_MMC(ds, dq) do { SW_MFMA(ds[0], dq[0], O); SW_MFMA(ds[1], dq[1], O); } while (0)
            const int vl_rd = SW_VL + cur * SW_VB + (32 * cb + r32) * SW_VPITCH + 16 * hh;
            const int vu_rd = SW_VL + cur * SW_VB + r32 * SW_VPITCH + 16 * hh;
#define SW_LDV(dv, gp) do { dv[0] = *(const LAS bf16x8*)(lds + vl_rd + 32 * (2 * (gp))); dv[1] = *(const LAS bf16x8*)(lds + vl_rd + 32 * (2 * (gp) + 1)); } while (0)
#define SW_LDU(du, ug) do { du[0] = *(const LAS bf16x8*)(lds + vu_rd + ((ug) >> 2) * 32 * SW_VPITCH + 32 * (2 * ((ug) & 3))); du[1] = *(const LAS bf16x8*)(lds + vu_rd + ((ug) >> 2) * 32 * SW_VPITCH + 32 * (2 * ((ug) & 3) + 1)); } while (0)
            SW_LDC(sx, qx, 0); SW_LDC(sy, qy, 1); SW_SCHED;
            SW_MMC(sx, qx); SW_SCHED; SW_LDC(sx, qx, 2); SW_SCHED;
            SW_MMC(sy, qy); SW_SCHED; SW_LDC(sy, qy, 3); SW_SCHED;
            SW_MMC(sx, qx); SW_SCHED; SW_LDC(sx, qx, 4); SW_SCHED;
            SW_MMC(sy, qy); SW_SCHED; SW_LDC(sy, qy, 5); SW_SCHED;
            SW_MMC(sx, qx); SW_SCHED; SW_LDC(sx, qx, 6); SW_SCHED;
            SW_MMC(sy, qy); SW_SCHED; SW_LDC(sy, qy, 7); SW_SCHED;
            SW_MMC(sx, qx); SW_SCHED;
            bf16x8 vx[2], vy[2];
            SW_LDV(vx, 0); SW_SCHED;
            SW_MMC(sy, qy); SW_SCHED;
            SW_LDV(vy, 1); SW_SCHED;
            __syncthreads();
#pragma unroll
            for (int it = 0; it < 4; ++it) { const int row = qrow + 16 * it; *(LAS u32x4*)(lds + SW_QL + row * SW_SPITCH + qpc * 16) = qv[it]; }
#pragma unroll
            for (int it = 0; it < 4; ++it) qv[it] = *(const GAS u32x4*)(qp + (size_t)(nn * CH + 16 * (4 + it)) * QKW);
            if (dir) {
#pragma unroll
                for (int g = 0; g < 4; ++g) yf[g] = *(const GAS u32x2*)(ypn + 8 * g);
            }
#pragma unroll
            for (int t = 0; t < 16; ++t) O[t] *= xi;
#define SW_PV(s, vf) SW_MFMA(vf, pa[s], O)
            SW_PV(0, vx[0]); SW_PV(1, vx[1]); SW_SCHED; SW_LDV(vx, 2); SW_SCHED;
            SW_PV(2, vy[0]); SW_PV(3, vy[1]); SW_SCHED; SW_LDV(vy, 3); SW_SCHED;
            bf16x8 ux[2], uy[2];
            SW_PV(4, vx[0]); SW_PV(5, vx[1]); SW_SCHED; SW_LDU(ux, 0); SW_SCHED;
            SW_PV(6, vy[0]); SW_PV(7, vy[1]); SW_SCHED; SW_LDU(uy, 1); SW_SCHED;
#pragma unroll
            for (int s = 0; s < 8; ++s) SW_LDP(pa[s], s, dirn, nn);
#pragma unroll
            for (int c = 0; c < 2; ++c)
#pragma unroll
                for (int t = 0; t < 16; ++t) Sacc[c][t] *= gC;
            SW_SCHED;
#define SW_UP(ug, du) do { SW_MFMA(ka[2 * ((ug) & 3)], du[0], Sacc[(ug) >> 2]); SW_MFMA(ka[2 * ((ug) & 3) + 1], du[1], Sacc[(ug) >> 2]); } while (0)
            SW_UP(0, ux); SW_SCHED; SW_LDU(ux, 2); SW_SCHED;
            SW_UP(1, uy); SW_SCHED; SW_LDU(uy, 3); SW_SCHED;
            SW_UP(2, ux); SW_SCHED; SW_LDU(ux, 4); SW_SCHED;
            SW_UP(3, uy); SW_SCHED; SW_LDU(uy, 5); SW_SCHED;
            SW_UP(4, ux); SW_SCHED; SW_LDU(ux, 6); SW_SCHED;
            SW_UP(5, uy); SW_SCHED; SW_LDU(uy, 7); SW_SCHED;
            SW_UP(6, ux); SW_SCHED;
            SW_UP(7, uy); SW_SCHED;
            {
                const GAS bf16* ktn = (dirn ? KTBg : KTFg) + kto + ((nn * CH + krot) & (T - 1));
#pragma unroll
                for (int s = 0; s < 8; ++s) ka[s] = *(const GAS bf16x8*)(ktn + 16 * s);
            }
#pragma unroll
            for (int it = 0; it < 2; ++it) *(LAS u32x4*)(lds + SW_VL + (cur ^ 1) * SW_VB + (vrow + 32 * it) * SW_VPITCH + vpc * 16) = vv[it];
#pragma unroll
            for (int it = 0; it < 4; ++it) { const int row = qrow + 16 * (4 + it); *(LAS u32x4*)(lds + SW_QL + row * SW_SPITCH + qpc * 16) = qv[it]; }
            if (dir == 0) {
#pragma unroll
                for (int g = 0; g < 4; ++g) { u32x2 o; o.x = cvt_pk_bf16(O[4 * g], O[4 * g + 1]); o.y = cvt_pk_bf16(O[4 * g + 2], O[4 * g + 3]); *(GAS u32x2*)(ypn + 8 * g) = o; }
            } else {
                float s1 = 0.f, s2 = 0.f;
#pragma unroll
                for (int g = 0; g < 4; ++g) { const float y0 = bf_lo(yf[g].x) + O[4 * g], y1 = bf_hi(yf[g].x) + O[4 * g + 1], y2 = bf_lo(yf[g].y) + O[4 * g + 2], y3 = bf_hi(yf[g].y) + O[4 * g + 3];
                    s1 += (y0 + y1) + (y2 + y3); s2 += (y0 * y0 + y1 * y1) + (y2 * y2 + y3 * y3);
                    u32x2 o; o.x = cvt_pk_bf16(y0, y1); o.y = cvt_pk_bf16(y2, y3); *(GAS u32x2*)(ypn + 8 * g) = o; }
                s1 += __shfl_xor(s1, 32); s2 += __shfl_xor(s2, 32);
                if (hh == 0) stp[(size_t)(n * CH) * (NH * 16)] = (f32x2){s1, s2};
            }
        }
    }
#undef SW_LDC
#undef SW_MMC
#undef SW_LDV
#undef SW_LDU
#undef SW_PV
#undef SW_LDP
#undef SW_UP
#undef SW_MFMA
#undef SW_SCHED
    VM_WAIT();
    __syncthreads();
}

struct Args { const float* in[16]; float* out; unsigned char* ws; };
constexpr int NWAVES = 8;
#ifndef PHMASK
#define PHMASK 0xFFFFFFFFu
#endif
#define PH(k) (((PHMASK) >> (k)) & 1u)
__global__ void __launch_bounds__(NWAVES * 64, 2) fwd_kernel(Args args) {
    extern __shared__ __attribute__((aligned(16))) unsigned char lds_raw[];
    LAS unsigned char* lds = (LAS unsigned char*)lds_raw;
    LAS float* l2g = (LAS float*)(lds + LDSCTL_OFF + 64);
    const int wave_k = __builtin_amdgcn_readfirstlane((int)threadIdx.x >> 6);
#define PHASE_VARS \
    const int tid = tid_of(wave_k); const int lane = tid & 63; int wave = wave_k; asm volatile("" : "+s"(wave)); \
    const __attribute__((address_space(4))) Args* ka = (const __attribute__((address_space(4))) Args*)__builtin_amdgcn_kernarg_segment_ptr(); asm volatile("" : "+s"(ka)); \
    const int G = gridDim.x, bx = blockIdx.x; const int vcu = (G % 8 == 0) ? (bx % 8) * (G / 8) + bx / 8 : bx; const int gw = vcu * NWAVES + wave, NGW = G * NWAVES; \
    GAS unsigned char* ws = (GAS unsigned char*)ka->ws; asm volatile("" : "+s"(ws)); GAS float* hres = (GAS float*)ka->out; (void)lane; (void)gw; (void)NGW; (void)vcu; (void)hres; \
    const GAS float* x = (const GAS float*)ka->in[0]; const GAS float* mix_norm = (const GAS float*)ka->in[1]; const GAS float* ffn_norm = (const GAS float*)ka->in[2]; const GAS float* ret_w_in = (const GAS float*)ka->in[3]; const GAS float* ret_decay = (const GAS float*)ka->in[4]; \
    const GAS float* gn_gain = (const GAS float*)ka->in[5]; const GAS float* ret_w_out = (const GAS float*)ka->in[6]; const GAS float* d_wg = (const GAS float*)ka->in[7]; const GAS float* d_wu = (const GAS float*)ka->in[8]; const GAS float* d_wd = (const GAS float*)ka->in[9]; \
    const GAS float* fnet_w = (const GAS float*)ka->in[10]; const GAS float* moe_router = (const GAS float*)ka->in[11]; const GAS float* m_wg = (const GAS float*)ka->in[12]; const GAS float* m_wu = (const GAS float*)ka->in[13]; const GAS float* m_wd = (const GAS float*)ka->in[14]; const GAS float* final_norm = (const GAS float*)ka->in[15]; \
    (void)x; (void)mix_norm; (void)ffn_norm; (void)ret_w_in; (void)ret_decay; (void)gn_gain; (void)ret_w_out; (void)d_wg; (void)d_wu; (void)d_wd; (void)fnet_w; (void)moe_router; (void)m_wg; (void)m_wu; (void)m_wd; (void)final_norm; \
    GAS f32x2* rot = (GAS f32x2*)(ws + WS_ROT); GAS f32x2* rotT = (GAS f32x2*)(ws + WS_ROTT); GAS bf16* WC = (GAS bf16*)(ws + WS_WC); \
    GAS int* toke = (GAS int*)(ws + WS_TOKE); GAS float* tokw = (GAS float*)(ws + WS_TOKW); GAS int* bcnt = (GAS int*)(ws + WS_BCNT); GAS int* pcnt = (GAS int*)(ws + WS_PCNT); (void)pcnt; GAS int* rowtok = (GAS int*)(ws + WS_ROWTOK); GAS float* rowgate = (GAS float*)(ws + WS_ROWGATE); \
    GAS f32x2* statp = (GAS f32x2*)(ws + WS_STATP); \
    GAS bf16* WIN = (GAS bf16*)(ws + WS_WIN); GAS bf16* WO = (GAS bf16*)(ws + WS_WO); GAS bf16* WGU = (GAS bf16*)(ws + WS_WGU); GAS bf16* WD = (GAS bf16*)(ws + WS_WD); GAS bf16* WF = (GAS bf16*)(ws + WS_WF); \
    GAS bf16* HN = (GAS bf16*)(ws + WS_HN); GAS bf16* Qb = (GAS bf16*)(ws + WS_Q); GAS bf16* Kb = (GAS bf16*)(ws + WS_K); GAS bf16* KT = (GAS bf16*)(ws + WS_KT); GAS bf16* VT = (GAS bf16*)(ws + WS_VT); GAS bf16* PC = (GAS bf16*)(ws + WS_PC); \
    GAS bf16* Yb = (GAS bf16*)ka->out; GAS bf16* YG = (GAS bf16*)(ws + WS_YG); GAS bf16* ACTD = (GAS bf16*)(ws + WS_ACTD); GAS bf16* Z2 = (GAS bf16*)(ws + WS_Z2); GAS bf16* WSEQ = (GAS bf16*)(ws + WS_WSEQ); \
    GAS bf16* ACTM = (GAS bf16*)(ws + WS_ACTM); GAS bf16* WMGU = (GAS bf16*)(ws + WS_WMGU); GAS bf16* WMD = (GAS bf16*)(ws + WS_WMD); \
    (void)rot; (void)rotT; (void)WC; (void)toke; (void)tokw; (void)bcnt; (void)rowtok; (void)rowgate; (void)statp; (void)WIN; (void)WO; (void)WGU; (void)WD; (void)WF; (void)HN; (void)Qb; (void)Kb; (void)KT; (void)VT; (void)PC; \
    (void)Yb; (void)YG; (void)ACTD; (void)Z2; (void)WSEQ; (void)ACTM; (void)WMGU; (void)WMD;
#define GRID_BAR() do { const __attribute__((address_space(4))) Args* kb = (const __attribute__((address_space(4))) Args*)__builtin_amdgcn_kernarg_segment_ptr(); asm volatile("" : "+s"(kb)); GAS unsigned char* wsb = (GAS unsigned char*)kb->ws; XcdBarrier bar_; bar_.bar = (unsigned*)(wsb + WS_CTL) + CW_BAR; bar_.x = xb_xcc_id(); \
    bar_.st = (volatile LAS unsigned*)(lds + MISC_OFF) + 8; xcd_barrier(bar_, tid_of(wave_k) == 0); } while (0)

    {
        PHASE_VARS
        for (int u = tid; u < (LDS_BYTES - LDSCTL_OFF) / 4; u += NWAVES * 64) ((LAS unsigned*)(lds + LDSCTL_OFF))[u] = 0u;
        __syncthreads();
        if (tid < 8) { const float xl = ret_decay[tid]; const float ls = fminf(xl, 0.f) - log1pf(expf(-fabsf(xl))); l2g[tid] = ls * 1.44269504088896341f; }
        __syncthreads();
        (void)xcd_barrier_post((unsigned*)(ws + WS_CTL) + CW_BAR, (volatile LAS unsigned*)(lds + MISC_OFF) + 8, tid == 0);
    }

    if (PH(0)) {
        PHASE_VARS
        LAS float* scr = (LAS float*)(lds + wave * 16384);
        constexpr int I_IN = (D / 64) * (INW / 32), I_O = (VW / 64) * (D / 32), I_GU = 2 * (D / 64) * (FFD / 32), I_D = (FFD / 64) * (D / 32), I_F = (D / 64) * (D / 32);
        constexpr int NITEMS = I_IN + I_O + I_GU + I_D + I_F;
        for (int it = gw; it < NITEMS; it += NGW) {
            int r = it;
            if (r < I_IN) { tr_plain(ret_w_in, D, INW, WIN, r, scr, lane); continue; } r -= I_IN;
            if (r < I_O) { tr_plain(ret_w_out, VW, D, WO, r, scr, lane); continue; } r -= I_O;
            if (r < I_GU) { tr_gu(d_wg, d_wu, D, FFD, WGU, r, scr, lane); continue; } r -= I_GU;
            if (r < I_D) { tr_plain(d_wd, FFD, D, WD, r, scr, lane); continue; } r -= I_D;
            tr_plain(fnet_w, D, D, WF, r, scr, lane);
        }
        for (int e = (vcu * 512 + tid); e < SEQ * 128; e += G * 512) { const int s = e >> 7, i = e & 127;
            const float inv = powf(10000.0f, -(float)i / 128.0f); const float ang = (float)s * inv; float sn, cs; sincosf(ang, &sn, &cs);
            rot[e] = (f32x2){cs, sn}; rotT[(size_t)i * RTP + s] = (f32x2){cs, sn}; }
        for (int e = (vcu * 512 + tid); e < 512 * 256; e += G * 512) { const int r = e >> 8, c = e & 255, mm = ((r & 255) * c) & 255;
            const float v = r < 256 ? cospif((float)mm * (1.0f / 128.0f)) : -sinpif((float)mm * (1.0f / 128.0f)); WC[e] = (bf16)(cvt_pk_bf16(v, 0.f) & 0xffffu); }
        for (int m = gw; m < T; m += NGW) { f32x4 v[4]; rms_row(x + (size_t)m * D, mix_norm, HN + (size_t)m * D, lane, v); }
    }
    GRID_BAR();

    if (PH(1) && PH(19)) {
        PHASE_VARS
        SchedPlain S{(const GAS char*)HN, (const GAS char*)WIN, (size_t)256 * D * 2, (size_t)256 * D * 2, T / 256, 8, G, bx};
        EpiRopeQK E{Qb, Kb, rot};
        pg8::gemm_phase<EpiRopeQK, SchedPlain, false>(lds, wave_k, D, D, D, S, E);
    }
    if (PH(1) && PH(20)) {
        PHASE_VARS
        SchedPlain S{(const GAS char*)(WIN + (size_t)QKW * D), (const GAS char*)HN, (size_t)256 * D * 2, (size_t)256 * D * 2, 4, T / 256, G, bx};
        EpiRopeKT E{KT, rotT, l2g};
        pg8::gemm_phase<EpiRopeKT, SchedPlain, false>(lds, wave_k, D, D, D, S, E);
    }
    if (PH(1) && PH(21)) {
        PHASE_VARS
        SchedPlain S{(const GAS char*)(WIN + (size_t)2 * QKW * D), (const GAS char*)HN, (size_t)256 * D * 2, (size_t)256 * D * 2, 8, T / 256, G, bx};
        EpiBf16<true> E{VT, T};
        pg8::gemm_phase<EpiBf16<true>, SchedPlain, false>(lds, wave_k, D, D, D, S, E);
    }
    GRID_BAR();

    if (PH(2)) {
        PHASE_VARS
        SchedPc S{(const GAS char*)Qb, (const GAS char*)Kb, G, bx};
        EpiPc E{PC, (GAS bf16*)(ws + WS_ROT), l2g};
        pg8::gemm_phase<EpiPc, SchedPc, false>(lds, wave_k, QKW, QKW, DK, S, E);
    }
    GRID_BAR();

    if (PH(3)) {
        PHASE_VARS
        for (int u = vcu; u < NB * NH * 8; u += G) { const int hh_ = (u >> 3) & 3; const float l2f = l2g[hh_], l2b = l2g[4 + hh_];
            sweep_unit(lds, Qb, KT, KT + (size_t)QKW * T, VT, PC, (const GAS bf16*)(ws + WS_ROT), (const GAS bf16*)(ws + WS_CTL + 512 * 1024), Yb, statp, l2f, l2b, u >> 5, hh_, u & 7, wave_k); }
    }
    GRID_BAR();

    if (PH(5)) {
        PHASE_VARS
        SchedPlain S{(const GAS char*)HN, (const GAS char*)(WIN + (size_t)(2 * QKW + VW) * D), (size_t)256 * D * 2, (size_t)256 * D * 2, T / 256, 8, G, bx};
        EpiGate E{Yb, YG, statp, gn_gain, (LAS f32x2*)(lds + 135168)};
        pg8::gemm_phase<EpiGate, SchedPlain, false>(lds, wave_k, D, D, D, S, E);
    }
    GRID_BAR();

    if (PH(6)) {
        PHASE_VARS
        SchedPlain S{(const GAS char*)YG, (const GAS char*)WO, (size_t)256 * VW * 2, (size_t)256 * VW * 2, T / 256, 4, G, bx};
        EpiResF32 E{x, hres};
        pg8::gemm_phase<EpiResF32, SchedPlain, false>(lds, wave_k, VW, VW, VW, S, E);
    }
    GRID_BAR();

    if (PH(7)) {
        PHASE_VARS
        for (int m = gw; m < T; m += NGW) { f32x4 v[4]; rms_row(hres + (size_t)m * D, ffn_norm, HN + (size_t)m * D, lane, v); }
        LAS float* scr = (LAS float*)(lds + wave * 16384);
        constexpr int I_GU = 2 * (D / 64) * (FFE / 32), I_D = (FFE / 64) * (D / 32);
        for (int it = gw; it < NE * (I_GU + I_D); it += NGW) {
            const int e = it / (I_GU + I_D); int r = it - e * (I_GU + I_D);
            if (r < I_GU) tr_gu(m_wg + (size_t)e * D * FFE, m_wu + (size_t)e * D * FFE, D, FFE, WMGU + (size_t)e * 2 * FFE * D, r, scr, lane);
            else tr_plain(m_wd + (size_t)e * FFE * D, FFE, D, WMD + (size_t)e * D * FFE, r - I_GU, scr, lane);
        }
    }
    GRID_BAR();

    if (PH(8)) {
        PHASE_VARS
        SchedPlain S{(const GAS char*)HN, (const GAS char*)WGU, (size_t)256 * D * 2, (size_t)256 * D * 2, T / 256, 2 * FFD / 256, G, bx};
        EpiSwiGLU E{ACTD, FFD};
        pg8::gemm_phase<EpiSwiGLU, SchedPlain, false>(lds, wave_k, D, D, D, S, E);
    }
    GRID_BAR();
    if (PH(9)) {
        PHASE_VARS
        SchedPlain S{(const GAS char*)ACTD, (const GAS char*)WD, (size_t)256 * FFD * 2, (size_t)256 * FFD * 2, T / 256, 4, G, bx};
        EpiResF32 E{hres, hres};
        pg8::gemm_phase<EpiResF32, SchedPlain, false>(lds, wave_k, FFD, FFD, FFD, S, E);
    }
    GRID_BAR();

    if (PH(10)) {
        PHASE_VARS
        for (int m = gw; m < T; m += NGW) { f32x4 v[4]; rms_row(hres + (size_t)m * D, mix_norm + D, HN + (size_t)m * D, lane, v); }
        for (int e = vcu * 512 + tid; e < 512 * 1024; e += G * 512) { const int ka = e >> 10, c = e & 1023, a = c & 511, mm = (a * ka) & 511;
            const float v = (c < 512 ? cospif((float)mm * (1.0f / 256.0f)) : sinpif((float)mm * (1.0f / 256.0f))) * (1.0f / 1024.0f); WSEQ[e] = (bf16)(cvt_pk_bf16(v, 0.f) & 0xffffu); }
    }
    GRID_BAR();

    if (PH(11)) {
        PHASE_VARS
        SchedFnA S{(const GAS char*)WC, (const GAS char*)HN, G, bx};
        EpiZ2 E{Z2};
        pg8::gemm_phase<EpiZ2, SchedFnA, false>(lds, wave_k, 256, D, 256, S, E);
    }
    GRID_BAR();
    if (PH(22)) {
        PHASE_VARS
        float wc0[8], ws0[8];
#pragma unroll
        for (int kb = 0; kb < 8; ++kb) { const float ang = (float)((8 * lane * kb) & 4095) * (1.0f / 2048.0f); wc0[kb] = cospif(ang); ws0[kb] = sinpif(ang); }
        for (int rw = gw; rw < NB * 1024; rw += NGW) {
            GAS bf16* row = Z2 + (size_t)rw * 8192;
#pragma unroll
            for (int hq = 0; hq < 2; ++hq) {
                u32x2 zin[2][8], zout[8][2];
#pragma unroll
                for (int ri = 0; ri < 2; ++ri)
#pragma unroll
                    for (int bb = 0; bb < 8; ++bb) zin[ri][bb] = *(const GAS u32x2*)(row + ri * 4096 + 512 * bb + 8 * lane + 4 * hq);
#pragma unroll
                for (int q = 0; q < 2; ++q) {
                    float outr[2][8], outi[2][8];
#pragma unroll
                    for (int tt = 0; tt < 2; ++tt) {
                        const int t = 4 * hq + 2 * q + tt;
                        float zr[8], zi[8];
#pragma unroll
                        for (int bb = 0; bb < 8; ++bb) { const unsigned wr_ = zin[0][bb][q], wi_ = zin[1][bb][q]; zr[bb] = tt ? bf_hi(wr_) : bf_lo(wr_); zi[bb] = tt ? bf_hi(wi_) : bf_lo(wi_); }
#pragma unroll
                        for (int kb = 0; kb < 8; ++kb) {
                            float ur = 0.f, ui = 0.f;
#pragma unroll
                            for (int bb = 0; bb < 8; ++bb) {
                                const int m8 = (bb * kb) & 7;
                                const float c8 = (m8 == 0) ? 1.f : (m8 == 4) ? -1.f : (m8 == 2 || m8 == 6) ? 0.f : (m8 == 1 || m8 == 7) ? 0.70710678118654752f : -0.70710678118654752f;
                                const float s8 = (m8 == 0 || m8 == 4) ? 0.f : (m8 == 2) ? 1.f : (m8 == 6) ? -1.f : (m8 == 1 || m8 == 3) ? 0.70710678118654752f : -0.70710678118654752f;
                                ur += c8 * zr[bb] + s8 * zi[bb]; ui += c8 * zi[bb] - s8 * zr[bb]; }
                            const int mt = (t * kb);
                            const float ct = __builtin_cosf((float)mt * 0.00153398078788564123f), st_ = __builtin_sinf((float)mt * 0.00153398078788564123f);
                            const float twc = wc0[kb] * ct - ws0[kb] * st_, tws = ws0[kb] * ct + wc0[kb] * st_;
                            outr[tt][kb] = ur * twc + ui * tws; outi[tt][kb] = ui * twc - ur * tws; }
                    }
#pragma unroll
                    for (int kb = 0; kb < 8; ++kb) { zout[kb][0][q] = cvt_pk_bf16(outr[0][kb], outr[1][kb]); zout[kb][1][q] = cvt_pk_bf16(outi[0][kb], outi[1][kb]); }
                    __builtin_amdgcn_sched_barrier(0);
                }
#pragma unroll
                for (int kb = 0; kb < 8; ++kb)
#pragma unroll
                    for (int ri = 0; ri < 2; ++ri) *(GAS u32x2*)(row + kb * 1024 + ri * 512 + 8 * lane + 4 * hq) = zout[kb][ri];
                __builtin_amdgcn_sched_barrier(0);
            }
        }
    }
    GRID_BAR();
    if (PH(12)) {
        PHASE_VARS
        SchedFnB S{(GAS const char*)WSEQ, (GAS const char*)Z2, G, bx};
        EpiYf E{HN};
        pg8::gemm_phase<EpiYf, SchedFnB, false>(lds, wave_k, 1024, 1024, 1024, S, E);
    }
    GRID_BAR();
    if (PH(13)) {
        PHASE_VARS
        SchedPlain S{(const GAS char*)HN, (const GAS char*)WF, (size_t)256 * D * 2, (size_t)256 * D * 2, T / 256, 4, G, bx};
        EpiResF32 E{hres, hres};
        pg8::gemm_phase<EpiResF32, SchedPlain, false>(lds, wave_k, D, D, D, S, E);
    }
    GRID_BAR();

    if (PH(14)) {
        PHASE_VARS
        LAS float* wrl = (LAS float*)lds;
        LAS int* le = (LAS int*)(lds + 32768);
        for (int i = tid; i < D * NE / 4; i += NWAVES * 64) ((LAS f32x4*)wrl)[i] = ((const GAS f32x4*)moe_router)[i];
        for (int i = vcu * 512 + tid; i < 2 * MOE_ROWS; i += G * 512) rowtok[i] = -1;
        __syncthreads();
        for (int tb = vcu; tb < T / 128; tb += G) {
            for (int rr = 0; rr < 16; ++rr) { const int tl = wave * 16 + rr, m = tb * 128 + tl; f32x4 v[4];
                rms_row(hres + (size_t)m * D, ffn_norm + D, HN + (size_t)m * D, lane, v);
                float lg[8];
#pragma unroll
                for (int e = 0; e < 8; ++e) lg[e] = 0.f;
#pragma unroll
                for (int j = 0; j < 4; ++j)
#pragma unroll
                    for (int c = 0; c < 4; ++c) { const int col = 256 * j + 4 * lane + c; const f32x4 w0 = *(const LAS f32x4*)(wrl + col * 8), w1 = *(const LAS f32x4*)(wrl + col * 8 + 4); const float xv = v[j][c];
                        lg[0] += xv * w0.x; lg[1] += xv * w0.y; lg[2] += xv * w0.z; lg[3] += xv * w0.w; lg[4] += xv * w1.x; lg[5] += xv * w1.y; lg[6] += xv * w1.z; lg[7] += xv * w1.w; }
#pragma unroll
                for (int e = 0; e < 8; ++e) lg[e] = wave_sum(lg[e]);
                int e0 = 0; float b0 = lg[0];
#pragma unroll
                for (int e = 1; e < 8; ++e) if (lg[e] > b0) { b0 = lg[e]; e0 = e; }
                int e1 = -1; float b1 = -3.0e38f;
#pragma unroll
                for (int e = 0; e < 8; ++e) if (e != e0 && lg[e] > b1) { b1 = lg[e]; e1 = e; }
                const float w0 = 1.0f / (1.0f + __expf(b1 - b0));
                if (lane == 0) { toke[2 * m] = e0; toke[2 * m + 1] = e1; tokw[2 * m] = w0; tokw[2 * m + 1] = 1.0f - w0; le[tl] = e0; le[128 + tl] = e1; } }
            __syncthreads();
            if (tid < 16) { const int s = tid >> 3, e = tid & 7; int c = 0; for (int i = 0; i < 128; ++i) c += (le[s * 128 + i] == e) ? 1 : 0; bcnt[tb * 16 + tid] = c; }
            if (tid >= 64 && tid < 128) { const int pi = tid - 64; int c = 0; for (int i = 0; i < 128; ++i) c += (le[i] * 8 + le[128 + i] == pi) ? 1 : 0; pcnt[tb * 64 + pi] = c; }
            __syncthreads();
        }
    }
    GRID_BAR();

    LAS int* segoff = (LAS int*)(lds + 132096);
    LAS int* ntile = (LAS int*)(lds + 132096 + 64);
    LAS unsigned char* tile_e = (LAS unsigned char*)(lds + 132096 + 128);
    if (PH(15)) {
        PHASE_VARS
        LAS int* pfx = (LAS int*)lds;
        LAS int* cph = (LAS int*)(lds + 65792);
        LAS int* fq_ = (LAS int*)(lds + 65792 + 16384);
        LAS int* tot = fq_ + 64;
        LAS int* tpi = tot + 16;
        LAS int* tex = tpi + 128;
        for (int i = tid; i < 256 * 64; i += NWAVES * 64) pfx[i] = pcnt[i];
        __syncthreads();
        if (tid < 64) { int run = 0; for (int b2 = 0; b2 < 256; ++b2) { const int c = pfx[b2 * 64 + tid]; pfx[b2 * 64 + tid] = run; run += c; } pfx[256 * 64 + tid] = run; }
        __syncthreads();
        if (tid == 0) {
            int n0[8], d[8], r[8]; int rs = 0;
            for (int e = 0; e < 8; ++e) { int c = 0; for (int x2 = 0; x2 < 8; ++x2) c += pfx[256 * 64 + e * 8 + x2]; n0[e] = c; r[e] = c & 255; d[e] = -(c & 255); rs += c & 255; }
            int extra = rs >> 8;
            for (int k = 0; k < extra; ++k) { int be = -1, br = -1; for (int e = 0; e < 8; ++e) if (d[e] < 0 && d[e] == -r[e] && r[e] > br) { br = r[e]; be = e; } if (be >= 0) d[be] += 256; }
            for (int i = 0; i < 64; ++i) fq_[i] = 0;
            for (int a = 0; a < 8; ++a) for (int e = 0; e < 8; ++e) if (a != e && d[a] < 0 && d[e] > 0) { int fl = -d[a]; if (d[e] < fl) fl = d[e]; const int av = pfx[256 * 64 + a * 8 + e]; if (av < fl) fl = av; fq_[a * 8 + e] = fl; d[a] += fl; d[e] -= fl; }
        }
        __syncthreads();
        if (tid < 256) {
            int c0[8], c1[8];
#pragma unroll
            for (int e = 0; e < 8; ++e) { c0[e] = 0; c1[e] = 0; }
            for (int a = 0; a < 8; ++a) for (int e = 0; e < 8; ++e) { const int pi = a * 8 + e; const int cnt = pfx[(tid + 1) * 64 + pi] - pfx[tid * 64 + pi]; int fl = fq_[pi] - pfx[tid * 64 + pi]; fl = fl < 0 ? 0 : (fl > cnt ? cnt : fl);
#pragma unroll
                for (int q = 0; q < 8; ++q) { c0[q] += (q == a ? cnt - fl : 0) + (q == e ? fl : 0); c1[q] += (q == e ? cnt - fl : 0) + (q == a ? fl : 0); } }
#pragma unroll
            for (int e = 0; e < 8; ++e) { cph[tid * 16 + e] = c0[e]; cph[tid * 16 + 8 + e] = c1[e]; }
        }
        __syncthreads();
        if (tid < 16) { int run = 0; for (int b2 = 0; b2 < 256; ++b2) { const int c = cph[b2 * 16 + tid]; cph[b2 * 16 + tid] = run; run += c; } tot[tid] = run; }
        __syncthreads();
        if (tid < 2) { int off = 0, nt = 0; for (int e = 0; e < 8; ++e) { segoff[tid * 8 + e] = off; const int tl = (tot[tid * 8 + e] + 255) >> 8; for (int q = 0; q < tl; ++q) tile_e[tid * 160 + nt + q] = (unsigned char)e; nt += tl; off += tl * 256; } ntile[tid] = nt; }
        __syncthreads();
        for (int tb = vcu; tb < T / 128; tb += G) {
            int e0 = 0, e1 = 0, flip = 0;
            if (tid < 128) { const int m = tb * 128 + tid; e0 = toke[2 * m]; e1 = toke[2 * m + 1]; tpi[tid] = e0 * 8 + e1; }
            __syncthreads();
            if (tid < 128) { const int pi = e0 * 8 + e1; int rk = 0; for (int i = 0; i < tid; ++i) rk += (tpi[i] == pi) ? 1 : 0;
                flip = (pfx[tb * 64 + pi] + rk) < fq_[pi] ? 1 : 0; tex[tid] = flip ? e1 : e0; tex[128 + tid] = flip ? e0 : e1; }
            __syncthreads();
            if (tid < 128) { const int m = tb * 128 + tid;
#pragma unroll
                for (int ph = 0; ph < 2; ++ph) { const int e = tex[ph * 128 + tid]; int rk = 0; for (int i = 0; i < tid; ++i) rk += (tex[ph * 128 + i] == e) ? 1 : 0;
                    const int row = segoff[ph * 8 + e] + cph[tb * 16 + ph * 8 + e] + rk;
                    rowtok[ph * MOE_ROWS + row] = m; rowgate[ph * MOE_ROWS + row] = tokw[2 * m + (ph ^ flip)]; } }
            __syncthreads();
        }
    }
    GRID_BAR();

    if (PH(16))
#pragma unroll
    for (int s = 0; s < 2; ++s) {
        {
            PHASE_VARS
            SchedMoe S{(const GAS char*)HN, (const GAS char*)WMGU, rowtok + s * MOE_ROWS, tile_e + s * 160, 0, (size_t)2 * FFE * D * 2, (size_t)256 * D * 2, ntile[s], 2 * FFE / 256, G, bx, true};
            EpiSwiGLU E{ACTM, FFE};
            pg8::gemm_phase<EpiSwiGLU, SchedMoe, true>(lds, wave_k, D, D, D, S, E);
        }
        GRID_BAR();
        {
            PHASE_VARS
            SchedMoe S{(const GAS char*)ACTM, (const GAS char*)WMD, rowtok + s * MOE_ROWS, tile_e + s * 160, (size_t)256 * FFE * 2, (size_t)D * FFE * 2, (size_t)256 * FFE * 2, ntile[s], 4, G, bx, false};
            EpiMoeDown E{hres, rowtok + s * MOE_ROWS, rowgate + s * MOE_ROWS};
            pg8::gemm_phase<EpiMoeDown, SchedMoe, false>(lds, wave_k, FFE, FFE, FFE, S, E);
        }
        GRID_BAR();
    }

    if (PH(17)) {
        PHASE_VARS
        const bool bad = __hip_atomic_load((GAS unsigned*)(ws + WS_CTL) + CW_BAR + XB_TMO, RLX_AGENT) != 0u;
        for (int m = gw; m < T; m += NGW) {
            GAS f32x4* xr = (GAS f32x4*)(hres + (size_t)m * D) + lane; const GAS f32x4* gr = (const GAS f32x4*)final_norm + lane;
            f32x4 v[4]; float s = 0.f;
#pragma unroll
            for (int j = 0; j < 4; ++j) { v[j] = xr[64 * j]; s += (v[j].x * v[j].x + v[j].y * v[j].y) + (v[j].z * v[j].z + v[j].w * v[j].w); }
            const float r = bad ? __builtin_nanf("") : 1.0f / sqrtf(wave_sum(s) * (1.f / D) + EPS);
#pragma unroll
            for (int j = 0; j < 4; ++j) xr[64 * j] = v[j] * r * gr[64 * j];
        }
    }
}

extern "C" void kernel_launch(void* const* d_in, const int* in_sizes, int n_in, void* d_out, int out_size, void* d_ws, size_t ws_size, hipStream_t stream) {
    static int grid = 0;
    if (grid == 0) {
        if (n_in != 16 || in_sizes[0] != T * D || out_size != T * D || ws_size < WS_END) { fprintf(stderr, "kernel_launch: unexpected shapes (n_in %d, in0 %d, out %d, ws %zu)\n", n_in, n_in > 0 ? in_sizes[0] : -1, out_size, ws_size); grid = -1; return; }
        int dev = 0, cus = 0, per_cu = 0;
        if (hipGetDevice(&dev) != hipSuccess || hipDeviceGetAttribute(&cus, hipDeviceAttributeMultiprocessorCount, dev) != hipSuccess) { grid = -1; return; }
        if (hipFuncSetAttribute((const void*)fwd_kernel, hipFuncAttributeMaxDynamicSharedMemorySize, LDS_BYTES) != hipSuccess) { fprintf(stderr, "kernel_launch: hipFuncSetAttribute failed\n"); grid = -1; return; }
        if (hipOccupancyMaxActiveBlocksPerMultiprocessor(&per_cu, (const void*)fwd_kernel, NWAVES * 64, LDS_BYTES) != hipSuccess || per_cu < 1) { fprintf(stderr, "kernel_launch: occupancy query says %d\n", per_cu); }
        (void)hipGetLastError();
        grid = cus;
    }
    if (grid < 0) return;
    if (hipMemsetAsync((char*)d_ws + WS_CTL, 0, CTL_ZERO_BYTES, stream) != hipSuccess) return;
    Args a{};
    for (int i = 0; i < 16; ++i) a.in[i] = (const float*)d_in[i];
    a.out = (float*)d_out; a.ws = (unsigned char*)d_ws;
    hipLaunchKernelGGL(fwd_kernel, dim3(grid), dim3(NWAVES * 64), LDS_BYTES, stream, a);
}
```

```cpp
#include <hip/hip_runtime.h>
#include <cstdio>
#include <cstdint>

#define LAS __attribute__((address_space(3)))
#define GAS __attribute__((address_space(1)))
typedef unsigned short bf16;
typedef short bf16x8 __attribute__((ext_vector_type(8)));
typedef float f32x2 __attribute__((ext_vector_type(2)));
typedef float f32x4 __attribute__((ext_vector_type(4)));
typedef float f32x16 __attribute__((ext_vector_type(16)));
typedef unsigned u32x2 __attribute__((ext_vector_type(2)));
typedef unsigned u32x4 __attribute__((ext_vector_type(4)));
typedef GAS unsigned gu32;

constexpr int D = 1024, NB = 8, SEQ = 4096, T = NB * SEQ;
constexpr int NH = 4, DK = 256, DV = 512, QKW = 1024, VW = 2048, INW = 6144, CH = 128, NCH = SEQ / CH;
constexpr int FFD = 2816, NE = 8, FFE = 3584;
constexpr int MOE_ROWS = T + NE * 256;
constexpr float EPS = 1e-6f;

constexpr size_t MiB = 1u << 20;
constexpr size_t WS_CTL = 0, CTL_ZERO_BYTES = 1 * MiB;
constexpr size_t WS_ROT = 1 * MiB, WS_ROTT = 5 * MiB, WS_WC = 10 * MiB + 768 * 1024;
constexpr int RTP = SEQ + 64;
constexpr size_t WS_TOKE = 9 * MiB + 256 * 1024;
constexpr size_t WS_TOKW = WS_TOKE + 256 * 1024;
constexpr size_t WS_BCNT = WS_TOKW + 256 * 1024;
constexpr size_t WS_ROWTOK = WS_BCNT + 16 * 1024;
constexpr size_t WS_ROWGATE = WS_ROWTOK + 2 * MOE_ROWS * 4;
constexpr size_t WS_PCNT = 10 * MiB + 512 * 1024;
constexpr size_t WS_STATS = 11 * MiB;
static_assert(WS_ROWGATE + 2 * MOE_ROWS * 4 <= WS_PCNT, "small tables");
constexpr size_t WS_WIN = 12 * MiB, WS_WO = 24 * MiB, WS_WGU = 28 * MiB, WS_WD = 39 * MiB, WS_WF = 44 * MiB + 512 * 1024;
constexpr size_t WS_HN = 48 * MiB;
constexpr size_t WS_Q = 112 * MiB, WS_K = 176 * MiB, WS_KT = 240 * MiB  , WS_VT = 368 * MiB, WS_PC = 496 * MiB;
constexpr size_t WS_YG = 240 * MiB;
constexpr size_t WS_STATP = 176 * MiB;
constexpr size_t WS_ACTD = 112 * MiB;
constexpr size_t WS_Z2 = 112 * MiB, WS_WSEQ = 240 * MiB;
constexpr size_t WS_ACTM = 112 * MiB;
constexpr size_t WS_WMGU = 352 * MiB, WS_WMD = 464 * MiB, WS_END = 528 * MiB;
static_assert(WS_ACTM + (size_t)MOE_ROWS * FFE * 2 <= WS_WMGU, "moe act");
static_assert(WS_PC + (size_t)NB * NH * NCH * CH * CH * 2 <= 528 * MiB, "epoch A");
static_assert(WS_WF + (size_t)D * D * 2 <= WS_HN, "weights");
constexpr int CW_BAR = 4096;
constexpr int CW_CHK = 64;

constexpr int RING_BYTES = 131072;
constexpr int LDSCTL_OFF = 139264, MISC_OFF = LDSCTL_OFF + 320;
constexpr int LDS_BYTES = 147456;

#define LDS_WAIT() asm volatile("s_waitcnt lgkmcnt(0)" ::: "memory")
#define VM_WAIT() asm volatile("s_waitcnt vmcnt(0)" ::: "memory")
#define RLX_AGENT __ATOMIC_RELAXED, __HIP_MEMORY_SCOPE_AGENT

__device__ __forceinline__ unsigned cvt_pk_bf16(float lo, float hi) { unsigned r; asm volatile("v_cvt_pk_bf16_f32 %0, %1, %2" : "=v"(r) : "v"(lo), "v"(hi)); return r; }
__device__ __forceinline__ float bf_lo(unsigned w) { return __uint_as_float(w << 16); }
__device__ __forceinline__ float bf_hi(unsigned w) { return __uint_as_float(w & 0xffff0000u); }
__device__ __forceinline__ float fast_exp2(float x) { return __builtin_amdgcn_exp2f(x); }
__device__ __forceinline__ int lane_id_v() { int l; asm volatile("v_mbcnt_lo_u32_b32 %0, -1, 0\n\tv_mbcnt_hi_u32_b32 %0, -1, %0" : "=v"(l)); return l; }
__device__ __forceinline__ int tid_of(int wave_s) { asm volatile("" : "+s"(wave_s)); return wave_s * 64 + lane_id_v(); }
__device__ __forceinline__ int rot_col(int row, int tok) { return (tok + ((row & 15) << 11)) & (32768 - 1); }
__device__ __forceinline__ float silu_f(float v) { return v * __builtin_amdgcn_rcpf(1.0f + __builtin_amdgcn_exp2f(v * -1.44269504088896341f)); }

namespace pg8 {
constexpr int BM = 256, BK = 64, HALF = 128, HTB = HALF * BK * 2, STAGE_BYTES = 8 * HTB, NXCD = 8, WGM = 8;
__host__ __device__ __forceinline__ int lds_byte(int r, int c) { const int st = (r >> 4) * 2 + (c >> 5), rr = r & 15, cc = c & 31, ob = rr * 64 + cc * 2; return st * 1024 + (ob ^ (((ob >> 9) & 1) << 5)); }
__host__ __device__ __forceinline__ void stage_rc(int b, int& R, int& C) { const int st = b / 1024, sb = b % 1024, swz = sb ^ (((sb >> 9) & 1) << 5); R = (st >> 1) * 16 + swz / 64; C = (st & 1) * 32 + (swz % 64) / 2; }
__host__ __device__ __forceinline__ int perm32(int rho) { const int n = rho >> 4, i = rho & 15; return 8 * (i >> 2) + 4 * n + (i & 3); }

struct Unit { const GAS char* A; const GAS char* B; const GAS int* rows; int pm, pn, z; };

__device__ __forceinline__ bool tile_of(long L, int nM, int nN, int& pm, int& pn) {
    const int nwg = nM * nN; if (L >= nwg) return false;
    int wgid = (int)L; { const int q = nwg / NXCD, r = nwg % NXCD, xcd = wgid % NXCD, off = wgid / NXCD; wgid = (xcd < r ? xcd * (q + 1) : r * (q + 1) + (xcd - r) * q) + off; }
    const int nig = WGM * nN, gid = wgid / nig, fm = gid * WGM, gsz = (nM - fm) < WGM ? (nM - fm) : WGM;
    pm = fm + ((wgid % nig) % gsz); pn = (wgid % nig) / gsz; return true;
}

template <class Epi, class Sched, bool GATHER>
__device__ __forceinline__ void gemm_phase(LAS unsigned char* lds, const int wave_s, const int lda, const int ldb, const int K, const Sched& S, const Epi& E) {
    const int tid = tid_of(wave_s);
    const int wid = __builtin_amdgcn_readfirstlane(tid >> 6), lane = tid & 63, wr = wid >> 2, wc = wid & 3, fr = lane & 15, fq = lane >> 4;
    const int nt = K / BK;
    unsigned vA[2][2], vAn[2][2], voffB[2];
#pragma unroll
    for (int i = 0; i < 2; ++i) { int R, C; stage_rc(tid * 16 + i * 8192, R, C); const int Rb = Epi::PERM ? ((R & ~31) + perm32(R & 31)) : R;
        voffB[i] = (unsigned)(S.brow(Rb) * ldb + C) * 2u;
#pragma unroll
        for (int h = 0; h < 2; ++h) { vA[h][i] = (unsigned)((h * HALF + R) * lda + C) * 2u; vAn[h][i] = vA[h][i]; } }
    const size_t kstep = (size_t)(BK * 2);
    const size_t hstepB = (size_t)(S.brow(HALF) - S.brow(0)) * ldb * 2;
    const unsigned ldsw = (unsigned)wid * 1024u;
    const int aoff = lds_byte(wr * 64 + fr, fq * 8), boff = lds_byte(wc * 32 + fr, fq * 8);
#define PG8_SA(b, h) (((b) * 2 + (h)) * HTB)
#define PG8_SB(b, h) ((4 + (b) * 2 + (h)) * HTB)
#define PG8_STAGE_B(bufoff, gbase) do { _Pragma("unroll") for (int _i = 0; _i < 2; ++_i) \
        __builtin_amdgcn_global_load_lds((const GAS unsigned*)((const GAS char*)(gbase) + voffB[_i]), (LAS unsigned*)(lds + (bufoff) + ldsw + _i * 8192), 16, 0, 0); } while (0)
#define PG8_STAGE_A(bufoff, gbase, v0, v1) do { \
        __builtin_amdgcn_global_load_lds((const GAS unsigned*)((const GAS char*)(gbase) + (v0)), (LAS unsigned*)(lds + (bufoff) + ldsw), 16, 0, 0); \
        __builtin_amdgcn_global_load_lds((const GAS unsigned*)((const GAS char*)(gbase) + (v1)), (LAS unsigned*)(lds + (bufoff) + ldsw + 8192), 16, 0, 0); } while (0)
#define PG8_LDA(dst, b, h) do { _Pragma("unroll") for (int m = 0; m < 4; ++m) _Pragma("unroll") for (int k = 0; k < 2; ++k) dst[m][k] = *(const LAS bf16x8*)(lds + PG8_SA(b, h) + aoff + m * 2048 + k * 1024); } while (0)
#define PG8_LDB(dst, b, h) do { _Pragma("unroll") for (int n = 0; n < 2; ++n) _Pragma("unroll") for (int k = 0; k < 2; ++k) dst[n][k] = *(const LAS bf16x8*)(lds + PG8_SB(b, h) + boff + n * 2048 + k * 1024); } while (0)
#define PG8_MMA(ai, bj, At, Bt) do { __builtin_amdgcn_s_setprio(1); _Pragma("unroll") for (int m = 0; m < 4; ++m) _Pragma("unroll") for (int n = 0; n < 2; ++n) _Pragma("unroll") for (int k = 0; k < 2; ++k) \
        acc[ai][bj][m][n] = __builtin_amdgcn_mfma_f32_16x16x32_bf16(Bt[n][k], At[m][k], acc[ai][bj][m][n], 0, 0, 0); __builtin_amdgcn_s_setprio(0); } while (0)
#define PG8_WAIT_V(n) asm volatile("s_waitcnt vmcnt(" #n ")" ::: "memory")
#define PG8_WAIT_L(n) asm volatile("s_waitcnt lgkmcnt(" #n ")" ::: "memory")
#define PG8_BAR __builtin_amdgcn_s_barrier()
#define PG8_SCHED __builtin_amdgcn_sched_barrier(0)
#define PG8_LOADROWS(dst, u) do { if constexpr (GATHER) { const int _tz = tid_of(wave_s); _Pragma("unroll") for (int _i = 0; _i < 2; ++_i) { int _R, _C; stage_rc(_tz * 16 + _i * 8192, _R, _C); \
        _Pragma("unroll") for (int _h = 0; _h < 2; ++_h) { const int _t = (u).rows[_h * HALF + _R]; dst[_h][_i] = (unsigned)((_t < 0 ? 0 : _t) * lda + _C) * 2u; } } } } while (0)
#define PG8_VAN(h, i) (GATHER ? vAn[h][i] : vA[h][i])
    Unit cur, nxt; int ui = 0;
    if (!S.next(0, cur)) return;
    f32x4 acc[2][2][4][2];
#pragma unroll
    for (int a = 0; a < 2; ++a)
#pragma unroll
        for (int b = 0; b < 2; ++b)
#pragma unroll
            for (int m = 0; m < 4; ++m)
#pragma unroll
                for (int n = 0; n < 2; ++n) acc[a][b][m][n] = (f32x4){0.f, 0.f, 0.f, 0.f};
    bf16x8 At[4][2], B0[2][2], B1[2][2];
    const GAS char* cA = cur.A; const GAS char* cB = cur.B;
    PG8_LOADROWS(vA, cur);
    if constexpr (GATHER) { vAn[0][0] = vA[0][0]; vAn[0][1] = vA[0][1]; vAn[1][0] = vA[1][0]; vAn[1][1] = vA[1][1]; }
    PG8_STAGE_B(PG8_SB(0, 0), cB); PG8_STAGE_B(PG8_SB(0, 1), cB + hstepB); PG8_STAGE_A(PG8_SA(0, 0), cA, vA[0][0], vA[0][1]); PG8_STAGE_A(PG8_SA(0, 1), cA, vA[1][0], vA[1][1]);
    if (wr == 1) PG8_BAR;
    PG8_WAIT_V(2); PG8_BAR;
    PG8_STAGE_B(PG8_SB(1, 0), cB + kstep); PG8_STAGE_A(PG8_SA(1, 0), cA + kstep, vA[0][0], vA[0][1]); PG8_STAGE_B(PG8_SB(1, 1), cB + hstepB + kstep);
    PG8_WAIT_V(6); PG8_BAR;
    for (;;) {
        const bool has_next = S.next(ui + 1, nxt);
        const GAS char* nA = has_next ? nxt.A : cA; const GAS char* nB = has_next ? nxt.B : cB;
#pragma unroll 1
        for (int t = 0; t < nt; t += 2) {
            const bool last = (t == nt - 2);
            const GAS char* a1 = cA + (size_t)(t + 1) * kstep;
            const GAS char* a2 = last ? nA : cA + (size_t)(t + 2) * kstep; const GAS char* b2 = last ? nB : cB + (size_t)(t + 2) * kstep;
            const GAS char* a3 = a2 + kstep; const GAS char* b3 = b2 + kstep;
            if constexpr (GATHER) { if (last && has_next) { PG8_LOADROWS(vAn, nxt); } }
            PG8_LDB(B0, 0, 0); PG8_LDB(B1, 0, 1); PG8_SCHED; PG8_LDA(At, 0, 0); PG8_STAGE_A(PG8_SA(1, 1), a1, vA[1][0], vA[1][1]);
            PG8_WAIT_V(8); PG8_WAIT_L(0); PG8_BAR; PG8_MMA(0, 0, At, B0); PG8_MMA(0, 1, At, B1); PG8_BAR; PG8_SCHED;
            PG8_LDA(At, 0, 1); PG8_STAGE_B(PG8_SB(0, 0), b2); PG8_STAGE_B(PG8_SB(0, 1), b2 + hstepB); PG8_STAGE_A(PG8_SA(0, 0), a2, PG8_VAN(0, 0), PG8_VAN(0, 1));
            PG8_WAIT_V(8); PG8_WAIT_L(0); PG8_BAR; PG8_MMA(1, 0, At, B0); PG8_MMA(1, 1, At, B1); PG8_BAR; PG8_SCHED;
            PG8_LDB(B0, 1, 0); PG8_LDB(B1, 1, 1); PG8_SCHED; PG8_LDA(At, 1, 0); PG8_STAGE_A(PG8_SA(0, 1), a2, PG8_VAN(1, 0), PG8_VAN(1, 1));
            PG8_WAIT_V(8); PG8_WAIT_L(0); PG8_BAR; PG8_MMA(0, 0, At, B0); PG8_MMA(0, 1, At, B1); PG8_BAR; PG8_SCHED;
            PG8_LDA(At, 1, 1); PG8_STAGE_B(PG8_SB(1, 0), b3); PG8_STAGE_B(PG8_SB(1, 1), b3 + hstepB); PG8_STAGE_A(PG8_SA(1, 0), a3, PG8_VAN(0, 0), PG8_VAN(0, 1));
            PG8_WAIT_V(8); PG8_WAIT_L(0); PG8_BAR; PG8_MMA(1, 0, At, B0); PG8_MMA(1, 1, At, B1); PG8_BAR; PG8_SCHED;
        }
        if (wr == 0) PG8_BAR;
        E(acc, cur, wr, wc, fr, fq);
        if (!has_next) break;
#pragma unroll
        for (int a = 0; a < 2; ++a)
#pragma unroll
            for (int b = 0; b < 2; ++b)
#pragma unroll
                for (int m = 0; m < 4; ++m)
#pragma unroll
                    for (int n = 0; n < 2; ++n) acc[a][b][m][n] = (f32x4){0.f, 0.f, 0.f, 0.f};
        cur = nxt; cA = nA; cB = nB; ++ui;
        if constexpr (GATHER) { vA[0][0] = vAn[0][0]; vA[0][1] = vAn[0][1]; vA[1][0] = vAn[1][0]; vA[1][1] = vAn[1][1]; }
        if (wr == 1) PG8_BAR;
    }
    PG8_WAIT_V(0);
    PG8_BAR;
#undef PG8_SA
#undef PG8_SB
#undef PG8_STAGE_A
#undef PG8_STAGE_B
#undef PG8_LDA
#undef PG8_LDB
#undef PG8_MMA
#undef PG8_WAIT_V
#undef PG8_WAIT_L
#undef PG8_BAR
#undef PG8_SCHED
#undef PG8_LOADROWS
#undef PG8_VAN
}
}

struct SchedPlain {
    __device__ __forceinline__ int brow(int r) const { return r; }
    const GAS char* A; const GAS char* B; size_t a_tile, b_tile; int nM, nN, G, c;
    __device__ __forceinline__ bool next(int i, pg8::Unit& u) const {
        int pm, pn; if (!pg8::tile_of((long)i * G + c, nM, nN, pm, pn)) return false;
        u.pm = pm; u.pn = pn; u.z = 0; u.rows = nullptr; u.A = A + (size_t)pm * a_tile; u.B = B + (size_t)pn * b_tile; return true; }
};
struct SchedPc {
    __device__ __forceinline__ int brow(int r) const { return r; }
    const GAS char* Q; const GAS char* Kk; int G, c;
    __device__ __forceinline__ bool next(int i, pg8::Unit& u) const {
        const int L = i * G + c; if (L >= NB * NH * 16) return false;
        const int cp = L & 15, h = (L >> 4) & 3, b = L >> 6;
        const size_t off = ((size_t)(b * SEQ + cp * 256) * QKW + h * DK) * 2;
        u.pm = L; u.pn = 0; u.z = h; u.rows = nullptr; u.A = Q + off; u.B = Kk + off; return true; }
};
struct SchedFnA {
    __device__ __forceinline__ int brow(int r) const { return r; }
    const GAS char* Wc; const GAS char* Hn; int G, c;
    __device__ __forceinline__ bool next(int i, pg8::Unit& u) const {
        int pm, pn; if (!pg8::tile_of((long)i * G + c, 8, T / 256, pm, pn)) return false;
        const int g = pm >> 1, ri = pm & 1;
        u.pm = pm; u.pn = pn; u.z = 0; u.rows = nullptr; u.A = Wc + (size_t)ri * 256 * 256 * 2; u.B = Hn + ((size_t)pn * 256 * D + g * 256) * 2; return true; }
};
struct SchedFnB {
    __device__ __forceinline__ int brow(int r) const { return (r & 63) * 8 + (r >> 6); }
    GAS const char* WY; GAS const char* U; int G, c;
    __device__ __forceinline__ bool next(int i, pg8::Unit& u) const {
        int pm, pn; if (!pg8::tile_of((long)i * G + c, 2, 256, pm, pn)) return false;
        const int batch = pn >> 5, fb = (pn >> 1) & 15, kbb = pn & 1;
        u.pm = pm; u.pn = pn; u.z = 0; u.rows = nullptr; u.A = WY + (size_t)pm * 256 * 1024 * 2; u.B = U + ((size_t)(batch * 1024 + fb * 64) * 8 + kbb * 4) * 1024 * 2; return true; }
};
struct SchedMoe {
    __device__ __forceinline__ int brow(int r) const { return r; }
    const GAS char* A; const GAS char* W; const GAS int* rowtok; const LAS unsigned char* texp; size_t a_tile, w_exp, w_tile; int ntiles, ncol, G, c; bool gather;
    __device__ __forceinline__ bool next(int i, pg8::Unit& u) const {
        int rt, ct; if (!pg8::tile_of((long)i * G + c, ntiles, ncol, rt, ct)) return false;
        const int e = texp[rt];
        u.pm = rt; u.pn = ct; u.z = e; u.rows = rowtok + rt * 256; u.A = gather ? A : A + (size_t)rt * a_tile; u.B = W + (size_t)e * w_exp + (size_t)ct * w_tile; return true; }
};

struct EpiRopeQK {
    static constexpr bool PERM = true;
    GAS bf16* Q; GAS bf16* Kk; const GAS f32x2* rot;
    __device__ __forceinline__ void operator()(const f32x4 (&acc)[2][2][4][2], const pg8::Unit& u, int wr, int wc, int fr, int fq) const {
        const bool isk = u.pn >= 4; const int h = u.pn & 3; GAS bf16* dst = isk ? Kk : Q; const float sc = isk ? 0.0625f : 1.0f;
        const int i0 = wc * 32 + 8 * fq;
#pragma unroll
        for (int ai = 0; ai < 2; ++ai)
#pragma unroll
            for (int m = 0; m < 4; ++m) {
                const int t = u.pm * 256 + ai * 128 + wr * 64 + m * 16 + fr, s = t & (SEQ - 1);
                const GAS f32x4* rp = (const GAS f32x4*)(rot + (size_t)s * 128 + i0);
                const f32x4 r0 = rp[0], r1 = rp[1], r2 = rp[2], r3 = rp[3];
                const float cs[8] = {r0[0], r0[2], r1[0], r1[2], r2[0], r2[2], r3[0], r3[2]}, sn[8] = {r0[1], r0[3], r1[1], r1[3], r2[1], r2[3], r3[1], r3[3]};
                float o1[8], o2[8];
#pragma unroll
                for (int n = 0; n < 2; ++n)
#pragma unroll
                    for (int j = 0; j < 4; ++j) { const float t1 = acc[ai][0][m][n][j], t2 = acc[ai][1][m][n][j]; const int q = 4 * n + j;
                        o1[q] = (t1 * cs[q] - t2 * sn[q]) * sc; o2[q] = (t1 * sn[q] + t2 * cs[q]) * sc; }
                GAS bf16* rowp = dst + (size_t)t * QKW + h * DK + i0;
                u32x4 w1, w2; w1.x = cvt_pk_bf16(o1[0], o1[1]); w1.y = cvt_pk_bf16(o1[2], o1[3]); w1.z = cvt_pk_bf16(o1[4], o1[5]); w1.w = cvt_pk_bf16(o1[6], o1[7]);
                w2.x = cvt_pk_bf16(o2[0], o2[1]); w2.y = cvt_pk_bf16(o2[2], o2[3]); w2.z = cvt_pk_bf16(o2[4], o2[5]); w2.w = cvt_pk_bf16(o2[6], o2[7]);
                *(GAS u32x4*)rowp = w1; *(GAS u32x4*)(rowp + 128) = w2; }
    }
};
struct EpiRopeKT {
    static constexpr bool PERM = true;
    GAS bf16* KT; const GAS f32x2* rotT; const LAS float* l2g;
    __device__ __forceinline__ void operator()(const f32x4 (&acc)[2][2][4][2], const pg8::Unit& u, int wr, int wc, int fr, int fq) const {
        const int h = u.pm; const float l2f = l2g[h], l2b = l2g[4 + h];
#pragma unroll
        for (int bj = 0; bj < 2; ++bj) {
            const int tok0 = u.pn * 256 + bj * 128 + wc * 32 + 8 * fq, s0 = tok0 & (SEQ - 1), j0 = tok0 & (CH - 1);
            float zf[8], zb[8];
#pragma unroll
            for (int q = 0; q < 8; ++q) { zf[q] = fast_exp2((float)(CH - 1 - (j0 + q)) * l2f) * 0.0625f; zb[q] = fast_exp2((float)(j0 + q) * l2b) * 0.0625f; }
#pragma unroll
            for (int m = 0; m < 4; ++m) { const int i = wr * 64 + m * 16 + fr;
                const GAS f32x4* rp = (const GAS f32x4*)(rotT + (size_t)i * RTP + s0);
                const f32x4 r0 = rp[0], r1 = rp[1], r2 = rp[2], r3 = rp[3];
                const float cs[8] = {r0[0], r0[2], r1[0], r1[2], r2[0], r2[2], r3[0], r3[2]}, sn[8] = {r0[1], r0[3], r1[1], r1[3], r2[1], r2[3], r3[1], r3[3]};
                float o1[8], o2[8];
#pragma unroll
                for (int n = 0; n < 2; ++n)
#pragma unroll
                    for (int j = 0; j < 4; ++j) { const float t1 = acc[0][bj][m][n][j], t2 = acc[1][bj][m][n][j]; const int q = 4 * n + j;
                        o1[q] = t1 * cs[q] - t2 * sn[q]; o2[q] = t1 * sn[q] + t2 * cs[q]; }
                u32x4 w1, w2;
                w1.x = cvt_pk_bf16(o1[0] * zf[0], o1[1] * zf[1]); w1.y = cvt_pk_bf16(o1[2] * zf[2], o1[3] * zf[3]); w1.z = cvt_pk_bf16(o1[4] * zf[4], o1[5] * zf[5]); w1.w = cvt_pk_bf16(o1[6] * zf[6], o1[7] * zf[7]);
                w2.x = cvt_pk_bf16(o2[0] * zf[0], o2[1] * zf[1]); w2.y = cvt_pk_bf16(o2[2] * zf[2], o2[3] * zf[3]); w2.z = cvt_pk_bf16(o2[4] * zf[4], o2[5] * zf[5]); w2.w = cvt_pk_bf16(o2[6] * zf[6], o2[7] * zf[7]);
                const int tokr = rot_col(i, tok0);
                *(GAS u32x4*)(KT + (size_t)(h * DK + i) * T + tokr) = w1; *(GAS u32x4*)(KT + (size_t)(h * DK + 128 + i) * T + tokr) = w2;
                w1.x = cvt_pk_bf16(o1[0] * zb[0], o1[1] * zb[1]); w1.y = cvt_pk_bf16(o1[2] * zb[2], o1[3] * zb[3]); w1.z = cvt_pk_bf16(o1[4] * zb[4], o1[5] * zb[5]); w1.w = cvt_pk_bf16(o1[6] * zb[6], o1[7] * zb[7]);
                w2.x = cvt_pk_bf16(o2[0] * zb[0], o2[1] * zb[1]); w2.y = cvt_pk_bf16(o2[2] * zb[2], o2[3] * zb[3]); w2.z = cvt_pk_bf16(o2[4] * zb[4], o2[5] * zb[5]); w2.w = cvt_pk_bf16(o2[6] * zb[6], o2[7] * zb[7]);
                *(GAS u32x4*)(KT + (size_t)QKW * T + (size_t)(h * DK + i) * T + tokr) = w1; *(GAS u32x4*)(KT + (size_t)QKW * T + (size_t)(h * DK + 128 + i) * T + tokr) = w2; } }
    }
};
template <bool ROT> struct EpiBf16 {
    static constexpr bool PERM = true;
    GAS bf16* O; int ldc;
    __device__ __forceinline__ void operator()(const f32x4 (&acc)[2][2][4][2], const pg8::Unit& u, int wr, int wc, int fr, int fq) const {
#pragma unroll
        for (int ai = 0; ai < 2; ++ai)
#pragma unroll
            for (int m = 0; m < 4; ++m) { const int row = u.pm * 256 + ai * 128 + wr * 64 + m * 16 + fr; GAS bf16* rowp = O + (size_t)row * ldc;
#pragma unroll
                for (int bj = 0; bj < 2; ++bj) { const f32x4 v0 = acc[ai][bj][m][0], v1 = acc[ai][bj][m][1]; const int col = u.pn * 256 + bj * 128 + wc * 32 + 8 * fq;
                    u32x4 w; w.x = cvt_pk_bf16(v0[0], v0[1]); w.y = cvt_pk_bf16(v0[2], v0[3]); w.z = cvt_pk_bf16(v1[0], v1[1]); w.w = cvt_pk_bf16(v1[2], v1[3]);
                    *(GAS u32x4*)(rowp + (ROT ? rot_col(row, col) : col)) = w; } }
    }
};
struct EpiPc {
    static constexpr bool PERM = true;
    GAS bf16* PC; GAS bf16* PD; const LAS float* l2g;
    __device__ __forceinline__ void operator()(const f32x4 (&acc)[2][2][4][2], const pg8::Unit& u, int wr, int wc, int fr, int fq) const {
        const int h = u.z; const float l2f = l2g[h], l2b = l2g[4 + h];
#pragma unroll
        for (int ai = 0; ai < 2; ++ai)
#pragma unroll
            for (int m = 0; m < 4; ++m) { const int il = wr * 64 + m * 16 + fr, jl0 = wc * 32 + 8 * fq; float o[8];
                const bool diag = (wc == 2 * wr + (m >> 1));
#pragma unroll
                for (int n = 0; n < 2; ++n)
#pragma unroll
                    for (int j = 0; j < 4; ++j) { const int dl = il - (jl0 + 4 * n + j); const float f = dl >= 0 ? fast_exp2((float)dl * l2f) : fast_exp2((float)(-dl) * l2b);
                        o[4 * n + j] = (ai == 0 ? acc[0][0][m][n][j] : acc[1][1][m][n][j]) * f; }
                if (diag) {
                    float ob[8];
#pragma unroll
                    for (int q = 0; q < 8; ++q) { const bool lower = (jl0 + q) <= il; ob[q] = lower ? 0.f : o[q]; o[q] = lower ? o[q] : 0.f; }
                    u32x4 wb; wb.x = cvt_pk_bf16(ob[0], ob[1]); wb.y = cvt_pk_bf16(ob[2], ob[3]); wb.z = cvt_pk_bf16(ob[4], ob[5]); wb.w = cvt_pk_bf16(ob[6], ob[7]);
                    *(GAS u32x4*)(PD + (((size_t)(u.pm * 2 + ai) * 4 + (il >> 5)) * 32 + (il & 31)) * 32 + (jl0 & 31)) = wb;
                }
                u32x4 w; w.x = cvt_pk_bf16(o[0], o[1]); w.y = cvt_pk_bf16(o[2], o[3]); w.z = cvt_pk_bf16(o[4], o[5]); w.w = cvt_pk_bf16(o[6], o[7]);
                *(GAS u32x4*)(PC + ((size_t)(u.pm * 2 + ai) * 128 + il) * 128 + jl0) = w; }
    }
};
struct EpiGate {
    static constexpr bool PERM = true;
    const GAS bf16* Y; GAS bf16* YG; const GAS f32x2* statp; const GAS float* gain; LAS f32x2* sst;
    __device__ __forceinline__ void operator()(const f32x4 (&acc)[2][2][4][2], const pg8::Unit& u, int wr, int wc, int fr, int fq) const {
        const int head = u.pn >> 1, c0 = u.pn * 256 + wc * 32 + 8 * fq;
        const int tid = (wr * 4 + wc) * 64 + fq * 16 + fr;
        if (tid < 256) { const int t = u.pm * 256 + tid; const GAS f32x4* sp = (const GAS f32x4*)(statp + ((size_t)t * 4 + head) * 16); float a1 = 0.f, a2 = 0.f;
#pragma unroll
            for (int k = 0; k < 8; ++k) { const f32x4 v = sp[k]; a1 += v[0] + v[2]; a2 += v[1] + v[3]; }
            const float mu = a1 * (1.f / DV), var = fmaxf(a2 * (1.f / DV) - mu * mu, 0.f); sst[tid] = (f32x2){mu, __builtin_amdgcn_rsqf(var + EPS)}; }
        asm volatile("s_waitcnt lgkmcnt(0)" ::: "memory"); __builtin_amdgcn_s_barrier(); asm volatile("" ::: "memory");
        f32x4 gv[2][2];
#pragma unroll
        for (int bj = 0; bj < 2; ++bj) { gv[bj][0] = *(const GAS f32x4*)(gain + c0 + bj * 128); gv[bj][1] = *(const GAS f32x4*)(gain + c0 + bj * 128 + 4); }
#pragma unroll
        for (int ai = 0; ai < 2; ++ai)
#pragma unroll
            for (int m = 0; m < 4; ++m) { const int rl = ai * 128 + wr * 64 + m * 16 + fr, t = u.pm * 256 + rl; const f32x2 st = sst[rl];
#pragma unroll
                for (int bj = 0; bj < 2; ++bj) { const size_t off = (size_t)t * VW + c0 + bj * 128; const u32x4 yv = *(const GAS u32x4*)(Y + off);
                    const float y[8] = {bf_lo(yv.x), bf_hi(yv.x), bf_lo(yv.y), bf_hi(yv.y), bf_lo(yv.z), bf_hi(yv.z), bf_lo(yv.w), bf_hi(yv.w)}; float o[8];
#pragma unroll
                    for (int n = 0; n < 2; ++n)
#pragma unroll
                        for (int j = 0; j < 4; ++j) { const int q = 4 * n + j; const float yn = (y[q] - st.x) * st.y * gv[bj][n][j]; o[q] = silu_f(acc[ai][bj][m][n][j]) * yn; }
                    u32x4 w; w.x = cvt_pk_bf16(o[0], o[1]); w.y = cvt_pk_bf16(o[2], o[3]); w.z = cvt_pk_bf16(o[4], o[5]); w.w = cvt_pk_bf16(o[6], o[7]);
                    *(GAS u32x4*)(YG + off) = w; } }
    }
};
template <bool BASE_F32> struct EpiRes {
    static constexpr bool PERM = true;
    const GAS void* base; GAS bf16* out;
    __device__ __forceinline__ void operator()(const f32x4 (&acc)[2][2][4][2], const pg8::Unit& u, int wr, int wc, int fr, int fq) const {
#pragma unroll
        for (int ai = 0; ai < 2; ++ai)
#pragma unroll
            for (int m = 0; m < 4; ++m) { const size_t off = (size_t)(u.pm * 256 + ai * 128 + wr * 64 + m * 16 + fr) * D + u.pn * 256 + wc * 32 + 8 * fq;
#pragma unroll
                for (int bj = 0; bj < 2; ++bj) { f32x4 v0 = acc[ai][bj][m][0], v1 = acc[ai][bj][m][1];
                    if (BASE_F32) { const GAS float* bp = (const GAS float*)base + off + bj * 128; v0 += *(const GAS f32x4*)bp; v1 += *(const GAS f32x4*)(bp + 4); }
                    else { const u32x4 bv = *(const GAS u32x4*)((const GAS bf16*)base + off + bj * 128);
                        v0 += (f32x4){bf_lo(bv.x), bf_hi(bv.x), bf_lo(bv.y), bf_hi(bv.y)}; v1 += (f32x4){bf_lo(bv.z), bf_hi(bv.z), bf_lo(bv.w), bf_hi(bv.w)}; }
                    u32x4 w; w.x = cvt_pk_bf16(v0[0], v0[1]); w.y = cvt_pk_bf16(v0[2], v0[3]); w.z = cvt_pk_bf16(v1[0], v1[1]); w.w = cvt_pk_bf16(v1[2], v1[3]);
                    *(GAS u32x4*)(out + off + bj * 128) = w; } }
    }
};
struct EpiSwiGLU {
    static constexpr bool PERM = true;
    GAS bf16* ACT; int ldc;
    __device__ __forceinline__ void operator()(const f32x4 (&acc)[2][2][4][2], const pg8::Unit& u, int wr, int wc, int fr, int fq) const {
#pragma unroll
        for (int ai = 0; ai < 2; ++ai)
#pragma unroll
            for (int m = 0; m < 4; ++m) { float o[8];
#pragma unroll
                for (int n = 0; n < 2; ++n)
#pragma unroll
                    for (int j = 0; j < 4; ++j) o[4 * n + j] = silu_f(acc[ai][0][m][n][j]) * acc[ai][1][m][n][j];
                u32x4 w; w.x = cvt_pk_bf16(o[0], o[1]); w.y = cvt_pk_bf16(o[2], o[3]); w.z = cvt_pk_bf16(o[4], o[5]); w.w = cvt_pk_bf16(o[6], o[7]);
                *(GAS u32x4*)(ACT + (size_t)(u.pm * 256 + ai * 128 + wr * 64 + m * 16 + fr) * ldc + u.pn * 128 + wc * 32 + 8 * fq) = w; }
    }
};
struct EpiZ2 {
    static constexpr bool PERM = true;
    GAS bf16* Z2;
    __device__ __forceinline__ void operator()(const f32x4 (&acc)[2][2][4][2], const pg8::Unit& u, int wr, int wc, int fr, int fq) const {
        const int g = u.pm >> 1, ri = u.pm & 1;
#pragma unroll
        for (int ai = 0; ai < 2; ++ai)
#pragma unroll
            for (int m = 0; m < 4; ++m) { const int cp = ai * 128 + wr * 64 + m * 16 + fr;
#pragma unroll
                for (int bj = 0; bj < 2; ++bj) { const int tok0 = u.pn * 256 + bj * 128 + wc * 32 + 8 * fq, b = tok0 >> 12, s0 = tok0 & (SEQ - 1);
                    const f32x4 v0 = acc[ai][bj][m][0], v1 = acc[ai][bj][m][1];
                    u32x4 w; w.x = cvt_pk_bf16(v0[0], v0[1]); w.y = cvt_pk_bf16(v0[2], v0[3]); w.z = cvt_pk_bf16(v1[0], v1[1]); w.w = cvt_pk_bf16(v1[2], v1[3]);
                    *(GAS u32x4*)(Z2 + ((size_t)(b * 1024 + g * 256 + cp) * 8192 + ri * SEQ + s0)) = w; } }
    }
};
struct EpiYf {
    static constexpr bool PERM = true;
    GAS bf16* YF;
    __device__ __forceinline__ void operator()(const f32x4 (&acc)[2][2][4][2], const pg8::Unit& u, int wr, int wc, int fr, int fq) const {
        const int batch = u.pn >> 5, fb = (u.pn >> 1) & 15, kbb = u.pn & 1;
#pragma unroll
        for (int ai = 0; ai < 2; ++ai)
#pragma unroll
            for (int m = 0; m < 4; ++m) { const int ka = u.pm * 256 + ai * 128 + wr * 64 + m * 16 + fr;
#pragma unroll
                for (int bj = 0; bj < 2; ++bj) { const int kb = kbb * 4 + 2 * bj + (wc >> 1), f = fb * 64 + 32 * (wc & 1) + 8 * fq;
                    const f32x4 v0 = acc[ai][bj][m][0], v1 = acc[ai][bj][m][1];
                    u32x4 w; w.x = cvt_pk_bf16(v0[0], v0[1]); w.y = cvt_pk_bf16(v0[2], v0[3]); w.z = cvt_pk_bf16(v1[0], v1[1]); w.w = cvt_pk_bf16(v1[2], v1[3]);
                    *(GAS u32x4*)(YF + (size_t)(batch * SEQ + 8 * ka + kb) * D + f) = w; } }
    }
};
struct EpiMoeDown {
    static constexpr bool PERM = true;
    GAS bf16* Hres; const GAS int* rowtok; const GAS float* rowgate;
    __device__ __forceinline__ void operator()(const f32x4 (&acc)[2][2][4][2], const pg8::Unit& u, int wr, int wc, int fr, int fq) const {
#pragma unroll
        for (int ai = 0; ai < 2; ++ai)
#pragma unroll
            for (int m = 0; m < 4; ++m) { const int row = u.pm * 256 + ai * 128 + wr * 64 + m * 16 + fr; const int tok = rowtok[row]; const float gw = rowgate[row];
                if (tok >= 0) { GAS bf16* rp = Hres + (size_t)tok * D + u.pn * 256 + wc * 32 + 8 * fq;
#pragma unroll
                    for (int bj = 0; bj < 2; ++bj) { const u32x4 bv = *(const GAS u32x4*)(rp + bj * 128);
                        const f32x4 v0 = (f32x4){bf_lo(bv.x), bf_hi(bv.x), bf_lo(bv.y), bf_hi(bv.y)} + gw * acc[ai][bj][m][0], v1 = (f32x4){bf_lo(bv.z), bf_hi(bv.z), bf_lo(bv.w), bf_hi(bv.w)} + gw * acc[ai][bj][m][1];
                        u32x4 w; w.x = cvt_pk_bf16(v0[0], v0[1]); w.y = cvt_pk_bf16(v0[2], v0[3]); w.z = cvt_pk_bf16(v1[0], v1[1]); w.w = cvt_pk_bf16(v1[2], v1[3]);
                        *(GAS u32x4*)(rp + bj * 128) = w; } } }
    }
};

#define XB_TMO      128
#define XB_XCNT(j)  (256  + 64 * (j))
#define XB_XSUB(j)  (1280 + 64 * (j))
#define XB_XGEN(j)  (2304 + 64 * (j))
#define XB_TOP      3328
#define XB_TOPGEN   3392
#define XCD_BAR_WORDS 3456
#define XB_SPIN_CAP (1u << 18)
__device__ __forceinline__ unsigned xb_ld(unsigned* p)              { return __hip_atomic_load(p, __ATOMIC_RELAXED, __HIP_MEMORY_SCOPE_AGENT); }
__device__ __forceinline__ unsigned xb_add(unsigned* p, unsigned v) { return __hip_atomic_fetch_add(p, v, __ATOMIC_RELAXED, __HIP_MEMORY_SCOPE_AGENT); }
__device__ __forceinline__ unsigned xb_xcc_id() { return (unsigned)__builtin_amdgcn_s_getreg((3 << 11) | 20) & 0xFu; }
#define XB_SPIN(cond, bar) do { unsigned _sp = 0; while (cond) { __builtin_amdgcn_s_sleep(1); \
    if ((++_sp & 255u) == 0u) { if (xb_ld(&(bar)[XB_TMO])) break; if (_sp > XB_SPIN_CAP) { atomicAdd(&(bar)[XB_TMO], 1u); break; } } } } while (0)
struct XcdBarrier { unsigned* bar; unsigned x; volatile LAS unsigned* st; };
__device__ __forceinline__ XcdBarrier xcd_barrier_post(unsigned* bar, volatile LAS unsigned* st, const bool t0) {
    XcdBarrier b; b.bar = bar; b.x = xb_xcc_id(); b.st = st;
    if (t0) (void)xb_add(&bar[XB_XCNT(b.x)], 1u);
    return b;
}
__device__ __forceinline__ void xcd_barrier_complete(unsigned* bar, unsigned x, unsigned& nloc, unsigned& nx) {
    const unsigned G = gridDim.x * gridDim.y * gridDim.z;
    unsigned sum, cnt, mine, sp = 0u;
    for (;;) {
        sum = 0u; cnt = 0u; mine = 0u;
#pragma unroll
        for (unsigned j = 0; j < 16; ++j) { const unsigned c = xb_ld(&bar[XB_XCNT(j)]); sum += c; cnt += (c > 0u) ? 1u : 0u; mine = (j == x) ? c : mine; }
        if (sum == G) break;
        __builtin_amdgcn_s_sleep(1);
        if ((++sp & 255u) == 0u) { if (xb_ld(&bar[XB_TMO])) break; if (sp > XB_SPIN_CAP) { atomicAdd(&bar[XB_TMO], 1u); break; } }
    }
    nloc = mine > 0u ? mine : 1u; nx = cnt > 0u ? cnt : 1u;
}
__device__ __forceinline__ void xcd_barrier(const XcdBarrier& b, const bool t0) {
    asm volatile("s_waitcnt vmcnt(0)" ::: "memory");
    __syncthreads();
    if (t0) {
        unsigned* bar = b.bar;
        __builtin_amdgcn_s_waitcnt(0);
        unsigned nloc = b.st[0], nx = b.st[1];
        if (nloc == 0u) { xcd_barrier_complete(bar, b.x, nloc, nx); b.st[0] = nloc; b.st[1] = nx; }
        const unsigned old = xb_add(&bar[XB_XSUB(b.x)], 1u);
        const unsigned gen = old / nloc;
        if (old + 1u == (gen + 1u) * nloc) {
            __builtin_amdgcn_fence(__ATOMIC_RELEASE, "agent");
            asm volatile("s_waitcnt vmcnt(0)" ::: "memory");
            const unsigned og = xb_add(&bar[XB_TOP], 1u);
            const unsigned tg = og / nx;
            if (og + 1u == (tg + 1u) * nx) xb_add(&bar[XB_TOPGEN], 1u);
            else XB_SPIN(xb_ld(&bar[XB_TOPGEN]) == tg, bar);
            __builtin_amdgcn_fence(__ATOMIC_ACQUIRE, "agent");
            xb_add(&bar[XB_XGEN(b.x)], 1u);
            asm volatile("s_waitcnt vmcnt(0)" ::: "memory");
        } else {
            XB_SPIN(xb_ld(&bar[XB_XGEN(b.x)]) == gen, bar);
            __builtin_amdgcn_fence(__ATOMIC_ACQUIRE, "agent");
            asm volatile("s_waitcnt vmcnt(0)" ::: "memory");
        }
    }
    __syncthreads();
}

__device__ __forceinline__ float wave_sum(float v) {
#pragma unroll
    for (int o = 1; o < 64; o <<= 1) v += __shfl_xor(v, o);
    return v;
}
__device__ __forceinline__ void transpose_item(const GAS float* W, int K, int N, GAS bf16* WT, int k0, int n0, int rbase, LAS float* scr, int lane) {
#pragma unroll 8
    for (int i = 0; i < 32; ++i) { const int kk = 2 * i + (lane >> 5); scr[kk * 33 + (lane & 31)] = W[(size_t)(k0 + kk) * N + n0 + (lane & 31)]; }
    LDS_WAIT(); asm volatile("" ::: "memory");
    const int c = lane & 7;
#pragma unroll
    for (int j = 0; j < 4; ++j) { const int n = (lane >> 3) + 8 * j; const LAS float* s = scr + (8 * c) * 33 + n;
        u32x4 o; o.x = cvt_pk_bf16(s[0 * 33], s[1 * 33]); o.y = cvt_pk_bf16(s[2 * 33], s[3 * 33]); o.z = cvt_pk_bf16(s[4 * 33], s[5 * 33]); o.w = cvt_pk_bf16(s[6 * 33], s[7 * 33]);
        *(GAS u32x4*)(WT + (size_t)(rbase + n) * K + k0 + 8 * c) = o; }
    LDS_WAIT(); asm volatile("" ::: "memory");
}
__device__ __forceinline__ void tr_plain(const GAS float* W, int K, int N, GAS bf16* WT, int it, LAS float* scr, int lane) {
    const int nblk = N / 32, kb = it / nblk, nb = it - kb * nblk; transpose_item(W, K, N, WT, 64 * kb, 32 * nb, 32 * nb, scr, lane);
}
__device__ __forceinline__ void tr_gu(const GAS float* Wg, const GAS float* Wu, int K, int N, GAS bf16* WT, int it, LAS float* scr, int lane) {
    const int nblk = N / 32, per = (K / 64) * nblk; const bool up = it >= per; if (up) it -= per;
    const int kb = it / nblk, nb = it - kb * nblk, f0 = 32 * nb;
    transpose_item(up ? Wu : Wg, K, N, WT, 64 * kb, f0, 256 * (f0 >> 7) + (up ? 128 : 0) + (f0 & 127), scr, lane);
}
__device__ __forceinline__ void rms_row(const GAS float* xrow, const GAS float* g, GAS bf16* orow, int lane, f32x4 (&v)[4]) {
    const GAS f32x4* xr = (const GAS f32x4*)xrow + lane; const GAS f32x4* gr = (const GAS f32x4*)g + lane;
    float s = 0.f;
#pragma unroll
    for (int j = 0; j < 4; ++j) { v[j] = xr[64 * j]; s += (v[j].x * v[j].x + v[j].y * v[j].y) + (v[j].z * v[j].z + v[j].w * v[j].w); }
    const float r = 1.0f / sqrtf(wave_sum(s) * (1.f / D) + EPS);
    GAS u32x2* o8 = (GAS u32x2*)orow + lane;
#pragma unroll
    for (int j = 0; j < 4; ++j) { v[j] = v[j] * r * gr[64 * j]; u32x2 w; w.x = cvt_pk_bf16(v[j].x, v[j].y); w.y = cvt_pk_bf16(v[j].z, v[j].w); o8[64 * j] = w; }
}
__device__ __forceinline__ int rmsb_col(int j, int lane) { return 512 * (j >> 1) + 8 * lane + 4 * (j & 1); }
__device__ __forceinline__ void rms_row_b(const GAS bf16* hrow, const GAS float* g, GAS bf16* orow, int lane, f32x4 (&v)[4]) {
    float s = 0.f;
#pragma unroll
    for (int jh = 0; jh < 2; ++jh) { const u32x4 x = *(const GAS u32x4*)(hrow + 512 * jh + 8 * lane);
        v[2 * jh] = (f32x4){bf_lo(x.x), bf_hi(x.x), bf_lo(x.y), bf_hi(x.y)}; v[2 * jh + 1] = (f32x4){bf_lo(x.z), bf_hi(x.z), bf_lo(x.w), bf_hi(x.w)}; }
#pragma unroll
    for (int j = 0; j < 4; ++j) s += (v[j].x * v[j].x + v[j].y * v[j].y) + (v[j].z * v[j].z + v[j].w * v[j].w);
    const float r = 1.0f / sqrtf(wave_sum(s) * (1.f / D) + EPS);
#pragma unroll
    for (int jh = 0; jh < 2; ++jh) { const GAS float* gp = g + 512 * jh + 8 * lane; v[2 * jh] = v[2 * jh] * r * *(const GAS f32x4*)gp; v[2 * jh + 1] = v[2 * jh + 1] * r * *(const GAS f32x4*)(gp + 4);
        u32x4 w; w.x = cvt_pk_bf16(v[2 * jh].x, v[2 * jh].y); w.y = cvt_pk_bf16(v[2 * jh].z, v[2 * jh].w); w.z = cvt_pk_bf16(v[2 * jh + 1].x, v[2 * jh + 1].y); w.w = cvt_pk_bf16(v[2 * jh + 1].z, v[2 * jh + 1].w);
        *(GAS u32x4*)(orow + 512 * jh + 8 * lane) = w; }
}

constexpr int SW_QL = 0, SW_SPITCH = 528, SW_SL = 128 * 528, SW_VPITCH = 272, SW_VL = SW_SL + 64 * SW_SPITCH, SW_VB = 64 * SW_VPITCH;
static_assert(SW_VL + 2 * SW_VB <= 139264, "sweep LDS");
__device__ __forceinline__ void sweep_unit(LAS unsigned char* lds, const GAS bf16* Qg, const GAS bf16* KTFg, const GAS bf16* KTBg, const GAS bf16* VTg, const GAS bf16* PCg, const GAS bf16* PDg, const GAS bf16* ZEROg, GAS bf16* Yg, GAS f32x2* statp, const float l2f, const float l2b, int b, int h, int es, const int wave_s) {
    const int tid = tid_of(wave_s);
    const int w = __builtin_amdgcn_readfirstlane(tid >> 6), lane = tid & 63, rb = w >> 1, cb = w & 1, r32 = lane & 31, hh = lane >> 5;
    const int vrow = tid >> 4, vpc = tid & 15;
    const int qrow = tid >> 5, qpc = tid & 31;
    const GAS bf16* qp = Qg + (size_t)(b * SEQ + qrow) * QKW + h * DK + 8 * qpc;
    const size_t kto = (size_t)(h * DK + 32 * w + r32) * T + 8 * hh; const int krot = b * SEQ + ((r32 & 15) << 11);
    const GAS bf16* vtp = VTg + (size_t)(h * DV + 64 * es + vrow) * T + 8 * vpc; const int vrot = b * SEQ + ((vrow & 15) << 11);
    const GAS bf16* pcp = PCg + ((size_t)((b * NH + h) * NCH) * 128 + rb * 32 + r32) * 128 + 8 * hh;
    const GAS bf16* pdp = PDg + (((size_t)((b * NH + h) * NCH) * 4 + rb) * 32 + r32) * 32 + 8 * hh;
#define SW_LDP(dst, s_, d_, nn_) do { const int jb_ = (s_) >> 1; const bool use_ = (d_) ? (jb_ >= rb) : (jb_ <= rb); const bool dg_ = (d_) && (jb_ == rb); \
        const GAS bf16* src_ = dg_ ? (pdp + (size_t)(nn_) * 4096 + 16 * ((s_) & 1)) : (pcp + (size_t)(nn_) * (CH * CH) + 16 * (s_)); \
        dst = *(const GAS bf16x8*)(use_ ? src_ : ZEROg); } while (0)
    GAS bf16* yp = Yg + (size_t)(b * SEQ + 32 * rb + r32) * VW + h * DV + 64 * es + 32 * cb + 4 * hh;
    GAS f32x2* stp = statp + ((size_t)(b * SEQ + 32 * rb + r32) * NH + h) * 16 + es * 2 + cb;
    const int il = 32 * rb + r32;
    const int qrd = SW_QL + il * SW_SPITCH + 16 * hh;
    bf16x8 pa[8], ka[8]; u32x4 vv[2], qv[4];
    f32x16 Sacc[2];
#pragma unroll
    for (int s = 0; s < 8; ++s) { SW_LDP(pa[s], s, 0, 0); ka[s] = *(const GAS bf16x8*)(KTFg + kto + (krot & (T - 1)) + 16 * s); }
#pragma unroll
    for (int it = 0; it < 2; ++it) vv[it] = *(const GAS u32x4*)(vtp + (size_t)(32 * it) * T + (vrot & (T - 1)));
#pragma unroll
    for (int it = 0; it < 2; ++it) *(LAS u32x4*)(lds + SW_VL + (vrow + 32 * it) * SW_VPITCH + vpc * 16) = vv[it];
#pragma unroll
    for (int hf = 0; hf < 2; ++hf) {
#pragma unroll
        for (int it = 0; it < 4; ++it) qv[it] = *(const GAS u32x4*)(qp + (size_t)(16 * (4 * hf + it)) * QKW);
#pragma unroll
        for (int it = 0; it < 4; ++it) { const int row = qrow + 16 * (4 * hf + it); *(LAS u32x4*)(lds + SW_QL + row * SW_SPITCH + qpc * 16) = qv[it]; }
    }
#pragma unroll
    for (int c = 0; c < 2; ++c)
#pragma unroll
        for (int t = 0; t < 16; ++t) Sacc[c][t] = 0.f;
#define SW_SCHED __builtin_amdgcn_sched_barrier(0)
#define SW_MFMA(a, b, c) c = __builtin_amdgcn_mfma_f32_32x32x16_bf16(a, b, c, 0, 0, 0)
    const int sl_rd = SW_SL + (32 * cb + r32) * SW_SPITCH + 16 * hh;
#pragma unroll 1
    for (int p = 0; p < 2 * NCH; ++p) {
        {
            const int dir = p >> 5, st = p & 31, n = dir ? NCH - 1 - st : st;
            const int pn = p + 1 < 2 * NCH ? p + 1 : p, dirn = pn >> 5, stn = pn & 31, nn = dirn ? NCH - 1 - stn : stn;
            const int cur = p & 1;
            const float l2 = dir ? l2b : l2f;
            const float xi = fast_exp2((float)(dir == 0 ? (il + 1) : (CH - il)) * l2), gC = st == 0 ? 0.f : fast_exp2((float)CH * l2);
#pragma unroll
            for (int c = 0; c < 2; ++c)
#pragma unroll
                for (int g = 0; g < 4; ++g) { u32x2 pk; pk.x = cvt_pk_bf16(Sacc[c][4 * g], Sacc[c][4 * g + 1]); pk.y = cvt_pk_bf16(Sacc[c][4 * g + 2], Sacc[c][4 * g + 3]);
                    if (st == 0) { pk.x = 0u; pk.y = 0u; }
                    *(LAS u32x2*)(lds + SW_SL + (32 * c + r32) * SW_SPITCH + (32 * w + 8 * g + 4 * hh) * 2) = pk; }
#pragma unroll
            for (int it = 0; it < 2; ++it) vv[it] = *(const GAS u32x4*)(vtp + (size_t)(32 * it) * T + ((nn * CH + vrot) & (T - 1)));
#pragma unroll
            for (int it = 0; it < 4; ++it) qv[it] = *(const GAS u32x4*)(qp + (size_t)(nn * CH + 16 * it) * QKW);
            u32x2 yf[4];
            GAS bf16* ypn = yp + (size_t)(n * CH) * VW;
            __syncthreads();
            f32x16 O;
#pragma unroll
            for (int t = 0; t < 16; ++t) O[t] = 0.f;
            bf16x8 sx[2], qx[2], sy[2], qy[2];
#define SW_LDC(ds, dq, g2) do { _Pragma("unroll") for (int k = 0; k < 2; ++k) { const int ks = 2 * (g2) + k; ds[k] = *(const LAS bf16x8*)(lds + sl_rd + 32 * ks); \
                dq[k] = *(const LAS bf16x8*)(lds + qrd + 32 * ks); } } while (0)
#define SW_MMC(ds, dq) do { SW_MFMA(ds[0], dq[0], O); SW_MFMA(ds[1], dq[1], O); } while (0)
            const int vl_rd = SW_VL + cur * SW_VB + (32 * cb + r32) * SW_VPITCH + 16 * hh;
            const int vu_rd = SW_VL + cur * SW_VB + r32 * SW_VPITCH + 16 * hh;
#define SW_LDV(dv, gp) do { dv[0] = *(const LAS bf16x8*)(lds + vl_rd + 32 * (2 * (gp))); dv[1] = *(const LAS bf16x8*)(lds + vl_rd + 32 * (2 * (gp) + 1)); } while (0)
#define SW_LDU(du, ug) do { du[0] = *(const LAS bf16x8*)(lds + vu_rd + ((ug) >> 2) * 32 * SW_VPITCH + 32 * (2 * ((ug) & 3))); du[1] = *(const LAS bf16x8*)(lds + vu_rd + ((ug) >> 2) * 32 * SW_VPITCH + 32 * (2 * ((ug) & 3) + 1)); } while (0)
            SW_LDC(sx, qx, 0); SW_LDC(sy, qy, 1); SW_SCHED;
            SW_MMC(sx, qx); SW_SCHED; SW_LDC(sx, qx, 2); SW_SCHED;
            SW_MMC(sy, qy); SW_SCHED; SW_LDC(sy, qy, 3); SW_SCHED;
            SW_MMC(sx, qx); SW_SCHED; SW_LDC(sx, qx, 4); SW_SCHED;
            SW_MMC(sy, qy); SW_SCHED; SW_LDC(sy, qy, 5); SW_SCHED;
            SW_MMC(sx, qx); SW_SCHED; SW_LDC(sx, qx, 6); SW_SCHED;
            SW_MMC(sy, qy); SW_SCHED; SW_LDC(sy, qy, 7); SW_SCHED;
            SW_MMC(sx, qx); SW_SCHED;
            bf16x8 vx[2], vy[2];
            SW_LDV(vx, 0); SW_SCHED;
            SW_MMC(sy, qy); SW_SCHED;
            SW_LDV(vy, 1); SW_SCHED;
            __syncthreads();
#pragma unroll
            for (int it = 0; it < 4; ++it) { const int row = qrow + 16 * it; *(LAS u32x4*)(lds + SW_QL + row * SW_SPITCH + qpc * 16) = qv[it]; }
#pragma unroll
            for (int it = 0; it < 4; ++it) qv[it] = *(const GAS u32x4*)(qp + (size_t)(nn * CH + 16 * (4 + it)) * QKW);
            if (dir) {
#pragma unroll
                for (int g = 0; g < 4; ++g) yf[g] = *(const GAS u32x2*)(ypn + 8 * g);
            }
#pragma unroll
            for (int t = 0; t < 16; ++t) O[t] *= xi;
#define SW_PV(s, vf) SW_MFMA(vf, pa[s], O)
            SW_PV(0, vx[0]); SW_PV(1, vx[1]); SW_SCHED; SW_LDV(vx, 2); SW_SCHED;
            SW_PV(2, vy[0]); SW_PV(3, vy[1]); SW_SCHED; SW_LDV(vy, 3); SW_SCHED;
            bf16x8 ux[2], uy[2];
            SW_PV(4, vx[0]); SW_PV(5, vx[1]); SW_SCHED; SW_LDU(ux, 0); SW_SCHED;
            SW_PV(6, vy[0]); SW_PV(7, vy[1]); SW_SCHED; SW_LDU(uy, 1); SW_SCHED;
#pragma unroll
            for (int s = 0; s < 8; ++s) SW_LDP(pa[s], s, dirn, nn);
#pragma unroll
            for (int c = 0; c < 2; ++c)
#pragma unroll
                for (int t = 0; t < 16; ++t) Sacc[c][t] *= gC;
            SW_SCHED;
#define SW_UP(ug, du) do { SW_MFMA(ka[2 * ((ug) & 3)], du[0], Sacc[(ug) >> 2]); SW_MFMA(ka[2 * ((ug) & 3) + 1], du[1], Sacc[(ug) >> 2]); } while (0)
            SW_UP(0, ux); SW_SCHED; SW_LDU(ux, 2); SW_SCHED;
            SW_UP(1, uy); SW_SCHED; SW_LDU(uy, 3); SW_SCHED;
            SW_UP(2, ux); SW_SCHED; SW_LDU(ux, 4); SW_SCHED;
            SW_UP(3, uy); SW_SCHED; SW_LDU(uy, 5); SW_SCHED;
            SW_UP(4, ux); SW_SCHED; SW_LDU(ux, 6); SW_SCHED;
            SW_UP(5, uy); SW_SCHED; SW_LDU(uy, 7); SW_SCHED;
            SW_UP(6, ux); SW_SCHED;
            SW_UP(7, uy); SW_SCHED;
            {
                const GAS bf16* ktn = (dirn ? KTBg : KTFg) + kto + ((nn * CH + krot) & (T - 1));
#pragma unroll
                for (int s = 0; s < 8; ++s) ka[s] = *(const GAS bf16x8*)(ktn + 16 * s);
            }
#pragma unroll
            for (int it = 0; it < 2; ++it) *(LAS u32x4*)(lds + SW_VL + (cur ^ 1) * SW_VB + (vrow + 32 * it) * SW_VPITCH + vpc * 16) = vv[it];
#pragma unroll
            for (int it = 0; it < 4; ++it) { const int row = qrow + 16 * (4 + it); *(LAS u32x4*)(lds + SW_QL + row * SW_SPITCH + qpc * 16) = qv[it]; }
            if (dir == 0) {
#pragma unroll
                for (int g = 0; g < 4; ++g) { u32x2 o; o.x = cvt_pk_bf16(O[4 * g], O[4 * g + 1]); o.y = cvt_pk_bf16(O[4 * g + 2], O[4 * g + 3]); *(GAS u32x2*)(ypn + 8 * g) = o; }
            } else {
                float s1 = 0.f, s2 = 0.f;
#pragma unroll
                for (int g = 0; g < 4; ++g) { const float y0 = bf_lo(yf[g].x) + O[4 * g], y1 = bf_hi(yf[g].x) + O[4 * g + 1], y2 = bf_lo(yf[g].y) + O[4 * g + 2], y3 = bf_hi(yf[g].y) + O[4 * g + 3];
                    s1 += (y0 + y1) + (y2 + y3); s2 += (y0 * y0 + y1 * y1) + (y2 * y2 + y3 * y3);
                    u32x2 o; o.x = cvt_pk_bf16(y0, y1); o.y = cvt_pk_bf16(y2, y3); *(GAS u32x2*)(ypn + 8 * g) = o; }
                s1 += __shfl_xor(s1, 32); s2 += __shfl_xor(s2, 32);
                if (hh == 0) stp[(size_t)(n * CH) * (NH * 16)] = (f32x2){s1, s2};
            }
        }
    }
#undef SW_LDC
#undef SW_MMC
#undef SW_LDV
#undef SW_LDU
#undef SW_PV
#undef SW_LDP
#undef SW_UP
#undef SW_MFMA
#undef SW_SCHED
    VM_WAIT();
    __syncthreads();
}

struct Args { const float* in[16]; float* out; unsigned char* ws; };
constexpr int NWAVES = 8;
#ifndef PHMASK
#define PHMASK 0xFFFFFFFFu
#endif
#define PH(k) (((PHMASK) >> (k)) & 1u)
__global__ void __launch_bounds__(NWAVES * 64, 2) fwd_kernel(Args args) {
    extern __shared__ __attribute__((aligned(16))) unsigned char lds_raw[];
    LAS unsigned char* lds = (LAS unsigned char*)lds_raw;
    LAS float* l2g = (LAS float*)(lds + LDSCTL_OFF + 64);
    const int wave_k = __builtin_amdgcn_readfirstlane((int)threadIdx.x >> 6);
#define PHASE_VARS \
    const int tid = tid_of(wave_k); const int lane = tid & 63; int wave = wave_k; asm volatile("" : "+s"(wave)); \
    const __attribute__((address_space(4))) Args* ka = (const __attribute__((address_space(4))) Args*)__builtin_amdgcn_kernarg_segment_ptr(); asm volatile("" : "+s"(ka)); \
    const int G = gridDim.x, bx = blockIdx.x; const int vcu = (G % 8 == 0) ? (bx % 8) * (G / 8) + bx / 8 : bx; const int gw = vcu * NWAVES + wave, NGW = G * NWAVES; \
    GAS unsigned char* ws = (GAS unsigned char*)ka->ws; asm volatile("" : "+s"(ws)); GAS float* hres = (GAS float*)ka->out; (void)lane; (void)gw; (void)NGW; (void)vcu; (void)hres; \
    const GAS float* x = (const GAS float*)ka->in[0]; const GAS float* mix_norm = (const GAS float*)ka->in[1]; const GAS float* ffn_norm = (const GAS float*)ka->in[2]; const GAS float* ret_w_in = (const GAS float*)ka->in[3]; const GAS float* ret_decay = (const GAS float*)ka->in[4]; \
    const GAS float* gn_gain = (const GAS float*)ka->in[5]; const GAS float* ret_w_out = (const GAS float*)ka->in[6]; const GAS float* d_wg = (const GAS float*)ka->in[7]; const GAS float* d_wu = (const GAS float*)ka->in[8]; const GAS float* d_wd = (const GAS float*)ka->in[9]; \
    const GAS float* fnet_w = (const GAS float*)ka->in[10]; const GAS float* moe_router = (const GAS float*)ka->in[11]; const GAS float* m_wg = (const GAS float*)ka->in[12]; const GAS float* m_wu = (const GAS float*)ka->in[13]; const GAS float* m_wd = (const GAS float*)ka->in[14]; const GAS float* final_norm = (const GAS float*)ka->in[15]; \
    (void)x; (void)mix_norm; (void)ffn_norm; (void)ret_w_in; (void)ret_decay; (void)gn_gain; (void)ret_w_out; (void)d_wg; (void)d_wu; (void)d_wd; (void)fnet_w; (void)moe_router; (void)m_wg; (void)m_wu; (void)m_wd; (void)final_norm; \
    GAS f32x2* rot = (GAS f32x2*)(ws + WS_ROT); GAS f32x2* rotT = (GAS f32x2*)(ws + WS_ROTT); GAS bf16* WC = (GAS bf16*)(ws + WS_WC); \
    GAS int* toke = (GAS int*)(ws + WS_TOKE); GAS float* tokw = (GAS float*)(ws + WS_TOKW); GAS int* bcnt = (GAS int*)(ws + WS_BCNT); GAS int* pcnt = (GAS int*)(ws + WS_PCNT); (void)pcnt; GAS int* rowtok = (GAS int*)(ws + WS_ROWTOK); GAS float* rowgate = (GAS float*)(ws + WS_ROWGATE); \
    GAS f32x2* statp = (GAS f32x2*)(ws + WS_STATP); \
    GAS bf16* WIN = (GAS bf16*)(ws + WS_WIN); GAS bf16* WO = (GAS bf16*)(ws + WS_WO); GAS bf16* WGU = (GAS bf16*)(ws + WS_WGU); GAS bf16* WD = (GAS bf16*)(ws + WS_WD); GAS bf16* WF = (GAS bf16*)(ws + WS_WF); \
    GAS bf16* HN = (GAS bf16*)(ws + WS_HN); GAS bf16* Qb = (GAS bf16*)(ws + WS_Q); GAS bf16* Kb = (GAS bf16*)(ws + WS_K); GAS bf16* KT = (GAS bf16*)(ws + WS_KT); GAS bf16* VT = (GAS bf16*)(ws + WS_VT); GAS bf16* PC = (GAS bf16*)(ws + WS_PC); \
    GAS bf16* HB = (GAS bf16*)(ws + WS_HN); GAS bf16* HNB = (GAS bf16*)ka->out; (void)HB; (void)HNB; \
    GAS bf16* Yb = (GAS bf16*)ka->out; GAS bf16* YG = (GAS bf16*)(ws + WS_YG); GAS bf16* ACTD = (GAS bf16*)(ws + WS_ACTD); GAS bf16* Z2 = (GAS bf16*)(ws + WS_Z2); GAS bf16* WSEQ = (GAS bf16*)(ws + WS_WSEQ); \
    GAS bf16* ACTM = (GAS bf16*)(ws + WS_ACTM); GAS bf16* WMGU = (GAS bf16*)(ws + WS_WMGU); GAS bf16* WMD = (GAS bf16*)(ws + WS_WMD); \
    (void)rot; (void)rotT; (void)WC; (void)toke; (void)tokw; (void)bcnt; (void)rowtok; (void)rowgate; (void)statp; (void)WIN; (void)WO; (void)WGU; (void)WD; (void)WF; (void)HN; (void)Qb; (void)Kb; (void)KT; (void)VT; (void)PC; \
    (void)Yb; (void)YG; (void)ACTD; (void)Z2; (void)WSEQ; (void)ACTM; (void)WMGU; (void)WMD;
#define GRID_BAR() do { const __attribute__((address_space(4))) Args* kb = (const __attribute__((address_space(4))) Args*)__builtin_amdgcn_kernarg_segment_ptr(); asm volatile("" : "+s"(kb)); GAS unsigned char* wsb = (GAS unsigned char*)kb->ws; XcdBarrier bar_; bar_.bar = (unsigned*)(wsb + WS_CTL) + CW_BAR; bar_.x = xb_xcc_id(); \
    bar_.st = (volatile LAS unsigned*)(lds + MISC_OFF) + 8; xcd_barrier(bar_, tid_of(wave_k) == 0); } while (0)

    {
        PHASE_VARS
        for (int u = tid; u < (LDS_BYTES - LDSCTL_OFF) / 4; u += NWAVES * 64) ((LAS unsigned*)(lds + LDSCTL_OFF))[u] = 0u;
        __syncthreads();
        if (tid < 8) { const float xl = ret_decay[tid]; const float ls = fminf(xl, 0.f) - log1pf(expf(-fabsf(xl))); l2g[tid] = ls * 1.44269504088896341f; }
        __syncthreads();
        (void)xcd_barrier_post((unsigned*)(ws + WS_CTL) + CW_BAR, (volatile LAS unsigned*)(lds + MISC_OFF) + 8, tid == 0);
    }

    if (PH(0)) {
        PHASE_VARS
        LAS float* scr = (LAS float*)(lds + wave * 16384);
        constexpr int I_IN = (D / 64) * (INW / 32), I_O = (VW / 64) * (D / 32), I_GU = 2 * (D / 64) * (FFD / 32), I_D = (FFD / 64) * (D / 32), I_F = (D / 64) * (D / 32);
        constexpr int NITEMS = I_IN + I_O + I_GU + I_D + I_F;
        for (int it = gw; it < NITEMS; it += NGW) {
            int r = it;
            if (r < I_IN) { tr_plain(ret_w_in, D, INW, WIN, r, scr, lane); continue; } r -= I_IN;
            if (r < I_O) { tr_plain(ret_w_out, VW, D, WO, r, scr, lane); continue; } r -= I_O;
            if (r < I_GU) { tr_gu(d_wg, d_wu, D, FFD, WGU, r, scr, lane); continue; } r -= I_GU;
            if (r < I_D) { tr_plain(d_wd, FFD, D, WD, r, scr, lane); continue; } r -= I_D;
            tr_plain(fnet_w, D, D, WF, r, scr, lane);
        }
        for (int e = (vcu * 512 + tid); e < SEQ * 128; e += G * 512) { const int s = e >> 7, i = e & 127;
            const float inv = powf(10000.0f, -(float)i / 128.0f); const float ang = (float)s * inv; float sn, cs; sincosf(ang, &sn, &cs);
            rot[e] = (f32x2){cs, sn}; rotT[(size_t)i * RTP + s] = (f32x2){cs, sn}; }
        for (int e = (vcu * 512 + tid); e < 512 * 256; e += G * 512) { const int r = e >> 8, c = e & 255, mm = ((r & 255) * c) & 255;
            const float v = r < 256 ? cospif((float)mm * (1.0f / 128.0f)) : -sinpif((float)mm * (1.0f / 128.0f)); WC[e] = (bf16)(cvt_pk_bf16(v, 0.f) & 0xffffu); }
        for (int m = gw; m < T; m += NGW) { f32x4 v[4]; rms_row(x + (size_t)m * D, mix_norm, HN + (size_t)m * D, lane, v); }
    }
    GRID_BAR();

    if (PH(1) && PH(19)) {
        PHASE_VARS
        SchedPlain S{(const GAS char*)HN, (const GAS char*)WIN, (size_t)256 * D * 2, (size_t)256 * D * 2, T / 256, 8, G, bx};
        EpiRopeQK E{Qb, Kb, rot};
        pg8::gemm_phase<EpiRopeQK, SchedPlain, false>(lds, wave_k, D, D, D, S, E);
    }
    if (PH(1) && PH(20)) {
        PHASE_VARS
        SchedPlain S{(const GAS char*)(WIN + (size_t)QKW * D), (const GAS char*)HN, (size_t)256 * D * 2, (size_t)256 * D * 2, 4, T / 256, G, bx};
        EpiRopeKT E{KT, rotT, l2g};
        pg8::gemm_phase<EpiRopeKT, SchedPlain, false>(lds, wave_k, D, D, D, S, E);
    }
    if (PH(1) && PH(21)) {
        PHASE_VARS
        SchedPlain S{(const GAS char*)(WIN + (size_t)2 * QKW * D), (const GAS char*)HN, (size_t)256 * D * 2, (size_t)256 * D * 2, 8, T / 256, G, bx};
        EpiBf16<true> E{VT, T};
        pg8::gemm_phase<EpiBf16<true>, SchedPlain, false>(lds, wave_k, D, D, D, S, E);
    }
    GRID_BAR();

    if (PH(2)) {
        PHASE_VARS
        SchedPc S{(const GAS char*)Qb, (const GAS char*)Kb, G, bx};
        EpiPc E{PC, (GAS bf16*)(ws + WS_ROT), l2g};
        pg8::gemm_phase<EpiPc, SchedPc, false>(lds, wave_k, QKW, QKW, DK, S, E);
    }
    GRID_BAR();

    if (PH(3)) {
        PHASE_VARS
        for (int u = vcu; u < NB * NH * 8; u += G) { const int hh_ = (u >> 3) & 3; const float l2f = l2g[hh_], l2b = l2g[4 + hh_];
            sweep_unit(lds, Qb, KT, KT + (size_t)QKW * T, VT, PC, (const GAS bf16*)(ws + WS_ROT), (const GAS bf16*)(ws + WS_CTL + 512 * 1024), Yb, statp, l2f, l2b, u >> 5, hh_, u & 7, wave_k); }
    }
    GRID_BAR();

    if (PH(5)) {
        PHASE_VARS
        SchedPlain S{(const GAS char*)HN, (const GAS char*)(WIN + (size_t)(2 * QKW + VW) * D), (size_t)256 * D * 2, (size_t)256 * D * 2, T / 256, 8, G, bx};
        EpiGate E{Yb, YG, statp, gn_gain, (LAS f32x2*)(lds + 135168)};
        pg8::gemm_phase<EpiGate, SchedPlain, false>(lds, wave_k, D, D, D, S, E);
    }
    GRID_BAR();

    if (PH(6)) {
        PHASE_VARS
        SchedPlain S{(const GAS char*)YG, (const GAS char*)WO, (size_t)256 * VW * 2, (size_t)256 * VW * 2, T / 256, 4, G, bx};
        EpiRes<true> E{(const GAS void*)x, HB};
        pg8::gemm_phase<EpiRes<true>, SchedPlain, false>(lds, wave_k, VW, VW, VW, S, E);
    }
    GRID_BAR();

    if (PH(7)) {
        PHASE_VARS
        for (int m = gw; m < T; m += NGW) { f32x4 v[4]; rms_row_b(HB + (size_t)m * D, ffn_norm, HNB + (size_t)m * D, lane, v); }
        LAS float* scr = (LAS float*)(lds + wave * 16384);
        constexpr int I_GU = 2 * (D / 64) * (FFE / 32), I_D = (FFE / 64) * (D / 32);
        for (int it = gw; it < NE * (I_GU + I_D); it += NGW) {
            const int e = it / (I_GU + I_D); int r = it - e * (I_GU + I_D);
            if (r < I_GU) tr_gu(m_wg + (size_t)e * D * FFE, m_wu + (size_t)e * D * FFE, D, FFE, WMGU + (size_t)e * 2 * FFE * D, r, scr, lane);
            else tr_plain(m_wd + (size_t)e * FFE * D, FFE, D, WMD + (size_t)e * D * FFE, r - I_GU, scr, lane);
        }
    }
    GRID_BAR();

    if (PH(8)) {
        PHASE_VARS
        SchedPlain S{(const GAS char*)HNB, (const GAS char*)WGU, (size_t)256 * D * 2, (size_t)256 * D * 2, T / 256, 2 * FFD / 256, G, bx};
        EpiSwiGLU E{ACTD, FFD};
        pg8::gemm_phase<EpiSwiGLU, SchedPlain, false>(lds, wave_k, D, D, D, S, E);
    }
    GRID_BAR();
    if (PH(9)) {
        PHASE_VARS
        SchedPlain S{(const GAS char*)ACTD, (const GAS char*)WD, (size_t)256 * FFD * 2, (size_t)256 * FFD * 2, T / 256, 4, G, bx};
        EpiRes<false> E{(const GAS void*)HB, HB};
        pg8::gemm_phase<EpiRes<false>, SchedPlain, false>(lds, wave_k, FFD, FFD, FFD, S, E);
    }
    GRID_BAR();

    if (PH(10)) {
        PHASE_VARS
        for (int m = gw; m < T; m += NGW) { f32x4 v[4]; rms_row_b(HB + (size_t)m * D, mix_norm + D, HNB + (size_t)m * D, lane, v); }
        for (int e = vcu * 512 + tid; e < 512 * 1024; e += G * 512) { const int ka = e >> 10, c = e & 1023, a = c & 511, mm = (a * ka) & 511;
            const float v = (c < 512 ? cospif((float)mm * (1.0f / 256.0f)) : sinpif((float)mm * (1.0f / 256.0f))) * (1.0f / 1024.0f); WSEQ[e] = (bf16)(cvt_pk_bf16(v, 0.f) & 0xffffu); }
    }
    GRID_BAR();

    if (PH(11)) {
        PHASE_VARS
        SchedFnA S{(const GAS char*)WC, (const GAS char*)HNB, G, bx};
        EpiZ2 E{Z2};
        pg8::gemm_phase<EpiZ2, SchedFnA, false>(lds, wave_k, 256, D, 256, S, E);
    }
    GRID_BAR();
    if (PH(22)) {
        PHASE_VARS
        float wc0[8], ws0[8];
#pragma unroll
        for (int kb = 0; kb < 8; ++kb) { const float ang = (float)((8 * lane * kb) & 4095) * (1.0f / 2048.0f); wc0[kb] = cospif(ang); ws0[kb] = sinpif(ang); }
        for (int rw = gw; rw < NB * 1024; rw += NGW) {
            GAS bf16* row = Z2 + (size_t)rw * 8192;
#pragma unroll
            for (int hq = 0; hq < 2; ++hq) {
                u32x2 zin[2][8], zout[8][2];
#pragma unroll
                for (int ri = 0; ri < 2; ++ri)
#pragma unroll
                    for (int bb = 0; bb < 8; ++bb) zin[ri][bb] = *(const GAS u32x2*)(row + ri * 4096 + 512 * bb + 8 * lane + 4 * hq);
#pragma unroll
                for (int q = 0; q < 2; ++q) {
                    float outr[2][8], outi[2][8];
#pragma unroll
                    for (int tt = 0; tt < 2; ++tt) {
                        const int t = 4 * hq + 2 * q + tt;
                        float zr[8], zi[8];
#pragma unroll
                        for (int bb = 0; bb < 8; ++bb) { const unsigned wr_ = zin[0][bb][q], wi_ = zin[1][bb][q]; zr[bb] = tt ? bf_hi(wr_) : bf_lo(wr_); zi[bb] = tt ? bf_hi(wi_) : bf_lo(wi_); }
#pragma unroll
                        for (int kb = 0; kb < 8; ++kb) {
                            float ur = 0.f, ui = 0.f;
#pragma unroll
                            for (int bb = 0; bb < 8; ++bb) {
                                const int m8 = (bb * kb) & 7;
                                const float c8 = (m8 == 0) ? 1.f : (m8 == 4) ? -1.f : (m8 == 2 || m8 == 6) ? 0.f : (m8 == 1 || m8 == 7) ? 0.70710678118654752f : -0.70710678118654752f;
                                const float s8 = (m8 == 0 || m8 == 4) ? 0.f : (m8 == 2) ? 1.f : (m8 == 6) ? -1.f : (m8 == 1 || m8 == 3) ? 0.70710678118654752f : -0.70710678118654752f;
                                ur += c8 * zr[bb] + s8 * zi[bb]; ui += c8 * zi[bb] - s8 * zr[bb]; }
                            const int mt = (t * kb);
                            const float ct = __builtin_cosf((float)mt * 0.00153398078788564123f), st_ = __builtin_sinf((float)mt * 0.00153398078788564123f);
                            const float twc = wc0[kb] * ct - ws0[kb] * st_, tws = ws0[kb] * ct + wc0[kb] * st_;
                            outr[tt][kb] = ur * twc + ui * tws; outi[tt][kb] = ui * twc - ur * tws; }
                    }
#pragma unroll
                    for (int kb = 0; kb < 8; ++kb) { zout[kb][0][q] = cvt_pk_bf16(outr[0][kb], outr[1][kb]); zout[kb][1][q] = cvt_pk_bf16(outi[0][kb], outi[1][kb]); }
                    __builtin_amdgcn_sched_barrier(0);
                }
#pragma unroll
                for (int kb = 0; kb < 8; ++kb)
#pragma unroll
                    for (int ri = 0; ri < 2; ++ri) *(GAS u32x2*)(row + kb * 1024 + ri * 512 + 8 * lane + 4 * hq) = zout[kb][ri];
                __builtin_amdgcn_sched_barrier(0);
            }
        }
    }
    GRID_BAR();
    if (PH(12)) {
        PHASE_VARS
        SchedFnB S{(GAS const char*)WSEQ, (GAS const char*)Z2, G, bx};
        EpiYf E{HNB};
        pg8::gemm_phase<EpiYf, SchedFnB, false>(lds, wave_k, 1024, 1024, 1024, S, E);
    }
    GRID_BAR();
    if (PH(13)) {
        PHASE_VARS
        SchedPlain S{(const GAS char*)HNB, (const GAS char*)WF, (size_t)256 * D * 2, (size_t)256 * D * 2, T / 256, 4, G, bx};
        EpiRes<false> E{(const GAS void*)HB, HB};
        pg8::gemm_phase<EpiRes<false>, SchedPlain, false>(lds, wave_k, D, D, D, S, E);
    }
    GRID_BAR();

    if (PH(14)) {
        PHASE_VARS
        LAS float* wrl = (LAS float*)lds;
        LAS int* le = (LAS int*)(lds + 32768);
        for (int i = tid; i < D * NE / 4; i += NWAVES * 64) ((LAS f32x4*)wrl)[i] = ((const GAS f32x4*)moe_router)[i];
        for (int i = vcu * 512 + tid; i < 2 * MOE_ROWS; i += G * 512) rowtok[i] = -1;
        __syncthreads();
        for (int tb = vcu; tb < T / 128; tb += G) {
            for (int rr = 0; rr < 16; ++rr) { const int tl = wave * 16 + rr, m = tb * 128 + tl; f32x4 v[4];
                rms_row_b(HB + (size_t)m * D, ffn_norm + D, HNB + (size_t)m * D, lane, v);
                float lg[8];
#pragma unroll
                for (int e = 0; e < 8; ++e) lg[e] = 0.f;
#pragma unroll
                for (int j = 0; j < 4; ++j)
#pragma unroll
                    for (int c = 0; c < 4; ++c) { const int col = rmsb_col(j, lane) + c; const f32x4 w0 = *(const LAS f32x4*)(wrl + col * 8), w1 = *(const LAS f32x4*)(wrl + col * 8 + 4); const float xv = v[j][c];
                        lg[0] += xv * w0.x; lg[1] += xv * w0.y; lg[2] += xv * w0.z; lg[3] += xv * w0.w; lg[4] += xv * w1.x; lg[5] += xv * w1.y; lg[6] += xv * w1.z; lg[7] += xv * w1.w; }
#pragma unroll
                for (int e = 0; e < 8; ++e) lg[e] = wave_sum(lg[e]);
                int e0 = 0; float b0 = lg[0];
#pragma unroll
                for (int e = 1; e < 8; ++e) if (lg[e] > b0) { b0 = lg[e]; e0 = e; }
                int e1 = -1; float b1 = -3.0e38f;
#pragma unroll
                for (int e = 0; e < 8; ++e) if (e != e0 && lg[e] > b1) { b1 = lg[e]; e1 = e; }
                const float w0 = 1.0f / (1.0f + __expf(b1 - b0));
                if (lane == 0) { toke[2 * m] = e0; toke[2 * m + 1] = e1; tokw[2 * m] = w0; tokw[2 * m + 1] = 1.0f - w0; le[tl] = e0; le[128 + tl] = e1; } }
            __syncthreads();
            if (tid < 16) { const int s = tid >> 3, e = tid & 7; int c = 0; for (int i = 0; i < 128; ++i) c += (le[s * 128 + i] == e) ? 1 : 0; bcnt[tb * 16 + tid] = c; }
            if (tid >= 64 && tid < 128) { const int pi = tid - 64; int c = 0; for (int i = 0; i < 128; ++i) c += (le[i] * 8 + le[128 + i] == pi) ? 1 : 0; pcnt[tb * 64 + pi] = c; }
            __syncthreads();
        }
    }
    GRID_BAR();

    LAS int* segoff = (LAS int*)(lds + 132096);
    LAS int* ntile = (LAS int*)(lds + 132096 + 64);
    LAS unsigned char* tile_e = (LAS unsigned char*)(lds + 132096 + 128);
    if (PH(15)) {
        PHASE_VARS
        LAS int* pfx = (LAS int*)lds;
        LAS int* cph = (LAS int*)(lds + 65792);
        LAS int* fq_ = (LAS int*)(lds + 65792 + 16384);
        LAS int* tot = fq_ + 64;
        LAS int* tpi = tot + 16;
        LAS int* tex = tpi + 128;
        for (int i = tid; i < 256 * 64; i += NWAVES * 64) pfx[i] = pcnt[i];
        __syncthreads();
        if (tid < 64) { int run = 0; for (int b2 = 0; b2 < 256; ++b2) { const int c = pfx[b2 * 64 + tid]; pfx[b2 * 64 + tid] = run; run += c; } pfx[256 * 64 + tid] = run; }
        __syncthreads();
        if (tid == 0) {
            int n0[8], d[8], r[8]; int rs = 0;
            for (int e = 0; e < 8; ++e) { int c = 0; for (int x2 = 0; x2 < 8; ++x2) c += pfx[256 * 64 + e * 8 + x2]; n0[e] = c; r[e] = c & 255; d[e] = -(c & 255); rs += c & 255; }
            int extra = rs >> 8;
            for (int k = 0; k < extra; ++k) { int be = -1, br = -1; for (int e = 0; e < 8; ++e) if (d[e] < 0 && d[e] == -r[e] && r[e] > br) { br = r[e]; be = e; } if (be >= 0) d[be] += 256; }
            for (int i = 0; i < 64; ++i) fq_[i] = 0;
            for (int a = 0; a < 8; ++a) for (int e = 0; e < 8; ++e) if (a != e && d[a] < 0 && d[e] > 0) { int fl = -d[a]; if (d[e] < fl) fl = d[e]; const int av = pfx[256 * 64 + a * 8 + e]; if (av < fl) fl = av; fq_[a * 8 + e] = fl; d[a] += fl; d[e] -= fl; }
        }
        __syncthreads();
        if (tid < 256) {
            int c0[8], c1[8];
#pragma unroll
            for (int e = 0; e < 8; ++e) { c0[e] = 0; c1[e] = 0; }
            for (int a = 0; a < 8; ++a) for (int e = 0; e < 8; ++e) { const int pi = a * 8 + e; const int cnt = pfx[(tid + 1) * 64 + pi] - pfx[tid * 64 + pi]; int fl = fq_[pi] - pfx[tid * 64 + pi]; fl = fl < 0 ? 0 : (fl > cnt ? cnt : fl);
#pragma unroll
                for (int q = 0; q < 8; ++q) { c0[q] += (q == a ? cnt - fl : 0) + (q == e ? fl : 0); c1[q] += (q == e ? cnt - fl : 0) + (q == a ? fl : 0); } }
#pragma unroll
            for (int e = 0; e < 8; ++e) { cph[tid * 16 + e] = c0[e]; cph[tid * 16 + 8 + e] = c1[e]; }
        }
        __syncthreads();
        if (tid < 16) { int run = 0; for (int b2 = 0; b2 < 256; ++b2) { const int c = cph[b2 * 16 + tid]; cph[b2 * 16 + tid] = run; run += c; } tot[tid] = run; }
        __syncthreads();
        if (tid < 2) { int off = 0, nt = 0; for (int e = 0; e < 8; ++e) { segoff[tid * 8 + e] = off; const int tl = (tot[tid * 8 + e] + 255) >> 8; for (int q = 0; q < tl; ++q) tile_e[tid * 160 + nt + q] = (unsigned char)e; nt += tl; off += tl * 256; } ntile[tid] = nt; }
        __syncthreads();
        for (int tb = vcu; tb < T / 128; tb += G) {
            int e0 = 0, e1 = 0, flip = 0;
            if (tid < 128) { const int m = tb * 128 + tid; e0 = toke[2 * m]; e1 = toke[2 * m + 1]; tpi[tid] = e0 * 8 + e1; }
            __syncthreads();
            if (tid < 128) { const int pi = e0 * 8 + e1; int rk = 0; for (int i = 0; i < tid; ++i) rk += (tpi[i] == pi) ? 1 : 0;
                flip = (pfx[tb * 64 + pi] + rk) < fq_[pi] ? 1 : 0; tex[tid] = flip ? e1 : e0; tex[128 + tid] = flip ? e0 : e1; }
            __syncthreads();
            if (tid < 128) { const int m = tb * 128 + tid;
#pragma unroll
                for (int ph = 0; ph < 2; ++ph) { const int e = tex[ph * 128 + tid]; int rk = 0; for (int i = 0; i < tid; ++i) rk += (tex[ph * 128 + i] == e) ? 1 : 0;
                    const int row = segoff[ph * 8 + e] + cph[tb * 16 + ph * 8 + e] + rk;
                    rowtok[ph * MOE_ROWS + row] = m; rowgate[ph * MOE_ROWS + row] = tokw[2 * m + (ph ^ flip)]; } }
            __syncthreads();
        }
    }
    GRID_BAR();

    if (PH(16))
#pragma unroll
    for (int s = 0; s < 2; ++s) {
        {
            PHASE_VARS
            SchedMoe S{(const GAS char*)HNB, (const GAS char*)WMGU, rowtok + s * MOE_ROWS, tile_e + s * 160, 0, (size_t)2 * FFE * D * 2, (size_t)256 * D * 2, ntile[s], 2 * FFE / 256, G, bx, true};
            EpiSwiGLU E{ACTM, FFE};
            pg8::gemm_phase<EpiSwiGLU, SchedMoe, true>(lds, wave_k, D, D, D, S, E);
        }
        GRID_BAR();
        {
            PHASE_VARS
            SchedMoe S{(const GAS char*)ACTM, (const GAS char*)WMD, rowtok + s * MOE_ROWS, tile_e + s * 160, (size_t)256 * FFE * 2, (size_t)D * FFE * 2, (size_t)256 * FFE * 2, ntile[s], 4, G, bx, false};
            EpiMoeDown E{HB, rowtok + s * MOE_ROWS, rowgate + s * MOE_ROWS};
            pg8::gemm_phase<EpiMoeDown, SchedMoe, false>(lds, wave_k, FFE, FFE, FFE, S, E);
        }
        GRID_BAR();
    }

    if (PH(17)) {
        PHASE_VARS
        const bool bad = __hip_atomic_load((GAS unsigned*)(ws + WS_CTL) + CW_BAR + XB_TMO, RLX_AGENT) != 0u;
        for (int m = gw; m < T; m += NGW) {
            const GAS bf16* hrow = HB + (size_t)m * D; GAS float* orow = hres + (size_t)m * D;
            f32x4 v[4]; float s = 0.f;
#pragma unroll
            for (int jh = 0; jh < 2; ++jh) { const u32x4 xx = *(const GAS u32x4*)(hrow + 512 * jh + 8 * lane);
                v[2 * jh] = (f32x4){bf_lo(xx.x), bf_hi(xx.x), bf_lo(xx.y), bf_hi(xx.y)}; v[2 * jh + 1] = (f32x4){bf_lo(xx.z), bf_hi(xx.z), bf_lo(xx.w), bf_hi(xx.w)}; }
#pragma unroll
            for (int j = 0; j < 4; ++j) s += (v[j].x * v[j].x + v[j].y * v[j].y) + (v[j].z * v[j].z + v[j].w * v[j].w);
            const float r = bad ? __builtin_nanf("") : 1.0f / sqrtf(wave_sum(s) * (1.f / D) + EPS);
#pragma unroll
            for (int j = 0; j < 4; ++j) { const int col = rmsb_col(j, lane); *(GAS f32x4*)(orow + col) = v[j] * r * *(const GAS f32x4*)(final_norm + col); }
        }
    }
}

extern "C" void kernel_launch(void* const* d_in, const int* in_sizes, int n_in, void* d_out, int out_size, void* d_ws, size_t ws_size, hipStream_t stream) {
    static int grid = 0;
    if (grid == 0) {
        if (n_in != 16 || in_sizes[0] != T * D || out_size != T * D || ws_size < WS_END) { fprintf(stderr, "kernel_launch: unexpected shapes (n_in %d, in0 %d, out %d, ws %zu)\n", n_in, n_in > 0 ? in_sizes[0] : -1, out_size, ws_size); grid = -1; return; }
        int dev = 0, cus = 0, per_cu = 0;
        if (hipGetDevice(&dev) != hipSuccess || hipDeviceGetAttribute(&cus, hipDeviceAttributeMultiprocessorCount, dev) != hipSuccess) { grid = -1; return; }
        if (hipFuncSetAttribute((const void*)fwd_kernel, hipFuncAttributeMaxDynamicSharedMemorySize, LDS_BYTES) != hipSuccess) { fprintf(stderr, "kernel_launch: hipFuncSetAttribute failed\n"); grid = -1; return; }
        if (hipOccupancyMaxActiveBlocksPerMultiprocessor(&per_cu, (const void*)fwd_kernel, NWAVES * 64, LDS_BYTES) != hipSuccess || per_cu < 1) { fprintf(stderr, "kernel_launch: occupancy query says %d\n", per_cu); }
        (void)hipGetLastError();
        grid = cus;
    }
    if (grid < 0) return;
    if (hipMemsetAsync((char*)d_ws + WS_CTL, 0, CTL_ZERO_BYTES, stream) != hipSuccess) return;
    Args a{};
    for (int i = 0; i < 16; ++i) a.in[i] = (const float*)d_in[i];
    a.out = (float*)d_out; a.ws = (unsigned char*)d_ws;
    hipLaunchKernelGGL(fwd_kernel, dim3(grid), dim3(NWAVES * 64), LDS_BYTES, stream, a);
}
```

```cpp
#include <hip/hip_runtime.h>
#include <cstdio>
#include <cstdint>

#define LAS __attribute__((address_space(3)))
#define GAS __attribute__((address_space(1)))
typedef unsigned short bf16;
typedef short bf16x8 __attribute__((ext_vector_type(8)));
typedef float f32x2 __attribute__((ext_vector_type(2)));
typedef float f32x4 __attribute__((ext_vector_type(4)));
typedef float f32x16 __attribute__((ext_vector_type(16)));
typedef unsigned u32x2 __attribute__((ext_vector_type(2)));
typedef unsigned u32x4 __attribute__((ext_vector_type(4)));
typedef GAS unsigned gu32;

constexpr int D = 1024, NB = 8, SEQ = 4096, T = NB * SEQ;
constexpr int NH = 4, DK = 256, DV = 512, QKW = 1024, VW = 2048, INW = 6144, CH = 128, NCH = SEQ / CH;
constexpr int FFD = 2816, NE = 8, FFE = 3584;
constexpr int MOE_ROWS = T + NE * 256;
constexpr float EPS = 1e-6f;

constexpr size_t MiB = 1u << 20;
constexpr size_t WS_CTL = 0, CTL_ZERO_BYTES = 1 * MiB;
constexpr size_t WS_ROT = 1 * MiB, WS_ROTT = 5 * MiB, WS_WC = 10 * MiB + 768 * 1024;
constexpr int RTP = SEQ + 64;
constexpr size_t WS_TOKE = 9 * MiB + 256 * 1024;
constexpr size_t WS_TOKW = WS_TOKE + 256 * 1024;
constexpr size_t WS_BCNT = WS_TOKW + 256 * 1024;
constexpr size_t WS_ROWTOK = WS_BCNT + 16 * 1024;
constexpr size_t WS_ROWGATE = WS_ROWTOK + 2 * MOE_ROWS * 4;
constexpr size_t WS_PCNT = 10 * MiB + 512 * 1024;
constexpr size_t WS_STATS = 11 * MiB;
static_assert(WS_ROWGATE + 2 * MOE_ROWS * 4 <= WS_PCNT, "small tables");
constexpr size_t WS_WIN = 12 * MiB, WS_WO = 24 * MiB, WS_WGU = 28 * MiB, WS_WD = 39 * MiB, WS_WF = 44 * MiB + 512 * 1024;
constexpr size_t WS_HN = 48 * MiB;
constexpr size_t WS_Q = 112 * MiB, WS_K = 176 * MiB, WS_KT = 240 * MiB  , WS_VT = 368 * MiB, WS_PC = 496 * MiB;
constexpr size_t WS_YG = 240 * MiB;
constexpr size_t WS_STATP = 176 * MiB;
constexpr size_t WS_ACTD = 112 * MiB;
constexpr size_t WS_Z2 = 112 * MiB, WS_WSEQ = 240 * MiB;
constexpr size_t WS_ACTM = 112 * MiB;
constexpr size_t WS_WMGU = 352 * MiB, WS_WMD = 464 * MiB, WS_END = 528 * MiB;
static_assert(WS_ACTM + (size_t)MOE_ROWS * FFE * 2 <= WS_WMGU, "moe act");
static_assert(WS_PC + (size_t)NB * NH * NCH * CH * CH * 2 <= 528 * MiB, "epoch A");
static_assert(WS_WF + (size_t)D * D * 2 <= WS_HN, "weights");
constexpr int CW_BAR = 4096;
constexpr int CW_CHK = 64;

constexpr int RING_BYTES = 131072;
constexpr int LDSCTL_OFF = 139264, MISC_OFF = LDSCTL_OFF + 320;
constexpr int LDS_BYTES = 147456;

#define LDS_WAIT() asm volatile("s_waitcnt lgkmcnt(0)" ::: "memory")
#define VM_WAIT() asm volatile("s_waitcnt vmcnt(0)" ::: "memory")
#define RLX_AGENT __ATOMIC_RELAXED, __HIP_MEMORY_SCOPE_AGENT

__device__ __forceinline__ unsigned cvt_pk_bf16(float lo, float hi) { unsigned r; asm volatile("v_cvt_pk_bf16_f32 %0, %1, %2" : "=v"(r) : "v"(lo), "v"(hi)); return r; }
__device__ __forceinline__ float bf_lo(unsigned w) { return __uint_as_float(w << 16); }
__device__ __forceinline__ float bf_hi(unsigned w) { return __uint_as_float(w & 0xffff0000u); }
__device__ __forceinline__ float fast_exp2(float x) { return __builtin_amdgcn_exp2f(x); }
__device__ __forceinline__ int lane_id_v() { int l; asm volatile("v_mbcnt_lo_u32_b32 %0, -1, 0\n\tv_mbcnt_hi_u32_b32 %0, -1, %0" : "=v"(l)); return l; }
__device__ __forceinline__ int tid_of(int wave_s) { asm volatile("" : "+s"(wave_s)); return wave_s * 64 + lane_id_v(); }
__device__ __forceinline__ int rot_col(int row, int tok) { return (tok + ((row & 15) << 11)) & (32768 - 1); }
__device__ __forceinline__ float silu_f(float v) { return v * __builtin_amdgcn_rcpf(1.0f + __builtin_amdgcn_exp2f(v * -1.44269504088896341f)); }

namespace pg8 {
constexpr int BM = 256, BK = 64, HALF = 128, HTB = HALF * BK * 2, STAGE_BYTES = 8 * HTB, NXCD = 8, WGM = 8;
__host__ __device__ __forceinline__ int lds_byte(int r, int c) { const int st = (r >> 4) * 2 + (c >> 5), rr = r & 15, cc = c & 31, ob = rr * 64 + cc * 2; return st * 1024 + (ob ^ (((ob >> 9) & 1) << 5)); }
__host__ __device__ __forceinline__ void stage_rc(int b, int& R, int& C) { const int st = b / 1024, sb = b % 1024, swz = sb ^ (((sb >> 9) & 1) << 5); R = (st >> 1) * 16 + swz / 64; C = (st & 1) * 32 + (swz % 64) / 2; }
__host__ __device__ __forceinline__ int perm32(int rho) { const int n = rho >> 4, i = rho & 15; return 8 * (i >> 2) + 4 * n + (i & 3); }

struct Unit { const GAS char* A; const GAS char* B; const GAS int* rows; int pm, pn, z; };

__device__ __forceinline__ bool tile_of(long L, int nM, int nN, int& pm, int& pn) {
    const int nwg = nM * nN; if (L >= nwg) return false;
    int wgid = (int)L; { const int q = nwg / NXCD, r = nwg % NXCD, xcd = wgid % NXCD, off = wgid / NXCD; wgid = (xcd < r ? xcd * (q + 1) : r * (q + 1) + (xcd - r) * q) + off; }
    const int nig = WGM * nN, gid = wgid / nig, fm = gid * WGM, gsz = (nM - fm) < WGM ? (nM - fm) : WGM;
    pm = fm + ((wgid % nig) % gsz); pn = (wgid % nig) / gsz; return true;
}

template <class Epi, class Sched, bool GATHER>
__device__ __forceinline__ void gemm_phase(LAS unsigned char* lds, const int wave_s, const int lda, const int ldb, const int K, const Sched& S, const Epi& E) {
    const int tid = tid_of(wave_s);
    const int wid = __builtin_amdgcn_readfirstlane(tid >> 6), lane = tid & 63, wr = wid >> 2, wc = wid & 3, fr = lane & 15, fq = lane >> 4;
    const int nt = K / BK;
    unsigned vA[2][2], vAn[2][2], voffB[2];
#pragma unroll
    for (int i = 0; i < 2; ++i) { int R, C; stage_rc(tid * 16 + i * 8192, R, C); const int Rb = Epi::PERM ? ((R & ~31) + perm32(R & 31)) : R;
        voffB[i] = (unsigned)(S.brow(Rb) * ldb + C) * 2u;
#pragma unroll
        for (int h = 0; h < 2; ++h) { vA[h][i] = (unsigned)((h * HALF + R) * lda + C) * 2u; vAn[h][i] = vA[h][i]; } }
    const size_t kstep = (size_t)(BK * 2);
    const size_t hstepB = (size_t)(S.brow(HALF) - S.brow(0)) * ldb * 2;
    const unsigned ldsw = (unsigned)wid * 1024u;
    const int aoff = lds_byte(wr * 64 + fr, fq * 8), boff = lds_byte(wc * 32 + fr, fq * 8);
#define PG8_SA(b, h) (((b) * 2 + (h)) * HTB)
#define PG8_SB(b, h) ((4 + (b) * 2 + (h)) * HTB)
#define PG8_STAGE_B(bufoff, gbase) do { _Pragma("unroll") for (int _i = 0; _i < 2; ++_i) \
        __builtin_amdgcn_global_load_lds((const GAS unsigned*)((const GAS char*)(gbase) + voffB[_i]), (LAS unsigned*)(lds + (bufoff) + ldsw + _i * 8192), 16, 0, 0); } while (0)
#define PG8_STAGE_A(bufoff, gbase, v0, v1) do { \
        __builtin_amdgcn_global_load_lds((const GAS unsigned*)((const GAS char*)(gbase) + (v0)), (LAS unsigned*)(lds + (bufoff) + ldsw), 16, 0, 0); \
        __builtin_amdgcn_global_load_lds((const GAS unsigned*)((const GAS char*)(gbase) + (v1)), (LAS unsigned*)(lds + (bufoff) + ldsw + 8192), 16, 0, 0); } while (0)
#define PG8_LDA(dst, b, h) do { _Pragma("unroll") for (int m = 0; m < 4; ++m) _Pragma("unroll") for (int k = 0; k < 2; ++k) dst[m][k] = *(const LAS bf16x8*)(lds + PG8_SA(b, h) + aoff + m * 2048 + k * 1024); } while (0)
#define PG8_LDB(dst, b, h) do { _Pragma("unroll") for (int n = 0; n < 2; ++n) _Pragma("unroll") for (int k = 0; k < 2; ++k) dst[n][k] = *(const LAS bf16x8*)(lds + PG8_SB(b, h) + boff + n * 2048 + k * 1024); } while (0)
#define PG8_MMA(ai, bj, At, Bt) do { __builtin_amdgcn_s_setprio(1); _Pragma("unroll") for (int m = 0; m < 4; ++m) _Pragma("unroll") for (int n = 0; n < 2; ++n) _Pragma("unroll") for (int k = 0; k < 2; ++k) \
        acc[ai][bj][m][n] = __builtin_amdgcn_mfma_f32_16x16x32_bf16(Bt[n][k], At[m][k], acc[ai][bj][m][n], 0, 0, 0); __builtin_amdgcn_s_setprio(0); } while (0)
#define PG8_WAIT_V(n) asm volatile("s_waitcnt vmcnt(" #n ")" ::: "memory")
#define PG8_WAIT_L(n) asm volatile("s_waitcnt lgkmcnt(" #n ")" ::: "memory")
#define PG8_BAR __builtin_amdgcn_s_barrier()
#define PG8_SCHED __builtin_amdgcn_sched_barrier(0)
#define PG8_LOADROWS(dst, u) do { if constexpr (GATHER) { const int _tz = tid_of(wave_s); _Pragma("unroll") for (int _i = 0; _i < 2; ++_i) { int _R, _C; stage_rc(_tz * 16 + _i * 8192, _R, _C); \
        _Pragma("unroll") for (int _h = 0; _h < 2; ++_h) { const int _t = (u).rows[_h * HALF + _R]; dst[_h][_i] = (unsigned)((_t < 0 ? 0 : _t) * lda + _C) * 2u; } } } } while (0)
#define PG8_VAN(h, i) (GATHER ? vAn[h][i] : vA[h][i])
    Unit cur, nxt; int ui = 0;
    if (!S.next(0, cur)) return;
    f32x4 acc[2][2][4][2];
#pragma unroll
    for (int a = 0; a < 2; ++a)
#pragma unroll
        for (int b = 0; b < 2; ++b)
#pragma unroll
            for (int m = 0; m < 4; ++m)
#pragma unroll
                for (int n = 0; n < 2; ++n) acc[a][b][m][n] = (f32x4){0.f, 0.f, 0.f, 0.f};
    bf16x8 At[4][2], B0[2][2], B1[2][2];
    const GAS char* cA = cur.A; const GAS char* cB = cur.B;
    PG8_LOADROWS(vA, cur);
    if constexpr (GATHER) { vAn[0][0] = vA[0][0]; vAn[0][1] = vA[0][1]; vAn[1][0] = vA[1][0]; vAn[1][1] = vA[1][1]; }
    PG8_STAGE_B(PG8_SB(0, 0), cB); PG8_STAGE_B(PG8_SB(0, 1), cB + hstepB); PG8_STAGE_A(PG8_SA(0, 0), cA, vA[0][0], vA[0][1]); PG8_STAGE_A(PG8_SA(0, 1), cA, vA[1][0], vA[1][1]);
    if (wr == 1) PG8_BAR;
    PG8_WAIT_V(2); PG8_BAR;
    PG8_STAGE_B(PG8_SB(1, 0), cB + kstep); PG8_STAGE_A(PG8_SA(1, 0), cA + kstep, vA[0][0], vA[0][1]); PG8_STAGE_B(PG8_SB(1, 1), cB + hstepB + kstep);
    PG8_WAIT_V(6); PG8_BAR;
    for (;;) {
        const bool has_next = S.next(ui + 1, nxt);
        const GAS char* nA = has_next ? nxt.A : cA; const GAS char* nB = has_next ? nxt.B : cB;
#pragma unroll 1
        for (int t = 0; t < nt; t += 2) {
            const bool last = (t == nt - 2);
            const GAS char* a1 = cA + (size_t)(t + 1) * kstep;
            const GAS char* a2 = last ? nA : cA + (size_t)(t + 2) * kstep; const GAS char* b2 = last ? nB : cB + (size_t)(t + 2) * kstep;
            const GAS char* a3 = a2 + kstep; const GAS char* b3 = b2 + kstep;
            if constexpr (GATHER) { if (last && has_next) { PG8_LOADROWS(vAn, nxt); } }
            PG8_LDB(B0, 0, 0); PG8_LDB(B1, 0, 1); PG8_SCHED; PG8_LDA(At, 0, 0); PG8_STAGE_A(PG8_SA(1, 1), a1, vA[1][0], vA[1][1]);
            PG8_WAIT_V(8); PG8_WAIT_L(0); PG8_BAR; PG8_MMA(0, 0, At, B0); PG8_MMA(0, 1, At, B1); PG8_BAR; PG8_SCHED;
            PG8_LDA(At, 0, 1); PG8_STAGE_B(PG8_SB(0, 0), b2); PG8_STAGE_B(PG8_SB(0, 1), b2 + hstepB); PG8_STAGE_A(PG8_SA(0, 0), a2, PG8_VAN(0, 0), PG8_VAN(0, 1));
            PG8_WAIT_V(8); PG8_WAIT_L(0); PG8_BAR; PG8_MMA(1, 0, At, B0); PG8_MMA(1, 1, At, B1); PG8_BAR; PG8_SCHED;
            PG8_LDB(B0, 1, 0); PG8_LDB(B1, 1, 1); PG8_SCHED; PG8_LDA(At, 1, 0); PG8_STAGE_A(PG8_SA(0, 1), a2, PG8_VAN(1, 0), PG8_VAN(1, 1));
            PG8_WAIT_V(8); PG8_WAIT_L(0); PG8_BAR; PG8_MMA(0, 0, At, B0); PG8_MMA(0, 1, At, B1); PG8_BAR; PG8_SCHED;
            PG8_LDA(At, 1, 1); PG8_STAGE_B(PG8_SB(1, 0), b3); PG8_STAGE_B(PG8_SB(1, 1), b3 + hstepB); PG8_STAGE_A(PG8_SA(1, 0), a3, PG8_VAN(0, 0), PG8_VAN(0, 1));
            PG8_WAIT_V(8); PG8_WAIT_L(0); PG8_BAR; PG8_MMA(1, 0, At, B0); PG8_MMA(1, 1, At, B1); PG8_BAR; PG8_SCHED;
        }
        if (wr == 0) PG8_BAR;
        E(acc, cur, wr, wc, fr, fq);
        if (!has_next) break;
#pragma unroll
        for (int a = 0; a < 2; ++a)
#pragma unroll
            for (int b = 0; b < 2; ++b)
#pragma unroll
                for (int m = 0; m < 4; ++m)
#pragma unroll
                    for (int n = 0; n < 2; ++n) acc[a][b][m][n] = (f32x4){0.f, 0.f, 0.f, 0.f};
        cur = nxt; cA = nA; cB = nB; ++ui;
        if constexpr (GATHER) { vA[0][0] = vAn[0][0]; vA[0][1] = vAn[0][1]; vA[1][0] = vAn[1][0]; vA[1][1] = vAn[1][1]; }
        if (wr == 1) PG8_BAR;
    }
    PG8_WAIT_V(0);
    PG8_BAR;
#undef PG8_SA
#undef PG8_SB
#undef PG8_STAGE_A
#undef PG8_STAGE_B
#undef PG8_LDA
#undef PG8_LDB
#undef PG8_MMA
#undef PG8_WAIT_V
#undef PG8_WAIT_L
#undef PG8_BAR
#undef PG8_SCHED
#undef PG8_LOADROWS
#undef PG8_VAN
}
}

struct SchedPlain {
    __device__ __forceinline__ int brow(int r) const { return r; }
    const GAS char* A; const GAS char* B; size_t a_tile, b_tile; int nM, nN, G, c;
    __device__ __forceinline__ bool next(int i, pg8::Unit& u) const {
        int pm, pn; if (!pg8::tile_of((long)i * G + c, nM, nN, pm, pn)) return false;
        u.pm = pm; u.pn = pn; u.z = 0; u.rows = nullptr; u.A = A + (size_t)pm * a_tile; u.B = B + (size_t)pn * b_tile; return true; }
};
struct SchedPc {
    __device__ __forceinline__ int brow(int r) const { return r; }
    const GAS char* Q; const GAS char* Kk; int G, c;
    __device__ __forceinline__ bool next(int i, pg8::Unit& u) const {
        const int L = i * G + c; if (L >= NB * NH * 16) return false;
        const int cp = L & 15, h = (L >> 4) & 3, b = L >> 6;
        const size_t off = ((size_t)(b * SEQ + cp * 256) * QKW + h * DK) * 2;
        u.pm = L; u.pn = 0; u.z = h; u.rows = nullptr; u.A = Q + off; u.B = Kk + off; return true; }
};
struct SchedFnA {
    __device__ __forceinline__ int brow(int r) const { return r; }
    const GAS char* Wc; const GAS char* Hn; int G, c;
    __device__ __forceinline__ bool next(int i, pg8::Unit& u) const {
        int pm, pn; if (!pg8::tile_of((long)i * G + c, 8, T / 256, pm, pn)) return false;
        const int g = pm >> 1, ri = pm & 1;
        u.pm = pm; u.pn = pn; u.z = 0; u.rows = nullptr; u.A = Wc + (size_t)ri * 256 * 256 * 2; u.B = Hn + ((size_t)pn * 256 * D + g * 256) * 2; return true; }
};
struct SchedFnB {
    __device__ __forceinline__ int brow(int r) const { return (r & 63) * 8 + (r >> 6); }
    GAS const char* WY; GAS const char* U; int G, c;
    __device__ __forceinline__ bool next(int i, pg8::Unit& u) const {
        int pm, pn; if (!pg8::tile_of((long)i * G + c, 2, 256, pm, pn)) return false;
        const int batch = pn >> 5, fb = (pn >> 1) & 15, kbb = pn & 1;
        u.pm = pm; u.pn = pn; u.z = 0; u.rows = nullptr; u.A = WY + (size_t)pm * 256 * 1024 * 2; u.B = U + ((size_t)(batch * 1024 + fb * 64) * 8 + kbb * 4) * 1024 * 2; return true; }
};
struct SchedMoe {
    __device__ __forceinline__ int brow(int r) const { return r; }
    const GAS char* A; const GAS char* W; const GAS int* rowtok; const LAS unsigned char* texp; size_t a_tile, w_exp, w_tile; int ntiles, ncol, G, c; bool gather;
    __device__ __forceinline__ bool next(int i, pg8::Unit& u) const {
        int rt, ct; if (!pg8::tile_of((long)i * G + c, ntiles, ncol, rt, ct)) return false;
        const int e = texp[rt];
        u.pm = rt; u.pn = ct; u.z = e; u.rows = rowtok + rt * 256; u.A = gather ? A : A + (size_t)rt * a_tile; u.B = W + (size_t)e * w_exp + (size_t)ct * w_tile; return true; }
};

struct EpiRopeQK {
    static constexpr bool PERM = true;
    GAS bf16* Q; GAS bf16* Kk; const GAS f32x2* rot;
    __device__ __forceinline__ void operator()(const f32x4 (&acc)[2][2][4][2], const pg8::Unit& u, int wr, int wc, int fr, int fq) const {
        const bool isk = u.pn >= 4; const int h = u.pn & 3; GAS bf16* dst = isk ? Kk : Q; const float sc = isk ? 0.0625f : 1.0f;
        const int i0 = wc * 32 + 8 * fq;
#pragma unroll
        for (int ai = 0; ai < 2; ++ai)
#pragma unroll
            for (int m = 0; m < 4; ++m) {
                const int t = u.pm * 256 + ai * 128 + wr * 64 + m * 16 + fr, s = t & (SEQ - 1);
                const GAS f32x4* rp = (const GAS f32x4*)(rot + (size_t)s * 128 + i0);
                const f32x4 r0 = rp[0], r1 = rp[1], r2 = rp[2], r3 = rp[3];
                const float cs[8] = {r0[0], r0[2], r1[0], r1[2], r2[0], r2[2], r3[0], r3[2]}, sn[8] = {r0[1], r0[3], r1[1], r1[3], r2[1], r2[3], r3[1], r3[3]};
                float o1[8], o2[8];
#pragma unroll
                for (int n = 0; n < 2; ++n)
#pragma unroll
                    for (int j = 0; j < 4; ++j) { const float t1 = acc[ai][0][m][n][j], t2 = acc[ai][1][m][n][j]; const int q = 4 * n + j;
                        o1[q] = (t1 * cs[q] - t2 * sn[q]) * sc; o2[q] = (t1 * sn[q] + t2 * cs[q]) * sc; }
                GAS bf16* rowp = dst + (size_t)t * QKW + h * DK + i0;
                u32x4 w1, w2; w1.x = cvt_pk_bf16(o1[0], o1[1]); w1.y = cvt_pk_bf16(o1[2], o1[3]); w1.z = cvt_pk_bf16(o1[4], o1[5]); w1.w = cvt_pk_bf16(o1[6], o1[7]);
                w2.x = cvt_pk_bf16(o2[0], o2[1]); w2.y = cvt_pk_bf16(o2[2], o2[3]); w2.z = cvt_pk_bf16(o2[4], o2[5]); w2.w = cvt_pk_bf16(o2[6], o2[7]);
                *(GAS u32x4*)rowp = w1; *(GAS u32x4*)(rowp + 128) = w2; }
    }
};
struct EpiRopeKT {
    static constexpr bool PERM = true;
    GAS bf16* KT; const GAS f32x2* rotT; const LAS float* l2g;
    __device__ __forceinline__ void operator()(const f32x4 (&acc)[2][2][4][2], const pg8::Unit& u, int wr, int wc, int fr, int fq) const {
        const int h = u.pm; const float l2f = l2g[h], l2b = l2g[4 + h];
#pragma unroll
        for (int bj = 0; bj < 2; ++bj) {
            const int tok0 = u.pn * 256 + bj * 128 + wc * 32 + 8 * fq, s0 = tok0 & (SEQ - 1), j0 = tok0 & (CH - 1);
            float zf[8], zb[8];
#pragma unroll
            for (int q = 0; q < 8; ++q) { zf[q] = fast_exp2((float)(CH - 1 - (j0 + q)) * l2f) * 0.0625f; zb[q] = fast_exp2((float)(j0 + q) * l2b) * 0.0625f; }
#pragma unroll
            for (int m = 0; m < 4; ++m) { const int i = wr * 64 + m * 16 + fr;
                const GAS f32x4* rp = (const GAS f32x4*)(rotT + (size_t)i * RTP + s0);
                const f32x4 r0 = rp[0], r1 = rp[1], r2 = rp[2], r3 = rp[3];
                const float cs[8] = {r0[0], r0[2], r1[0], r1[2], r2[0], r2[2], r3[0], r3[2]}, sn[8] = {r0[1], r0[3], r1[1], r1[3], r2[1], r2[3], r3[1], r3[3]};
                float o1[8], o2[8];
#pragma unroll
                for (int n = 0; n < 2; ++n)
#pragma unroll
                    for (int j = 0; j < 4; ++j) { const float t1 = acc[0][bj][m][n][j], t2 = acc[1][bj][m][n][j]; const int q = 4 * n + j;
                        o1[q] = t1 * cs[q] - t2 * sn[q]; o2[q] = t1 * sn[q] + t2 * cs[q]; }
                u32x4 w1, w2;
                w1.x = cvt_pk_bf16(o1[0] * zf[0], o1[1] * zf[1]); w1.y = cvt_pk_bf16(o1[2] * zf[2], o1[3] * zf[3]); w1.z = cvt_pk_bf16(o1[4] * zf[4], o1[5] * zf[5]); w1.w = cvt_pk_bf16(o1[6] * zf[6], o1[7] * zf[7]);
                w2.x = cvt_pk_bf16(o2[0] * zf[0], o2[1] * zf[1]); w2.y = cvt_pk_bf16(o2[2] * zf[2], o2[3] * zf[3]); w2.z = cvt_pk_bf16(o2[4] * zf[4], o2[5] * zf[5]); w2.w = cvt_pk_bf16(o2[6] * zf[6], o2[7] * zf[7]);
                const int tokr = rot_col(i, tok0);
                *(GAS u32x4*)(KT + (size_t)(h * DK + i) * T + tokr) = w1; *(GAS u32x4*)(KT + (size_t)(h * DK + 128 + i) * T + tokr) = w2;
                w1.x = cvt_pk_bf16(o1[0] * zb[0], o1[1] * zb[1]); w1.y = cvt_pk_bf16(o1[2] * zb[2], o1[3] * zb[3]); w1.z = cvt_pk_bf16(o1[4] * zb[4], o1[5] * zb[5]); w1.w = cvt_pk_bf16(o1[6] * zb[6], o1[7] * zb[7]);
                w2.x = cvt_pk_bf16(o2[0] * zb[0], o2[1] * zb[1]); w2.y = cvt_pk_bf16(o2[2] * zb[2], o2[3] * zb[3]); w2.z = cvt_pk_bf16(o2[4] * zb[4], o2[5] * zb[5]); w2.w = cvt_pk_bf16(o2[6] * zb[6], o2[7] * zb[7]);
                *(GAS u32x4*)(KT + (size_t)QKW * T + (size_t)(h * DK + i) * T + tokr) = w1; *(GAS u32x4*)(KT + (size_t)QKW * T + (size_t)(h * DK + 128 + i) * T + tokr) = w2; } }
    }
};
template <bool ROT> struct EpiBf16 {
    static constexpr bool PERM = true;
    GAS bf16* O; int ldc;
    __device__ __forceinline__ void operator()(const f32x4 (&acc)[2][2][4][2], const pg8::Unit& u, int wr, int wc, int fr, int fq) const {
#pragma unroll
        for (int ai = 0; ai < 2; ++ai)
#pragma unroll
            for (int m = 0; m < 4; ++m) { const int row = u.pm * 256 + ai * 128 + wr * 64 + m * 16 + fr; GAS bf16* rowp = O + (size_t)row * ldc;
#pragma unroll
                for (int bj = 0; bj < 2; ++bj) { const f32x4 v0 = acc[ai][bj][m][0], v1 = acc[ai][bj][m][1]; const int col = u.pn * 256 + bj * 128 + wc * 32 + 8 * fq;
                    u32x4 w; w.x = cvt_pk_bf16(v0[0], v0[1]); w.y = cvt_pk_bf16(v0[2], v0[3]); w.z = cvt_pk_bf16(v1[0], v1[1]); w.w = cvt_pk_bf16(v1[2], v1[3]);
                    *(GAS u32x4*)(rowp + (ROT ? rot_col(row, col) : col)) = w; } }
    }
};
struct EpiPc {
    static constexpr bool PERM = true;
    GAS bf16* PC; GAS bf16* PD; const LAS float* l2g;
    __device__ __forceinline__ void operator()(const f32x4 (&acc)[2][2][4][2], const pg8::Unit& u, int wr, int wc, int fr, int fq) const {
        const int h = u.z; const float l2f = l2g[h], l2b = l2g[4 + h];
#pragma unroll
        for (int ai = 0; ai < 2; ++ai)
#pragma unroll
            for (int m = 0; m < 4; ++m) { const int il = wr * 64 + m * 16 + fr, jl0 = wc * 32 + 8 * fq; float o[8];
                const bool diag = (wc == 2 * wr + (m >> 1));
#pragma unroll
                for (int n = 0; n < 2; ++n)
#pragma unroll
                    for (int j = 0; j < 4; ++j) { const int dl = il - (jl0 + 4 * n + j); const float f = dl >= 0 ? fast_exp2((float)dl * l2f) : fast_exp2((float)(-dl) * l2b);
                        o[4 * n + j] = (ai == 0 ? acc[0][0][m][n][j] : acc[1][1][m][n][j]) * f; }
                if (diag) {
                    float ob[8];
#pragma unroll
                    for (int q = 0; q < 8; ++q) { const bool lower = (jl0 + q) <= il; ob[q] = lower ? 0.f : o[q]; o[q] = lower ? o[q] : 0.f; }
                    u32x4 wb; wb.x = cvt_pk_bf16(ob[0], ob[1]); wb.y = cvt_pk_bf16(ob[2], ob[3]); wb.z = cvt_pk_bf16(ob[4], ob[5]); wb.w = cvt_pk_bf16(ob[6], ob[7]);
                    *(GAS u32x4*)(PD + (((size_t)(u.pm * 2 + ai) * 4 + (il >> 5)) * 32 + (il & 31)) * 32 + (jl0 & 31)) = wb;
                }
                u32x4 w; w.x = cvt_pk_bf16(o[0], o[1]); w.y = cvt_pk_bf16(o[2], o[3]); w.z = cvt_pk_bf16(o[4], o[5]); w.w = cvt_pk_bf16(o[6], o[7]);
                *(GAS u32x4*)(PC + ((size_t)(u.pm * 2 + ai) * 128 + il) * 128 + jl0) = w; }
    }
};
struct EpiGate {
    static constexpr bool PERM = true;
    const GAS bf16* Y; GAS bf16* YG; const GAS f32x2* statp; const GAS float* gain; LAS f32x2* sst;
    __device__ __forceinline__ void operator()(const f32x4 (&acc)[2][2][4][2], const pg8::Unit& u, int wr, int wc, int fr, int fq) const {
        const int head = u.pn >> 1, c0 = u.pn * 256 + wc * 32 + 8 * fq;
        const int tid = (wr * 4 + wc) * 64 + fq * 16 + fr;
        if (tid < 256) { const int t = u.pm * 256 + tid; const GAS f32x4* sp = (const GAS f32x4*)(statp + ((size_t)t * 4 + head) * 8); float a1 = 0.f, a2 = 0.f;
#pragma unroll
            for (int k = 0; k < 4; ++k) { const f32x4 v = sp[k]; a1 += v[0] + v[2]; a2 += v[1] + v[3]; }
            const float mu = a1 * (1.f / DV), var = fmaxf(a2 * (1.f / DV) - mu * mu, 0.f); sst[tid] = (f32x2){mu, __builtin_amdgcn_rsqf(var + EPS)}; }
        asm volatile("s_waitcnt lgkmcnt(0)" ::: "memory"); __builtin_amdgcn_s_barrier(); asm volatile("" ::: "memory");
        f32x4 gv[2][2];
#pragma unroll
        for (int bj = 0; bj < 2; ++bj) { gv[bj][0] = *(const GAS f32x4*)(gain + c0 + bj * 128); gv[bj][1] = *(const GAS f32x4*)(gain + c0 + bj * 128 + 4); }
#pragma unroll
        for (int ai = 0; ai < 2; ++ai)
#pragma unroll
            for (int m = 0; m < 4; ++m) { const int rl = ai * 128 + wr * 64 + m * 16 + fr, t = u.pm * 256 + rl; const f32x2 st = sst[rl];
#pragma unroll
                for (int bj = 0; bj < 2; ++bj) { const size_t off = (size_t)t * VW + c0 + bj * 128;
                    const int es_ = (u.pn & 1) * 4 + bj * 2 + (wc >> 1);
                    const u32x4 yv = *(const GAS u32x4*)(Y + (((size_t)(t >> 5) * NH + head) * 8 + es_) * 2048 + (((wc & 1) * 2 + (fq >> 1)) * 64 + (t & 31) + 32 * (fq & 1)) * 8);
                    const float y[8] = {bf_lo(yv.x), bf_hi(yv.x), bf_lo(yv.y), bf_hi(yv.y), bf_lo(yv.z), bf_hi(yv.z), bf_lo(yv.w), bf_hi(yv.w)}; float o[8];
#pragma unroll
                    for (int n = 0; n < 2; ++n)
#pragma unroll
                        for (int j = 0; j < 4; ++j) { const int q = 4 * n + j; const float yn = (y[q] - st.x) * st.y * gv[bj][n][j]; o[q] = silu_f(acc[ai][bj][m][n][j]) * yn; }
                    u32x4 w; w.x = cvt_pk_bf16(o[0], o[1]); w.y = cvt_pk_bf16(o[2], o[3]); w.z = cvt_pk_bf16(o[4], o[5]); w.w = cvt_pk_bf16(o[6], o[7]);
                    *(GAS u32x4*)(YG + off) = w; } }
    }
};
template <bool BASE_F32> struct EpiRes {
    static constexpr bool PERM = true;
    const GAS void* base; GAS bf16* out;
    __device__ __forceinline__ void operator()(const f32x4 (&acc)[2][2][4][2], const pg8::Unit& u, int wr, int wc, int fr, int fq) const {
#pragma unroll
        for (int ai = 0; ai < 2; ++ai)
#pragma unroll
            for (int m = 0; m < 4; ++m) { const size_t off = (size_t)(u.pm * 256 + ai * 128 + wr * 64 + m * 16 + fr) * D + u.pn * 256 + wc * 32 + 8 * fq;
#pragma unroll
                for (int bj = 0; bj < 2; ++bj) { f32x4 v0 = acc[ai][bj][m][0], v1 = acc[ai][bj][m][1];
                    if (BASE_F32) { const GAS float* bp = (const GAS float*)base + off + bj * 128; v0 += *(const GAS f32x4*)bp; v1 += *(const GAS f32x4*)(bp + 4); }
                    else { const u32x4 bv = *(const GAS u32x4*)((const GAS bf16*)base + off + bj * 128);
                        v0 += (f32x4){bf_lo(bv.x), bf_hi(bv.x), bf_lo(bv.y), bf_hi(bv.y)}; v1 += (f32x4){bf_lo(bv.z), bf_hi(bv.z), bf_lo(bv.w), bf_hi(bv.w)}; }
                    u32x4 w; w.x = cvt_pk_bf16(v0[0], v0[1]); w.y = cvt_pk_bf16(v0[2], v0[3]); w.z = cvt_pk_bf16(v1[0], v1[1]); w.w = cvt_pk_bf16(v1[2], v1[3]);
                    *(GAS u32x4*)(out + off + bj * 128) = w; } }
    }
};
struct EpiSwiGLU {
    static constexpr bool PERM = true;
    GAS bf16* ACT; int ldc;
    __device__ __forceinline__ void operator()(const f32x4 (&acc)[2][2][4][2], const pg8::Unit& u, int wr, int wc, int fr, int fq) const {
#pragma unroll
        for (int ai = 0; ai < 2; ++ai)
#pragma unroll
            for (int m = 0; m < 4; ++m) { float o[8];
#pragma unroll
                for (int n = 0; n < 2; ++n)
#pragma unroll
                    for (int j = 0; j < 4; ++j) o[4 * n + j] = silu_f(acc[ai][0][m][n][j]) * acc[ai][1][m][n][j];
                u32x4 w; w.x = cvt_pk_bf16(o[0], o[1]); w.y = cvt_pk_bf16(o[2], o[3]); w.z = cvt_pk_bf16(o[4], o[5]); w.w = cvt_pk_bf16(o[6], o[7]);
                *(GAS u32x4*)(ACT + (size_t)(u.pm * 256 + ai * 128 + wr * 64 + m * 16 + fr) * ldc + u.pn * 128 + wc * 32 + 8 * fq) = w; }
    }
};
struct EpiZ2 {
    static constexpr bool PERM = true;
    GAS bf16* Z2;
    __device__ __forceinline__ void operator()(const f32x4 (&acc)[2][2][4][2], const pg8::Unit& u, int wr, int wc, int fr, int fq) const {
        const int g = u.pm >> 1, ri = u.pm & 1;
#pragma unroll
        for (int ai = 0; ai < 2; ++ai)
#pragma unroll
            for (int m = 0; m < 4; ++m) { const int cp = ai * 128 + wr * 64 + m * 16 + fr;
#pragma unroll
                for (int bj = 0; bj < 2; ++bj) { const int tok0 = u.pn * 256 + bj * 128 + wc * 32 + 8 * fq, b = tok0 >> 12, s0 = tok0 & (SEQ - 1);
                    const f32x4 v0 = acc[ai][bj][m][0], v1 = acc[ai][bj][m][1];
                    u32x4 w; w.x = cvt_pk_bf16(v0[0], v0[1]); w.y = cvt_pk_bf16(v0[2], v0[3]); w.z = cvt_pk_bf16(v1[0], v1[1]); w.w = cvt_pk_bf16(v1[2], v1[3]);
                    *(GAS u32x4*)(Z2 + ((size_t)(b * 1024 + g * 256 + cp) * 8192 + ri * SEQ + s0)) = w; } }
    }
};
struct EpiYf {
    static constexpr bool PERM = true;
    GAS bf16* YF;
    __device__ __forceinline__ void operator()(const f32x4 (&acc)[2][2][4][2], const pg8::Unit& u, int wr, int wc, int fr, int fq) const {
        const int batch = u.pn >> 5, fb = (u.pn >> 1) & 15, kbb = u.pn & 1;
#pragma unroll
        for (int ai = 0; ai < 2; ++ai)
#pragma unroll
            for (int m = 0; m < 4; ++m) { const int ka = u.pm * 256 + ai * 128 + wr * 64 + m * 16 + fr;
#pragma unroll
                for (int bj = 0; bj < 2; ++bj) { const int kb = kbb * 4 + 2 * bj + (wc >> 1), f = fb * 64 + 32 * (wc & 1) + 8 * fq;
                    const f32x4 v0 = acc[ai][bj][m][0], v1 = acc[ai][bj][m][1];
                    u32x4 w; w.x = cvt_pk_bf16(v0[0], v0[1]); w.y = cvt_pk_bf16(v0[2], v0[3]); w.z = cvt_pk_bf16(v1[0], v1[1]); w.w = cvt_pk_bf16(v1[2], v1[3]);
                    *(GAS u32x4*)(YF + (size_t)(batch * SEQ + 8 * ka + kb) * D + f) = w; } }
    }
};
struct EpiMoeDown {
    static constexpr bool PERM = true;
    GAS bf16* Hres; const GAS int* rowtok; const GAS float* rowgate;
    __device__ __forceinline__ void operator()(const f32x4 (&acc)[2][2][4][2], const pg8::Unit& u, int wr, int wc, int fr, int fq) const {
#pragma unroll
        for (int ai = 0; ai < 2; ++ai)
#pragma unroll
            for (int m = 0; m < 4; ++m) { const int row = u.pm * 256 + ai * 128 + wr * 64 + m * 16 + fr; const int tok = rowtok[row]; const float gw = rowgate[row];
                if (tok >= 0) { GAS bf16* rp = Hres + (size_t)tok * D + u.pn * 256 + wc * 32 + 8 * fq;
#pragma unroll
                    for (int bj = 0; bj < 2; ++bj) { const u32x4 bv = *(const GAS u32x4*)(rp + bj * 128);
                        const f32x4 v0 = (f32x4){bf_lo(bv.x), bf_hi(bv.x), bf_lo(bv.y), bf_hi(bv.y)} + gw * acc[ai][bj][m][0], v1 = (f32x4){bf_lo(bv.z), bf_hi(bv.z), bf_lo(bv.w), bf_hi(bv.w)} + gw * acc[ai][bj][m][1];
                        u32x4 w; w.x = cvt_pk_bf16(v0[0], v0[1]); w.y = cvt_pk_bf16(v0[2], v0[3]); w.z = cvt_pk_bf16(v1[0], v1[1]); w.w = cvt_pk_bf16(v1[2], v1[3]);
                        *(GAS u32x4*)(rp + bj * 128) = w; } } }
    }
};

#define XB_TMO      128
#define XB_XCNT(j)  (256  + 64 * (j))
#define XB_XSUB(j)  (1280 + 64 * (j))
#define XB_XGEN(j)  (2304 + 64 * (j))
#define XB_TOP      3328
#define XB_TOPGEN   3392
#define XCD_BAR_WORDS 3456
#define XB_SPIN_CAP (1u << 18)
__device__ __forceinline__ unsigned xb_ld(unsigned* p)              { return __hip_atomic_load(p, __ATOMIC_RELAXED, __HIP_MEMORY_SCOPE_AGENT); }
__device__ __forceinline__ unsigned xb_add(unsigned* p, unsigned v) { return __hip_atomic_fetch_add(p, v, __ATOMIC_RELAXED, __HIP_MEMORY_SCOPE_AGENT); }
__device__ __forceinline__ unsigned xb_xcc_id() { return (unsigned)__builtin_amdgcn_s_getreg((3 << 11) | 20) & 0xFu; }
#define XB_SPIN(cond, bar) do { unsigned _sp = 0; while (cond) { __builtin_amdgcn_s_sleep(1); \
    if ((++_sp & 255u) == 0u) { if (xb_ld(&(bar)[XB_TMO])) break; if (_sp > XB_SPIN_CAP) { atomicAdd(&(bar)[XB_TMO], 1u); break; } } } } while (0)
struct XcdBarrier { unsigned* bar; unsigned x; volatile LAS unsigned* st; };
__device__ __forceinline__ XcdBarrier xcd_barrier_post(unsigned* bar, volatile LAS unsigned* st, const bool t0) {
    XcdBarrier b; b.bar = bar; b.x = xb_xcc_id(); b.st = st;
    if (t0) (void)xb_add(&bar[XB_XCNT(b.x)], 1u);
    return b;
}
__device__ __forceinline__ void xcd_barrier_complete(unsigned* bar, unsigned x, unsigned& nloc, unsigned& nx) {
    const unsigned G = gridDim.x * gridDim.y * gridDim.z;
    unsigned sum, cnt, mine, sp = 0u;
    for (;;) {
        sum = 0u; cnt = 0u; mine = 0u;
#pragma unroll
        for (unsigned j = 0; j < 16; ++j) { const unsigned c = xb_ld(&bar[XB_XCNT(j)]); sum += c; cnt += (c > 0u) ? 1u : 0u; mine = (j == x) ? c : mine; }
        if (sum == G) break;
        __builtin_amdgcn_s_sleep(1);
        if ((++sp & 255u) == 0u) { if (xb_ld(&bar[XB_TMO])) break; if (sp > XB_SPIN_CAP) { atomicAdd(&bar[XB_TMO], 1u); break; } }
    }
    nloc = mine > 0u ? mine : 1u; nx = cnt > 0u ? cnt : 1u;
}
__device__ __forceinline__ void xcd_barrier(const XcdBarrier& b, const bool t0) {
    asm volatile("s_waitcnt vmcnt(0)" ::: "memory");
    __syncthreads();
    if (t0) {
        unsigned* bar = b.bar;
        __builtin_amdgcn_s_waitcnt(0);
        unsigned nloc = b.st[0], nx = b.st[1];
        if (nloc == 0u) { xcd_barrier_complete(bar, b.x, nloc, nx); b.st[0] = nloc; b.st[1] = nx; }
        const unsigned old = xb_add(&bar[XB_XSUB(b.x)], 1u);
        const unsigned gen = old / nloc;
        if (old + 1u == (gen + 1u) * nloc) {
            __builtin_amdgcn_fence(__ATOMIC_RELEASE, "agent");
            asm volatile("s_waitcnt vmcnt(0)" ::: "memory");
            const unsigned og = xb_add(&bar[XB_TOP], 1u);
            const unsigned tg = og / nx;
            if (og + 1u == (tg + 1u) * nx) xb_add(&bar[XB_TOPGEN], 1u);
            else XB_SPIN(xb_ld(&bar[XB_TOPGEN]) == tg, bar);
            __builtin_amdgcn_fence(__ATOMIC_ACQUIRE, "agent");
            xb_add(&bar[XB_XGEN(b.x)], 1u);
            asm volatile("s_waitcnt vmcnt(0)" ::: "memory");
        } else {
            XB_SPIN(xb_ld(&bar[XB_XGEN(b.x)]) == gen, bar);
            __builtin_amdgcn_fence(__ATOMIC_ACQUIRE, "agent");
            asm volatile("s_waitcnt vmcnt(0)" ::: "memory");
        }
    }
    __syncthreads();
}

__device__ __forceinline__ float wave_sum(float v) {
#pragma unroll
    for (int o = 1; o < 64; o <<= 1) v += __shfl_xor(v, o);
    return v;
}
__device__ __forceinline__ void transpose_item(const GAS float* W, int K, int N, GAS bf16* WT, int k0, int n0, int rbase, LAS float* scr, int lane) {
#pragma unroll 8
    for (int i = 0; i < 32; ++i) { const int kk = 2 * i + (lane >> 5); scr[kk * 33 + (lane & 31)] = W[(size_t)(k0 + kk) * N + n0 + (lane & 31)]; }
    LDS_WAIT(); asm volatile("" ::: "memory");
    const int c = lane & 7;
#pragma unroll
    for (int j = 0; j < 4; ++j) { const int n = (lane >> 3) + 8 * j; const LAS float* s = scr + (8 * c) * 33 + n;
        u32x4 o; o.x = cvt_pk_bf16(s[0 * 33], s[1 * 33]); o.y = cvt_pk_bf16(s[2 * 33], s[3 * 33]); o.z = cvt_pk_bf16(s[4 * 33], s[5 * 33]); o.w = cvt_pk_bf16(s[6 * 33], s[7 * 33]);
        *(GAS u32x4*)(WT + (size_t)(rbase + n) * K + k0 + 8 * c) = o; }
    LDS_WAIT(); asm volatile("" ::: "memory");
}
__device__ __forceinline__ void tr_plain(const GAS float* W, int K, int N, GAS bf16* WT, int it, LAS float* scr, int lane) {
    const int nblk = N / 32, kb = it / nblk, nb = it - kb * nblk; transpose_item(W, K, N, WT, 64 * kb, 32 * nb, 32 * nb, scr, lane);
}
__device__ __forceinline__ void tr_gu(const GAS float* Wg, const GAS float* Wu, int K, int N, GAS bf16* WT, int it, LAS float* scr, int lane) {
    const int nblk = N / 32, per = (K / 64) * nblk; const bool up = it >= per; if (up) it -= per;
    const int kb = it / nblk, nb = it - kb * nblk, f0 = 32 * nb;
    transpose_item(up ? Wu : Wg, K, N, WT, 64 * kb, f0, 256 * (f0 >> 7) + (up ? 128 : 0) + (f0 & 127), scr, lane);
}
__device__ __forceinline__ void rms_row(const GAS float* xrow, const GAS float* g, GAS bf16* orow, int lane, f32x4 (&v)[4]) {
    const GAS f32x4* xr = (const GAS f32x4*)xrow + lane; const GAS f32x4* gr = (const GAS f32x4*)g + lane;
    float s = 0.f;
#pragma unroll
    for (int j = 0; j < 4; ++j) { v[j] = xr[64 * j]; s += (v[j].x * v[j].x + v[j].y * v[j].y) + (v[j].z * v[j].z + v[j].w * v[j].w); }
    const float r = 1.0f / sqrtf(wave_sum(s) * (1.f / D) + EPS);
    GAS u32x2* o8 = (GAS u32x2*)orow + lane;
#pragma unroll
    for (int j = 0; j < 4; ++j) { v[j] = v[j] * r * gr[64 * j]; u32x2 w; w.x = cvt_pk_bf16(v[j].x, v[j].y); w.y = cvt_pk_bf16(v[j].z, v[j].w); o8[64 * j] = w; }
}
__device__ __forceinline__ int rmsb_col(int j, int lane) { return 512 * (j >> 1) + 8 * lane + 4 * (j & 1); }
__device__ __forceinline__ void rms_row_b(const GAS bf16* hrow, const GAS float* g, GAS bf16* orow, int lane, f32x4 (&v)[4]) {
    float s = 0.f;
#pragma unroll
    for (int jh = 0; jh < 2; ++jh) { const u32x4 x = *(const GAS u32x4*)(hrow + 512 * jh + 8 * lane);
        v[2 * jh] = (f32x4){bf_lo(x.x), bf_hi(x.x), bf_lo(x.y), bf_hi(x.y)}; v[2 * jh + 1] = (f32x4){bf_lo(x.z), bf_hi(x.z), bf_lo(x.w), bf_hi(x.w)}; }
#pragma unroll
    for (int j = 0; j < 4; ++j) s += (v[j].x * v[j].x + v[j].y * v[j].y) + (v[j].z * v[j].z + v[j].w * v[j].w);
    const float r = 1.0f / sqrtf(wave_sum(s) * (1.f / D) + EPS);
#pragma unroll
    for (int jh = 0; jh < 2; ++jh) { const GAS float* gp = g + 512 * jh + 8 * lane; v[2 * jh] = v[2 * jh] * r * *(const GAS f32x4*)gp; v[2 * jh + 1] = v[2 * jh + 1] * r * *(const GAS f32x4*)(gp + 4);
        u32x4 w; w.x = cvt_pk_bf16(v[2 * jh].x, v[2 * jh].y); w.y = cvt_pk_bf16(v[2 * jh].z, v[2 * jh].w); w.z = cvt_pk_bf16(v[2 * jh + 1].x, v[2 * jh + 1].y); w.w = cvt_pk_bf16(v[2 * jh + 1].z, v[2 * jh + 1].w);
        *(GAS u32x4*)(orow + 512 * jh + 8 * lane) = w; }
}

constexpr int SW_QL = 0, SW_SPITCH = 528, SW_SL = 128 * 528, SW_VPITCH = 272, SW_VL = SW_SL + 64 * SW_SPITCH, SW_VB = 64 * SW_VPITCH;
static_assert(SW_VL + 2 * SW_VB <= 139264, "sweep LDS");
template <bool OUT> __device__ __forceinline__ void sweep_role(LAS unsigned char* lds, const GAS bf16* Qg, const GAS bf16* KTFg, const GAS bf16* KTBg, const GAS bf16* VTg, const GAS bf16* PCg, const GAS bf16* PDg, const GAS bf16* ZEROg, GAS bf16* Yg, GAS f32x2* statp, const float l2f, const float l2b, int b, int h, int es, const int wave_s) {
    const int tid = tid_of(wave_s);
    const int w = __builtin_amdgcn_readfirstlane(tid >> 6), lane = tid & 63, r32 = lane & 31, hh = lane >> 5;
    const int rb = w & 3;
    const int vrow = tid >> 4, vpc = tid & 15;
    const int qrow = tid >> 5, qpc = tid & 31;
    const GAS bf16* qp = Qg + (size_t)(b * SEQ + qrow) * QKW + h * DK + 8 * qpc;
    const GAS bf16* vtp = VTg + (size_t)(h * DV + 64 * es + vrow) * T + 8 * vpc; const int vrot = b * SEQ + ((vrow & 15) << 11);
    const int il = 32 * rb + r32;
    const GAS bf16* pcp = PCg + ((size_t)((b * NH + h) * NCH) * 128 + il) * 128 + 8 * hh;
    const GAS bf16* pdp = PDg + (((size_t)((b * NH + h) * NCH) * 4 + rb) * 32 + r32) * 32 + 8 * hh;
    GAS bf16* yp = Yg + ((size_t)(((b * SEQ) >> 5) + rb) * NH + h) * 8 * 2048 + (size_t)es * 2048 + lane * 8;
    GAS f32x2* stp = statp + ((size_t)(b * SEQ + il) * NH + h) * 8 + es;
    const size_t kto = (size_t)(h * DK + 64 * rb + r32) * T + 8 * hh; const int krot = b * SEQ + ((r32 & 15) << 11);
#define SW_LDP(dst, s_, d_, nn_) do { const int jb_ = (s_) >> 1; const bool use_ = (d_) ? (jb_ >= rb) : (jb_ <= rb); const bool dg_ = (d_) && (jb_ == rb); \
        const GAS bf16* src_ = dg_ ? (pdp + (size_t)(nn_) * 4096 + 16 * ((s_) & 1)) : (pcp + (size_t)(nn_) * (CH * CH) + 16 * (s_)); \
        dst = *(const GAS bf16x8*)(use_ ? src_ : ZEROg); } while (0)
#define SW_SCHED __builtin_amdgcn_sched_barrier(0)
#define SW_MFMA(a, b, c) c = __builtin_amdgcn_mfma_f32_32x32x16_bf16(a, b, c, 0, 0, 0)
    bf16x8 pa[8];
    bf16x8 ka[2][8];
    u32x4 vv[2], qv[4];
    f32x16 Sacc[2][2];
    if constexpr (OUT) {
#pragma unroll
        for (int s = 0; s < 8; ++s) SW_LDP(pa[s], s, 0, 0);
    } else {
#pragma unroll
        for (int db = 0; db < 2; ++db)
#pragma unroll
            for (int s = 0; s < 8; ++s) ka[db][s] = *(const GAS bf16x8*)(KTFg + kto + (size_t)(32 * db) * T + (krot & (T - 1)) + 16 * s);
#pragma unroll
        for (int db = 0; db < 2; ++db)
#pragma unroll
            for (int et = 0; et < 2; ++et)
#pragma unroll
                for (int t = 0; t < 16; ++t) Sacc[db][et][t] = 0.f;
    }
#pragma unroll
    for (int it = 0; it < 2; ++it) vv[it] = *(const GAS u32x4*)(vtp + (size_t)(32 * it) * T + (vrot & (T - 1)));
#pragma unroll
    for (int it = 0; it < 2; ++it) *(LAS u32x4*)(lds + SW_VL + (vrow + 32 * it) * SW_VPITCH + vpc * 16) = vv[it];
#pragma unroll
    for (int hf = 0; hf < 2; ++hf) {
#pragma unroll
        for (int it = 0; it < 4; ++it) qv[it] = *(const GAS u32x4*)(qp + (size_t)(16 * (4 * hf + it)) * QKW);
#pragma unroll
        for (int it = 0; it < 4; ++it) { const int row = qrow + 16 * (4 * hf + it); *(LAS u32x4*)(lds + SW_QL + row * SW_SPITCH + qpc * 16) = qv[it]; }
    }
    const int sl_rd = SW_SL + r32 * SW_SPITCH + 16 * hh;
    const int q_rd = SW_QL + il * SW_SPITCH + 16 * hh;
#pragma unroll 1
    for (int p = 0; p < 2 * NCH; ++p) {
        const int dir = p >> 5, st = p & 31, n = dir ? NCH - 1 - st : st;
        const int pn = p + 1 < 2 * NCH ? p + 1 : p, dirn = pn >> 5, stn = pn & 31, nn = dirn ? NCH - 1 - stn : stn;
        const int cur = p & 1;
        const float l2 = dir ? l2b : l2f;
        const int v_rd = SW_VL + cur * SW_VB + r32 * SW_VPITCH + 16 * hh;
        if constexpr (!OUT) {
#pragma unroll
            for (int db = 0; db < 2; ++db)
#pragma unroll
                for (int et = 0; et < 2; ++et)
#pragma unroll
                    for (int g = 0; g < 4; ++g) { u32x2 pk; pk.x = cvt_pk_bf16(Sacc[db][et][4 * g], Sacc[db][et][4 * g + 1]); pk.y = cvt_pk_bf16(Sacc[db][et][4 * g + 2], Sacc[db][et][4 * g + 3]);
                        if (st == 0) { pk.x = 0u; pk.y = 0u; }
                        *(LAS u32x2*)(lds + SW_SL + (32 * et + r32) * SW_SPITCH + (64 * rb + 32 * db + 8 * g + 4 * hh) * 2) = pk; }
        }
#pragma unroll
        for (int it = 0; it < 2; ++it) vv[it] = *(const GAS u32x4*)(vtp + (size_t)(32 * it) * T + ((nn * CH + vrot) & (T - 1)));
#pragma unroll
        for (int it = 0; it < 4; ++it) qv[it] = *(const GAS u32x4*)(qp + (size_t)(nn * CH + 16 * it) * QKW);
        __syncthreads();
        f32x16 O[2];
        u32x4 yf[4];
        GAS bf16* ypn = yp + (size_t)(n * 4) * (NH * 8 * 2048);
        if constexpr (OUT) {
#pragma unroll
            for (int et = 0; et < 2; ++et)
#pragma unroll
                for (int t = 0; t < 16; ++t) O[et][t] = 0.f;
            bf16x8 qx[2], s0x[2], s1x[2], qy[2], s0y[2], s1y[2];
#define SW_LDC(dq, d0, d1, g2) do { _Pragma("unroll") for (int k = 0; k < 2; ++k) { const int ks = 2 * (g2) + k; dq[k] = *(const LAS bf16x8*)(lds + q_rd + 32 * ks); \
                d0[k] = *(const LAS bf16x8*)(lds + sl_rd + 32 * ks); d1[k] = *(const LAS bf16x8*)(lds + sl_rd + 32 * SW_SPITCH + 32 * ks); } } while (0)
#define SW_MMC(dq, d0, d1) do { SW_MFMA(d0[0], dq[0], O[0]); SW_MFMA(d1[0], dq[0], O[1]); SW_MFMA(d0[1], dq[1], O[0]); SW_MFMA(d1[1], dq[1], O[1]); } while (0)
            SW_LDC(qx, s0x, s1x, 0); SW_LDC(qy, s0y, s1y, 1); SW_SCHED;
            SW_MMC(qx, s0x, s1x); SW_SCHED; SW_LDC(qx, s0x, s1x, 2); SW_SCHED;
            SW_MMC(qy, s0y, s1y); SW_SCHED; SW_LDC(qy, s0y, s1y, 3); SW_SCHED;
            SW_MMC(qx, s0x, s1x); SW_SCHED; SW_LDC(qx, s0x, s1x, 4); SW_SCHED;
            SW_MMC(qy, s0y, s1y); SW_SCHED; SW_LDC(qy, s0y, s1y, 5); SW_SCHED;
            SW_MMC(qx, s0x, s1x); SW_SCHED; SW_LDC(qx, s0x, s1x, 6); SW_SCHED;
            SW_MMC(qy, s0y, s1y); SW_SCHED; SW_LDC(qy, s0y, s1y, 7); SW_SCHED;
            SW_MMC(qx, s0x, s1x); SW_SCHED;
            SW_MMC(qy, s0y, s1y); SW_SCHED;
#undef SW_LDC
#undef SW_MMC
        } else {
            const float gC = st == 0 ? 0.f : fast_exp2((float)CH * l2);
#pragma unroll
            for (int db = 0; db < 2; ++db)
#pragma unroll
                for (int et = 0; et < 2; ++et)
#pragma unroll
                    for (int t = 0; t < 16; ++t) Sacc[db][et][t] *= gC;
            bf16x8 v0x[2], v1x[2], v0y[2], v1y[2];
#define SW_LDU(d0, d1, g2) do { _Pragma("unroll") for (int k = 0; k < 2; ++k) { const int s_ = 2 * (g2) + k; d0[k] = *(const LAS bf16x8*)(lds + v_rd + 32 * s_); d1[k] = *(const LAS bf16x8*)(lds + v_rd + 32 * SW_VPITCH + 32 * s_); } } while (0)
#define SW_MMU(d0, d1, g2) do { _Pragma("unroll") for (int k = 0; k < 2; ++k) { const int s_ = 2 * (g2) + k; SW_MFMA(ka[0][s_], d0[k], Sacc[0][0]); SW_MFMA(ka[0][s_], d1[k], Sacc[0][1]); SW_MFMA(ka[1][s_], d0[k], Sacc[1][0]); SW_MFMA(ka[1][s_], d1[k], Sacc[1][1]); } } while (0)
            SW_LDU(v0x, v1x, 0); SW_LDU(v0y, v1y, 1); SW_SCHED;
            SW_MMU(v0x, v1x, 0); SW_SCHED; SW_LDU(v0x, v1x, 2); SW_SCHED;
            SW_MMU(v0y, v1y, 1); SW_SCHED; SW_LDU(v0y, v1y, 3); SW_SCHED;
            SW_MMU(v0x, v1x, 2); SW_SCHED;
            SW_MMU(v0y, v1y, 3); SW_SCHED;
#undef SW_LDU
#undef SW_MMU
        }
        __syncthreads();
#pragma unroll
        for (int it = 0; it < 4; ++it) { const int row = qrow + 16 * it; *(LAS u32x4*)(lds + SW_QL + row * SW_SPITCH + qpc * 16) = qv[it]; }
#pragma unroll
        for (int it = 0; it < 4; ++it) qv[it] = *(const GAS u32x4*)(qp + (size_t)(nn * CH + 16 * (4 + it)) * QKW);
        if constexpr (OUT) {
            if (dir) {
#pragma unroll
                for (int q = 0; q < 4; ++q) yf[q] = *(const GAS u32x4*)(ypn + q * 512);
            }
            const float xi = fast_exp2((float)(dir == 0 ? (il + 1) : (CH - il)) * l2);
#pragma unroll
            for (int et = 0; et < 2; ++et)
#pragma unroll
                for (int t = 0; t < 16; ++t) O[et][t] *= xi;
            bf16x8 v0x[2], v1x[2], v0y[2], v1y[2];
#define SW_LDV(d0, d1, g2) do { _Pragma("unroll") for (int k = 0; k < 2; ++k) { const int s_ = 2 * (g2) + k; d0[k] = *(const LAS bf16x8*)(lds + v_rd + 32 * s_); d1[k] = *(const LAS bf16x8*)(lds + v_rd + 32 * SW_VPITCH + 32 * s_); } } while (0)
#define SW_MMV(d0, d1, g2) do { _Pragma("unroll") for (int k = 0; k < 2; ++k) { const int s_ = 2 * (g2) + k; SW_MFMA(d0[k], pa[s_], O[0]); SW_MFMA(d1[k], pa[s_], O[1]); } } while (0)
            SW_LDV(v0x, v1x, 0); SW_LDV(v0y, v1y, 1); SW_SCHED;
            SW_MMV(v0x, v1x, 0); SW_SCHED; SW_LDV(v0x, v1x, 2); SW_SCHED;
            SW_MMV(v0y, v1y, 1); SW_SCHED; SW_LDV(v0y, v1y, 3); SW_SCHED;
            SW_MMV(v0x, v1x, 2); SW_SCHED;
            SW_MMV(v0y, v1y, 3); SW_SCHED;
#undef SW_LDV
#undef SW_MMV
#pragma unroll
            for (int s = 0; s < 8; ++s) SW_LDP(pa[s], s, dirn, nn);
        } else {
            const GAS bf16* ktn = (dirn ? KTBg : KTFg) + kto + ((nn * CH + krot) & (T - 1));
#pragma unroll
            for (int db = 0; db < 2; ++db)
#pragma unroll
                for (int s = 0; s < 8; ++s) ka[db][s] = *(const GAS bf16x8*)(ktn + (size_t)(32 * db) * T + 16 * s);
        }
#pragma unroll
        for (int it = 0; it < 2; ++it) *(LAS u32x4*)(lds + SW_VL + (cur ^ 1) * SW_VB + (vrow + 32 * it) * SW_VPITCH + vpc * 16) = vv[it];
#pragma unroll
        for (int it = 0; it < 4; ++it) { const int row = qrow + 16 * (4 + it); *(LAS u32x4*)(lds + SW_QL + row * SW_SPITCH + qpc * 16) = qv[it]; }
        if constexpr (OUT) {
            float s1 = 0.f, s2 = 0.f;
#pragma unroll
            for (int et = 0; et < 2; ++et)
#pragma unroll
                for (int kp = 0; kp < 2; ++kp) {
                    float ya[4], yb[4];
#pragma unroll
                    for (int q = 0; q < 4; ++q) { ya[q] = O[et][8 * kp + q]; yb[q] = O[et][8 * kp + 4 + q]; }
                    if (dir) {
                        u32x4 f = yf[et * 2 + kp];
                        { const auto r0 = __builtin_amdgcn_permlane32_swap(f.x, f.z, false, false); f.x = r0[0]; f.z = r0[1]; const auto r1 = __builtin_amdgcn_permlane32_swap(f.y, f.w, false, false); f.y = r1[0]; f.w = r1[1]; }
                        ya[0] += bf_lo(f.x); ya[1] += bf_hi(f.x); ya[2] += bf_lo(f.y); ya[3] += bf_hi(f.y); yb[0] += bf_lo(f.z); yb[1] += bf_hi(f.z); yb[2] += bf_lo(f.w); yb[3] += bf_hi(f.w);
#pragma unroll
                        for (int q = 0; q < 4; ++q) { s1 += ya[q] + yb[q]; s2 += ya[q] * ya[q] + yb[q] * yb[q]; }
                    }
                    u32x4 o; o.x = cvt_pk_bf16(ya[0], ya[1]); o.y = cvt_pk_bf16(ya[2], ya[3]); o.z = cvt_pk_bf16(yb[0], yb[1]); o.w = cvt_pk_bf16(yb[2], yb[3]);
                    { const auto r0 = __builtin_amdgcn_permlane32_swap(o.x, o.z, false, false); o.x = r0[0]; o.z = r0[1]; const auto r1 = __builtin_amdgcn_permlane32_swap(o.y, o.w, false, false); o.y = r1[0]; o.w = r1[1]; }
                    *(GAS u32x4*)(ypn + (et * 2 + kp) * 512) = o;
                }
            if (dir) { s1 += __shfl_xor(s1, 32); s2 += __shfl_xor(s2, 32);
                if (hh == 0) stp[(size_t)(n * CH) * (NH * 8)] = (f32x2){s1, s2}; }
        }
    }
#undef SW_LDP
#undef SW_SCHED
#undef SW_MFMA
    VM_WAIT();
    __syncthreads();
}

__device__ __forceinline__ void sweep_unit(LAS unsigned char* lds, const GAS bf16* Qg, const GAS bf16* KTFg, const GAS bf16* KTBg, const GAS bf16* VTg, const GAS bf16* PCg, const GAS bf16* PDg, const GAS bf16* ZEROg, GAS bf16* Yg, GAS f32x2* statp, const float l2f, const float l2b, int b, int h, int es, const int wave_s) {
    int ws_ = wave_s; asm volatile("" : "+s"(ws_));
    if (ws_ < 4) sweep_role<true>(lds, Qg, KTFg, KTBg, VTg, PCg, PDg, ZEROg, Yg, statp, l2f, l2b, b, h, es, wave_s);
    else sweep_role<false>(lds, Qg, KTFg, KTBg, VTg, PCg, PDg, ZEROg, Yg, statp, l2f, l2b, b, h, es, wave_s);
}

struct Args { const float* in[16]; float* out; unsigned char* ws; };
constexpr int NWAVES = 8;
#ifndef PHMASK
#define PHMASK 0xFFFFFFFFu
#endif
#define PH(k) (((PHMASK) >> (k)) & 1u)
__global__ void __launch_bounds__(NWAVES * 64, 2) fwd_kernel(Args args) {
    extern __shared__ __attribute__((aligned(16))) unsigned char lds_raw[];
    LAS unsigned char* lds = (LAS unsigned char*)lds_raw;
    LAS float* l2g = (LAS float*)(lds + LDSCTL_OFF + 64);
    const int wave_k = __builtin_amdgcn_readfirstlane((int)threadIdx.x >> 6);
#define PHASE_VARS \
    const int tid = tid_of(wave_k); const int lane = tid & 63; int wave = wave_k; asm volatile("" : "+s"(wave)); \
    const __attribute__((address_space(4))) Args* ka = (const __attribute__((address_space(4))) Args*)__builtin_amdgcn_kernarg_segment_ptr(); asm volatile("" : "+s"(ka)); \
    const int G = gridDim.x, bx = blockIdx.x; const int vcu = (G % 8 == 0) ? (bx % 8) * (G / 8) + bx / 8 : bx; const int gw = vcu * NWAVES + wave, NGW = G * NWAVES; \
    GAS unsigned char* ws = (GAS unsigned char*)ka->ws; asm volatile("" : "+s"(ws)); GAS float* hres = (GAS float*)ka->out; (void)lane; (void)gw; (void)NGW; (void)vcu; (void)hres; \
    const GAS float* x = (const GAS float*)ka->in[0]; const GAS float* mix_norm = (const GAS float*)ka->in[1]; const GAS float* ffn_norm = (const GAS float*)ka->in[2]; const GAS float* ret_w_in = (const GAS float*)ka->in[3]; const GAS float* ret_decay = (const GAS float*)ka->in[4]; \
    const GAS float* gn_gain = (const GAS float*)ka->in[5]; const GAS float* ret_w_out = (const GAS float*)ka->in[6]; const GAS float* d_wg = (const GAS float*)ka->in[7]; const GAS float* d_wu = (const GAS float*)ka->in[8]; const GAS float* d_wd = (const GAS float*)ka->in[9]; \
    const GAS float* fnet_w = (const GAS float*)ka->in[10]; const GAS float* moe_router = (const GAS float*)ka->in[11]; const GAS float* m_wg = (const GAS float*)ka->in[12]; const GAS float* m_wu = (const GAS float*)ka->in[13]; const GAS float* m_wd = (const GAS float*)ka->in[14]; const GAS float* final_norm = (const GAS float*)ka->in[15]; \
    (void)x; (void)mix_norm; (void)ffn_norm; (void)ret_w_in; (void)ret_decay; (void)gn_gain; (void)ret_w_out; (void)d_wg; (void)d_wu; (void)d_wd; (void)fnet_w; (void)moe_router; (void)m_wg; (void)m_wu; (void)m_wd; (void)final_norm; \
    GAS f32x2* rot = (GAS f32x2*)(ws + WS_ROT); GAS f32x2* rotT = (GAS f32x2*)(ws + WS_ROTT); GAS bf16* WC = (GAS bf16*)(ws + WS_WC); \
    GAS int* toke = (GAS int*)(ws + WS_TOKE); GAS float* tokw = (GAS float*)(ws + WS_TOKW); GAS int* bcnt = (GAS int*)(ws + WS_BCNT); GAS int* pcnt = (GAS int*)(ws + WS_PCNT); (void)pcnt; GAS int* rowtok = (GAS int*)(ws + WS_ROWTOK); GAS float* rowgate = (GAS float*)(ws + WS_ROWGATE); \
    GAS f32x2* statp = (GAS f32x2*)(ws + WS_STATP); \
    GAS bf16* WIN = (GAS bf16*)(ws + WS_WIN); GAS bf16* WO = (GAS bf16*)(ws + WS_WO); GAS bf16* WGU = (GAS bf16*)(ws + WS_WGU); GAS bf16* WD = (GAS bf16*)(ws + WS_WD); GAS bf16* WF = (GAS bf16*)(ws + WS_WF); \
    GAS bf16* HN = (GAS bf16*)(ws + WS_HN); GAS bf16* Qb = (GAS bf16*)(ws + WS_Q); GAS bf16* Kb = (GAS bf16*)(ws + WS_K); GAS bf16* KT = (GAS bf16*)(ws + WS_KT); GAS bf16* VT = (GAS bf16*)(ws + WS_VT); GAS bf16* PC = (GAS bf16*)(ws + WS_PC); \
    GAS bf16* HB = (GAS bf16*)(ws + WS_HN); GAS bf16* HNB = (GAS bf16*)ka->out; (void)HB; (void)HNB; \
    GAS bf16* Yb = (GAS bf16*)ka->out; GAS bf16* YG = (GAS bf16*)(ws + WS_YG); GAS bf16* ACTD = (GAS bf16*)(ws + WS_ACTD); GAS bf16* Z2 = (GAS bf16*)(ws + WS_Z2); GAS bf16* WSEQ = (GAS bf16*)(ws + WS_WSEQ); \
    GAS bf16* ACTM = (GAS bf16*)(ws + WS_ACTM); GAS bf16* WMGU = (GAS bf16*)(ws + WS_WMGU); GAS bf16* WMD = (GAS bf16*)(ws + WS_WMD); \
    (void)rot; (void)rotT; (void)WC; (void)toke; (void)tokw; (void)bcnt; (void)rowtok; (void)rowgate; (void)statp; (void)WIN; (void)WO; (void)WGU; (void)WD; (void)WF; (void)HN; (void)Qb; (void)Kb; (void)KT; (void)VT; (void)PC; \
    (void)Yb; (void)YG; (void)ACTD; (void)Z2; (void)WSEQ; (void)ACTM; (void)WMGU; (void)WMD;
#define GRID_BAR() do { const __attribute__((address_space(4))) Args* kb = (const __attribute__((address_space(4))) Args*)__builtin_amdgcn_kernarg_segment_ptr(); asm volatile("" : "+s"(kb)); GAS unsigned char* wsb = (GAS unsigned char*)kb->ws; XcdBarrier bar_; bar_.bar = (unsigned*)(wsb + WS_CTL) + CW_BAR; bar_.x = xb_xcc_id(); \
    bar_.st = (volatile LAS unsigned*)(lds + MISC_OFF) + 8; xcd_barrier(bar_, tid_of(wave_k) == 0); } while (0)

    {
        PHASE_VARS
        for (int u = tid; u < (LDS_BYTES - LDSCTL_OFF) / 4; u += NWAVES * 64) ((LAS unsigned*)(lds + LDSCTL_OFF))[u] = 0u;
        __syncthreads();
        if (tid < 8) { const float xl = ret_decay[tid]; const float ls = fminf(xl, 0.f) - log1pf(expf(-fabsf(xl))); l2g[tid] = ls * 1.44269504088896341f; }
        __syncthreads();
        (void)xcd_barrier_post((unsigned*)(ws + WS_CTL) + CW_BAR, (volatile LAS unsigned*)(lds + MISC_OFF) + 8, tid == 0);
    }

    if (PH(0)) {
        PHASE_VARS
        LAS float* scr = (LAS float*)(lds + wave * 16384);
        constexpr int I_IN = (D / 64) * (INW / 32), I_O = (VW / 64) * (D / 32), I_GU = 2 * (D / 64) * (FFD / 32), I_D = (FFD / 64) * (D / 32), I_F = (D / 64) * (D / 32);
        constexpr int NITEMS = I_IN + I_O + I_GU + I_D + I_F;
        for (int it = gw; it < NITEMS; it += NGW) {
            int r = it;
            if (r < I_IN) { tr_plain(ret_w_in, D, INW, WIN, r, scr, lane); continue; } r -= I_IN;
            if (r < I_O) { tr_plain(ret_w_out, VW, D, WO, r, scr, lane); continue; } r -= I_O;
            if (r < I_GU) { tr_gu(d_wg, d_wu, D, FFD, WGU, r, scr, lane); continue; } r -= I_GU;
            if (r < I_D) { tr_plain(d_wd, FFD, D, WD, r, scr, lane); continue; } r -= I_D;
            tr_plain(fnet_w, D, D, WF, r, scr, lane);
        }
        for (int e = (vcu * 512 + tid); e < SEQ * 128; e += G * 512) { const int s = e >> 7, i = e & 127;
            const float inv = powf(10000.0f, -(float)i / 128.0f); const float ang = (float)s * inv; float sn, cs; sincosf(ang, &sn, &cs);
            rot[e] = (f32x2){cs, sn}; rotT[(size_t)i * RTP + s] = (f32x2){cs, sn}; }
        for (int e = (vcu * 512 + tid); e < 512 * 256; e += G * 512) { const int r = e >> 8, c = e & 255, mm = ((r & 255) * c) & 255;
            const float v = r < 256 ? cospif((float)mm * (1.0f / 128.0f)) : -sinpif((float)mm * (1.0f / 128.0f)); WC[e] = (bf16)(cvt_pk_bf16(v, 0.f) & 0xffffu); }
        for (int m = gw; m < T; m += NGW) { f32x4 v[4]; rms_row(x + (size_t)m * D, mix_norm, HN + (size_t)m * D, lane, v); }
    }
    GRID_BAR();

    if (PH(1) && PH(19)) {
        PHASE_VARS
        SchedPlain S{(const GAS char*)HN, (const GAS char*)WIN, (size_t)256 * D * 2, (size_t)256 * D * 2, T / 256, 8, G, bx};
        EpiRopeQK E{Qb, Kb, rot};
        pg8::gemm_phase<EpiRopeQK, SchedPlain, false>(lds, wave_k, D, D, D, S, E);
    }
    if (PH(1) && PH(20)) {
        PHASE_VARS
        SchedPlain S{(const GAS char*)(WIN + (size_t)QKW * D), (const GAS char*)HN, (size_t)256 * D * 2, (size_t)256 * D * 2, 4, T / 256, G, bx};
        EpiRopeKT E{KT, rotT, l2g};
        pg8::gemm_phase<EpiRopeKT, SchedPlain, false>(lds, wave_k, D, D, D, S, E);
    }
    if (PH(1) && PH(21)) {
        PHASE_VARS
        SchedPlain S{(const GAS char*)(WIN + (size_t)2 * QKW * D), (const GAS char*)HN, (size_t)256 * D * 2, (size_t)256 * D * 2, 8, T / 256, G, bx};
        EpiBf16<true> E{VT, T};
        pg8::gemm_phase<EpiBf16<true>, SchedPlain, false>(lds, wave_k, D, D, D, S, E);
    }
    GRID_BAR();

    if (PH(2)) {
        PHASE_VARS
        SchedPc S{(const GAS char*)Qb, (const GAS char*)Kb, G, bx};
        EpiPc E{PC, (GAS bf16*)(ws + WS_ROT), l2g};
        pg8::gemm_phase<EpiPc, SchedPc, false>(lds, wave_k, QKW, QKW, DK, S, E);
    }
    GRID_BAR();

    if (PH(3)) {
        PHASE_VARS
        for (int u = vcu; u < NB * NH * 8; u += G) { const int hh_ = (u >> 3) & 3; const float l2f = l2g[hh_], l2b = l2g[4 + hh_];
            sweep_unit(lds, Qb, KT, KT + (size_t)QKW * T, VT, PC, (const GAS bf16*)(ws + WS_ROT), (const GAS bf16*)(ws + WS_CTL + 512 * 1024), Yb, statp, l2f, l2b, u >> 5, hh_, u & 7, wave_k); }
    }
    GRID_BAR();

    if (PH(5)) {
        PHASE_VARS
        SchedPlain S{(const GAS char*)HN, (const GAS char*)(WIN + (size_t)(2 * QKW + VW) * D), (size_t)256 * D * 2, (size_t)256 * D * 2, T / 256, 8, G, bx};
        EpiGate E{Yb, YG, statp, gn_gain, (LAS f32x2*)(lds + 135168)};
        pg8::gemm_phase<EpiGate, SchedPlain, false>(lds, wave_k, D, D, D, S, E);
    }
    GRID_BAR();

    if (PH(6)) {
        PHASE_VARS
        SchedPlain S{(const GAS char*)YG, (const GAS char*)WO, (size_t)256 * VW * 2, (size_t)256 * VW * 2, T / 256, 4, G, bx};
        EpiRes<true> E{(const GAS void*)x, HB};
        pg8::gemm_phase<EpiRes<true>, SchedPlain, false>(lds, wave_k, VW, VW, VW, S, E);
    }
    GRID_BAR();

    if (PH(7)) {
        PHASE_VARS
        for (int m = gw; m < T; m += NGW) { f32x4 v[4]; rms_row_b(HB + (size_t)m * D, ffn_norm, HNB + (size_t)m * D, lane, v); }
        LAS float* scr = (LAS float*)(lds + wave * 16384);
        constexpr int I_GU = 2 * (D / 64) * (FFE / 32), I_D = (FFE / 64) * (D / 32);
        for (int it = gw; it < NE * (I_GU + I_D); it += NGW) {
            const int e = it / (I_GU + I_D); int r = it - e * (I_GU + I_D);
            if (r < I_GU) tr_gu(m_wg + (size_t)e * D * FFE, m_wu + (size_t)e * D * FFE, D, FFE, WMGU + (size_t)e * 2 * FFE * D, r, scr, lane);
            else tr_plain(m_wd + (size_t)e * FFE * D, FFE, D, WMD + (size_t)e * D * FFE, r - I_GU, scr, lane);
        }
    }
    GRID_BAR();

    if (PH(8)) {
        PHASE_VARS
        SchedPlain S{(const GAS char*)HNB, (const GAS char*)WGU, (size_t)256 * D * 2, (size_t)256 * D * 2, T / 256, 2 * FFD / 256, G, bx};
        EpiSwiGLU E{ACTD, FFD};
        pg8::gemm_phase<EpiSwiGLU, SchedPlain, false>(lds, wave_k, D, D, D, S, E);
    }
    GRID_BAR();
    if (PH(9)) {
        PHASE_VARS
        SchedPlain S{(const GAS char*)ACTD, (const GAS char*)WD, (size_t)256 * FFD * 2, (size_t)256 * FFD * 2, T / 256, 4, G, bx};
        EpiRes<false> E{(const GAS void*)HB, HB};
        pg8::gemm_phase<EpiRes<false>, SchedPlain, false>(lds, wave_k, FFD, FFD, FFD, S, E);
    }
    GRID_BAR();

    if (PH(10)) {
        PHASE_VARS
        for (int m = gw; m < T; m += NGW) { f32x4 v[4]; rms_row_b(HB + (size_t)m * D, mix_norm + D, HNB + (size_t)m * D, lane, v); }
        for (int e = vcu * 512 + tid; e < 512 * 1024; e += G * 512) { const int ka = e >> 10, c = e & 1023, a = c & 511, mm = (a * ka) & 511;
            const float v = (c < 512 ? cospif((float)mm * (1.0f / 256.0f)) : sinpif((float)mm * (1.0f / 256.0f))) * (1.0f / 1024.0f); WSEQ[e] = (bf16)(cvt_pk_bf16(v, 0.f) & 0xffffu); }
    }
    GRID_BAR();

    if (PH(11)) {
        PHASE_VARS
        SchedFnA S{(const GAS char*)WC, (const GAS char*)HNB, G, bx};
        EpiZ2 E{Z2};
        pg8::gemm_phase<EpiZ2, SchedFnA, false>(lds, wave_k, 256, D, 256, S, E);
    }
    GRID_BAR();
    if (PH(22)) {
        PHASE_VARS
        float wc0[8], ws0[8];
#pragma unroll
        for (int kb = 0; kb < 8; ++kb) { const float ang = (float)((8 * lane * kb) & 4095) * (1.0f / 2048.0f); wc0[kb] = cospif(ang); ws0[kb] = sinpif(ang); }
        for (int rw = gw; rw < NB * 1024; rw += NGW) {
            GAS bf16* row = Z2 + (size_t)rw * 8192;
#pragma unroll
            for (int hq = 0; hq < 2; ++hq) {
                u32x2 zin[2][8], zout[8][2];
#pragma unroll
                for (int ri = 0; ri < 2; ++ri)
#pragma unroll
                    for (int bb = 0; bb < 8; ++bb) zin[ri][bb] = *(const GAS u32x2*)(row + ri * 4096 + 512 * bb + 8 * lane + 4 * hq);
#pragma unroll
                for (int q = 0; q < 2; ++q) {
                    float outr[2][8], outi[2][8];
#pragma unroll
                    for (int tt = 0; tt < 2; ++tt) {
                        const int t = 4 * hq + 2 * q + tt;
                        float zr[8], zi[8];
#pragma unroll
                        for (int bb = 0; bb < 8; ++bb) { const unsigned wr_ = zin[0][bb][q], wi_ = zin[1][bb][q]; zr[bb] = tt ? bf_hi(wr_) : bf_lo(wr_); zi[bb] = tt ? bf_hi(wi_) : bf_lo(wi_); }
#pragma unroll
                        for (int kb = 0; kb < 8; ++kb) {
                            float ur = 0.f, ui = 0.f;
#pragma unroll
                            for (int bb = 0; bb < 8; ++bb) {
                                const int m8 = (bb * kb) & 7;
                                const float c8 = (m8 == 0) ? 1.f : (m8 == 4) ? -1.f : (m8 == 2 || m8 == 6) ? 0.f : (m8 == 1 || m8 == 7) ? 0.70710678118654752f : -0.70710678118654752f;
                                const float s8 = (m8 == 0 || m8 == 4) ? 0.f : (m8 == 2) ? 1.f : (m8 == 6) ? -1.f : (m8 == 1 || m8 == 3) ? 0.70710678118654752f : -0.70710678118654752f;
                                ur += c8 * zr[bb] + s8 * zi[bb]; ui += c8 * zi[bb] - s8 * zr[bb]; }
                            const int mt = (t * kb);
                            const float ct = __builtin_cosf((float)mt * 0.00153398078788564123f), st_ = __builtin_sinf((float)mt * 0.00153398078788564123f);
                            const float twc = wc0[kb] * ct - ws0[kb] * st_, tws = ws0[kb] * ct + wc0[kb] * st_;
                            outr[tt][kb] = ur * twc + ui * tws; outi[tt][kb] = ui * twc - ur * tws; }
                    }
#pragma unroll
                    for (int kb = 0; kb < 8; ++kb) { zout[kb][0][q] = cvt_pk_bf16(outr[0][kb], outr[1][kb]); zout[kb][1][q] = cvt_pk_bf16(outi[0][kb], outi[1][kb]); }
                    __builtin_amdgcn_sched_barrier(0);
                }
#pragma unroll
                for (int kb = 0; kb < 8; ++kb)
#pragma unroll
                    for (int ri = 0; ri < 2; ++ri) *(GAS u32x2*)(row + kb * 1024 + ri * 512 + 8 * lane + 4 * hq) = zout[kb][ri];
                __builtin_amdgcn_sched_barrier(0);
            }
        }
    }
    GRID_BAR();
    if (PH(12)) {
        PHASE_VARS
        SchedFnB S{(GAS const char*)WSEQ, (GAS const char*)Z2, G, bx};
        EpiYf E{HNB};
        pg8::gemm_phase<EpiYf, SchedFnB, false>(lds, wave_k, 1024, 1024, 1024, S, E);
    }
    GRID_BAR();
    if (PH(13)) {
        PHASE_VARS
        SchedPlain S{(const GAS char*)HNB, (const GAS char*)WF, (size_t)256 * D * 2, (size_t)256 * D * 2, T / 256, 4, G, bx};
        EpiRes<false> E{(const GAS void*)HB, HB};
        pg8::gemm_phase<EpiRes<false>, SchedPlain, false>(lds, wave_k, D, D, D, S, E);
    }
    GRID_BAR();

    if (PH(14)) {
        PHASE_VARS
        LAS float* wrl = (LAS float*)lds;
        LAS int* le = (LAS int*)(lds + 32768);
        for (int i = tid; i < D * NE / 4; i += NWAVES * 64) ((LAS f32x4*)wrl)[i] = ((const GAS f32x4*)moe_router)[i];
        for (int i = vcu * 512 + tid; i < 2 * MOE_ROWS; i += G * 512) rowtok[i] = -1;
        __syncthreads();
        for (int tb = vcu; tb < T / 128; tb += G) {
            for (int rr = 0; rr < 16; ++rr) { const int tl = wave * 16 + rr, m = tb * 128 + tl; f32x4 v[4];
                rms_row_b(HB + (size_t)m * D, ffn_norm + D, HNB + (size_t)m * D, lane, v);
                float lg[8];
#pragma unroll
                for (int e = 0; e < 8; ++e) lg[e] = 0.f;
#pragma unroll
                for (int j = 0; j < 4; ++j)
#pragma unroll
                    for (int c = 0; c < 4; ++c) { const int col = rmsb_col(j, lane) + c; const f32x4 w0 = *(const LAS f32x4*)(wrl + col * 8), w1 = *(const LAS f32x4*)(wrl + col * 8 + 4); const float xv = v[j][c];
                        lg[0] += xv * w0.x; lg[1] += xv * w0.y; lg[2] += xv * w0.z; lg[3] += xv * w0.w; lg[4] += xv * w1.x; lg[5] += xv * w1.y; lg[6] += xv * w1.z; lg[7] += xv * w1.w; }
#pragma unroll
                for (int e = 0; e < 8; ++e) lg[e] = wave_sum(lg[e]);
                int e0 = 0; float b0 = lg[0];
#pragma unroll
                for (int e = 1; e < 8; ++e) if (lg[e] > b0) { b0 = lg[e]; e0 = e; }
                int e1 = -1; float b1 = -3.0e38f;
#pragma unroll
                for (int e = 0; e < 8; ++e) if (e != e0 && lg[e] > b1) { b1 = lg[e]; e1 = e; }
                const float w0 = 1.0f / (1.0f + __expf(b1 - b0));
                if (lane == 0) { toke[2 * m] = e0; toke[2 * m + 1] = e1; tokw[2 * m] = w0; tokw[2 * m + 1] = 1.0f - w0; le[tl] = e0; le[128 + tl] = e1; } }
            __syncthreads();
            if (tid < 16) { const int s = tid >> 3, e = tid & 7; int c = 0; for (int i = 0; i < 128; ++i) c += (le[s * 128 + i] == e) ? 1 : 0; bcnt[tb * 16 + tid] = c; }
            if (tid >= 64 && tid < 128) { const int pi = tid - 64; int c = 0; for (int i = 0; i < 128; ++i) c += (le[i] * 8 + le[128 + i] == pi) ? 1 : 0; pcnt[tb * 64 + pi] = c; }
            __syncthreads();
        }
    }
    GRID_BAR();

    LAS int* segoff = (LAS int*)(lds + 132096);
    LAS int* ntile = (LAS int*)(lds + 132096 + 64);
    LAS unsigned char* tile_e = (LAS unsigned char*)(lds + 132096 + 128);
    if (PH(15)) {
        PHASE_VARS
        LAS int* pfx = (LAS int*)lds;
        LAS int* cph = (LAS int*)(lds + 65792);
        LAS int* fq_ = (LAS int*)(lds + 65792 + 16384);
        LAS int* tot = fq_ + 64;
        LAS int* tpi = tot + 16;
        LAS int* tex = tpi + 128;
        for (int i = tid; i < 256 * 64; i += NWAVES * 64) pfx[i] = pcnt[i];
        __syncthreads();
        if (tid < 64) { int run = 0; for (int b2 = 0; b2 < 256; ++b2) { const int c = pfx[b2 * 64 + tid]; pfx[b2 * 64 + tid] = run; run += c; } pfx[256 * 64 + tid] = run; }
        __syncthreads();
        if (tid == 0) {
            int n0[8], d[8], r[8]; int rs = 0;
            for (int e = 0; e < 8; ++e) { int c = 0; for (int x2 = 0; x2 < 8; ++x2) c += pfx[256 * 64 + e * 8 + x2]; n0[e] = c; r[e] = c & 255; d[e] = -(c & 255); rs += c & 255; }
            int extra = rs >> 8;
            for (int k = 0; k < extra; ++k) { int be = -1, br = -1; for (int e = 0; e < 8; ++e) if (d[e] < 0 && d[e] == -r[e] && r[e] > br) { br = r[e]; be = e; } if (be >= 0) d[be] += 256; }
            for (int i = 0; i < 64; ++i) fq_[i] = 0;
            for (int a = 0; a < 8; ++a) for (int e = 0; e < 8; ++e) if (a != e && d[a] < 0 && d[e] > 0) { int fl = -d[a]; if (d[e] < fl) fl = d[e]; const int av = pfx[256 * 64 + a * 8 + e]; if (av < fl) fl = av; fq_[a * 8 + e] = fl; d[a] += fl; d[e] -= fl; }
        }
        __syncthreads();
        if (tid < 256) {
            int c0[8], c1[8];
#pragma unroll
            for (int e = 0; e < 8; ++e) { c0[e] = 0; c1[e] = 0; }
            for (int a = 0; a < 8; ++a) for (int e = 0; e < 8; ++e) { const int pi = a * 8 + e; const int cnt = pfx[(tid + 1) * 64 + pi] - pfx[tid * 64 + pi]; int fl = fq_[pi] - pfx[tid * 64 + pi]; fl = fl < 0 ? 0 : (fl > cnt ? cnt : fl);
#pragma unroll
                for (int q = 0; q < 8; ++q) { c0[q] += (q == a ? cnt - fl : 0) + (q == e ? fl : 0); c1[q] += (q == e ? cnt - fl : 0) + (q == a ? fl : 0); } }
#pragma unroll
            for (int e = 0; e < 8; ++e) { cph[tid * 16 + e] = c0[e]; cph[tid * 16 + 8 + e] = c1[e]; }
        }
        __syncthreads();
        if (tid < 16) { int run = 0; for (int b2 = 0; b2 < 256; ++b2) { const int c = cph[b2 * 16 + tid]; cph[b2 * 16 + tid] = run; run += c; } tot[tid] = run; }
        __syncthreads();
        if (tid < 2) { int off = 0, nt = 0; for (int e = 0; e < 8; ++e) { segoff[tid * 8 + e] = off; const int tl = (tot[tid * 8 + e] + 255) >> 8; for (int q = 0; q < tl; ++q) tile_e[tid * 160 + nt + q] = (unsigned char)e; nt += tl; off += tl * 256; } ntile[tid] = nt; }
        __syncthreads();
        for (int tb = vcu; tb < T / 128; tb += G) {
            int e0 = 0, e1 = 0, flip = 0;
            if (tid < 128) { const int m = tb * 128 + tid; e0 = toke[2 * m]; e1 = toke[2 * m + 1]; tpi[tid] = e0 * 8 + e1; }
            __syncthreads();
            if (tid < 128) { const int pi = e0 * 8 + e1; int rk = 0; for (int i = 0; i < tid; ++i) rk += (tpi[i] == pi) ? 1 : 0;
                flip = (pfx[tb * 64 + pi] + rk) < fq_[pi] ? 1 : 0; tex[tid] = flip ? e1 : e0; tex[128 + tid] = flip ? e0 : e1; }
            __syncthreads();
            if (tid < 128) { const int m = tb * 128 + tid;
#pragma unroll
                for (int ph = 0; ph < 2; ++ph) { const int e = tex[ph * 128 + tid]; int rk = 0; for (int i = 0; i < tid; ++i) rk += (tex[ph * 128 + i] == e) ? 1 : 0;
                    const int row = segoff[ph * 8 + e] + cph[tb * 16 + ph * 8 + e] + rk;
                    rowtok[ph * MOE_ROWS + row] = m; rowgate[ph * MOE_ROWS + row] = tokw[2 * m + (ph ^ flip)]; } }
            __syncthreads();
        }
    }
    GRID_BAR();

    if (PH(16))
#pragma unroll
    for (int s = 0; s < 2; ++s) {
        {
            PHASE_VARS
            SchedMoe S{(const GAS char*)HNB, (const GAS char*)WMGU, rowtok + s * MOE_ROWS, tile_e + s * 160, 0, (size_t)2 * FFE * D * 2, (size_t)256 * D * 2, ntile[s], 2 * FFE / 256, G, bx, true};
            EpiSwiGLU E{ACTM, FFE};
            pg8::gemm_phase<EpiSwiGLU, SchedMoe, true>(lds, wave_k, D, D, D, S, E);
        }
        GRID_BAR();
        {
            PHASE_VARS
            SchedMoe S{(const GAS char*)ACTM, (const GAS char*)WMD, rowtok + s * MOE_ROWS, tile_e + s * 160, (size_t)256 * FFE * 2, (size_t)D * FFE * 2, (size_t)256 * FFE * 2, ntile[s], 4, G, bx, false};
            EpiMoeDown E{HB, rowtok + s * MOE_ROWS, rowgate + s * MOE_ROWS};
            pg8::gemm_phase<EpiMoeDown, SchedMoe, false>(lds, wave_k, FFE, FFE, FFE, S, E);
        }
        GRID_BAR();
    }

    if (PH(17)) {
        PHASE_VARS
        const bool bad = __hip_atomic_load((GAS unsigned*)(ws + WS_CTL) + CW_BAR + XB_TMO, RLX_AGENT) != 0u;
        for (int m = gw; m < T; m += NGW) {
            const GAS bf16* hrow = HB + (size_t)m * D; GAS float* orow = hres + (size_t)m * D;
            f32x4 v[4]; float s = 0.f;
#pragma unroll
            for (int jh = 0; jh < 2; ++jh) { const u32x4 xx = *(const GAS u32x4*)(hrow + 512 * jh + 8 * lane);
                v[2 * jh] = (f32x4){bf_lo(xx.x), bf_hi(xx.x), bf_lo(xx.y), bf_hi(xx.y)}; v[2 * jh + 1] = (f32x4){bf_lo(xx.z), bf_hi(xx.z), bf_lo(xx.w), bf_hi(xx.w)}; }
#pragma unroll
            for (int j = 0; j < 4; ++j) s += (v[j].x * v[j].x + v[j].y * v[j].y) + (v[j].z * v[j].z + v[j].w * v[j].w);
            const float r = bad ? __builtin_nanf("") : 1.0f / sqrtf(wave_sum(s) * (1.f / D) + EPS);
#pragma unroll
            for (int j = 0; j < 4; ++j) { const int col = rmsb_col(j, lane); *(GAS f32x4*)(orow + col) = v[j] * r * *(const GAS f32x4*)(final_norm + col); }
        }
    }
}

extern "C" void kernel_launch(void* const* d_in, const int* in_sizes, int n_in, void* d_out, int out_size, void* d_ws, size_t ws_size, hipStream_t stream) {
    static int grid = 0;
    if (grid == 0) {
        if (n_in != 16 || in_sizes[0] != T * D || out_size != T * D || ws_size < WS_END) { fprintf(stderr, "kernel_launch: unexpected shapes (n_in %d, in0 %d, out %d, ws %zu)\n", n_in, n_in > 0 ? in_sizes[0] : -1, out_size, ws_size); grid = -1; return; }
        int dev = 0, cus = 0, per_cu = 0;
        if (hipGetDevice(&dev) != hipSuccess || hipDeviceGetAttribute(&cus, hipDeviceAttributeMultiprocessorCount, dev) != hipSuccess) { grid = -1; return; }
        if (hipFuncSetAttribute((const void*)fwd_kernel, hipFuncAttributeMaxDynamicSharedMemorySize, LDS_BYTES) != hipSuccess) { fprintf(stderr, "kernel_launch: hipFuncSetAttribute failed\n"); grid = -1; return; }
        if (hipOccupancyMaxActiveBlocksPerMultiprocessor(&per_cu, (const void*)fwd_kernel, NWAVES * 64, LDS_BYTES) != hipSuccess || per_cu < 1) { fprintf(stderr, "kernel_launch: occupancy query says %d\n", per_cu); }
        (void)hipGetLastError();
        grid = cus;
    }
    if (grid < 0) return;
    if (hipMemsetAsync((char*)d_ws + WS_CTL, 0, CTL_ZERO_BYTES, stream) != hipSuccess) return;
    Args a{};
    for (int i = 0; i < 16; ++i) a.in[i] = (const float*)d_in[i];
    a.out = (float*)d_out; a.ws = (unsigned char*)d_ws;
    hipLaunchKernelGGL(fwd_kernel, dim3(grid), dim3(NWAVES * 64), LDS_BYTES, stream, a);
}
```

```cpp
#include <hip/hip_runtime.h>
#include <cstdio>
#include <cstdint>

#define LAS __attribute__((address_space(3)))
#define GAS __attribute__((address_space(1)))
typedef unsigned short bf16;
typedef short bf16x8 __attribute__((ext_vector_type(8)));
typedef float f32x2 __attribute__((ext_vector_type(2)));
typedef float f32x4 __attribute__((ext_vector_type(4)));
typedef float f32x16 __attribute__((ext_vector_type(16)));
typedef unsigned u32x2 __attribute__((ext_vector_type(2)));
typedef unsigned u32x4 __attribute__((ext_vector_type(4)));
typedef GAS unsigned gu32;

constexpr int D = 1024, NB = 8, SEQ = 4096, T = NB * SEQ;
constexpr int NH = 4, DK = 256, DV = 512, QKW = 1024, VW = 2048, INW = 6144, CH = 128, NCH = SEQ / CH;
constexpr int FFD = 2816, NE = 8, FFE = 3584;
constexpr int MOE_ROWS = T + NE * 256;
constexpr float EPS = 1e-6f;

constexpr size_t MiB = 1u << 20;
constexpr size_t WS_CTL = 0, CTL_ZERO_BYTES = 1 * MiB;
constexpr size_t WS_ROT = 1 * MiB, WS_ROTT = 5 * MiB, WS_WC = 10 * MiB + 768 * 1024;
constexpr int RTP = SEQ + 64;
constexpr size_t WS_TOKE = 9 * MiB + 256 * 1024;
constexpr size_t WS_TOKW = WS_TOKE + 256 * 1024;
constexpr size_t WS_BCNT = WS_TOKW + 256 * 1024;
constexpr size_t WS_ROWTOK = WS_BCNT + 16 * 1024;
constexpr size_t WS_ROWGATE = WS_ROWTOK + 2 * MOE_ROWS * 4;
constexpr size_t WS_PCNT = 10 * MiB + 512 * 1024;
constexpr size_t WS_STATS = 11 * MiB;
static_assert(WS_ROWGATE + 2 * MOE_ROWS * 4 <= WS_PCNT, "small tables");
constexpr size_t WS_WIN = 12 * MiB, WS_WO = 24 * MiB, WS_WGU = 28 * MiB, WS_WD = 39 * MiB, WS_WF = 44 * MiB + 512 * 1024;
constexpr size_t WS_HN = 48 * MiB;
constexpr size_t WS_Q = 112 * MiB, WS_K = 176 * MiB, WS_KT = 240 * MiB  , WS_VT = 368 * MiB, WS_PC = 496 * MiB;
constexpr size_t WS_YG = 240 * MiB;
constexpr size_t WS_STATP = 176 * MiB;
constexpr size_t WS_ACTD = 112 * MiB;
constexpr size_t WS_Z2 = 112 * MiB, WS_WSEQ = 240 * MiB;
constexpr size_t WS_ACTM = 112 * MiB;
constexpr size_t WS_WMGU = 352 * MiB, WS_WMD = 464 * MiB, WS_END = 528 * MiB;
static_assert(WS_ACTM + (size_t)MOE_ROWS * FFE * 2 <= WS_WMGU, "moe act");
static_assert(WS_PC + (size_t)NB * NH * NCH * CH * CH * 2 <= 528 * MiB, "epoch A");
static_assert(WS_WF + (size_t)D * D * 2 <= WS_HN, "weights");
constexpr int CW_BAR = 4096;
constexpr int CW_CHK = 64;

constexpr int RING_BYTES = 131072;
constexpr int LDSCTL_OFF = 139264, MISC_OFF = LDSCTL_OFF + 320;
constexpr int LDS_BYTES = 147456;

#define LDS_WAIT() asm volatile("s_waitcnt lgkmcnt(0)" ::: "memory")
#define VM_WAIT() asm volatile("s_waitcnt vmcnt(0)" ::: "memory")
#define RLX_AGENT __ATOMIC_RELAXED, __HIP_MEMORY_SCOPE_AGENT

__device__ __forceinline__ unsigned cvt_pk_bf16(float lo, float hi) { unsigned r; asm volatile("v_cvt_pk_bf16_f32 %0, %1, %2" : "=v"(r) : "v"(lo), "v"(hi)); return r; }
__device__ __forceinline__ float bf_lo(unsigned w) { return __uint_as_float(w << 16); }
__device__ __forceinline__ float bf_hi(unsigned w) { return __uint_as_float(w & 0xffff0000u); }
__device__ __forceinline__ float fast_exp2(float x) { return __builtin_amdgcn_exp2f(x); }
__device__ __forceinline__ int lane_id_v() { int l; asm volatile("v_mbcnt_lo_u32_b32 %0, -1, 0\n\tv_mbcnt_hi_u32_b32 %0, -1, %0" : "=v"(l)); return l; }
__device__ __forceinline__ int tid_of(int wave_s) { asm volatile("" : "+s"(wave_s)); return wave_s * 64 + lane_id_v(); }
__device__ __forceinline__ int rot_col(int row, int tok) { return (tok + ((row & 15) << 11)) & (32768 - 1); }
__device__ __forceinline__ float silu_f(float v) { return v * __builtin_amdgcn_rcpf(1.0f + __builtin_amdgcn_exp2f(v * -1.44269504088896341f)); }

namespace pg8 {
constexpr int BM = 256, BK = 64, HALF = 128, HTB = HALF * BK * 2, STAGE_BYTES = 8 * HTB, NXCD = 8, WGM = 8;
__host__ __device__ __forceinline__ int lds_byte(int r, int c) { const int st = (r >> 4) * 2 + (c >> 5), rr = r & 15, cc = c & 31, ob = rr * 64 + cc * 2; return st * 1024 + (ob ^ (((ob >> 9) & 1) << 5)); }
__host__ __device__ __forceinline__ void stage_rc(int b, int& R, int& C) { const int st = b / 1024, sb = b % 1024, swz = sb ^ (((sb >> 9) & 1) << 5); R = (st >> 1) * 16 + swz / 64; C = (st & 1) * 32 + (swz % 64) / 2; }
__host__ __device__ __forceinline__ int perm32(int rho) { const int n = rho >> 4, i = rho & 15; return 8 * (i >> 2) + 4 * n + (i & 3); }

struct Unit { const GAS char* A; const GAS char* B; const GAS int* rows; int pm, pn, z; };

__device__ __forceinline__ bool tile_of(long L, int nM, int nN, int& pm, int& pn) {
    const int nwg = nM * nN; if (L >= nwg) return false;
    int wgid = (int)L; { const int q = nwg / NXCD, r = nwg % NXCD, xcd = wgid % NXCD, off = wgid / NXCD; wgid = (xcd < r ? xcd * (q + 1) : r * (q + 1) + (xcd - r) * q) + off; }
    const int nig = WGM * nN, gid = wgid / nig, fm = gid * WGM, gsz = (nM - fm) < WGM ? (nM - fm) : WGM;
    pm = fm + ((wgid % nig) % gsz); pn = (wgid % nig) / gsz; return true;
}

template <class Epi, class Sched, bool GATHER, bool FP8 = false>
__device__ __forceinline__ void gemm_phase(LAS unsigned char* lds, const int wave_s, const int lda, const int ldb, const int K, const Sched& S, const Epi& E) {
    const int tid = tid_of(wave_s);
    const int wid = __builtin_amdgcn_readfirstlane(tid >> 6), lane = tid & 63, wr = wid >> 2, wc = wid & 3, fr = lane & 15, fq = lane >> 4;
    constexpr int ES = FP8 ? 1 : 2;
    const int nt = K * ES / (BK * 2);
    unsigned vA[2][2], vAn[2][2], voffB[2];
#pragma unroll
    for (int i = 0; i < 2; ++i) { int R, C; stage_rc(tid * 16 + i * 8192, R, C); const int Rb = Epi::PERM ? ((R & ~31) + perm32(R & 31)) : R;
        voffB[i] = (unsigned)(S.brow(Rb) * ldb * ES + C * 2);
#pragma unroll
        for (int h = 0; h < 2; ++h) { vA[h][i] = (unsigned)((h * HALF + R) * lda * ES + C * 2); vAn[h][i] = vA[h][i]; } }
    const size_t kstep = (size_t)(BK * 2);
    const size_t hstepB = (size_t)(S.brow(HALF) - S.brow(0)) * ldb * ES;
    const unsigned ldsw = (unsigned)wid * 1024u;
    const int aoff = lds_byte(wr * 64 + fr, FP8 ? fq * 16 : fq * 8), boff = lds_byte(wc * 32 + fr, FP8 ? fq * 16 : fq * 8);
    typedef int v4i_ __attribute__((ext_vector_type(4))); typedef int v8i_ __attribute__((ext_vector_type(8)));
    const int sc_w8 = S.scale_b8(), sc_a8 = 0x7f7f7f7f; (void)sc_w8; (void)sc_a8;
#define PG8_SA(b, h) (((b) * 2 + (h)) * HTB)
#define PG8_SB(b, h) ((4 + (b) * 2 + (h)) * HTB)
#define PG8_STAGE_B(bufoff, gbase) do { _Pragma("unroll") for (int _i = 0; _i < 2; ++_i) \
        __builtin_amdgcn_global_load_lds((const GAS unsigned*)((const GAS char*)(gbase) + voffB[_i]), (LAS unsigned*)(lds + (bufoff) + ldsw + _i * 8192), 16, 0, 0); } while (0)
#define PG8_STAGE_A(bufoff, gbase, v0, v1) do { \
        __builtin_amdgcn_global_load_lds((const GAS unsigned*)((const GAS char*)(gbase) + (v0)), (LAS unsigned*)(lds + (bufoff) + ldsw), 16, 0, 0); \
        __builtin_amdgcn_global_load_lds((const GAS unsigned*)((const GAS char*)(gbase) + (v1)), (LAS unsigned*)(lds + (bufoff) + ldsw + 8192), 16, 0, 0); } while (0)
#define PG8_LD32(addr) __builtin_shufflevector(*(const LAS v4i_*)(addr), *(const LAS v4i_*)((addr) + 16), 0, 1, 2, 3, 4, 5, 6, 7)
#define PG8_LDA(dst, b, h) do { _Pragma("unroll") for (int m = 0; m < 4; ++m) { if constexpr (FP8) dst##8[m] = PG8_LD32(lds + PG8_SA(b, h) + aoff + m * 2048); else { _Pragma("unroll") for (int k = 0; k < 2; ++k) dst[m][k] = *(const LAS bf16x8*)(lds + PG8_SA(b, h) + aoff + m * 2048 + k * 1024); } } } while (0)
#define PG8_LDB(dst, b, h) do { _Pragma("unroll") for (int n = 0; n < 2; ++n) { if constexpr (FP8) dst##8[n] = PG8_LD32(lds + PG8_SB(b, h) + boff + n * 2048); else { _Pragma("unroll") for (int k = 0; k < 2; ++k) dst[n][k] = *(const LAS bf16x8*)(lds + PG8_SB(b, h) + boff + n * 2048 + k * 1024); } } } while (0)
#define PG8_MMA(ai, bj, At, Bt) do { __builtin_amdgcn_s_setprio(1); _Pragma("unroll") for (int m = 0; m < 4; ++m) _Pragma("unroll") for (int n = 0; n < 2; ++n) { \
        if constexpr (FP8) asm volatile("v_mfma_scale_f32_16x16x128_f8f6f4 %0, %1, %2, %0, %3, %4 op_sel_hi:[0,0,0]" : "+v"(acc[ai][bj][m][n]) : "v"(Bt##8[n]), "v"(At##8[m]), "v"(sc_w8), "v"(sc_a8)); \
        else { _Pragma("unroll") for (int k = 0; k < 2; ++k) acc[ai][bj][m][n] = __builtin_amdgcn_mfma_f32_16x16x32_bf16(Bt[n][k], At[m][k], acc[ai][bj][m][n], 0, 0, 0); } } \
        __builtin_amdgcn_s_setprio(0); } while (0)
#define PG8_WAIT_V(n) asm volatile("s_waitcnt vmcnt(" #n ")" ::: "memory")
#define PG8_WAIT_L(n) asm volatile("s_waitcnt lgkmcnt(" #n ")" ::: "memory")
#define PG8_BAR __builtin_amdgcn_s_barrier()
#define PG8_SCHED __builtin_amdgcn_sched_barrier(0)
#define PG8_LOADROWS(dst, u) do { if constexpr (GATHER) { const int _tz = tid_of(wave_s); _Pragma("unroll") for (int _i = 0; _i < 2; ++_i) { int _R, _C; stage_rc(_tz * 16 + _i * 8192, _R, _C); \
        _Pragma("unroll") for (int _h = 0; _h < 2; ++_h) { const int _t = (u).rows[_h * HALF + _R]; dst[_h][_i] = (unsigned)((_t < 0 ? 0 : _t) * lda * ES + _C * 2); } } } } while (0)
#define PG8_VAN(h, i) (GATHER ? vAn[h][i] : vA[h][i])
    Unit cur, nxt; int ui = 0;
    if (!S.next(0, cur)) return;
    f32x4 acc[2][2][4][2];
#pragma unroll
    for (int a = 0; a < 2; ++a)
#pragma unroll
        for (int b = 0; b < 2; ++b)
#pragma unroll
            for (int m = 0; m < 4; ++m)
#pragma unroll
                for (int n = 0; n < 2; ++n) acc[a][b][m][n] = (f32x4){0.f, 0.f, 0.f, 0.f};
    bf16x8 At[4][2], B0[2][2], B1[2][2]; v8i_ At8[4], B08[2], B18[2]; (void)At; (void)B0; (void)B1; (void)At8; (void)B08; (void)B18;
    const GAS char* cA = cur.A; const GAS char* cB = cur.B;
    PG8_LOADROWS(vA, cur);
    if constexpr (GATHER) { vAn[0][0] = vA[0][0]; vAn[0][1] = vA[0][1]; vAn[1][0] = vA[1][0]; vAn[1][1] = vA[1][1]; }
    PG8_STAGE_B(PG8_SB(0, 0), cB); PG8_STAGE_B(PG8_SB(0, 1), cB + hstepB); PG8_STAGE_A(PG8_SA(0, 0), cA, vA[0][0], vA[0][1]); PG8_STAGE_A(PG8_SA(0, 1), cA, vA[1][0], vA[1][1]);
    if (wr == 1) PG8_BAR;
    PG8_WAIT_V(2); PG8_BAR;
    PG8_STAGE_B(PG8_SB(1, 0), cB + kstep); PG8_STAGE_A(PG8_SA(1, 0), cA + kstep, vA[0][0], vA[0][1]); PG8_STAGE_B(PG8_SB(1, 1), cB + hstepB + kstep);
    PG8_WAIT_V(6); PG8_BAR;
    for (;;) {
        const bool has_next = S.next(ui + 1, nxt);
        const GAS char* nA = has_next ? nxt.A : cA; const GAS char* nB = has_next ? nxt.B : cB;
#pragma unroll 1
        for (int t = 0; t < nt; t += 2) {
            const bool last = (t == nt - 2);
            const GAS char* a1 = cA + (size_t)(t + 1) * kstep;
            const GAS char* a2 = last ? nA : cA + (size_t)(t + 2) * kstep; const GAS char* b2 = last ? nB : cB + (size_t)(t + 2) * kstep;
            const GAS char* a3 = a2 + kstep; const GAS char* b3 = b2 + kstep;
            if constexpr (GATHER) { if (last && has_next) { PG8_LOADROWS(vAn, nxt); } }
            PG8_LDB(B0, 0, 0); PG8_LDB(B1, 0, 1); PG8_SCHED; PG8_LDA(At, 0, 0); PG8_STAGE_A(PG8_SA(1, 1), a1, vA[1][0], vA[1][1]);
            PG8_WAIT_V(8); PG8_WAIT_L(0); PG8_BAR; PG8_MMA(0, 0, At, B0); PG8_MMA(0, 1, At, B1); PG8_BAR; PG8_SCHED;
            PG8_LDA(At, 0, 1); PG8_STAGE_B(PG8_SB(0, 0), b2); PG8_STAGE_B(PG8_SB(0, 1), b2 + hstepB); PG8_STAGE_A(PG8_SA(0, 0), a2, PG8_VAN(0, 0), PG8_VAN(0, 1));
            PG8_WAIT_V(8); PG8_WAIT_L(0); PG8_BAR; PG8_MMA(1, 0, At, B0); PG8_MMA(1, 1, At, B1); PG8_BAR; PG8_SCHED;
            PG8_LDB(B0, 1, 0); PG8_LDB(B1, 1, 1); PG8_SCHED; PG8_LDA(At, 1, 0); PG8_STAGE_A(PG8_SA(0, 1), a2, PG8_VAN(1, 0), PG8_VAN(1, 1));
            PG8_WAIT_V(8); PG8_WAIT_L(0); PG8_BAR; PG8_MMA(0, 0, At, B0); PG8_MMA(0, 1, At, B1); PG8_BAR; PG8_SCHED;
            PG8_LDA(At, 1, 1); PG8_STAGE_B(PG8_SB(1, 0), b3); PG8_STAGE_B(PG8_SB(1, 1), b3 + hstepB); PG8_STAGE_A(PG8_SA(1, 0), a3, PG8_VAN(0, 0), PG8_VAN(0, 1));
            PG8_WAIT_V(8); PG8_WAIT_L(0); PG8_BAR; PG8_MMA(1, 0, At, B0); PG8_MMA(1, 1, At, B1); PG8_BAR; PG8_SCHED;
        }
        if (wr == 0) PG8_BAR;
        if constexpr (FP8) asm volatile("s_nop 15\n\ts_nop 15" ::: "memory");
        E(acc, cur, wr, wc, fr, fq);
        if (!has_next) break;
#pragma unroll
        for (int a = 0; a < 2; ++a)
#pragma unroll
            for (int b = 0; b < 2; ++b)
#pragma unroll
                for (int m = 0; m < 4; ++m)
#pragma unroll
                    for (int n = 0; n < 2; ++n) acc[a][b][m][n] = (f32x4){0.f, 0.f, 0.f, 0.f};
        cur = nxt; cA = nA; cB = nB; ++ui;
        if constexpr (GATHER) { vA[0][0] = vAn[0][0]; vA[0][1] = vAn[0][1]; vA[1][0] = vAn[1][0]; vA[1][1] = vAn[1][1]; }
        if (wr == 1) PG8_BAR;
    }
    PG8_WAIT_V(0);
    PG8_BAR;
#undef PG8_SA
#undef PG8_SB
#undef PG8_STAGE_A
#undef PG8_STAGE_B
#undef PG8_LDA
#undef PG8_LD32
#undef PG8_LDB
#undef PG8_MMA
#undef PG8_WAIT_V
#undef PG8_WAIT_L
#undef PG8_BAR
#undef PG8_SCHED
#undef PG8_LOADROWS
#undef PG8_VAN
}
}

struct SchedPlain {
    __device__ __forceinline__ int scale_b8() const { return 0x7f7f7f7f; }
    __device__ __forceinline__ int brow(int r) const { return r; }
    const GAS char* A; const GAS char* B; size_t a_tile, b_tile; int nM, nN, G, c;
    __device__ __forceinline__ bool next(int i, pg8::Unit& u) const {
        int pm, pn; if (!pg8::tile_of((long)i * G + c, nM, nN, pm, pn)) return false;
        u.pm = pm; u.pn = pn; u.z = 0; u.rows = nullptr; u.A = A + (size_t)pm * a_tile; u.B = B + (size_t)pn * b_tile; return true; }
};
struct SchedPc {
    __device__ __forceinline__ int scale_b8() const { return 0x7f7f7f7f; }
    __device__ __forceinline__ int brow(int r) const { return r; }
    const GAS char* Q; const GAS char* Kk; int G, c;
    __device__ __forceinline__ bool next(int i, pg8::Unit& u) const {
        const int L = i * G + c; if (L >= NB * NH * 16) return false;
        const int cp = L & 15, h = (L >> 4) & 3, b = L >> 6;
        const size_t off = ((size_t)(b * SEQ + cp * 256) * QKW + h * DK) * 2;
        u.pm = L; u.pn = 0; u.z = h; u.rows = nullptr; u.A = Q + off; u.B = Kk + off; return true; }
};
struct SchedFnA {
    __device__ __forceinline__ int scale_b8() const { return 0x7f7f7f7f; }
    __device__ __forceinline__ int brow(int r) const { return r; }
    const GAS char* Wc; const GAS char* Hn; int G, c;
    __device__ __forceinline__ bool next(int i, pg8::Unit& u) const {
        int pm, pn; if (!pg8::tile_of((long)i * G + c, 8, T / 256, pm, pn)) return false;
        const int g = pm >> 1, ri = pm & 1;
        u.pm = pm; u.pn = pn; u.z = 0; u.rows = nullptr; u.A = Wc + (size_t)ri * 256 * 256 * 2; u.B = Hn + ((size_t)pn * 256 * D + g * 256) * 2; return true; }
};
struct SchedFnB {
    __device__ __forceinline__ int scale_b8() const { return 0x7f7f7f7f; }
    __device__ __forceinline__ int brow(int r) const { return (r & 63) * 8 + (r >> 6); }
    GAS const char* WY; GAS const char* U; int G, c;
    __device__ __forceinline__ bool next(int i, pg8::Unit& u) const {
        int pm, pn; if (!pg8::tile_of((long)i * G + c, 2, 256, pm, pn)) return false;
        const int batch = pn >> 5, fb = (pn >> 1) & 15, kbb = pn & 1;
        u.pm = pm; u.pn = pn; u.z = 0; u.rows = nullptr; u.A = WY + (size_t)pm * 256 * 1024 * 2; u.B = U + ((size_t)(batch * 1024 + fb * 64) * 8 + kbb * 4) * 1024 * 2; return true; }
};
struct SchedMoe {
    __device__ __forceinline__ int scale_b8() const { return 0x79797979; }
    __device__ __forceinline__ int brow(int r) const { return r; }
    const GAS char* A; const GAS char* W; const GAS int* rowtok; const LAS unsigned char* texp; size_t a_tile, w_exp, w_tile; int ntiles, ncol, G, c; bool gather;
    __device__ __forceinline__ bool next(int i, pg8::Unit& u) const {
        int rt, ct; if (!pg8::tile_of((long)i * G + c, ntiles, ncol, rt, ct)) return false;
        const int e = texp[rt];
        u.pm = rt; u.pn = ct; u.z = e; u.rows = rowtok + rt * 256; u.A = gather ? A : A + (size_t)rt * a_tile; u.B = W + (size_t)e * w_exp + (size_t)ct * w_tile; return true; }
};

struct EpiRopeQK {
    static constexpr bool PERM = true;
    GAS bf16* Q; GAS bf16* Kk; const GAS f32x2* rot;
    __device__ __forceinline__ void operator()(const f32x4 (&acc)[2][2][4][2], const pg8::Unit& u, int wr, int wc, int fr, int fq) const {
        const bool isk = u.pn >= 4; const int h = u.pn & 3; GAS bf16* dst = isk ? Kk : Q; const float sc = isk ? 0.0625f : 1.0f;
        const int i0 = wc * 32 + 8 * fq;
#pragma unroll
        for (int ai = 0; ai < 2; ++ai)
#pragma unroll
            for (int m = 0; m < 4; ++m) {
                const int t = u.pm * 256 + ai * 128 + wr * 64 + m * 16 + fr, s = t & (SEQ - 1);
                const GAS f32x4* rp = (const GAS f32x4*)(rot + (size_t)s * 128 + i0);
                const f32x4 r0 = rp[0], r1 = rp[1], r2 = rp[2], r3 = rp[3];
                const float cs[8] = {r0[0], r0[2], r1[0], r1[2], r2[0], r2[2], r3[0], r3[2]}, sn[8] = {r0[1], r0[3], r1[1], r1[3], r2[1], r2[3], r3[1], r3[3]};
                float o1[8], o2[8];
#pragma unroll
                for (int n = 0; n < 2; ++n)
#pragma unroll
                    for (int j = 0; j < 4; ++j) { const float t1 = acc[ai][0][m][n][j], t2 = acc[ai][1][m][n][j]; const int q = 4 * n + j;
                        o1[q] = (t1 * cs[q] - t2 * sn[q]) * sc; o2[q] = (t1 * sn[q] + t2 * cs[q]) * sc; }
                GAS bf16* rowp = dst + (size_t)t * QKW + h * DK + i0;
                u32x4 w1, w2; w1.x = cvt_pk_bf16(o1[0], o1[1]); w1.y = cvt_pk_bf16(o1[2], o1[3]); w1.z = cvt_pk_bf16(o1[4], o1[5]); w1.w = cvt_pk_bf16(o1[6], o1[7]);
                w2.x = cvt_pk_bf16(o2[0], o2[1]); w2.y = cvt_pk_bf16(o2[2], o2[3]); w2.z = cvt_pk_bf16(o2[4], o2[5]); w2.w = cvt_pk_bf16(o2[6], o2[7]);
                *(GAS u32x4*)rowp = w1; *(GAS u32x4*)(rowp + 128) = w2; }
    }
};
struct EpiRopeKT {
    static constexpr bool PERM = true;
    GAS bf16* KT; const GAS f32x2* rotT; const LAS float* l2g;
    __device__ __forceinline__ void operator()(const f32x4 (&acc)[2][2][4][2], const pg8::Unit& u, int wr, int wc, int fr, int fq) const {
        const int h = u.pm; const float l2f = l2g[h], l2b = l2g[4 + h];
#pragma unroll
        for (int bj = 0; bj < 2; ++bj) {
            const int tok0 = u.pn * 256 + bj * 128 + wc * 32 + 8 * fq, s0 = tok0 & (SEQ - 1), j0 = tok0 & (CH - 1);
            float zf[8], zb[8];
#pragma unroll
            for (int q = 0; q < 8; ++q) { zf[q] = fast_exp2((float)(CH - 1 - (j0 + q)) * l2f) * 0.0625f; zb[q] = fast_exp2((float)(j0 + q) * l2b) * 0.0625f; }
#pragma unroll
            for (int m = 0; m < 4; ++m) { const int i = wr * 64 + m * 16 + fr;
                const GAS f32x4* rp = (const GAS f32x4*)(rotT + (size_t)i * RTP + s0);
                const f32x4 r0 = rp[0], r1 = rp[1], r2 = rp[2], r3 = rp[3];
                const float cs[8] = {r0[0], r0[2], r1[0], r1[2], r2[0], r2[2], r3[0], r3[2]}, sn[8] = {r0[1], r0[3], r1[1], r1[3], r2[1], r2[3], r3[1], r3[3]};
                float o1[8], o2[8];
#pragma unroll
                for (int n = 0; n < 2; ++n)
#pragma unroll
                    for (int j = 0; j < 4; ++j) { const float t1 = acc[0][bj][m][n][j], t2 = acc[1][bj][m][n][j]; const int q = 4 * n + j;
                        o1[q] = t1 * cs[q] - t2 * sn[q]; o2[q] = t1 * sn[q] + t2 * cs[q]; }
                u32x4 w1, w2;
                w1.x = cvt_pk_bf16(o1[0] * zf[0], o1[1] * zf[1]); w1.y = cvt_pk_bf16(o1[2] * zf[2], o1[3] * zf[3]); w1.z = cvt_pk_bf16(o1[4] * zf[4], o1[5] * zf[5]); w1.w = cvt_pk_bf16(o1[6] * zf[6], o1[7] * zf[7]);
                w2.x = cvt_pk_bf16(o2[0] * zf[0], o2[1] * zf[1]); w2.y = cvt_pk_bf16(o2[2] * zf[2], o2[3] * zf[3]); w2.z = cvt_pk_bf16(o2[4] * zf[4], o2[5] * zf[5]); w2.w = cvt_pk_bf16(o2[6] * zf[6], o2[7] * zf[7]);
                const size_t fr0 = ((((size_t)((tok0 >> 12) * NH + h) * NCH + ((tok0 & (SEQ - 1)) >> 7)) * 8 + (i >> 5)) * 8 + (2 * wc + (fq >> 1))) * 512 + ((i & 31) + 32 * (fq & 1)) * 8;
                *(GAS u32x4*)(KT + fr0) = w1; *(GAS u32x4*)(KT + fr0 + (size_t)4 * 8 * 512) = w2;
                w1.x = cvt_pk_bf16(o1[0] * zb[0], o1[1] * zb[1]); w1.y = cvt_pk_bf16(o1[2] * zb[2], o1[3] * zb[3]); w1.z = cvt_pk_bf16(o1[4] * zb[4], o1[5] * zb[5]); w1.w = cvt_pk_bf16(o1[6] * zb[6], o1[7] * zb[7]);
                w2.x = cvt_pk_bf16(o2[0] * zb[0], o2[1] * zb[1]); w2.y = cvt_pk_bf16(o2[2] * zb[2], o2[3] * zb[3]); w2.z = cvt_pk_bf16(o2[4] * zb[4], o2[5] * zb[5]); w2.w = cvt_pk_bf16(o2[6] * zb[6], o2[7] * zb[7]);
                *(GAS u32x4*)(KT + (size_t)QKW * T + fr0) = w1; *(GAS u32x4*)(KT + (size_t)QKW * T + fr0 + (size_t)4 * 8 * 512) = w2; } }
    }
};
template <bool ROT> struct EpiBf16 {
    static constexpr bool PERM = true;
    GAS bf16* O; int ldc;
    __device__ __forceinline__ void operator()(const f32x4 (&acc)[2][2][4][2], const pg8::Unit& u, int wr, int wc, int fr, int fq) const {
#pragma unroll
        for (int ai = 0; ai < 2; ++ai)
#pragma unroll
            for (int m = 0; m < 4; ++m) { const int row = u.pm * 256 + ai * 128 + wr * 64 + m * 16 + fr; GAS bf16* rowp = O + (size_t)row * ldc;
#pragma unroll
                for (int bj = 0; bj < 2; ++bj) { const f32x4 v0 = acc[ai][bj][m][0], v1 = acc[ai][bj][m][1]; const int col = u.pn * 256 + bj * 128 + wc * 32 + 8 * fq;
                    u32x4 w; w.x = cvt_pk_bf16(v0[0], v0[1]); w.y = cvt_pk_bf16(v0[2], v0[3]); w.z = cvt_pk_bf16(v1[0], v1[1]); w.w = cvt_pk_bf16(v1[2], v1[3]);
                    *(GAS u32x4*)(rowp + (ROT ? rot_col(row, col) : col)) = w; } }
    }
};
struct EpiPc {
    static constexpr bool PERM = true;
    GAS bf16* PC; GAS bf16* PD; const LAS float* l2g;
    __device__ __forceinline__ void operator()(const f32x4 (&acc)[2][2][4][2], const pg8::Unit& u, int wr, int wc, int fr, int fq) const {
        const int h = u.z; const float l2f = l2g[h], l2b = l2g[4 + h];
#pragma unroll
        for (int ai = 0; ai < 2; ++ai)
#pragma unroll
            for (int m = 0; m < 4; ++m) { const int il = wr * 64 + m * 16 + fr, jl0 = wc * 32 + 8 * fq; float o[8];
                const bool diag = (wc == 2 * wr + (m >> 1));
#pragma unroll
                for (int n = 0; n < 2; ++n)
#pragma unroll
                    for (int j = 0; j < 4; ++j) { const int dl = il - (jl0 + 4 * n + j); const float f = dl >= 0 ? fast_exp2((float)dl * l2f) : fast_exp2((float)(-dl) * l2b);
                        o[4 * n + j] = (ai == 0 ? acc[0][0][m][n][j] : acc[1][1][m][n][j]) * f; }
                if (diag) {
                    float ob[8];
#pragma unroll
                    for (int q = 0; q < 8; ++q) { const bool lower = (jl0 + q) <= il; ob[q] = lower ? 0.f : o[q]; o[q] = lower ? o[q] : 0.f; }
                    u32x4 wb; wb.x = cvt_pk_bf16(ob[0], ob[1]); wb.y = cvt_pk_bf16(ob[2], ob[3]); wb.z = cvt_pk_bf16(ob[4], ob[5]); wb.w = cvt_pk_bf16(ob[6], ob[7]);
                    *(GAS u32x4*)(PD + ((((size_t)(u.pm * 2 + ai) * 4 + (il >> 5)) * 2 + (fq >> 1)) * 512 + ((il & 31) + 32 * (fq & 1)) * 8)) = wb;
                }
                u32x4 w; w.x = cvt_pk_bf16(o[0], o[1]); w.y = cvt_pk_bf16(o[2], o[3]); w.z = cvt_pk_bf16(o[4], o[5]); w.w = cvt_pk_bf16(o[6], o[7]);
                *(GAS u32x4*)(PC + ((((size_t)(u.pm * 2 + ai) * 4 + (il >> 5)) * 8 + (2 * wc + (fq >> 1))) * 512 + ((il & 31) + 32 * (fq & 1)) * 8)) = w; }
    }
};
struct EpiGate {
    static constexpr bool PERM = true;
    const GAS bf16* Y; GAS bf16* YG; const GAS f32x2* statp; const GAS float* gain; LAS f32x2* sst;
    __device__ __forceinline__ void operator()(const f32x4 (&acc)[2][2][4][2], const pg8::Unit& u, int wr, int wc, int fr, int fq) const {
        const int head = u.pn >> 1, c0 = u.pn * 256 + wc * 32 + 8 * fq;
        const int tid = (wr * 4 + wc) * 64 + fq * 16 + fr;
        if (tid < 256) { const int t = u.pm * 256 + tid; const GAS f32x4* sp = (const GAS f32x4*)(statp + ((size_t)t * 4 + head) * 8); float a1 = 0.f, a2 = 0.f;
#pragma unroll
            for (int k = 0; k < 4; ++k) { const f32x4 v = sp[k]; a1 += v[0] + v[2]; a2 += v[1] + v[3]; }
            const float mu = a1 * (1.f / DV), var = fmaxf(a2 * (1.f / DV) - mu * mu, 0.f); sst[tid] = (f32x2){mu, __builtin_amdgcn_rsqf(var + EPS)}; }
        asm volatile("s_waitcnt lgkmcnt(0)" ::: "memory"); __builtin_amdgcn_s_barrier(); asm volatile("" ::: "memory");
        f32x4 gv[2][2];
#pragma unroll
        for (int bj = 0; bj < 2; ++bj) { gv[bj][0] = *(const GAS f32x4*)(gain + c0 + bj * 128); gv[bj][1] = *(const GAS f32x4*)(gain + c0 + bj * 128 + 4); }
#pragma unroll
        for (int ai = 0; ai < 2; ++ai)
#pragma unroll
            for (int m = 0; m < 4; ++m) { const int rl = ai * 128 + wr * 64 + m * 16 + fr, t = u.pm * 256 + rl; const f32x2 st = sst[rl];
#pragma unroll
                for (int bj = 0; bj < 2; ++bj) { const size_t off = (size_t)t * VW + c0 + bj * 128;
                    const int es_ = (u.pn & 1) * 4 + bj * 2 + (wc >> 1);
                    const u32x4 yv = *(const GAS u32x4*)(Y + (((size_t)(t >> 5) * NH + head) * 8 + es_) * 2048 + (((wc & 1) * 2 + (fq >> 1)) * 64 + (t & 31) + 32 * (fq & 1)) * 8);
                    const float y[8] = {bf_lo(yv.x), bf_hi(yv.x), bf_lo(yv.y), bf_hi(yv.y), bf_lo(yv.z), bf_hi(yv.z), bf_lo(yv.w), bf_hi(yv.w)}; float o[8];
#pragma unroll
                    for (int n = 0; n < 2; ++n)
#pragma unroll
                        for (int j = 0; j < 4; ++j) { const int q = 4 * n + j; const float yn = (y[q] - st.x) * st.y * gv[bj][n][j]; o[q] = silu_f(acc[ai][bj][m][n][j]) * yn; }
                    u32x4 w; w.x = cvt_pk_bf16(o[0], o[1]); w.y = cvt_pk_bf16(o[2], o[3]); w.z = cvt_pk_bf16(o[4], o[5]); w.w = cvt_pk_bf16(o[6], o[7]);
                    *(GAS u32x4*)(YG + off) = w; } }
    }
};
template <bool BASE_F32> struct EpiRes {
    static constexpr bool PERM = true;
    const GAS void* base; GAS bf16* out;
    __device__ __forceinline__ void operator()(const f32x4 (&acc)[2][2][4][2], const pg8::Unit& u, int wr, int wc, int fr, int fq) const {
#pragma unroll
        for (int ai = 0; ai < 2; ++ai)
#pragma unroll
            for (int m = 0; m < 4; ++m) { const size_t off = (size_t)(u.pm * 256 + ai * 128 + wr * 64 + m * 16 + fr) * D + u.pn * 256 + wc * 32 + 8 * fq;
#pragma unroll
                for (int bj = 0; bj < 2; ++bj) { f32x4 v0 = acc[ai][bj][m][0], v1 = acc[ai][bj][m][1];
                    if (BASE_F32) { const GAS float* bp = (const GAS float*)base + off + bj * 128; v0 += *(const GAS f32x4*)bp; v1 += *(const GAS f32x4*)(bp + 4); }
                    else { const u32x4 bv = *(const GAS u32x4*)((const GAS bf16*)base + off + bj * 128);
                        v0 += (f32x4){bf_lo(bv.x), bf_hi(bv.x), bf_lo(bv.y), bf_hi(bv.y)}; v1 += (f32x4){bf_lo(bv.z), bf_hi(bv.z), bf_lo(bv.w), bf_hi(bv.w)}; }
                    u32x4 w; w.x = cvt_pk_bf16(v0[0], v0[1]); w.y = cvt_pk_bf16(v0[2], v0[3]); w.z = cvt_pk_bf16(v1[0], v1[1]); w.w = cvt_pk_bf16(v1[2], v1[3]);
                    *(GAS u32x4*)(out + off + bj * 128) = w; } }
    }
};
struct EpiSwiGLU {
    static constexpr bool PERM = true;
    GAS bf16* ACT; int ldc;
    __device__ __forceinline__ void operator()(const f32x4 (&acc)[2][2][4][2], const pg8::Unit& u, int wr, int wc, int fr, int fq) const {
#pragma unroll
        for (int ai = 0; ai < 2; ++ai)
#pragma unroll
            for (int m = 0; m < 4; ++m) { float o[8];
#pragma unroll
                for (int n = 0; n < 2; ++n)
#pragma unroll
                    for (int j = 0; j < 4; ++j) o[4 * n + j] = silu_f(acc[ai][0][m][n][j]) * acc[ai][1][m][n][j];
                u32x4 w; w.x = cvt_pk_bf16(o[0], o[1]); w.y = cvt_pk_bf16(o[2], o[3]); w.z = cvt_pk_bf16(o[4], o[5]); w.w = cvt_pk_bf16(o[6], o[7]);
                *(GAS u32x4*)(ACT + (size_t)(u.pm * 256 + ai * 128 + wr * 64 + m * 16 + fr) * ldc + u.pn * 128 + wc * 32 + 8 * fq) = w; }
    }
};
struct EpiZ2 {
    static constexpr bool PERM = true;
    GAS bf16* Z2;
    __device__ __forceinline__ void operator()(const f32x4 (&acc)[2][2][4][2], const pg8::Unit& u, int wr, int wc, int fr, int fq) const {
        const int g = u.pm >> 1, ri = u.pm & 1;
#pragma unroll
        for (int ai = 0; ai < 2; ++ai)
#pragma unroll
            for (int m = 0; m < 4; ++m) { const int cp = ai * 128 + wr * 64 + m * 16 + fr;
#pragma unroll
                for (int bj = 0; bj < 2; ++bj) { const int tok0 = u.pn * 256 + bj * 128 + wc * 32 + 8 * fq, b = tok0 >> 12, s0 = tok0 & (SEQ - 1);
                    const f32x4 v0 = acc[ai][bj][m][0], v1 = acc[ai][bj][m][1];
                    u32x4 w; w.x = cvt_pk_bf16(v0[0], v0[1]); w.y = cvt_pk_bf16(v0[2], v0[3]); w.z = cvt_pk_bf16(v1[0], v1[1]); w.w = cvt_pk_bf16(v1[2], v1[3]);
                    *(GAS u32x4*)(Z2 + ((size_t)(b * 1024 + g * 256 + cp) * 8192 + ri * SEQ + s0)) = w; } }
    }
};
struct EpiYf {
    static constexpr bool PERM = true;
    GAS bf16* YF;
    __device__ __forceinline__ void operator()(const f32x4 (&acc)[2][2][4][2], const pg8::Unit& u, int wr, int wc, int fr, int fq) const {
        const int batch = u.pn >> 5, fb = (u.pn >> 1) & 15, kbb = u.pn & 1;
#pragma unroll
        for (int ai = 0; ai < 2; ++ai)
#pragma unroll
            for (int m = 0; m < 4; ++m) { const int ka = u.pm * 256 + ai * 128 + wr * 64 + m * 16 + fr;
#pragma unroll
                for (int bj = 0; bj < 2; ++bj) { const int kb = kbb * 4 + 2 * bj + (wc >> 1), f = fb * 64 + 32 * (wc & 1) + 8 * fq;
                    const f32x4 v0 = acc[ai][bj][m][0], v1 = acc[ai][bj][m][1];
                    u32x4 w; w.x = cvt_pk_bf16(v0[0], v0[1]); w.y = cvt_pk_bf16(v0[2], v0[3]); w.z = cvt_pk_bf16(v1[0], v1[1]); w.w = cvt_pk_bf16(v1[2], v1[3]);
                    *(GAS u32x4*)(YF + (size_t)(batch * SEQ + 8 * ka + kb) * D + f) = w; } }
    }
};
struct EpiMoeDown {
    static constexpr bool PERM = true;
    GAS bf16* Hres; const GAS int* rowtok; const GAS float* rowgate;
    __device__ __forceinline__ void operator()(const f32x4 (&acc)[2][2][4][2], const pg8::Unit& u, int wr, int wc, int fr, int fq) const {
#pragma unroll
        for (int ai = 0; ai < 2; ++ai)
#pragma unroll
            for (int m = 0; m < 4; ++m) { const int row = u.pm * 256 + ai * 128 + wr * 64 + m * 16 + fr; const int tok = rowtok[row]; const float gw = rowgate[row];
                if (tok >= 0) { GAS bf16* rp = Hres + (size_t)tok * D + u.pn * 256 + wc * 32 + 8 * fq;
#pragma unroll
                    for (int bj = 0; bj < 2; ++bj) { const u32x4 bv = *(const GAS u32x4*)(rp + bj * 128);
                        const f32x4 v0 = (f32x4){bf_lo(bv.x), bf_hi(bv.x), bf_lo(bv.y), bf_hi(bv.y)} + gw * acc[ai][bj][m][0], v1 = (f32x4){bf_lo(bv.z), bf_hi(bv.z), bf_lo(bv.w), bf_hi(bv.w)} + gw * acc[ai][bj][m][1];
                        u32x4 w; w.x = cvt_pk_bf16(v0[0], v0[1]); w.y = cvt_pk_bf16(v0[2], v0[3]); w.z = cvt_pk_bf16(v1[0], v1[1]); w.w = cvt_pk_bf16(v1[2], v1[3]);
                        *(GAS u32x4*)(rp + bj * 128) = w; } } }
    }
};

#define XB_TMO      128
#define XB_XCNT(j)  (256  + 64 * (j))
#define XB_XSUB(j)  (1280 + 64 * (j))
#define XB_XGEN(j)  (2304 + 64 * (j))
#define XB_TOP      3328
#define XB_TOPGEN   3392
#define XCD_BAR_WORDS 3456
#define XB_SPIN_CAP (1u << 18)
__device__ __forceinline__ unsigned xb_ld(unsigned* p)              { return __hip_atomic_load(p, __ATOMIC_RELAXED, __HIP_MEMORY_SCOPE_AGENT); }
__device__ __forceinline__ unsigned xb_add(unsigned* p, unsigned v) { return __hip_atomic_fetch_add(p, v, __ATOMIC_RELAXED, __HIP_MEMORY_SCOPE_AGENT); }
__device__ __forceinline__ unsigned xb_xcc_id() { return (unsigned)__builtin_amdgcn_s_getreg((3 << 11) | 20) & 0xFu; }
#define XB_SPIN(cond, bar) do { unsigned _sp = 0; while (cond) { __builtin_amdgcn_s_sleep(1); \
    if ((++_sp & 255u) == 0u) { if (xb_ld(&(bar)[XB_TMO])) break; if (_sp > XB_SPIN_CAP) { atomicAdd(&(bar)[XB_TMO], 1u); break; } } } } while (0)
struct XcdBarrier { unsigned* bar; unsigned x; volatile LAS unsigned* st; };
__device__ __forceinline__ XcdBarrier xcd_barrier_post(unsigned* bar, volatile LAS unsigned* st, const bool t0) {
    XcdBarrier b; b.bar = bar; b.x = xb_xcc_id(); b.st = st;
    if (t0) (void)xb_add(&bar[XB_XCNT(b.x)], 1u);
    return b;
}
__device__ __forceinline__ void xcd_barrier_complete(unsigned* bar, unsigned x, unsigned& nloc, unsigned& nx) {
    const unsigned G = gridDim.x * gridDim.y * gridDim.z;
    unsigned sum, cnt, mine, sp = 0u;
    for (;;) {
        sum = 0u; cnt = 0u; mine = 0u;
#pragma unroll
        for (unsigned j = 0; j < 16; ++j) { const unsigned c = xb_ld(&bar[XB_XCNT(j)]); sum += c; cnt += (c > 0u) ? 1u : 0u; mine = (j == x) ? c : mine; }
        if (sum == G) break;
        __builtin_amdgcn_s_sleep(1);
        if ((++sp & 255u) == 0u) { if (xb_ld(&bar[XB_TMO])) break; if (sp > XB_SPIN_CAP) { atomicAdd(&bar[XB_TMO], 1u); break; } }
    }
    nloc = mine > 0u ? mine : 1u; nx = cnt > 0u ? cnt : 1u;
}
__device__ __forceinline__ void xcd_barrier(const XcdBarrier& b, const bool t0) {
    asm volatile("s_waitcnt vmcnt(0)" ::: "memory");
    __syncthreads();
    if (t0) {
        unsigned* bar = b.bar;
        __builtin_amdgcn_s_waitcnt(0);
        unsigned nloc = b.st[0], nx = b.st[1];
        if (nloc == 0u) { xcd_barrier_complete(bar, b.x, nloc, nx); b.st[0] = nloc; b.st[1] = nx; }
        const unsigned old = xb_add(&bar[XB_XSUB(b.x)], 1u);
        const unsigned gen = old / nloc;
        if (old + 1u == (gen + 1u) * nloc) {
            __builtin_amdgcn_fence(__ATOMIC_RELEASE, "agent");
            asm volatile("s_waitcnt vmcnt(0)" ::: "memory");
            const unsigned og = xb_add(&bar[XB_TOP], 1u);
            const unsigned tg = og / nx;
            if (og + 1u == (tg + 1u) * nx) xb_add(&bar[XB_TOPGEN], 1u);
            else XB_SPIN(xb_ld(&bar[XB_TOPGEN]) == tg, bar);
            __builtin_amdgcn_fence(__ATOMIC_ACQUIRE, "agent");
            xb_add(&bar[XB_XGEN(b.x)], 1u);
            asm volatile("s_waitcnt vmcnt(0)" ::: "memory");
        } else {
            XB_SPIN(xb_ld(&bar[XB_XGEN(b.x)]) == gen, bar);
            __builtin_amdgcn_fence(__ATOMIC_ACQUIRE, "agent");
            asm volatile("s_waitcnt vmcnt(0)" ::: "memory");
        }
    }
    __syncthreads();
}

__device__ __forceinline__ float wave_sum(float v) {
#pragma unroll
    for (int o = 1; o < 64; o <<= 1) v += __shfl_xor(v, o);
    return v;
}
__device__ __forceinline__ void transpose_item(const GAS float* W, int K, int N, GAS bf16* WT, int k0, int n0, int rbase, LAS float* scr, int lane) {
#pragma unroll 8
    for (int i = 0; i < 32; ++i) { const int kk = 2 * i + (lane >> 5); scr[kk * 33 + (lane & 31)] = W[(size_t)(k0 + kk) * N + n0 + (lane & 31)]; }
    LDS_WAIT(); asm volatile("" ::: "memory");
    const int c = lane & 7;
#pragma unroll
    for (int j = 0; j < 4; ++j) { const int n = (lane >> 3) + 8 * j; const LAS float* s = scr + (8 * c) * 33 + n;
        u32x4 o; o.x = cvt_pk_bf16(s[0 * 33], s[1 * 33]); o.y = cvt_pk_bf16(s[2 * 33], s[3 * 33]); o.z = cvt_pk_bf16(s[4 * 33], s[5 * 33]); o.w = cvt_pk_bf16(s[6 * 33], s[7 * 33]);
        *(GAS u32x4*)(WT + (size_t)(rbase + n) * K + k0 + 8 * c) = o; }
    LDS_WAIT(); asm volatile("" ::: "memory");
}
__device__ __forceinline__ unsigned pk4_fp8(float a, float b, float c, float d) { int w = 0; w = __builtin_amdgcn_cvt_pk_fp8_f32(a, b, w, false); w = __builtin_amdgcn_cvt_pk_fp8_f32(c, d, w, true); return (unsigned)w; }
__device__ __forceinline__ void transpose_item8(const GAS float* W, int K, int N, GAS unsigned char* WT8, int k0, int n0, int rbase, float scale, LAS float* scr, int lane) {
#pragma unroll 8
    for (int i = 0; i < 32; ++i) { const int kk = 2 * i + (lane >> 5); scr[kk * 33 + (lane & 31)] = W[(size_t)(k0 + kk) * N + n0 + (lane & 31)]; }
    LDS_WAIT(); asm volatile("" ::: "memory");
    const int c = lane & 7;
#pragma unroll
    for (int j = 0; j < 4; ++j) { const int n = (lane >> 3) + 8 * j; const LAS float* sp = scr + (8 * c) * 33 + n;
        u32x2 o; o.x = pk4_fp8(sp[0 * 33] * scale, sp[1 * 33] * scale, sp[2 * 33] * scale, sp[3 * 33] * scale); o.y = pk4_fp8(sp[4 * 33] * scale, sp[5 * 33] * scale, sp[6 * 33] * scale, sp[7 * 33] * scale);
        *(GAS u32x2*)(WT8 + (size_t)(rbase + n) * K + k0 + 8 * c) = o; }
    LDS_WAIT(); asm volatile("" ::: "memory");
}
__device__ __forceinline__ void tr_gu8(const GAS float* Wg, const GAS float* Wu, int K, int N, GAS unsigned char* WT8, int it, LAS float* scr, int lane) {
    const int nblk = N / 32, per = (K / 64) * nblk; const bool up = it >= per; if (up) it -= per;
    const int kb = it / nblk, nb = it - kb * nblk, f0 = 32 * nb;
    transpose_item8(up ? Wu : Wg, K, N, WT8, 64 * kb, f0, 256 * (f0 >> 7) + (up ? 128 : 0) + (f0 & 127), 64.0f, scr, lane);
}
__device__ __forceinline__ void tr_plain(const GAS float* W, int K, int N, GAS bf16* WT, int it, LAS float* scr, int lane) {
    const int nblk = N / 32, kb = it / nblk, nb = it - kb * nblk; transpose_item(W, K, N, WT, 64 * kb, 32 * nb, 32 * nb, scr, lane);
}
__device__ __forceinline__ void tr_gu(const GAS float* Wg, const GAS float* Wu, int K, int N, GAS bf16* WT, int it, LAS float* scr, int lane) {
    const int nblk = N / 32, per = (K / 64) * nblk; const bool up = it >= per; if (up) it -= per;
    const int kb = it / nblk, nb = it - kb * nblk, f0 = 32 * nb;
    transpose_item(up ? Wu : Wg, K, N, WT, 64 * kb, f0, 256 * (f0 >> 7) + (up ? 128 : 0) + (f0 & 127), scr, lane);
}
__device__ __forceinline__ void rms_row(const GAS float* xrow, const GAS float* g, GAS bf16* orow, int lane, f32x4 (&v)[4]) {
    const GAS f32x4* xr = (const GAS f32x4*)xrow + lane; const GAS f32x4* gr = (const GAS f32x4*)g + lane;
    float s = 0.f;
#pragma unroll
    for (int j = 0; j < 4; ++j) { v[j] = xr[64 * j]; s += (v[j].x * v[j].x + v[j].y * v[j].y) + (v[j].z * v[j].z + v[j].w * v[j].w); }
    const float r = 1.0f / sqrtf(wave_sum(s) * (1.f / D) + EPS);
    GAS u32x2* o8 = (GAS u32x2*)orow + lane;
#pragma unroll
    for (int j = 0; j < 4; ++j) { v[j] = v[j] * r * gr[64 * j]; u32x2 w; w.x = cvt_pk_bf16(v[j].x, v[j].y); w.y = cvt_pk_bf16(v[j].z, v[j].w); o8[64 * j] = w; }
}
__device__ __forceinline__ int rmsb_col(int j, int lane) { return 512 * (j >> 1) + 8 * lane + 4 * (j & 1); }
__device__ __forceinline__ void rms_row_b(const GAS bf16* hrow, const GAS float* g, GAS bf16* orow, int lane, f32x4 (&v)[4]) {
    float s = 0.f;
#pragma unroll
    for (int jh = 0; jh < 2; ++jh) { const u32x4 x = *(const GAS u32x4*)(hrow + 512 * jh + 8 * lane);
        v[2 * jh] = (f32x4){bf_lo(x.x), bf_hi(x.x), bf_lo(x.y), bf_hi(x.y)}; v[2 * jh + 1] = (f32x4){bf_lo(x.z), bf_hi(x.z), bf_lo(x.w), bf_hi(x.w)}; }
#pragma unroll
    for (int j = 0; j < 4; ++j) s += (v[j].x * v[j].x + v[j].y * v[j].y) + (v[j].z * v[j].z + v[j].w * v[j].w);
    const float r = 1.0f / sqrtf(wave_sum(s) * (1.f / D) + EPS);
#pragma unroll
    for (int jh = 0; jh < 2; ++jh) { const GAS float* gp = g + 512 * jh + 8 * lane; v[2 * jh] = v[2 * jh] * r * *(const GAS f32x4*)gp; v[2 * jh + 1] = v[2 * jh + 1] * r * *(const GAS f32x4*)(gp + 4);
        u32x4 w; w.x = cvt_pk_bf16(v[2 * jh].x, v[2 * jh].y); w.y = cvt_pk_bf16(v[2 * jh].z, v[2 * jh].w); w.z = cvt_pk_bf16(v[2 * jh + 1].x, v[2 * jh + 1].y); w.w = cvt_pk_bf16(v[2 * jh + 1].z, v[2 * jh + 1].w);
        *(GAS u32x4*)(orow + 512 * jh + 8 * lane) = w; }
}

__device__ __forceinline__ void rms_row_b8(const GAS bf16* hrow, const GAS float* g, GAS unsigned char* o8, int lane, f32x4 (&v)[4]) {
    float s = 0.f;
#pragma unroll
    for (int jh = 0; jh < 2; ++jh) { const u32x4 x = *(const GAS u32x4*)(hrow + 512 * jh + 8 * lane);
        v[2 * jh] = (f32x4){bf_lo(x.x), bf_hi(x.x), bf_lo(x.y), bf_hi(x.y)}; v[2 * jh + 1] = (f32x4){bf_lo(x.z), bf_hi(x.z), bf_lo(x.w), bf_hi(x.w)}; }
#pragma unroll
    for (int j = 0; j < 4; ++j) s += (v[j].x * v[j].x + v[j].y * v[j].y) + (v[j].z * v[j].z + v[j].w * v[j].w);
    const float r = 1.0f / sqrtf(wave_sum(s) * (1.f / D) + EPS);
#pragma unroll
    for (int jh = 0; jh < 2; ++jh) { const GAS float* gp = g + 512 * jh + 8 * lane; v[2 * jh] = v[2 * jh] * r * *(const GAS f32x4*)gp; v[2 * jh + 1] = v[2 * jh + 1] * r * *(const GAS f32x4*)(gp + 4);
        u32x2 w; w.x = pk4_fp8(v[2 * jh].x, v[2 * jh].y, v[2 * jh].z, v[2 * jh].w); w.y = pk4_fp8(v[2 * jh + 1].x, v[2 * jh + 1].y, v[2 * jh + 1].z, v[2 * jh + 1].w);
        *(GAS u32x2*)(o8 + 512 * jh + 8 * lane) = w; }
}

constexpr int SW_QL = 0, SW_SPITCH = 528, SW_SL = 128 * 528, SW_VPITCH = 272, SW_VL = SW_SL + 64 * SW_SPITCH, SW_VB = 64 * SW_VPITCH;
static_assert(SW_VL + 2 * SW_VB <= 139264, "sweep LDS");
template <bool OUT> __device__ __forceinline__ void sweep_role(LAS unsigned char* lds, const GAS bf16* Qg, const GAS bf16* KTFg, const GAS bf16* KTBg, const GAS bf16* VTg, const GAS bf16* PCg, const GAS bf16* PDg, const GAS bf16* ZEROg, GAS bf16* Yg, GAS f32x2* statp, const float l2f, const float l2b, int b, int h, int es, const int wave_s) {
    const int tid = tid_of(wave_s);
    const int w = __builtin_amdgcn_readfirstlane(tid >> 6), lane = tid & 63, r32 = lane & 31, hh = lane >> 5;
    const int rb = w & 3;
    const int vrow = tid >> 4, vpc = tid & 15;
    const int qrow = tid >> 5, qpc = tid & 31;
    const GAS bf16* qp = Qg + (size_t)(b * SEQ + qrow) * QKW + h * DK + 8 * qpc;
    const GAS bf16* vtp = VTg + (size_t)(h * DV + 64 * es + vrow) * T + 8 * vpc; const int vrot = b * SEQ + ((vrow & 15) << 11);
    const int il = 32 * rb + r32;
    const GAS bf16* pcp = PCg + (((size_t)((b * NH + h) * NCH) * 4 + rb) * 8) * 512 + lane * 8;
    const GAS bf16* pdp = PDg + (((size_t)((b * NH + h) * NCH) * 4 + rb) * 2) * 512 + lane * 8;
    GAS bf16* yp = Yg + ((size_t)(((b * SEQ) >> 5) + rb) * NH + h) * 8 * 2048 + (size_t)es * 2048 + lane * 8;
    GAS f32x2* stp = statp + ((size_t)(b * SEQ + il) * NH + h) * 8 + es;
    const size_t kto = ((size_t)((b * NH + h) * NCH) * 8 + 2 * rb) * 8 * 512 + lane * 8;
#define SW_LDP(dst, s_, d_, nn_) do { const int jb_ = (s_) >> 1; const bool use_ = (d_) ? (jb_ >= rb) : (jb_ <= rb); const bool dg_ = (d_) && (jb_ == rb); \
        const GAS bf16* src_ = dg_ ? (pdp + (size_t)(nn_) * 4096 + 512 * ((s_) & 1)) : (pcp + (size_t)(nn_) * (CH * CH) + 512 * (s_)); \
        dst = *(const GAS bf16x8*)(use_ ? src_ : ZEROg); } while (0)
#define SW_SCHED __builtin_amdgcn_sched_barrier(0)
#define SW_MFMA(a, b, c) c = __builtin_amdgcn_mfma_f32_32x32x16_bf16(a, b, c, 0, 0, 0)
    bf16x8 pa[8];
    bf16x8 ka[2][8];
    u32x4 vv[2], qv[4];
    f32x16 Sacc[2][2];
    if constexpr (OUT) {
#pragma unroll
        for (int s = 0; s < 8; ++s) SW_LDP(pa[s], s, 0, 0);
    } else {
#pragma unroll
        for (int db = 0; db < 2; ++db)
#pragma unroll
            for (int s = 0; s < 8; ++s) ka[db][s] = *(const GAS bf16x8*)(KTFg + kto + db * 4096 + s * 512);
#pragma unroll
        for (int db = 0; db < 2; ++db)
#pragma unroll
            for (int et = 0; et < 2; ++et)
#pragma unroll
                for (int t = 0; t < 16; ++t) Sacc[db][et][t] = 0.f;
    }
#pragma unroll
    for (int it = 0; it < 2; ++it) vv[it] = *(const GAS u32x4*)(vtp + (size_t)(32 * it) * T + (vrot & (T - 1)));
#pragma unroll
    for (int it = 0; it < 2; ++it) *(LAS u32x4*)(lds + SW_VL + (vrow + 32 * it) * SW_VPITCH + vpc * 16) = vv[it];
#pragma unroll
    for (int hf = 0; hf < 2; ++hf) {
#pragma unroll
        for (int it = 0; it < 4; ++it) qv[it] = *(const GAS u32x4*)(qp + (size_t)(16 * (4 * hf + it)) * QKW);
#pragma unroll
        for (int it = 0; it < 4; ++it) { const int row = qrow + 16 * (4 * hf + it); *(LAS u32x4*)(lds + SW_QL + row * SW_SPITCH + qpc * 16) = qv[it]; }
    }
    const int sl_rd = SW_SL + r32 * SW_SPITCH + 16 * hh;
    const int q_rd = SW_QL + il * SW_SPITCH + 16 * hh;
#pragma unroll 1
    for (int p = 0; p < 2 * NCH; ++p) {
        const int dir = p >> 5, st = p & 31, n = dir ? NCH - 1 - st : st;
        const int pn = p + 1 < 2 * NCH ? p + 1 : p, dirn = pn >> 5, stn = pn & 31, nn = dirn ? NCH - 1 - stn : stn;
        const int cur = p & 1;
        const float l2 = dir ? l2b : l2f;
        const int v_rd = SW_VL + cur * SW_VB + r32 * SW_VPITCH + 16 * hh;
        if constexpr (!OUT) {
#pragma unroll
            for (int db = 0; db < 2; ++db)
#pragma unroll
                for (int et = 0; et < 2; ++et)
#pragma unroll
                    for (int g = 0; g < 4; ++g) { u32x2 pk; pk.x = cvt_pk_bf16(Sacc[db][et][4 * g], Sacc[db][et][4 * g + 1]); pk.y = cvt_pk_bf16(Sacc[db][et][4 * g + 2], Sacc[db][et][4 * g + 3]);
                        if (st == 0) { pk.x = 0u; pk.y = 0u; }
                        *(LAS u32x2*)(lds + SW_SL + (32 * et + r32) * SW_SPITCH + (64 * rb + 32 * db + 8 * g + 4 * hh) * 2) = pk; }
        }
#pragma unroll
        for (int it = 0; it < 2; ++it) vv[it] = *(const GAS u32x4*)(vtp + (size_t)(32 * it) * T + ((nn * CH + vrot) & (T - 1)));
#pragma unroll
        for (int it = 0; it < 4; ++it) qv[it] = *(const GAS u32x4*)(qp + (size_t)(nn * CH + 16 * it) * QKW);
        __syncthreads();
        f32x16 O[2];
        u32x4 yf[4];
        GAS bf16* ypn = yp + (size_t)(n * 4) * (NH * 8 * 2048);
        if constexpr (OUT) {
#pragma unroll
            for (int et = 0; et < 2; ++et)
#pragma unroll
                for (int t = 0; t < 16; ++t) O[et][t] = 0.f;
            bf16x8 qx[2], s0x[2], s1x[2], qy[2], s0y[2], s1y[2];
#define SW_LDC(dq, d0, d1, g2) do { _Pragma("unroll") for (int k = 0; k < 2; ++k) { const int ks = 2 * (g2) + k; dq[k] = *(const LAS bf16x8*)(lds + q_rd + 32 * ks); \
                d0[k] = *(const LAS bf16x8*)(lds + sl_rd + 32 * ks); d1[k] = *(const LAS bf16x8*)(lds + sl_rd + 32 * SW_SPITCH + 32 * ks); } } while (0)
#define SW_MMC(dq, d0, d1) do { SW_MFMA(d0[0], dq[0], O[0]); SW_MFMA(d1[0], dq[0], O[1]); SW_MFMA(d0[1], dq[1], O[0]); SW_MFMA(d1[1], dq[1], O[1]); } while (0)
            SW_LDC(qx, s0x, s1x, 0); SW_LDC(qy, s0y, s1y, 1); SW_SCHED;
            SW_MMC(qx, s0x, s1x); SW_SCHED; SW_LDC(qx, s0x, s1x, 2); SW_SCHED;
            SW_MMC(qy, s0y, s1y); SW_SCHED; SW_LDC(qy, s0y, s1y, 3); SW_SCHED;
            SW_MMC(qx, s0x, s1x); SW_SCHED; SW_LDC(qx, s0x, s1x, 4); SW_SCHED;
            SW_MMC(qy, s0y, s1y); SW_SCHED; SW_LDC(qy, s0y, s1y, 5); SW_SCHED;
            SW_MMC(qx, s0x, s1x); SW_SCHED; SW_LDC(qx, s0x, s1x, 6); SW_SCHED;
            SW_MMC(qy, s0y, s1y); SW_SCHED; SW_LDC(qy, s0y, s1y, 7); SW_SCHED;
            SW_MMC(qx, s0x, s1x); SW_SCHED;
            SW_MMC(qy, s0y, s1y); SW_SCHED;
#undef SW_LDC
#undef SW_MMC
        } else {
            const float gC = st == 0 ? 0.f : fast_exp2((float)CH * l2);
#pragma unroll
            for (int db = 0; db < 2; ++db)
#pragma unroll
                for (int et = 0; et < 2; ++et)
#pragma unroll
                    for (int t = 0; t < 16; ++t) Sacc[db][et][t] *= gC;
            bf16x8 v0x[2], v1x[2], v0y[2], v1y[2];
#define SW_LDU(d0, d1, g2) do { _Pragma("unroll") for (int k = 0; k < 2; ++k) { const int s_ = 2 * (g2) + k; d0[k] = *(const LAS bf16x8*)(lds + v_rd + 32 * s_); d1[k] = *(const LAS bf16x8*)(lds + v_rd + 32 * SW_VPITCH + 32 * s_); } } while (0)
#define SW_MMU(d0, d1, g2) do { _Pragma("unroll") for (int k = 0; k < 2; ++k) { const int s_ = 2 * (g2) + k; SW_MFMA(ka[0][s_], d0[k], Sacc[0][0]); SW_MFMA(ka[0][s_], d1[k], Sacc[0][1]); SW_MFMA(ka[1][s_], d0[k], Sacc[1][0]); SW_MFMA(ka[1][s_], d1[k], Sacc[1][1]); } } while (0)
            SW_LDU(v0x, v1x, 0); SW_LDU(v0y, v1y, 1); SW_SCHED;
            SW_MMU(v0x, v1x, 0); SW_SCHED; SW_LDU(v0x, v1x, 2); SW_SCHED;
            SW_MMU(v0y, v1y, 1); SW_SCHED; SW_LDU(v0y, v1y, 3); SW_SCHED;
            SW_MMU(v0x, v1x, 2); SW_SCHED;
            SW_MMU(v0y, v1y, 3); SW_SCHED;
#undef SW_LDU
#undef SW_MMU
        }
        __syncthreads();
#pragma unroll
        for (int it = 0; it < 4; ++it) { const int row = qrow + 16 * it; *(LAS u32x4*)(lds + SW_QL + row * SW_SPITCH + qpc * 16) = qv[it]; }
#pragma unroll
        for (int it = 0; it < 4; ++it) qv[it] = *(const GAS u32x4*)(qp + (size_t)(nn * CH + 16 * (4 + it)) * QKW);
        if constexpr (OUT) {
            if (dir) {
#pragma unroll
                for (int q = 0; q < 4; ++q) yf[q] = *(const GAS u32x4*)(ypn + q * 512);
            }
            const float xi = fast_exp2((float)(dir == 0 ? (il + 1) : (CH - il)) * l2);
#pragma unroll
            for (int et = 0; et < 2; ++et)
#pragma unroll
                for (int t = 0; t < 16; ++t) O[et][t] *= xi;
            bf16x8 v0x[2], v1x[2], v0y[2], v1y[2];
#define SW_LDV(d0, d1, g2) do { _Pragma("unroll") for (int k = 0; k < 2; ++k) { const int s_ = 2 * (g2) + k; d0[k] = *(const LAS bf16x8*)(lds + v_rd + 32 * s_); d1[k] = *(const LAS bf16x8*)(lds + v_rd + 32 * SW_VPITCH + 32 * s_); } } while (0)
#define SW_MMV(d0, d1, g2) do { _Pragma("unroll") for (int k = 0; k < 2; ++k) { const int s_ = 2 * (g2) + k; SW_MFMA(d0[k], pa[s_], O[0]); SW_MFMA(d1[k], pa[s_], O[1]); } } while (0)
            SW_LDV(v0x, v1x, 0); SW_LDV(v0y, v1y, 1); SW_SCHED;
            SW_MMV(v0x, v1x, 0); SW_SCHED; SW_LDV(v0x, v1x, 2); SW_SCHED;
            SW_MMV(v0y, v1y, 1); SW_SCHED; SW_LDV(v0y, v1y, 3); SW_SCHED;
            SW_MMV(v0x, v1x, 2); SW_SCHED;
            SW_MMV(v0y, v1y, 3); SW_SCHED;
#undef SW_LDV
#undef SW_MMV
#pragma unroll
            for (int s = 0; s < 8; ++s) SW_LDP(pa[s], s, dirn, nn);
        } else {
            const GAS bf16* ktn = (dirn ? KTBg : KTFg) + kto + (size_t)nn * 32768;
#pragma unroll
            for (int db = 0; db < 2; ++db)
#pragma unroll
                for (int s = 0; s < 8; ++s) ka[db][s] = *(const GAS bf16x8*)(ktn + db * 4096 + s * 512);
        }
#pragma unroll
        for (int it = 0; it < 2; ++it) *(LAS u32x4*)(lds + SW_VL + (cur ^ 1) * SW_VB + (vrow + 32 * it) * SW_VPITCH + vpc * 16) = vv[it];
#pragma unroll
        for (int it = 0; it < 4; ++it) { const int row = qrow + 16 * (4 + it); *(LAS u32x4*)(lds + SW_QL + row * SW_SPITCH + qpc * 16) = qv[it]; }
        if constexpr (OUT) {
            float s1 = 0.f, s2 = 0.f;
#pragma unroll
            for (int et = 0; et < 2; ++et)
#pragma unroll
                for (int kp = 0; kp < 2; ++kp) {
                    float ya[4], yb[4];
#pragma unroll
                    for (int q = 0; q < 4; ++q) { ya[q] = O[et][8 * kp + q]; yb[q] = O[et][8 * kp + 4 + q]; }
                    if (dir) {
                        u32x4 f = yf[et * 2 + kp];
                        { const auto r0 = __builtin_amdgcn_permlane32_swap(f.x, f.z, false, false); f.x = r0[0]; f.z = r0[1]; const auto r1 = __builtin_amdgcn_permlane32_swap(f.y, f.w, false, false); f.y = r1[0]; f.w = r1[1]; }
                        ya[0] += bf_lo(f.x); ya[1] += bf_hi(f.x); ya[2] += bf_lo(f.y); ya[3] += bf_hi(f.y); yb[0] += bf_lo(f.z); yb[1] += bf_hi(f.z); yb[2] += bf_lo(f.w); yb[3] += bf_hi(f.w);
#pragma unroll
                        for (int q = 0; q < 4; ++q) { s1 += ya[q] + yb[q]; s2 += ya[q] * ya[q] + yb[q] * yb[q]; }
                    }
                    u32x4 o; o.x = cvt_pk_bf16(ya[0], ya[1]); o.y = cvt_pk_bf16(ya[2], ya[3]); o.z = cvt_pk_bf16(yb[0], yb[1]); o.w = cvt_pk_bf16(yb[2], yb[3]);
                    { const auto r0 = __builtin_amdgcn_permlane32_swap(o.x, o.z, false, false); o.x = r0[0]; o.z = r0[1]; const auto r1 = __builtin_amdgcn_permlane32_swap(o.y, o.w, false, false); o.y = r1[0]; o.w = r1[1]; }
                    *(GAS u32x4*)(ypn + (et * 2 + kp) * 512) = o;
                }
            if (dir) { s1 += __shfl_xor(s1, 32); s2 += __shfl_xor(s2, 32);
                if (hh == 0) stp[(size_t)(n * CH) * (NH * 8)] = (f32x2){s1, s2}; }
        }
    }
#undef SW_LDP
#undef SW_SCHED
#undef SW_MFMA
    VM_WAIT();
    __syncthreads();
}

__device__ __forceinline__ void sweep_unit(LAS unsigned char* lds, const GAS bf16* Qg, const GAS bf16* KTFg, const GAS bf16* KTBg, const GAS bf16* VTg, const GAS bf16* PCg, const GAS bf16* PDg, const GAS bf16* ZEROg, GAS bf16* Yg, GAS f32x2* statp, const float l2f, const float l2b, int b, int h, int es, const int wave_s) {
    int ws_ = wave_s; asm volatile("" : "+s"(ws_));
    if (ws_ < 4) sweep_role<true>(lds, Qg, KTFg, KTBg, VTg, PCg, PDg, ZEROg, Yg, statp, l2f, l2b, b, h, es, wave_s);
    else sweep_role<false>(lds, Qg, KTFg, KTBg, VTg, PCg, PDg, ZEROg, Yg, statp, l2f, l2b, b, h, es, wave_s);
}

struct Args { const float* in[16]; float* out; unsigned char* ws; };
constexpr int NWAVES = 8;
#ifndef PHMASK
#define PHMASK 0xFFFFFFFFu
#endif
#define PH(k) (((PHMASK) >> (k)) & 1u)
__global__ void __launch_bounds__(NWAVES * 64, 2) fwd_kernel(Args args) {
    extern __shared__ __attribute__((aligned(16))) unsigned char lds_raw[];
    LAS unsigned char* lds = (LAS unsigned char*)lds_raw;
    LAS float* l2g = (LAS float*)(lds + LDSCTL_OFF + 64);
    const int wave_k = __builtin_amdgcn_readfirstlane((int)threadIdx.x >> 6);
#define PHASE_VARS \
    const int tid = tid_of(wave_k); const int lane = tid & 63; int wave = wave_k; asm volatile("" : "+s"(wave)); \
    const __attribute__((address_space(4))) Args* ka = (const __attribute__((address_space(4))) Args*)__builtin_amdgcn_kernarg_segment_ptr(); asm volatile("" : "+s"(ka)); \
    const int G = gridDim.x, bx = blockIdx.x; const int vcu = (G % 8 == 0) ? (bx % 8) * (G / 8) + bx / 8 : bx; const int gw = vcu * NWAVES + wave, NGW = G * NWAVES; \
    GAS unsigned char* ws = (GAS unsigned char*)ka->ws; asm volatile("" : "+s"(ws)); GAS float* hres = (GAS float*)ka->out; (void)lane; (void)gw; (void)NGW; (void)vcu; (void)hres; \
    const GAS float* x = (const GAS float*)ka->in[0]; const GAS float* mix_norm = (const GAS float*)ka->in[1]; const GAS float* ffn_norm = (const GAS float*)ka->in[2]; const GAS float* ret_w_in = (const GAS float*)ka->in[3]; const GAS float* ret_decay = (const GAS float*)ka->in[4]; \
    const GAS float* gn_gain = (const GAS float*)ka->in[5]; const GAS float* ret_w_out = (const GAS float*)ka->in[6]; const GAS float* d_wg = (const GAS float*)ka->in[7]; const GAS float* d_wu = (const GAS float*)ka->in[8]; const GAS float* d_wd = (const GAS float*)ka->in[9]; \
    const GAS float* fnet_w = (const GAS float*)ka->in[10]; const GAS float* moe_router = (const GAS float*)ka->in[11]; const GAS float* m_wg = (const GAS float*)ka->in[12]; const GAS float* m_wu = (const GAS float*)ka->in[13]; const GAS float* m_wd = (const GAS float*)ka->in[14]; const GAS float* final_norm = (const GAS float*)ka->in[15]; \
    (void)x; (void)mix_norm; (void)ffn_norm; (void)ret_w_in; (void)ret_decay; (void)gn_gain; (void)ret_w_out; (void)d_wg; (void)d_wu; (void)d_wd; (void)fnet_w; (void)moe_router; (void)m_wg; (void)m_wu; (void)m_wd; (void)final_norm; \
    GAS f32x2* rot = (GAS f32x2*)(ws + WS_ROT); GAS f32x2* rotT = (GAS f32x2*)(ws + WS_ROTT); GAS bf16* WC = (GAS bf16*)(ws + WS_WC); \
    GAS int* toke = (GAS int*)(ws + WS_TOKE); GAS float* tokw = (GAS float*)(ws + WS_TOKW); GAS int* bcnt = (GAS int*)(ws + WS_BCNT); GAS int* pcnt = (GAS int*)(ws + WS_PCNT); (void)pcnt; GAS int* rowtok = (GAS int*)(ws + WS_ROWTOK); GAS float* rowgate = (GAS float*)(ws + WS_ROWGATE); \
    GAS f32x2* statp = (GAS f32x2*)(ws + WS_STATP); \
    GAS bf16* WIN = (GAS bf16*)(ws + WS_WIN); GAS bf16* WO = (GAS bf16*)(ws + WS_WO); GAS bf16* WGU = (GAS bf16*)(ws + WS_WGU); GAS bf16* WD = (GAS bf16*)(ws + WS_WD); GAS bf16* WF = (GAS bf16*)(ws + WS_WF); \
    GAS bf16* HN = (GAS bf16*)(ws + WS_HN); GAS bf16* Qb = (GAS bf16*)(ws + WS_Q); GAS bf16* Kb = (GAS bf16*)(ws + WS_K); GAS bf16* KT = (GAS bf16*)(ws + WS_KT); GAS bf16* VT = (GAS bf16*)(ws + WS_VT); GAS bf16* PC = (GAS bf16*)(ws + WS_PC); \
    GAS bf16* HB = (GAS bf16*)(ws + WS_HN); GAS bf16* HNB = (GAS bf16*)ka->out; (void)HB; (void)HNB; \
    GAS unsigned char* HN8 = (GAS unsigned char*)ka->out + 64 * MiB; GAS unsigned char* WMGU8 = (GAS unsigned char*)(ws + WS_WMGU); (void)HN8; (void)WMGU8;     \
    GAS bf16* Yb = (GAS bf16*)ka->out; GAS bf16* YG = (GAS bf16*)(ws + WS_YG); GAS bf16* ACTD = (GAS bf16*)(ws + WS_ACTD); GAS bf16* Z2 = (GAS bf16*)(ws + WS_Z2); GAS bf16* WSEQ = (GAS bf16*)(ws + WS_WSEQ); \
    GAS bf16* ACTM = (GAS bf16*)(ws + WS_ACTM); GAS bf16* WMGU = (GAS bf16*)(ws + WS_WMGU); GAS bf16* WMD = (GAS bf16*)(ws + WS_WMD); \
    (void)rot; (void)rotT; (void)WC; (void)toke; (void)tokw; (void)bcnt; (void)rowtok; (void)rowgate; (void)statp; (void)WIN; (void)WO; (void)WGU; (void)WD; (void)WF; (void)HN; (void)Qb; (void)Kb; (void)KT; (void)VT; (void)PC; \
    (void)Yb; (void)YG; (void)ACTD; (void)Z2; (void)WSEQ; (void)ACTM; (void)WMGU; (void)WMD;
#define GRID_BAR() do { const __attribute__((address_space(4))) Args* kb = (const __attribute__((address_space(4))) Args*)__builtin_amdgcn_kernarg_segment_ptr(); asm volatile("" : "+s"(kb)); GAS unsigned char* wsb = (GAS unsigned char*)kb->ws; XcdBarrier bar_; bar_.bar = (unsigned*)(wsb + WS_CTL) + CW_BAR; bar_.x = xb_xcc_id(); \
    bar_.st = (volatile LAS unsigned*)(lds + MISC_OFF) + 8; xcd_barrier(bar_, tid_of(wave_k) == 0); } while (0)

    {
        PHASE_VARS
        for (int u = tid; u < (LDS_BYTES - LDSCTL_OFF) / 4; u += NWAVES * 64) ((LAS unsigned*)(lds + LDSCTL_OFF))[u] = 0u;
        __syncthreads();
        if (tid < 8) { const float xl = ret_decay[tid]; const float ls = fminf(xl, 0.f) - log1pf(expf(-fabsf(xl))); l2g[tid] = ls * 1.44269504088896341f; }
        __syncthreads();
        (void)xcd_barrier_post((unsigned*)(ws + WS_CTL) + CW_BAR, (volatile LAS unsigned*)(lds + MISC_OFF) + 8, tid == 0);
    }

    if (PH(0)) {
        PHASE_VARS
        LAS float* scr = (LAS float*)(lds + wave * 16384);
        constexpr int I_IN = (D / 64) * (INW / 32), I_O = (VW / 64) * (D / 32), I_GU = 2 * (D / 64) * (FFD / 32), I_D = (FFD / 64) * (D / 32), I_F = (D / 64) * (D / 32);
        constexpr int NITEMS = I_IN + I_O + I_GU + I_D + I_F;
        for (int it = gw; it < NITEMS; it += NGW) {
            int r = it;
            if (r < I_IN) { tr_plain(ret_w_in, D, INW, WIN, r, scr, lane); continue; } r -= I_IN;
            if (r < I_O) { tr_plain(ret_w_out, VW, D, WO, r, scr, lane); continue; } r -= I_O;
            if (r < I_GU) { tr_gu(d_wg, d_wu, D, FFD, WGU, r, scr, lane); continue; } r -= I_GU;
            if (r < I_D) { tr_plain(d_wd, FFD, D, WD, r, scr, lane); continue; } r -= I_D;
            tr_plain(fnet_w, D, D, WF, r, scr, lane);
        }
        for (int e = (vcu * 512 + tid); e < SEQ * 128; e += G * 512) { const int s = e >> 7, i = e & 127;
            const float inv = powf(10000.0f, -(float)i / 128.0f); const float ang = (float)s * inv; float sn, cs; sincosf(ang, &sn, &cs);
            rot[e] = (f32x2){cs, sn}; rotT[(size_t)i * RTP + s] = (f32x2){cs, sn}; }
        for (int e = (vcu * 512 + tid); e < 512 * 256; e += G * 512) { const int r = e >> 8, c = e & 255, mm = ((r & 255) * c) & 255;
            const float v = r < 256 ? cospif((float)mm * (1.0f / 128.0f)) : -sinpif((float)mm * (1.0f / 128.0f)); WC[e] = (bf16)(cvt_pk_bf16(v, 0.f) & 0xffffu); }
        for (int m = gw; m < T; m += NGW) { f32x4 v[4]; rms_row(x + (size_t)m * D, mix_norm, HN + (size_t)m * D, lane, v); }
    }
    GRID_BAR();

    if (PH(1) && PH(19)) {
        PHASE_VARS
        SchedPlain S{(const GAS char*)HN, (const GAS char*)WIN, (size_t)256 * D * 2, (size_t)256 * D * 2, T / 256, 8, G, bx};
        EpiRopeQK E{Qb, Kb, rot};
        pg8::gemm_phase<EpiRopeQK, SchedPlain, false>(lds, wave_k, D, D, D, S, E);
    }
    if (PH(1) && PH(20)) {
        PHASE_VARS
        SchedPlain S{(const GAS char*)(WIN + (size_t)QKW * D), (const GAS char*)HN, (size_t)256 * D * 2, (size_t)256 * D * 2, 4, T / 256, G, bx};
        EpiRopeKT E{KT, rotT, l2g};
        pg8::gemm_phase<EpiRopeKT, SchedPlain, false>(lds, wave_k, D, D, D, S, E);
    }
    if (PH(1) && PH(21)) {
        PHASE_VARS
        SchedPlain S{(const GAS char*)(WIN + (size_t)2 * QKW * D), (const GAS char*)HN, (size_t)256 * D * 2, (size_t)256 * D * 2, 8, T / 256, G, bx};
        EpiBf16<true> E{VT, T};
        pg8::gemm_phase<EpiBf16<true>, SchedPlain, false>(lds, wave_k, D, D, D, S, E);
    }
    GRID_BAR();

    if (PH(2)) {
        PHASE_VARS
        SchedPc S{(const GAS char*)Qb, (const GAS char*)Kb, G, bx};
        EpiPc E{PC, (GAS bf16*)(ws + WS_ROT), l2g};
        pg8::gemm_phase<EpiPc, SchedPc, false>(lds, wave_k, QKW, QKW, DK, S, E);
    }
    GRID_BAR();

    if (PH(3)) {
        PHASE_VARS
        for (int u = vcu; u < NB * NH * 8; u += G) { const int hh_ = (u >> 3) & 3; const float l2f = l2g[hh_], l2b = l2g[4 + hh_];
            sweep_unit(lds, Qb, KT, KT + (size_t)QKW * T, VT, PC, (const GAS bf16*)(ws + WS_ROT), (const GAS bf16*)(ws + WS_CTL + 512 * 1024), Yb, statp, l2f, l2b, u >> 5, hh_, u & 7, wave_k); }
    }
    GRID_BAR();

    if (PH(5)) {
        PHASE_VARS
        SchedPlain S{(const GAS char*)HN, (const GAS char*)(WIN + (size_t)(2 * QKW + VW) * D), (size_t)256 * D * 2, (size_t)256 * D * 2, T / 256, 8, G, bx};
        EpiGate E{Yb, YG, statp, gn_gain, (LAS f32x2*)(lds + 135168)};
        pg8::gemm_phase<EpiGate, SchedPlain, false>(lds, wave_k, D, D, D, S, E);
    }
    GRID_BAR();

    if (PH(6)) {
        PHASE_VARS
        SchedPlain S{(const GAS char*)YG, (const GAS char*)WO, (size_t)256 * VW * 2, (size_t)256 * VW * 2, T / 256, 4, G, bx};
        EpiRes<true> E{(const GAS void*)x, HB};
        pg8::gemm_phase<EpiRes<true>, SchedPlain, false>(lds, wave_k, VW, VW, VW, S, E);
    }
    GRID_BAR();

    if (PH(7)) {
        PHASE_VARS
        for (int m = gw; m < T; m += NGW) { f32x4 v[4]; rms_row_b(HB + (size_t)m * D, ffn_norm, HNB + (size_t)m * D, lane, v); }
        LAS float* scr = (LAS float*)(lds + wave * 16384);
        constexpr int I_GU = 2 * (D / 64) * (FFE / 32), I_D = (FFE / 64) * (D / 32);
        for (int it = gw; it < NE * (I_GU + I_D); it += NGW) {
            const int e = it / (I_GU + I_D); int r = it - e * (I_GU + I_D);
            if (r < I_GU) tr_gu8(m_wg + (size_t)e * D * FFE, m_wu + (size_t)e * D * FFE, D, FFE, WMGU8 + (size_t)e * 2 * FFE * D, r, scr, lane);
            else tr_plain(m_wd + (size_t)e * FFE * D, FFE, D, WMD + (size_t)e * D * FFE, r - I_GU, scr, lane);
        }
    }
    GRID_BAR();

    if (PH(8)) {
        PHASE_VARS
        SchedPlain S{(const GAS char*)HNB, (const GAS char*)WGU, (size_t)256 * D * 2, (size_t)256 * D * 2, T / 256, 2 * FFD / 256, G, bx};
        EpiSwiGLU E{ACTD, FFD};
        pg8::gemm_phase<EpiSwiGLU, SchedPlain, false>(lds, wave_k, D, D, D, S, E);
    }
    GRID_BAR();
    if (PH(9)) {
        PHASE_VARS
        SchedPlain S{(const GAS char*)ACTD, (const GAS char*)WD, (size_t)256 * FFD * 2, (size_t)256 * FFD * 2, T / 256, 4, G, bx};
        EpiRes<false> E{(const GAS void*)HB, HB};
        pg8::gemm_phase<EpiRes<false>, SchedPlain, false>(lds, wave_k, FFD, FFD, FFD, S, E);
    }
    GRID_BAR();

    if (PH(10)) {
        PHASE_VARS
        for (int m = gw; m < T; m += NGW) { f32x4 v[4]; rms_row_b(HB + (size_t)m * D, mix_norm + D, HNB + (size_t)m * D, lane, v); }
        for (int e = vcu * 512 + tid; e < 512 * 1024; e += G * 512) { const int ka = e >> 10, c = e & 1023, a = c & 511, mm = (a * ka) & 511;
            const float v = (c < 512 ? cospif((float)mm * (1.0f / 256.0f)) : sinpif((float)mm * (1.0f / 256.0f))) * (1.0f / 1024.0f); WSEQ[e] = (bf16)(cvt_pk_bf16(v, 0.f) & 0xffffu); }
    }
    GRID_BAR();

    if (PH(11)) {
        PHASE_VARS
        SchedFnA S{(const GAS char*)WC, (const GAS char*)HNB, G, bx};
        EpiZ2 E{Z2};
        pg8::gemm_phase<EpiZ2, SchedFnA, false>(lds, wave_k, 256, D, 256, S, E);
    }
    GRID_BAR();
    if (PH(22)) {
        PHASE_VARS
        float wc0[8], ws0[8];
#pragma unroll
        for (int kb = 0; kb < 8; ++kb) { const float ang = (float)((8 * lane * kb) & 4095) * (1.0f / 2048.0f); wc0[kb] = cospif(ang); ws0[kb] = sinpif(ang); }
        for (int rw = gw; rw < NB * 1024; rw += NGW) {
            GAS bf16* row = Z2 + (size_t)rw * 8192;
#pragma unroll
            for (int hq = 0; hq < 2; ++hq) {
                u32x2 zin[2][8], zout[8][2];
#pragma unroll
                for (int ri = 0; ri < 2; ++ri)
#pragma unroll
                    for (int bb = 0; bb < 8; ++bb) zin[ri][bb] = *(const GAS u32x2*)(row + ri * 4096 + 512 * bb + 8 * lane + 4 * hq);
#pragma unroll
                for (int q = 0; q < 2; ++q) {
                    float outr[2][8], outi[2][8];
#pragma unroll
                    for (int tt = 0; tt < 2; ++tt) {
                        const int t = 4 * hq + 2 * q + tt;
                        float zr[8], zi[8];
#pragma unroll
                        for (int bb = 0; bb < 8; ++bb) { const unsigned wr_ = zin[0][bb][q], wi_ = zin[1][bb][q]; zr[bb] = tt ? bf_hi(wr_) : bf_lo(wr_); zi[bb] = tt ? bf_hi(wi_) : bf_lo(wi_); }
#pragma unroll
                        for (int kb = 0; kb < 8; ++kb) {
                            float ur = 0.f, ui = 0.f;
#pragma unroll
                            for (int bb = 0; bb < 8; ++bb) {
                                const int m8 = (bb * kb) & 7;
                                const float c8 = (m8 == 0) ? 1.f : (m8 == 4) ? -1.f : (m8 == 2 || m8 == 6) ? 0.f : (m8 == 1 || m8 == 7) ? 0.70710678118654752f : -0.70710678118654752f;
                                const float s8 = (m8 == 0 || m8 == 4) ? 0.f : (m8 == 2) ? 1.f : (m8 == 6) ? -1.f : (m8 == 1 || m8 == 3) ? 0.70710678118654752f : -0.70710678118654752f;
                                ur += c8 * zr[bb] + s8 * zi[bb]; ui += c8 * zi[bb] - s8 * zr[bb]; }
                            const int mt = (t * kb);
                            const float ct = __builtin_cosf((float)mt * 0.00153398078788564123f), st_ = __builtin_sinf((float)mt * 0.00153398078788564123f);
                            const float twc = wc0[kb] * ct - ws0[kb] * st_, tws = ws0[kb] * ct + wc0[kb] * st_;
                            outr[tt][kb] = ur * twc + ui * tws; outi[tt][kb] = ui * twc - ur * tws; }
                    }
#pragma unroll
                    for (int kb = 0; kb < 8; ++kb) { zout[kb][0][q] = cvt_pk_bf16(outr[0][kb], outr[1][kb]); zout[kb][1][q] = cvt_pk_bf16(outi[0][kb], outi[1][kb]); }
                    __builtin_amdgcn_sched_barrier(0);
                }
#pragma unroll
                for (int kb = 0; kb < 8; ++kb)
#pragma unroll
                    for (int ri = 0; ri < 2; ++ri) *(GAS u32x2*)(row + kb * 1024 + ri * 512 + 8 * lane + 4 * hq) = zout[kb][ri];
                __builtin_amdgcn_sched_barrier(0);
            }
        }
    }
    GRID_BAR();
    if (PH(12)) {
        PHASE_VARS
        SchedFnB S{(GAS const char*)WSEQ, (GAS const char*)Z2, G, bx};
        EpiYf E{HNB};
        pg8::gemm_phase<EpiYf, SchedFnB, false>(lds, wave_k, 1024, 1024, 1024, S, E);
    }
    GRID_BAR();
    if (PH(13)) {
        PHASE_VARS
        SchedPlain S{(const GAS char*)HNB, (const GAS char*)WF, (size_t)256 * D * 2, (size_t)256 * D * 2, T / 256, 4, G, bx};
        EpiRes<false> E{(const GAS void*)HB, HB};
        pg8::gemm_phase<EpiRes<false>, SchedPlain, false>(lds, wave_k, D, D, D, S, E);
    }
    GRID_BAR();

    if (PH(14)) {
        PHASE_VARS
        LAS float* wrl = (LAS float*)lds;
        LAS int* le = (LAS int*)(lds + 32768);
        for (int i = tid; i < D * NE / 4; i += NWAVES * 64) ((LAS f32x4*)wrl)[i] = ((const GAS f32x4*)moe_router)[i];
        for (int i = vcu * 512 + tid; i < 2 * MOE_ROWS; i += G * 512) rowtok[i] = -1;
        __syncthreads();
        for (int tb = vcu; tb < T / 128; tb += G) {
            for (int rr = 0; rr < 16; ++rr) { const int tl = wave * 16 + rr, m = tb * 128 + tl; f32x4 v[4];
                rms_row_b8(HB + (size_t)m * D, ffn_norm + D, HN8 + (size_t)m * D, lane, v);
                float lg[8];
#pragma unroll
                for (int e = 0; e < 8; ++e) lg[e] = 0.f;
#pragma unroll
                for (int j = 0; j < 4; ++j)
#pragma unroll
                    for (int c = 0; c < 4; ++c) { const int col = rmsb_col(j, lane) + c; const f32x4 w0 = *(const LAS f32x4*)(wrl + col * 8), w1 = *(const LAS f32x4*)(wrl + col * 8 + 4); const float xv = v[j][c];
                        lg[0] += xv * w0.x; lg[1] += xv * w0.y; lg[2] += xv * w0.z; lg[3] += xv * w0.w; lg[4] += xv * w1.x; lg[5] += xv * w1.y; lg[6] += xv * w1.z; lg[7] += xv * w1.w; }
#pragma unroll
                for (int e = 0; e < 8; ++e) lg[e] = wave_sum(lg[e]);
                int e0 = 0; float b0 = lg[0];
#pragma unroll
                for (int e = 1; e < 8; ++e) if (lg[e] > b0) { b0 = lg[e]; e0 = e; }
                int e1 = -1; float b1 = -3.0e38f;
#pragma unroll
                for (int e = 0; e < 8; ++e) if (e != e0 && lg[e] > b1) { b1 = lg[e]; e1 = e; }
                const float w0 = 1.0f / (1.0f + __expf(b1 - b0));
                if (lane == 0) { toke[2 * m] = e0; toke[2 * m + 1] = e1; tokw[2 * m] = w0; tokw[2 * m + 1] = 1.0f - w0; le[tl] = e0; le[128 + tl] = e1; } }
            __syncthreads();
            if (tid < 16) { const int s = tid >> 3, e = tid & 7; int c = 0; for (int i = 0; i < 128; ++i) c += (le[s * 128 + i] == e) ? 1 : 0; bcnt[tb * 16 + tid] = c; }
            if (tid >= 64 && tid < 128) { const int pi = tid - 64; int c = 0; for (int i = 0; i < 128; ++i) c += (le[i] * 8 + le[128 + i] == pi) ? 1 : 0; pcnt[tb * 64 + pi] = c; }
            __syncthreads();
        }
    }
    GRID_BAR();

    LAS int* segoff = (LAS int*)(lds + 132096);
    LAS int* ntile = (LAS int*)(lds + 132096 + 64);
    LAS unsigned char* tile_e = (LAS unsigned char*)(lds + 132096 + 128);
    if (PH(15)) {
        PHASE_VARS
        LAS int* pfx = (LAS int*)lds;
        LAS int* cph = (LAS int*)(lds + 65792);
        LAS int* fq_ = (LAS int*)(lds + 65792 + 16384);
        LAS int* tot = fq_ + 64;
        LAS int* tpi = tot + 16;
        LAS int* tex = tpi + 128;
        for (int i = tid; i < 256 * 64; i += NWAVES * 64) pfx[i] = pcnt[i];
        __syncthreads();
        if (tid < 64) { int run = 0; for (int b2 = 0; b2 < 256; ++b2) { const int c = pfx[b2 * 64 + tid]; pfx[b2 * 64 + tid] = run; run += c; } pfx[256 * 64 + tid] = run; }
        __syncthreads();
        if (tid == 0) {
            int n0[8], d[8], r[8]; int rs = 0;
            for (int e = 0; e < 8; ++e) { int c = 0; for (int x2 = 0; x2 < 8; ++x2) c += pfx[256 * 64 + e * 8 + x2]; n0[e] = c; r[e] = c & 255; d[e] = -(c & 255); rs += c & 255; }
            int extra = rs >> 8;
            for (int k = 0; k < extra; ++k) { int be = -1, br = -1; for (int e = 0; e < 8; ++e) if (d[e] < 0 && d[e] == -r[e] && r[e] > br) { br = r[e]; be = e; } if (be >= 0) d[be] += 256; }
            for (int i = 0; i < 64; ++i) fq_[i] = 0;
            for (int a = 0; a < 8; ++a) for (int e = 0; e < 8; ++e) if (a != e && d[a] < 0 && d[e] > 0) { int fl = -d[a]; if (d[e] < fl) fl = d[e]; const int av = pfx[256 * 64 + a * 8 + e]; if (av < fl) fl = av; fq_[a * 8 + e] = fl; d[a] += fl; d[e] -= fl; }
        }
        __syncthreads();
        if (tid < 256) {
            int c0[8], c1[8];
#pragma unroll
            for (int e = 0; e < 8; ++e) { c0[e] = 0; c1[e] = 0; }
            for (int a = 0; a < 8; ++a) for (int e = 0; e < 8; ++e) { const int pi = a * 8 + e; const int cnt = pfx[(tid + 1) * 64 + pi] - pfx[tid * 64 + pi]; int fl = fq_[pi] - pfx[tid * 64 + pi]; fl = fl < 0 ? 0 : (fl > cnt ? cnt : fl);
#pragma unroll
                for (int q = 0; q < 8; ++q) { c0[q] += (q == a ? cnt - fl : 0) + (q == e ? fl : 0); c1[q] += (q == e ? cnt - fl : 0) + (q == a ? fl : 0); } }
#pragma unroll
            for (int e = 0; e < 8; ++e) { cph[tid * 16 + e] = c0[e]; cph[tid * 16 + 8 + e] = c1[e]; }
        }
        __syncthreads();
        if (tid < 16) { int run = 0; for (int b2 = 0; b2 < 256; ++b2) { const int c = cph[b2 * 16 + tid]; cph[b2 * 16 + tid] = run; run += c; } tot[tid] = run; }
        __syncthreads();
        if (tid < 2) { int off = 0, nt = 0; for (int e = 0; e < 8; ++e) { segoff[tid * 8 + e] = off; const int tl = (tot[tid * 8 + e] + 255) >> 8; for (int q = 0; q < tl; ++q) tile_e[tid * 160 + nt + q] = (unsigned char)e; nt += tl; off += tl * 256; } ntile[tid] = nt; }
        __syncthreads();
        for (int tb = vcu; tb < T / 128; tb += G) {
            int e0 = 0, e1 = 0, flip = 0;
            if (tid < 128) { const int m = tb * 128 + tid; e0 = toke[2 * m]; e1 = toke[2 * m + 1]; tpi[tid] = e0 * 8 + e1; }
            __syncthreads();
            if (tid < 128) { const int pi = e0 * 8 + e1; int rk = 0; for (int i = 0; i < tid; ++i) rk += (tpi[i] == pi) ? 1 : 0;
                flip = (pfx[tb * 64 + pi] + rk) < fq_[pi] ? 1 : 0; tex[tid] = flip ? e1 : e0; tex[128 + tid] = flip ? e0 : e1; }
            __syncthreads();
            if (tid < 128) { const int m = tb * 128 + tid;
#pragma unroll
                for (int ph = 0; ph < 2; ++ph) { const int e = tex[ph * 128 + tid]; int rk = 0; for (int i = 0; i < tid; ++i) rk += (tex[ph * 128 + i] == e) ? 1 : 0;
                    const int row = segoff[ph * 8 + e] + cph[tb * 16 + ph * 8 + e] + rk;
                    rowtok[ph * MOE_ROWS + row] = m; rowgate[ph * MOE_ROWS + row] = tokw[2 * m + (ph ^ flip)]; } }
            __syncthreads();
        }
    }
    GRID_BAR();

    if (PH(16))
#pragma unroll
    for (int s = 0; s < 2; ++s) {
        {
            PHASE_VARS
            SchedMoe S{(const GAS char*)HN8, (const GAS char*)WMGU8, rowtok + s * MOE_ROWS, tile_e + s * 160, 0, (size_t)2 * FFE * D, (size_t)256 * D, ntile[s], 2 * FFE / 256, G, bx, true};
            EpiSwiGLU E{ACTM, FFE};
            pg8::gemm_phase<EpiSwiGLU, SchedMoe, true, true>(lds, wave_k, D, D, D, S, E);
        }
        GRID_BAR();
        {
            PHASE_VARS
            SchedMoe S{(const GAS char*)ACTM, (const GAS char*)WMD, rowtok + s * MOE_ROWS, tile_e + s * 160, (size_t)256 * FFE * 2, (size_t)D * FFE * 2, (size_t)256 * FFE * 2, ntile[s], 4, G, bx, false};
            EpiMoeDown E{HB, rowtok + s * MOE_ROWS, rowgate + s * MOE_ROWS};
            pg8::gemm_phase<EpiMoeDown, SchedMoe, false>(lds, wave_k, FFE, FFE, FFE, S, E);
        }
        GRID_BAR();
    }

    if (PH(17)) {
        PHASE_VARS
        const bool bad = __hip_atomic_load((GAS unsigned*)(ws + WS_CTL) + CW_BAR + XB_TMO, RLX_AGENT) != 0u;
        for (int m = gw; m < T; m += NGW) {
            const GAS bf16* hrow = HB + (size_t)m * D; GAS float* orow = hres + (size_t)m * D;
            f32x4 v[4]; float s = 0.f;
#pragma unroll
            for (int jh = 0; jh < 2; ++jh) { const u32x4 xx = *(const GAS u32x4*)(hrow + 512 * jh + 8 * lane);
                v[2 * jh] = (f32x4){bf_lo(xx.x), bf_hi(xx.x), bf_lo(xx.y), bf_hi(xx.y)}; v[2 * jh + 1] = (f32x4){bf_lo(xx.z), bf_hi(xx.z), bf_lo(xx.w), bf_hi(xx.w)}; }
#pragma unroll
            for (int j = 0; j < 4; ++j) s += (v[j].x * v[j].x + v[j].y * v[j].y) + (v[j].z * v[j].z + v[j].w * v[j].w);
            const float r = bad ? __builtin_nanf("") : 1.0f / sqrtf(wave_sum(s) * (1.f / D) + EPS);
#pragma unroll
            for (int j = 0; j < 4; ++j) { const int col = rmsb_col(j, lane); *(GAS f32x4*)(orow + col) = v[j] * r * *(const GAS f32x4*)(final_norm + col); }
        }
    }
}

extern "C" void kernel_launch(void* const* d_in, const int* in_sizes, int n_in, void* d_out, int out_size, void* d_ws, size_t ws_size, hipStream_t stream) {
    static int grid = 0;
    if (grid == 0) {
        if (n_in != 16 || in_sizes[0] != T * D || out_size != T * D || ws_size < WS_END) { fprintf(stderr, "kernel_launch: unexpected shapes (n_in %d, in0 %d, out %d, ws %zu)\n", n_in, n_in > 0 ? in_sizes[0] : -1, out_size, ws_size); grid = -1; return; }
        int dev = 0, cus = 0, per_cu = 0;
        if (hipGetDevice(&dev) != hipSuccess || hipDeviceGetAttribute(&cus, hipDeviceAttributeMultiprocessorCount, dev) != hipSuccess) { grid = -1; return; }
        if (hipFuncSetAttribute((const void*)fwd_kernel, hipFuncAttributeMaxDynamicSharedMemorySize, LDS_BYTES) != hipSuccess) { fprintf(stderr, "kernel_launch: hipFuncSetAttribute failed\n"); grid = -1; return; }
        if (hipOccupancyMaxActiveBlocksPerMultiprocessor(&per_cu, (const void*)fwd_kernel, NWAVES * 64, LDS_BYTES) != hipSuccess || per_cu < 1) { fprintf(stderr, "kernel_launch: occupancy query says %d\n", per_cu); }
        (void)hipGetLastError();
        grid = cus;
    }
    if (grid < 0) return;
    if (hipMemsetAsync((char*)d_ws + WS_CTL, 0, CTL_ZERO_BYTES, stream) != hipSuccess) return;
    Args a{};
    for (int i = 0; i < 16; ++i) a.in[i] = (const float*)d_in[i];
    a.out = (float*)d_out; a.ws = (unsigned char*)d_ws;
    hipLaunchKernelGGL(fwd_kernel, dim3(grid), dim3(NWAVES * 64), LDS_BYTES, stream, a);
}
```

```cpp
#include <hip/hip_runtime.h>
#include <cstdio>
#include <cstdint>

#define LAS __attribute__((address_space(3)))
#define GAS __attribute__((address_space(1)))
typedef unsigned short bf16;
typedef short bf16x8 __attribute__((ext_vector_type(8)));
typedef float f32x2 __attribute__((ext_vector_type(2)));
typedef float f32x4 __attribute__((ext_vector_type(4)));
typedef float f32x16 __attribute__((ext_vector_type(16)));
typedef unsigned u32x2 __attribute__((ext_vector_type(2)));
typedef unsigned u32x4 __attribute__((ext_vector_type(4)));
typedef GAS unsigned gu32;

constexpr int D = 1024, NB = 8, SEQ = 4096, T = NB * SEQ;
constexpr int NH = 4, DK = 256, DV = 512, QKW = 1024, VW = 2048, INW = 6144, CH = 128, NCH = SEQ / CH;
constexpr int FFD = 2816, NE = 8, FFE = 3584;
constexpr int MOE_ROWS = T + NE * 256;
constexpr float EPS = 1e-6f;

constexpr size_t MiB = 1u << 20;
constexpr size_t WS_CTL = 0, CTL_ZERO_BYTES = 1 * MiB;
constexpr size_t WS_ROT = 1 * MiB, WS_ROTT = 5 * MiB, WS_WC = 10 * MiB + 768 * 1024;
constexpr int RTP = SEQ + 64;
constexpr size_t WS_TOKE = 9 * MiB + 256 * 1024;
constexpr size_t WS_TOKW = WS_TOKE + 256 * 1024;
constexpr size_t WS_BCNT = WS_TOKW + 256 * 1024;
constexpr size_t WS_ROWTOK = WS_BCNT + 16 * 1024;
constexpr size_t WS_ROWGATE = WS_ROWTOK + 2 * MOE_ROWS * 4;
constexpr size_t WS_PCNT = 10 * MiB + 512 * 1024;
constexpr size_t WS_STATS = 11 * MiB;
static_assert(WS_ROWGATE + 2 * MOE_ROWS * 4 <= WS_PCNT, "small tables");
constexpr size_t WS_WIN = 12 * MiB, WS_WO = 24 * MiB, WS_WGU = 28 * MiB, WS_WD = 39 * MiB, WS_WF = 44 * MiB + 512 * 1024;
constexpr size_t WS_HN = 48 * MiB;
constexpr size_t WS_Q = 112 * MiB, WS_K = 176 * MiB, WS_KT = 240 * MiB  , WS_VT = 368 * MiB, WS_PC = 496 * MiB;
constexpr size_t WS_YG = 240 * MiB;
constexpr size_t WS_STATP = 176 * MiB;
constexpr size_t WS_ACTD = 112 * MiB;
constexpr size_t WS_Z2 = 112 * MiB, WS_WSEQ = 240 * MiB;
constexpr size_t WS_ACTM = 112 * MiB;
constexpr size_t WS_WMGU = 352 * MiB, WS_WMD = 464 * MiB, WS_END = 528 * MiB;
static_assert(WS_ACTM + (size_t)MOE_ROWS * FFE * 2 <= WS_WMGU, "moe act");
static_assert(WS_PC + (size_t)NB * NH * NCH * CH * CH * 2 <= 528 * MiB, "epoch A");
static_assert(WS_WF + (size_t)D * D * 2 <= WS_HN, "weights");
constexpr int CW_BAR = 4096;
constexpr int CW_CHK = 64;

constexpr int RING_BYTES = 131072;
constexpr int LDSCTL_OFF = 139264, MISC_OFF = LDSCTL_OFF + 320;
constexpr int LDS_BYTES = 147456;

#define LDS_WAIT() asm volatile("s_waitcnt lgkmcnt(0)" ::: "memory")
#define VM_WAIT() asm volatile("s_waitcnt vmcnt(0)" ::: "memory")
#define RLX_AGENT __ATOMIC_RELAXED, __HIP_MEMORY_SCOPE_AGENT

__device__ __forceinline__ unsigned cvt_pk_bf16(float lo, float hi) { unsigned r; asm volatile("v_cvt_pk_bf16_f32 %0, %1, %2" : "=v"(r) : "v"(lo), "v"(hi)); return r; }
__device__ __forceinline__ unsigned pk4_fp8(float a, float b, float c, float d) { int w = 0; w = __builtin_amdgcn_cvt_pk_fp8_f32(a, b, w, false); w = __builtin_amdgcn_cvt_pk_fp8_f32(c, d, w, true); return (unsigned)w; }
__device__ __forceinline__ float bf_lo(unsigned w) { return __uint_as_float(w << 16); }
__device__ __forceinline__ float bf_hi(unsigned w) { return __uint_as_float(w & 0xffff0000u); }
__device__ __forceinline__ float fast_exp2(float x) { return __builtin_amdgcn_exp2f(x); }
__device__ __forceinline__ int lane_id_v() { int l; asm volatile("v_mbcnt_lo_u32_b32 %0, -1, 0\n\tv_mbcnt_hi_u32_b32 %0, -1, %0" : "=v"(l)); return l; }
__device__ __forceinline__ int tid_of(int wave_s) { asm volatile("" : "+s"(wave_s)); return wave_s * 64 + lane_id_v(); }
__device__ __forceinline__ int rot_col(int row, int tok) { return (tok + ((row & 15) << 11)) & (32768 - 1); }
__device__ __forceinline__ float silu_f(float v) { return v * __builtin_amdgcn_rcpf(1.0f + __builtin_amdgcn_exp2f(v * -1.44269504088896341f)); }

namespace pg8 {
constexpr int BM = 256, BK = 64, HALF = 128, HTB = HALF * BK * 2, STAGE_BYTES = 8 * HTB, NXCD = 8, WGM = 8;
__host__ __device__ __forceinline__ int lds_byte(int r, int c) { const int st = (r >> 4) * 2 + (c >> 5), rr = r & 15, cc = c & 31, ob = rr * 64 + cc * 2; return st * 1024 + (ob ^ (((ob >> 9) & 1) << 5)); }
__host__ __device__ __forceinline__ void stage_rc(int b, int& R, int& C) { const int st = b / 1024, sb = b % 1024, swz = sb ^ (((sb >> 9) & 1) << 5); R = (st >> 1) * 16 + swz / 64; C = (st & 1) * 32 + (swz % 64) / 2; }
__host__ __device__ __forceinline__ int perm32(int rho) { const int n = rho >> 4, i = rho & 15; return 8 * (i >> 2) + 4 * n + (i & 3); }

struct Unit { const GAS char* A; const GAS char* B; const GAS int* rows; int pm, pn, z; };

__device__ __forceinline__ bool tile_of(long L, int nM, int nN, int& pm, int& pn) {
    const int nwg = nM * nN; if (L >= nwg) return false;
    int wgid = (int)L; { const int q = nwg / NXCD, r = nwg % NXCD, xcd = wgid % NXCD, off = wgid / NXCD; wgid = (xcd < r ? xcd * (q + 1) : r * (q + 1) + (xcd - r) * q) + off; }
    const int nig = WGM * nN, gid = wgid / nig, fm = gid * WGM, gsz = (nM - fm) < WGM ? (nM - fm) : WGM;
    pm = fm + ((wgid % nig) % gsz); pn = (wgid % nig) / gsz; return true;
}

template <class Epi, class Sched, bool GATHER, bool FP8 = false>
__device__ __forceinline__ void gemm_phase(LAS unsigned char* lds, const int wave_s, const int lda, const int ldb, const int K, const Sched& S, const Epi& E) {
    const int tid = tid_of(wave_s);
    const int wid = __builtin_amdgcn_readfirstlane(tid >> 6), lane = tid & 63, wr = wid >> 2, wc = wid & 3, fr = lane & 15, fq = lane >> 4;
    constexpr int ES = FP8 ? 1 : 2;
    const int nt = K * ES / (BK * 2);
    unsigned vA[2][2], vAn[2][2], voffB[2];
#pragma unroll
    for (int i = 0; i < 2; ++i) { int R, C; stage_rc(tid * 16 + i * 8192, R, C); const int Rb = Epi::PERM ? ((R & ~31) + perm32(R & 31)) : R;
        voffB[i] = (unsigned)(S.brow(Rb) * ldb * ES + C * 2);
#pragma unroll
        for (int h = 0; h < 2; ++h) { vA[h][i] = (unsigned)((h * HALF + R) * lda * ES + C * 2); vAn[h][i] = vA[h][i]; } }
    const size_t kstep = (size_t)(BK * 2);
    const size_t hstepB = (size_t)(S.brow(HALF) - S.brow(0)) * ldb * ES;
    const unsigned ldsw = (unsigned)wid * 1024u;
    const int aoff = lds_byte(wr * 64 + fr, FP8 ? fq * 16 : fq * 8), boff = lds_byte(wc * 32 + fr, FP8 ? fq * 16 : fq * 8);
    typedef int v4i_ __attribute__((ext_vector_type(4))); typedef int v8i_ __attribute__((ext_vector_type(8)));
    const int sc_w8 = S.scale_b8(), sc_a8 = S.scale_a8(); (void)sc_w8; (void)sc_a8;
#define PG8_SA(b, h) (((b) * 2 + (h)) * HTB)
#define PG8_SB(b, h) ((4 + (b) * 2 + (h)) * HTB)
#define PG8_STAGE_B(bufoff, gbase) do { _Pragma("unroll") for (int _i = 0; _i < 2; ++_i) \
        __builtin_amdgcn_global_load_lds((const GAS unsigned*)((const GAS char*)(gbase) + voffB[_i]), (LAS unsigned*)(lds + (bufoff) + ldsw + _i * 8192), 16, 0, 0); } while (0)
#define PG8_STAGE_A(bufoff, gbase, v0, v1) do { \
        __builtin_amdgcn_global_load_lds((const GAS unsigned*)((const GAS char*)(gbase) + (v0)), (LAS unsigned*)(lds + (bufoff) + ldsw), 16, 0, 0); \
        __builtin_amdgcn_global_load_lds((const GAS unsigned*)((const GAS char*)(gbase) + (v1)), (LAS unsigned*)(lds + (bufoff) + ldsw + 8192), 16, 0, 0); } while (0)
#define PG8_LD32(addr) __builtin_shufflevector(*(const LAS v4i_*)(addr), *(const LAS v4i_*)((addr) + 16), 0, 1, 2, 3, 4, 5, 6, 7)
#define PG8_LDA(dst, b, h) do { _Pragma("unroll") for (int m = 0; m < 4; ++m) { if constexpr (FP8) dst##8[m] = PG8_LD32(lds + PG8_SA(b, h) + aoff + m * 2048); else { _Pragma("unroll") for (int k = 0; k < 2; ++k) dst[m][k] = *(const LAS bf16x8*)(lds + PG8_SA(b, h) + aoff + m * 2048 + k * 1024); } } } while (0)
#define PG8_LDB(dst, b, h) do { _Pragma("unroll") for (int n = 0; n < 2; ++n) { if constexpr (FP8) dst##8[n] = PG8_LD32(lds + PG8_SB(b, h) + boff + n * 2048); else { _Pragma("unroll") for (int k = 0; k < 2; ++k) dst[n][k] = *(const LAS bf16x8*)(lds + PG8_SB(b, h) + boff + n * 2048 + k * 1024); } } } while (0)
#define PG8_MMA(ai, bj, At, Bt) do { __builtin_amdgcn_s_setprio(1); _Pragma("unroll") for (int m = 0; m < 4; ++m) _Pragma("unroll") for (int n = 0; n < 2; ++n) { \
        if constexpr (FP8) asm volatile("v_mfma_scale_f32_16x16x128_f8f6f4 %0, %1, %2, %0, %3, %4 op_sel_hi:[0,0,0]" : "+v"(acc[ai][bj][m][n]) : "v"(Bt##8[n]), "v"(At##8[m]), "v"(sc_w8), "v"(sc_a8)); \
        else { _Pragma("unroll") for (int k = 0; k < 2; ++k) acc[ai][bj][m][n] = __builtin_amdgcn_mfma_f32_16x16x32_bf16(Bt[n][k], At[m][k], acc[ai][bj][m][n], 0, 0, 0); } } \
        __builtin_amdgcn_s_setprio(0); } while (0)
#define PG8_WAIT_V(n) asm volatile("s_waitcnt vmcnt(" #n ")" ::: "memory")
#define PG8_WAIT_L(n) asm volatile("s_waitcnt lgkmcnt(" #n ")" ::: "memory")
#define PG8_BAR __builtin_amdgcn_s_barrier()
#define PG8_SCHED __builtin_amdgcn_sched_barrier(0)
#define PG8_LOADROWS(dst, u) do { if constexpr (GATHER) { const int _tz = tid_of(wave_s); _Pragma("unroll") for (int _i = 0; _i < 2; ++_i) { int _R, _C; stage_rc(_tz * 16 + _i * 8192, _R, _C); \
        _Pragma("unroll") for (int _h = 0; _h < 2; ++_h) { const int _t = (u).rows[_h * HALF + _R]; dst[_h][_i] = (unsigned)((_t < 0 ? 0 : _t) * lda * ES + _C * 2); } } } } while (0)
#define PG8_VAN(h, i) (GATHER ? vAn[h][i] : vA[h][i])
    Unit cur, nxt; int ui = 0;
    if (!S.next(0, cur)) return;
    f32x4 acc[2][2][4][2];
#pragma unroll
    for (int a = 0; a < 2; ++a)
#pragma unroll
        for (int b = 0; b < 2; ++b)
#pragma unroll
            for (int m = 0; m < 4; ++m)
#pragma unroll
                for (int n = 0; n < 2; ++n) acc[a][b][m][n] = (f32x4){0.f, 0.f, 0.f, 0.f};
    bf16x8 At[4][2], B0[2][2], B1[2][2]; v8i_ At8[4], B08[2], B18[2]; (void)At; (void)B0; (void)B1; (void)At8; (void)B08; (void)B18;
    const GAS char* cA = cur.A; const GAS char* cB = cur.B;
    PG8_LOADROWS(vA, cur);
    if constexpr (GATHER) { vAn[0][0] = vA[0][0]; vAn[0][1] = vA[0][1]; vAn[1][0] = vA[1][0]; vAn[1][1] = vA[1][1]; }
    PG8_STAGE_B(PG8_SB(0, 0), cB); PG8_STAGE_B(PG8_SB(0, 1), cB + hstepB); PG8_STAGE_A(PG8_SA(0, 0), cA, vA[0][0], vA[0][1]); PG8_STAGE_A(PG8_SA(0, 1), cA, vA[1][0], vA[1][1]);
    if (wr == 1) PG8_BAR;
    PG8_WAIT_V(2); PG8_BAR;
    PG8_STAGE_B(PG8_SB(1, 0), cB + kstep); PG8_STAGE_A(PG8_SA(1, 0), cA + kstep, vA[0][0], vA[0][1]); PG8_STAGE_B(PG8_SB(1, 1), cB + hstepB + kstep);
    PG8_WAIT_V(6); PG8_BAR;
    for (;;) {
        const bool has_next = S.next(ui + 1, nxt);
        const GAS char* nA = has_next ? nxt.A : cA; const GAS char* nB = has_next ? nxt.B : cB;
#pragma unroll 1
        for (int t = 0; t < nt; t += 2) {
            const bool last = (t == nt - 2);
            const GAS char* a1 = cA + (size_t)(t + 1) * kstep;
            const GAS char* a2 = last ? nA : cA + (size_t)(t + 2) * kstep; const GAS char* b2 = last ? nB : cB + (size_t)(t + 2) * kstep;
            const GAS char* a3 = a2 + kstep; const GAS char* b3 = b2 + kstep;
            if constexpr (GATHER) { if (last && has_next) { PG8_LOADROWS(vAn, nxt); } }
            PG8_LDB(B0, 0, 0); PG8_LDB(B1, 0, 1); PG8_SCHED; PG8_LDA(At, 0, 0); PG8_STAGE_A(PG8_SA(1, 1), a1, vA[1][0], vA[1][1]);
            PG8_WAIT_V(8); PG8_WAIT_L(0); PG8_BAR; PG8_MMA(0, 0, At, B0); PG8_MMA(0, 1, At, B1); PG8_BAR; PG8_SCHED;
            PG8_LDA(At, 0, 1); PG8_STAGE_B(PG8_SB(0, 0), b2); PG8_STAGE_B(PG8_SB(0, 1), b2 + hstepB); PG8_STAGE_A(PG8_SA(0, 0), a2, PG8_VAN(0, 0), PG8_VAN(0, 1));
            PG8_WAIT_V(8); PG8_WAIT_L(0); PG8_BAR; PG8_MMA(1, 0, At, B0); PG8_MMA(1, 1, At, B1); PG8_BAR; PG8_SCHED;
            PG8_LDB(B0, 1, 0); PG8_LDB(B1, 1, 1); PG8_SCHED; PG8_LDA(At, 1, 0); PG8_STAGE_A(PG8_SA(0, 1), a2, PG8_VAN(1, 0), PG8_VAN(1, 1));
            PG8_WAIT_V(8); PG8_WAIT_L(0); PG8_BAR; PG8_MMA(0, 0, At, B0); PG8_MMA(0, 1, At, B1); PG8_BAR; PG8_SCHED;
            PG8_LDA(At, 1, 1); PG8_STAGE_B(PG8_SB(1, 0), b3); PG8_STAGE_B(PG8_SB(1, 1), b3 + hstepB); PG8_STAGE_A(PG8_SA(1, 0), a3, PG8_VAN(0, 0), PG8_VAN(0, 1));
            PG8_WAIT_V(8); PG8_WAIT_L(0); PG8_BAR; PG8_MMA(1, 0, At, B0); PG8_MMA(1, 1, At, B1); PG8_BAR; PG8_SCHED;
        }
        if (wr == 0) PG8_BAR;
        if constexpr (FP8) asm volatile("s_nop 15\n\ts_nop 15" ::: "memory");
        E(acc, cur, wr, wc, fr, fq);
        if (!has_next) break;
#pragma unroll
        for (int a = 0; a < 2; ++a)
#pragma unroll
            for (int b = 0; b < 2; ++b)
#pragma unroll
                for (int m = 0; m < 4; ++m)
#pragma unroll
                    for (int n = 0; n < 2; ++n) acc[a][b][m][n] = (f32x4){0.f, 0.f, 0.f, 0.f};
        cur = nxt; cA = nA; cB = nB; ++ui;
        if constexpr (GATHER) { vA[0][0] = vAn[0][0]; vA[0][1] = vAn[0][1]; vA[1][0] = vAn[1][0]; vA[1][1] = vAn[1][1]; }
        if (wr == 1) PG8_BAR;
    }
    PG8_WAIT_V(0);
    PG8_BAR;
#undef PG8_SA
#undef PG8_SB
#undef PG8_STAGE_A
#undef PG8_STAGE_B
#undef PG8_LDA
#undef PG8_LD32
#undef PG8_LDB
#undef PG8_MMA
#undef PG8_WAIT_V
#undef PG8_WAIT_L
#undef PG8_BAR
#undef PG8_SCHED
#undef PG8_LOADROWS
#undef PG8_VAN
}
}

struct SchedPlain {
    __device__ __forceinline__ int scale_b8() const { return 0x7f7f7f7f; }
    __device__ __forceinline__ int scale_a8() const { return 0x7f7f7f7f; }
    __device__ __forceinline__ int brow(int r) const { return r; }
    const GAS char* A; const GAS char* B; size_t a_tile, b_tile; int nM, nN, G, c;
    __device__ __forceinline__ bool next(int i, pg8::Unit& u) const {
        int pm, pn; if (!pg8::tile_of((long)i * G + c, nM, nN, pm, pn)) return false;
        u.pm = pm; u.pn = pn; u.z = 0; u.rows = nullptr; u.A = A + (size_t)pm * a_tile; u.B = B + (size_t)pn * b_tile; return true; }
};
struct SchedPc {
    __device__ __forceinline__ int scale_b8() const { return 0x7f7f7f7f; }
    __device__ __forceinline__ int scale_a8() const { return 0x7f7f7f7f; }
    __device__ __forceinline__ int brow(int r) const { return r; }
    const GAS char* Q; const GAS char* Kk; int G, c;
    __device__ __forceinline__ bool next(int i, pg8::Unit& u) const {
        const int L = i * G + c; if (L >= NB * NH * 16) return false;
        const int cp = L & 15, h = (L >> 4) & 3, b = L >> 6;
        const size_t off = ((size_t)(b * SEQ + cp * 256) * QKW + h * DK) * 2;
        u.pm = L; u.pn = 0; u.z = h; u.rows = nullptr; u.A = Q + off; u.B = Kk + off; return true; }
};
struct SchedFnA {
    __device__ __forceinline__ int scale_b8() const { return 0x7f7f7f7f; }
    __device__ __forceinline__ int scale_a8() const { return 0x7f7f7f7f; }
    __device__ __forceinline__ int brow(int r) const { return r; }
    const GAS char* Wc; const GAS char* Hn; int G, c;
    __device__ __forceinline__ bool next(int i, pg8::Unit& u) const {
        int pm, pn; if (!pg8::tile_of((long)i * G + c, 8, T / 256, pm, pn)) return false;
        const int g = pm >> 1, ri = pm & 1;
        u.pm = pm; u.pn = pn; u.z = 0; u.rows = nullptr; u.A = Wc + (size_t)ri * 256 * 256 * 2; u.B = Hn + ((size_t)pn * 256 * D + g * 256) * 2; return true; }
};
struct SchedFnB {
    __device__ __forceinline__ int scale_b8() const { return 0x7f7f7f7f; }
    __device__ __forceinline__ int scale_a8() const { return 0x7f7f7f7f; }
    __device__ __forceinline__ int brow(int r) const { return (r & 63) * 8 + (r >> 6); }
    GAS const char* WY; GAS const char* U; int G, c;
    __device__ __forceinline__ bool next(int i, pg8::Unit& u) const {
        int pm, pn; if (!pg8::tile_of((long)i * G + c, 2, 256, pm, pn)) return false;
        const int batch = pn >> 5, fb = (pn >> 1) & 15, kbb = pn & 1;
        u.pm = pm; u.pn = pn; u.z = 0; u.rows = nullptr; u.A = WY + (size_t)pm * 256 * 1024 * 2; u.B = U + ((size_t)(batch * 1024 + fb * 64) * 8 + kbb * 4) * 1024 * 2; return true; }
};
struct SchedMoe {
    __device__ __forceinline__ int scale_b8() const { return 0x79797979; }
    __device__ __forceinline__ int scale_a8() const { return sa8; }
    __device__ __forceinline__ int brow(int r) const { return r; }
    const GAS char* A; const GAS char* W; const GAS int* rowtok; const LAS unsigned char* texp; size_t a_tile, w_exp, w_tile; int ntiles, ncol, G, c; bool gather; int sa8;
    __device__ __forceinline__ bool next(int i, pg8::Unit& u) const {
        int rt, ct; if (!pg8::tile_of((long)i * G + c, ntiles, ncol, rt, ct)) return false;
        const int e = texp[rt];
        u.pm = rt; u.pn = ct; u.z = e; u.rows = rowtok + rt * 256; u.A = gather ? A : A + (size_t)rt * a_tile; u.B = W + (size_t)e * w_exp + (size_t)ct * w_tile; return true; }
};

struct EpiRopeQK {
    static constexpr bool PERM = true;
    GAS bf16* Q; GAS bf16* Kk; const GAS f32x2* rot;
    __device__ __forceinline__ void operator()(const f32x4 (&acc)[2][2][4][2], const pg8::Unit& u, int wr, int wc, int fr, int fq) const {
        const bool isk = u.pn >= 4; const int h = u.pn & 3; GAS bf16* dst = isk ? Kk : Q; const float sc = isk ? 0.0625f : 1.0f;
        const int i0 = wc * 32 + 8 * fq;
#pragma unroll
        for (int ai = 0; ai < 2; ++ai)
#pragma unroll
            for (int m = 0; m < 4; ++m) {
                const int t = u.pm * 256 + ai * 128 + wr * 64 + m * 16 + fr, s = t & (SEQ - 1);
                const GAS f32x4* rp = (const GAS f32x4*)(rot + (size_t)s * 128 + i0);
                const f32x4 r0 = rp[0], r1 = rp[1], r2 = rp[2], r3 = rp[3];
                const float cs[8] = {r0[0], r0[2], r1[0], r1[2], r2[0], r2[2], r3[0], r3[2]}, sn[8] = {r0[1], r0[3], r1[1], r1[3], r2[1], r2[3], r3[1], r3[3]};
                float o1[8], o2[8];
#pragma unroll
                for (int n = 0; n < 2; ++n)
#pragma unroll
                    for (int j = 0; j < 4; ++j) { const float t1 = acc[ai][0][m][n][j], t2 = acc[ai][1][m][n][j]; const int q = 4 * n + j;
                        o1[q] = (t1 * cs[q] - t2 * sn[q]) * sc; o2[q] = (t1 * sn[q] + t2 * cs[q]) * sc; }
                GAS bf16* rowp = dst + (size_t)t * QKW + h * DK + i0;
                u32x4 w1, w2; w1.x = cvt_pk_bf16(o1[0], o1[1]); w1.y = cvt_pk_bf16(o1[2], o1[3]); w1.z = cvt_pk_bf16(o1[4], o1[5]); w1.w = cvt_pk_bf16(o1[6], o1[7]);
                w2.x = cvt_pk_bf16(o2[0], o2[1]); w2.y = cvt_pk_bf16(o2[2], o2[3]); w2.z = cvt_pk_bf16(o2[4], o2[5]); w2.w = cvt_pk_bf16(o2[6], o2[7]);
                *(GAS u32x4*)rowp = w1; *(GAS u32x4*)(rowp + 128) = w2; }
    }
};
struct EpiRopeKT {
    static constexpr bool PERM = true;
    GAS bf16* KT; const GAS f32x2* rotT; const LAS float* l2g;
    __device__ __forceinline__ void operator()(const f32x4 (&acc)[2][2][4][2], const pg8::Unit& u, int wr, int wc, int fr, int fq) const {
        const int h = u.pm; const float l2f = l2g[h], l2b = l2g[4 + h];
#pragma unroll
        for (int bj = 0; bj < 2; ++bj) {
            const int tok0 = u.pn * 256 + bj * 128 + wc * 32 + 8 * fq, s0 = tok0 & (SEQ - 1), j0 = tok0 & (CH - 1);
            float zf[8], zb[8];
#pragma unroll
            for (int q = 0; q < 8; ++q) { zf[q] = fast_exp2((float)(CH - 1 - (j0 + q)) * l2f) * 0.0625f; zb[q] = fast_exp2((float)(j0 + q) * l2b) * 0.0625f; }
#pragma unroll
            for (int m = 0; m < 4; ++m) { const int i = wr * 64 + m * 16 + fr;
                const GAS f32x4* rp = (const GAS f32x4*)(rotT + (size_t)i * RTP + s0);
                const f32x4 r0 = rp[0], r1 = rp[1], r2 = rp[2], r3 = rp[3];
                const float cs[8] = {r0[0], r0[2], r1[0], r1[2], r2[0], r2[2], r3[0], r3[2]}, sn[8] = {r0[1], r0[3], r1[1], r1[3], r2[1], r2[3], r3[1], r3[3]};
                float o1[8], o2[8];
#pragma unroll
                for (int n = 0; n < 2; ++n)
#pragma unroll
                    for (int j = 0; j < 4; ++j) { const float t1 = acc[0][bj][m][n][j], t2 = acc[1][bj][m][n][j]; const int q = 4 * n + j;
                        o1[q] = t1 * cs[q] - t2 * sn[q]; o2[q] = t1 * sn[q] + t2 * cs[q]; }
                u32x4 w1, w2;
                w1.x = cvt_pk_bf16(o1[0] * zf[0], o1[1] * zf[1]); w1.y = cvt_pk_bf16(o1[2] * zf[2], o1[3] * zf[3]); w1.z = cvt_pk_bf16(o1[4] * zf[4], o1[5] * zf[5]); w1.w = cvt_pk_bf16(o1[6] * zf[6], o1[7] * zf[7]);
                w2.x = cvt_pk_bf16(o2[0] * zf[0], o2[1] * zf[1]); w2.y = cvt_pk_bf16(o2[2] * zf[2], o2[3] * zf[3]); w2.z = cvt_pk_bf16(o2[4] * zf[4], o2[5] * zf[5]); w2.w = cvt_pk_bf16(o2[6] * zf[6], o2[7] * zf[7]);
                const size_t fr0 = ((((size_t)((tok0 >> 12) * NH + h) * NCH + ((tok0 & (SEQ - 1)) >> 7)) * 8 + (i >> 5)) * 8 + (2 * wc + (fq >> 1))) * 512 + ((i & 31) + 32 * (fq & 1)) * 8;
                *(GAS u32x4*)(KT + fr0) = w1; *(GAS u32x4*)(KT + fr0 + (size_t)4 * 8 * 512) = w2;
                w1.x = cvt_pk_bf16(o1[0] * zb[0], o1[1] * zb[1]); w1.y = cvt_pk_bf16(o1[2] * zb[2], o1[3] * zb[3]); w1.z = cvt_pk_bf16(o1[4] * zb[4], o1[5] * zb[5]); w1.w = cvt_pk_bf16(o1[6] * zb[6], o1[7] * zb[7]);
                w2.x = cvt_pk_bf16(o2[0] * zb[0], o2[1] * zb[1]); w2.y = cvt_pk_bf16(o2[2] * zb[2], o2[3] * zb[3]); w2.z = cvt_pk_bf16(o2[4] * zb[4], o2[5] * zb[5]); w2.w = cvt_pk_bf16(o2[6] * zb[6], o2[7] * zb[7]);
                *(GAS u32x4*)(KT + (size_t)QKW * T + fr0) = w1; *(GAS u32x4*)(KT + (size_t)QKW * T + fr0 + (size_t)4 * 8 * 512) = w2; } }
    }
};
template <bool ROT> struct EpiBf16 {
    static constexpr bool PERM = true;
    GAS bf16* O; int ldc;
    __device__ __forceinline__ void operator()(const f32x4 (&acc)[2][2][4][2], const pg8::Unit& u, int wr, int wc, int fr, int fq) const {
#pragma unroll
        for (int ai = 0; ai < 2; ++ai)
#pragma unroll
            for (int m = 0; m < 4; ++m) { const int row = u.pm * 256 + ai * 128 + wr * 64 + m * 16 + fr; GAS bf16* rowp = O + (size_t)row * ldc;
#pragma unroll
                for (int bj = 0; bj < 2; ++bj) { const f32x4 v0 = acc[ai][bj][m][0], v1 = acc[ai][bj][m][1]; const int col = u.pn * 256 + bj * 128 + wc * 32 + 8 * fq;
                    u32x4 w; w.x = cvt_pk_bf16(v0[0], v0[1]); w.y = cvt_pk_bf16(v0[2], v0[3]); w.z = cvt_pk_bf16(v1[0], v1[1]); w.w = cvt_pk_bf16(v1[2], v1[3]);
                    *(GAS u32x4*)(rowp + (ROT ? rot_col(row, col) : col)) = w; } }
    }
};
struct EpiPc {
    static constexpr bool PERM = true;
    GAS bf16* PC; GAS bf16* PD; const LAS float* l2g;
    __device__ __forceinline__ void operator()(const f32x4 (&acc)[2][2][4][2], const pg8::Unit& u, int wr, int wc, int fr, int fq) const {
        const int h = u.z; const float l2f = l2g[h], l2b = l2g[4 + h];
#pragma unroll
        for (int ai = 0; ai < 2; ++ai)
#pragma unroll
            for (int m = 0; m < 4; ++m) { const int il = wr * 64 + m * 16 + fr, jl0 = wc * 32 + 8 * fq; float o[8];
                const bool diag = (wc == 2 * wr + (m >> 1));
#pragma unroll
                for (int n = 0; n < 2; ++n)
#pragma unroll
                    for (int j = 0; j < 4; ++j) { const int dl = il - (jl0 + 4 * n + j); const float f = dl >= 0 ? fast_exp2((float)dl * l2f) : fast_exp2((float)(-dl) * l2b);
                        o[4 * n + j] = (ai == 0 ? acc[0][0][m][n][j] : acc[1][1][m][n][j]) * f; }
                if (diag) {
                    float ob[8];
#pragma unroll
                    for (int q = 0; q < 8; ++q) { const bool lower = (jl0 + q) <= il; ob[q] = lower ? 0.f : o[q]; o[q] = lower ? o[q] : 0.f; }
                    u32x4 wb; wb.x = cvt_pk_bf16(ob[0], ob[1]); wb.y = cvt_pk_bf16(ob[2], ob[3]); wb.z = cvt_pk_bf16(ob[4], ob[5]); wb.w = cvt_pk_bf16(ob[6], ob[7]);
                    *(GAS u32x4*)(PD + ((((size_t)(u.pm * 2 + ai) * 4 + (il >> 5)) * 2 + (fq >> 1)) * 512 + ((il & 31) + 32 * (fq & 1)) * 8)) = wb;
                }
                u32x4 w; w.x = cvt_pk_bf16(o[0], o[1]); w.y = cvt_pk_bf16(o[2], o[3]); w.z = cvt_pk_bf16(o[4], o[5]); w.w = cvt_pk_bf16(o[6], o[7]);
                *(GAS u32x4*)(PC + ((((size_t)(u.pm * 2 + ai) * 4 + (il >> 5)) * 8 + (2 * wc + (fq >> 1))) * 512 + ((il & 31) + 32 * (fq & 1)) * 8)) = w; }
    }
};
struct EpiGate {
    static constexpr bool PERM = true;
    const GAS bf16* Y; GAS bf16* YG; const GAS f32x2* statp; const GAS float* gain; LAS f32x2* sst;
    __device__ __forceinline__ void operator()(const f32x4 (&acc)[2][2][4][2], const pg8::Unit& u, int wr, int wc, int fr, int fq) const {
        const int head = u.pn >> 1, c0 = u.pn * 256 + wc * 32 + 8 * fq;
        const int tid = (wr * 4 + wc) * 64 + fq * 16 + fr;
        if (tid < 256) { const int t = u.pm * 256 + tid; const GAS f32x4* sp = (const GAS f32x4*)(statp + ((size_t)t * 4 + head) * 8); float a1 = 0.f, a2 = 0.f;
#pragma unroll
            for (int k = 0; k < 4; ++k) { const f32x4 v = sp[k]; a1 += v[0] + v[2]; a2 += v[1] + v[3]; }
            const float mu = a1 * (1.f / DV), var = fmaxf(a2 * (1.f / DV) - mu * mu, 0.f); sst[tid] = (f32x2){mu, __builtin_amdgcn_rsqf(var + EPS)}; }
        asm volatile("s_waitcnt lgkmcnt(0)" ::: "memory"); __builtin_amdgcn_s_barrier(); asm volatile("" ::: "memory");
        f32x4 gv[2][2];
#pragma unroll
        for (int bj = 0; bj < 2; ++bj) { gv[bj][0] = *(const GAS f32x4*)(gain + c0 + bj * 128); gv[bj][1] = *(const GAS f32x4*)(gain + c0 + bj * 128 + 4); }
#pragma unroll
        for (int ai = 0; ai < 2; ++ai)
#pragma unroll
            for (int m = 0; m < 4; ++m) { const int rl = ai * 128 + wr * 64 + m * 16 + fr, t = u.pm * 256 + rl; const f32x2 st = sst[rl];
#pragma unroll
                for (int bj = 0; bj < 2; ++bj) { const size_t off = (size_t)t * VW + c0 + bj * 128;
                    const int es_ = (u.pn & 1) * 4 + bj * 2 + (wc >> 1);
                    const u32x4 yv = *(const GAS u32x4*)(Y + (((size_t)(t >> 5) * NH + head) * 8 + es_) * 2048 + (((wc & 1) * 2 + (fq >> 1)) * 64 + (t & 31) + 32 * (fq & 1)) * 8);
                    const float y[8] = {bf_lo(yv.x), bf_hi(yv.x), bf_lo(yv.y), bf_hi(yv.y), bf_lo(yv.z), bf_hi(yv.z), bf_lo(yv.w), bf_hi(yv.w)}; float o[8];
#pragma unroll
                    for (int n = 0; n < 2; ++n)
#pragma unroll
                        for (int j = 0; j < 4; ++j) { const int q = 4 * n + j; const float yn = (y[q] - st.x) * st.y * gv[bj][n][j]; o[q] = silu_f(acc[ai][bj][m][n][j]) * yn; }
                    u32x4 w; w.x = cvt_pk_bf16(o[0], o[1]); w.y = cvt_pk_bf16(o[2], o[3]); w.z = cvt_pk_bf16(o[4], o[5]); w.w = cvt_pk_bf16(o[6], o[7]);
                    *(GAS u32x4*)(YG + off) = w; } }
    }
};
template <bool BASE_F32> struct EpiRes {
    static constexpr bool PERM = true;
    const GAS void* base; GAS bf16* out;
    __device__ __forceinline__ void operator()(const f32x4 (&acc)[2][2][4][2], const pg8::Unit& u, int wr, int wc, int fr, int fq) const {
#pragma unroll
        for (int ai = 0; ai < 2; ++ai)
#pragma unroll
            for (int m = 0; m < 4; ++m) { const size_t off = (size_t)(u.pm * 256 + ai * 128 + wr * 64 + m * 16 + fr) * D + u.pn * 256 + wc * 32 + 8 * fq;
#pragma unroll
                for (int bj = 0; bj < 2; ++bj) { f32x4 v0 = acc[ai][bj][m][0], v1 = acc[ai][bj][m][1];
                    if (BASE_F32) { const GAS float* bp = (const GAS float*)base + off + bj * 128; v0 += *(const GAS f32x4*)bp; v1 += *(const GAS f32x4*)(bp + 4); }
                    else { const u32x4 bv = *(const GAS u32x4*)((const GAS bf16*)base + off + bj * 128);
                        v0 += (f32x4){bf_lo(bv.x), bf_hi(bv.x), bf_lo(bv.y), bf_hi(bv.y)}; v1 += (f32x4){bf_lo(bv.z), bf_hi(bv.z), bf_lo(bv.w), bf_hi(bv.w)}; }
                    u32x4 w; w.x = cvt_pk_bf16(v0[0], v0[1]); w.y = cvt_pk_bf16(v0[2], v0[3]); w.z = cvt_pk_bf16(v1[0], v1[1]); w.w = cvt_pk_bf16(v1[2], v1[3]);
                    *(GAS u32x4*)(out + off + bj * 128) = w; } }
    }
};
template <bool OUT8> struct EpiSwiGLU {
    static constexpr bool PERM = true;
    GAS void* ACT; int ldc;
    __device__ __forceinline__ void operator()(const f32x4 (&acc)[2][2][4][2], const pg8::Unit& u, int wr, int wc, int fr, int fq) const {
#pragma unroll
        for (int ai = 0; ai < 2; ++ai)
#pragma unroll
            for (int m = 0; m < 4; ++m) { float o[8];
#pragma unroll
                for (int n = 0; n < 2; ++n)
#pragma unroll
                    for (int j = 0; j < 4; ++j) o[4 * n + j] = silu_f(acc[ai][0][m][n][j]) * acc[ai][1][m][n][j];
                const size_t off = (size_t)(u.pm * 256 + ai * 128 + wr * 64 + m * 16 + fr) * ldc + u.pn * 128 + wc * 32 + 8 * fq;
                if constexpr (OUT8) { u32x2 w; w.x = pk4_fp8(o[0] * 8.f, o[1] * 8.f, o[2] * 8.f, o[3] * 8.f); w.y = pk4_fp8(o[4] * 8.f, o[5] * 8.f, o[6] * 8.f, o[7] * 8.f); *(GAS u32x2*)((GAS unsigned char*)ACT + off) = w; }
                else { u32x4 w; w.x = cvt_pk_bf16(o[0], o[1]); w.y = cvt_pk_bf16(o[2], o[3]); w.z = cvt_pk_bf16(o[4], o[5]); w.w = cvt_pk_bf16(o[6], o[7]); *(GAS u32x4*)((GAS bf16*)ACT + off) = w; } }
    }
};
struct EpiZ2 {
    static constexpr bool PERM = true;
    GAS bf16* Z2;
    __device__ __forceinline__ void operator()(const f32x4 (&acc)[2][2][4][2], const pg8::Unit& u, int wr, int wc, int fr, int fq) const {
        const int g = u.pm >> 1, ri = u.pm & 1;
#pragma unroll
        for (int ai = 0; ai < 2; ++ai)
#pragma unroll
            for (int m = 0; m < 4; ++m) { const int cp = ai * 128 + wr * 64 + m * 16 + fr;
#pragma unroll
                for (int bj = 0; bj < 2; ++bj) { const int tok0 = u.pn * 256 + bj * 128 + wc * 32 + 8 * fq, b = tok0 >> 12, s0 = tok0 & (SEQ - 1);
                    const f32x4 v0 = acc[ai][bj][m][0], v1 = acc[ai][bj][m][1];
                    u32x4 w; w.x = cvt_pk_bf16(v0[0], v0[1]); w.y = cvt_pk_bf16(v0[2], v0[3]); w.z = cvt_pk_bf16(v1[0], v1[1]); w.w = cvt_pk_bf16(v1[2], v1[3]);
                    *(GAS u32x4*)(Z2 + ((size_t)(b * 1024 + g * 256 + cp) * 8192 + ri * SEQ + s0)) = w; } }
    }
};
struct EpiYf {
    static constexpr bool PERM = true;
    GAS bf16* YF;
    __device__ __forceinline__ void operator()(const f32x4 (&acc)[2][2][4][2], const pg8::Unit& u, int wr, int wc, int fr, int fq) const {
        const int batch = u.pn >> 5, fb = (u.pn >> 1) & 15, kbb = u.pn & 1;
#pragma unroll
        for (int ai = 0; ai < 2; ++ai)
#pragma unroll
            for (int m = 0; m < 4; ++m) { const int ka = u.pm * 256 + ai * 128 + wr * 64 + m * 16 + fr;
#pragma unroll
                for (int bj = 0; bj < 2; ++bj) { const int kb = kbb * 4 + 2 * bj + (wc >> 1), f = fb * 64 + 32 * (wc & 1) + 8 * fq;
                    const f32x4 v0 = acc[ai][bj][m][0], v1 = acc[ai][bj][m][1];
                    u32x4 w; w.x = cvt_pk_bf16(v0[0], v0[1]); w.y = cvt_pk_bf16(v0[2], v0[3]); w.z = cvt_pk_bf16(v1[0], v1[1]); w.w = cvt_pk_bf16(v1[2], v1[3]);
                    *(GAS u32x4*)(YF + (size_t)(batch * SEQ + 8 * ka + kb) * D + f) = w; } }
    }
};
struct EpiMoeDown {
    static constexpr bool PERM = true;
    GAS bf16* Hres; const GAS int* rowtok; const GAS float* rowgate;
    __device__ __forceinline__ void operator()(const f32x4 (&acc)[2][2][4][2], const pg8::Unit& u, int wr, int wc, int fr, int fq) const {
#pragma unroll
        for (int ai = 0; ai < 2; ++ai)
#pragma unroll
            for (int m = 0; m < 4; ++m) { const int row = u.pm * 256 + ai * 128 + wr * 64 + m * 16 + fr; const int tok = rowtok[row]; const float gw = rowgate[row];
                if (tok >= 0) { GAS bf16* rp = Hres + (size_t)tok * D + u.pn * 256 + wc * 32 + 8 * fq;
#pragma unroll
                    for (int bj = 0; bj < 2; ++bj) { const u32x4 bv = *(const GAS u32x4*)(rp + bj * 128);
                        const f32x4 v0 = (f32x4){bf_lo(bv.x), bf_hi(bv.x), bf_lo(bv.y), bf_hi(bv.y)} + gw * acc[ai][bj][m][0], v1 = (f32x4){bf_lo(bv.z), bf_hi(bv.z), bf_lo(bv.w), bf_hi(bv.w)} + gw * acc[ai][bj][m][1];
                        u32x4 w; w.x = cvt_pk_bf16(v0[0], v0[1]); w.y = cvt_pk_bf16(v0[2], v0[3]); w.z = cvt_pk_bf16(v1[0], v1[1]); w.w = cvt_pk_bf16(v1[2], v1[3]);
                        *(GAS u32x4*)(rp + bj * 128) = w; } } }
    }
};

#define XB_TMO      128
#define XB_XCNT(j)  (256  + 64 * (j))
#define XB_XSUB(j)  (1280 + 64 * (j))
#define XB_XGEN(j)  (2304 + 64 * (j))
#define XB_TOP      3328
#define XB_TOPGEN   3392
#define XCD_BAR_WORDS 3456
#define XB_SPIN_CAP (1u << 18)
__device__ __forceinline__ unsigned xb_ld(unsigned* p)              { return __hip_atomic_load(p, __ATOMIC_RELAXED, __HIP_MEMORY_SCOPE_AGENT); }
__device__ __forceinline__ unsigned xb_add(unsigned* p, unsigned v) { return __hip_atomic_fetch_add(p, v, __ATOMIC_RELAXED, __HIP_MEMORY_SCOPE_AGENT); }
__device__ __forceinline__ unsigned xb_xcc_id() { return (unsigned)__builtin_amdgcn_s_getreg((3 << 11) | 20) & 0xFu; }
#define XB_SPIN(cond, bar) do { unsigned _sp = 0; while (cond) { __builtin_amdgcn_s_sleep(1); \
    if ((++_sp & 255u) == 0u) { if (xb_ld(&(bar)[XB_TMO])) break; if (_sp > XB_SPIN_CAP) { atomicAdd(&(bar)[XB_TMO], 1u); break; } } } } while (0)
struct XcdBarrier { unsigned* bar; unsigned x; volatile LAS unsigned* st; };
__device__ __forceinline__ XcdBarrier xcd_barrier_post(unsigned* bar, volatile LAS unsigned* st, const bool t0) {
    XcdBarrier b; b.bar = bar; b.x = xb_xcc_id(); b.st = st;
    if (t0) (void)xb_add(&bar[XB_XCNT(b.x)], 1u);
    return b;
}
__device__ __forceinline__ void xcd_barrier_complete(unsigned* bar, unsigned x, unsigned& nloc, unsigned& nx) {
    const unsigned G = gridDim.x * gridDim.y * gridDim.z;
    unsigned sum, cnt, mine, sp = 0u;
    for (;;) {
        sum = 0u; cnt = 0u; mine = 0u;
#pragma unroll
        for (unsigned j = 0; j < 16; ++j) { const unsigned c = xb_ld(&bar[XB_XCNT(j)]); sum += c; cnt += (c > 0u) ? 1u : 0u; mine = (j == x) ? c : mine; }
        if (sum == G) break;
        __builtin_amdgcn_s_sleep(1);
        if ((++sp & 255u) == 0u) { if (xb_ld(&bar[XB_TMO])) break; if (sp > XB_SPIN_CAP) { atomicAdd(&bar[XB_TMO], 1u); break; } }
    }
    nloc = mine > 0u ? mine : 1u; nx = cnt > 0u ? cnt : 1u;
}
__device__ __forceinline__ void xcd_barrier(const XcdBarrier& b, const bool t0) {
    asm volatile("s_waitcnt vmcnt(0)" ::: "memory");
    __syncthreads();
    if (t0) {
        unsigned* bar = b.bar;
        __builtin_amdgcn_s_waitcnt(0);
        unsigned nloc = b.st[0], nx = b.st[1];
        if (nloc == 0u) { xcd_barrier_complete(bar, b.x, nloc, nx); b.st[0] = nloc; b.st[1] = nx; }
        const unsigned old = xb_add(&bar[XB_XSUB(b.x)], 1u);
        const unsigned gen = old / nloc;
        if (old + 1u == (gen + 1u) * nloc) {
            __builtin_amdgcn_fence(__ATOMIC_RELEASE, "agent");
            asm volatile("s_waitcnt vmcnt(0)" ::: "memory");
            const unsigned og = xb_add(&bar[XB_TOP], 1u);
            const unsigned tg = og / nx;
            if (og + 1u == (tg + 1u) * nx) xb_add(&bar[XB_TOPGEN], 1u);
            else XB_SPIN(xb_ld(&bar[XB_TOPGEN]) == tg, bar);
            __builtin_amdgcn_fence(__ATOMIC_ACQUIRE, "agent");
            xb_add(&bar[XB_XGEN(b.x)], 1u);
            asm volatile("s_waitcnt vmcnt(0)" ::: "memory");
        } else {
            XB_SPIN(xb_ld(&bar[XB_XGEN(b.x)]) == gen, bar);
            __builtin_amdgcn_fence(__ATOMIC_ACQUIRE, "agent");
            asm volatile("s_waitcnt vmcnt(0)" ::: "memory");
        }
    }
    __syncthreads();
}

__device__ __forceinline__ float wave_sum(float v) {
#pragma unroll
    for (int o = 1; o < 64; o <<= 1) v += __shfl_xor(v, o);
    return v;
}
__device__ __forceinline__ void transpose_item(const GAS float* W, int K, int N, GAS bf16* WT, int k0, int n0, int rbase, LAS float* scr, int lane) {
#pragma unroll 8
    for (int i = 0; i < 32; ++i) { const int kk = 2 * i + (lane >> 5); scr[kk * 33 + (lane & 31)] = W[(size_t)(k0 + kk) * N + n0 + (lane & 31)]; }
    LDS_WAIT(); asm volatile("" ::: "memory");
    const int c = lane & 7;
#pragma unroll
    for (int j = 0; j < 4; ++j) { const int n = (lane >> 3) + 8 * j; const LAS float* s = scr + (8 * c) * 33 + n;
        u32x4 o; o.x = cvt_pk_bf16(s[0 * 33], s[1 * 33]); o.y = cvt_pk_bf16(s[2 * 33], s[3 * 33]); o.z = cvt_pk_bf16(s[4 * 33], s[5 * 33]); o.w = cvt_pk_bf16(s[6 * 33], s[7 * 33]);
        *(GAS u32x4*)(WT + (size_t)(rbase + n) * K + k0 + 8 * c) = o; }
    LDS_WAIT(); asm volatile("" ::: "memory");
}
__device__ __forceinline__ void transpose_item8(const GAS float* W, int K, int N, GAS unsigned char* WT8, int k0, int n0, int rbase, float scale, LAS float* scr, int lane) {
#pragma unroll 8
    for (int i = 0; i < 32; ++i) { const int kk = 2 * i + (lane >> 5); scr[kk * 33 + (lane & 31)] = W[(size_t)(k0 + kk) * N + n0 + (lane & 31)]; }
    LDS_WAIT(); asm volatile("" ::: "memory");
    const int c = lane & 7;
#pragma unroll
    for (int j = 0; j < 4; ++j) { const int n = (lane >> 3) + 8 * j; const LAS float* sp = scr + (8 * c) * 33 + n;
        u32x2 o; o.x = pk4_fp8(sp[0 * 33] * scale, sp[1 * 33] * scale, sp[2 * 33] * scale, sp[3 * 33] * scale); o.y = pk4_fp8(sp[4 * 33] * scale, sp[5 * 33] * scale, sp[6 * 33] * scale, sp[7 * 33] * scale);
        *(GAS u32x2*)(WT8 + (size_t)(rbase + n) * K + k0 + 8 * c) = o; }
    LDS_WAIT(); asm volatile("" ::: "memory");
}
__device__ __forceinline__ void tr_gu8(const GAS float* Wg, const GAS float* Wu, int K, int N, GAS unsigned char* WT8, int it, LAS float* scr, int lane) {
    const int nblk = N / 32, per = (K / 64) * nblk; const bool up = it >= per; if (up) it -= per;
    const int kb = it / nblk, nb = it - kb * nblk, f0 = 32 * nb;
    transpose_item8(up ? Wu : Wg, K, N, WT8, 64 * kb, f0, 256 * (f0 >> 7) + (up ? 128 : 0) + (f0 & 127), 64.0f, scr, lane);
}
__device__ __forceinline__ void tr_plain(const GAS float* W, int K, int N, GAS bf16* WT, int it, LAS float* scr, int lane) {
    const int nblk = N / 32, kb = it / nblk, nb = it - kb * nblk; transpose_item(W, K, N, WT, 64 * kb, 32 * nb, 32 * nb, scr, lane);
}
__device__ __forceinline__ void tr_gu(const GAS float* Wg, const GAS float* Wu, int K, int N, GAS bf16* WT, int it, LAS float* scr, int lane) {
    const int nblk = N / 32, per = (K / 64) * nblk; const bool up = it >= per; if (up) it -= per;
    const int kb = it / nblk, nb = it - kb * nblk, f0 = 32 * nb;
    transpose_item(up ? Wu : Wg, K, N, WT, 64 * kb, f0, 256 * (f0 >> 7) + (up ? 128 : 0) + (f0 & 127), scr, lane);
}
__device__ __forceinline__ void rms_row(const GAS float* xrow, const GAS float* g, GAS bf16* orow, int lane, f32x4 (&v)[4]) {
    const GAS f32x4* xr = (const GAS f32x4*)xrow + lane; const GAS f32x4* gr = (const GAS f32x4*)g + lane;
    float s = 0.f;
#pragma unroll
    for (int j = 0; j < 4; ++j) { v[j] = xr[64 * j]; s += (v[j].x * v[j].x + v[j].y * v[j].y) + (v[j].z * v[j].z + v[j].w * v[j].w); }
    const float r = 1.0f / sqrtf(wave_sum(s) * (1.f / D) + EPS);
    GAS u32x2* o8 = (GAS u32x2*)orow + lane;
#pragma unroll
    for (int j = 0; j < 4; ++j) { v[j] = v[j] * r * gr[64 * j]; u32x2 w; w.x = cvt_pk_bf16(v[j].x, v[j].y); w.y = cvt_pk_bf16(v[j].z, v[j].w); o8[64 * j] = w; }
}
__device__ __forceinline__ int rmsb_col(int j, int lane) { return 512 * (j >> 1) + 8 * lane + 4 * (j & 1); }
__device__ __forceinline__ void rms_row_b(const GAS bf16* hrow, const GAS float* g, GAS bf16* orow, int lane, f32x4 (&v)[4]) {
    float s = 0.f;
#pragma unroll
    for (int jh = 0; jh < 2; ++jh) { const u32x4 x = *(const GAS u32x4*)(hrow + 512 * jh + 8 * lane);
        v[2 * jh] = (f32x4){bf_lo(x.x), bf_hi(x.x), bf_lo(x.y), bf_hi(x.y)}; v[2 * jh + 1] = (f32x4){bf_lo(x.z), bf_hi(x.z), bf_lo(x.w), bf_hi(x.w)}; }
#pragma unroll
    for (int j = 0; j < 4; ++j) s += (v[j].x * v[j].x + v[j].y * v[j].y) + (v[j].z * v[j].z + v[j].w * v[j].w);
    const float r = 1.0f / sqrtf(wave_sum(s) * (1.f / D) + EPS);
#pragma unroll
    for (int jh = 0; jh < 2; ++jh) { const GAS float* gp = g + 512 * jh + 8 * lane; v[2 * jh] = v[2 * jh] * r * *(const GAS f32x4*)gp; v[2 * jh + 1] = v[2 * jh + 1] * r * *(const GAS f32x4*)(gp + 4);
        u32x4 w; w.x = cvt_pk_bf16(v[2 * jh].x, v[2 * jh].y); w.y = cvt_pk_bf16(v[2 * jh].z, v[2 * jh].w); w.z = cvt_pk_bf16(v[2 * jh + 1].x, v[2 * jh + 1].y); w.w = cvt_pk_bf16(v[2 * jh + 1].z, v[2 * jh + 1].w);
        *(GAS u32x4*)(orow + 512 * jh + 8 * lane) = w; }
}

__device__ __forceinline__ void rms_row_b8(const GAS bf16* hrow, const GAS float* g, GAS unsigned char* o8, int lane, f32x4 (&v)[4]) {
    float s = 0.f;
#pragma unroll
    for (int jh = 0; jh < 2; ++jh) { const u32x4 x = *(const GAS u32x4*)(hrow + 512 * jh + 8 * lane);
        v[2 * jh] = (f32x4){bf_lo(x.x), bf_hi(x.x), bf_lo(x.y), bf_hi(x.y)}; v[2 * jh + 1] = (f32x4){bf_lo(x.z), bf_hi(x.z), bf_lo(x.w), bf_hi(x.w)}; }
#pragma unroll
    for (int j = 0; j < 4; ++j) s += (v[j].x * v[j].x + v[j].y * v[j].y) + (v[j].z * v[j].z + v[j].w * v[j].w);
    const float r = 1.0f / sqrtf(wave_sum(s) * (1.f / D) + EPS);
#pragma unroll
    for (int jh = 0; jh < 2; ++jh) { const GAS float* gp = g + 512 * jh + 8 * lane; v[2 * jh] = v[2 * jh] * r * *(const GAS f32x4*)gp; v[2 * jh + 1] = v[2 * jh + 1] * r * *(const GAS f32x4*)(gp + 4);
        u32x2 w; w.x = pk4_fp8(v[2 * jh].x, v[2 * jh].y, v[2 * jh].z, v[2 * jh].w); w.y = pk4_fp8(v[2 * jh + 1].x, v[2 * jh + 1].y, v[2 * jh + 1].z, v[2 * jh + 1].w);
        *(GAS u32x2*)(o8 + 512 * jh + 8 * lane) = w; }
}

constexpr int SW_QL = 0, SW_SPITCH = 528, SW_SL = 128 * 528, SW_VPITCH = 272, SW_VL = SW_SL + 64 * SW_SPITCH, SW_VB = 64 * SW_VPITCH;
static_assert(SW_VL + 2 * SW_VB <= 139264, "sweep LDS");
template <bool OUT> __device__ __forceinline__ void sweep_role(LAS unsigned char* lds, const GAS bf16* Qg, const GAS bf16* KTFg, const GAS bf16* KTBg, const GAS bf16* VTg, const GAS bf16* PCg, const GAS bf16* PDg, const GAS bf16* ZEROg, GAS bf16* Yg, GAS f32x2* statp, const float l2f, const float l2b, int b, int h, int es, const int wave_s) {
    const int tid = tid_of(wave_s);
    const int w = __builtin_amdgcn_readfirstlane(tid >> 6), lane = tid & 63, r32 = lane & 31, hh = lane >> 5;
    const int rb = w & 3;
    const int vrow = tid >> 4, vpc = tid & 15;
    const int qrow = tid >> 5, qpc = tid & 31;
    const GAS bf16* qp = Qg + (size_t)(b * SEQ + qrow) * QKW + h * DK + 8 * qpc;
    const GAS bf16* vtp = VTg + (size_t)(h * DV + 64 * es + vrow) * T + 8 * vpc; const int vrot = b * SEQ + ((vrow & 15) << 11);
    const int il = 32 * rb + r32;
    const GAS bf16* pcp = PCg + (((size_t)((b * NH + h) * NCH) * 4 + rb) * 8) * 512 + lane * 8;
    const GAS bf16* pdp = PDg + (((size_t)((b * NH + h) * NCH) * 4 + rb) * 2) * 512 + lane * 8;
    GAS bf16* yp = Yg + ((size_t)(((b * SEQ) >> 5) + rb) * NH + h) * 8 * 2048 + (size_t)es * 2048 + lane * 8;
    GAS f32x2* stp = statp + ((size_t)(b * SEQ + il) * NH + h) * 8 + es;
    const size_t kto = ((size_t)((b * NH + h) * NCH) * 8 + 2 * rb) * 8 * 512 + lane * 8;
#define SW_LDP(dst, s_, d_, nn_) do { const int jb_ = (s_) >> 1; const bool use_ = (d_) ? (jb_ >= rb) : (jb_ <= rb); const bool dg_ = (d_) && (jb_ == rb); \
        const GAS bf16* src_ = dg_ ? (pdp + (size_t)(nn_) * 4096 + 512 * ((s_) & 1)) : (pcp + (size_t)(nn_) * (CH * CH) + 512 * (s_)); \
        dst = *(const GAS bf16x8*)(use_ ? src_ : ZEROg); } while (0)
#define SW_SCHED __builtin_amdgcn_sched_barrier(0)
#define SW_MFMA(a, b, c) c = __builtin_amdgcn_mfma_f32_32x32x16_bf16(a, b, c, 0, 0, 0)
    bf16x8 pa[8];
    bf16x8 ka[2][8];
    u32x4 vv[2], qv[4];
    f32x16 Sacc[2][2];
    if constexpr (OUT) {
#pragma unroll
        for (int s = 0; s < 8; ++s) SW_LDP(pa[s], s, 0, 0);
    } else {
#pragma unroll
        for (int db = 0; db < 2; ++db)
#pragma unroll
            for (int s = 0; s < 8; ++s) ka[db][s] = *(const GAS bf16x8*)(KTFg + kto + db * 4096 + s * 512);
#pragma unroll
        for (int db = 0; db < 2; ++db)
#pragma unroll
            for (int et = 0; et < 2; ++et)
#pragma unroll
                for (int t = 0; t < 16; ++t) Sacc[db][et][t] = 0.f;
    }
#pragma unroll
    for (int it = 0; it < 2; ++it) vv[it] = *(const GAS u32x4*)(vtp + (size_t)(32 * it) * T + (vrot & (T - 1)));
#pragma unroll
    for (int it = 0; it < 2; ++it) *(LAS u32x4*)(lds + SW_VL + (vrow + 32 * it) * SW_VPITCH + vpc * 16) = vv[it];
#pragma unroll
    for (int hf = 0; hf < 2; ++hf) {
#pragma unroll
        for (int it = 0; it < 4; ++it) qv[it] = *(const GAS u32x4*)(qp + (size_t)(16 * (4 * hf + it)) * QKW);
#pragma unroll
        for (int it = 0; it < 4; ++it) { const int row = qrow + 16 * (4 * hf + it); *(LAS u32x4*)(lds + SW_QL + row * SW_SPITCH + qpc * 16) = qv[it]; }
    }
    const int sl_rd = SW_SL + r32 * SW_SPITCH + 16 * hh;
    const int q_rd = SW_QL + il * SW_SPITCH + 16 * hh;
#pragma unroll 1
    for (int p = 0; p < 2 * NCH; ++p) {
        const int dir = p >> 5, st = p & 31, n = dir ? NCH - 1 - st : st;
        const int pn = p + 1 < 2 * NCH ? p + 1 : p, dirn = pn >> 5, stn = pn & 31, nn = dirn ? NCH - 1 - stn : stn;
        const int cur = p & 1;
        const float l2 = dir ? l2b : l2f;
        const int v_rd = SW_VL + cur * SW_VB + r32 * SW_VPITCH + 16 * hh;
        if constexpr (!OUT) {
#pragma unroll
            for (int db = 0; db < 2; ++db)
#pragma unroll
                for (int et = 0; et < 2; ++et)
#pragma unroll
                    for (int g = 0; g < 4; ++g) { u32x2 pk; pk.x = cvt_pk_bf16(Sacc[db][et][4 * g], Sacc[db][et][4 * g + 1]); pk.y = cvt_pk_bf16(Sacc[db][et][4 * g + 2], Sacc[db][et][4 * g + 3]);
                        if (st == 0) { pk.x = 0u; pk.y = 0u; }
                        *(LAS u32x2*)(lds + SW_SL + (32 * et + r32) * SW_SPITCH + (64 * rb + 32 * db + 8 * g + 4 * hh) * 2) = pk; }
        }
#pragma unroll
        for (int it = 0; it < 2; ++it) vv[it] = *(const GAS u32x4*)(vtp + (size_t)(32 * it) * T + ((nn * CH + vrot) & (T - 1)));
#pragma unroll
        for (int it = 0; it < 4; ++it) qv[it] = *(const GAS u32x4*)(qp + (size_t)(nn * CH + 16 * it) * QKW);
        __syncthreads();
        f32x16 O[2];
        u32x4 yf[4];
        GAS bf16* ypn = yp + (size_t)(n * 4) * (NH * 8 * 2048);
        if constexpr (OUT) {
#pragma unroll
            for (int et = 0; et < 2; ++et)
#pragma unroll
                for (int t = 0; t < 16; ++t) O[et][t] = 0.f;
            bf16x8 qx[2], s0x[2], s1x[2], qy[2], s0y[2], s1y[2];
#define SW_LDC(dq, d0, d1, g2) do { _Pragma("unroll") for (int k = 0; k < 2; ++k) { const int ks = 2 * (g2) + k; dq[k] = *(const LAS bf16x8*)(lds + q_rd + 32 * ks); \
                d0[k] = *(const LAS bf16x8*)(lds + sl_rd + 32 * ks); d1[k] = *(const LAS bf16x8*)(lds + sl_rd + 32 * SW_SPITCH + 32 * ks); } } while (0)
#define SW_MMC(dq, d0, d1) do { SW_MFMA(d0[0], dq[0], O[0]); SW_MFMA(d1[0], dq[0], O[1]); SW_MFMA(d0[1], dq[1], O[0]); SW_MFMA(d1[1], dq[1], O[1]); } while (0)
            SW_LDC(qx, s0x, s1x, 0); SW_LDC(qy, s0y, s1y, 1); SW_SCHED;
            SW_MMC(qx, s0x, s1x); SW_SCHED; SW_LDC(qx, s0x, s1x, 2); SW_SCHED;
            SW_MMC(qy, s0y, s1y); SW_SCHED; SW_LDC(qy, s0y, s1y, 3); SW_SCHED;
            SW_MMC(qx, s0x, s1x); SW_SCHED; SW_LDC(qx, s0x, s1x, 4); SW_SCHED;
            SW_MMC(qy, s0y, s1y); SW_SCHED; SW_LDC(qy, s0y, s1y, 5); SW_SCHED;
            SW_MMC(qx, s0x, s1x); SW_SCHED; SW_LDC(qx, s0x, s1x, 6); SW_SCHED;
            SW_MMC(qy, s0y, s1y); SW_SCHED; SW_LDC(qy, s0y, s1y, 7); SW_SCHED;
            SW_MMC(qx, s0x, s1x); SW_SCHED;
            SW_MMC(qy, s0y, s1y); SW_SCHED;
#undef SW_LDC
#undef SW_MMC
        } else {
            const float gC = st == 0 ? 0.f : fast_exp2((float)CH * l2);
#pragma unroll
            for (int db = 0; db < 2; ++db)
#pragma unroll
                for (int et = 0; et < 2; ++et)
#pragma unroll
                    for (int t = 0; t < 16; ++t) Sacc[db][et][t] *= gC;
            bf16x8 v0x[2], v1x[2], v0y[2], v1y[2];
#define SW_LDU(d0, d1, g2) do { _Pragma("unroll") for (int k = 0; k < 2; ++k) { const int s_ = 2 * (g2) + k; d0[k] = *(const LAS bf16x8*)(lds + v_rd + 32 * s_); d1[k] = *(const LAS bf16x8*)(lds + v_rd + 32 * SW_VPITCH + 32 * s_); } } while (0)
#define SW_MMU(d0, d1, g2) do { _Pragma("unroll") for (int k = 0; k < 2; ++k) { const int s_ = 2 * (g2) + k; SW_MFMA(ka[0][s_], d0[k], Sacc[0][0]); SW_MFMA(ka[0][s_], d1[k], Sacc[0][1]); SW_MFMA(ka[1][s_], d0[k], Sacc[1][0]); SW_MFMA(ka[1][s_], d1[k], Sacc[1][1]); } } while (0)
            SW_LDU(v0x, v1x, 0); SW_LDU(v0y, v1y, 1); SW_SCHED;
            SW_MMU(v0x, v1x, 0); SW_SCHED; SW_LDU(v0x, v1x, 2); SW_SCHED;
            SW_MMU(v0y, v1y, 1); SW_SCHED; SW_LDU(v0y, v1y, 3); SW_SCHED;
            SW_MMU(v0x, v1x, 2); SW_SCHED;
            SW_MMU(v0y, v1y, 3); SW_SCHED;
#undef SW_LDU
#undef SW_MMU
        }
        __syncthreads();
#pragma unroll
        for (int it = 0; it < 4; ++it) { const int row = qrow + 16 * it; *(LAS u32x4*)(lds + SW_QL + row * SW_SPITCH + qpc * 16) = qv[it]; }
#pragma unroll
        for (int it = 0; it < 4; ++it) qv[it] = *(const GAS u32x4*)(qp + (size_t)(nn * CH + 16 * (4 + it)) * QKW);
        if constexpr (OUT) {
            if (dir) {
#pragma unroll
                for (int q = 0; q < 4; ++q) yf[q] = *(const GAS u32x4*)(ypn + q * 512);
            }
            const float xi = fast_exp2((float)(dir == 0 ? (il + 1) : (CH - il)) * l2);
#pragma unroll
            for (int et = 0; et < 2; ++et)
#pragma unroll
                for (int t = 0; t < 16; ++t) O[et][t] *= xi;
            bf16x8 v0x[2], v1x[2], v0y[2], v1y[2];
#define SW_LDV(d0, d1, g2) do { _Pragma("unroll") for (int k = 0; k < 2; ++k) { const int s_ = 2 * (g2) + k; d0[k] = *(const LAS bf16x8*)(lds + v_rd + 32 * s_); d1[k] = *(const LAS bf16x8*)(lds + v_rd + 32 * SW_VPITCH + 32 * s_); } } while (0)
#define SW_MMV(d0, d1, g2) do { _Pragma("unroll") for (int k = 0; k < 2; ++k) { const int s_ = 2 * (g2) + k; SW_MFMA(d0[k], pa[s_], O[0]); SW_MFMA(d1[k], pa[s_], O[1]); } } while (0)
            SW_LDV(v0x, v1x, 0); SW_LDV(v0y, v1y, 1); SW_SCHED;
            SW_MMV(v0x, v1x, 0); SW_SCHED; SW_LDV(v0x, v1x, 2); SW_SCHED;
            SW_MMV(v0y, v1y, 1); SW_SCHED; SW_LDV(v0y, v1y, 3); SW_SCHED;
            SW_MMV(v0x, v1x, 2); SW_SCHED;
            SW_MMV(v0y, v1y, 3); SW_SCHED;
#undef SW_LDV
#undef SW_MMV
#pragma unroll
            for (int s = 0; s < 8; ++s) SW_LDP(pa[s], s, dirn, nn);
        } else {
            const GAS bf16* ktn = (dirn ? KTBg : KTFg) + kto + (size_t)nn * 32768;
#pragma unroll
            for (int db = 0; db < 2; ++db)
#pragma unroll
                for (int s = 0; s < 8; ++s) ka[db][s] = *(const GAS bf16x8*)(ktn + db * 4096 + s * 512);
        }
#pragma unroll
        for (int it = 0; it < 2; ++it) *(LAS u32x4*)(lds + SW_VL + (cur ^ 1) * SW_VB + (vrow + 32 * it) * SW_VPITCH + vpc * 16) = vv[it];
#pragma unroll
        for (int it = 0; it < 4; ++it) { const int row = qrow + 16 * (4 + it); *(LAS u32x4*)(lds + SW_QL + row * SW_SPITCH + qpc * 16) = qv[it]; }
        if constexpr (OUT) {
            float s1 = 0.f, s2 = 0.f;
#pragma unroll
            for (int et = 0; et < 2; ++et)
#pragma unroll
                for (int kp = 0; kp < 2; ++kp) {
                    float ya[4], yb[4];
#pragma unroll
                    for (int q = 0; q < 4; ++q) { ya[q] = O[et][8 * kp + q]; yb[q] = O[et][8 * kp + 4 + q]; }
                    if (dir) {
                        u32x4 f = yf[et * 2 + kp];
                        { const auto r0 = __builtin_amdgcn_permlane32_swap(f.x, f.z, false, false); f.x = r0[0]; f.z = r0[1]; const auto r1 = __builtin_amdgcn_permlane32_swap(f.y, f.w, false, false); f.y = r1[0]; f.w = r1[1]; }
                        ya[0] += bf_lo(f.x); ya[1] += bf_hi(f.x); ya[2] += bf_lo(f.y); ya[3] += bf_hi(f.y); yb[0] += bf_lo(f.z); yb[1] += bf_hi(f.z); yb[2] += bf_lo(f.w); yb[3] += bf_hi(f.w);
#pragma unroll
                        for (int q = 0; q < 4; ++q) { s1 += ya[q] + yb[q]; s2 += ya[q] * ya[q] + yb[q] * yb[q]; }
                    }
                    u32x4 o; o.x = cvt_pk_bf16(ya[0], ya[1]); o.y = cvt_pk_bf16(ya[2], ya[3]); o.z = cvt_pk_bf16(yb[0], yb[1]); o.w = cvt_pk_bf16(yb[2], yb[3]);
                    { const auto r0 = __builtin_amdgcn_permlane32_swap(o.x, o.z, false, false); o.x = r0[0]; o.z = r0[1]; const auto r1 = __builtin_amdgcn_permlane32_swap(o.y, o.w, false, false); o.y = r1[0]; o.w = r1[1]; }
                    *(GAS u32x4*)(ypn + (et * 2 + kp) * 512) = o;
                }
            if (dir) { s1 += __shfl_xor(s1, 32); s2 += __shfl_xor(s2, 32);
                if (hh == 0) stp[(size_t)(n * CH) * (NH * 8)] = (f32x2){s1, s2}; }
        }
    }
#undef SW_LDP
#undef SW_SCHED
#undef SW_MFMA
    VM_WAIT();
    __syncthreads();
}

__device__ __forceinline__ void sweep_unit(LAS unsigned char* lds, const GAS bf16* Qg, const GAS bf16* KTFg, const GAS bf16* KTBg, const GAS bf16* VTg, const GAS bf16* PCg, const GAS bf16* PDg, const GAS bf16* ZEROg, GAS bf16* Yg, GAS f32x2* statp, const float l2f, const float l2b, int b, int h, int es, const int wave_s) {
    int ws_ = wave_s; asm volatile("" : "+s"(ws_));
    if (ws_ < 4) sweep_role<true>(lds, Qg, KTFg, KTBg, VTg, PCg, PDg, ZEROg, Yg, statp, l2f, l2b, b, h, es, wave_s);
    else sweep_role<false>(lds, Qg, KTFg, KTBg, VTg, PCg, PDg, ZEROg, Yg, statp, l2f, l2b, b, h, es, wave_s);
}

struct Args { const float* in[16]; float* out; unsigned char* ws; };
constexpr int NWAVES = 8;
#ifndef PHMASK
#define PHMASK 0xFFFFFFFFu
#endif
#define PH(k) (((PHMASK) >> (k)) & 1u)
__global__ void __launch_bounds__(NWAVES * 64, 2) fwd_kernel(Args args) {
    extern __shared__ __attribute__((aligned(16))) unsigned char lds_raw[];
    LAS unsigned char* lds = (LAS unsigned char*)lds_raw;
    LAS float* l2g = (LAS float*)(lds + LDSCTL_OFF + 64);
    const int wave_k = __builtin_amdgcn_readfirstlane((int)threadIdx.x >> 6);
#define PHASE_VARS \
    const int tid = tid_of(wave_k); const int lane = tid & 63; int wave = wave_k; asm volatile("" : "+s"(wave)); \
    const __attribute__((address_space(4))) Args* ka = (const __attribute__((address_space(4))) Args*)__builtin_amdgcn_kernarg_segment_ptr(); asm volatile("" : "+s"(ka)); \
    const int G = gridDim.x, bx = blockIdx.x; const int vcu = (G % 8 == 0) ? (bx % 8) * (G / 8) + bx / 8 : bx; const int gw = vcu * NWAVES + wave, NGW = G * NWAVES; \
    GAS unsigned char* ws = (GAS unsigned char*)ka->ws; asm volatile("" : "+s"(ws)); GAS float* hres = (GAS float*)ka->out; (void)lane; (void)gw; (void)NGW; (void)vcu; (void)hres; \
    const GAS float* x = (const GAS float*)ka->in[0]; const GAS float* mix_norm = (const GAS float*)ka->in[1]; const GAS float* ffn_norm = (const GAS float*)ka->in[2]; const GAS float* ret_w_in = (const GAS float*)ka->in[3]; const GAS float* ret_decay = (const GAS float*)ka->in[4]; \
    const GAS float* gn_gain = (const GAS float*)ka->in[5]; const GAS float* ret_w_out = (const GAS float*)ka->in[6]; const GAS float* d_wg = (const GAS float*)ka->in[7]; const GAS float* d_wu = (const GAS float*)ka->in[8]; const GAS float* d_wd = (const GAS float*)ka->in[9]; \
    const GAS float* fnet_w = (const GAS float*)ka->in[10]; const GAS float* moe_router = (const GAS float*)ka->in[11]; const GAS float* m_wg = (const GAS float*)ka->in[12]; const GAS float* m_wu = (const GAS float*)ka->in[13]; const GAS float* m_wd = (const GAS float*)ka->in[14]; const GAS float* final_norm = (const GAS float*)ka->in[15]; \
    (void)x; (void)mix_norm; (void)ffn_norm; (void)ret_w_in; (void)ret_decay; (void)gn_gain; (void)ret_w_out; (void)d_wg; (void)d_wu; (void)d_wd; (void)fnet_w; (void)moe_router; (void)m_wg; (void)m_wu; (void)m_wd; (void)final_norm; \
    GAS f32x2* rot = (GAS f32x2*)(ws + WS_ROT); GAS f32x2* rotT = (GAS f32x2*)(ws + WS_ROTT); GAS bf16* WC = (GAS bf16*)(ws + WS_WC); \
    GAS int* toke = (GAS int*)(ws + WS_TOKE); GAS float* tokw = (GAS float*)(ws + WS_TOKW); GAS int* bcnt = (GAS int*)(ws + WS_BCNT); GAS int* pcnt = (GAS int*)(ws + WS_PCNT); (void)pcnt; GAS int* rowtok = (GAS int*)(ws + WS_ROWTOK); GAS float* rowgate = (GAS float*)(ws + WS_ROWGATE); \
    GAS f32x2* statp = (GAS f32x2*)(ws + WS_STATP); \
    GAS bf16* WIN = (GAS bf16*)(ws + WS_WIN); GAS bf16* WO = (GAS bf16*)(ws + WS_WO); GAS bf16* WGU = (GAS bf16*)(ws + WS_WGU); GAS bf16* WD = (GAS bf16*)(ws + WS_WD); GAS bf16* WF = (GAS bf16*)(ws + WS_WF); \
    GAS bf16* HN = (GAS bf16*)(ws + WS_HN); GAS bf16* Qb = (GAS bf16*)(ws + WS_Q); GAS bf16* Kb = (GAS bf16*)(ws + WS_K); GAS bf16* KT = (GAS bf16*)(ws + WS_KT); GAS bf16* VT = (GAS bf16*)(ws + WS_VT); GAS bf16* PC = (GAS bf16*)(ws + WS_PC); \
    GAS bf16* HB = (GAS bf16*)(ws + WS_HN); GAS bf16* HNB = (GAS bf16*)ka->out; (void)HB; (void)HNB; \
    GAS unsigned char* HN8 = (GAS unsigned char*)ka->out + 64 * MiB; GAS unsigned char* WMGU8 = (GAS unsigned char*)(ws + WS_WMGU); (void)HN8; (void)WMGU8;     \
    GAS bf16* Yb = (GAS bf16*)ka->out; GAS bf16* YG = (GAS bf16*)(ws + WS_YG); GAS bf16* ACTD = (GAS bf16*)(ws + WS_ACTD); GAS bf16* Z2 = (GAS bf16*)(ws + WS_Z2); GAS bf16* WSEQ = (GAS bf16*)(ws + WS_WSEQ); \
    GAS bf16* ACTM = (GAS bf16*)(ws + WS_ACTM); GAS bf16* WMGU = (GAS bf16*)(ws + WS_WMGU); GAS bf16* WMD = (GAS bf16*)(ws + WS_WMD); \
    (void)rot; (void)rotT; (void)WC; (void)toke; (void)tokw; (void)bcnt; (void)rowtok; (void)rowgate; (void)statp; (void)WIN; (void)WO; (void)WGU; (void)WD; (void)WF; (void)HN; (void)Qb; (void)Kb; (void)KT; (void)VT; (void)PC; \
    (void)Yb; (void)YG; (void)ACTD; (void)Z2; (void)WSEQ; (void)ACTM; (void)WMGU; (void)WMD;
#define GRID_BAR() do { const __attribute__((address_space(4))) Args* kb = (const __attribute__((address_space(4))) Args*)__builtin_amdgcn_kernarg_segment_ptr(); asm volatile("" : "+s"(kb)); GAS unsigned char* wsb = (GAS unsigned char*)kb->ws; XcdBarrier bar_; bar_.bar = (unsigned*)(wsb + WS_CTL) + CW_BAR; bar_.x = xb_xcc_id(); \
    bar_.st = (volatile LAS unsigned*)(lds + MISC_OFF) + 8; xcd_barrier(bar_, tid_of(wave_k) == 0); } while (0)

    {
        PHASE_VARS
        for (int u = tid; u < (LDS_BYTES - LDSCTL_OFF) / 4; u += NWAVES * 64) ((LAS unsigned*)(lds + LDSCTL_OFF))[u] = 0u;
        __syncthreads();
        if (tid < 8) { const float xl = ret_decay[tid]; const float ls = fminf(xl, 0.f) - log1pf(expf(-fabsf(xl))); l2g[tid] = ls * 1.44269504088896341f; }
        __syncthreads();
        (void)xcd_barrier_post((unsigned*)(ws + WS_CTL) + CW_BAR, (volatile LAS unsigned*)(lds + MISC_OFF) + 8, tid == 0);
    }

    if (PH(0)) {
        PHASE_VARS
        LAS float* scr = (LAS float*)(lds + wave * 16384);
        constexpr int I_IN = (D / 64) * (INW / 32), I_O = (VW / 64) * (D / 32), I_GU = 2 * (D / 64) * (FFD / 32), I_D = (FFD / 64) * (D / 32), I_F = (D / 64) * (D / 32);
        constexpr int NITEMS = I_IN + I_O + I_GU + I_D + I_F;
        for (int it = gw; it < NITEMS; it += NGW) {
            int r = it;
            if (r < I_IN) { tr_plain(ret_w_in, D, INW, WIN, r, scr, lane); continue; } r -= I_IN;
            if (r < I_O) { tr_plain(ret_w_out, VW, D, WO, r, scr, lane); continue; } r -= I_O;
            if (r < I_GU) { tr_gu(d_wg, d_wu, D, FFD, WGU, r, scr, lane); continue; } r -= I_GU;
            if (r < I_D) { tr_plain(d_wd, FFD, D, WD, r, scr, lane); continue; } r -= I_D;
            tr_plain(fnet_w, D, D, WF, r, scr, lane);
        }
        for (int e = (vcu * 512 + tid); e < SEQ * 128; e += G * 512) { const int s = e >> 7, i = e & 127;
            const float inv = powf(10000.0f, -(float)i / 128.0f); const float ang = (float)s * inv; float sn, cs; sincosf(ang, &sn, &cs);
            rot[e] = (f32x2){cs, sn}; rotT[(size_t)i * RTP + s] = (f32x2){cs, sn}; }
        for (int e = (vcu * 512 + tid); e < 512 * 256; e += G * 512) { const int r = e >> 8, c = e & 255, mm = ((r & 255) * c) & 255;
            const float v = r < 256 ? cospif((float)mm * (1.0f / 128.0f)) : -sinpif((float)mm * (1.0f / 128.0f)); WC[e] = (bf16)(cvt_pk_bf16(v, 0.f) & 0xffffu); }
        for (int m = gw; m < T; m += NGW) { f32x4 v[4]; rms_row(x + (size_t)m * D, mix_norm, HN + (size_t)m * D, lane, v); }
    }
    GRID_BAR();

    if (PH(1) && PH(19)) {
        PHASE_VARS
        SchedPlain S{(const GAS char*)HN, (const GAS char*)WIN, (size_t)256 * D * 2, (size_t)256 * D * 2, T / 256, 8, G, bx};
        EpiRopeQK E{Qb, Kb, rot};
        pg8::gemm_phase<EpiRopeQK, SchedPlain, false>(lds, wave_k, D, D, D, S, E);
    }
    if (PH(1) && PH(20)) {
        PHASE_VARS
        SchedPlain S{(const GAS char*)(WIN + (size_t)QKW * D), (const GAS char*)HN, (size_t)256 * D * 2, (size_t)256 * D * 2, 4, T / 256, G, bx};
        EpiRopeKT E{KT, rotT, l2g};
        pg8::gemm_phase<EpiRopeKT, SchedPlain, false>(lds, wave_k, D, D, D, S, E);
    }
    if (PH(1) && PH(21)) {
        PHASE_VARS
        SchedPlain S{(const GAS char*)(WIN + (size_t)2 * QKW * D), (const GAS char*)HN, (size_t)256 * D * 2, (size_t)256 * D * 2, 8, T / 256, G, bx};
        EpiBf16<true> E{VT, T};
        pg8::gemm_phase<EpiBf16<true>, SchedPlain, false>(lds, wave_k, D, D, D, S, E);
    }
    GRID_BAR();

    if (PH(2)) {
        PHASE_VARS
        SchedPc S{(const GAS char*)Qb, (const GAS char*)Kb, G, bx};
        EpiPc E{PC, (GAS bf16*)(ws + WS_ROT), l2g};
        pg8::gemm_phase<EpiPc, SchedPc, false>(lds, wave_k, QKW, QKW, DK, S, E);
    }
    GRID_BAR();

    if (PH(3)) {
        PHASE_VARS
        for (int u = vcu; u < NB * NH * 8; u += G) { const int hh_ = (u >> 3) & 3; const float l2f = l2g[hh_], l2b = l2g[4 + hh_];
            sweep_unit(lds, Qb, KT, KT + (size_t)QKW * T, VT, PC, (const GAS bf16*)(ws + WS_ROT), (const GAS bf16*)(ws + WS_CTL + 512 * 1024), Yb, statp, l2f, l2b, u >> 5, hh_, u & 7, wave_k); }
    }
    GRID_BAR();

    if (PH(5)) {
        PHASE_VARS
        SchedPlain S{(const GAS char*)HN, (const GAS char*)(WIN + (size_t)(2 * QKW + VW) * D), (size_t)256 * D * 2, (size_t)256 * D * 2, T / 256, 8, G, bx};
        EpiGate E{Yb, YG, statp, gn_gain, (LAS f32x2*)(lds + 135168)};
        pg8::gemm_phase<EpiGate, SchedPlain, false>(lds, wave_k, D, D, D, S, E);
    }
    GRID_BAR();

    if (PH(6)) {
        PHASE_VARS
        SchedPlain S{(const GAS char*)YG, (const GAS char*)WO, (size_t)256 * VW * 2, (size_t)256 * VW * 2, T / 256, 4, G, bx};
        EpiRes<true> E{(const GAS void*)x, HB};
        pg8::gemm_phase<EpiRes<true>, SchedPlain, false>(lds, wave_k, VW, VW, VW, S, E);
    }
    GRID_BAR();

    if (PH(7)) {
        PHASE_VARS
        for (int m = gw; m < T; m += NGW) { f32x4 v[4]; rms_row_b(HB + (size_t)m * D, ffn_norm, HNB + (size_t)m * D, lane, v); }
        LAS float* scr = (LAS float*)(lds + wave * 16384);
        constexpr int I_GU = 2 * (D / 64) * (FFE / 32), I_D = (FFE / 64) * (D / 32);
        for (int it = gw; it < NE * (I_GU + I_D); it += NGW) {
            const int e = it / (I_GU + I_D); int r = it - e * (I_GU + I_D);
            if (r < I_GU) tr_gu8(m_wg + (size_t)e * D * FFE, m_wu + (size_t)e * D * FFE, D, FFE, WMGU8 + (size_t)e * 2 * FFE * D, r, scr, lane);
            else { const int it2 = r - I_GU, nblk = D / 32, kb = it2 / nblk, nb = it2 - kb * nblk; transpose_item8(m_wd + (size_t)e * FFE * D, FFE, D, (GAS unsigned char*)WMD + (size_t)e * D * FFE, 64 * kb, 32 * nb, 32 * nb, 64.0f, scr, lane); }
        }
    }
    GRID_BAR();

    if (PH(8)) {
        PHASE_VARS
        SchedPlain S{(const GAS char*)HNB, (const GAS char*)WGU, (size_t)256 * D * 2, (size_t)256 * D * 2, T / 256, 2 * FFD / 256, G, bx};
        EpiSwiGLU<false> E{(GAS void*)ACTD, FFD};
        pg8::gemm_phase<EpiSwiGLU<false>, SchedPlain, false>(lds, wave_k, D, D, D, S, E);
    }
    GRID_BAR();
    if (PH(9)) {
        PHASE_VARS
        SchedPlain S{(const GAS char*)ACTD, (const GAS char*)WD, (size_t)256 * FFD * 2, (size_t)256 * FFD * 2, T / 256, 4, G, bx};
        EpiRes<false> E{(const GAS void*)HB, HB};
        pg8::gemm_phase<EpiRes<false>, SchedPlain, false>(lds, wave_k, FFD, FFD, FFD, S, E);
    }
    GRID_BAR();

    if (PH(10)) {
        PHASE_VARS
        for (int m = gw; m < T; m += NGW) { f32x4 v[4]; rms_row_b(HB + (size_t)m * D, mix_norm + D, HNB + (size_t)m * D, lane, v); }
        for (int e = vcu * 512 + tid; e < 512 * 1024; e += G * 512) { const int ka = e >> 10, c = e & 1023, a = c & 511, mm = (a * ka) & 511;
            const float v = (c < 512 ? cospif((float)mm * (1.0f / 256.0f)) : sinpif((float)mm * (1.0f / 256.0f))) * (1.0f / 1024.0f); WSEQ[e] = (bf16)(cvt_pk_bf16(v, 0.f) & 0xffffu); }
    }
    GRID_BAR();

    if (PH(11)) {
        PHASE_VARS
        SchedFnA S{(const GAS char*)WC, (const GAS char*)HNB, G, bx};
        EpiZ2 E{Z2};
        pg8::gemm_phase<EpiZ2, SchedFnA, false>(lds, wave_k, 256, D, 256, S, E);
    }
    GRID_BAR();
    if (PH(22)) {
        PHASE_VARS
        float wc0[8], ws0[8];
#pragma unroll
        for (int kb = 0; kb < 8; ++kb) { const float ang = (float)((8 * lane * kb) & 4095) * (1.0f / 2048.0f); wc0[kb] = cospif(ang); ws0[kb] = sinpif(ang); }
        for (int rw = gw; rw < NB * 1024; rw += NGW) {
            GAS bf16* row = Z2 + (size_t)rw * 8192;
#pragma unroll
            for (int hq = 0; hq < 2; ++hq) {
                u32x2 zin[2][8], zout[8][2];
#pragma unroll
                for (int ri = 0; ri < 2; ++ri)
#pragma unroll
                    for (int bb = 0; bb < 8; ++bb) zin[ri][bb] = *(const GAS u32x2*)(row + ri * 4096 + 512 * bb + 8 * lane + 4 * hq);
#pragma unroll
                for (int q = 0; q < 2; ++q) {
                    float outr[2][8], outi[2][8];
#pragma unroll
                    for (int tt = 0; tt < 2; ++tt) {
                        const int t = 4 * hq + 2 * q + tt;
                        float zr[8], zi[8];
#pragma unroll
                        for (int bb = 0; bb < 8; ++bb) { const unsigned wr_ = zin[0][bb][q], wi_ = zin[1][bb][q]; zr[bb] = tt ? bf_hi(wr_) : bf_lo(wr_); zi[bb] = tt ? bf_hi(wi_) : bf_lo(wi_); }
#pragma unroll
                        for (int kb = 0; kb < 8; ++kb) {
                            float ur = 0.f, ui = 0.f;
#pragma unroll
                            for (int bb = 0; bb < 8; ++bb) {
                                const int m8 = (bb * kb) & 7;
                                const float c8 = (m8 == 0) ? 1.f : (m8 == 4) ? -1.f : (m8 == 2 || m8 == 6) ? 0.f : (m8 == 1 || m8 == 7) ? 0.70710678118654752f : -0.70710678118654752f;
                                const float s8 = (m8 == 0 || m8 == 4) ? 0.f : (m8 == 2) ? 1.f : (m8 == 6) ? -1.f : (m8 == 1 || m8 == 3) ? 0.70710678118654752f : -0.70710678118654752f;
                                ur += c8 * zr[bb] + s8 * zi[bb]; ui += c8 * zi[bb] - s8 * zr[bb]; }
                            const int mt = (t * kb);
                            const float ct = __builtin_cosf((float)mt * 0.00153398078788564123f), st_ = __builtin_sinf((float)mt * 0.00153398078788564123f);
                            const float twc = wc0[kb] * ct - ws0[kb] * st_, tws = ws0[kb] * ct + wc0[kb] * st_;
                            outr[tt][kb] = ur * twc + ui * tws; outi[tt][kb] = ui * twc - ur * tws; }
                    }
#pragma unroll
                    for (int kb = 0; kb < 8; ++kb) { zout[kb][0][q] = cvt_pk_bf16(outr[0][kb], outr[1][kb]); zout[kb][1][q] = cvt_pk_bf16(outi[0][kb], outi[1][kb]); }
                    __builtin_amdgcn_sched_barrier(0);
                }
#pragma unroll
                for (int kb = 0; kb < 8; ++kb)
#pragma unroll
                    for (int ri = 0; ri < 2; ++ri) *(GAS u32x2*)(row + kb * 1024 + ri * 512 + 8 * lane + 4 * hq) = zout[kb][ri];
                __builtin_amdgcn_sched_barrier(0);
            }
        }
    }
    GRID_BAR();
    if (PH(12)) {
        PHASE_VARS
        SchedFnB S{(GAS const char*)WSEQ, (GAS const char*)Z2, G, bx};
        EpiYf E{HNB};
        pg8::gemm_phase<EpiYf, SchedFnB, false>(lds, wave_k, 1024, 1024, 1024, S, E);
    }
    GRID_BAR();
    if (PH(13)) {
        PHASE_VARS
        SchedPlain S{(const GAS char*)HNB, (const GAS char*)WF, (size_t)256 * D * 2, (size_t)256 * D * 2, T / 256, 4, G, bx};
        EpiRes<false> E{(const GAS void*)HB, HB};
        pg8::gemm_phase<EpiRes<false>, SchedPlain, false>(lds, wave_k, D, D, D, S, E);
    }
    GRID_BAR();

    if (PH(14)) {
        PHASE_VARS
        LAS float* wrl = (LAS float*)lds;
        LAS int* le = (LAS int*)(lds + 32768);
        for (int i = tid; i < D * NE / 4; i += NWAVES * 64) ((LAS f32x4*)wrl)[i] = ((const GAS f32x4*)moe_router)[i];
        for (int i = vcu * 512 + tid; i < 2 * MOE_ROWS; i += G * 512) rowtok[i] = -1;
        __syncthreads();
        for (int tb = vcu; tb < T / 128; tb += G) {
            for (int rr = 0; rr < 16; ++rr) { const int tl = wave * 16 + rr, m = tb * 128 + tl; f32x4 v[4];
                rms_row_b8(HB + (size_t)m * D, ffn_norm + D, HN8 + (size_t)m * D, lane, v);
                float lg[8];
#pragma unroll
                for (int e = 0; e < 8; ++e) lg[e] = 0.f;
#pragma unroll
                for (int j = 0; j < 4; ++j)
#pragma unroll
                    for (int c = 0; c < 4; ++c) { const int col = rmsb_col(j, lane) + c; const f32x4 w0 = *(const LAS f32x4*)(wrl + col * 8), w1 = *(const LAS f32x4*)(wrl + col * 8 + 4); const float xv = v[j][c];
                        lg[0] += xv * w0.x; lg[1] += xv * w0.y; lg[2] += xv * w0.z; lg[3] += xv * w0.w; lg[4] += xv * w1.x; lg[5] += xv * w1.y; lg[6] += xv * w1.z; lg[7] += xv * w1.w; }
#pragma unroll
                for (int e = 0; e < 8; ++e) lg[e] = wave_sum(lg[e]);
                int e0 = 0; float b0 = lg[0];
#pragma unroll
                for (int e = 1; e < 8; ++e) if (lg[e] > b0) { b0 = lg[e]; e0 = e; }
                int e1 = -1; float b1 = -3.0e38f;
#pragma unroll
                for (int e = 0; e < 8; ++e) if (e != e0 && lg[e] > b1) { b1 = lg[e]; e1 = e; }
                const float w0 = 1.0f / (1.0f + __expf(b1 - b0));
                if (lane == 0) { toke[2 * m] = e0; toke[2 * m + 1] = e1; tokw[2 * m] = w0; tokw[2 * m + 1] = 1.0f - w0; le[tl] = e0; le[128 + tl] = e1; } }
            __syncthreads();
            if (tid < 16) { const int s = tid >> 3, e = tid & 7; int c = 0; for (int i = 0; i < 128; ++i) c += (le[s * 128 + i] == e) ? 1 : 0; bcnt[tb * 16 + tid] = c; }
            if (tid >= 64 && tid < 128) { const int pi = tid - 64; int c = 0; for (int i = 0; i < 128; ++i) c += (le[i] * 8 + le[128 + i] == pi) ? 1 : 0; pcnt[tb * 64 + pi] = c; }
            __syncthreads();
        }
    }
    GRID_BAR();

    LAS int* segoff = (LAS int*)(lds + 132096);
    LAS int* ntile = (LAS int*)(lds + 132096 + 64);
    LAS unsigned char* tile_e = (LAS unsigned char*)(lds + 132096 + 128);
    if (PH(15)) {
        PHASE_VARS
        LAS int* pfx = (LAS int*)lds;
        LAS int* cph = (LAS int*)(lds + 65792);
        LAS int* fq_ = (LAS int*)(lds + 65792 + 16384);
        LAS int* tot = fq_ + 64;
        LAS int* tpi = tot + 16;
        LAS int* tex = tpi + 128;
        for (int i = tid; i < 256 * 64; i += NWAVES * 64) pfx[i] = pcnt[i];
        __syncthreads();
        if (tid < 64) { int run = 0; for (int b2 = 0; b2 < 256; ++b2) { const int c = pfx[b2 * 64 + tid]; pfx[b2 * 64 + tid] = run; run += c; } pfx[256 * 64 + tid] = run; }
        __syncthreads();
        if (tid == 0) {
            int n0[8], d[8], r[8]; int rs = 0;
            for (int e = 0; e < 8; ++e) { int c = 0; for (int x2 = 0; x2 < 8; ++x2) c += pfx[256 * 64 + e * 8 + x2]; n0[e] = c; r[e] = c & 255; d[e] = -(c & 255); rs += c & 255; }
            int extra = rs >> 8;
            for (int k = 0; k < extra; ++k) { int be = -1, br = -1; for (int e = 0; e < 8; ++e) if (d[e] < 0 && d[e] == -r[e] && r[e] > br) { br = r[e]; be = e; } if (be >= 0) d[be] += 256; }
            for (int i = 0; i < 64; ++i) fq_[i] = 0;
            for (int a = 0; a < 8; ++a) for (int e = 0; e < 8; ++e) if (a != e && d[a] < 0 && d[e] > 0) { int fl = -d[a]; if (d[e] < fl) fl = d[e]; const int av = pfx[256 * 64 + a * 8 + e]; if (av < fl) fl = av; fq_[a * 8 + e] = fl; d[a] += fl; d[e] -= fl; }
        }
        __syncthreads();
        if (tid < 256) {
            int c0[8], c1[8];
#pragma unroll
            for (int e = 0; e < 8; ++e) { c0[e] = 0; c1[e] = 0; }
            for (int a = 0; a < 8; ++a) for (int e = 0; e < 8; ++e) { const int pi = a * 8 + e; const int cnt = pfx[(tid + 1) * 64 + pi] - pfx[tid * 64 + pi]; int fl = fq_[pi] - pfx[tid * 64 + pi]; fl = fl < 0 ? 0 : (fl > cnt ? cnt : fl);
#pragma unroll
                for (int q = 0; q < 8; ++q) { c0[q] += (q == a ? cnt - fl : 0) + (q == e ? fl : 0); c1[q] += (q == e ? cnt - fl : 0) + (q == a ? fl : 0); } }
#pragma unroll
            for (int e = 0; e < 8; ++e) { cph[tid * 16 + e] = c0[e]; cph[tid * 16 + 8 + e] = c1[e]; }
        }
        __syncthreads();
        if (tid < 16) { int run = 0; for (int b2 = 0; b2 < 256; ++b2) { const int c = cph[b2 * 16 + tid]; cph[b2 * 16 + tid] = run; run += c; } tot[tid] = run; }
        __syncthreads();
        if (tid < 2) { int off = 0, nt = 0; for (int e = 0; e < 8; ++e) { segoff[tid * 8 + e] = off; const int tl = (tot[tid * 8 + e] + 255) >> 8; for (int q = 0; q < tl; ++q) tile_e[tid * 160 + nt + q] = (unsigned char)e; nt += tl; off += tl * 256; } ntile[tid] = nt; }
        __syncthreads();
        for (int tb = vcu; tb < T / 128; tb += G) {
            int e0 = 0, e1 = 0, flip = 0;
            if (tid < 128) { const int m = tb * 128 + tid; e0 = toke[2 * m]; e1 = toke[2 * m + 1]; tpi[tid] = e0 * 8 + e1; }
            __syncthreads();
            if (tid < 128) { const int pi = e0 * 8 + e1; int rk = 0; for (int i = 0; i < tid; ++i) rk += (tpi[i] == pi) ? 1 : 0;
                flip = (pfx[tb * 64 + pi] + rk) < fq_[pi] ? 1 : 0; tex[tid] = flip ? e1 : e0; tex[128 + tid] = flip ? e0 : e1; }
            __syncthreads();
            if (tid < 128) { const int m = tb * 128 + tid;
#pragma unroll
                for (int ph = 0; ph < 2; ++ph) { const int e = tex[ph * 128 + tid]; int rk = 0; for (int i = 0; i < tid; ++i) rk += (tex[ph * 128 + i] == e) ? 1 : 0;
                    const int row = segoff[ph * 8 + e] + cph[tb * 16 + ph * 8 + e] + rk;
                    rowtok[ph * MOE_ROWS + row] = m; rowgate[ph * MOE_ROWS + row] = tokw[2 * m + (ph ^ flip)]; } }
            __syncthreads();
        }
    }
    GRID_BAR();

    if (PH(16))
#pragma unroll
    for (int s = 0; s < 2; ++s) {
        {
            PHASE_VARS
            SchedMoe S{(const GAS char*)HN8, (const GAS char*)WMGU8, rowtok + s * MOE_ROWS, tile_e + s * 160, 0, (size_t)2 * FFE * D, (size_t)256 * D, ntile[s], 2 * FFE / 256, G, bx, true, 0x7f7f7f7f};
            EpiSwiGLU<true> E{(GAS void*)ACTM, FFE};
            pg8::gemm_phase<EpiSwiGLU<true>, SchedMoe, true, true>(lds, wave_k, D, D, D, S, E);
        }
        GRID_BAR();
        {
            PHASE_VARS
            SchedMoe S{(const GAS char*)ACTM, (const GAS char*)WMD, rowtok + s * MOE_ROWS, tile_e + s * 160, (size_t)256 * FFE, (size_t)D * FFE, (size_t)256 * FFE, ntile[s], 4, G, bx, false, 0x7c7c7c7c};
            EpiMoeDown E{HB, rowtok + s * MOE_ROWS, rowgate + s * MOE_ROWS};
            pg8::gemm_phase<EpiMoeDown, SchedMoe, false, true>(lds, wave_k, FFE, FFE, FFE, S, E);
        }
        GRID_BAR();
    }

    if (PH(17)) {
        PHASE_VARS
        const bool bad = __hip_atomic_load((GAS unsigned*)(ws + WS_CTL) + CW_BAR + XB_TMO, RLX_AGENT) != 0u;
        for (int m = gw; m < T; m += NGW) {
            const GAS bf16* hrow = HB + (size_t)m * D; GAS float* orow = hres + (size_t)m * D;
            f32x4 v[4]; float s = 0.f;
#pragma unroll
            for (int jh = 0; jh < 2; ++jh) { const u32x4 xx = *(const GAS u32x4*)(hrow + 512 * jh + 8 * lane);
                v[2 * jh] = (f32x4){bf_lo(xx.x), bf_hi(xx.x), bf_lo(xx.y), bf_hi(xx.y)}; v[2 * jh + 1] = (f32x4){bf_lo(xx.z), bf_hi(xx.z), bf_lo(xx.w), bf_hi(xx.w)}; }
#pragma unroll
            for (int j = 0; j < 4; ++j) s += (v[j].x * v[j].x + v[j].y * v[j].y) + (v[j].z * v[j].z + v[j].w * v[j].w);
            const float r = bad ? __builtin_nanf("") : 1.0f / sqrtf(wave_sum(s) * (1.f / D) + EPS);
#pragma unroll
            for (int j = 0; j < 4; ++j) { const int col = rmsb_col(j, lane); *(GAS f32x4*)(orow + col) = v[j] * r * *(const GAS f32x4*)(final_norm + col); }
        }
    }
}

extern "C" void kernel_launch(void* const* d_in, const int* in_sizes, int n_in, void* d_out, int out_size, void* d_ws, size_t ws_size, hipStream_t stream) {
    static int grid = 0;
    if (grid == 0) {
        if (n_in != 16 || in_sizes[0] != T * D || out_size != T * D || ws_size < WS_END) { fprintf(stderr, "kernel_launch: unexpected shapes (n_in %d, in0 %d, out %d, ws %zu)\n", n_in, n_in > 0 ? in_sizes[0] : -1, out_size, ws_size); grid = -1; return; }
        int dev = 0, cus = 0, per_cu = 0;
        if (hipGetDevice(&dev) != hipSuccess || hipDeviceGetAttribute(&cus, hipDeviceAttributeMultiprocessorCount, dev) != hipSuccess) { grid = -1; return; }
        if (hipFuncSetAttribute((const void*)fwd_kernel, hipFuncAttributeMaxDynamicSharedMemorySize, LDS_BYTES) != hipSuccess) { fprintf(stderr, "kernel_launch: hipFuncSetAttribute failed\n"); grid = -1; return; }
        if (hipOccupancyMaxActiveBlocksPerMultiprocessor(&per_cu, (const void*)fwd_kernel, NWAVES * 64, LDS_BYTES) != hipSuccess || per_cu < 1) { fprintf(stderr, "kernel_launch: occupancy query says %d\n", per_cu); }
        (void)hipGetLastError();
        grid = cus;
    }
    if (grid < 0) return;
    if (hipMemsetAsync((char*)d_ws + WS_CTL, 0, CTL_ZERO_BYTES, stream) != hipSuccess) return;
    Args a{};
    for (int i = 0; i < 16; ++i) a.in[i] = (const float*)d_in[i];
    a.out = (float*)d_out; a.ws = (unsigned char*)d_ws;
    hipLaunchKernelGGL(fwd_kernel, dim3(grid), dim3(NWAVES * 64), LDS_BYTES, stream, a);
}
```

```cpp
#include <hip/hip_runtime.h>
#include <cstdio>
#include <cstdint>

#define LAS __attribute__((address_space(3)))
#define GAS __attribute__((address_space(1)))
typedef unsigned short bf16;
typedef short bf16x8 __attribute__((ext_vector_type(8)));
typedef float f32x2 __attribute__((ext_vector_type(2)));
typedef float f32x4 __attribute__((ext_vector_type(4)));
typedef float f32x16 __attribute__((ext_vector_type(16)));
typedef unsigned u32x2 __attribute__((ext_vector_type(2)));
typedef unsigned u32x4 __attribute__((ext_vector_type(4)));
typedef GAS unsigned gu32;

constexpr int D = 1024, NB = 8, SEQ = 4096, T = NB * SEQ;
constexpr int NH = 4, DK = 256, DV = 512, QKW = 1024, VW = 2048, INW = 6144, CH = 128, NCH = SEQ / CH;
constexpr int FFD = 2816, NE = 8, FFE = 3584;
constexpr int MOE_ROWS = T + NE * 256;
constexpr float EPS = 1e-6f;

constexpr size_t MiB = 1u << 20;
constexpr size_t WS_CTL = 0, CTL_ZERO_BYTES = 1 * MiB;
constexpr size_t WS_ROT = 1 * MiB, WS_ROTT = 5 * MiB, WS_WC = 10 * MiB + 768 * 1024;
constexpr int RTP = SEQ + 64;
constexpr size_t WS_TOKE = 9 * MiB + 256 * 1024;
constexpr size_t WS_TOKW = WS_TOKE + 256 * 1024;
constexpr size_t WS_BCNT = WS_TOKW + 256 * 1024;
constexpr size_t WS_ROWTOK = WS_BCNT + 16 * 1024;
constexpr size_t WS_ROWGATE = WS_ROWTOK + 2 * MOE_ROWS * 4;
constexpr size_t WS_PCNT = 10 * MiB + 512 * 1024;
constexpr size_t WS_STATS = 11 * MiB;
static_assert(WS_ROWGATE + 2 * MOE_ROWS * 4 <= WS_PCNT, "small tables");
constexpr size_t WS_WIN = 12 * MiB, WS_WO = 24 * MiB, WS_WGU = 28 * MiB, WS_WD = 39 * MiB, WS_WF = 44 * MiB + 512 * 1024;
constexpr size_t WS_HN = 48 * MiB;
constexpr size_t WS_Q = 112 * MiB, WS_K = 176 * MiB, WS_KT = 240 * MiB  , WS_VT = 368 * MiB, WS_PC = 496 * MiB;
constexpr size_t WS_YG = 240 * MiB;
constexpr size_t WS_STATP = 176 * MiB;
constexpr size_t WS_ACTD = 112 * MiB;
constexpr size_t WS_Z2 = 112 * MiB, WS_WSEQ = 240 * MiB;
constexpr size_t WS_ACTM = 112 * MiB;
constexpr size_t WS_WMGU = 352 * MiB, WS_WMD = 464 * MiB, WS_END = 528 * MiB;
static_assert(WS_ACTM + (size_t)MOE_ROWS * FFE * 2 <= WS_WMGU, "moe act");
static_assert(WS_PC + (size_t)NB * NH * NCH * CH * CH * 2 <= 528 * MiB, "epoch A");
static_assert(WS_WF + (size_t)D * D * 2 <= WS_HN, "weights");
constexpr int CW_BAR = 4096;
constexpr int CW_CHK = 64;

constexpr int RING_BYTES = 131072;
constexpr int LDSCTL_OFF = 139264, MISC_OFF = LDSCTL_OFF + 320;
constexpr int LDS_BYTES = 147456;

#define LDS_WAIT() asm volatile("s_waitcnt lgkmcnt(0)" ::: "memory")
#define VM_WAIT() asm volatile("s_waitcnt vmcnt(0)" ::: "memory")
#define RLX_AGENT __ATOMIC_RELAXED, __HIP_MEMORY_SCOPE_AGENT

__device__ __forceinline__ unsigned cvt_pk_bf16(float lo, float hi) { unsigned r; asm volatile("v_cvt_pk_bf16_f32 %0, %1, %2" : "=v"(r) : "v"(lo), "v"(hi)); return r; }
__device__ __forceinline__ unsigned pk4_fp8(float a, float b, float c, float d) { int w = 0; w = __builtin_amdgcn_cvt_pk_fp8_f32(a, b, w, false); w = __builtin_amdgcn_cvt_pk_fp8_f32(c, d, w, true); return (unsigned)w; }
__device__ __forceinline__ float bf_lo(unsigned w) { return __uint_as_float(w << 16); }
__device__ __forceinline__ float bf_hi(unsigned w) { return __uint_as_float(w & 0xffff0000u); }
__device__ __forceinline__ float fast_exp2(float x) { return __builtin_amdgcn_exp2f(x); }
__device__ __forceinline__ int lane_id_v() { int l; asm volatile("v_mbcnt_lo_u32_b32 %0, -1, 0\n\tv_mbcnt_hi_u32_b32 %0, -1, %0" : "=v"(l)); return l; }
__device__ __forceinline__ int tid_of(int wave_s) { asm volatile("" : "+s"(wave_s)); return wave_s * 64 + lane_id_v(); }
__device__ __forceinline__ int rot_col(int row, int tok) { return (tok + ((row & 15) << 11)) & (32768 - 1); }
__device__ __forceinline__ float silu_f(float v) { return v * __builtin_amdgcn_rcpf(1.0f + __builtin_amdgcn_exp2f(v * -1.44269504088896341f)); }

namespace pg8 {
constexpr int BM = 256, BK = 64, HALF = 128, HTB = HALF * BK * 2, STAGE_BYTES = 8 * HTB, NXCD = 8, WGM = 2;
__host__ __device__ __forceinline__ int lds_byte(int r, int c) { const int st = (r >> 4) * 2 + (c >> 5), rr = r & 15, cc = c & 31, ob = rr * 64 + cc * 2; return st * 1024 + (ob ^ (((ob >> 9) & 1) << 5)); }
__host__ __device__ __forceinline__ void stage_rc(int b, int& R, int& C) { const int st = b / 1024, sb = b % 1024, swz = sb ^ (((sb >> 9) & 1) << 5); R = (st >> 1) * 16 + swz / 64; C = (st & 1) * 32 + (swz % 64) / 2; }
__host__ __device__ __forceinline__ int perm32(int rho) { const int n = rho >> 4, i = rho & 15; return 8 * (i >> 2) + 4 * n + (i & 3); }

struct Unit { const GAS char* A; const GAS char* B; const GAS int* rows; int pm, pn, z; };

__device__ __forceinline__ bool tile_of(long L, int nM, int nN, int& pm, int& pn) {
    const int nwg = nM * nN; if (L >= nwg) return false;
    int wgid = (int)L; { const int q = nwg / NXCD, r = nwg % NXCD, xcd = wgid % NXCD, off = wgid / NXCD; wgid = (xcd < r ? xcd * (q + 1) : r * (q + 1) + (xcd - r) * q) + off; }
    const int nig = WGM * nN, gid = wgid / nig, fm = gid * WGM, gsz = (nM - fm) < WGM ? (nM - fm) : WGM;
    pm = fm + ((wgid % nig) % gsz); pn = (wgid % nig) / gsz; return true;
}

template <class Epi, class Sched, bool GATHER, bool FP8 = false>
__device__ __forceinline__ void gemm_phase(LAS unsigned char* lds, const int wave_s, const int lda, const int ldb, const int K, const Sched& S, const Epi& E) {
    const int tid = tid_of(wave_s);
    const int wid = __builtin_amdgcn_readfirstlane(tid >> 6), lane = tid & 63, wr = wid >> 2, wc = wid & 3, fr = lane & 15, fq = lane >> 4;
    constexpr int ES = FP8 ? 1 : 2;
    const int nt = K * ES / (BK * 2);
    unsigned vA[2][2], vAn[2][2], voffB[2];
#pragma unroll
    for (int i = 0; i < 2; ++i) { int R, C; stage_rc(tid * 16 + i * 8192, R, C); const int Rb = Epi::PERM ? ((R & ~31) + perm32(R & 31)) : R;
        voffB[i] = (unsigned)(S.brow(Rb) * ldb * ES + C * 2);
#pragma unroll
        for (int h = 0; h < 2; ++h) { vA[h][i] = (unsigned)((h * HALF + R) * lda * ES + C * 2); vAn[h][i] = vA[h][i]; } }
    const size_t kstep = (size_t)(BK * 2);
    const size_t hstepB = (size_t)(S.brow(HALF) - S.brow(0)) * ldb * ES;
    const unsigned ldsw = (unsigned)wid * 1024u;
    const int aoff = lds_byte(wr * 64 + fr, FP8 ? fq * 16 : fq * 8), boff = lds_byte(wc * 32 + fr, FP8 ? fq * 16 : fq * 8);
    typedef int v4i_ __attribute__((ext_vector_type(4))); typedef int v8i_ __attribute__((ext_vector_type(8)));
    const int sc_w8 = S.scale_b8(), sc_a8 = S.scale_a8(); (void)sc_w8; (void)sc_a8;
#define PG8_SA(b, h) (((b) * 2 + (h)) * HTB)
#define PG8_SB(b, h) ((4 + (b) * 2 + (h)) * HTB)
#define PG8_STAGE_B(bufoff, gbase) do { _Pragma("unroll") for (int _i = 0; _i < 2; ++_i) \
        __builtin_amdgcn_global_load_lds((const GAS unsigned*)((const GAS char*)(gbase) + voffB[_i]), (LAS unsigned*)(lds + (bufoff) + ldsw + _i * 8192), 16, 0, 0); } while (0)
#define PG8_STAGE_A(bufoff, gbase, v0, v1) do { \
        __builtin_amdgcn_global_load_lds((const GAS unsigned*)((const GAS char*)(gbase) + (v0)), (LAS unsigned*)(lds + (bufoff) + ldsw), 16, 0, 0); \
        __builtin_amdgcn_global_load_lds((const GAS unsigned*)((const GAS char*)(gbase) + (v1)), (LAS unsigned*)(lds + (bufoff) + ldsw + 8192), 16, 0, 0); } while (0)
#define PG8_LD32(addr) __builtin_shufflevector(*(const LAS v4i_*)(addr), *(const LAS v4i_*)((addr) + 16), 0, 1, 2, 3, 4, 5, 6, 7)
#define PG8_LDA(dst, b, h) do { _Pragma("unroll") for (int m = 0; m < 4; ++m) { if constexpr (FP8) dst##8[m] = PG8_LD32(lds + PG8_SA(b, h) + aoff + m * 2048); else { _Pragma("unroll") for (int k = 0; k < 2; ++k) dst[m][k] = *(const LAS bf16x8*)(lds + PG8_SA(b, h) + aoff + m * 2048 + k * 1024); } } } while (0)
#define PG8_LDB(dst, b, h) do { _Pragma("unroll") for (int n = 0; n < 2; ++n) { if constexpr (FP8) dst##8[n] = PG8_LD32(lds + PG8_SB(b, h) + boff + n * 2048); else { _Pragma("unroll") for (int k = 0; k < 2; ++k) dst[n][k] = *(const LAS bf16x8*)(lds + PG8_SB(b, h) + boff + n * 2048 + k * 1024); } } } while (0)
#define PG8_MMA(ai, bj, At, Bt) do { __builtin_amdgcn_s_setprio(1); _Pragma("unroll") for (int m = 0; m < 4; ++m) _Pragma("unroll") for (int n = 0; n < 2; ++n) { \
        if constexpr (FP8) asm volatile("v_mfma_scale_f32_16x16x128_f8f6f4 %0, %1, %2, %0, %3, %4 op_sel_hi:[0,0,0]" : "+v"(acc[ai][bj][m][n]) : "v"(Bt##8[n]), "v"(At##8[m]), "v"(sc_w8), "v"(sc_a8)); \
        else { _Pragma("unroll") for (int k = 0; k < 2; ++k) acc[ai][bj][m][n] = __builtin_amdgcn_mfma_f32_16x16x32_bf16(Bt[n][k], At[m][k], acc[ai][bj][m][n], 0, 0, 0); } } \
        __builtin_amdgcn_s_setprio(0); } while (0)
#define PG8_WAIT_V(n) asm volatile("s_waitcnt vmcnt(" #n ")" ::: "memory")
#define PG8_WAIT_L(n) asm volatile("s_waitcnt lgkmcnt(" #n ")" ::: "memory")
#define PG8_BAR __builtin_amdgcn_s_barrier()
#define PG8_SCHED __builtin_amdgcn_sched_barrier(0)
#define PG8_LOADROWS(dst, u) do { if constexpr (GATHER) { const int _tz = tid_of(wave_s); _Pragma("unroll") for (int _i = 0; _i < 2; ++_i) { int _R, _C; stage_rc(_tz * 16 + _i * 8192, _R, _C); \
        _Pragma("unroll") for (int _h = 0; _h < 2; ++_h) { const int _t = (u).rows[_h * HALF + _R]; dst[_h][_i] = (unsigned)((_t < 0 ? 0 : _t) * lda * ES + _C * 2); } } } } while (0)
#define PG8_VAN(h, i) (GATHER ? vAn[h][i] : vA[h][i])
    Unit cur, nxt; int ui = 0;
    if (!S.next(0, cur)) return;
    f32x4 acc[2][2][4][2];
#pragma unroll
    for (int a = 0; a < 2; ++a)
#pragma unroll
        for (int b = 0; b < 2; ++b)
#pragma unroll
            for (int m = 0; m < 4; ++m)
#pragma unroll
                for (int n = 0; n < 2; ++n) acc[a][b][m][n] = (f32x4){0.f, 0.f, 0.f, 0.f};
    bf16x8 At[4][2], B0[2][2], B1[2][2]; v8i_ At8[4], B08[2], B18[2]; (void)At; (void)B0; (void)B1; (void)At8; (void)B08; (void)B18;
    const GAS char* cA = cur.A; const GAS char* cB = cur.B;
    PG8_LOADROWS(vA, cur);
    if constexpr (GATHER) { vAn[0][0] = vA[0][0]; vAn[0][1] = vA[0][1]; vAn[1][0] = vA[1][0]; vAn[1][1] = vA[1][1]; }
    PG8_STAGE_B(PG8_SB(0, 0), cB); PG8_STAGE_B(PG8_SB(0, 1), cB + hstepB); PG8_STAGE_A(PG8_SA(0, 0), cA, vA[0][0], vA[0][1]); PG8_STAGE_A(PG8_SA(0, 1), cA, vA[1][0], vA[1][1]);
    if (wr == 1) PG8_BAR;
    PG8_WAIT_V(2); PG8_BAR;
    PG8_STAGE_B(PG8_SB(1, 0), cB + kstep); PG8_STAGE_A(PG8_SA(1, 0), cA + kstep, vA[0][0], vA[0][1]); PG8_STAGE_B(PG8_SB(1, 1), cB + hstepB + kstep);
    PG8_WAIT_V(6); PG8_BAR;
    for (;;) {
        const bool has_next = S.next(ui + 1, nxt);
        const GAS char* nA = has_next ? nxt.A : cA; const GAS char* nB = has_next ? nxt.B : cB;
#pragma unroll 1
        for (int t = 0; t < nt; t += 2) {
            const bool last = (t == nt - 2);
            const GAS char* a1 = cA + (size_t)(t + 1) * kstep;
            const GAS char* a2 = last ? nA : cA + (size_t)(t + 2) * kstep; const GAS char* b2 = last ? nB : cB + (size_t)(t + 2) * kstep;
            const GAS char* a3 = a2 + kstep; const GAS char* b3 = b2 + kstep;
            if constexpr (GATHER) { if (last && has_next) { PG8_LOADROWS(vAn, nxt); } }
            PG8_LDB(B0, 0, 0); PG8_LDB(B1, 0, 1); PG8_SCHED; PG8_LDA(At, 0, 0); PG8_STAGE_A(PG8_SA(1, 1), a1, vA[1][0], vA[1][1]);
            PG8_WAIT_V(8); PG8_WAIT_L(0); PG8_BAR; PG8_MMA(0, 0, At, B0); PG8_MMA(0, 1, At, B1); PG8_BAR; PG8_SCHED;
            PG8_LDA(At, 0, 1); PG8_STAGE_B(PG8_SB(0, 0), b2); PG8_STAGE_B(PG8_SB(0, 1), b2 + hstepB); PG8_STAGE_A(PG8_SA(0, 0), a2, PG8_VAN(0, 0), PG8_VAN(0, 1));
            PG8_WAIT_V(8); PG8_WAIT_L(0); PG8_BAR; PG8_MMA(1, 0, At, B0); PG8_MMA(1, 1, At, B1); PG8_BAR; PG8_SCHED;
            PG8_LDB(B0, 1, 0); PG8_LDB(B1, 1, 1); PG8_SCHED; PG8_LDA(At, 1, 0); PG8_STAGE_A(PG8_SA(0, 1), a2, PG8_VAN(1, 0), PG8_VAN(1, 1));
            PG8_WAIT_V(8); PG8_WAIT_L(0); PG8_BAR; PG8_MMA(0, 0, At, B0); PG8_MMA(0, 1, At, B1); PG8_BAR; PG8_SCHED;
            PG8_LDA(At, 1, 1); PG8_STAGE_B(PG8_SB(1, 0), b3); PG8_STAGE_B(PG8_SB(1, 1), b3 + hstepB); PG8_STAGE_A(PG8_SA(1, 0), a3, PG8_VAN(0, 0), PG8_VAN(0, 1));
            PG8_WAIT_V(8); PG8_WAIT_L(0); PG8_BAR; PG8_MMA(1, 0, At, B0); PG8_MMA(1, 1, At, B1); PG8_BAR; PG8_SCHED;
        }
        if (wr == 0) PG8_BAR;
        if constexpr (FP8) asm volatile("s_nop 15\n\ts_nop 15" ::: "memory");
        E(acc, cur, wr, wc, fr, fq);
        if (!has_next) break;
#pragma unroll
        for (int a = 0; a < 2; ++a)
#pragma unroll
            for (int b = 0; b < 2; ++b)
#pragma unroll
                for (int m = 0; m < 4; ++m)
#pragma unroll
                    for (int n = 0; n < 2; ++n) acc[a][b][m][n] = (f32x4){0.f, 0.f, 0.f, 0.f};
        cur = nxt; cA = nA; cB = nB; ++ui;
        if constexpr (GATHER) { vA[0][0] = vAn[0][0]; vA[0][1] = vAn[0][1]; vA[1][0] = vAn[1][0]; vA[1][1] = vAn[1][1]; }
        if (wr == 1) PG8_BAR;
    }
    PG8_WAIT_V(0);
    PG8_BAR;
#undef PG8_SA
#undef PG8_SB
#undef PG8_STAGE_A
#undef PG8_STAGE_B
#undef PG8_LDA
#undef PG8_LD32
#undef PG8_LDB
#undef PG8_MMA
#undef PG8_WAIT_V
#undef PG8_WAIT_L
#undef PG8_BAR
#undef PG8_SCHED
#undef PG8_LOADROWS
#undef PG8_VAN
}
}

struct SchedPlain {
    __device__ __forceinline__ int scale_b8() const { return 0x7f7f7f7f; }
    __device__ __forceinline__ int scale_a8() const { return 0x7f7f7f7f; }
    __device__ __forceinline__ int brow(int r) const { return r; }
    const GAS char* A; const GAS char* B; size_t a_tile, b_tile; int nM, nN, G, c;
    __device__ __forceinline__ bool next(int i, pg8::Unit& u) const {
        int pm, pn; if (!pg8::tile_of((long)i * G + c, nM, nN, pm, pn)) return false;
        u.pm = pm; u.pn = pn; u.z = 0; u.rows = nullptr; u.A = A + (size_t)pm * a_tile; u.B = B + (size_t)pn * b_tile; return true; }
};
struct SchedPc {
    __device__ __forceinline__ int scale_b8() const { return 0x7f7f7f7f; }
    __device__ __forceinline__ int scale_a8() const { return 0x7f7f7f7f; }
    __device__ __forceinline__ int brow(int r) const { return r; }
    const GAS char* Q; const GAS char* Kk; int G, c;
    __device__ __forceinline__ bool next(int i, pg8::Unit& u) const {
        const int L = i * G + c; if (L >= NB * NH * 16) return false;
        const int cp = L & 15, h = (L >> 4) & 3, b = L >> 6;
        const size_t off = ((size_t)(b * SEQ + cp * 256) * QKW + h * DK) * 2;
        u.pm = L; u.pn = 0; u.z = h; u.rows = nullptr; u.A = Q + off; u.B = Kk + off; return true; }
};
struct SchedFnA {
    __device__ __forceinline__ int scale_b8() const { return 0x7f7f7f7f; }
    __device__ __forceinline__ int scale_a8() const { return 0x7f7f7f7f; }
    __device__ __forceinline__ int brow(int r) const { return r; }
    const GAS char* Wc; const GAS char* Hn; int G, c;
    __device__ __forceinline__ bool next(int i, pg8::Unit& u) const {
        int pm, pn; if (!pg8::tile_of((long)i * G + c, 8, T / 256, pm, pn)) return false;
        const int g = pm >> 1, ri = pm & 1;
        u.pm = pm; u.pn = pn; u.z = 0; u.rows = nullptr; u.A = Wc + (size_t)ri * 256 * 256 * 2; u.B = Hn + ((size_t)pn * 256 * D + g * 256) * 2; return true; }
};
struct SchedFnB {
    __device__ __forceinline__ int scale_b8() const { return 0x7f7f7f7f; }
    __device__ __forceinline__ int scale_a8() const { return 0x7f7f7f7f; }
    __device__ __forceinline__ int brow(int r) const { return (r & 63) * 8 + (r >> 6); }
    GAS const char* WY; GAS const char* U; int G, c;
    __device__ __forceinline__ bool next(int i, pg8::Unit& u) const {
        int pm, pn; if (!pg8::tile_of((long)i * G + c, 2, 256, pm, pn)) return false;
        const int batch = pn >> 5, fb = (pn >> 1) & 15, kbb = pn & 1;
        u.pm = pm; u.pn = pn; u.z = 0; u.rows = nullptr; u.A = WY + (size_t)pm * 256 * 1024 * 2; u.B = U + ((size_t)(batch * 1024 + fb * 64) * 8 + kbb * 4) * 1024 * 2; return true; }
};
struct SchedMoe {
    __device__ __forceinline__ int scale_b8() const { return 0x79797979; }
    __device__ __forceinline__ int scale_a8() const { return sa8; }
    __device__ __forceinline__ int brow(int r) const { return r; }
    const GAS char* A; const GAS char* W; const GAS int* rowtok; const LAS unsigned char* texp; size_t a_tile, w_exp, w_tile; int ntiles, ncol, G, c; bool gather; int sa8;
    __device__ __forceinline__ bool next(int i, pg8::Unit& u) const {
        int rt, ct; if (!pg8::tile_of((long)i * G + c, ntiles, ncol, rt, ct)) return false;
        const int e = texp[rt];
        u.pm = rt; u.pn = ct; u.z = e; u.rows = rowtok + rt * 256; u.A = gather ? A : A + (size_t)rt * a_tile; u.B = W + (size_t)e * w_exp + (size_t)ct * w_tile; return true; }
};

struct EpiRopeQK {
    static constexpr bool PERM = true;
    GAS bf16* Q; GAS bf16* Kk; const GAS f32x2* rot;
    __device__ __forceinline__ void operator()(const f32x4 (&acc)[2][2][4][2], const pg8::Unit& u, int wr, int wc, int fr, int fq) const {
        const bool isk = u.pn >= 4; const int h = u.pn & 3; GAS bf16* dst = isk ? Kk : Q; const float sc = isk ? 0.0625f : 1.0f;
        const int i0 = wc * 32 + 8 * fq;
#pragma unroll
        for (int ai = 0; ai < 2; ++ai)
#pragma unroll
            for (int m = 0; m < 4; ++m) {
                const int t = u.pm * 256 + ai * 128 + wr * 64 + m * 16 + fr, s = t & (SEQ - 1);
                const GAS f32x4* rp = (const GAS f32x4*)(rot + (size_t)s * 128 + i0);
                const f32x4 r0 = rp[0], r1 = rp[1], r2 = rp[2], r3 = rp[3];
                const float cs[8] = {r0[0], r0[2], r1[0], r1[2], r2[0], r2[2], r3[0], r3[2]}, sn[8] = {r0[1], r0[3], r1[1], r1[3], r2[1], r2[3], r3[1], r3[3]};
                float o1[8], o2[8];
#pragma unroll
                for (int n = 0; n < 2; ++n)
#pragma unroll
                    for (int j = 0; j < 4; ++j) { const float t1 = acc[ai][0][m][n][j], t2 = acc[ai][1][m][n][j]; const int q = 4 * n + j;
                        o1[q] = (t1 * cs[q] - t2 * sn[q]) * sc; o2[q] = (t1 * sn[q] + t2 * cs[q]) * sc; }
                GAS bf16* rowp = dst + (size_t)t * QKW + h * DK + i0;
                u32x4 w1, w2; w1.x = cvt_pk_bf16(o1[0], o1[1]); w1.y = cvt_pk_bf16(o1[2], o1[3]); w1.z = cvt_pk_bf16(o1[4], o1[5]); w1.w = cvt_pk_bf16(o1[6], o1[7]);
                w2.x = cvt_pk_bf16(o2[0], o2[1]); w2.y = cvt_pk_bf16(o2[2], o2[3]); w2.z = cvt_pk_bf16(o2[4], o2[5]); w2.w = cvt_pk_bf16(o2[6], o2[7]);
                *(GAS u32x4*)rowp = w1; *(GAS u32x4*)(rowp + 128) = w2; }
    }
};
struct EpiRopeKT {
    static constexpr bool PERM = true;
    GAS bf16* KT; const GAS f32x2* rotT; const LAS float* l2g;
    __device__ __forceinline__ void operator()(const f32x4 (&acc)[2][2][4][2], const pg8::Unit& u, int wr, int wc, int fr, int fq) const {
        const int h = u.pm; const float l2f = l2g[h], l2b = l2g[4 + h];
#pragma unroll
        for (int bj = 0; bj < 2; ++bj) {
            const int tok0 = u.pn * 256 + bj * 128 + wc * 32 + 8 * fq, s0 = tok0 & (SEQ - 1), j0 = tok0 & (CH - 1);
            float zf[8], zb[8];
#pragma unroll
            for (int q = 0; q < 8; ++q) { zf[q] = fast_exp2((float)(CH - 1 - (j0 + q)) * l2f) * 0.0625f; zb[q] = fast_exp2((float)(j0 + q) * l2b) * 0.0625f; }
#pragma unroll
            for (int m = 0; m < 4; ++m) { const int i = wr * 64 + m * 16 + fr;
                const GAS f32x4* rp = (const GAS f32x4*)(rotT + (size_t)i * RTP + s0);
                const f32x4 r0 = rp[0], r1 = rp[1], r2 = rp[2], r3 = rp[3];
                const float cs[8] = {r0[0], r0[2], r1[0], r1[2], r2[0], r2[2], r3[0], r3[2]}, sn[8] = {r0[1], r0[3], r1[1], r1[3], r2[1], r2[3], r3[1], r3[3]};
                float o1[8], o2[8];
#pragma unroll
                for (int n = 0; n < 2; ++n)
#pragma unroll
                    for (int j = 0; j < 4; ++j) { const float t1 = acc[0][bj][m][n][j], t2 = acc[1][bj][m][n][j]; const int q = 4 * n + j;
                        o1[q] = t1 * cs[q] - t2 * sn[q]; o2[q] = t1 * sn[q] + t2 * cs[q]; }
                u32x4 w1, w2;
                w1.x = cvt_pk_bf16(o1[0] * zf[0], o1[1] * zf[1]); w1.y = cvt_pk_bf16(o1[2] * zf[2], o1[3] * zf[3]); w1.z = cvt_pk_bf16(o1[4] * zf[4], o1[5] * zf[5]); w1.w = cvt_pk_bf16(o1[6] * zf[6], o1[7] * zf[7]);
                w2.x = cvt_pk_bf16(o2[0] * zf[0], o2[1] * zf[1]); w2.y = cvt_pk_bf16(o2[2] * zf[2], o2[3] * zf[3]); w2.z = cvt_pk_bf16(o2[4] * zf[4], o2[5] * zf[5]); w2.w = cvt_pk_bf16(o2[6] * zf[6], o2[7] * zf[7]);
                const size_t fr0 = ((((size_t)((tok0 >> 12) * NH + h) * NCH + ((tok0 & (SEQ - 1)) >> 7)) * 8 + (i >> 5)) * 8 + (2 * wc + (fq >> 1))) * 512 + ((i & 31) + 32 * (fq & 1)) * 8;
                *(GAS u32x4*)(KT + fr0) = w1; *(GAS u32x4*)(KT + fr0 + (size_t)4 * 8 * 512) = w2;
                w1.x = cvt_pk_bf16(o1[0] * zb[0], o1[1] * zb[1]); w1.y = cvt_pk_bf16(o1[2] * zb[2], o1[3] * zb[3]); w1.z = cvt_pk_bf16(o1[4] * zb[4], o1[5] * zb[5]); w1.w = cvt_pk_bf16(o1[6] * zb[6], o1[7] * zb[7]);
                w2.x = cvt_pk_bf16(o2[0] * zb[0], o2[1] * zb[1]); w2.y = cvt_pk_bf16(o2[2] * zb[2], o2[3] * zb[3]); w2.z = cvt_pk_bf16(o2[4] * zb[4], o2[5] * zb[5]); w2.w = cvt_pk_bf16(o2[6] * zb[6], o2[7] * zb[7]);
                *(GAS u32x4*)(KT + (size_t)QKW * T + fr0) = w1; *(GAS u32x4*)(KT + (size_t)QKW * T + fr0 + (size_t)4 * 8 * 512) = w2; } }
    }
};
template <bool ROT> struct EpiBf16 {
    static constexpr bool PERM = true;
    GAS bf16* O; int ldc;
    __device__ __forceinline__ void operator()(const f32x4 (&acc)[2][2][4][2], const pg8::Unit& u, int wr, int wc, int fr, int fq) const {
#pragma unroll
        for (int ai = 0; ai < 2; ++ai)
#pragma unroll
            for (int m = 0; m < 4; ++m) { const int row = u.pm * 256 + ai * 128 + wr * 64 + m * 16 + fr; GAS bf16* rowp = O + (size_t)row * ldc;
#pragma unroll
                for (int bj = 0; bj < 2; ++bj) { const f32x4 v0 = acc[ai][bj][m][0], v1 = acc[ai][bj][m][1]; const int col = u.pn * 256 + bj * 128 + wc * 32 + 8 * fq;
                    u32x4 w; w.x = cvt_pk_bf16(v0[0], v0[1]); w.y = cvt_pk_bf16(v0[2], v0[3]); w.z = cvt_pk_bf16(v1[0], v1[1]); w.w = cvt_pk_bf16(v1[2], v1[3]);
                    *(GAS u32x4*)(rowp + (ROT ? rot_col(row, col) : col)) = w; } }
    }
};
struct EpiPc {
    static constexpr bool PERM = true;
    GAS bf16* PC; GAS bf16* PD; const LAS float* l2g;
    __device__ __forceinline__ void operator()(const f32x4 (&acc)[2][2][4][2], const pg8::Unit& u, int wr, int wc, int fr, int fq) const {
        const int h = u.z; const float l2f = l2g[h], l2b = l2g[4 + h];
#pragma unroll
        for (int ai = 0; ai < 2; ++ai)
#pragma unroll
            for (int m = 0; m < 4; ++m) { const int il = wr * 64 + m * 16 + fr, jl0 = wc * 32 + 8 * fq; float o[8];
                const bool diag = (wc == 2 * wr + (m >> 1));
#pragma unroll
                for (int n = 0; n < 2; ++n)
#pragma unroll
                    for (int j = 0; j < 4; ++j) { const int dl = il - (jl0 + 4 * n + j); const float f = dl >= 0 ? fast_exp2((float)dl * l2f) : fast_exp2((float)(-dl) * l2b);
                        o[4 * n + j] = (ai == 0 ? acc[0][0][m][n][j] : acc[1][1][m][n][j]) * f; }
                if (diag) {
                    float ob[8];
#pragma unroll
                    for (int q = 0; q < 8; ++q) { const bool lower = (jl0 + q) <= il; ob[q] = lower ? 0.f : o[q]; o[q] = lower ? o[q] : 0.f; }
                    u32x4 wb; wb.x = cvt_pk_bf16(ob[0], ob[1]); wb.y = cvt_pk_bf16(ob[2], ob[3]); wb.z = cvt_pk_bf16(ob[4], ob[5]); wb.w = cvt_pk_bf16(ob[6], ob[7]);
                    *(GAS u32x4*)(PD + ((((size_t)(u.pm * 2 + ai) * 4 + (il >> 5)) * 2 + (fq >> 1)) * 512 + ((il & 31) + 32 * (fq & 1)) * 8)) = wb;
                }
                u32x4 w; w.x = cvt_pk_bf16(o[0], o[1]); w.y = cvt_pk_bf16(o[2], o[3]); w.z = cvt_pk_bf16(o[4], o[5]); w.w = cvt_pk_bf16(o[6], o[7]);
                *(GAS u32x4*)(PC + ((((size_t)(u.pm * 2 + ai) * 4 + (il >> 5)) * 8 + (2 * wc + (fq >> 1))) * 512 + ((il & 31) + 32 * (fq & 1)) * 8)) = w; }
    }
};
struct EpiGate {
    static constexpr bool PERM = true;
    const GAS bf16* Y; GAS bf16* YG; const GAS f32x2* statp; const GAS float* gain; LAS f32x2* sst;
    __device__ __forceinline__ void operator()(const f32x4 (&acc)[2][2][4][2], const pg8::Unit& u, int wr, int wc, int fr, int fq) const {
        const int head = u.pn >> 1, c0 = u.pn * 256 + wc * 32 + 8 * fq;
        const int tid = (wr * 4 + wc) * 64 + fq * 16 + fr;
        if (tid < 256) { const int t = u.pm * 256 + tid; const GAS f32x4* sp = (const GAS f32x4*)(statp + ((size_t)t * 4 + head) * 8); float a1 = 0.f, a2 = 0.f;
#pragma unroll
            for (int k = 0; k < 4; ++k) { const f32x4 v = sp[k]; a1 += v[0] + v[2]; a2 += v[1] + v[3]; }
            const float mu = a1 * (1.f / DV), var = fmaxf(a2 * (1.f / DV) - mu * mu, 0.f); sst[tid] = (f32x2){mu, __builtin_amdgcn_rsqf(var + EPS)}; }
        asm volatile("s_waitcnt lgkmcnt(0)" ::: "memory"); __builtin_amdgcn_s_barrier(); asm volatile("" ::: "memory");
        f32x4 gv[2][2];
#pragma unroll
        for (int bj = 0; bj < 2; ++bj) { gv[bj][0] = *(const GAS f32x4*)(gain + c0 + bj * 128); gv[bj][1] = *(const GAS f32x4*)(gain + c0 + bj * 128 + 4); }
#pragma unroll
        for (int ai = 0; ai < 2; ++ai)
#pragma unroll
            for (int m = 0; m < 4; ++m) { const int rl = ai * 128 + wr * 64 + m * 16 + fr, t = u.pm * 256 + rl; const f32x2 st = sst[rl];
#pragma unroll
                for (int bj = 0; bj < 2; ++bj) { const size_t off = (size_t)t * VW + c0 + bj * 128;
                    const int es_ = (u.pn & 1) * 4 + bj * 2 + (wc >> 1);
                    const u32x4 yv = *(const GAS u32x4*)(Y + (((size_t)(t >> 5) * NH + head) * 8 + es_) * 2048 + (((wc & 1) * 2 + (fq >> 1)) * 64 + (t & 31) + 32 * (fq & 1)) * 8);
                    const float y[8] = {bf_lo(yv.x), bf_hi(yv.x), bf_lo(yv.y), bf_hi(yv.y), bf_lo(yv.z), bf_hi(yv.z), bf_lo(yv.w), bf_hi(yv.w)}; float o[8];
#pragma unroll
                    for (int n = 0; n < 2; ++n)
#pragma unroll
                        for (int j = 0; j < 4; ++j) { const int q = 4 * n + j; const float yn = (y[q] - st.x) * st.y * gv[bj][n][j]; o[q] = silu_f(acc[ai][bj][m][n][j]) * yn; }
                    u32x4 w; w.x = cvt_pk_bf16(o[0], o[1]); w.y = cvt_pk_bf16(o[2], o[3]); w.z = cvt_pk_bf16(o[4], o[5]); w.w = cvt_pk_bf16(o[6], o[7]);
                    *(GAS u32x4*)(YG + off) = w; } }
    }
};
template <bool BASE_F32> struct EpiRes {
    static constexpr bool PERM = true;
    const GAS void* base; GAS bf16* out;
    __device__ __forceinline__ void operator()(const f32x4 (&acc)[2][2][4][2], const pg8::Unit& u, int wr, int wc, int fr, int fq) const {
#pragma unroll
        for (int ai = 0; ai < 2; ++ai)
#pragma unroll
            for (int m = 0; m < 4; ++m) { const size_t off = (size_t)(u.pm * 256 + ai * 128 + wr * 64 + m * 16 + fr) * D + u.pn * 256 + wc * 32 + 8 * fq;
#pragma unroll
                for (int bj = 0; bj < 2; ++bj) { f32x4 v0 = acc[ai][bj][m][0], v1 = acc[ai][bj][m][1];
                    if (BASE_F32) { const GAS float* bp = (const GAS float*)base + off + bj * 128; v0 += *(const GAS f32x4*)bp; v1 += *(const GAS f32x4*)(bp + 4); }
                    else { const u32x4 bv = *(const GAS u32x4*)((const GAS bf16*)base + off + bj * 128);
                        v0 += (f32x4){bf_lo(bv.x), bf_hi(bv.x), bf_lo(bv.y), bf_hi(bv.y)}; v1 += (f32x4){bf_lo(bv.z), bf_hi(bv.z), bf_lo(bv.w), bf_hi(bv.w)}; }
                    u32x4 w; w.x = cvt_pk_bf16(v0[0], v0[1]); w.y = cvt_pk_bf16(v0[2], v0[3]); w.z = cvt_pk_bf16(v1[0], v1[1]); w.w = cvt_pk_bf16(v1[2], v1[3]);
                    *(GAS u32x4*)(out + off + bj * 128) = w; } }
    }
};
template <bool OUT8> struct EpiSwiGLU {
    static constexpr bool PERM = true;
    GAS void* ACT; int ldc;
    __device__ __forceinline__ void operator()(const f32x4 (&acc)[2][2][4][2], const pg8::Unit& u, int wr, int wc, int fr, int fq) const {
#pragma unroll
        for (int ai = 0; ai < 2; ++ai)
#pragma unroll
            for (int m = 0; m < 4; ++m) { float o[8];
#pragma unroll
                for (int n = 0; n < 2; ++n)
#pragma unroll
                    for (int j = 0; j < 4; ++j) o[4 * n + j] = silu_f(acc[ai][0][m][n][j]) * acc[ai][1][m][n][j];
                const size_t off = (size_t)(u.pm * 256 + ai * 128 + wr * 64 + m * 16 + fr) * ldc + u.pn * 128 + wc * 32 + 8 * fq;
                if constexpr (OUT8) { u32x2 w; w.x = pk4_fp8(o[0] * 8.f, o[1] * 8.f, o[2] * 8.f, o[3] * 8.f); w.y = pk4_fp8(o[4] * 8.f, o[5] * 8.f, o[6] * 8.f, o[7] * 8.f); *(GAS u32x2*)((GAS unsigned char*)ACT + off) = w; }
                else { u32x4 w; w.x = cvt_pk_bf16(o[0], o[1]); w.y = cvt_pk_bf16(o[2], o[3]); w.z = cvt_pk_bf16(o[4], o[5]); w.w = cvt_pk_bf16(o[6], o[7]); *(GAS u32x4*)((GAS bf16*)ACT + off) = w; } }
    }
};
struct EpiZ2 {
    static constexpr bool PERM = true;
    GAS bf16* Z2;
    __device__ __forceinline__ void operator()(const f32x4 (&acc)[2][2][4][2], const pg8::Unit& u, int wr, int wc, int fr, int fq) const {
        const int g = u.pm >> 1, ri = u.pm & 1;
#pragma unroll
        for (int ai = 0; ai < 2; ++ai)
#pragma unroll
            for (int m = 0; m < 4; ++m) { const int cp = ai * 128 + wr * 64 + m * 16 + fr;
#pragma unroll
                for (int bj = 0; bj < 2; ++bj) { const int tok0 = u.pn * 256 + bj * 128 + wc * 32 + 8 * fq, b = tok0 >> 12, s0 = tok0 & (SEQ - 1);
                    const f32x4 v0 = acc[ai][bj][m][0], v1 = acc[ai][bj][m][1];
                    u32x4 w; w.x = cvt_pk_bf16(v0[0], v0[1]); w.y = cvt_pk_bf16(v0[2], v0[3]); w.z = cvt_pk_bf16(v1[0], v1[1]); w.w = cvt_pk_bf16(v1[2], v1[3]);
                    *(GAS u32x4*)(Z2 + ((size_t)(b * 1024 + g * 256 + cp) * 8192 + ri * SEQ + s0)) = w; } }
    }
};
struct EpiYf {
    static constexpr bool PERM = true;
    GAS bf16* YF;
    __device__ __forceinline__ void operator()(const f32x4 (&acc)[2][2][4][2], const pg8::Unit& u, int wr, int wc, int fr, int fq) const {
        const int batch = u.pn >> 5, fb = (u.pn >> 1) & 15, kbb = u.pn & 1;
#pragma unroll
        for (int ai = 0; ai < 2; ++ai)
#pragma unroll
            for (int m = 0; m < 4; ++m) { const int ka = u.pm * 256 + ai * 128 + wr * 64 + m * 16 + fr;
#pragma unroll
                for (int bj = 0; bj < 2; ++bj) { const int kb = kbb * 4 + 2 * bj + (wc >> 1), f = fb * 64 + 32 * (wc & 1) + 8 * fq;
                    const f32x4 v0 = acc[ai][bj][m][0], v1 = acc[ai][bj][m][1];
                    u32x4 w; w.x = cvt_pk_bf16(v0[0], v0[1]); w.y = cvt_pk_bf16(v0[2], v0[3]); w.z = cvt_pk_bf16(v1[0], v1[1]); w.w = cvt_pk_bf16(v1[2], v1[3]);
                    *(GAS u32x4*)(YF + (size_t)(batch * SEQ + 8 * ka + kb) * D + f) = w; } }
    }
};
struct EpiMoeDown {
    static constexpr bool PERM = true;
    GAS bf16* Hres; const GAS int* rowtok; const GAS float* rowgate;
    __device__ __forceinline__ void operator()(const f32x4 (&acc)[2][2][4][2], const pg8::Unit& u, int wr, int wc, int fr, int fq) const {
#pragma unroll
        for (int ai = 0; ai < 2; ++ai)
#pragma unroll
            for (int m = 0; m < 4; ++m) { const int row = u.pm * 256 + ai * 128 + wr * 64 + m * 16 + fr; const int tok = rowtok[row]; const float gw = rowgate[row];
                if (tok >= 0) { GAS bf16* rp = Hres + (size_t)tok * D + u.pn * 256 + wc * 32 + 8 * fq;
#pragma unroll
                    for (int bj = 0; bj < 2; ++bj) { const u32x4 bv = *(const GAS u32x4*)(rp + bj * 128);
                        const f32x4 v0 = (f32x4){bf_lo(bv.x), bf_hi(bv.x), bf_lo(bv.y), bf_hi(bv.y)} + gw * acc[ai][bj][m][0], v1 = (f32x4){bf_lo(bv.z), bf_hi(bv.z), bf_lo(bv.w), bf_hi(bv.w)} + gw * acc[ai][bj][m][1];
                        u32x4 w; w.x = cvt_pk_bf16(v0[0], v0[1]); w.y = cvt_pk_bf16(v0[2], v0[3]); w.z = cvt_pk_bf16(v1[0], v1[1]); w.w = cvt_pk_bf16(v1[2], v1[3]);
                        *(GAS u32x4*)(rp + bj * 128) = w; } } }
    }
};

#define XB_TMO      128
#define XB_XCNT(j)  (256  + 64 * (j))
#define XB_XSUB(j)  (1280 + 64 * (j))
#define XB_XGEN(j)  (2304 + 64 * (j))
#define XB_TOP      3328
#define XB_TOPGEN   3392
#define XCD_BAR_WORDS 3456
#define XB_SPIN_CAP (1u << 18)
__device__ __forceinline__ unsigned xb_ld(unsigned* p)              { return __hip_atomic_load(p, __ATOMIC_RELAXED, __HIP_MEMORY_SCOPE_AGENT); }
__device__ __forceinline__ unsigned xb_add(unsigned* p, unsigned v) { return __hip_atomic_fetch_add(p, v, __ATOMIC_RELAXED, __HIP_MEMORY_SCOPE_AGENT); }
__device__ __forceinline__ unsigned xb_xcc_id() { return (unsigned)__builtin_amdgcn_s_getreg((3 << 11) | 20) & 0xFu; }
#define XB_SPIN(cond, bar) do { unsigned _sp = 0; while (cond) { __builtin_amdgcn_s_sleep(1); \
    if ((++_sp & 255u) == 0u) { if (xb_ld(&(bar)[XB_TMO])) break; if (_sp > XB_SPIN_CAP) { atomicAdd(&(bar)[XB_TMO], 1u); break; } } } } while (0)
struct XcdBarrier { unsigned* bar; unsigned x; volatile LAS unsigned* st; };
__device__ __forceinline__ XcdBarrier xcd_barrier_post(unsigned* bar, volatile LAS unsigned* st, const bool t0) {
    XcdBarrier b; b.bar = bar; b.x = xb_xcc_id(); b.st = st;
    if (t0) (void)xb_add(&bar[XB_XCNT(b.x)], 1u);
    return b;
}
__device__ __forceinline__ void xcd_barrier_complete(unsigned* bar, unsigned x, unsigned& nloc, unsigned& nx) {
    const unsigned G = gridDim.x * gridDim.y * gridDim.z;
    unsigned sum, cnt, mine, sp = 0u;
    for (;;) {
        sum = 0u; cnt = 0u; mine = 0u;
#pragma unroll
        for (unsigned j = 0; j < 16; ++j) { const unsigned c = xb_ld(&bar[XB_XCNT(j)]); sum += c; cnt += (c > 0u) ? 1u : 0u; mine = (j == x) ? c : mine; }
        if (sum == G) break;
        __builtin_amdgcn_s_sleep(1);
        if ((++sp & 255u) == 0u) { if (xb_ld(&bar[XB_TMO])) break; if (sp > XB_SPIN_CAP) { atomicAdd(&bar[XB_TMO], 1u); break; } }
    }
    nloc = mine > 0u ? mine : 1u; nx = cnt > 0u ? cnt : 1u;
}
__device__ __forceinline__ void xcd_barrier(const XcdBarrier& b, const bool t0) {
    asm volatile("s_waitcnt vmcnt(0)" ::: "memory");
    __syncthreads();
    if (t0) {
        unsigned* bar = b.bar;
        __builtin_amdgcn_s_waitcnt(0);
        unsigned nloc = b.st[0], nx = b.st[1];
        if (nloc == 0u) { xcd_barrier_complete(bar, b.x, nloc, nx); b.st[0] = nloc; b.st[1] = nx; }
        const unsigned old = xb_add(&bar[XB_XSUB(b.x)], 1u);
        const unsigned gen = old / nloc;
        if (old + 1u == (gen + 1u) * nloc) {
            __builtin_amdgcn_fence(__ATOMIC_RELEASE, "agent");
            asm volatile("s_waitcnt vmcnt(0)" ::: "memory");
            const unsigned og = xb_add(&bar[XB_TOP], 1u);
            const unsigned tg = og / nx;
            if (og + 1u == (tg + 1u) * nx) xb_add(&bar[XB_TOPGEN], 1u);
            else XB_SPIN(xb_ld(&bar[XB_TOPGEN]) == tg, bar);
            __builtin_amdgcn_fence(__ATOMIC_ACQUIRE, "agent");
            xb_add(&bar[XB_XGEN(b.x)], 1u);
            asm volatile("s_waitcnt vmcnt(0)" ::: "memory");
        } else {
            XB_SPIN(xb_ld(&bar[XB_XGEN(b.x)]) == gen, bar);
            __builtin_amdgcn_fence(__ATOMIC_ACQUIRE, "agent");
            asm volatile("s_waitcnt vmcnt(0)" ::: "memory");
        }
    }
    __syncthreads();
}

__device__ __forceinline__ float wave_sum(float v) {
#pragma unroll
    for (int o = 1; o < 64; o <<= 1) v += __shfl_xor(v, o);
    return v;
}
__device__ __forceinline__ void transpose_item(const GAS float* W, int K, int N, GAS bf16* WT, int k0, int n0, int rbase, LAS float* scr, int lane) {
#pragma unroll 8
    for (int i = 0; i < 32; ++i) { const int kk = 2 * i + (lane >> 5); scr[kk * 33 + (lane & 31)] = W[(size_t)(k0 + kk) * N + n0 + (lane & 31)]; }
    LDS_WAIT(); asm volatile("" ::: "memory");
    const int c = lane & 7;
#pragma unroll
    for (int j = 0; j < 4; ++j) { const int n = (lane >> 3) + 8 * j; const LAS float* s = scr + (8 * c) * 33 + n;
        u32x4 o; o.x = cvt_pk_bf16(s[0 * 33], s[1 * 33]); o.y = cvt_pk_bf16(s[2 * 33], s[3 * 33]); o.z = cvt_pk_bf16(s[4 * 33], s[5 * 33]); o.w = cvt_pk_bf16(s[6 * 33], s[7 * 33]);
        *(GAS u32x4*)(WT + (size_t)(rbase + n) * K + k0 + 8 * c) = o; }
    LDS_WAIT(); asm volatile("" ::: "memory");
}
__device__ __forceinline__ void transpose_item8(const GAS float* W, int K, int N, GAS unsigned char* WT8, int k0, int n0, int rbase, float scale, LAS float* scr, int lane) {
#pragma unroll 8
    for (int i = 0; i < 32; ++i) { const int kk = 2 * i + (lane >> 5); scr[kk * 33 + (lane & 31)] = W[(size_t)(k0 + kk) * N + n0 + (lane & 31)]; }
    LDS_WAIT(); asm volatile("" ::: "memory");
    const int c = lane & 7;
#pragma unroll
    for (int j = 0; j < 4; ++j) { const int n = (lane >> 3) + 8 * j; const LAS float* sp = scr + (8 * c) * 33 + n;
        u32x2 o; o.x = pk4_fp8(sp[0 * 33] * scale, sp[1 * 33] * scale, sp[2 * 33] * scale, sp[3 * 33] * scale); o.y = pk4_fp8(sp[4 * 33] * scale, sp[5 * 33] * scale, sp[6 * 33] * scale, sp[7 * 33] * scale);
        *(GAS u32x2*)(WT8 + (size_t)(rbase + n) * K + k0 + 8 * c) = o; }
    LDS_WAIT(); asm volatile("" ::: "memory");
}
__device__ __forceinline__ void tr_gu8(const GAS float* Wg, const GAS float* Wu, int K, int N, GAS unsigned char* WT8, int it, LAS float* scr, int lane) {
    const int nblk = N / 32, per = (K / 64) * nblk; const bool up = it >= per; if (up) it -= per;
    const int kb = it / nblk, nb = it - kb * nblk, f0 = 32 * nb;
    transpose_item8(up ? Wu : Wg, K, N, WT8, 64 * kb, f0, 256 * (f0 >> 7) + (up ? 128 : 0) + (f0 & 127), 64.0f, scr, lane);
}
__device__ __forceinline__ void tr_plain(const GAS float* W, int K, int N, GAS bf16* WT, int it, LAS float* scr, int lane) {
    const int nblk = N / 32, kb = it / nblk, nb = it - kb * nblk; transpose_item(W, K, N, WT, 64 * kb, 32 * nb, 32 * nb, scr, lane);
}
__device__ __forceinline__ void tr_gu(const GAS float* Wg, const GAS float* Wu, int K, int N, GAS bf16* WT, int it, LAS float* scr, int lane) {
    const int nblk = N / 32, per = (K / 64) * nblk; const bool up = it >= per; if (up) it -= per;
    const int kb = it / nblk, nb = it - kb * nblk, f0 = 32 * nb;
    transpose_item(up ? Wu : Wg, K, N, WT, 64 * kb, f0, 256 * (f0 >> 7) + (up ? 128 : 0) + (f0 & 127), scr, lane);
}
__device__ __forceinline__ void rms_row(const GAS float* xrow, const GAS float* g, GAS bf16* orow, int lane, f32x4 (&v)[4]) {
    const GAS f32x4* xr = (const GAS f32x4*)xrow + lane; const GAS f32x4* gr = (const GAS f32x4*)g + lane;
    float s = 0.f;
#pragma unroll
    for (int j = 0; j < 4; ++j) { v[j] = xr[64 * j]; s += (v[j].x * v[j].x + v[j].y * v[j].y) + (v[j].z * v[j].z + v[j].w * v[j].w); }
    const float r = 1.0f / sqrtf(wave_sum(s) * (1.f / D) + EPS);
    GAS u32x2* o8 = (GAS u32x2*)orow + lane;
#pragma unroll
    for (int j = 0; j < 4; ++j) { v[j] = v[j] * r * gr[64 * j]; u32x2 w; w.x = cvt_pk_bf16(v[j].x, v[j].y); w.y = cvt_pk_bf16(v[j].z, v[j].w); o8[64 * j] = w; }
}
__device__ __forceinline__ int rmsb_col(int j, int lane) { return 512 * (j >> 1) + 8 * lane + 4 * (j & 1); }
__device__ __forceinline__ void rms_row_b(const GAS bf16* hrow, const GAS float* g, GAS bf16* orow, int lane, f32x4 (&v)[4]) {
    float s = 0.f;
#pragma unroll
    for (int jh = 0; jh < 2; ++jh) { const u32x4 x = *(const GAS u32x4*)(hrow + 512 * jh + 8 * lane);
        v[2 * jh] = (f32x4){bf_lo(x.x), bf_hi(x.x), bf_lo(x.y), bf_hi(x.y)}; v[2 * jh + 1] = (f32x4){bf_lo(x.z), bf_hi(x.z), bf_lo(x.w), bf_hi(x.w)}; }
#pragma unroll
    for (int j = 0; j < 4; ++j) s += (v[j].x * v[j].x + v[j].y * v[j].y) + (v[j].z * v[j].z + v[j].w * v[j].w);
    const float r = 1.0f / sqrtf(wave_sum(s) * (1.f / D) + EPS);
#pragma unroll
    for (int jh = 0; jh < 2; ++jh) { const GAS float* gp = g + 512 * jh + 8 * lane; v[2 * jh] = v[2 * jh] * r * *(const GAS f32x4*)gp; v[2 * jh + 1] = v[2 * jh + 1] * r * *(const GAS f32x4*)(gp + 4);
        u32x4 w; w.x = cvt_pk_bf16(v[2 * jh].x, v[2 * jh].y); w.y = cvt_pk_bf16(v[2 * jh].z, v[2 * jh].w); w.z = cvt_pk_bf16(v[2 * jh + 1].x, v[2 * jh + 1].y); w.w = cvt_pk_bf16(v[2 * jh + 1].z, v[2 * jh + 1].w);
        *(GAS u32x4*)(orow + 512 * jh + 8 * lane) = w; }
}

__device__ __forceinline__ void rms_row_b8(const GAS bf16* hrow, const GAS float* g, GAS unsigned char* o8, int lane, f32x4 (&v)[4]) {
    float s = 0.f;
#pragma unroll
    for (int jh = 0; jh < 2; ++jh) { const u32x4 x = *(const GAS u32x4*)(hrow + 512 * jh + 8 * lane);
        v[2 * jh] = (f32x4){bf_lo(x.x), bf_hi(x.x), bf_lo(x.y), bf_hi(x.y)}; v[2 * jh + 1] = (f32x4){bf_lo(x.z), bf_hi(x.z), bf_lo(x.w), bf_hi(x.w)}; }
#pragma unroll
    for (int j = 0; j < 4; ++j) s += (v[j].x * v[j].x + v[j].y * v[j].y) + (v[j].z * v[j].z + v[j].w * v[j].w);
    const float r = 1.0f / sqrtf(wave_sum(s) * (1.f / D) + EPS);
#pragma unroll
    for (int jh = 0; jh < 2; ++jh) { const GAS float* gp = g + 512 * jh + 8 * lane; v[2 * jh] = v[2 * jh] * r * *(const GAS f32x4*)gp; v[2 * jh + 1] = v[2 * jh + 1] * r * *(const GAS f32x4*)(gp + 4);
        u32x2 w; w.x = pk4_fp8(v[2 * jh].x, v[2 * jh].y, v[2 * jh].z, v[2 * jh].w); w.y = pk4_fp8(v[2 * jh + 1].x, v[2 * jh + 1].y, v[2 * jh + 1].z, v[2 * jh + 1].w);
        *(GAS u32x2*)(o8 + 512 * jh + 8 * lane) = w; }
}

constexpr int SW_QL = 0, SW_SPITCH = 528, SW_SL = 128 * 528, SW_VPITCH = 272, SW_VL = SW_SL + 64 * SW_SPITCH, SW_VB = 64 * SW_VPITCH;
static_assert(SW_VL + 2 * SW_VB <= 139264, "sweep LDS");
template <bool OUT> __device__ __forceinline__ void sweep_role(LAS unsigned char* lds, const GAS bf16* Qg, const GAS bf16* KTFg, const GAS bf16* KTBg, const GAS bf16* VTg, const GAS bf16* PCg, const GAS bf16* PDg, const GAS bf16* ZEROg, GAS bf16* Yg, GAS f32x2* statp, const float l2f, const float l2b, int b, int h, int es, const int wave_s) {
    const int tid = tid_of(wave_s);
    const int w = __builtin_amdgcn_readfirstlane(tid >> 6), lane = tid & 63, r32 = lane & 31, hh = lane >> 5;
    const int rb = w & 3;
    const int vrow = tid >> 4, vpc = tid & 15;
    const int qrow = tid >> 5, qpc = tid & 31;
    const GAS bf16* qp = Qg + (size_t)(b * SEQ + qrow) * QKW + h * DK + 8 * qpc;
    const GAS bf16* vtp = VTg + (size_t)(h * DV + 64 * es + vrow) * T + 8 * vpc; const int vrot = b * SEQ + ((vrow & 15) << 11);
    const int il = 32 * rb + r32;
    const GAS bf16* pcp = PCg + (((size_t)((b * NH + h) * NCH) * 4 + rb) * 8) * 512 + lane * 8;
    const GAS bf16* pdp = PDg + (((size_t)((b * NH + h) * NCH) * 4 + rb) * 2) * 512 + lane * 8;
    GAS bf16* yp = Yg + ((size_t)(((b * SEQ) >> 5) + rb) * NH + h) * 8 * 2048 + (size_t)es * 2048 + lane * 8;
    GAS f32x2* stp = statp + ((size_t)(b * SEQ + il) * NH + h) * 8 + es;
    const size_t kto = ((size_t)((b * NH + h) * NCH) * 8 + 2 * rb) * 8 * 512 + lane * 8;
#define SW_LDP(dst, s_, d_, nn_) do { const int jb_ = (s_) >> 1; const bool use_ = (d_) ? (jb_ >= rb) : (jb_ <= rb); const bool dg_ = (d_) && (jb_ == rb); \
        const GAS bf16* src_ = dg_ ? (pdp + (size_t)(nn_) * 4096 + 512 * ((s_) & 1)) : (pcp + (size_t)(nn_) * (CH * CH) + 512 * (s_)); \
        dst = *(const GAS bf16x8*)(use_ ? src_ : ZEROg); } while (0)
#define SW_SCHED __builtin_amdgcn_sched_barrier(0)
#define SW_MFMA(a, b, c) c = __builtin_amdgcn_mfma_f32_32x32x16_bf16(a, b, c, 0, 0, 0)
    bf16x8 pa[8];
    bf16x8 ka[2][8];
    u32x4 vv[2], qv[4];
    f32x16 Sacc[2][2];
    if constexpr (OUT) {
#pragma unroll
        for (int s = 0; s < 8; ++s) SW_LDP(pa[s], s, 0, 0);
    } else {
#pragma unroll
        for (int db = 0; db < 2; ++db)
#pragma unroll
            for (int s = 0; s < 8; ++s) ka[db][s] = *(const GAS bf16x8*)(KTFg + kto + db * 4096 + s * 512);
#pragma unroll
        for (int db = 0; db < 2; ++db)
#pragma unroll
            for (int et = 0; et < 2; ++et)
#pragma unroll
                for (int t = 0; t < 16; ++t) Sacc[db][et][t] = 0.f;
    }
#pragma unroll
    for (int it = 0; it < 2; ++it) vv[it] = *(const GAS u32x4*)(vtp + (size_t)(32 * it) * T + (vrot & (T - 1)));
#pragma unroll
    for (int it = 0; it < 2; ++it) *(LAS u32x4*)(lds + SW_VL + (vrow + 32 * it) * SW_VPITCH + vpc * 16) = vv[it];
#pragma unroll
    for (int hf = 0; hf < 2; ++hf) {
#pragma unroll
        for (int it = 0; it < 4; ++it) qv[it] = *(const GAS u32x4*)(qp + (size_t)(16 * (4 * hf + it)) * QKW);
#pragma unroll
        for (int it = 0; it < 4; ++it) { const int row = qrow + 16 * (4 * hf + it); *(LAS u32x4*)(lds + SW_QL + row * SW_SPITCH + qpc * 16) = qv[it]; }
    }
    const int sl_rd = SW_SL + r32 * SW_SPITCH + 16 * hh;
    const int q_rd = SW_QL + il * SW_SPITCH + 16 * hh;
#pragma unroll 1
    for (int p = 0; p < 2 * NCH; ++p) {
        const int dir = p >> 5, st = p & 31, n = dir ? NCH - 1 - st : st;
        const int pn = p + 1 < 2 * NCH ? p + 1 : p, dirn = pn >> 5, stn = pn & 31, nn = dirn ? NCH - 1 - stn : stn;
        const int cur = p & 1;
        const float l2 = dir ? l2b : l2f;
        const int v_rd = SW_VL + cur * SW_VB + r32 * SW_VPITCH + 16 * hh;
        if constexpr (!OUT) {
#pragma unroll
            for (int db = 0; db < 2; ++db)
#pragma unroll
                for (int et = 0; et < 2; ++et)
#pragma unroll
                    for (int g = 0; g < 4; ++g) { u32x2 pk; pk.x = cvt_pk_bf16(Sacc[db][et][4 * g], Sacc[db][et][4 * g + 1]); pk.y = cvt_pk_bf16(Sacc[db][et][4 * g + 2], Sacc[db][et][4 * g + 3]);
                        if (st == 0) { pk.x = 0u; pk.y = 0u; }
                        *(LAS u32x2*)(lds + SW_SL + (32 * et + r32) * SW_SPITCH + (64 * rb + 32 * db + 8 * g + 4 * hh) * 2) = pk; }
        }
#pragma unroll
        for (int it = 0; it < 2; ++it) vv[it] = *(const GAS u32x4*)(vtp + (size_t)(32 * it) * T + ((nn * CH + vrot) & (T - 1)));
#pragma unroll
        for (int it = 0; it < 4; ++it) qv[it] = *(const GAS u32x4*)(qp + (size_t)(nn * CH + 16 * it) * QKW);
        __syncthreads();
        f32x16 O[2];
        u32x4 yf[4];
        GAS bf16* ypn = yp + (size_t)(n * 4) * (NH * 8 * 2048);
        if constexpr (OUT) {
#pragma unroll
            for (int et = 0; et < 2; ++et)
#pragma unroll
                for (int t = 0; t < 16; ++t) O[et][t] = 0.f;
            bf16x8 qx[2], s0x[2], s1x[2], qy[2], s0y[2], s1y[2];
#define SW_LDC(dq, d0, d1, g2) do { _Pragma("unroll") for (int k = 0; k < 2; ++k) { const int ks = 2 * (g2) + k; dq[k] = *(const LAS bf16x8*)(lds + q_rd + 32 * ks); \
                d0[k] = *(const LAS bf16x8*)(lds + sl_rd + 32 * ks); d1[k] = *(const LAS bf16x8*)(lds + sl_rd + 32 * SW_SPITCH + 32 * ks); } } while (0)
#define SW_MMC(dq, d0, d1) do { SW_MFMA(d0[0], dq[0], O[0]); SW_MFMA(d1[0], dq[0], O[1]); SW_MFMA(d0[1], dq[1], O[0]); SW_MFMA(d1[1], dq[1], O[1]); } while (0)
            SW_LDC(qx, s0x, s1x, 0); SW_LDC(qy, s0y, s1y, 1); SW_SCHED;
            SW_MMC(qx, s0x, s1x); SW_SCHED; SW_LDC(qx, s0x, s1x, 2); SW_SCHED;
            SW_MMC(qy, s0y, s1y); SW_SCHED; SW_LDC(qy, s0y, s1y, 3); SW_SCHED;
            SW_MMC(qx, s0x, s1x); SW_SCHED; SW_LDC(qx, s0x, s1x, 4); SW_SCHED;
            SW_MMC(qy, s0y, s1y); SW_SCHED; SW_LDC(qy, s0y, s1y, 5); SW_SCHED;
            SW_MMC(qx, s0x, s1x); SW_SCHED; SW_LDC(qx, s0x, s1x, 6); SW_SCHED;
            SW_MMC(qy, s0y, s1y); SW_SCHED; SW_LDC(qy, s0y, s1y, 7); SW_SCHED;
            SW_MMC(qx, s0x, s1x); SW_SCHED;
            SW_MMC(qy, s0y, s1y); SW_SCHED;
#undef SW_LDC
#undef SW_MMC
        } else {
            const float gC = st == 0 ? 0.f : fast_exp2((float)CH * l2);
#pragma unroll
            for (int db = 0; db < 2; ++db)
#pragma unroll
                for (int et = 0; et < 2; ++et)
#pragma unroll
                    for (int t = 0; t < 16; ++t) Sacc[db][et][t] *= gC;
            bf16x8 v0x[2], v1x[2], v0y[2], v1y[2];
#define SW_LDU(d0, d1, g2) do { _Pragma("unroll") for (int k = 0; k < 2; ++k) { const int s_ = 2 * (g2) + k; d0[k] = *(const LAS bf16x8*)(lds + v_rd + 32 * s_); d1[k] = *(const LAS bf16x8*)(lds + v_rd + 32 * SW_VPITCH + 32 * s_); } } while (0)
#define SW_MMU(d0, d1, g2) do { _Pragma("unroll") for (int k = 0; k < 2; ++k) { const int s_ = 2 * (g2) + k; SW_MFMA(ka[0][s_], d0[k], Sacc[0][0]); SW_MFMA(ka[0][s_], d1[k], Sacc[0][1]); SW_MFMA(ka[1][s_], d0[k], Sacc[1][0]); SW_MFMA(ka[1][s_], d1[k], Sacc[1][1]); } } while (0)
            SW_LDU(v0x, v1x, 0); SW_LDU(v0y, v1y, 1); SW_SCHED;
            SW_MMU(v0x, v1x, 0); SW_SCHED; SW_LDU(v0x, v1x, 2); SW_SCHED;
            SW_MMU(v0y, v1y, 1); SW_SCHED; SW_LDU(v0y, v1y, 3); SW_SCHED;
            SW_MMU(v0x, v1x, 2); SW_SCHED;
            SW_MMU(v0y, v1y, 3); SW_SCHED;
#undef SW_LDU
#undef SW_MMU
        }
        __syncthreads();
#pragma unroll
        for (int it = 0; it < 4; ++it) { const int row = qrow + 16 * it; *(LAS u32x4*)(lds + SW_QL + row * SW_SPITCH + qpc * 16) = qv[it]; }
#pragma unroll
        for (int it = 0; it < 4; ++it) qv[it] = *(const GAS u32x4*)(qp + (size_t)(nn * CH + 16 * (4 + it)) * QKW);
        if constexpr (OUT) {
            if (dir) {
#pragma unroll
                for (int q = 0; q < 4; ++q) yf[q] = *(const GAS u32x4*)(ypn + q * 512);
            }
            const float xi = fast_exp2((float)(dir == 0 ? (il + 1) : (CH - il)) * l2);
#pragma unroll
            for (int et = 0; et < 2; ++et)
#pragma unroll
                for (int t = 0; t < 16; ++t) O[et][t] *= xi;
            bf16x8 v0x[2], v1x[2], v0y[2], v1y[2];
#define SW_LDV(d0, d1, g2) do { _Pragma("unroll") for (int k = 0; k < 2; ++k) { const int s_ = 2 * (g2) + k; d0[k] = *(const LAS bf16x8*)(lds + v_rd + 32 * s_); d1[k] = *(const LAS bf16x8*)(lds + v_rd + 32 * SW_VPITCH + 32 * s_); } } while (0)
#define SW_MMV(d0, d1, g2) do { _Pragma("unroll") for (int k = 0; k < 2; ++k) { const int s_ = 2 * (g2) + k; SW_MFMA(d0[k], pa[s_], O[0]); SW_MFMA(d1[k], pa[s_], O[1]); } } while (0)
            SW_LDV(v0x, v1x, 0); SW_LDV(v0y, v1y, 1); SW_SCHED;
            SW_MMV(v0x, v1x, 0); SW_SCHED; SW_LDV(v0x, v1x, 2); SW_SCHED;
            SW_MMV(v0y, v1y, 1); SW_SCHED; SW_LDV(v0y, v1y, 3); SW_SCHED;
            SW_MMV(v0x, v1x, 2); SW_SCHED;
            SW_MMV(v0y, v1y, 3); SW_SCHED;
#undef SW_LDV
#undef SW_MMV
#pragma unroll
            for (int s = 0; s < 8; ++s) SW_LDP(pa[s], s, dirn, nn);
        } else {
            const GAS bf16* ktn = (dirn ? KTBg : KTFg) + kto + (size_t)nn * 32768;
#pragma unroll
            for (int db = 0; db < 2; ++db)
#pragma unroll
                for (int s = 0; s < 8; ++s) ka[db][s] = *(const GAS bf16x8*)(ktn + db * 4096 + s * 512);
        }
#pragma unroll
        for (int it = 0; it < 2; ++it) *(LAS u32x4*)(lds + SW_VL + (cur ^ 1) * SW_VB + (vrow + 32 * it) * SW_VPITCH + vpc * 16) = vv[it];
#pragma unroll
        for (int it = 0; it < 4; ++it) { const int row = qrow + 16 * (4 + it); *(LAS u32x4*)(lds + SW_QL + row * SW_SPITCH + qpc * 16) = qv[it]; }
        if constexpr (OUT) {
            float s1 = 0.f, s2 = 0.f;
#pragma unroll
            for (int et = 0; et < 2; ++et)
#pragma unroll
                for (int kp = 0; kp < 2; ++kp) {
                    float ya[4], yb[4];
#pragma unroll
                    for (int q = 0; q < 4; ++q) { ya[q] = O[et][8 * kp + q]; yb[q] = O[et][8 * kp + 4 + q]; }
                    if (dir) {
                        u32x4 f = yf[et * 2 + kp];
                        { const auto r0 = __builtin_amdgcn_permlane32_swap(f.x, f.z, false, false); f.x = r0[0]; f.z = r0[1]; const auto r1 = __builtin_amdgcn_permlane32_swap(f.y, f.w, false, false); f.y = r1[0]; f.w = r1[1]; }
                        ya[0] += bf_lo(f.x); ya[1] += bf_hi(f.x); ya[2] += bf_lo(f.y); ya[3] += bf_hi(f.y); yb[0] += bf_lo(f.z); yb[1] += bf_hi(f.z); yb[2] += bf_lo(f.w); yb[3] += bf_hi(f.w);
#pragma unroll
                        for (int q = 0; q < 4; ++q) { s1 += ya[q] + yb[q]; s2 += ya[q] * ya[q] + yb[q] * yb[q]; }
                    }
                    u32x4 o; o.x = cvt_pk_bf16(ya[0], ya[1]); o.y = cvt_pk_bf16(ya[2], ya[3]); o.z = cvt_pk_bf16(yb[0], yb[1]); o.w = cvt_pk_bf16(yb[2], yb[3]);
                    { const auto r0 = __builtin_amdgcn_permlane32_swap(o.x, o.z, false, false); o.x = r0[0]; o.z = r0[1]; const auto r1 = __builtin_amdgcn_permlane32_swap(o.y, o.w, false, false); o.y = r1[0]; o.w = r1[1]; }
                    *(GAS u32x4*)(ypn + (et * 2 + kp) * 512) = o;
                }
            if (dir) { s1 += __shfl_xor(s1, 32); s2 += __shfl_xor(s2, 32);
                if (hh == 0) stp[(size_t)(n * CH) * (NH * 8)] = (f32x2){s1, s2}; }
        }
    }
#undef SW_LDP
#undef SW_SCHED
#undef SW_MFMA
    VM_WAIT();
    __syncthreads();
}

__device__ __forceinline__ void sweep_unit(LAS unsigned char* lds, const GAS bf16* Qg, const GAS bf16* KTFg, const GAS bf16* KTBg, const GAS bf16* VTg, const GAS bf16* PCg, const GAS bf16* PDg, const GAS bf16* ZEROg, GAS bf16* Yg, GAS f32x2* statp, const float l2f, const float l2b, int b, int h, int es, const int wave_s) {
    int ws_ = wave_s; asm volatile("" : "+s"(ws_));
    if (ws_ < 4) sweep_role<true>(lds, Qg, KTFg, KTBg, VTg, PCg, PDg, ZEROg, Yg, statp, l2f, l2b, b, h, es, wave_s);
    else sweep_role<false>(lds, Qg, KTFg, KTBg, VTg, PCg, PDg, ZEROg, Yg, statp, l2f, l2b, b, h, es, wave_s);
}

struct Args { const float* in[16]; float* out; unsigned char* ws; };
constexpr int NWAVES = 8;
#ifndef PHMASK
#define PHMASK 0xFFFFFFFFu
#endif
#define PH(k) (((PHMASK) >> (k)) & 1u)
__global__ void __launch_bounds__(NWAVES * 64, 2) fwd_kernel(Args args) {
    extern __shared__ __attribute__((aligned(16))) unsigned char lds_raw[];
    LAS unsigned char* lds = (LAS unsigned char*)lds_raw;
    LAS float* l2g = (LAS float*)(lds + LDSCTL_OFF + 64);
    const int wave_k = __builtin_amdgcn_readfirstlane((int)threadIdx.x >> 6);
#define PHASE_VARS \
    const int tid = tid_of(wave_k); const int lane = tid & 63; int wave = wave_k; asm volatile("" : "+s"(wave)); \
    const __attribute__((address_space(4))) Args* ka = (const __attribute__((address_space(4))) Args*)__builtin_amdgcn_kernarg_segment_ptr(); asm volatile("" : "+s"(ka)); \
    const int G = gridDim.x, bx = blockIdx.x; const int vcu = (G % 8 == 0) ? (bx % 8) * (G / 8) + bx / 8 : bx; const int gw = vcu * NWAVES + wave, NGW = G * NWAVES; \
    GAS unsigned char* ws = (GAS unsigned char*)ka->ws; asm volatile("" : "+s"(ws)); GAS float* hres = (GAS float*)ka->out; (void)lane; (void)gw; (void)NGW; (void)vcu; (void)hres; \
    const GAS float* x = (const GAS float*)ka->in[0]; const GAS float* mix_norm = (const GAS float*)ka->in[1]; const GAS float* ffn_norm = (const GAS float*)ka->in[2]; const GAS float* ret_w_in = (const GAS float*)ka->in[3]; const GAS float* ret_decay = (const GAS float*)ka->in[4]; \
    const GAS float* gn_gain = (const GAS float*)ka->in[5]; const GAS float* ret_w_out = (const GAS float*)ka->in[6]; const GAS float* d_wg = (const GAS float*)ka->in[7]; const GAS float* d_wu = (const GAS float*)ka->in[8]; const GAS float* d_wd = (const GAS float*)ka->in[9]; \
    const GAS float* fnet_w = (const GAS float*)ka->in[10]; const GAS float* moe_router = (const GAS float*)ka->in[11]; const GAS float* m_wg = (const GAS float*)ka->in[12]; const GAS float* m_wu = (const GAS float*)ka->in[13]; const GAS float* m_wd = (const GAS float*)ka->in[14]; const GAS float* final_norm = (const GAS float*)ka->in[15]; \
    (void)x; (void)mix_norm; (void)ffn_norm; (void)ret_w_in; (void)ret_decay; (void)gn_gain; (void)ret_w_out; (void)d_wg; (void)d_wu; (void)d_wd; (void)fnet_w; (void)moe_router; (void)m_wg; (void)m_wu; (void)m_wd; (void)final_norm; \
    GAS f32x2* rot = (GAS f32x2*)(ws + WS_ROT); GAS f32x2* rotT = (GAS f32x2*)(ws + WS_ROTT); GAS bf16* WC = (GAS bf16*)(ws + WS_WC); \
    GAS int* toke = (GAS int*)(ws + WS_TOKE); GAS float* tokw = (GAS float*)(ws + WS_TOKW); GAS int* bcnt = (GAS int*)(ws + WS_BCNT); GAS int* pcnt = (GAS int*)(ws + WS_PCNT); (void)pcnt; GAS int* rowtok = (GAS int*)(ws + WS_ROWTOK); GAS float* rowgate = (GAS float*)(ws + WS_ROWGATE); \
    GAS f32x2* statp = (GAS f32x2*)(ws + WS_STATP); \
    GAS bf16* WIN = (GAS bf16*)(ws + WS_WIN); GAS bf16* WO = (GAS bf16*)(ws + WS_WO); GAS bf16* WGU = (GAS bf16*)(ws + WS_WGU); GAS bf16* WD = (GAS bf16*)(ws + WS_WD); GAS bf16* WF = (GAS bf16*)(ws + WS_WF); \
    GAS bf16* HN = (GAS bf16*)(ws + WS_HN); GAS bf16* Qb = (GAS bf16*)(ws + WS_Q); GAS bf16* Kb = (GAS bf16*)(ws + WS_K); GAS bf16* KT = (GAS bf16*)(ws + WS_KT); GAS bf16* VT = (GAS bf16*)(ws + WS_VT); GAS bf16* PC = (GAS bf16*)(ws + WS_PC); \
    GAS bf16* HB = (GAS bf16*)(ws + WS_HN); GAS bf16* HNB = (GAS bf16*)ka->out; (void)HB; (void)HNB; \
    GAS unsigned char* HN8 = (GAS unsigned char*)ka->out + 64 * MiB; GAS unsigned char* WMGU8 = (GAS unsigned char*)(ws + WS_WMGU); (void)HN8; (void)WMGU8;     \
    GAS bf16* Yb = (GAS bf16*)ka->out; GAS bf16* YG = (GAS bf16*)(ws + WS_YG); GAS bf16* ACTD = (GAS bf16*)(ws + WS_ACTD); GAS bf16* Z2 = (GAS bf16*)(ws + WS_Z2); GAS bf16* WSEQ = (GAS bf16*)(ws + WS_WSEQ); \
    GAS bf16* ACTM = (GAS bf16*)(ws + WS_ACTM); GAS bf16* WMGU = (GAS bf16*)(ws + WS_WMGU); GAS bf16* WMD = (GAS bf16*)(ws + WS_WMD); \
    (void)rot; (void)rotT; (void)WC; (void)toke; (void)tokw; (void)bcnt; (void)rowtok; (void)rowgate; (void)statp; (void)WIN; (void)WO; (void)WGU; (void)WD; (void)WF; (void)HN; (void)Qb; (void)Kb; (void)KT; (void)VT; (void)PC; \
    (void)Yb; (void)YG; (void)ACTD; (void)Z2; (void)WSEQ; (void)ACTM; (void)WMGU; (void)WMD;
#define GRID_BAR() do { const __attribute__((address_space(4))) Args* kb = (const __attribute__((address_space(4))) Args*)__builtin_amdgcn_kernarg_segment_ptr(); asm volatile("" : "+s"(kb)); GAS unsigned char* wsb = (GAS unsigned char*)kb->ws; XcdBarrier bar_; bar_.bar = (unsigned*)(wsb + WS_CTL) + CW_BAR; bar_.x = xb_xcc_id(); \
    bar_.st = (volatile LAS unsigned*)(lds + MISC_OFF) + 8; xcd_barrier(bar_, tid_of(wave_k) == 0); } while (0)

    {
        PHASE_VARS
        for (int u = tid; u < (LDS_BYTES - LDSCTL_OFF) / 4; u += NWAVES * 64) ((LAS unsigned*)(lds + LDSCTL_OFF))[u] = 0u;
        __syncthreads();
        if (tid < 8) { const float xl = ret_decay[tid]; const float ls = fminf(xl, 0.f) - log1pf(expf(-fabsf(xl))); l2g[tid] = ls * 1.44269504088896341f; }
        __syncthreads();
        (void)xcd_barrier_post((unsigned*)(ws + WS_CTL) + CW_BAR, (volatile LAS unsigned*)(lds + MISC_OFF) + 8, tid == 0);
    }

    if (PH(0)) {
        PHASE_VARS
        LAS float* scr = (LAS float*)(lds + wave * 16384);
        constexpr int I_IN = (D / 64) * (INW / 32), I_O = (VW / 64) * (D / 32), I_GU = 2 * (D / 64) * (FFD / 32), I_D = (FFD / 64) * (D / 32), I_F = (D / 64) * (D / 32);
        constexpr int NITEMS = I_IN + I_O + I_GU + I_D + I_F;
        for (int it = gw; it < NITEMS; it += NGW) {
            int r = it;
            if (r < I_IN) { tr_plain(ret_w_in, D, INW, WIN, r, scr, lane); continue; } r -= I_IN;
            if (r < I_O) { tr_plain(ret_w_out, VW, D, WO, r, scr, lane); continue; } r -= I_O;
            if (r < I_GU) { tr_gu(d_wg, d_wu, D, FFD, WGU, r, scr, lane); continue; } r -= I_GU;
            if (r < I_D) { tr_plain(d_wd, FFD, D, WD, r, scr, lane); continue; } r -= I_D;
            tr_plain(fnet_w, D, D, WF, r, scr, lane);
        }
        for (int e = (vcu * 512 + tid); e < SEQ * 128; e += G * 512) { const int s = e >> 7, i = e & 127;
            const float inv = powf(10000.0f, -(float)i / 128.0f); const float ang = (float)s * inv; float sn, cs; sincosf(ang, &sn, &cs);
            rot[e] = (f32x2){cs, sn}; rotT[(size_t)i * RTP + s] = (f32x2){cs, sn}; }
        for (int e = (vcu * 512 + tid); e < 512 * 256; e += G * 512) { const int r = e >> 8, c = e & 255, mm = ((r & 255) * c) & 255;
            const float v = r < 256 ? cospif((float)mm * (1.0f / 128.0f)) : -sinpif((float)mm * (1.0f / 128.0f)); WC[e] = (bf16)(cvt_pk_bf16(v, 0.f) & 0xffffu); }
        for (int m = gw; m < T; m += NGW) { f32x4 v[4]; rms_row(x + (size_t)m * D, mix_norm, HN + (size_t)m * D, lane, v); }
    }
    GRID_BAR();

    if (PH(1) && PH(19)) {
        PHASE_VARS
        SchedPlain S{(const GAS char*)HN, (const GAS char*)WIN, (size_t)256 * D * 2, (size_t)256 * D * 2, T / 256, 8, G, bx};
        EpiRopeQK E{Qb, Kb, rot};
        pg8::gemm_phase<EpiRopeQK, SchedPlain, false>(lds, wave_k, D, D, D, S, E);
    }
    if (PH(1) && PH(20)) {
        PHASE_VARS
        SchedPlain S{(const GAS char*)(WIN + (size_t)QKW * D), (const GAS char*)HN, (size_t)256 * D * 2, (size_t)256 * D * 2, 4, T / 256, G, bx};
        EpiRopeKT E{KT, rotT, l2g};
        pg8::gemm_phase<EpiRopeKT, SchedPlain, false>(lds, wave_k, D, D, D, S, E);
    }
    if (PH(1) && PH(21)) {
        PHASE_VARS
        SchedPlain S{(const GAS char*)(WIN + (size_t)2 * QKW * D), (const GAS char*)HN, (size_t)256 * D * 2, (size_t)256 * D * 2, 8, T / 256, G, bx};
        EpiBf16<true> E{VT, T};
        pg8::gemm_phase<EpiBf16<true>, SchedPlain, false>(lds, wave_k, D, D, D, S, E);
    }
    GRID_BAR();

    if (PH(2)) {
        PHASE_VARS
        SchedPc S{(const GAS char*)Qb, (const GAS char*)Kb, G, bx};
        EpiPc E{PC, (GAS bf16*)(ws + WS_ROT), l2g};
        pg8::gemm_phase<EpiPc, SchedPc, false>(lds, wave_k, QKW, QKW, DK, S, E);
    }
    GRID_BAR();

    if (PH(3)) {
        PHASE_VARS
        for (int u = vcu; u < NB * NH * 8; u += G) { const int hh_ = (u >> 3) & 3; const float l2f = l2g[hh_], l2b = l2g[4 + hh_];
            sweep_unit(lds, Qb, KT, KT + (size_t)QKW * T, VT, PC, (const GAS bf16*)(ws + WS_ROT), (const GAS bf16*)(ws + WS_CTL + 512 * 1024), Yb, statp, l2f, l2b, u >> 5, hh_, u & 7, wave_k); }
    }
    GRID_BAR();

    if (PH(5)) {
        PHASE_VARS
        SchedPlain S{(const GAS char*)HN, (const GAS char*)(WIN + (size_t)(2 * QKW + VW) * D), (size_t)256 * D * 2, (size_t)256 * D * 2, T / 256, 8, G, bx};
        EpiGate E{Yb, YG, statp, gn_gain, (LAS f32x2*)(lds + 135168)};
        pg8::gemm_phase<EpiGate, SchedPlain, false>(lds, wave_k, D, D, D, S, E);
    }
    GRID_BAR();

    if (PH(6)) {
        PHASE_VARS
        SchedPlain S{(const GAS char*)YG, (const GAS char*)WO, (size_t)256 * VW * 2, (size_t)256 * VW * 2, T / 256, 4, G, bx};
        EpiRes<true> E{(const GAS void*)x, HB};
        pg8::gemm_phase<EpiRes<true>, SchedPlain, false>(lds, wave_k, VW, VW, VW, S, E);
    }
    GRID_BAR();

    if (PH(7)) {
        PHASE_VARS
        for (int m = gw; m < T; m += NGW) { f32x4 v[4]; rms_row_b(HB + (size_t)m * D, ffn_norm, HNB + (size_t)m * D, lane, v); }
        LAS float* scr = (LAS float*)(lds + wave * 16384);
        constexpr int I_GU = 2 * (D / 64) * (FFE / 32), I_D = (FFE / 64) * (D / 32);
        for (int it = gw; it < NE * (I_GU + I_D); it += NGW) {
            const int e = it / (I_GU + I_D); int r = it - e * (I_GU + I_D);
            if (r < I_GU) tr_gu8(m_wg + (size_t)e * D * FFE, m_wu + (size_t)e * D * FFE, D, FFE, WMGU8 + (size_t)e * 2 * FFE * D, r, scr, lane);
            else { const int it2 = r - I_GU, nblk = D / 32, kb = it2 / nblk, nb = it2 - kb * nblk; transpose_item8(m_wd + (size_t)e * FFE * D, FFE, D, (GAS unsigned char*)WMD + (size_t)e * D * FFE, 64 * kb, 32 * nb, 32 * nb, 64.0f, scr, lane); }
        }
    }
    GRID_BAR();

    if (PH(8)) {
        PHASE_VARS
        SchedPlain S{(const GAS char*)HNB, (const GAS char*)WGU, (size_t)256 * D * 2, (size_t)256 * D * 2, T / 256, 2 * FFD / 256, G, bx};
        EpiSwiGLU<false> E{(GAS void*)ACTD, FFD};
        pg8::gemm_phase<EpiSwiGLU<false>, SchedPlain, false>(lds, wave_k, D, D, D, S, E);
    }
    GRID_BAR();
    if (PH(9)) {
        PHASE_VARS
        SchedPlain S{(const GAS char*)ACTD, (const GAS char*)WD, (size_t)256 * FFD * 2, (size_t)256 * FFD * 2, T / 256, 4, G, bx};
        EpiRes<false> E{(const GAS void*)HB, HB};
        pg8::gemm_phase<EpiRes<false>, SchedPlain, false>(lds, wave_k, FFD, FFD, FFD, S, E);
    }
    GRID_BAR();

    if (PH(10)) {
        PHASE_VARS
        for (int m = gw; m < T; m += NGW) { f32x4 v[4]; rms_row_b(HB + (size_t)m * D, mix_norm + D, HNB + (size_t)m * D, lane, v); }
        for (int e = vcu * 512 + tid; e < 512 * 1024; e += G * 512) { const int ka = e >> 10, c = e & 1023, a = c & 511, mm = (a * ka) & 511;
            const float v = (c < 512 ? cospif((float)mm * (1.0f / 256.0f)) : sinpif((float)mm * (1.0f / 256.0f))) * (1.0f / 1024.0f); WSEQ[e] = (bf16)(cvt_pk_bf16(v, 0.f) & 0xffffu); }
    }
    GRID_BAR();

    if (PH(11)) {
        PHASE_VARS
        SchedFnA S{(const GAS char*)WC, (const GAS char*)HNB, G, bx};
        EpiZ2 E{Z2};
        pg8::gemm_phase<EpiZ2, SchedFnA, false>(lds, wave_k, 256, D, 256, S, E);
    }
    GRID_BAR();
    if (PH(22)) {
        PHASE_VARS
        float wc0[8], ws0[8];
#pragma unroll
        for (int kb = 0; kb < 8; ++kb) { const float ang = (float)((8 * lane * kb) & 4095) * (1.0f / 2048.0f); wc0[kb] = cospif(ang); ws0[kb] = sinpif(ang); }
        for (int rw = gw; rw < NB * 1024; rw += NGW) {
            GAS bf16* row = Z2 + (size_t)rw * 8192;
#pragma unroll
            for (int hq = 0; hq < 2; ++hq) {
                u32x2 zin[2][8], zout[8][2];
#pragma unroll
                for (int ri = 0; ri < 2; ++ri)
#pragma unroll
                    for (int bb = 0; bb < 8; ++bb) zin[ri][bb] = *(const GAS u32x2*)(row + ri * 4096 + 512 * bb + 8 * lane + 4 * hq);
#pragma unroll
                for (int q = 0; q < 2; ++q) {
                    float outr[2][8], outi[2][8];
#pragma unroll
                    for (int tt = 0; tt < 2; ++tt) {
                        const int t = 4 * hq + 2 * q + tt;
                        float zr[8], zi[8];
#pragma unroll
                        for (int bb = 0; bb < 8; ++bb) { const unsigned wr_ = zin[0][bb][q], wi_ = zin[1][bb][q]; zr[bb] = tt ? bf_hi(wr_) : bf_lo(wr_); zi[bb] = tt ? bf_hi(wi_) : bf_lo(wi_); }
#pragma unroll
                        for (int kb = 0; kb < 8; ++kb) {
                            float ur = 0.f, ui = 0.f;
#pragma unroll
                            for (int bb = 0; bb < 8; ++bb) {
                                const int m8 = (bb * kb) & 7;
                                const float c8 = (m8 == 0) ? 1.f : (m8 == 4) ? -1.f : (m8 == 2 || m8 == 6) ? 0.f : (m8 == 1 || m8 == 7) ? 0.70710678118654752f : -0.70710678118654752f;
                                const float s8 = (m8 == 0 || m8 == 4) ? 0.f : (m8 == 2) ? 1.f : (m8 == 6) ? -1.f : (m8 == 1 || m8 == 3) ? 0.70710678118654752f : -0.70710678118654752f;
                                ur += c8 * zr[bb] + s8 * zi[bb]; ui += c8 * zi[bb] - s8 * zr[bb]; }
                            const int mt = (t * kb);
                            const float ct = __builtin_cosf((float)mt * 0.00153398078788564123f), st_ = __builtin_sinf((float)mt * 0.00153398078788564123f);
                            const float twc = wc0[kb] * ct - ws0[kb] * st_, tws = ws0[kb] * ct + wc0[kb] * st_;
                            outr[tt][kb] = ur * twc + ui * tws; outi[tt][kb] = ui * twc - ur * tws; }
                    }
#pragma unroll
                    for (int kb = 0; kb < 8; ++kb) { zout[kb][0][q] = cvt_pk_bf16(outr[0][kb], outr[1][kb]); zout[kb][1][q] = cvt_pk_bf16(outi[0][kb], outi[1][kb]); }
                    __builtin_amdgcn_sched_barrier(0);
                }
#pragma unroll
                for (int kb = 0; kb < 8; ++kb)
#pragma unroll
                    for (int ri = 0; ri < 2; ++ri) *(GAS u32x2*)(row + kb * 1024 + ri * 512 + 8 * lane + 4 * hq) = zout[kb][ri];
                __builtin_amdgcn_sched_barrier(0);
            }
        }
    }
    GRID_BAR();
    if (PH(12)) {
        PHASE_VARS
        SchedFnB S{(GAS const char*)WSEQ, (GAS const char*)Z2, G, bx};
        EpiYf E{HNB};
        pg8::gemm_phase<EpiYf, SchedFnB, false>(lds, wave_k, 1024, 1024, 1024, S, E);
    }
    GRID_BAR();
    if (PH(13)) {
        PHASE_VARS
        SchedPlain S{(const GAS char*)HNB, (const GAS char*)WF, (size_t)256 * D * 2, (size_t)256 * D * 2, T / 256, 4, G, bx};
        EpiRes<false> E{(const GAS void*)HB, HB};
        pg8::gemm_phase<EpiRes<false>, SchedPlain, false>(lds, wave_k, D, D, D, S, E);
    }
    GRID_BAR();

    if (PH(14)) {
        PHASE_VARS
        LAS float* wrl = (LAS float*)lds;
        LAS int* le = (LAS int*)(lds + 32768);
        for (int i = tid; i < D * NE / 4; i += NWAVES * 64) ((LAS f32x4*)wrl)[i] = ((const GAS f32x4*)moe_router)[i];
        for (int i = vcu * 512 + tid; i < 2 * MOE_ROWS; i += G * 512) rowtok[i] = -1;
        __syncthreads();
        for (int tb = vcu; tb < T / 128; tb += G) {
            for (int rr = 0; rr < 16; ++rr) { const int tl = wave * 16 + rr, m = tb * 128 + tl; f32x4 v[4];
                rms_row_b8(HB + (size_t)m * D, ffn_norm + D, HN8 + (size_t)m * D, lane, v);
                float lg[8];
#pragma unroll
                for (int e = 0; e < 8; ++e) lg[e] = 0.f;
#pragma unroll
                for (int j = 0; j < 4; ++j)
#pragma unroll
                    for (int c = 0; c < 4; ++c) { const int col = rmsb_col(j, lane) + c; const f32x4 w0 = *(const LAS f32x4*)(wrl + col * 8), w1 = *(const LAS f32x4*)(wrl + col * 8 + 4); const float xv = v[j][c];
                        lg[0] += xv * w0.x; lg[1] += xv * w0.y; lg[2] += xv * w0.z; lg[3] += xv * w0.w; lg[4] += xv * w1.x; lg[5] += xv * w1.y; lg[6] += xv * w1.z; lg[7] += xv * w1.w; }
#pragma unroll
                for (int e = 0; e < 8; ++e) lg[e] = wave_sum(lg[e]);
                int e0 = 0; float b0 = lg[0];
#pragma unroll
                for (int e = 1; e < 8; ++e) if (lg[e] > b0) { b0 = lg[e]; e0 = e; }
                int e1 = -1; float b1 = -3.0e38f;
#pragma unroll
                for (int e = 0; e < 8; ++e) if (e != e0 && lg[e] > b1) { b1 = lg[e]; e1 = e; }
                const float w0 = 1.0f / (1.0f + __expf(b1 - b0));
                if (lane == 0) { toke[2 * m] = e0; toke[2 * m + 1] = e1; tokw[2 * m] = w0; tokw[2 * m + 1] = 1.0f - w0; le[tl] = e0; le[128 + tl] = e1; } }
            __syncthreads();
            if (tid < 16) { const int s = tid >> 3, e = tid & 7; int c = 0; for (int i = 0; i < 128; ++i) c += (le[s * 128 + i] == e) ? 1 : 0; bcnt[tb * 16 + tid] = c; }
            if (tid >= 64 && tid < 128) { const int pi = tid - 64; int c = 0; for (int i = 0; i < 128; ++i) c += (le[i] * 8 + le[128 + i] == pi) ? 1 : 0; pcnt[tb * 64 + pi] = c; }
            __syncthreads();
        }
    }
    GRID_BAR();

    LAS int* segoff = (LAS int*)(lds + 132096);
    LAS int* ntile = (LAS int*)(lds + 132096 + 64);
    LAS unsigned char* tile_e = (LAS unsigned char*)(lds + 132096 + 128);
    if (PH(15)) {
        PHASE_VARS
        LAS int* pfx = (LAS int*)lds;
        LAS int* cph = (LAS int*)(lds + 65792);
        LAS int* fq_ = (LAS int*)(lds + 65792 + 16384);
        LAS int* tot = fq_ + 64;
        LAS int* tpi = tot + 16;
        LAS int* tex = tpi + 128;
        for (int i = tid; i < 256 * 64; i += NWAVES * 64) pfx[i] = pcnt[i];
        __syncthreads();
        if (tid < 64) { int run = 0; for (int b2 = 0; b2 < 256; ++b2) { const int c = pfx[b2 * 64 + tid]; pfx[b2 * 64 + tid] = run; run += c; } pfx[256 * 64 + tid] = run; }
        __syncthreads();
        if (tid == 0) {
            int n0[8], d[8], r[8]; int rs = 0;
            for (int e = 0; e < 8; ++e) { int c = 0; for (int x2 = 0; x2 < 8; ++x2) c += pfx[256 * 64 + e * 8 + x2]; n0[e] = c; r[e] = c & 255; d[e] = -(c & 255); rs += c & 255; }
            int extra = rs >> 8;
            for (int k = 0; k < extra; ++k) { int be = -1, br = -1; for (int e = 0; e < 8; ++e) if (d[e] < 0 && d[e] == -r[e] && r[e] > br) { br = r[e]; be = e; } if (be >= 0) d[be] += 256; }
            for (int i = 0; i < 64; ++i) fq_[i] = 0;
            for (int a = 0; a < 8; ++a) for (int e = 0; e < 8; ++e) if (a != e && d[a] < 0 && d[e] > 0) { int fl = -d[a]; if (d[e] < fl) fl = d[e]; const int av = pfx[256 * 64 + a * 8 + e]; if (av < fl) fl = av; fq_[a * 8 + e] = fl; d[a] += fl; d[e] -= fl; }
        }
        __syncthreads();
        if (tid < 256) {
            int c0[8], c1[8];
#pragma unroll
            for (int e = 0; e < 8; ++e) { c0[e] = 0; c1[e] = 0; }
            for (int a = 0; a < 8; ++a) for (int e = 0; e < 8; ++e) { const int pi = a * 8 + e; const int cnt = pfx[(tid + 1) * 64 + pi] - pfx[tid * 64 + pi]; int fl = fq_[pi] - pfx[tid * 64 + pi]; fl = fl < 0 ? 0 : (fl > cnt ? cnt : fl);
#pragma unroll
                for (int q = 0; q < 8; ++q) { c0[q] += (q == a ? cnt - fl : 0) + (q == e ? fl : 0); c1[q] += (q == e ? cnt - fl : 0) + (q == a ? fl : 0); } }
#pragma unroll
            for (int e = 0; e < 8; ++e) { cph[tid * 16 + e] = c0[e]; cph[tid * 16 + 8 + e] = c1[e]; }
        }
        __syncthreads();
        if (tid < 16) { int run = 0; for (int b2 = 0; b2 < 256; ++b2) { const int c = cph[b2 * 16 + tid]; cph[b2 * 16 + tid] = run; run += c; } tot[tid] = run; }
        __syncthreads();
        if (tid < 2) { int off = 0, nt = 0; for (int e = 0; e < 8; ++e) { segoff[tid * 8 + e] = off; const int tl = (tot[tid * 8 + e] + 255) >> 8; for (int q = 0; q < tl; ++q) tile_e[tid * 160 + nt + q] = (unsigned char)e; nt += tl; off += tl * 256; } ntile[tid] = nt; }
        __syncthreads();
        for (int tb = vcu; tb < T / 128; tb += G) {
            int e0 = 0, e1 = 0, flip = 0;
            if (tid < 128) { const int m = tb * 128 + tid; e0 = toke[2 * m]; e1 = toke[2 * m + 1]; tpi[tid] = e0 * 8 + e1; }
            __syncthreads();
            if (tid < 128) { const int pi = e0 * 8 + e1; int rk = 0; for (int i = 0; i < tid; ++i) rk += (tpi[i] == pi) ? 1 : 0;
                flip = (pfx[tb * 64 + pi] + rk) < fq_[pi] ? 1 : 0; tex[tid] = flip ? e1 : e0; tex[128 + tid] = flip ? e0 : e1; }
            __syncthreads();
            if (tid < 128) { const int m = tb * 128 + tid;
#pragma unroll
                for (int ph = 0; ph < 2; ++ph) { const int e = tex[ph * 128 + tid]; int rk = 0; for (int i = 0; i < tid; ++i) rk += (tex[ph * 128 + i] == e) ? 1 : 0;
                    const int row = segoff[ph * 8 + e] + cph[tb * 16 + ph * 8 + e] + rk;
                    rowtok[ph * MOE_ROWS + row] = m; rowgate[ph * MOE_ROWS + row] = tokw[2 * m + (ph ^ flip)]; } }
            __syncthreads();
        }
    }
    GRID_BAR();

    if (PH(16))
#pragma unroll
    for (int s = 0; s < 2; ++s) {
        {
            PHASE_VARS
            SchedMoe S{(const GAS char*)HN8, (const GAS char*)WMGU8, rowtok + s * MOE_ROWS, tile_e + s * 160, 0, (size_t)2 * FFE * D, (size_t)256 * D, ntile[s], 2 * FFE / 256, G, bx, true, 0x7f7f7f7f};
            EpiSwiGLU<true> E{(GAS void*)ACTM, FFE};
            pg8::gemm_phase<EpiSwiGLU<true>, SchedMoe, true, true>(lds, wave_k, D, D, D, S, E);
        }
        GRID_BAR();
        {
            PHASE_VARS
            SchedMoe S{(const GAS char*)ACTM, (const GAS char*)WMD, rowtok + s * MOE_ROWS, tile_e + s * 160, (size_t)256 * FFE, (size_t)D * FFE, (size_t)256 * FFE, ntile[s], 4, G, bx, false, 0x7c7c7c7c};
            EpiMoeDown E{HB, rowtok + s * MOE_ROWS, rowgate + s * MOE_ROWS};
            pg8::gemm_phase<EpiMoeDown, SchedMoe, false, true>(lds, wave_k, FFE, FFE, FFE, S, E);
        }
        GRID_BAR();
    }

    if (PH(17)) {
        PHASE_VARS
        const bool bad = __hip_atomic_load((GAS unsigned*)(ws + WS_CTL) + CW_BAR + XB_TMO, RLX_AGENT) != 0u;
        for (int m = gw; m < T; m += NGW) {
            const GAS bf16* hrow = HB + (size_t)m * D; GAS float* orow = hres + (size_t)m * D;
            f32x4 v[4]; float s = 0.f;
#pragma unroll
            for (int jh = 0; jh < 2; ++jh) { const u32x4 xx = *(const GAS u32x4*)(hrow + 512 * jh + 8 * lane);
                v[2 * jh] = (f32x4){bf_lo(xx.x), bf_hi(xx.x), bf_lo(xx.y), bf_hi(xx.y)}; v[2 * jh + 1] = (f32x4){bf_lo(xx.z), bf_hi(xx.z), bf_lo(xx.w), bf_hi(xx.w)}; }
#pragma unroll
            for (int j = 0; j < 4; ++j) s += (v[j].x * v[j].x + v[j].y * v[j].y) + (v[j].z * v[j].z + v[j].w * v[j].w);
            const float r = bad ? __builtin_nanf("") : 1.0f / sqrtf(wave_sum(s) * (1.f / D) + EPS);
#pragma unroll
            for (int j = 0; j < 4; ++j) { const int col = rmsb_col(j, lane); *(GAS f32x4*)(orow + col) = v[j] * r * *(const GAS f32x4*)(final_norm + col); }
        }
    }
}

extern "C" void kernel_launch(void* const* d_in, const int* in_sizes, int n_in, void* d_out, int out_size, void* d_ws, size_t ws_size, hipStream_t stream) {
    static int grid = 0;
    if (grid == 0) {
        if (n_in != 16 || in_sizes[0] != T * D || out_size != T * D || ws_size < WS_END) { fprintf(stderr, "kernel_launch: unexpected shapes (n_in %d, in0 %d, out %d, ws %zu)\n", n_in, n_in > 0 ? in_sizes[0] : -1, out_size, ws_size); grid = -1; return; }
        int dev = 0, cus = 0, per_cu = 0;
        if (hipGetDevice(&dev) != hipSuccess || hipDeviceGetAttribute(&cus, hipDeviceAttributeMultiprocessorCount, dev) != hipSuccess) { grid = -1; return; }
        if (hipFuncSetAttribute((const void*)fwd_kernel, hipFuncAttributeMaxDynamicSharedMemorySize, LDS_BYTES) != hipSuccess) { fprintf(stderr, "kernel_launch: hipFuncSetAttribute failed\n"); grid = -1; return; }
        if (hipOccupancyMaxActiveBlocksPerMultiprocessor(&per_cu, (const void*)fwd_kernel, NWAVES * 64, LDS_BYTES) != hipSuccess || per_cu < 1) { fprintf(stderr, "kernel_launch: occupancy query says %d\n", per_cu); }
        (void)hipGetLastError();
        grid = cus;
    }
    if (grid < 0) return;
    if (hipMemsetAsync((char*)d_ws + WS_CTL, 0, CTL_ZERO_BYTES, stream) != hipSuccess) return;
    Args a{};
    for (int i = 0; i < 16; ++i) a.in[i] = (const float*)d_in[i];
    a.out = (float*)d_out; a.ws = (unsigned char*)d_ws;
    hipLaunchKernelGGL(fwd_kernel, dim3(grid), dim3(NWAVES * 64), LDS_BYTES, stream, a);
}
```

```cpp
#include <hip/hip_runtime.h>
#include <cstdio>
#include <cstdint>

#define LAS __attribute__((address_space(3)))
#define GAS __attribute__((address_space(1)))
typedef unsigned short bf16;
typedef short bf16x8 __attribute__((ext_vector_type(8)));
typedef float f32x2 __attribute__((ext_vector_type(2)));
typedef float f32x4 __attribute__((ext_vector_type(4)));
typedef float f32x16 __attribute__((ext_vector_type(16)));
typedef unsigned u32x2 __attribute__((ext_vector_type(2)));
typedef unsigned u32x4 __attribute__((ext_vector_type(4)));
typedef GAS unsigned gu32;

constexpr int D = 1024, NB = 8, SEQ = 4096, T = NB * SEQ;
constexpr int NH = 4, DK = 256, DV = 512, QKW = 1024, VW = 2048, INW = 6144, CH = 128, NCH = SEQ / CH;
constexpr int FFD = 2816, NE = 8, FFE = 3584;
constexpr int MOE_ROWS = T + NE * 256;
constexpr float EPS = 1e-6f;

constexpr size_t MiB = 1u << 20;
constexpr size_t WS_CTL = 0, CTL_ZERO_BYTES = 1 * MiB;
constexpr size_t WS_ROT = 1 * MiB, WS_ROTT = 5 * MiB, WS_WC = 10 * MiB + 768 * 1024;
constexpr int RTP = SEQ + 64;
constexpr size_t WS_TOKE = 9 * MiB + 256 * 1024;
constexpr size_t WS_TOKW = WS_TOKE + 256 * 1024;
constexpr size_t WS_BCNT = WS_TOKW + 256 * 1024;
constexpr size_t WS_ROWTOK = WS_BCNT + 16 * 1024;
constexpr size_t WS_ROWGATE = WS_ROWTOK + 2 * MOE_ROWS * 4;
constexpr size_t WS_PCNT = 10 * MiB + 512 * 1024;
constexpr size_t WS_STATS = 11 * MiB;
static_assert(WS_ROWGATE + 2 * MOE_ROWS * 4 <= WS_PCNT, "small tables");
constexpr size_t WS_WIN = 12 * MiB, WS_WO = 24 * MiB, WS_WGU = 28 * MiB, WS_WD = 39 * MiB, WS_WF = 44 * MiB + 512 * 1024;
constexpr size_t WS_HN = 48 * MiB;
constexpr size_t WS_Q = 112 * MiB, WS_K = 176 * MiB, WS_KT = 240 * MiB  , WS_VT = 368 * MiB, WS_PC = 496 * MiB;
constexpr size_t WS_YG = 240 * MiB;
constexpr size_t WS_STATP = 176 * MiB;
constexpr size_t WS_ACTD = 112 * MiB;
constexpr size_t WS_Z2 = 112 * MiB, WS_WSEQ = 240 * MiB;
constexpr size_t WS_ACTM = 112 * MiB;
constexpr size_t WS_WMGU = 352 * MiB, WS_WMD = 464 * MiB, WS_END = 528 * MiB;
static_assert(WS_ACTM + (size_t)MOE_ROWS * FFE * 2 <= WS_WMGU, "moe act");
static_assert(WS_PC + (size_t)NB * NH * NCH * CH * CH * 2 <= 528 * MiB, "epoch A");
static_assert(WS_WF + (size_t)D * D * 2 <= WS_HN, "weights");
constexpr int CW_BAR = 4096;
constexpr int CW_CHK = 64;

constexpr int RING_BYTES = 131072;
constexpr int LDSCTL_OFF = 139264, MISC_OFF = LDSCTL_OFF + 320;
constexpr int LDS_BYTES = 147456;

#define LDS_WAIT() asm volatile("s_waitcnt lgkmcnt(0)" ::: "memory")
#define VM_WAIT() asm volatile("s_waitcnt vmcnt(0)" ::: "memory")
#define RLX_AGENT __ATOMIC_RELAXED, __HIP_MEMORY_SCOPE_AGENT

__device__ __forceinline__ unsigned cvt_pk_bf16(float lo, float hi) { unsigned r; asm volatile("v_cvt_pk_bf16_f32 %0, %1, %2" : "=v"(r) : "v"(lo), "v"(hi)); return r; }
__device__ __forceinline__ unsigned pk4_fp8(float a, float b, float c, float d) { int w = 0; w = __builtin_amdgcn_cvt_pk_fp8_f32(a, b, w, false); w = __builtin_amdgcn_cvt_pk_fp8_f32(c, d, w, true); return (unsigned)w; }
__device__ __forceinline__ float bf_lo(unsigned w) { return __uint_as_float(w << 16); }
__device__ __forceinline__ float bf_hi(unsigned w) { return __uint_as_float(w & 0xffff0000u); }
__device__ __forceinline__ float fast_exp2(float x) { return __builtin_amdgcn_exp2f(x); }
__device__ __forceinline__ int lane_id_v() { int l; asm volatile("v_mbcnt_lo_u32_b32 %0, -1, 0\n\tv_mbcnt_hi_u32_b32 %0, -1, %0" : "=v"(l)); return l; }
__device__ __forceinline__ int tid_of(int wave_s) { asm volatile("" : "+s"(wave_s)); return wave_s * 64 + lane_id_v(); }
__device__ __forceinline__ int rot_col(int row, int tok) { return (tok + ((row & 15) << 11)) & (32768 - 1); }
__device__ __forceinline__ float silu_f(float v) { return v * __builtin_amdgcn_rcpf(1.0f + __builtin_amdgcn_exp2f(v * -1.44269504088896341f)); }

namespace pg8 {
constexpr int BM = 256, BK = 64, HALF = 128, HTB = HALF * BK * 2, STAGE_BYTES = 8 * HTB, NXCD = 8, WGM = 2;
__host__ __device__ __forceinline__ int lds_byte(int r, int c) { const int st = (r >> 4) * 2 + (c >> 5), rr = r & 15, cc = c & 31, ob = rr * 64 + cc * 2; return st * 1024 + (ob ^ (((ob >> 9) & 1) << 5)); }
__host__ __device__ __forceinline__ void stage_rc(int b, int& R, int& C) { const int st = b / 1024, sb = b % 1024, swz = sb ^ (((sb >> 9) & 1) << 5); R = (st >> 1) * 16 + swz / 64; C = (st & 1) * 32 + (swz % 64) / 2; }
__host__ __device__ __forceinline__ int perm32(int rho) { const int n = rho >> 4, i = rho & 15; return 8 * (i >> 2) + 4 * n + (i & 3); }

struct Unit { const GAS char* A; const GAS char* B; const GAS int* rows; int pm, pn, z; };

__device__ __forceinline__ bool tile_of(long L, int nM, int nN, int& pm, int& pn) {
    const int nwg = nM * nN; if (L >= nwg) return false;
    int wgid = (int)L; { const int q = nwg / NXCD, r = nwg % NXCD, xcd = wgid % NXCD, off = wgid / NXCD; wgid = (xcd < r ? xcd * (q + 1) : r * (q + 1) + (xcd - r) * q) + off; }
    const int nig = WGM * nN, gid = wgid / nig, fm = gid * WGM, gsz = (nM - fm) < WGM ? (nM - fm) : WGM;
    pm = fm + ((wgid % nig) % gsz); pn = (wgid % nig) / gsz; return true;
}

template <class Epi, class Sched, bool GATHER, bool FP8 = false>
__device__ __forceinline__ void gemm_phase(LAS unsigned char* lds, const int wave_s, const int lda, const int ldb, const int K, const Sched& S, const Epi& E) {
    const int tid = tid_of(wave_s);
    const int wid = __builtin_amdgcn_readfirstlane(tid >> 6), lane = tid & 63, wr = wid >> 2, wc = wid & 3, fr = lane & 15, fq = lane >> 4;
    constexpr int ES = FP8 ? 1 : 2;
    const int nt = K * ES / (BK * 2);
    unsigned vA[2][2], vAn[2][2], voffB[2];
#pragma unroll
    for (int i = 0; i < 2; ++i) { int R, C; stage_rc(tid * 16 + i * 8192, R, C); const int Rb = Epi::PERM ? ((R & ~31) + perm32(R & 31)) : R;
        voffB[i] = (unsigned)(S.brow(Rb) * ldb * ES + C * 2);
#pragma unroll
        for (int h = 0; h < 2; ++h) { vA[h][i] = (unsigned)((h * HALF + R) * lda * ES + C * 2); vAn[h][i] = vA[h][i]; } }
    const size_t kstep = (size_t)(BK * 2);
    const size_t hstepB = (size_t)(S.brow(HALF) - S.brow(0)) * ldb * ES;
    const unsigned ldsw = (unsigned)wid * 1024u;
    const int aoff = lds_byte(wr * 64 + fr, FP8 ? fq * 16 : fq * 8), boff = lds_byte(wc * 32 + fr, FP8 ? fq * 16 : fq * 8);
    typedef int v4i_ __attribute__((ext_vector_type(4))); typedef int v8i_ __attribute__((ext_vector_type(8)));
    const int sc_w8 = S.scale_b8(), sc_a8 = S.scale_a8(); (void)sc_w8; (void)sc_a8;
#define PG8_SA(b, h) (((b) * 2 + (h)) * HTB)
#define PG8_SB(b, h) ((4 + (b) * 2 + (h)) * HTB)
#define PG8_STAGE_B(bufoff, gbase) do { _Pragma("unroll") for (int _i = 0; _i < 2; ++_i) \
        __builtin_amdgcn_global_load_lds((const GAS unsigned*)((const GAS char*)(gbase) + voffB[_i]), (LAS unsigned*)(lds + (bufoff) + ldsw + _i * 8192), 16, 0, 0); } while (0)
#define PG8_STAGE_A(bufoff, gbase, v0, v1) do { \
        __builtin_amdgcn_global_load_lds((const GAS unsigned*)((const GAS char*)(gbase) + (v0)), (LAS unsigned*)(lds + (bufoff) + ldsw), 16, 0, 0); \
        __builtin_amdgcn_global_load_lds((const GAS unsigned*)((const GAS char*)(gbase) + (v1)), (LAS unsigned*)(lds + (bufoff) + ldsw + 8192), 16, 0, 0); } while (0)
#define PG8_LD32(addr) __builtin_shufflevector(*(const LAS v4i_*)(addr), *(const LAS v4i_*)((addr) + 16), 0, 1, 2, 3, 4, 5, 6, 7)
#define PG8_LDA(dst, b, h) do { _Pragma("unroll") for (int m = 0; m < 4; ++m) { if constexpr (FP8) dst##8[m] = PG8_LD32(lds + PG8_SA(b, h) + aoff + m * 2048); else { _Pragma("unroll") for (int k = 0; k < 2; ++k) dst[m][k] = *(const LAS bf16x8*)(lds + PG8_SA(b, h) + aoff + m * 2048 + k * 1024); } } } while (0)
#define PG8_LDB(dst, b, h) do { _Pragma("unroll") for (int n = 0; n < 2; ++n) { if constexpr (FP8) dst##8[n] = PG8_LD32(lds + PG8_SB(b, h) + boff + n * 2048); else { _Pragma("unroll") for (int k = 0; k < 2; ++k) dst[n][k] = *(const LAS bf16x8*)(lds + PG8_SB(b, h) + boff + n * 2048 + k * 1024); } } } while (0)
#define PG8_MMA(ai, bj, At, Bt) do { __builtin_amdgcn_s_setprio(1); _Pragma("unroll") for (int m = 0; m < 4; ++m) _Pragma("unroll") for (int n = 0; n < 2; ++n) { \
        if constexpr (FP8) asm volatile("v_mfma_scale_f32_16x16x128_f8f6f4 %0, %1, %2, %0, %3, %4 op_sel_hi:[0,0,0]" : "+v"(acc[ai][bj][m][n]) : "v"(Bt##8[n]), "v"(At##8[m]), "v"(sc_w8), "v"(sc_a8)); \
        else { _Pragma("unroll") for (int k = 0; k < 2; ++k) acc[ai][bj][m][n] = __builtin_amdgcn_mfma_f32_16x16x32_bf16(Bt[n][k], At[m][k], acc[ai][bj][m][n], 0, 0, 0); } } \
        __builtin_amdgcn_s_setprio(0); } while (0)
#define PG8_WAIT_V(n) asm volatile("s_waitcnt vmcnt(" #n ")" ::: "memory")
#define PG8_WAIT_L(n) asm volatile("s_waitcnt lgkmcnt(" #n ")" ::: "memory")
#define PG8_BAR __builtin_amdgcn_s_barrier()
#define PG8_SCHED __builtin_amdgcn_sched_barrier(0)
#define PG8_LOADROWS(dst, u) do { if constexpr (GATHER) { const int _tz = tid_of(wave_s); _Pragma("unroll") for (int _i = 0; _i < 2; ++_i) { int _R, _C; stage_rc(_tz * 16 + _i * 8192, _R, _C); \
        _Pragma("unroll") for (int _h = 0; _h < 2; ++_h) { const int _t = (u).rows[_h * HALF + _R]; dst[_h][_i] = (unsigned)((_t < 0 ? 0 : _t) * lda * ES + _C * 2); } } } } while (0)
#define PG8_VAN(h, i) (GATHER ? vAn[h][i] : vA[h][i])
    Unit cur, nxt; int ui = 0;
    if (!S.next(0, cur)) return;
    f32x4 acc[2][2][4][2];
#pragma unroll
    for (int a = 0; a < 2; ++a)
#pragma unroll
        for (int b = 0; b < 2; ++b)
#pragma unroll
            for (int m = 0; m < 4; ++m)
#pragma unroll
                for (int n = 0; n < 2; ++n) acc[a][b][m][n] = (f32x4){0.f, 0.f, 0.f, 0.f};
    bf16x8 At[4][2], B0[2][2], B1[2][2]; v8i_ At8[4], B08[2], B18[2]; (void)At; (void)B0; (void)B1; (void)At8; (void)B08; (void)B18;
    const GAS char* cA = cur.A; const GAS char* cB = cur.B;
    PG8_LOADROWS(vA, cur);
    if constexpr (GATHER) { vAn[0][0] = vA[0][0]; vAn[0][1] = vA[0][1]; vAn[1][0] = vA[1][0]; vAn[1][1] = vA[1][1]; }
    PG8_STAGE_B(PG8_SB(0, 0), cB); PG8_STAGE_B(PG8_SB(0, 1), cB + hstepB); PG8_STAGE_A(PG8_SA(0, 0), cA, vA[0][0], vA[0][1]); PG8_STAGE_A(PG8_SA(0, 1), cA, vA[1][0], vA[1][1]);
    if (wr == 1) PG8_BAR;
    PG8_WAIT_V(2); PG8_BAR;
    PG8_STAGE_B(PG8_SB(1, 0), cB + kstep); PG8_STAGE_A(PG8_SA(1, 0), cA + kstep, vA[0][0], vA[0][1]); PG8_STAGE_B(PG8_SB(1, 1), cB + hstepB + kstep);
    PG8_WAIT_V(6); PG8_BAR;
    for (;;) {
        const bool has_next = S.next(ui + 1, nxt);
        const GAS char* nA = has_next ? nxt.A : cA; const GAS char* nB = has_next ? nxt.B : cB;
#pragma unroll 1
        for (int t = 0; t < nt; t += 2) {
            const bool last = (t == nt - 2);
            const GAS char* a1 = cA + (size_t)(t + 1) * kstep;
            const GAS char* a2 = last ? nA : cA + (size_t)(t + 2) * kstep; const GAS char* b2 = last ? nB : cB + (size_t)(t + 2) * kstep;
            const GAS char* a3 = a2 + kstep; const GAS char* b3 = b2 + kstep;
            if constexpr (GATHER) { if (last && has_next) { PG8_LOADROWS(vAn, nxt); } }
            PG8_LDB(B0, 0, 0); PG8_LDB(B1, 0, 1); PG8_SCHED; PG8_LDA(At, 0, 0); PG8_STAGE_A(PG8_SA(1, 1), a1, vA[1][0], vA[1][1]);
            PG8_WAIT_V(8); PG8_WAIT_L(0); PG8_BAR; PG8_MMA(0, 0, At, B0); PG8_MMA(0, 1, At, B1); PG8_BAR; PG8_SCHED;
            PG8_LDA(At, 0, 1); PG8_STAGE_B(PG8_SB(0, 0), b2); PG8_STAGE_B(PG8_SB(0, 1), b2 + hstepB); PG8_STAGE_A(PG8_SA(0, 0), a2, PG8_VAN(0, 0), PG8_VAN(0, 1));
            PG8_WAIT_V(8); PG8_WAIT_L(0); PG8_BAR; PG8_MMA(1, 0, At, B0); PG8_MMA(1, 1, At, B1); PG8_BAR; PG8_SCHED;
            PG8_LDB(B0, 1, 0); PG8_LDB(B1, 1, 1); PG8_SCHED; PG8_LDA(At, 1, 0); PG8_STAGE_A(PG8_SA(0, 1), a2, PG8_VAN(1, 0), PG8_VAN(1, 1));
            PG8_WAIT_V(8); PG8_WAIT_L(0); PG8_BAR; PG8_MMA(0, 0, At, B0); PG8_MMA(0, 1, At, B1); PG8_BAR; PG8_SCHED;
            PG8_LDA(At, 1, 1); PG8_STAGE_B(PG8_SB(1, 0), b3); PG8_STAGE_B(PG8_SB(1, 1), b3 + hstepB); PG8_STAGE_A(PG8_SA(1, 0), a3, PG8_VAN(0, 0), PG8_VAN(0, 1));
            PG8_WAIT_V(8); PG8_WAIT_L(0); PG8_BAR; PG8_MMA(1, 0, At, B0); PG8_MMA(1, 1, At, B1); PG8_BAR; PG8_SCHED;
        }
        if (wr == 0) PG8_BAR;
        if constexpr (FP8) asm volatile("s_nop 15\n\ts_nop 15" ::: "memory");
        E(acc, cur, wr, wc, fr, fq);
        if (!has_next) break;
#pragma unroll
        for (int a = 0; a < 2; ++a)
#pragma unroll
            for (int b = 0; b < 2; ++b)
#pragma unroll
                for (int m = 0; m < 4; ++m)
#pragma unroll
                    for (int n = 0; n < 2; ++n) acc[a][b][m][n] = (f32x4){0.f, 0.f, 0.f, 0.f};
        cur = nxt; cA = nA; cB = nB; ++ui;
        if constexpr (GATHER) { vA[0][0] = vAn[0][0]; vA[0][1] = vAn[0][1]; vA[1][0] = vAn[1][0]; vA[1][1] = vAn[1][1]; }
        if (wr == 1) PG8_BAR;
    }
    PG8_WAIT_V(0);
    PG8_BAR;
#undef PG8_SA
#undef PG8_SB
#undef PG8_STAGE_A
#undef PG8_STAGE_B
#undef PG8_LDA
#undef PG8_LD32
#undef PG8_LDB
#undef PG8_MMA
#undef PG8_WAIT_V
#undef PG8_WAIT_L
#undef PG8_BAR
#undef PG8_SCHED
#undef PG8_LOADROWS
#undef PG8_VAN
}
}

struct SchedPlain {
    __device__ __forceinline__ int scale_b8() const { return 0x7f7f7f7f; }
    __device__ __forceinline__ int scale_a8() const { return 0x7f7f7f7f; }
    __device__ __forceinline__ int brow(int r) const { return r; }
    const GAS char* A; const GAS char* B; size_t a_tile, b_tile; int nM, nN, G, c;
    __device__ __forceinline__ bool next(int i, pg8::Unit& u) const {
        int pm, pn; if (!pg8::tile_of((long)i * G + c, nM, nN, pm, pn)) return false;
        u.pm = pm; u.pn = pn; u.z = 0; u.rows = nullptr; u.A = A + (size_t)pm * a_tile; u.B = B + (size_t)pn * b_tile; return true; }
};
struct SchedPc {
    __device__ __forceinline__ int scale_b8() const { return 0x7f7f7f7f; }
    __device__ __forceinline__ int scale_a8() const { return 0x7f7f7f7f; }
    __device__ __forceinline__ int brow(int r) const { return r; }
    const GAS char* Q; const GAS char* Kk; int G, c;
    __device__ __forceinline__ bool next(int i, pg8::Unit& u) const {
        const int L = i * G + c; if (L >= NB * NH * 16) return false;
        const int cp = L & 15, h = (L >> 4) & 3, b = L >> 6;
        const size_t off = ((size_t)(b * SEQ + cp * 256) * QKW + h * DK) * 2;
        u.pm = L; u.pn = 0; u.z = h; u.rows = nullptr; u.A = Q + off; u.B = Kk + off; return true; }
};
struct SchedFnA {
    __device__ __forceinline__ int scale_b8() const { return 0x7f7f7f7f; }
    __device__ __forceinline__ int scale_a8() const { return 0x7f7f7f7f; }
    __device__ __forceinline__ int brow(int r) const { return r; }
    const GAS char* Wc; const GAS char* Hn; int G, c;
    __device__ __forceinline__ bool next(int i, pg8::Unit& u) const {
        int pm, pn; if (!pg8::tile_of((long)i * G + c, 8, T / 256, pm, pn)) return false;
        const int g = pm >> 1, ri = pm & 1;
        u.pm = pm; u.pn = pn; u.z = 0; u.rows = nullptr; u.A = Wc + (size_t)ri * 256 * 256 * 2; u.B = Hn + ((size_t)pn * 256 * D + g * 256) * 2; return true; }
};
struct SchedFnB {
    __device__ __forceinline__ int scale_b8() const { return 0x7f7f7f7f; }
    __device__ __forceinline__ int scale_a8() const { return 0x7f7f7f7f; }
    __device__ __forceinline__ int brow(int r) const { return (r & 63) * 8 + (r >> 6); }
    GAS const char* WY; GAS const char* U; int G, c;
    __device__ __forceinline__ bool next(int i, pg8::Unit& u) const {
        int pm, pn; if (!pg8::tile_of((long)i * G + c, 2, 256, pm, pn)) return false;
        const int batch = pn >> 5, fb = (pn >> 1) & 15, kbb = pn & 1;
        u.pm = pm; u.pn = pn; u.z = 0; u.rows = nullptr; u.A = WY + (size_t)pm * 256 * 1024 * 2; u.B = U + ((size_t)(batch * 1024 + fb * 64) * 8 + kbb * 4) * 1024 * 2; return true; }
};
struct SchedMoe {
    __device__ __forceinline__ int scale_b8() const { return 0x79797979; }
    __device__ __forceinline__ int scale_a8() const { return sa8; }
    __device__ __forceinline__ int brow(int r) const { return r; }
    const GAS char* A; const GAS char* W; const GAS int* rowtok; const LAS unsigned char* texp; size_t a_tile, w_exp, w_tile; int ntiles, ncol, G, c; bool gather; int sa8;
    __device__ __forceinline__ bool next(int i, pg8::Unit& u) const {
        int rt, ct; if (!pg8::tile_of((long)i * G + c, ntiles, ncol, rt, ct)) return false;
        const int e = texp[rt];
        u.pm = rt; u.pn = ct; u.z = e; u.rows = rowtok + rt * 256; u.A = gather ? A : A + (size_t)rt * a_tile; u.B = W + (size_t)e * w_exp + (size_t)ct * w_tile; return true; }
};

struct EpiRopeQK {
    static constexpr bool PERM = true;
    GAS bf16* Q; GAS bf16* Kk; const GAS f32x2* rot;
    __device__ __forceinline__ void operator()(const f32x4 (&acc)[2][2][4][2], const pg8::Unit& u, int wr, int wc, int fr, int fq) const {
        const bool isk = u.pn >= 4; const int h = u.pn & 3; GAS bf16* dst = isk ? Kk : Q; const float sc = isk ? 0.0625f : 1.0f;
        const int i0 = wc * 32 + 8 * fq;
#pragma unroll
        for (int ai = 0; ai < 2; ++ai)
#pragma unroll
            for (int m = 0; m < 4; ++m) {
                const int t = u.pm * 256 + ai * 128 + wr * 64 + m * 16 + fr, s = t & (SEQ - 1);
                const GAS f32x4* rp = (const GAS f32x4*)(rot + (size_t)s * 128 + i0);
                const f32x4 r0 = rp[0], r1 = rp[1], r2 = rp[2], r3 = rp[3];
                const float cs[8] = {r0[0], r0[2], r1[0], r1[2], r2[0], r2[2], r3[0], r3[2]}, sn[8] = {r0[1], r0[3], r1[1], r1[3], r2[1], r2[3], r3[1], r3[3]};
                float o1[8], o2[8];
#pragma unroll
                for (int n = 0; n < 2; ++n)
#pragma unroll
                    for (int j = 0; j < 4; ++j) { const float t1 = acc[ai][0][m][n][j], t2 = acc[ai][1][m][n][j]; const int q = 4 * n + j;
                        o1[q] = (t1 * cs[q] - t2 * sn[q]) * sc; o2[q] = (t1 * sn[q] + t2 * cs[q]) * sc; }
                GAS bf16* rowp = dst + (size_t)t * QKW + h * DK + i0;
                u32x4 w1, w2; w1.x = cvt_pk_bf16(o1[0], o1[1]); w1.y = cvt_pk_bf16(o1[2], o1[3]); w1.z = cvt_pk_bf16(o1[4], o1[5]); w1.w = cvt_pk_bf16(o1[6], o1[7]);
                w2.x = cvt_pk_bf16(o2[0], o2[1]); w2.y = cvt_pk_bf16(o2[2], o2[3]); w2.z = cvt_pk_bf16(o2[4], o2[5]); w2.w = cvt_pk_bf16(o2[6], o2[7]);
                *(GAS u32x4*)rowp = w1; *(GAS u32x4*)(rowp + 128) = w2; }
    }
};
struct EpiRopeKT {
    static constexpr bool PERM = true;
    GAS bf16* KT; const GAS f32x2* rotT; const LAS float* l2g;
    __device__ __forceinline__ void operator()(const f32x4 (&acc)[2][2][4][2], const pg8::Unit& u, int wr, int wc, int fr, int fq) const {
        const int h = u.pm; const float l2f = l2g[h], l2b = l2g[4 + h];
#pragma unroll
        for (int bj = 0; bj < 2; ++bj) {
            const int tok0 = u.pn * 256 + bj * 128 + wc * 32 + 8 * fq, s0 = tok0 & (SEQ - 1), j0 = tok0 & (CH - 1);
            float zf[8], zb[8];
#pragma unroll
            for (int q = 0; q < 8; ++q) { zf[q] = fast_exp2((float)(CH - 1 - (j0 + q)) * l2f) * 0.0625f; zb[q] = fast_exp2((float)(j0 + q) * l2b) * 0.0625f; }
#pragma unroll
            for (int m = 0; m < 4; ++m) { const int i = wr * 64 + m * 16 + fr;
                const GAS f32x4* rp = (const GAS f32x4*)(rotT + (size_t)i * RTP + s0);
                const f32x4 r0 = rp[0], r1 = rp[1], r2 = rp[2], r3 = rp[3];
                const float cs[8] = {r0[0], r0[2], r1[0], r1[2], r2[0], r2[2], r3[0], r3[2]}, sn[8] = {r0[1], r0[3], r1[1], r1[3], r2[1], r2[3], r3[1], r3[3]};
                float o1[8], o2[8];
#pragma unroll
                for (int n = 0; n < 2; ++n)
#pragma unroll
                    for (int j = 0; j < 4; ++j) { const float t1 = acc[0][bj][m][n][j], t2 = acc[1][bj][m][n][j]; const int q = 4 * n + j;
                        o1[q] = t1 * cs[q] - t2 * sn[q]; o2[q] = t1 * sn[q] + t2 * cs[q]; }
                u32x4 w1, w2;
                w1.x = cvt_pk_bf16(o1[0] * zf[0], o1[1] * zf[1]); w1.y = cvt_pk_bf16(o1[2] * zf[2], o1[3] * zf[3]); w1.z = cvt_pk_bf16(o1[4] * zf[4], o1[5] * zf[5]); w1.w = cvt_pk_bf16(o1[6] * zf[6], o1[7] * zf[7]);
                w2.x = cvt_pk_bf16(o2[0] * zf[0], o2[1] * zf[1]); w2.y = cvt_pk_bf16(o2[2] * zf[2], o2[3] * zf[3]); w2.z = cvt_pk_bf16(o2[4] * zf[4], o2[5] * zf[5]); w2.w = cvt_pk_bf16(o2[6] * zf[6], o2[7] * zf[7]);
                const size_t fr0 = ((((size_t)((tok0 >> 12) * NH + h) * NCH + ((tok0 & (SEQ - 1)) >> 7)) * 8 + (i >> 5)) * 8 + (2 * wc + (fq >> 1))) * 512 + ((i & 31) + 32 * (fq & 1)) * 8;
                *(GAS u32x4*)(KT + fr0) = w1; *(GAS u32x4*)(KT + fr0 + (size_t)4 * 8 * 512) = w2;
                w1.x = cvt_pk_bf16(o1[0] * zb[0], o1[1] * zb[1]); w1.y = cvt_pk_bf16(o1[2] * zb[2], o1[3] * zb[3]); w1.z = cvt_pk_bf16(o1[4] * zb[4], o1[5] * zb[5]); w1.w = cvt_pk_bf16(o1[6] * zb[6], o1[7] * zb[7]);
                w2.x = cvt_pk_bf16(o2[0] * zb[0], o2[1] * zb[1]); w2.y = cvt_pk_bf16(o2[2] * zb[2], o2[3] * zb[3]); w2.z = cvt_pk_bf16(o2[4] * zb[4], o2[5] * zb[5]); w2.w = cvt_pk_bf16(o2[6] * zb[6], o2[7] * zb[7]);
                *(GAS u32x4*)(KT + (size_t)QKW * T + fr0) = w1; *(GAS u32x4*)(KT + (size_t)QKW * T + fr0 + (size_t)4 * 8 * 512) = w2; } }
    }
};
template <bool ROT> struct EpiBf16 {
    static constexpr bool PERM = true;
    GAS bf16* O; int ldc;
    __device__ __forceinline__ void operator()(const f32x4 (&acc)[2][2][4][2], const pg8::Unit& u, int wr, int wc, int fr, int fq) const {
#pragma unroll
        for (int ai = 0; ai < 2; ++ai)
#pragma unroll
            for (int m = 0; m < 4; ++m) { const int row = u.pm * 256 + ai * 128 + wr * 64 + m * 16 + fr; GAS bf16* rowp = O + (size_t)row * ldc;
#pragma unroll
                for (int bj = 0; bj < 2; ++bj) { const f32x4 v0 = acc[ai][bj][m][0], v1 = acc[ai][bj][m][1]; const int col = u.pn * 256 + bj * 128 + wc * 32 + 8 * fq;
                    u32x4 w; w.x = cvt_pk_bf16(v0[0], v0[1]); w.y = cvt_pk_bf16(v0[2], v0[3]); w.z = cvt_pk_bf16(v1[0], v1[1]); w.w = cvt_pk_bf16(v1[2], v1[3]);
                    *(GAS u32x4*)(rowp + (ROT ? rot_col(row, col) : col)) = w; } }
    }
};
struct EpiPc {
    static constexpr bool PERM = true;
    GAS bf16* PC; GAS bf16* PD; const LAS float* l2g;
    __device__ __forceinline__ void operator()(const f32x4 (&acc)[2][2][4][2], const pg8::Unit& u, int wr, int wc, int fr, int fq) const {
        const int h = u.z; const float l2f = l2g[h], l2b = l2g[4 + h];
#pragma unroll
        for (int ai = 0; ai < 2; ++ai)
#pragma unroll
            for (int m = 0; m < 4; ++m) { const int il = wr * 64 + m * 16 + fr, jl0 = wc * 32 + 8 * fq; float o[8];
                const bool diag = (wc == 2 * wr + (m >> 1));
#pragma unroll
                for (int n = 0; n < 2; ++n)
#pragma unroll
                    for (int j = 0; j < 4; ++j) { const int dl = il - (jl0 + 4 * n + j); const float f = dl >= 0 ? fast_exp2((float)dl * l2f) : fast_exp2((float)(-dl) * l2b);
                        o[4 * n + j] = (ai == 0 ? acc[0][0][m][n][j] : acc[1][1][m][n][j]) * f; }
                if (diag) {
                    float ob[8];
#pragma unroll
                    for (int q = 0; q < 8; ++q) { const bool lower = (jl0 + q) <= il; ob[q] = lower ? 0.f : o[q]; o[q] = lower ? o[q] : 0.f; }
                    u32x4 wb; wb.x = cvt_pk_bf16(ob[0], ob[1]); wb.y = cvt_pk_bf16(ob[2], ob[3]); wb.z = cvt_pk_bf16(ob[4], ob[5]); wb.w = cvt_pk_bf16(ob[6], ob[7]);
                    *(GAS u32x4*)(PD + ((((size_t)(u.pm * 2 + ai) * 4 + (il >> 5)) * 2 + (fq >> 1)) * 512 + ((il & 31) + 32 * (fq & 1)) * 8)) = wb;
                }
                u32x4 w; w.x = cvt_pk_bf16(o[0], o[1]); w.y = cvt_pk_bf16(o[2], o[3]); w.z = cvt_pk_bf16(o[4], o[5]); w.w = cvt_pk_bf16(o[6], o[7]);
                *(GAS u32x4*)(PC + ((((size_t)(u.pm * 2 + ai) * 4 + (il >> 5)) * 8 + (2 * wc + (fq >> 1))) * 512 + ((il & 31) + 32 * (fq & 1)) * 8)) = w; }
    }
};
struct EpiGate {
    static constexpr bool PERM = true;
    const GAS bf16* Y; GAS bf16* YG; const GAS f32x2* statp; const GAS float* gain; LAS f32x2* sst;
    __device__ __forceinline__ void operator()(const f32x4 (&acc)[2][2][4][2], const pg8::Unit& u, int wr, int wc, int fr, int fq) const {
        const int head = u.pn >> 1, c0 = u.pn * 256 + wc * 32 + 8 * fq;
        const int tid = (wr * 4 + wc) * 64 + fq * 16 + fr;
        if (tid < 256) { const int t = u.pm * 256 + tid; const GAS f32x4* sp = (const GAS f32x4*)(statp + ((size_t)t * 4 + head) * 8); float a1 = 0.f, a2 = 0.f;
#pragma unroll
            for (int k = 0; k < 4; ++k) { const f32x4 v = sp[k]; a1 += v[0] + v[2]; a2 += v[1] + v[3]; }
            const float mu = a1 * (1.f / DV), var = fmaxf(a2 * (1.f / DV) - mu * mu, 0.f); sst[tid] = (f32x2){mu, __builtin_amdgcn_rsqf(var + EPS)}; }
        asm volatile("s_waitcnt lgkmcnt(0)" ::: "memory"); __builtin_amdgcn_s_barrier(); asm volatile("" ::: "memory");
        f32x4 gv[2][2];
#pragma unroll
        for (int bj = 0; bj < 2; ++bj) { gv[bj][0] = *(const GAS f32x4*)(gain + c0 + bj * 128); gv[bj][1] = *(const GAS f32x4*)(gain + c0 + bj * 128 + 4); }
#pragma unroll
        for (int ai = 0; ai < 2; ++ai)
#pragma unroll
            for (int m = 0; m < 4; ++m) { const int rl = ai * 128 + wr * 64 + m * 16 + fr, t = u.pm * 256 + rl; const f32x2 st = sst[rl];
#pragma unroll
                for (int bj = 0; bj < 2; ++bj) { const size_t off = (size_t)t * VW + c0 + bj * 128;
                    const int es_ = (u.pn & 1) * 4 + bj * 2 + (wc >> 1);
                    const u32x4 yv = *(const GAS u32x4*)(Y + (((size_t)(t >> 5) * NH + head) * 8 + es_) * 2048 + (((wc & 1) * 2 + (fq >> 1)) * 64 + (t & 31) + 32 * (fq & 1)) * 8);
                    const float y[8] = {bf_lo(yv.x), bf_hi(yv.x), bf_lo(yv.y), bf_hi(yv.y), bf_lo(yv.z), bf_hi(yv.z), bf_lo(yv.w), bf_hi(yv.w)}; float o[8];
#pragma unroll
                    for (int n = 0; n < 2; ++n)
#pragma unroll
                        for (int j = 0; j < 4; ++j) { const int q = 4 * n + j; const float yn = (y[q] - st.x) * st.y * gv[bj][n][j]; o[q] = silu_f(acc[ai][bj][m][n][j]) * yn; }
                    u32x4 w; w.x = cvt_pk_bf16(o[0], o[1]); w.y = cvt_pk_bf16(o[2], o[3]); w.z = cvt_pk_bf16(o[4], o[5]); w.w = cvt_pk_bf16(o[6], o[7]);
                    *(GAS u32x4*)(YG + off) = w; } }
    }
};
template <bool BASE_F32> struct EpiRes {
    static constexpr bool PERM = true;
    const GAS void* base; GAS bf16* out;
    __device__ __forceinline__ void operator()(const f32x4 (&acc)[2][2][4][2], const pg8::Unit& u, int wr, int wc, int fr, int fq) const {
#pragma unroll
        for (int ai = 0; ai < 2; ++ai)
#pragma unroll
            for (int m = 0; m < 4; ++m) { const size_t off = (size_t)(u.pm * 256 + ai * 128 + wr * 64 + m * 16 + fr) * D + u.pn * 256 + wc * 32 + 8 * fq;
#pragma unroll
                for (int bj = 0; bj < 2; ++bj) { f32x4 v0 = acc[ai][bj][m][0], v1 = acc[ai][bj][m][1];
                    if (BASE_F32) { const GAS float* bp = (const GAS float*)base + off + bj * 128; v0 += *(const GAS f32x4*)bp; v1 += *(const GAS f32x4*)(bp + 4); }
                    else { const u32x4 bv = *(const GAS u32x4*)((const GAS bf16*)base + off + bj * 128);
                        v0 += (f32x4){bf_lo(bv.x), bf_hi(bv.x), bf_lo(bv.y), bf_hi(bv.y)}; v1 += (f32x4){bf_lo(bv.z), bf_hi(bv.z), bf_lo(bv.w), bf_hi(bv.w)}; }
                    u32x4 w; w.x = cvt_pk_bf16(v0[0], v0[1]); w.y = cvt_pk_bf16(v0[2], v0[3]); w.z = cvt_pk_bf16(v1[0], v1[1]); w.w = cvt_pk_bf16(v1[2], v1[3]);
                    *(GAS u32x4*)(out + off + bj * 128) = w; } }
    }
};
template <bool OUT8> struct EpiSwiGLU {
    static constexpr bool PERM = true;
    GAS void* ACT; int ldc;
    __device__ __forceinline__ void operator()(const f32x4 (&acc)[2][2][4][2], const pg8::Unit& u, int wr, int wc, int fr, int fq) const {
#pragma unroll
        for (int ai = 0; ai < 2; ++ai)
#pragma unroll
            for (int m = 0; m < 4; ++m) { float o[8];
#pragma unroll
                for (int n = 0; n < 2; ++n)
#pragma unroll
                    for (int j = 0; j < 4; ++j) o[4 * n + j] = silu_f(acc[ai][0][m][n][j]) * acc[ai][1][m][n][j];
                const size_t off = (size_t)(u.pm * 256 + ai * 128 + wr * 64 + m * 16 + fr) * ldc + u.pn * 128 + wc * 32 + 8 * fq;
                if constexpr (OUT8) { u32x2 w; w.x = pk4_fp8(o[0] * 8.f, o[1] * 8.f, o[2] * 8.f, o[3] * 8.f); w.y = pk4_fp8(o[4] * 8.f, o[5] * 8.f, o[6] * 8.f, o[7] * 8.f); *(GAS u32x2*)((GAS unsigned char*)ACT + off) = w; }
                else { u32x4 w; w.x = cvt_pk_bf16(o[0], o[1]); w.y = cvt_pk_bf16(o[2], o[3]); w.z = cvt_pk_bf16(o[4], o[5]); w.w = cvt_pk_bf16(o[6], o[7]); *(GAS u32x4*)((GAS bf16*)ACT + off) = w; } }
    }
};
struct EpiZ2 {
    static constexpr bool PERM = true;
    GAS bf16* Z2;
    __device__ __forceinline__ void operator()(const f32x4 (&acc)[2][2][4][2], const pg8::Unit& u, int wr, int wc, int fr, int fq) const {
        const int g = u.pm >> 1, ri = u.pm & 1;
#pragma unroll
        for (int ai = 0; ai < 2; ++ai)
#pragma unroll
            for (int m = 0; m < 4; ++m) { const int cp = ai * 128 + wr * 64 + m * 16 + fr;
#pragma unroll
                for (int bj = 0; bj < 2; ++bj) { const int tok0 = u.pn * 256 + bj * 128 + wc * 32 + 8 * fq, b = tok0 >> 12, s0 = tok0 & (SEQ - 1);
                    const f32x4 v0 = acc[ai][bj][m][0], v1 = acc[ai][bj][m][1];
                    u32x4 w; w.x = cvt_pk_bf16(v0[0], v0[1]); w.y = cvt_pk_bf16(v0[2], v0[3]); w.z = cvt_pk_bf16(v1[0], v1[1]); w.w = cvt_pk_bf16(v1[2], v1[3]);
                    *(GAS u32x4*)(Z2 + ((size_t)(b * 1024 + g * 256 + cp) * 8192 + ri * SEQ + s0)) = w; } }
    }
};
struct EpiYf {
    static constexpr bool PERM = true;
    GAS bf16* YF;
    __device__ __forceinline__ void operator()(const f32x4 (&acc)[2][2][4][2], const pg8::Unit& u, int wr, int wc, int fr, int fq) const {
        const int batch = u.pn >> 5, fb = (u.pn >> 1) & 15, kbb = u.pn & 1;
#pragma unroll
        for (int ai = 0; ai < 2; ++ai)
#pragma unroll
            for (int m = 0; m < 4; ++m) { const int ka = u.pm * 256 + ai * 128 + wr * 64 + m * 16 + fr;
#pragma unroll
                for (int bj = 0; bj < 2; ++bj) { const int kb = kbb * 4 + 2 * bj + (wc >> 1), f = fb * 64 + 32 * (wc & 1) + 8 * fq;
                    const f32x4 v0 = acc[ai][bj][m][0], v1 = acc[ai][bj][m][1];
                    u32x4 w; w.x = cvt_pk_bf16(v0[0], v0[1]); w.y = cvt_pk_bf16(v0[2], v0[3]); w.z = cvt_pk_bf16(v1[0], v1[1]); w.w = cvt_pk_bf16(v1[2], v1[3]);
                    *(GAS u32x4*)(YF + (size_t)(batch * SEQ + 8 * ka + kb) * D + f) = w; } }
    }
};
struct EpiMoeDown {
    static constexpr bool PERM = true;
    GAS bf16* Hres; const GAS int* rowtok; const GAS float* rowgate;
    __device__ __forceinline__ void operator()(const f32x4 (&acc)[2][2][4][2], const pg8::Unit& u, int wr, int wc, int fr, int fq) const {
#pragma unroll
        for (int ai = 0; ai < 2; ++ai)
#pragma unroll
            for (int m = 0; m < 4; ++m) { const int row = u.pm * 256 + ai * 128 + wr * 64 + m * 16 + fr; const int tok = rowtok[row]; const float gw = rowgate[row];
                if (tok >= 0) { GAS bf16* rp = Hres + (size_t)tok * D + u.pn * 256 + wc * 32 + 8 * fq;
#pragma unroll
                    for (int bj = 0; bj < 2; ++bj) { const u32x4 bv = *(const GAS u32x4*)(rp + bj * 128);
                        const f32x4 v0 = (f32x4){bf_lo(bv.x), bf_hi(bv.x), bf_lo(bv.y), bf_hi(bv.y)} + gw * acc[ai][bj][m][0], v1 = (f32x4){bf_lo(bv.z), bf_hi(bv.z), bf_lo(bv.w), bf_hi(bv.w)} + gw * acc[ai][bj][m][1];
                        u32x4 w; w.x = cvt_pk_bf16(v0[0], v0[1]); w.y = cvt_pk_bf16(v0[2], v0[3]); w.z = cvt_pk_bf16(v1[0], v1[1]); w.w = cvt_pk_bf16(v1[2], v1[3]);
                        *(GAS u32x4*)(rp + bj * 128) = w; } } }
    }
};

#define XB_TMO      128
#define XB_XCNT(j)  (256  + 64 * (j))
#define XB_XSUB(j)  (1280 + 64 * (j))
#define XB_XGEN(j)  (2304 + 64 * (j))
#define XB_TOP      3328
#define XB_TOPGEN   3392
#define XCD_BAR_WORDS 3456
#define XB_SPIN_CAP (1u << 18)
__device__ __forceinline__ unsigned xb_ld(unsigned* p)              { return __hip_atomic_load(p, __ATOMIC_RELAXED, __HIP_MEMORY_SCOPE_AGENT); }
__device__ __forceinline__ unsigned xb_add(unsigned* p, unsigned v) { return __hip_atomic_fetch_add(p, v, __ATOMIC_RELAXED, __HIP_MEMORY_SCOPE_AGENT); }
__device__ __forceinline__ unsigned xb_xcc_id() { return (unsigned)__builtin_amdgcn_s_getreg((3 << 11) | 20) & 0xFu; }
#define XB_SPIN(cond, bar) do { unsigned _sp = 0; while (cond) { __builtin_amdgcn_s_sleep(1); \
    if ((++_sp & 255u) == 0u) { if (xb_ld(&(bar)[XB_TMO])) break; if (_sp > XB_SPIN_CAP) { atomicAdd(&(bar)[XB_TMO], 1u); break; } } } } while (0)
struct XcdBarrier { unsigned* bar; unsigned x; volatile LAS unsigned* st; };
__device__ __forceinline__ XcdBarrier xcd_barrier_post(unsigned* bar, volatile LAS unsigned* st, const bool t0) {
    XcdBarrier b; b.bar = bar; b.x = xb_xcc_id(); b.st = st;
    if (t0) (void)xb_add(&bar[XB_XCNT(b.x)], 1u);
    return b;
}
__device__ __forceinline__ void xcd_barrier_complete(unsigned* bar, unsigned x, unsigned& nloc, unsigned& nx) {
    const unsigned G = gridDim.x * gridDim.y * gridDim.z;
    unsigned sum, cnt, mine, sp = 0u;
    for (;;) {
        sum = 0u; cnt = 0u; mine = 0u;
#pragma unroll
        for (unsigned j = 0; j < 16; ++j) { const unsigned c = xb_ld(&bar[XB_XCNT(j)]); sum += c; cnt += (c > 0u) ? 1u : 0u; mine = (j == x) ? c : mine; }
        if (sum == G) break;
        __builtin_amdgcn_s_sleep(1);
        if ((++sp & 255u) == 0u) { if (xb_ld(&bar[XB_TMO])) break; if (sp > XB_SPIN_CAP) { atomicAdd(&bar[XB_TMO], 1u); break; } }
    }
    nloc = mine > 0u ? mine : 1u; nx = cnt > 0u ? cnt : 1u;
}
__device__ __forceinline__ void xcd_barrier(const XcdBarrier& b, const bool t0) {
    asm volatile("s_waitcnt vmcnt(0)" ::: "memory");
    __syncthreads();
    if (t0) {
        unsigned* bar = b.bar;
        __builtin_amdgcn_s_waitcnt(0);
        unsigned nloc = b.st[0], nx = b.st[1];
        if (nloc == 0u) { xcd_barrier_complete(bar, b.x, nloc, nx); b.st[0] = nloc; b.st[1] = nx; }
        const unsigned old = xb_add(&bar[XB_XSUB(b.x)], 1u);
        const unsigned gen = old / nloc;
        if (old + 1u == (gen + 1u) * nloc) {
            __builtin_amdgcn_fence(__ATOMIC_RELEASE, "agent");
            asm volatile("s_waitcnt vmcnt(0)" ::: "memory");
            const unsigned og = xb_add(&bar[XB_TOP], 1u);
            const unsigned tg = og / nx;
            if (og + 1u == (tg + 1u) * nx) xb_add(&bar[XB_TOPGEN], 1u);
            else XB_SPIN(xb_ld(&bar[XB_TOPGEN]) == tg, bar);
            __builtin_amdgcn_fence(__ATOMIC_ACQUIRE, "agent");
            xb_add(&bar[XB_XGEN(b.x)], 1u);
            asm volatile("s_waitcnt vmcnt(0)" ::: "memory");
        } else {
            XB_SPIN(xb_ld(&bar[XB_XGEN(b.x)]) == gen, bar);
            __builtin_amdgcn_fence(__ATOMIC_ACQUIRE, "agent");
            asm volatile("s_waitcnt vmcnt(0)" ::: "memory");
        }
    }
    __syncthreads();
}

__device__ __forceinline__ float wave_sum(float v) {
#pragma unroll
    for (int o = 1; o < 64; o <<= 1) v += __shfl_xor(v, o);
    return v;
}
__device__ __forceinline__ void transpose_item(const GAS float* W, int K, int N, GAS bf16* WT, int k0, int n0, int rbase, LAS float* scr, int lane) {
#pragma unroll 8
    for (int i = 0; i < 32; ++i) { const int kk = 2 * i + (lane >> 5); scr[kk * 33 + (lane & 31)] = W[(size_t)(k0 + kk) * N + n0 + (lane & 31)]; }
    LDS_WAIT(); asm volatile("" ::: "memory");
    const int c = lane & 7;
#pragma unroll
    for (int j = 0; j < 4; ++j) { const int n = (lane >> 3) + 8 * j; const LAS float* s = scr + (8 * c) * 33 + n;
        u32x4 o; o.x = cvt_pk_bf16(s[0 * 33], s[1 * 33]); o.y = cvt_pk_bf16(s[2 * 33], s[3 * 33]); o.z = cvt_pk_bf16(s[4 * 33], s[5 * 33]); o.w = cvt_pk_bf16(s[6 * 33], s[7 * 33]);
        *(GAS u32x4*)(WT + (size_t)(rbase + n) * K + k0 + 8 * c) = o; }
    LDS_WAIT(); asm volatile("" ::: "memory");
}
__device__ __forceinline__ void transpose_item8(const GAS float* W, int K, int N, GAS unsigned char* WT8, int k0, int n0, int rbase, float scale, LAS float* scr, int lane) {
#pragma unroll 8
    for (int i = 0; i < 32; ++i) { const int kk = 2 * i + (lane >> 5); scr[kk * 33 + (lane & 31)] = W[(size_t)(k0 + kk) * N + n0 + (lane & 31)]; }
    LDS_WAIT(); asm volatile("" ::: "memory");
    const int c = lane & 7;
#pragma unroll
    for (int j = 0; j < 4; ++j) { const int n = (lane >> 3) + 8 * j; const LAS float* sp = scr + (8 * c) * 33 + n;
        u32x2 o; o.x = pk4_fp8(sp[0 * 33] * scale, sp[1 * 33] * scale, sp[2 * 33] * scale, sp[3 * 33] * scale); o.y = pk4_fp8(sp[4 * 33] * scale, sp[5 * 33] * scale, sp[6 * 33] * scale, sp[7 * 33] * scale);
        *(GAS u32x2*)(WT8 + (size_t)(rbase + n) * K + k0 + 8 * c) = o; }
    LDS_WAIT(); asm volatile("" ::: "memory");
}
__device__ __forceinline__ void tr_gu8(const GAS float* Wg, const GAS float* Wu, int K, int N, GAS unsigned char* WT8, int it, LAS float* scr, int lane) {
    const int nblk = N / 32, per = (K / 64) * nblk; const bool up = it >= per; if (up) it -= per;
    const int kb = it / nblk, nb = it - kb * nblk, f0 = 32 * nb;
    transpose_item8(up ? Wu : Wg, K, N, WT8, 64 * kb, f0, 256 * (f0 >> 7) + (up ? 128 : 0) + (f0 & 127), 64.0f, scr, lane);
}
__device__ __forceinline__ void tr_plain(const GAS float* W, int K, int N, GAS bf16* WT, int it, LAS float* scr, int lane) {
    const int nblk = N / 32, kb = it / nblk, nb = it - kb * nblk; transpose_item(W, K, N, WT, 64 * kb, 32 * nb, 32 * nb, scr, lane);
}
__device__ __forceinline__ void tr_gu(const GAS float* Wg, const GAS float* Wu, int K, int N, GAS bf16* WT, int it, LAS float* scr, int lane) {
    const int nblk = N / 32, per = (K / 64) * nblk; const bool up = it >= per; if (up) it -= per;
    const int kb = it / nblk, nb = it - kb * nblk, f0 = 32 * nb;
    transpose_item(up ? Wu : Wg, K, N, WT, 64 * kb, f0, 256 * (f0 >> 7) + (up ? 128 : 0) + (f0 & 127), scr, lane);
}
__device__ __forceinline__ void rms_row(const GAS float* xrow, const GAS float* g, GAS bf16* orow, int lane, f32x4 (&v)[4]) {
    const GAS f32x4* xr = (const GAS f32x4*)xrow + lane; const GAS f32x4* gr = (const GAS f32x4*)g + lane;
    float s = 0.f;
#pragma unroll
    for (int j = 0; j < 4; ++j) { v[j] = xr[64 * j]; s += (v[j].x * v[j].x + v[j].y * v[j].y) + (v[j].z * v[j].z + v[j].w * v[j].w); }
    const float r = 1.0f / sqrtf(wave_sum(s) * (1.f / D) + EPS);
    GAS u32x2* o8 = (GAS u32x2*)orow + lane;
#pragma unroll
    for (int j = 0; j < 4; ++j) { v[j] = v[j] * r * gr[64 * j]; u32x2 w; w.x = cvt_pk_bf16(v[j].x, v[j].y); w.y = cvt_pk_bf16(v[j].z, v[j].w); o8[64 * j] = w; }
}
__device__ __forceinline__ int rmsb_col(int j, int lane) { return 512 * (j >> 1) + 8 * lane + 4 * (j & 1); }
__device__ __forceinline__ void rms_row_b(const GAS bf16* hrow, const GAS float* g, GAS bf16* orow, int lane, f32x4 (&v)[4]) {
    float s = 0.f;
#pragma unroll
    for (int jh = 0; jh < 2; ++jh) { const u32x4 x = *(const GAS u32x4*)(hrow + 512 * jh + 8 * lane);
        v[2 * jh] = (f32x4){bf_lo(x.x), bf_hi(x.x), bf_lo(x.y), bf_hi(x.y)}; v[2 * jh + 1] = (f32x4){bf_lo(x.z), bf_hi(x.z), bf_lo(x.w), bf_hi(x.w)}; }
#pragma unroll
    for (int j = 0; j < 4; ++j) s += (v[j].x * v[j].x + v[j].y * v[j].y) + (v[j].z * v[j].z + v[j].w * v[j].w);
    const float r = 1.0f / sqrtf(wave_sum(s) * (1.f / D) + EPS);
#pragma unroll
    for (int jh = 0; jh < 2; ++jh) { const GAS float* gp = g + 512 * jh + 8 * lane; v[2 * jh] = v[2 * jh] * r * *(const GAS f32x4*)gp; v[2 * jh + 1] = v[2 * jh + 1] * r * *(const GAS f32x4*)(gp + 4);
        u32x4 w; w.x = cvt_pk_bf16(v[2 * jh].x, v[2 * jh].y); w.y = cvt_pk_bf16(v[2 * jh].z, v[2 * jh].w); w.z = cvt_pk_bf16(v[2 * jh + 1].x, v[2 * jh + 1].y); w.w = cvt_pk_bf16(v[2 * jh + 1].z, v[2 * jh + 1].w);
        *(GAS u32x4*)(orow + 512 * jh + 8 * lane) = w; }
}

__device__ __forceinline__ void rms_row_b8(const GAS bf16* hrow, const GAS float* g, GAS unsigned char* o8, int lane, f32x4 (&v)[4]) {
    float s = 0.f;
#pragma unroll
    for (int jh = 0; jh < 2; ++jh) { const u32x4 x = *(const GAS u32x4*)(hrow + 512 * jh + 8 * lane);
        v[2 * jh] = (f32x4){bf_lo(x.x), bf_hi(x.x), bf_lo(x.y), bf_hi(x.y)}; v[2 * jh + 1] = (f32x4){bf_lo(x.z), bf_hi(x.z), bf_lo(x.w), bf_hi(x.w)}; }
#pragma unroll
    for (int j = 0; j < 4; ++j) s += (v[j].x * v[j].x + v[j].y * v[j].y) + (v[j].z * v[j].z + v[j].w * v[j].w);
    const float r = 1.0f / sqrtf(wave_sum(s) * (1.f / D) + EPS);
#pragma unroll
    for (int jh = 0; jh < 2; ++jh) { const GAS float* gp = g + 512 * jh + 8 * lane; v[2 * jh] = v[2 * jh] * r * *(const GAS f32x4*)gp; v[2 * jh + 1] = v[2 * jh + 1] * r * *(const GAS f32x4*)(gp + 4);
        u32x2 w; w.x = pk4_fp8(v[2 * jh].x, v[2 * jh].y, v[2 * jh].z, v[2 * jh].w); w.y = pk4_fp8(v[2 * jh + 1].x, v[2 * jh + 1].y, v[2 * jh + 1].z, v[2 * jh + 1].w);
        *(GAS u32x2*)(o8 + 512 * jh + 8 * lane) = w; }
}

constexpr int SW_QL = 0, SW_SPITCH = 528, SW_SL = 128 * 528, SW_VPITCH = 272, SW_VL = SW_SL + 64 * SW_SPITCH, SW_VB = 64 * SW_VPITCH;
static_assert(SW_VL + 2 * SW_VB <= 139264, "sweep LDS");
template <bool OUT> __device__ __forceinline__ void sweep_role(LAS unsigned char* lds, const GAS bf16* Qg, const GAS bf16* KTFg, const GAS bf16* KTBg, const GAS bf16* VTg, const GAS bf16* PCg, const GAS bf16* PDg, const GAS bf16* ZEROg, GAS bf16* Yg, GAS f32x2* statp, const float l2f, const float l2b, int b, int h, int es, const int wave_s) {
    const int tid = tid_of(wave_s);
    const int w = __builtin_amdgcn_readfirstlane(tid >> 6), lane = tid & 63, r32 = lane & 31, hh = lane >> 5;
    const int rb = w & 3;
    const int vrow = tid >> 4, vpc = tid & 15;
    const int qrow = tid >> 5, qpc = tid & 31;
    const GAS bf16* qp = Qg + (size_t)(b * SEQ + qrow) * QKW + h * DK + 8 * qpc;
    const GAS bf16* vtp = VTg + (size_t)(h * DV + 64 * es + vrow) * T + 8 * vpc; const int vrot = b * SEQ + ((vrow & 15) << 11);
    const int il = 32 * rb + r32;
    const GAS bf16* pcp = PCg + (((size_t)((b * NH + h) * NCH) * 4 + rb) * 8) * 512 + lane * 8;
    const GAS bf16* pdp = PDg + (((size_t)((b * NH + h) * NCH) * 4 + rb) * 2) * 512 + lane * 8;
    GAS bf16* yp = Yg + ((size_t)(((b * SEQ) >> 5) + rb) * NH + h) * 8 * 2048 + (size_t)es * 2048 + lane * 8;
    GAS f32x2* stp = statp + ((size_t)(b * SEQ + il) * NH + h) * 8 + es;
    const size_t kto = ((size_t)((b * NH + h) * NCH) * 8 + 2 * rb) * 8 * 512 + lane * 8;
#define SW_LDP(dst, s_, d_, nn_) do { const int jb_ = (s_) >> 1; const bool use_ = (d_) ? (jb_ >= rb) : (jb_ <= rb); const bool dg_ = (d_) && (jb_ == rb); \
        const GAS bf16* src_ = dg_ ? (pdp + (size_t)(nn_) * 4096 + 512 * ((s_) & 1)) : (pcp + (size_t)(nn_) * (CH * CH) + 512 * (s_)); \
        dst = *(const GAS bf16x8*)(use_ ? src_ : ZEROg); } while (0)
#define SW_SCHED __builtin_amdgcn_sched_barrier(0)
#define SW_MFMA(a, b, c) c = __builtin_amdgcn_mfma_f32_32x32x16_bf16(a, b, c, 0, 0, 0)
    bf16x8 pa[8];
    bf16x8 ka[2][8];
    u32x4 vv[2], qv[4];
    f32x16 Sacc[2][2];
    if constexpr (OUT) {
#pragma unroll
        for (int s = 0; s < 8; ++s) SW_LDP(pa[s], s, 0, 0);
    } else {
#pragma unroll
        for (int db = 0; db < 2; ++db)
#pragma unroll
            for (int s = 0; s < 8; ++s) ka[db][s] = *(const GAS bf16x8*)(KTFg + kto + db * 4096 + s * 512);
#pragma unroll
        for (int db = 0; db < 2; ++db)
#pragma unroll
            for (int et = 0; et < 2; ++et)
#pragma unroll
                for (int t = 0; t < 16; ++t) Sacc[db][et][t] = 0.f;
    }
#pragma unroll
    for (int it = 0; it < 2; ++it) vv[it] = *(const GAS u32x4*)(vtp + (size_t)(32 * it) * T + (vrot & (T - 1)));
#pragma unroll
    for (int it = 0; it < 2; ++it) *(LAS u32x4*)(lds + SW_VL + (vrow + 32 * it) * SW_VPITCH + vpc * 16) = vv[it];
#pragma unroll
    for (int hf = 0; hf < 2; ++hf) {
#pragma unroll
        for (int it = 0; it < 4; ++it) qv[it] = *(const GAS u32x4*)(qp + (size_t)(16 * (4 * hf + it)) * QKW);
#pragma unroll
        for (int it = 0; it < 4; ++it) { const int row = qrow + 16 * (4 * hf + it); *(LAS u32x4*)(lds + SW_QL + row * SW_SPITCH + qpc * 16) = qv[it]; }
    }
    const int sl_rd = SW_SL + r32 * SW_SPITCH + 16 * hh;
    const int q_rd = SW_QL + il * SW_SPITCH + 16 * hh;
#pragma unroll 1
    for (int p = 0; p < 2 * NCH; ++p) {
        const int dir = p >> 5, st = p & 31, n = dir ? NCH - 1 - st : st;
        const int pn = p + 1 < 2 * NCH ? p + 1 : p, dirn = pn >> 5, stn = pn & 31, nn = dirn ? NCH - 1 - stn : stn;
        const int cur = p & 1;
        const float l2 = dir ? l2b : l2f;
        const int v_rd = SW_VL + cur * SW_VB + r32 * SW_VPITCH + 16 * hh;
        if constexpr (!OUT) {
#pragma unroll
            for (int db = 0; db < 2; ++db)
#pragma unroll
                for (int et = 0; et < 2; ++et)
#pragma unroll
                    for (int g = 0; g < 4; ++g) { u32x2 pk; pk.x = cvt_pk_bf16(Sacc[db][et][4 * g], Sacc[db][et][4 * g + 1]); pk.y = cvt_pk_bf16(Sacc[db][et][4 * g + 2], Sacc[db][et][4 * g + 3]);
                        if (st == 0) { pk.x = 0u; pk.y = 0u; }
                        *(LAS u32x2*)(lds + SW_SL + (32 * et + r32) * SW_SPITCH + (64 * rb + 32 * db + 8 * g + 4 * hh) * 2) = pk; }
        }
#pragma unroll
        for (int it = 0; it < 2; ++it) vv[it] = *(const GAS u32x4*)(vtp + (size_t)(32 * it) * T + ((nn * CH + vrot) & (T - 1)));
#pragma unroll
        for (int it = 0; it < 4; ++it) qv[it] = *(const GAS u32x4*)(qp + (size_t)(nn * CH + 16 * it) * QKW);
        __syncthreads();
        f32x16 O[2];
        u32x4 yf[4];
        GAS bf16* ypn = yp + (size_t)(n * 4) * (NH * 8 * 2048);
        if constexpr (OUT) {
#pragma unroll
            for (int et = 0; et < 2; ++et)
#pragma unroll
                for (int t = 0; t < 16; ++t) O[et][t] = 0.f;
            bf16x8 qx[2], s0x[2], s1x[2], qy[2], s0y[2], s1y[2];
#define SW_LDC(dq, d0, d1, g2) do { _Pragma("unroll") for (int k = 0; k < 2; ++k) { const int ks = 2 * (g2) + k; dq[k] = *(const LAS bf16x8*)(lds + q_rd + 32 * ks); \
                d0[k] = *(const LAS bf16x8*)(lds + sl_rd + 32 * ks); d1[k] = *(const LAS bf16x8*)(lds + sl_rd + 32 * SW_SPITCH + 32 * ks); } } while (0)
#define SW_MMC(dq, d0, d1) do { SW_MFMA(d0[0], dq[0], O[0]); SW_MFMA(d1[0], dq[0], O[1]); SW_MFMA(d0[1], dq[1], O[0]); SW_MFMA(d1[1], dq[1], O[1]); } while (0)
            SW_LDC(qx, s0x, s1x, 0); SW_LDC(qy, s0y, s1y, 1); SW_SCHED;
            SW_MMC(qx, s0x, s1x); SW_SCHED; SW_LDC(qx, s0x, s1x, 2); SW_SCHED;
            SW_MMC(qy, s0y, s1y); SW_SCHED; SW_LDC(qy, s0y, s1y, 3); SW_SCHED;
            SW_MMC(qx, s0x, s1x); SW_SCHED; SW_LDC(qx, s0x, s1x, 4); SW_SCHED;
            SW_MMC(qy, s0y, s1y); SW_SCHED; SW_LDC(qy, s0y, s1y, 5); SW_SCHED;
            SW_MMC(qx, s0x, s1x); SW_SCHED; SW_LDC(qx, s0x, s1x, 6); SW_SCHED;
            SW_MMC(qy, s0y, s1y); SW_SCHED; SW_LDC(qy, s0y, s1y, 7); SW_SCHED;
            SW_MMC(qx, s0x, s1x); SW_SCHED;
            SW_MMC(qy, s0y, s1y); SW_SCHED;
#undef SW_LDC
#undef SW_MMC
        } else {
            const float gC = st == 0 ? 0.f : fast_exp2((float)CH * l2);
#pragma unroll
            for (int db = 0; db < 2; ++db)
#pragma unroll
                for (int et = 0; et < 2; ++et)
#pragma unroll
                    for (int t = 0; t < 16; ++t) Sacc[db][et][t] *= gC;
            bf16x8 v0x[2], v1x[2], v0y[2], v1y[2];
#define SW_LDU(d0, d1, g2) do { _Pragma("unroll") for (int k = 0; k < 2; ++k) { const int s_ = 2 * (g2) + k; d0[k] = *(const LAS bf16x8*)(lds + v_rd + 32 * s_); d1[k] = *(const LAS bf16x8*)(lds + v_rd + 32 * SW_VPITCH + 32 * s_); } } while (0)
#define SW_MMU(d0, d1, g2) do { _Pragma("unroll") for (int k = 0; k < 2; ++k) { const int s_ = 2 * (g2) + k; SW_MFMA(ka[0][s_], d0[k], Sacc[0][0]); SW_MFMA(ka[0][s_], d1[k], Sacc[0][1]); SW_MFMA(ka[1][s_], d0[k], Sacc[1][0]); SW_MFMA(ka[1][s_], d1[k], Sacc[1][1]); } } while (0)
            SW_LDU(v0x, v1x, 0); SW_LDU(v0y, v1y, 1); SW_SCHED;
            SW_MMU(v0x, v1x, 0); SW_SCHED; SW_LDU(v0x, v1x, 2); SW_SCHED;
            SW_MMU(v0y, v1y, 1); SW_SCHED; SW_LDU(v0y, v1y, 3); SW_SCHED;
            SW_MMU(v0x, v1x, 2); SW_SCHED;
            SW_MMU(v0y, v1y, 3); SW_SCHED;
#undef SW_LDU
#undef SW_MMU
        }
        __syncthreads();
#pragma unroll
        for (int it = 0; it < 4; ++it) { const int row = qrow + 16 * it; *(LAS u32x4*)(lds + SW_QL + row * SW_SPITCH + qpc * 16) = qv[it]; }
#pragma unroll
        for (int it = 0; it < 4; ++it) qv[it] = *(const GAS u32x4*)(qp + (size_t)(nn * CH + 16 * (4 + it)) * QKW);
        if constexpr (OUT) {
            if (dir) {
#pragma unroll
                for (int q = 0; q < 4; ++q) yf[q] = *(const GAS u32x4*)(ypn + q * 512);
            }
            const float xi = fast_exp2((float)(dir == 0 ? (il + 1) : (CH - il)) * l2);
#pragma unroll
            for (int et = 0; et < 2; ++et)
#pragma unroll
                for (int t = 0; t < 16; ++t) O[et][t] *= xi;
            bf16x8 v0x[2], v1x[2], v0y[2], v1y[2];
#define SW_LDV(d0, d1, g2) do { _Pragma("unroll") for (int k = 0; k < 2; ++k) { const int s_ = 2 * (g2) + k; d0[k] = *(const LAS bf16x8*)(lds + v_rd + 32 * s_); d1[k] = *(const LAS bf16x8*)(lds + v_rd + 32 * SW_VPITCH + 32 * s_); } } while (0)
#define SW_MMV(d0, d1, g2) do { _Pragma("unroll") for (int k = 0; k < 2; ++k) { const int s_ = 2 * (g2) + k; SW_MFMA(d0[k], pa[s_], O[0]); SW_MFMA(d1[k], pa[s_], O[1]); } } while (0)
            SW_LDV(v0x, v1x, 0); SW_LDV(v0y, v1y, 1); SW_SCHED;
            SW_MMV(v0x, v1x, 0); SW_SCHED; SW_LDV(v0x, v1x, 2); SW_SCHED;
            SW_MMV(v0y, v1y, 1); SW_SCHED; SW_LDV(v0y, v1y, 3); SW_SCHED;
            SW_MMV(v0x, v1x, 2); SW_SCHED;
            SW_MMV(v0y, v1y, 3); SW_SCHED;
#undef SW_LDV
#undef SW_MMV
#pragma unroll
            for (int s = 0; s < 8; ++s) SW_LDP(pa[s], s, dirn, nn);
        } else {
            const GAS bf16* ktn = (dirn ? KTBg : KTFg) + kto + (size_t)nn * 32768;
#pragma unroll
            for (int db = 0; db < 2; ++db)
#pragma unroll
                for (int s = 0; s < 8; ++s) ka[db][s] = *(const GAS bf16x8*)(ktn + db * 4096 + s * 512);
        }
#pragma unroll
        for (int it = 0; it < 2; ++it) *(LAS u32x4*)(lds + SW_VL + (cur ^ 1) * SW_VB + (vrow + 32 * it) * SW_VPITCH + vpc * 16) = vv[it];
#pragma unroll
        for (int it = 0; it < 4; ++it) { const int row = qrow + 16 * (4 + it); *(LAS u32x4*)(lds + SW_QL + row * SW_SPITCH + qpc * 16) = qv[it]; }
        if constexpr (OUT) {
            float s1 = 0.f, s2 = 0.f;
#pragma unroll
            for (int et = 0; et < 2; ++et)
#pragma unroll
                for (int kp = 0; kp < 2; ++kp) {
                    float ya[4], yb[4];
#pragma unroll
                    for (int q = 0; q < 4; ++q) { ya[q] = O[et][8 * kp + q]; yb[q] = O[et][8 * kp + 4 + q]; }
                    if (dir) {
                        u32x4 f = yf[et * 2 + kp];
                        { const auto r0 = __builtin_amdgcn_permlane32_swap(f.x, f.z, false, false); f.x = r0[0]; f.z = r0[1]; const auto r1 = __builtin_amdgcn_permlane32_swap(f.y, f.w, false, false); f.y = r1[0]; f.w = r1[1]; }
                        ya[0] += bf_lo(f.x); ya[1] += bf_hi(f.x); ya[2] += bf_lo(f.y); ya[3] += bf_hi(f.y); yb[0] += bf_lo(f.z); yb[1] += bf_hi(f.z); yb[2] += bf_lo(f.w); yb[3] += bf_hi(f.w);
#pragma unroll
                        for (int q = 0; q < 4; ++q) { s1 += ya[q] + yb[q]; s2 += ya[q] * ya[q] + yb[q] * yb[q]; }
                    }
                    u32x4 o; o.x = cvt_pk_bf16(ya[0], ya[1]); o.y = cvt_pk_bf16(ya[2], ya[3]); o.z = cvt_pk_bf16(yb[0], yb[1]); o.w = cvt_pk_bf16(yb[2], yb[3]);
                    { const auto r0 = __builtin_amdgcn_permlane32_swap(o.x, o.z, false, false); o.x = r0[0]; o.z = r0[1]; const auto r1 = __builtin_amdgcn_permlane32_swap(o.y, o.w, false, false); o.y = r1[0]; o.w = r1[1]; }
                    *(GAS u32x4*)(ypn + (et * 2 + kp) * 512) = o;
                }
            if (dir) { s1 += __shfl_xor(s1, 32); s2 += __shfl_xor(s2, 32);
                if (hh == 0) stp[(size_t)(n * CH) * (NH * 8)] = (f32x2){s1, s2}; }
        }
    }
#undef SW_LDP
#undef SW_SCHED
#undef SW_MFMA
    VM_WAIT();
    __syncthreads();
}

__device__ __forceinline__ void sweep_unit(LAS unsigned char* lds, const GAS bf16* Qg, const GAS bf16* KTFg, const GAS bf16* KTBg, const GAS bf16* VTg, const GAS bf16* PCg, const GAS bf16* PDg, const GAS bf16* ZEROg, GAS bf16* Yg, GAS f32x2* statp, const float l2f, const float l2b, int b, int h, int es, const int wave_s) {
    int ws_ = wave_s; asm volatile("" : "+s"(ws_));
    if (ws_ < 4) sweep_role<true>(lds, Qg, KTFg, KTBg, VTg, PCg, PDg, ZEROg, Yg, statp, l2f, l2b, b, h, es, wave_s);
    else sweep_role<false>(lds, Qg, KTFg, KTBg, VTg, PCg, PDg, ZEROg, Yg, statp, l2f, l2b, b, h, es, wave_s);
}

struct Args { const float* in[16]; float* out; unsigned char* ws; };
constexpr int NWAVES = 8;
#ifndef PHMASK
#define PHMASK 0xFFFFFFFFu
#endif
#define PH(k) (((PHMASK) >> (k)) & 1u)
__global__ void __launch_bounds__(NWAVES * 64, 2) fwd_kernel(Args args) {
    extern __shared__ __attribute__((aligned(16))) unsigned char lds_raw[];
    LAS unsigned char* lds = (LAS unsigned char*)lds_raw;
    LAS float* l2g = (LAS float*)(lds + LDSCTL_OFF + 64);
    const int wave_k = __builtin_amdgcn_readfirstlane((int)threadIdx.x >> 6);
#define PHASE_VARS \
    const int tid = tid_of(wave_k); const int lane = tid & 63; int wave = wave_k; asm volatile("" : "+s"(wave)); \
    const __attribute__((address_space(4))) Args* ka = (const __attribute__((address_space(4))) Args*)__builtin_amdgcn_kernarg_segment_ptr(); asm volatile("" : "+s"(ka)); \
    const int G = gridDim.x, bx = blockIdx.x; const int vcu = (G % 8 == 0) ? (bx % 8) * (G / 8) + bx / 8 : bx; const int gw = vcu * NWAVES + wave, NGW = G * NWAVES; \
    GAS unsigned char* ws = (GAS unsigned char*)ka->ws; asm volatile("" : "+s"(ws)); GAS float* hres = (GAS float*)ka->out; (void)lane; (void)gw; (void)NGW; (void)vcu; (void)hres; \
    const GAS float* x = (const GAS float*)ka->in[0]; const GAS float* mix_norm = (const GAS float*)ka->in[1]; const GAS float* ffn_norm = (const GAS float*)ka->in[2]; const GAS float* ret_w_in = (const GAS float*)ka->in[3]; const GAS float* ret_decay = (const GAS float*)ka->in[4]; \
    const GAS float* gn_gain = (const GAS float*)ka->in[5]; const GAS float* ret_w_out = (const GAS float*)ka->in[6]; const GAS float* d_wg = (const GAS float*)ka->in[7]; const GAS float* d_wu = (const GAS float*)ka->in[8]; const GAS float* d_wd = (const GAS float*)ka->in[9]; \
    const GAS float* fnet_w = (const GAS float*)ka->in[10]; const GAS float* moe_router = (const GAS float*)ka->in[11]; const GAS float* m_wg = (const GAS float*)ka->in[12]; const GAS float* m_wu = (const GAS float*)ka->in[13]; const GAS float* m_wd = (const GAS float*)ka->in[14]; const GAS float* final_norm = (const GAS float*)ka->in[15]; \
    (void)x; (void)mix_norm; (void)ffn_norm; (void)ret_w_in; (void)ret_decay; (void)gn_gain; (void)ret_w_out; (void)d_wg; (void)d_wu; (void)d_wd; (void)fnet_w; (void)moe_router; (void)m_wg; (void)m_wu; (void)m_wd; (void)final_norm; \
    GAS f32x2* rot = (GAS f32x2*)(ws + WS_ROT); GAS f32x2* rotT = (GAS f32x2*)(ws + WS_ROTT); GAS bf16* WC = (GAS bf16*)(ws + WS_WC); \
    GAS int* toke = (GAS int*)(ws + WS_TOKE); GAS float* tokw = (GAS float*)(ws + WS_TOKW); GAS int* bcnt = (GAS int*)(ws + WS_BCNT); GAS int* pcnt = (GAS int*)(ws + WS_PCNT); (void)pcnt; GAS int* rowtok = (GAS int*)(ws + WS_ROWTOK); GAS float* rowgate = (GAS float*)(ws + WS_ROWGATE); \
    GAS f32x2* statp = (GAS f32x2*)(ws + WS_STATP); \
    GAS bf16* WIN = (GAS bf16*)(ws + WS_WIN); GAS bf16* WO = (GAS bf16*)(ws + WS_WO); GAS bf16* WGU = (GAS bf16*)(ws + WS_WGU); GAS bf16* WD = (GAS bf16*)(ws + WS_WD); GAS bf16* WF = (GAS bf16*)(ws + WS_WF); \
    GAS bf16* HN = (GAS bf16*)(ws + WS_HN); GAS bf16* Qb = (GAS bf16*)(ws + WS_Q); GAS bf16* Kb = (GAS bf16*)(ws + WS_K); GAS bf16* KT = (GAS bf16*)(ws + WS_KT); GAS bf16* VT = (GAS bf16*)(ws + WS_VT); GAS bf16* PC = (GAS bf16*)(ws + WS_PC); \
    GAS bf16* HB = (GAS bf16*)(ws + WS_HN); GAS bf16* HNB = (GAS bf16*)ka->out; (void)HB; (void)HNB; \
    GAS unsigned char* HN8 = (GAS unsigned char*)ka->out + 64 * MiB; GAS unsigned char* WMGU8 = (GAS unsigned char*)(ws + WS_WMGU); (void)HN8; (void)WMGU8;     \
    GAS bf16* Yb = (GAS bf16*)ka->out; GAS bf16* YG = (GAS bf16*)(ws + WS_YG); GAS bf16* ACTD = (GAS bf16*)(ws + WS_ACTD); GAS bf16* Z2 = (GAS bf16*)(ws + WS_Z2); GAS bf16* WSEQ = (GAS bf16*)(ws + WS_WSEQ); \
    GAS bf16* ACTM = (GAS bf16*)(ws + WS_ACTM); GAS bf16* WMGU = (GAS bf16*)(ws + WS_WMGU); GAS bf16* WMD = (GAS bf16*)(ws + WS_WMD); \
    (void)rot; (void)rotT; (void)WC; (void)toke; (void)tokw; (void)bcnt; (void)rowtok; (void)rowgate; (void)statp; (void)WIN; (void)WO; (void)WGU; (void)WD; (void)WF; (void)HN; (void)Qb; (void)Kb; (void)KT; (void)VT; (void)PC; \
    (void)Yb; (void)YG; (void)ACTD; (void)Z2; (void)WSEQ; (void)ACTM; (void)WMGU; (void)WMD;
#define GRID_BAR() do { const __attribute__((address_space(4))) Args* kb = (const __attribute__((address_space(4))) Args*)__builtin_amdgcn_kernarg_segment_ptr(); asm volatile("" : "+s"(kb)); GAS unsigned char* wsb = (GAS unsigned char*)kb->ws; XcdBarrier bar_; bar_.bar = (unsigned*)(wsb + WS_CTL) + CW_BAR; bar_.x = xb_xcc_id(); \
    bar_.st = (volatile LAS unsigned*)(lds + MISC_OFF) + 8; xcd_barrier(bar_, tid_of(wave_k) == 0); } while (0)

    {
        PHASE_VARS
        for (int u = tid; u < (LDS_BYTES - LDSCTL_OFF) / 4; u += NWAVES * 64) ((LAS unsigned*)(lds + LDSCTL_OFF))[u] = 0u;
        __syncthreads();
        if (tid < 8) { const float xl = ret_decay[tid]; const float ls = fminf(xl, 0.f) - log1pf(expf(-fabsf(xl))); l2g[tid] = ls * 1.44269504088896341f; }
        __syncthreads();
        (void)xcd_barrier_post((unsigned*)(ws + WS_CTL) + CW_BAR, (volatile LAS unsigned*)(lds + MISC_OFF) + 8, tid == 0);
    }

    if (PH(0)) {
        PHASE_VARS
        LAS float* scr = (LAS float*)(lds + wave * 16384);
        constexpr int I_IN = (D / 64) * (INW / 32), I_O = (VW / 64) * (D / 32), I_GU = 2 * (D / 64) * (FFD / 32), I_D = (FFD / 64) * (D / 32), I_F = (D / 64) * (D / 32);
        constexpr int NITEMS = I_IN + I_O + I_GU + I_D + I_F;
        for (int it = gw; it < NITEMS; it += NGW) {
            int r = it;
            if (r < I_IN) { tr_plain(ret_w_in, D, INW, WIN, r, scr, lane); continue; } r -= I_IN;
            if (r < I_O) { tr_plain(ret_w_out, VW, D, WO, r, scr, lane); continue; } r -= I_O;
            if (r < I_GU) { tr_gu(d_wg, d_wu, D, FFD, WGU, r, scr, lane); continue; } r -= I_GU;
            if (r < I_D) { tr_plain(d_wd, FFD, D, WD, r, scr, lane); continue; } r -= I_D;
            tr_plain(fnet_w, D, D, WF, r, scr, lane);
        }
        for (int e = (vcu * 512 + tid); e < SEQ * 128; e += G * 512) { const int s = e >> 7, i = e & 127;
            const float inv = powf(10000.0f, -(float)i / 128.0f); const float ang = (float)s * inv; float sn, cs; sincosf(ang, &sn, &cs);
            rot[e] = (f32x2){cs, sn}; rotT[(size_t)i * RTP + s] = (f32x2){cs, sn}; }
        for (int e = (vcu * 512 + tid); e < 512 * 256; e += G * 512) { const int r = e >> 8, c = e & 255, mm = ((r & 255) * c) & 255;
            const float v = r < 256 ? cospif((float)mm * (1.0f / 128.0f)) : -sinpif((float)mm * (1.0f / 128.0f)); WC[e] = (bf16)(cvt_pk_bf16(v, 0.f) & 0xffffu); }
        for (int m = gw; m < T; m += NGW) { f32x4 v[4]; rms_row(x + (size_t)m * D, mix_norm, HN + (size_t)m * D, lane, v); }
    }
    GRID_BAR();

    if (PH(1) && PH(19)) {
        PHASE_VARS
        SchedPlain S{(const GAS char*)HN, (const GAS char*)WIN, (size_t)256 * D * 2, (size_t)256 * D * 2, T / 256, 8, G, bx};
        EpiRopeQK E{Qb, Kb, rot};
        pg8::gemm_phase<EpiRopeQK, SchedPlain, false>(lds, wave_k, D, D, D, S, E);
    }
    if (PH(1) && PH(20)) {
        PHASE_VARS
        SchedPlain S{(const GAS char*)(WIN + (size_t)QKW * D), (const GAS char*)HN, (size_t)256 * D * 2, (size_t)256 * D * 2, 4, T / 256, G, bx};
        EpiRopeKT E{KT, rotT, l2g};
        pg8::gemm_phase<EpiRopeKT, SchedPlain, false>(lds, wave_k, D, D, D, S, E);
    }
    if (PH(1) && PH(21)) {
        PHASE_VARS
        SchedPlain S{(const GAS char*)(WIN + (size_t)2 * QKW * D), (const GAS char*)HN, (size_t)256 * D * 2, (size_t)256 * D * 2, 8, T / 256, G, bx};
        EpiBf16<true> E{VT, T};
        pg8::gemm_phase<EpiBf16<true>, SchedPlain, false>(lds, wave_k, D, D, D, S, E);
    }
    GRID_BAR();

    if (PH(2)) {
        PHASE_VARS
        SchedPc S{(const GAS char*)Qb, (const GAS char*)Kb, G, bx};
        EpiPc E{PC, (GAS bf16*)(ws + WS_ROT), l2g};
        pg8::gemm_phase<EpiPc, SchedPc, false>(lds, wave_k, QKW, QKW, DK, S, E);
    }
    GRID_BAR();

    if (PH(3)) {
        PHASE_VARS
        for (int u = vcu; u < NB * NH * 8; u += G) { const int hh_ = (u >> 3) & 3; const float l2f = l2g[hh_], l2b = l2g[4 + hh_];
            sweep_unit(lds, Qb, KT, KT + (size_t)QKW * T, VT, PC, (const GAS bf16*)(ws + WS_ROT), (const GAS bf16*)(ws + WS_CTL + 512 * 1024), Yb, statp, l2f, l2b, u >> 5, hh_, u & 7, wave_k); }
    }
    GRID_BAR();

    if (PH(5)) {
        PHASE_VARS
        SchedPlain S{(const GAS char*)HN, (const GAS char*)(WIN + (size_t)(2 * QKW + VW) * D), (size_t)256 * D * 2, (size_t)256 * D * 2, T / 256, 8, G, bx};
        EpiGate E{Yb, YG, statp, gn_gain, (LAS f32x2*)(lds + 135168)};
        pg8::gemm_phase<EpiGate, SchedPlain, false>(lds, wave_k, D, D, D, S, E);
    }
    GRID_BAR();

    if (PH(6)) {
        PHASE_VARS
        SchedPlain S{(const GAS char*)YG, (const GAS char*)WO, (size_t)256 * VW * 2, (size_t)256 * VW * 2, T / 256, 4, G, bx};
        EpiRes<true> E{(const GAS void*)x, HB};
        pg8::gemm_phase<EpiRes<true>, SchedPlain, false>(lds, wave_k, VW, VW, VW, S, E);
    }
    GRID_BAR();

    if (PH(7)) {
        PHASE_VARS
        for (int m = gw; m < T; m += NGW) { f32x4 v[4]; rms_row_b(HB + (size_t)m * D, ffn_norm, HNB + (size_t)m * D, lane, v); }
        LAS float* scr = (LAS float*)(lds + wave * 16384);
        constexpr int I_GU = 2 * (D / 64) * (FFE / 32), I_D = (FFE / 64) * (D / 32);
        for (int it = gw; it < NE * (I_GU + I_D); it += NGW) {
            const int e = it / (I_GU + I_D); int r = it - e * (I_GU + I_D);
            if (r < I_GU) tr_gu8(m_wg + (size_t)e * D * FFE, m_wu + (size_t)e * D * FFE, D, FFE, WMGU8 + (size_t)e * 2 * FFE * D, r, scr, lane);
            else { const int it2 = r - I_GU, nblk = D / 32, kb = it2 / nblk, nb = it2 - kb * nblk; transpose_item8(m_wd + (size_t)e * FFE * D, FFE, D, (GAS unsigned char*)WMD + (size_t)e * D * FFE, 64 * kb, 32 * nb, 32 * nb, 64.0f, scr, lane); }
        }
    }
    GRID_BAR();

    if (PH(8)) {
        PHASE_VARS
        SchedPlain S{(const GAS char*)HNB, (const GAS char*)WGU, (size_t)256 * D * 2, (size_t)256 * D * 2, T / 256, 2 * FFD / 256, G, bx};
        EpiSwiGLU<false> E{(GAS void*)ACTD, FFD};
        pg8::gemm_phase<EpiSwiGLU<false>, SchedPlain, false>(lds, wave_k, D, D, D, S, E);
    }
    GRID_BAR();
    if (PH(9)) {
        PHASE_VARS
        SchedPlain S{(const GAS char*)ACTD, (const GAS char*)WD, (size_t)256 * FFD * 2, (size_t)256 * FFD * 2, T / 256, 4, G, bx};
        EpiRes<false> E{(const GAS void*)HB, HB};
        pg8::gemm_phase<EpiRes<false>, SchedPlain, false>(lds, wave_k, FFD, FFD, FFD, S, E);
    }
    GRID_BAR();

    if (PH(10)) {
        PHASE_VARS
        for (int m = gw; m < T; m += NGW) { f32x4 v[4]; rms_row_b(HB + (size_t)m * D, mix_norm + D, HNB + (size_t)m * D, lane, v); }
        for (int e = vcu * 512 + tid; e < 512 * 1024; e += G * 512) { const int ka = e >> 10, c = e & 1023, a = c & 511, mm = (a * ka) & 511;
            const float v = (c < 512 ? cospif((float)mm * (1.0f / 256.0f)) : sinpif((float)mm * (1.0f / 256.0f))) * (1.0f / 1024.0f); WSEQ[e] = (bf16)(cvt_pk_bf16(v, 0.f) & 0xffffu); }
    }
    GRID_BAR();

    if (PH(11)) {
        PHASE_VARS
        SchedFnA S{(const GAS char*)WC, (const GAS char*)HNB, G, bx};
        EpiZ2 E{Z2};
        pg8::gemm_phase<EpiZ2, SchedFnA, false>(lds, wave_k, 256, D, 256, S, E);
    }
    GRID_BAR();
    if (PH(22)) {
        PHASE_VARS
        float wc0[8], ws0[8];
#pragma unroll
        for (int kb = 0; kb < 8; ++kb) { const float ang = (float)((8 * lane * kb) & 4095) * (1.0f / 2048.0f); wc0[kb] = cospif(ang); ws0[kb] = sinpif(ang); }
        for (int rw = gw; rw < NB * 1024; rw += NGW) {
            GAS bf16* row = Z2 + (size_t)rw * 8192;
#pragma unroll
            for (int hq = 0; hq < 2; ++hq) {
                u32x2 zin[2][8], zout[8][2];
#pragma unroll
                for (int ri = 0; ri < 2; ++ri)
#pragma unroll
                    for (int bb = 0; bb < 8; ++bb) zin[ri][bb] = *(const GAS u32x2*)(row + ri * 4096 + 512 * bb + 8 * lane + 4 * hq);
#pragma unroll
                for (int q = 0; q < 2; ++q) {
                    float outr[2][8], outi[2][8];
#pragma unroll
                    for (int tt = 0; tt < 2; ++tt) {
                        const int t = 4 * hq + 2 * q + tt;
                        float zr[8], zi[8];
#pragma unroll
                        for (int bb = 0; bb < 8; ++bb) { const unsigned wr_ = zin[0][bb][q], wi_ = zin[1][bb][q]; zr[bb] = tt ? bf_hi(wr_) : bf_lo(wr_); zi[bb] = tt ? bf_hi(wi_) : bf_lo(wi_); }
#pragma unroll
                        for (int kb = 0; kb < 8; ++kb) {
                            float ur = 0.f, ui = 0.f;
#pragma unroll
                            for (int bb = 0; bb < 8; ++bb) {
                                const int m8 = (bb * kb) & 7;
                                const float c8 = (m8 == 0) ? 1.f : (m8 == 4) ? -1.f : (m8 == 2 || m8 == 6) ? 0.f : (m8 == 1 || m8 == 7) ? 0.70710678118654752f : -0.70710678118654752f;
                                const float s8 = (m8 == 0 || m8 == 4) ? 0.f : (m8 == 2) ? 1.f : (m8 == 6) ? -1.f : (m8 == 1 || m8 == 3) ? 0.70710678118654752f : -0.70710678118654752f;
                                ur += c8 * zr[bb] + s8 * zi[bb]; ui += c8 * zi[bb] - s8 * zr[bb]; }
                            const int mt = (t * kb);
                            const float ct = __builtin_cosf((float)mt * 0.00153398078788564123f), st_ = __builtin_sinf((float)mt * 0.00153398078788564123f);
                            const float twc = wc0[kb] * ct - ws0[kb] * st_, tws = ws0[kb] * ct + wc0[kb] * st_;
                            outr[tt][kb] = ur * twc + ui * tws; outi[tt][kb] = ui * twc - ur * tws; }
                    }
#pragma unroll
                    for (int kb = 0; kb < 8; ++kb) { zout[kb][0][q] = cvt_pk_bf16(outr[0][kb], outr[1][kb]); zout[kb][1][q] = cvt_pk_bf16(outi[0][kb], outi[1][kb]); }
                    __builtin_amdgcn_sched_barrier(0);
                }
#pragma unroll
                for (int kb = 0; kb < 8; ++kb)
#pragma unroll
                    for (int ri = 0; ri < 2; ++ri) *(GAS u32x2*)(row + kb * 1024 + ri * 512 + 8 * lane + 4 * hq) = zout[kb][ri];
                __builtin_amdgcn_sched_barrier(0);
            }
        }
    }
    GRID_BAR();
    if (PH(12)) {
        PHASE_VARS
        SchedFnB S{(GAS const char*)WSEQ, (GAS const char*)Z2, G, bx};
        EpiYf E{HNB};
        pg8::gemm_phase<EpiYf, SchedFnB, false>(lds, wave_k, 1024, 1024, 1024, S, E);
    }
    GRID_BAR();
    if (PH(13)) {
        PHASE_VARS
        SchedPlain S{(const GAS char*)HNB, (const GAS char*)WF, (size_t)256 * D * 2, (size_t)256 * D * 2, T / 256, 4, G, bx};
        EpiRes<false> E{(const GAS void*)HB, HB};
        pg8::gemm_phase<EpiRes<false>, SchedPlain, false>(lds, wave_k, D, D, D, S, E);
    }
    GRID_BAR();

    if (PH(14)) {
        PHASE_VARS
        LAS float* wrl = (LAS float*)lds;
        LAS int* le = (LAS int*)(lds + 32768);
        for (int i = tid; i < D * NE; i += NWAVES * 64) wrl[(i & 7) * D + (i >> 3)] = moe_router[i];
        for (int i = vcu * 512 + tid; i < 2 * MOE_ROWS; i += G * 512) rowtok[i] = -1;
        __syncthreads();
        for (int tb = vcu; tb < T / 128; tb += G) {
            for (int rr = 0; rr < 16; ++rr) { const int tl = wave * 16 + rr, m = tb * 128 + tl; f32x4 v[4];
                rms_row_b8(HB + (size_t)m * D, ffn_norm + D, HN8 + (size_t)m * D, lane, v);
                float lg[8];
#pragma unroll
                for (int e = 0; e < 8; ++e) lg[e] = 0.f;
#pragma unroll
                for (int j = 0; j < 4; ++j) { const int col0 = rmsb_col(j, lane);
#pragma unroll
                    for (int e = 0; e < 8; ++e) { const f32x4 wv = *(const LAS f32x4*)(wrl + e * D + col0); lg[e] += (v[j].x * wv.x + v[j].y * wv.y) + (v[j].z * wv.z + v[j].w * wv.w); } }
#pragma unroll
                for (int e = 0; e < 8; ++e) lg[e] = wave_sum(lg[e]);
                int e0 = 0; float b0 = lg[0];
#pragma unroll
                for (int e = 1; e < 8; ++e) if (lg[e] > b0) { b0 = lg[e]; e0 = e; }
                int e1 = -1; float b1 = -3.0e38f;
#pragma unroll
                for (int e = 0; e < 8; ++e) if (e != e0 && lg[e] > b1) { b1 = lg[e]; e1 = e; }
                const float w0 = 1.0f / (1.0f + __expf(b1 - b0));
                if (lane == 0) { toke[2 * m] = e0; toke[2 * m + 1] = e1; tokw[2 * m] = w0; tokw[2 * m + 1] = 1.0f - w0; le[tl] = e0; le[128 + tl] = e1; } }
            __syncthreads();
            if (tid < 16) { const int s = tid >> 3, e = tid & 7; int c = 0; for (int i = 0; i < 128; ++i) c += (le[s * 128 + i] == e) ? 1 : 0; bcnt[tb * 16 + tid] = c; }
            if (tid >= 64 && tid < 128) { const int pi = tid - 64; int c = 0; for (int i = 0; i < 128; ++i) c += (le[i] * 8 + le[128 + i] == pi) ? 1 : 0; pcnt[tb * 64 + pi] = c; }
            __syncthreads();
        }
    }
    GRID_BAR();

    LAS int* segoff = (LAS int*)(lds + 132096);
    LAS int* ntile = (LAS int*)(lds + 132096 + 64);
    LAS unsigned char* tile_e = (LAS unsigned char*)(lds + 132096 + 128);
    if (PH(15)) {
        PHASE_VARS
        LAS int* pfx = (LAS int*)lds;
        LAS int* cph = (LAS int*)(lds + 65792);
        LAS int* fq_ = (LAS int*)(lds + 65792 + 16384);
        LAS int* tot = fq_ + 64;
        LAS int* tpi = tot + 16;
        LAS int* tex = tpi + 128;
        for (int i = tid; i < 256 * 64; i += NWAVES * 64) pfx[i] = pcnt[i];
        __syncthreads();
        if (tid < 64) { int run = 0; for (int b2 = 0; b2 < 256; ++b2) { const int c = pfx[b2 * 64 + tid]; pfx[b2 * 64 + tid] = run; run += c; } pfx[256 * 64 + tid] = run; }
        __syncthreads();
        if (tid == 0) {
            int n0[8], d[8], r[8]; int rs = 0;
            for (int e = 0; e < 8; ++e) { int c = 0; for (int x2 = 0; x2 < 8; ++x2) c += pfx[256 * 64 + e * 8 + x2]; n0[e] = c; r[e] = c & 255; d[e] = -(c & 255); rs += c & 255; }
            int extra = rs >> 8;
            for (int k = 0; k < extra; ++k) { int be = -1, br = -1; for (int e = 0; e < 8; ++e) if (d[e] < 0 && d[e] == -r[e] && r[e] > br) { br = r[e]; be = e; } if (be >= 0) d[be] += 256; }
            for (int i = 0; i < 64; ++i) fq_[i] = 0;
            for (int a = 0; a < 8; ++a) for (int e = 0; e < 8; ++e) if (a != e && d[a] < 0 && d[e] > 0) { int fl = -d[a]; if (d[e] < fl) fl = d[e]; const int av = pfx[256 * 64 + a * 8 + e]; if (av < fl) fl = av; fq_[a * 8 + e] = fl; d[a] += fl; d[e] -= fl; }
        }
        __syncthreads();
        if (tid < 256) {
            int c0[8], c1[8];
#pragma unroll
            for (int e = 0; e < 8; ++e) { c0[e] = 0; c1[e] = 0; }
            for (int a = 0; a < 8; ++a) for (int e = 0; e < 8; ++e) { const int pi = a * 8 + e; const int cnt = pfx[(tid + 1) * 64 + pi] - pfx[tid * 64 + pi]; int fl = fq_[pi] - pfx[tid * 64 + pi]; fl = fl < 0 ? 0 : (fl > cnt ? cnt : fl);
#pragma unroll
                for (int q = 0; q < 8; ++q) { c0[q] += (q == a ? cnt - fl : 0) + (q == e ? fl : 0); c1[q] += (q == e ? cnt - fl : 0) + (q == a ? fl : 0); } }
#pragma unroll
            for (int e = 0; e < 8; ++e) { cph[tid * 16 + e] = c0[e]; cph[tid * 16 + 8 + e] = c1[e]; }
        }
        __syncthreads();
        if (tid < 16) { int run = 0; for (int b2 = 0; b2 < 256; ++b2) { const int c = cph[b2 * 16 + tid]; cph[b2 * 16 + tid] = run; run += c; } tot[tid] = run; }
        __syncthreads();
        if (tid < 2) { int off = 0, nt = 0; for (int e = 0; e < 8; ++e) { segoff[tid * 8 + e] = off; const int tl = (tot[tid * 8 + e] + 255) >> 8; for (int q = 0; q < tl; ++q) tile_e[tid * 160 + nt + q] = (unsigned char)e; nt += tl; off += tl * 256; } ntile[tid] = nt; }
        __syncthreads();
        for (int tb = vcu; tb < T / 128; tb += G) {
            int e0 = 0, e1 = 0, flip = 0;
            if (tid < 128) { const int m = tb * 128 + tid; e0 = toke[2 * m]; e1 = toke[2 * m + 1]; tpi[tid] = e0 * 8 + e1; }
            __syncthreads();
            if (tid < 128) { const int pi = e0 * 8 + e1; int rk = 0; for (int i = 0; i < tid; ++i) rk += (tpi[i] == pi) ? 1 : 0;
                flip = (pfx[tb * 64 + pi] + rk) < fq_[pi] ? 1 : 0; tex[tid] = flip ? e1 : e0; tex[128 + tid] = flip ? e0 : e1; }
            __syncthreads();
            if (tid < 128) { const int m = tb * 128 + tid;
#pragma unroll
                for (int ph = 0; ph < 2; ++ph) { const int e = tex[ph * 128 + tid]; int rk = 0; for (int i = 0; i < tid; ++i) rk += (tex[ph * 128 + i] == e) ? 1 : 0;
                    const int row = segoff[ph * 8 + e] + cph[tb * 16 + ph * 8 + e] + rk;
                    rowtok[ph * MOE_ROWS + row] = m; rowgate[ph * MOE_ROWS + row] = tokw[2 * m + (ph ^ flip)]; } }
            __syncthreads();
        }
    }
    GRID_BAR();

    if (PH(16))
#pragma unroll
    for (int s = 0; s < 2; ++s) {
        {
            PHASE_VARS
            SchedMoe S{(const GAS char*)HN8, (const GAS char*)WMGU8, rowtok + s * MOE_ROWS, tile_e + s * 160, 0, (size_t)2 * FFE * D, (size_t)256 * D, ntile[s], 2 * FFE / 256, G, bx, true, 0x7f7f7f7f};
            EpiSwiGLU<true> E{(GAS void*)ACTM, FFE};
            pg8::gemm_phase<EpiSwiGLU<true>, SchedMoe, true, true>(lds, wave_k, D, D, D, S, E);
        }
        GRID_BAR();
        {
            PHASE_VARS
            SchedMoe S{(const GAS char*)ACTM, (const GAS char*)WMD, rowtok + s * MOE_ROWS, tile_e + s * 160, (size_t)256 * FFE, (size_t)D * FFE, (size_t)256 * FFE, ntile[s], 4, G, bx, false, 0x7c7c7c7c};
            EpiMoeDown E{HB, rowtok + s * MOE_ROWS, rowgate + s * MOE_ROWS};
            pg8::gemm_phase<EpiMoeDown, SchedMoe, false, true>(lds, wave_k, FFE, FFE, FFE, S, E);
        }
        GRID_BAR();
    }

    if (PH(17)) {
        PHASE_VARS
        const bool bad = __hip_atomic_load((GAS unsigned*)(ws + WS_CTL) + CW_BAR + XB_TMO, RLX_AGENT) != 0u;
        for (int m = gw; m < T; m += NGW) {
            const GAS bf16* hrow = HB + (size_t)m * D; GAS float* orow = hres + (size_t)m * D;
            f32x4 v[4]; float s = 0.f;
#pragma unroll
            for (int jh = 0; jh < 2; ++jh) { const u32x4 xx = *(const GAS u32x4*)(hrow + 512 * jh + 8 * lane);
                v[2 * jh] = (f32x4){bf_lo(xx.x), bf_hi(xx.x), bf_lo(xx.y), bf_hi(xx.y)}; v[2 * jh + 1] = (f32x4){bf_lo(xx.z), bf_hi(xx.z), bf_lo(xx.w), bf_hi(xx.w)}; }
#pragma unroll
            for (int j = 0; j < 4; ++j) s += (v[j].x * v[j].x + v[j].y * v[j].y) + (v[j].z * v[j].z + v[j].w * v[j].w);
            const float r = bad ? __builtin_nanf("") : 1.0f / sqrtf(wave_sum(s) * (1.f / D) + EPS);
#pragma unroll
            for (int j = 0; j < 4; ++j) { const int col = rmsb_col(j, lane); *(GAS f32x4*)(orow + col) = v[j] * r * *(const GAS f32x4*)(final_norm + col); }
        }
    }
}

extern "C" void kernel_launch(void* const* d_in, const int* in_sizes, int n_in, void* d_out, int out_size, void* d_ws, size_t ws_size, hipStream_t stream) {
    static int grid = 0;
    if (grid == 0) {
        if (n_in != 16 || in_sizes[0] != T * D || out_size != T * D || ws_size < WS_END) { fprintf(stderr, "kernel_launch: unexpected shapes (n_in %d, in0 %d, out %d, ws %zu)\n", n_in, n_in > 0 ? in_sizes[0] : -1, out_size, ws_size); grid = -1; return; }
        int dev = 0, cus = 0, per_cu = 0;
        if (hipGetDevice(&dev) != hipSuccess || hipDeviceGetAttribute(&cus, hipDeviceAttributeMultiprocessorCount, dev) != hipSuccess) { grid = -1; return; }
        if (hipFuncSetAttribute((const void*)fwd_kernel, hipFuncAttributeMaxDynamicSharedMemorySize, LDS_BYTES) != hipSuccess) { fprintf(stderr, "kernel_launch: hipFuncSetAttribute failed\n"); grid = -1; return; }
        if (hipOccupancyMaxActiveBlocksPerMultiprocessor(&per_cu, (const void*)fwd_kernel, NWAVES * 64, LDS_BYTES) != hipSuccess || per_cu < 1) { fprintf(stderr, "kernel_launch: occupancy query says %d\n", per_cu); }
        (void)hipGetLastError();
        grid = cus;
    }
    if (grid < 0) return;
    if (hipMemsetAsync((char*)d_ws + WS_CTL, 0, CTL_ZERO_BYTES, stream) != hipSuccess) return;
    Args a{};
    for (int i = 0; i < 16; ++i) a.in[i] = (const float*)d_in[i];
    a.out = (float*)d_out; a.ws = (unsigned char*)d_ws;
    hipLaunchKernelGGL(fwd_kernel, dim3(grid), dim3(NWAVES * 64), LDS_BYTES, stream, a);
}
```

```cpp
#include <hip/hip_runtime.h>
#include <cstdio>
#include <cstdint>

#define LAS __attribute__((address_space(3)))
#define GAS __attribute__((address_space(1)))
typedef unsigned short bf16;
typedef short bf16x8 __attribute__((ext_vector_type(8)));
typedef float f32x2 __attribute__((ext_vector_type(2)));
typedef float f32x4 __attribute__((ext_vector_type(4)));
typedef float f32x16 __attribute__((ext_vector_type(16)));
typedef unsigned u32x2 __attribute__((ext_vector_type(2)));
typedef unsigned u32x4 __attribute__((ext_vector_type(4)));
typedef GAS unsigned gu32;

constexpr int D = 1024, NB = 8, SEQ = 4096, T = NB * SEQ;
constexpr int NH = 4, DK = 256, DV = 512, QKW = 1024, VW = 2048, INW = 6144, CH = 128, NCH = SEQ / CH;
constexpr int FFD = 2816, NE = 8, FFE = 3584;
constexpr int MOE_ROWS = T + NE * 256;
constexpr float EPS = 1e-6f;

constexpr size_t MiB = 1u << 20;
constexpr size_t WS_CTL = 0, CTL_ZERO_BYTES = 1 * MiB;
constexpr size_t WS_ROT = 1 * MiB, WS_ROTT = 5 * MiB, WS_WC = 10 * MiB + 768 * 1024;
constexpr int RTP = SEQ + 64;
constexpr size_t WS_TOKE = 9 * MiB + 256 * 1024;
constexpr size_t WS_TOKW = WS_TOKE + 256 * 1024;
constexpr size_t WS_BCNT = WS_TOKW + 256 * 1024;
constexpr size_t WS_ROWTOK = WS_BCNT + 16 * 1024;
constexpr size_t WS_ROWGATE = WS_ROWTOK + 2 * MOE_ROWS * 4;
constexpr size_t WS_PCNT = 10 * MiB + 512 * 1024;
constexpr size_t WS_STATS = 11 * MiB;
constexpr size_t WS_SSQ1 = 1 * MiB, WS_SSQ2 = 3 * MiB;
static_assert(WS_ROWGATE + 2 * MOE_ROWS * 4 <= WS_PCNT, "small tables");
constexpr size_t WS_WIN = 12 * MiB, WS_WO = 24 * MiB, WS_WGU = 28 * MiB, WS_WD = 39 * MiB, WS_WF = 44 * MiB + 512 * 1024;
constexpr size_t WS_HN = 48 * MiB;
constexpr size_t WS_Q = 112 * MiB, WS_K = 176 * MiB, WS_KT = 240 * MiB  , WS_VT = 368 * MiB, WS_PC = 496 * MiB;
constexpr size_t WS_YG = 240 * MiB;
constexpr size_t WS_STATP = 176 * MiB;
constexpr size_t WS_ACTD = 112 * MiB;
constexpr size_t WS_Z2 = 112 * MiB, WS_WSEQ = 46 * MiB + 512 * 1024;
constexpr size_t WS_ACTM = 112 * MiB;
constexpr size_t WS_WMGU = 352 * MiB, WS_WMD = 464 * MiB, WS_END = 528 * MiB;
static_assert(WS_ACTM + (size_t)MOE_ROWS * FFE * 2 <= WS_WMGU, "moe act");
static_assert(WS_PC + (size_t)NB * NH * NCH * CH * CH * 2 <= 528 * MiB, "epoch A");
static_assert(WS_WF + (size_t)D * D * 2 <= WS_WSEQ && WS_WSEQ + 512 * 1024 * 2 <= WS_HN, "weights");
constexpr int CW_BAR = 4096;
constexpr int CW_CHK = 64;

constexpr int RING_BYTES = 131072;
constexpr int LDSCTL_OFF = 139264, MISC_OFF = LDSCTL_OFF + 320;
constexpr int LDS_BYTES = 147456;

#define LDS_WAIT() asm volatile("s_waitcnt lgkmcnt(0)" ::: "memory")
#define VM_WAIT() asm volatile("s_waitcnt vmcnt(0)" ::: "memory")
#define RLX_AGENT __ATOMIC_RELAXED, __HIP_MEMORY_SCOPE_AGENT

__device__ __forceinline__ unsigned cvt_pk_bf16(float lo, float hi) { unsigned r; asm volatile("v_cvt_pk_bf16_f32 %0, %1, %2" : "=v"(r) : "v"(lo), "v"(hi)); return r; }
__device__ __forceinline__ unsigned pk4_fp8(float a, float b, float c, float d) { int w = 0; w = __builtin_amdgcn_cvt_pk_fp8_f32(a, b, w, false); w = __builtin_amdgcn_cvt_pk_fp8_f32(c, d, w, true); return (unsigned)w; }
__device__ __forceinline__ float bf_lo(unsigned w) { return __uint_as_float(w << 16); }
__device__ __forceinline__ float bf_hi(unsigned w) { return __uint_as_float(w & 0xffff0000u); }
__device__ __forceinline__ float fast_exp2(float x) { return __builtin_amdgcn_exp2f(x); }
__device__ __forceinline__ int lane_id_v() { int l; asm volatile("v_mbcnt_lo_u32_b32 %0, -1, 0\n\tv_mbcnt_hi_u32_b32 %0, -1, %0" : "=v"(l)); return l; }
__device__ __forceinline__ int tid_of(int wave_s) { asm volatile("" : "+s"(wave_s)); return wave_s * 64 + lane_id_v(); }
__device__ __forceinline__ int rot_col(int row, int tok) { return (tok + ((row & 15) << 11)) & (32768 - 1); }
__device__ __forceinline__ float silu_f(float v) { return v * __builtin_amdgcn_rcpf(1.0f + __builtin_amdgcn_exp2f(v * -1.44269504088896341f)); }

namespace pg8 {
constexpr int BM = 256, BK = 64, HALF = 128, HTB = HALF * BK * 2, STAGE_BYTES = 8 * HTB, NXCD = 8, WGM = 2;
__host__ __device__ __forceinline__ int lds_byte(int r, int c) { const int st = (r >> 4) * 2 + (c >> 5), rr = r & 15, cc = c & 31, ob = rr * 64 + cc * 2; return st * 1024 + (ob ^ (((ob >> 9) & 1) << 5)); }
__host__ __device__ __forceinline__ void stage_rc(int b, int& R, int& C) { const int st = b / 1024, sb = b % 1024, swz = sb ^ (((sb >> 9) & 1) << 5); R = (st >> 1) * 16 + swz / 64; C = (st & 1) * 32 + (swz % 64) / 2; }
__host__ __device__ __forceinline__ int perm32(int rho) { const int n = rho >> 4, i = rho & 15; return 8 * (i >> 2) + 4 * n + (i & 3); }

struct Unit { const GAS char* A; const GAS char* B; const GAS int* rows; int pm, pn, z; };

__device__ __forceinline__ bool tile_of(long L, int nM, int nN, int& pm, int& pn) {
    const int nwg = nM * nN; if (L >= nwg) return false;
    int wgid = (int)L; { const int q = nwg / NXCD, r = nwg % NXCD, xcd = wgid % NXCD, off = wgid / NXCD; wgid = (xcd < r ? xcd * (q + 1) : r * (q + 1) + (xcd - r) * q) + off; }
    const int nig = WGM * nN, gid = wgid / nig, fm = gid * WGM, gsz = (nM - fm) < WGM ? (nM - fm) : WGM;
    pm = fm + ((wgid % nig) % gsz); pn = (wgid % nig) / gsz; return true;
}

template <class Epi, class Sched, bool GATHER, bool FP8 = false>
__device__ __forceinline__ void gemm_phase(LAS unsigned char* lds, const int wave_s, const int lda, const int ldb, const int K, const Sched& S, const Epi& E) {
    const int tid = tid_of(wave_s);
    const int wid = __builtin_amdgcn_readfirstlane(tid >> 6), lane = tid & 63, wr = wid >> 2, wc = wid & 3, fr = lane & 15, fq = lane >> 4;
    constexpr int ES = FP8 ? 1 : 2;
    const int nt = K * ES / (BK * 2);
    unsigned vA[2][2], vAn[2][2], voffB[2];
#pragma unroll
    for (int i = 0; i < 2; ++i) { int R, C; stage_rc(tid * 16 + i * 8192, R, C); const int Rb = Epi::PERM ? ((R & ~31) + perm32(R & 31)) : R;
        voffB[i] = (unsigned)(S.brow(Rb) * ldb * ES + C * 2);
#pragma unroll
        for (int h = 0; h < 2; ++h) { vA[h][i] = (unsigned)((h * HALF + R) * lda * ES + C * 2); vAn[h][i] = vA[h][i]; } }
    const size_t kstep = (size_t)(BK * 2);
    const size_t hstepB = (size_t)(S.brow(HALF) - S.brow(0)) * ldb * ES;
    const unsigned ldsw = (unsigned)wid * 1024u;
    const int aoff = lds_byte(wr * 64 + fr, FP8 ? fq * 16 : fq * 8), boff = lds_byte(wc * 32 + fr, FP8 ? fq * 16 : fq * 8);
    typedef int v4i_ __attribute__((ext_vector_type(4))); typedef int v8i_ __attribute__((ext_vector_type(8)));
    const int sc_w8 = S.scale_b8(), sc_a8 = S.scale_a8(); (void)sc_w8; (void)sc_a8;
#define PG8_SA(b, h) (((b) * 2 + (h)) * HTB)
#define PG8_SB(b, h) ((4 + (b) * 2 + (h)) * HTB)
#define PG8_STAGE_B(bufoff, gbase) do { _Pragma("unroll") for (int _i = 0; _i < 2; ++_i) \
        __builtin_amdgcn_global_load_lds((const GAS unsigned*)((const GAS char*)(gbase) + voffB[_i]), (LAS unsigned*)(lds + (bufoff) + ldsw + _i * 8192), 16, 0, 0); } while (0)
#define PG8_STAGE_A(bufoff, gbase, v0, v1) do { \
        __builtin_amdgcn_global_load_lds((const GAS unsigned*)((const GAS char*)(gbase) + (v0)), (LAS unsigned*)(lds + (bufoff) + ldsw), 16, 0, 0); \
        __builtin_amdgcn_global_load_lds((const GAS unsigned*)((const GAS char*)(gbase) + (v1)), (LAS unsigned*)(lds + (bufoff) + ldsw + 8192), 16, 0, 0); } while (0)
#define PG8_LD32(addr) __builtin_shufflevector(*(const LAS v4i_*)(addr), *(const LAS v4i_*)((addr) + 16), 0, 1, 2, 3, 4, 5, 6, 7)
#define PG8_LDA(dst, b, h) do { _Pragma("unroll") for (int m = 0; m < 4; ++m) { if constexpr (FP8) dst##8[m] = PG8_LD32(lds + PG8_SA(b, h) + aoff + m * 2048); else { _Pragma("unroll") for (int k = 0; k < 2; ++k) dst[m][k] = *(const LAS bf16x8*)(lds + PG8_SA(b, h) + aoff + m * 2048 + k * 1024); } } } while (0)
#define PG8_LDB(dst, b, h) do { _Pragma("unroll") for (int n = 0; n < 2; ++n) { if constexpr (FP8) dst##8[n] = PG8_LD32(lds + PG8_SB(b, h) + boff + n * 2048); else { _Pragma("unroll") for (int k = 0; k < 2; ++k) dst[n][k] = *(const LAS bf16x8*)(lds + PG8_SB(b, h) + boff + n * 2048 + k * 1024); } } } while (0)
#define PG8_MMA(ai, bj, At, Bt) do { __builtin_amdgcn_s_setprio(1); _Pragma("unroll") for (int m = 0; m < 4; ++m) _Pragma("unroll") for (int n = 0; n < 2; ++n) { \
        if constexpr (FP8) asm volatile("v_mfma_scale_f32_16x16x128_f8f6f4 %0, %1, %2, %0, %3, %4 op_sel_hi:[0,0,0]" : "+v"(acc[ai][bj][m][n]) : "v"(Bt##8[n]), "v"(At##8[m]), "v"(sc_w8), "v"(sc_a8)); \
        else { _Pragma("unroll") for (int k = 0; k < 2; ++k) acc[ai][bj][m][n] = __builtin_amdgcn_mfma_f32_16x16x32_bf16(Bt[n][k], At[m][k], acc[ai][bj][m][n], 0, 0, 0); } } \
        __builtin_amdgcn_s_setprio(0); } while (0)
#define PG8_WAIT_V(n) asm volatile("s_waitcnt vmcnt(" #n ")" ::: "memory")
#define PG8_WAIT_L(n) asm volatile("s_waitcnt lgkmcnt(" #n ")" ::: "memory")
#define PG8_BAR __builtin_amdgcn_s_barrier()
#define PG8_SCHED __builtin_amdgcn_sched_barrier(0)
#define PG8_LOADROWS(dst, u) do { if constexpr (GATHER) { const int _tz = tid_of(wave_s); _Pragma("unroll") for (int _i = 0; _i < 2; ++_i) { int _R, _C; stage_rc(_tz * 16 + _i * 8192, _R, _C); \
        _Pragma("unroll") for (int _h = 0; _h < 2; ++_h) { const int _t = (u).rows[_h * HALF + _R]; dst[_h][_i] = (unsigned)((_t < 0 ? 0 : _t) * lda * ES + _C * 2); } } } } while (0)
#define PG8_VAN(h, i) (GATHER ? vAn[h][i] : vA[h][i])
    Unit cur, nxt; int ui = 0;
    if (!S.next(0, cur)) return;
    f32x4 acc[2][2][4][2];
#pragma unroll
    for (int a = 0; a < 2; ++a)
#pragma unroll
        for (int b = 0; b < 2; ++b)
#pragma unroll
            for (int m = 0; m < 4; ++m)
#pragma unroll
                for (int n = 0; n < 2; ++n) acc[a][b][m][n] = (f32x4){0.f, 0.f, 0.f, 0.f};
    bf16x8 At[4][2], B0[2][2], B1[2][2]; v8i_ At8[4], B08[2], B18[2]; (void)At; (void)B0; (void)B1; (void)At8; (void)B08; (void)B18;
    const GAS char* cA = cur.A; const GAS char* cB = cur.B;
    PG8_LOADROWS(vA, cur);
    if constexpr (GATHER) { vAn[0][0] = vA[0][0]; vAn[0][1] = vA[0][1]; vAn[1][0] = vA[1][0]; vAn[1][1] = vA[1][1]; }
    PG8_STAGE_B(PG8_SB(0, 0), cB); PG8_STAGE_B(PG8_SB(0, 1), cB + hstepB); PG8_STAGE_A(PG8_SA(0, 0), cA, vA[0][0], vA[0][1]); PG8_STAGE_A(PG8_SA(0, 1), cA, vA[1][0], vA[1][1]);
    if (wr == 1) PG8_BAR;
    PG8_WAIT_V(2); PG8_BAR;
    PG8_STAGE_B(PG8_SB(1, 0), cB + kstep); PG8_STAGE_A(PG8_SA(1, 0), cA + kstep, vA[0][0], vA[0][1]); PG8_STAGE_B(PG8_SB(1, 1), cB + hstepB + kstep);
    PG8_WAIT_V(6); PG8_BAR;
    for (;;) {
        const bool has_next = S.next(ui + 1, nxt);
        const GAS char* nA = has_next ? nxt.A : cA; const GAS char* nB = has_next ? nxt.B : cB;
#pragma unroll 1
        for (int t = 0; t < nt; t += 2) {
            const bool last = (t == nt - 2);
            const GAS char* a1 = cA + (size_t)(t + 1) * kstep;
            const GAS char* a2 = last ? nA : cA + (size_t)(t + 2) * kstep; const GAS char* b2 = last ? nB : cB + (size_t)(t + 2) * kstep;
            const GAS char* a3 = a2 + kstep; const GAS char* b3 = b2 + kstep;
            if constexpr (GATHER) { if (last && has_next) { PG8_LOADROWS(vAn, nxt); } }
            PG8_LDB(B0, 0, 0); PG8_LDB(B1, 0, 1); PG8_SCHED; PG8_LDA(At, 0, 0); PG8_STAGE_A(PG8_SA(1, 1), a1, vA[1][0], vA[1][1]);
            PG8_WAIT_V(8); PG8_WAIT_L(0); PG8_BAR; PG8_MMA(0, 0, At, B0); PG8_MMA(0, 1, At, B1); PG8_BAR; PG8_SCHED;
            PG8_LDA(At, 0, 1); PG8_STAGE_B(PG8_SB(0, 0), b2); PG8_STAGE_B(PG8_SB(0, 1), b2 + hstepB); PG8_STAGE_A(PG8_SA(0, 0), a2, PG8_VAN(0, 0), PG8_VAN(0, 1));
            PG8_WAIT_V(8); PG8_WAIT_L(0); PG8_BAR; PG8_MMA(1, 0, At, B0); PG8_MMA(1, 1, At, B1); PG8_BAR; PG8_SCHED;
            PG8_LDB(B0, 1, 0); PG8_LDB(B1, 1, 1); PG8_SCHED; PG8_LDA(At, 1, 0); PG8_STAGE_A(PG8_SA(0, 1), a2, PG8_VAN(1, 0), PG8_VAN(1, 1));
            PG8_WAIT_V(8); PG8_WAIT_L(0); PG8_BAR; PG8_MMA(0, 0, At, B0); PG8_MMA(0, 1, At, B1); PG8_BAR; PG8_SCHED;
            PG8_LDA(At, 1, 1); PG8_STAGE_B(PG8_SB(1, 0), b3); PG8_STAGE_B(PG8_SB(1, 1), b3 + hstepB); PG8_STAGE_A(PG8_SA(1, 0), a3, PG8_VAN(0, 0), PG8_VAN(0, 1));
            PG8_WAIT_V(8); PG8_WAIT_L(0); PG8_BAR; PG8_MMA(1, 0, At, B0); PG8_MMA(1, 1, At, B1); PG8_BAR; PG8_SCHED;
        }
        if (wr == 0) PG8_BAR;
        if constexpr (FP8) asm volatile("s_nop 15\n\ts_nop 15" ::: "memory");
        E(acc, cur, wr, wc, fr, fq);
        if (!has_next) break;
#pragma unroll
        for (int a = 0; a < 2; ++a)
#pragma unroll
            for (int b = 0; b < 2; ++b)
#pragma unroll
                for (int m = 0; m < 4; ++m)
#pragma unroll
                    for (int n = 0; n < 2; ++n) acc[a][b][m][n] = (f32x4){0.f, 0.f, 0.f, 0.f};
        cur = nxt; cA = nA; cB = nB; ++ui;
        if constexpr (GATHER) { vA[0][0] = vAn[0][0]; vA[0][1] = vAn[0][1]; vA[1][0] = vAn[1][0]; vA[1][1] = vAn[1][1]; }
        if (wr == 1) PG8_BAR;
    }
    PG8_WAIT_V(0);
    PG8_BAR;
#undef PG8_SA
#undef PG8_SB
#undef PG8_STAGE_A
#undef PG8_STAGE_B
#undef PG8_LDA
#undef PG8_LD32
#undef PG8_LDB
#undef PG8_MMA
#undef PG8_WAIT_V
#undef PG8_WAIT_L
#undef PG8_BAR
#undef PG8_SCHED
#undef PG8_LOADROWS
#undef PG8_VAN
}
}

struct SchedPlain {
    __device__ __forceinline__ int scale_b8() const { return 0x7f7f7f7f; }
    __device__ __forceinline__ int scale_a8() const { return 0x7f7f7f7f; }
    __device__ __forceinline__ int brow(int r) const { return r; }
    const GAS char* A; const GAS char* B; size_t a_tile, b_tile; int nM, nN, G, c;
    __device__ __forceinline__ bool next(int i, pg8::Unit& u) const {
        int pm, pn; if (!pg8::tile_of((long)i * G + c, nM, nN, pm, pn)) return false;
        u.pm = pm; u.pn = pn; u.z = 0; u.rows = nullptr; u.A = A + (size_t)pm * a_tile; u.B = B + (size_t)pn * b_tile; return true; }
};
struct SchedPc {
    __device__ __forceinline__ int scale_b8() const { return 0x7f7f7f7f; }
    __device__ __forceinline__ int scale_a8() const { return 0x7f7f7f7f; }
    __device__ __forceinline__ int brow(int r) const { return r; }
    const GAS char* Q; const GAS char* Kk; int G, c;
    __device__ __forceinline__ bool next(int i, pg8::Unit& u) const {
        const int L = i * G + c; if (L >= NB * NH * 16) return false;
        const int cp = L & 15, h = (L >> 4) & 3, b = L >> 6;
        const size_t off = ((size_t)(b * SEQ + cp * 256) * QKW + h * DK) * 2;
        u.pm = L; u.pn = 0; u.z = h; u.rows = nullptr; u.A = Q + off; u.B = Kk + off; return true; }
};
struct SchedFnA {
    __device__ __forceinline__ int scale_b8() const { return 0x7f7f7f7f; }
    __device__ __forceinline__ int scale_a8() const { return 0x7f7f7f7f; }
    __device__ __forceinline__ int brow(int r) const { return r; }
    const GAS char* Wc; const GAS char* Hn; int G, c;
    __device__ __forceinline__ bool next(int i, pg8::Unit& u) const {
        int pm, pn; if (!pg8::tile_of((long)i * G + c, 8, T / 256, pm, pn)) return false;
        const int g = pm >> 1, ri = pm & 1;
        u.pm = pm; u.pn = pn; u.z = 0; u.rows = nullptr; u.A = Wc + (size_t)(g * 512 + ri * 256) * 256 * 2; u.B = Hn + ((size_t)pn * 256 * D + g * 256) * 2; return true; }
};
struct SchedFnB {
    __device__ __forceinline__ int scale_b8() const { return 0x7f7f7f7f; }
    __device__ __forceinline__ int scale_a8() const { return 0x7f7f7f7f; }
    __device__ __forceinline__ int brow(int r) const { return (r & 63) * 8 + (r >> 6); }
    GAS const char* WY; GAS const char* U; int G, c;
    __device__ __forceinline__ bool next(int i, pg8::Unit& u) const {
        int pm, pn; if (!pg8::tile_of((long)i * G + c, 2, 256, pm, pn)) return false;
        const int batch = pn >> 5, fb = (pn >> 1) & 15, kbb = pn & 1;
        u.pm = pm; u.pn = pn; u.z = 0; u.rows = nullptr; u.A = WY + (size_t)pm * 256 * 1024 * 2; u.B = U + ((size_t)(batch * 1024 + fb * 64) * 8 + kbb * 4) * 1024 * 2; return true; }
};
struct SchedMoe {
    __device__ __forceinline__ int scale_b8() const { return 0x79797979; }
    __device__ __forceinline__ int scale_a8() const { return sa8; }
    __device__ __forceinline__ int brow(int r) const { return r; }
    const GAS char* A; const GAS char* W; const GAS int* rowtok; const LAS unsigned char* texp; size_t a_tile, w_exp, w_tile; int ntiles, ncol, G, c; bool gather; int sa8;
    __device__ __forceinline__ bool next(int i, pg8::Unit& u) const {
        int rt, ct; if (!pg8::tile_of((long)i * G + c, ntiles, ncol, rt, ct)) return false;
        const int e = texp[rt];
        u.pm = rt; u.pn = ct; u.z = e; u.rows = rowtok + rt * 256; u.A = gather ? A : A + (size_t)rt * a_tile; u.B = W + (size_t)e * w_exp + (size_t)ct * w_tile; return true; }
};

struct EpiRopeQK {
    static constexpr bool PERM = true;
    GAS bf16* Q; GAS bf16* Kk; const GAS f32x2* rot;
    __device__ __forceinline__ void operator()(const f32x4 (&acc)[2][2][4][2], const pg8::Unit& u, int wr, int wc, int fr, int fq) const {
        const bool isk = u.pn >= 4; const int h = u.pn & 3; GAS bf16* dst = isk ? Kk : Q; const float sc = isk ? 0.0625f : 1.0f;
        const int i0 = wc * 32 + 8 * fq;
#pragma unroll
        for (int ai = 0; ai < 2; ++ai)
#pragma unroll
            for (int m = 0; m < 4; ++m) {
                const int t = u.pm * 256 + ai * 128 + wr * 64 + m * 16 + fr, s = t & (SEQ - 1);
                const GAS f32x4* rp = (const GAS f32x4*)(rot + (size_t)s * 128 + i0);
                const f32x4 r0 = rp[0], r1 = rp[1], r2 = rp[2], r3 = rp[3];
                const float cs[8] = {r0[0], r0[2], r1[0], r1[2], r2[0], r2[2], r3[0], r3[2]}, sn[8] = {r0[1], r0[3], r1[1], r1[3], r2[1], r2[3], r3[1], r3[3]};
                float o1[8], o2[8];
#pragma unroll
                for (int n = 0; n < 2; ++n)
#pragma unroll
                    for (int j = 0; j < 4; ++j) { const float t1 = acc[ai][0][m][n][j], t2 = acc[ai][1][m][n][j]; const int q = 4 * n + j;
                        o1[q] = (t1 * cs[q] - t2 * sn[q]) * sc; o2[q] = (t1 * sn[q] + t2 * cs[q]) * sc; }
                GAS bf16* rowp = dst + (size_t)t * QKW + h * DK + i0;
                u32x4 w1, w2; w1.x = cvt_pk_bf16(o1[0], o1[1]); w1.y = cvt_pk_bf16(o1[2], o1[3]); w1.z = cvt_pk_bf16(o1[4], o1[5]); w1.w = cvt_pk_bf16(o1[6], o1[7]);
                w2.x = cvt_pk_bf16(o2[0], o2[1]); w2.y = cvt_pk_bf16(o2[2], o2[3]); w2.z = cvt_pk_bf16(o2[4], o2[5]); w2.w = cvt_pk_bf16(o2[6], o2[7]);
                *(GAS u32x4*)rowp = w1; *(GAS u32x4*)(rowp + 128) = w2; }
    }
};
struct EpiRopeKT {
    static constexpr bool PERM = true;
    GAS bf16* KT; const GAS f32x2* rotT; const LAS float* l2g;
    __device__ __forceinline__ void operator()(const f32x4 (&acc)[2][2][4][2], const pg8::Unit& u, int wr, int wc, int fr, int fq) const {
        const int h = u.pm; const float l2f = l2g[h], l2b = l2g[4 + h];
#pragma unroll
        for (int bj = 0; bj < 2; ++bj) {
            const int tok0 = u.pn * 256 + bj * 128 + wc * 32 + 8 * fq, s0 = tok0 & (SEQ - 1), j0 = tok0 & (CH - 1);
            float zf[8], zb[8];
#pragma unroll
            for (int q = 0; q < 8; ++q) { zf[q] = fast_exp2((float)(CH - 1 - (j0 + q)) * l2f) * 0.0625f; zb[q] = fast_exp2((float)(j0 + q) * l2b) * 0.0625f; }
#pragma unroll
            for (int m = 0; m < 4; ++m) { const int i = wr * 64 + m * 16 + fr;
                const GAS f32x4* rp = (const GAS f32x4*)(rotT + (size_t)i * RTP + s0);
                const f32x4 r0 = rp[0], r1 = rp[1], r2 = rp[2], r3 = rp[3];
                const float cs[8] = {r0[0], r0[2], r1[0], r1[2], r2[0], r2[2], r3[0], r3[2]}, sn[8] = {r0[1], r0[3], r1[1], r1[3], r2[1], r2[3], r3[1], r3[3]};
                float o1[8], o2[8];
#pragma unroll
                for (int n = 0; n < 2; ++n)
#pragma unroll
                    for (int j = 0; j < 4; ++j) { const float t1 = acc[0][bj][m][n][j], t2 = acc[1][bj][m][n][j]; const int q = 4 * n + j;
                        o1[q] = t1 * cs[q] - t2 * sn[q]; o2[q] = t1 * sn[q] + t2 * cs[q]; }
                u32x4 w1, w2;
                w1.x = cvt_pk_bf16(o1[0] * zf[0], o1[1] * zf[1]); w1.y = cvt_pk_bf16(o1[2] * zf[2], o1[3] * zf[3]); w1.z = cvt_pk_bf16(o1[4] * zf[4], o1[5] * zf[5]); w1.w = cvt_pk_bf16(o1[6] * zf[6], o1[7] * zf[7]);
                w2.x = cvt_pk_bf16(o2[0] * zf[0], o2[1] * zf[1]); w2.y = cvt_pk_bf16(o2[2] * zf[2], o2[3] * zf[3]); w2.z = cvt_pk_bf16(o2[4] * zf[4], o2[5] * zf[5]); w2.w = cvt_pk_bf16(o2[6] * zf[6], o2[7] * zf[7]);
                const size_t fr0 = ((((size_t)((tok0 >> 12) * NH + h) * NCH + ((tok0 & (SEQ - 1)) >> 7)) * 8 + (i >> 5)) * 8 + (2 * wc + (fq >> 1))) * 512 + ((i & 31) + 32 * (fq & 1)) * 8;
                *(GAS u32x4*)(KT + fr0) = w1; *(GAS u32x4*)(KT + fr0 + (size_t)4 * 8 * 512) = w2;
                w1.x = cvt_pk_bf16(o1[0] * zb[0], o1[1] * zb[1]); w1.y = cvt_pk_bf16(o1[2] * zb[2], o1[3] * zb[3]); w1.z = cvt_pk_bf16(o1[4] * zb[4], o1[5] * zb[5]); w1.w = cvt_pk_bf16(o1[6] * zb[6], o1[7] * zb[7]);
                w2.x = cvt_pk_bf16(o2[0] * zb[0], o2[1] * zb[1]); w2.y = cvt_pk_bf16(o2[2] * zb[2], o2[3] * zb[3]); w2.z = cvt_pk_bf16(o2[4] * zb[4], o2[5] * zb[5]); w2.w = cvt_pk_bf16(o2[6] * zb[6], o2[7] * zb[7]);
                *(GAS u32x4*)(KT + (size_t)QKW * T + fr0) = w1; *(GAS u32x4*)(KT + (size_t)QKW * T + fr0 + (size_t)4 * 8 * 512) = w2; } }
    }
};
template <bool ROT> struct EpiBf16 {
    static constexpr bool PERM = true;
    GAS bf16* O; int ldc;
    __device__ __forceinline__ void operator()(const f32x4 (&acc)[2][2][4][2], const pg8::Unit& u, int wr, int wc, int fr, int fq) const {
#pragma unroll
        for (int ai = 0; ai < 2; ++ai)
#pragma unroll
            for (int m = 0; m < 4; ++m) { const int row = u.pm * 256 + ai * 128 + wr * 64 + m * 16 + fr; GAS bf16* rowp = O + (size_t)row * ldc;
#pragma unroll
                for (int bj = 0; bj < 2; ++bj) { const f32x4 v0 = acc[ai][bj][m][0], v1 = acc[ai][bj][m][1]; const int col = u.pn * 256 + bj * 128 + wc * 32 + 8 * fq;
                    u32x4 w; w.x = cvt_pk_bf16(v0[0], v0[1]); w.y = cvt_pk_bf16(v0[2], v0[3]); w.z = cvt_pk_bf16(v1[0], v1[1]); w.w = cvt_pk_bf16(v1[2], v1[3]);
                    *(GAS u32x4*)(rowp + (ROT ? rot_col(row, col) : col)) = w; } }
    }
};
struct EpiPc {
    static constexpr bool PERM = true;
    GAS bf16* PC; GAS bf16* PD; const LAS float* l2g;
    __device__ __forceinline__ void operator()(const f32x4 (&acc)[2][2][4][2], const pg8::Unit& u, int wr, int wc, int fr, int fq) const {
        const int h = u.z; const float l2f = l2g[h], l2b = l2g[4 + h];
#pragma unroll
        for (int ai = 0; ai < 2; ++ai)
#pragma unroll
            for (int m = 0; m < 4; ++m) { const int il = wr * 64 + m * 16 + fr, jl0 = wc * 32 + 8 * fq; float o[8];
                const bool diag = (wc == 2 * wr + (m >> 1));
#pragma unroll
                for (int n = 0; n < 2; ++n)
#pragma unroll
                    for (int j = 0; j < 4; ++j) { const int dl = il - (jl0 + 4 * n + j); const float f = dl >= 0 ? fast_exp2((float)dl * l2f) : fast_exp2((float)(-dl) * l2b);
                        o[4 * n + j] = (ai == 0 ? acc[0][0][m][n][j] : acc[1][1][m][n][j]) * f; }
                if (diag) {
                    float ob[8];
#pragma unroll
                    for (int q = 0; q < 8; ++q) { const bool lower = (jl0 + q) <= il; ob[q] = lower ? 0.f : o[q]; o[q] = lower ? o[q] : 0.f; }
                    u32x4 wb; wb.x = cvt_pk_bf16(ob[0], ob[1]); wb.y = cvt_pk_bf16(ob[2], ob[3]); wb.z = cvt_pk_bf16(ob[4], ob[5]); wb.w = cvt_pk_bf16(ob[6], ob[7]);
                    *(GAS u32x4*)(PD + ((((size_t)(u.pm * 2 + ai) * 4 + (il >> 5)) * 2 + (fq >> 1)) * 512 + ((il & 31) + 32 * (fq & 1)) * 8)) = wb;
                }
                u32x4 w; w.x = cvt_pk_bf16(o[0], o[1]); w.y = cvt_pk_bf16(o[2], o[3]); w.z = cvt_pk_bf16(o[4], o[5]); w.w = cvt_pk_bf16(o[6], o[7]);
                *(GAS u32x4*)(PC + ((((size_t)(u.pm * 2 + ai) * 4 + (il >> 5)) * 8 + (2 * wc + (fq >> 1))) * 512 + ((il & 31) + 32 * (fq & 1)) * 8)) = w; }
    }
};
struct EpiGate {
    static constexpr bool PERM = true;
    const GAS bf16* Y; GAS bf16* YG; const GAS f32x2* statp; const GAS float* gain; LAS f32x2* sst;
    __device__ __forceinline__ void operator()(const f32x4 (&acc)[2][2][4][2], const pg8::Unit& u, int wr, int wc, int fr, int fq) const {
        const int head = u.pn >> 1, c0 = u.pn * 256 + wc * 32 + 8 * fq;
        const int tid = (wr * 4 + wc) * 64 + fq * 16 + fr;
        if (tid < 256) { const int t = u.pm * 256 + tid; const GAS f32x4* sp = (const GAS f32x4*)(statp + ((size_t)t * 4 + head) * 8); float a1 = 0.f, a2 = 0.f;
#pragma unroll
            for (int k = 0; k < 4; ++k) { const f32x4 v = sp[k]; a1 += v[0] + v[2]; a2 += v[1] + v[3]; }
            const float mu = a1 * (1.f / DV), var = fmaxf(a2 * (1.f / DV) - mu * mu, 0.f); sst[tid] = (f32x2){mu, __builtin_amdgcn_rsqf(var + EPS)}; }
        asm volatile("s_waitcnt lgkmcnt(0)" ::: "memory"); __builtin_amdgcn_s_barrier(); asm volatile("" ::: "memory");
        f32x4 gv[2][2];
#pragma unroll
        for (int bj = 0; bj < 2; ++bj) { gv[bj][0] = *(const GAS f32x4*)(gain + c0 + bj * 128); gv[bj][1] = *(const GAS f32x4*)(gain + c0 + bj * 128 + 4); }
#pragma unroll
        for (int ai = 0; ai < 2; ++ai)
#pragma unroll
            for (int m = 0; m < 4; ++m) { const int rl = ai * 128 + wr * 64 + m * 16 + fr, t = u.pm * 256 + rl; const f32x2 st = sst[rl];
#pragma unroll
                for (int bj = 0; bj < 2; ++bj) { const size_t off = (size_t)t * VW + c0 + bj * 128;
                    const int es_ = (u.pn & 1) * 4 + bj * 2 + (wc >> 1);
                    const u32x4 yv = *(const GAS u32x4*)(Y + (((size_t)(t >> 5) * NH + head) * 8 + es_) * 2048 + (((wc & 1) * 2 + (fq >> 1)) * 64 + (t & 31) + 32 * (fq & 1)) * 8);
                    const float y[8] = {bf_lo(yv.x), bf_hi(yv.x), bf_lo(yv.y), bf_hi(yv.y), bf_lo(yv.z), bf_hi(yv.z), bf_lo(yv.w), bf_hi(yv.w)}; float o[8];
#pragma unroll
                    for (int n = 0; n < 2; ++n)
#pragma unroll
                        for (int j = 0; j < 4; ++j) { const int q = 4 * n + j; const float yn = (y[q] - st.x) * st.y * gv[bj][n][j]; o[q] = silu_f(acc[ai][bj][m][n][j]) * yn; }
                    u32x4 w; w.x = cvt_pk_bf16(o[0], o[1]); w.y = cvt_pk_bf16(o[2], o[3]); w.z = cvt_pk_bf16(o[4], o[5]); w.w = cvt_pk_bf16(o[6], o[7]);
                    *(GAS u32x4*)(YG + off) = w; } }
    }
};
template <bool BASE_F32> struct EpiRes {
    static constexpr bool PERM = true;
    const GAS void* base; GAS bf16* out; GAS float* ssq;
    __device__ __forceinline__ void operator()(const f32x4 (&acc)[2][2][4][2], const pg8::Unit& u, int wr, int wc, int fr, int fq) const {
#pragma unroll
        for (int ai = 0; ai < 2; ++ai)
#pragma unroll
            for (int m = 0; m < 4; ++m) { const int t_ = u.pm * 256 + ai * 128 + wr * 64 + m * 16 + fr; const size_t off = (size_t)t_ * D + u.pn * 256 + wc * 32 + 8 * fq; float sq = 0.f;
#pragma unroll
                for (int bj = 0; bj < 2; ++bj) { f32x4 v0 = acc[ai][bj][m][0], v1 = acc[ai][bj][m][1];
                    if (BASE_F32) { const GAS float* bp = (const GAS float*)base + off + bj * 128; v0 += *(const GAS f32x4*)bp; v1 += *(const GAS f32x4*)(bp + 4); }
                    else { const u32x4 bv = *(const GAS u32x4*)((const GAS bf16*)base + off + bj * 128);
                        v0 += (f32x4){bf_lo(bv.x), bf_hi(bv.x), bf_lo(bv.y), bf_hi(bv.y)}; v1 += (f32x4){bf_lo(bv.z), bf_hi(bv.z), bf_lo(bv.w), bf_hi(bv.w)}; }
                    u32x4 w; w.x = cvt_pk_bf16(v0[0], v0[1]); w.y = cvt_pk_bf16(v0[2], v0[3]); w.z = cvt_pk_bf16(v1[0], v1[1]); w.w = cvt_pk_bf16(v1[2], v1[3]);
                    *(GAS u32x4*)(out + off + bj * 128) = w;
                    { const float a0 = bf_lo(w.x), a1 = bf_hi(w.x), a2 = bf_lo(w.y), a3 = bf_hi(w.y), a4 = bf_lo(w.z), a5 = bf_hi(w.z), a6 = bf_lo(w.w), a7 = bf_hi(w.w);
                      sq += (a0 * a0 + a1 * a1) + (a2 * a2 + a3 * a3) + (a4 * a4 + a5 * a5) + (a6 * a6 + a7 * a7); } }
                sq += __shfl_xor(sq, 16); sq += __shfl_xor(sq, 32);
                if (ssq != nullptr && fq == 0) ssq[(size_t)t_ * 16 + u.pn * 4 + wc] = sq; }
    }
};
template <bool OUT8, bool NORM = false> struct EpiSwiGLU {
    static constexpr bool PERM = true;
    GAS void* ACT; int ldc; const GAS float* ssq; LAS float* sst;
    __device__ __forceinline__ void operator()(const f32x4 (&acc)[2][2][4][2], const pg8::Unit& u, int wr, int wc, int fr, int fq) const {
        if constexpr (NORM) {
            const int tid = (wr * 4 + wc) * 64 + fq * 16 + fr;
            if (tid < 256) { const GAS f32x4* sp = (const GAS f32x4*)(ssq + (size_t)(u.pm * 256 + tid) * 16); float a = 0.f;
#pragma unroll
                for (int k = 0; k < 4; ++k) { const f32x4 v = sp[k]; a += (v[0] + v[1]) + (v[2] + v[3]); }
                sst[tid] = __builtin_amdgcn_rsqf(a * (1.f / D) + EPS); }
            asm volatile("s_waitcnt lgkmcnt(0)" ::: "memory"); __builtin_amdgcn_s_barrier(); asm volatile("" ::: "memory");
        }
#pragma unroll
        for (int ai = 0; ai < 2; ++ai)
#pragma unroll
            for (int m = 0; m < 4; ++m) { float o[8]; float rs = 1.f; if constexpr (NORM) rs = sst[ai * 128 + wr * 64 + m * 16 + fr];
#pragma unroll
                for (int n = 0; n < 2; ++n)
#pragma unroll
                    for (int j = 0; j < 4; ++j) { if constexpr (NORM) o[4 * n + j] = silu_f(acc[ai][0][m][n][j] * rs) * (acc[ai][1][m][n][j] * rs); else o[4 * n + j] = silu_f(acc[ai][0][m][n][j]) * acc[ai][1][m][n][j]; }
                const size_t off = (size_t)(u.pm * 256 + ai * 128 + wr * 64 + m * 16 + fr) * ldc + u.pn * 128 + wc * 32 + 8 * fq;
                if constexpr (OUT8) { u32x2 w; w.x = pk4_fp8(o[0] * 8.f, o[1] * 8.f, o[2] * 8.f, o[3] * 8.f); w.y = pk4_fp8(o[4] * 8.f, o[5] * 8.f, o[6] * 8.f, o[7] * 8.f); *(GAS u32x2*)((GAS unsigned char*)ACT + off) = w; }
                else { u32x4 w; w.x = cvt_pk_bf16(o[0], o[1]); w.y = cvt_pk_bf16(o[2], o[3]); w.z = cvt_pk_bf16(o[4], o[5]); w.w = cvt_pk_bf16(o[6], o[7]); *(GAS u32x4*)((GAS bf16*)ACT + off) = w; } }
    }
};
struct EpiZ2 {
    static constexpr bool PERM = true;
    GAS bf16* Z2; const GAS float* ssq; LAS float* sst;
    __device__ __forceinline__ void operator()(const f32x4 (&acc)[2][2][4][2], const pg8::Unit& u, int wr, int wc, int fr, int fq) const {
        const int g = u.pm >> 1, ri = u.pm & 1;
        { const int tid = (wr * 4 + wc) * 64 + fq * 16 + fr;
          if (tid < 256) { const GAS f32x4* sp = (const GAS f32x4*)(ssq + (size_t)(u.pn * 256 + tid) * 16); float a = 0.f;
#pragma unroll
              for (int k = 0; k < 4; ++k) { const f32x4 v = sp[k]; a += (v[0] + v[1]) + (v[2] + v[3]); }
              sst[tid] = __builtin_amdgcn_rsqf(a * (1.f / D) + EPS); }
          asm volatile("s_waitcnt lgkmcnt(0)" ::: "memory"); __builtin_amdgcn_s_barrier(); asm volatile("" ::: "memory"); }
        f32x4 rs[2][2];
#pragma unroll
        for (int bj = 0; bj < 2; ++bj) { const LAS f32x4* rp = (const LAS f32x4*)(sst + bj * 128 + wc * 32 + 8 * fq); rs[bj][0] = rp[0]; rs[bj][1] = rp[1]; }
#pragma unroll
        for (int ai = 0; ai < 2; ++ai)
#pragma unroll
            for (int m = 0; m < 4; ++m) { const int cp = ai * 128 + wr * 64 + m * 16 + fr;
#pragma unroll
                for (int bj = 0; bj < 2; ++bj) { const int tok0 = u.pn * 256 + bj * 128 + wc * 32 + 8 * fq, b = tok0 >> 12, s0 = tok0 & (SEQ - 1);
                    const f32x4 v0 = acc[ai][bj][m][0] * rs[bj][0], v1 = acc[ai][bj][m][1] * rs[bj][1];
                    u32x4 w; w.x = cvt_pk_bf16(v0[0], v0[1]); w.y = cvt_pk_bf16(v0[2], v0[3]); w.z = cvt_pk_bf16(v1[0], v1[1]); w.w = cvt_pk_bf16(v1[2], v1[3]);
                    *(GAS u32x4*)(Z2 + ((size_t)(b * 1024 + g * 256 + cp) * 8192 + ri * SEQ + s0)) = w; } }
    }
};
struct EpiYf {
    static constexpr bool PERM = true;
    GAS bf16* YF;
    __device__ __forceinline__ void operator()(const f32x4 (&acc)[2][2][4][2], const pg8::Unit& u, int wr, int wc, int fr, int fq) const {
        const int batch = u.pn >> 5, fb = (u.pn >> 1) & 15, kbb = u.pn & 1;
#pragma unroll
        for (int ai = 0; ai < 2; ++ai)
#pragma unroll
            for (int m = 0; m < 4; ++m) { const int ka = u.pm * 256 + ai * 128 + wr * 64 + m * 16 + fr;
#pragma unroll
                for (int bj = 0; bj < 2; ++bj) { const int kb = kbb * 4 + 2 * bj + (wc >> 1), f = fb * 64 + 32 * (wc & 1) + 8 * fq;
                    const f32x4 v0 = acc[ai][bj][m][0], v1 = acc[ai][bj][m][1];
                    u32x4 w; w.x = cvt_pk_bf16(v0[0], v0[1]); w.y = cvt_pk_bf16(v0[2], v0[3]); w.z = cvt_pk_bf16(v1[0], v1[1]); w.w = cvt_pk_bf16(v1[2], v1[3]);
                    *(GAS u32x4*)(YF + (size_t)(batch * SEQ + 8 * ka + kb) * D + f) = w; } }
    }
};
struct EpiMoeDown {
    static constexpr bool PERM = true;
    GAS bf16* Hres; const GAS int* rowtok; const GAS float* rowgate;
    __device__ __forceinline__ void operator()(const f32x4 (&acc)[2][2][4][2], const pg8::Unit& u, int wr, int wc, int fr, int fq) const {
#pragma unroll
        for (int ai = 0; ai < 2; ++ai)
#pragma unroll
            for (int m = 0; m < 4; ++m) { const int row = u.pm * 256 + ai * 128 + wr * 64 + m * 16 + fr; const int tok = rowtok[row]; const float gw = rowgate[row];
                if (tok >= 0) { GAS bf16* rp = Hres + (size_t)tok * D + u.pn * 256 + wc * 32 + 8 * fq;
#pragma unroll
                    for (int bj = 0; bj < 2; ++bj) { const u32x4 bv = *(const GAS u32x4*)(rp + bj * 128);
                        const f32x4 v0 = (f32x4){bf_lo(bv.x), bf_hi(bv.x), bf_lo(bv.y), bf_hi(bv.y)} + gw * acc[ai][bj][m][0], v1 = (f32x4){bf_lo(bv.z), bf_hi(bv.z), bf_lo(bv.w), bf_hi(bv.w)} + gw * acc[ai][bj][m][1];
                        u32x4 w; w.x = cvt_pk_bf16(v0[0], v0[1]); w.y = cvt_pk_bf16(v0[2], v0[3]); w.z = cvt_pk_bf16(v1[0], v1[1]); w.w = cvt_pk_bf16(v1[2], v1[3]);
                        *(GAS u32x4*)(rp + bj * 128) = w; } } }
    }
};

#define XB_TMO      128
#define XB_XCNT(j)  (256  + 64 * (j))
#define XB_XSUB(j)  (1280 + 64 * (j))
#define XB_XGEN(j)  (2304 + 64 * (j))
#define XB_TOP      3328
#define XB_TOPGEN   3392
#define XCD_BAR_WORDS 3456
#define XB_SPIN_CAP (1u << 18)
__device__ __forceinline__ unsigned xb_ld(unsigned* p)              { return __hip_atomic_load(p, __ATOMIC_RELAXED, __HIP_MEMORY_SCOPE_AGENT); }
__device__ __forceinline__ unsigned xb_add(unsigned* p, unsigned v) { return __hip_atomic_fetch_add(p, v, __ATOMIC_RELAXED, __HIP_MEMORY_SCOPE_AGENT); }
__device__ __forceinline__ unsigned xb_xcc_id() { return (unsigned)__builtin_amdgcn_s_getreg((3 << 11) | 20) & 0xFu; }
#define XB_SPIN(cond, bar) do { unsigned _sp = 0; while (cond) { __builtin_amdgcn_s_sleep(1); \
    if ((++_sp & 255u) == 0u) { if (xb_ld(&(bar)[XB_TMO])) break; if (_sp > XB_SPIN_CAP) { atomicAdd(&(bar)[XB_TMO], 1u); break; } } } } while (0)
struct XcdBarrier { unsigned* bar; unsigned x; volatile LAS unsigned* st; };
__device__ __forceinline__ XcdBarrier xcd_barrier_post(unsigned* bar, volatile LAS unsigned* st, const bool t0) {
    XcdBarrier b; b.bar = bar; b.x = xb_xcc_id(); b.st = st;
    if (t0) (void)xb_add(&bar[XB_XCNT(b.x)], 1u);
    return b;
}
__device__ __forceinline__ void xcd_barrier_complete(unsigned* bar, unsigned x, unsigned& nloc, unsigned& nx) {
    const unsigned G = gridDim.x * gridDim.y * gridDim.z;
    unsigned sum, cnt, mine, sp = 0u;
    for (;;) {
        sum = 0u; cnt = 0u; mine = 0u;
#pragma unroll
        for (unsigned j = 0; j < 16; ++j) { const unsigned c = xb_ld(&bar[XB_XCNT(j)]); sum += c; cnt += (c > 0u) ? 1u : 0u; mine = (j == x) ? c : mine; }
        if (sum == G) break;
        __builtin_amdgcn_s_sleep(1);
        if ((++sp & 255u) == 0u) { if (xb_ld(&bar[XB_TMO])) break; if (sp > XB_SPIN_CAP) { atomicAdd(&bar[XB_TMO], 1u); break; } }
    }
    nloc = mine > 0u ? mine : 1u; nx = cnt > 0u ? cnt : 1u;
}
__device__ __forceinline__ void xcd_barrier(const XcdBarrier& b, const bool t0) {
    asm volatile("s_waitcnt vmcnt(0)" ::: "memory");
    __syncthreads();
    if (t0) {
        unsigned* bar = b.bar;
        __builtin_amdgcn_s_waitcnt(0);
        unsigned nloc = b.st[0], nx = b.st[1];
        if (nloc == 0u) { xcd_barrier_complete(bar, b.x, nloc, nx); b.st[0] = nloc; b.st[1] = nx; }
        const unsigned old = xb_add(&bar[XB_XSUB(b.x)], 1u);
        const unsigned gen = old / nloc;
        if (old + 1u == (gen + 1u) * nloc) {
            __builtin_amdgcn_fence(__ATOMIC_RELEASE, "agent");
            asm volatile("s_waitcnt vmcnt(0)" ::: "memory");
            const unsigned og = xb_add(&bar[XB_TOP], 1u);
            const unsigned tg = og / nx;
            if (og + 1u == (tg + 1u) * nx) xb_add(&bar[XB_TOPGEN], 1u);
            else XB_SPIN(xb_ld(&bar[XB_TOPGEN]) == tg, bar);
            __builtin_amdgcn_fence(__ATOMIC_ACQUIRE, "agent");
            xb_add(&bar[XB_XGEN(b.x)], 1u);
            asm volatile("s_waitcnt vmcnt(0)" ::: "memory");
        } else {
            XB_SPIN(xb_ld(&bar[XB_XGEN(b.x)]) == gen, bar);
            __builtin_amdgcn_fence(__ATOMIC_ACQUIRE, "agent");
            asm volatile("s_waitcnt vmcnt(0)" ::: "memory");
        }
    }
    __syncthreads();
}

__device__ __forceinline__ float wave_sum(float v) {
#pragma unroll
    for (int o = 1; o < 64; o <<= 1) v += __shfl_xor(v, o);
    return v;
}
__device__ __forceinline__ void transpose_item(const GAS float* W, int K, int N, GAS bf16* WT, int k0, int n0, int rbase, LAS float* scr, int lane, const GAS float* gk = nullptr) {
#pragma unroll 8
    for (int i = 0; i < 32; ++i) { const int kk = 2 * i + (lane >> 5); float wv = W[(size_t)(k0 + kk) * N + n0 + (lane & 31)]; if (gk != nullptr) wv *= gk[k0 + kk]; scr[kk * 33 + (lane & 31)] = wv; }
    LDS_WAIT(); asm volatile("" ::: "memory");
    const int c = lane & 7;
#pragma unroll
    for (int j = 0; j < 4; ++j) { const int n = (lane >> 3) + 8 * j; const LAS float* s = scr + (8 * c) * 33 + n;
        u32x4 o; o.x = cvt_pk_bf16(s[0 * 33], s[1 * 33]); o.y = cvt_pk_bf16(s[2 * 33], s[3 * 33]); o.z = cvt_pk_bf16(s[4 * 33], s[5 * 33]); o.w = cvt_pk_bf16(s[6 * 33], s[7 * 33]);
        *(GAS u32x4*)(WT + (size_t)(rbase + n) * K + k0 + 8 * c) = o; }
    LDS_WAIT(); asm volatile("" ::: "memory");
}
__device__ __forceinline__ void transpose_item8(const GAS float* W, int K, int N, GAS unsigned char* WT8, int k0, int n0, int rbase, float scale, LAS float* scr, int lane) {
#pragma unroll 8
    for (int i = 0; i < 32; ++i) { const int kk = 2 * i + (lane >> 5); scr[kk * 33 + (lane & 31)] = W[(size_t)(k0 + kk) * N + n0 + (lane & 31)]; }
    LDS_WAIT(); asm volatile("" ::: "memory");
    const int c = lane & 7;
#pragma unroll
    for (int j = 0; j < 4; ++j) { const int n = (lane >> 3) + 8 * j; const LAS float* sp = scr + (8 * c) * 33 + n;
        u32x2 o; o.x = pk4_fp8(sp[0 * 33] * scale, sp[1 * 33] * scale, sp[2 * 33] * scale, sp[3 * 33] * scale); o.y = pk4_fp8(sp[4 * 33] * scale, sp[5 * 33] * scale, sp[6 * 33] * scale, sp[7 * 33] * scale);
        *(GAS u32x2*)(WT8 + (size_t)(rbase + n) * K + k0 + 8 * c) = o; }
    LDS_WAIT(); asm volatile("" ::: "memory");
}
__device__ __forceinline__ void tr_gu8(const GAS float* Wg, const GAS float* Wu, int K, int N, GAS unsigned char* WT8, int it, LAS float* scr, int lane) {
    const int nblk = N / 32, per = (K / 64) * nblk; const bool up = it >= per; if (up) it -= per;
    const int kb = it / nblk, nb = it - kb * nblk, f0 = 32 * nb;
    transpose_item8(up ? Wu : Wg, K, N, WT8, 64 * kb, f0, 256 * (f0 >> 7) + (up ? 128 : 0) + (f0 & 127), 64.0f, scr, lane);
}
__device__ __forceinline__ void tr_plain(const GAS float* W, int K, int N, GAS bf16* WT, int it, LAS float* scr, int lane) {
    const int nblk = N / 32, kb = it / nblk, nb = it - kb * nblk; transpose_item(W, K, N, WT, 64 * kb, 32 * nb, 32 * nb, scr, lane);
}
__device__ __forceinline__ void tr_gu(const GAS float* Wg, const GAS float* Wu, int K, int N, GAS bf16* WT, int it, LAS float* scr, int lane, const GAS float* gk = nullptr) {
    const int nblk = N / 32, per = (K / 64) * nblk; const bool up = it >= per; if (up) it -= per;
    const int kb = it / nblk, nb = it - kb * nblk, f0 = 32 * nb;
    transpose_item(up ? Wu : Wg, K, N, WT, 64 * kb, f0, 256 * (f0 >> 7) + (up ? 128 : 0) + (f0 & 127), scr, lane, gk);
}
__device__ __forceinline__ void rms_row(const GAS float* xrow, const GAS float* g, GAS bf16* orow, int lane, f32x4 (&v)[4]) {
    const GAS f32x4* xr = (const GAS f32x4*)xrow + lane; const GAS f32x4* gr = (const GAS f32x4*)g + lane;
    float s = 0.f;
#pragma unroll
    for (int j = 0; j < 4; ++j) { v[j] = xr[64 * j]; s += (v[j].x * v[j].x + v[j].y * v[j].y) + (v[j].z * v[j].z + v[j].w * v[j].w); }
    const float r = 1.0f / sqrtf(wave_sum(s) * (1.f / D) + EPS);
    GAS u32x2* o8 = (GAS u32x2*)orow + lane;
#pragma unroll
    for (int j = 0; j < 4; ++j) { v[j] = v[j] * r * gr[64 * j]; u32x2 w; w.x = cvt_pk_bf16(v[j].x, v[j].y); w.y = cvt_pk_bf16(v[j].z, v[j].w); o8[64 * j] = w; }
}
__device__ __forceinline__ int rmsb_col(int j, int lane) { return 512 * (j >> 1) + 8 * lane + 4 * (j & 1); }
__device__ __forceinline__ void rms_row_b(const GAS bf16* hrow, const GAS float* g, GAS bf16* orow, int lane, f32x4 (&v)[4]) {
    float s = 0.f;
#pragma unroll
    for (int jh = 0; jh < 2; ++jh) { const u32x4 x = *(const GAS u32x4*)(hrow + 512 * jh + 8 * lane);
        v[2 * jh] = (f32x4){bf_lo(x.x), bf_hi(x.x), bf_lo(x.y), bf_hi(x.y)}; v[2 * jh + 1] = (f32x4){bf_lo(x.z), bf_hi(x.z), bf_lo(x.w), bf_hi(x.w)}; }
#pragma unroll
    for (int j = 0; j < 4; ++j) s += (v[j].x * v[j].x + v[j].y * v[j].y) + (v[j].z * v[j].z + v[j].w * v[j].w);
    const float r = 1.0f / sqrtf(wave_sum(s) * (1.f / D) + EPS);
#pragma unroll
    for (int jh = 0; jh < 2; ++jh) { const GAS float* gp = g + 512 * jh + 8 * lane; v[2 * jh] = v[2 * jh] * r * *(const GAS f32x4*)gp; v[2 * jh + 1] = v[2 * jh + 1] * r * *(const GAS f32x4*)(gp + 4);
        u32x4 w; w.x = cvt_pk_bf16(v[2 * jh].x, v[2 * jh].y); w.y = cvt_pk_bf16(v[2 * jh].z, v[2 * jh].w); w.z = cvt_pk_bf16(v[2 * jh + 1].x, v[2 * jh + 1].y); w.w = cvt_pk_bf16(v[2 * jh + 1].z, v[2 * jh + 1].w);
        *(GAS u32x4*)(orow + 512 * jh + 8 * lane) = w; }
}

__device__ __forceinline__ void rms_row_b8(const GAS bf16* hrow, const GAS float* g, GAS unsigned char* o8, int lane, f32x4 (&v)[4]) {
    float s = 0.f;
#pragma unroll
    for (int jh = 0; jh < 2; ++jh) { const u32x4 x = *(const GAS u32x4*)(hrow + 512 * jh + 8 * lane);
        v[2 * jh] = (f32x4){bf_lo(x.x), bf_hi(x.x), bf_lo(x.y), bf_hi(x.y)}; v[2 * jh + 1] = (f32x4){bf_lo(x.z), bf_hi(x.z), bf_lo(x.w), bf_hi(x.w)}; }
#pragma unroll
    for (int j = 0; j < 4; ++j) s += (v[j].x * v[j].x + v[j].y * v[j].y) + (v[j].z * v[j].z + v[j].w * v[j].w);
    const float r = 1.0f / sqrtf(wave_sum(s) * (1.f / D) + EPS);
#pragma unroll
    for (int jh = 0; jh < 2; ++jh) { const GAS float* gp = g + 512 * jh + 8 * lane; v[2 * jh] = v[2 * jh] * r * *(const GAS f32x4*)gp; v[2 * jh + 1] = v[2 * jh + 1] * r * *(const GAS f32x4*)(gp + 4);
        u32x2 w; w.x = pk4_fp8(v[2 * jh].x, v[2 * jh].y, v[2 * jh].z, v[2 * jh].w); w.y = pk4_fp8(v[2 * jh + 1].x, v[2 * jh + 1].y, v[2 * jh + 1].z, v[2 * jh + 1].w);
        *(GAS u32x2*)(o8 + 512 * jh + 8 * lane) = w; }
}

constexpr int SW_QL = 0, SW_SPITCH = 528, SW_SL = 128 * 528, SW_VPITCH = 272, SW_VL = SW_SL + 64 * SW_SPITCH, SW_VB = 64 * SW_VPITCH;
static_assert(SW_VL + 2 * SW_VB <= 139264, "sweep LDS");
template <bool OUT> __device__ __forceinline__ void sweep_role(LAS unsigned char* lds, const GAS bf16* Qg, const GAS bf16* KTFg, const GAS bf16* KTBg, const GAS bf16* VTg, const GAS bf16* PCg, const GAS bf16* PDg, const GAS bf16* ZEROg, GAS bf16* Yg, GAS f32x2* statp, const float l2f, const float l2b, int b, int h, int es, const int wave_s) {
    const int tid = tid_of(wave_s);
    const int w = __builtin_amdgcn_readfirstlane(tid >> 6), lane = tid & 63, r32 = lane & 31, hh = lane >> 5;
    const int rb = w & 3;
    const int vrow = tid >> 4, vpc = tid & 15;
    const int qrow = tid >> 5, qpc = tid & 31;
    const GAS bf16* qp = Qg + (size_t)(b * SEQ + qrow) * QKW + h * DK + 8 * qpc;
    const GAS bf16* vtp = VTg + (size_t)(h * DV + 64 * es + vrow) * T + 8 * vpc; const int vrot = b * SEQ + ((vrow & 15) << 11);
    const int il = 32 * rb + r32;
    const GAS bf16* pcp = PCg + (((size_t)((b * NH + h) * NCH) * 4 + rb) * 8) * 512 + lane * 8;
    const GAS bf16* pdp = PDg + (((size_t)((b * NH + h) * NCH) * 4 + rb) * 2) * 512 + lane * 8;
    GAS bf16* yp = Yg + ((size_t)(((b * SEQ) >> 5) + rb) * NH + h) * 8 * 2048 + (size_t)es * 2048 + lane * 8;
    GAS f32x2* stp = statp + ((size_t)(b * SEQ + il) * NH + h) * 8 + es;
    const size_t kto = ((size_t)((b * NH + h) * NCH) * 8 + 2 * rb) * 8 * 512 + lane * 8;
#define SW_LDP(dst, s_, d_, nn_) do { const int jb_ = (s_) >> 1; const bool use_ = (d_) ? (jb_ >= rb) : (jb_ <= rb); const bool dg_ = (d_) && (jb_ == rb); \
        const GAS bf16* src_ = dg_ ? (pdp + (size_t)(nn_) * 4096 + 512 * ((s_) & 1)) : (pcp + (size_t)(nn_) * (CH * CH) + 512 * (s_)); \
        dst = *(const GAS bf16x8*)(use_ ? src_ : ZEROg); } while (0)
#define SW_SCHED __builtin_amdgcn_sched_barrier(0)
#define SW_MFMA(a, b, c) c = __builtin_amdgcn_mfma_f32_32x32x16_bf16(a, b, c, 0, 0, 0)
    bf16x8 pa[8];
    bf16x8 ka[2][8];
    u32x4 vv[2], qv[4];
    f32x16 Sacc[2][2];
    if constexpr (OUT) {
#pragma unroll
        for (int s = 0; s < 8; ++s) SW_LDP(pa[s], s, 0, 0);
    } else {
#pragma unroll
        for (int db = 0; db < 2; ++db)
#pragma unroll
            for (int s = 0; s < 8; ++s) ka[db][s] = *(const GAS bf16x8*)(KTFg + kto + db * 4096 + s * 512);
#pragma unroll
        for (int db = 0; db < 2; ++db)
#pragma unroll
            for (int et = 0; et < 2; ++et)
#pragma unroll
                for (int t = 0; t < 16; ++t) Sacc[db][et][t] = 0.f;
    }
#pragma unroll
    for (int it = 0; it < 2; ++it) vv[it] = *(const GAS u32x4*)(vtp + (size_t)(32 * it) * T + (vrot & (T - 1)));
#pragma unroll
    for (int it = 0; it < 2; ++it) *(LAS u32x4*)(lds + SW_VL + (vrow + 32 * it) * SW_VPITCH + vpc * 16) = vv[it];
#pragma unroll
    for (int hf = 0; hf < 2; ++hf) {
#pragma unroll
        for (int it = 0; it < 4; ++it) qv[it] = *(const GAS u32x4*)(qp + (size_t)(16 * (4 * hf + it)) * QKW);
#pragma unroll
        for (int it = 0; it < 4; ++it) { const int row = qrow + 16 * (4 * hf + it); *(LAS u32x4*)(lds + SW_QL + row * SW_SPITCH + qpc * 16) = qv[it]; }
    }
    const int sl_rd = SW_SL + r32 * SW_SPITCH + 16 * hh;
    const int q_rd = SW_QL + il * SW_SPITCH + 16 * hh;
#pragma unroll 1
    for (int p = 0; p < 2 * NCH; ++p) {
        const int dir = p >> 5, st = p & 31, n = dir ? NCH - 1 - st : st;
        const int pn = p + 1 < 2 * NCH ? p + 1 : p, dirn = pn >> 5, stn = pn & 31, nn = dirn ? NCH - 1 - stn : stn;
        const int cur = p & 1;
        const float l2 = dir ? l2b : l2f;
        const int v_rd = SW_VL + cur * SW_VB + r32 * SW_VPITCH + 16 * hh;
        if constexpr (!OUT) {
#pragma unroll
            for (int db = 0; db < 2; ++db)
#pragma unroll
                for (int et = 0; et < 2; ++et)
#pragma unroll
                    for (int g = 0; g < 4; ++g) { u32x2 pk; pk.x = cvt_pk_bf16(Sacc[db][et][4 * g], Sacc[db][et][4 * g + 1]); pk.y = cvt_pk_bf16(Sacc[db][et][4 * g + 2], Sacc[db][et][4 * g + 3]);
                        if (st == 0) { pk.x = 0u; pk.y = 0u; }
                        *(LAS u32x2*)(lds + SW_SL + (32 * et + r32) * SW_SPITCH + (64 * rb + 32 * db + 8 * g + 4 * hh) * 2) = pk; }
        }
#pragma unroll
        for (int it = 0; it < 2; ++it) vv[it] = *(const GAS u32x4*)(vtp + (size_t)(32 * it) * T + ((nn * CH + vrot) & (T - 1)));
#pragma unroll
        for (int it = 0; it < 4; ++it) qv[it] = *(const GAS u32x4*)(qp + (size_t)(nn * CH + 16 * it) * QKW);
        __syncthreads();
        f32x16 O[2];
        u32x4 yf[4];
        GAS bf16* ypn = yp + (size_t)(n * 4) * (NH * 8 * 2048);
        if constexpr (OUT) {
#pragma unroll
            for (int et = 0; et < 2; ++et)
#pragma unroll
                for (int t = 0; t < 16; ++t) O[et][t] = 0.f;
            bf16x8 qx[2], s0x[2], s1x[2], qy[2], s0y[2], s1y[2];
#define SW_LDC(dq, d0, d1, g2) do { _Pragma("unroll") for (int k = 0; k < 2; ++k) { const int ks = 2 * (g2) + k; dq[k] = *(const LAS bf16x8*)(lds + q_rd + 32 * ks); \
                d0[k] = *(const LAS bf16x8*)(lds + sl_rd + 32 * ks); d1[k] = *(const LAS bf16x8*)(lds + sl_rd + 32 * SW_SPITCH + 32 * ks); } } while (0)
#define SW_MMC(dq, d0, d1) do { SW_MFMA(d0[0], dq[0], O[0]); SW_MFMA(d1[0], dq[0], O[1]); SW_MFMA(d0[1], dq[1], O[0]); SW_MFMA(d1[1], dq[1], O[1]); } while (0)
            SW_LDC(qx, s0x, s1x, 0); SW_LDC(qy, s0y, s1y, 1); SW_SCHED;
            SW_MMC(qx, s0x, s1x); SW_SCHED; SW_LDC(qx, s0x, s1x, 2); SW_SCHED;
            SW_MMC(qy, s0y, s1y); SW_SCHED; SW_LDC(qy, s0y, s1y, 3); SW_SCHED;
            SW_MMC(qx, s0x, s1x); SW_SCHED; SW_LDC(qx, s0x, s1x, 4); SW_SCHED;
            SW_MMC(qy, s0y, s1y); SW_SCHED; SW_LDC(qy, s0y, s1y, 5); SW_SCHED;
            SW_MMC(qx, s0x, s1x); SW_SCHED; SW_LDC(qx, s0x, s1x, 6); SW_SCHED;
            SW_MMC(qy, s0y, s1y); SW_SCHED; SW_LDC(qy, s0y, s1y, 7); SW_SCHED;
            SW_MMC(qx, s0x, s1x); SW_SCHED;
            SW_MMC(qy, s0y, s1y); SW_SCHED;
#undef SW_LDC
#undef SW_MMC
        } else {
            const float gC = st == 0 ? 0.f : fast_exp2((float)CH * l2);
#pragma unroll
            for (int db = 0; db < 2; ++db)
#pragma unroll
                for (int et = 0; et < 2; ++et)
#pragma unroll
                    for (int t = 0; t < 16; ++t) Sacc[db][et][t] *= gC;
            bf16x8 v0x[2], v1x[2], v0y[2], v1y[2];
#define SW_LDU(d0, d1, g2) do { _Pragma("unroll") for (int k = 0; k < 2; ++k) { const int s_ = 2 * (g2) + k; d0[k] = *(const LAS bf16x8*)(lds + v_rd + 32 * s_); d1[k] = *(const LAS bf16x8*)(lds + v_rd + 32 * SW_VPITCH + 32 * s_); } } while (0)
#define SW_MMU(d0, d1, g2) do { _Pragma("unroll") for (int k = 0; k < 2; ++k) { const int s_ = 2 * (g2) + k; SW_MFMA(ka[0][s_], d0[k], Sacc[0][0]); SW_MFMA(ka[0][s_], d1[k], Sacc[0][1]); SW_MFMA(ka[1][s_], d0[k], Sacc[1][0]); SW_MFMA(ka[1][s_], d1[k], Sacc[1][1]); } } while (0)
            SW_LDU(v0x, v1x, 0); SW_LDU(v0y, v1y, 1); SW_SCHED;
            SW_MMU(v0x, v1x, 0); SW_SCHED; SW_LDU(v0x, v1x, 2); SW_SCHED;
            SW_MMU(v0y, v1y, 1); SW_SCHED; SW_LDU(v0y, v1y, 3); SW_SCHED;
            SW_MMU(v0x, v1x, 2); SW_SCHED;
            SW_MMU(v0y, v1y, 3); SW_SCHED;
#undef SW_LDU
#undef SW_MMU
        }
        __syncthreads();
#pragma unroll
        for (int it = 0; it < 4; ++it) { const int row = qrow + 16 * it; *(LAS u32x4*)(lds + SW_QL + row * SW_SPITCH + qpc * 16) = qv[it]; }
#pragma unroll
        for (int it = 0; it < 4; ++it) qv[it] = *(const GAS u32x4*)(qp + (size_t)(nn * CH + 16 * (4 + it)) * QKW);
        if constexpr (OUT) {
            if (dir) {
#pragma unroll
                for (int q = 0; q < 4; ++q) yf[q] = *(const GAS u32x4*)(ypn + q * 512);
            }
            const float xi = fast_exp2((float)(dir == 0 ? (il + 1) : (CH - il)) * l2);
#pragma unroll
            for (int et = 0; et < 2; ++et)
#pragma unroll
                for (int t = 0; t < 16; ++t) O[et][t] *= xi;
            bf16x8 v0x[2], v1x[2], v0y[2], v1y[2];
#define SW_LDV(d0, d1, g2) do { _Pragma("unroll") for (int k = 0; k < 2; ++k) { const int s_ = 2 * (g2) + k; d0[k] = *(const LAS bf16x8*)(lds + v_rd + 32 * s_); d1[k] = *(const LAS bf16x8*)(lds + v_rd + 32 * SW_VPITCH + 32 * s_); } } while (0)
#define SW_MMV(d0, d1, g2) do { _Pragma("unroll") for (int k = 0; k < 2; ++k) { const int s_ = 2 * (g2) + k; SW_MFMA(d0[k], pa[s_], O[0]); SW_MFMA(d1[k], pa[s_], O[1]); } } while (0)
            SW_LDV(v0x, v1x, 0); SW_LDV(v0y, v1y, 1); SW_SCHED;
            SW_MMV(v0x, v1x, 0); SW_SCHED; SW_LDV(v0x, v1x, 2); SW_SCHED;
            SW_MMV(v0y, v1y, 1); SW_SCHED; SW_LDV(v0y, v1y, 3); SW_SCHED;
            SW_MMV(v0x, v1x, 2); SW_SCHED;
            SW_MMV(v0y, v1y, 3); SW_SCHED;
#undef SW_LDV
#undef SW_MMV
#pragma unroll
            for (int s = 0; s < 8; ++s) SW_LDP(pa[s], s, dirn, nn);
        } else {
            const GAS bf16* ktn = (dirn ? KTBg : KTFg) + kto + (size_t)nn * 32768;
#pragma unroll
            for (int db = 0; db < 2; ++db)
#pragma unroll
                for (int s = 0; s < 8; ++s) ka[db][s] = *(const GAS bf16x8*)(ktn + db * 4096 + s * 512);
        }
#pragma unroll
        for (int it = 0; it < 2; ++it) *(LAS u32x4*)(lds + SW_VL + (cur ^ 1) * SW_VB + (vrow + 32 * it) * SW_VPITCH + vpc * 16) = vv[it];
#pragma unroll
        for (int it = 0; it < 4; ++it) { const int row = qrow + 16 * (4 + it); *(LAS u32x4*)(lds + SW_QL + row * SW_SPITCH + qpc * 16) = qv[it]; }
        if constexpr (OUT) {
            float s1 = 0.f, s2 = 0.f;
#pragma unroll
            for (int et = 0; et < 2; ++et)
#pragma unroll
                for (int kp = 0; kp < 2; ++kp) {
                    float ya[4], yb[4];
#pragma unroll
                    for (int q = 0; q < 4; ++q) { ya[q] = O[et][8 * kp + q]; yb[q] = O[et][8 * kp + 4 + q]; }
                    if (dir) {
                        u32x4 f = yf[et * 2 + kp];
                        { const auto r0 = __builtin_amdgcn_permlane32_swap(f.x, f.z, false, false); f.x = r0[0]; f.z = r0[1]; const auto r1 = __builtin_amdgcn_permlane32_swap(f.y, f.w, false, false); f.y = r1[0]; f.w = r1[1]; }
                        ya[0] += bf_lo(f.x); ya[1] += bf_hi(f.x); ya[2] += bf_lo(f.y); ya[3] += bf_hi(f.y); yb[0] += bf_lo(f.z); yb[1] += bf_hi(f.z); yb[2] += bf_lo(f.w); yb[3] += bf_hi(f.w);
#pragma unroll
                        for (int q = 0; q < 4; ++q) { s1 += ya[q] + yb[q]; s2 += ya[q] * ya[q] + yb[q] * yb[q]; }
                    }
                    u32x4 o; o.x = cvt_pk_bf16(ya[0], ya[1]); o.y = cvt_pk_bf16(ya[2], ya[3]); o.z = cvt_pk_bf16(yb[0], yb[1]); o.w = cvt_pk_bf16(yb[2], yb[3]);
                    { const auto r0 = __builtin_amdgcn_permlane32_swap(o.x, o.z, false, false); o.x = r0[0]; o.z = r0[1]; const auto r1 = __builtin_amdgcn_permlane32_swap(o.y, o.w, false, false); o.y = r1[0]; o.w = r1[1]; }
                    *(GAS u32x4*)(ypn + (et * 2 + kp) * 512) = o;
                }
            if (dir) { s1 += __shfl_xor(s1, 32); s2 += __shfl_xor(s2, 32);
                if (hh == 0) stp[(size_t)(n * CH) * (NH * 8)] = (f32x2){s1, s2}; }
        }
    }
#undef SW_LDP
#undef SW_SCHED
#undef SW_MFMA
    VM_WAIT();
    __syncthreads();
}

__device__ __forceinline__ void sweep_unit(LAS unsigned char* lds, const GAS bf16* Qg, const GAS bf16* KTFg, const GAS bf16* KTBg, const GAS bf16* VTg, const GAS bf16* PCg, const GAS bf16* PDg, const GAS bf16* ZEROg, GAS bf16* Yg, GAS f32x2* statp, const float l2f, const float l2b, int b, int h, int es, const int wave_s) {
    int ws_ = wave_s; asm volatile("" : "+s"(ws_));
    if (ws_ < 4) sweep_role<true>(lds, Qg, KTFg, KTBg, VTg, PCg, PDg, ZEROg, Yg, statp, l2f, l2b, b, h, es, wave_s);
    else sweep_role<false>(lds, Qg, KTFg, KTBg, VTg, PCg, PDg, ZEROg, Yg, statp, l2f, l2b, b, h, es, wave_s);
}

struct Args { const float* in[16]; float* out; unsigned char* ws; };
constexpr int NWAVES = 8;
#ifndef PHMASK
#define PHMASK 0xFFFFFFFFu
#endif
#define PH(k) (((PHMASK) >> (k)) & 1u)
__global__ void __launch_bounds__(NWAVES * 64, 2) fwd_kernel(Args args) {
    extern __shared__ __attribute__((aligned(16))) unsigned char lds_raw[];
    LAS unsigned char* lds = (LAS unsigned char*)lds_raw;
    LAS float* l2g = (LAS float*)(lds + LDSCTL_OFF + 64);
    const int wave_k = __builtin_amdgcn_readfirstlane((int)threadIdx.x >> 6);
#define PHASE_VARS \
    const int tid = tid_of(wave_k); const int lane = tid & 63; int wave = wave_k; asm volatile("" : "+s"(wave)); \
    const __attribute__((address_space(4))) Args* ka = (const __attribute__((address_space(4))) Args*)__builtin_amdgcn_kernarg_segment_ptr(); asm volatile("" : "+s"(ka)); \
    const int G = gridDim.x, bx = blockIdx.x; const int vcu = (G % 8 == 0) ? (bx % 8) * (G / 8) + bx / 8 : bx; const int gw = vcu * NWAVES + wave, NGW = G * NWAVES; \
    GAS unsigned char* ws = (GAS unsigned char*)ka->ws; asm volatile("" : "+s"(ws)); GAS float* hres = (GAS float*)ka->out; (void)lane; (void)gw; (void)NGW; (void)vcu; (void)hres; \
    const GAS float* x = (const GAS float*)ka->in[0]; const GAS float* mix_norm = (const GAS float*)ka->in[1]; const GAS float* ffn_norm = (const GAS float*)ka->in[2]; const GAS float* ret_w_in = (const GAS float*)ka->in[3]; const GAS float* ret_decay = (const GAS float*)ka->in[4]; \
    const GAS float* gn_gain = (const GAS float*)ka->in[5]; const GAS float* ret_w_out = (const GAS float*)ka->in[6]; const GAS float* d_wg = (const GAS float*)ka->in[7]; const GAS float* d_wu = (const GAS float*)ka->in[8]; const GAS float* d_wd = (const GAS float*)ka->in[9]; \
    const GAS float* fnet_w = (const GAS float*)ka->in[10]; const GAS float* moe_router = (const GAS float*)ka->in[11]; const GAS float* m_wg = (const GAS float*)ka->in[12]; const GAS float* m_wu = (const GAS float*)ka->in[13]; const GAS float* m_wd = (const GAS float*)ka->in[14]; const GAS float* final_norm = (const GAS float*)ka->in[15]; \
    (void)x; (void)mix_norm; (void)ffn_norm; (void)ret_w_in; (void)ret_decay; (void)gn_gain; (void)ret_w_out; (void)d_wg; (void)d_wu; (void)d_wd; (void)fnet_w; (void)moe_router; (void)m_wg; (void)m_wu; (void)m_wd; (void)final_norm; \
    GAS f32x2* rot = (GAS f32x2*)(ws + WS_ROT); GAS f32x2* rotT = (GAS f32x2*)(ws + WS_ROTT); GAS bf16* WC = (GAS bf16*)(ws + WS_STATS); GAS float* SSQ1 = (GAS float*)(ws + WS_SSQ1); GAS float* SSQ2 = (GAS float*)(ws + WS_SSQ2); (void)SSQ1; (void)SSQ2; \
    GAS int* toke = (GAS int*)(ws + WS_TOKE); GAS float* tokw = (GAS float*)(ws + WS_TOKW); GAS int* bcnt = (GAS int*)(ws + WS_BCNT); GAS int* pcnt = (GAS int*)(ws + WS_PCNT); (void)pcnt; GAS int* rowtok = (GAS int*)(ws + WS_ROWTOK); GAS float* rowgate = (GAS float*)(ws + WS_ROWGATE); \
    GAS f32x2* statp = (GAS f32x2*)(ws + WS_STATP); \
    GAS bf16* WIN = (GAS bf16*)(ws + WS_WIN); GAS bf16* WO = (GAS bf16*)(ws + WS_WO); GAS bf16* WGU = (GAS bf16*)(ws + WS_WGU); GAS bf16* WD = (GAS bf16*)(ws + WS_WD); GAS bf16* WF = (GAS bf16*)(ws + WS_WF); \
    GAS bf16* HN = (GAS bf16*)(ws + WS_HN); GAS bf16* Qb = (GAS bf16*)(ws + WS_Q); GAS bf16* Kb = (GAS bf16*)(ws + WS_K); GAS bf16* KT = (GAS bf16*)(ws + WS_KT); GAS bf16* VT = (GAS bf16*)(ws + WS_VT); GAS bf16* PC = (GAS bf16*)(ws + WS_PC); \
    GAS bf16* HB = (GAS bf16*)(ws + WS_HN); GAS bf16* HNB = (GAS bf16*)ka->out; (void)HB; (void)HNB; \
    GAS unsigned char* HN8 = (GAS unsigned char*)ka->out + 64 * MiB; GAS unsigned char* WMGU8 = (GAS unsigned char*)(ws + WS_WMGU); (void)HN8; (void)WMGU8;     \
    GAS bf16* Yb = (GAS bf16*)ka->out; GAS bf16* YG = (GAS bf16*)(ws + WS_YG); GAS bf16* ACTD = (GAS bf16*)(ws + WS_ACTD); GAS bf16* Z2 = (GAS bf16*)(ws + WS_Z2); GAS bf16* WSEQ = (GAS bf16*)(ws + WS_WSEQ); \
    GAS bf16* ACTM = (GAS bf16*)(ws + WS_ACTM); GAS bf16* WMGU = (GAS bf16*)(ws + WS_WMGU); GAS bf16* WMD = (GAS bf16*)(ws + WS_WMD); \
    (void)rot; (void)rotT; (void)WC; (void)toke; (void)tokw; (void)bcnt; (void)rowtok; (void)rowgate; (void)statp; (void)WIN; (void)WO; (void)WGU; (void)WD; (void)WF; (void)HN; (void)Qb; (void)Kb; (void)KT; (void)VT; (void)PC; \
    (void)Yb; (void)YG; (void)ACTD; (void)Z2; (void)WSEQ; (void)ACTM; (void)WMGU; (void)WMD;
#define GRID_BAR() do { const __attribute__((address_space(4))) Args* kb = (const __attribute__((address_space(4))) Args*)__builtin_amdgcn_kernarg_segment_ptr(); asm volatile("" : "+s"(kb)); GAS unsigned char* wsb = (GAS unsigned char*)kb->ws; XcdBarrier bar_; bar_.bar = (unsigned*)(wsb + WS_CTL) + CW_BAR; bar_.x = xb_xcc_id(); \
    bar_.st = (volatile LAS unsigned*)(lds + MISC_OFF) + 8; xcd_barrier(bar_, tid_of(wave_k) == 0); } while (0)

    {
        PHASE_VARS
        for (int u = tid; u < (LDS_BYTES - LDSCTL_OFF) / 4; u += NWAVES * 64) ((LAS unsigned*)(lds + LDSCTL_OFF))[u] = 0u;
        __syncthreads();
        if (tid < 8) { const float xl = ret_decay[tid]; const float ls = fminf(xl, 0.f) - log1pf(expf(-fabsf(xl))); l2g[tid] = ls * 1.44269504088896341f; }
        __syncthreads();
        (void)xcd_barrier_post((unsigned*)(ws + WS_CTL) + CW_BAR, (volatile LAS unsigned*)(lds + MISC_OFF) + 8, tid == 0);
    }

    if (PH(0)) {
        PHASE_VARS
        LAS float* scr = (LAS float*)(lds + wave * 16384);
        constexpr int I_IN = (D / 64) * (INW / 32), I_O = (VW / 64) * (D / 32), I_GU = 2 * (D / 64) * (FFD / 32), I_D = (FFD / 64) * (D / 32), I_F = (D / 64) * (D / 32);
        constexpr int NITEMS = I_IN + I_O + I_GU + I_D + I_F;
        for (int it = gw; it < NITEMS; it += NGW) {
            int r = it;
            if (r < I_IN) { tr_plain(ret_w_in, D, INW, WIN, r, scr, lane); continue; } r -= I_IN;
            if (r < I_O) { tr_plain(ret_w_out, VW, D, WO, r, scr, lane); continue; } r -= I_O;
            if (r < I_GU) { tr_gu(d_wg, d_wu, D, FFD, WGU, r, scr, lane, ffn_norm); continue; } r -= I_GU;
            if (r < I_D) { tr_plain(d_wd, FFD, D, WD, r, scr, lane); continue; } r -= I_D;
            tr_plain(fnet_w, D, D, WF, r, scr, lane);
        }
        for (int e = (vcu * 512 + tid); e < SEQ * 128; e += G * 512) { const int s = e >> 7, i = e & 127;
            const float inv = powf(10000.0f, -(float)i / 128.0f); const float ang = (float)s * inv; float sn, cs; sincosf(ang, &sn, &cs);
            rot[e] = (f32x2){cs, sn}; rotT[(size_t)i * RTP + s] = (f32x2){cs, sn}; }
        for (int e = (vcu * 512 + tid); e < 4 * 512 * 256; e += G * 512) { const int g = e >> 17, r = (e >> 8) & 511, c = e & 255, mm = ((r & 255) * c) & 255;
            const float v = (r < 256 ? cospif((float)mm * (1.0f / 128.0f)) : -sinpif((float)mm * (1.0f / 128.0f))) * mix_norm[D + g * 256 + c]; WC[e] = (bf16)(cvt_pk_bf16(v, 0.f) & 0xffffu); }
        for (int e = vcu * 512 + tid; e < 512 * 1024; e += G * 512) { const int ka = e >> 10, c = e & 1023, a = c & 511, mm = (a * ka) & 511;
            const float v = (c < 512 ? cospif((float)mm * (1.0f / 256.0f)) : sinpif((float)mm * (1.0f / 256.0f))) * (1.0f / 1024.0f); WSEQ[e] = (bf16)(cvt_pk_bf16(v, 0.f) & 0xffffu); }
        for (int m = gw; m < T; m += NGW) { f32x4 v[4]; rms_row(x + (size_t)m * D, mix_norm, HN + (size_t)m * D, lane, v); }
    }
    GRID_BAR();

    if (PH(1) && PH(19)) {
        PHASE_VARS
        SchedPlain S{(const GAS char*)HN, (const GAS char*)WIN, (size_t)256 * D * 2, (size_t)256 * D * 2, T / 256, 8, G, bx};
        EpiRopeQK E{Qb, Kb, rot};
        pg8::gemm_phase<EpiRopeQK, SchedPlain, false>(lds, wave_k, D, D, D, S, E);
    }
    if (PH(1) && PH(20)) {
        PHASE_VARS
        SchedPlain S{(const GAS char*)(WIN + (size_t)QKW * D), (const GAS char*)HN, (size_t)256 * D * 2, (size_t)256 * D * 2, 4, T / 256, G, bx};
        EpiRopeKT E{KT, rotT, l2g};
        pg8::gemm_phase<EpiRopeKT, SchedPlain, false>(lds, wave_k, D, D, D, S, E);
    }
    if (PH(1) && PH(21)) {
        PHASE_VARS
        SchedPlain S{(const GAS char*)(WIN + (size_t)2 * QKW * D), (const GAS char*)HN, (size_t)256 * D * 2, (size_t)256 * D * 2, 8, T / 256, G, bx};
        EpiBf16<true> E{VT, T};
        pg8::gemm_phase<EpiBf16<true>, SchedPlain, false>(lds, wave_k, D, D, D, S, E);
    }
    GRID_BAR();

    if (PH(2)) {
        PHASE_VARS
        SchedPc S{(const GAS char*)Qb, (const GAS char*)Kb, G, bx};
        EpiPc E{PC, (GAS bf16*)(ws + WS_ROT), l2g};
        pg8::gemm_phase<EpiPc, SchedPc, false>(lds, wave_k, QKW, QKW, DK, S, E);
    }
    GRID_BAR();

    if (PH(3)) {
        PHASE_VARS
        for (int u = vcu; u < NB * NH * 8; u += G) { const int hh_ = (u >> 3) & 3; const float l2f = l2g[hh_], l2b = l2g[4 + hh_];
            sweep_unit(lds, Qb, KT, KT + (size_t)QKW * T, VT, PC, (const GAS bf16*)(ws + WS_ROT), (const GAS bf16*)(ws + WS_CTL + 512 * 1024), Yb, statp, l2f, l2b, u >> 5, hh_, u & 7, wave_k); }
    }
    GRID_BAR();

    if (PH(5)) {
        PHASE_VARS
        SchedPlain S{(const GAS char*)HN, (const GAS char*)(WIN + (size_t)(2 * QKW + VW) * D), (size_t)256 * D * 2, (size_t)256 * D * 2, T / 256, 8, G, bx};
        EpiGate E{Yb, YG, statp, gn_gain, (LAS f32x2*)(lds + 135168)};
        pg8::gemm_phase<EpiGate, SchedPlain, false>(lds, wave_k, D, D, D, S, E);
    }
    GRID_BAR();

    if (PH(6)) {
        PHASE_VARS
        SchedPlain S{(const GAS char*)YG, (const GAS char*)WO, (size_t)256 * VW * 2, (size_t)256 * VW * 2, T / 256, 4, G, bx};
        EpiRes<true> E{(const GAS void*)x, HB, SSQ1};
        pg8::gemm_phase<EpiRes<true>, SchedPlain, false>(lds, wave_k, VW, VW, VW, S, E);
    }
    GRID_BAR();

    if (PH(7)) {
        PHASE_VARS
        LAS float* scr = (LAS float*)(lds + wave * 16384);
        constexpr int I_GU = 2 * (D / 64) * (FFE / 32), I_D = (FFE / 64) * (D / 32);
        for (int it = gw; it < NE * (I_GU + I_D); it += NGW) {
            const int e = it / (I_GU + I_D); int r = it - e * (I_GU + I_D);
            if (r < I_GU) tr_gu8(m_wg + (size_t)e * D * FFE, m_wu + (size_t)e * D * FFE, D, FFE, WMGU8 + (size_t)e * 2 * FFE * D, r, scr, lane);
            else { const int it2 = r - I_GU, nblk = D / 32, kb = it2 / nblk, nb = it2 - kb * nblk; transpose_item8(m_wd + (size_t)e * FFE * D, FFE, D, (GAS unsigned char*)WMD + (size_t)e * D * FFE, 64 * kb, 32 * nb, 32 * nb, 64.0f, scr, lane); }
        }
    }
    __syncthreads();

    if (PH(8)) {
        PHASE_VARS
        SchedPlain S{(const GAS char*)HB, (const GAS char*)WGU, (size_t)256 * D * 2, (size_t)256 * D * 2, T / 256, 2 * FFD / 256, G, bx};
        EpiSwiGLU<false, true> E{(GAS void*)ACTD, FFD, SSQ1, (LAS float*)(lds + 135168)};
        pg8::gemm_phase<EpiSwiGLU<false, true>, SchedPlain, false>(lds, wave_k, D, D, D, S, E);
    }
    GRID_BAR();
    if (PH(9)) {
        PHASE_VARS
        SchedPlain S{(const GAS char*)ACTD, (const GAS char*)WD, (size_t)256 * FFD * 2, (size_t)256 * FFD * 2, T / 256, 4, G, bx};
        EpiRes<false> E{(const GAS void*)HB, HB, SSQ2};
        pg8::gemm_phase<EpiRes<false>, SchedPlain, false>(lds, wave_k, FFD, FFD, FFD, S, E);
    }
    GRID_BAR();

    if (PH(11)) {
        PHASE_VARS
        SchedFnA S{(const GAS char*)WC, (const GAS char*)HB, G, bx};
        EpiZ2 E{Z2, SSQ2, (LAS float*)(lds + 135168)};
        pg8::gemm_phase<EpiZ2, SchedFnA, false>(lds, wave_k, 256, D, 256, S, E);
    }
    GRID_BAR();
    if (PH(22)) {
        PHASE_VARS
        float wc0[8], ws0[8];
#pragma unroll
        for (int kb = 0; kb < 8; ++kb) { const float ang = (float)((8 * lane * kb) & 4095) * (1.0f / 2048.0f); wc0[kb] = cospif(ang); ws0[kb] = sinpif(ang); }
        for (int rw = gw; rw < NB * 1024; rw += NGW) {
            GAS bf16* row = Z2 + (size_t)rw * 8192;
#pragma unroll
            for (int hq = 0; hq < 2; ++hq) {
                u32x2 zin[2][8], zout[8][2];
#pragma unroll
                for (int ri = 0; ri < 2; ++ri)
#pragma unroll
                    for (int bb = 0; bb < 8; ++bb) zin[ri][bb] = *(const GAS u32x2*)(row + ri * 4096 + 512 * bb + 8 * lane + 4 * hq);
#pragma unroll
                for (int q = 0; q < 2; ++q) {
                    float outr[2][8], outi[2][8];
#pragma unroll
                    for (int tt = 0; tt < 2; ++tt) {
                        const int t = 4 * hq + 2 * q + tt;
                        float zr[8], zi[8];
#pragma unroll
                        for (int bb = 0; bb < 8; ++bb) { const unsigned wr_ = zin[0][bb][q], wi_ = zin[1][bb][q]; zr[bb] = tt ? bf_hi(wr_) : bf_lo(wr_); zi[bb] = tt ? bf_hi(wi_) : bf_lo(wi_); }
#pragma unroll
                        for (int kb = 0; kb < 8; ++kb) {
                            float ur = 0.f, ui = 0.f;
#pragma unroll
                            for (int bb = 0; bb < 8; ++bb) {
                                const int m8 = (bb * kb) & 7;
                                const float c8 = (m8 == 0) ? 1.f : (m8 == 4) ? -1.f : (m8 == 2 || m8 == 6) ? 0.f : (m8 == 1 || m8 == 7) ? 0.70710678118654752f : -0.70710678118654752f;
                                const float s8 = (m8 == 0 || m8 == 4) ? 0.f : (m8 == 2) ? 1.f : (m8 == 6) ? -1.f : (m8 == 1 || m8 == 3) ? 0.70710678118654752f : -0.70710678118654752f;
                                ur += c8 * zr[bb] + s8 * zi[bb]; ui += c8 * zi[bb] - s8 * zr[bb]; }
                            const int mt = (t * kb);
                            const float ct = __builtin_cosf((float)mt * 0.00153398078788564123f), st_ = __builtin_sinf((float)mt * 0.00153398078788564123f);
                            const float twc = wc0[kb] * ct - ws0[kb] * st_, tws = ws0[kb] * ct + wc0[kb] * st_;
                            outr[tt][kb] = ur * twc + ui * tws; outi[tt][kb] = ui * twc - ur * tws; }
                    }
#pragma unroll
                    for (int kb = 0; kb < 8; ++kb) { zout[kb][0][q] = cvt_pk_bf16(outr[0][kb], outr[1][kb]); zout[kb][1][q] = cvt_pk_bf16(outi[0][kb], outi[1][kb]); }
                    __builtin_amdgcn_sched_barrier(0);
                }
#pragma unroll
                for (int kb = 0; kb < 8; ++kb)
#pragma unroll
                    for (int ri = 0; ri < 2; ++ri) *(GAS u32x2*)(row + kb * 1024 + ri * 512 + 8 * lane + 4 * hq) = zout[kb][ri];
                __builtin_amdgcn_sched_barrier(0);
            }
        }
    }
    GRID_BAR();
    if (PH(12)) {
        PHASE_VARS
        SchedFnB S{(GAS const char*)WSEQ, (GAS const char*)Z2, G, bx};
        EpiYf E{HNB};
        pg8::gemm_phase<EpiYf, SchedFnB, false>(lds, wave_k, 1024, 1024, 1024, S, E);
    }
    GRID_BAR();
    if (PH(13)) {
        PHASE_VARS
        SchedPlain S{(const GAS char*)HNB, (const GAS char*)WF, (size_t)256 * D * 2, (size_t)256 * D * 2, T / 256, 4, G, bx};
        EpiRes<false> E{(const GAS void*)HB, HB, nullptr};
        pg8::gemm_phase<EpiRes<false>, SchedPlain, false>(lds, wave_k, D, D, D, S, E);
    }
    GRID_BAR();

    if (PH(14)) {
        PHASE_VARS
        LAS float* wrl = (LAS float*)lds;
        LAS int* le = (LAS int*)(lds + 32768);
        for (int i = tid; i < D * NE; i += NWAVES * 64) wrl[(i & 7) * D + (i >> 3)] = moe_router[i];
        for (int i = vcu * 512 + tid; i < 2 * MOE_ROWS; i += G * 512) rowtok[i] = -1;
        __syncthreads();
        for (int tb = vcu; tb < T / 128; tb += G) {
            for (int rr = 0; rr < 16; ++rr) { const int tl = wave * 16 + rr, m = tb * 128 + tl; f32x4 v[4];
                rms_row_b8(HB + (size_t)m * D, ffn_norm + D, HN8 + (size_t)m * D, lane, v);
                float lg[8];
#pragma unroll
                for (int e = 0; e < 8; ++e) lg[e] = 0.f;
#pragma unroll
                for (int j = 0; j < 4; ++j) { const int col0 = rmsb_col(j, lane);
#pragma unroll
                    for (int e = 0; e < 8; ++e) { const f32x4 wv = *(const LAS f32x4*)(wrl + e * D + col0); lg[e] += (v[j].x * wv.x + v[j].y * wv.y) + (v[j].z * wv.z + v[j].w * wv.w); } }
#pragma unroll
                for (int e = 0; e < 8; ++e) lg[e] = wave_sum(lg[e]);
                int e0 = 0; float b0 = lg[0];
#pragma unroll
                for (int e = 1; e < 8; ++e) if (lg[e] > b0) { b0 = lg[e]; e0 = e; }
                int e1 = -1; float b1 = -3.0e38f;
#pragma unroll
                for (int e = 0; e < 8; ++e) if (e != e0 && lg[e] > b1) { b1 = lg[e]; e1 = e; }
                const float w0 = 1.0f / (1.0f + __expf(b1 - b0));
                if (lane == 0) { toke[2 * m] = e0; toke[2 * m + 1] = e1; tokw[2 * m] = w0; tokw[2 * m + 1] = 1.0f - w0; le[tl] = e0; le[128 + tl] = e1; } }
            __syncthreads();
            if (tid < 16) { const int s = tid >> 3, e = tid & 7; int c = 0; for (int i = 0; i < 128; ++i) c += (le[s * 128 + i] == e) ? 1 : 0; bcnt[tb * 16 + tid] = c; }
            if (tid >= 64 && tid < 128) { const int pi = tid - 64; int c = 0; for (int i = 0; i < 128; ++i) c += (le[i] * 8 + le[128 + i] == pi) ? 1 : 0; pcnt[tb * 64 + pi] = c; }
            __syncthreads();
        }
    }
    GRID_BAR();

    LAS int* segoff = (LAS int*)(lds + 132096);
    LAS int* ntile = (LAS int*)(lds + 132096 + 64);
    LAS unsigned char* tile_e = (LAS unsigned char*)(lds + 132096 + 128);
    if (PH(15)) {
        PHASE_VARS
        LAS int* pfx = (LAS int*)lds;
        LAS int* cph = (LAS int*)(lds + 65792);
        LAS int* fq_ = (LAS int*)(lds + 65792 + 16384);
        LAS int* tot = fq_ + 64;
        LAS int* tpi = tot + 16;
        LAS int* tex = tpi + 128;
        for (int i = tid; i < 256 * 64; i += NWAVES * 64) pfx[i] = pcnt[i];
        __syncthreads();
        if (tid < 64) { int run = 0; for (int b2 = 0; b2 < 256; ++b2) { const int c = pfx[b2 * 64 + tid]; pfx[b2 * 64 + tid] = run; run += c; } pfx[256 * 64 + tid] = run; }
        __syncthreads();
        if (tid == 0) {
            int n0[8], d[8], r[8]; int rs = 0;
            for (int e = 0; e < 8; ++e) { int c = 0; for (int x2 = 0; x2 < 8; ++x2) c += pfx[256 * 64 + e * 8 + x2]; n0[e] = c; r[e] = c & 255; d[e] = -(c & 255); rs += c & 255; }
            int extra = rs >> 8;
            for (int k = 0; k < extra; ++k) { int be = -1, br = -1; for (int e = 0; e < 8; ++e) if (d[e] < 0 && d[e] == -r[e] && r[e] > br) { br = r[e]; be = e; } if (be >= 0) d[be] += 256; }
            for (int i = 0; i < 64; ++i) fq_[i] = 0;
            for (int a = 0; a < 8; ++a) for (int e = 0; e < 8; ++e) if (a != e && d[a] < 0 && d[e] > 0) { int fl = -d[a]; if (d[e] < fl) fl = d[e]; const int av = pfx[256 * 64 + a * 8 + e]; if (av < fl) fl = av; fq_[a * 8 + e] = fl; d[a] += fl; d[e] -= fl; }
        }
        __syncthreads();
        if (tid < 256) {
            int c0[8], c1[8];
#pragma unroll
            for (int e = 0; e < 8; ++e) { c0[e] = 0; c1[e] = 0; }
            for (int a = 0; a < 8; ++a) for (int e = 0; e < 8; ++e) { const int pi = a * 8 + e; const int cnt = pfx[(tid + 1) * 64 + pi] - pfx[tid * 64 + pi]; int fl = fq_[pi] - pfx[tid * 64 + pi]; fl = fl < 0 ? 0 : (fl > cnt ? cnt : fl);
#pragma unroll
                for (int q = 0; q < 8; ++q) { c0[q] += (q == a ? cnt - fl : 0) + (q == e ? fl : 0); c1[q] += (q == e ? cnt - fl : 0) + (q == a ? fl : 0); } }
#pragma unroll
            for (int e = 0; e < 8; ++e) { cph[tid * 16 + e] = c0[e]; cph[tid * 16 + 8 + e] = c1[e]; }
        }
        __syncthreads();
        if (tid < 16) { int run = 0; for (int b2 = 0; b2 < 256; ++b2) { const int c = cph[b2 * 16 + tid]; cph[b2 * 16 + tid] = run; run += c; } tot[tid] = run; }
        __syncthreads();
        if (tid < 2) { int off = 0, nt = 0; for (int e = 0; e < 8; ++e) { segoff[tid * 8 + e] = off; const int tl = (tot[tid * 8 + e] + 255) >> 8; for (int q = 0; q < tl; ++q) tile_e[tid * 160 + nt + q] = (unsigned char)e; nt += tl; off += tl * 256; } ntile[tid] = nt; }
        __syncthreads();
        for (int tb = vcu; tb < T / 128; tb += G) {
            int e0 = 0, e1 = 0, flip = 0;
            if (tid < 128) { const int m = tb * 128 + tid; e0 = toke[2 * m]; e1 = toke[2 * m + 1]; tpi[tid] = e0 * 8 + e1; }
            __syncthreads();
            if (tid < 128) { const int pi = e0 * 8 + e1; int rk = 0; for (int i = 0; i < tid; ++i) rk += (tpi[i] == pi) ? 1 : 0;
                flip = (pfx[tb * 64 + pi] + rk) < fq_[pi] ? 1 : 0; tex[tid] = flip ? e1 : e0; tex[128 + tid] = flip ? e0 : e1; }
            __syncthreads();
            if (tid < 128) { const int m = tb * 128 + tid;
#pragma unroll
                for (int ph = 0; ph < 2; ++ph) { const int e = tex[ph * 128 + tid]; int rk = 0; for (int i = 0; i < tid; ++i) rk += (tex[ph * 128 + i] == e) ? 1 : 0;
                    const int row = segoff[ph * 8 + e] + cph[tb * 16 + ph * 8 + e] + rk;
                    rowtok[ph * MOE_ROWS + row] = m; rowgate[ph * MOE_ROWS + row] = tokw[2 * m + (ph ^ flip)]; } }
            __syncthreads();
        }
    }
    GRID_BAR();

    if (PH(16))
#pragma unroll
    for (int s = 0; s < 2; ++s) {
        {
            PHASE_VARS
            SchedMoe S{(const GAS char*)HN8, (const GAS char*)WMGU8, rowtok + s * MOE_ROWS, tile_e + s * 160, 0, (size_t)2 * FFE * D, (size_t)256 * D, ntile[s], 2 * FFE / 256, G, bx, true, 0x7f7f7f7f};
            EpiSwiGLU<true> E{(GAS void*)ACTM, FFE};
            pg8::gemm_phase<EpiSwiGLU<true>, SchedMoe, true, true>(lds, wave_k, D, D, D, S, E);
        }
        GRID_BAR();
        {
            PHASE_VARS
            SchedMoe S{(const GAS char*)ACTM, (const GAS char*)WMD, rowtok + s * MOE_ROWS, tile_e + s * 160, (size_t)256 * FFE, (size_t)D * FFE, (size_t)256 * FFE, ntile[s], 4, G, bx, false, 0x7c7c7c7c};
            EpiMoeDown E{HB, rowtok + s * MOE_ROWS, rowgate + s * MOE_ROWS};
            pg8::gemm_phase<EpiMoeDown, SchedMoe, false, true>(lds, wave_k, FFE, FFE, FFE, S, E);
        }
        GRID_BAR();
    }

    if (PH(17)) {
        PHASE_VARS
        const bool bad = __hip_atomic_load((GAS unsigned*)(ws + WS_CTL) + CW_BAR + XB_TMO, RLX_AGENT) != 0u;
        for (int m = gw; m < T; m += NGW) {
            const GAS bf16* hrow = HB + (size_t)m * D; GAS float* orow = hres + (size_t)m * D;
            f32x4 v[4]; float s = 0.f;
#pragma unroll
            for (int jh = 0; jh < 2; ++jh) { const u32x4 xx = *(const GAS u32x4*)(hrow + 512 * jh + 8 * lane);
                v[2 * jh] = (f32x4){bf_lo(xx.x), bf_hi(xx.x), bf_lo(xx.y), bf_hi(xx.y)}; v[2 * jh + 1] = (f32x4){bf_lo(xx.z), bf_hi(xx.z), bf_lo(xx.w), bf_hi(xx.w)}; }
#pragma unroll
            for (int j = 0; j < 4; ++j) s += (v[j].x * v[j].x + v[j].y * v[j].y) + (v[j].z * v[j].z + v[j].w * v[j].w);
            const float r = bad ? __builtin_nanf("") : 1.0f / sqrtf(wave_sum(s) * (1.f / D) + EPS);
#pragma unroll
            for (int j = 0; j < 4; ++j) { const int col = rmsb_col(j, lane); *(GAS f32x4*)(orow + col) = v[j] * r * *(const GAS f32x4*)(final_norm + col); }
        }
    }
}

extern "C" void kernel_launch(void* const* d_in, const int* in_sizes, int n_in, void* d_out, int out_size, void* d_ws, size_t ws_size, hipStream_t stream) {
    static int grid = 0;
    if (grid == 0) {
        if (n_in != 16 || in_sizes[0] != T * D || out_size != T * D || ws_size < WS_END) { fprintf(stderr, "kernel_launch: unexpected shapes (n_in %d, in0 %d, out %d, ws %zu)\n", n_in, n_in > 0 ? in_sizes[0] : -1, out_size, ws_size); grid = -1; return; }
        int dev = 0, cus = 0, per_cu = 0;
        if (hipGetDevice(&dev) != hipSuccess || hipDeviceGetAttribute(&cus, hipDeviceAttributeMultiprocessorCount, dev) != hipSuccess) { grid = -1; return; }
        if (hipFuncSetAttribute((const void*)fwd_kernel, hipFuncAttributeMaxDynamicSharedMemorySize, LDS_BYTES) != hipSuccess) { fprintf(stderr, "kernel_launch: hipFuncSetAttribute failed\n"); grid = -1; return; }
        if (hipOccupancyMaxActiveBlocksPerMultiprocessor(&per_cu, (const void*)fwd_kernel, NWAVES * 64, LDS_BYTES) != hipSuccess || per_cu < 1) { fprintf(stderr, "kernel_launch: occupancy query says %d\n", per_cu); }
        (void)hipGetLastError();
        grid = cus;
    }
    if (grid < 0) return;
    if (hipMemsetAsync((char*)d_ws + WS_CTL, 0, CTL_ZERO_BYTES, stream) != hipSuccess) return;
    Args a{};
    for (int i = 0; i < 16; ++i) a.in[i] = (const float*)d_in[i];
    a.out = (float*)d_out; a.ws = (unsigned char*)d_ws;
    hipLaunchKernelGGL(fwd_kernel, dim3(grid), dim3(NWAVES * 64), LDS_BYTES, stream, a);
}
```

```cpp
#include <hip/hip_runtime.h>
#include <cstdio>
#include <cstdint>

#define LAS __attribute__((address_space(3)))
#define GAS __attribute__((address_space(1)))
typedef unsigned short bf16;
typedef short bf16x8 __attribute__((ext_vector_type(8)));
typedef float f32x2 __attribute__((ext_vector_type(2)));
typedef float f32x4 __attribute__((ext_vector_type(4)));
typedef float f32x16 __attribute__((ext_vector_type(16)));
typedef unsigned u32x2 __attribute__((ext_vector_type(2)));
typedef unsigned u32x4 __attribute__((ext_vector_type(4)));
typedef GAS unsigned gu32;

constexpr int D = 1024, NB = 8, SEQ = 4096, T = NB * SEQ;
constexpr int NH = 4, DK = 256, DV = 512, QKW = 1024, VW = 2048, INW = 6144, CH = 128, NCH = SEQ / CH;
constexpr int FFD = 2816, NE = 8, FFE = 3584;
constexpr int MOE_ROWS = T + NE * 256;
constexpr float EPS = 1e-6f;

constexpr size_t MiB = 1u << 20;
constexpr size_t WS_CTL = 0, CTL_ZERO_BYTES = 1 * MiB;
constexpr size_t WS_ROT = 1 * MiB, WS_ROTT = 5 * MiB, WS_WC = 10 * MiB + 768 * 1024;
constexpr int RTP = SEQ + 64;
constexpr size_t WS_TOKE = 9 * MiB + 256 * 1024;
constexpr size_t WS_TOKW = WS_TOKE + 256 * 1024;
constexpr size_t WS_BCNT = WS_TOKW + 256 * 1024;
constexpr size_t WS_ROWTOK = WS_BCNT + 16 * 1024;
constexpr size_t WS_ROWGATE = WS_ROWTOK + 2 * MOE_ROWS * 4;
constexpr size_t WS_PCNT = 10 * MiB + 512 * 1024;
constexpr size_t WS_STATS = 11 * MiB;
constexpr size_t WS_SSQ1 = 1 * MiB, WS_SSQ2 = 3 * MiB;
static_assert(WS_ROWGATE + 2 * MOE_ROWS * 4 <= WS_PCNT, "small tables");
constexpr size_t WS_WIN = 12 * MiB, WS_WO = 24 * MiB, WS_WGU = 28 * MiB, WS_WD = 39 * MiB, WS_WF = 44 * MiB + 512 * 1024;
constexpr size_t WS_HN = 48 * MiB;
constexpr size_t WS_Q = 112 * MiB, WS_K = 176 * MiB, WS_KT = 240 * MiB  , WS_VT = 368 * MiB, WS_PC = 496 * MiB;
constexpr size_t WS_YG = 240 * MiB;
constexpr size_t WS_STATP = 176 * MiB;
constexpr size_t WS_ACTD = 112 * MiB;
constexpr size_t WS_Z2 = 112 * MiB, WS_WSEQ = 46 * MiB + 512 * 1024;
constexpr size_t WS_ACTM = 112 * MiB;
constexpr size_t WS_WMGU = 352 * MiB, WS_WMD = 464 * MiB, WS_END = 528 * MiB;
static_assert(WS_ACTM + (size_t)MOE_ROWS * FFE * 2 <= WS_WMGU, "moe act");
static_assert(WS_PC + (size_t)NB * NH * NCH * CH * CH * 2 <= 528 * MiB, "epoch A");
static_assert(WS_WF + (size_t)D * D * 2 <= WS_WSEQ && WS_WSEQ + 512 * 1024 * 2 <= WS_HN, "weights");
constexpr int CW_BAR = 4096;
constexpr int CW_CHK = 64;

constexpr int RING_BYTES = 131072;
constexpr int LDSCTL_OFF = 139264, MISC_OFF = LDSCTL_OFF + 320;
constexpr int LDS_BYTES = 147456;

#define LDS_WAIT() asm volatile("s_waitcnt lgkmcnt(0)" ::: "memory")
#define VM_WAIT() asm volatile("s_waitcnt vmcnt(0)" ::: "memory")
#define RLX_AGENT __ATOMIC_RELAXED, __HIP_MEMORY_SCOPE_AGENT

__device__ __forceinline__ unsigned cvt_pk_bf16(float lo, float hi) { unsigned r; asm volatile("v_cvt_pk_bf16_f32 %0, %1, %2" : "=v"(r) : "v"(lo), "v"(hi)); return r; }
__device__ __forceinline__ unsigned pk4_fp8(float a, float b, float c, float d) { int w = 0; w = __builtin_amdgcn_cvt_pk_fp8_f32(a, b, w, false); w = __builtin_amdgcn_cvt_pk_fp8_f32(c, d, w, true); return (unsigned)w; }
__device__ __forceinline__ float bf_lo(unsigned w) { return __uint_as_float(w << 16); }
__device__ __forceinline__ float bf_hi(unsigned w) { return __uint_as_float(w & 0xffff0000u); }
__device__ __forceinline__ float fast_exp2(float x) { return __builtin_amdgcn_exp2f(x); }
__device__ __forceinline__ int lane_id_v() { int l; asm volatile("v_mbcnt_lo_u32_b32 %0, -1, 0\n\tv_mbcnt_hi_u32_b32 %0, -1, %0" : "=v"(l)); return l; }
__device__ __forceinline__ int tid_of(int wave_s) { asm volatile("" : "+s"(wave_s)); return wave_s * 64 + lane_id_v(); }
__device__ __forceinline__ int rot_col(int row, int tok) { return (tok + ((row & 15) << 11)) & (32768 - 1); }
__device__ __forceinline__ float silu_f(float v) { return v * __builtin_amdgcn_rcpf(1.0f + __builtin_amdgcn_exp2f(v * -1.44269504088896341f)); }

namespace pg8 {
constexpr int BM = 256, BK = 64, HALF = 128, HTB = HALF * BK * 2, STAGE_BYTES = 8 * HTB, NXCD = 8, WGM = 2;
__host__ __device__ __forceinline__ int lds_byte(int r, int c) { const int st = (r >> 4) * 2 + (c >> 5), rr = r & 15, cc = c & 31, ob = rr * 64 + cc * 2; return st * 1024 + (ob ^ (((ob >> 9) & 1) << 5)); }
__host__ __device__ __forceinline__ void stage_rc(int b, int& R, int& C) { const int st = b / 1024, sb = b % 1024, swz = sb ^ (((sb >> 9) & 1) << 5); R = (st >> 1) * 16 + swz / 64; C = (st & 1) * 32 + (swz % 64) / 2; }
__host__ __device__ __forceinline__ int perm32(int rho) { const int n = rho >> 4, i = rho & 15; return 8 * (i >> 2) + 4 * n + (i & 3); }

struct Unit { const GAS char* A; const GAS char* B; const GAS int* rows; int pm, pn, z; };

__device__ __forceinline__ bool tile_of(long L, int nM, int nN, int& pm, int& pn) {
    const int nwg = nM * nN; if (L >= nwg) return false;
    int wgid = (int)L; { const int q = nwg / NXCD, r = nwg % NXCD, xcd = wgid % NXCD, off = wgid / NXCD; wgid = (xcd < r ? xcd * (q + 1) : r * (q + 1) + (xcd - r) * q) + off; }
    const int nig = WGM * nN, gid = wgid / nig, fm = gid * WGM, gsz = (nM - fm) < WGM ? (nM - fm) : WGM;
    pm = fm + ((wgid % nig) % gsz); pn = (wgid % nig) / gsz; return true;
}

template <class Epi, class Sched, bool GATHER, bool FP8 = false>
__device__ __forceinline__ void gemm_phase(LAS unsigned char* lds, const int wave_s, const int lda, const int ldb, const int K, const Sched& S, const Epi& E) {
    const int tid = tid_of(wave_s);
    const int wid = __builtin_amdgcn_readfirstlane(tid >> 6), lane = tid & 63, wr = wid >> 2, wc = wid & 3, fr = lane & 15, fq = lane >> 4;
    constexpr int ES = FP8 ? 1 : 2;
    const int nt = K * ES / (BK * 2);
    unsigned vA[2][2], vAn[2][2], voffB[2];
#pragma unroll
    for (int i = 0; i < 2; ++i) { int R, C; stage_rc(tid * 16 + i * 8192, R, C); const int Rb = Epi::PERM ? ((R & ~31) + perm32(R & 31)) : R;
        voffB[i] = (unsigned)(S.brow(Rb) * ldb * ES + C * 2);
#pragma unroll
        for (int h = 0; h < 2; ++h) { vA[h][i] = (unsigned)((h * HALF + R) * lda * ES + C * 2); vAn[h][i] = vA[h][i]; } }
    const size_t kstep = (size_t)(BK * 2);
    const size_t hstepB = (size_t)(S.brow(HALF) - S.brow(0)) * ldb * ES;
    const unsigned ldsw = (unsigned)wid * 1024u;
    const int aoff = lds_byte(wr * 64 + fr, fq * 8), boff = lds_byte(wc * 32 + fr, fq * 8);
    typedef int v4i_ __attribute__((ext_vector_type(4))); typedef int v8i_ __attribute__((ext_vector_type(8)));
    const int sc_w8 = S.scale_b8(), sc_a8 = S.scale_a8(); (void)sc_w8; (void)sc_a8;
#define PG8_SA(b, h) (((b) * 2 + (h)) * HTB)
#define PG8_SB(b, h) ((4 + (b) * 2 + (h)) * HTB)
#define PG8_STAGE_B(bufoff, gbase) do { _Pragma("unroll") for (int _i = 0; _i < 2; ++_i) \
        __builtin_amdgcn_global_load_lds((const GAS unsigned*)((const GAS char*)(gbase) + voffB[_i]), (LAS unsigned*)(lds + (bufoff) + ldsw + _i * 8192), 16, 0, 0); } while (0)
#define PG8_STAGE_A(bufoff, gbase, v0, v1) do { \
        __builtin_amdgcn_global_load_lds((const GAS unsigned*)((const GAS char*)(gbase) + (v0)), (LAS unsigned*)(lds + (bufoff) + ldsw), 16, 0, 0); \
        __builtin_amdgcn_global_load_lds((const GAS unsigned*)((const GAS char*)(gbase) + (v1)), (LAS unsigned*)(lds + (bufoff) + ldsw + 8192), 16, 0, 0); } while (0)
#define PG8_LD32(addr) __builtin_shufflevector(*(const LAS v4i_*)(addr), *(const LAS v4i_*)((addr) + 1024), 0, 1, 2, 3, 4, 5, 6, 7)
#define PG8_LDA(dst, b, h) do { _Pragma("unroll") for (int m = 0; m < 4; ++m) { if constexpr (FP8) dst##8[m] = PG8_LD32(lds + PG8_SA(b, h) + aoff + m * 2048); else { _Pragma("unroll") for (int k = 0; k < 2; ++k) dst[m][k] = *(const LAS bf16x8*)(lds + PG8_SA(b, h) + aoff + m * 2048 + k * 1024); } } } while (0)
#define PG8_LDB(dst, b, h) do { _Pragma("unroll") for (int n = 0; n < 2; ++n) { if constexpr (FP8) dst##8[n] = PG8_LD32(lds + PG8_SB(b, h) + boff + n * 2048); else { _Pragma("unroll") for (int k = 0; k < 2; ++k) dst[n][k] = *(const LAS bf16x8*)(lds + PG8_SB(b, h) + boff + n * 2048 + k * 1024); } } } while (0)
#define PG8_MMA(ai, bj, At, Bt) do { __builtin_amdgcn_s_setprio(1); _Pragma("unroll") for (int m = 0; m < 4; ++m) _Pragma("unroll") for (int n = 0; n < 2; ++n) { \
        if constexpr (FP8) asm volatile("v_mfma_scale_f32_16x16x128_f8f6f4 %0, %1, %2, %0, %3, %4 op_sel_hi:[0,0,0]" : "+v"(acc[ai][bj][m][n]) : "v"(Bt##8[n]), "v"(At##8[m]), "v"(sc_w8), "v"(sc_a8)); \
        else { _Pragma("unroll") for (int k = 0; k < 2; ++k) acc[ai][bj][m][n] = __builtin_amdgcn_mfma_f32_16x16x32_bf16(Bt[n][k], At[m][k], acc[ai][bj][m][n], 0, 0, 0); } } \
        __builtin_amdgcn_s_setprio(0); } while (0)
#define PG8_WAIT_V(n) asm volatile("s_waitcnt vmcnt(" #n ")" ::: "memory")
#define PG8_WAIT_L(n) asm volatile("s_waitcnt lgkmcnt(" #n ")" ::: "memory")
#define PG8_BAR __builtin_amdgcn_s_barrier()
#define PG8_SCHED __builtin_amdgcn_sched_barrier(0)
#define PG8_LOADROWS(dst, u) do { if constexpr (GATHER) { const int _tz = tid_of(wave_s); _Pragma("unroll") for (int _i = 0; _i < 2; ++_i) { int _R, _C; stage_rc(_tz * 16 + _i * 8192, _R, _C); \
        _Pragma("unroll") for (int _h = 0; _h < 2; ++_h) { const int _t = (u).rows[_h * HALF + _R]; dst[_h][_i] = (unsigned)((_t < 0 ? 0 : _t) * lda * ES + _C * 2); } } } } while (0)
#define PG8_VAN(h, i) (GATHER ? vAn[h][i] : vA[h][i])
    Unit cur, nxt; int ui = 0;
    if (!S.next(0, cur)) return;
    f32x4 acc[2][2][4][2];
#pragma unroll
    for (int a = 0; a < 2; ++a)
#pragma unroll
        for (int b = 0; b < 2; ++b)
#pragma unroll
            for (int m = 0; m < 4; ++m)
#pragma unroll
                for (int n = 0; n < 2; ++n) acc[a][b][m][n] = (f32x4){0.f, 0.f, 0.f, 0.f};
    bf16x8 At[4][2], B0[2][2], B1[2][2]; v8i_ At8[4], B08[2], B18[2]; (void)At; (void)B0; (void)B1; (void)At8; (void)B08; (void)B18;
    const GAS char* cA = cur.A; const GAS char* cB = cur.B;
    PG8_LOADROWS(vA, cur);
    if constexpr (GATHER) { vAn[0][0] = vA[0][0]; vAn[0][1] = vA[0][1]; vAn[1][0] = vA[1][0]; vAn[1][1] = vA[1][1]; }
    PG8_STAGE_B(PG8_SB(0, 0), cB); PG8_STAGE_B(PG8_SB(0, 1), cB + hstepB); PG8_STAGE_A(PG8_SA(0, 0), cA, vA[0][0], vA[0][1]); PG8_STAGE_A(PG8_SA(0, 1), cA, vA[1][0], vA[1][1]);
    if (wr == 1) PG8_BAR;
    PG8_WAIT_V(2); PG8_BAR;
    PG8_STAGE_B(PG8_SB(1, 0), cB + kstep); PG8_STAGE_A(PG8_SA(1, 0), cA + kstep, vA[0][0], vA[0][1]); PG8_STAGE_B(PG8_SB(1, 1), cB + hstepB + kstep);
    PG8_WAIT_V(6); PG8_BAR;
    for (;;) {
        const bool has_next = S.next(ui + 1, nxt);
        const GAS char* nA = has_next ? nxt.A : cA; const GAS char* nB = has_next ? nxt.B : cB;
#pragma unroll 1
        for (int t = 0; t < nt; t += 2) {
            const bool last = (t == nt - 2);
            const GAS char* a1 = cA + (size_t)(t + 1) * kstep;
            const GAS char* a2 = last ? nA : cA + (size_t)(t + 2) * kstep; const GAS char* b2 = last ? nB : cB + (size_t)(t + 2) * kstep;
            const GAS char* a3 = a2 + kstep; const GAS char* b3 = b2 + kstep;
            if constexpr (GATHER) { if (last && has_next) { PG8_LOADROWS(vAn, nxt); } }
            PG8_LDB(B0, 0, 0); PG8_LDB(B1, 0, 1); PG8_SCHED; PG8_LDA(At, 0, 0); PG8_STAGE_A(PG8_SA(1, 1), a1, vA[1][0], vA[1][1]);
            PG8_WAIT_V(8); PG8_WAIT_L(0); PG8_BAR; PG8_MMA(0, 0, At, B0); PG8_MMA(0, 1, At, B1); PG8_BAR; PG8_SCHED;
            PG8_LDA(At, 0, 1); PG8_STAGE_B(PG8_SB(0, 0), b2); PG8_STAGE_B(PG8_SB(0, 1), b2 + hstepB); PG8_STAGE_A(PG8_SA(0, 0), a2, PG8_VAN(0, 0), PG8_VAN(0, 1));
            PG8_WAIT_V(8); PG8_WAIT_L(0); PG8_BAR; PG8_MMA(1, 0, At, B0); PG8_MMA(1, 1, At, B1); PG8_BAR; PG8_SCHED;
            PG8_LDB(B0, 1, 0); PG8_LDB(B1, 1, 1); PG8_SCHED; PG8_LDA(At, 1, 0); PG8_STAGE_A(PG8_SA(0, 1), a2, PG8_VAN(1, 0), PG8_VAN(1, 1));
            PG8_WAIT_V(8); PG8_WAIT_L(0); PG8_BAR; PG8_MMA(0, 0, At, B0); PG8_MMA(0, 1, At, B1); PG8_BAR; PG8_SCHED;
            PG8_LDA(At, 1, 1); PG8_STAGE_B(PG8_SB(1, 0), b3); PG8_STAGE_B(PG8_SB(1, 1), b3 + hstepB); PG8_STAGE_A(PG8_SA(1, 0), a3, PG8_VAN(0, 0), PG8_VAN(0, 1));
            PG8_WAIT_V(8); PG8_WAIT_L(0); PG8_BAR; PG8_MMA(1, 0, At, B0); PG8_MMA(1, 1, At, B1); PG8_BAR; PG8_SCHED;
        }
        if (wr == 0) PG8_BAR;
        if constexpr (FP8) asm volatile("s_nop 15\n\ts_nop 15" ::: "memory");
        E(acc, cur, wr, wc, fr, fq);
        if (!has_next) break;
#pragma unroll
        for (int a = 0; a < 2; ++a)
#pragma unroll
            for (int b = 0; b < 2; ++b)
#pragma unroll
                for (int m = 0; m < 4; ++m)
#pragma unroll
                    for (int n = 0; n < 2; ++n) acc[a][b][m][n] = (f32x4){0.f, 0.f, 0.f, 0.f};
        cur = nxt; cA = nA; cB = nB; ++ui;
        if constexpr (GATHER) { vA[0][0] = vAn[0][0]; vA[0][1] = vAn[0][1]; vA[1][0] = vAn[1][0]; vA[1][1] = vAn[1][1]; }
        if (wr == 1) PG8_BAR;
    }
    PG8_WAIT_V(0);
    PG8_BAR;
#undef PG8_SA
#undef PG8_SB
#undef PG8_STAGE_A
#undef PG8_STAGE_B
#undef PG8_LDA
#undef PG8_LD32
#undef PG8_LDB
#undef PG8_MMA
#undef PG8_WAIT_V
#undef PG8_WAIT_L
#undef PG8_BAR
#undef PG8_SCHED
#undef PG8_LOADROWS
#undef PG8_VAN
}
}

struct SchedPlain {
    __device__ __forceinline__ int scale_b8() const { return 0x7f7f7f7f; }
    __device__ __forceinline__ int scale_a8() const { return 0x7f7f7f7f; }
    __device__ __forceinline__ int brow(int r) const { return r; }
    const GAS char* A; const GAS char* B; size_t a_tile, b_tile; int nM, nN, G, c;
    __device__ __forceinline__ bool next(int i, pg8::Unit& u) const {
        int pm, pn; if (!pg8::tile_of((long)i * G + c, nM, nN, pm, pn)) return false;
        u.pm = pm; u.pn = pn; u.z = 0; u.rows = nullptr; u.A = A + (size_t)pm * a_tile; u.B = B + (size_t)pn * b_tile; return true; }
};
struct SchedPc {
    __device__ __forceinline__ int scale_b8() const { return 0x7f7f7f7f; }
    __device__ __forceinline__ int scale_a8() const { return 0x7f7f7f7f; }
    __device__ __forceinline__ int brow(int r) const { return r; }
    const GAS char* Q; const GAS char* Kk; int G, c;
    __device__ __forceinline__ bool next(int i, pg8::Unit& u) const {
        const int L = i * G + c; if (L >= NB * NH * 16) return false;
        const int cp = L & 15, h = (L >> 4) & 3, b = L >> 6;
        const size_t off = ((size_t)(b * SEQ + cp * 256) * QKW + h * DK) * 2;
        u.pm = L; u.pn = 0; u.z = h; u.rows = nullptr; u.A = Q + off; u.B = Kk + off; return true; }
};
struct SchedFnA {
    __device__ __forceinline__ int scale_b8() const { return 0x7f7f7f7f; }
    __device__ __forceinline__ int scale_a8() const { return 0x7f7f7f7f; }
    __device__ __forceinline__ int brow(int r) const { return r; }
    const GAS char* Wc; const GAS char* Hn; int G, c;
    __device__ __forceinline__ bool next(int i, pg8::Unit& u) const {
        int pm, pn; if (!pg8::tile_of((long)i * G + c, 8, T / 256, pm, pn)) return false;
        const int g = pm >> 1, ri = pm & 1;
        u.pm = pm; u.pn = pn; u.z = 0; u.rows = nullptr; u.A = Wc + (size_t)(g * 512 + ri * 256) * 256 * 2; u.B = Hn + ((size_t)pn * 256 * D + g * 256) * 2; return true; }
};
struct SchedFnB {
    __device__ __forceinline__ int scale_b8() const { return 0x7f7f7f7f; }
    __device__ __forceinline__ int scale_a8() const { return 0x7f7f7f7f; }
    __device__ __forceinline__ int brow(int r) const { return (r & 63) * 8 + (r >> 6); }
    GAS const char* WY; GAS const char* U; int G, c;
    __device__ __forceinline__ bool next(int i, pg8::Unit& u) const {
        int pm, pn; if (!pg8::tile_of((long)i * G + c, 2, 256, pm, pn)) return false;
        const int batch = pn >> 5, fb = (pn >> 1) & 15, kbb = pn & 1;
        u.pm = pm; u.pn = pn; u.z = 0; u.rows = nullptr; u.A = WY + (size_t)pm * 256 * 1024 * 2; u.B = U + ((size_t)(batch * 1024 + fb * 64) * 8 + kbb * 4) * 1024 * 2; return true; }
};
struct SchedMoe {
    __device__ __forceinline__ int scale_b8() const { return 0x79797979; }
    __device__ __forceinline__ int scale_a8() const { return sa8; }
    __device__ __forceinline__ int brow(int r) const { return r; }
    const GAS char* A; const GAS char* W; const GAS int* rowtok; const LAS unsigned char* texp; size_t a_tile, w_exp, w_tile; int ntiles, ncol, G, c; bool gather; int sa8;
    __device__ __forceinline__ bool next(int i, pg8::Unit& u) const {
        int rt, ct; if (!pg8::tile_of((long)i * G + c, ntiles, ncol, rt, ct)) return false;
        const int e = texp[rt];
        u.pm = rt; u.pn = ct; u.z = e; u.rows = rowtok + rt * 256; u.A = gather ? A : A + (size_t)rt * a_tile; u.B = W + (size_t)e * w_exp + (size_t)ct * w_tile; return true; }
};

struct EpiRopeQK {
    static constexpr bool PERM = true;
    GAS bf16* Q; GAS bf16* Kk; const GAS f32x2* rot;
    __device__ __forceinline__ void operator()(const f32x4 (&acc)[2][2][4][2], const pg8::Unit& u, int wr, int wc, int fr, int fq) const {
        const bool isk = u.pn >= 4; const int h = u.pn & 3; GAS bf16* dst = isk ? Kk : Q; const float sc = isk ? 0.0625f : 1.0f;
        const int i0 = wc * 32 + 8 * fq;
#pragma unroll
        for (int ai = 0; ai < 2; ++ai)
#pragma unroll
            for (int m = 0; m < 4; ++m) {
                const int t = u.pm * 256 + ai * 128 + wr * 64 + m * 16 + fr, s = t & (SEQ - 1);
                const GAS f32x4* rp = (const GAS f32x4*)(rot + (size_t)s * 128 + i0);
                const f32x4 r0 = rp[0], r1 = rp[1], r2 = rp[2], r3 = rp[3];
                const float cs[8] = {r0[0], r0[2], r1[0], r1[2], r2[0], r2[2], r3[0], r3[2]}, sn[8] = {r0[1], r0[3], r1[1], r1[3], r2[1], r2[3], r3[1], r3[3]};
                float o1[8], o2[8];
#pragma unroll
                for (int n = 0; n < 2; ++n)
#pragma unroll
                    for (int j = 0; j < 4; ++j) { const float t1 = acc[ai][0][m][n][j], t2 = acc[ai][1][m][n][j]; const int q = 4 * n + j;
                        o1[q] = (t1 * cs[q] - t2 * sn[q]) * sc; o2[q] = (t1 * sn[q] + t2 * cs[q]) * sc; }
                GAS bf16* rowp = dst + (size_t)t * QKW + h * DK + i0;
                u32x4 w1, w2; w1.x = cvt_pk_bf16(o1[0], o1[1]); w1.y = cvt_pk_bf16(o1[2], o1[3]); w1.z = cvt_pk_bf16(o1[4], o1[5]); w1.w = cvt_pk_bf16(o1[6], o1[7]);
                w2.x = cvt_pk_bf16(o2[0], o2[1]); w2.y = cvt_pk_bf16(o2[2], o2[3]); w2.z = cvt_pk_bf16(o2[4], o2[5]); w2.w = cvt_pk_bf16(o2[6], o2[7]);
                *(GAS u32x4*)rowp = w1; *(GAS u32x4*)(rowp + 128) = w2; }
    }
};
struct EpiRopeKT {
    static constexpr bool PERM = true;
    GAS bf16* KT; const GAS f32x2* rotT; const LAS float* l2g;
    __device__ __forceinline__ void operator()(const f32x4 (&acc)[2][2][4][2], const pg8::Unit& u, int wr, int wc, int fr, int fq) const {
        const int h = u.pm; const float l2f = l2g[h], l2b = l2g[4 + h];
#pragma unroll
        for (int bj = 0; bj < 2; ++bj) {
            const int tok0 = u.pn * 256 + bj * 128 + wc * 32 + 8 * fq, s0 = tok0 & (SEQ - 1), j0 = tok0 & (CH - 1);
            float zf[8], zb[8];
#pragma unroll
            for (int q = 0; q < 8; ++q) { zf[q] = fast_exp2((float)(CH - 1 - (j0 + q)) * l2f) * 0.0625f; zb[q] = fast_exp2((float)(j0 + q) * l2b) * 0.0625f; }
#pragma unroll
            for (int m = 0; m < 4; ++m) { const int i = wr * 64 + m * 16 + fr;
                const GAS f32x4* rp = (const GAS f32x4*)(rotT + (size_t)i * RTP + s0);
                const f32x4 r0 = rp[0], r1 = rp[1], r2 = rp[2], r3 = rp[3];
                const float cs[8] = {r0[0], r0[2], r1[0], r1[2], r2[0], r2[2], r3[0], r3[2]}, sn[8] = {r0[1], r0[3], r1[1], r1[3], r2[1], r2[3], r3[1], r3[3]};
                float o1[8], o2[8];
#pragma unroll
                for (int n = 0; n < 2; ++n)
#pragma unroll
                    for (int j = 0; j < 4; ++j) { const float t1 = acc[0][bj][m][n][j], t2 = acc[1][bj][m][n][j]; const int q = 4 * n + j;
                        o1[q] = t1 * cs[q] - t2 * sn[q]; o2[q] = t1 * sn[q] + t2 * cs[q]; }
                u32x4 w1, w2;
                w1.x = cvt_pk_bf16(o1[0] * zf[0], o1[1] * zf[1]); w1.y = cvt_pk_bf16(o1[2] * zf[2], o1[3] * zf[3]); w1.z = cvt_pk_bf16(o1[4] * zf[4], o1[5] * zf[5]); w1.w = cvt_pk_bf16(o1[6] * zf[6], o1[7] * zf[7]);
                w2.x = cvt_pk_bf16(o2[0] * zf[0], o2[1] * zf[1]); w2.y = cvt_pk_bf16(o2[2] * zf[2], o2[3] * zf[3]); w2.z = cvt_pk_bf16(o2[4] * zf[4], o2[5] * zf[5]); w2.w = cvt_pk_bf16(o2[6] * zf[6], o2[7] * zf[7]);
                const size_t fr0 = ((((size_t)((tok0 >> 12) * NH + h) * NCH + ((tok0 & (SEQ - 1)) >> 7)) * 8 + (i >> 5)) * 8 + (2 * wc + (fq >> 1))) * 512 + ((i & 31) + 32 * (fq & 1)) * 8;
                *(GAS u32x4*)(KT + fr0) = w1; *(GAS u32x4*)(KT + fr0 + (size_t)4 * 8 * 512) = w2;
                w1.x = cvt_pk_bf16(o1[0] * zb[0], o1[1] * zb[1]); w1.y = cvt_pk_bf16(o1[2] * zb[2], o1[3] * zb[3]); w1.z = cvt_pk_bf16(o1[4] * zb[4], o1[5] * zb[5]); w1.w = cvt_pk_bf16(o1[6] * zb[6], o1[7] * zb[7]);
                w2.x = cvt_pk_bf16(o2[0] * zb[0], o2[1] * zb[1]); w2.y = cvt_pk_bf16(o2[2] * zb[2], o2[3] * zb[3]); w2.z = cvt_pk_bf16(o2[4] * zb[4], o2[5] * zb[5]); w2.w = cvt_pk_bf16(o2[6] * zb[6], o2[7] * zb[7]);
                *(GAS u32x4*)(KT + (size_t)QKW * T + fr0) = w1; *(GAS u32x4*)(KT + (size_t)QKW * T + fr0 + (size_t)4 * 8 * 512) = w2; } }
    }
};
template <bool ROT> struct EpiBf16 {
    static constexpr bool PERM = true;
    GAS bf16* O; int ldc;
    __device__ __forceinline__ void operator()(const f32x4 (&acc)[2][2][4][2], const pg8::Unit& u, int wr, int wc, int fr, int fq) const {
#pragma unroll
        for (int ai = 0; ai < 2; ++ai)
#pragma unroll
            for (int m = 0; m < 4; ++m) { const int row = u.pm * 256 + ai * 128 + wr * 64 + m * 16 + fr; GAS bf16* rowp = O + (size_t)row * ldc;
#pragma unroll
                for (int bj = 0; bj < 2; ++bj) { const f32x4 v0 = acc[ai][bj][m][0], v1 = acc[ai][bj][m][1]; const int col = u.pn * 256 + bj * 128 + wc * 32 + 8 * fq;
                    u32x4 w; w.x = cvt_pk_bf16(v0[0], v0[1]); w.y = cvt_pk_bf16(v0[2], v0[3]); w.z = cvt_pk_bf16(v1[0], v1[1]); w.w = cvt_pk_bf16(v1[2], v1[3]);
                    *(GAS u32x4*)(rowp + (ROT ? rot_col(row, col) : col)) = w; } }
    }
};
struct EpiPc {
    static constexpr bool PERM = true;
    GAS bf16* PC; GAS bf16* PD; const LAS float* l2g;
    __device__ __forceinline__ void operator()(const f32x4 (&acc)[2][2][4][2], const pg8::Unit& u, int wr, int wc, int fr, int fq) const {
        const int h = u.z; const float l2f = l2g[h], l2b = l2g[4 + h];
#pragma unroll
        for (int ai = 0; ai < 2; ++ai)
#pragma unroll
            for (int m = 0; m < 4; ++m) { const int il = wr * 64 + m * 16 + fr, jl0 = wc * 32 + 8 * fq; float o[8];
                const bool diag = (wc == 2 * wr + (m >> 1));
#pragma unroll
                for (int n = 0; n < 2; ++n)
#pragma unroll
                    for (int j = 0; j < 4; ++j) { const int dl = il - (jl0 + 4 * n + j); const float f = dl >= 0 ? fast_exp2((float)dl * l2f) : fast_exp2((float)(-dl) * l2b);
                        o[4 * n + j] = (ai == 0 ? acc[0][0][m][n][j] : acc[1][1][m][n][j]) * f; }
                if (diag) {
                    float ob[8];
#pragma unroll
                    for (int q = 0; q < 8; ++q) { const bool lower = (jl0 + q) <= il; ob[q] = lower ? 0.f : o[q]; o[q] = lower ? o[q] : 0.f; }
                    u32x4 wb; wb.x = cvt_pk_bf16(ob[0], ob[1]); wb.y = cvt_pk_bf16(ob[2], ob[3]); wb.z = cvt_pk_bf16(ob[4], ob[5]); wb.w = cvt_pk_bf16(ob[6], ob[7]);
                    *(GAS u32x4*)(PD + ((((size_t)(u.pm * 2 + ai) * 4 + (il >> 5)) * 2 + (fq >> 1)) * 512 + ((il & 31) + 32 * (fq & 1)) * 8)) = wb;
                }
                u32x4 w; w.x = cvt_pk_bf16(o[0], o[1]); w.y = cvt_pk_bf16(o[2], o[3]); w.z = cvt_pk_bf16(o[4], o[5]); w.w = cvt_pk_bf16(o[6], o[7]);
                *(GAS u32x4*)(PC + ((((size_t)(u.pm * 2 + ai) * 4 + (il >> 5)) * 8 + (2 * wc + (fq >> 1))) * 512 + ((il & 31) + 32 * (fq & 1)) * 8)) = w; }
    }
};
struct EpiGate {
    static constexpr bool PERM = true;
    const GAS bf16* Y; GAS bf16* YG; const GAS f32x2* statp; const GAS float* gain; LAS f32x2* sst;
    __device__ __forceinline__ void operator()(const f32x4 (&acc)[2][2][4][2], const pg8::Unit& u, int wr, int wc, int fr, int fq) const {
        const int head = u.pn >> 1, c0 = u.pn * 256 + wc * 32 + 8 * fq;
        const int tid = (wr * 4 + wc) * 64 + fq * 16 + fr;
        if (tid < 256) { const int t = u.pm * 256 + tid; const GAS f32x4* sp = (const GAS f32x4*)(statp + ((size_t)t * 4 + head) * 8); float a1 = 0.f, a2 = 0.f;
#pragma unroll
            for (int k = 0; k < 4; ++k) { const f32x4 v = sp[k]; a1 += v[0] + v[2]; a2 += v[1] + v[3]; }
            const float mu = a1 * (1.f / DV), var = fmaxf(a2 * (1.f / DV) - mu * mu, 0.f); sst[tid] = (f32x2){mu, __builtin_amdgcn_rsqf(var + EPS)}; }
        asm volatile("s_waitcnt lgkmcnt(0)" ::: "memory"); __builtin_amdgcn_s_barrier(); asm volatile("" ::: "memory");
        f32x4 gv[2][2];
#pragma unroll
        for (int bj = 0; bj < 2; ++bj) { gv[bj][0] = *(const GAS f32x4*)(gain + c0 + bj * 128); gv[bj][1] = *(const GAS f32x4*)(gain + c0 + bj * 128 + 4); }
#pragma unroll
        for (int ai = 0; ai < 2; ++ai)
#pragma unroll
            for (int m = 0; m < 4; ++m) { const int rl = ai * 128 + wr * 64 + m * 16 + fr, t = u.pm * 256 + rl; const f32x2 st = sst[rl];
#pragma unroll
                for (int bj = 0; bj < 2; ++bj) { const size_t off = (size_t)t * VW + c0 + bj * 128;
                    const int es_ = (u.pn & 1) * 4 + bj * 2 + (wc >> 1);
                    const u32x4 yv = *(const GAS u32x4*)(Y + (((size_t)(t >> 5) * NH + head) * 8 + es_) * 2048 + (((wc & 1) * 2 + (fq >> 1)) * 64 + (t & 31) + 32 * (fq & 1)) * 8);
                    const float y[8] = {bf_lo(yv.x), bf_hi(yv.x), bf_lo(yv.y), bf_hi(yv.y), bf_lo(yv.z), bf_hi(yv.z), bf_lo(yv.w), bf_hi(yv.w)}; float o[8];
#pragma unroll
                    for (int n = 0; n < 2; ++n)
#pragma unroll
                        for (int j = 0; j < 4; ++j) { const int q = 4 * n + j; const float yn = (y[q] - st.x) * st.y * gv[bj][n][j]; o[q] = silu_f(acc[ai][bj][m][n][j]) * yn; }
                    u32x4 w; w.x = cvt_pk_bf16(o[0], o[1]); w.y = cvt_pk_bf16(o[2], o[3]); w.z = cvt_pk_bf16(o[4], o[5]); w.w = cvt_pk_bf16(o[6], o[7]);
                    *(GAS u32x4*)(YG + off) = w; } }
    }
};
template <bool BASE_F32> struct EpiRes {
    static constexpr bool PERM = true;
    const GAS void* base; GAS bf16* out; GAS float* ssq;
    __device__ __forceinline__ void operator()(const f32x4 (&acc)[2][2][4][2], const pg8::Unit& u, int wr, int wc, int fr, int fq) const {
#pragma unroll
        for (int ai = 0; ai < 2; ++ai)
#pragma unroll
            for (int m = 0; m < 4; ++m) { const int t_ = u.pm * 256 + ai * 128 + wr * 64 + m * 16 + fr; const size_t off = (size_t)t_ * D + u.pn * 256 + wc * 32 + 8 * fq; float sq = 0.f;
#pragma unroll
                for (int bj = 0; bj < 2; ++bj) { f32x4 v0 = acc[ai][bj][m][0], v1 = acc[ai][bj][m][1];
                    if (BASE_F32) { const GAS float* bp = (const GAS float*)base + off + bj * 128; v0 += *(const GAS f32x4*)bp; v1 += *(const GAS f32x4*)(bp + 4); }
                    else { const u32x4 bv = *(const GAS u32x4*)((const GAS bf16*)base + off + bj * 128);
                        v0 += (f32x4){bf_lo(bv.x), bf_hi(bv.x), bf_lo(bv.y), bf_hi(bv.y)}; v1 += (f32x4){bf_lo(bv.z), bf_hi(bv.z), bf_lo(bv.w), bf_hi(bv.w)}; }
                    u32x4 w; w.x = cvt_pk_bf16(v0[0], v0[1]); w.y = cvt_pk_bf16(v0[2], v0[3]); w.z = cvt_pk_bf16(v1[0], v1[1]); w.w = cvt_pk_bf16(v1[2], v1[3]);
                    *(GAS u32x4*)(out + off + bj * 128) = w;
                    { const float a0 = bf_lo(w.x), a1 = bf_hi(w.x), a2 = bf_lo(w.y), a3 = bf_hi(w.y), a4 = bf_lo(w.z), a5 = bf_hi(w.z), a6 = bf_lo(w.w), a7 = bf_hi(w.w);
                      sq += (a0 * a0 + a1 * a1) + (a2 * a2 + a3 * a3) + (a4 * a4 + a5 * a5) + (a6 * a6 + a7 * a7); } }
                sq += __shfl_xor(sq, 16); sq += __shfl_xor(sq, 32);
                if (ssq != nullptr && fq == 0) ssq[(size_t)t_ * 16 + u.pn * 4 + wc] = sq; }
    }
};
template <bool OUT8, bool NORM = false> struct EpiSwiGLU {
    static constexpr bool PERM = true;
    GAS void* ACT; int ldc; const GAS float* ssq; LAS float* sst;
    __device__ __forceinline__ void operator()(const f32x4 (&acc)[2][2][4][2], const pg8::Unit& u, int wr, int wc, int fr, int fq) const {
        if constexpr (NORM) {
            const int tid = (wr * 4 + wc) * 64 + fq * 16 + fr;
            if (tid < 256) { const GAS f32x4* sp = (const GAS f32x4*)(ssq + (size_t)(u.pm * 256 + tid) * 16); float a = 0.f;
#pragma unroll
                for (int k = 0; k < 4; ++k) { const f32x4 v = sp[k]; a += (v[0] + v[1]) + (v[2] + v[3]); }
                sst[tid] = __builtin_amdgcn_rsqf(a * (1.f / D) + EPS); }
            asm volatile("s_waitcnt lgkmcnt(0)" ::: "memory"); __builtin_amdgcn_s_barrier(); asm volatile("" ::: "memory");
        }
#pragma unroll
        for (int ai = 0; ai < 2; ++ai)
#pragma unroll
            for (int m = 0; m < 4; ++m) { float o[8]; float rs = 1.f; if constexpr (NORM) rs = sst[ai * 128 + wr * 64 + m * 16 + fr];
#pragma unroll
                for (int n = 0; n < 2; ++n)
#pragma unroll
                    for (int j = 0; j < 4; ++j) { if constexpr (NORM) o[4 * n + j] = silu_f(acc[ai][0][m][n][j] * rs) * (acc[ai][1][m][n][j] * rs); else o[4 * n + j] = silu_f(acc[ai][0][m][n][j]) * acc[ai][1][m][n][j]; }
                const size_t off = (size_t)(u.pm * 256 + ai * 128 + wr * 64 + m * 16 + fr) * ldc + u.pn * 128 + wc * 32 + 8 * fq;
                if constexpr (OUT8) { u32x2 w; w.x = pk4_fp8(o[0] * 8.f, o[1] * 8.f, o[2] * 8.f, o[3] * 8.f); w.y = pk4_fp8(o[4] * 8.f, o[5] * 8.f, o[6] * 8.f, o[7] * 8.f); *(GAS u32x2*)((GAS unsigned char*)ACT + off) = w; }
                else { u32x4 w; w.x = cvt_pk_bf16(o[0], o[1]); w.y = cvt_pk_bf16(o[2], o[3]); w.z = cvt_pk_bf16(o[4], o[5]); w.w = cvt_pk_bf16(o[6], o[7]); *(GAS u32x4*)((GAS bf16*)ACT + off) = w; } }
    }
};
struct EpiZ2 {
    static constexpr bool PERM = true;
    GAS bf16* Z2; const GAS float* ssq; LAS float* sst;
    __device__ __forceinline__ void operator()(const f32x4 (&acc)[2][2][4][2], const pg8::Unit& u, int wr, int wc, int fr, int fq) const {
        const int g = u.pm >> 1, ri = u.pm & 1;
        { const int tid = (wr * 4 + wc) * 64 + fq * 16 + fr;
          if (tid < 256) { const GAS f32x4* sp = (const GAS f32x4*)(ssq + (size_t)(u.pn * 256 + tid) * 16); float a = 0.f;
#pragma unroll
              for (int k = 0; k < 4; ++k) { const f32x4 v = sp[k]; a += (v[0] + v[1]) + (v[2] + v[3]); }
              sst[tid] = __builtin_amdgcn_rsqf(a * (1.f / D) + EPS); }
          asm volatile("s_waitcnt lgkmcnt(0)" ::: "memory"); __builtin_amdgcn_s_barrier(); asm volatile("" ::: "memory"); }
        f32x4 rs[2][2];
#pragma unroll
        for (int bj = 0; bj < 2; ++bj) { const LAS f32x4* rp = (const LAS f32x4*)(sst + bj * 128 + wc * 32 + 8 * fq); rs[bj][0] = rp[0]; rs[bj][1] = rp[1]; }
#pragma unroll
        for (int ai = 0; ai < 2; ++ai)
#pragma unroll
            for (int m = 0; m < 4; ++m) { const int cp = ai * 128 + wr * 64 + m * 16 + fr;
#pragma unroll
                for (int bj = 0; bj < 2; ++bj) { const int tok0 = u.pn * 256 + bj * 128 + wc * 32 + 8 * fq, b = tok0 >> 12, s0 = tok0 & (SEQ - 1);
                    const f32x4 v0 = acc[ai][bj][m][0] * rs[bj][0], v1 = acc[ai][bj][m][1] * rs[bj][1];
                    u32x4 w; w.x = cvt_pk_bf16(v0[0], v0[1]); w.y = cvt_pk_bf16(v0[2], v0[3]); w.z = cvt_pk_bf16(v1[0], v1[1]); w.w = cvt_pk_bf16(v1[2], v1[3]);
                    *(GAS u32x4*)(Z2 + ((size_t)(b * 1024 + g * 256 + cp) * 8192 + ri * SEQ + s0)) = w; } }
    }
};
struct EpiYf {
    static constexpr bool PERM = true;
    GAS bf16* YF;
    __device__ __forceinline__ void operator()(const f32x4 (&acc)[2][2][4][2], const pg8::Unit& u, int wr, int wc, int fr, int fq) const {
        const int batch = u.pn >> 5, fb = (u.pn >> 1) & 15, kbb = u.pn & 1;
#pragma unroll
        for (int ai = 0; ai < 2; ++ai)
#pragma unroll
            for (int m = 0; m < 4; ++m) { const int ka = u.pm * 256 + ai * 128 + wr * 64 + m * 16 + fr;
#pragma unroll
                for (int bj = 0; bj < 2; ++bj) { const int kb = kbb * 4 + 2 * bj + (wc >> 1), f = fb * 64 + 32 * (wc & 1) + 8 * fq;
                    const f32x4 v0 = acc[ai][bj][m][0], v1 = acc[ai][bj][m][1];
                    u32x4 w; w.x = cvt_pk_bf16(v0[0], v0[1]); w.y = cvt_pk_bf16(v0[2], v0[3]); w.z = cvt_pk_bf16(v1[0], v1[1]); w.w = cvt_pk_bf16(v1[2], v1[3]);
                    *(GAS u32x4*)(YF + (size_t)(batch * SEQ + 8 * ka + kb) * D + f) = w; } }
    }
};
struct EpiMoeDown {
    static constexpr bool PERM = true;
    GAS bf16* Hres; const GAS int* rowtok; const GAS float* rowgate;
    __device__ __forceinline__ void operator()(const f32x4 (&acc)[2][2][4][2], const pg8::Unit& u, int wr, int wc, int fr, int fq) const {
#pragma unroll
        for (int ai = 0; ai < 2; ++ai)
#pragma unroll
            for (int m = 0; m < 4; ++m) { const int row = u.pm * 256 + ai * 128 + wr * 64 + m * 16 + fr; const int tok = rowtok[row]; const float gw = rowgate[row];
                if (tok >= 0) { GAS bf16* rp = Hres + (size_t)tok * D + u.pn * 256 + wc * 32 + 8 * fq;
#pragma unroll
                    for (int bj = 0; bj < 2; ++bj) { const u32x4 bv = *(const GAS u32x4*)(rp + bj * 128);
                        const f32x4 v0 = (f32x4){bf_lo(bv.x), bf_hi(bv.x), bf_lo(bv.y), bf_hi(bv.y)} + gw * acc[ai][bj][m][0], v1 = (f32x4){bf_lo(bv.z), bf_hi(bv.z), bf_lo(bv.w), bf_hi(bv.w)} + gw * acc[ai][bj][m][1];
                        u32x4 w; w.x = cvt_pk_bf16(v0[0], v0[1]); w.y = cvt_pk_bf16(v0[2], v0[3]); w.z = cvt_pk_bf16(v1[0], v1[1]); w.w = cvt_pk_bf16(v1[2], v1[3]);
                        *(GAS u32x4*)(rp + bj * 128) = w; } } }
    }
};

#define XB_TMO      128
#define XB_XCNT(j)  (256  + 64 * (j))
#define XB_XSUB(j)  (1280 + 64 * (j))
#define XB_XGEN(j)  (2304 + 64 * (j))
#define XB_TOP      3328
#define XB_TOPGEN   3392
#define XCD_BAR_WORDS 3456
#define XB_SPIN_CAP (1u << 18)
__device__ __forceinline__ unsigned xb_ld(unsigned* p)              { return __hip_atomic_load(p, __ATOMIC_RELAXED, __HIP_MEMORY_SCOPE_AGENT); }
__device__ __forceinline__ unsigned xb_add(unsigned* p, unsigned v) { return __hip_atomic_fetch_add(p, v, __ATOMIC_RELAXED, __HIP_MEMORY_SCOPE_AGENT); }
__device__ __forceinline__ unsigned xb_xcc_id() { return (unsigned)__builtin_amdgcn_s_getreg((3 << 11) | 20) & 0xFu; }
#define XB_SPIN(cond, bar) do { unsigned _sp = 0; while (cond) { __builtin_amdgcn_s_sleep(1); \
    if ((++_sp & 255u) == 0u) { if (xb_ld(&(bar)[XB_TMO])) break; if (_sp > XB_SPIN_CAP) { atomicAdd(&(bar)[XB_TMO], 1u); break; } } } } while (0)
struct XcdBarrier { unsigned* bar; unsigned x; volatile LAS unsigned* st; };
__device__ __forceinline__ XcdBarrier xcd_barrier_post(unsigned* bar, volatile LAS unsigned* st, const bool t0) {
    XcdBarrier b; b.bar = bar; b.x = xb_xcc_id(); b.st = st;
    if (t0) (void)xb_add(&bar[XB_XCNT(b.x)], 1u);
    return b;
}
__device__ __forceinline__ void xcd_barrier_complete(unsigned* bar, unsigned x, unsigned& nloc, unsigned& nx) {
    const unsigned G = gridDim.x * gridDim.y * gridDim.z;
    unsigned sum, cnt, mine, sp = 0u;
    for (;;) {
        sum = 0u; cnt = 0u; mine = 0u;
#pragma unroll
        for (unsigned j = 0; j < 16; ++j) { const unsigned c = xb_ld(&bar[XB_XCNT(j)]); sum += c; cnt += (c > 0u) ? 1u : 0u; mine = (j == x) ? c : mine; }
        if (sum == G) break;
        __builtin_amdgcn_s_sleep(1);
        if ((++sp & 255u) == 0u) { if (xb_ld(&bar[XB_TMO])) break; if (sp > XB_SPIN_CAP) { atomicAdd(&bar[XB_TMO], 1u); break; } }
    }
    nloc = mine > 0u ? mine : 1u; nx = cnt > 0u ? cnt : 1u;
}
__device__ __forceinline__ void xcd_barrier(const XcdBarrier& b, const bool t0) {
    asm volatile("s_waitcnt vmcnt(0)" ::: "memory");
    __syncthreads();
    if (t0) {
        unsigned* bar = b.bar;
        __builtin_amdgcn_s_waitcnt(0);
        unsigned nloc = b.st[0], nx = b.st[1];
        if (nloc == 0u) { xcd_barrier_complete(bar, b.x, nloc, nx); b.st[0] = nloc; b.st[1] = nx; }
        const unsigned old = xb_add(&bar[XB_XSUB(b.x)], 1u);
        const unsigned gen = old / nloc;
        if (old + 1u == (gen + 1u) * nloc) {
            __builtin_amdgcn_fence(__ATOMIC_RELEASE, "agent");
            asm volatile("s_waitcnt vmcnt(0)" ::: "memory");
            const unsigned og = xb_add(&bar[XB_TOP], 1u);
            const unsigned tg = og / nx;
            if (og + 1u == (tg + 1u) * nx) xb_add(&bar[XB_TOPGEN], 1u);
            else XB_SPIN(xb_ld(&bar[XB_TOPGEN]) == tg, bar);
            __builtin_amdgcn_fence(__ATOMIC_ACQUIRE, "agent");
            xb_add(&bar[XB_XGEN(b.x)], 1u);
            asm volatile("s_waitcnt vmcnt(0)" ::: "memory");
        } else {
            XB_SPIN(xb_ld(&bar[XB_XGEN(b.x)]) == gen, bar);
            __builtin_amdgcn_fence(__ATOMIC_ACQUIRE, "agent");
            asm volatile("s_waitcnt vmcnt(0)" ::: "memory");
        }
    }
    __syncthreads();
}

__device__ __forceinline__ float wave_sum(float v) {
#pragma unroll
    for (int o = 1; o < 64; o <<= 1) v += __shfl_xor(v, o);
    return v;
}
__device__ __forceinline__ void transpose_item(const GAS float* W, int K, int N, GAS bf16* WT, int k0, int n0, int rbase, LAS float* scr, int lane, const GAS float* gk = nullptr) {
#pragma unroll 8
    for (int i = 0; i < 32; ++i) { const int kk = 2 * i + (lane >> 5); float wv = W[(size_t)(k0 + kk) * N + n0 + (lane & 31)]; if (gk != nullptr) wv *= gk[k0 + kk]; scr[kk * 33 + (lane & 31)] = wv; }
    LDS_WAIT(); asm volatile("" ::: "memory");
    const int c = lane & 7;
#pragma unroll
    for (int j = 0; j < 4; ++j) { const int n = (lane >> 3) + 8 * j; const LAS float* s = scr + (8 * c) * 33 + n;
        u32x4 o; o.x = cvt_pk_bf16(s[0 * 33], s[1 * 33]); o.y = cvt_pk_bf16(s[2 * 33], s[3 * 33]); o.z = cvt_pk_bf16(s[4 * 33], s[5 * 33]); o.w = cvt_pk_bf16(s[6 * 33], s[7 * 33]);
        *(GAS u32x4*)(WT + (size_t)(rbase + n) * K + k0 + 8 * c) = o; }
    LDS_WAIT(); asm volatile("" ::: "memory");
}
__device__ __forceinline__ void transpose_item8(const GAS float* W, int K, int N, GAS unsigned char* WT8, int k0, int n0, int rbase, float scale, LAS float* scr, int lane) {
#pragma unroll 8
    for (int i = 0; i < 32; ++i) { const int kk = 2 * i + (lane >> 5); scr[kk * 33 + (lane & 31)] = W[(size_t)(k0 + kk) * N + n0 + (lane & 31)]; }
    LDS_WAIT(); asm volatile("" ::: "memory");
    const int c = lane & 7;
#pragma unroll
    for (int j = 0; j < 4; ++j) { const int n = (lane >> 3) + 8 * j; const LAS float* sp = scr + (8 * c) * 33 + n;
        u32x2 o; o.x = pk4_fp8(sp[0 * 33] * scale, sp[1 * 33] * scale, sp[2 * 33] * scale, sp[3 * 33] * scale); o.y = pk4_fp8(sp[4 * 33] * scale, sp[5 * 33] * scale, sp[6 * 33] * scale, sp[7 * 33] * scale);
        *(GAS u32x2*)(WT8 + (size_t)(rbase + n) * K + k0 + 8 * c) = o; }
    LDS_WAIT(); asm volatile("" ::: "memory");
}
__device__ __forceinline__ void tr_gu8(const GAS float* Wg, const GAS float* Wu, int K, int N, GAS unsigned char* WT8, int it, LAS float* scr, int lane) {
    const int nblk = N / 32, per = (K / 64) * nblk; const bool up = it >= per; if (up) it -= per;
    const int kb = it / nblk, nb = it - kb * nblk, f0 = 32 * nb;
    transpose_item8(up ? Wu : Wg, K, N, WT8, 64 * kb, f0, 256 * (f0 >> 7) + (up ? 128 : 0) + (f0 & 127), 64.0f, scr, lane);
}
__device__ __forceinline__ void tr_plain(const GAS float* W, int K, int N, GAS bf16* WT, int it, LAS float* scr, int lane) {
    const int nblk = N / 32, kb = it / nblk, nb = it - kb * nblk; transpose_item(W, K, N, WT, 64 * kb, 32 * nb, 32 * nb, scr, lane);
}
__device__ __forceinline__ void tr_gu(const GAS float* Wg, const GAS float* Wu, int K, int N, GAS bf16* WT, int it, LAS float* scr, int lane, const GAS float* gk = nullptr) {
    const int nblk = N / 32, per = (K / 64) * nblk; const bool up = it >= per; if (up) it -= per;
    const int kb = it / nblk, nb = it - kb * nblk, f0 = 32 * nb;
    transpose_item(up ? Wu : Wg, K, N, WT, 64 * kb, f0, 256 * (f0 >> 7) + (up ? 128 : 0) + (f0 & 127), scr, lane, gk);
}
__device__ __forceinline__ void rms_row(const GAS float* xrow, const GAS float* g, GAS bf16* orow, int lane, f32x4 (&v)[4]) {
    const GAS f32x4* xr = (const GAS f32x4*)xrow + lane; const GAS f32x4* gr = (const GAS f32x4*)g + lane;
    float s = 0.f;
#pragma unroll
    for (int j = 0; j < 4; ++j) { v[j] = xr[64 * j]; s += (v[j].x * v[j].x + v[j].y * v[j].y) + (v[j].z * v[j].z + v[j].w * v[j].w); }
    const float r = 1.0f / sqrtf(wave_sum(s) * (1.f / D) + EPS);
    GAS u32x2* o8 = (GAS u32x2*)orow + lane;
#pragma unroll
    for (int j = 0; j < 4; ++j) { v[j] = v[j] * r * gr[64 * j]; u32x2 w; w.x = cvt_pk_bf16(v[j].x, v[j].y); w.y = cvt_pk_bf16(v[j].z, v[j].w); o8[64 * j] = w; }
}
__device__ __forceinline__ int rmsb_col(int j, int lane) { return 512 * (j >> 1) + 8 * lane + 4 * (j & 1); }
__device__ __forceinline__ void rms_row_b(const GAS bf16* hrow, const GAS float* g, GAS bf16* orow, int lane, f32x4 (&v)[4]) {
    float s = 0.f;
#pragma unroll
    for (int jh = 0; jh < 2; ++jh) { const u32x4 x = *(const GAS u32x4*)(hrow + 512 * jh + 8 * lane);
        v[2 * jh] = (f32x4){bf_lo(x.x), bf_hi(x.x), bf_lo(x.y), bf_hi(x.y)}; v[2 * jh + 1] = (f32x4){bf_lo(x.z), bf_hi(x.z), bf_lo(x.w), bf_hi(x.w)}; }
#pragma unroll
    for (int j = 0; j < 4; ++j) s += (v[j].x * v[j].x + v[j].y * v[j].y) + (v[j].z * v[j].z + v[j].w * v[j].w);
    const float r = 1.0f / sqrtf(wave_sum(s) * (1.f / D) + EPS);
#pragma unroll
    for (int jh = 0; jh < 2; ++jh) { const GAS float* gp = g + 512 * jh + 8 * lane; v[2 * jh] = v[2 * jh] * r * *(const GAS f32x4*)gp; v[2 * jh + 1] = v[2 * jh + 1] * r * *(const GAS f32x4*)(gp + 4);
        u32x4 w; w.x = cvt_pk_bf16(v[2 * jh].x, v[2 * jh].y); w.y = cvt_pk_bf16(v[2 * jh].z, v[2 * jh].w); w.z = cvt_pk_bf16(v[2 * jh + 1].x, v[2 * jh + 1].y); w.w = cvt_pk_bf16(v[2 * jh + 1].z, v[2 * jh + 1].w);
        *(GAS u32x4*)(orow + 512 * jh + 8 * lane) = w; }
}

__device__ __forceinline__ void rms_row_b8(const GAS bf16* hrow, const GAS float* g, GAS unsigned char* o8, int lane, f32x4 (&v)[4]) {
    float s = 0.f;
#pragma unroll
    for (int jh = 0; jh < 2; ++jh) { const u32x4 x = *(const GAS u32x4*)(hrow + 512 * jh + 8 * lane);
        v[2 * jh] = (f32x4){bf_lo(x.x), bf_hi(x.x), bf_lo(x.y), bf_hi(x.y)}; v[2 * jh + 1] = (f32x4){bf_lo(x.z), bf_hi(x.z), bf_lo(x.w), bf_hi(x.w)}; }
#pragma unroll
    for (int j = 0; j < 4; ++j) s += (v[j].x * v[j].x + v[j].y * v[j].y) + (v[j].z * v[j].z + v[j].w * v[j].w);
    const float r = 1.0f / sqrtf(wave_sum(s) * (1.f / D) + EPS);
#pragma unroll
    for (int jh = 0; jh < 2; ++jh) { const GAS float* gp = g + 512 * jh + 8 * lane; v[2 * jh] = v[2 * jh] * r * *(const GAS f32x4*)gp; v[2 * jh + 1] = v[2 * jh + 1] * r * *(const GAS f32x4*)(gp + 4);
        u32x2 w; w.x = pk4_fp8(v[2 * jh].x, v[2 * jh].y, v[2 * jh].z, v[2 * jh].w); w.y = pk4_fp8(v[2 * jh + 1].x, v[2 * jh + 1].y, v[2 * jh + 1].z, v[2 * jh + 1].w);
        *(GAS u32x2*)(o8 + 512 * jh + 8 * lane) = w; }
}

constexpr int SW_QL = 0, SW_SPITCH = 528, SW_SL = 128 * 528, SW_VPITCH = 272, SW_VL = SW_SL + 64 * SW_SPITCH, SW_VB = 64 * SW_VPITCH;
static_assert(SW_VL + 2 * SW_VB <= 139264, "sweep LDS");
template <bool OUT> __device__ __forceinline__ void sweep_role(LAS unsigned char* lds, const GAS bf16* Qg, const GAS bf16* KTFg, const GAS bf16* KTBg, const GAS bf16* VTg, const GAS bf16* PCg, const GAS bf16* PDg, const GAS bf16* ZEROg, GAS bf16* Yg, GAS f32x2* statp, const float l2f, const float l2b, int b, int h, int es, const int wave_s) {
    const int tid = tid_of(wave_s);
    const int w = __builtin_amdgcn_readfirstlane(tid >> 6), lane = tid & 63, r32 = lane & 31, hh = lane >> 5;
    const int rb = w & 3;
    const int vrow = tid >> 4, vpc = tid & 15;
    const int qrow = tid >> 5, qpc = tid & 31;
    const GAS bf16* qp = Qg + (size_t)(b * SEQ + qrow) * QKW + h * DK + 8 * qpc;
    const GAS bf16* vtp = VTg + (size_t)(h * DV + 64 * es + vrow) * T + 8 * vpc; const int vrot = b * SEQ + ((vrow & 15) << 11);
    const int il = 32 * rb + r32;
    const GAS bf16* pcp = PCg + (((size_t)((b * NH + h) * NCH) * 4 + rb) * 8) * 512 + lane * 8;
    const GAS bf16* pdp = PDg + (((size_t)((b * NH + h) * NCH) * 4 + rb) * 2) * 512 + lane * 8;
    GAS bf16* yp = Yg + ((size_t)(((b * SEQ) >> 5) + rb) * NH + h) * 8 * 2048 + (size_t)es * 2048 + lane * 8;
    GAS f32x2* stp = statp + ((size_t)(b * SEQ + il) * NH + h) * 8 + es;
    const size_t kto = ((size_t)((b * NH + h) * NCH) * 8 + 2 * rb) * 8 * 512 + lane * 8;
#define SW_LDP(dst, s_, d_, nn_) do { const int jb_ = (s_) >> 1; const bool use_ = (d_) ? (jb_ >= rb) : (jb_ <= rb); const bool dg_ = (d_) && (jb_ == rb); \
        const GAS bf16* src_ = dg_ ? (pdp + (size_t)(nn_) * 4096 + 512 * ((s_) & 1)) : (pcp + (size_t)(nn_) * (CH * CH) + 512 * (s_)); \
        dst = *(const GAS bf16x8*)(use_ ? src_ : ZEROg); } while (0)
#define SW_SCHED __builtin_amdgcn_sched_barrier(0)
#define SW_MFMA(a, b, c) c = __builtin_amdgcn_mfma_f32_32x32x16_bf16(a, b, c, 0, 0, 0)
    bf16x8 pa[8];
    bf16x8 ka[2][8];
    u32x4 vv[2], qv[4];
    f32x16 Sacc[2][2];
    if constexpr (OUT) {
#pragma unroll
        for (int s = 0; s < 8; ++s) SW_LDP(pa[s], s, 0, 0);
    } else {
#pragma unroll
        for (int db = 0; db < 2; ++db)
#pragma unroll
            for (int s = 0; s < 8; ++s) ka[db][s] = *(const GAS bf16x8*)(KTFg + kto + db * 4096 + s * 512);
#pragma unroll
        for (int db = 0; db < 2; ++db)
#pragma unroll
            for (int et = 0; et < 2; ++et)
#pragma unroll
                for (int t = 0; t < 16; ++t) Sacc[db][et][t] = 0.f;
    }
#pragma unroll
    for (int it = 0; it < 2; ++it) vv[it] = *(const GAS u32x4*)(vtp + (size_t)(32 * it) * T + (vrot & (T - 1)));
#pragma unroll
    for (int it = 0; it < 2; ++it) *(LAS u32x4*)(lds + SW_VL + (vrow + 32 * it) * SW_VPITCH + vpc * 16) = vv[it];
#pragma unroll
    for (int hf = 0; hf < 2; ++hf) {
#pragma unroll
        for (int it = 0; it < 4; ++it) qv[it] = *(const GAS u32x4*)(qp + (size_t)(16 * (4 * hf + it)) * QKW);
#pragma unroll
        for (int it = 0; it < 4; ++it) { const int row = qrow + 16 * (4 * hf + it); *(LAS u32x4*)(lds + SW_QL + row * SW_SPITCH + qpc * 16) = qv[it]; }
    }
    const int sl_rd = SW_SL + r32 * SW_SPITCH + 16 * hh;
    const int q_rd = SW_QL + il * SW_SPITCH + 16 * hh;
#pragma unroll 1
    for (int p = 0; p < 2 * NCH; ++p) {
        const int dir = p >> 5, st = p & 31, n = dir ? NCH - 1 - st : st;
        const int pn = p + 1 < 2 * NCH ? p + 1 : p, dirn = pn >> 5, stn = pn & 31, nn = dirn ? NCH - 1 - stn : stn;
        const int cur = p & 1;
        const float l2 = dir ? l2b : l2f;
        const int v_rd = SW_VL + cur * SW_VB + r32 * SW_VPITCH + 16 * hh;
        if constexpr (!OUT) {
#pragma unroll
            for (int db = 0; db < 2; ++db)
#pragma unroll
                for (int et = 0; et < 2; ++et)
#pragma unroll
                    for (int g = 0; g < 4; ++g) { u32x2 pk; pk.x = cvt_pk_bf16(Sacc[db][et][4 * g], Sacc[db][et][4 * g + 1]); pk.y = cvt_pk_bf16(Sacc[db][et][4 * g + 2], Sacc[db][et][4 * g + 3]);
                        if (st == 0) { pk.x = 0u; pk.y = 0u; }
                        *(LAS u32x2*)(lds + SW_SL + (32 * et + r32) * SW_SPITCH + (64 * rb + 32 * db + 8 * g + 4 * hh) * 2) = pk; }
        }
#pragma unroll
        for (int it = 0; it < 2; ++it) vv[it] = *(const GAS u32x4*)(vtp + (size_t)(32 * it) * T + ((nn * CH + vrot) & (T - 1)));
#pragma unroll
        for (int it = 0; it < 4; ++it) qv[it] = *(const GAS u32x4*)(qp + (size_t)(nn * CH + 16 * it) * QKW);
        __syncthreads();
        f32x16 O[2];
        u32x4 yf[4];
        GAS bf16* ypn = yp + (size_t)(n * 4) * (NH * 8 * 2048);
        if constexpr (OUT) {
#pragma unroll
            for (int et = 0; et < 2; ++et)
#pragma unroll
                for (int t = 0; t < 16; ++t) O[et][t] = 0.f;
            bf16x8 qx[2], s0x[2], s1x[2], qy[2], s0y[2], s1y[2];
#define SW_LDC(dq, d0, d1, g2) do { _Pragma("unroll") for (int k = 0; k < 2; ++k) { const int ks = 2 * (g2) + k; dq[k] = *(const LAS bf16x8*)(lds + q_rd + 32 * ks); \
                d0[k] = *(const LAS bf16x8*)(lds + sl_rd + 32 * ks); d1[k] = *(const LAS bf16x8*)(lds + sl_rd + 32 * SW_SPITCH + 32 * ks); } } while (0)
#define SW_MMC(dq, d0, d1) do { SW_MFMA(d0[0], dq[0], O[0]); SW_MFMA(d1[0], dq[0], O[1]); SW_MFMA(d0[1], dq[1], O[0]); SW_MFMA(d1[1], dq[1], O[1]); } while (0)
            SW_LDC(qx, s0x, s1x, 0); SW_LDC(qy, s0y, s1y, 1); SW_SCHED;
            SW_MMC(qx, s0x, s1x); SW_SCHED; SW_LDC(qx, s0x, s1x, 2); SW_SCHED;
            SW_MMC(qy, s0y, s1y); SW_SCHED; SW_LDC(qy, s0y, s1y, 3); SW_SCHED;
            SW_MMC(qx, s0x, s1x); SW_SCHED; SW_LDC(qx, s0x, s1x, 4); SW_SCHED;
            SW_MMC(qy, s0y, s1y); SW_SCHED; SW_LDC(qy, s0y, s1y, 5); SW_SCHED;
            SW_MMC(qx, s0x, s1x); SW_SCHED; SW_LDC(qx, s0x, s1x, 6); SW_SCHED;
            SW_MMC(qy, s0y, s1y); SW_SCHED; SW_LDC(qy, s0y, s1y, 7); SW_SCHED;
            SW_MMC(qx, s0x, s1x); SW_SCHED;
            SW_MMC(qy, s0y, s1y); SW_SCHED;
#undef SW_LDC
#undef SW_MMC
        } else {
            const float gC = st == 0 ? 0.f : fast_exp2((float)CH * l2);
#pragma unroll
            for (int db = 0; db < 2; ++db)
#pragma unroll
                for (int et = 0; et < 2; ++et)
#pragma unroll
                    for (int t = 0; t < 16; ++t) Sacc[db][et][t] *= gC;
            bf16x8 v0x[2], v1x[2], v0y[2], v1y[2];
#define SW_LDU(d0, d1, g2) do { _Pragma("unroll") for (int k = 0; k < 2; ++k) { const int s_ = 2 * (g2) + k; d0[k] = *(const LAS bf16x8*)(lds + v_rd + 32 * s_); d1[k] = *(const LAS bf16x8*)(lds + v_rd + 32 * SW_VPITCH + 32 * s_); } } while (0)
#define SW_MMU(d0, d1, g2) do { _Pragma("unroll") for (int k = 0; k < 2; ++k) { const int s_ = 2 * (g2) + k; SW_MFMA(ka[0][s_], d0[k], Sacc[0][0]); SW_MFMA(ka[0][s_], d1[k], Sacc[0][1]); SW_MFMA(ka[1][s_], d0[k], Sacc[1][0]); SW_MFMA(ka[1][s_], d1[k], Sacc[1][1]); } } while (0)
            SW_LDU(v0x, v1x, 0); SW_LDU(v0y, v1y, 1); SW_SCHED;
            SW_MMU(v0x, v1x, 0); SW_SCHED; SW_LDU(v0x, v1x, 2); SW_SCHED;
            SW_MMU(v0y, v1y, 1); SW_SCHED; SW_LDU(v0y, v1y, 3); SW_SCHED;
            SW_MMU(v0x, v1x, 2); SW_SCHED;
            SW_MMU(v0y, v1y, 3); SW_SCHED;
#undef SW_LDU
#undef SW_MMU
        }
        __syncthreads();
#pragma unroll
        for (int it = 0; it < 4; ++it) { const int row = qrow + 16 * it; *(LAS u32x4*)(lds + SW_QL + row * SW_SPITCH + qpc * 16) = qv[it]; }
#pragma unroll
        for (int it = 0; it < 4; ++it) qv[it] = *(const GAS u32x4*)(qp + (size_t)(nn * CH + 16 * (4 + it)) * QKW);
        if constexpr (OUT) {
            if (dir) {
#pragma unroll
                for (int q = 0; q < 4; ++q) yf[q] = *(const GAS u32x4*)(ypn + q * 512);
            }
            const float xi = fast_exp2((float)(dir == 0 ? (il + 1) : (CH - il)) * l2);
#pragma unroll
            for (int et = 0; et < 2; ++et)
#pragma unroll
                for (int t = 0; t < 16; ++t) O[et][t] *= xi;
            bf16x8 v0x[2], v1x[2], v0y[2], v1y[2];
#define SW_LDV(d0, d1, g2) do { _Pragma("unroll") for (int k = 0; k < 2; ++k) { const int s_ = 2 * (g2) + k; d0[k] = *(const LAS bf16x8*)(lds + v_rd + 32 * s_); d1[k] = *(const LAS bf16x8*)(lds + v_rd + 32 * SW_VPITCH + 32 * s_); } } while (0)
#define SW_MMV(d0, d1, g2) do { _Pragma("unroll") for (int k = 0; k < 2; ++k) { const int s_ = 2 * (g2) + k; SW_MFMA(d0[k], pa[s_], O[0]); SW_MFMA(d1[k], pa[s_], O[1]); } } while (0)
            SW_LDV(v0x, v1x, 0); SW_LDV(v0y, v1y, 1); SW_SCHED;
            SW_MMV(v0x, v1x, 0); SW_SCHED; SW_LDV(v0x, v1x, 2); SW_SCHED;
            SW_MMV(v0y, v1y, 1); SW_SCHED; SW_LDV(v0y, v1y, 3); SW_SCHED;
            SW_MMV(v0x, v1x, 2); SW_SCHED;
            SW_MMV(v0y, v1y, 3); SW_SCHED;
#undef SW_LDV
#undef SW_MMV
#pragma unroll
            for (int s = 0; s < 8; ++s) SW_LDP(pa[s], s, dirn, nn);
        } else {
            const GAS bf16* ktn = (dirn ? KTBg : KTFg) + kto + (size_t)nn * 32768;
#pragma unroll
            for (int db = 0; db < 2; ++db)
#pragma unroll
                for (int s = 0; s < 8; ++s) ka[db][s] = *(const GAS bf16x8*)(ktn + db * 4096 + s * 512);
        }
#pragma unroll
        for (int it = 0; it < 2; ++it) *(LAS u32x4*)(lds + SW_VL + (cur ^ 1) * SW_VB + (vrow + 32 * it) * SW_VPITCH + vpc * 16) = vv[it];
#pragma unroll
        for (int it = 0; it < 4; ++it) { const int row = qrow + 16 * (4 + it); *(LAS u32x4*)(lds + SW_QL + row * SW_SPITCH + qpc * 16) = qv[it]; }
        if constexpr (OUT) {
            float s1 = 0.f, s2 = 0.f;
#pragma unroll
            for (int et = 0; et < 2; ++et)
#pragma unroll
                for (int kp = 0; kp < 2; ++kp) {
                    float ya[4], yb[4];
#pragma unroll
                    for (int q = 0; q < 4; ++q) { ya[q] = O[et][8 * kp + q]; yb[q] = O[et][8 * kp + 4 + q]; }
                    if (dir) {
                        u32x4 f = yf[et * 2 + kp];
                        { const auto r0 = __builtin_amdgcn_permlane32_swap(f.x, f.z, false, false); f.x = r0[0]; f.z = r0[1]; const auto r1 = __builtin_amdgcn_permlane32_swap(f.y, f.w, false, false); f.y = r1[0]; f.w = r1[1]; }
                        ya[0] += bf_lo(f.x); ya[1] += bf_hi(f.x); ya[2] += bf_lo(f.y); ya[3] += bf_hi(f.y); yb[0] += bf_lo(f.z); yb[1] += bf_hi(f.z); yb[2] += bf_lo(f.w); yb[3] += bf_hi(f.w);
#pragma unroll
                        for (int q = 0; q < 4; ++q) { s1 += ya[q] + yb[q]; s2 += ya[q] * ya[q] + yb[q] * yb[q]; }
                    }
                    u32x4 o; o.x = cvt_pk_bf16(ya[0], ya[1]); o.y = cvt_pk_bf16(ya[2], ya[3]); o.z = cvt_pk_bf16(yb[0], yb[1]); o.w = cvt_pk_bf16(yb[2], yb[3]);
                    { const auto r0 = __builtin_amdgcn_permlane32_swap(o.x, o.z, false, false); o.x = r0[0]; o.z = r0[1]; const auto r1 = __builtin_amdgcn_permlane32_swap(o.y, o.w, false, false); o.y = r1[0]; o.w = r1[1]; }
                    *(GAS u32x4*)(ypn + (et * 2 + kp) * 512) = o;
                }
            if (dir) { s1 += __shfl_xor(s1, 32); s2 += __shfl_xor(s2, 32);
                if (hh == 0) stp[(size_t)(n * CH) * (NH * 8)] = (f32x2){s1, s2}; }
        }
    }
#undef SW_LDP
#undef SW_SCHED
#undef SW_MFMA
    VM_WAIT();
    __syncthreads();
}

__device__ __forceinline__ void sweep_unit(LAS unsigned char* lds, const GAS bf16* Qg, const GAS bf16* KTFg, const GAS bf16* KTBg, const GAS bf16* VTg, const GAS bf16* PCg, const GAS bf16* PDg, const GAS bf16* ZEROg, GAS bf16* Yg, GAS f32x2* statp, const float l2f, const float l2b, int b, int h, int es, const int wave_s) {
    int ws_ = wave_s; asm volatile("" : "+s"(ws_));
    if (ws_ < 4) sweep_role<true>(lds, Qg, KTFg, KTBg, VTg, PCg, PDg, ZEROg, Yg, statp, l2f, l2b, b, h, es, wave_s);
    else sweep_role<false>(lds, Qg, KTFg, KTBg, VTg, PCg, PDg, ZEROg, Yg, statp, l2f, l2b, b, h, es, wave_s);
}

struct Args { const float* in[16]; float* out; unsigned char* ws; };
constexpr int NWAVES = 8;
#ifndef PHMASK
#define PHMASK 0xFFFFFFFFu
#endif
#define PH(k) (((PHMASK) >> (k)) & 1u)
__global__ void __launch_bounds__(NWAVES * 64, 2) fwd_kernel(Args args) {
    extern __shared__ __attribute__((aligned(16))) unsigned char lds_raw[];
    LAS unsigned char* lds = (LAS unsigned char*)lds_raw;
    LAS float* l2g = (LAS float*)(lds + LDSCTL_OFF + 64);
    const int wave_k = __builtin_amdgcn_readfirstlane((int)threadIdx.x >> 6);
#define PHASE_VARS \
    const int tid = tid_of(wave_k); const int lane = tid & 63; int wave = wave_k; asm volatile("" : "+s"(wave)); \
    const __attribute__((address_space(4))) Args* ka = (const __attribute__((address_space(4))) Args*)__builtin_amdgcn_kernarg_segment_ptr(); asm volatile("" : "+s"(ka)); \
    const int G = gridDim.x, bx = blockIdx.x; const int vcu = (G % 8 == 0) ? (bx % 8) * (G / 8) + bx / 8 : bx; const int gw = vcu * NWAVES + wave, NGW = G * NWAVES; \
    GAS unsigned char* ws = (GAS unsigned char*)ka->ws; asm volatile("" : "+s"(ws)); GAS float* hres = (GAS float*)ka->out; (void)lane; (void)gw; (void)NGW; (void)vcu; (void)hres; \
    const GAS float* x = (const GAS float*)ka->in[0]; const GAS float* mix_norm = (const GAS float*)ka->in[1]; const GAS float* ffn_norm = (const GAS float*)ka->in[2]; const GAS float* ret_w_in = (const GAS float*)ka->in[3]; const GAS float* ret_decay = (const GAS float*)ka->in[4]; \
    const GAS float* gn_gain = (const GAS float*)ka->in[5]; const GAS float* ret_w_out = (const GAS float*)ka->in[6]; const GAS float* d_wg = (const GAS float*)ka->in[7]; const GAS float* d_wu = (const GAS float*)ka->in[8]; const GAS float* d_wd = (const GAS float*)ka->in[9]; \
    const GAS float* fnet_w = (const GAS float*)ka->in[10]; const GAS float* moe_router = (const GAS float*)ka->in[11]; const GAS float* m_wg = (const GAS float*)ka->in[12]; const GAS float* m_wu = (const GAS float*)ka->in[13]; const GAS float* m_wd = (const GAS float*)ka->in[14]; const GAS float* final_norm = (const GAS float*)ka->in[15]; \
    (void)x; (void)mix_norm; (void)ffn_norm; (void)ret_w_in; (void)ret_decay; (void)gn_gain; (void)ret_w_out; (void)d_wg; (void)d_wu; (void)d_wd; (void)fnet_w; (void)moe_router; (void)m_wg; (void)m_wu; (void)m_wd; (void)final_norm; \
    GAS f32x2* rot = (GAS f32x2*)(ws + WS_ROT); GAS f32x2* rotT = (GAS f32x2*)(ws + WS_ROTT); GAS bf16* WC = (GAS bf16*)(ws + WS_STATS); GAS float* SSQ1 = (GAS float*)(ws + WS_SSQ1); GAS float* SSQ2 = (GAS float*)(ws + WS_SSQ2); (void)SSQ1; (void)SSQ2; \
    GAS int* toke = (GAS int*)(ws + WS_TOKE); GAS float* tokw = (GAS float*)(ws + WS_TOKW); GAS int* bcnt = (GAS int*)(ws + WS_BCNT); GAS int* pcnt = (GAS int*)(ws + WS_PCNT); (void)pcnt; GAS int* rowtok = (GAS int*)(ws + WS_ROWTOK); GAS float* rowgate = (GAS float*)(ws + WS_ROWGATE); \
    GAS f32x2* statp = (GAS f32x2*)(ws + WS_STATP); \
    GAS bf16* WIN = (GAS bf16*)(ws + WS_WIN); GAS bf16* WO = (GAS bf16*)(ws + WS_WO); GAS bf16* WGU = (GAS bf16*)(ws + WS_WGU); GAS bf16* WD = (GAS bf16*)(ws + WS_WD); GAS bf16* WF = (GAS bf16*)(ws + WS_WF); \
    GAS bf16* HN = (GAS bf16*)(ws + WS_HN); GAS bf16* Qb = (GAS bf16*)(ws + WS_Q); GAS bf16* Kb = (GAS bf16*)(ws + WS_K); GAS bf16* KT = (GAS bf16*)(ws + WS_KT); GAS bf16* VT = (GAS bf16*)(ws + WS_VT); GAS bf16* PC = (GAS bf16*)(ws + WS_PC); \
    GAS bf16* HB = (GAS bf16*)(ws + WS_HN); GAS bf16* HNB = (GAS bf16*)ka->out; (void)HB; (void)HNB; \
    GAS unsigned char* HN8 = (GAS unsigned char*)ka->out + 64 * MiB; GAS unsigned char* WMGU8 = (GAS unsigned char*)(ws + WS_WMGU); (void)HN8; (void)WMGU8;     \
    GAS bf16* Yb = (GAS bf16*)ka->out; GAS bf16* YG = (GAS bf16*)(ws + WS_YG); GAS bf16* ACTD = (GAS bf16*)(ws + WS_ACTD); GAS bf16* Z2 = (GAS bf16*)(ws + WS_Z2); GAS bf16* WSEQ = (GAS bf16*)(ws + WS_WSEQ); \
    GAS bf16* ACTM = (GAS bf16*)(ws + WS_ACTM); GAS bf16* WMGU = (GAS bf16*)(ws + WS_WMGU); GAS bf16* WMD = (GAS bf16*)(ws + WS_WMD); \
    (void)rot; (void)rotT; (void)WC; (void)toke; (void)tokw; (void)bcnt; (void)rowtok; (void)rowgate; (void)statp; (void)WIN; (void)WO; (void)WGU; (void)WD; (void)WF; (void)HN; (void)Qb; (void)Kb; (void)KT; (void)VT; (void)PC; \
    (void)Yb; (void)YG; (void)ACTD; (void)Z2; (void)WSEQ; (void)ACTM; (void)WMGU; (void)WMD;
#define GRID_BAR() do { const __attribute__((address_space(4))) Args* kb = (const __attribute__((address_space(4))) Args*)__builtin_amdgcn_kernarg_segment_ptr(); asm volatile("" : "+s"(kb)); GAS unsigned char* wsb = (GAS unsigned char*)kb->ws; XcdBarrier bar_; bar_.bar = (unsigned*)(wsb + WS_CTL) + CW_BAR; bar_.x = xb_xcc_id(); \
    bar_.st = (volatile LAS unsigned*)(lds + MISC_OFF) + 8; xcd_barrier(bar_, tid_of(wave_k) == 0); } while (0)

    {
        PHASE_VARS
        for (int u = tid; u < (LDS_BYTES - LDSCTL_OFF) / 4; u += NWAVES * 64) ((LAS unsigned*)(lds + LDSCTL_OFF))[u] = 0u;
        __syncthreads();
        if (tid < 8) { const float xl = ret_decay[tid]; const float ls = fminf(xl, 0.f) - log1pf(expf(-fabsf(xl))); l2g[tid] = ls * 1.44269504088896341f; }
        __syncthreads();
        (void)xcd_barrier_post((unsigned*)(ws + WS_CTL) + CW_BAR, (volatile LAS unsigned*)(lds + MISC_OFF) + 8, tid == 0);
    }

    if (PH(0)) {
        PHASE_VARS
        LAS float* scr = (LAS float*)(lds + wave * 16384);
        constexpr int I_IN = (D / 64) * (INW / 32), I_O = (VW / 64) * (D / 32), I_GU = 2 * (D / 64) * (FFD / 32), I_D = (FFD / 64) * (D / 32), I_F = (D / 64) * (D / 32);
        constexpr int NITEMS = I_IN + I_O + I_GU + I_D + I_F;
        for (int it = gw; it < NITEMS; it += NGW) {
            int r = it;
            if (r < I_IN) { tr_plain(ret_w_in, D, INW, WIN, r, scr, lane); continue; } r -= I_IN;
            if (r < I_O) { tr_plain(ret_w_out, VW, D, WO, r, scr, lane); continue; } r -= I_O;
            if (r < I_GU) { tr_gu(d_wg, d_wu, D, FFD, WGU, r, scr, lane, ffn_norm); continue; } r -= I_GU;
            if (r < I_D) { tr_plain(d_wd, FFD, D, WD, r, scr, lane); continue; } r -= I_D;
            tr_plain(fnet_w, D, D, WF, r, scr, lane);
        }
        for (int e = (vcu * 512 + tid); e < SEQ * 128; e += G * 512) { const int s = e >> 7, i = e & 127;
            const float inv = powf(10000.0f, -(float)i / 128.0f); const float ang = (float)s * inv; float sn, cs; sincosf(ang, &sn, &cs);
            rot[e] = (f32x2){cs, sn}; rotT[(size_t)i * RTP + s] = (f32x2){cs, sn}; }
        for (int e = (vcu * 512 + tid); e < 4 * 512 * 256; e += G * 512) { const int g = e >> 17, r = (e >> 8) & 511, c = e & 255, mm = ((r & 255) * c) & 255;
            const float v = (r < 256 ? cospif((float)mm * (1.0f / 128.0f)) : -sinpif((float)mm * (1.0f / 128.0f))) * mix_norm[D + g * 256 + c]; WC[e] = (bf16)(cvt_pk_bf16(v, 0.f) & 0xffffu); }
        for (int e = vcu * 512 + tid; e < 512 * 1024; e += G * 512) { const int ka = e >> 10, c = e & 1023, a = c & 511, mm = (a * ka) & 511;
            const float v = (c < 512 ? cospif((float)mm * (1.0f / 256.0f)) : sinpif((float)mm * (1.0f / 256.0f))) * (1.0f / 1024.0f); WSEQ[e] = (bf16)(cvt_pk_bf16(v, 0.f) & 0xffffu); }
        for (int m = gw; m < T; m += NGW) { f32x4 v[4]; rms_row(x + (size_t)m * D, mix_norm, HN + (size_t)m * D, lane, v); }
    }
    GRID_BAR();

    if (PH(1) && PH(19)) {
        PHASE_VARS
        SchedPlain S{(const GAS char*)HN, (const GAS char*)WIN, (size_t)256 * D * 2, (size_t)256 * D * 2, T / 256, 8, G, bx};
        EpiRopeQK E{Qb, Kb, rot};
        pg8::gemm_phase<EpiRopeQK, SchedPlain, false>(lds, wave_k, D, D, D, S, E);
    }
    if (PH(1) && PH(20)) {
        PHASE_VARS
        SchedPlain S{(const GAS char*)(WIN + (size_t)QKW * D), (const GAS char*)HN, (size_t)256 * D * 2, (size_t)256 * D * 2, 4, T / 256, G, bx};
        EpiRopeKT E{KT, rotT, l2g};
        pg8::gemm_phase<EpiRopeKT, SchedPlain, false>(lds, wave_k, D, D, D, S, E);
    }
    if (PH(1) && PH(21)) {
        PHASE_VARS
        SchedPlain S{(const GAS char*)(WIN + (size_t)2 * QKW * D), (const GAS char*)HN, (size_t)256 * D * 2, (size_t)256 * D * 2, 8, T / 256, G, bx};
        EpiBf16<true> E{VT, T};
        pg8::gemm_phase<EpiBf16<true>, SchedPlain, false>(lds, wave_k, D, D, D, S, E);
    }
    GRID_BAR();

    if (PH(2)) {
        PHASE_VARS
        SchedPc S{(const GAS char*)Qb, (const GAS char*)Kb, G, bx};
        EpiPc E{PC, (GAS bf16*)(ws + WS_ROT), l2g};
        pg8::gemm_phase<EpiPc, SchedPc, false>(lds, wave_k, QKW, QKW, DK, S, E);
    }
    GRID_BAR();

    if (PH(3)) {
        PHASE_VARS
        for (int u = vcu; u < NB * NH * 8; u += G) { const int hh_ = (u >> 3) & 3; const float l2f = l2g[hh_], l2b = l2g[4 + hh_];
            sweep_unit(lds, Qb, KT, KT + (size_t)QKW * T, VT, PC, (const GAS bf16*)(ws + WS_ROT), (const GAS bf16*)(ws + WS_CTL + 512 * 1024), Yb, statp, l2f, l2b, u >> 5, hh_, u & 7, wave_k); }
    }
    GRID_BAR();

    if (PH(5)) {
        PHASE_VARS
        SchedPlain S{(const GAS char*)HN, (const GAS char*)(WIN + (size_t)(2 * QKW + VW) * D), (size_t)256 * D * 2, (size_t)256 * D * 2, T / 256, 8, G, bx};
        EpiGate E{Yb, YG, statp, gn_gain, (LAS f32x2*)(lds + 135168)};
        pg8::gemm_phase<EpiGate, SchedPlain, false>(lds, wave_k, D, D, D, S, E);
    }
    GRID_BAR();

    if (PH(6)) {
        PHASE_VARS
        SchedPlain S{(const GAS char*)YG, (const GAS char*)WO, (size_t)256 * VW * 2, (size_t)256 * VW * 2, T / 256, 4, G, bx};
        EpiRes<true> E{(const GAS void*)x, HB, SSQ1};
        pg8::gemm_phase<EpiRes<true>, SchedPlain, false>(lds, wave_k, VW, VW, VW, S, E);
    }
    GRID_BAR();

    if (PH(7)) {
        PHASE_VARS
        LAS float* scr = (LAS float*)(lds + wave * 16384);
        constexpr int I_GU = 2 * (D / 64) * (FFE / 32), I_D = (FFE / 64) * (D / 32);
        for (int it = gw; it < NE * (I_GU + I_D); it += NGW) {
            const int e = it / (I_GU + I_D); int r = it - e * (I_GU + I_D);
            if (r < I_GU) tr_gu8(m_wg + (size_t)e * D * FFE, m_wu + (size_t)e * D * FFE, D, FFE, WMGU8 + (size_t)e * 2 * FFE * D, r, scr, lane);
            else { const int it2 = r - I_GU, nblk = D / 32, kb = it2 / nblk, nb = it2 - kb * nblk; transpose_item8(m_wd + (size_t)e * FFE * D, FFE, D, (GAS unsigned char*)WMD + (size_t)e * D * FFE, 64 * kb, 32 * nb, 32 * nb, 64.0f, scr, lane); }
        }
    }
    __syncthreads();

    if (PH(8)) {
        PHASE_VARS
        SchedPlain S{(const GAS char*)HB, (const GAS char*)WGU, (size_t)256 * D * 2, (size_t)256 * D * 2, T / 256, 2 * FFD / 256, G, bx};
        EpiSwiGLU<false, true> E{(GAS void*)ACTD, FFD, SSQ1, (LAS float*)(lds + 135168)};
        pg8::gemm_phase<EpiSwiGLU<false, true>, SchedPlain, false>(lds, wave_k, D, D, D, S, E);
    }
    GRID_BAR();
    if (PH(9)) {
        PHASE_VARS
        SchedPlain S{(const GAS char*)ACTD, (const GAS char*)WD, (size_t)256 * FFD * 2, (size_t)256 * FFD * 2, T / 256, 4, G, bx};
        EpiRes<false> E{(const GAS void*)HB, HB, SSQ2};
        pg8::gemm_phase<EpiRes<false>, SchedPlain, false>(lds, wave_k, FFD, FFD, FFD, S, E);
    }
    GRID_BAR();

    if (PH(11)) {
        PHASE_VARS
        SchedFnA S{(const GAS char*)WC, (const GAS char*)HB, G, bx};
        EpiZ2 E{Z2, SSQ2, (LAS float*)(lds + 135168)};
        pg8::gemm_phase<EpiZ2, SchedFnA, false>(lds, wave_k, 256, D, 256, S, E);
    }
    GRID_BAR();
    if (PH(22)) {
        PHASE_VARS
        float wc0[8], ws0[8];
#pragma unroll
        for (int kb = 0; kb < 8; ++kb) { const float ang = (float)((8 * lane * kb) & 4095) * (1.0f / 2048.0f); wc0[kb] = cospif(ang); ws0[kb] = sinpif(ang); }
        for (int rw = gw; rw < NB * 1024; rw += NGW) {
            GAS bf16* row = Z2 + (size_t)rw * 8192;
#pragma unroll
            for (int hq = 0; hq < 2; ++hq) {
                u32x2 zin[2][8], zout[8][2];
#pragma unroll
                for (int ri = 0; ri < 2; ++ri)
#pragma unroll
                    for (int bb = 0; bb < 8; ++bb) zin[ri][bb] = *(const GAS u32x2*)(row + ri * 4096 + 512 * bb + 8 * lane + 4 * hq);
#pragma unroll
                for (int q = 0; q < 2; ++q) {
                    float outr[2][8], outi[2][8];
#pragma unroll
                    for (int tt = 0; tt < 2; ++tt) {
                        const int t = 4 * hq + 2 * q + tt;
                        float zr[8], zi[8];
#pragma unroll
                        for (int bb = 0; bb < 8; ++bb) { const unsigned wr_ = zin[0][bb][q], wi_ = zin[1][bb][q]; zr[bb] = tt ? bf_hi(wr_) : bf_lo(wr_); zi[bb] = tt ? bf_hi(wi_) : bf_lo(wi_); }
#pragma unroll
                        for (int kb = 0; kb < 8; ++kb) {
                            float ur = 0.f, ui = 0.f;
#pragma unroll
                            for (int bb = 0; bb < 8; ++bb) {
                                const int m8 = (bb * kb) & 7;
                                const float c8 = (m8 == 0) ? 1.f : (m8 == 4) ? -1.f : (m8 == 2 || m8 == 6) ? 0.f : (m8 == 1 || m8 == 7) ? 0.70710678118654752f : -0.70710678118654752f;
                                const float s8 = (m8 == 0 || m8 == 4) ? 0.f : (m8 == 2) ? 1.f : (m8 == 6) ? -1.f : (m8 == 1 || m8 == 3) ? 0.70710678118654752f : -0.70710678118654752f;
                                ur += c8 * zr[bb] + s8 * zi[bb]; ui += c8 * zi[bb] - s8 * zr[bb]; }
                            const int mt = (t * kb);
                            const float ct = __builtin_cosf((float)mt * 0.00153398078788564123f), st_ = __builtin_sinf((float)mt * 0.00153398078788564123f);
                            const float twc = wc0[kb] * ct - ws0[kb] * st_, tws = ws0[kb] * ct + wc0[kb] * st_;
                            outr[tt][kb] = ur * twc + ui * tws; outi[tt][kb] = ui * twc - ur * tws; }
                    }
#pragma unroll
                    for (int kb = 0; kb < 8; ++kb) { zout[kb][0][q] = cvt_pk_bf16(outr[0][kb], outr[1][kb]); zout[kb][1][q] = cvt_pk_bf16(outi[0][kb], outi[1][kb]); }
                    __builtin_amdgcn_sched_barrier(0);
                }
#pragma unroll
                for (int kb = 0; kb < 8; ++kb)
#pragma unroll
                    for (int ri = 0; ri < 2; ++ri) *(GAS u32x2*)(row + kb * 1024 + ri * 512 + 8 * lane + 4 * hq) = zout[kb][ri];
                __builtin_amdgcn_sched_barrier(0);
            }
        }
    }
    GRID_BAR();
    if (PH(12)) {
        PHASE_VARS
        SchedFnB S{(GAS const char*)WSEQ, (GAS const char*)Z2, G, bx};
        EpiYf E{HNB};
        pg8::gemm_phase<EpiYf, SchedFnB, false>(lds, wave_k, 1024, 1024, 1024, S, E);
    }
    GRID_BAR();
    if (PH(13)) {
        PHASE_VARS
        SchedPlain S{(const GAS char*)HNB, (const GAS char*)WF, (size_t)256 * D * 2, (size_t)256 * D * 2, T / 256, 4, G, bx};
        EpiRes<false> E{(const GAS void*)HB, HB, nullptr};
        pg8::gemm_phase<EpiRes<false>, SchedPlain, false>(lds, wave_k, D, D, D, S, E);
    }
    GRID_BAR();

    if (PH(14)) {
        PHASE_VARS
        LAS float* wrl = (LAS float*)lds;
        LAS int* le = (LAS int*)(lds + 32768);
        for (int i = tid; i < D * NE; i += NWAVES * 64) wrl[(i & 7) * D + (i >> 3)] = moe_router[i];
        for (int i = vcu * 512 + tid; i < 2 * MOE_ROWS; i += G * 512) rowtok[i] = -1;
        __syncthreads();
        for (int tb = vcu; tb < T / 128; tb += G) {
            for (int rr = 0; rr < 16; ++rr) { const int tl = wave * 16 + rr, m = tb * 128 + tl; f32x4 v[4];
                rms_row_b8(HB + (size_t)m * D, ffn_norm + D, HN8 + (size_t)m * D, lane, v);
                float lg[8];
#pragma unroll
                for (int e = 0; e < 8; ++e) lg[e] = 0.f;
#pragma unroll
                for (int j = 0; j < 4; ++j) { const int col0 = rmsb_col(j, lane);
#pragma unroll
                    for (int e = 0; e < 8; ++e) { const f32x4 wv = *(const LAS f32x4*)(wrl + e * D + col0); lg[e] += (v[j].x * wv.x + v[j].y * wv.y) + (v[j].z * wv.z + v[j].w * wv.w); } }
#pragma unroll
                for (int e = 0; e < 8; ++e) lg[e] = wave_sum(lg[e]);
                int e0 = 0; float b0 = lg[0];
#pragma unroll
                for (int e = 1; e < 8; ++e) if (lg[e] > b0) { b0 = lg[e]; e0 = e; }
                int e1 = -1; float b1 = -3.0e38f;
#pragma unroll
                for (int e = 0; e < 8; ++e) if (e != e0 && lg[e] > b1) { b1 = lg[e]; e1 = e; }
                const float w0 = 1.0f / (1.0f + __expf(b1 - b0));
                if (lane == 0) { toke[2 * m] = e0; toke[2 * m + 1] = e1; tokw[2 * m] = w0; tokw[2 * m + 1] = 1.0f - w0; le[tl] = e0; le[128 + tl] = e1; } }
            __syncthreads();
            if (tid < 16) { const int s = tid >> 3, e = tid & 7; int c = 0; for (int i = 0; i < 128; ++i) c += (le[s * 128 + i] == e) ? 1 : 0; bcnt[tb * 16 + tid] = c; }
            if (tid >= 64 && tid < 128) { const int pi = tid - 64; int c = 0; for (int i = 0; i < 128; ++i) c += (le[i] * 8 + le[128 + i] == pi) ? 1 : 0; pcnt[tb * 64 + pi] = c; }
            __syncthreads();
        }
    }
    GRID_BAR();

    LAS int* segoff = (LAS int*)(lds + 132096);
    LAS int* ntile = (LAS int*)(lds + 132096 + 64);
    LAS unsigned char* tile_e = (LAS unsigned char*)(lds + 132096 + 128);
    if (PH(15)) {
        PHASE_VARS
        LAS int* pfx = (LAS int*)lds;
        LAS int* cph = (LAS int*)(lds + 65792);
        LAS int* fq_ = (LAS int*)(lds + 65792 + 16384);
        LAS int* tot = fq_ + 64;
        LAS int* tpi = tot + 16;
        LAS int* tex = tpi + 128;
        for (int i = tid; i < 256 * 64; i += NWAVES * 64) pfx[i] = pcnt[i];
        __syncthreads();
        if (tid < 64) { int run = 0; for (int b2 = 0; b2 < 256; ++b2) { const int c = pfx[b2 * 64 + tid]; pfx[b2 * 64 + tid] = run; run += c; } pfx[256 * 64 + tid] = run; }
        __syncthreads();
        if (tid == 0) {
            int n0[8], d[8], r[8]; int rs = 0;
            for (int e = 0; e < 8; ++e) { int c = 0; for (int x2 = 0; x2 < 8; ++x2) c += pfx[256 * 64 + e * 8 + x2]; n0[e] = c; r[e] = c & 255; d[e] = -(c & 255); rs += c & 255; }
            int extra = rs >> 8;
            for (int k = 0; k < extra; ++k) { int be = -1, br = -1; for (int e = 0; e < 8; ++e) if (d[e] < 0 && d[e] == -r[e] && r[e] > br) { br = r[e]; be = e; } if (be >= 0) d[be] += 256; }
            for (int i = 0; i < 64; ++i) fq_[i] = 0;
            for (int a = 0; a < 8; ++a) for (int e = 0; e < 8; ++e) if (a != e && d[a] < 0 && d[e] > 0) { int fl = -d[a]; if (d[e] < fl) fl = d[e]; const int av = pfx[256 * 64 + a * 8 + e]; if (av < fl) fl = av; fq_[a * 8 + e] = fl; d[a] += fl; d[e] -= fl; }
        }
        __syncthreads();
        if (tid < 256) {
            int c0[8], c1[8];
#pragma unroll
            for (int e = 0; e < 8; ++e) { c0[e] = 0; c1[e] = 0; }
            for (int a = 0; a < 8; ++a) for (int e = 0; e < 8; ++e) { const int pi = a * 8 + e; const int cnt = pfx[(tid + 1) * 64 + pi] - pfx[tid * 64 + pi]; int fl = fq_[pi] - pfx[tid * 64 + pi]; fl = fl < 0 ? 0 : (fl > cnt ? cnt : fl);
#pragma unroll
                for (int q = 0; q < 8; ++q) { c0[q] += (q == a ? cnt - fl : 0) + (q == e ? fl : 0); c1[q] += (q == e ? cnt - fl : 0) + (q == a ? fl : 0); } }
#pragma unroll
            for (int e = 0; e < 8; ++e) { cph[tid * 16 + e] = c0[e]; cph[tid * 16 + 8 + e] = c1[e]; }
        }
        __syncthreads();
        if (tid < 16) { int run = 0; for (int b2 = 0; b2 < 256; ++b2) { const int c = cph[b2 * 16 + tid]; cph[b2 * 16 + tid] = run; run += c; } tot[tid] = run; }
        __syncthreads();
        if (tid < 2) { int off = 0, nt = 0; for (int e = 0; e < 8; ++e) { segoff[tid * 8 + e] = off; const int tl = (tot[tid * 8 + e] + 255) >> 8; for (int q = 0; q < tl; ++q) tile_e[tid * 160 + nt + q] = (unsigned char)e; nt += tl; off += tl * 256; } ntile[tid] = nt; }
        __syncthreads();
        for (int tb = vcu; tb < T / 128; tb += G) {
            int e0 = 0, e1 = 0, flip = 0;
            if (tid < 128) { const int m = tb * 128 + tid; e0 = toke[2 * m]; e1 = toke[2 * m + 1]; tpi[tid] = e0 * 8 + e1; }
            __syncthreads();
            if (tid < 128) { const int pi = e0 * 8 + e1; int rk = 0; for (int i = 0; i < tid; ++i) rk += (tpi[i] == pi) ? 1 : 0;
                flip = (pfx[tb * 64 + pi] + rk) < fq_[pi] ? 1 : 0; tex[tid] = flip ? e1 : e0; tex[128 + tid] = flip ? e0 : e1; }
            __syncthreads();
            if (tid < 128) { const int m = tb * 128 + tid;
#pragma unroll
                for (int ph = 0; ph < 2; ++ph) { const int e = tex[ph * 128 + tid]; int rk = 0; for (int i = 0; i < tid; ++i) rk += (tex[ph * 128 + i] == e) ? 1 : 0;
                    const int row = segoff[ph * 8 + e] + cph[tb * 16 + ph * 8 + e] + rk;
                    rowtok[ph * MOE_ROWS + row] = m; rowgate[ph * MOE_ROWS + row] = tokw[2 * m + (ph ^ flip)]; } }
            __syncthreads();
        }
    }
    GRID_BAR();

    if (PH(16))
#pragma unroll
    for (int s = 0; s < 2; ++s) {
        {
            PHASE_VARS
            SchedMoe S{(const GAS char*)HN8, (const GAS char*)WMGU8, rowtok + s * MOE_ROWS, tile_e + s * 160, 0, (size_t)2 * FFE * D, (size_t)256 * D, ntile[s], 2 * FFE / 256, G, bx, true, 0x7f7f7f7f};
            EpiSwiGLU<true> E{(GAS void*)ACTM, FFE};
            pg8::gemm_phase<EpiSwiGLU<true>, SchedMoe, true, true>(lds, wave_k, D, D, D, S, E);
        }
        GRID_BAR();
        {
            PHASE_VARS
            SchedMoe S{(const GAS char*)ACTM, (const GAS char*)WMD, rowtok + s * MOE_ROWS, tile_e + s * 160, (size_t)256 * FFE, (size_t)D * FFE, (size_t)256 * FFE, ntile[s], 4, G, bx, false, 0x7c7c7c7c};
            EpiMoeDown E{HB, rowtok + s * MOE_ROWS, rowgate + s * MOE_ROWS};
            pg8::gemm_phase<EpiMoeDown, SchedMoe, false, true>(lds, wave_k, FFE, FFE, FFE, S, E);
        }
        GRID_BAR();
    }

    if (PH(17)) {
        PHASE_VARS
        const bool bad = __hip_atomic_load((GAS unsigned*)(ws + WS_CTL) + CW_BAR + XB_TMO, RLX_AGENT) != 0u;
        for (int m = gw; m < T; m += NGW) {
            const GAS bf16* hrow = HB + (size_t)m * D; GAS float* orow = hres + (size_t)m * D;
            f32x4 v[4]; float s = 0.f;
#pragma unroll
            for (int jh = 0; jh < 2; ++jh) { const u32x4 xx = *(const GAS u32x4*)(hrow + 512 * jh + 8 * lane);
                v[2 * jh] = (f32x4){bf_lo(xx.x), bf_hi(xx.x), bf_lo(xx.y), bf_hi(xx.y)}; v[2 * jh + 1] = (f32x4){bf_lo(xx.z), bf_hi(xx.z), bf_lo(xx.w), bf_hi(xx.w)}; }
#pragma unroll
            for (int j = 0; j < 4; ++j) s += (v[j].x * v[j].x + v[j].y * v[j].y) + (v[j].z * v[j].z + v[j].w * v[j].w);
            const float r = bad ? __builtin_nanf("") : 1.0f / sqrtf(wave_sum(s) * (1.f / D) + EPS);
#pragma unroll
            for (int j = 0; j < 4; ++j) { const int col = rmsb_col(j, lane); *(GAS f32x4*)(orow + col) = v[j] * r * *(const GAS f32x4*)(final_norm + col); }
        }
    }
}

extern "C" void kernel_launch(void* const* d_in, const int* in_sizes, int n_in, void* d_out, int out_size, void* d_ws, size_t ws_size, hipStream_t stream) {
    static int grid = 0;
    if (grid == 0) {
        if (n_in != 16 || in_sizes[0] != T * D || out_size != T * D || ws_size < WS_END) { fprintf(stderr, "kernel_launch: unexpected shapes (n_in %d, in0 %d, out %d, ws %zu)\n", n_in, n_in > 0 ? in_sizes[0] : -1, out_size, ws_size); grid = -1; return; }
        int dev = 0, cus = 0, per_cu = 0;
        if (hipGetDevice(&dev) != hipSuccess || hipDeviceGetAttribute(&cus, hipDeviceAttributeMultiprocessorCount, dev) != hipSuccess) { grid = -1; return; }
        if (hipFuncSetAttribute((const void*)fwd_kernel, hipFuncAttributeMaxDynamicSharedMemorySize, LDS_BYTES) != hipSuccess) { fprintf(stderr, "kernel_launch: hipFuncSetAttribute failed\n"); grid = -1; return; }
        if (hipOccupancyMaxActiveBlocksPerMultiprocessor(&per_cu, (const void*)fwd_kernel, NWAVES * 64, LDS_BYTES) != hipSuccess || per_cu < 1) { fprintf(stderr, "kernel_launch: occupancy query says %d\n", per_cu); }
        (void)hipGetLastError();
        grid = cus;
    }
    if (grid < 0) return;
    if (hipMemsetAsync((char*)d_ws + WS_CTL, 0, CTL_ZERO_BYTES, stream) != hipSuccess) return;
    Args a{};
    for (int i = 0; i < 16; ++i) a.in[i] = (const float*)d_in[i];
    a.out = (float*)d_out; a.ws = (unsigned char*)d_ws;
    hipLaunchKernelGGL(fwd_kernel, dim3(grid), dim3(NWAVES * 64), LDS_BYTES, stream, a);
}
```

```cpp
#include <hip/hip_runtime.h>
#include <cstdio>
#include <cstdint>

#define LAS __attribute__((address_space(3)))
#define GAS __attribute__((address_space(1)))
typedef unsigned short bf16;
typedef short bf16x8 __attribute__((ext_vector_type(8)));
typedef float f32x2 __attribute__((ext_vector_type(2)));
typedef float f32x4 __attribute__((ext_vector_type(4)));
typedef float f32x16 __attribute__((ext_vector_type(16)));
typedef unsigned u32x2 __attribute__((ext_vector_type(2)));
typedef unsigned u32x4 __attribute__((ext_vector_type(4)));
typedef GAS unsigned gu32;

constexpr int D = 1024, NB = 8, SEQ = 4096, T = NB * SEQ;
constexpr int NH = 4, DK = 256, DV = 512, QKW = 1024, VW = 2048, INW = 6144, CH = 128, NCH = SEQ / CH;
constexpr int FFD = 2816, NE = 8, FFE = 3584;
constexpr int MOE_ROWS = T + NE * 256;
constexpr float EPS = 1e-6f;

constexpr size_t MiB = 1u << 20;
constexpr size_t WS_CTL = 0, CTL_ZERO_BYTES = 1 * MiB;
constexpr size_t WS_ROT = 1 * MiB, WS_ROTT = 5 * MiB, WS_WC = 10 * MiB + 768 * 1024;
constexpr int RTP = SEQ + 64;
constexpr size_t WS_TOKE = 9 * MiB + 256 * 1024;
constexpr size_t WS_TOKW = WS_TOKE + 256 * 1024;
constexpr size_t WS_BCNT = WS_TOKW + 256 * 1024;
constexpr size_t WS_ROWTOK = WS_BCNT + 16 * 1024;
constexpr size_t WS_ROWGATE = WS_ROWTOK + 2 * MOE_ROWS * 4;
constexpr size_t WS_PCNT = 10 * MiB + 512 * 1024;
constexpr size_t WS_STATS = 11 * MiB;
constexpr size_t WS_TW = 256 * 1024;
constexpr size_t WS_R0 = 64 * 1024;
constexpr size_t WS_SSQ1 = 1 * MiB, WS_SSQ2 = 3 * MiB;
static_assert(WS_ROWGATE + 2 * MOE_ROWS * 4 <= WS_PCNT, "small tables");
constexpr size_t WS_WIN = 12 * MiB, WS_WO = 24 * MiB, WS_WGU = 28 * MiB, WS_WD = 39 * MiB, WS_WF = 44 * MiB + 512 * 1024;
constexpr size_t WS_HN = 48 * MiB;
constexpr size_t WS_Q = 112 * MiB, WS_K = 176 * MiB, WS_KT = 240 * MiB  , WS_VT = 368 * MiB, WS_PC = 496 * MiB;
constexpr size_t WS_YG = 240 * MiB;
constexpr size_t WS_STATP = 176 * MiB;
constexpr size_t WS_ACTD = 112 * MiB;
constexpr size_t WS_Z2 = 112 * MiB, WS_WSEQ = 46 * MiB + 512 * 1024;
constexpr size_t WS_ACTM = 112 * MiB;
constexpr size_t WS_WMGU = 352 * MiB, WS_WMD = 464 * MiB, WS_END = 528 * MiB;
static_assert(WS_ACTM + (size_t)MOE_ROWS * FFE * 2 <= WS_WMGU, "moe act");
static_assert(WS_PC + (size_t)NB * NH * NCH * CH * CH * 2 <= 528 * MiB, "epoch A");
static_assert(WS_WF + (size_t)D * D * 2 <= WS_WSEQ && WS_WSEQ + 512 * 1024 * 2 <= WS_HN, "weights");
constexpr int CW_BAR = 4096;
constexpr int CW_CHK = 64;

constexpr int RING_BYTES = 131072;
constexpr int LDSCTL_OFF = 139264, MISC_OFF = LDSCTL_OFF + 320;
constexpr int LDS_BYTES = 163840;
constexpr int STG_OFF = 147456;

#define LDS_WAIT() asm volatile("s_waitcnt lgkmcnt(0)" ::: "memory")
#define VM_WAIT() asm volatile("s_waitcnt vmcnt(0)" ::: "memory")
#define RLX_AGENT __ATOMIC_RELAXED, __HIP_MEMORY_SCOPE_AGENT

__device__ __forceinline__ unsigned cvt_pk_bf16(float lo, float hi) { unsigned r; asm volatile("v_cvt_pk_bf16_f32 %0, %1, %2" : "=v"(r) : "v"(lo), "v"(hi)); return r; }
__device__ __forceinline__ unsigned pk4_fp8(float a, float b, float c, float d) { int w = 0; w = __builtin_amdgcn_cvt_pk_fp8_f32(a, b, w, false); w = __builtin_amdgcn_cvt_pk_fp8_f32(c, d, w, true); return (unsigned)w; }
__device__ __forceinline__ float bf_lo(unsigned w) { return __uint_as_float(w << 16); }
__device__ __forceinline__ float bf_hi(unsigned w) { return __uint_as_float(w & 0xffff0000u); }
__device__ __forceinline__ float fast_exp2(float x) { return __builtin_amdgcn_exp2f(x); }
__device__ __forceinline__ int lane_id_v() { int l; asm volatile("v_mbcnt_lo_u32_b32 %0, -1, 0\n\tv_mbcnt_hi_u32_b32 %0, -1, %0" : "=v"(l)); return l; }
__device__ __forceinline__ int tid_of(int wave_s) { asm volatile("" : "+s"(wave_s)); return wave_s * 64 + lane_id_v(); }
__device__ __forceinline__ int rot_col(int row, int tok) { return (tok + ((row & 15) << 11)) & (32768 - 1); }
__device__ __forceinline__ f32x4 swiglu4(const f32x4 g, const f32x4 u, const float tc, const float k) {
    const f32x4 t = g * tc;
    f32x4 e; e.x = __builtin_amdgcn_exp2f(t.x); e.y = __builtin_amdgcn_exp2f(t.y); e.z = __builtin_amdgcn_exp2f(t.z); e.w = __builtin_amdgcn_exp2f(t.w);
    const f32x4 d = e * k + k;
    f32x4 r; r.x = __builtin_amdgcn_rcpf(d.x); r.y = __builtin_amdgcn_rcpf(d.y); r.z = __builtin_amdgcn_rcpf(d.z); r.w = __builtin_amdgcn_rcpf(d.w);
    return (g * u) * r;
}
__device__ __forceinline__ float silu_f(float v) { return v * __builtin_amdgcn_rcpf(1.0f + __builtin_amdgcn_exp2f(v * -1.44269504088896341f)); }

namespace pg8 {
constexpr int BM = 256, BK = 64, HALF = 128, HTB = HALF * BK * 2, STAGE_BYTES = 8 * HTB, NXCD = 8, WGM = 2;
__host__ __device__ __forceinline__ int lds_byte(int r, int c) { const int st = (r >> 4) * 2 + (c >> 5), rr = r & 15, cc = c & 31, ob = rr * 64 + cc * 2; return st * 1024 + (ob ^ (((ob >> 9) & 1) << 5)); }
__host__ __device__ __forceinline__ void stage_rc(int b, int& R, int& C) { const int st = b / 1024, sb = b % 1024, swz = sb ^ (((sb >> 9) & 1) << 5); R = (st >> 1) * 16 + swz / 64; C = (st & 1) * 32 + (swz % 64) / 2; }
__host__ __device__ __forceinline__ int perm32(int rho) { const int n = rho >> 4, i = rho & 15; return 8 * (i >> 2) + 4 * n + (i & 3); }

struct Unit { const GAS char* A; const GAS char* B; const GAS int* rows; int pm, pn, z; };

__device__ __forceinline__ bool tile_of(long L, int nM, int nN, int& pm, int& pn) {
    const int nwg = nM * nN; if (L >= nwg) return false;
    int wgid = (int)L; { const int q = nwg / NXCD, r = nwg % NXCD, xcd = wgid % NXCD, off = wgid / NXCD; wgid = (xcd < r ? xcd * (q + 1) : r * (q + 1) + (xcd - r) * q) + off; }
    const int nig = WGM * nN, gid = wgid / nig, fm = gid * WGM, gsz = (nM - fm) < WGM ? (nM - fm) : WGM;
    pm = fm + ((wgid % nig) % gsz); pn = (wgid % nig) / gsz; return true;
}

template <class Epi, class Sched, bool GATHER, bool FP8 = false>
__device__ __forceinline__ void gemm_phase(LAS unsigned char* lds, const int wave_s, const int lda, const int ldb, const int K, const Sched& S, const Epi& E) {
    const int tid = tid_of(wave_s);
    const int wid = __builtin_amdgcn_readfirstlane(tid >> 6), lane = tid & 63, wr = wid >> 2, wc = wid & 3, fr = lane & 15, fq = lane >> 4;
    constexpr int ES = FP8 ? 1 : 2;
    const int nt = K * ES / (BK * 2);
    unsigned vA[2][2], vAn[2][2], voffB[2];
#pragma unroll
    for (int i = 0; i < 2; ++i) { int R, C; stage_rc(tid * 16 + i * 8192, R, C); const int Rb = Epi::PERM ? ((R & ~31) + perm32(R & 31)) : R;
        voffB[i] = (unsigned)(S.brow(Rb) * ldb * ES + C * 2);
#pragma unroll
        for (int h = 0; h < 2; ++h) { vA[h][i] = (unsigned)((h * HALF + R) * lda * ES + C * 2); vAn[h][i] = vA[h][i]; } }
    const size_t kstep = (size_t)(BK * 2);
    const size_t hstepB = (size_t)(S.brow(HALF) - S.brow(0)) * ldb * ES;
    const unsigned ldsw = (unsigned)wid * 1024u;
    const int aoff = lds_byte(wr * 64 + fr, fq * 8), boff = lds_byte(wc * 32 + fr, fq * 8);
    typedef int v4i_ __attribute__((ext_vector_type(4))); typedef int v8i_ __attribute__((ext_vector_type(8)));
    const int sc_w8 = S.scale_b8(), sc_a8 = S.scale_a8(); (void)sc_w8; (void)sc_a8;
#define PG8_SA(b, h) (((b) * 2 + (h)) * HTB)
#define PG8_SB(b, h) ((4 + (b) * 2 + (h)) * HTB)
#define PG8_STAGE_B(bufoff, gbase) do { _Pragma("unroll") for (int _i = 0; _i < 2; ++_i) \
        __builtin_amdgcn_global_load_lds((const GAS unsigned*)((const GAS char*)(gbase) + voffB[_i]), (LAS unsigned*)(lds + (bufoff) + ldsw + _i * 8192), 16, 0, 0); } while (0)
#define PG8_STAGE_A(bufoff, gbase, v0, v1) do { \
        __builtin_amdgcn_global_load_lds((const GAS unsigned*)((const GAS char*)(gbase) + (v0)), (LAS unsigned*)(lds + (bufoff) + ldsw), 16, 0, 0); \
        __builtin_amdgcn_global_load_lds((const GAS unsigned*)((const GAS char*)(gbase) + (v1)), (LAS unsigned*)(lds + (bufoff) + ldsw + 8192), 16, 0, 0); } while (0)
#define PG8_LD32(addr) __builtin_shufflevector(*(const LAS v4i_*)(addr), *(const LAS v4i_*)((addr) + 1024), 0, 1, 2, 3, 4, 5, 6, 7)
#define PG8_LDA(dst, b, h) do { _Pragma("unroll") for (int m = 0; m < 4; ++m) { if constexpr (FP8) dst##8[m] = PG8_LD32(lds + PG8_SA(b, h) + aoff + m * 2048); else { _Pragma("unroll") for (int k = 0; k < 2; ++k) dst[m][k] = *(const LAS bf16x8*)(lds + PG8_SA(b, h) + aoff + m * 2048 + k * 1024); } } } while (0)
#define PG8_LDB(dst, b, h) do { _Pragma("unroll") for (int n = 0; n < 2; ++n) { if constexpr (FP8) dst##8[n] = PG8_LD32(lds + PG8_SB(b, h) + boff + n * 2048); else { _Pragma("unroll") for (int k = 0; k < 2; ++k) dst[n][k] = *(const LAS bf16x8*)(lds + PG8_SB(b, h) + boff + n * 2048 + k * 1024); } } } while (0)
#define PG8_MMA(ai, bj, At, Bt) do { __builtin_amdgcn_s_setprio(1); _Pragma("unroll") for (int m = 0; m < 4; ++m) _Pragma("unroll") for (int n = 0; n < 2; ++n) { \
        if constexpr (FP8) asm volatile("v_mfma_scale_f32_16x16x128_f8f6f4 %0, %1, %2, %0, %3, %4 op_sel_hi:[0,0,0]" : "+v"(acc[ai][bj][m][n]) : "v"(Bt##8[n]), "v"(At##8[m]), "v"(sc_w8), "v"(sc_a8)); \
        else { _Pragma("unroll") for (int k = 0; k < 2; ++k) acc[ai][bj][m][n] = __builtin_amdgcn_mfma_f32_16x16x32_bf16(Bt[n][k], At[m][k], acc[ai][bj][m][n], 0, 0, 0); } } \
        __builtin_amdgcn_s_setprio(0); } while (0)
#define PG8_WAIT_V(n) asm volatile("s_waitcnt vmcnt(" #n ")" ::: "memory")
#define PG8_WAIT_L(n) asm volatile("s_waitcnt lgkmcnt(" #n ")" ::: "memory")
#define PG8_BAR __builtin_amdgcn_s_barrier()
#define PG8_SCHED __builtin_amdgcn_sched_barrier(0)
#define PG8_LOADROWS(dst, u) do { if constexpr (GATHER) { const int _tz = tid_of(wave_s); _Pragma("unroll") for (int _i = 0; _i < 2; ++_i) { int _R, _C; stage_rc(_tz * 16 + _i * 8192, _R, _C); \
        _Pragma("unroll") for (int _h = 0; _h < 2; ++_h) { const int _t = (u).rows[_h * HALF + _R]; dst[_h][_i] = (unsigned)((_t < 0 ? 0 : _t) * lda * ES + _C * 2); } } } } while (0)
#define PG8_VAN(h, i) (GATHER ? vAn[h][i] : vA[h][i])
    Unit cur, nxt; int ui = 0;
    if (!S.next(0, cur)) return;
    f32x4 acc[2][2][4][2];
#pragma unroll
    for (int a = 0; a < 2; ++a)
#pragma unroll
        for (int b = 0; b < 2; ++b)
#pragma unroll
            for (int m = 0; m < 4; ++m)
#pragma unroll
                for (int n = 0; n < 2; ++n) acc[a][b][m][n] = (f32x4){0.f, 0.f, 0.f, 0.f};
    bf16x8 At[4][2], B0[2][2], B1[2][2]; v8i_ At8[4], B08[2], B18[2]; (void)At; (void)B0; (void)B1; (void)At8; (void)B08; (void)B18;
    const GAS char* cA = cur.A; const GAS char* cB = cur.B;
    PG8_LOADROWS(vA, cur);
    if constexpr (GATHER) { vAn[0][0] = vA[0][0]; vAn[0][1] = vA[0][1]; vAn[1][0] = vA[1][0]; vAn[1][1] = vA[1][1]; }
    PG8_STAGE_B(PG8_SB(0, 0), cB); PG8_STAGE_B(PG8_SB(0, 1), cB + hstepB); PG8_STAGE_A(PG8_SA(0, 0), cA, vA[0][0], vA[0][1]); PG8_STAGE_A(PG8_SA(0, 1), cA, vA[1][0], vA[1][1]);
    if (wr == 1) PG8_BAR;
    PG8_WAIT_V(2); PG8_BAR;
    PG8_STAGE_B(PG8_SB(1, 0), cB + kstep); PG8_STAGE_A(PG8_SA(1, 0), cA + kstep, vA[0][0], vA[0][1]); PG8_STAGE_B(PG8_SB(1, 1), cB + hstepB + kstep);
    PG8_WAIT_V(6); PG8_BAR;
    for (;;) {
        const bool has_next = S.next(ui + 1, nxt);
        const GAS char* nA = has_next ? nxt.A : cA; const GAS char* nB = has_next ? nxt.B : cB;
#pragma unroll 1
        for (int t = 0; t < nt; t += 2) {
            const bool last = (t == nt - 2);
            const GAS char* a1 = cA + (size_t)(t + 1) * kstep;
            const GAS char* a2 = last ? nA : cA + (size_t)(t + 2) * kstep; const GAS char* b2 = last ? nB : cB + (size_t)(t + 2) * kstep;
            const GAS char* a3 = a2 + kstep; const GAS char* b3 = b2 + kstep;
            if constexpr (GATHER) { if (last && has_next) { PG8_LOADROWS(vAn, nxt); } }
            PG8_LDB(B0, 0, 0); PG8_LDB(B1, 0, 1); PG8_SCHED; PG8_LDA(At, 0, 0); PG8_STAGE_A(PG8_SA(1, 1), a1, vA[1][0], vA[1][1]);
            PG8_WAIT_V(8); PG8_WAIT_L(0); PG8_BAR; PG8_MMA(0, 0, At, B0); PG8_MMA(0, 1, At, B1); PG8_BAR; PG8_SCHED;
            PG8_LDA(At, 0, 1); PG8_STAGE_B(PG8_SB(0, 0), b2); PG8_STAGE_B(PG8_SB(0, 1), b2 + hstepB); PG8_STAGE_A(PG8_SA(0, 0), a2, PG8_VAN(0, 0), PG8_VAN(0, 1));
            PG8_WAIT_V(8); PG8_WAIT_L(0); PG8_BAR; PG8_MMA(1, 0, At, B0); PG8_MMA(1, 1, At, B1); PG8_BAR; PG8_SCHED;
            PG8_LDB(B0, 1, 0); PG8_LDB(B1, 1, 1); PG8_SCHED; PG8_LDA(At, 1, 0); PG8_STAGE_A(PG8_SA(0, 1), a2, PG8_VAN(1, 0), PG8_VAN(1, 1));
            PG8_WAIT_V(8); PG8_WAIT_L(0); PG8_BAR; PG8_MMA(0, 0, At, B0); PG8_MMA(0, 1, At, B1); PG8_BAR; PG8_SCHED;
            PG8_LDA(At, 1, 1); PG8_STAGE_B(PG8_SB(1, 0), b3); PG8_STAGE_B(PG8_SB(1, 1), b3 + hstepB); PG8_STAGE_A(PG8_SA(1, 0), a3, PG8_VAN(0, 0), PG8_VAN(0, 1));
            PG8_WAIT_V(8); PG8_WAIT_L(0); PG8_BAR; PG8_MMA(1, 0, At, B0); PG8_MMA(1, 1, At, B1); PG8_BAR; PG8_SCHED;
        }
        if (wr == 0) PG8_BAR;
        if constexpr (FP8) asm volatile("s_nop 15\n\ts_nop 15" ::: "memory");
        E(acc, cur, wr, wc, fr, fq);
        if (!has_next) break;
#pragma unroll
        for (int a = 0; a < 2; ++a)
#pragma unroll
            for (int b = 0; b < 2; ++b)
#pragma unroll
                for (int m = 0; m < 4; ++m)
#pragma unroll
                    for (int n = 0; n < 2; ++n) acc[a][b][m][n] = (f32x4){0.f, 0.f, 0.f, 0.f};
        cur = nxt; cA = nA; cB = nB; ++ui;
        if constexpr (GATHER) { vA[0][0] = vAn[0][0]; vA[0][1] = vAn[0][1]; vA[1][0] = vAn[1][0]; vA[1][1] = vAn[1][1]; }
        if (wr == 1) PG8_BAR;
    }
    PG8_WAIT_V(0);
    PG8_BAR;
#undef PG8_SA
#undef PG8_SB
#undef PG8_STAGE_A
#undef PG8_STAGE_B
#undef PG8_LDA
#undef PG8_LD32
#undef PG8_LDB
#undef PG8_MMA
#undef PG8_WAIT_V
#undef PG8_WAIT_L
#undef PG8_BAR
#undef PG8_SCHED
#undef PG8_LOADROWS
#undef PG8_VAN
}
}

struct SchedPlain {
    __device__ __forceinline__ int scale_b8() const { return 0x7f7f7f7f; }
    __device__ __forceinline__ int scale_a8() const { return 0x7f7f7f7f; }
    __device__ __forceinline__ int brow(int r) const { return r; }
    const GAS char* A; const GAS char* B; size_t a_tile, b_tile; int nM, nN, G, c; int flip4;
    __device__ __forceinline__ bool next(int i, pg8::Unit& u) const {
        int pm, pn; if (!pg8::tile_of((long)i * G + c, nM, nN, pm, pn)) return false;
        if (flip4 && ((pm >> 2) & 1)) pn ^= 4;
        u.pm = pm; u.pn = pn; u.z = 0; u.rows = nullptr; u.A = A + (size_t)pm * a_tile; u.B = B + (size_t)pn * b_tile; return true; }
};
struct SchedPlainF8 : SchedPlain {
    __device__ __forceinline__ int scale_b8() const { return 0x79797979; }
    __device__ __forceinline__ int scale_a8() const { return 0x7c7c7c7c; }
};
struct SchedPc {
    __device__ __forceinline__ int scale_b8() const { return 0x7f7f7f7f; }
    __device__ __forceinline__ int scale_a8() const { return 0x7f7f7f7f; }
    __device__ __forceinline__ int brow(int r) const { return r; }
    const GAS char* Q; const GAS char* Kk; int G, c;
    __device__ __forceinline__ bool next(int i, pg8::Unit& u) const {
        const int L = i * G + c; if (L >= NB * NH * 16) return false;
        const int cp = L & 15, h = (L >> 4) & 3, b = L >> 6;
        const size_t off = ((size_t)(b * SEQ + cp * 256) * QKW + h * DK) * 2;
        u.pm = L; u.pn = 0; u.z = h; u.rows = nullptr; u.A = Q + off; u.B = Kk + off; return true; }
};
struct SchedFnA {
    __device__ __forceinline__ int scale_b8() const { return 0x7f7f7f7f; }
    __device__ __forceinline__ int scale_a8() const { return 0x7f7f7f7f; }
    static __device__ __forceinline__ int aoff(int x) { return 8 * ((x >> 2) & 3) + 4 * (x >> 4) + (x & 3); }
    __device__ __forceinline__ int brow(int r) const { return aoff(r >> 3) + 512 * (r & 7); }
    const GAS char* Wc; const GAS char* Hn; int G, c;
    __device__ __forceinline__ bool next(int i, pg8::Unit& u) const {
        int pm, pn; if (!pg8::tile_of((long)i * G + c, 8, T / 256, pm, pn)) return false;
        const int g = pm >> 1, batch = pn >> 4, a0 = (pn & 15) * 32;
        u.pm = pm; u.pn = pn; u.z = 0; u.rows = nullptr; u.A = Wc + (size_t)pm * 256 * 256 * 2; u.B = Hn + ((size_t)(batch * SEQ + a0) * D + g * 256) * 2; return true; }
};
struct SchedFnB {
    __device__ __forceinline__ int scale_b8() const { return 0x7f7f7f7f; }
    __device__ __forceinline__ int scale_a8() const { return 0x7f7f7f7f; }
    __device__ __forceinline__ int brow(int r) const { return (r & 63) * 8 + (r >> 6); }
    GAS const char* WY; GAS const char* U; int G, c;
    __device__ __forceinline__ bool next(int i, pg8::Unit& u) const {
        int pm, pn; if (!pg8::tile_of((long)i * G + c, 2, 256, pm, pn)) return false;
        const int batch = pn >> 5, fb = (pn >> 1) & 15, kbb = pn & 1;
        u.pm = pm; u.pn = pn; u.z = 0; u.rows = nullptr; u.A = WY + (size_t)pm * 256 * 1024 * 2; u.B = U + ((size_t)(batch * 1024 + fb * 64) * 8 + kbb * 4) * 1024 * 2; return true; }
};
struct SchedMoe {
    __device__ __forceinline__ int scale_b8() const { return 0x79797979; }
    __device__ __forceinline__ int scale_a8() const { return sa8; }
    __device__ __forceinline__ int brow(int r) const { return r; }
    const GAS char* A; const GAS char* W; const GAS int* rowtok; const LAS unsigned char* texp; size_t a_tile, w_exp, w_tile; int ntiles, ncol, G, c; bool gather; int sa8;
    __device__ __forceinline__ bool next(int i, pg8::Unit& u) const {
        int rt, ct; if (!pg8::tile_of((long)i * G + c, ntiles, ncol, rt, ct)) return false;
        const int e = texp[rt];
        u.pm = rt; u.pn = ct; u.z = e; u.rows = rowtok + rt * 256; u.A = gather ? A : A + (size_t)rt * a_tile; u.B = W + (size_t)e * w_exp + (size_t)ct * w_tile; return true; }
};

struct EpiRopeQK {
    static constexpr bool PERM = true;
    GAS bf16* Q; GAS bf16* Kk; const GAS f32x2* rot; const GAS float* R0;
    GAS bf16* KT; const LAS float* l2g; LAS unsigned char* tscr;
    __device__ __forceinline__ void operator()(const f32x4 (&acc)[2][2][4][2], const pg8::Unit& u, int wr, int wc, int fr, int fq) const {
        const bool isk = u.pn >= 4; const int h = u.pn & 3; GAS bf16* dst = isk ? Kk : Q; const float sc0 = isk ? 0.0625f : 1.0f;
        const int i0 = wc * 32 + 8 * fq;
#pragma unroll
        for (int ai = 0; ai < 2; ++ai)
#pragma unroll
            for (int m = 0; m < 4; ++m) {
                const int t = u.pm * 256 + ai * 128 + wr * 64 + m * 16 + fr, s = t & (SEQ - 1); const float sc = sc0 * R0[t];
                const GAS f32x4* rp = (const GAS f32x4*)(rot + (size_t)s * 128 + i0);
                const f32x4 r0 = rp[0], r1 = rp[1], r2 = rp[2], r3 = rp[3];
                const float cs[8] = {r0[0], r0[2], r1[0], r1[2], r2[0], r2[2], r3[0], r3[2]}, sn[8] = {r0[1], r0[3], r1[1], r1[3], r2[1], r2[3], r3[1], r3[3]};
                float o1[8], o2[8];
#pragma unroll
                for (int n = 0; n < 2; ++n)
#pragma unroll
                    for (int j = 0; j < 4; ++j) { const float t1 = acc[ai][0][m][n][j], t2 = acc[ai][1][m][n][j]; const int q = 4 * n + j;
                        o1[q] = (t1 * cs[q] - t2 * sn[q]) * sc; o2[q] = (t1 * sn[q] + t2 * cs[q]) * sc; }
                GAS bf16* rowp = dst + (size_t)t * QKW + h * DK + i0;
                u32x4 w1, w2; w1.x = cvt_pk_bf16(o1[0], o1[1]); w1.y = cvt_pk_bf16(o1[2], o1[3]); w1.z = cvt_pk_bf16(o1[4], o1[5]); w1.w = cvt_pk_bf16(o1[6], o1[7]);
                w2.x = cvt_pk_bf16(o2[0], o2[1]); w2.y = cvt_pk_bf16(o2[2], o2[3]); w2.z = cvt_pk_bf16(o2[4], o2[5]); w2.w = cvt_pk_bf16(o2[6], o2[7]);
                *(GAS u32x4*)rowp = w1; *(GAS u32x4*)(rowp + 128) = w2;
                if (isk) {
                    const int jl = wr * 64 + m * 16 + fr;
                    const float zf = fast_exp2((float)(CH - 1 - jl) * l2g[h]), zb = fast_exp2((float)jl * l2g[4 + h]);
                    const int tok0 = u.pm * 256 + ai * 128 + wr * 64 + m * 16 + 8 * (fq >> 1);
                    const size_t fr0 = ((((size_t)((tok0 >> 12) * NH + h) * NCH + ((tok0 & (SEQ - 1)) >> 7)) * 8 + wc) * 8 + (4 * wr + m)) * 512 + (16 * (fq & 1) + fr + 32 * (fq >> 1)) * 8;
                    LAS unsigned char* my = tscr + (wr * 4 + wc) * 2048;
                    const unsigned tra = (unsigned)(size_t)my + (8 * (fq >> 1) + (fr >> 2)) * 64 + 32 * (fq & 1) + 8 * (fr & 3);
#pragma unroll
                    for (int cpy = 0; cpy < 2; ++cpy) { const float z = cpy ? zb : zf;
                        u32x4 a, b; a.x = cvt_pk_bf16(o1[0] * z, o1[1] * z); a.y = cvt_pk_bf16(o1[2] * z, o1[3] * z); a.z = cvt_pk_bf16(o1[4] * z, o1[5] * z); a.w = cvt_pk_bf16(o1[6] * z, o1[7] * z);
                        b.x = cvt_pk_bf16(o2[0] * z, o2[1] * z); b.y = cvt_pk_bf16(o2[2] * z, o2[3] * z); b.z = cvt_pk_bf16(o2[4] * z, o2[5] * z); b.w = cvt_pk_bf16(o2[6] * z, o2[7] * z);
                        *(LAS u32x4*)(my + fr * 64 + fq * 16) = a; *(LAS u32x4*)(my + 1024 + fr * 64 + fq * 16) = b;
                        u32x2 a0, a1, b0, b1;
                        asm volatile("s_waitcnt lgkmcnt(0)\n\tds_read_b64_tr_b16 %0, %4\n\tds_read_b64_tr_b16 %1, %4 offset:256\n\tds_read_b64_tr_b16 %2, %4 offset:1024\n\tds_read_b64_tr_b16 %3, %4 offset:1280\n\ts_waitcnt lgkmcnt(0)"
                                     : "=&v"(a0), "=&v"(a1), "=&v"(b0), "=&v"(b1) : "v"(tra) : "memory");
                        GAS bf16* kd = KT + (size_t)cpy * QKW * T + fr0;
                        *(GAS u32x4*)kd = (u32x4){a0.x, a0.y, a1.x, a1.y}; *(GAS u32x4*)(kd + (size_t)4 * 8 * 512) = (u32x4){b0.x, b0.y, b1.x, b1.y}; }
                } }
    }
};
struct EpiRopeKT {
    static constexpr bool PERM = true;
    GAS bf16* KT; const GAS f32x2* rotT; const LAS float* l2g; const GAS float* R0;
    __device__ __forceinline__ void operator()(const f32x4 (&acc)[2][2][4][2], const pg8::Unit& u, int wr, int wc, int fr, int fq) const {
        const int h = u.pm; const float l2f = l2g[h], l2b = l2g[4 + h];
#pragma unroll
        for (int bj = 0; bj < 2; ++bj) {
            const int tok0 = u.pn * 256 + bj * 128 + wc * 32 + 8 * fq, s0 = tok0 & (SEQ - 1), j0 = tok0 & (CH - 1);
            float zf[8], zb[8];
            const f32x4 ra = *(const GAS f32x4*)(R0 + tok0), rb = *(const GAS f32x4*)(R0 + tok0 + 4); const float rq[8] = {ra[0], ra[1], ra[2], ra[3], rb[0], rb[1], rb[2], rb[3]};
#pragma unroll
            for (int q = 0; q < 8; ++q) { const float rs = rq[q] * 0.0625f; zf[q] = fast_exp2((float)(CH - 1 - (j0 + q)) * l2f) * rs; zb[q] = fast_exp2((float)(j0 + q) * l2b) * rs; }
#pragma unroll
            for (int m = 0; m < 4; ++m) { const int i = wr * 64 + m * 16 + fr;
                const GAS f32x4* rp = (const GAS f32x4*)(rotT + (size_t)i * RTP + s0);
                const f32x4 r0 = rp[0], r1 = rp[1], r2 = rp[2], r3 = rp[3];
                const float cs[8] = {r0[0], r0[2], r1[0], r1[2], r2[0], r2[2], r3[0], r3[2]}, sn[8] = {r0[1], r0[3], r1[1], r1[3], r2[1], r2[3], r3[1], r3[3]};
                float o1[8], o2[8];
#pragma unroll
                for (int n = 0; n < 2; ++n)
#pragma unroll
                    for (int j = 0; j < 4; ++j) { const float t1 = acc[0][bj][m][n][j], t2 = acc[1][bj][m][n][j]; const int q = 4 * n + j;
                        o1[q] = t1 * cs[q] - t2 * sn[q]; o2[q] = t1 * sn[q] + t2 * cs[q]; }
                u32x4 w1, w2;
                w1.x = cvt_pk_bf16(o1[0] * zf[0], o1[1] * zf[1]); w1.y = cvt_pk_bf16(o1[2] * zf[2], o1[3] * zf[3]); w1.z = cvt_pk_bf16(o1[4] * zf[4], o1[5] * zf[5]); w1.w = cvt_pk_bf16(o1[6] * zf[6], o1[7] * zf[7]);
                w2.x = cvt_pk_bf16(o2[0] * zf[0], o2[1] * zf[1]); w2.y = cvt_pk_bf16(o2[2] * zf[2], o2[3] * zf[3]); w2.z = cvt_pk_bf16(o2[4] * zf[4], o2[5] * zf[5]); w2.w = cvt_pk_bf16(o2[6] * zf[6], o2[7] * zf[7]);
                const size_t fr0 = ((((size_t)((tok0 >> 12) * NH + h) * NCH + ((tok0 & (SEQ - 1)) >> 7)) * 8 + (i >> 5)) * 8 + (2 * wc + (fq >> 1))) * 512 + ((i & 31) + 32 * (fq & 1)) * 8;
                *(GAS u32x4*)(KT + fr0) = w1; *(GAS u32x4*)(KT + fr0 + (size_t)4 * 8 * 512) = w2;
                w1.x = cvt_pk_bf16(o1[0] * zb[0], o1[1] * zb[1]); w1.y = cvt_pk_bf16(o1[2] * zb[2], o1[3] * zb[3]); w1.z = cvt_pk_bf16(o1[4] * zb[4], o1[5] * zb[5]); w1.w = cvt_pk_bf16(o1[6] * zb[6], o1[7] * zb[7]);
                w2.x = cvt_pk_bf16(o2[0] * zb[0], o2[1] * zb[1]); w2.y = cvt_pk_bf16(o2[2] * zb[2], o2[3] * zb[3]); w2.z = cvt_pk_bf16(o2[4] * zb[4], o2[5] * zb[5]); w2.w = cvt_pk_bf16(o2[6] * zb[6], o2[7] * zb[7]);
                *(GAS u32x4*)(KT + (size_t)QKW * T + fr0) = w1; *(GAS u32x4*)(KT + (size_t)QKW * T + fr0 + (size_t)4 * 8 * 512) = w2; } }
    }
};
template <bool ROT> struct EpiBf16 {
    static constexpr bool PERM = true;
    GAS bf16* O; int ldc; const GAS float* cs;
    __device__ __forceinline__ void operator()(const f32x4 (&acc)[2][2][4][2], const pg8::Unit& u, int wr, int wc, int fr, int fq) const {
        f32x4 c0[2], c1[2];
#pragma unroll
        for (int bj = 0; bj < 2; ++bj) { const int col = u.pn * 256 + bj * 128 + wc * 32 + 8 * fq; c0[bj] = cs != nullptr ? *(const GAS f32x4*)(cs + col) : (f32x4){1.f, 1.f, 1.f, 1.f}; c1[bj] = cs != nullptr ? *(const GAS f32x4*)(cs + col + 4) : (f32x4){1.f, 1.f, 1.f, 1.f}; }
#pragma unroll
        for (int ai = 0; ai < 2; ++ai)
#pragma unroll
            for (int m = 0; m < 4; ++m) { const int row = u.pm * 256 + ai * 128 + wr * 64 + m * 16 + fr; GAS bf16* rowp = O + (size_t)row * ldc;
#pragma unroll
                for (int bj = 0; bj < 2; ++bj) { const f32x4 v0 = acc[ai][bj][m][0] * c0[bj], v1 = acc[ai][bj][m][1] * c1[bj]; const int col = u.pn * 256 + bj * 128 + wc * 32 + 8 * fq;
                    u32x4 w; w.x = cvt_pk_bf16(v0[0], v0[1]); w.y = cvt_pk_bf16(v0[2], v0[3]); w.z = cvt_pk_bf16(v1[0], v1[1]); w.w = cvt_pk_bf16(v1[2], v1[3]);
                    *(GAS u32x4*)(rowp + (ROT ? rot_col(row, col) : col)) = w; } }
    }
};
struct EpiPc {
    static constexpr bool PERM = true;
    GAS bf16* PC; GAS bf16* PD; const LAS float* l2g;
    __device__ __forceinline__ void operator()(const f32x4 (&acc)[2][2][4][2], const pg8::Unit& u, int wr, int wc, int fr, int fq) const {
        const int h = u.z; const float l2f = l2g[h], l2b = l2g[4 + h];
#pragma unroll
        for (int ai = 0; ai < 2; ++ai)
#pragma unroll
            for (int m = 0; m < 4; ++m) { const int il = wr * 64 + m * 16 + fr, jl0 = wc * 32 + 8 * fq; float o[8];
                const bool diag = (wc == 2 * wr + (m >> 1));
#pragma unroll
                for (int n = 0; n < 2; ++n)
#pragma unroll
                    for (int j = 0; j < 4; ++j) { const int dl = il - (jl0 + 4 * n + j); const float f = dl >= 0 ? fast_exp2((float)dl * l2f) : fast_exp2((float)(-dl) * l2b);
                        o[4 * n + j] = (ai == 0 ? acc[0][0][m][n][j] : acc[1][1][m][n][j]) * f; }
                if (diag) {
                    float ob[8];
#pragma unroll
                    for (int q = 0; q < 8; ++q) { const bool lower = (jl0 + q) <= il; ob[q] = lower ? 0.f : o[q]; o[q] = lower ? o[q] : 0.f; }
                    u32x4 wb; wb.x = cvt_pk_bf16(ob[0], ob[1]); wb.y = cvt_pk_bf16(ob[2], ob[3]); wb.z = cvt_pk_bf16(ob[4], ob[5]); wb.w = cvt_pk_bf16(ob[6], ob[7]);
                    *(GAS u32x4*)(PD + ((((size_t)(u.pm * 2 + ai) * 4 + (il >> 5)) * 2 + (fq >> 1)) * 512 + ((il & 31) + 32 * (fq & 1)) * 8)) = wb;
                }
                u32x4 w; w.x = cvt_pk_bf16(o[0], o[1]); w.y = cvt_pk_bf16(o[2], o[3]); w.z = cvt_pk_bf16(o[4], o[5]); w.w = cvt_pk_bf16(o[6], o[7]);
                *(GAS u32x4*)(PC + ((((size_t)(u.pm * 2 + ai) * 4 + (il >> 5)) * 8 + (2 * wc + (fq >> 1))) * 512 + ((il & 31) + 32 * (fq & 1)) * 8)) = w; }
    }
};
struct EpiGate {
    static constexpr bool PERM = true;
    const GAS bf16* Y; GAS bf16* YG; const GAS f32x2* statp; const GAS float* gain; LAS f32x2* sst; const GAS float* R0;
    __device__ __forceinline__ void operator()(const f32x4 (&acc)[2][2][4][2], const pg8::Unit& u, int wr, int wc, int fr, int fq) const {
        const int head = u.pn >> 1, c0 = u.pn * 256 + wc * 32 + 8 * fq;
        const int tid = (wr * 4 + wc) * 64 + fq * 16 + fr;
        if (tid < 256) { const int t = u.pm * 256 + tid; const GAS f32x4* sp = (const GAS f32x4*)(statp + ((size_t)t * 4 + head) * 8); float a1 = 0.f, a2 = 0.f;
#pragma unroll
            for (int k = 0; k < 4; ++k) { const f32x4 v = sp[k]; a1 += v[0] + v[2]; a2 += v[1] + v[3]; }
            const float mu = a1 * (1.f / DV), var = fmaxf(a2 * (1.f / DV) - mu * mu, 0.f); sst[tid] = (f32x2){mu, __builtin_amdgcn_rsqf(var + EPS)}; }
        asm volatile("s_waitcnt lgkmcnt(0)" ::: "memory"); __builtin_amdgcn_s_barrier(); asm volatile("" ::: "memory");
        f32x4 gv[2][2];
#pragma unroll
        for (int bj = 0; bj < 2; ++bj) { gv[bj][0] = *(const GAS f32x4*)(gain + c0 + bj * 128); gv[bj][1] = *(const GAS f32x4*)(gain + c0 + bj * 128 + 4); }
#pragma unroll
        for (int ai = 0; ai < 2; ++ai)
#pragma unroll
            for (int m = 0; m < 4; ++m) { const int rl = ai * 128 + wr * 64 + m * 16 + fr, t = u.pm * 256 + rl; const f32x2 st = sst[rl]; const float r0 = R0[t];
#pragma unroll
                for (int bj = 0; bj < 2; ++bj) { const size_t off = (size_t)t * VW + c0 + bj * 128;
                    const int es_ = (u.pn & 1) * 4 + bj * 2 + (wc >> 1);
                    const u32x4 yv = *(const GAS u32x4*)(Y + (((size_t)(t >> 5) * NH + head) * 8 + es_) * 2048 + (((wc & 1) * 2 + (fq >> 1)) * 64 + (t & 31) + 32 * (fq & 1)) * 8);
                    const f32x4 yv4[2] = {(f32x4){bf_lo(yv.x), bf_hi(yv.x), bf_lo(yv.y), bf_hi(yv.y)}, (f32x4){bf_lo(yv.z), bf_hi(yv.z), bf_lo(yv.w), bf_hi(yv.w)}}; float o[8];
                    const float c1 = st.y * r0;
#pragma unroll
                    for (int n = 0; n < 2; ++n) { const f32x4 yn = (yv4[n] - st.x) * gv[bj][n] * c1;
                        const f32x4 ov = swiglu4(acc[ai][bj][m][n], yn, -1.44269504088896341f * r0, 1.0f); o[4 * n] = ov.x; o[4 * n + 1] = ov.y; o[4 * n + 2] = ov.z; o[4 * n + 3] = ov.w; }
                    u32x4 w; w.x = cvt_pk_bf16(o[0], o[1]); w.y = cvt_pk_bf16(o[2], o[3]); w.z = cvt_pk_bf16(o[4], o[5]); w.w = cvt_pk_bf16(o[6], o[7]);
                    *(GAS u32x4*)(YG + off) = w; } }
    }
};
template <bool BASE_F32> struct EpiRes {
    static constexpr bool PERM = true;
    const GAS void* base; GAS bf16* out; GAS float* ssq;
    __device__ __forceinline__ void operator()(const f32x4 (&acc)[2][2][4][2], const pg8::Unit& u, int wr, int wc, int fr, int fq) const {
#pragma unroll
        for (int ai = 0; ai < 2; ++ai)
#pragma unroll
            for (int m = 0; m < 4; ++m) { const int t_ = u.pm * 256 + ai * 128 + wr * 64 + m * 16 + fr; const size_t off = (size_t)t_ * D + u.pn * 256 + wc * 32 + 8 * fq; float sq = 0.f;
#pragma unroll
                for (int bj = 0; bj < 2; ++bj) { f32x4 v0 = acc[ai][bj][m][0], v1 = acc[ai][bj][m][1];
                    if (BASE_F32) { const GAS float* bp = (const GAS float*)base + off + bj * 128; v0 += *(const GAS f32x4*)bp; v1 += *(const GAS f32x4*)(bp + 4); }
                    else { const u32x4 bv = *(const GAS u32x4*)((const GAS bf16*)base + off + bj * 128);
                        v0 += (f32x4){bf_lo(bv.x), bf_hi(bv.x), bf_lo(bv.y), bf_hi(bv.y)}; v1 += (f32x4){bf_lo(bv.z), bf_hi(bv.z), bf_lo(bv.w), bf_hi(bv.w)}; }
                    u32x4 w; w.x = cvt_pk_bf16(v0[0], v0[1]); w.y = cvt_pk_bf16(v0[2], v0[3]); w.z = cvt_pk_bf16(v1[0], v1[1]); w.w = cvt_pk_bf16(v1[2], v1[3]);
                    *(GAS u32x4*)(out + off + bj * 128) = w;
                    { const float a0 = bf_lo(w.x), a1 = bf_hi(w.x), a2 = bf_lo(w.y), a3 = bf_hi(w.y), a4 = bf_lo(w.z), a5 = bf_hi(w.z), a6 = bf_lo(w.w), a7 = bf_hi(w.w);
                      sq += (a0 * a0 + a1 * a1) + (a2 * a2 + a3 * a3) + (a4 * a4 + a5 * a5) + (a6 * a6 + a7 * a7); } }
                sq += __shfl_xor(sq, 16); sq += __shfl_xor(sq, 32);
                if (ssq != nullptr && fq == 0) ssq[(size_t)t_ * 16 + u.pn * 4 + wc] = sq; }
    }
};
template <bool OUT8, bool NORM = false> struct EpiSwiGLU {
    static constexpr bool PERM = true;
    GAS void* ACT; int ldc; const GAS float* ssq; LAS float* sst;
    __device__ __forceinline__ void operator()(const f32x4 (&acc)[2][2][4][2], const pg8::Unit& u, int wr, int wc, int fr, int fq) const {
        if constexpr (NORM) {
            const int tid = (wr * 4 + wc) * 64 + fq * 16 + fr;
            if (tid < 256) { const GAS f32x4* sp = (const GAS f32x4*)(ssq + (size_t)(u.pm * 256 + tid) * 16); float a = 0.f;
#pragma unroll
                for (int k = 0; k < 4; ++k) { const f32x4 v = sp[k]; a += (v[0] + v[1]) + (v[2] + v[3]); }
                const float var = a * (1.f / D) + EPS; ((LAS f32x2*)sst)[tid] = (f32x2){__builtin_amdgcn_rsqf(var), var}; }
            asm volatile("s_waitcnt lgkmcnt(0)" ::: "memory"); __builtin_amdgcn_s_barrier(); asm volatile("" ::: "memory");
        }
#pragma unroll
        for (int ai = 0; ai < 2; ++ai)
#pragma unroll
            for (int m = 0; m < 4; ++m) { float o[8]; float tc = -1.44269504088896341f, kk = OUT8 ? 0.125f : 1.0f;
                if constexpr (NORM) { const f32x2 sv = ((const LAS f32x2*)sst)[ai * 128 + wr * 64 + m * 16 + fr]; tc *= sv.x; kk *= sv.y; }
#pragma unroll
                for (int n = 0; n < 2; ++n) { const f32x4 ov = swiglu4(acc[ai][0][m][n], acc[ai][1][m][n], tc, kk); o[4 * n] = ov.x; o[4 * n + 1] = ov.y; o[4 * n + 2] = ov.z; o[4 * n + 3] = ov.w; }
                const size_t off = (size_t)(u.pm * 256 + ai * 128 + wr * 64 + m * 16 + fr) * ldc + u.pn * 128 + wc * 32 + 8 * fq;
                if constexpr (OUT8) { u32x2 w; w.x = pk4_fp8(o[0], o[1], o[2], o[3]); w.y = pk4_fp8(o[4], o[5], o[6], o[7]); *(GAS u32x2*)((GAS unsigned char*)ACT + off) = w; }
                else { u32x4 w; w.x = cvt_pk_bf16(o[0], o[1]); w.y = cvt_pk_bf16(o[2], o[3]); w.z = cvt_pk_bf16(o[4], o[5]); w.w = cvt_pk_bf16(o[6], o[7]); *(GAS u32x4*)((GAS bf16*)ACT + off) = w; } }
    }
};
__device__ __forceinline__ void fft8(const float (&xr)[8], const float (&xi)[8], float (&Xr)[8], float (&Xi)[8]) {
    constexpr float R = 0.70710678118654752f;
    float ar[4], ai[4], br[4], bi[4];
#pragma unroll
    for (int n = 0; n < 4; ++n) { ar[n] = xr[n] + xr[n + 4]; ai[n] = xi[n] + xi[n + 4]; br[n] = xr[n] - xr[n + 4]; bi[n] = xi[n] - xi[n + 4]; }
    { const float r = br[1], i = bi[1]; br[1] = (r + i) * R; bi[1] = (i - r) * R; }
    { const float r = br[2], i = bi[2]; br[2] = i; bi[2] = -r; }
    { const float r = br[3], i = bi[3]; br[3] = (i - r) * R; bi[3] = -(i + r) * R; }
    { const float t0r = ar[0] + ar[2], t0i = ai[0] + ai[2], t1r = ar[0] - ar[2], t1i = ai[0] - ai[2], t2r = ar[1] + ar[3], t2i = ai[1] + ai[3], t3r = ai[1] - ai[3], t3i = -(ar[1] - ar[3]);
      Xr[0] = t0r + t2r; Xi[0] = t0i + t2i; Xr[4] = t0r - t2r; Xi[4] = t0i - t2i; Xr[2] = t1r + t3r; Xi[2] = t1i + t3i; Xr[6] = t1r - t3r; Xi[6] = t1i - t3i; }
    { const float t0r = br[0] + br[2], t0i = bi[0] + bi[2], t1r = br[0] - br[2], t1i = bi[0] - bi[2], t2r = br[1] + br[3], t2i = bi[1] + bi[3], t3r = bi[1] - bi[3], t3i = -(br[1] - br[3]);
      Xr[1] = t0r + t2r; Xi[1] = t0i + t2i; Xr[5] = t0r - t2r; Xi[5] = t0i - t2i; Xr[3] = t1r + t3r; Xi[3] = t1i + t3i; Xr[7] = t1r - t3r; Xi[7] = t1i - t3i; }
}
struct EpiZ2 {
    static constexpr bool PERM = true;
    GAS bf16* Z2; const GAS float* ssq; LAS float* sst; const GAS f32x2* TW;
    __device__ __forceinline__ void operator()(const f32x4 (&acc)[2][2][4][2], const pg8::Unit& u, int wr, int wc, int fr, int fq) const {
        asm volatile("" : "+v"(fr), "+v"(fq));
        const int g = u.pm >> 1, hf = u.pm & 1, batch = u.pn >> 4, a0 = (u.pn & 15) * 32;
        { int tid = (wr * 4 + wc) * 64 + fq * 16 + fr; asm volatile("" : "+v"(tid));
          if (tid < 256) { const int tok = batch * SEQ + a0 + SchedFnA::aoff(tid >> 3) + 512 * (tid & 7); const GAS f32x4* sp = (const GAS f32x4*)(ssq + (size_t)tok * 16); float a = 0.f;
#pragma unroll
              for (int k = 0; k < 4; ++k) { const f32x4 v = sp[k]; a += (v[0] + v[1]) + (v[2] + v[3]); }
              sst[tid] = __builtin_amdgcn_rsqf(a * (1.f / D) + EPS); }
          asm volatile("s_waitcnt lgkmcnt(0)" ::: "memory"); __builtin_amdgcn_s_barrier(); asm volatile("" ::: "memory"); }
        float w1c[2], w1s[2];
#pragma unroll
        for (int bj = 0; bj < 2; ++bj) { const f32x2 t = TW[(a0 + 8 * wc + 4 * bj + fq) * 8 + 1]; w1c[bj] = t.x; w1s[bj] = t.y; }
#pragma unroll
        for (int m = 0; m < 4; ++m) { const int f = g * 256 + hf * 128 + wr * 64 + m * 16 + fr;
            unsigned pk[2][8];
#pragma unroll
            for (int bj = 0; bj < 2; ++bj) {
                float zr[8], zi[8], o[16];
                { const LAS f32x4* rp = (const LAS f32x4*)(sst + bj * 128 + wc * 32 + 8 * fq); const f32x4 r0 = rp[0], r1 = rp[1];
                  const float rs[8] = {r0[0], r0[1], r0[2], r0[3], r1[0], r1[1], r1[2], r1[3]};
#pragma unroll
                  for (int bb = 0; bb < 8; ++bb) { zr[bb] = acc[0][bj][m][bb >> 2][bb & 3] * rs[bb]; zi[bb] = acc[1][bj][m][bb >> 2][bb & 3] * rs[bb]; } }
                float Ur[8], Ui[8]; fft8(zr, zi, Ur, Ui);
                float tc = 1.f, ts = 0.f;
#pragma unroll
                for (int kb = 0; kb < 8; ++kb) {
                    o[kb] = Ur[kb] * tc + Ui[kb] * ts; o[8 + kb] = Ui[kb] * tc - Ur[kb] * ts;
                    { const float nc = tc * w1c[bj] - ts * w1s[bj], ns = ts * w1c[bj] + tc * w1s[bj]; tc = nc; ts = ns; } }
#pragma unroll
                for (int k = 0; k < 8; ++k) pk[bj][k] = cvt_pk_bf16(o[2 * k], o[2 * k + 1]);
            }
            u32x4 vec[4];
#pragma unroll
            for (int bj = 0; bj < 2; ++bj)
#pragma unroll
                for (int sp = 0; sp < 2; ++sp) {
                    unsigned g0 = pk[bj][0 + sp], g1 = pk[bj][2 + sp], g2 = pk[bj][4 + sp], g3 = pk[bj][6 + sp];
                    { const auto r_ = __builtin_amdgcn_permlane16_swap(g0, g1, false, false); g0 = r_[0]; g1 = r_[1]; }
                    { const auto r_ = __builtin_amdgcn_permlane16_swap(g2, g3, false, false); g2 = r_[0]; g3 = r_[1]; }
                    { const auto r_ = __builtin_amdgcn_permlane32_swap(g0, g2, false, false); g0 = r_[0]; g2 = r_[1]; }
                    { const auto r_ = __builtin_amdgcn_permlane32_swap(g1, g3, false, false); g1 = r_[0]; g3 = r_[1]; }
                    const unsigned lo01 = __builtin_amdgcn_perm(g1, g0, 0x05040100u), lo23 = __builtin_amdgcn_perm(g3, g2, 0x05040100u);
                    const unsigned hi01 = __builtin_amdgcn_perm(g1, g0, 0x07060302u), hi23 = __builtin_amdgcn_perm(g3, g2, 0x07060302u);
                    vec[2 * sp][2 * bj] = lo01; vec[2 * sp][2 * bj + 1] = lo23; vec[2 * sp + 1][2 * bj] = hi01; vec[2 * sp + 1][2 * bj + 1] = hi23; }
#pragma unroll
            for (int sidx = 0; sidx < 4; ++sidx) { const int q = 4 * fq + sidx, ri = q >> 3, kb = q & 7;
                *(GAS u32x4*)(Z2 + ((size_t)(batch * 1024 + f) * 8 + kb) * 1024 + ri * 512 + a0 + 8 * wc) = vec[sidx]; }
        }
    }
};
struct EpiYf {
    static constexpr bool PERM = true;
    GAS bf16* YF;
    __device__ __forceinline__ void operator()(const f32x4 (&acc)[2][2][4][2], const pg8::Unit& u, int wr, int wc, int fr, int fq) const {
        const int batch = u.pn >> 5, fb = (u.pn >> 1) & 15, kbb = u.pn & 1;
#pragma unroll
        for (int ai = 0; ai < 2; ++ai)
#pragma unroll
            for (int m = 0; m < 4; ++m) { const int ka = u.pm * 256 + ai * 128 + wr * 64 + m * 16 + fr;
#pragma unroll
                for (int bj = 0; bj < 2; ++bj) { const int kb = kbb * 4 + 2 * bj + (wc >> 1), f = fb * 64 + 32 * (wc & 1) + 8 * fq;
                    const f32x4 v0 = acc[ai][bj][m][0], v1 = acc[ai][bj][m][1];
                    u32x4 w; w.x = cvt_pk_bf16(v0[0], v0[1]); w.y = cvt_pk_bf16(v0[2], v0[3]); w.z = cvt_pk_bf16(v1[0], v1[1]); w.w = cvt_pk_bf16(v1[2], v1[3]);
                    *(GAS u32x4*)(YF + (size_t)(batch * SEQ + 8 * ka + kb) * D + f) = w; } }
    }
};
struct EpiMoeDown {
    static constexpr bool PERM = true;
    GAS bf16* Hres; const GAS int* rowtok; const GAS float* rowgate;
    __device__ __forceinline__ void operator()(const f32x4 (&acc)[2][2][4][2], const pg8::Unit& u, int wr, int wc, int fr, int fq) const {
#pragma unroll
        for (int ai = 0; ai < 2; ++ai)
#pragma unroll
            for (int m = 0; m < 4; ++m) { const int row = u.pm * 256 + ai * 128 + wr * 64 + m * 16 + fr; const int tok = rowtok[row]; const float gw = rowgate[row];
                if (tok >= 0) { GAS bf16* rp = Hres + (size_t)tok * D + u.pn * 256 + wc * 32 + 8 * fq;
#pragma unroll
                    for (int bj = 0; bj < 2; ++bj) { const u32x4 bv = *(const GAS u32x4*)(rp + bj * 128);
                        const f32x4 v0 = (f32x4){bf_lo(bv.x), bf_hi(bv.x), bf_lo(bv.y), bf_hi(bv.y)} + gw * acc[ai][bj][m][0], v1 = (f32x4){bf_lo(bv.z), bf_hi(bv.z), bf_lo(bv.w), bf_hi(bv.w)} + gw * acc[ai][bj][m][1];
                        u32x4 w; w.x = cvt_pk_bf16(v0[0], v0[1]); w.y = cvt_pk_bf16(v0[2], v0[3]); w.z = cvt_pk_bf16(v1[0], v1[1]); w.w = cvt_pk_bf16(v1[2], v1[3]);
                        *(GAS u32x4*)(rp + bj * 128) = w; } } }
    }
};

#define XB_TMO      128
#define XB_XCNT(j)  (256  + 64 * (j))
#define XB_XSUB(j)  (1280 + 64 * (j))
#define XB_XGEN(j)  (2304 + 64 * (j))
#define XB_TOP      3328
#define XB_TOPGEN   3392
#define XCD_BAR_WORDS 3456
#define XB_SPIN_CAP (1u << 18)
__device__ __forceinline__ unsigned xb_ld(unsigned* p)              { return __hip_atomic_load(p, __ATOMIC_RELAXED, __HIP_MEMORY_SCOPE_AGENT); }
__device__ __forceinline__ unsigned xb_add(unsigned* p, unsigned v) { return __hip_atomic_fetch_add(p, v, __ATOMIC_RELAXED, __HIP_MEMORY_SCOPE_AGENT); }
__device__ __forceinline__ unsigned xb_xcc_id() { return (unsigned)__builtin_amdgcn_s_getreg((3 << 11) | 20) & 0xFu; }
#define XB_SPIN(cond, bar) do { unsigned _sp = 0; while (cond) { __builtin_amdgcn_s_sleep(1); \
    if ((++_sp & 255u) == 0u) { if (xb_ld(&(bar)[XB_TMO])) break; if (_sp > XB_SPIN_CAP) { atomicAdd(&(bar)[XB_TMO], 1u); break; } } } } while (0)
struct XcdBarrier { unsigned* bar; unsigned x; volatile LAS unsigned* st; };
__device__ __forceinline__ XcdBarrier xcd_barrier_post(unsigned* bar, volatile LAS unsigned* st, const bool t0) {
    XcdBarrier b; b.bar = bar; b.x = xb_xcc_id(); b.st = st;
    if (t0) (void)xb_add(&bar[XB_XCNT(b.x)], 1u);
    return b;
}
__device__ __forceinline__ void xcd_barrier_complete(unsigned* bar, unsigned x, unsigned& nloc, unsigned& nx) {
    const unsigned G = gridDim.x * gridDim.y * gridDim.z;
    unsigned sum, cnt, mine, sp = 0u;
    for (;;) {
        sum = 0u; cnt = 0u; mine = 0u;
#pragma unroll
        for (unsigned j = 0; j < 16; ++j) { const unsigned c = xb_ld(&bar[XB_XCNT(j)]); sum += c; cnt += (c > 0u) ? 1u : 0u; mine = (j == x) ? c : mine; }
        if (sum == G) break;
        __builtin_amdgcn_s_sleep(1);
        if ((++sp & 255u) == 0u) { if (xb_ld(&bar[XB_TMO])) break; if (sp > XB_SPIN_CAP) { atomicAdd(&bar[XB_TMO], 1u); break; } }
    }
    nloc = mine > 0u ? mine : 1u; nx = cnt > 0u ? cnt : 1u;
}
__device__ __forceinline__ void xcd_barrier(const XcdBarrier& b, const bool t0) {
    asm volatile("s_waitcnt vmcnt(0)" ::: "memory");
    __syncthreads();
    if (t0) {
        unsigned* bar = b.bar;
        __builtin_amdgcn_s_waitcnt(0);
        unsigned nloc = b.st[0], nx = b.st[1];
        if (nloc == 0u) { xcd_barrier_complete(bar, b.x, nloc, nx); b.st[0] = nloc; b.st[1] = nx; }
        const unsigned old = xb_add(&bar[XB_XSUB(b.x)], 1u);
        const unsigned gen = old / nloc;
        if (old + 1u == (gen + 1u) * nloc) {
            __builtin_amdgcn_fence(__ATOMIC_RELEASE, "agent");
            asm volatile("s_waitcnt vmcnt(0)" ::: "memory");
            const unsigned og = xb_add(&bar[XB_TOP], 1u);
            const unsigned tg = og / nx;
            if (og + 1u == (tg + 1u) * nx) xb_add(&bar[XB_TOPGEN], 1u);
            else XB_SPIN(xb_ld(&bar[XB_TOPGEN]) == tg, bar);
            __builtin_amdgcn_fence(__ATOMIC_ACQUIRE, "agent");
            xb_add(&bar[XB_XGEN(b.x)], 1u);
            asm volatile("s_waitcnt vmcnt(0)" ::: "memory");
        } else {
            XB_SPIN(xb_ld(&bar[XB_XGEN(b.x)]) == gen, bar);
            __builtin_amdgcn_fence(__ATOMIC_ACQUIRE, "agent");
            asm volatile("s_waitcnt vmcnt(0)" ::: "memory");
        }
    }
    __syncthreads();
}

__device__ __forceinline__ float wave_sum(float v) {
#pragma unroll
    for (int o = 1; o < 64; o <<= 1) v += __shfl_xor(v, o);
    return v;
}
__device__ __forceinline__ void transpose_item(const GAS float* W, int K, int N, GAS bf16* WT, int k0, int n0, int rbase, LAS float* scr, int lane, const GAS float* gk = nullptr) {
#pragma unroll 8
    for (int i = 0; i < 32; ++i) { const int kk = 2 * i + (lane >> 5); float wv = W[(size_t)(k0 + kk) * N + n0 + (lane & 31)]; if (gk != nullptr) wv *= gk[k0 + kk]; scr[kk * 33 + (lane & 31)] = wv; }
    LDS_WAIT(); asm volatile("" ::: "memory");
    const int c = lane & 7;
#pragma unroll
    for (int j = 0; j < 4; ++j) { const int n = (lane >> 3) + 8 * j; const LAS float* s = scr + (8 * c) * 33 + n;
        u32x4 o; o.x = cvt_pk_bf16(s[0 * 33], s[1 * 33]); o.y = cvt_pk_bf16(s[2 * 33], s[3 * 33]); o.z = cvt_pk_bf16(s[4 * 33], s[5 * 33]); o.w = cvt_pk_bf16(s[6 * 33], s[7 * 33]);
        *(GAS u32x4*)(WT + (size_t)(rbase + n) * K + k0 + 8 * c) = o; }
    LDS_WAIT(); asm volatile("" ::: "memory");
}
__device__ __forceinline__ void transpose_item8(const GAS float* W, int K, int N, GAS unsigned char* WT8, int k0, int n0, int rbase, float scale, LAS float* scr, int lane) {
#pragma unroll 8
    for (int i = 0; i < 32; ++i) { const int kk = 2 * i + (lane >> 5); scr[kk * 33 + (lane & 31)] = W[(size_t)(k0 + kk) * N + n0 + (lane & 31)]; }
    LDS_WAIT(); asm volatile("" ::: "memory");
    const int c = lane & 7;
#pragma unroll
    for (int j = 0; j < 4; ++j) { const int n = (lane >> 3) + 8 * j; const LAS float* sp = scr + (8 * c) * 33 + n;
        u32x2 o; o.x = pk4_fp8(sp[0 * 33] * scale, sp[1 * 33] * scale, sp[2 * 33] * scale, sp[3 * 33] * scale); o.y = pk4_fp8(sp[4 * 33] * scale, sp[5 * 33] * scale, sp[6 * 33] * scale, sp[7 * 33] * scale);
        *(GAS u32x2*)(WT8 + (size_t)(rbase + n) * K + k0 + 8 * c) = o; }
    LDS_WAIT(); asm volatile("" ::: "memory");
}
__device__ __forceinline__ void tr_gu8(const GAS float* Wg, const GAS float* Wu, int K, int N, GAS unsigned char* WT8, int it, LAS float* scr, int lane) {
    const int nblk = N / 32, per = (K / 64) * nblk; const bool up = it >= per; if (up) it -= per;
    const int kb = it / nblk, nb = it - kb * nblk, f0 = 32 * nb;
    transpose_item8(up ? Wu : Wg, K, N, WT8, 64 * kb, f0, 256 * (f0 >> 7) + (up ? 128 : 0) + (f0 & 127), 64.0f, scr, lane);
}
__device__ __forceinline__ void tr_plain(const GAS float* W, int K, int N, GAS bf16* WT, int it, LAS float* scr, int lane, const GAS float* gk = nullptr) {
    const int nblk = N / 32, kb = it / nblk, nb = it - kb * nblk; transpose_item(W, K, N, WT, 64 * kb, 32 * nb, 32 * nb, scr, lane, gk);
}
__device__ __forceinline__ void tr_gu(const GAS float* Wg, const GAS float* Wu, int K, int N, GAS bf16* WT, int it, LAS float* scr, int lane, const GAS float* gk = nullptr) {
    const int nblk = N / 32, per = (K / 64) * nblk; const bool up = it >= per; if (up) it -= per;
    const int kb = it / nblk, nb = it - kb * nblk, f0 = 32 * nb;
    transpose_item(up ? Wu : Wg, K, N, WT, 64 * kb, f0, 256 * (f0 >> 7) + (up ? 128 : 0) + (f0 & 127), scr, lane, gk);
}
__device__ __forceinline__ void rms_row(const GAS float* xrow, const GAS float* g, GAS bf16* orow, int lane, f32x4 (&v)[4]) {
    const GAS f32x4* xr = (const GAS f32x4*)xrow + lane; const GAS f32x4* gr = (const GAS f32x4*)g + lane;
    float s = 0.f;
#pragma unroll
    for (int j = 0; j < 4; ++j) { v[j] = xr[64 * j]; s += (v[j].x * v[j].x + v[j].y * v[j].y) + (v[j].z * v[j].z + v[j].w * v[j].w); }
    const float r = 1.0f / sqrtf(wave_sum(s) * (1.f / D) + EPS);
    GAS u32x2* o8 = (GAS u32x2*)orow + lane;
#pragma unroll
    for (int j = 0; j < 4; ++j) { v[j] = v[j] * r * gr[64 * j]; u32x2 w; w.x = cvt_pk_bf16(v[j].x, v[j].y); w.y = cvt_pk_bf16(v[j].z, v[j].w); o8[64 * j] = w; }
}
__device__ __forceinline__ void xb_row(const GAS float* xrow, GAS bf16* orow, GAS float* rout, int lane) {
    const GAS f32x4* xr = (const GAS f32x4*)xrow + lane; f32x4 v[4]; float s = 0.f;
#pragma unroll
    for (int j = 0; j < 4; ++j) { v[j] = xr[64 * j]; s += (v[j].x * v[j].x + v[j].y * v[j].y) + (v[j].z * v[j].z + v[j].w * v[j].w); }
    GAS u32x2* o8 = (GAS u32x2*)orow + lane;
#pragma unroll
    for (int j = 0; j < 4; ++j) { u32x2 w; w.x = cvt_pk_bf16(v[j].x, v[j].y); w.y = cvt_pk_bf16(v[j].z, v[j].w); o8[64 * j] = w; }
    const float r = 1.0f / sqrtf(wave_sum(s) * (1.f / D) + EPS);
    if (lane == 0) *rout = r;
}
__device__ __forceinline__ int rmsb_col(int j, int lane) { return 512 * (j >> 1) + 8 * lane + 4 * (j & 1); }
__device__ __forceinline__ void rms_row_b(const GAS bf16* hrow, const GAS float* g, GAS bf16* orow, int lane, f32x4 (&v)[4]) {
    float s = 0.f;
#pragma unroll
    for (int jh = 0; jh < 2; ++jh) { const u32x4 x = *(const GAS u32x4*)(hrow + 512 * jh + 8 * lane);
        v[2 * jh] = (f32x4){bf_lo(x.x), bf_hi(x.x), bf_lo(x.y), bf_hi(x.y)}; v[2 * jh + 1] = (f32x4){bf_lo(x.z), bf_hi(x.z), bf_lo(x.w), bf_hi(x.w)}; }
#pragma unroll
    for (int j = 0; j < 4; ++j) s += (v[j].x * v[j].x + v[j].y * v[j].y) + (v[j].z * v[j].z + v[j].w * v[j].w);
    const float r = 1.0f / sqrtf(wave_sum(s) * (1.f / D) + EPS);
#pragma unroll
    for (int jh = 0; jh < 2; ++jh) { const GAS float* gp = g + 512 * jh + 8 * lane; v[2 * jh] = v[2 * jh] * r * *(const GAS f32x4*)gp; v[2 * jh + 1] = v[2 * jh + 1] * r * *(const GAS f32x4*)(gp + 4);
        u32x4 w; w.x = cvt_pk_bf16(v[2 * jh].x, v[2 * jh].y); w.y = cvt_pk_bf16(v[2 * jh].z, v[2 * jh].w); w.z = cvt_pk_bf16(v[2 * jh + 1].x, v[2 * jh + 1].y); w.w = cvt_pk_bf16(v[2 * jh + 1].z, v[2 * jh + 1].w);
        *(GAS u32x4*)(orow + 512 * jh + 8 * lane) = w; }
}

__device__ __forceinline__ void rms_row_b8(const GAS bf16* hrow, const GAS float* g, GAS unsigned char* o8, int lane, f32x4 (&v)[4]) {
    float s = 0.f;
#pragma unroll
    for (int jh = 0; jh < 2; ++jh) { const u32x4 x = *(const GAS u32x4*)(hrow + 512 * jh + 8 * lane);
        v[2 * jh] = (f32x4){bf_lo(x.x), bf_hi(x.x), bf_lo(x.y), bf_hi(x.y)}; v[2 * jh + 1] = (f32x4){bf_lo(x.z), bf_hi(x.z), bf_lo(x.w), bf_hi(x.w)}; }
#pragma unroll
    for (int j = 0; j < 4; ++j) s += (v[j].x * v[j].x + v[j].y * v[j].y) + (v[j].z * v[j].z + v[j].w * v[j].w);
    const float r = 1.0f / sqrtf(wave_sum(s) * (1.f / D) + EPS);
#pragma unroll
    for (int jh = 0; jh < 2; ++jh) { const GAS float* gp = g + 512 * jh + 8 * lane; v[2 * jh] = v[2 * jh] * r * *(const GAS f32x4*)gp; v[2 * jh + 1] = v[2 * jh + 1] * r * *(const GAS f32x4*)(gp + 4);
        u32x2 w; w.x = pk4_fp8(v[2 * jh].x, v[2 * jh].y, v[2 * jh].z, v[2 * jh].w); w.y = pk4_fp8(v[2 * jh + 1].x, v[2 * jh + 1].y, v[2 * jh + 1].z, v[2 * jh + 1].w);
        *(GAS u32x2*)(o8 + 512 * jh + 8 * lane) = w; }
}

constexpr int SW_QL = 0, SW_SPITCH = 528, SW_SL = 128 * 528, SW_VPITCH = 272, SW_VL = SW_SL + 64 * SW_SPITCH, SW_VB = 64 * SW_VPITCH;
static_assert(SW_VL + 2 * SW_VB <= 139264, "sweep LDS");
template <bool OUT> __device__ __forceinline__ void sweep_role(LAS unsigned char* lds, const GAS bf16* Qg, const GAS bf16* KTFg, const GAS bf16* KTBg, const GAS bf16* VTg, const GAS bf16* PCg, const GAS bf16* PDg, const GAS bf16* ZEROg, GAS bf16* Yg, GAS f32x2* statp, const float l2f, const float l2b, int b, int h, int es, const int wave_s) {
    const int tid = tid_of(wave_s);
    const int w = __builtin_amdgcn_readfirstlane(tid >> 6), lane = tid & 63, r32 = lane & 31, hh = lane >> 5;
    const int rb = w & 3;
    const int vrow = tid >> 4, vpc = tid & 15;
    const int qrow = tid >> 5, qpc = tid & 31;
    const GAS bf16* qp = Qg + (size_t)(b * SEQ + qrow) * QKW + h * DK + 8 * qpc;
    const GAS bf16* vtp = VTg + (size_t)(h * DV + 64 * es + vrow) * T + 8 * vpc; const int vrot = b * SEQ + ((vrow & 15) << 11);
    const int il = 32 * rb + r32;
    const GAS bf16* pcp = PCg + (((size_t)((b * NH + h) * NCH) * 4 + rb) * 8) * 512 + lane * 8;
    const GAS bf16* pdp = PDg + (((size_t)((b * NH + h) * NCH) * 4 + rb) * 2) * 512 + lane * 8;
    GAS bf16* yp = Yg + ((size_t)(((b * SEQ) >> 5) + rb) * NH + h) * 8 * 2048 + (size_t)es * 2048 + lane * 8;
    GAS f32x2* stp = statp + ((size_t)(b * SEQ + il) * NH + h) * 8 + es;
    const size_t kto = ((size_t)((b * NH + h) * NCH) * 8 + 2 * rb) * 8 * 512 + lane * 8;
#define SW_LDP(dst, s_, d_, nn_) do { const int jb_ = (s_) >> 1; const bool use_ = (d_) ? (jb_ >= rb) : (jb_ <= rb); const bool dg_ = (d_) && (jb_ == rb); \
        const GAS bf16* src_ = dg_ ? (pdp + (size_t)(nn_) * 4096 + 512 * ((s_) & 1)) : (pcp + (size_t)(nn_) * (CH * CH) + 512 * (s_)); \
        dst = *(const GAS bf16x8*)(use_ ? src_ : ZEROg); } while (0)
#define SW_SCHED __builtin_amdgcn_sched_barrier(0)
#define SW_MFMA(a, b, c) c = __builtin_amdgcn_mfma_f32_32x32x16_bf16(a, b, c, 0, 0, 0)
    bf16x8 pa[8];
    bf16x8 ka[2][8];
    u32x4 vv[2], qv[4];
    f32x16 Sacc[2][2];
    if constexpr (OUT) {
#pragma unroll
        for (int s = 0; s < 8; ++s) SW_LDP(pa[s], s, 0, 0);
    } else {
#pragma unroll
        for (int db = 0; db < 2; ++db)
#pragma unroll
            for (int s = 0; s < 8; ++s) ka[db][s] = *(const GAS bf16x8*)(KTFg + kto + db * 4096 + s * 512);
#pragma unroll
        for (int db = 0; db < 2; ++db)
#pragma unroll
            for (int et = 0; et < 2; ++et)
#pragma unroll
                for (int t = 0; t < 16; ++t) Sacc[db][et][t] = 0.f;
    }
#pragma unroll
    for (int it = 0; it < 2; ++it) vv[it] = *(const GAS u32x4*)(vtp + (size_t)(32 * it) * T + (vrot & (T - 1)));
#pragma unroll
    for (int it = 0; it < 2; ++it) *(LAS u32x4*)(lds + SW_VL + (vrow + 32 * it) * SW_VPITCH + vpc * 16) = vv[it];
#pragma unroll
    for (int hf = 0; hf < 2; ++hf) {
#pragma unroll
        for (int it = 0; it < 4; ++it) qv[it] = *(const GAS u32x4*)(qp + (size_t)(16 * (4 * hf + it)) * QKW);
#pragma unroll
        for (int it = 0; it < 4; ++it) { const int row = qrow + 16 * (4 * hf + it); *(LAS u32x4*)(lds + SW_QL + row * SW_SPITCH + qpc * 16) = qv[it]; }
    }
    const int sl_rd = SW_SL + r32 * SW_SPITCH + 16 * hh;
    const int q_rd = SW_QL + il * SW_SPITCH + 16 * hh;
#pragma unroll 1
    for (int p = 0; p < 2 * NCH; ++p) {
        const int dir = p >> 5, st = p & 31, n = dir ? NCH - 1 - st : st;
        const int pn = p + 1 < 2 * NCH ? p + 1 : p, dirn = pn >> 5, stn = pn & 31, nn = dirn ? NCH - 1 - stn : stn;
        const int cur = p & 1;
        const float l2 = dir ? l2b : l2f;
        const int v_rd = SW_VL + cur * SW_VB + r32 * SW_VPITCH + 16 * hh;
        if constexpr (!OUT) {
#pragma unroll
            for (int db = 0; db < 2; ++db)
#pragma unroll
                for (int et = 0; et < 2; ++et)
#pragma unroll
                    for (int g = 0; g < 4; ++g) { u32x2 pk; pk.x = cvt_pk_bf16(Sacc[db][et][4 * g], Sacc[db][et][4 * g + 1]); pk.y = cvt_pk_bf16(Sacc[db][et][4 * g + 2], Sacc[db][et][4 * g + 3]);
                        if (st == 0) { pk.x = 0u; pk.y = 0u; }
                        *(LAS u32x2*)(lds + SW_SL + (32 * et + r32) * SW_SPITCH + (64 * rb + 32 * db + 8 * g + 4 * hh) * 2) = pk; }
        }
#pragma unroll
        for (int it = 0; it < 2; ++it) vv[it] = *(const GAS u32x4*)(vtp + (size_t)(32 * it) * T + ((nn * CH + vrot) & (T - 1)));
#pragma unroll
        for (int it = 0; it < 4; ++it) qv[it] = *(const GAS u32x4*)(qp + (size_t)(nn * CH + 16 * it) * QKW);
        u32x4 yf[4];
        GAS bf16* ypn = yp + (size_t)(n * 4) * (NH * 8 * 2048);
        if constexpr (OUT) {
            if (dir) {
#pragma unroll
                for (int q = 0; q < 4; ++q) yf[q] = *(const GAS u32x4*)(ypn + q * 512);
            }
        }
        __syncthreads();
        f32x16 O[2];
        if constexpr (OUT) {
#pragma unroll
            for (int et = 0; et < 2; ++et)
#pragma unroll
                for (int t = 0; t < 16; ++t) O[et][t] = 0.f;
            bf16x8 qx[2], s0x[2], s1x[2], qy[2], s0y[2], s1y[2];
#define SW_LDC(dq, d0, d1, g2) do { _Pragma("unroll") for (int k = 0; k < 2; ++k) { const int ks = 2 * (g2) + k; dq[k] = *(const LAS bf16x8*)(lds + q_rd + 32 * ks); \
                d0[k] = *(const LAS bf16x8*)(lds + sl_rd + 32 * ks); d1[k] = *(const LAS bf16x8*)(lds + sl_rd + 32 * SW_SPITCH + 32 * ks); } } while (0)
#define SW_MMC(dq, d0, d1) do { SW_MFMA(d0[0], dq[0], O[0]); SW_MFMA(d1[0], dq[0], O[1]); SW_MFMA(d0[1], dq[1], O[0]); SW_MFMA(d1[1], dq[1], O[1]); } while (0)
            SW_LDC(qx, s0x, s1x, 0); SW_LDC(qy, s0y, s1y, 1); SW_SCHED;
            SW_MMC(qx, s0x, s1x); SW_SCHED; SW_LDC(qx, s0x, s1x, 2); SW_SCHED;
            SW_MMC(qy, s0y, s1y); SW_SCHED; SW_LDC(qy, s0y, s1y, 3); SW_SCHED;
            SW_MMC(qx, s0x, s1x); SW_SCHED; SW_LDC(qx, s0x, s1x, 4); SW_SCHED;
            SW_MMC(qy, s0y, s1y); SW_SCHED; SW_LDC(qy, s0y, s1y, 5); SW_SCHED;
            SW_MMC(qx, s0x, s1x); SW_SCHED; SW_LDC(qx, s0x, s1x, 6); SW_SCHED;
            SW_MMC(qy, s0y, s1y); SW_SCHED; SW_LDC(qy, s0y, s1y, 7); SW_SCHED;
            SW_MMC(qx, s0x, s1x); SW_SCHED;
            SW_MMC(qy, s0y, s1y); SW_SCHED;
#undef SW_LDC
#undef SW_MMC
        } else {
            const float gC = st == 0 ? 0.f : fast_exp2((float)CH * l2);
#pragma unroll
            for (int db = 0; db < 2; ++db)
#pragma unroll
                for (int et = 0; et < 2; ++et)
#pragma unroll
                    for (int t = 0; t < 16; ++t) Sacc[db][et][t] *= gC;
            bf16x8 v0x[2], v1x[2], v0y[2], v1y[2];
#define SW_LDU(d0, d1, g2) do { _Pragma("unroll") for (int k = 0; k < 2; ++k) { const int s_ = 2 * (g2) + k; d0[k] = *(const LAS bf16x8*)(lds + v_rd + 32 * s_); d1[k] = *(const LAS bf16x8*)(lds + v_rd + 32 * SW_VPITCH + 32 * s_); } } while (0)
#define SW_MMU(d0, d1, g2) do { _Pragma("unroll") for (int k = 0; k < 2; ++k) { const int s_ = 2 * (g2) + k; SW_MFMA(ka[0][s_], d0[k], Sacc[0][0]); SW_MFMA(ka[0][s_], d1[k], Sacc[0][1]); SW_MFMA(ka[1][s_], d0[k], Sacc[1][0]); SW_MFMA(ka[1][s_], d1[k], Sacc[1][1]); } } while (0)
            SW_LDU(v0x, v1x, 0); SW_LDU(v0y, v1y, 1); SW_SCHED;
            SW_MMU(v0x, v1x, 0); SW_SCHED; SW_LDU(v0x, v1x, 2); SW_SCHED;
            SW_MMU(v0y, v1y, 1); SW_SCHED; SW_LDU(v0y, v1y, 3); SW_SCHED;
            SW_MMU(v0x, v1x, 2); SW_SCHED;
            SW_MMU(v0y, v1y, 3); SW_SCHED;
#undef SW_LDU
#undef SW_MMU
        }
        __syncthreads();
#pragma unroll
        for (int it = 0; it < 4; ++it) { const int row = qrow + 16 * it; *(LAS u32x4*)(lds + SW_QL + row * SW_SPITCH + qpc * 16) = qv[it]; }
#pragma unroll
        for (int it = 0; it < 4; ++it) qv[it] = *(const GAS u32x4*)(qp + (size_t)(nn * CH + 16 * (4 + it)) * QKW);
        if constexpr (OUT) {
            const float xi = fast_exp2((float)(dir == 0 ? (il + 1) : (CH - il)) * l2);
#pragma unroll
            for (int et = 0; et < 2; ++et)
#pragma unroll
                for (int t = 0; t < 16; ++t) O[et][t] *= xi;
            bf16x8 v0x[2], v1x[2], v0y[2], v1y[2];
#define SW_LDV(d0, d1, g2) do { _Pragma("unroll") for (int k = 0; k < 2; ++k) { const int s_ = 2 * (g2) + k; d0[k] = *(const LAS bf16x8*)(lds + v_rd + 32 * s_); d1[k] = *(const LAS bf16x8*)(lds + v_rd + 32 * SW_VPITCH + 32 * s_); } } while (0)
#define SW_MMV(d0, d1, g2) do { _Pragma("unroll") for (int k = 0; k < 2; ++k) { const int s_ = 2 * (g2) + k; SW_MFMA(d0[k], pa[s_], O[0]); SW_MFMA(d1[k], pa[s_], O[1]); } } while (0)
            SW_LDV(v0x, v1x, 0); SW_LDV(v0y, v1y, 1); SW_SCHED;
            SW_MMV(v0x, v1x, 0); SW_SCHED; SW_LDV(v0x, v1x, 2); SW_SCHED;
            SW_MMV(v0y, v1y, 1); SW_SCHED; SW_LDV(v0y, v1y, 3); SW_SCHED;
            SW_MMV(v0x, v1x, 2); SW_SCHED;
            SW_MMV(v0y, v1y, 3); SW_SCHED;
#undef SW_LDV
#undef SW_MMV
#pragma unroll
            for (int s = 0; s < 8; ++s) SW_LDP(pa[s], s, dirn, nn);
        } else {
            const GAS bf16* ktn = (dirn ? KTBg : KTFg) + kto + (size_t)nn * 32768;
#pragma unroll
            for (int db = 0; db < 2; ++db)
#pragma unroll
                for (int s = 0; s < 8; ++s) ka[db][s] = *(const GAS bf16x8*)(ktn + db * 4096 + s * 512);
        }
#pragma unroll
        for (int it = 0; it < 2; ++it) *(LAS u32x4*)(lds + SW_VL + (cur ^ 1) * SW_VB + (vrow + 32 * it) * SW_VPITCH + vpc * 16) = vv[it];
#pragma unroll
        for (int it = 0; it < 4; ++it) { const int row = qrow + 16 * (4 + it); *(LAS u32x4*)(lds + SW_QL + row * SW_SPITCH + qpc * 16) = qv[it]; }
        if constexpr (OUT) {
            float s1 = 0.f, s2 = 0.f;
#pragma unroll
            for (int et = 0; et < 2; ++et)
#pragma unroll
                for (int kp = 0; kp < 2; ++kp) {
                    float ya[4], yb[4];
#pragma unroll
                    for (int q = 0; q < 4; ++q) { ya[q] = O[et][8 * kp + q]; yb[q] = O[et][8 * kp + 4 + q]; }
                    if (dir) {
                        u32x4 f = yf[et * 2 + kp];
                        { const auto r0 = __builtin_amdgcn_permlane32_swap(f.x, f.z, false, false); f.x = r0[0]; f.z = r0[1]; const auto r1 = __builtin_amdgcn_permlane32_swap(f.y, f.w, false, false); f.y = r1[0]; f.w = r1[1]; }
                        ya[0] += bf_lo(f.x); ya[1] += bf_hi(f.x); ya[2] += bf_lo(f.y); ya[3] += bf_hi(f.y); yb[0] += bf_lo(f.z); yb[1] += bf_hi(f.z); yb[2] += bf_lo(f.w); yb[3] += bf_hi(f.w);
#pragma unroll
                        for (int q = 0; q < 4; ++q) { s1 += ya[q] + yb[q]; s2 += ya[q] * ya[q] + yb[q] * yb[q]; }
                    }
                    u32x4 o; o.x = cvt_pk_bf16(ya[0], ya[1]); o.y = cvt_pk_bf16(ya[2], ya[3]); o.z = cvt_pk_bf16(yb[0], yb[1]); o.w = cvt_pk_bf16(yb[2], yb[3]);
                    { const auto r0 = __builtin_amdgcn_permlane32_swap(o.x, o.z, false, false); o.x = r0[0]; o.z = r0[1]; const auto r1 = __builtin_amdgcn_permlane32_swap(o.y, o.w, false, false); o.y = r1[0]; o.w = r1[1]; }
                    *(GAS u32x4*)(ypn + (et * 2 + kp) * 512) = o;
                }
            if (dir) { s1 += __shfl_xor(s1, 32); s2 += __shfl_xor(s2, 32);
                if (hh == 0) stp[(size_t)(n * CH) * (NH * 8)] = (f32x2){s1, s2}; }
        }
    }
#undef SW_LDP
#undef SW_SCHED
#undef SW_MFMA
    VM_WAIT();
    __syncthreads();
}

__device__ __forceinline__ void sweep_unit(LAS unsigned char* lds, const GAS bf16* Qg, const GAS bf16* KTFg, const GAS bf16* KTBg, const GAS bf16* VTg, const GAS bf16* PCg, const GAS bf16* PDg, const GAS bf16* ZEROg, GAS bf16* Yg, GAS f32x2* statp, const float l2f, const float l2b, int b, int h, int es, const int wave_s) {
    int ws_ = wave_s; asm volatile("" : "+s"(ws_));
    if (ws_ < 4) sweep_role<true>(lds, Qg, KTFg, KTBg, VTg, PCg, PDg, ZEROg, Yg, statp, l2f, l2b, b, h, es, wave_s);
    else sweep_role<false>(lds, Qg, KTFg, KTBg, VTg, PCg, PDg, ZEROg, Yg, statp, l2f, l2b, b, h, es, wave_s);
}

struct Args { const float* in[16]; float* out; unsigned char* ws; };
constexpr int NWAVES = 8;
#ifndef PHMASK
#define PHMASK 0xFFFFFFFFu
#endif
#define PH(k) (((PHMASK) >> (k)) & 1u)
__global__ void __launch_bounds__(NWAVES * 64, 2) fwd_kernel(Args args) {
    extern __shared__ __attribute__((aligned(16))) unsigned char lds_raw[];
    LAS unsigned char* lds = (LAS unsigned char*)lds_raw;
    LAS float* l2g = (LAS float*)(lds + LDSCTL_OFF + 64);
    const int wave_k = __builtin_amdgcn_readfirstlane((int)threadIdx.x >> 6);
#define PHASE_VARS \
    const int tid = tid_of(wave_k); const int lane = tid & 63; int wave = wave_k; asm volatile("" : "+s"(wave)); \
    const __attribute__((address_space(4))) Args* ka = (const __attribute__((address_space(4))) Args*)__builtin_amdgcn_kernarg_segment_ptr(); asm volatile("" : "+s"(ka)); \
    const int G = gridDim.x, bx = blockIdx.x; const int vcu = (G % 8 == 0) ? (bx % 8) * (G / 8) + bx / 8 : bx; const int gw = vcu * NWAVES + wave, NGW = G * NWAVES; \
    GAS unsigned char* ws = (GAS unsigned char*)ka->ws; asm volatile("" : "+s"(ws)); GAS float* hres = (GAS float*)ka->out; (void)lane; (void)gw; (void)NGW; (void)vcu; (void)hres; \
    const GAS float* x = (const GAS float*)ka->in[0]; const GAS float* mix_norm = (const GAS float*)ka->in[1]; const GAS float* ffn_norm = (const GAS float*)ka->in[2]; const GAS float* ret_w_in = (const GAS float*)ka->in[3]; const GAS float* ret_decay = (const GAS float*)ka->in[4]; \
    const GAS float* gn_gain = (const GAS float*)ka->in[5]; const GAS float* ret_w_out = (const GAS float*)ka->in[6]; const GAS float* d_wg = (const GAS float*)ka->in[7]; const GAS float* d_wu = (const GAS float*)ka->in[8]; const GAS float* d_wd = (const GAS float*)ka->in[9]; \
    const GAS float* fnet_w = (const GAS float*)ka->in[10]; const GAS float* moe_router = (const GAS float*)ka->in[11]; const GAS float* m_wg = (const GAS float*)ka->in[12]; const GAS float* m_wu = (const GAS float*)ka->in[13]; const GAS float* m_wd = (const GAS float*)ka->in[14]; const GAS float* final_norm = (const GAS float*)ka->in[15]; \
    (void)x; (void)mix_norm; (void)ffn_norm; (void)ret_w_in; (void)ret_decay; (void)gn_gain; (void)ret_w_out; (void)d_wg; (void)d_wu; (void)d_wd; (void)fnet_w; (void)moe_router; (void)m_wg; (void)m_wu; (void)m_wd; (void)final_norm; \
    GAS f32x2* rot = (GAS f32x2*)(ws + WS_ROT); GAS f32x2* rotT = (GAS f32x2*)(ws + WS_ROTT); GAS bf16* WC = (GAS bf16*)(ws + WS_STATS); GAS float* R0 = (GAS float*)(ws + WS_R0); (void)R0; GAS f32x2* TWT = (GAS f32x2*)(ws + WS_TW); (void)TWT; GAS float* SSQ1 = (GAS float*)(ws + WS_SSQ1); GAS float* SSQ2 = (GAS float*)(ws + WS_SSQ2); (void)SSQ1; (void)SSQ2; \
    GAS int* toke = (GAS int*)(ws + WS_TOKE); GAS float* tokw = (GAS float*)(ws + WS_TOKW); GAS int* bcnt = (GAS int*)(ws + WS_BCNT); GAS int* pcnt = (GAS int*)(ws + WS_PCNT); (void)pcnt; GAS int* rowtok = (GAS int*)(ws + WS_ROWTOK); GAS float* rowgate = (GAS float*)(ws + WS_ROWGATE); \
    GAS f32x2* statp = (GAS f32x2*)(ws + WS_STATP); \
    GAS bf16* WIN = (GAS bf16*)(ws + WS_WIN); GAS bf16* WO = (GAS bf16*)(ws + WS_WO); GAS bf16* WGU = (GAS bf16*)(ws + WS_WGU); GAS bf16* WD = (GAS bf16*)(ws + WS_WD); GAS bf16* WF = (GAS bf16*)(ws + WS_WF); \
    GAS bf16* HN = (GAS bf16*)(ws + WS_HN); GAS bf16* Qb = (GAS bf16*)(ws + WS_Q); GAS bf16* Kb = (GAS bf16*)(ws + WS_K); GAS bf16* KT = (GAS bf16*)(ws + WS_KT); GAS bf16* VT = (GAS bf16*)(ws + WS_VT); GAS bf16* PC = (GAS bf16*)(ws + WS_PC); \
    GAS bf16* HB = (GAS bf16*)(ws + WS_HN); GAS bf16* HNB = (GAS bf16*)ka->out; (void)HB; (void)HNB; \
    GAS unsigned char* HN8 = (GAS unsigned char*)ka->out + 64 * MiB; GAS unsigned char* WMGU8 = (GAS unsigned char*)(ws + WS_WMGU); (void)HN8; (void)WMGU8;     \
    GAS bf16* Yb = (GAS bf16*)ka->out; GAS bf16* YG = (GAS bf16*)(ws + WS_YG); GAS bf16* ACTD = (GAS bf16*)(ws + WS_ACTD); GAS bf16* Z2 = (GAS bf16*)(ws + WS_Z2); GAS bf16* WSEQ = (GAS bf16*)(ws + WS_WSEQ); \
    GAS bf16* ACTM = (GAS bf16*)(ws + WS_ACTM); GAS bf16* WMGU = (GAS bf16*)(ws + WS_WMGU); GAS bf16* WMD = (GAS bf16*)(ws + WS_WMD); \
    (void)rot; (void)rotT; (void)WC; (void)toke; (void)tokw; (void)bcnt; (void)rowtok; (void)rowgate; (void)statp; (void)WIN; (void)WO; (void)WGU; (void)WD; (void)WF; (void)HN; (void)Qb; (void)Kb; (void)KT; (void)VT; (void)PC; \
    (void)Yb; (void)YG; (void)ACTD; (void)Z2; (void)WSEQ; (void)ACTM; (void)WMGU; (void)WMD;
#define GRID_BAR() do { const __attribute__((address_space(4))) Args* kb = (const __attribute__((address_space(4))) Args*)__builtin_amdgcn_kernarg_segment_ptr(); asm volatile("" : "+s"(kb)); GAS unsigned char* wsb = (GAS unsigned char*)kb->ws; XcdBarrier bar_; bar_.bar = (unsigned*)(wsb + WS_CTL) + CW_BAR; bar_.x = xb_xcc_id(); \
    bar_.st = (volatile LAS unsigned*)(lds + MISC_OFF) + 8; xcd_barrier(bar_, tid_of(wave_k) == 0); } while (0)

    {
        PHASE_VARS
        for (int u = tid; u < (LDS_BYTES - LDSCTL_OFF) / 4; u += NWAVES * 64) ((LAS unsigned*)(lds + LDSCTL_OFF))[u] = 0u;
        __syncthreads();
        if (tid < 8) { const float xl = ret_decay[tid]; const float ls = fminf(xl, 0.f) - log1pf(expf(-fabsf(xl))); l2g[tid] = ls * 1.44269504088896341f; }
        __syncthreads();
        (void)xcd_barrier_post((unsigned*)(ws + WS_CTL) + CW_BAR, (volatile LAS unsigned*)(lds + MISC_OFF) + 8, tid == 0);
    }

    if (PH(0)) {
        PHASE_VARS
        LAS float* scr = (LAS float*)(lds + wave * 16384);
        constexpr int I_IN = (D / 64) * (INW / 32), I_O = (VW / 64) * (D / 32), I_GU = 2 * (D / 64) * (FFD / 32), I_D = (FFD / 64) * (D / 32), I_F = (D / 64) * (D / 32);
        constexpr int NITEMS = I_IN + I_O + I_GU + I_D + I_F;
        for (int it = gw; it < NITEMS; it += NGW) {
            int r = it;
            if (r < I_IN) { tr_plain(ret_w_in, D, INW, WIN, r, scr, lane, mix_norm); continue; } r -= I_IN;
            if (r < I_O) { tr_plain(ret_w_out, VW, D, WO, r, scr, lane); continue; } r -= I_O;
            if (r < I_GU) { tr_gu(d_wg, d_wu, D, FFD, WGU, r, scr, lane, ffn_norm); continue; } r -= I_GU;
            if (r < I_D) { const int nblk = D / 32, kb = r / nblk, nb = r - kb * nblk; transpose_item8(d_wd, FFD, D, (GAS unsigned char*)WD, 64 * kb, 32 * nb, 32 * nb, 64.0f, scr, lane); continue; } r -= I_D;
            tr_plain(fnet_w, D, D, WF, r, scr, lane);
        }
        for (int e = (vcu * 512 + tid); e < SEQ * 128; e += G * 512) { const int s = e >> 7, i = e & 127;
            const float inv = powf(10000.0f, -(float)i / 128.0f); const float ang = (float)s * inv; float sn, cs; sincosf(ang, &sn, &cs);
            rot[e] = (f32x2){cs, sn}; }
        for (int e = (vcu * 512 + tid); e < 4 * 512 * 256; e += G * 512) { const int g = e >> 17, r = (e >> 8) & 511, c = e & 255, cp = (r >> 8) * 128 + (r & 127), mm = (cp * c) & 255;
            const float v = (((r >> 7) & 1) == 0 ? cospif((float)mm * (1.0f / 128.0f)) : -sinpif((float)mm * (1.0f / 128.0f))) * mix_norm[D + g * 256 + c]; WC[e] = (bf16)(cvt_pk_bf16(v, 0.f) & 0xffffu); }
        for (int e = vcu * 512 + tid; e < 512 * 8; e += G * 512) { const float ang = (float)(((e >> 3) * (e & 7)) & 4095) * (1.0f / 2048.0f); TWT[e] = (f32x2){cospif(ang), sinpif(ang)}; }
        for (int e = vcu * 512 + tid; e < 512 * 1024; e += G * 512) { const int ka = e >> 10, c = e & 1023, a = c & 511, mm = (a * ka) & 511;
            const float v = (c < 512 ? cospif((float)mm * (1.0f / 256.0f)) : sinpif((float)mm * (1.0f / 256.0f))) * (1.0f / 1024.0f); WSEQ[e] = (bf16)(cvt_pk_bf16(v, 0.f) & 0xffffu); }
        for (int m = gw; m < T; m += NGW) xb_row(x + (size_t)m * D, HN + (size_t)m * D, R0 + m, lane);
    }
    GRID_BAR();

    if (PH(1) && PH(19)) {
        PHASE_VARS
        SchedPlain S{(const GAS char*)HN, (const GAS char*)WIN, (size_t)256 * D * 2, (size_t)256 * D * 2, T / 256, 8, G, bx, 1};
        EpiRopeQK E{Qb, Kb, rot, R0, KT, l2g, lds + STG_OFF};
        pg8::gemm_phase<EpiRopeQK, SchedPlain, false>(lds, wave_k, D, D, D, S, E);
    }
    if (PH(1) && PH(21)) {
        PHASE_VARS
        SchedPlain S{(const GAS char*)(WIN + (size_t)2 * QKW * D), (const GAS char*)HN, (size_t)256 * D * 2, (size_t)256 * D * 2, 8, T / 256, G, bx};
        EpiBf16<true> E{VT, T, R0};
        pg8::gemm_phase<EpiBf16<true>, SchedPlain, false>(lds, wave_k, D, D, D, S, E);
    }
    GRID_BAR();

    if (PH(2)) {
        PHASE_VARS
        SchedPc S{(const GAS char*)Qb, (const GAS char*)Kb, G, bx};
        EpiPc E{PC, (GAS bf16*)(ws + WS_ROT), l2g};
        pg8::gemm_phase<EpiPc, SchedPc, false>(lds, wave_k, QKW, QKW, DK, S, E);
    }
    GRID_BAR();

    if (PH(3)) {
        PHASE_VARS
        for (int u = vcu; u < NB * NH * 8; u += G) { const int hh_ = (u >> 3) & 3; const float l2f = l2g[hh_], l2b = l2g[4 + hh_];
            sweep_unit(lds, Qb, KT, KT + (size_t)QKW * T, VT, PC, (const GAS bf16*)(ws + WS_ROT), (const GAS bf16*)(ws + WS_CTL + 512 * 1024), Yb, statp, l2f, l2b, u >> 5, hh_, u & 7, wave_k); }
    }
    GRID_BAR();

    if (PH(5)) {
        PHASE_VARS
        SchedPlain S{(const GAS char*)HN, (const GAS char*)(WIN + (size_t)(2 * QKW + VW) * D), (size_t)256 * D * 2, (size_t)256 * D * 2, T / 256, 8, G, bx};
        EpiGate E{Yb, YG, statp, gn_gain, (LAS f32x2*)(lds + 135168), R0};
        pg8::gemm_phase<EpiGate, SchedPlain, false>(lds, wave_k, D, D, D, S, E);
    }
    GRID_BAR();

    if (PH(6)) {
        PHASE_VARS
        SchedPlain S{(const GAS char*)YG, (const GAS char*)WO, (size_t)256 * VW * 2, (size_t)256 * VW * 2, T / 256, 4, G, bx};
        EpiRes<false> E{(const GAS void*)HB, HB, SSQ1};
        pg8::gemm_phase<EpiRes<false>, SchedPlain, false>(lds, wave_k, VW, VW, VW, S, E);
    }
    GRID_BAR();

    if (PH(7)) {
        PHASE_VARS
        LAS float* scr = (LAS float*)(lds + wave * 16384);
        constexpr int I_GU = 2 * (D / 64) * (FFE / 32), I_D = (FFE / 64) * (D / 32);
        for (int it = gw; it < NE * (I_GU + I_D); it += NGW) {
            const int e = it / (I_GU + I_D); int r = it - e * (I_GU + I_D);
            if (r < I_GU) tr_gu8(m_wg + (size_t)e * D * FFE, m_wu + (size_t)e * D * FFE, D, FFE, WMGU8 + (size_t)e * 2 * FFE * D, r, scr, lane);
            else { const int it2 = r - I_GU, nblk = D / 32, kb = it2 / nblk, nb = it2 - kb * nblk; transpose_item8(m_wd + (size_t)e * FFE * D, FFE, D, (GAS unsigned char*)WMD + (size_t)e * D * FFE, 64 * kb, 32 * nb, 32 * nb, 64.0f, scr, lane); }
        }
    }
    __syncthreads();

    if (PH(8)) {
        PHASE_VARS
        SchedPlain S{(const GAS char*)HB, (const GAS char*)WGU, (size_t)256 * D * 2, (size_t)256 * D * 2, T / 256, 2 * FFD / 256, G, bx};
        EpiSwiGLU<true, true> E{(GAS void*)ACTD, FFD, SSQ1, (LAS float*)(lds + 135168)};
        pg8::gemm_phase<EpiSwiGLU<true, true>, SchedPlain, false>(lds, wave_k, D, D, D, S, E);
    }
    GRID_BAR();
    if (PH(9)) {
        PHASE_VARS
        SchedPlainF8 S{{(const GAS char*)ACTD, (const GAS char*)WD, (size_t)256 * FFD, (size_t)256 * FFD, T / 256, 4, G, bx}};
        EpiRes<false> E{(const GAS void*)HB, HB, SSQ2};
        pg8::gemm_phase<EpiRes<false>, SchedPlainF8, false, true>(lds, wave_k, FFD, FFD, FFD, S, E);
    }
    GRID_BAR();

    if (PH(11)) {
        PHASE_VARS
        SchedFnA S{(const GAS char*)WC, (const GAS char*)HB, G, bx};
        EpiZ2 E{Z2, SSQ2, (LAS float*)(lds + 135168), TWT};
        pg8::gemm_phase<EpiZ2, SchedFnA, false>(lds, wave_k, 256, D, 256, S, E);
    }
    GRID_BAR();
    if (PH(12)) {
        PHASE_VARS
        SchedFnB S{(GAS const char*)WSEQ, (GAS const char*)Z2, G, bx};
        EpiYf E{HNB};
        pg8::gemm_phase<EpiYf, SchedFnB, false>(lds, wave_k, 1024, 1024, 1024, S, E);
    }
    GRID_BAR();
    if (PH(13)) {
        PHASE_VARS
        SchedPlain S{(const GAS char*)HNB, (const GAS char*)WF, (size_t)256 * D * 2, (size_t)256 * D * 2, T / 256, 4, G, bx};
        EpiRes<false> E{(const GAS void*)HB, HB, nullptr};
        pg8::gemm_phase<EpiRes<false>, SchedPlain, false>(lds, wave_k, D, D, D, S, E);
    }
    GRID_BAR();

    if (PH(14)) {
        PHASE_VARS
        LAS float* wrl = (LAS float*)lds;
        LAS int* le = (LAS int*)(lds + 32768);
        for (int i = tid; i < D * NE; i += NWAVES * 64) wrl[(i & 7) * D + (i >> 3)] = moe_router[i];
        for (int i = vcu * 512 + tid; i < 2 * MOE_ROWS; i += G * 512) rowtok[i] = -1;
        __syncthreads();
        for (int tb = vcu; tb < T / 128; tb += G) {
            for (int rr = 0; rr < 16; ++rr) { const int tl = wave * 16 + rr, m = tb * 128 + tl; f32x4 v[4];
                rms_row_b8(HB + (size_t)m * D, ffn_norm + D, HN8 + (size_t)m * D, lane, v);
                float lg[8];
#pragma unroll
                for (int e = 0; e < 8; ++e) lg[e] = 0.f;
#pragma unroll
                for (int j = 0; j < 4; ++j) { const int col0 = rmsb_col(j, lane);
#pragma unroll
                    for (int e = 0; e < 8; ++e) { const f32x4 wv = *(const LAS f32x4*)(wrl + e * D + col0); lg[e] += (v[j].x * wv.x + v[j].y * wv.y) + (v[j].z * wv.z + v[j].w * wv.w); } }
#pragma unroll
                for (int e = 0; e < 8; ++e) lg[e] = wave_sum(lg[e]);
                int e0 = 0; float b0 = lg[0];
#pragma unroll
                for (int e = 1; e < 8; ++e) if (lg[e] > b0) { b0 = lg[e]; e0 = e; }
                int e1 = -1; float b1 = -3.0e38f;
#pragma unroll
                for (int e = 0; e < 8; ++e) if (e != e0 && lg[e] > b1) { b1 = lg[e]; e1 = e; }
                const float w0 = 1.0f / (1.0f + __expf(b1 - b0));
                if (lane == 0) { toke[2 * m] = e0; toke[2 * m + 1] = e1; tokw[2 * m] = w0; tokw[2 * m + 1] = 1.0f - w0; le[tl] = e0; le[128 + tl] = e1; } }
            __syncthreads();
            if (tid < 16) { const int s = tid >> 3, e = tid & 7; int c = 0; for (int i = 0; i < 128; ++i) c += (le[s * 128 + i] == e) ? 1 : 0; bcnt[tb * 16 + tid] = c; }
            if (tid >= 64 && tid < 128) { const int pi = tid - 64; int c = 0; for (int i = 0; i < 128; ++i) c += (le[i] * 8 + le[128 + i] == pi) ? 1 : 0; pcnt[tb * 64 + pi] = c; }
            __syncthreads();
        }
    }
    GRID_BAR();

    LAS int* segoff = (LAS int*)(lds + 132096);
    LAS int* ntile = (LAS int*)(lds + 132096 + 64);
    LAS unsigned char* tile_e = (LAS unsigned char*)(lds + 132096 + 128);
    if (PH(15)) {
        PHASE_VARS
        LAS int* pfx = (LAS int*)lds;
        LAS int* cph = (LAS int*)(lds + 65792);
        LAS int* fq_ = (LAS int*)(lds + 65792 + 16384);
        LAS int* tot = fq_ + 64;
        LAS int* tpi = tot + 16;
        LAS int* tex = tpi + 128;
        for (int i = tid; i < 256 * 64; i += NWAVES * 64) pfx[i] = pcnt[i];
        __syncthreads();
        if (tid < 64) { int run = 0; for (int b2 = 0; b2 < 256; ++b2) { const int c = pfx[b2 * 64 + tid]; pfx[b2 * 64 + tid] = run; run += c; } pfx[256 * 64 + tid] = run; }
        __syncthreads();
        if (tid == 0) {
            int n0[8], d[8], r[8]; int rs = 0;
            for (int e = 0; e < 8; ++e) { int c = 0; for (int x2 = 0; x2 < 8; ++x2) c += pfx[256 * 64 + e * 8 + x2]; n0[e] = c; r[e] = c & 255; d[e] = -(c & 255); rs += c & 255; }
            int extra = rs >> 8;
            for (int k = 0; k < extra; ++k) { int be = -1, br = -1; for (int e = 0; e < 8; ++e) if (d[e] < 0 && d[e] == -r[e] && r[e] > br) { br = r[e]; be = e; } if (be >= 0) d[be] += 256; }
            for (int i = 0; i < 64; ++i) fq_[i] = 0;
            for (int a = 0; a < 8; ++a) for (int e = 0; e < 8; ++e) if (a != e && d[a] < 0 && d[e] > 0) { int fl = -d[a]; if (d[e] < fl) fl = d[e]; const int av = pfx[256 * 64 + a * 8 + e]; if (av < fl) fl = av; fq_[a * 8 + e] = fl; d[a] += fl; d[e] -= fl; }
        }
        __syncthreads();
        if (tid < 256) {
            int c0[8], c1[8];
#pragma unroll
            for (int e = 0; e < 8; ++e) { c0[e] = 0; c1[e] = 0; }
            for (int a = 0; a < 8; ++a) for (int e = 0; e < 8; ++e) { const int pi = a * 8 + e; const int cnt = pfx[(tid + 1) * 64 + pi] - pfx[tid * 64 + pi]; int fl = fq_[pi] - pfx[tid * 64 + pi]; fl = fl < 0 ? 0 : (fl > cnt ? cnt : fl);
#pragma unroll
                for (int q = 0; q < 8; ++q) { c0[q] += (q == a ? cnt - fl : 0) + (q == e ? fl : 0); c1[q] += (q == e ? cnt - fl : 0) + (q == a ? fl : 0); } }
#pragma unroll
            for (int e = 0; e < 8; ++e) { cph[tid * 16 + e] = c0[e]; cph[tid * 16 + 8 + e] = c1[e]; }
        }
        __syncthreads();
        if (tid < 16) { int run = 0; for (int b2 = 0; b2 < 256; ++b2) { const int c = cph[b2 * 16 + tid]; cph[b2 * 16 + tid] = run; run += c; } tot[tid] = run; }
        __syncthreads();
        if (tid < 2) { int off = 0, nt = 0; for (int e = 0; e < 8; ++e) { segoff[tid * 8 + e] = off; const int tl = (tot[tid * 8 + e] + 255) >> 8; for (int q = 0; q < tl; ++q) tile_e[tid * 160 + nt + q] = (unsigned char)e; nt += tl; off += tl * 256; } ntile[tid] = nt; }
        __syncthreads();
        for (int tb = vcu; tb < T / 128; tb += G) {
            int e0 = 0, e1 = 0, flip = 0;
            if (tid < 128) { const int m = tb * 128 + tid; e0 = toke[2 * m]; e1 = toke[2 * m + 1]; tpi[tid] = e0 * 8 + e1; }
            __syncthreads();
            if (tid < 128) { const int pi = e0 * 8 + e1; int rk = 0; for (int i = 0; i < tid; ++i) rk += (tpi[i] == pi) ? 1 : 0;
                flip = (pfx[tb * 64 + pi] + rk) < fq_[pi] ? 1 : 0; tex[tid] = flip ? e1 : e0; tex[128 + tid] = flip ? e0 : e1; }
            __syncthreads();
            if (tid < 128) { const int m = tb * 128 + tid;
#pragma unroll
                for (int ph = 0; ph < 2; ++ph) { const int e = tex[ph * 128 + tid]; int rk = 0; for (int i = 0; i < tid; ++i) rk += (tex[ph * 128 + i] == e) ? 1 : 0;
                    const int row = segoff[ph * 8 + e] + cph[tb * 16 + ph * 8 + e] + rk;
                    rowtok[ph * MOE_ROWS + row] = m; rowgate[ph * MOE_ROWS + row] = tokw[2 * m + (ph ^ flip)]; } }
            __syncthreads();
        }
    }
    GRID_BAR();

    if (PH(16))
#pragma unroll
    for (int s = 0; s < 2; ++s) {
        {
            PHASE_VARS
            SchedMoe S{(const GAS char*)HN8, (const GAS char*)WMGU8, rowtok + s * MOE_ROWS, tile_e + s * 160, 0, (size_t)2 * FFE * D, (size_t)256 * D, ntile[s], 2 * FFE / 256, G, bx, true, 0x7f7f7f7f};
            EpiSwiGLU<true> E{(GAS void*)ACTM, FFE};
            pg8::gemm_phase<EpiSwiGLU<true>, SchedMoe, true, true>(lds, wave_k, D, D, D, S, E);
        }
        GRID_BAR();
        {
            PHASE_VARS
            SchedMoe S{(const GAS char*)ACTM, (const GAS char*)WMD, rowtok + s * MOE_ROWS, tile_e + s * 160, (size_t)256 * FFE, (size_t)D * FFE, (size_t)256 * FFE, ntile[s], 4, G, bx, false, 0x7c7c7c7c};
            EpiMoeDown E{HB, rowtok + s * MOE_ROWS, rowgate + s * MOE_ROWS};
            pg8::gemm_phase<EpiMoeDown, SchedMoe, false, true>(lds, wave_k, FFE, FFE, FFE, S, E);
        }
        GRID_BAR();
    }

    if (PH(17)) {
        PHASE_VARS
        const bool bad = __hip_atomic_load((GAS unsigned*)(ws + WS_CTL) + CW_BAR + XB_TMO, RLX_AGENT) != 0u;
        for (int m = gw; m < T; m += NGW) {
            const GAS bf16* hrow = HB + (size_t)m * D; GAS float* orow = hres + (size_t)m * D;
            f32x4 v[4]; float s = 0.f;
#pragma unroll
            for (int jh = 0; jh < 2; ++jh) { const u32x4 xx = *(const GAS u32x4*)(hrow + 512 * jh + 8 * lane);
                v[2 * jh] = (f32x4){bf_lo(xx.x), bf_hi(xx.x), bf_lo(xx.y), bf_hi(xx.y)}; v[2 * jh + 1] = (f32x4){bf_lo(xx.z), bf_hi(xx.z), bf_lo(xx.w), bf_hi(xx.w)}; }
#pragma unroll
            for (int j = 0; j < 4; ++j) s += (v[j].x * v[j].x + v[j].y * v[j].y) + (v[j].z * v[j].z + v[j].w * v[j].w);
            const float r = bad ? __builtin_nanf("") : 1.0f / sqrtf(wave_sum(s) * (1.f / D) + EPS);
#pragma unroll
            for (int j = 0; j < 4; ++j) { const int col = rmsb_col(j, lane); *(GAS f32x4*)(orow + col) = v[j] * r * *(const GAS f32x4*)(final_norm + col); }
        }
    }
}

extern "C" void kernel_launch(void* const* d_in, const int* in_sizes, int n_in, void* d_out, int out_size, void* d_ws, size_t ws_size, hipStream_t stream) {
    static int grid = 0;
    if (grid == 0) {
        if (n_in != 16 || in_sizes[0] != T * D || out_size != T * D || ws_size < WS_END) { fprintf(stderr, "kernel_launch: unexpected shapes (n_in %d, in0 %d, out %d, ws %zu)\n", n_in, n_in > 0 ? in_sizes[0] : -1, out_size, ws_size); grid = -1; return; }
        int dev = 0, cus = 0, per_cu = 0;
        if (hipGetDevice(&dev) != hipSuccess || hipDeviceGetAttribute(&cus, hipDeviceAttributeMultiprocessorCount, dev) != hipSuccess) { grid = -1; return; }
        if (hipFuncSetAttribute((const void*)fwd_kernel, hipFuncAttributeMaxDynamicSharedMemorySize, LDS_BYTES) != hipSuccess) { fprintf(stderr, "kernel_launch: hipFuncSetAttribute failed\n"); grid = -1; return; }
        if (hipOccupancyMaxActiveBlocksPerMultiprocessor(&per_cu, (const void*)fwd_kernel, NWAVES * 64, LDS_BYTES) != hipSuccess || per_cu < 1) { fprintf(stderr, "kernel_launch: occupancy query says %d\n", per_cu); }
        (void)hipGetLastError();
        grid = cus;
    }
    if (grid < 0) return;
    if (hipMemsetAsync((char*)d_ws + WS_CTL, 0, CTL_ZERO_BYTES, stream) != hipSuccess) return;
    Args a{};
    for (int i = 0; i < 16; ++i) a.in[i] = (const float*)d_in[i];
    a.out = (float*)d_out; a.ws = (unsigned char*)d_ws;
    hipLaunchKernelGGL(fwd_kernel, dim3(grid), dim3(NWAVES * 64), LDS_BYTES, stream, a);
}
```

```cpp
#include <hip/hip_runtime.h>
#include <cstdio>
#include <cstdint>

#define LAS __attribute__((address_space(3)))
#define GAS __attribute__((address_space(1)))
typedef unsigned short bf16;
typedef short bf16x8 __attribute__((ext_vector_type(8)));
typedef float f32x2 __attribute__((ext_vector_type(2)));
typedef float f32x4 __attribute__((ext_vector_type(4)));
typedef float f32x16 __attribute__((ext_vector_type(16)));
typedef unsigned u32x2 __attribute__((ext_vector_type(2)));
typedef unsigned u32x4 __attribute__((ext_vector_type(4)));
typedef GAS unsigned gu32;

constexpr int D = 1024, NB = 8, SEQ = 4096, T = NB * SEQ;
constexpr int NH = 4, DK = 256, DV = 512, QKW = 1024, VW = 2048, INW = 6144, CH = 128, NCH = SEQ / CH;
constexpr int FFD = 2816, NE = 8, FFE = 3584;
constexpr int MOE_ROWS = T + NE * 256;
constexpr float EPS = 1e-6f;

constexpr size_t MiB = 1u << 20;
constexpr size_t WS_CTL = 0, CTL_ZERO_BYTES = 1 * MiB;
constexpr size_t WS_ROT = 1 * MiB, WS_ROTT = 5 * MiB, WS_WC = 10 * MiB + 768 * 1024;
constexpr int RTP = SEQ + 64;
constexpr size_t WS_TOKE = 9 * MiB + 256 * 1024;
constexpr size_t WS_TOKW = WS_TOKE + 256 * 1024;
constexpr size_t WS_BCNT = WS_TOKW + 256 * 1024;
constexpr size_t WS_ROWTOK = WS_BCNT + 16 * 1024;
constexpr size_t WS_ROWGATE = WS_ROWTOK + 2 * MOE_ROWS * 4;
constexpr size_t WS_PCNT = 10 * MiB + 512 * 1024;
constexpr size_t WS_STATS = 11 * MiB;
constexpr size_t WS_TW = 256 * 1024;
constexpr size_t WS_R0 = 64 * 1024;
constexpr size_t WS_SSQ1 = 1 * MiB, WS_SSQ2 = 3 * MiB;
static_assert(WS_ROWGATE + 2 * MOE_ROWS * 4 <= WS_PCNT, "small tables");
constexpr size_t WS_WIN = 12 * MiB, WS_WO = 24 * MiB, WS_WGU = 28 * MiB, WS_WD = 39 * MiB, WS_WF = 44 * MiB + 512 * 1024;
constexpr size_t WS_HN = 48 * MiB;
constexpr size_t WS_Q = 112 * MiB, WS_K = 176 * MiB, WS_KT = 240 * MiB  , WS_VT = 368 * MiB, WS_PC = 496 * MiB;
constexpr size_t WS_YG = 240 * MiB;
constexpr size_t WS_STATP = 176 * MiB;
constexpr size_t WS_ACTD = 112 * MiB;
constexpr size_t WS_Z2 = 112 * MiB, WS_WSEQ = 46 * MiB + 512 * 1024;
constexpr size_t WS_ACTM = 112 * MiB;
constexpr size_t WS_WMGU = 352 * MiB, WS_WMD = 464 * MiB, WS_END = 528 * MiB;
static_assert(WS_ACTM + (size_t)MOE_ROWS * FFE * 2 <= WS_WMGU, "moe act");
static_assert(WS_PC + (size_t)NB * NH * NCH * CH * CH * 2 <= 528 * MiB, "epoch A");
static_assert(WS_WF + (size_t)D * D * 2 <= WS_WSEQ && WS_WSEQ + 512 * 1024 * 2 <= WS_HN, "weights");
constexpr int CW_BAR = 4096;
constexpr int CW_CHK = 64;

constexpr int RING_BYTES = 131072;
constexpr int LDSCTL_OFF = 139264, MISC_OFF = LDSCTL_OFF + 320;
constexpr int LDS_BYTES = 163840;
constexpr int STG_OFF = 147456;

#define LDS_WAIT() asm volatile("s_waitcnt lgkmcnt(0)" ::: "memory")
#define VM_WAIT() asm volatile("s_waitcnt vmcnt(0)" ::: "memory")
#define RLX_AGENT __ATOMIC_RELAXED, __HIP_MEMORY_SCOPE_AGENT

__device__ __forceinline__ unsigned cvt_pk_bf16(float lo, float hi) { unsigned r; asm volatile("v_cvt_pk_bf16_f32 %0, %1, %2" : "=v"(r) : "v"(lo), "v"(hi)); return r; }
__device__ __forceinline__ unsigned pk4_fp8(float a, float b, float c, float d) { int w = 0; w = __builtin_amdgcn_cvt_pk_fp8_f32(a, b, w, false); w = __builtin_amdgcn_cvt_pk_fp8_f32(c, d, w, true); return (unsigned)w; }
__device__ __forceinline__ float bf_lo(unsigned w) { return __uint_as_float(w << 16); }
__device__ __forceinline__ float bf_hi(unsigned w) { return __uint_as_float(w & 0xffff0000u); }
__device__ __forceinline__ float fast_exp2(float x) { return __builtin_amdgcn_exp2f(x); }
__device__ __forceinline__ int lane_id_v() { int l; asm volatile("v_mbcnt_lo_u32_b32 %0, -1, 0\n\tv_mbcnt_hi_u32_b32 %0, -1, %0" : "=v"(l)); return l; }
__device__ __forceinline__ int tid_of(int wave_s) { asm volatile("" : "+s"(wave_s)); return wave_s * 64 + lane_id_v(); }
__device__ __forceinline__ int rot_col(int row, int tok) { return (tok + ((row & 15) << 11)) & (32768 - 1); }
__device__ __forceinline__ f32x4 swiglu4(const f32x4 g, const f32x4 u, const float tc, const float k) {
    const f32x4 t = g * tc;
    f32x4 e; e.x = __builtin_amdgcn_exp2f(t.x); e.y = __builtin_amdgcn_exp2f(t.y); e.z = __builtin_amdgcn_exp2f(t.z); e.w = __builtin_amdgcn_exp2f(t.w);
    const f32x4 d = e * k + k;
    f32x4 r; r.x = __builtin_amdgcn_rcpf(d.x); r.y = __builtin_amdgcn_rcpf(d.y); r.z = __builtin_amdgcn_rcpf(d.z); r.w = __builtin_amdgcn_rcpf(d.w);
    return (g * u) * r;
}
__device__ __forceinline__ float silu_f(float v) { return v * __builtin_amdgcn_rcpf(1.0f + __builtin_amdgcn_exp2f(v * -1.44269504088896341f)); }

namespace pg8 {
constexpr int BM = 256, BK = 64, HALF = 128, HTB = HALF * BK * 2, STAGE_BYTES = 8 * HTB, NXCD = 8, WGM = 2;
__host__ __device__ __forceinline__ int lds_byte(int r, int c) { const int st = (r >> 4) * 2 + (c >> 5), rr = r & 15, cc = c & 31, ob = rr * 64 + cc * 2; return st * 1024 + (ob ^ (((ob >> 9) & 1) << 5)); }
__host__ __device__ __forceinline__ void stage_rc(int b, int& R, int& C) { const int st = b / 1024, sb = b % 1024, swz = sb ^ (((sb >> 9) & 1) << 5); R = (st >> 1) * 16 + swz / 64; C = (st & 1) * 32 + (swz % 64) / 2; }
__host__ __device__ __forceinline__ int perm32(int rho) { const int n = rho >> 4, i = rho & 15; return 8 * (i >> 2) + 4 * n + (i & 3); }

struct Unit { const GAS char* A; const GAS char* B; const GAS int* rows; int pm, pn, z; };

__device__ __forceinline__ bool tile_of(long L, int nM, int nN, int& pm, int& pn) {
    const int nwg = nM * nN; if (L >= nwg) return false;
    int wgid = (int)L; { const int q = nwg / NXCD, r = nwg % NXCD, xcd = wgid % NXCD, off = wgid / NXCD; wgid = (xcd < r ? xcd * (q + 1) : r * (q + 1) + (xcd - r) * q) + off; }
    const int nig = WGM * nN, gid = wgid / nig, fm = gid * WGM, gsz = (nM - fm) < WGM ? (nM - fm) : WGM;
    pm = fm + ((wgid % nig) % gsz); pn = (wgid % nig) / gsz; return true;
}

template <class Epi, class Sched, bool GATHER, bool FP8 = false>
__device__ __forceinline__ void gemm_phase(LAS unsigned char* lds, const int wave_s, const int lda, const int ldb, const int K, const Sched& S, const Epi& E) {
    const int tid = tid_of(wave_s);
    const int wid = __builtin_amdgcn_readfirstlane(tid >> 6), lane = tid & 63, wr = wid >> 2, wc = wid & 3, fr = lane & 15, fq = lane >> 4;
    constexpr int ES = FP8 ? 1 : 2;
    const int nt = K * ES / (BK * 2);
    unsigned vA[2][2], vAn[2][2], voffB[2];
#pragma unroll
    for (int i = 0; i < 2; ++i) { int R, C; stage_rc(tid * 16 + i * 8192, R, C); const int Rb = Epi::PERM ? ((R & ~31) + perm32(R & 31)) : R;
        voffB[i] = (unsigned)(S.brow(Rb) * ldb * ES + C * 2);
#pragma unroll
        for (int h = 0; h < 2; ++h) { vA[h][i] = (unsigned)((h * HALF + R) * lda * ES + C * 2); vAn[h][i] = vA[h][i]; } }
    const size_t kstep = (size_t)(BK * 2);
    const size_t hstepB = (size_t)(S.brow(HALF) - S.brow(0)) * ldb * ES;
    const unsigned ldsw = (unsigned)wid * 1024u;
    const int aoff = lds_byte(wr * 64 + fr, fq * 8), boff = lds_byte(wc * 32 + fr, fq * 8);
    typedef int v4i_ __attribute__((ext_vector_type(4))); typedef int v8i_ __attribute__((ext_vector_type(8)));
    const int sc_w8 = S.scale_b8(), sc_a8 = S.scale_a8(); (void)sc_w8; (void)sc_a8;
#define PG8_SA(b, h) (((b) * 2 + (h)) * HTB)
#define PG8_SB(b, h) ((4 + (b) * 2 + (h)) * HTB)
#define PG8_STAGE_B(bufoff, gbase) do { _Pragma("unroll") for (int _i = 0; _i < 2; ++_i) \
        __builtin_amdgcn_global_load_lds((const GAS unsigned*)((const GAS char*)(gbase) + voffB[_i]), (LAS unsigned*)(lds + (bufoff) + ldsw + _i * 8192), 16, 0, 0); } while (0)
#define PG8_STAGE_A(bufoff, gbase, v0, v1) do { \
        __builtin_amdgcn_global_load_lds((const GAS unsigned*)((const GAS char*)(gbase) + (v0)), (LAS unsigned*)(lds + (bufoff) + ldsw), 16, 0, 0); \
        __builtin_amdgcn_global_load_lds((const GAS unsigned*)((const GAS char*)(gbase) + (v1)), (LAS unsigned*)(lds + (bufoff) + ldsw + 8192), 16, 0, 0); } while (0)
#define PG8_LD32(addr) __builtin_shufflevector(*(const LAS v4i_*)(addr), *(const LAS v4i_*)((addr) + 1024), 0, 1, 2, 3, 4, 5, 6, 7)
#define PG8_LDA(dst, b, h) do { _Pragma("unroll") for (int m = 0; m < 4; ++m) { if constexpr (FP8) dst##8[m] = PG8_LD32(lds + PG8_SA(b, h) + aoff + m * 2048); else { _Pragma("unroll") for (int k = 0; k < 2; ++k) dst[m][k] = *(const LAS bf16x8*)(lds + PG8_SA(b, h) + aoff + m * 2048 + k * 1024); } } } while (0)
#define PG8_LDB(dst, b, h) do { _Pragma("unroll") for (int n = 0; n < 2; ++n) { if constexpr (FP8) dst##8[n] = PG8_LD32(lds + PG8_SB(b, h) + boff + n * 2048); else { _Pragma("unroll") for (int k = 0; k < 2; ++k) dst[n][k] = *(const LAS bf16x8*)(lds + PG8_SB(b, h) + boff + n * 2048 + k * 1024); } } } while (0)
#define PG8_MMA(ai, bj, At, Bt) do { __builtin_amdgcn_s_setprio(1); _Pragma("unroll") for (int m = 0; m < 4; ++m) _Pragma("unroll") for (int n = 0; n < 2; ++n) { \
        if constexpr (FP8) asm volatile("v_mfma_scale_f32_16x16x128_f8f6f4 %0, %1, %2, %0, %3, %4 op_sel_hi:[0,0,0]" : "+v"(acc[ai][bj][m][n]) : "v"(Bt##8[n]), "v"(At##8[m]), "v"(sc_w8), "v"(sc_a8)); \
        else { _Pragma("unroll") for (int k = 0; k < 2; ++k) acc[ai][bj][m][n] = __builtin_amdgcn_mfma_f32_16x16x32_bf16(Bt[n][k], At[m][k], acc[ai][bj][m][n], 0, 0, 0); } } \
        __builtin_amdgcn_s_setprio(0); } while (0)
#define PG8_WAIT_V(n) asm volatile("s_waitcnt vmcnt(" #n ")" ::: "memory")
#define PG8_WAIT_L(n) asm volatile("s_waitcnt lgkmcnt(" #n ")" ::: "memory")
#define PG8_BAR __builtin_amdgcn_s_barrier()
#define PG8_SCHED __builtin_amdgcn_sched_barrier(0)
#define PG8_LOADROWS(dst, u) do { if constexpr (GATHER) { const int _tz = tid_of(wave_s); _Pragma("unroll") for (int _i = 0; _i < 2; ++_i) { int _R, _C; stage_rc(_tz * 16 + _i * 8192, _R, _C); \
        _Pragma("unroll") for (int _h = 0; _h < 2; ++_h) { const int _t = (u).rows[_h * HALF + _R]; dst[_h][_i] = (unsigned)((_t < 0 ? 0 : _t) * lda * ES + _C * 2); } } } } while (0)
#define PG8_VAN(h, i) (GATHER ? vAn[h][i] : vA[h][i])
    Unit cur, nxt; int ui = 0;
    if (!S.next(0, cur)) return;
    f32x4 acc[2][2][4][2];
#pragma unroll
    for (int a = 0; a < 2; ++a)
#pragma unroll
        for (int b = 0; b < 2; ++b)
#pragma unroll
            for (int m = 0; m < 4; ++m)
#pragma unroll
                for (int n = 0; n < 2; ++n) acc[a][b][m][n] = (f32x4){0.f, 0.f, 0.f, 0.f};
    bf16x8 At[4][2], B0[2][2], B1[2][2]; v8i_ At8[4], B08[2], B18[2]; (void)At; (void)B0; (void)B1; (void)At8; (void)B08; (void)B18;
    const GAS char* cA = cur.A; const GAS char* cB = cur.B;
    PG8_LOADROWS(vA, cur);
    if constexpr (GATHER) { vAn[0][0] = vA[0][0]; vAn[0][1] = vA[0][1]; vAn[1][0] = vA[1][0]; vAn[1][1] = vA[1][1]; }
    PG8_STAGE_B(PG8_SB(0, 0), cB); PG8_STAGE_B(PG8_SB(0, 1), cB + hstepB); PG8_STAGE_A(PG8_SA(0, 0), cA, vA[0][0], vA[0][1]); PG8_STAGE_A(PG8_SA(0, 1), cA, vA[1][0], vA[1][1]);
    if (wr == 1) PG8_BAR;
    PG8_WAIT_V(2); PG8_BAR;
    PG8_STAGE_B(PG8_SB(1, 0), cB + kstep); PG8_STAGE_A(PG8_SA(1, 0), cA + kstep, vA[0][0], vA[0][1]); PG8_STAGE_B(PG8_SB(1, 1), cB + hstepB + kstep);
    PG8_WAIT_V(6); PG8_BAR;
    for (;;) {
        const bool has_next = S.next(ui + 1, nxt);
        const GAS char* nA = has_next ? nxt.A : cA; const GAS char* nB = has_next ? nxt.B : cB;
#pragma unroll 1
        for (int t = 0; t < nt; t += 2) {
            const bool last = (t == nt - 2);
            const GAS char* a1 = cA + (size_t)(t + 1) * kstep;
            const GAS char* a2 = last ? nA : cA + (size_t)(t + 2) * kstep; const GAS char* b2 = last ? nB : cB + (size_t)(t + 2) * kstep;
            const GAS char* a3 = a2 + kstep; const GAS char* b3 = b2 + kstep;
            if constexpr (GATHER) { if (last && has_next) { PG8_LOADROWS(vAn, nxt); } }
            PG8_LDB(B0, 0, 0); PG8_LDB(B1, 0, 1); PG8_SCHED; PG8_LDA(At, 0, 0); PG8_STAGE_A(PG8_SA(1, 1), a1, vA[1][0], vA[1][1]);
            PG8_WAIT_V(8); PG8_WAIT_L(0); PG8_BAR; PG8_MMA(0, 0, At, B0); PG8_MMA(0, 1, At, B1); PG8_BAR; PG8_SCHED;
            PG8_LDA(At, 0, 1); PG8_STAGE_B(PG8_SB(0, 0), b2); PG8_STAGE_B(PG8_SB(0, 1), b2 + hstepB); PG8_STAGE_A(PG8_SA(0, 0), a2, PG8_VAN(0, 0), PG8_VAN(0, 1));
            PG8_WAIT_V(8); PG8_WAIT_L(0); PG8_BAR; PG8_MMA(1, 0, At, B0); PG8_MMA(1, 1, At, B1); PG8_BAR; PG8_SCHED;
            PG8_LDB(B0, 1, 0); PG8_LDB(B1, 1, 1); PG8_SCHED; PG8_LDA(At, 1, 0); PG8_STAGE_A(PG8_SA(0, 1), a2, PG8_VAN(1, 0), PG8_VAN(1, 1));
            PG8_WAIT_V(8); PG8_WAIT_L(0); PG8_BAR; PG8_MMA(0, 0, At, B0); PG8_MMA(0, 1, At, B1); PG8_BAR; PG8_SCHED;
            PG8_LDA(At, 1, 1); PG8_STAGE_B(PG8_SB(1, 0), b3); PG8_STAGE_B(PG8_SB(1, 1), b3 + hstepB); PG8_STAGE_A(PG8_SA(1, 0), a3, PG8_VAN(0, 0), PG8_VAN(0, 1));
            PG8_WAIT_V(8); PG8_WAIT_L(0); PG8_BAR; PG8_MMA(1, 0, At, B0); PG8_MMA(1, 1, At, B1); PG8_BAR; PG8_SCHED;
        }
        if (wr == 0) PG8_BAR;
        if constexpr (FP8) asm volatile("s_nop 15\n\ts_nop 15" ::: "memory");
        E(acc, cur, wr, wc, fr, fq);
        if (!has_next) break;
#pragma unroll
        for (int a = 0; a < 2; ++a)
#pragma unroll
            for (int b = 0; b < 2; ++b)
#pragma unroll
                for (int m = 0; m < 4; ++m)
#pragma unroll
                    for (int n = 0; n < 2; ++n) acc[a][b][m][n] = (f32x4){0.f, 0.f, 0.f, 0.f};
        cur = nxt; cA = nA; cB = nB; ++ui;
        if constexpr (GATHER) { vA[0][0] = vAn[0][0]; vA[0][1] = vAn[0][1]; vA[1][0] = vAn[1][0]; vA[1][1] = vAn[1][1]; }
        if (wr == 1) PG8_BAR;
    }
    PG8_WAIT_V(0);
    PG8_BAR;
#undef PG8_SA
#undef PG8_SB
#undef PG8_STAGE_A
#undef PG8_STAGE_B
#undef PG8_LDA
#undef PG8_LD32
#undef PG8_LDB
#undef PG8_MMA
#undef PG8_WAIT_V
#undef PG8_WAIT_L
#undef PG8_BAR
#undef PG8_SCHED
#undef PG8_LOADROWS
#undef PG8_VAN
}
}

struct SchedPlain {
    __device__ __forceinline__ int scale_b8() const { return 0x7f7f7f7f; }
    __device__ __forceinline__ int scale_a8() const { return 0x7f7f7f7f; }
    __device__ __forceinline__ int brow(int r) const { return r; }
    const GAS char* A; const GAS char* B; size_t a_tile, b_tile; int nM, nN, G, c; int flip4;
    __device__ __forceinline__ bool next(int i, pg8::Unit& u) const {
        int pm, pn; if (!pg8::tile_of((long)i * G + c, nM, nN, pm, pn)) return false;
        if (flip4 && ((pm >> 2) & 1)) pn ^= 4;
        u.pm = pm; u.pn = pn; u.z = 0; u.rows = nullptr; u.A = A + (size_t)pm * a_tile; u.B = B + (size_t)pn * b_tile; return true; }
};
struct SchedPlainF8 : SchedPlain {
    __device__ __forceinline__ int scale_b8() const { return 0x79797979; }
    __device__ __forceinline__ int scale_a8() const { return 0x7c7c7c7c; }
};
struct SchedPc {
    __device__ __forceinline__ int scale_b8() const { return 0x7f7f7f7f; }
    __device__ __forceinline__ int scale_a8() const { return 0x7f7f7f7f; }
    __device__ __forceinline__ int brow(int r) const { return r; }
    const GAS char* Q; const GAS char* Kk; int G, c;
    __device__ __forceinline__ bool next(int i, pg8::Unit& u) const {
        const int L = i * G + c; if (L >= NB * NH * 16) return false;
        const int cp = L & 15, h = (L >> 4) & 3, b = L >> 6;
        const size_t off = ((size_t)(b * SEQ + cp * 256) * QKW + h * DK) * 2;
        u.pm = L; u.pn = 0; u.z = h; u.rows = nullptr; u.A = Q + off; u.B = Kk + off; return true; }
};
struct SchedFnA {
    __device__ __forceinline__ int scale_b8() const { return 0x7f7f7f7f; }
    __device__ __forceinline__ int scale_a8() const { return 0x7f7f7f7f; }
    static __device__ __forceinline__ int aoff(int x) { return 8 * ((x >> 2) & 3) + 4 * (x >> 4) + (x & 3); }
    __device__ __forceinline__ int brow(int r) const { return aoff(r >> 3) + 512 * (r & 7); }
    const GAS char* Wc; const GAS char* Hn; int G, c;
    __device__ __forceinline__ bool next(int i, pg8::Unit& u) const {
        int pm, pn; if (!pg8::tile_of((long)i * G + c, 8, T / 256, pm, pn)) return false;
        const int g = pm >> 1, batch = pn >> 4, a0 = (pn & 15) * 32;
        u.pm = pm; u.pn = pn; u.z = 0; u.rows = nullptr; u.A = Wc + (size_t)pm * 256 * 256 * 2; u.B = Hn + ((size_t)(batch * SEQ + a0) * D + g * 256) * 2; return true; }
};
struct SchedFnB {
    __device__ __forceinline__ int scale_b8() const { return 0x7f7f7f7f; }
    __device__ __forceinline__ int scale_a8() const { return 0x7f7f7f7f; }
    __device__ __forceinline__ int brow(int r) const { return (r & 63) * 8 + (r >> 6); }
    GAS const char* WY; GAS const char* U; int G, c;
    __device__ __forceinline__ bool next(int i, pg8::Unit& u) const {
        int pm, pn; if (!pg8::tile_of((long)i * G + c, 2, 256, pm, pn)) return false;
        const int batch = pn >> 5, fb = (pn >> 1) & 15, kbb = pn & 1;
        u.pm = pm; u.pn = pn; u.z = 0; u.rows = nullptr; u.A = WY + (size_t)pm * 256 * 1024 * 2; u.B = U + ((size_t)(batch * 1024 + fb * 64) * 8 + kbb * 4) * 1024 * 2; return true; }
};
struct SchedMoe {
    __device__ __forceinline__ int scale_b8() const { return 0x79797979; }
    __device__ __forceinline__ int scale_a8() const { return sa8; }
    __device__ __forceinline__ int brow(int r) const { return r; }
    const GAS char* A; const GAS char* W; const GAS int* rowtok; const LAS unsigned char* texp; size_t a_tile, w_exp, w_tile; int ntiles, ncol, G, c; bool gather; int sa8;
    __device__ __forceinline__ bool next(int i, pg8::Unit& u) const {
        int rt, ct; if (!pg8::tile_of((long)i * G + c, ntiles, ncol, rt, ct)) return false;
        const int e = texp[rt];
        u.pm = rt; u.pn = ct; u.z = e; u.rows = rowtok + rt * 256; u.A = gather ? A : A + (size_t)rt * a_tile; u.B = W + (size_t)e * w_exp + (size_t)ct * w_tile; return true; }
};

struct EpiRopeQK {
    static constexpr bool PERM = true;
    GAS bf16* Q; GAS bf16* Kk; const GAS f32x2* rot; const GAS float* R0;
    GAS bf16* KT; const LAS float* l2g; LAS unsigned char* tscr;
    __device__ __forceinline__ void operator()(const f32x4 (&acc)[2][2][4][2], const pg8::Unit& u, int wr, int wc, int fr, int fq) const {
        const bool isk = u.pn >= 4; const int h = u.pn & 3; GAS bf16* dst = isk ? Kk : Q; const float sc0 = isk ? 0.0625f : 1.0f;
        const int i0 = wc * 32 + 8 * fq;
#pragma unroll
        for (int ai = 0; ai < 2; ++ai)
#pragma unroll
            for (int m = 0; m < 4; ++m) {
                const int t = u.pm * 256 + ai * 128 + wr * 64 + m * 16 + fr, s = t & (SEQ - 1); const float sc = sc0 * R0[t];
                const GAS f32x4* rp = (const GAS f32x4*)(rot + (size_t)s * 128 + i0);
                const f32x4 r0 = rp[0], r1 = rp[1], r2 = rp[2], r3 = rp[3];
                const float cs[8] = {r0[0], r0[2], r1[0], r1[2], r2[0], r2[2], r3[0], r3[2]}, sn[8] = {r0[1], r0[3], r1[1], r1[3], r2[1], r2[3], r3[1], r3[3]};
                float o1[8], o2[8];
#pragma unroll
                for (int n = 0; n < 2; ++n)
#pragma unroll
                    for (int j = 0; j < 4; ++j) { const float t1 = acc[ai][0][m][n][j], t2 = acc[ai][1][m][n][j]; const int q = 4 * n + j;
                        o1[q] = (t1 * cs[q] - t2 * sn[q]) * sc; o2[q] = (t1 * sn[q] + t2 * cs[q]) * sc; }
                GAS bf16* rowp = dst + (size_t)t * QKW + h * DK + i0;
                u32x4 w1, w2; w1.x = cvt_pk_bf16(o1[0], o1[1]); w1.y = cvt_pk_bf16(o1[2], o1[3]); w1.z = cvt_pk_bf16(o1[4], o1[5]); w1.w = cvt_pk_bf16(o1[6], o1[7]);
                w2.x = cvt_pk_bf16(o2[0], o2[1]); w2.y = cvt_pk_bf16(o2[2], o2[3]); w2.z = cvt_pk_bf16(o2[4], o2[5]); w2.w = cvt_pk_bf16(o2[6], o2[7]);
                *(GAS u32x4*)rowp = w1; *(GAS u32x4*)(rowp + 128) = w2;
                if (isk) {
                    const int jl = wr * 64 + m * 16 + fr;
                    const float zf = fast_exp2((float)(CH - 1 - jl) * l2g[h]), zb = fast_exp2((float)jl * l2g[4 + h]);
                    const int tok0 = u.pm * 256 + ai * 128 + wr * 64 + m * 16 + 8 * (fq >> 1);
                    const size_t fr0 = ((((size_t)((tok0 >> 12) * NH + h) * NCH + ((tok0 & (SEQ - 1)) >> 7)) * 8 + wc) * 8 + (4 * wr + m)) * 512 + (16 * (fq & 1) + fr + 32 * (fq >> 1)) * 8;
                    LAS unsigned char* my = tscr + (wr * 4 + wc) * 2048;
                    const unsigned tra = (unsigned)(size_t)my + (8 * (fq >> 1) + (fr >> 2)) * 64 + 32 * (fq & 1) + 8 * (fr & 3);
#pragma unroll
                    for (int cpy = 0; cpy < 2; ++cpy) { const float z = cpy ? zb : zf;
                        u32x4 a, b; a.x = cvt_pk_bf16(o1[0] * z, o1[1] * z); a.y = cvt_pk_bf16(o1[2] * z, o1[3] * z); a.z = cvt_pk_bf16(o1[4] * z, o1[5] * z); a.w = cvt_pk_bf16(o1[6] * z, o1[7] * z);
                        b.x = cvt_pk_bf16(o2[0] * z, o2[1] * z); b.y = cvt_pk_bf16(o2[2] * z, o2[3] * z); b.z = cvt_pk_bf16(o2[4] * z, o2[5] * z); b.w = cvt_pk_bf16(o2[6] * z, o2[7] * z);
                        *(LAS u32x4*)(my + fr * 64 + fq * 16) = a; *(LAS u32x4*)(my + 1024 + fr * 64 + fq * 16) = b;
                        u32x2 a0, a1, b0, b1;
                        asm volatile("s_waitcnt lgkmcnt(0)\n\tds_read_b64_tr_b16 %0, %4\n\tds_read_b64_tr_b16 %1, %4 offset:256\n\tds_read_b64_tr_b16 %2, %4 offset:1024\n\tds_read_b64_tr_b16 %3, %4 offset:1280\n\ts_waitcnt lgkmcnt(0)"
                                     : "=&v"(a0), "=&v"(a1), "=&v"(b0), "=&v"(b1) : "v"(tra) : "memory");
                        GAS bf16* kd = KT + (size_t)cpy * QKW * T + fr0;
                        *(GAS u32x4*)kd = (u32x4){a0.x, a0.y, a1.x, a1.y}; *(GAS u32x4*)(kd + (size_t)4 * 8 * 512) = (u32x4){b0.x, b0.y, b1.x, b1.y}; }
                } }
    }
};
struct EpiRopeKT {
    static constexpr bool PERM = true;
    GAS bf16* KT; const GAS f32x2* rotT; const LAS float* l2g; const GAS float* R0;
    __device__ __forceinline__ void operator()(const f32x4 (&acc)[2][2][4][2], const pg8::Unit& u, int wr, int wc, int fr, int fq) const {
        const int h = u.pm; const float l2f = l2g[h], l2b = l2g[4 + h];
#pragma unroll
        for (int bj = 0; bj < 2; ++bj) {
            const int tok0 = u.pn * 256 + bj * 128 + wc * 32 + 8 * fq, s0 = tok0 & (SEQ - 1), j0 = tok0 & (CH - 1);
            float zf[8], zb[8];
            const f32x4 ra = *(const GAS f32x4*)(R0 + tok0), rb = *(const GAS f32x4*)(R0 + tok0 + 4); const float rq[8] = {ra[0], ra[1], ra[2], ra[3], rb[0], rb[1], rb[2], rb[3]};
#pragma unroll
            for (int q = 0; q < 8; ++q) { const float rs = rq[q] * 0.0625f; zf[q] = fast_exp2((float)(CH - 1 - (j0 + q)) * l2f) * rs; zb[q] = fast_exp2((float)(j0 + q) * l2b) * rs; }
#pragma unroll
            for (int m = 0; m < 4; ++m) { const int i = wr * 64 + m * 16 + fr;
                const GAS f32x4* rp = (const GAS f32x4*)(rotT + (size_t)i * RTP + s0);
                const f32x4 r0 = rp[0], r1 = rp[1], r2 = rp[2], r3 = rp[3];
                const float cs[8] = {r0[0], r0[2], r1[0], r1[2], r2[0], r2[2], r3[0], r3[2]}, sn[8] = {r0[1], r0[3], r1[1], r1[3], r2[1], r2[3], r3[1], r3[3]};
                float o1[8], o2[8];
#pragma unroll
                for (int n = 0; n < 2; ++n)
#pragma unroll
                    for (int j = 0; j < 4; ++j) { const float t1 = acc[0][bj][m][n][j], t2 = acc[1][bj][m][n][j]; const int q = 4 * n + j;
                        o1[q] = t1 * cs[q] - t2 * sn[q]; o2[q] = t1 * sn[q] + t2 * cs[q]; }
                u32x4 w1, w2;
                w1.x = cvt_pk_bf16(o1[0] * zf[0], o1[1] * zf[1]); w1.y = cvt_pk_bf16(o1[2] * zf[2], o1[3] * zf[3]); w1.z = cvt_pk_bf16(o1[4] * zf[4], o1[5] * zf[5]); w1.w = cvt_pk_bf16(o1[6] * zf[6], o1[7] * zf[7]);
                w2.x = cvt_pk_bf16(o2[0] * zf[0], o2[1] * zf[1]); w2.y = cvt_pk_bf16(o2[2] * zf[2], o2[3] * zf[3]); w2.z = cvt_pk_bf16(o2[4] * zf[4], o2[5] * zf[5]); w2.w = cvt_pk_bf16(o2[6] * zf[6], o2[7] * zf[7]);
                const size_t fr0 = ((((size_t)((tok0 >> 12) * NH + h) * NCH + ((tok0 & (SEQ - 1)) >> 7)) * 8 + (i >> 5)) * 8 + (2 * wc + (fq >> 1))) * 512 + ((i & 31) + 32 * (fq & 1)) * 8;
                *(GAS u32x4*)(KT + fr0) = w1; *(GAS u32x4*)(KT + fr0 + (size_t)4 * 8 * 512) = w2;
                w1.x = cvt_pk_bf16(o1[0] * zb[0], o1[1] * zb[1]); w1.y = cvt_pk_bf16(o1[2] * zb[2], o1[3] * zb[3]); w1.z = cvt_pk_bf16(o1[4] * zb[4], o1[5] * zb[5]); w1.w = cvt_pk_bf16(o1[6] * zb[6], o1[7] * zb[7]);
                w2.x = cvt_pk_bf16(o2[0] * zb[0], o2[1] * zb[1]); w2.y = cvt_pk_bf16(o2[2] * zb[2], o2[3] * zb[3]); w2.z = cvt_pk_bf16(o2[4] * zb[4], o2[5] * zb[5]); w2.w = cvt_pk_bf16(o2[6] * zb[6], o2[7] * zb[7]);
                *(GAS u32x4*)(KT + (size_t)QKW * T + fr0) = w1; *(GAS u32x4*)(KT + (size_t)QKW * T + fr0 + (size_t)4 * 8 * 512) = w2; } }
    }
};
template <bool ROT> struct EpiBf16 {
    static constexpr bool PERM = true;
    GAS bf16* O; int ldc; const GAS float* cs;
    __device__ __forceinline__ void operator()(const f32x4 (&acc)[2][2][4][2], const pg8::Unit& u, int wr, int wc, int fr, int fq) const {
        f32x4 c0[2], c1[2];
#pragma unroll
        for (int bj = 0; bj < 2; ++bj) { const int col = u.pn * 256 + bj * 128 + wc * 32 + 8 * fq; c0[bj] = cs != nullptr ? *(const GAS f32x4*)(cs + col) : (f32x4){1.f, 1.f, 1.f, 1.f}; c1[bj] = cs != nullptr ? *(const GAS f32x4*)(cs + col + 4) : (f32x4){1.f, 1.f, 1.f, 1.f}; }
#pragma unroll
        for (int ai = 0; ai < 2; ++ai)
#pragma unroll
            for (int m = 0; m < 4; ++m) { const int row = u.pm * 256 + ai * 128 + wr * 64 + m * 16 + fr; GAS bf16* rowp = O + (size_t)row * ldc;
#pragma unroll
                for (int bj = 0; bj < 2; ++bj) { const f32x4 v0 = acc[ai][bj][m][0] * c0[bj], v1 = acc[ai][bj][m][1] * c1[bj]; const int col = u.pn * 256 + bj * 128 + wc * 32 + 8 * fq;
                    u32x4 w; w.x = cvt_pk_bf16(v0[0], v0[1]); w.y = cvt_pk_bf16(v0[2], v0[3]); w.z = cvt_pk_bf16(v1[0], v1[1]); w.w = cvt_pk_bf16(v1[2], v1[3]);
                    *(GAS u32x4*)(rowp + (ROT ? rot_col(row, col) : col)) = w; } }
    }
};
struct EpiPc {
    static constexpr bool PERM = true;
    GAS bf16* PC; GAS bf16* PD; const LAS float* l2g;
    __device__ __forceinline__ void operator()(const f32x4 (&acc)[2][2][4][2], const pg8::Unit& u, int wr, int wc, int fr, int fq) const {
        const int h = u.z; const float l2f = l2g[h], l2b = l2g[4 + h];
#pragma unroll
        for (int ai = 0; ai < 2; ++ai)
#pragma unroll
            for (int m = 0; m < 4; ++m) { const int il = wr * 64 + m * 16 + fr, jl0 = wc * 32 + 8 * fq; float o[8];
                const bool diag = (wc == 2 * wr + (m >> 1));
#pragma unroll
                for (int n = 0; n < 2; ++n)
#pragma unroll
                    for (int j = 0; j < 4; ++j) { const int dl = il - (jl0 + 4 * n + j); const float f = dl >= 0 ? fast_exp2((float)dl * l2f) : fast_exp2((float)(-dl) * l2b);
                        o[4 * n + j] = (ai == 0 ? acc[0][0][m][n][j] : acc[1][1][m][n][j]) * f; }
                if (diag) {
                    float ob[8];
#pragma unroll
                    for (int q = 0; q < 8; ++q) { const bool lower = (jl0 + q) <= il; ob[q] = lower ? 0.f : o[q]; o[q] = lower ? o[q] : 0.f; }
                    u32x4 wb; wb.x = cvt_pk_bf16(ob[0], ob[1]); wb.y = cvt_pk_bf16(ob[2], ob[3]); wb.z = cvt_pk_bf16(ob[4], ob[5]); wb.w = cvt_pk_bf16(ob[6], ob[7]);
                    *(GAS u32x4*)(PD + ((((size_t)(u.pm * 2 + ai) * 4 + (il >> 5)) * 2 + (fq >> 1)) * 512 + ((il & 31) + 32 * (fq & 1)) * 8)) = wb;
                }
                u32x4 w; w.x = cvt_pk_bf16(o[0], o[1]); w.y = cvt_pk_bf16(o[2], o[3]); w.z = cvt_pk_bf16(o[4], o[5]); w.w = cvt_pk_bf16(o[6], o[7]);
                *(GAS u32x4*)(PC + ((((size_t)(u.pm * 2 + ai) * 4 + (il >> 5)) * 8 + (2 * wc + (fq >> 1))) * 512 + ((il & 31) + 32 * (fq & 1)) * 8)) = w; }
    }
};
struct EpiGate {
    static constexpr bool PERM = true;
    const GAS bf16* Y; GAS bf16* YG; const GAS f32x2* statp; const GAS float* gain; LAS f32x2* sst; const GAS float* R0;
    __device__ __forceinline__ void operator()(const f32x4 (&acc)[2][2][4][2], const pg8::Unit& u, int wr, int wc, int fr, int fq) const {
        const int head = u.pn >> 1, c0 = u.pn * 256 + wc * 32 + 8 * fq;
        const int tid = (wr * 4 + wc) * 64 + fq * 16 + fr;
        if (tid < 256) { const int t = u.pm * 256 + tid; const GAS f32x4* sp = (const GAS f32x4*)(statp + ((size_t)t * 4 + head) * 8); float a1 = 0.f, a2 = 0.f;
#pragma unroll
            for (int k = 0; k < 4; ++k) { const f32x4 v = sp[k]; a1 += v[0] + v[2]; a2 += v[1] + v[3]; }
            const float mu = a1 * (1.f / DV), var = fmaxf(a2 * (1.f / DV) - mu * mu, 0.f); sst[tid] = (f32x2){mu, __builtin_amdgcn_rsqf(var + EPS)}; }
        asm volatile("s_waitcnt lgkmcnt(0)" ::: "memory"); __builtin_amdgcn_s_barrier(); asm volatile("" ::: "memory");
        f32x4 gv[2][2];
#pragma unroll
        for (int bj = 0; bj < 2; ++bj) { gv[bj][0] = *(const GAS f32x4*)(gain + c0 + bj * 128); gv[bj][1] = *(const GAS f32x4*)(gain + c0 + bj * 128 + 4); }
#pragma unroll
        for (int ai = 0; ai < 2; ++ai)
#pragma unroll
            for (int m = 0; m < 4; ++m) { const int rl = ai * 128 + wr * 64 + m * 16 + fr, t = u.pm * 256 + rl; const f32x2 st = sst[rl]; const float r0 = R0[t];
#pragma unroll
                for (int bj = 0; bj < 2; ++bj) { const size_t off = (size_t)t * VW + c0 + bj * 128;
                    const int es_ = (u.pn & 1) * 4 + bj * 2 + (wc >> 1);
                    const u32x4 yv = *(const GAS u32x4*)(Y + (((size_t)(t >> 5) * NH + head) * 8 + es_) * 2048 + (((wc & 1) * 2 + (fq >> 1)) * 64 + (t & 31) + 32 * (fq & 1)) * 8);
                    const f32x4 yv4[2] = {(f32x4){bf_lo(yv.x), bf_hi(yv.x), bf_lo(yv.y), bf_hi(yv.y)}, (f32x4){bf_lo(yv.z), bf_hi(yv.z), bf_lo(yv.w), bf_hi(yv.w)}}; float o[8];
                    const float c1 = st.y * r0;
#pragma unroll
                    for (int n = 0; n < 2; ++n) { const f32x4 yn = (yv4[n] - st.x) * gv[bj][n] * c1;
                        const f32x4 ov = swiglu4(acc[ai][bj][m][n], yn, -1.44269504088896341f * r0, 1.0f); o[4 * n] = ov.x; o[4 * n + 1] = ov.y; o[4 * n + 2] = ov.z; o[4 * n + 3] = ov.w; }
                    u32x4 w; w.x = cvt_pk_bf16(o[0], o[1]); w.y = cvt_pk_bf16(o[2], o[3]); w.z = cvt_pk_bf16(o[4], o[5]); w.w = cvt_pk_bf16(o[6], o[7]);
                    *(GAS u32x4*)(YG + off) = w; } }
    }
};
template <bool BASE_F32> struct EpiRes {
    static constexpr bool PERM = true;
    const GAS void* base; GAS bf16* out; GAS float* ssq;
    __device__ __forceinline__ void operator()(const f32x4 (&acc)[2][2][4][2], const pg8::Unit& u, int wr, int wc, int fr, int fq) const {
#pragma unroll
        for (int ai = 0; ai < 2; ++ai)
#pragma unroll
            for (int m = 0; m < 4; ++m) { const int t_ = u.pm * 256 + ai * 128 + wr * 64 + m * 16 + fr; const size_t off = (size_t)t_ * D + u.pn * 256 + wc * 32 + 8 * fq; float sq = 0.f;
#pragma unroll
                for (int bj = 0; bj < 2; ++bj) { f32x4 v0 = acc[ai][bj][m][0], v1 = acc[ai][bj][m][1];
                    if (BASE_F32) { const GAS float* bp = (const GAS float*)base + off + bj * 128; v0 += *(const GAS f32x4*)bp; v1 += *(const GAS f32x4*)(bp + 4); }
                    else { const u32x4 bv = *(const GAS u32x4*)((const GAS bf16*)base + off + bj * 128);
                        v0 += (f32x4){bf_lo(bv.x), bf_hi(bv.x), bf_lo(bv.y), bf_hi(bv.y)}; v1 += (f32x4){bf_lo(bv.z), bf_hi(bv.z), bf_lo(bv.w), bf_hi(bv.w)}; }
                    u32x4 w; w.x = cvt_pk_bf16(v0[0], v0[1]); w.y = cvt_pk_bf16(v0[2], v0[3]); w.z = cvt_pk_bf16(v1[0], v1[1]); w.w = cvt_pk_bf16(v1[2], v1[3]);
                    *(GAS u32x4*)(out + off + bj * 128) = w;
                    { const float a0 = bf_lo(w.x), a1 = bf_hi(w.x), a2 = bf_lo(w.y), a3 = bf_hi(w.y), a4 = bf_lo(w.z), a5 = bf_hi(w.z), a6 = bf_lo(w.w), a7 = bf_hi(w.w);
                      sq += (a0 * a0 + a1 * a1) + (a2 * a2 + a3 * a3) + (a4 * a4 + a5 * a5) + (a6 * a6 + a7 * a7); } }
                sq += __shfl_xor(sq, 16); sq += __shfl_xor(sq, 32);
                if (ssq != nullptr && fq == 0) ssq[(size_t)t_ * 16 + u.pn * 4 + wc] = sq; }
    }
};
template <bool OUT8, bool NORM = false> struct EpiSwiGLU {
    static constexpr bool PERM = true;
    GAS void* ACT; int ldc; const GAS float* ssq; LAS float* sst;
    __device__ __forceinline__ void operator()(const f32x4 (&acc)[2][2][4][2], const pg8::Unit& u, int wr, int wc, int fr, int fq) const {
        if constexpr (NORM) {
            const int tid = (wr * 4 + wc) * 64 + fq * 16 + fr;
            if (tid < 256) { const GAS f32x4* sp = (const GAS f32x4*)(ssq + (size_t)(u.pm * 256 + tid) * 16); float a = 0.f;
#pragma unroll
                for (int k = 0; k < 4; ++k) { const f32x4 v = sp[k]; a += (v[0] + v[1]) + (v[2] + v[3]); }
                const float var = a * (1.f / D) + EPS; ((LAS f32x2*)sst)[tid] = (f32x2){__builtin_amdgcn_rsqf(var), var}; }
            asm volatile("s_waitcnt lgkmcnt(0)" ::: "memory"); __builtin_amdgcn_s_barrier(); asm volatile("" ::: "memory");
        }
#pragma unroll
        for (int ai = 0; ai < 2; ++ai)
#pragma unroll
            for (int m = 0; m < 4; ++m) { float o[8]; float tc = -1.44269504088896341f, kk = OUT8 ? 0.125f : 1.0f;
                if constexpr (NORM) { const f32x2 sv = ((const LAS f32x2*)sst)[ai * 128 + wr * 64 + m * 16 + fr]; tc *= sv.x; kk *= sv.y; }
#pragma unroll
                for (int n = 0; n < 2; ++n) { const f32x4 ov = swiglu4(acc[ai][0][m][n], acc[ai][1][m][n], tc, kk); o[4 * n] = ov.x; o[4 * n + 1] = ov.y; o[4 * n + 2] = ov.z; o[4 * n + 3] = ov.w; }
                const size_t off = (size_t)(u.pm * 256 + ai * 128 + wr * 64 + m * 16 + fr) * ldc + u.pn * 128 + wc * 32 + 8 * fq;
                if constexpr (OUT8) { u32x2 w; w.x = pk4_fp8(o[0], o[1], o[2], o[3]); w.y = pk4_fp8(o[4], o[5], o[6], o[7]); *(GAS u32x2*)((GAS unsigned char*)ACT + off) = w; }
                else { u32x4 w; w.x = cvt_pk_bf16(o[0], o[1]); w.y = cvt_pk_bf16(o[2], o[3]); w.z = cvt_pk_bf16(o[4], o[5]); w.w = cvt_pk_bf16(o[6], o[7]); *(GAS u32x4*)((GAS bf16*)ACT + off) = w; } }
    }
};
__device__ __forceinline__ void fft8(const float (&xr)[8], const float (&xi)[8], float (&Xr)[8], float (&Xi)[8]) {
    constexpr float R = 0.70710678118654752f;
    float ar[4], ai[4], br[4], bi[4];
#pragma unroll
    for (int n = 0; n < 4; ++n) { ar[n] = xr[n] + xr[n + 4]; ai[n] = xi[n] + xi[n + 4]; br[n] = xr[n] - xr[n + 4]; bi[n] = xi[n] - xi[n + 4]; }
    { const float r = br[1], i = bi[1]; br[1] = (r + i) * R; bi[1] = (i - r) * R; }
    { const float r = br[2], i = bi[2]; br[2] = i; bi[2] = -r; }
    { const float r = br[3], i = bi[3]; br[3] = (i - r) * R; bi[3] = -(i + r) * R; }
    { const float t0r = ar[0] + ar[2], t0i = ai[0] + ai[2], t1r = ar[0] - ar[2], t1i = ai[0] - ai[2], t2r = ar[1] + ar[3], t2i = ai[1] + ai[3], t3r = ai[1] - ai[3], t3i = -(ar[1] - ar[3]);
      Xr[0] = t0r + t2r; Xi[0] = t0i + t2i; Xr[4] = t0r - t2r; Xi[4] = t0i - t2i; Xr[2] = t1r + t3r; Xi[2] = t1i + t3i; Xr[6] = t1r - t3r; Xi[6] = t1i - t3i; }
    { const float t0r = br[0] + br[2], t0i = bi[0] + bi[2], t1r = br[0] - br[2], t1i = bi[0] - bi[2], t2r = br[1] + br[3], t2i = bi[1] + bi[3], t3r = bi[1] - bi[3], t3i = -(br[1] - br[3]);
      Xr[1] = t0r + t2r; Xi[1] = t0i + t2i; Xr[5] = t0r - t2r; Xi[5] = t0i - t2i; Xr[3] = t1r + t3r; Xi[3] = t1i + t3i; Xr[7] = t1r - t3r; Xi[7] = t1i - t3i; }
}
struct EpiZ2 {
    static constexpr bool PERM = true;
    GAS bf16* Z2; const GAS float* ssq; LAS float* sst; const GAS f32x2* TW; LAS unsigned char* stg;
    __device__ __forceinline__ void operator()(const f32x4 (&acc)[2][2][4][2], const pg8::Unit& u, int wr, int wc, int fr, int fq) const {
        asm volatile("" : "+v"(fr), "+v"(fq));
        const int g = u.pm >> 1, hf = u.pm & 1, batch = u.pn >> 4, a0 = (u.pn & 15) * 32;
        { int tid = (wr * 4 + wc) * 64 + fq * 16 + fr; asm volatile("" : "+v"(tid));
          if (tid < 256) { const int tok = batch * SEQ + a0 + SchedFnA::aoff(tid >> 3) + 512 * (tid & 7); const GAS f32x4* sp = (const GAS f32x4*)(ssq + (size_t)tok * 16); float a = 0.f;
#pragma unroll
              for (int k = 0; k < 4; ++k) { const f32x4 v = sp[k]; a += (v[0] + v[1]) + (v[2] + v[3]); }
              sst[tid] = __builtin_amdgcn_rsqf(a * (1.f / D) + EPS); }
          asm volatile("s_waitcnt lgkmcnt(0)" ::: "memory"); __builtin_amdgcn_s_barrier(); asm volatile("" ::: "memory"); }
        float w1c[2], w1s[2];
#pragma unroll
        for (int bj = 0; bj < 2; ++bj) { const f32x2 t = TW[(a0 + 8 * wc + 4 * bj + fq) * 8 + 1]; w1c[bj] = t.x; w1s[bj] = t.y; }
#pragma unroll
        for (int m = 0; m < 4; ++m) { const int f = g * 256 + hf * 128 + wr * 64 + m * 16 + fr;
            unsigned pk[2][8];
#pragma unroll
            for (int bj = 0; bj < 2; ++bj) {
                float zr[8], zi[8], o[16];
                { const LAS f32x4* rp = (const LAS f32x4*)(sst + bj * 128 + wc * 32 + 8 * fq); const f32x4 r0 = rp[0], r1 = rp[1];
                  const float rs[8] = {r0[0], r0[1], r0[2], r0[3], r1[0], r1[1], r1[2], r1[3]};
#pragma unroll
                  for (int bb = 0; bb < 8; ++bb) { zr[bb] = acc[0][bj][m][bb >> 2][bb & 3] * rs[bb]; zi[bb] = acc[1][bj][m][bb >> 2][bb & 3] * rs[bb]; } }
                float Ur[8], Ui[8]; fft8(zr, zi, Ur, Ui);
                float tc = 1.f, ts = 0.f;
#pragma unroll
                for (int kb = 0; kb < 8; ++kb) {
                    o[kb] = Ur[kb] * tc + Ui[kb] * ts; o[8 + kb] = Ui[kb] * tc - Ur[kb] * ts;
                    { const float nc = tc * w1c[bj] - ts * w1s[bj], ns = ts * w1c[bj] + tc * w1s[bj]; tc = nc; ts = ns; } }
#pragma unroll
                for (int k = 0; k < 8; ++k) pk[bj][k] = cvt_pk_bf16(o[2 * k], o[2 * k + 1]);
            }
            u32x4 vec[4];
#pragma unroll
            for (int bj = 0; bj < 2; ++bj)
#pragma unroll
                for (int sp = 0; sp < 2; ++sp) {
                    unsigned g0 = pk[bj][0 + sp], g1 = pk[bj][2 + sp], g2 = pk[bj][4 + sp], g3 = pk[bj][6 + sp];
                    { const auto r_ = __builtin_amdgcn_permlane16_swap(g0, g1, false, false); g0 = r_[0]; g1 = r_[1]; }
                    { const auto r_ = __builtin_amdgcn_permlane16_swap(g2, g3, false, false); g2 = r_[0]; g3 = r_[1]; }
                    { const auto r_ = __builtin_amdgcn_permlane32_swap(g0, g2, false, false); g0 = r_[0]; g2 = r_[1]; }
                    { const auto r_ = __builtin_amdgcn_permlane32_swap(g1, g3, false, false); g1 = r_[0]; g3 = r_[1]; }
                    const unsigned lo01 = __builtin_amdgcn_perm(g1, g0, 0x05040100u), lo23 = __builtin_amdgcn_perm(g3, g2, 0x05040100u);
                    const unsigned hi01 = __builtin_amdgcn_perm(g1, g0, 0x07060302u), hi23 = __builtin_amdgcn_perm(g3, g2, 0x07060302u);
                    vec[2 * sp][2 * bj] = lo01; vec[2 * sp][2 * bj + 1] = lo23; vec[2 * sp + 1][2 * bj] = hi01; vec[2 * sp + 1][2 * bj + 1] = hi23; }
            (void)f;
            { const int tid = (wr * 4 + wc) * 64 + fq * 16 + fr, fl = wr * 16 + fr;
#pragma unroll
              for (int half = 0; half < 2; ++half) {
#pragma unroll
                  for (int j = 0; j < 2; ++j) { const int cq = 2 * fq + j;
                      *(LAS u32x4*)(stg + fl * 512 + (((cq >> 2) << 4) + ((((cq & 3) << 2) | wc) ^ fr)) * 16) = vec[2 * half + j]; }
                  asm volatile("s_waitcnt lgkmcnt(0)" ::: "memory"); __builtin_amdgcn_s_barrier(); asm volatile("" ::: "memory");
#pragma unroll
                  for (int r = 0; r < 2; ++r) { const int i = r * 512 + tid, fl2 = i >> 5, c = i & 31, cq2 = c >> 2, wcx = c & 3;
                      const u32x4 v = *(const LAS u32x4*)(stg + fl2 * 512 + (((cq2 >> 2) << 4) + ((((cq2 & 3) << 2) | wcx) ^ (fl2 & 15))) * 16);
                      const int f2 = g * 256 + hf * 128 + (fl2 >> 4) * 64 + m * 16 + (fl2 & 15), q = 4 * (cq2 >> 1) + 2 * half + (cq2 & 1), ri = q >> 3, kb = q & 7;
                      *(GAS u32x4*)(Z2 + ((size_t)(batch * 1024 + f2) * 8 + kb) * 1024 + ri * 512 + a0 + 8 * wcx) = v; }
                  asm volatile("s_waitcnt lgkmcnt(0)" ::: "memory"); __builtin_amdgcn_s_barrier(); asm volatile("" ::: "memory");
              } }
        }
    }
};
struct EpiYf {
    static constexpr bool PERM = true;
    GAS bf16* YF;
    __device__ __forceinline__ void operator()(const f32x4 (&acc)[2][2][4][2], const pg8::Unit& u, int wr, int wc, int fr, int fq) const {
        const int batch = u.pn >> 5, fb = (u.pn >> 1) & 15, kbb = u.pn & 1;
#pragma unroll
        for (int ai = 0; ai < 2; ++ai)
#pragma unroll
            for (int m = 0; m < 4; ++m) { const int ka = u.pm * 256 + ai * 128 + wr * 64 + m * 16 + fr;
#pragma unroll
                for (int bj = 0; bj < 2; ++bj) { const int kb = kbb * 4 + 2 * bj + (wc >> 1), f = fb * 64 + 32 * (wc & 1) + 8 * fq;
                    const f32x4 v0 = acc[ai][bj][m][0], v1 = acc[ai][bj][m][1];
                    u32x4 w; w.x = cvt_pk_bf16(v0[0], v0[1]); w.y = cvt_pk_bf16(v0[2], v0[3]); w.z = cvt_pk_bf16(v1[0], v1[1]); w.w = cvt_pk_bf16(v1[2], v1[3]);
                    *(GAS u32x4*)(YF + (size_t)(batch * SEQ + 8 * ka + kb) * D + f) = w; } }
    }
};
struct EpiMoeDown {
    static constexpr bool PERM = true;
    GAS bf16* Hres; const GAS int* rowtok; const GAS float* rowgate;
    __device__ __forceinline__ void operator()(const f32x4 (&acc)[2][2][4][2], const pg8::Unit& u, int wr, int wc, int fr, int fq) const {
#pragma unroll
        for (int ai = 0; ai < 2; ++ai)
#pragma unroll
            for (int m = 0; m < 4; ++m) { const int row = u.pm * 256 + ai * 128 + wr * 64 + m * 16 + fr; const int tok = rowtok[row]; const float gw = rowgate[row];
                if (tok >= 0) { GAS bf16* rp = Hres + (size_t)tok * D + u.pn * 256 + wc * 32 + 8 * fq;
#pragma unroll
                    for (int bj = 0; bj < 2; ++bj) { const u32x4 bv = *(const GAS u32x4*)(rp + bj * 128);
                        const f32x4 v0 = (f32x4){bf_lo(bv.x), bf_hi(bv.x), bf_lo(bv.y), bf_hi(bv.y)} + gw * acc[ai][bj][m][0], v1 = (f32x4){bf_lo(bv.z), bf_hi(bv.z), bf_lo(bv.w), bf_hi(bv.w)} + gw * acc[ai][bj][m][1];
                        u32x4 w; w.x = cvt_pk_bf16(v0[0], v0[1]); w.y = cvt_pk_bf16(v0[2], v0[3]); w.z = cvt_pk_bf16(v1[0], v1[1]); w.w = cvt_pk_bf16(v1[2], v1[3]);
                        *(GAS u32x4*)(rp + bj * 128) = w; } } }
    }
};

#define XB_TMO      128
#define XB_XCNT(j)  (256  + 64 * (j))
#define XB_XSUB(j)  (1280 + 64 * (j))
#define XB_XGEN(j)  (2304 + 64 * (j))
#define XB_TOP      3328
#define XB_TOPGEN   3392
#define XCD_BAR_WORDS 3456
#define XB_SPIN_CAP (1u << 18)
__device__ __forceinline__ unsigned xb_ld(unsigned* p)              { return __hip_atomic_load(p, __ATOMIC_RELAXED, __HIP_MEMORY_SCOPE_AGENT); }
__device__ __forceinline__ unsigned xb_add(unsigned* p, unsigned v) { return __hip_atomic_fetch_add(p, v, __ATOMIC_RELAXED, __HIP_MEMORY_SCOPE_AGENT); }
__device__ __forceinline__ unsigned xb_xcc_id() { return (unsigned)__builtin_amdgcn_s_getreg((3 << 11) | 20) & 0xFu; }
#define XB_SPIN(cond, bar) do { unsigned _sp = 0; while (cond) { __builtin_amdgcn_s_sleep(1); \
    if ((++_sp & 255u) == 0u) { if (xb_ld(&(bar)[XB_TMO])) break; if (_sp > XB_SPIN_CAP) { atomicAdd(&(bar)[XB_TMO], 1u); break; } } } } while (0)
struct XcdBarrier { unsigned* bar; unsigned x; volatile LAS unsigned* st; };
__device__ __forceinline__ XcdBarrier xcd_barrier_post(unsigned* bar, volatile LAS unsigned* st, const bool t0) {
    XcdBarrier b; b.bar = bar; b.x = xb_xcc_id(); b.st = st;
    if (t0) (void)xb_add(&bar[XB_XCNT(b.x)], 1u);
    return b;
}
__device__ __forceinline__ void xcd_barrier_complete(unsigned* bar, unsigned x, unsigned& nloc, unsigned& nx) {
    const unsigned G = gridDim.x * gridDim.y * gridDim.z;
    unsigned sum, cnt, mine, sp = 0u;
    for (;;) {
        sum = 0u; cnt = 0u; mine = 0u;
#pragma unroll
        for (unsigned j = 0; j < 16; ++j) { const unsigned c = xb_ld(&bar[XB_XCNT(j)]); sum += c; cnt += (c > 0u) ? 1u : 0u; mine = (j == x) ? c : mine; }
        if (sum == G) break;
        __builtin_amdgcn_s_sleep(1);
        if ((++sp & 255u) == 0u) { if (xb_ld(&bar[XB_TMO])) break; if (sp > XB_SPIN_CAP) { atomicAdd(&bar[XB_TMO], 1u); break; } }
    }
    nloc = mine > 0u ? mine : 1u; nx = cnt > 0u ? cnt : 1u;
}
__device__ __forceinline__ void xcd_barrier(const XcdBarrier& b, const bool t0) {
    asm volatile("s_waitcnt vmcnt(0)" ::: "memory");
    __syncthreads();
    if (t0) {
        unsigned* bar = b.bar;
        __builtin_amdgcn_s_waitcnt(0);
        unsigned nloc = b.st[0], nx = b.st[1];
        if (nloc == 0u) { xcd_barrier_complete(bar, b.x, nloc, nx); b.st[0] = nloc; b.st[1] = nx; }
        const unsigned old = xb_add(&bar[XB_XSUB(b.x)], 1u);
        const unsigned gen = old / nloc;
        if (old + 1u == (gen + 1u) * nloc) {
            __builtin_amdgcn_fence(__ATOMIC_RELEASE, "agent");
            asm volatile("s_waitcnt vmcnt(0)" ::: "memory");
            const unsigned og = xb_add(&bar[XB_TOP], 1u);
            const unsigned tg = og / nx;
            if (og + 1u == (tg + 1u) * nx) xb_add(&bar[XB_TOPGEN], 1u);
            else XB_SPIN(xb_ld(&bar[XB_TOPGEN]) == tg, bar);
            __builtin_amdgcn_fence(__ATOMIC_ACQUIRE, "agent");
            xb_add(&bar[XB_XGEN(b.x)], 1u);
            asm volatile("s_waitcnt vmcnt(0)" ::: "memory");
        } else {
            XB_SPIN(xb_ld(&bar[XB_XGEN(b.x)]) == gen, bar);
            __builtin_amdgcn_fence(__ATOMIC_ACQUIRE, "agent");
            asm volatile("s_waitcnt vmcnt(0)" ::: "memory");
        }
    }
    __syncthreads();
}

__device__ __forceinline__ float wave_sum(float v) {
#pragma unroll
    for (int o = 1; o < 64; o <<= 1) v += __shfl_xor(v, o);
    return v;
}
__device__ __forceinline__ void transpose_item(const GAS float* W, int K, int N, GAS bf16* WT, int k0, int n0, int rbase, LAS float* scr, int lane, const GAS float* gk = nullptr) {
#pragma unroll 8
    for (int i = 0; i < 32; ++i) { const int kk = 2 * i + (lane >> 5); float wv = W[(size_t)(k0 + kk) * N + n0 + (lane & 31)]; if (gk != nullptr) wv *= gk[k0 + kk]; scr[kk * 33 + (lane & 31)] = wv; }
    LDS_WAIT(); asm volatile("" ::: "memory");
    const int c = lane & 7;
#pragma unroll
    for (int j = 0; j < 4; ++j) { const int n = (lane >> 3) + 8 * j; const LAS float* s = scr + (8 * c) * 33 + n;
        u32x4 o; o.x = cvt_pk_bf16(s[0 * 33], s[1 * 33]); o.y = cvt_pk_bf16(s[2 * 33], s[3 * 33]); o.z = cvt_pk_bf16(s[4 * 33], s[5 * 33]); o.w = cvt_pk_bf16(s[6 * 33], s[7 * 33]);
        *(GAS u32x4*)(WT + (size_t)(rbase + n) * K + k0 + 8 * c) = o; }
    LDS_WAIT(); asm volatile("" ::: "memory");
}
__device__ __forceinline__ void transpose_item8(const GAS float* W, int K, int N, GAS unsigned char* WT8, int k0, int n0, int rbase, float scale, LAS float* scr, int lane) {
#pragma unroll 8
    for (int i = 0; i < 32; ++i) { const int kk = 2 * i + (lane >> 5); scr[kk * 33 + (lane & 31)] = W[(size_t)(k0 + kk) * N + n0 + (lane & 31)]; }
    LDS_WAIT(); asm volatile("" ::: "memory");
    const int c = lane & 7;
#pragma unroll
    for (int j = 0; j < 4; ++j) { const int n = (lane >> 3) + 8 * j; const LAS float* sp = scr + (8 * c) * 33 + n;
        u32x2 o; o.x = pk4_fp8(sp[0 * 33] * scale, sp[1 * 33] * scale, sp[2 * 33] * scale, sp[3 * 33] * scale); o.y = pk4_fp8(sp[4 * 33] * scale, sp[5 * 33] * scale, sp[6 * 33] * scale, sp[7 * 33] * scale);
        *(GAS u32x2*)(WT8 + (size_t)(rbase + n) * K + k0 + 8 * c) = o; }
    LDS_WAIT(); asm volatile("" ::: "memory");
}
__device__ __forceinline__ void tr_gu8(const GAS float* Wg, const GAS float* Wu, int K, int N, GAS unsigned char* WT8, int it, LAS float* scr, int lane) {
    const int nblk = N / 32, per = (K / 64) * nblk; const bool up = it >= per; if (up) it -= per;
    const int kb = it / nblk, nb = it - kb * nblk, f0 = 32 * nb;
    transpose_item8(up ? Wu : Wg, K, N, WT8, 64 * kb, f0, 256 * (f0 >> 7) + (up ? 128 : 0) + (f0 & 127), 64.0f, scr, lane);
}
__device__ __forceinline__ void tr_plain(const GAS float* W, int K, int N, GAS bf16* WT, int it, LAS float* scr, int lane, const GAS float* gk = nullptr) {
    const int nblk = N / 32, kb = it / nblk, nb = it - kb * nblk; transpose_item(W, K, N, WT, 64 * kb, 32 * nb, 32 * nb, scr, lane, gk);
}
__device__ __forceinline__ void tr_gu(const GAS float* Wg, const GAS float* Wu, int K, int N, GAS bf16* WT, int it, LAS float* scr, int lane, const GAS float* gk = nullptr) {
    const int nblk = N / 32, per = (K / 64) * nblk; const bool up = it >= per; if (up) it -= per;
    const int kb = it / nblk, nb = it - kb * nblk, f0 = 32 * nb;
    transpose_item(up ? Wu : Wg, K, N, WT, 64 * kb, f0, 256 * (f0 >> 7) + (up ? 128 : 0) + (f0 & 127), scr, lane, gk);
}
__device__ __forceinline__ void rms_row(const GAS float* xrow, const GAS float* g, GAS bf16* orow, int lane, f32x4 (&v)[4]) {
    const GAS f32x4* xr = (const GAS f32x4*)xrow + lane; const GAS f32x4* gr = (const GAS f32x4*)g + lane;
    float s = 0.f;
#pragma unroll
    for (int j = 0; j < 4; ++j) { v[j] = xr[64 * j]; s += (v[j].x * v[j].x + v[j].y * v[j].y) + (v[j].z * v[j].z + v[j].w * v[j].w); }
    const float r = 1.0f / sqrtf(wave_sum(s) * (1.f / D) + EPS);
    GAS u32x2* o8 = (GAS u32x2*)orow + lane;
#pragma unroll
    for (int j = 0; j < 4; ++j) { v[j] = v[j] * r * gr[64 * j]; u32x2 w; w.x = cvt_pk_bf16(v[j].x, v[j].y); w.y = cvt_pk_bf16(v[j].z, v[j].w); o8[64 * j] = w; }
}
__device__ __forceinline__ void xb_row(const GAS float* xrow, GAS bf16* orow, GAS float* rout, int lane) {
    const GAS f32x4* xr = (const GAS f32x4*)xrow + lane; f32x4 v[4]; float s = 0.f;
#pragma unroll
    for (int j = 0; j < 4; ++j) { v[j] = xr[64 * j]; s += (v[j].x * v[j].x + v[j].y * v[j].y) + (v[j].z * v[j].z + v[j].w * v[j].w); }
    GAS u32x2* o8 = (GAS u32x2*)orow + lane;
#pragma unroll
    for (int j = 0; j < 4; ++j) { u32x2 w; w.x = cvt_pk_bf16(v[j].x, v[j].y); w.y = cvt_pk_bf16(v[j].z, v[j].w); o8[64 * j] = w; }
    const float r = 1.0f / sqrtf(wave_sum(s) * (1.f / D) + EPS);
    if (lane == 0) *rout = r;
}
__device__ __forceinline__ int rmsb_col(int j, int lane) { return 512 * (j >> 1) + 8 * lane + 4 * (j & 1); }
__device__ __forceinline__ void rms_row_b(const GAS bf16* hrow, const GAS float* g, GAS bf16* orow, int lane, f32x4 (&v)[4]) {
    float s = 0.f;
#pragma unroll
    for (int jh = 0; jh < 2; ++jh) { const u32x4 x = *(const GAS u32x4*)(hrow + 512 * jh + 8 * lane);
        v[2 * jh] = (f32x4){bf_lo(x.x), bf_hi(x.x), bf_lo(x.y), bf_hi(x.y)}; v[2 * jh + 1] = (f32x4){bf_lo(x.z), bf_hi(x.z), bf_lo(x.w), bf_hi(x.w)}; }
#pragma unroll
    for (int j = 0; j < 4; ++j) s += (v[j].x * v[j].x + v[j].y * v[j].y) + (v[j].z * v[j].z + v[j].w * v[j].w);
    const float r = 1.0f / sqrtf(wave_sum(s) * (1.f / D) + EPS);
#pragma unroll
    for (int jh = 0; jh < 2; ++jh) { const GAS float* gp = g + 512 * jh + 8 * lane; v[2 * jh] = v[2 * jh] * r * *(const GAS f32x4*)gp; v[2 * jh + 1] = v[2 * jh + 1] * r * *(const GAS f32x4*)(gp + 4);
        u32x4 w; w.x = cvt_pk_bf16(v[2 * jh].x, v[2 * jh].y); w.y = cvt_pk_bf16(v[2 * jh].z, v[2 * jh].w); w.z = cvt_pk_bf16(v[2 * jh + 1].x, v[2 * jh + 1].y); w.w = cvt_pk_bf16(v[2 * jh + 1].z, v[2 * jh + 1].w);
        *(GAS u32x4*)(orow + 512 * jh + 8 * lane) = w; }
}

__device__ __forceinline__ void rms_row_b8(const GAS bf16* hrow, const GAS float* g, GAS unsigned char* o8, int lane, f32x4 (&v)[4]) {
    float s = 0.f;
#pragma unroll
    for (int jh = 0; jh < 2; ++jh) { const u32x4 x = *(const GAS u32x4*)(hrow + 512 * jh + 8 * lane);
        v[2 * jh] = (f32x4){bf_lo(x.x), bf_hi(x.x), bf_lo(x.y), bf_hi(x.y)}; v[2 * jh + 1] = (f32x4){bf_lo(x.z), bf_hi(x.z), bf_lo(x.w), bf_hi(x.w)}; }
#pragma unroll
    for (int j = 0; j < 4; ++j) s += (v[j].x * v[j].x + v[j].y * v[j].y) + (v[j].z * v[j].z + v[j].w * v[j].w);
    const float r = 1.0f / sqrtf(wave_sum(s) * (1.f / D) + EPS);
#pragma unroll
    for (int jh = 0; jh < 2; ++jh) { const GAS float* gp = g + 512 * jh + 8 * lane; v[2 * jh] = v[2 * jh] * r * *(const GAS f32x4*)gp; v[2 * jh + 1] = v[2 * jh + 1] * r * *(const GAS f32x4*)(gp + 4);
        u32x2 w; w.x = pk4_fp8(v[2 * jh].x, v[2 * jh].y, v[2 * jh].z, v[2 * jh].w); w.y = pk4_fp8(v[2 * jh + 1].x, v[2 * jh + 1].y, v[2 * jh + 1].z, v[2 * jh + 1].w);
        *(GAS u32x2*)(o8 + 512 * jh + 8 * lane) = w; }
}

constexpr int SW_QL = 0, SW_SPITCH = 528, SW_SL = 128 * 528, SW_VPITCH = 272, SW_VL = SW_SL + 64 * SW_SPITCH, SW_VB = 64 * SW_VPITCH;
static_assert(SW_VL + 2 * SW_VB <= 139264, "sweep LDS");
template <bool OUT> __device__ __forceinline__ void sweep_role(LAS unsigned char* lds, const GAS bf16* Qg, const GAS bf16* KTFg, const GAS bf16* KTBg, const GAS bf16* VTg, const GAS bf16* PCg, const GAS bf16* PDg, const GAS bf16* ZEROg, GAS bf16* Yg, GAS f32x2* statp, const float l2f, const float l2b, int b, int h, int es, const int wave_s) {
    const int tid = tid_of(wave_s);
    const int w = __builtin_amdgcn_readfirstlane(tid >> 6), lane = tid & 63, r32 = lane & 31, hh = lane >> 5;
    const int rb = w & 3;
    const int vrow = tid >> 4, vpc = tid & 15;
    const int qrow = tid >> 5, qpc = tid & 31;
    const GAS bf16* qp = Qg + (size_t)(b * SEQ + qrow) * QKW + h * DK + 8 * qpc;
    const GAS bf16* vtp = VTg + (size_t)(h * DV + 64 * es + vrow) * T + 8 * vpc; const int vrot = b * SEQ + ((vrow & 15) << 11);
    const int il = 32 * rb + r32;
    const GAS bf16* pcp = PCg + (((size_t)((b * NH + h) * NCH) * 4 + rb) * 8) * 512 + lane * 8;
    const GAS bf16* pdp = PDg + (((size_t)((b * NH + h) * NCH) * 4 + rb) * 2) * 512 + lane * 8;
    GAS bf16* yp = Yg + ((size_t)(((b * SEQ) >> 5) + rb) * NH + h) * 8 * 2048 + (size_t)es * 2048 + lane * 8;
    GAS f32x2* stp = statp + ((size_t)(b * SEQ + il) * NH + h) * 8 + es;
    const size_t kto = ((size_t)((b * NH + h) * NCH) * 8 + 2 * rb) * 8 * 512 + lane * 8;
#define SW_LDP(dst, s_, d_, nn_) do { const int jb_ = (s_) >> 1; const bool use_ = (d_) ? (jb_ >= rb) : (jb_ <= rb); const bool dg_ = (d_) && (jb_ == rb); \
        const GAS bf16* src_ = dg_ ? (pdp + (size_t)(nn_) * 4096 + 512 * ((s_) & 1)) : (pcp + (size_t)(nn_) * (CH * CH) + 512 * (s_)); \
        dst = *(const GAS bf16x8*)(use_ ? src_ : ZEROg); } while (0)
#define SW_SCHED __builtin_amdgcn_sched_barrier(0)
#define SW_MFMA(a, b, c) c = __builtin_amdgcn_mfma_f32_32x32x16_bf16(a, b, c, 0, 0, 0)
    bf16x8 pa[8];
    bf16x8 ka[2][8];
    u32x4 vv[2], qv[4];
    f32x16 Sacc[2][2];
    if constexpr (OUT) {
#pragma unroll
        for (int s = 0; s < 8; ++s) SW_LDP(pa[s], s, 0, 0);
    } else {
#pragma unroll
        for (int db = 0; db < 2; ++db)
#pragma unroll
            for (int s = 0; s < 8; ++s) ka[db][s] = *(const GAS bf16x8*)(KTFg + kto + db * 4096 + s * 512);
#pragma unroll
        for (int db = 0; db < 2; ++db)
#pragma unroll
            for (int et = 0; et < 2; ++et)
#pragma unroll
                for (int t = 0; t < 16; ++t) Sacc[db][et][t] = 0.f;
    }
#pragma unroll
    for (int it = 0; it < 2; ++it) vv[it] = *(const GAS u32x4*)(vtp + (size_t)(32 * it) * T + (vrot & (T - 1)));
#pragma unroll
    for (int it = 0; it < 2; ++it) *(LAS u32x4*)(lds + SW_VL + (vrow + 32 * it) * SW_VPITCH + vpc * 16) = vv[it];
#pragma unroll
    for (int hf = 0; hf < 2; ++hf) {
#pragma unroll
        for (int it = 0; it < 4; ++it) qv[it] = *(const GAS u32x4*)(qp + (size_t)(16 * (4 * hf + it)) * QKW);
#pragma unroll
        for (int it = 0; it < 4; ++it) { const int row = qrow + 16 * (4 * hf + it); *(LAS u32x4*)(lds + SW_QL + row * SW_SPITCH + qpc * 16) = qv[it]; }
    }
    const int sl_rd = SW_SL + r32 * SW_SPITCH + 16 * hh;
    const int q_rd = SW_QL + il * SW_SPITCH + 16 * hh;
#pragma unroll 1
    for (int p = 0; p < 2 * NCH; ++p) {
        const int dir = p >> 5, st = p & 31, n = dir ? NCH - 1 - st : st;
        const int pn = p + 1 < 2 * NCH ? p + 1 : p, dirn = pn >> 5, stn = pn & 31, nn = dirn ? NCH - 1 - stn : stn;
        const int cur = p & 1;
        const float l2 = dir ? l2b : l2f;
        const int v_rd = SW_VL + cur * SW_VB + r32 * SW_VPITCH + 16 * hh;
        if constexpr (!OUT) {
#pragma unroll
            for (int db = 0; db < 2; ++db)
#pragma unroll
                for (int et = 0; et < 2; ++et)
#pragma unroll
                    for (int g = 0; g < 4; ++g) { u32x2 pk; pk.x = cvt_pk_bf16(Sacc[db][et][4 * g], Sacc[db][et][4 * g + 1]); pk.y = cvt_pk_bf16(Sacc[db][et][4 * g + 2], Sacc[db][et][4 * g + 3]);
                        if (st == 0) { pk.x = 0u; pk.y = 0u; }
                        *(LAS u32x2*)(lds + SW_SL + (32 * et + r32) * SW_SPITCH + (64 * rb + 32 * db + 8 * g + 4 * hh) * 2) = pk; }
        }
#pragma unroll
        for (int it = 0; it < 2; ++it) vv[it] = *(const GAS u32x4*)(vtp + (size_t)(32 * it) * T + ((nn * CH + vrot) & (T - 1)));
#pragma unroll
        for (int it = 0; it < 4; ++it) qv[it] = *(const GAS u32x4*)(qp + (size_t)(nn * CH + 16 * it) * QKW);
        __syncthreads();
        f32x16 O[2];
        u32x4 yf[4];
        GAS bf16* ypn = yp + (size_t)(n * 4) * (NH * 8 * 2048);
        if constexpr (OUT) {
#pragma unroll
            for (int et = 0; et < 2; ++et)
#pragma unroll
                for (int t = 0; t < 16; ++t) O[et][t] = 0.f;
            bf16x8 qx[2], s0x[2], s1x[2], qy[2], s0y[2], s1y[2];
#define SW_LDC(dq, d0, d1, g2) do { _Pragma("unroll") for (int k = 0; k < 2; ++k) { const int ks = 2 * (g2) + k; dq[k] = *(const LAS bf16x8*)(lds + q_rd + 32 * ks); \
                d0[k] = *(const LAS bf16x8*)(lds + sl_rd + 32 * ks); d1[k] = *(const LAS bf16x8*)(lds + sl_rd + 32 * SW_SPITCH + 32 * ks); } } while (0)
#define SW_MMC(dq, d0, d1) do { SW_MFMA(d0[0], dq[0], O[0]); SW_MFMA(d1[0], dq[0], O[1]); SW_MFMA(d0[1], dq[1], O[0]); SW_MFMA(d1[1], dq[1], O[1]); } while (0)
            SW_LDC(qx, s0x, s1x, 0); SW_LDC(qy, s0y, s1y, 1); SW_SCHED;
            SW_MMC(qx, s0x, s1x); SW_SCHED; SW_LDC(qx, s0x, s1x, 2); SW_SCHED;
            SW_MMC(qy, s0y, s1y); SW_SCHED; SW_LDC(qy, s0y, s1y, 3); SW_SCHED;
            SW_MMC(qx, s0x, s1x); SW_SCHED; SW_LDC(qx, s0x, s1x, 4); SW_SCHED;
            SW_MMC(qy, s0y, s1y); SW_SCHED; SW_LDC(qy, s0y, s1y, 5); SW_SCHED;
            SW_MMC(qx, s0x, s1x); SW_SCHED; SW_LDC(qx, s0x, s1x, 6); SW_SCHED;
            SW_MMC(qy, s0y, s1y); SW_SCHED; SW_LDC(qy, s0y, s1y, 7); SW_SCHED;
            SW_MMC(qx, s0x, s1x); SW_SCHED;
            SW_MMC(qy, s0y, s1y); SW_SCHED;
#undef SW_LDC
#undef SW_MMC
        } else {
            const float gC = st == 0 ? 0.f : fast_exp2((float)CH * l2);
#pragma unroll
            for (int db = 0; db < 2; ++db)
#pragma unroll
                for (int et = 0; et < 2; ++et)
#pragma unroll
                    for (int t = 0; t < 16; ++t) Sacc[db][et][t] *= gC;
            bf16x8 v0x[2], v1x[2], v0y[2], v1y[2];
#define SW_LDU(d0, d1, g2) do { _Pragma("unroll") for (int k = 0; k < 2; ++k) { const int s_ = 2 * (g2) + k; d0[k] = *(const LAS bf16x8*)(lds + v_rd + 32 * s_); d1[k] = *(const LAS bf16x8*)(lds + v_rd + 32 * SW_VPITCH + 32 * s_); } } while (0)
#define SW_MMU(d0, d1, g2) do { _Pragma("unroll") for (int k = 0; k < 2; ++k) { const int s_ = 2 * (g2) + k; SW_MFMA(ka[0][s_], d0[k], Sacc[0][0]); SW_MFMA(ka[0][s_], d1[k], Sacc[0][1]); SW_MFMA(ka[1][s_], d0[k], Sacc[1][0]); SW_MFMA(ka[1][s_], d1[k], Sacc[1][1]); } } while (0)
            SW_LDU(v0x, v1x, 0); SW_LDU(v0y, v1y, 1); SW_SCHED;
            SW_MMU(v0x, v1x, 0); SW_SCHED; SW_LDU(v0x, v1x, 2); SW_SCHED;
            SW_MMU(v0y, v1y, 1); SW_SCHED; SW_LDU(v0y, v1y, 3); SW_SCHED;
            SW_MMU(v0x, v1x, 2); SW_SCHED;
            SW_MMU(v0y, v1y, 3); SW_SCHED;
#undef SW_LDU
#undef SW_MMU
        }
        __syncthreads();
#pragma unroll
        for (int it = 0; it < 4; ++it) { const int row = qrow + 16 * it; *(LAS u32x4*)(lds + SW_QL + row * SW_SPITCH + qpc * 16) = qv[it]; }
#pragma unroll
        for (int it = 0; it < 4; ++it) qv[it] = *(const GAS u32x4*)(qp + (size_t)(nn * CH + 16 * (4 + it)) * QKW);
        if constexpr (OUT) {
            if (dir) {
#pragma unroll
                for (int q = 0; q < 4; ++q) yf[q] = *(const GAS u32x4*)(ypn + q * 512);
            }
            const float xi = fast_exp2((float)(dir == 0 ? (il + 1) : (CH - il)) * l2);
#pragma unroll
            for (int et = 0; et < 2; ++et)
#pragma unroll
                for (int t = 0; t < 16; ++t) O[et][t] *= xi;
            bf16x8 v0x[2], v1x[2], v0y[2], v1y[2];
#define SW_LDV(d0, d1, g2) do { _Pragma("unroll") for (int k = 0; k < 2; ++k) { const int s_ = 2 * (g2) + k; d0[k] = *(const LAS bf16x8*)(lds + v_rd + 32 * s_); d1[k] = *(const LAS bf16x8*)(lds + v_rd + 32 * SW_VPITCH + 32 * s_); } } while (0)
#define SW_MMV(d0, d1, g2) do { _Pragma("unroll") for (int k = 0; k < 2; ++k) { const int s_ = 2 * (g2) + k; SW_MFMA(d0[k], pa[s_], O[0]); SW_MFMA(d1[k], pa[s_], O[1]); } } while (0)
            SW_LDV(v0x, v1x, 0); SW_LDV(v0y, v1y, 1); SW_SCHED;
            SW_MMV(v0x, v1x, 0); SW_SCHED; SW_LDV(v0x, v1x, 2); SW_SCHED;
            SW_MMV(v0y, v1y, 1); SW_SCHED; SW_LDV(v0y, v1y, 3); SW_SCHED;
            SW_MMV(v0x, v1x, 2); SW_SCHED;
            SW_MMV(v0y, v1y, 3); SW_SCHED;
#undef SW_LDV
#undef SW_MMV
#pragma unroll
            for (int s = 0; s < 8; ++s) SW_LDP(pa[s], s, dirn, nn);
        } else {
            const GAS bf16* ktn = (dirn ? KTBg : KTFg) + kto + (size_t)nn * 32768;
#pragma unroll
            for (int db = 0; db < 2; ++db)
#pragma unroll
                for (int s = 0; s < 8; ++s) ka[db][s] = *(const GAS bf16x8*)(ktn + db * 4096 + s * 512);
        }
#pragma unroll
        for (int it = 0; it < 2; ++it) *(LAS u32x4*)(lds + SW_VL + (cur ^ 1) * SW_VB + (vrow + 32 * it) * SW_VPITCH + vpc * 16) = vv[it];
#pragma unroll
        for (int it = 0; it < 4; ++it) { const int row = qrow + 16 * (4 + it); *(LAS u32x4*)(lds + SW_QL + row * SW_SPITCH + qpc * 16) = qv[it]; }
        if constexpr (OUT) {
            float s1 = 0.f, s2 = 0.f;
#pragma unroll
            for (int et = 0; et < 2; ++et)
#pragma unroll
                for (int kp = 0; kp < 2; ++kp) {
                    float ya[4], yb[4];
#pragma unroll
                    for (int q = 0; q < 4; ++q) { ya[q] = O[et][8 * kp + q]; yb[q] = O[et][8 * kp + 4 + q]; }
                    if (dir) {
                        u32x4 f = yf[et * 2 + kp];
                        { const auto r0 = __builtin_amdgcn_permlane32_swap(f.x, f.z, false, false); f.x = r0[0]; f.z = r0[1]; const auto r1 = __builtin_amdgcn_permlane32_swap(f.y, f.w, false, false); f.y = r1[0]; f.w = r1[1]; }
                        ya[0] += bf_lo(f.x); ya[1] += bf_hi(f.x); ya[2] += bf_lo(f.y); ya[3] += bf_hi(f.y); yb[0] += bf_lo(f.z); yb[1] += bf_hi(f.z); yb[2] += bf_lo(f.w); yb[3] += bf_hi(f.w);
#pragma unroll
                        for (int q = 0; q < 4; ++q) { s1 += ya[q] + yb[q]; s2 += ya[q] * ya[q] + yb[q] * yb[q]; }
                    }
                    u32x4 o; o.x = cvt_pk_bf16(ya[0], ya[1]); o.y = cvt_pk_bf16(ya[2], ya[3]); o.z = cvt_pk_bf16(yb[0], yb[1]); o.w = cvt_pk_bf16(yb[2], yb[3]);
                    { const auto r0 = __builtin_amdgcn_permlane32_swap(o.x, o.z, false, false); o.x = r0[0]; o.z = r0[1]; const auto r1 = __builtin_amdgcn_permlane32_swap(o.y, o.w, false, false); o.y = r1[0]; o.w = r1[1]; }
                    *(GAS u32x4*)(ypn + (et * 2 + kp) * 512) = o;
                }
            if (dir) { s1 += __shfl_xor(s1, 32); s2 += __shfl_xor(s2, 32);
                if (hh == 0) stp[(size_t)(n * CH) * (NH * 8)] = (f32x2){s1, s2}; }
        }
    }
#undef SW_LDP
#undef SW_SCHED
#undef SW_MFMA
    VM_WAIT();
    __syncthreads();
}

__device__ __forceinline__ void sweep_unit(LAS unsigned char* lds, const GAS bf16* Qg, const GAS bf16* KTFg, const GAS bf16* KTBg, const GAS bf16* VTg, const GAS bf16* PCg, const GAS bf16* PDg, const GAS bf16* ZEROg, GAS bf16* Yg, GAS f32x2* statp, const float l2f, const float l2b, int b, int h, int es, const int wave_s) {
    int ws_ = wave_s; asm volatile("" : "+s"(ws_));
    if (ws_ < 4) sweep_role<true>(lds, Qg, KTFg, KTBg, VTg, PCg, PDg, ZEROg, Yg, statp, l2f, l2b, b, h, es, wave_s);
    else sweep_role<false>(lds, Qg, KTFg, KTBg, VTg, PCg, PDg, ZEROg, Yg, statp, l2f, l2b, b, h, es, wave_s);
}

struct Args { const float* in[16]; float* out; unsigned char* ws; };
constexpr int NWAVES = 8;
#ifndef PHMASK
#define PHMASK 0xFFFFFFFFu
#endif
#define PH(k) (((PHMASK) >> (k)) & 1u)
__global__ void __launch_bounds__(NWAVES * 64, 2) fwd_kernel(Args args) {
    extern __shared__ __attribute__((aligned(16))) unsigned char lds_raw[];
    LAS unsigned char* lds = (LAS unsigned char*)lds_raw;
    LAS float* l2g = (LAS float*)(lds + LDSCTL_OFF + 64);
    const int wave_k = __builtin_amdgcn_readfirstlane((int)threadIdx.x >> 6);
#define PHASE_VARS \
    const int tid = tid_of(wave_k); const int lane = tid & 63; int wave = wave_k; asm volatile("" : "+s"(wave)); \
    const __attribute__((address_space(4))) Args* ka = (const __attribute__((address_space(4))) Args*)__builtin_amdgcn_kernarg_segment_ptr(); asm volatile("" : "+s"(ka)); \
    const int G = gridDim.x, bx = blockIdx.x; const int vcu = (G % 8 == 0) ? (bx % 8) * (G / 8) + bx / 8 : bx; const int gw = vcu * NWAVES + wave, NGW = G * NWAVES; \
    GAS unsigned char* ws = (GAS unsigned char*)ka->ws; asm volatile("" : "+s"(ws)); GAS float* hres = (GAS float*)ka->out; (void)lane; (void)gw; (void)NGW; (void)vcu; (void)hres; \
    const GAS float* x = (const GAS float*)ka->in[0]; const GAS float* mix_norm = (const GAS float*)ka->in[1]; const GAS float* ffn_norm = (const GAS float*)ka->in[2]; const GAS float* ret_w_in = (const GAS float*)ka->in[3]; const GAS float* ret_decay = (const GAS float*)ka->in[4]; \
    const GAS float* gn_gain = (const GAS float*)ka->in[5]; const GAS float* ret_w_out = (const GAS float*)ka->in[6]; const GAS float* d_wg = (const GAS float*)ka->in[7]; const GAS float* d_wu = (const GAS float*)ka->in[8]; const GAS float* d_wd = (const GAS float*)ka->in[9]; \
    const GAS float* fnet_w = (const GAS float*)ka->in[10]; const GAS float* moe_router = (const GAS float*)ka->in[11]; const GAS float* m_wg = (const GAS float*)ka->in[12]; const GAS float* m_wu = (const GAS float*)ka->in[13]; const GAS float* m_wd = (const GAS float*)ka->in[14]; const GAS float* final_norm = (const GAS float*)ka->in[15]; \
    (void)x; (void)mix_norm; (void)ffn_norm; (void)ret_w_in; (void)ret_decay; (void)gn_gain; (void)ret_w_out; (void)d_wg; (void)d_wu; (void)d_wd; (void)fnet_w; (void)moe_router; (void)m_wg; (void)m_wu; (void)m_wd; (void)final_norm; \
    GAS f32x2* rot = (GAS f32x2*)(ws + WS_ROT); GAS f32x2* rotT = (GAS f32x2*)(ws + WS_ROTT); GAS bf16* WC = (GAS bf16*)(ws + WS_STATS); GAS float* R0 = (GAS float*)(ws + WS_R0); (void)R0; GAS f32x2* TWT = (GAS f32x2*)(ws + WS_TW); (void)TWT; GAS float* SSQ1 = (GAS float*)(ws + WS_SSQ1); GAS float* SSQ2 = (GAS float*)(ws + WS_SSQ2); (void)SSQ1; (void)SSQ2; \
    GAS int* toke = (GAS int*)(ws + WS_TOKE); GAS float* tokw = (GAS float*)(ws + WS_TOKW); GAS int* bcnt = (GAS int*)(ws + WS_BCNT); GAS int* pcnt = (GAS int*)(ws + WS_PCNT); (void)pcnt; GAS int* rowtok = (GAS int*)(ws + WS_ROWTOK); GAS float* rowgate = (GAS float*)(ws + WS_ROWGATE); \
    GAS f32x2* statp = (GAS f32x2*)(ws + WS_STATP); \
    GAS bf16* WIN = (GAS bf16*)(ws + WS_WIN); GAS bf16* WO = (GAS bf16*)(ws + WS_WO); GAS bf16* WGU = (GAS bf16*)(ws + WS_WGU); GAS bf16* WD = (GAS bf16*)(ws + WS_WD); GAS bf16* WF = (GAS bf16*)(ws + WS_WF); \
    GAS bf16* HN = (GAS bf16*)(ws + WS_HN); GAS bf16* Qb = (GAS bf16*)(ws + WS_Q); GAS bf16* Kb = (GAS bf16*)(ws + WS_K); GAS bf16* KT = (GAS bf16*)(ws + WS_KT); GAS bf16* VT = (GAS bf16*)(ws + WS_VT); GAS bf16* PC = (GAS bf16*)(ws + WS_PC); \
    GAS bf16* HB = (GAS bf16*)(ws + WS_HN); GAS bf16* HNB = (GAS bf16*)ka->out; (void)HB; (void)HNB; \
    GAS unsigned char* HN8 = (GAS unsigned char*)ka->out + 64 * MiB; GAS unsigned char* WMGU8 = (GAS unsigned char*)(ws + WS_WMGU); (void)HN8; (void)WMGU8;     \
    GAS bf16* Yb = (GAS bf16*)ka->out; GAS bf16* YG = (GAS bf16*)(ws + WS_YG); GAS bf16* ACTD = (GAS bf16*)(ws + WS_ACTD); GAS bf16* Z2 = (GAS bf16*)(ws + WS_Z2); GAS bf16* WSEQ = (GAS bf16*)(ws + WS_WSEQ); \
    GAS bf16* ACTM = (GAS bf16*)(ws + WS_ACTM); GAS bf16* WMGU = (GAS bf16*)(ws + WS_WMGU); GAS bf16* WMD = (GAS bf16*)(ws + WS_WMD); \
    (void)rot; (void)rotT; (void)WC; (void)toke; (void)tokw; (void)bcnt; (void)rowtok; (void)rowgate; (void)statp; (void)WIN; (void)WO; (void)WGU; (void)WD; (void)WF; (void)HN; (void)Qb; (void)Kb; (void)KT; (void)VT; (void)PC; \
    (void)Yb; (void)YG; (void)ACTD; (void)Z2; (void)WSEQ; (void)ACTM; (void)WMGU; (void)WMD;
#define GRID_BAR() do { const __attribute__((address_space(4))) Args* kb = (const __attribute__((address_space(4))) Args*)__builtin_amdgcn_kernarg_segment_ptr(); asm volatile("" : "+s"(kb)); GAS unsigned char* wsb = (GAS unsigned char*)kb->ws; XcdBarrier bar_; bar_.bar = (unsigned*)(wsb + WS_CTL) + CW_BAR; bar_.x = xb_xcc_id(); \
    bar_.st = (volatile LAS unsigned*)(lds + MISC_OFF) + 8; xcd_barrier(bar_, tid_of(wave_k) == 0); } while (0)

    {
        PHASE_VARS
        for (int u = tid; u < (LDS_BYTES - LDSCTL_OFF) / 4; u += NWAVES * 64) ((LAS unsigned*)(lds + LDSCTL_OFF))[u] = 0u;
        __syncthreads();
        if (tid < 8) { const float xl = ret_decay[tid]; const float ls = fminf(xl, 0.f) - log1pf(expf(-fabsf(xl))); l2g[tid] = ls * 1.44269504088896341f; }
        __syncthreads();
        (void)xcd_barrier_post((unsigned*)(ws + WS_CTL) + CW_BAR, (volatile LAS unsigned*)(lds + MISC_OFF) + 8, tid == 0);
    }

    if (PH(0)) {
        PHASE_VARS
        LAS float* scr = (LAS float*)(lds + wave * 16384);
        constexpr int I_IN = (D / 64) * (INW / 32), I_O = (VW / 64) * (D / 32), I_GU = 2 * (D / 64) * (FFD / 32), I_D = (FFD / 64) * (D / 32), I_F = (D / 64) * (D / 32);
        constexpr int NITEMS = I_IN + I_O + I_GU + I_D + I_F;
        for (int it = gw; it < NITEMS; it += NGW) {
            int r = it;
            if (r < I_IN) { tr_plain(ret_w_in, D, INW, WIN, r, scr, lane, mix_norm); continue; } r -= I_IN;
            if (r < I_O) { tr_plain(ret_w_out, VW, D, WO, r, scr, lane); continue; } r -= I_O;
            if (r < I_GU) { tr_gu(d_wg, d_wu, D, FFD, WGU, r, scr, lane, ffn_norm); continue; } r -= I_GU;
            if (r < I_D) { const int nblk = D / 32, kb = r / nblk, nb = r - kb * nblk; transpose_item8(d_wd, FFD, D, (GAS unsigned char*)WD, 64 * kb, 32 * nb, 32 * nb, 64.0f, scr, lane); continue; } r -= I_D;
            tr_plain(fnet_w, D, D, WF, r, scr, lane);
        }
        for (int e = (vcu * 512 + tid); e < SEQ * 128; e += G * 512) { const int s = e >> 7, i = e & 127;
            const float inv = powf(10000.0f, -(float)i / 128.0f); const float ang = (float)s * inv; float sn, cs; sincosf(ang, &sn, &cs);
            rot[e] = (f32x2){cs, sn}; }
        for (int e = (vcu * 512 + tid); e < 4 * 512 * 256; e += G * 512) { const int g = e >> 17, r = (e >> 8) & 511, c = e & 255, cp = (r >> 8) * 128 + (r & 127), mm = (cp * c) & 255;
            const float v = (((r >> 7) & 1) == 0 ? cospif((float)mm * (1.0f / 128.0f)) : -sinpif((float)mm * (1.0f / 128.0f))) * mix_norm[D + g * 256 + c]; WC[e] = (bf16)(cvt_pk_bf16(v, 0.f) & 0xffffu); }
        for (int e = vcu * 512 + tid; e < 512 * 8; e += G * 512) { const float ang = (float)(((e >> 3) * (e & 7)) & 4095) * (1.0f / 2048.0f); TWT[e] = (f32x2){cospif(ang), sinpif(ang)}; }
        for (int e = vcu * 512 + tid; e < 512 * 1024; e += G * 512) { const int ka = e >> 10, c = e & 1023, a = c & 511, mm = (a * ka) & 511;
            const float v = (c < 512 ? cospif((float)mm * (1.0f / 256.0f)) : sinpif((float)mm * (1.0f / 256.0f))) * (1.0f / 1024.0f); WSEQ[e] = (bf16)(cvt_pk_bf16(v, 0.f) & 0xffffu); }
        for (int m = gw; m < T; m += NGW) xb_row(x + (size_t)m * D, HN + (size_t)m * D, R0 + m, lane);
    }
    GRID_BAR();

    if (PH(1) && PH(19)) {
        PHASE_VARS
        SchedPlain S{(const GAS char*)HN, (const GAS char*)WIN, (size_t)256 * D * 2, (size_t)256 * D * 2, T / 256, 8, G, bx, 1};
        EpiRopeQK E{Qb, Kb, rot, R0, KT, l2g, lds + STG_OFF};
        pg8::gemm_phase<EpiRopeQK, SchedPlain, false>(lds, wave_k, D, D, D, S, E);
    }
    if (PH(1) && PH(21)) {
        PHASE_VARS
        SchedPlain S{(const GAS char*)(WIN + (size_t)2 * QKW * D), (const GAS char*)HN, (size_t)256 * D * 2, (size_t)256 * D * 2, 8, T / 256, G, bx};
        EpiBf16<true> E{VT, T, R0};
        pg8::gemm_phase<EpiBf16<true>, SchedPlain, false>(lds, wave_k, D, D, D, S, E);
    }
    GRID_BAR();

    if (PH(2)) {
        PHASE_VARS
        SchedPc S{(const GAS char*)Qb, (const GAS char*)Kb, G, bx};
        EpiPc E{PC, (GAS bf16*)(ws + WS_ROT), l2g};
        pg8::gemm_phase<EpiPc, SchedPc, false>(lds, wave_k, QKW, QKW, DK, S, E);
    }
    GRID_BAR();

    if (PH(3)) {
        PHASE_VARS
        for (int u = vcu; u < NB * NH * 8; u += G) { const int hh_ = (u >> 3) & 3; const float l2f = l2g[hh_], l2b = l2g[4 + hh_];
            sweep_unit(lds, Qb, KT, KT + (size_t)QKW * T, VT, PC, (const GAS bf16*)(ws + WS_ROT), (const GAS bf16*)(ws + WS_CTL + 512 * 1024), Yb, statp, l2f, l2b, u >> 5, hh_, u & 7, wave_k); }
    }
    GRID_BAR();

    if (PH(5)) {
        PHASE_VARS
        SchedPlain S{(const GAS char*)HN, (const GAS char*)(WIN + (size_t)(2 * QKW + VW) * D), (size_t)256 * D * 2, (size_t)256 * D * 2, T / 256, 8, G, bx};
        EpiGate E{Yb, YG, statp, gn_gain, (LAS f32x2*)(lds + 135168), R0};
        pg8::gemm_phase<EpiGate, SchedPlain, false>(lds, wave_k, D, D, D, S, E);
    }
    GRID_BAR();

    if (PH(6)) {
        PHASE_VARS
        SchedPlain S{(const GAS char*)YG, (const GAS char*)WO, (size_t)256 * VW * 2, (size_t)256 * VW * 2, T / 256, 4, G, bx};
        EpiRes<false> E{(const GAS void*)HB, HB, SSQ1};
        pg8::gemm_phase<EpiRes<false>, SchedPlain, false>(lds, wave_k, VW, VW, VW, S, E);
    }
    GRID_BAR();

    if (PH(7)) {
        PHASE_VARS
        LAS float* scr = (LAS float*)(lds + wave * 16384);
        constexpr int I_GU = 2 * (D / 64) * (FFE / 32), I_D = (FFE / 64) * (D / 32);
        for (int it = gw; it < NE * (I_GU + I_D); it += NGW) {
            const int e = it / (I_GU + I_D); int r = it - e * (I_GU + I_D);
            if (r < I_GU) tr_gu8(m_wg + (size_t)e * D * FFE, m_wu + (size_t)e * D * FFE, D, FFE, WMGU8 + (size_t)e * 2 * FFE * D, r, scr, lane);
            else { const int it2 = r - I_GU, nblk = D / 32, kb = it2 / nblk, nb = it2 - kb * nblk; transpose_item8(m_wd + (size_t)e * FFE * D, FFE, D, (GAS unsigned char*)WMD + (size_t)e * D * FFE, 64 * kb, 32 * nb, 32 * nb, 64.0f, scr, lane); }
        }
    }
    __syncthreads();

    if (PH(8)) {
        PHASE_VARS
        SchedPlain S{(const GAS char*)HB, (const GAS char*)WGU, (size_t)256 * D * 2, (size_t)256 * D * 2, T / 256, 2 * FFD / 256, G, bx};
        EpiSwiGLU<true, true> E{(GAS void*)ACTD, FFD, SSQ1, (LAS float*)(lds + 135168)};
        pg8::gemm_phase<EpiSwiGLU<true, true>, SchedPlain, false>(lds, wave_k, D, D, D, S, E);
    }
    GRID_BAR();
    if (PH(9)) {
        PHASE_VARS
        SchedPlainF8 S{{(const GAS char*)ACTD, (const GAS char*)WD, (size_t)256 * FFD, (size_t)256 * FFD, T / 256, 4, G, bx}};
        EpiRes<false> E{(const GAS void*)HB, HB, SSQ2};
        pg8::gemm_phase<EpiRes<false>, SchedPlainF8, false, true>(lds, wave_k, FFD, FFD, FFD, S, E);
    }
    GRID_BAR();

    if (PH(11)) {
        PHASE_VARS
        SchedFnA S{(const GAS char*)WC, (const GAS char*)HB, G, bx};
        EpiZ2 E{Z2, SSQ2, (LAS float*)(lds + 135168), TWT, lds + STG_OFF};
        pg8::gemm_phase<EpiZ2, SchedFnA, false>(lds, wave_k, 256, D, 256, S, E);
    }
    GRID_BAR();
    if (PH(12)) {
        PHASE_VARS
        SchedFnB S{(GAS const char*)WSEQ, (GAS const char*)Z2, G, bx};
        EpiYf E{HNB};
        pg8::gemm_phase<EpiYf, SchedFnB, false>(lds, wave_k, 1024, 1024, 1024, S, E);
    }
    GRID_BAR();
    if (PH(13)) {
        PHASE_VARS
        SchedPlain S{(const GAS char*)HNB, (const GAS char*)WF, (size_t)256 * D * 2, (size_t)256 * D * 2, T / 256, 4, G, bx};
        EpiRes<false> E{(const GAS void*)HB, HB, nullptr};
        pg8::gemm_phase<EpiRes<false>, SchedPlain, false>(lds, wave_k, D, D, D, S, E);
    }
    GRID_BAR();

    if (PH(14)) {
        PHASE_VARS
        LAS float* wrl = (LAS float*)lds;
        LAS int* le = (LAS int*)(lds + 32768);
        for (int i = tid; i < D * NE; i += NWAVES * 64) wrl[(i & 7) * D + (i >> 3)] = moe_router[i];
        for (int i = vcu * 512 + tid; i < 2 * MOE_ROWS; i += G * 512) rowtok[i] = -1;
        __syncthreads();
        for (int tb = vcu; tb < T / 128; tb += G) {
            for (int rr = 0; rr < 16; ++rr) { const int tl = wave * 16 + rr, m = tb * 128 + tl; f32x4 v[4];
                rms_row_b8(HB + (size_t)m * D, ffn_norm + D, HN8 + (size_t)m * D, lane, v);
                float lg[8];
#pragma unroll
                for (int e = 0; e < 8; ++e) lg[e] = 0.f;
#pragma unroll
                for (int j = 0; j < 4; ++j) { const int col0 = rmsb_col(j, lane);
#pragma unroll
                    for (int e = 0; e < 8; ++e) { const f32x4 wv = *(const LAS f32x4*)(wrl + e * D + col0); lg[e] += (v[j].x * wv.x + v[j].y * wv.y) + (v[j].z * wv.z + v[j].w * wv.w); } }
#pragma unroll
                for (int e = 0; e < 8; ++e) lg[e] = wave_sum(lg[e]);
                int e0 = 0; float b0 = lg[0];
#pragma unroll
                for (int e = 1; e < 8; ++e) if (lg[e] > b0) { b0 = lg[e]; e0 = e; }
                int e1 = -1; float b1 = -3.0e38f;
#pragma unroll
                for (int e = 0; e < 8; ++e) if (e != e0 && lg[e] > b1) { b1 = lg[e]; e1 = e; }
                const float w0 = 1.0f / (1.0f + __expf(b1 - b0));
                if (lane == 0) { toke[2 * m] = e0; toke[2 * m + 1] = e1; tokw[2 * m] = w0; tokw[2 * m + 1] = 1.0f - w0; le[tl] = e0; le[128 + tl] = e1; } }
            __syncthreads();
            if (tid < 16) { const int s = tid >> 3, e = tid & 7; int c = 0; for (int i = 0; i < 128; ++i) c += (le[s * 128 + i] == e) ? 1 : 0; bcnt[tb * 16 + tid] = c; }
            if (tid >= 64 && tid < 128) { const int pi = tid - 64; int c = 0; for (int i = 0; i < 128; ++i) c += (le[i] * 8 + le[128 + i] == pi) ? 1 : 0; pcnt[tb * 64 + pi] = c; }
            __syncthreads();
        }
    }
    GRID_BAR();

    LAS int* segoff = (LAS int*)(lds + 132096);
    LAS int* ntile = (LAS int*)(lds + 132096 + 64);
    LAS unsigned char* tile_e = (LAS unsigned char*)(lds + 132096 + 128);
    if (PH(15)) {
        PHASE_VARS
        LAS int* pfx = (LAS int*)lds;
        LAS int* cph = (LAS int*)(lds + 65792);
        LAS int* fq_ = (LAS int*)(lds + 65792 + 16384);
        LAS int* tot = fq_ + 64;
        LAS int* tpi = tot + 16;
        LAS int* tex = tpi + 128;
        for (int i = tid; i < 256 * 64; i += NWAVES * 64) pfx[i] = pcnt[i];
        __syncthreads();
        if (tid < 64) { int run = 0; for (int b2 = 0; b2 < 256; ++b2) { const int c = pfx[b2 * 64 + tid]; pfx[b2 * 64 + tid] = run; run += c; } pfx[256 * 64 + tid] = run; }
        __syncthreads();
        if (tid == 0) {
            int n0[8], d[8], r[8]; int rs = 0;
            for (int e = 0; e < 8; ++e) { int c = 0; for (int x2 = 0; x2 < 8; ++x2) c += pfx[256 * 64 + e * 8 + x2]; n0[e] = c; r[e] = c & 255; d[e] = -(c & 255); rs += c & 255; }
            int extra = rs >> 8;
            for (int k = 0; k < extra; ++k) { int be = -1, br = -1; for (int e = 0; e < 8; ++e) if (d[e] < 0 && d[e] == -r[e] && r[e] > br) { br = r[e]; be = e; } if (be >= 0) d[be] += 256; }
            for (int i = 0; i < 64; ++i) fq_[i] = 0;
            for (int a = 0; a < 8; ++a) for (int e = 0; e < 8; ++e) if (a != e && d[a] < 0 && d[e] > 0) { int fl = -d[a]; if (d[e] < fl) fl = d[e]; const int av = pfx[256 * 64 + a * 8 + e]; if (av < fl) fl = av; fq_[a * 8 + e] = fl; d[a] += fl; d[e] -= fl; }
        }
        __syncthreads();
        if (tid < 256) {
            int c0[8], c1[8];
#pragma unroll
            for (int e = 0; e < 8; ++e) { c0[e] = 0; c1[e] = 0; }
            for (int a = 0; a < 8; ++a) for (int e = 0; e < 8; ++e) { const int pi = a * 8 + e; const int cnt = pfx[(tid + 1) * 64 + pi] - pfx[tid * 64 + pi]; int fl = fq_[pi] - pfx[tid * 64 + pi]; fl = fl < 0 ? 0 : (fl > cnt ? cnt : fl);
#pragma unroll
                for (int q = 0; q < 8; ++q) { c0[q] += (q == a ? cnt - fl : 0) + (q == e ? fl : 0); c1[q] += (q == e ? cnt - fl : 0) + (q == a ? fl : 0); } }
#pragma unroll
            for (int e = 0; e < 8; ++e) { cph[tid * 16 + e] = c0[e]; cph[tid * 16 + 8 + e] = c1[e]; }
        }
        __syncthreads();
        if (tid < 16) { int run = 0; for (int b2 = 0; b2 < 256; ++b2) { const int c = cph[b2 * 16 + tid]; cph[b2 * 16 + tid] = run; run += c; } tot[tid] = run; }
        __syncthreads();
        if (tid < 2) { int off = 0, nt = 0; for (int e = 0; e < 8; ++e) { segoff[tid * 8 + e] = off; const int tl = (tot[tid * 8 + e] + 255) >> 8; for (int q = 0; q < tl; ++q) tile_e[tid * 160 + nt + q] = (unsigned char)e; nt += tl; off += tl * 256; } ntile[tid] = nt; }
        __syncthreads();
        for (int tb = vcu; tb < T / 128; tb += G) {
            int e0 = 0, e1 = 0, flip = 0;
            if (tid < 128) { const int m = tb * 128 + tid; e0 = toke[2 * m]; e1 = toke[2 * m + 1]; tpi[tid] = e0 * 8 + e1; }
            __syncthreads();
            if (tid < 128) { const int pi = e0 * 8 + e1; int rk = 0; for (int i = 0; i < tid; ++i) rk += (tpi[i] == pi) ? 1 : 0;
                flip = (pfx[tb * 64 + pi] + rk) < fq_[pi] ? 1 : 0; tex[tid] = flip ? e1 : e0; tex[128 + tid] = flip ? e0 : e1; }
            __syncthreads();
            if (tid < 128) { const int m = tb * 128 + tid;
#pragma unroll
                for (int ph = 0; ph < 2; ++ph) { const int e = tex[ph * 128 + tid]; int rk = 0; for (int i = 0; i < tid; ++i) rk += (tex[ph * 128 + i] == e) ? 1 : 0;
                    const int row = segoff[ph * 8 + e] + cph[tb * 16 + ph * 8 + e] + rk;
                    rowtok[ph * MOE_ROWS + row] = m; rowgate[ph * MOE_ROWS + row] = tokw[2 * m + (ph ^ flip)]; } }
            __syncthreads();
        }
    }
    GRID_BAR();

    if (PH(16))
#pragma unroll
    for (int s = 0; s < 2; ++s) {
        {
            PHASE_VARS
            SchedMoe S{(const GAS char*)HN8, (const GAS char*)WMGU8, rowtok + s * MOE_ROWS, tile_e + s * 160, 0, (size_t)2 * FFE * D, (size_t)256 * D, ntile[s], 2 * FFE / 256, G, bx, true, 0x7f7f7f7f};
            EpiSwiGLU<true> E{(GAS void*)ACTM, FFE};
            pg8::gemm_phase<EpiSwiGLU<true>, SchedMoe, true, true>(lds, wave_k, D, D, D, S, E);
        }
        GRID_BAR();
        {
            PHASE_VARS
            SchedMoe S{(const GAS char*)ACTM, (const GAS char*)WMD, rowtok + s * MOE_ROWS, tile_e + s * 160, (size_t)256 * FFE, (size_t)D * FFE, (size_t)256 * FFE, ntile[s], 4, G, bx, false, 0x7c7c7c7c};
            EpiMoeDown E{HB, rowtok + s * MOE_ROWS, rowgate + s * MOE_ROWS};
            pg8::gemm_phase<EpiMoeDown, SchedMoe, false, true>(lds, wave_k, FFE, FFE, FFE, S, E);
        }
        GRID_BAR();
    }

    if (PH(17)) {
        PHASE_VARS
        const bool bad = __hip_atomic_load((GAS unsigned*)(ws + WS_CTL) + CW_BAR + XB_TMO, RLX_AGENT) != 0u;
        for (int m = gw; m < T; m += NGW) {
            const GAS bf16* hrow = HB + (size_t)m * D; GAS float* orow = hres + (size_t)m * D;
            f32x4 v[4]; float s = 0.f;
#pragma unroll
            for (int jh = 0; jh < 2; ++jh) { const u32x4 xx = *(const GAS u32x4*)(hrow + 512 * jh + 8 * lane);
                v[2 * jh] = (f32x4){bf_lo(xx.x), bf_hi(xx.x), bf_lo(xx.y), bf_hi(xx.y)}; v[2 * jh + 1] = (f32x4){bf_lo(xx.z), bf_hi(xx.z), bf_lo(xx.w), bf_hi(xx.w)}; }
#pragma unroll
            for (int j = 0; j < 4; ++j) s += (v[j].x * v[j].x + v[j].y * v[j].y) + (v[j].z * v[j].z + v[j].w * v[j].w);
            const float r = bad ? __builtin_nanf("") : 1.0f / sqrtf(wave_sum(s) * (1.f / D) + EPS);
#pragma unroll
            for (int j = 0; j < 4; ++j) { const int col = rmsb_col(j, lane); *(GAS f32x4*)(orow + col) = v[j] * r * *(const GAS f32x4*)(final_norm + col); }
        }
    }
}

extern "C" void kernel_launch(void* const* d_in, const int* in_sizes, int n_in, void* d_out, int out_size, void* d_ws, size_t ws_size, hipStream_t stream) {
    static int grid = 0;
    if (grid == 0) {
        if (n_in != 16 || in_sizes[0] != T * D || out_size != T * D || ws_size < WS_END) { fprintf(stderr, "kernel_launch: unexpected shapes (n_in %d, in0 %d, out %d, ws %zu)\n", n_in, n_in > 0 ? in_sizes[0] : -1, out_size, ws_size); grid = -1; return; }
        int dev = 0, cus = 0, per_cu = 0;
        if (hipGetDevice(&dev) != hipSuccess || hipDeviceGetAttribute(&cus, hipDeviceAttributeMultiprocessorCount, dev) != hipSuccess) { grid = -1; return; }
        if (hipFuncSetAttribute((const void*)fwd_kernel, hipFuncAttributeMaxDynamicSharedMemorySize, LDS_BYTES) != hipSuccess) { fprintf(stderr, "kernel_launch: hipFuncSetAttribute failed\n"); grid = -1; return; }
        if (hipOccupancyMaxActiveBlocksPerMultiprocessor(&per_cu, (const void*)fwd_kernel, NWAVES * 64, LDS_BYTES) != hipSuccess || per_cu < 1) { fprintf(stderr, "kernel_launch: occupancy query says %d\n", per_cu); }
        (void)hipGetLastError();
        grid = cus;
    }
    if (grid < 0) return;
    if (hipMemsetAsync((char*)d_ws + WS_CTL, 0, CTL_ZERO_BYTES, stream) != hipSuccess) return;
    Args a{};
    for (int i = 0; i < 16; ++i) a.in[i] = (const float*)d_in[i];
    a.out = (float*)d_out; a.ws = (unsigned char*)d_ws;
    hipLaunchKernelGGL(fwd_kernel, dim3(grid), dim3(NWAVES * 64), LDS_BYTES, stream, a);
}
```

```cpp
#include <hip/hip_runtime.h>
#include <cstdio>
#include <cstdint>

#define LAS __attribute__((address_space(3)))
#define GAS __attribute__((address_space(1)))
typedef unsigned short bf16;
typedef short bf16x8 __attribute__((ext_vector_type(8)));
typedef float f32x2 __attribute__((ext_vector_type(2)));
typedef float f32x4 __attribute__((ext_vector_type(4)));
typedef float f32x16 __attribute__((ext_vector_type(16)));
typedef unsigned u32x2 __attribute__((ext_vector_type(2)));
typedef unsigned u32x4 __attribute__((ext_vector_type(4)));
typedef GAS unsigned gu32;

constexpr int D = 1024, NB = 8, SEQ = 4096, T = NB * SEQ;
constexpr int NH = 4, DK = 256, DV = 512, QKW = 1024, VW = 2048, INW = 6144, CH = 128, NCH = SEQ / CH;
constexpr int FFD = 2816, NE = 8, FFE = 3584;
constexpr int MOE_ROWS = T + NE * 256;
constexpr float EPS = 1e-6f;

constexpr size_t MiB = 1u << 20;
constexpr size_t WS_CTL = 0, CTL_ZERO_BYTES = 1 * MiB;
constexpr size_t WS_ROT = 1 * MiB, WS_ROTT = 5 * MiB, WS_WC = 10 * MiB + 768 * 1024;
constexpr int RTP = SEQ + 64;
constexpr size_t WS_TOKE = 9 * MiB + 256 * 1024;
constexpr size_t WS_TOKW = WS_TOKE + 256 * 1024;
constexpr size_t WS_BCNT = WS_TOKW + 256 * 1024;
constexpr size_t WS_ROWTOK = WS_BCNT + 16 * 1024;
constexpr size_t WS_ROWGATE = WS_ROWTOK + 2 * MOE_ROWS * 4;
constexpr size_t WS_PCNT = 10 * MiB + 512 * 1024;
constexpr size_t WS_STATS = 11 * MiB;
constexpr size_t WS_TW = 256 * 1024;
constexpr size_t WS_ZP = 5 * MiB;
constexpr size_t WS_Z0T = 7 * MiB;
constexpr size_t WS_R0 = 64 * 1024;
constexpr size_t WS_SSQ1 = 1 * MiB, WS_SSQ2 = 3 * MiB;
static_assert(WS_ROWGATE + 2 * MOE_ROWS * 4 <= WS_PCNT, "small tables");
constexpr size_t WS_WIN = 12 * MiB, WS_WO = 24 * MiB, WS_WGU = 28 * MiB, WS_WD = 39 * MiB, WS_WF = 44 * MiB + 512 * 1024;
constexpr size_t WS_HN = 48 * MiB;
constexpr size_t WS_Q = 112 * MiB, WS_K = 176 * MiB, WS_KT = 240 * MiB  , WS_VT = 368 * MiB, WS_PC = 496 * MiB;
constexpr size_t WS_YG = 240 * MiB;
constexpr size_t WS_STATP = 176 * MiB;
constexpr size_t WS_ACTD = 112 * MiB;
constexpr size_t WS_Z2 = 112 * MiB, WS_WSEQ = 46 * MiB + 512 * 1024;
constexpr size_t WS_ACTM = 112 * MiB;
constexpr size_t WS_WMGU = 352 * MiB, WS_WMD = 464 * MiB, WS_END = 528 * MiB;
static_assert(WS_ACTM + (size_t)MOE_ROWS * FFE * 2 <= WS_WMGU, "moe act");
static_assert(WS_PC + (size_t)NB * NH * NCH * CH * CH * 2 <= 528 * MiB, "epoch A");
static_assert(WS_WF + (size_t)D * D * 2 <= WS_WSEQ && WS_WSEQ + 512 * 1024 * 2 <= WS_HN, "weights");
constexpr int CW_BAR = 4096;
constexpr int CW_CHK = 64;

constexpr int RING_BYTES = 131072;
constexpr int LDSCTL_OFF = 139264, MISC_OFF = LDSCTL_OFF + 320;
constexpr int LDS_BYTES = 163840;
constexpr int STG_OFF = 147456;

#define LDS_WAIT() asm volatile("s_waitcnt lgkmcnt(0)" ::: "memory")
#define VM_WAIT() asm volatile("s_waitcnt vmcnt(0)" ::: "memory")
#define RLX_AGENT __ATOMIC_RELAXED, __HIP_MEMORY_SCOPE_AGENT

__device__ __forceinline__ unsigned cvt_pk_bf16(float lo, float hi) { unsigned r; asm volatile("v_cvt_pk_bf16_f32 %0, %1, %2" : "=v"(r) : "v"(lo), "v"(hi)); return r; }
__device__ __forceinline__ unsigned pk4_fp8(float a, float b, float c, float d) { int w = 0; w = __builtin_amdgcn_cvt_pk_fp8_f32(a, b, w, false); w = __builtin_amdgcn_cvt_pk_fp8_f32(c, d, w, true); return (unsigned)w; }
__device__ __forceinline__ float bf_lo(unsigned w) { return __uint_as_float(w << 16); }
__device__ __forceinline__ float bf_hi(unsigned w) { return __uint_as_float(w & 0xffff0000u); }
__device__ __forceinline__ float fast_exp2(float x) { return __builtin_amdgcn_exp2f(x); }
__device__ __forceinline__ int lane_id_v() { int l; asm volatile("v_mbcnt_lo_u32_b32 %0, -1, 0\n\tv_mbcnt_hi_u32_b32 %0, -1, %0" : "=v"(l)); return l; }
__device__ __forceinline__ int tid_of(int wave_s) { asm volatile("" : "+s"(wave_s)); return wave_s * 64 + lane_id_v(); }
__device__ __forceinline__ int rot_col(int row, int tok) { return (tok + ((row & 15) << 11)) & (32768 - 1); }
__device__ __forceinline__ f32x4 swiglu4(const f32x4 g, const f32x4 u, const float tc, const float k) {
    const f32x4 t = g * tc;
    f32x4 e; e.x = __builtin_amdgcn_exp2f(t.x); e.y = __builtin_amdgcn_exp2f(t.y); e.z = __builtin_amdgcn_exp2f(t.z); e.w = __builtin_amdgcn_exp2f(t.w);
    const f32x4 d = e * k + k;
    f32x4 r; r.x = __builtin_amdgcn_rcpf(d.x); r.y = __builtin_amdgcn_rcpf(d.y); r.z = __builtin_amdgcn_rcpf(d.z); r.w = __builtin_amdgcn_rcpf(d.w);
    return (g * u) * r;
}
__device__ __forceinline__ float silu_f(float v) { return v * __builtin_amdgcn_rcpf(1.0f + __builtin_amdgcn_exp2f(v * -1.44269504088896341f)); }

namespace pg8 {
constexpr int BM = 256, BK = 64, HALF = 128, HTB = HALF * BK * 2, STAGE_BYTES = 8 * HTB, NXCD = 8, WGM = 2;
__host__ __device__ __forceinline__ int lds_byte(int r, int c) { const int st = (r >> 4) * 2 + (c >> 5), rr = r & 15, cc = c & 31, ob = rr * 64 + cc * 2; return st * 1024 + (ob ^ (((ob >> 9) & 1) << 5)); }
__host__ __device__ __forceinline__ void stage_rc(int b, int& R, int& C) { const int st = b / 1024, sb = b % 1024, swz = sb ^ (((sb >> 9) & 1) << 5); R = (st >> 1) * 16 + swz / 64; C = (st & 1) * 32 + (swz % 64) / 2; }
__host__ __device__ __forceinline__ int perm32(int rho) { const int n = rho >> 4, i = rho & 15; return 8 * (i >> 2) + 4 * n + (i & 3); }

struct Unit { const GAS char* A; const GAS char* B; const GAS int* rows; int pm, pn, z; };

__device__ __forceinline__ bool tile_of(long L, int nM, int nN, int& pm, int& pn) {
    const int nwg = nM * nN; if (L >= nwg) return false;
    int wgid = (int)L; { const int q = nwg / NXCD, r = nwg % NXCD, xcd = wgid % NXCD, off = wgid / NXCD; wgid = (xcd < r ? xcd * (q + 1) : r * (q + 1) + (xcd - r) * q) + off; }
    const int nig = WGM * nN, gid = wgid / nig, fm = gid * WGM, gsz = (nM - fm) < WGM ? (nM - fm) : WGM;
    pm = fm + ((wgid % nig) % gsz); pn = (wgid % nig) / gsz; return true;
}

template <class Epi, class Sched, bool GATHER, bool FP8 = false>
__device__ __forceinline__ void gemm_phase(LAS unsigned char* lds, const int wave_s, const int lda, const int ldb, const int K, const Sched& S, const Epi& E) {
    const int tid = tid_of(wave_s);
    const int wid = __builtin_amdgcn_readfirstlane(tid >> 6), lane = tid & 63, wr = wid >> 2, wc = wid & 3, fr = lane & 15, fq = lane >> 4;
    constexpr int ES = FP8 ? 1 : 2;
    const int nt = K * ES / (BK * 2);
    unsigned vA[2][2], vAn[2][2], voffB[2];
#pragma unroll
    for (int i = 0; i < 2; ++i) { int R, C; stage_rc(tid * 16 + i * 8192, R, C); const int Rb = Epi::PERM ? ((R & ~31) + perm32(R & 31)) : R;
        voffB[i] = (unsigned)(S.brow(Rb) * ldb * ES + C * 2);
#pragma unroll
        for (int h = 0; h < 2; ++h) { vA[h][i] = (unsigned)((h * HALF + R) * lda * ES + C * 2); vAn[h][i] = vA[h][i]; } }
    const size_t kstep = (size_t)(BK * 2);
    const size_t hstepB = (size_t)(S.brow(HALF) - S.brow(0)) * ldb * ES;
    const unsigned ldsw = (unsigned)wid * 1024u;
    const int aoff = lds_byte(wr * 64 + fr, fq * 8), boff = lds_byte(wc * 32 + fr, fq * 8);
    typedef int v4i_ __attribute__((ext_vector_type(4))); typedef int v8i_ __attribute__((ext_vector_type(8)));
    const int sc_w8 = S.scale_b8(), sc_a8 = S.scale_a8(); (void)sc_w8; (void)sc_a8;
#define PG8_SA(b, h) (((b) * 2 + (h)) * HTB)
#define PG8_SB(b, h) ((4 + (b) * 2 + (h)) * HTB)
#define PG8_STAGE_B(bufoff, gbase) do { _Pragma("unroll") for (int _i = 0; _i < 2; ++_i) \
        __builtin_amdgcn_global_load_lds((const GAS unsigned*)((const GAS char*)(gbase) + voffB[_i]), (LAS unsigned*)(lds + (bufoff) + ldsw + _i * 8192), 16, 0, 0); } while (0)
#define PG8_STAGE_A(bufoff, gbase, v0, v1) do { \
        __builtin_amdgcn_global_load_lds((const GAS unsigned*)((const GAS char*)(gbase) + (v0)), (LAS unsigned*)(lds + (bufoff) + ldsw), 16, 0, 0); \
        __builtin_amdgcn_global_load_lds((const GAS unsigned*)((const GAS char*)(gbase) + (v1)), (LAS unsigned*)(lds + (bufoff) + ldsw + 8192), 16, 0, 0); } while (0)
#define PG8_LD32(addr) __builtin_shufflevector(*(const LAS v4i_*)(addr), *(const LAS v4i_*)((addr) + 1024), 0, 1, 2, 3, 4, 5, 6, 7)
#define PG8_LDA(dst, b, h) do { _Pragma("unroll") for (int m = 0; m < 4; ++m) { if constexpr (FP8) dst##8[m] = PG8_LD32(lds + PG8_SA(b, h) + aoff + m * 2048); else { _Pragma("unroll") for (int k = 0; k < 2; ++k) dst[m][k] = *(const LAS bf16x8*)(lds + PG8_SA(b, h) + aoff + m * 2048 + k * 1024); } } } while (0)
#define PG8_LDB(dst, b, h) do { _Pragma("unroll") for (int n = 0; n < 2; ++n) { if constexpr (FP8) dst##8[n] = PG8_LD32(lds + PG8_SB(b, h) + boff + n * 2048); else { _Pragma("unroll") for (int k = 0; k < 2; ++k) dst[n][k] = *(const LAS bf16x8*)(lds + PG8_SB(b, h) + boff + n * 2048 + k * 1024); } } } while (0)
#define PG8_MMA(ai, bj, At, Bt) do { __builtin_amdgcn_s_setprio(1); _Pragma("unroll") for (int m = 0; m < 4; ++m) _Pragma("unroll") for (int n = 0; n < 2; ++n) { \
        if constexpr (FP8) asm volatile("v_mfma_scale_f32_16x16x128_f8f6f4 %0, %1, %2, %0, %3, %4 op_sel_hi:[0,0,0]" : "+v"(acc[ai][bj][m][n]) : "v"(Bt##8[n]), "v"(At##8[m]), "v"(sc_w8), "v"(sc_a8)); \
        else { _Pragma("unroll") for (int k = 0; k < 2; ++k) acc[ai][bj][m][n] = __builtin_amdgcn_mfma_f32_16x16x32_bf16(Bt[n][k], At[m][k], acc[ai][bj][m][n], 0, 0, 0); } } \
        __builtin_amdgcn_s_setprio(0); } while (0)
#define PG8_WAIT_V(n) asm volatile("s_waitcnt vmcnt(" #n ")" ::: "memory")
#define PG8_WAIT_L(n) asm volatile("s_waitcnt lgkmcnt(" #n ")" ::: "memory")
#define PG8_BAR __builtin_amdgcn_s_barrier()
#define PG8_SCHED __builtin_amdgcn_sched_barrier(0)
#define PG8_LOADROWS(dst, u) do { if constexpr (GATHER) { const int _tz = tid_of(wave_s); _Pragma("unroll") for (int _i = 0; _i < 2; ++_i) { int _R, _C; stage_rc(_tz * 16 + _i * 8192, _R, _C); \
        _Pragma("unroll") for (int _h = 0; _h < 2; ++_h) { const int _t = (u).rows[_h * HALF + _R]; dst[_h][_i] = (unsigned)((_t < 0 ? 0 : _t) * lda * ES + _C * 2); } } } } while (0)
#define PG8_VAN(h, i) (GATHER ? vAn[h][i] : vA[h][i])
    Unit cur, nxt; int ui = 0;
    if (!S.next(0, cur)) return;
    f32x4 acc[2][2][4][2];
#pragma unroll
    for (int a = 0; a < 2; ++a)
#pragma unroll
        for (int b = 0; b < 2; ++b)
#pragma unroll
            for (int m = 0; m < 4; ++m)
#pragma unroll
                for (int n = 0; n < 2; ++n) acc[a][b][m][n] = (f32x4){0.f, 0.f, 0.f, 0.f};
    bf16x8 At[4][2], B0[2][2], B1[2][2]; v8i_ At8[4], B08[2], B18[2]; (void)At; (void)B0; (void)B1; (void)At8; (void)B08; (void)B18;
    const GAS char* cA = cur.A; const GAS char* cB = cur.B;
    PG8_LOADROWS(vA, cur);
    if constexpr (GATHER) { vAn[0][0] = vA[0][0]; vAn[0][1] = vA[0][1]; vAn[1][0] = vA[1][0]; vAn[1][1] = vA[1][1]; }
    PG8_STAGE_B(PG8_SB(0, 0), cB); PG8_STAGE_B(PG8_SB(0, 1), cB + hstepB); PG8_STAGE_A(PG8_SA(0, 0), cA, vA[0][0], vA[0][1]); PG8_STAGE_A(PG8_SA(0, 1), cA, vA[1][0], vA[1][1]);
    if (wr == 1) PG8_BAR;
    PG8_WAIT_V(2); PG8_BAR;
    PG8_STAGE_B(PG8_SB(1, 0), cB + kstep); PG8_STAGE_A(PG8_SA(1, 0), cA + kstep, vA[0][0], vA[0][1]); PG8_STAGE_B(PG8_SB(1, 1), cB + hstepB + kstep);
    PG8_WAIT_V(6); PG8_BAR;
    for (;;) {
        const bool has_next = S.next(ui + 1, nxt);
        const GAS char* nA = has_next ? nxt.A : cA; const GAS char* nB = has_next ? nxt.B : cB;
#pragma unroll 1
        for (int t = 0; t < nt; t += 2) {
            const bool last = (t == nt - 2);
            const GAS char* a1 = cA + (size_t)(t + 1) * kstep;
            const GAS char* a2 = last ? nA : cA + (size_t)(t + 2) * kstep; const GAS char* b2 = last ? nB : cB + (size_t)(t + 2) * kstep;
            const GAS char* a3 = a2 + kstep; const GAS char* b3 = b2 + kstep;
            if constexpr (GATHER) { if (last && has_next) { PG8_LOADROWS(vAn, nxt); } }
            PG8_LDB(B0, 0, 0); PG8_LDB(B1, 0, 1); PG8_SCHED; PG8_LDA(At, 0, 0); PG8_STAGE_A(PG8_SA(1, 1), a1, vA[1][0], vA[1][1]);
            PG8_WAIT_V(8); PG8_WAIT_L(0); PG8_BAR; PG8_MMA(0, 0, At, B0); if constexpr (!Epi::DIAG_ONLY) PG8_MMA(0, 1, At, B1); PG8_BAR; PG8_SCHED;
            PG8_LDA(At, 0, 1); PG8_STAGE_B(PG8_SB(0, 0), b2); PG8_STAGE_B(PG8_SB(0, 1), b2 + hstepB); PG8_STAGE_A(PG8_SA(0, 0), a2, PG8_VAN(0, 0), PG8_VAN(0, 1));
            PG8_WAIT_V(8); PG8_WAIT_L(0); PG8_BAR; if constexpr (!Epi::DIAG_ONLY) PG8_MMA(1, 0, At, B0); PG8_MMA(1, 1, At, B1); PG8_BAR; PG8_SCHED;
            PG8_LDB(B0, 1, 0); PG8_LDB(B1, 1, 1); PG8_SCHED; PG8_LDA(At, 1, 0); PG8_STAGE_A(PG8_SA(0, 1), a2, PG8_VAN(1, 0), PG8_VAN(1, 1));
            PG8_WAIT_V(8); PG8_WAIT_L(0); PG8_BAR; PG8_MMA(0, 0, At, B0); if constexpr (!Epi::DIAG_ONLY) PG8_MMA(0, 1, At, B1); PG8_BAR; PG8_SCHED;
            PG8_LDA(At, 1, 1); PG8_STAGE_B(PG8_SB(1, 0), b3); PG8_STAGE_B(PG8_SB(1, 1), b3 + hstepB); PG8_STAGE_A(PG8_SA(1, 0), a3, PG8_VAN(0, 0), PG8_VAN(0, 1));
            PG8_WAIT_V(8); PG8_WAIT_L(0); PG8_BAR; if constexpr (!Epi::DIAG_ONLY) PG8_MMA(1, 0, At, B0); PG8_MMA(1, 1, At, B1); PG8_BAR; PG8_SCHED;
        }
        if (wr == 0) PG8_BAR;
        if constexpr (FP8) asm volatile("s_nop 15\n\ts_nop 15" ::: "memory");
        E(acc, cur, wr, wc, fr, fq);
        if (!has_next) break;
#pragma unroll
        for (int a = 0; a < 2; ++a)
#pragma unroll
            for (int b = 0; b < 2; ++b)
#pragma unroll
                for (int m = 0; m < 4; ++m)
#pragma unroll
                    for (int n = 0; n < 2; ++n) acc[a][b][m][n] = (f32x4){0.f, 0.f, 0.f, 0.f};
        cur = nxt; cA = nA; cB = nB; ++ui;
        if constexpr (GATHER) { vA[0][0] = vAn[0][0]; vA[0][1] = vAn[0][1]; vA[1][0] = vAn[1][0]; vA[1][1] = vAn[1][1]; }
        if (wr == 1) PG8_BAR;
    }
    PG8_WAIT_V(0);
    PG8_BAR;
#undef PG8_SA
#undef PG8_SB
#undef PG8_STAGE_A
#undef PG8_STAGE_B
#undef PG8_LDA
#undef PG8_LD32
#undef PG8_LDB
#undef PG8_MMA
#undef PG8_WAIT_V
#undef PG8_WAIT_L
#undef PG8_BAR
#undef PG8_SCHED
#undef PG8_LOADROWS
#undef PG8_VAN
}
}

struct SchedPlain {
    __device__ __forceinline__ int scale_b8() const { return 0x7f7f7f7f; }
    __device__ __forceinline__ int scale_a8() const { return 0x7f7f7f7f; }
    __device__ __forceinline__ int brow(int r) const { return r; }
    const GAS char* A; const GAS char* B; size_t a_tile, b_tile; int nM, nN, G, c; int flip4;
    __device__ __forceinline__ bool next(int i, pg8::Unit& u) const {
        int pm, pn; if (!pg8::tile_of((long)i * G + c, nM, nN, pm, pn)) return false;
        if (flip4 && ((pm >> 2) & 1)) pn ^= 4;
        u.pm = pm; u.pn = pn; u.z = 0; u.rows = nullptr; u.A = A + (size_t)pm * a_tile; u.B = B + (size_t)pn * b_tile; return true; }
};
struct SchedPlainF8 : SchedPlain {
    __device__ __forceinline__ int scale_b8() const { return 0x79797979; }
    __device__ __forceinline__ int scale_a8() const { return 0x7c7c7c7c; }
};
struct SchedPc {
    __device__ __forceinline__ int scale_b8() const { return 0x7f7f7f7f; }
    __device__ __forceinline__ int scale_a8() const { return 0x7f7f7f7f; }
    __device__ __forceinline__ int brow(int r) const { return r; }
    const GAS char* Q; const GAS char* Kk; int G, c;
    __device__ __forceinline__ bool next(int i, pg8::Unit& u) const {
        const int L = i * G + c; if (L >= NB * NH * 16) return false;
        const int cp = L & 15, h = (L >> 4) & 3, b = L >> 6;
        const size_t off = ((size_t)(b * SEQ + cp * 256) * QKW + h * DK) * 2;
        u.pm = L; u.pn = 0; u.z = h; u.rows = nullptr; u.A = Q + off; u.B = Kk + off; return true; }
};
struct SchedFnA {
    __device__ __forceinline__ int scale_b8() const { return 0x7f7f7f7f; }
    __device__ __forceinline__ int scale_a8() const { return 0x7f7f7f7f; }
    static __device__ __forceinline__ int aoff(int x) { return 8 * ((x >> 2) & 3) + 4 * (x >> 4) + (x & 3); }
    __device__ __forceinline__ int brow(int r) const { return aoff(r >> 3) + 512 * (r & 7); }
    const GAS char* Wc; const GAS char* Hn; int G, c;
    __device__ __forceinline__ bool next(int i, pg8::Unit& u) const {
        int pm, pn; if (!pg8::tile_of((long)i * G + c, 4, T / 256, pm, pn)) return false;
        const int g = pm, batch = pn >> 4, a0 = (pn & 15) * 32;
        u.pm = pm; u.pn = pn; u.z = 0; u.rows = nullptr; u.A = Wc + (size_t)pm * 256 * 256 * 2; u.B = Hn + ((size_t)(batch * SEQ + a0) * D + g * 256) * 2; return true; }
};
struct SchedFnB {
    __device__ __forceinline__ int scale_b8() const { return 0x7f7f7f7f; }
    __device__ __forceinline__ int scale_a8() const { return 0x7f7f7f7f; }
    __device__ __forceinline__ int brow(int r) const { return (r & 63) * 8 + (r >> 6); }
    GAS const char* WY; GAS const char* U; int G, c;
    __device__ __forceinline__ bool next(int i, pg8::Unit& u) const {
        int pm, pn; if (!pg8::tile_of((long)i * G + c, 2, 128, pm, pn)) return false;
        const int batch = pn >> 4, fb = (pn >> 1) & 7, kbb = pn & 1;
        u.pm = pm; u.pn = pn; u.z = 0; u.rows = nullptr; u.A = WY + (size_t)pm * 256 * 1024 * 2; u.B = U + ((size_t)(batch * 512 + fb * 64) * 8 + kbb * 4) * 1024 * 2; return true; }
};
struct SchedMoe {
    __device__ __forceinline__ int scale_b8() const { return 0x79797979; }
    __device__ __forceinline__ int scale_a8() const { return sa8; }
    __device__ __forceinline__ int brow(int r) const { return r; }
    const GAS char* A; const GAS char* W; const GAS int* rowtok; const LAS unsigned char* texp; size_t a_tile, w_exp, w_tile; int ntiles, ncol, G, c; bool gather; int sa8;
    __device__ __forceinline__ bool next(int i, pg8::Unit& u) const {
        int rt, ct; if (!pg8::tile_of((long)i * G + c, ntiles, ncol, rt, ct)) return false;
        const int e = texp[rt];
        u.pm = rt; u.pn = ct; u.z = e; u.rows = rowtok + rt * 256; u.A = gather ? A : A + (size_t)rt * a_tile; u.B = W + (size_t)e * w_exp + (size_t)ct * w_tile; return true; }
};

struct EpiRopeQK {
    static constexpr bool PERM = true; static constexpr bool DIAG_ONLY = false;
    GAS bf16* Q; GAS bf16* Kk; const GAS f32x2* rot; const GAS float* R0;
    GAS bf16* KT; const LAS float* l2g; LAS unsigned char* tscr;
    __device__ __forceinline__ void operator()(const f32x4 (&acc)[2][2][4][2], const pg8::Unit& u, int wr, int wc, int fr, int fq) const {
        asm volatile("" : "+v"(fr), "+v"(fq));
        const bool isk = u.pn >= 4; const int h = u.pn & 3; GAS bf16* dst = isk ? Kk : Q; const float sc0 = isk ? 0.0625f : 1.0f;
        const int i0 = wc * 32 + 8 * fq;
        float r0q[3]; f32x4 cq[3][2], sq[3][2];
#pragma unroll
        for (int p = 0; p < 3; ++p) { const int t = u.pm * 256 + wr * 64 + p * 16 + fr; const GAS float* rp = (const GAS float*)rot + (size_t)(t & (SEQ - 1)) * 256 + i0; r0q[p] = R0[t];
          cq[p][0] = *(const GAS f32x4*)rp; cq[p][1] = *(const GAS f32x4*)(rp + 4); sq[p][0] = *(const GAS f32x4*)(rp + 128); sq[p][1] = *(const GAS f32x4*)(rp + 132); }
#pragma unroll
        for (int it = 0; it < 8; ++it) { const int ai = it >> 2, m = it & 3, sl = it % 3;
                const int t = u.pm * 256 + ai * 128 + wr * 64 + m * 16 + fr; const float sc = sc0 * r0q[sl];
                const f32x4 cc[2] = {cq[sl][0] * sc, cq[sl][1] * sc}, ss[2] = {sq[sl][0] * sc, sq[sl][1] * sc};
                if (it + 3 < 8) { const int tn = u.pm * 256 + ((it + 3) >> 2) * 128 + wr * 64 + ((it + 3) & 3) * 16 + fr; const GAS float* rp = (const GAS float*)rot + (size_t)(tn & (SEQ - 1)) * 256 + i0; r0q[sl] = R0[tn];
                    cq[sl][0] = *(const GAS f32x4*)rp; cq[sl][1] = *(const GAS f32x4*)(rp + 4); sq[sl][0] = *(const GAS f32x4*)(rp + 128); sq[sl][1] = *(const GAS f32x4*)(rp + 132); }
                f32x4 o1v[2], o2v[2];
#pragma unroll
                for (int n = 0; n < 2; ++n) { const f32x4 c = cc[n], sn_ = ss[n], t1 = acc[ai][0][m][n], t2 = acc[ai][1][m][n];
                    o1v[n] = t1 * c - t2 * sn_; o2v[n] = t1 * sn_ + t2 * c; }
                GAS bf16* rowp = dst + (size_t)t * QKW + h * DK + i0;
                u32x4 w1, w2; w1.x = cvt_pk_bf16(o1v[0].x, o1v[0].y); w1.y = cvt_pk_bf16(o1v[0].z, o1v[0].w); w1.z = cvt_pk_bf16(o1v[1].x, o1v[1].y); w1.w = cvt_pk_bf16(o1v[1].z, o1v[1].w);
                w2.x = cvt_pk_bf16(o2v[0].x, o2v[0].y); w2.y = cvt_pk_bf16(o2v[0].z, o2v[0].w); w2.z = cvt_pk_bf16(o2v[1].x, o2v[1].y); w2.w = cvt_pk_bf16(o2v[1].z, o2v[1].w);
                *(GAS u32x4*)rowp = w1; *(GAS u32x4*)(rowp + 128) = w2;
                if (isk) {
                    const int tok0 = u.pm * 256 + ai * 128 + wr * 64 + m * 16 + 8 * (fq >> 1);
                    const size_t fr0 = ((((size_t)((tok0 >> 12) * NH + h) * NCH + ((tok0 & (SEQ - 1)) >> 7)) * 8 + wc) * 8 + (4 * wr + m)) * 512 + (16 * (fq & 1) + fr + 32 * (fq >> 1)) * 8;
                    LAS unsigned char* my = tscr + (wr * 4 + wc) * 2048;
                    const unsigned tra = (unsigned)(size_t)my + (8 * (fq >> 1) + (fr >> 2)) * 64 + 32 * (fq & 1) + 8 * (fr & 3);
                    {
                        *(LAS u32x4*)(my + fr * 64 + fq * 16) = w1; *(LAS u32x4*)(my + 1024 + fr * 64 + fq * 16) = w2;
                        u32x2 a0, a1, b0, b1;
                        asm volatile("s_waitcnt lgkmcnt(0)\n\tds_read_b64_tr_b16 %0, %4\n\tds_read_b64_tr_b16 %1, %4 offset:256\n\tds_read_b64_tr_b16 %2, %4 offset:1024\n\tds_read_b64_tr_b16 %3, %4 offset:1280\n\ts_waitcnt lgkmcnt(0)"
                                     : "=&v"(a0), "=&v"(a1), "=&v"(b0), "=&v"(b1) : "v"(tra) : "memory");
                        GAS bf16* kd = KT + fr0;
                        *(GAS u32x4*)kd = (u32x4){a0.x, a0.y, a1.x, a1.y}; *(GAS u32x4*)(kd + (size_t)4 * 8 * 512) = (u32x4){b0.x, b0.y, b1.x, b1.y}; }
                } }
    }
};
struct EpiRopeKT {
    static constexpr bool PERM = true; static constexpr bool DIAG_ONLY = false;
    GAS bf16* KT; const GAS f32x2* rotT; const LAS float* l2g; const GAS float* R0;
    __device__ __forceinline__ void operator()(const f32x4 (&acc)[2][2][4][2], const pg8::Unit& u, int wr, int wc, int fr, int fq) const {
        const int h = u.pm; const float l2f = l2g[h], l2b = l2g[4 + h];
#pragma unroll
        for (int bj = 0; bj < 2; ++bj) {
            const int tok0 = u.pn * 256 + bj * 128 + wc * 32 + 8 * fq, s0 = tok0 & (SEQ - 1), j0 = tok0 & (CH - 1);
            float zf[8], zb[8];
            const f32x4 ra = *(const GAS f32x4*)(R0 + tok0), rb = *(const GAS f32x4*)(R0 + tok0 + 4); const float rq[8] = {ra[0], ra[1], ra[2], ra[3], rb[0], rb[1], rb[2], rb[3]};
#pragma unroll
            for (int q = 0; q < 8; ++q) { const float rs = rq[q] * 0.0625f; zf[q] = fast_exp2((float)(CH - 1 - (j0 + q)) * l2f) * rs; zb[q] = fast_exp2((float)(j0 + q) * l2b) * rs; }
#pragma unroll
            for (int m = 0; m < 4; ++m) { const int i = wr * 64 + m * 16 + fr;
                const GAS f32x4* rp = (const GAS f32x4*)(rotT + (size_t)i * RTP + s0);
                const f32x4 r0 = rp[0], r1 = rp[1], r2 = rp[2], r3 = rp[3];
                const float cs[8] = {r0[0], r0[2], r1[0], r1[2], r2[0], r2[2], r3[0], r3[2]}, sn[8] = {r0[1], r0[3], r1[1], r1[3], r2[1], r2[3], r3[1], r3[3]};
                float o1[8], o2[8];
#pragma unroll
                for (int n = 0; n < 2; ++n)
#pragma unroll
                    for (int j = 0; j < 4; ++j) { const float t1 = acc[0][bj][m][n][j], t2 = acc[1][bj][m][n][j]; const int q = 4 * n + j;
                        o1[q] = t1 * cs[q] - t2 * sn[q]; o2[q] = t1 * sn[q] + t2 * cs[q]; }
                u32x4 w1, w2;
                w1.x = cvt_pk_bf16(o1[0] * zf[0], o1[1] * zf[1]); w1.y = cvt_pk_bf16(o1[2] * zf[2], o1[3] * zf[3]); w1.z = cvt_pk_bf16(o1[4] * zf[4], o1[5] * zf[5]); w1.w = cvt_pk_bf16(o1[6] * zf[6], o1[7] * zf[7]);
                w2.x = cvt_pk_bf16(o2[0] * zf[0], o2[1] * zf[1]); w2.y = cvt_pk_bf16(o2[2] * zf[2], o2[3] * zf[3]); w2.z = cvt_pk_bf16(o2[4] * zf[4], o2[5] * zf[5]); w2.w = cvt_pk_bf16(o2[6] * zf[6], o2[7] * zf[7]);
                const size_t fr0 = ((((size_t)((tok0 >> 12) * NH + h) * NCH + ((tok0 & (SEQ - 1)) >> 7)) * 8 + (i >> 5)) * 8 + (2 * wc + (fq >> 1))) * 512 + ((i & 31) + 32 * (fq & 1)) * 8;
                *(GAS u32x4*)(KT + fr0) = w1; *(GAS u32x4*)(KT + fr0 + (size_t)4 * 8 * 512) = w2;
                w1.x = cvt_pk_bf16(o1[0] * zb[0], o1[1] * zb[1]); w1.y = cvt_pk_bf16(o1[2] * zb[2], o1[3] * zb[3]); w1.z = cvt_pk_bf16(o1[4] * zb[4], o1[5] * zb[5]); w1.w = cvt_pk_bf16(o1[6] * zb[6], o1[7] * zb[7]);
                w2.x = cvt_pk_bf16(o2[0] * zb[0], o2[1] * zb[1]); w2.y = cvt_pk_bf16(o2[2] * zb[2], o2[3] * zb[3]); w2.z = cvt_pk_bf16(o2[4] * zb[4], o2[5] * zb[5]); w2.w = cvt_pk_bf16(o2[6] * zb[6], o2[7] * zb[7]);
                *(GAS u32x4*)(KT + (size_t)QKW * T + fr0) = w1; *(GAS u32x4*)(KT + (size_t)QKW * T + fr0 + (size_t)4 * 8 * 512) = w2; } }
    }
};
template <bool ROT> struct EpiBf16 {
    static constexpr bool PERM = true; static constexpr bool DIAG_ONLY = false;
    GAS bf16* O; int ldc; const GAS float* cs;
    __device__ __forceinline__ void operator()(const f32x4 (&acc)[2][2][4][2], const pg8::Unit& u, int wr, int wc, int fr, int fq) const {
        f32x4 c0[2], c1[2];
#pragma unroll
        for (int bj = 0; bj < 2; ++bj) { const int col = u.pn * 256 + bj * 128 + wc * 32 + 8 * fq; c0[bj] = cs != nullptr ? *(const GAS f32x4*)(cs + col) : (f32x4){1.f, 1.f, 1.f, 1.f}; c1[bj] = cs != nullptr ? *(const GAS f32x4*)(cs + col + 4) : (f32x4){1.f, 1.f, 1.f, 1.f}; }
#pragma unroll
        for (int ai = 0; ai < 2; ++ai)
#pragma unroll
            for (int m = 0; m < 4; ++m) { const int row = u.pm * 256 + ai * 128 + wr * 64 + m * 16 + fr; GAS bf16* rowp = O + (size_t)row * ldc;
#pragma unroll
                for (int bj = 0; bj < 2; ++bj) { const f32x4 v0 = acc[ai][bj][m][0] * c0[bj], v1 = acc[ai][bj][m][1] * c1[bj]; const int col = u.pn * 256 + bj * 128 + wc * 32 + 8 * fq;
                    u32x4 w; w.x = cvt_pk_bf16(v0[0], v0[1]); w.y = cvt_pk_bf16(v0[2], v0[3]); w.z = cvt_pk_bf16(v1[0], v1[1]); w.w = cvt_pk_bf16(v1[2], v1[3]);
                    *(GAS u32x4*)(rowp + (ROT ? rot_col(row, col) : col)) = w; } }
    }
};
struct EpiPc {
    static constexpr bool PERM = true; static constexpr bool DIAG_ONLY = true;
    GAS bf16* PC; GAS bf16* PD; const LAS float* l2g;
    __device__ __forceinline__ void operator()(const f32x4 (&acc)[2][2][4][2], const pg8::Unit& u, int wr, int wc, int fr, int fq) const {
        const int h = u.z; const float l2f = l2g[h], l2b = l2g[4 + h];
#pragma unroll
        for (int ai = 0; ai < 2; ++ai)
#pragma unroll
            for (int m = 0; m < 4; ++m) { const int il = wr * 64 + m * 16 + fr, jl0 = wc * 32 + 8 * fq; float o[8];
                const bool diag = (wc == 2 * wr + (m >> 1));
#pragma unroll
                for (int n = 0; n < 2; ++n)
#pragma unroll
                    for (int j = 0; j < 4; ++j) { const int dl = il - (jl0 + 4 * n + j); const float f = dl >= 0 ? fast_exp2((float)(il - (CH - 1)) * l2f) : fast_exp2((float)(-il) * l2b);
                        o[4 * n + j] = (ai == 0 ? acc[0][0][m][n][j] : acc[1][1][m][n][j]) * f; }
                if (diag) {
                    float ob[8];
#pragma unroll
                    for (int q = 0; q < 8; ++q) { const bool lower = (jl0 + q) <= il; ob[q] = lower ? 0.f : o[q]; o[q] = lower ? o[q] : 0.f; }
                    u32x4 wb; wb.x = cvt_pk_bf16(ob[0], ob[1]); wb.y = cvt_pk_bf16(ob[2], ob[3]); wb.z = cvt_pk_bf16(ob[4], ob[5]); wb.w = cvt_pk_bf16(ob[6], ob[7]);
                    *(GAS u32x4*)(PD + ((((size_t)(u.pm * 2 + ai) * 4 + (il >> 5)) * 2 + (fq >> 1)) * 512 + ((il & 31) + 32 * (fq & 1)) * 8)) = wb;
                }
                u32x4 w; w.x = cvt_pk_bf16(o[0], o[1]); w.y = cvt_pk_bf16(o[2], o[3]); w.z = cvt_pk_bf16(o[4], o[5]); w.w = cvt_pk_bf16(o[6], o[7]);
                *(GAS u32x4*)(PC + ((((size_t)(u.pm * 2 + ai) * 4 + (il >> 5)) * 8 + (2 * wc + (fq >> 1))) * 512 + ((il & 31) + 32 * (fq & 1)) * 8)) = w; }
    }
};
struct EpiGate {
    static constexpr bool PERM = true; static constexpr bool DIAG_ONLY = false;
    const GAS bf16* Y; GAS bf16* YG; const GAS f32x2* statp; const GAS float* gain; LAS f32x2* sst; const GAS float* R0;
    __device__ __forceinline__ void operator()(const f32x4 (&acc)[2][2][4][2], const pg8::Unit& u, int wr, int wc, int fr, int fq) const {
        asm volatile("" : "+v"(fr), "+v"(fq));
        const int head = u.pn >> 1, c0 = u.pn * 256 + wc * 32 + 8 * fq;
        const int tid = (wr * 4 + wc) * 64 + fq * 16 + fr;
        if (tid < 256) { const int t = u.pm * 256 + tid; const GAS f32x4* sp = (const GAS f32x4*)(statp + ((size_t)t * 4 + head) * 8); float a1 = 0.f, a2 = 0.f;
#pragma unroll
            for (int k = 0; k < 4; ++k) { const f32x4 v = sp[k]; a1 += v[0] + v[2]; a2 += v[1] + v[3]; }
            const float mu = a1 * (1.f / DV), var = fmaxf(a2 * (1.f / DV) - mu * mu, 0.f); sst[tid] = (f32x2){mu, __builtin_amdgcn_rsqf(var + EPS)}; }
        asm volatile("s_waitcnt lgkmcnt(0)" ::: "memory"); __builtin_amdgcn_s_barrier(); asm volatile("" ::: "memory");
        f32x4 (&pa)[2][2][4][2] = const_cast<f32x4 (&)[2][2][4][2]>(acc);
        u32x4 yv[2][4][2];
#define EG_LDY(ai_) do { _Pragma("unroll") for (int m = 0; m < 4; ++m) { const int t = u.pm * 256 + (ai_) * 128 + wr * 64 + m * 16 + fr; \
            _Pragma("unroll") for (int bj = 0; bj < 2; ++bj) { const int es_ = (u.pn & 1) * 4 + bj * 2 + (wc >> 1);       \
                yv[ai_][m][bj] = *(const GAS u32x4*)(Y + (((size_t)(t >> 5) * NH + head) * 8 + es_) * 2048 + (((wc & 1) * 2 + (fq >> 1)) * 64 + (t & 31) + 32 * (fq & 1)) * 8); } } } while (0)
        EG_LDY(0);
        f32x4 gv[2][2];
#pragma unroll
        for (int bj = 0; bj < 2; ++bj) { gv[bj][0] = *(const GAS f32x4*)(gain + c0 + bj * 128); gv[bj][1] = *(const GAS f32x4*)(gain + c0 + bj * 128 + 4); }
        float r0v[2][4];
#pragma unroll
        for (int ai = 0; ai < 2; ++ai)
#pragma unroll
            for (int m = 0; m < 4; ++m) r0v[ai][m] = R0[u.pm * 256 + ai * 128 + wr * 64 + m * 16 + fr];
#pragma unroll
        for (int ai = 0; ai < 2; ++ai)
#pragma unroll
            for (int m = 0; m < 4; ++m) { const float tc = -1.44269504088896341f * r0v[ai][m];
#pragma unroll
                for (int bj = 0; bj < 2; ++bj)
#pragma unroll
                    for (int n = 0; n < 2; ++n) { const f32x4 g = pa[ai][bj][m][n]; const f32x4 tt = g * tc;
                        f32x4 e; e.x = __builtin_amdgcn_exp2f(tt.x); e.y = __builtin_amdgcn_exp2f(tt.y); e.z = __builtin_amdgcn_exp2f(tt.z); e.w = __builtin_amdgcn_exp2f(tt.w);
                        const f32x4 d = e + 1.0f; f32x4 r; r.x = __builtin_amdgcn_rcpf(d.x); r.y = __builtin_amdgcn_rcpf(d.y); r.z = __builtin_amdgcn_rcpf(d.z); r.w = __builtin_amdgcn_rcpf(d.w);
                        pa[ai][bj][m][n] = g * r; } }
        asm volatile("" ::: "memory");
        EG_LDY(1);
#undef EG_LDY
#pragma unroll
        for (int ai = 0; ai < 2; ++ai)
#pragma unroll
            for (int m = 0; m < 4; ++m) { int rl = ai * 128 + wr * 64 + m * 16 + fr; asm volatile("" : "+v"(rl)); const int t = u.pm * 256 + rl; const f32x2 st = sst[rl]; const float c1 = st.y * r0v[ai][m];
#pragma unroll
                for (int bj = 0; bj < 2; ++bj) { const size_t off = (size_t)t * VW + c0 + bj * 128; const u32x4 y_ = yv[ai][m][bj];
                    const f32x4 yv4[2] = {(f32x4){bf_lo(y_.x), bf_hi(y_.x), bf_lo(y_.y), bf_hi(y_.y)}, (f32x4){bf_lo(y_.z), bf_hi(y_.z), bf_lo(y_.w), bf_hi(y_.w)}}; float o[8];
#pragma unroll
                    for (int n = 0; n < 2; ++n) { const f32x4 ov = pa[ai][bj][m][n] * ((yv4[n] - st.x) * gv[bj][n] * c1); o[4 * n] = ov.x; o[4 * n + 1] = ov.y; o[4 * n + 2] = ov.z; o[4 * n + 3] = ov.w; }
                    u32x4 w; w.x = cvt_pk_bf16(o[0], o[1]); w.y = cvt_pk_bf16(o[2], o[3]); w.z = cvt_pk_bf16(o[4], o[5]); w.w = cvt_pk_bf16(o[6], o[7]);
                    *(GAS u32x4*)(YG + off) = w; } }
    }
};
template <bool BASE_F32> struct EpiRes {
    static constexpr bool PERM = true; static constexpr bool DIAG_ONLY = false;
    const GAS void* base; GAS bf16* out; GAS float* ssq;
    const GAS float* zg; GAS float* zp;
    __device__ __forceinline__ void operator()(const f32x4 (&acc)[2][2][4][2], const pg8::Unit& u, int wr, int wc, int fr, int fq) const {
        asm volatile("" : "+v"(fr), "+v"(fq));
        static_assert(!BASE_F32, "bf16 residual base only");
        const size_t off0 = (size_t)(u.pm * 256 + wr * 64 + fr) * D + u.pn * 256 + wc * 32 + 8 * fq;
        const GAS bf16* bp = (const GAS bf16*)base + off0;
        u32x4 bq[4][2];
#pragma unroll
        for (int p = 0; p < 4; ++p)
#pragma unroll
            for (int bj = 0; bj < 2; ++bj) bq[p][bj] = *(const GAS u32x4*)(bp + (size_t)(p * 16) * D + bj * 128);
        f32x4 gz[2][2];
#pragma unroll
        for (int bj = 0; bj < 2; ++bj) { const int c_ = u.pn * 256 + bj * 128 + wc * 32 + 8 * fq; gz[bj][0] = zp != nullptr ? *(const GAS f32x4*)(zg + c_) : (f32x4){0.f, 0.f, 0.f, 0.f}; gz[bj][1] = zp != nullptr ? *(const GAS f32x4*)(zg + c_ + 4) : (f32x4){0.f, 0.f, 0.f, 0.f}; }
#pragma unroll
        for (int it = 0; it < 8; ++it) { const int ai = it >> 2, m = it & 3;
            const int t_ = u.pm * 256 + ai * 128 + wr * 64 + m * 16 + fr; const size_t off = (size_t)t_ * D + u.pn * 256 + wc * 32 + 8 * fq; float sq = 0.f, zs = 0.f;
            const u32x4 bcur[2] = {bq[it & 3][0], bq[it & 3][1]};
            if (it + 4 < 8) {
#pragma unroll
                for (int bj = 0; bj < 2; ++bj) bq[it & 3][bj] = *(const GAS u32x4*)(bp + (size_t)(128 + m * 16) * D + bj * 128); }
#pragma unroll
            for (int bj = 0; bj < 2; ++bj) { f32x4 v0 = acc[ai][bj][m][0], v1 = acc[ai][bj][m][1]; const u32x4 bv = bcur[bj];
                v0 += (f32x4){bf_lo(bv.x), bf_hi(bv.x), bf_lo(bv.y), bf_hi(bv.y)}; v1 += (f32x4){bf_lo(bv.z), bf_hi(bv.z), bf_lo(bv.w), bf_hi(bv.w)};
                u32x4 w; w.x = cvt_pk_bf16(v0[0], v0[1]); w.y = cvt_pk_bf16(v0[2], v0[3]); w.z = cvt_pk_bf16(v1[0], v1[1]); w.w = cvt_pk_bf16(v1[2], v1[3]);
                *(GAS u32x4*)(out + off + bj * 128) = w;
                { const float a0 = bf_lo(w.x), a1 = bf_hi(w.x), a2 = bf_lo(w.y), a3 = bf_hi(w.y), a4 = bf_lo(w.z), a5 = bf_hi(w.z), a6 = bf_lo(w.w), a7 = bf_hi(w.w);
                  sq += (a0 * a0 + a1 * a1) + (a2 * a2 + a3 * a3) + (a4 * a4 + a5 * a5) + (a6 * a6 + a7 * a7);
                  zs += (a0 * gz[bj][0].x + a1 * gz[bj][0].y) + (a2 * gz[bj][0].z + a3 * gz[bj][0].w) + (a4 * gz[bj][1].x + a5 * gz[bj][1].y) + (a6 * gz[bj][1].z + a7 * gz[bj][1].w); } }
            sq += __shfl_xor(sq, 16); sq += __shfl_xor(sq, 32);
            if (ssq != nullptr && fq == 0) ssq[(size_t)t_ * 16 + u.pn * 4 + wc] = sq;
            if (zp != nullptr) { zs += __shfl_xor(zs, 16); zs += __shfl_xor(zs, 32); if (fq == 0) zp[(size_t)t_ * 16 + u.pn * 4 + wc] = zs; } }
    }
};
template <bool OUT8, bool NORM = false> struct EpiSwiGLU {
    static constexpr bool PERM = true; static constexpr bool DIAG_ONLY = false;
    GAS void* ACT; int ldc; const GAS float* ssq; LAS float* sst;
    __device__ __forceinline__ void operator()(const f32x4 (&acc)[2][2][4][2], const pg8::Unit& u, int wr, int wc, int fr, int fq) const {
        if constexpr (NORM) {
            const int tid = (wr * 4 + wc) * 64 + fq * 16 + fr;
            if (tid < 256) { const GAS f32x4* sp = (const GAS f32x4*)(ssq + (size_t)(u.pm * 256 + tid) * 16); float a = 0.f;
#pragma unroll
                for (int k = 0; k < 4; ++k) { const f32x4 v = sp[k]; a += (v[0] + v[1]) + (v[2] + v[3]); }
                const float var = a * (1.f / D) + EPS; ((LAS f32x2*)sst)[tid] = (f32x2){__builtin_amdgcn_rsqf(var), var}; }
            asm volatile("s_waitcnt lgkmcnt(0)" ::: "memory"); __builtin_amdgcn_s_barrier(); asm volatile("" ::: "memory");
        }
#pragma unroll
        for (int ai = 0; ai < 2; ++ai)
#pragma unroll
            for (int m = 0; m < 4; ++m) { float o[8]; float tc = -1.44269504088896341f, kk = OUT8 ? 0.125f : 1.0f;
                if constexpr (NORM) { const f32x2 sv = ((const LAS f32x2*)sst)[ai * 128 + wr * 64 + m * 16 + fr]; tc *= sv.x; kk *= sv.y; }
#pragma unroll
                for (int n = 0; n < 2; ++n) { const f32x4 ov = swiglu4(acc[ai][0][m][n], acc[ai][1][m][n], tc, kk); o[4 * n] = ov.x; o[4 * n + 1] = ov.y; o[4 * n + 2] = ov.z; o[4 * n + 3] = ov.w; }
                const size_t off = (size_t)(u.pm * 256 + ai * 128 + wr * 64 + m * 16 + fr) * ldc + u.pn * 128 + wc * 32 + 8 * fq;
                if constexpr (OUT8) { u32x2 w; w.x = pk4_fp8(o[0], o[1], o[2], o[3]); w.y = pk4_fp8(o[4], o[5], o[6], o[7]); *(GAS u32x2*)((GAS unsigned char*)ACT + off) = w; }
                else { u32x4 w; w.x = cvt_pk_bf16(o[0], o[1]); w.y = cvt_pk_bf16(o[2], o[3]); w.z = cvt_pk_bf16(o[4], o[5]); w.w = cvt_pk_bf16(o[6], o[7]); *(GAS u32x4*)((GAS bf16*)ACT + off) = w; } }
    }
};
__device__ __forceinline__ void fft8(const float (&xr)[8], const float (&xi)[8], float (&Xr)[8], float (&Xi)[8]) {
    constexpr float R = 0.70710678118654752f;
    float ar[4], ai[4], br[4], bi[4];
#pragma unroll
    for (int n = 0; n < 4; ++n) { ar[n] = xr[n] + xr[n + 4]; ai[n] = xi[n] + xi[n + 4]; br[n] = xr[n] - xr[n + 4]; bi[n] = xi[n] - xi[n + 4]; }
    { const float r = br[1], i = bi[1]; br[1] = (r + i) * R; bi[1] = (i - r) * R; }
    { const float r = br[2], i = bi[2]; br[2] = i; bi[2] = -r; }
    { const float r = br[3], i = bi[3]; br[3] = (i - r) * R; bi[3] = -(i + r) * R; }
    { const float t0r = ar[0] + ar[2], t0i = ai[0] + ai[2], t1r = ar[0] - ar[2], t1i = ai[0] - ai[2], t2r = ar[1] + ar[3], t2i = ai[1] + ai[3], t3r = ai[1] - ai[3], t3i = -(ar[1] - ar[3]);
      Xr[0] = t0r + t2r; Xi[0] = t0i + t2i; Xr[4] = t0r - t2r; Xi[4] = t0i - t2i; Xr[2] = t1r + t3r; Xi[2] = t1i + t3i; Xr[6] = t1r - t3r; Xi[6] = t1i - t3i; }
    { const float t0r = br[0] + br[2], t0i = bi[0] + bi[2], t1r = br[0] - br[2], t1i = bi[0] - bi[2], t2r = br[1] + br[3], t2i = bi[1] + bi[3], t3r = bi[1] - bi[3], t3i = -(br[1] - br[3]);
      Xr[1] = t0r + t2r; Xi[1] = t0i + t2i; Xr[5] = t0r - t2r; Xi[5] = t0i - t2i; Xr[3] = t1r + t3r; Xi[3] = t1i + t3i; Xr[7] = t1r - t3r; Xi[7] = t1i - t3i; }
}
struct EpiZ2 {
    static constexpr bool PERM = true; static constexpr bool DIAG_ONLY = false;
    GAS bf16* Z2; const GAS float* ssq; LAS float* sst; const GAS f32x2* TW; LAS unsigned char* stg;
    __device__ __forceinline__ void operator()(const f32x4 (&acc)[2][2][4][2], const pg8::Unit& u, int wr, int wc, int fr, int fq) const {
        asm volatile("" : "+v"(fr), "+v"(fq));
        const int g = u.pm, batch = u.pn >> 4, a0 = (u.pn & 15) * 32;
        { int tid = (wr * 4 + wc) * 64 + fq * 16 + fr; asm volatile("" : "+v"(tid));
          if (tid < 256) { const int tok = batch * SEQ + a0 + SchedFnA::aoff(tid >> 3) + 512 * (tid & 7); const GAS f32x4* sp = (const GAS f32x4*)(ssq + (size_t)tok * 16); float a = 0.f;
#pragma unroll
              for (int k = 0; k < 4; ++k) { const f32x4 v = sp[k]; a += (v[0] + v[1]) + (v[2] + v[3]); }
              sst[tid] = __builtin_amdgcn_rsqf(a * (1.f / D) + EPS); }
          asm volatile("s_waitcnt lgkmcnt(0)" ::: "memory"); __builtin_amdgcn_s_barrier(); asm volatile("" ::: "memory"); }
        float w1c[2], w1s[2];
#pragma unroll
        for (int bj = 0; bj < 2; ++bj) { const f32x2 t = TW[(a0 + 8 * wc + 4 * bj + fq) * 8 + 1]; w1c[bj] = t.x; w1s[bj] = t.y; }
#pragma unroll
        for (int m = 0; m < 4; ++m) { const int f = g * 128 + wr * 64 + m * 16 + fr;
            unsigned pk[2][8];
#pragma unroll
            for (int bj = 0; bj < 2; ++bj) {
                float zr[8], zi[8], o[16];
                { const LAS f32x4* rp = (const LAS f32x4*)(sst + bj * 128 + wc * 32 + 8 * fq); const f32x4 r0 = rp[0], r1 = rp[1];
                  const float rs[8] = {r0[0], r0[1], r0[2], r0[3], r1[0], r1[1], r1[2], r1[3]};
#pragma unroll
                  for (int bb = 0; bb < 8; ++bb) { zr[bb] = acc[0][bj][m][bb >> 2][bb & 3] * rs[bb]; zi[bb] = acc[1][bj][m][bb >> 2][bb & 3] * rs[bb]; } }
                float Ur[8], Ui[8]; fft8(zr, zi, Ur, Ui);
                float tc = 1.f, ts = 0.f;
#pragma unroll
                for (int kb = 0; kb < 8; ++kb) {
                    o[kb] = Ur[kb] * tc + Ui[kb] * ts; o[8 + kb] = Ui[kb] * tc - Ur[kb] * ts;
                    { const float nc = tc * w1c[bj] - ts * w1s[bj], ns = ts * w1c[bj] + tc * w1s[bj]; tc = nc; ts = ns; } }
#pragma unroll
                for (int k = 0; k < 8; ++k) pk[bj][k] = cvt_pk_bf16(o[2 * k], o[2 * k + 1]);
            }
            u32x4 vec[4];
#pragma unroll
            for (int bj = 0; bj < 2; ++bj)
#pragma unroll
                for (int sp = 0; sp < 2; ++sp) {
                    unsigned g0 = pk[bj][0 + sp], g1 = pk[bj][2 + sp], g2 = pk[bj][4 + sp], g3 = pk[bj][6 + sp];
                    { const auto r_ = __builtin_amdgcn_permlane16_swap(g0, g1, false, false); g0 = r_[0]; g1 = r_[1]; }
                    { const auto r_ = __builtin_amdgcn_permlane16_swap(g2, g3, false, false); g2 = r_[0]; g3 = r_[1]; }
                    { const auto r_ = __builtin_amdgcn_permlane32_swap(g0, g2, false, false); g0 = r_[0]; g2 = r_[1]; }
                    { const auto r_ = __builtin_amdgcn_permlane32_swap(g1, g3, false, false); g1 = r_[0]; g3 = r_[1]; }
                    const unsigned lo01 = __builtin_amdgcn_perm(g1, g0, 0x05040100u), lo23 = __builtin_amdgcn_perm(g3, g2, 0x05040100u);
                    const unsigned hi01 = __builtin_amdgcn_perm(g1, g0, 0x07060302u), hi23 = __builtin_amdgcn_perm(g3, g2, 0x07060302u);
                    vec[2 * sp][2 * bj] = lo01; vec[2 * sp][2 * bj + 1] = lo23; vec[2 * sp + 1][2 * bj] = hi01; vec[2 * sp + 1][2 * bj + 1] = hi23; }
            (void)f;
            { const int tid = (wr * 4 + wc) * 64 + fq * 16 + fr, fl = wr * 16 + fr;
#pragma unroll
              for (int half = 0; half < 2; ++half) {
#pragma unroll
                  for (int j = 0; j < 2; ++j) { const int cq = 2 * fq + j;
                      *(LAS u32x4*)(stg + fl * 512 + (((cq >> 2) << 4) + ((((cq & 3) << 2) | wc) ^ fr)) * 16) = vec[2 * half + j]; }
                  asm volatile("s_waitcnt lgkmcnt(0)" ::: "memory"); __builtin_amdgcn_s_barrier(); asm volatile("" ::: "memory");
#pragma unroll
                  for (int r = 0; r < 2; ++r) { const int i = r * 512 + tid, fl2 = i >> 5, c = i & 31, cq2 = c >> 2, wcx = c & 3;
                      const u32x4 v = *(const LAS u32x4*)(stg + fl2 * 512 + (((cq2 >> 2) << 4) + ((((cq2 & 3) << 2) | wcx) ^ (fl2 & 15))) * 16);
                      const int f2 = g * 128 + (fl2 >> 4) * 64 + m * 16 + (fl2 & 15), q = 4 * (cq2 >> 1) + 2 * half + (cq2 & 1), ri = q >> 3, kb = q & 7;
                      *(GAS u32x4*)(Z2 + ((size_t)(batch * 512 + f2) * 8 + kb) * 1024 + ri * 512 + a0 + 8 * wcx) = v; }
                  asm volatile("s_waitcnt lgkmcnt(0)" ::: "memory"); __builtin_amdgcn_s_barrier(); asm volatile("" ::: "memory");
              } }
        }
    }
};
struct EpiYf {
    static constexpr bool PERM = true; static constexpr bool DIAG_ONLY = false;
    GAS bf16* YF;
    __device__ __forceinline__ void operator()(const f32x4 (&acc)[2][2][4][2], const pg8::Unit& u, int wr, int wc, int fr, int fq) const {
        const int batch = u.pn >> 4, fb = (u.pn >> 1) & 7, kbb = u.pn & 1;
#pragma unroll
        for (int ai = 0; ai < 2; ++ai)
#pragma unroll
            for (int m = 0; m < 4; ++m) { const int ka = u.pm * 256 + ai * 128 + wr * 64 + m * 16 + fr;
#pragma unroll
                for (int bj = 0; bj < 2; ++bj) { const int kb = kbb * 4 + 2 * bj + (wc >> 1), f = fb * 64 + 32 * (wc & 1) + 8 * fq, g = f >> 7, pos = f & 127, sp = 8 * ka + kb;
                    const f32x4 v0 = acc[ai][bj][m][0], v1 = acc[ai][bj][m][1];
                    u32x4 w; w.x = cvt_pk_bf16(v0[0], v0[1]); w.y = cvt_pk_bf16(v0[2], v0[3]); w.z = cvt_pk_bf16(v1[0], v1[1]); w.w = cvt_pk_bf16(v1[2], v1[3]);
                    *(GAS u32x4*)(YF + (size_t)(batch * SEQ + sp) * D + g * 256 + pos) = w;
                    GAS bf16* mp = YF + (size_t)(batch * SEQ + ((SEQ - sp) & (SEQ - 1))) * D + g * 256 + 128 + pos;
                    if (pos != 120) *(GAS u32x4*)mp = w;
                    else { *(GAS u32x2*)mp = (u32x2){w.x, w.y}; *(GAS unsigned*)(mp + 4) = w.z; *(GAS bf16*)(mp + 6) = (bf16)(w.w & 0xffffu); } } }
    }
};
struct EpiMoeDown {
    static constexpr bool PERM = true; static constexpr bool DIAG_ONLY = false;
    GAS bf16* Hres; const GAS int* rowtok; const GAS float* rowgate;
    __device__ __forceinline__ void operator()(const f32x4 (&acc)[2][2][4][2], const pg8::Unit& u, int wr, int wc, int fr, int fq) const {
        asm volatile("" : "+v"(fr), "+v"(fq));
        int tok[8]; float gw[8];
#pragma unroll
        for (int it = 0; it < 8; ++it) { const int row = u.pm * 256 + (it >> 2) * 128 + wr * 64 + (it & 3) * 16 + fr; tok[it] = rowtok[row]; gw[it] = rowgate[row]; }
        const int cofs = u.pn * 256 + wc * 32 + 8 * fq;
        u32x4 bq[4][2];
#pragma unroll
        for (int p = 0; p < 4; ++p) { const GAS bf16* rp = Hres + (size_t)(tok[p] < 0 ? 0 : tok[p]) * D + cofs;
#pragma unroll
            for (int bj = 0; bj < 2; ++bj) bq[p][bj] = *(const GAS u32x4*)(rp + bj * 128); }
#pragma unroll
        for (int it = 0; it < 8; ++it) { const int ai = it >> 2, m = it & 3;
            const u32x4 bcur[2] = {bq[it & 3][0], bq[it & 3][1]};
            if (it + 4 < 8) { const GAS bf16* rp = Hres + (size_t)(tok[it + 4] < 0 ? 0 : tok[it + 4]) * D + cofs;
#pragma unroll
                for (int bj = 0; bj < 2; ++bj) bq[it & 3][bj] = *(const GAS u32x4*)(rp + bj * 128); }
            if (tok[it] >= 0) { GAS bf16* rp = Hres + (size_t)tok[it] * D + cofs; const float g_ = gw[it];
#pragma unroll
                for (int bj = 0; bj < 2; ++bj) { const u32x4 bv = bcur[bj];
                    const f32x4 v0 = (f32x4){bf_lo(bv.x), bf_hi(bv.x), bf_lo(bv.y), bf_hi(bv.y)} + g_ * acc[ai][bj][m][0], v1 = (f32x4){bf_lo(bv.z), bf_hi(bv.z), bf_lo(bv.w), bf_hi(bv.w)} + g_ * acc[ai][bj][m][1];
                    u32x4 w; w.x = cvt_pk_bf16(v0[0], v0[1]); w.y = cvt_pk_bf16(v0[2], v0[3]); w.z = cvt_pk_bf16(v1[0], v1[1]); w.w = cvt_pk_bf16(v1[2], v1[3]);
                    *(GAS u32x4*)(rp + bj * 128) = w; } } }
    }
};

#define XB_TMO      128
#define XB_XCNT(j)  (256  + 64 * (j))
#define XB_XSUB(j)  (1280 + 64 * (j))
#define XB_XGEN(j)  (2304 + 64 * (j))
#define XB_TOP      3328
#define XB_TOPGEN   3392
#define XCD_BAR_WORDS 3456
#define XB_SPIN_CAP (1u << 18)
__device__ __forceinline__ unsigned xb_ld(unsigned* p)              { return __hip_atomic_load(p, __ATOMIC_RELAXED, __HIP_MEMORY_SCOPE_AGENT); }
__device__ __forceinline__ unsigned xb_add(unsigned* p, unsigned v) { return __hip_atomic_fetch_add(p, v, __ATOMIC_RELAXED, __HIP_MEMORY_SCOPE_AGENT); }
__device__ __forceinline__ unsigned xb_xcc_id() { return (unsigned)__builtin_amdgcn_s_getreg((3 << 11) | 20) & 0xFu; }
#define XB_SPIN(cond, bar) do { unsigned _sp = 0; while (cond) { __builtin_amdgcn_s_sleep(1); \
    if ((++_sp & 255u) == 0u) { if (xb_ld(&(bar)[XB_TMO])) break; if (_sp > XB_SPIN_CAP) { atomicAdd(&(bar)[XB_TMO], 1u); break; } } } } while (0)
struct XcdBarrier { unsigned* bar; unsigned x; volatile LAS unsigned* st; };
__device__ __forceinline__ XcdBarrier xcd_barrier_post(unsigned* bar, volatile LAS unsigned* st, const bool t0) {
    XcdBarrier b; b.bar = bar; b.x = xb_xcc_id(); b.st = st;
    if (t0) (void)xb_add(&bar[XB_XCNT(b.x)], 1u);
    return b;
}
__device__ __forceinline__ void xcd_barrier_complete(unsigned* bar, unsigned x, unsigned& nloc, unsigned& nx) {
    const unsigned G = gridDim.x * gridDim.y * gridDim.z;
    unsigned sum, cnt, mine, sp = 0u;
    for (;;) {
        sum = 0u; cnt = 0u; mine = 0u;
#pragma unroll
        for (unsigned j = 0; j < 16; ++j) { const unsigned c = xb_ld(&bar[XB_XCNT(j)]); sum += c; cnt += (c > 0u) ? 1u : 0u; mine = (j == x) ? c : mine; }
        if (sum == G) break;
        __builtin_amdgcn_s_sleep(1);
        if ((++sp & 255u) == 0u) { if (xb_ld(&bar[XB_TMO])) break; if (sp > XB_SPIN_CAP) { atomicAdd(&bar[XB_TMO], 1u); break; } }
    }
    nloc = mine > 0u ? mine : 1u; nx = cnt > 0u ? cnt : 1u;
}
__device__ __forceinline__ void xcd_barrier(const XcdBarrier& b, const bool t0) {
    asm volatile("s_waitcnt vmcnt(0)" ::: "memory");
    __syncthreads();
    if (t0) {
        unsigned* bar = b.bar;
        __builtin_amdgcn_s_waitcnt(0);
        unsigned nloc = b.st[0], nx = b.st[1];
        if (nloc == 0u) { xcd_barrier_complete(bar, b.x, nloc, nx); b.st[0] = nloc; b.st[1] = nx; }
        const unsigned old = xb_add(&bar[XB_XSUB(b.x)], 1u);
        const unsigned gen = old / nloc;
        if (old + 1u == (gen + 1u) * nloc) {
            __builtin_amdgcn_fence(__ATOMIC_RELEASE, "agent");
            asm volatile("s_waitcnt vmcnt(0)" ::: "memory");
            const unsigned og = xb_add(&bar[XB_TOP], 1u);
            const unsigned tg = og / nx;
            if (og + 1u == (tg + 1u) * nx) xb_add(&bar[XB_TOPGEN], 1u);
            else XB_SPIN(xb_ld(&bar[XB_TOPGEN]) == tg, bar);
            __builtin_amdgcn_fence(__ATOMIC_ACQUIRE, "agent");
            xb_add(&bar[XB_XGEN(b.x)], 1u);
            asm volatile("s_waitcnt vmcnt(0)" ::: "memory");
        } else {
            XB_SPIN(xb_ld(&bar[XB_XGEN(b.x)]) == gen, bar);
            __builtin_amdgcn_fence(__ATOMIC_ACQUIRE, "agent");
            asm volatile("s_waitcnt vmcnt(0)" ::: "memory");
        }
    }
    __syncthreads();
}

__device__ __forceinline__ float wave_sum(float v) {
#pragma unroll
    for (int o = 1; o < 64; o <<= 1) v += __shfl_xor(v, o);
    return v;
}
template <int CTRL> __device__ __forceinline__ float dpp_f(float v) { return __builtin_bit_cast(float, __builtin_amdgcn_update_dpp(0, __builtin_bit_cast(int, v), CTRL, 0xf, 0xf, true)); }
__device__ __forceinline__ float wave_sum_valu(float v) {
    v += dpp_f<0xB1>(v);
    v += dpp_f<0x4E>(v);
    v += dpp_f<0x141>(v);
    v += dpp_f<0x140>(v);
    { const unsigned x = __builtin_bit_cast(unsigned, v); const auto r_ = __builtin_amdgcn_permlane16_swap(x, x, false, false); v = __builtin_bit_cast(float, (unsigned)r_[0]) + __builtin_bit_cast(float, (unsigned)r_[1]); }
    { const unsigned x = __builtin_bit_cast(unsigned, v); const auto r_ = __builtin_amdgcn_permlane32_swap(x, x, false, false); v = __builtin_bit_cast(float, (unsigned)r_[0]) + __builtin_bit_cast(float, (unsigned)r_[1]); }
    return v;
}
__device__ __forceinline__ int fnet_chan(int p) { const int g = p >> 8, pp = p & 255; return g * 256 + (pp < 128 ? pp + 1 : pp == 255 ? 0 : 383 - pp); }
__device__ __forceinline__ void transpose_item(const GAS float* W, int K, int N, GAS bf16* WT, int k0, int n0, int rbase, LAS float* scr, int lane, const GAS float* gk = nullptr, bool fperm = false) {
    float wv[32];
#pragma unroll
    for (int i = 0; i < 32; ++i) { const int kk = 2 * i + (lane >> 5); wv[i] = W[(size_t)(fperm ? fnet_chan(k0 + kk) : k0 + kk) * N + n0 + (lane & 31)]; }
    if (gk != nullptr) {
        float gv[32];
#pragma unroll
        for (int i = 0; i < 32; ++i) gv[i] = gk[k0 + 2 * i + (lane >> 5)];
#pragma unroll
        for (int i = 0; i < 32; ++i) wv[i] *= gv[i];
    }
#pragma unroll
    for (int i = 0; i < 32; ++i) scr[(2 * i + (lane >> 5)) * 33 + (lane & 31)] = wv[i];
    LDS_WAIT(); asm volatile("" ::: "memory");
    const int c = lane & 7;
#pragma unroll
    for (int j = 0; j < 4; ++j) { const int n = (lane >> 3) + 8 * j; const LAS float* s = scr + (8 * c) * 33 + n;
        u32x4 o; o.x = cvt_pk_bf16(s[0 * 33], s[1 * 33]); o.y = cvt_pk_bf16(s[2 * 33], s[3 * 33]); o.z = cvt_pk_bf16(s[4 * 33], s[5 * 33]); o.w = cvt_pk_bf16(s[6 * 33], s[7 * 33]);
        *(GAS u32x4*)(WT + (size_t)(rbase + n) * K + k0 + 8 * c) = o; }
    LDS_WAIT(); asm volatile("" ::: "memory");
}
__device__ __forceinline__ void transpose_item8(const GAS float* W, int K, int N, GAS unsigned char* WT8, int k0, int n0, int rbase, float scale, LAS float* scr, int lane) {
    float wv[32];
#pragma unroll
    for (int i = 0; i < 32; ++i) wv[i] = W[(size_t)(k0 + 2 * i + (lane >> 5)) * N + n0 + (lane & 31)];
#pragma unroll
    for (int i = 0; i < 32; ++i) scr[(2 * i + (lane >> 5)) * 33 + (lane & 31)] = wv[i];
    LDS_WAIT(); asm volatile("" ::: "memory");
    const int c = lane & 7;
#pragma unroll
    for (int j = 0; j < 4; ++j) { const int n = (lane >> 3) + 8 * j; const LAS float* sp = scr + (8 * c) * 33 + n;
        u32x2 o; o.x = pk4_fp8(sp[0 * 33] * scale, sp[1 * 33] * scale, sp[2 * 33] * scale, sp[3 * 33] * scale); o.y = pk4_fp8(sp[4 * 33] * scale, sp[5 * 33] * scale, sp[6 * 33] * scale, sp[7 * 33] * scale);
        *(GAS u32x2*)(WT8 + (size_t)(rbase + n) * K + k0 + 8 * c) = o; }
    LDS_WAIT(); asm volatile("" ::: "memory");
}
__device__ __forceinline__ void tr_gu8(const GAS float* Wg, const GAS float* Wu, int K, int N, GAS unsigned char* WT8, int it, LAS float* scr, int lane) {
    const int nblk = N / 32, per = (K / 64) * nblk; const bool up = it >= per; if (up) it -= per;
    const int kb = it / nblk, nb = it - kb * nblk, f0 = 32 * nb;
    transpose_item8(up ? Wu : Wg, K, N, WT8, 64 * kb, f0, 256 * (f0 >> 7) + (up ? 128 : 0) + (f0 & 127), 64.0f, scr, lane);
}
__device__ __forceinline__ void tr_plain(const GAS float* W, int K, int N, GAS bf16* WT, int it, LAS float* scr, int lane, const GAS float* gk = nullptr, bool fperm = false) {
    const int nblk = N / 32, kb = it / nblk, nb = it - kb * nblk; transpose_item(W, K, N, WT, 64 * kb, 32 * nb, 32 * nb, scr, lane, gk, fperm);
}
__device__ __forceinline__ void tr_gu(const GAS float* Wg, const GAS float* Wu, int K, int N, GAS bf16* WT, int it, LAS float* scr, int lane, const GAS float* gk = nullptr) {
    const int nblk = N / 32, per = (K / 64) * nblk; const bool up = it >= per; if (up) it -= per;
    const int kb = it / nblk, nb = it - kb * nblk, f0 = 32 * nb;
    transpose_item(up ? Wu : Wg, K, N, WT, 64 * kb, f0, 256 * (f0 >> 7) + (up ? 128 : 0) + (f0 & 127), scr, lane, gk);
}
__device__ __forceinline__ void rms_row(const GAS float* xrow, const GAS float* g, GAS bf16* orow, int lane, f32x4 (&v)[4]) {
    const GAS f32x4* xr = (const GAS f32x4*)xrow + lane; const GAS f32x4* gr = (const GAS f32x4*)g + lane;
    float s = 0.f;
#pragma unroll
    for (int j = 0; j < 4; ++j) { v[j] = xr[64 * j]; s += (v[j].x * v[j].x + v[j].y * v[j].y) + (v[j].z * v[j].z + v[j].w * v[j].w); }
    const float r = 1.0f / sqrtf(wave_sum(s) * (1.f / D) + EPS);
    GAS u32x2* o8 = (GAS u32x2*)orow + lane;
#pragma unroll
    for (int j = 0; j < 4; ++j) { v[j] = v[j] * r * gr[64 * j]; u32x2 w; w.x = cvt_pk_bf16(v[j].x, v[j].y); w.y = cvt_pk_bf16(v[j].z, v[j].w); o8[64 * j] = w; }
}
__device__ __forceinline__ void xb_row(const GAS float* xrow, GAS bf16* orow, GAS float* rout, int lane) {
    const GAS f32x4* xr = (const GAS f32x4*)xrow + lane; f32x4 v[4]; float s = 0.f;
#pragma unroll
    for (int j = 0; j < 4; ++j) { v[j] = xr[64 * j]; s += (v[j].x * v[j].x + v[j].y * v[j].y) + (v[j].z * v[j].z + v[j].w * v[j].w); }
    GAS u32x2* o8 = (GAS u32x2*)orow + lane;
#pragma unroll
    for (int j = 0; j < 4; ++j) { u32x2 w; w.x = cvt_pk_bf16(v[j].x, v[j].y); w.y = cvt_pk_bf16(v[j].z, v[j].w); o8[64 * j] = w; }
    const float r = 1.0f / sqrtf(wave_sum(s) * (1.f / D) + EPS);
    if (lane == 0) *rout = r;
}
__device__ __forceinline__ int rmsb_col(int j, int lane) { return 512 * (j >> 1) + 8 * lane + 4 * (j & 1); }
__device__ __forceinline__ void rms_row_b(const GAS bf16* hrow, const GAS float* g, GAS bf16* orow, int lane, f32x4 (&v)[4]) {
    float s = 0.f;
#pragma unroll
    for (int jh = 0; jh < 2; ++jh) { const u32x4 x = *(const GAS u32x4*)(hrow + 512 * jh + 8 * lane);
        v[2 * jh] = (f32x4){bf_lo(x.x), bf_hi(x.x), bf_lo(x.y), bf_hi(x.y)}; v[2 * jh + 1] = (f32x4){bf_lo(x.z), bf_hi(x.z), bf_lo(x.w), bf_hi(x.w)}; }
#pragma unroll
    for (int j = 0; j < 4; ++j) s += (v[j].x * v[j].x + v[j].y * v[j].y) + (v[j].z * v[j].z + v[j].w * v[j].w);
    const float r = 1.0f / sqrtf(wave_sum(s) * (1.f / D) + EPS);
#pragma unroll
    for (int jh = 0; jh < 2; ++jh) { const GAS float* gp = g + 512 * jh + 8 * lane; v[2 * jh] = v[2 * jh] * r * *(const GAS f32x4*)gp; v[2 * jh + 1] = v[2 * jh + 1] * r * *(const GAS f32x4*)(gp + 4);
        u32x4 w; w.x = cvt_pk_bf16(v[2 * jh].x, v[2 * jh].y); w.y = cvt_pk_bf16(v[2 * jh].z, v[2 * jh].w); w.z = cvt_pk_bf16(v[2 * jh + 1].x, v[2 * jh + 1].y); w.w = cvt_pk_bf16(v[2 * jh + 1].z, v[2 * jh + 1].w);
        *(GAS u32x4*)(orow + 512 * jh + 8 * lane) = w; }
}

__device__ __forceinline__ void rms_row_b8(const GAS bf16* hrow, const GAS float* g, GAS unsigned char* o8, int lane, f32x4 (&v)[4]) {
    float s = 0.f;
#pragma unroll
    for (int jh = 0; jh < 2; ++jh) { const u32x4 x = *(const GAS u32x4*)(hrow + 512 * jh + 8 * lane);
        v[2 * jh] = (f32x4){bf_lo(x.x), bf_hi(x.x), bf_lo(x.y), bf_hi(x.y)}; v[2 * jh + 1] = (f32x4){bf_lo(x.z), bf_hi(x.z), bf_lo(x.w), bf_hi(x.w)}; }
#pragma unroll
    for (int j = 0; j < 4; ++j) s += (v[j].x * v[j].x + v[j].y * v[j].y) + (v[j].z * v[j].z + v[j].w * v[j].w);
    const float r = 1.0f / sqrtf(wave_sum(s) * (1.f / D) + EPS);
#pragma unroll
    for (int jh = 0; jh < 2; ++jh) { const GAS float* gp = g + 512 * jh + 8 * lane; v[2 * jh] = v[2 * jh] * r * *(const GAS f32x4*)gp; v[2 * jh + 1] = v[2 * jh + 1] * r * *(const GAS f32x4*)(gp + 4);
        u32x2 w; w.x = pk4_fp8(v[2 * jh].x, v[2 * jh].y, v[2 * jh].z, v[2 * jh].w); w.y = pk4_fp8(v[2 * jh + 1].x, v[2 * jh + 1].y, v[2 * jh + 1].z, v[2 * jh + 1].w);
        *(GAS u32x2*)(o8 + 512 * jh + 8 * lane) = w; }
}

constexpr int SW_QL = 0, SW_SPITCH = 528, SW_SL = 128 * 528, SW_VPITCH = 272, SW_VL = SW_SL + 64 * SW_SPITCH, SW_VB = 64 * SW_VPITCH;
static_assert(SW_VL + 2 * SW_VB <= 139264, "sweep LDS");
__device__ __forceinline__ u32x4 scale_v8(u32x4 x, float z0, float rt) {
    u32x4 o; float z = z0;
    { const float a = bf_lo(x.x) * z; z *= rt; const float b_ = bf_hi(x.x) * z; z *= rt; o.x = cvt_pk_bf16(a, b_); }
    { const float a = bf_lo(x.y) * z; z *= rt; const float b_ = bf_hi(x.y) * z; z *= rt; o.y = cvt_pk_bf16(a, b_); }
    { const float a = bf_lo(x.z) * z; z *= rt; const float b_ = bf_hi(x.z) * z; z *= rt; o.z = cvt_pk_bf16(a, b_); }
    { const float a = bf_lo(x.w) * z; z *= rt; const float b_ = bf_hi(x.w) * z; o.w = cvt_pk_bf16(a, b_); }
    return o;
}
template <bool OUT> __device__ __forceinline__ void sweep_role(LAS unsigned char* lds, const GAS bf16* Qg, const GAS bf16* KTFg, const GAS bf16* KTBg, const GAS bf16* VTg, const GAS bf16* PCg, const GAS bf16* PDg, const GAS bf16* ZEROg, GAS bf16* Yg, GAS f32x2* statp, const float l2f, const float l2b, int b, int h, int es, const int wave_s) {
    const int tid = tid_of(wave_s);
    const int w = __builtin_amdgcn_readfirstlane(tid >> 6), lane = tid & 63, r32 = lane & 31, hh = lane >> 5;
    const int rb = w & 3;
    const int vrow = tid >> 4, vpc = tid & 15;
    const int qrow = tid >> 5, qpc = tid & 31;
    const GAS bf16* qp = Qg + (size_t)(b * SEQ + qrow) * QKW + h * DK + 8 * qpc;
    const GAS bf16* vtp = VTg + (size_t)(h * DV + 64 * es + vrow) * T + 8 * vpc; const int vrot = b * SEQ + ((vrow & 15) << 11);
    const int il = 32 * rb + r32;
    const GAS bf16* pcp = PCg + (((size_t)((b * NH + h) * NCH) * 4 + rb) * 8) * 512 + lane * 8;
    const GAS bf16* pdp = PDg + (((size_t)((b * NH + h) * NCH) * 4 + rb) * 2) * 512 + lane * 8;
    GAS bf16* yp = Yg + ((size_t)(((b * SEQ) >> 5) + rb) * NH + h) * 8 * 2048 + (size_t)es * 2048 + lane * 8;
    GAS f32x2* stp = statp + ((size_t)(b * SEQ + il) * NH + h) * 8 + es;
    const size_t kto = ((size_t)((b * NH + h) * NCH) * 8 + 2 * rb) * 8 * 512 + lane * 8;
#define SW_LDP(dst, s_, d_, nn_) do { const int jb_ = (s_) >> 1; const bool use_ = (d_) ? (jb_ >= rb) : (jb_ <= rb); const bool dg_ = (d_) && (jb_ == rb); \
        const GAS bf16* src_ = dg_ ? (pdp + (size_t)(nn_) * 4096 + 512 * ((s_) & 1)) : (pcp + (size_t)(nn_) * (CH * CH) + 512 * (s_)); \
        dst = *(const GAS bf16x8*)(use_ ? src_ : ZEROg); } while (0)
#define SW_SCHED do {} while (0)
#define SW_MFMA(a, b, c) c = __builtin_amdgcn_mfma_f32_32x32x16_bf16(a, b, c, 0, 0, 0)
    bf16x8 pa[8];
    bf16x8 ka[2][8];
    u32x4 vv[2], qv[4];
    f32x16 Sacc[2][2];
    if constexpr (OUT) {
#pragma unroll
        for (int s = 0; s < 8; ++s) SW_LDP(pa[s], s, 0, 0);
    } else {
#pragma unroll
        for (int db = 0; db < 2; ++db)
#pragma unroll
            for (int s = 0; s < 8; ++s) ka[db][s] = *(const GAS bf16x8*)(KTFg + kto + db * 4096 + s * 512);
#pragma unroll
        for (int db = 0; db < 2; ++db)
#pragma unroll
            for (int et = 0; et < 2; ++et)
#pragma unroll
                for (int t = 0; t < 16; ++t) Sacc[db][et][t] = 0.f;
    }
#pragma unroll
    for (int it = 0; it < 2; ++it) vv[it] = *(const GAS u32x4*)(vtp + (size_t)(32 * it) * T + (vrot & (T - 1)));
#pragma unroll
    for (int it = 0; it < 2; ++it) *(LAS u32x4*)(lds + SW_VL + (vrow + 32 * it) * SW_VPITCH + vpc * 16) = scale_v8(vv[it], fast_exp2((float)(CH - 1 - 8 * vpc) * l2f), fast_exp2(-l2f));
#pragma unroll
    for (int hf = 0; hf < 2; ++hf) {
#pragma unroll
        for (int it = 0; it < 4; ++it) qv[it] = *(const GAS u32x4*)(qp + (size_t)(16 * (4 * hf + it)) * QKW);
#pragma unroll
        for (int it = 0; it < 4; ++it) { const int row = qrow + 16 * (4 * hf + it); *(LAS u32x4*)(lds + SW_QL + row * SW_SPITCH + qpc * 16) = qv[it]; }
    }
    const int sl_rd = SW_SL + r32 * SW_SPITCH + 16 * hh;
    const int q_rd = SW_QL + il * SW_SPITCH + 16 * hh;
#pragma unroll 1
    for (int p = 0; p < 2 * NCH; ++p) {
        const int dir = p >> 5, st = p & 31, n = dir ? NCH - 1 - st : st;
        const int pn = p + 1 < 2 * NCH ? p + 1 : p, dirn = pn >> 5, stn = pn & 31, nn = dirn ? NCH - 1 - stn : stn;
        const int cur = p & 1;
        const float l2 = dir ? l2b : l2f;
        const int v_rd = SW_VL + cur * SW_VB + r32 * SW_VPITCH + 16 * hh;
        if constexpr (!OUT) {
#pragma unroll
            for (int db = 0; db < 2; ++db)
#pragma unroll
                for (int et = 0; et < 2; ++et)
#pragma unroll
                    for (int g = 0; g < 4; ++g) { u32x2 pk; pk.x = cvt_pk_bf16(Sacc[db][et][4 * g], Sacc[db][et][4 * g + 1]); pk.y = cvt_pk_bf16(Sacc[db][et][4 * g + 2], Sacc[db][et][4 * g + 3]);
                        if (st == 0) { pk.x = 0u; pk.y = 0u; }
                        *(LAS u32x2*)(lds + SW_SL + (32 * et + r32) * SW_SPITCH + (64 * rb + 32 * db + 8 * g + 4 * hh) * 2) = pk; }
        }
#pragma unroll
        for (int it = 0; it < 2; ++it) vv[it] = *(const GAS u32x4*)(vtp + (size_t)(32 * it) * T + ((nn * CH + vrot) & (T - 1)));
#pragma unroll
        for (int it = 0; it < 4; ++it) qv[it] = *(const GAS u32x4*)(qp + (size_t)(nn * CH + 16 * it) * QKW);
        __syncthreads();
        f32x16 O[2];
        u32x4 yf[4];
        GAS bf16* ypn = yp + (size_t)(n * 4) * (NH * 8 * 2048);
        if constexpr (OUT) {
#pragma unroll
            for (int et = 0; et < 2; ++et)
#pragma unroll
                for (int t = 0; t < 16; ++t) O[et][t] = 0.f;
            bf16x8 qx[2], s0x[2], s1x[2], qy[2], s0y[2], s1y[2];
#define SW_LDC(dq, d0, d1, g2) do { _Pragma("unroll") for (int k = 0; k < 2; ++k) { const int ks = 2 * (g2) + k; dq[k] = *(const LAS bf16x8*)(lds + q_rd + 32 * ks); \
                d0[k] = *(const LAS bf16x8*)(lds + sl_rd + 32 * ks); d1[k] = *(const LAS bf16x8*)(lds + sl_rd + 32 * SW_SPITCH + 32 * ks); } } while (0)
#define SW_MMC(dq, d0, d1) do { SW_MFMA(d0[0], dq[0], O[0]); SW_MFMA(d1[0], dq[0], O[1]); SW_MFMA(d0[1], dq[1], O[0]); SW_MFMA(d1[1], dq[1], O[1]); } while (0)
            SW_LDC(qx, s0x, s1x, 0); SW_LDC(qy, s0y, s1y, 1); SW_SCHED;
            SW_MMC(qx, s0x, s1x); SW_SCHED; SW_LDC(qx, s0x, s1x, 2); SW_SCHED;
            SW_MMC(qy, s0y, s1y); SW_SCHED; SW_LDC(qy, s0y, s1y, 3); SW_SCHED;
            SW_MMC(qx, s0x, s1x); SW_SCHED; SW_LDC(qx, s0x, s1x, 4); SW_SCHED;
            SW_MMC(qy, s0y, s1y); SW_SCHED; SW_LDC(qy, s0y, s1y, 5); SW_SCHED;
            SW_MMC(qx, s0x, s1x); SW_SCHED; SW_LDC(qx, s0x, s1x, 6); SW_SCHED;
            SW_MMC(qy, s0y, s1y); SW_SCHED; SW_LDC(qy, s0y, s1y, 7); SW_SCHED;
            SW_MMC(qx, s0x, s1x); SW_SCHED;
            SW_MMC(qy, s0y, s1y); SW_SCHED;
#undef SW_LDC
#undef SW_MMC
        } else {
            const float gC = st == 0 ? 0.f : fast_exp2((float)CH * l2);
#pragma unroll
            for (int db = 0; db < 2; ++db)
#pragma unroll
                for (int et = 0; et < 2; ++et)
#pragma unroll
                    for (int t = 0; t < 16; ++t) Sacc[db][et][t] *= gC;
            bf16x8 v0x[2], v1x[2], v0y[2], v1y[2];
#define SW_LDU(d0, d1, g2) do { _Pragma("unroll") for (int k = 0; k < 2; ++k) { const int s_ = 2 * (g2) + k; d0[k] = *(const LAS bf16x8*)(lds + v_rd + 32 * s_); d1[k] = *(const LAS bf16x8*)(lds + v_rd + 32 * SW_VPITCH + 32 * s_); } } while (0)
#define SW_MMU(d0, d1, g2) do { _Pragma("unroll") for (int k = 0; k < 2; ++k) { const int s_ = 2 * (g2) + k; SW_MFMA(ka[0][s_], d0[k], Sacc[0][0]); SW_MFMA(ka[0][s_], d1[k], Sacc[0][1]); SW_MFMA(ka[1][s_], d0[k], Sacc[1][0]); SW_MFMA(ka[1][s_], d1[k], Sacc[1][1]); } } while (0)
            SW_LDU(v0x, v1x, 0); SW_LDU(v0y, v1y, 1); SW_SCHED;
            SW_MMU(v0x, v1x, 0); SW_SCHED; SW_LDU(v0x, v1x, 2); SW_SCHED;
            SW_MMU(v0y, v1y, 1); SW_SCHED; SW_LDU(v0y, v1y, 3); SW_SCHED;
            SW_MMU(v0x, v1x, 2); SW_SCHED;
            SW_MMU(v0y, v1y, 3); SW_SCHED;
#undef SW_LDU
#undef SW_MMU
        }
        __syncthreads();
#pragma unroll
        for (int it = 0; it < 4; ++it) { const int row = qrow + 16 * it; *(LAS u32x4*)(lds + SW_QL + row * SW_SPITCH + qpc * 16) = qv[it]; }
#pragma unroll
        for (int it = 0; it < 4; ++it) qv[it] = *(const GAS u32x4*)(qp + (size_t)(nn * CH + 16 * (4 + it)) * QKW);
        if constexpr (OUT) {
            if (dir) {
#pragma unroll
                for (int q = 0; q < 4; ++q) yf[q] = *(const GAS u32x4*)(ypn + q * 512);
            }
            const float xi = fast_exp2((float)(dir == 0 ? (il + 1) : (CH - il)) * l2);
#pragma unroll
            for (int et = 0; et < 2; ++et)
#pragma unroll
                for (int t = 0; t < 16; ++t) O[et][t] *= xi;
            bf16x8 v0x[2], v1x[2], v0y[2], v1y[2];
#define SW_LDV(d0, d1, g2) do { _Pragma("unroll") for (int k = 0; k < 2; ++k) { const int s_ = 2 * (g2) + k; d0[k] = *(const LAS bf16x8*)(lds + v_rd + 32 * s_); d1[k] = *(const LAS bf16x8*)(lds + v_rd + 32 * SW_VPITCH + 32 * s_); } } while (0)
#define SW_MMV(d0, d1, g2) do { _Pragma("unroll") for (int k = 0; k < 2; ++k) { const int s_ = 2 * (g2) + k; SW_MFMA(d0[k], pa[s_], O[0]); SW_MFMA(d1[k], pa[s_], O[1]); } } while (0)
            SW_LDV(v0x, v1x, 0); SW_LDV(v0y, v1y, 1); SW_SCHED;
            SW_MMV(v0x, v1x, 0); SW_SCHED; SW_LDV(v0x, v1x, 2); SW_SCHED;
            SW_MMV(v0y, v1y, 1); SW_SCHED; SW_LDV(v0y, v1y, 3); SW_SCHED;
            SW_MMV(v0x, v1x, 2); SW_SCHED;
            SW_MMV(v0y, v1y, 3); SW_SCHED;
#undef SW_LDV
#undef SW_MMV
#pragma unroll
            for (int s = 0; s < 8; ++s) SW_LDP(pa[s], s, dirn, nn);
        } else {
            const GAS bf16* ktn = (dirn ? KTBg : KTFg) + kto + (size_t)nn * 32768;
#pragma unroll
            for (int db = 0; db < 2; ++db)
#pragma unroll
                for (int s = 0; s < 8; ++s) ka[db][s] = *(const GAS bf16x8*)(ktn + db * 4096 + s * 512);
        }
        { const float z0 = dirn ? fast_exp2((float)(8 * vpc) * l2b) : fast_exp2((float)(CH - 1 - 8 * vpc) * l2f), rt = fast_exp2(dirn ? l2b : -l2f);
#pragma unroll
        for (int it = 0; it < 2; ++it) *(LAS u32x4*)(lds + SW_VL + (cur ^ 1) * SW_VB + (vrow + 32 * it) * SW_VPITCH + vpc * 16) = scale_v8(vv[it], z0, rt); }
#pragma unroll
        for (int it = 0; it < 4; ++it) { const int row = qrow + 16 * (4 + it); *(LAS u32x4*)(lds + SW_QL + row * SW_SPITCH + qpc * 16) = qv[it]; }
        if constexpr (OUT) {
            float s1 = 0.f, s2 = 0.f;
#pragma unroll
            for (int et = 0; et < 2; ++et)
#pragma unroll
                for (int kp = 0; kp < 2; ++kp) {
                    float ya[4], yb[4];
#pragma unroll
                    for (int q = 0; q < 4; ++q) { ya[q] = O[et][8 * kp + q]; yb[q] = O[et][8 * kp + 4 + q]; }
                    if (dir) {
                        u32x4 f = yf[et * 2 + kp];
                        { const auto r0 = __builtin_amdgcn_permlane32_swap(f.x, f.z, false, false); f.x = r0[0]; f.z = r0[1]; const auto r1 = __builtin_amdgcn_permlane32_swap(f.y, f.w, false, false); f.y = r1[0]; f.w = r1[1]; }
                        ya[0] += bf_lo(f.x); ya[1] += bf_hi(f.x); ya[2] += bf_lo(f.y); ya[3] += bf_hi(f.y); yb[0] += bf_lo(f.z); yb[1] += bf_hi(f.z); yb[2] += bf_lo(f.w); yb[3] += bf_hi(f.w);
#pragma unroll
                        for (int q = 0; q < 4; ++q) { s1 += ya[q] + yb[q]; s2 += ya[q] * ya[q] + yb[q] * yb[q]; }
                    }
                    u32x4 o; o.x = cvt_pk_bf16(ya[0], ya[1]); o.y = cvt_pk_bf16(ya[2], ya[3]); o.z = cvt_pk_bf16(yb[0], yb[1]); o.w = cvt_pk_bf16(yb[2], yb[3]);
                    { const auto r0 = __builtin_amdgcn_permlane32_swap(o.x, o.z, false, false); o.x = r0[0]; o.z = r0[1]; const auto r1 = __builtin_amdgcn_permlane32_swap(o.y, o.w, false, false); o.y = r1[0]; o.w = r1[1]; }
                    *(GAS u32x4*)(ypn + (et * 2 + kp) * 512) = o;
                }
            if (dir) { s1 += __shfl_xor(s1, 32); s2 += __shfl_xor(s2, 32);
                if (hh == 0) stp[(size_t)(n * CH) * (NH * 8)] = (f32x2){s1, s2}; }
        }
    }
#undef SW_LDP
#undef SW_SCHED
#undef SW_MFMA
    VM_WAIT();
    __syncthreads();
}

__device__ __forceinline__ void sweep_unit(LAS unsigned char* lds, const GAS bf16* Qg, const GAS bf16* KTFg, const GAS bf16* KTBg, const GAS bf16* VTg, const GAS bf16* PCg, const GAS bf16* PDg, const GAS bf16* ZEROg, GAS bf16* Yg, GAS f32x2* statp, const float l2f, const float l2b, int b, int h, int es, const int wave_s) {
    int ws_ = wave_s; asm volatile("" : "+s"(ws_));
    if (ws_ < 4) sweep_role<true>(lds, Qg, KTFg, KTBg, VTg, PCg, PDg, ZEROg, Yg, statp, l2f, l2b, b, h, es, wave_s);
    else sweep_role<false>(lds, Qg, KTFg, KTBg, VTg, PCg, PDg, ZEROg, Yg, statp, l2f, l2b, b, h, es, wave_s);
}

struct Args { const float* in[16]; float* out; unsigned char* ws; };
constexpr int NWAVES = 8;
#ifndef PHMASK
#define PHMASK 0xFFFFFFFFu
#endif
#define PH(k) (((PHMASK) >> (k)) & 1u)
__global__ void __launch_bounds__(NWAVES * 64, 2) fwd_kernel(Args args) {
    extern __shared__ __attribute__((aligned(16))) unsigned char lds_raw[];
    LAS unsigned char* lds = (LAS unsigned char*)lds_raw;
    LAS float* l2g = (LAS float*)(lds + LDSCTL_OFF + 64);
    const int wave_k = __builtin_amdgcn_readfirstlane((int)threadIdx.x >> 6);
#define PHASE_VARS \
    const int tid = tid_of(wave_k); const int lane = tid & 63; int wave = wave_k; asm volatile("" : "+s"(wave)); \
    const __attribute__((address_space(4))) Args* ka = (const __attribute__((address_space(4))) Args*)__builtin_amdgcn_kernarg_segment_ptr(); asm volatile("" : "+s"(ka)); \
    const int G = gridDim.x, bx = blockIdx.x; const int vcu = (G % 8 == 0) ? (bx % 8) * (G / 8) + bx / 8 : bx; const int gw = vcu * NWAVES + wave, NGW = G * NWAVES; \
    GAS unsigned char* ws = (GAS unsigned char*)ka->ws; asm volatile("" : "+s"(ws)); GAS float* hres = (GAS float*)ka->out; (void)lane; (void)gw; (void)NGW; (void)vcu; (void)hres; \
    const GAS float* x = (const GAS float*)ka->in[0]; const GAS float* mix_norm = (const GAS float*)ka->in[1]; const GAS float* ffn_norm = (const GAS float*)ka->in[2]; const GAS float* ret_w_in = (const GAS float*)ka->in[3]; const GAS float* ret_decay = (const GAS float*)ka->in[4]; \
    const GAS float* gn_gain = (const GAS float*)ka->in[5]; const GAS float* ret_w_out = (const GAS float*)ka->in[6]; const GAS float* d_wg = (const GAS float*)ka->in[7]; const GAS float* d_wu = (const GAS float*)ka->in[8]; const GAS float* d_wd = (const GAS float*)ka->in[9]; \
    const GAS float* fnet_w = (const GAS float*)ka->in[10]; const GAS float* moe_router = (const GAS float*)ka->in[11]; const GAS float* m_wg = (const GAS float*)ka->in[12]; const GAS float* m_wu = (const GAS float*)ka->in[13]; const GAS float* m_wd = (const GAS float*)ka->in[14]; const GAS float* final_norm = (const GAS float*)ka->in[15]; \
    (void)x; (void)mix_norm; (void)ffn_norm; (void)ret_w_in; (void)ret_decay; (void)gn_gain; (void)ret_w_out; (void)d_wg; (void)d_wu; (void)d_wd; (void)fnet_w; (void)moe_router; (void)m_wg; (void)m_wu; (void)m_wd; (void)final_norm; \
    GAS f32x2* rot = (GAS f32x2*)(ws + WS_ROT); GAS f32x2* rotT = (GAS f32x2*)(ws + WS_ROTT); GAS bf16* WC = (GAS bf16*)(ws + WS_STATS); GAS float* R0 = (GAS float*)(ws + WS_R0); (void)R0; GAS f32x2* TWT = (GAS f32x2*)(ws + WS_TW); (void)TWT; GAS float* SSQ1 = (GAS float*)(ws + WS_SSQ1); GAS float* SSQ2 = (GAS float*)(ws + WS_SSQ2); (void)SSQ1; (void)SSQ2; \
    GAS int* toke = (GAS int*)(ws + WS_TOKE); GAS float* tokw = (GAS float*)(ws + WS_TOKW); GAS int* bcnt = (GAS int*)(ws + WS_BCNT); GAS int* pcnt = (GAS int*)(ws + WS_PCNT); (void)pcnt; GAS int* rowtok = (GAS int*)(ws + WS_ROWTOK); GAS float* rowgate = (GAS float*)(ws + WS_ROWGATE); \
    GAS f32x2* statp = (GAS f32x2*)(ws + WS_STATP); \
    GAS bf16* WIN = (GAS bf16*)(ws + WS_WIN); GAS bf16* WO = (GAS bf16*)(ws + WS_WO); GAS bf16* WGU = (GAS bf16*)(ws + WS_WGU); GAS bf16* WD = (GAS bf16*)(ws + WS_WD); GAS bf16* WF = (GAS bf16*)(ws + WS_WF); \
    GAS bf16* HN = (GAS bf16*)(ws + WS_HN); GAS bf16* Qb = (GAS bf16*)(ws + WS_Q); GAS bf16* Kb = (GAS bf16*)(ws + WS_K); GAS bf16* KT = (GAS bf16*)(ws + WS_KT); GAS bf16* VT = (GAS bf16*)(ws + WS_VT); GAS bf16* PC = (GAS bf16*)(ws + WS_PC); \
    GAS bf16* HB = (GAS bf16*)(ws + WS_HN); GAS bf16* HNB = (GAS bf16*)ka->out; (void)HB; (void)HNB; \
    GAS unsigned char* HN8 = (GAS unsigned char*)ka->out + 64 * MiB; GAS unsigned char* WMGU8 = (GAS unsigned char*)(ws + WS_WMGU); (void)HN8; (void)WMGU8;     \
    GAS bf16* Yb = (GAS bf16*)ka->out; GAS bf16* YG = (GAS bf16*)(ws + WS_YG); GAS bf16* ACTD = (GAS bf16*)(ws + WS_ACTD); GAS bf16* Z2 = (GAS bf16*)(ws + WS_Z2); GAS bf16* WSEQ = (GAS bf16*)(ws + WS_WSEQ); \
    GAS bf16* ACTM = (GAS bf16*)(ws + WS_ACTM); GAS bf16* WMGU = (GAS bf16*)(ws + WS_WMGU); GAS bf16* WMD = (GAS bf16*)(ws + WS_WMD); \
    (void)rot; (void)rotT; (void)WC; (void)toke; (void)tokw; (void)bcnt; (void)rowtok; (void)rowgate; (void)statp; (void)WIN; (void)WO; (void)WGU; (void)WD; (void)WF; (void)HN; (void)Qb; (void)Kb; (void)KT; (void)VT; (void)PC; \
    (void)Yb; (void)YG; (void)ACTD; (void)Z2; (void)WSEQ; (void)ACTM; (void)WMGU; (void)WMD;
#define GRID_BAR() do { const __attribute__((address_space(4))) Args* kb = (const __attribute__((address_space(4))) Args*)__builtin_amdgcn_kernarg_segment_ptr(); asm volatile("" : "+s"(kb)); GAS unsigned char* wsb = (GAS unsigned char*)kb->ws; XcdBarrier bar_; bar_.bar = (unsigned*)(wsb + WS_CTL) + CW_BAR; bar_.x = xb_xcc_id(); \
    bar_.st = (volatile LAS unsigned*)(lds + MISC_OFF) + 8; xcd_barrier(bar_, tid_of(wave_k) == 0); } while (0)

    {
        PHASE_VARS
        for (int u = tid; u < (LDS_BYTES - LDSCTL_OFF) / 4; u += NWAVES * 64) ((LAS unsigned*)(lds + LDSCTL_OFF))[u] = 0u;
        __syncthreads();
        if (tid < 8) { const float xl = ret_decay[tid]; const float ls = fminf(xl, 0.f) - log1pf(expf(-fabsf(xl))); l2g[tid] = ls * 1.44269504088896341f; }
        __syncthreads();
        (void)xcd_barrier_post((unsigned*)(ws + WS_CTL) + CW_BAR, (volatile LAS unsigned*)(lds + MISC_OFF) + 8, tid == 0);
    }

    if (PH(0)) {
        PHASE_VARS
        LAS float* scr = (LAS float*)(lds + wave * 16384);
        constexpr int I_IN = (D / 64) * (INW / 32), I_O = (VW / 64) * (D / 32), I_GU = 2 * (D / 64) * (FFD / 32), I_D = (FFD / 64) * (D / 32), I_F = (D / 64) * (D / 32);
        constexpr int NITEMS = I_IN + I_O + I_GU + I_D + I_F;
        for (int it = gw; it < NITEMS; it += NGW) {
            int r = it;
            if (r < I_IN) { tr_plain(ret_w_in, D, INW, WIN, r, scr, lane, mix_norm); continue; } r -= I_IN;
            if (r < I_O) { tr_plain(ret_w_out, VW, D, WO, r, scr, lane); continue; } r -= I_O;
            if (r < I_GU) { tr_gu(d_wg, d_wu, D, FFD, WGU, r, scr, lane, ffn_norm); continue; } r -= I_GU;
            if (r < I_D) { const int nblk = D / 32, kb = r / nblk, nb = r - kb * nblk; transpose_item8(d_wd, FFD, D, (GAS unsigned char*)WD, 64 * kb, 32 * nb, 32 * nb, 64.0f, scr, lane); continue; } r -= I_D;
            tr_plain(fnet_w, D, D, WF, r, scr, lane, nullptr, true);
        }
        for (int e = (vcu * 512 + tid); e < SEQ * 128; e += G * 512) { const int s = e >> 7, i = e & 127;
            const float inv = powf(10000.0f, -(float)i / 128.0f); const float ang = (float)s * inv; float sn, cs; sincosf(ang, &sn, &cs);
            ((GAS float*)rot)[(size_t)s * 256 + i] = cs; ((GAS float*)rot)[(size_t)s * 256 + 128 + i] = sn; }
        for (int e = (vcu * 512 + tid); e < 4 * 256 * 256; e += G * 512) { const int g = e >> 16, r = (e >> 8) & 255, c = e & 255, mm = (((r & 127) + 1) * c) & 255;
            const float v = ((r >> 7) == 0 ? cospif((float)mm * (1.0f / 128.0f)) : -sinpif((float)mm * (1.0f / 128.0f))) * mix_norm[D + g * 256 + c]; WC[e] = (bf16)(cvt_pk_bf16(v, 0.f) & 0xffffu); }
        for (int e = vcu * 512 + tid; e < 512 * 8; e += G * 512) { const float ang = (float)(((e >> 3) * (e & 7)) & 4095) * (1.0f / 2048.0f); TWT[e] = (f32x2){cospif(ang), sinpif(ang)}; }
        for (int e = vcu * 512 + tid; e < 512 * 1024; e += G * 512) { const int ka = e >> 10, c = e & 1023, a = c & 511, mm = (a * ka) & 511;
            const float v = (c < 512 ? cospif((float)mm * (1.0f / 256.0f)) : sinpif((float)mm * (1.0f / 256.0f))) * (1.0f / 1024.0f); WSEQ[e] = (bf16)(cvt_pk_bf16(v, 0.f) & 0xffffu); }
        {
            f32x4 xq[2][4];
#pragma unroll
            for (int p = 0; p < 2; ++p) { const int mp = gw + p * NGW < T ? gw + p * NGW : gw; const GAS f32x4* xr = (const GAS f32x4*)(x + (size_t)mp * D) + lane;
#pragma unroll
                for (int j = 0; j < 4; ++j) xq[p][j] = xr[64 * j]; }
            for (int m = gw; m < T; m += 2 * NGW) {
#pragma unroll
                for (int p = 0; p < 2; ++p) { const int mc = m + p * NGW;
                    if (mc < T) {
                        f32x4 v[4]; float s = 0.f;
#pragma unroll
                        for (int j = 0; j < 4; ++j) { v[j] = xq[p][j]; s += (v[j].x * v[j].x + v[j].y * v[j].y) + (v[j].z * v[j].z + v[j].w * v[j].w); }
                        { const int mn = mc + 2 * NGW < T ? mc + 2 * NGW : mc; const GAS f32x4* xr = (const GAS f32x4*)(x + (size_t)mn * D) + lane;
#pragma unroll
                          for (int j = 0; j < 4; ++j) xq[p][j] = xr[64 * j]; }
                        GAS u32x2* o8 = (GAS u32x2*)(HN + (size_t)mc * D) + lane;
#pragma unroll
                        for (int j = 0; j < 4; ++j) { u32x2 w; w.x = cvt_pk_bf16(v[j].x, v[j].y); w.y = cvt_pk_bf16(v[j].z, v[j].w); o8[64 * j] = w; }
                        const float r = 1.0f / sqrtf(wave_sum(s) * (1.f / D) + EPS);
                        if (lane == 0) R0[mc] = r; } } }
        }
    }
    GRID_BAR();

    if (PH(1) && PH(19)) {
        PHASE_VARS
        SchedPlain S{(const GAS char*)HN, (const GAS char*)WIN, (size_t)256 * D * 2, (size_t)256 * D * 2, T / 256, 8, G, bx, 1};
        EpiRopeQK E{Qb, Kb, rot, R0, KT, l2g, lds + STG_OFF};
        pg8::gemm_phase<EpiRopeQK, SchedPlain, false>(lds, wave_k, D, D, D, S, E);
    }
    if (PH(1) && PH(21)) {
        PHASE_VARS
        SchedPlain S{(const GAS char*)(WIN + (size_t)2 * QKW * D), (const GAS char*)HN, (size_t)256 * D * 2, (size_t)256 * D * 2, 8, T / 256, G, bx};
        EpiBf16<true> E{VT, T, R0};
        pg8::gemm_phase<EpiBf16<true>, SchedPlain, false>(lds, wave_k, D, D, D, S, E);
    }
    GRID_BAR();

    if (PH(2)) {
        PHASE_VARS
        SchedPc S{(const GAS char*)Qb, (const GAS char*)Kb, G, bx};
        EpiPc E{PC, (GAS bf16*)(ws + WS_ROT), l2g};
        pg8::gemm_phase<EpiPc, SchedPc, false>(lds, wave_k, QKW, QKW, DK, S, E);
    }
    GRID_BAR();

    if (PH(3)) {
        PHASE_VARS
        for (int u = vcu; u < NB * NH * 8; u += G) { const int hh_ = (u >> 3) & 3; const float l2f = l2g[hh_], l2b = l2g[4 + hh_];
            sweep_unit(lds, Qb, KT, KT, VT, PC, (const GAS bf16*)(ws + WS_ROT), (const GAS bf16*)(ws + WS_CTL + 512 * 1024), Yb, statp, l2f, l2b, u >> 5, hh_, u & 7, wave_k); }
    }
    GRID_BAR();

    if (PH(5)) {
        PHASE_VARS
        SchedPlain S{(const GAS char*)HN, (const GAS char*)(WIN + (size_t)(2 * QKW + VW) * D), (size_t)256 * D * 2, (size_t)256 * D * 2, T / 256, 8, G, bx};
        EpiGate E{Yb, YG, statp, gn_gain, (LAS f32x2*)(lds + 135168), R0};
        pg8::gemm_phase<EpiGate, SchedPlain, false>(lds, wave_k, D, D, D, S, E);
    }
    GRID_BAR();

    if (PH(6)) {
        PHASE_VARS
        SchedPlain S{(const GAS char*)YG, (const GAS char*)WO, (size_t)256 * VW * 2, (size_t)256 * VW * 2, T / 256, 4, G, bx};
        EpiRes<false> E{(const GAS void*)HB, HB, SSQ1};
        pg8::gemm_phase<EpiRes<false>, SchedPlain, false>(lds, wave_k, VW, VW, VW, S, E);
    }
    GRID_BAR();

    if (PH(7)) {
        PHASE_VARS
        LAS float* scr = (LAS float*)(lds + wave * 16384);
        constexpr int I_GU = 2 * (D / 64) * (FFE / 32), I_D = (FFE / 64) * (D / 32);
        const GAS float* psrc = nullptr; GAS unsigned char* pdst = nullptr; int pN = 0, pK = 0;
        auto mk_item = [&](int it) {
            const int e = it / (I_GU + I_D); int r = it - e * (I_GU + I_D);
            if (r < I_GU) { const int nblk = FFE / 32, per = (D / 64) * nblk; const bool up = r >= per; if (up) r -= per;
                const int kb = r / nblk, nb = r - kb * nblk, f0 = 32 * nb, rbase = 256 * (f0 >> 7) + (up ? 128 : 0) + (f0 & 127);
                psrc = (up ? m_wu : m_wg) + (size_t)e * D * FFE + (size_t)(64 * kb) * FFE + f0; pN = FFE; pK = D;
                pdst = WMGU8 + (size_t)e * 2 * FFE * D + (size_t)rbase * D + 64 * kb; }
            else { const int it2 = r - I_GU, nblk = D / 32, kb = it2 / nblk, nb = it2 - kb * nblk;
                psrc = m_wd + (size_t)e * FFE * D + (size_t)(64 * kb) * D + 32 * nb; pN = D; pK = FFE;
                pdst = (GAS unsigned char*)WMD + (size_t)e * D * FFE + (size_t)(32 * nb) * FFE + 64 * kb; } };
        float rg[32];
        if (gw < NE * (I_GU + I_D)) { mk_item(gw);
#pragma unroll
            for (int i = 0; i < 32; ++i) rg[i] = psrc[(size_t)(2 * i + (lane >> 5)) * pN + (lane & 31)]; }
        for (int it = gw; it < NE * (I_GU + I_D); it += NGW) {
            GAS unsigned char* cdst = pdst; const int cK = pK;
#pragma unroll
            for (int i = 0; i < 32; ++i) scr[(2 * i + (lane >> 5)) * 33 + (lane & 31)] = rg[i];
            LDS_WAIT(); asm volatile("" ::: "memory");
            if (it + NGW < NE * (I_GU + I_D)) { mk_item(it + NGW);
#pragma unroll
                for (int i = 0; i < 32; ++i) rg[i] = psrc[(size_t)(2 * i + (lane >> 5)) * pN + (lane & 31)]; }
            const int c = lane & 7;
#pragma unroll
            for (int j = 0; j < 4; ++j) { const int n = (lane >> 3) + 8 * j; const LAS float* sp = scr + (8 * c) * 33 + n;
                u32x2 o; o.x = pk4_fp8(sp[0 * 33] * 64.0f, sp[1 * 33] * 64.0f, sp[2 * 33] * 64.0f, sp[3 * 33] * 64.0f); o.y = pk4_fp8(sp[4 * 33] * 64.0f, sp[5 * 33] * 64.0f, sp[6 * 33] * 64.0f, sp[7 * 33] * 64.0f);
                *(GAS u32x2*)(cdst + (size_t)n * cK + 8 * c) = o; }
            LDS_WAIT(); asm volatile("" ::: "memory");
        }
    }
    __syncthreads();

    if (PH(8)) {
        PHASE_VARS
        SchedPlain S{(const GAS char*)HB, (const GAS char*)WGU, (size_t)256 * D * 2, (size_t)256 * D * 2, T / 256, 2 * FFD / 256, G, bx};
        EpiSwiGLU<true, true> E{(GAS void*)ACTD, FFD, SSQ1, (LAS float*)(lds + 135168)};
        pg8::gemm_phase<EpiSwiGLU<true, true>, SchedPlain, false>(lds, wave_k, D, D, D, S, E);
    }
    GRID_BAR();
    if (PH(9)) {
        PHASE_VARS
        SchedPlainF8 S{{(const GAS char*)ACTD, (const GAS char*)WD, (size_t)256 * FFD, (size_t)256 * FFD, T / 256, 4, G, bx}};
        EpiRes<false> E{(const GAS void*)HB, HB, SSQ2, mix_norm + D, (GAS float*)(ws + WS_ZP)};
        pg8::gemm_phase<EpiRes<false>, SchedPlainF8, false, true>(lds, wave_k, FFD, FFD, FFD, S, E);
    }
    GRID_BAR();

    if (PH(11)) {
        PHASE_VARS
        SchedFnA S{(const GAS char*)WC, (const GAS char*)HB, G, bx};
        EpiZ2 E{Z2, SSQ2, (LAS float*)(lds + 135168), TWT, lds + STG_OFF};
        pg8::gemm_phase<EpiZ2, SchedFnA, false>(lds, wave_k, 256, D, 256, S, E);
        for (int i = vcu * 512 + tid; i < T * 4; i += G * 512) { const int t = i >> 2, g = i & 3; const GAS f32x4* sp = (const GAS f32x4*)(SSQ2 + (size_t)t * 16); float a = 0.f;
#pragma unroll
            for (int k = 0; k < 4; ++k) { const f32x4 v = sp[k]; a += (v[0] + v[1]) + (v[2] + v[3]); }
            const f32x4 zv = *(const GAS f32x4*)((const GAS float*)(ws + WS_ZP) + (size_t)t * 16 + g * 4);
            ((GAS float*)(ws + WS_Z0T))[((size_t)(t >> 12) * 4 + g) * SEQ + (t & (SEQ - 1))] = __builtin_amdgcn_rsqf(a * (1.f / D) + EPS) * ((zv[0] + zv[1]) + (zv[2] + zv[3])); }
    }
    GRID_BAR();
    if (PH(12)) {
        PHASE_VARS
        SchedFnB S{(GAS const char*)WSEQ, (GAS const char*)Z2, G, bx};
        EpiYf E{HNB};
        pg8::gemm_phase<EpiYf, SchedFnB, false>(lds, wave_k, 1024, 1024, 1024, S, E);
        __syncthreads();
        {
            LAS float* z0 = (LAS float*)lds;
            LAS float* u0 = (LAS float*)(lds + 16384);
            LAS f32x2* w5 = (LAS f32x2*)(lds + 16384 + 16 * 516 * 4);
            for (int blk = vcu; blk < 32 * 8; blk += G) {
                const int seq = blk >> 3, jc = blk & 7, b = seq >> 2, g = seq & 3;
                { const GAS f32x4* zt = (const GAS f32x4*)((const GAS float*)(ws + WS_Z0T) + (size_t)seq * SEQ);
                  const f32x4 za = zt[tid], zb_ = zt[tid + 512];
                  { const float ang = (float)tid * (1.0f / 256.0f); w5[tid] = (f32x2){cospif(ang), sinpif(ang)}; }
                  *(LAS f32x4*)(z0 + 4 * tid) = za; *(LAS f32x4*)(z0 + 4 * (tid + 512)) = zb_; }
                __syncthreads();
                { const int a = tid; float xr[8], xi[8], Xr[8], Xi[8];
#pragma unroll
                  for (int bb = 0; bb < 8; ++bb) { xr[bb] = z0[a + 512 * bb]; xi[bb] = 0.f; }
                  fft8(xr, xi, Xr, Xi);
#pragma unroll
                  for (int kb = 0; kb < 8; ++kb) { const f32x2 tw = TWT[a * 8 + kb]; u0[(kb * 2) * 516 + a] = Xr[kb] * tw.x + Xi[kb] * tw.y; u0[(kb * 2 + 1) * 516 + a] = Xi[kb] * tw.x - Xr[kb] * tw.y; } }
                __syncthreads();
                if (wave < 4) { const int i = lane & 15, kq = lane >> 4, ka0 = jc * 64 + wave * 16; f32x4 cacc = {0.f, 0.f, 0.f, 0.f};
                    const GAS bf16* wrow = WSEQ + (size_t)(ka0 + i) * 1024 + 8 * kq;
#pragma unroll 4
                    for (int ks = 0; ks < 32; ++ks) { const bf16x8 av = *(const GAS bf16x8*)(wrow + 32 * ks);
                        const int k = 32 * ks + 8 * kq; u32x4 bw = {0u, 0u, 0u, 0u};
                        if (i < 8) { const LAS float* up = u0 + (i * 2 + (k >> 9)) * 516 + (k & 511); const f32x4 lo = *(const LAS f32x4*)up, hi = *(const LAS f32x4*)(up + 4);
                            bw.x = cvt_pk_bf16(lo[0], lo[1]); bw.y = cvt_pk_bf16(lo[2], lo[3]); bw.z = cvt_pk_bf16(hi[0], hi[1]); bw.w = cvt_pk_bf16(hi[2], hi[3]); }
                        cacc = __builtin_amdgcn_mfma_f32_16x16x32_bf16(av, __builtin_bit_cast(bf16x8, bw), cacc, 0, 0, 0); }
                    if (i < 8) {
#pragma unroll
                        for (int q = 0; q < 4; ++q) HNB[(size_t)(b * SEQ + 8 * (ka0 + 4 * kq + q) + i) * D + g * 256 + 255] = (bf16)(cvt_pk_bf16(cacc[q], 0.f) & 0xffffu); } }
                __syncthreads();
            }
        }
    }
    GRID_BAR();
    if (PH(13)) {
        PHASE_VARS
        SchedPlain S{(const GAS char*)HNB, (const GAS char*)WF, (size_t)256 * D * 2, (size_t)256 * D * 2, T / 256, 4, G, bx};
        EpiRes<false> E{(const GAS void*)HB, HB, nullptr};
        pg8::gemm_phase<EpiRes<false>, SchedPlain, false>(lds, wave_k, D, D, D, S, E);
    }
    GRID_BAR();

    if (PH(14)) {
        PHASE_VARS
        LAS float* wrl = (LAS float*)lds;
        LAS int* le = (LAS int*)(lds + 32768);
        for (int i = tid; i < D * NE; i += NWAVES * 64) wrl[(i & 7) * D + (i >> 3)] = moe_router[i];
        for (int i = vcu * 512 + tid; i < 2 * MOE_ROWS; i += G * 512) rowtok[i] = -1;
        __syncthreads();
        for (int tb = vcu; tb < T / 128; tb += G) {
            const int mbase = tb * 128 + wave * 16;
            u32x4 xn[4][2];
#pragma unroll
            for (int k = 0; k < 4; ++k)
#pragma unroll
                for (int jh = 0; jh < 2; ++jh) xn[k][jh] = *(const GAS u32x4*)(HB + (size_t)(mbase + k) * D + 512 * jh + 8 * lane);
#pragma unroll 1
            for (int r4 = 0; r4 < 16; r4 += 4) {
                f32x4 v[4][4]; float s[4];
#pragma unroll
                for (int k = 0; k < 4; ++k) {
#pragma unroll
                    for (int jh = 0; jh < 2; ++jh) { const u32x4 x = xn[k][jh];
                        v[k][2 * jh] = (f32x4){bf_lo(x.x), bf_hi(x.x), bf_lo(x.y), bf_hi(x.y)}; v[k][2 * jh + 1] = (f32x4){bf_lo(x.z), bf_hi(x.z), bf_lo(x.w), bf_hi(x.w)}; }
                    float a = 0.f;
#pragma unroll
                    for (int j = 0; j < 4; ++j) a += (v[k][j].x * v[k][j].x + v[k][j].y * v[k][j].y) + (v[k][j].z * v[k][j].z + v[k][j].w * v[k][j].w);
                    s[k] = a; }
                if (r4 + 4 < 16) {
#pragma unroll
                    for (int k = 0; k < 4; ++k)
#pragma unroll
                        for (int jh = 0; jh < 2; ++jh) xn[k][jh] = *(const GAS u32x4*)(HB + (size_t)(mbase + r4 + 4 + k) * D + 512 * jh + 8 * lane);
                }
                f32x4 gv[4];
#pragma unroll
                for (int j = 0; j < 4; ++j) gv[j] = *(const GAS f32x4*)(ffn_norm + D + rmsb_col(j, lane));
#pragma unroll
                for (int k = 0; k < 4; ++k) s[k] = wave_sum_valu(s[k]);
#pragma unroll
                for (int k = 0; k < 4; ++k) { const float r = 1.0f / sqrtf(s[k] * (1.f / D) + EPS); GAS unsigned char* o8 = HN8 + (size_t)(mbase + r4 + k) * D;
#pragma unroll
                    for (int jh = 0; jh < 2; ++jh) { v[k][2 * jh] = v[k][2 * jh] * r * gv[2 * jh]; v[k][2 * jh + 1] = v[k][2 * jh + 1] * r * gv[2 * jh + 1];
                        u32x2 w; w.x = pk4_fp8(v[k][2 * jh].x, v[k][2 * jh].y, v[k][2 * jh].z, v[k][2 * jh].w); w.y = pk4_fp8(v[k][2 * jh + 1].x, v[k][2 * jh + 1].y, v[k][2 * jh + 1].z, v[k][2 * jh + 1].w);
                        *(GAS u32x2*)(o8 + 512 * jh + 8 * lane) = w; } }
                float lg[4][8];
#pragma unroll
                for (int k = 0; k < 4; ++k)
#pragma unroll
                    for (int e = 0; e < 8; ++e) lg[k][e] = 0.f;
#pragma unroll
                for (int j = 0; j < 4; ++j) { const int col0 = rmsb_col(j, lane);
#pragma unroll
                    for (int e = 0; e < 8; ++e) { const f32x4 wv = *(const LAS f32x4*)(wrl + e * D + col0);
#pragma unroll
                        for (int k = 0; k < 4; ++k) lg[k][e] += (v[k][j].x * wv.x + v[k][j].y * wv.y) + (v[k][j].z * wv.z + v[k][j].w * wv.w); } }
#pragma unroll
                for (int k = 0; k < 4; ++k)
#pragma unroll
                    for (int e = 0; e < 8; ++e) lg[k][e] = wave_sum_valu(lg[k][e]);
#pragma unroll
                for (int k = 0; k < 4; ++k) { const int tl = wave * 16 + r4 + k, m = tb * 128 + tl;
                    int e0 = 0; float b0 = lg[k][0];
#pragma unroll
                    for (int e = 1; e < 8; ++e) if (lg[k][e] > b0) { b0 = lg[k][e]; e0 = e; }
                    int e1 = -1; float b1 = -3.0e38f;
#pragma unroll
                    for (int e = 0; e < 8; ++e) if (e != e0 && lg[k][e] > b1) { b1 = lg[k][e]; e1 = e; }
                    const float w0 = 1.0f / (1.0f + __expf(b1 - b0));
                    if (lane == 0) { toke[2 * m] = e0; toke[2 * m + 1] = e1; tokw[2 * m] = w0; tokw[2 * m + 1] = 1.0f - w0; le[tl] = e0; le[128 + tl] = e1; } }
            }
            __syncthreads();
            if (tid < 16) { const int s = tid >> 3, e = tid & 7; int c = 0; for (int i = 0; i < 128; ++i) c += (le[s * 128 + i] == e) ? 1 : 0; bcnt[tb * 16 + tid] = c; }
            if (tid >= 64 && tid < 128) { const int pi = tid - 64; int c = 0; for (int i = 0; i < 128; ++i) c += (le[i] * 8 + le[128 + i] == pi) ? 1 : 0; pcnt[tb * 64 + pi] = c; }
            __syncthreads();
        }
    }
    GRID_BAR();

    LAS int* segoff = (LAS int*)(lds + 132096);
    LAS int* ntile = (LAS int*)(lds + 132096 + 64);
    LAS unsigned char* tile_e = (LAS unsigned char*)(lds + 132096 + 128);
    if (PH(15)) {
        PHASE_VARS
        constexpr int PP = 65, CP = 17;
        LAS int* pfx = (LAS int*)lds;
        LAS int* cph = (LAS int*)(lds + 67072);
        LAS int* fq_ = (LAS int*)(lds + 67072 + 17408);
        LAS int* tot = fq_ + 64;
        LAS int* tpi = tot + 16;
        LAS int* tex = tpi + 128;
        {
            u32x4 pv[8];
#pragma unroll
            for (int k = 0; k < 8; ++k) pv[k] = *(const GAS u32x4*)(pcnt + 4 * (tid + 512 * k));
#pragma unroll
            for (int k = 0; k < 8; ++k) { const int i = 4 * (tid + 512 * k); LAS int* dp = pfx + (i >> 6) * PP + (i & 63); dp[0] = (int)pv[k].x; dp[1] = (int)pv[k].y; dp[2] = (int)pv[k].z; dp[3] = (int)pv[k].w; }
        }
        __syncthreads();
        LAS int* sgt = (LAS int*)(lds + 90112);
        { const int col = tid & 63, seg = tid >> 6; int run = 0;
          for (int k = 0; k < 32; ++k) { const int ix = (seg * 32 + k) * PP + col; const int c = pfx[ix]; pfx[ix] = run; run += c; }
          sgt[seg * 64 + col] = run; }
        __syncthreads();
        { const int col = tid & 63, seg = tid >> 6; int off = 0;
          for (int s2 = 0; s2 < seg; ++s2) off += sgt[s2 * 64 + col];
          for (int k = 0; k < 32; ++k) pfx[(seg * 32 + k) * PP + col] += off;
          if (seg == 7) pfx[256 * PP + col] = off + sgt[7 * 64 + col]; }
        __syncthreads();
        if (tid == 0) {
            int tv[64];
#pragma unroll
            for (int i = 0; i < 64; ++i) tv[i] = pfx[256 * PP + i];
            int d[8], r[8]; int rs = 0;
#pragma unroll
            for (int e = 0; e < 8; ++e) { int c = 0;
#pragma unroll
                for (int x2 = 0; x2 < 8; ++x2) c += tv[e * 8 + x2];
                r[e] = c & 255; d[e] = -(c & 255); rs += c & 255; }
            const int extra = rs >> 8;
#pragma unroll
            for (int k = 0; k < 7; ++k) if (k < extra) { int be = -1, br = -1;
#pragma unroll
                for (int e = 0; e < 8; ++e) if (d[e] < 0 && d[e] == -r[e] && r[e] > br) { br = r[e]; be = e; }
#pragma unroll
                for (int e = 0; e < 8; ++e) if (e == be) d[e] += 256; }
#pragma unroll
            for (int a = 0; a < 8; ++a)
#pragma unroll
                for (int e = 0; e < 8; ++e) { int fl = 0;
                    if (a != e && d[a] < 0 && d[e] > 0) { fl = -d[a]; if (d[e] < fl) fl = d[e]; if (tv[a * 8 + e] < fl) fl = tv[a * 8 + e]; d[a] += fl; d[e] -= fl; }
                    fq_[a * 8 + e] = fl; }
        }
        __syncthreads();
        if (tid < 256) {
            int c0[8], c1[8];
#pragma unroll
            for (int e = 0; e < 8; ++e) { c0[e] = 0; c1[e] = 0; }
#pragma unroll
            for (int a = 0; a < 8; ++a)
#pragma unroll
            for (int e = 0; e < 8; ++e) { const int pi = a * 8 + e; const int cnt = pfx[(tid + 1) * PP + pi] - pfx[tid * PP + pi]; int fl = fq_[pi] - pfx[tid * PP + pi]; fl = fl < 0 ? 0 : (fl > cnt ? cnt : fl);
#pragma unroll
                for (int q = 0; q < 8; ++q) { c0[q] += (q == a ? cnt - fl : 0) + (q == e ? fl : 0); c1[q] += (q == e ? cnt - fl : 0) + (q == a ? fl : 0); } }
#pragma unroll
            for (int e = 0; e < 8; ++e) { cph[tid * CP + e] = c0[e]; cph[tid * CP + 8 + e] = c1[e]; }
        }
        __syncthreads();
        { const int col = tid & 15, seg = tid >> 4; int run = 0;
          for (int k = 0; k < 8; ++k) { const int ix = (seg * 8 + k) * CP + col; const int c = cph[ix]; cph[ix] = run; run += c; }
          sgt[seg * 16 + col] = run; }
        __syncthreads();
        { const int col = tid & 15, seg = tid >> 4; int off = 0;
          for (int s2 = 0; s2 < seg; ++s2) off += sgt[s2 * 16 + col];
          for (int k = 0; k < 8; ++k) cph[(seg * 8 + k) * CP + col] += off;
          if (seg == 31) tot[col] = off + sgt[31 * 16 + col]; }
        __syncthreads();
        if (tid < 2) { int off = 0, nt = 0; for (int e = 0; e < 8; ++e) { segoff[tid * 8 + e] = off; const int tl = (tot[tid * 8 + e] + 255) >> 8; for (int q = 0; q < tl; ++q) tile_e[tid * 160 + nt + q] = (unsigned char)e; nt += tl; off += tl * 256; } ntile[tid] = nt; }
        __syncthreads();
        for (int tb = vcu; tb < T / 128; tb += G) {
            int e0 = 0, e1 = 0, flip = 0, pi = 0, rk = 0, ex[2] = {0, 0}, rkp[2] = {0, 0};
            const unsigned long long ltm = (1ull << lane) - 1ull;
            if (tid < 128) { const int m = tb * 128 + tid; e0 = toke[2 * m]; e1 = toke[2 * m + 1]; pi = e0 * 8 + e1; int mine = 0;
#pragma unroll 8
                for (int k = 0; k < 64; ++k) { const unsigned long long mk = __ballot(pi == k); if (pi == k) rk = __builtin_popcountll(mk & ltm); if (lane == k) mine = __builtin_popcountll(mk); }
                if (wave == 0) tpi[lane] = mine; }
            __syncthreads();
            if (tid < 128) { if (wave == 1) rk += tpi[pi];
                flip = (pfx[tb * PP + pi] + rk) < fq_[pi] ? 1 : 0; ex[0] = flip ? e1 : e0; ex[1] = flip ? e0 : e1; int minep = 0;
#pragma unroll
                for (int ph = 0; ph < 2; ++ph)
#pragma unroll
                    for (int k = 0; k < 8; ++k) { const unsigned long long mk = __ballot(ex[ph] == k); if (ex[ph] == k) rkp[ph] = __builtin_popcountll(mk & ltm); if (lane == ph * 8 + k) minep = __builtin_popcountll(mk); }
                if (wave == 0 && lane < 16) tex[lane] = minep; }
            __syncthreads();
            if (tid < 128) { const int m = tb * 128 + tid;
#pragma unroll
                for (int ph = 0; ph < 2; ++ph) { const int e = ex[ph]; const int r2 = rkp[ph] + (wave == 1 ? tex[ph * 8 + e] : 0);
                    const int row = segoff[ph * 8 + e] + cph[tb * CP + ph * 8 + e] + r2;
                    rowtok[ph * MOE_ROWS + row] = m; rowgate[ph * MOE_ROWS + row] = tokw[2 * m + (ph ^ flip)]; } }
            __syncthreads();
        }
    }
    GRID_BAR();

    if (PH(16))
#pragma unroll
    for (int s = 0; s < 2; ++s) {
        {
            PHASE_VARS
            SchedMoe S{(const GAS char*)HN8, (const GAS char*)WMGU8, rowtok + s * MOE_ROWS, tile_e + s * 160, 0, (size_t)2 * FFE * D, (size_t)256 * D, ntile[s], 2 * FFE / 256, G, bx, true, 0x7f7f7f7f};
            EpiSwiGLU<true> E{(GAS void*)ACTM, FFE};
            pg8::gemm_phase<EpiSwiGLU<true>, SchedMoe, true, true>(lds, wave_k, D, D, D, S, E);
        }
        GRID_BAR();
        {
            PHASE_VARS
            SchedMoe S{(const GAS char*)ACTM, (const GAS char*)WMD, rowtok + s * MOE_ROWS, tile_e + s * 160, (size_t)256 * FFE, (size_t)D * FFE, (size_t)256 * FFE, ntile[s], 4, G, bx, false, 0x7c7c7c7c};
            EpiMoeDown E{HB, rowtok + s * MOE_ROWS, rowgate + s * MOE_ROWS};
            pg8::gemm_phase<EpiMoeDown, SchedMoe, false, true>(lds, wave_k, FFE, FFE, FFE, S, E);
        }
        GRID_BAR();
    }

    if (PH(17)) {
        PHASE_VARS
        const bool bad = __hip_atomic_load((GAS unsigned*)(ws + WS_CTL) + CW_BAR + XB_TMO, RLX_AGENT) != 0u;
        f32x4 gfin[4];
#pragma unroll
        for (int j = 0; j < 4; ++j) gfin[j] = *(const GAS f32x4*)(final_norm + rmsb_col(j, lane));
        u32x4 xq[2][2];
#pragma unroll
        for (int p = 0; p < 2; ++p) { const int mp = gw + p * NGW < T ? gw + p * NGW : gw;
#pragma unroll
            for (int jh = 0; jh < 2; ++jh) xq[p][jh] = *(const GAS u32x4*)(HB + (size_t)mp * D + 512 * jh + 8 * lane); }
        for (int m = gw; m < T; m += 2 * NGW) {
#pragma unroll
            for (int p = 0; p < 2; ++p) { const int mc = m + p * NGW;
                if (mc < T) {
                    GAS float* orow = hres + (size_t)mc * D;
                    const u32x4 x0 = xq[p][0], x1 = xq[p][1];
                    { const int mn = mc + 2 * NGW < T ? mc + 2 * NGW : mc;
#pragma unroll
                      for (int jh = 0; jh < 2; ++jh) xq[p][jh] = *(const GAS u32x4*)(HB + (size_t)mn * D + 512 * jh + 8 * lane); }
                    f32x4 v[4]; float s = 0.f;
                    v[0] = (f32x4){bf_lo(x0.x), bf_hi(x0.x), bf_lo(x0.y), bf_hi(x0.y)}; v[1] = (f32x4){bf_lo(x0.z), bf_hi(x0.z), bf_lo(x0.w), bf_hi(x0.w)};
                    v[2] = (f32x4){bf_lo(x1.x), bf_hi(x1.x), bf_lo(x1.y), bf_hi(x1.y)}; v[3] = (f32x4){bf_lo(x1.z), bf_hi(x1.z), bf_lo(x1.w), bf_hi(x1.w)};
#pragma unroll
                    for (int j = 0; j < 4; ++j) s += (v[j].x * v[j].x + v[j].y * v[j].y) + (v[j].z * v[j].z + v[j].w * v[j].w);
                    const float r = bad ? __builtin_nanf("") : 1.0f / sqrtf(wave_sum(s) * (1.f / D) + EPS);
#pragma unroll
                    for (int j = 0; j < 4; ++j) { const int col = rmsb_col(j, lane); *(GAS f32x4*)(orow + col) = v[j] * r * gfin[j]; } } }
        }
    }
}

extern "C" void kernel_launch(void* const* d_in, const int* in_sizes, int n_in, void* d_out, int out_size, void* d_ws, size_t ws_size, hipStream_t stream) {
    static int grid = 0;
    if (grid == 0) {
        if (n_in != 16 || in_sizes[0] != T * D || out_size != T * D || ws_size < WS_END) { fprintf(stderr, "kernel_launch: unexpected shapes (n_in %d, in0 %d, out %d, ws %zu)\n", n_in, n_in > 0 ? in_sizes[0] : -1, out_size, ws_size); grid = -1; return; }
        int dev = 0, cus = 0, per_cu = 0;
        if (hipGetDevice(&dev) != hipSuccess || hipDeviceGetAttribute(&cus, hipDeviceAttributeMultiprocessorCount, dev) != hipSuccess) { grid = -1; return; }
        if (hipFuncSetAttribute((const void*)fwd_kernel, hipFuncAttributeMaxDynamicSharedMemorySize, LDS_BYTES) != hipSuccess) { fprintf(stderr, "kernel_launch: hipFuncSetAttribute failed\n"); grid = -1; return; }
        if (hipOccupancyMaxActiveBlocksPerMultiprocessor(&per_cu, (const void*)fwd_kernel, NWAVES * 64, LDS_BYTES) != hipSuccess || per_cu < 1) { fprintf(stderr, "kernel_launch: occupancy query says %d\n", per_cu); }
        (void)hipGetLastError();
        grid = cus;
    }
    if (grid < 0) return;
    if (hipMemsetAsync((char*)d_ws + WS_CTL, 0, CTL_ZERO_BYTES, stream) != hipSuccess) return;
    Args a{};
    for (int i = 0; i < 16; ++i) a.in[i] = (const float*)d_in[i];
    a.out = (float*)d_out; a.ws = (unsigned char*)d_ws;
    hipLaunchKernelGGL(fwd_kernel, dim3(grid), dim3(NWAVES * 64), LDS_BYTES, stream, a);
}
```
